# Optimizing an MI355X kernel written in HIP

```python
import math
import jax, jax.numpy as jnp
from jax import lax
import numpy as np

D_MODEL = 1024
BATCH = 4
SEQ = 4096
DEPTH = 4

N_EVEN = (DEPTH + 1) // 2
N_ODD = DEPTH // 2
RMS_EPS = 1e-6

GDN_HEADS = 4
GDN_DK = 128
GDN_DV = 128
GDN_CONV = 4
GDN_CHUNK = 64
GDN_QK = GDN_HEADS * GDN_DK
GDN_VD = GDN_HEADS * GDN_DV
GDN_SPLITS = (GDN_QK, GDN_QK, GDN_VD, GDN_VD, GDN_HEADS, GDN_HEADS)
GDN_COLS = sum(GDN_SPLITS)

RWKV_HEADS = 8
RWKV_HEAD = 64
RWKV_DIM = RWKV_HEADS * RWKV_HEAD
DECAY_LORA = 32
AAA_LORA = 32
MV_LORA = 32
GATE_LORA = 96
RWKV_LN_EPS = 64e-5
RWKV_SPLITS = (RWKV_DIM, RWKV_DIM, RWKV_DIM, DECAY_LORA, AAA_LORA, GATE_LORA)
RWKV_COLS = sum(RWKV_SPLITS)

EV_COLS = GDN_COLS + RWKV_COLS
MIX_WIDTH_EVEN = GDN_VD + RWKV_DIM

DIL_PATTERNS = ((128, 1), (512, 4), (2048, 16))
N_DIL_GROUPS = len(DIL_PATTERNS)
DIL_HEADS = 8
DIL_HEAD_DIM = 64
DIL_WIDTH = DIL_HEADS * DIL_HEAD_DIM
DIL_QKV = N_DIL_GROUPS * DIL_WIDTH
OD_COLS = 3 * DIL_QKV
ATT_BLOCK = 128
ROPE_THETA = 10000.0

N_GROUPS = 4
EXPERTS_PER_GROUP = 4
N_EXPERTS = N_GROUPS * EXPERTS_PER_GROUP
EXPERT_FF = 256
TOP_K_INNER = 2

kernel_name = "hybrid_gdn_rwkv7_dilated_hmoe"


def rmsnorm(x, gain):
    xf = x.astype(jnp.float32)
    y = xf * lax.rsqrt(jnp.mean(xf * xf, axis=-1, keepdims=True) + RMS_EPS)
    return (y * gain.astype(jnp.float32)).astype(x.dtype)


def l2norm(t):
    return t * lax.rsqrt(jnp.sum(t * t, axis=-1, keepdims=True) + 1e-6)


def split_cols(h, sizes):
    return jnp.split(h, np.cumsum(sizes)[:-1].tolist(), axis=-1)


def token_shift(h):
    return jnp.pad(h, ((0, 0), (1, 0), (0, 0)))[:, :-1]


def causal_depthwise_conv(x, w):
    K = w.shape[0]
    S = x.shape[1]
    xp = jnp.pad(x, ((0, 0), (K - 1, 0), (0, 0)))
    return sum(xp[:, i:i + S] * w[i] for i in range(K))


def gated_delta_rule_chunked(q, k, v, g, beta):
    B, S, H, Dk = q.shape
    Dv = v.shape[-1]
    C = GDN_CHUNK
    N = S // C

    def to_chunks(t):
        return jnp.moveaxis(t.reshape(B, N, C, H, *t.shape[3:]), 3, 1)

    q, k, v, g, beta = (to_chunks(t) for t in (q, k, v, g, beta))
    gc = jnp.cumsum(g, axis=-1)
    causal = jnp.tril(jnp.ones((C, C), bool))
    strict = jnp.tril(jnp.ones((C, C), bool), -1)
    diff = gc[..., :, None] - gc[..., None, :]
    decay = jnp.where(causal, jnp.exp(jnp.where(causal, diff, 0.0)), 0.0)
    kb = k * beta[..., None]
    vb = v * beta[..., None]
    L = jnp.where(strict, jnp.einsum('bhnik,bhnjk->bhnij', kb, k) * decay, 0.0)
    eye = jnp.eye(C, dtype=q.dtype)
    rhs = jnp.concatenate([vb, kb * jnp.exp(gc)[..., None]], axis=-1)
    sol = lax.linalg.triangular_solve(L + eye, rhs, left_side=True, lower=True, unit_diagonal=True)
    u, w = sol[..., :Dv], sol[..., Dv:]
    aqk = jnp.einsum('bhnik,bhnjk->bhnij', q, k) * decay
    q_dec = q * jnp.exp(gc)[..., None]
    g_last = gc[..., -1]
    k_dec = k * jnp.exp(g_last[..., None] - gc)[..., None]

    def step(state, inp):
        u_n, w_n, aqk_n, qd_n, kd_n, gl_n = inp
        v_new = u_n - jnp.einsum('bhck,bhkv->bhcv', w_n, state)
        o = jnp.einsum('bhck,bhkv->bhcv', qd_n, state) + jnp.einsum('bhij,bhjv->bhiv', aqk_n, v_new)
        state = state * jnp.exp(gl_n)[..., None, None] + jnp.einsum('bhck,bhcv->bhkv', kd_n, v_new)
        return state, o

    xs = tuple(jnp.moveaxis(t, 2, 0) for t in (u, w, aqk, q_dec, k_dec, g_last))
    s0 = jnp.zeros((B, H, Dk, Dv), q.dtype)
    _, o = lax.scan(step, s0, xs)
    return jnp.transpose(o, (1, 0, 3, 2, 4)).reshape(B, S, H, Dv)


def gdn_mixer(hA, conv_w, A_log, dt_bias, norm_w):
    B, S, _ = hA.shape
    f32 = jnp.float32
    q, k, v, z, a, b = split_cols(hA, GDN_SPLITS)
    qkv = jax.nn.silu(causal_depthwise_conv(jnp.concatenate([q, k, v], axis=-1), conv_w)).astype(f32)
    q, k, v = split_cols(qkv, (GDN_QK, GDN_QK, GDN_VD))
    q = l2norm(q.reshape(B, S, GDN_HEADS, GDN_DK)) * (GDN_DK ** -0.5)
    k = l2norm(k.reshape(B, S, GDN_HEADS, GDN_DK))
    v = v.reshape(B, S, GDN_HEADS, GDN_DV)
    beta = jax.nn.sigmoid(b.astype(f32))
    g = -jnp.exp(A_log.astype(f32)) * jax.nn.softplus(a.astype(f32) + dt_bias.astype(f32))
    o = gated_delta_rule_chunked(q, k, v, g, beta)
    o = rmsnorm(o, norm_w) * jax.nn.silu(z.astype(f32).reshape(B, S, GDN_HEADS, GDN_DV))
    return o.reshape(B, S, GDN_VD)


def rwkv7_scan(r, w, k, v, a, b):
    B, S, H, N = r.shape

    def step(state, inp):
        r_t, w_t, k_t, v_t, a_t, b_t = inp
        sa = jnp.einsum('bhvk,bhk->bhv', state, a_t)
        state = state * w_t[:, :, None, :] + sa[..., None] * b_t[:, :, None, :] + v_t[..., None] * k_t[:, :, None, :]
        return state, jnp.einsum('bhvk,bhk->bhv', state, r_t)

    xs = tuple(jnp.moveaxis(t, 1, 0) for t in (r, w, k, v, a, b))
    s0 = jnp.zeros((B, H, N, N), r.dtype)
    _, y = lax.scan(step, s0, xs)
    return jnp.moveaxis(y, 0, 1)


def rwkv7_mixer(hB, mu, w0, w2, a0, a2, g2, k_k, k_a, r_k, ln_w, ln_b, v_first, vres):
    B, S, _ = hB.shape
    f32 = jnp.float32
    hB = hB.astype(f32)
    hB = hB + mu * (token_shift(hB) - hB)
    r, k, v, hw, ha, hg = split_cols(hB, RWKV_SPLITS)
    w_log = -jax.nn.softplus(-(w0 + jnp.tanh(hw) @ w2)) - 0.5
    decay = jnp.exp(-jnp.exp(w_log))
    a = jax.nn.sigmoid(a0 + ha @ a2)
    g = jax.nn.sigmoid(hg) @ g2
    if vres is None:
        v_first = v
    else:
        hv, vres_mu, v0, v2 = vres
        hv = hv.astype(f32)
        hv = hv + vres_mu * (token_shift(hv) - hv)
        v = v + (v_first - v) * jax.nn.sigmoid(v0 + hv @ v2)

    def heads(t):
        return t.reshape(B, S, RWKV_HEADS, RWKV_HEAD)

    kk = l2norm(heads(k * k_k))
    k = k * (1.0 + (a - 1.0) * k_a)
    r_h, k_h, v_h, a_h = heads(r), heads(k), heads(v), heads(a)
    y = rwkv7_scan(r_h, heads(decay), k_h, v_h, -kk, kk * a_h)
    mean = jnp.mean(y, axis=-1, keepdims=True)
    var = jnp.mean(jnp.square(y - mean), axis=-1, keepdims=True)
    y = ((y - mean) * lax.rsqrt(var + RWKV_LN_EPS)).reshape(B, S, RWKV_DIM) * ln_w + ln_b
    bonus = jnp.sum(r_h * k_h * r_k, axis=-1, keepdims=True) * v_h
    y = y + bonus.reshape(B, S, RWKV_DIM)
    return y * g, v_first


def rope(x, positions):
    half = x.shape[-1] // 2
    inv_freq = ROPE_THETA ** (-jnp.arange(half, dtype=jnp.float32) * 2.0 / x.shape[-1])
    ang = positions.astype(jnp.float32)[..., None] * inv_freq
    cos, sin = jnp.cos(ang)[:, :, None, :], jnp.sin(ang)[:, :, None, :]
    x1, x2 = x[..., :half], x[..., half:]
    return jnp.concatenate([x1 * cos - x2 * sin, x2 * cos + x1 * sin], axis=-1)


def dilated_window_attention(q, k, v, window, dilation):
    B, S, H, Dh = q.shape
    span = window // dilation
    L = S // dilation
    nb = -(-L // ATT_BLOCK)
    Lp = nb * ATT_BLOCK

    def to_blocks(t):
        t = t.reshape(B, L, dilation, H, Dh)
        t = jnp.pad(t, ((0, 0), (0, Lp - L), (0, 0), (0, 0), (0, 0)))
        return jnp.transpose(t.reshape(B, nb, ATT_BLOCK, dilation, H, Dh), (0, 3, 4, 1, 2, 5))

    def with_prev(t):
        prev = jnp.pad(t, ((0, 0), (0, 0), (0, 0), (1, 0), (0, 0), (0, 0)))[:, :, :, :-1]
        return jnp.concatenate([prev, t], axis=-2)

    qb = to_blocks(q)
    kw = with_prev(to_blocks(k))
    vw = with_prev(to_blocks(v))
    s = jnp.einsum('brhnqd,brhnkd->brhnqk', qb, kw) * (Dh ** -0.5)
    qi = jnp.arange(ATT_BLOCK)[:, None]
    kj = jnp.arange(2 * ATT_BLOCK)[None, :]
    rel = ATT_BLOCK + qi - kj
    blk = jnp.arange(nb)[:, None, None]
    valid = (rel >= 0) & (rel <= span) & ((blk > 0) | (kj >= ATT_BLOCK))
    s = jnp.where(valid, s, -jnp.inf)
    m = jnp.max(s, axis=-1, keepdims=True)
    p = jnp.exp(s - m)
    l = jnp.sum(p, axis=-1, keepdims=True)
    o = jnp.einsum('brhnqk,brhnkd->brhnqd', p, vw) / l
    lse = (m + jnp.log(l))[..., 0]

    def from_blocks(t):
        t = jnp.moveaxis(t, (3, 4), (1, 2))
        t = t.reshape(B, Lp, dilation, H, *t.shape[5:])[:, :L]
        return t.reshape(B, S, H, *t.shape[4:])

    return from_blocks(o), from_blocks(lse)


def dilated_mixer(h, positions):
    B, S, _ = h.shape
    q, k, v = split_cols(h.astype(jnp.float32), (DIL_QKV, DIL_QKV, DIL_QKV))
    shp = (B, S, N_DIL_GROUPS * DIL_HEADS, DIL_HEAD_DIM)
    q = rope(q.reshape(shp), positions)
    k = rope(k.reshape(shp), positions)
    v = v.reshape(shp)
    outs, lses = [], []
    for gi, (window, dilation) in enumerate(DIL_PATTERNS):
        sl = slice(gi * DIL_HEADS, (gi + 1) * DIL_HEADS)
        o, lse = dilated_window_attention(q[:, :, sl], k[:, :, sl], v[:, :, sl], window, dilation)
        outs.append(o)
        lses.append(lse)
    wts = jax.nn.softmax(jnp.stack(lses), axis=0)
    o = jnp.sum(wts[..., None] * jnp.stack(outs), axis=0)
    return o.reshape(B, S, DIL_WIDTH)


def hierarchical_moe(x, w_group, w_expert, w1, w3, w2):
    B, S, D = x.shape
    t = x.reshape(B * S, D)
    f32 = jnp.float32
    group_logits = (t @ w_group).astype(f32)
    group_prob = jax.nn.softmax(group_logits, axis=-1)
    g_sel = jnp.argmax(group_logits, axis=-1)
    p_group = jnp.take_along_axis(group_prob, g_sel[:, None], axis=-1)
    exp_logits = jnp.einsum('td,gde->tge', t, w_expert).astype(f32)
    sel_logits = jnp.take_along_axis(exp_logits, g_sel[:, None, None], axis=1)[:, 0]
    top_val, top_idx = lax.top_k(sel_logits, TOP_K_INNER)
    inner = jax.nn.softmax(top_val, axis=-1) * p_group
    expert_id = g_sel[:, None] * EXPERTS_PER_GROUP + top_idx
    gates = jnp.sum(jax.nn.one_hot(expert_id, N_EXPERTS, dtype=f32) * inner[..., None], axis=1)
    h = jax.nn.silu(jnp.einsum('td,edf->tef', t, w1)) * jnp.einsum('td,edf->tef', t, w3)
    y = jnp.einsum('tef,efd->td', h * gates[..., None].astype(h.dtype), w2)
    return y.reshape(B, S, D)


def setup_inputs(seed: int = 0) -> dict:
    key = jax.random.key(seed)
    ks = iter(jax.random.split(key, 48))
    f32 = jnp.float32

    def nrm(shape, scale):
        return jax.random.normal(next(ks), shape, f32) * scale

    def uni(shape, lo, hi):
        return jax.random.uniform(next(ks), shape, f32, lo, hi)

    NE, NO = N_EVEN, N_ODD
    res_scale = (2 * DEPTH) ** -0.5
    dt = jnp.exp(uni((NE, GDN_HEADS), math.log(1e-3), math.log(1e-1)))
    return {
        'x': nrm((BATCH, SEQ, D_MODEL), 1.0),
        'positions': jnp.broadcast_to(jnp.arange(SEQ, dtype=jnp.int32), (BATCH, SEQ)),
        'ev_norm': 1.0 + nrm((NE, D_MODEL), 0.02),
        'ev_w_in': nrm((NE, D_MODEL, EV_COLS), D_MODEL ** -0.5),
        'rwkv_vres_down': nrm((NE - 1, D_MODEL, MV_LORA), D_MODEL ** -0.5),
        'ev_w_out': nrm((NE, MIX_WIDTH_EVEN, D_MODEL), MIX_WIDTH_EVEN ** -0.5 * res_scale),
        'gdn_conv_w': nrm((NE, GDN_CONV, 2 * GDN_QK + GDN_VD), GDN_CONV ** -0.5),
        'gdn_A_log': jnp.log(uni((NE, GDN_HEADS), 1.0, 16.0)),
        'gdn_dt_bias': dt + jnp.log(-jnp.expm1(-dt)),
        'gdn_norm': 1.0 + nrm((NE, GDN_DV), 0.02),
        'rwkv_mu': uni((NE, RWKV_COLS), 0.0, 1.0),
        'rwkv_w0': uni((NE, RWKV_DIM), -6.5, -1.5),
        'rwkv_w2': nrm((NE, DECAY_LORA, RWKV_DIM), 0.1),
        'rwkv_a0': nrm((NE, RWKV_DIM), 0.1),
        'rwkv_a2': nrm((NE, AAA_LORA, RWKV_DIM), AAA_LORA ** -0.5),
        'rwkv_g2': nrm((NE, GATE_LORA, RWKV_DIM), GATE_LORA ** -0.5),
        'rwkv_k_k': 0.85 + nrm((NE, RWKV_DIM), 0.02),
        'rwkv_k_a': 1.0 + nrm((NE, RWKV_DIM), 0.02),
        'rwkv_r_k': nrm((NE, RWKV_HEADS, RWKV_HEAD), 0.1),
        'rwkv_ln_w': 1.0 + nrm((NE, RWKV_DIM), 0.02),
        'rwkv_ln_b': nrm((NE, RWKV_DIM), 0.02),
        'rwkv_vres_mu': uni((NE - 1, MV_LORA), 0.0, 1.0),
        'rwkv_v0': 1.0 + nrm((NE - 1, RWKV_DIM), 0.1),
        'rwkv_v2': nrm((NE - 1, MV_LORA, RWKV_DIM), MV_LORA ** -0.5),
        'od_norm': 1.0 + nrm((NO, D_MODEL), 0.02),
        'od_w_in': nrm((NO, D_MODEL, OD_COLS), D_MODEL ** -0.5),
        'od_w_out': nrm((NO, DIL_WIDTH, D_MODEL), DIL_WIDTH ** -0.5 * res_scale),
        'ffn_norm': 1.0 + nrm((DEPTH, D_MODEL), 0.02),
        'moe_w_group': nrm((DEPTH, D_MODEL, N_GROUPS), D_MODEL ** -0.5),
        'moe_w_expert': nrm((DEPTH, N_GROUPS, D_MODEL, EXPERTS_PER_GROUP), D_MODEL ** -0.5),
        'moe_w1': nrm((DEPTH, N_EXPERTS, D_MODEL, EXPERT_FF), D_MODEL ** -0.5),
        'moe_w3': nrm((DEPTH, N_EXPERTS, D_MODEL, EXPERT_FF), D_MODEL ** -0.5),
        'moe_w2': nrm((DEPTH, N_EXPERTS, EXPERT_FF, D_MODEL), EXPERT_FF ** -0.5 * res_scale),
        'final_norm': 1.0 + nrm((D_MODEL,), 0.02),
    }


def reference(x, positions, ev_norm, ev_w_in, rwkv_vres_down, ev_w_out,
              gdn_conv_w, gdn_A_log, gdn_dt_bias, gdn_norm,
              rwkv_mu, rwkv_w0, rwkv_w2, rwkv_a0, rwkv_a2, rwkv_g2, rwkv_k_k, rwkv_k_a, rwkv_r_k,
              rwkv_ln_w, rwkv_ln_b, rwkv_vres_mu, rwkv_v0, rwkv_v2,
              od_norm, od_w_in, od_w_out,
              ffn_norm, moe_w_group, moe_w_expert, moe_w1, moe_w3, moe_w2,
              final_norm):
    v_first = None
    for layer in range(DEPTH):
        if layer % 2 == 0:
            i = layer // 2
            h = rmsnorm(x, ev_norm[i])
            if i == 0:
                w_in = ev_w_in[0]
            else:
                w_in = jnp.concatenate([ev_w_in[i], rwkv_vres_down[i - 1]], axis=-1)
            proj = h @ w_in
            hA = proj[..., :GDN_COLS]
            hB = proj[..., GDN_COLS:EV_COLS]
            yA = gdn_mixer(hA, gdn_conv_w[i], gdn_A_log[i], gdn_dt_bias[i], gdn_norm[i])
            vres = None if i == 0 else (proj[..., EV_COLS:], rwkv_vres_mu[i - 1], rwkv_v0[i - 1], rwkv_v2[i - 1])
            yB, v_first = rwkv7_mixer(hB, rwkv_mu[i], rwkv_w0[i], rwkv_w2[i], rwkv_a0[i], rwkv_a2[i], rwkv_g2[i],
                                      rwkv_k_k[i], rwkv_k_a[i], rwkv_r_k[i], rwkv_ln_w[i], rwkv_ln_b[i],
                                      v_first, vres)
            mixed = jnp.concatenate([yA, yB], axis=-1).astype(x.dtype) @ ev_w_out[i]
        else:
            i = layer // 2
            h = rmsnorm(x, od_norm[i])
            mixed = dilated_mixer(h @ od_w_in[i], positions).astype(x.dtype) @ od_w_out[i]
        x = x + mixed
        x = x + hierarchical_moe(rmsnorm(x, ffn_norm[layer]), moe_w_group[layer], moe_w_expert[layer],
                                 moe_w1[layer], moe_w3[layer], moe_w2[layer])
    return rmsnorm(x, final_norm)
```

```cpp
#include <hip/hip_runtime.h>
#include <cstdio>
#include <cstdint>
#include <cmath>
#include <hip/hip_cooperative_groups.h>
namespace cg = cooperative_groups;

typedef unsigned short bf16_t;
typedef short bf16x8 __attribute__((ext_vector_type(8)));
typedef float f32x4 __attribute__((ext_vector_type(4)));
typedef unsigned u32x4 __attribute__((ext_vector_type(4)));
typedef unsigned u32x2 __attribute__((ext_vector_type(2)));
#define DI __device__ __forceinline__

constexpr int T = 16384, SEQ = 4096, BATCH = 4, D = 1024;
constexpr int EVC = 3784, EVLD = 3784, EVPAD = 3840;
constexpr int ODC = 4608;
constexpr int RW0 = 2056;
constexpr int C_R = 2056, C_K = 2568, C_V = 3080, C_HW = 3592, C_HA = 3624, C_HG = 3656, C_HV = 3752;
constexpr int NEXP = 16, FF = 256;
constexpr int HROWS = 34816;

constexpr size_t WS_CTL = 0;
constexpr size_t CTL_EGL = 4096;
constexpr size_t CTL_QUEUE = 49152;
constexpr size_t CTL_CNT = 32768;
constexpr size_t CTL_BAR = 16384;
constexpr size_t WS_LIST = 65536;
constexpr size_t WS_GATE = WS_LIST + 16 * 16384 * 4;
constexpr size_t WS_RK = WS_GATE + 16 * 16384 * 4;
constexpr size_t WS_ROPE = WS_RK + (size_t)T * 8 * 4;
constexpr size_t WS_W = WS_ROPE + (size_t)T * 32 * 8;
constexpr size_t W_IN = 0;
constexpr size_t W_OUT = (size_t)4608 * 1024 * 2;
constexpr size_t W_13 = W_OUT + (size_t)1024 * 1024 * 2;
constexpr size_t W_2 = W_13 + (size_t)16 * 512 * 1024 * 2;
constexpr size_t W_LW = W_2 + (size_t)16 * 1024 * 256 * 2;
constexpr size_t W_BYTES = W_LW + (size_t)512 * 192 * 2;
constexpr size_t WS_HN = WS_W + W_BYTES;
constexpr size_t WS_VF = WS_HN + (size_t)T * 1024 * 2;
constexpr size_t WS_R2 = WS_VF + (size_t)T * 512 * 2;
constexpr size_t WS_PROJ = WS_R2;
constexpr size_t WS_GOPS = WS_R2 + (size_t)T * EVLD * 2;
constexpr size_t GOPS_CH = 73728, GO_WF = 0, GO_QF = 16384, GO_UF = 32768, GO_AF = 49152, GO_KF = 57344;
constexpr size_t WS_ROPS = WS_GOPS + 1024 * GOPS_CH;
constexpr size_t WS_QK = WS_R2;
constexpr size_t WS_VT = WS_QK + (size_t)T * 3072 * 2;
constexpr size_t WS_OG = WS_VT + (size_t)T * 1536 * 2;
constexpr size_t WS_LSE = WS_OG + (size_t)3 * T * 512 * 2;
constexpr size_t WS_END3 = WS_LSE + (size_t)3 * T * 8 * 4;
constexpr size_t WS_YS = WS_R2;
constexpr size_t WS_H = WS_YS + (size_t)2 * T * 1024 * 2;
constexpr size_t WS_GG = WS_ROPS + (size_t)2048 * 16384;
constexpr size_t WS_END0 = WS_GG + (size_t)T * 512 * 2;
constexpr size_t WS_END1 = WS_H + (size_t)HROWS * 256 * 2;
constexpr size_t WS_END2 = WS_R2 + (size_t)T * 4608 * 2;
static_assert(WS_END3 <= WS_END0, "odd-layer regions exceed even-layer footprint");
constexpr size_t WS_END = WS_END0 > WS_END1 ? (WS_END0 > WS_END2 ? WS_END0 : WS_END2) : (WS_END1 > WS_END2 ? WS_END1 : WS_END2);

constexpr size_t WS_DUMMY = WS_END0;
struct P {
    const float* in[34];
    float* out;
    unsigned char* ws;
};
enum { I_X = 0, I_POS, I_EVNORM, I_EVWIN, I_VRESDOWN, I_EVWOUT, I_CONVW, I_ALOG, I_DTB, I_GDNNORM, I_MU, I_W0, I_W2, I_A0, I_A2, I_G2,
       I_KK, I_KA, I_RK, I_LNW, I_LNB, I_VRESMU, I_V0, I_V2, I_ODNORM, I_ODWIN, I_ODWOUT, I_FFNNORM, I_WGROUP, I_WEXPERT, I_W1, I_W3, I_MW2, I_FINAL };

DI int tidx() { int t = threadIdx.x; asm volatile("" : "+v"(t)); return t; }
DI int bidx() { int b = blockIdx.x; asm volatile("" : "+s"(b)); return b; }
typedef __bf16 bf2_t __attribute__((ext_vector_type(2)));
typedef float f2_t __attribute__((ext_vector_type(2)));
DI bf16_t f2bf(float x) { return __builtin_bit_cast(bf16_t, (__bf16)x); }
DI float bf2f(bf16_t h) { return __uint_as_float(((unsigned)h) << 16); }
DI unsigned pack2(float lo, float hi) { const f2_t v = {lo, hi}; return __builtin_bit_cast(unsigned, __builtin_convertvector(v, bf2_t)); }
DI float wave_sum(float v) {
#pragma unroll
    for (int o = 32; o > 0; o >>= 1) v += __shfl_xor(v, o);
    return v;
}
DI float wave_max(float v) {
#pragma unroll
    for (int o = 32; o > 0; o >>= 1) v = fmaxf(v, __shfl_xor(v, o));
    return v;
}
DI float sigmoidf_(float x) { return __builtin_amdgcn_rcpf(1.f + __expf(-x)); }
DI float siluf_(float x) { return x * __builtin_amdgcn_rcpf(1.f + __expf(-x)); }
DI float softplusf_(float x) { return fmaxf(x, 0.f) + __logf(1.f + __expf(-fabsf(x))); }

struct ConvJob { const float* src; bf16_t* dst; int K, N, ldd; int mode; };
DI int rowmap(int mode, int n) { return mode == 0 ? n : ((n >> 4) * 32 + (n & 15) + (mode == 2 ? 16 : 0)); }
DI void conv_tile(const ConvJob& j, int tile, float* lds  ) {
    const int ntn = (j.N + 63) / 64;
    const int tk = tile / ntn, tn = tile % ntn;
    const int tid = tidx();
    __syncthreads();
#pragma unroll
    for (int i = 0; i < 4; ++i) {
        const int e = tid + i * 256, k = e >> 4, n4 = (e & 15) * 4;
        const int gk = tk * 64 + k, gn = tn * 64 + n4;
        float4 v = make_float4(0.f, 0.f, 0.f, 0.f);
        if (gn < j.N) v = *(const float4*)(j.src + (size_t)gk * j.N + gn);
        *(float4*)(lds + k * 68 + n4) = v;
    }
    __syncthreads();
#pragma unroll
    for (int i = 0; i < 2; ++i) {
        const int e = tid + i * 256, n = e & 63, k8 = (e >> 6) * 8;
        const int gn = tn * 64 + n;
        if (gn < j.N) {
            u32x4 w;
            w.x = pack2(lds[(k8 + 0) * 68 + n], lds[(k8 + 1) * 68 + n]); w.y = pack2(lds[(k8 + 2) * 68 + n], lds[(k8 + 3) * 68 + n]);
            w.z = pack2(lds[(k8 + 4) * 68 + n], lds[(k8 + 5) * 68 + n]); w.w = pack2(lds[(k8 + 6) * 68 + n], lds[(k8 + 7) * 68 + n]);
            *(u32x4*)(j.dst + (size_t)rowmap(j.mode, gn) * j.ldd + tk * 64 + k8) = w;
        }
    }
}
DI void phase_convert_io(const P& p, int layer, char* ldsc) {
    float* lds = (float*)ldsc;
    unsigned char* W = p.ws + WS_W;
    const int li = layer >> 1;
    if ((layer & 1) == 0) {
        const ConvJob j0{p.in[I_EVWIN] + (size_t)li * 1024 * 3752, (bf16_t*)(W + W_IN), 1024, 3752, 1024, 0};
        for (int t = bidx(); t < 16 * 59; t += gridDim.x) conv_tile(j0, t, lds);
        if (li == 1) {
            const ConvJob j1{p.in[I_VRESDOWN], (bf16_t*)(W + W_IN) + (size_t)3752 * 1024, 1024, 32, 1024, 0};
            for (int t = bidx(); t < 16; t += gridDim.x) conv_tile(j1, t, lds);
        }
        const ConvJob j2{p.in[I_EVWOUT] + (size_t)li * 1024 * 1024, (bf16_t*)(W + W_OUT), 1024, 1024, 1024, 0};
        for (int t = bidx(); t < 256; t += gridDim.x) conv_tile(j2, t, lds);
        {
            bf16_t* LW = (bf16_t*)(W + W_LW);
            for (int i = bidx() * 256 + tidx(); i < 512 * 192; i += gridDim.x * 256) {
                const int ch = i / 192, j = i % 192;
                float v;
                if (j < 32) v = p.in[I_W2][((size_t)li * 32 + j) * 512 + ch];
                else if (j < 64) v = p.in[I_A2][((size_t)li * 32 + j - 32) * 512 + ch];
                else if (j < 160) v = p.in[I_G2][((size_t)li * 96 + j - 64) * 512 + ch];
                else v = (li == 1) ? p.in[I_V2][(size_t)(j - 160) * 512 + ch] : 0.f;
                LW[i] = f2bf(v);
            }
        }
        const int r0 = (li == 1) ? 3784 : 3752;
        bf16_t* z = (bf16_t*)(W + W_IN) + (size_t)r0 * 1024;
        const size_t n = (size_t)(EVPAD - r0) * 1024;
        for (size_t i = (size_t)bidx() * 256 + tidx(); i < n; i += (size_t)gridDim.x * 256) z[i] = 0;
    } else {
        const ConvJob j0{p.in[I_ODWIN] + (size_t)li * 1024 * 4608, (bf16_t*)(W + W_IN), 1024, 4608, 1024, 0};
        for (int t = bidx(); t < 16 * 72; t += gridDim.x) conv_tile(j0, t, lds);
        const ConvJob j2{p.in[I_ODWOUT] + (size_t)li * 512 * 1024, (bf16_t*)(W + W_OUT), 512, 1024, 512, 0};
        for (int t = bidx(); t < 128; t += gridDim.x) conv_tile(j2, t, lds);
    }
}
DI void phase_convert_moe(const P& p, int layer, char* ldsc, int b0, int bs) {
    float* lds = (float*)ldsc;
    unsigned char* W = p.ws + WS_W;
    for (int t = b0; t < 16 * 3 * 64; t += bs) {
        const int e = t / 192, r = t % 192, which = r / 64, tile = r % 64;
        ConvJob j;
        if (which == 0) j = ConvJob{p.in[I_W1] + ((size_t)layer * 16 + e) * 1024 * 256, (bf16_t*)(W + W_13) + (size_t)e * 512 * 1024, 1024, 256, 1024, 1};
        else if (which == 1) j = ConvJob{p.in[I_W3] + ((size_t)layer * 16 + e) * 1024 * 256, (bf16_t*)(W + W_13) + (size_t)e * 512 * 1024, 1024, 256, 1024, 2};
        else j = ConvJob{p.in[I_MW2] + ((size_t)layer * 16 + e) * 256 * 1024, (bf16_t*)(W + W_2) + (size_t)e * 1024 * 256, 256, 1024, 256, 0};
        conv_tile(j, tile, lds);
    }
}

DI void phase_rope(const P& p) {
    float2* tab = (float2*)(p.ws + WS_ROPE);
    const int* pos = (const int*)p.in[I_POS];
    for (int i = bidx() * 256 + tidx(); i < T * 32; i += gridDim.x * 256) {
        const int t = i >> 5, f = i & 31;
        const float inv = powf(10000.0f, -(float)f * (2.0f / 64.0f));
        const float ang = (float)pos[t] * inv;
        float s, c; sincosf(ang, &s, &c);
        tab[i] = make_float2(c, s);
    }
}

template <int MODE>
DI void phase_prep(const P& p, const float* gain, int layer, bool dry = false) {
    const int lane = tidx() & 63, wid = tidx() >> 6;
    const int nw = gridDim.x * 4;
    bf16_t* hn = (bf16_t*)(p.ws + WS_HN);
    const bf16_t* y0 = (const bf16_t*)(p.ws + WS_YS);
    const bf16_t* y1 = y0 + (size_t)T * 1024;
    for (int t = bidx() * 4 + wid; t < T; t += nw) {
        float4 v[4];
        float ss = 0.f;
#pragma unroll
        for (int i = 0; i < 4; ++i) {
            const size_t off = (size_t)t * 1024 + i * 256 + lane * 4;
            if (MODE == 0) v[i] = *(const float4*)(p.in[I_X] + off);
            else v[i] = *(const float4*)(p.out + off);
            if (MODE == 1 || MODE == 3) {
                const u32x2 a = *(const u32x2*)(y0 + off), b = *(const u32x2*)(y1 + off);
                v[i].x += __uint_as_float(a.x << 16) + __uint_as_float(b.x << 16); v[i].y += __uint_as_float(a.x & 0xffff0000u) + __uint_as_float(b.x & 0xffff0000u);
                v[i].z += __uint_as_float(a.y << 16) + __uint_as_float(b.y << 16); v[i].w += __uint_as_float(a.y & 0xffff0000u) + __uint_as_float(b.y & 0xffff0000u);
            }
            ss += v[i].x * v[i].x + v[i].y * v[i].y + v[i].z * v[i].z + v[i].w * v[i].w;
        }
        ss = wave_sum(ss);
        const float rstd = rsqrtf(ss * (1.0f / 1024.0f) + 1e-6f);
        float lg[20];
        if (MODE == 2) {
#pragma unroll
            for (int q = 0; q < 20; ++q) lg[q] = 0.f;
        }
#pragma unroll
        for (int i = 0; i < 4; ++i) {
            const int col = i * 256 + lane * 4;
            const size_t off = (size_t)t * 1024 + col;
            const float4 g = *(const float4*)(gain + col);
            float4 h; h.x = v[i].x * rstd * g.x; h.y = v[i].y * rstd * g.y; h.z = v[i].z * rstd * g.z; h.w = v[i].w * rstd * g.w;
            float* od = dry ? (float*)(p.ws + WS_DUMMY) + (off & 0x7FFFF) : p.out + off;
            bf16_t* hd = dry ? (bf16_t*)(p.ws + WS_DUMMY + 2097152) + (off & 0x7FFFF) : hn + off;
            if (MODE == 0 || MODE == 1) *(float4*)od = v[i];
            if (MODE == 3) *(float4*)od = h;
            else { u32x2 w; w.x = pack2(h.x, h.y); w.y = pack2(h.z, h.w); *(u32x2*)hd = w; }
            if (MODE == 2) {
                const float hh[4] = {h.x, h.y, h.z, h.w};
                const float* wg = p.in[I_WGROUP] + (size_t)layer * 1024 * 4;
                const float* we = p.in[I_WEXPERT] + (size_t)layer * 4 * 1024 * 4;
#pragma unroll
                for (int e = 0; e < 4; ++e) {
                    const float4 a = *(const float4*)(wg + (size_t)(col + e) * 4);
                    lg[0] += hh[e] * a.x; lg[1] += hh[e] * a.y; lg[2] += hh[e] * a.z; lg[3] += hh[e] * a.w;
#pragma unroll
                    for (int g2 = 0; g2 < 4; ++g2) {
                        const float4 b = *(const float4*)(we + ((size_t)g2 * 1024 + col + e) * 4);
                        lg[4 + g2 * 4 + 0] += hh[e] * b.x; lg[4 + g2 * 4 + 1] += hh[e] * b.y; lg[4 + g2 * 4 + 2] += hh[e] * b.z; lg[4 + g2 * 4 + 3] += hh[e] * b.w;
                    }
                }
            }
        }
        if (MODE == 2) {
#pragma unroll
            for (int q = 0; q < 20; ++q) lg[q] = wave_sum(lg[q]);
            if (lane == 0) {
                int gs = 0; float gm = lg[0];
#pragma unroll
                for (int g2 = 1; g2 < 4; ++g2) if (lg[g2] > gm) { gm = lg[g2]; gs = g2; }
                float den = 0.f;
#pragma unroll
                for (int g2 = 0; g2 < 4; ++g2) den += __expf(lg[g2] - gm);
                const float pg = 1.f / den;
                float el[4];
#pragma unroll
                for (int e = 0; e < 4; ++e) el[e] = gs == 0 ? lg[4 + e] : gs == 1 ? lg[8 + e] : gs == 2 ? lg[12 + e] : lg[16 + e];
                int i1 = 0; float v1 = el[0];
#pragma unroll
                for (int e = 1; e < 4; ++e) if (el[e] > v1) { v1 = el[e]; i1 = e; }
                int i2 = 0; float v2 = -3.4e38f;
#pragma unroll
                for (int e = 0; e < 4; ++e) if (e != i1 && el[e] > v2) { v2 = el[e]; i2 = e; }
                const float e2 = __expf(v2 - v1);
                const float g1 = pg / (1.f + e2), g2v = pg * e2 / (1.f + e2);
                unsigned* cnt = (unsigned*)(p.ws + WS_CTL + CTL_CNT) + layer * 16 * 64;
                int* list = (int*)(p.ws + WS_LIST);
                float* gl = (float*)(p.ws + WS_GATE);
                const int ea = gs * 4 + i1, eb = gs * 4 + i2;
                const unsigned ra = atomicAdd(&cnt[ea * 64], 1u);
                list[ea * 16384 + ra] = t * 2; gl[ea * 16384 + ra] = g1;
                const unsigned rb = atomicAdd(&cnt[eb * 64], 1u);
                list[eb * 16384 + rb] = t * 2 + 1; gl[eb * 16384 + rb] = g2v;
            }
        }
    }
}


DI void phase_router(const P& p, const float* gain, int layer, char* ldsc, bool dry = false) {
    const int tid = tidx(), lane = tid & 63, wid = tid >> 6;
    bf16_t* hn = (bf16_t*)(p.ws + WS_HN);
    const float* wg = p.in[I_WGROUP] + (size_t)layer * 1024 * 4;
    const float* we = p.in[I_WEXPERT] + (size_t)layer * 4 * 1024 * 4;
    unsigned* cnt = dry ? (unsigned*)(p.ws + WS_DUMMY + 3145728) : (unsigned*)(p.ws + WS_CTL + CTL_CNT) + layer * 16 * 64;
    int* list = dry ? (int*)(p.ws + WS_DUMMY) : (int*)(p.ws + WS_LIST);
    float* gl = dry ? (float*)(p.ws + WS_DUMMY + 1048576) : (float*)(p.ws + WS_GATE);
    if (dry) hn = (bf16_t*)(p.ws + WS_DUMMY + 2097152);
    f32x4* WS = (f32x4*)ldsc;
    unsigned* lcnt = (unsigned*)(ldsc + 40960); unsigned* lbase = lcnt + 16; int* e_ent = (int*)(lcnt + 32); unsigned* r_ent = (unsigned*)(e_ent + 32); int* t_ent = (int*)(r_ent + 32); float* g_ent = (float*)(t_ent + 32);
    auto stage = [&](int i, int buf) {
#pragma unroll
        for (int r = 0; r < 5; ++r) {
            const int kk = tid;
            const float* src = (r == 0 ? wg : we + (size_t)(r - 1) * 4096) + (size_t)(i * 256 + kk) * 4;
            WS[buf * 1280 + (r * 4 + (kk & 3)) * 64 + (kk >> 2)] = *(const f32x4*)src;
        }
    };
    for (int tb = bidx() * 16; tb < T; tb += gridDim.x * 16) {
        __syncthreads();
        if (tid < 16) lcnt[tid] = 0u;
        stage(0, 0);
        const int t0 = tb + wid * 4;
        float rstd[4];
#pragma unroll
        for (int q = 0; q < 4; ++q) {
            float ss = 0.f;
#pragma unroll
            for (int i = 0; i < 4; ++i) {
                const float4 x4 = *(const float4*)(p.out + (size_t)(t0 + q) * 1024 + i * 256 + lane * 4);
                ss += x4.x * x4.x + x4.y * x4.y + x4.z * x4.z + x4.w * x4.w;
            }
            ss = wave_sum(ss);
            rstd[q] = rsqrtf(ss * (1.0f / 1024.0f) + 1e-6f);
        }
        float lg[4][20];
#pragma unroll
        for (int q = 0; q < 4; ++q)
#pragma unroll
            for (int j = 0; j < 20; ++j) lg[q][j] = 0.f;
#pragma unroll 1
        for (int i = 0; i < 4; ++i) {
            __syncthreads();
            if (i + 1 < 4) stage(i + 1, (i + 1) & 1);
            const f32x4* W = WS + (i & 1) * 1280;
            const int col = i * 256 + lane * 4;
            const float4 g = *(const float4*)(gain + col);
            float hh[4][4];
#pragma unroll
            for (int q = 0; q < 4; ++q) {
                const float4 x4 = *(const float4*)(p.out + (size_t)(t0 + q) * 1024 + col);
                hh[q][0] = x4.x * rstd[q] * g.x; hh[q][1] = x4.y * rstd[q] * g.y; hh[q][2] = x4.z * rstd[q] * g.z; hh[q][3] = x4.w * rstd[q] * g.w;
                u32x2 w; w.x = pack2(hh[q][0], hh[q][1]); w.y = pack2(hh[q][2], hh[q][3]);
                *(u32x2*)(hn + (dry ? (((size_t)(t0 + q) * 1024 + col) & 0x7FFFF) : ((size_t)(t0 + q) * 1024 + col))) = w;
            }
#pragma unroll
            for (int e = 0; e < 4; ++e) {
                const f32x4 a = W[(0 * 4 + e) * 64 + lane];
#pragma unroll
                for (int q = 0; q < 4; ++q) { lg[q][0] += hh[q][e] * a[0]; lg[q][1] += hh[q][e] * a[1]; lg[q][2] += hh[q][e] * a[2]; lg[q][3] += hh[q][e] * a[3]; }
#pragma unroll
                for (int g2 = 0; g2 < 4; ++g2) {
                    const f32x4 b = W[((1 + g2) * 4 + e) * 64 + lane];
#pragma unroll
                    for (int q = 0; q < 4; ++q) { lg[q][4 + g2 * 4] += hh[q][e] * b[0]; lg[q][5 + g2 * 4] += hh[q][e] * b[1]; lg[q][6 + g2 * 4] += hh[q][e] * b[2]; lg[q][7 + g2 * 4] += hh[q][e] * b[3]; }
                }
            }
        }
#pragma unroll
        for (int q = 0; q < 4; ++q) {
#pragma unroll
            for (int j = 0; j < 20; ++j) lg[q][j] = wave_sum(lg[q][j]);
            if (lane == q) {
                const int t = t0 + q;
                int gs = 0; float gm = lg[q][0];
#pragma unroll
                for (int g2 = 1; g2 < 4; ++g2) if (lg[q][g2] > gm) { gm = lg[q][g2]; gs = g2; }
                float den = 0.f;
#pragma unroll
                for (int g2 = 0; g2 < 4; ++g2) den += __expf(lg[q][g2] - gm);
                const float pg = 1.f / den;
                float el[4];
#pragma unroll
                for (int e = 0; e < 4; ++e) el[e] = gs == 0 ? lg[q][4 + e] : gs == 1 ? lg[q][8 + e] : gs == 2 ? lg[q][12 + e] : lg[q][16 + e];
                int i1 = 0; float v1 = el[0];
#pragma unroll
                for (int e = 1; e < 4; ++e) if (el[e] > v1) { v1 = el[e]; i1 = e; }
                int i2 = 0; float v2 = -3.4e38f;
#pragma unroll
                for (int e = 0; e < 4; ++e) if (e != i1 && el[e] > v2) { v2 = el[e]; i2 = e; }
                const float e2 = __expf(v2 - v1);
                const float g1 = pg / (1.f + e2), g2v = pg * e2 / (1.f + e2);
                const int ea = gs * 4 + i1, eb = gs * 4 + i2;
                const int sl = (wid * 4 + q) * 2;
                e_ent[sl] = ea; r_ent[sl] = atomicAdd(&lcnt[ea], 1u); t_ent[sl] = t * 2; g_ent[sl] = g1;
                e_ent[sl + 1] = eb; r_ent[sl + 1] = atomicAdd(&lcnt[eb], 1u); t_ent[sl + 1] = t * 2 + 1; g_ent[sl + 1] = g2v;
            }
        }
        __syncthreads();
        if (tid < 16) lbase[tid] = lcnt[tid] ? atomicAdd(&cnt[tid * 64], lcnt[tid]) : 0u;
        __syncthreads();
        if (tid < 32) {
            const int e = e_ent[tid];
            const unsigned pos = (lbase[e] + r_ent[tid]) & 16383u;
            list[e * 16384 + pos] = t_ent[tid]; gl[e * 16384 + pos] = g_ent[tid];
        }
    }
}

constexpr int GBK = 64;
typedef __attribute__((address_space(3))) unsigned lds_u32;
struct TileP { const bf16_t* ar[4]; const bf16_t* br[4]; const bf16_t* ar2[4]; };
DI void gemm_core(const TileP& tp, int K, char* lds, f32x4 (&acc)[4][4], int ksplit, bool primed, const TileP& nx, bool have_nx) {
    const bf16_t* const (&ar)[4] = tp.ar; const bf16_t* const (&br)[4] = tp.br; const bf16_t* const (&ar2)[4] = tp.ar2;
    const int tid = tidx(), wid = tid >> 6, lane = tid & 63, wr = wid >> 1, wc = wid & 1, fr = lane & 15, fq = lane >> 4;
    const int scol = ((tid & 7) ^ ((tid >> 3) & 7)) * 8;
#pragma unroll
    for (int n = 0; n < 4; ++n)
#pragma unroll
        for (int m = 0; m < 4; ++m) acc[n][m] = (f32x4){0.f, 0.f, 0.f, 0.f};
    const int nk = K / GBK;
    if (!primed) {
        __syncthreads();
#pragma unroll
        for (int i = 0; i < 4; ++i) {
            __builtin_amdgcn_global_load_lds((const unsigned*)(ar[i] + scol), (lds_u32*)(lds + tid * 16 + i * 4096), 16, 0, 0);
            __builtin_amdgcn_global_load_lds((const unsigned*)(br[i] + scol), (lds_u32*)(lds + 16384 + tid * 16 + i * 4096), 16, 0, 0);
        }
    }
    const int sw = fr & 7;
    for (int kt = 0; kt < nk; ++kt) {
        asm volatile("s_waitcnt vmcnt(0)" ::: "memory");
        __builtin_amdgcn_s_barrier();
        if (kt + 1 < nk) {
            char* nb = lds + ((kt + 1) & 1) * 32768;
            const int ko = (kt + 1) * GBK + scol;
#pragma unroll
            for (int i = 0; i < 4; ++i) {
                __builtin_amdgcn_global_load_lds((const unsigned*)(((kt + 1) * GBK >= ksplit ? ar2[i] : ar[i]) + ko), (lds_u32*)(nb + tid * 16 + i * 4096), 16, 0, 0);
                __builtin_amdgcn_global_load_lds((const unsigned*)(br[i] + ko), (lds_u32*)(nb + 16384 + tid * 16 + i * 4096), 16, 0, 0);
            }
        } else if (have_nx) {
#pragma unroll
            for (int i = 0; i < 4; ++i) {
                __builtin_amdgcn_global_load_lds((const unsigned*)(nx.ar[i] + scol), (lds_u32*)(lds + tid * 16 + i * 4096), 16, 0, 0);
                __builtin_amdgcn_global_load_lds((const unsigned*)(nx.br[i] + scol), (lds_u32*)(lds + 16384 + tid * 16 + i * 4096), 16, 0, 0);
            }
        }
        const char* SA = lds + (kt & 1) * 32768; const char* SB = SA + 16384;
#pragma unroll
        for (int kh = 0; kh < 2; ++kh) {
            bf16x8 af[4], bfr[4];
            const int co = ((kh * 4 + fq) ^ sw) * 16;
#pragma unroll
            for (int m = 0; m < 4; ++m) af[m] = *(const bf16x8*)(SA + (wr * 64 + m * 16 + fr) * 128 + co);
#pragma unroll
            for (int n = 0; n < 4; ++n) bfr[n] = *(const bf16x8*)(SB + (wc * 64 + n * 16 + fr) * 128 + co);
#pragma unroll
            for (int n = 0; n < 4; ++n)
#pragma unroll
                for (int m = 0; m < 4; ++m) acc[n][m] = __builtin_amdgcn_mfma_f32_16x16x32_bf16(bfr[n], af[m], acc[n][m], 0, 0, 0);
        }
    }
}

enum { EPI_EVEN_IN = 0, EPI_ODD_IN, EPI_RESID };
template <int EPI>
DI void phase_gemm(const P& p, const bf16_t* A, int lda, const bf16_t* Bt, int K, int ntn, char* lds, bool dry = false, const bf16_t* A2 = nullptr, int lda2 = 0, int ksplit = 1 << 30) {
    const int tid = tidx(), wid = tid >> 6, lane = tid & 63, wr = wid >> 1, wc = wid & 1, fr = lane & 15, fq = lane >> 4;
    const int ntm = T / 128, ntiles = ntm * ntn;
    auto fill = [&](TileP& t, int tile) {
        const int tn = tile / ntm, tm = tile % ntm, r = tid >> 3;
#pragma unroll
        for (int i = 0; i < 4; ++i) { t.ar[i] = A + (size_t)(tm * 128 + r + 32 * i) * lda; t.br[i] = Bt + (size_t)(tn * 128 + r + 32 * i) * K; t.ar2[i] = A2 ? A2 + (size_t)(tm * 128 + r + 32 * i) * lda2 : t.ar[i]; }
    };
    TileP cur, nxt;
    bool primed = false;
    fill(cur, bidx() < ntiles ? bidx() : 0); nxt = cur;
    for (int tile = bidx(); tile < ntiles; tile += gridDim.x) {
        const int tn = tile / ntm, tm = tile % ntm;
        const bool have_next = tile + (int)gridDim.x < ntiles;
        if (have_next) fill(nxt, tile + gridDim.x);
        f32x4 acc[4][4];
        gemm_core(cur, K, lds, acc, ksplit, primed, nxt, have_next);
        primed = have_next; cur = nxt;
        const int m0 = tm * 128 + wr * 64, n0 = tn * 128 + wc * 64;
        if (EPI == EPI_EVEN_IN) {
            bf16_t* C = (bf16_t*)(p.ws + WS_PROJ);
#pragma unroll
            for (int m = 0; m < 4; ++m)
#pragma unroll
                for (int n = 0; n < 4; ++n) {
                    const int row = m0 + m * 16 + fr, col = n0 + n * 16 + fq * 4;
                    if (col < EVC) { u32x2 w; w.x = pack2(acc[n][m][0], acc[n][m][1]); w.y = pack2(acc[n][m][2], acc[n][m][3]); *(u32x2*)(C + (size_t)row * EVLD + col) = w; }
                }
        } else if (EPI == EPI_ODD_IN) {
            bf16_t* C = (bf16_t*)(p.ws + WS_QK);
            const float2* tab = (const float2*)(p.ws + WS_ROPE);
            if (n0 < 3072) {
#pragma unroll
                for (int m = 0; m < 4; ++m) {
                    const int row = m0 + m * 16 + fr;
#pragma unroll
                    for (int n = 0; n < 2; ++n) {
                        float lo[4], hi[4];
#pragma unroll
                        for (int j = 0; j < 4; ++j) {
                            const float2 cs = tab[(size_t)row * 32 + n * 16 + fq * 4 + j];
                            const float x1 = acc[n][m][j], x2 = acc[n + 2][m][j];
                            lo[j] = x1 * cs.x - x2 * cs.y; hi[j] = x2 * cs.x + x1 * cs.y;
                        }
                        u32x2 w; w.x = pack2(lo[0], lo[1]); w.y = pack2(lo[2], lo[3]);
                        *(u32x2*)(C + (size_t)row * 3072 + n0 + n * 16 + fq * 4) = w;
                        w.x = pack2(hi[0], hi[1]); w.y = pack2(hi[2], hi[3]);
                        *(u32x2*)(C + (size_t)row * 3072 + n0 + (n + 2) * 16 + fq * 4) = w;
                    }
                }
            }
            if (tn * 128 >= 3072) {
                bf16_t* VT = (bf16_t*)(p.ws + WS_VT);
                const int hg0 = (tn * 128 - 3072) >> 6, g = hg0 >> 3, lg2 = g * 2, dil = 1 << lg2, L = SEQ >> lg2, run = 128 >> lg2;
                __syncthreads();
#pragma unroll
                for (int m = 0; m < 4; ++m)
#pragma unroll
                    for (int n = 0; n < 4; ++n)
#pragma unroll
                        for (int j = 0; j < 4; ++j)
                            *(bf16_t*)(lds + 32768 + (wc * 64 + n * 16 + fq * 4 + j) * 272 + (wr * 64 + m * 16 + fr) * 2) = f2bf(acc[n][m][j]);
                __syncthreads();
                const int bb = (tm * 128) >> 12, s0 = (tm * 128) & (SEQ - 1);
#pragma unroll
                for (int q = 0; q < 8; ++q) {
                    const int item = tid + q * 256, dim = item >> 4, o0 = (item & 15) * 8;
                    const int rr = o0 / run, i0 = o0 % run;
                    const char* src = lds + 32768 + dim * 272 + (rr + dil * i0) * 2;
                    float e8[8];
#pragma unroll
                    for (int e = 0; e < 8; ++e) e8[e] = bf2f(*(const bf16_t*)(src + e * dil * 2));
                    u32x4 w; w.x = pack2(e8[0], e8[1]); w.y = pack2(e8[2], e8[3]); w.z = pack2(e8[4], e8[5]); w.w = pack2(e8[6], e8[7]);
                    const int hg = hg0 + (dim >> 6);
                    *(u32x4*)(VT + ((size_t)((bb * 24 + hg) * dil + rr) * 64 + (dim & 63)) * L + (s0 >> lg2) + i0) = w;
                }
            }
        } else {
#pragma unroll
            for (int m = 0; m < 4; ++m)
#pragma unroll
                for (int n = 0; n < 4; ++n) {
                    const size_t qo = (size_t)(m0 + m * 16 + fr) * 1024 + n0 + n * 16 + fq * 4;
                    float* q = dry ? (float*)(p.ws + WS_DUMMY) + (qo & 0x7FFFF) : p.out + qo;
                    float4 v = *(float4*)q;
                    v.x += acc[n][m][0]; v.y += acc[n][m][1]; v.z += acc[n][m][2]; v.w += acc[n][m][3];
                    *(float4*)q = v;
                }
        }
    }
}

DI void phase_moe_up(const P& p, int layer, char* lds) {
    const int tid = tidx(), wid = tid >> 6, lane = tid & 63, wr = wid >> 1, wc = wid & 1, fr = lane & 15, fq = lane >> 4;
    const unsigned* cntb = (const unsigned*)(p.ws + WS_CTL + CTL_CNT) + layer * 16 * 64;
    unsigned cnt[16];
#pragma unroll
    for (int e = 0; e < 16; ++e) cnt[e] = cntb[e * 64];
    const int* list = (const int*)(p.ws + WS_LIST);
    const float* gl = (const float*)(p.ws + WS_GATE);
    const bf16_t* hn = (const bf16_t*)(p.ws + WS_HN);
    const bf16_t* W13 = (const bf16_t*)(p.ws + WS_W + W_13);
    bf16_t* H = (bf16_t*)(p.ws + WS_H);
    int ttot = 0;
#pragma unroll
    for (int e = 0; e < 16; ++e) ttot += ((int)cnt[e] + 127) >> 7;
    const int ntiles = ttot * 4;
    auto locate = [&](int tile, int& e, int& lt, int& ce, int& rbe, int& tn) {
        const int mt = tile >> 2; tn = tile & 3;
        int tbe = 0, acc_t = 0; e = 0;
#pragma unroll
        for (int q = 0; q < 16; ++q) { const int nt = ((int)cnt[q] + 127) >> 7; if (mt >= acc_t) { e = q; tbe = acc_t; } acc_t += nt; }
        lt = mt - tbe; ce = (int)cnt[e]; rbe = tbe * 128;
    };
    auto fill = [&](TileP& t, int tile) {
        int e, lt, ce, rbe, tn; locate(tile, e, lt, ce, rbe, tn);
        const int r = tid >> 3;
#pragma unroll
        for (int i = 0; i < 4; ++i) {
            const int ii = lt * 128 + r + 32 * i;
            const int tk = ii < ce ? (list[e * 16384 + ii] >> 1) : 0;
            t.ar[i] = hn + (size_t)tk * 1024; t.ar2[i] = t.ar[i];
            t.br[i] = W13 + ((size_t)e * 512 + tn * 128 + r + 32 * i) * 1024;
        }
    };
    TileP cur, nxt;
    bool primed = false;
    fill(cur, bidx() < ntiles ? bidx() : 0); nxt = cur;
    for (int tile = bidx(); tile < ntiles; tile += gridDim.x) {
        int e, lt, ce, rbe, tn; locate(tile, e, lt, ce, rbe, tn);
        const bool have_next = tile + (int)gridDim.x < ntiles;
        if (have_next) fill(nxt, tile + gridDim.x);
        f32x4 acc[4][4];
        gemm_core(cur, 1024, lds, acc, 1 << 30, primed, nxt, have_next);
        primed = have_next; cur = nxt;
#pragma unroll
        for (int m = 0; m < 4; ++m) {
            const int li = lt * 128 + wr * 64 + m * 16 + fr;
            if (li < ce) {
                const float g = gl[e * 16384 + li];
                bf16_t* hrow = H + (size_t)(rbe + li) * 256;
#pragma unroll
                for (int n = 0; n < 4; n += 2) {
                    float o[4];
#pragma unroll
                    for (int j = 0; j < 4; ++j) o[j] = siluf_(acc[n][m][j]) * acc[n + 1][m][j] * g;
                    const int f = tn * 64 + wc * 32 + (n >> 1) * 16 + fq * 4;
                    u32x2 w; w.x = pack2(o[0], o[1]); w.y = pack2(o[2], o[3]);
                    *(u32x2*)(hrow + f) = w;
                }
            }
        }
    }
}
DI void phase_moe_down(const P& p, int layer, char* lds) {
    const int tid = tidx(), wid = tid >> 6, lane = tid & 63, wr = wid >> 1, wc = wid & 1, fr = lane & 15, fq = lane >> 4;
    const unsigned* cntb = (const unsigned*)(p.ws + WS_CTL + CTL_CNT) + layer * 16 * 64;
    unsigned cnt[16];
#pragma unroll
    for (int e = 0; e < 16; ++e) cnt[e] = cntb[e * 64];
    const int* list = (const int*)(p.ws + WS_LIST);
    const bf16_t* W2 = (const bf16_t*)(p.ws + WS_W + W_2);
    const bf16_t* H = (const bf16_t*)(p.ws + WS_H);
    bf16_t* ys = (bf16_t*)(p.ws + WS_YS);
    int ttot = 0;
#pragma unroll
    for (int e = 0; e < 16; ++e) ttot += ((int)cnt[e] + 127) >> 7;
    const int ntiles = ttot * 8;
    auto locate = [&](int tile, int& e, int& lt, int& ce, int& rbe, int& tn) {
        const int mt = tile >> 3; tn = tile & 7;
        int tbe = 0, acc_t = 0; e = 0;
#pragma unroll
        for (int q = 0; q < 16; ++q) { const int nt = ((int)cnt[q] + 127) >> 7; if (mt >= acc_t) { e = q; tbe = acc_t; } acc_t += nt; }
        lt = mt - tbe; ce = (int)cnt[e]; rbe = tbe * 128;
    };
    auto fill = [&](TileP& t, int tile) {
        int e, lt, ce, rbe, tn; locate(tile, e, lt, ce, rbe, tn);
        const int r = tid >> 3;
#pragma unroll
        for (int i = 0; i < 4; ++i) { t.ar[i] = H + (size_t)(rbe + lt * 128 + r + 32 * i) * 256; t.ar2[i] = t.ar[i]; t.br[i] = W2 + ((size_t)e * 1024 + tn * 128 + r + 32 * i) * 256; }
    };
    TileP cur, nxt;
    bool primed = false;
    fill(cur, bidx() < ntiles ? bidx() : 0); nxt = cur;
    for (int tile = bidx(); tile < ntiles; tile += gridDim.x) {
        int e, lt, ce, rbe, tn; locate(tile, e, lt, ce, rbe, tn);
        const bool have_next = tile + (int)gridDim.x < ntiles;
        if (have_next) fill(nxt, tile + gridDim.x);
        f32x4 acc[4][4];
        gemm_core(cur, 256, lds, acc, 1 << 30, primed, nxt, have_next);
        primed = have_next; cur = nxt;
#pragma unroll
        for (int m = 0; m < 4; ++m) {
            const int li = lt * 128 + wr * 64 + m * 16 + fr;
            if (li < ce) {
                const int ts = list[e * 16384 + li];
                bf16_t* yrow = ys + ((size_t)(ts & 1) * T + (ts >> 1)) * 1024 + tn * 128 + wc * 64 + fq * 4;
#pragma unroll
                for (int n = 0; n < 4; ++n) { u32x2 w; w.x = pack2(acc[n][m][0], acc[n][m][1]); w.y = pack2(acc[n][m][2], acc[n][m][3]); *(u32x2*)(yrow + n * 16) = w; }
            }
        }
    }
}


typedef float f32x16 __attribute__((ext_vector_type(16)));
DI f32x4 mfma16(bf16x8 a, bf16x8 b, f32x4 c) { return __builtin_amdgcn_mfma_f32_16x16x32_bf16(a, b, c, 0, 0, 0); }
DI f32x16 mfma32(bf16x8 a, bf16x8 b, f32x16 c) { return __builtin_amdgcn_mfma_f32_32x32x16_bf16(a, b, c, 0, 0, 0); }
DI f32x4 tile16(const char* X, int ldx, int row0, const char* Y, int ldy, int col0, int K) {
    const int lane = tidx() & 63, fr = lane & 15, fq = lane >> 4;
    f32x4 acc = {0.f, 0.f, 0.f, 0.f};
#pragma unroll
    for (int k = 0; k < K; k += 32) {
        const bf16x8 a = *(const bf16x8*)(X + (row0 + fr) * ldx + (k + fq * 8) * 2);
        const bf16x8 b = *(const bf16x8*)(Y + (col0 + fr) * ldy + (k + fq * 8) * 2);
        acc = mfma16(a, b, acc);
    }
    return acc;
}
DI bf16x8 pack_step(const f32x16& x, int s) {
    u32x4 r;
    r.x = pack2(x[8 * s + 0], x[8 * s + 1]); r.y = pack2(x[8 * s + 2], x[8 * s + 3]);
    r.z = pack2(x[8 * s + 4], x[8 * s + 5]); r.w = pack2(x[8 * s + 6], x[8 * s + 7]);
    return __builtin_bit_cast(bf16x8, r);
}

constexpr int GP_LF = 0, GP_T = 17408, GP_VEC = GP_T + 9216, GP_U = GP_VEC + 1024, GP_END = GP_U + 36864;
DI void gdn_prep_unit(const P& p, int li, int ch, char* lds) {
    const int tid = tidx(), lane = tid & 63, wid = tid >> 6, fr = lane & 15, fq = lane >> 4;
    const int h = ch & 3, n = (ch >> 2) & 63, b = ch >> 8;
    const int t0 = b * SEQ + n * 64;
    float* Lf = (float*)(lds + GP_LF);
    char* Trow = lds + GP_T;
    float* gcs = (float*)(lds + GP_VEC); float* egc = gcs + 64; float* bet = gcs + 128; float* ekd = gcs + 192;
    char* Qrow = lds + GP_U; char* Krow = Qrow + 17408; char* VbT = lds + GP_U; char* KbgT = VbT + 18432;
    const bf16_t* proj = (const bf16_t*)(p.ws + WS_PROJ);
    unsigned char* ops = p.ws + WS_GOPS + (size_t)ch * GOPS_CH;
    const float* cw = p.in[I_CONVW] + (size_t)li * 4 * 1536;
    const int c = tid >> 2, cq = tid & 3;
    __syncthreads();
    float* cwl = (float*)(lds + GP_END);
    for (int i = tid; i < 4 * 3 * 32; i += 256) {
        const int j = i / 96, r = i % 96, sl = r >> 5, q4 = (r & 31) * 4;
        *(f32x4*)(cwl + (j * 3 + sl) * 128 + q4) = *(const f32x4*)(cw + j * 1536 + sl * 512 + h * 128 + q4);
    }
    __syncthreads();
    unsigned vvp[16];
#pragma unroll 1
    for (int which = 0; which < 3; ++which) {
        const int col0 = which * 512 + h * 128 + cq * 32;
        u32x4 xin[4][4];
#pragma unroll
        for (int j = 0; j < 4; ++j) {
            const int sp = n * 64 + c - 3 + j;
            const bf16_t* src = proj + (size_t)(b * SEQ + (sp < 0 ? 0 : sp)) * EVLD + col0;
#pragma unroll
            for (int i4 = 0; i4 < 4; ++i4) xin[j][i4] = *(const u32x4*)(src + i4 * 8);
        }
        float acc[32];
#pragma unroll
        for (int i = 0; i < 32; ++i) acc[i] = 0.f;
#pragma unroll
        for (int j = 0; j < 4; ++j) {
            const float ok = (n * 64 + c - 3 + j) >= 0 ? 1.f : 0.f;
            const float* wj = cwl + (j * 3 + which) * 128 + cq * 32;
#pragma unroll
            for (int i4 = 0; i4 < 4; ++i4) {
                const f32x4 wa = *(const f32x4*)(wj + i4 * 8), wb = *(const f32x4*)(wj + i4 * 8 + 4);
                const u32x4 w = xin[j][i4];
                acc[i4 * 8 + 0] += ok * wa[0] * __uint_as_float(w[0] << 16); acc[i4 * 8 + 1] += ok * wa[1] * __uint_as_float(w[0] & 0xffff0000u);
                acc[i4 * 8 + 2] += ok * wa[2] * __uint_as_float(w[1] << 16); acc[i4 * 8 + 3] += ok * wa[3] * __uint_as_float(w[1] & 0xffff0000u);
                acc[i4 * 8 + 4] += ok * wb[0] * __uint_as_float(w[2] << 16); acc[i4 * 8 + 5] += ok * wb[1] * __uint_as_float(w[2] & 0xffff0000u);
                acc[i4 * 8 + 6] += ok * wb[2] * __uint_as_float(w[3] << 16); acc[i4 * 8 + 7] += ok * wb[3] * __uint_as_float(w[3] & 0xffff0000u);
            }
        }
        float ss = 0.f;
#pragma unroll
        for (int i = 0; i < 32; ++i) { acc[i] = siluf_(acc[i]); ss += acc[i] * acc[i]; }
        ss += __shfl_xor(ss, 1); ss += __shfl_xor(ss, 2);
        const float rn = which == 2 ? 1.f : rsqrtf(ss + 1e-6f) * (which == 0 ? 0.08838834764831845f : 1.f);
        unsigned pk[16];
#pragma unroll
        for (int i = 0; i < 16; ++i) pk[i] = pack2(acc[2 * i] * rn, acc[2 * i + 1] * rn);
        if (which < 2) {
            char* img = which == 0 ? Qrow : Krow;
#pragma unroll
            for (int i4 = 0; i4 < 4; ++i4) { u32x4 w; w.x = pk[i4 * 4]; w.y = pk[i4 * 4 + 1]; w.z = pk[i4 * 4 + 2]; w.w = pk[i4 * 4 + 3]; *(u32x4*)(img + c * 272 + (cq * 32 + i4 * 8) * 2) = w; }
        } else {
#pragma unroll
            for (int i = 0; i < 16; ++i) vvp[i] = pk[i];
        }
    }
    if (cq == 0) {
        const float a = bf2f(proj[(size_t)(t0 + c) * EVLD + 2048 + h]);
        const float bb = bf2f(proj[(size_t)(t0 + c) * EVLD + 2052 + h]);
        const float Aexp = __expf(p.in[I_ALOG][li * 4 + h]), dtb = p.in[I_DTB][li * 4 + h];
        gcs[c] = -Aexp * softplusf_(a + dtb);
        bet[c] = sigmoidf_(bb);
    }
    __syncthreads();
    if (wid == 0) {
        float x = gcs[lane];
#pragma unroll
        for (int o = 1; o < 64; o <<= 1) { const float y = __shfl_up(x, o); if (lane >= o) x += y; }
        const float gl = __shfl(x, 63);
        gcs[lane] = x; egc[lane] = __expf(x); ekd[lane] = __expf(gl - x);
        if (lane == 63) ((float*)(p.ws + WS_CTL + CTL_EGL))[ch] = __expf(gl);
    }
    __syncthreads();
    {
        const int ti = wid;
#pragma unroll
        for (int tj = 0; tj < 4; ++tj) {
            if (tj <= ti) {
                const f32x4 kk = tile16(Krow, 272, 16 * ti, Krow, 272, 16 * tj, 128);
                const int c2 = 16 * tj + fr;
                f32x4 lv;
#pragma unroll
                for (int r = 0; r < 4; ++r) {
                    const int c1 = 16 * ti + fq * 4 + r;
                    lv[r] = (c1 > c2) ? bet[c1] * kk[r] * __expf(gcs[c1] - gcs[c2]) : 0.f;
                }
                *(f32x4*)&Lf[c2 * 68 + 16 * ti + fq * 4] = lv;
            }
            f32x4 qk = {0.f, 0.f, 0.f, 0.f};
            if (tj <= ti) qk = tile16(Krow, 272, 16 * tj, Qrow, 272, 16 * ti, 128);
            const int c1 = 16 * ti + fr;
            float o4[4];
#pragma unroll
            for (int r = 0; r < 4; ++r) { const int c2 = 16 * tj + fq * 4 + r; o4[r] = (c1 >= c2) ? qk[r] * __expf(gcs[c1] - gcs[c2]) : 0.f; }
            const int mt = c1 >> 5, rr = c1 & 31, hh = fq & 1, jg = fq >> 1;
            u32x2 w; w.x = pack2(o4[0], o4[1]); w.y = pack2(o4[2], o4[3]);
            *(u32x2*)(ops + GO_AF + ((size_t)((mt * 4 + tj) * 64 + hh * 32 + rr) * 8 + jg * 4) * 2) = w;
        }
#pragma unroll
        for (int i = 0; i < 4; ++i) {
            const int idx = tid + i * 256;
            {
                const int mt = idx >> 9, ks = (idx >> 6) & 7, l2 = idx & 63, rr = l2 & 31, hh = l2 >> 5, cc = 32 * mt + rr;
                const float sc = egc[cc];
                const u32x2 lo = *(const u32x2*)(Qrow + cc * 272 + (16 * ks + 4 * hh) * 2), hi = *(const u32x2*)(Qrow + cc * 272 + (16 * ks + 8 + 4 * hh) * 2);
                u32x4 w;
                w.x = pack2(__uint_as_float(lo.x << 16) * sc, __uint_as_float(lo.x & 0xffff0000u) * sc); w.y = pack2(__uint_as_float(lo.y << 16) * sc, __uint_as_float(lo.y & 0xffff0000u) * sc);
                w.z = pack2(__uint_as_float(hi.x << 16) * sc, __uint_as_float(hi.x & 0xffff0000u) * sc); w.w = pack2(__uint_as_float(hi.y << 16) * sc, __uint_as_float(hi.y & 0xffff0000u) * sc);
                *(u32x4*)(ops + GO_QF + (size_t)idx * 16) = w;
            }
            {
                const int mt = idx >> 8, ks = (idx >> 6) & 3, l2 = idx & 63, rr = l2 & 31, hh = l2 >> 5, dk = 32 * mt + rr;
                float e8[8];
#pragma unroll
                for (int j = 0; j < 8; ++j) { const int c2 = 16 * ks + 8 * (j >> 2) + 4 * hh + (j & 3); e8[j] = bf2f(*(const bf16_t*)(Krow + c2 * 272 + dk * 2)) * ekd[c2]; }
                u32x4 w; w.x = pack2(e8[0], e8[1]); w.y = pack2(e8[2], e8[3]); w.z = pack2(e8[4], e8[5]); w.w = pack2(e8[6], e8[7]);
                *(u32x4*)(ops + GO_KF + (size_t)idx * 16) = w;
            }
        }
    }
    __syncthreads();
    {
        const float bc = bet[c], bg = bc * egc[c];
        unsigned kvp[16];
#pragma unroll
        for (int i4 = 0; i4 < 4; ++i4) { const u32x4 w = *(const u32x4*)(Krow + c * 272 + (cq * 32 + i4 * 8) * 2); kvp[i4 * 4] = w.x; kvp[i4 * 4 + 1] = w.y; kvp[i4 * 4 + 2] = w.z; kvp[i4 * 4 + 3] = w.w; }
        __syncthreads();
#pragma unroll
        for (int i = 0; i < 16; ++i) {
            *(bf16_t*)(VbT + (cq * 32 + 2 * i) * 144 + c * 2) = f2bf(__uint_as_float(vvp[i] << 16) * bc);
            *(bf16_t*)(VbT + (cq * 32 + 2 * i + 1) * 144 + c * 2) = f2bf(__uint_as_float(vvp[i] & 0xffff0000u) * bc);
            *(bf16_t*)(KbgT + (cq * 32 + 2 * i) * 144 + c * 2) = f2bf(__uint_as_float(kvp[i] << 16) * bg);
            *(bf16_t*)(KbgT + (cq * 32 + 2 * i + 1) * 144 + c * 2) = f2bf(__uint_as_float(kvp[i] & 0xffff0000u) * bg);
        }
    }
    if (wid == 0) {
        float Tc[64];
#pragma unroll
        for (int i = 0; i < 64; ++i) Tc[i] = (i == lane) ? 1.f : 0.f;
#pragma unroll
        for (int j = 0; j < 63; ++j) {
            const float tj = Tc[j];
#pragma unroll
            for (int i4 = (j + 1) >> 2; i4 < 16; ++i4) {
                const f32x4 l4 = *(const f32x4*)&Lf[j * 68 + i4 * 4];
#pragma unroll
                for (int e = 0; e < 4; ++e) if (i4 * 4 + e > j) Tc[i4 * 4 + e] -= l4[e] * tj;
            }
        }
#pragma unroll
        for (int i = 0; i < 64; ++i) *(bf16_t*)(Trow + i * 144 + lane * 2) = f2bf(Tc[i]);
    }
    __syncthreads();
#pragma unroll
    for (int tq = 0; tq < 2; ++tq) {
        const int tj = wid * 2 + tq;
#pragma unroll
        for (int ti = 0; ti < 4; ++ti) {
            const f32x4 u = tile16(Trow, 144, 16 * ti, VbT, 144, 16 * tj, 64);
            {
                const int dv = 16 * tj + fr, slice = dv >> 5, rr = dv & 31, cb = 16 * ti + fq * 4, mt = cb >> 5, q4 = (cb & 31) >> 2, hh = q4 & 1, rg = q4 >> 1;
                u32x2 w; w.x = pack2(u[0], u[1]); w.y = pack2(u[2], u[3]);
                *(u32x2*)(ops + GO_UF + ((size_t)((slice * 2 + mt) * 64 + hh * 32 + rr) * 16 + rg * 4) * 2) = w;
            }
            const f32x4 wv = tile16(KbgT, 144, 16 * tj, Trow, 144, 16 * ti, 64);
            {
                const int c1 = 16 * ti + fr, mt = c1 >> 5, rr = c1 & 31, hh = fq & 1, jg = fq >> 1;
                u32x2 w; w.x = pack2(wv[0], wv[1]); w.y = pack2(wv[2], wv[3]);
                *(u32x2*)(ops + GO_WF + ((size_t)((mt * 8 + tj) * 64 + hh * 32 + rr) * 8 + jg * 4) * 2) = w;
            }
        }
    }
}

DI void glds16(const void* g, char* l) { __builtin_amdgcn_global_load_lds((const unsigned*)g, (lds_u32*)l, 16, 0, 0); }
#define GS_WAIT(n) asm volatile("s_waitcnt vmcnt(" #n ")" ::: "memory")
DI void gdn_scan_block(const P& p, int bh, char* lds, bool dry = false) {
    const int tid = tidx(), lane = tid & 63, w = tid >> 6;
    const int h = bh & 3, b = bh >> 2;
    const float eglv = ((const float*)(p.ws + WS_CTL + CTL_EGL))[(b * 64 + lane) * 4 + h];
    unsigned char* gbase = p.ws + WS_GOPS + (size_t)(b * 256 + h) * GOPS_CH;
    constexpr int NST = 64 * 9;
    f32x16 S[4];
#pragma unroll
    for (int i = 0; i < 4; ++i)
#pragma unroll
        for (int r = 0; r < 16; ++r) S[i][r] = 0.f;
    __syncthreads();
#pragma unroll
    for (int j = 0; j < 8; ++j) { const unsigned char* src = gbase + j * 8192 + tid * 16; char* dst = lds + j * 8192 + tid * 16; glds16(src, dst); glds16(src + 4096, dst + 4096); }
#pragma unroll 1
    for (int n = 0; n < 64; ++n) {
        const float egl = __shfl(eglv, n);
        bf16x8 Sb[8];
#pragma unroll
        for (int i = 0; i < 4; ++i) { Sb[i * 2] = pack_step(S[i], 0); Sb[i * 2 + 1] = pack_step(S[i], 1); }
        f32x16 av[2], ao[2];
        bf16x8 Vb[4];
#pragma unroll
        for (int k = 0; k < 9; ++k) {
            const int j = n * 9 + k;
            if (n < 63 || k <= 1) GS_WAIT(14); else if (k == 2) GS_WAIT(12); else if (k == 3) GS_WAIT(10); else if (k == 4) GS_WAIT(8); else if (k == 5) GS_WAIT(6);
            else if (k == 6) GS_WAIT(4); else if (k == 7) GS_WAIT(2); else GS_WAIT(0);
            __builtin_amdgcn_s_barrier();
            if (j + 8 < NST) {
                const int k8 = (k + 8) % 9, n8 = (k == 0) ? n : n + 1;
                const unsigned char* src = gbase + (size_t)n8 * 4 * GOPS_CH + k8 * 8192 + tid * 16;
                char* dst = lds + k8 * 8192 + tid * 16;
                glds16(src, dst); glds16(src + 4096, dst + 4096);
            }
            __builtin_amdgcn_sched_barrier(0);
            const char* sl = lds + k * 8192;
            const bf16x8* fr = (const bf16x8*)sl + lane;
            if (k < 2) {
#pragma unroll
                for (int r = 0; r < 16; ++r) av[k][r] = 0.f;
                bf16x8 f8[8];
#pragma unroll
                for (int ks = 0; ks < 8; ++ks) f8[ks] = fr[ks * 64];
                __builtin_amdgcn_sched_barrier(0);
#pragma unroll
                for (int ks = 0; ks < 8; ++ks) av[k] = mfma32(f8[ks], Sb[ks], av[k]);
            } else if (k < 4) {
#pragma unroll
                for (int r = 0; r < 16; ++r) ao[k - 2][r] = 0.f;
                bf16x8 f8[8];
#pragma unroll
                for (int ks = 0; ks < 8; ++ks) f8[ks] = fr[ks * 64];
                __builtin_amdgcn_sched_barrier(0);
#pragma unroll
                for (int ks = 0; ks < 8; ++ks) ao[k - 2] = mfma32(f8[ks], Sb[ks], ao[k - 2]);
            } else if (k < 6) {
                if ((w >> 1) == (k - 4)) {
#pragma unroll
                    for (int mt = 0; mt < 2; ++mt) {
                        const u32x4* up = (const u32x4*)(sl + ((w & 1) * 2 + mt) * 2048 + lane * 32);
                        const u32x4 u0 = up[0], u1 = up[1];
#pragma unroll
                        for (int e = 0; e < 4; ++e) {
                            av[mt][e * 2] = __uint_as_float(u0[e] << 16) - av[mt][e * 2]; av[mt][e * 2 + 1] = __uint_as_float(u0[e] & 0xffff0000u) - av[mt][e * 2 + 1];
                            av[mt][8 + e * 2] = __uint_as_float(u1[e] << 16) - av[mt][8 + e * 2]; av[mt][8 + e * 2 + 1] = __uint_as_float(u1[e] & 0xffff0000u) - av[mt][8 + e * 2 + 1];
                        }
                    }
                }
            } else if (k == 6) {
#pragma unroll
                for (int mt = 0; mt < 2; ++mt) { Vb[mt * 2] = pack_step(av[mt], 0); Vb[mt * 2 + 1] = pack_step(av[mt], 1); }
                bf16x8 f6[6];
#pragma unroll
                for (int ks = 0; ks < 2; ++ks) f6[ks] = fr[ks * 64];
#pragma unroll
                for (int ks = 0; ks < 4; ++ks) f6[2 + ks] = fr[(4 + ks) * 64];
                __builtin_amdgcn_sched_barrier(0);
#pragma unroll
                for (int ks = 0; ks < 4; ++ks) { if (ks < 2) ao[0] = mfma32(f6[ks], Vb[ks], ao[0]); ao[1] = mfma32(f6[2 + ks], Vb[ks], ao[1]); }
            } else {
                bf16x8 f8[8];
#pragma unroll
                for (int q = 0; q < 8; ++q) f8[q] = fr[q * 64];
#pragma unroll
                for (int i2 = 0; i2 < 2; ++i2) {
                    const int i = (k - 7) * 2 + i2;
#pragma unroll
                    for (int r = 0; r < 16; ++r) S[i][r] *= egl;
                }
                __builtin_amdgcn_sched_barrier(0);
#pragma unroll
                for (int ks = 0; ks < 4; ++ks)
#pragma unroll
                    for (int i2 = 0; i2 < 2; ++i2) S[(k - 7) * 2 + i2] = mfma32(f8[i2 * 4 + ks], Vb[ks], S[(k - 7) * 2 + i2]);
                if (k == 8) {
                    u32x4* Of = (u32x4*)((dry ? p.ws + WS_DUMMY + (size_t)(bh & 15) * 65536 : gbase + (size_t)n * 4 * GOPS_CH) + GO_UF) + (size_t)(w * 2 * 64 + lane) * 2;
#pragma unroll
                    for (int mt = 0; mt < 2; ++mt) {
                        u32x4 o0, o1;
#pragma unroll
                        for (int e = 0; e < 4; ++e) { o0[e] = pack2(ao[mt][e * 2], ao[mt][e * 2 + 1]); o1[e] = pack2(ao[mt][8 + e * 2], ao[mt][8 + e * 2 + 1]); }
                        Of[mt * 128] = o0; Of[mt * 128 + 1] = o1;
                    }
                }
            }
        }
    }
    __syncthreads();
}

DI void gdn_post_unit(const P& p, int li, int ch) {
    const int tid = tidx();
    const int h = ch & 3, n = (ch >> 2) & 63, b = ch >> 8;
    const int t0 = b * SEQ + n * 64;
    const int c = tid >> 2, cq = tid & 3;
    const bf16_t* Of = (const bf16_t*)(p.ws + WS_GOPS + (size_t)ch * GOPS_CH + GO_UF);
    const bf16_t* proj = (const bf16_t*)(p.ws + WS_PROJ);
    bf16_t* mix = (bf16_t*)(p.ws + WS_PROJ);
    const float* nw = p.in[I_GDNNORM] + li * 128 + cq * 32;
    const int mt = c >> 5, q4 = (c & 31) >> 2, hh = q4 & 1, rg = q4 >> 1, reg = rg * 4 + (c & 3);
    float o[32]; float ss = 0.f;
#pragma unroll
    for (int r = 0; r < 32; ++r) { o[r] = bf2f(Of[(size_t)((cq * 2 + mt) * 64 + hh * 32 + r) * 16 + reg]); ss += o[r] * o[r]; }
    ss += __shfl_xor(ss, 1); ss += __shfl_xor(ss, 2);
    const float rs = rsqrtf(ss * (1.f / 128.f) + 1e-6f);
    const bf16_t* zp = proj + (size_t)(t0 + c) * EVLD + 1536 + h * 128 + cq * 32;
    bf16_t* mp = mix + (size_t)(t0 + c) * EVLD + h * 128 + cq * 32;
#pragma unroll
    for (int i4 = 0; i4 < 4; ++i4) {
        const u32x4 zw = *(const u32x4*)(zp + i4 * 8);
        u32x4 w;
#pragma unroll
        for (int e = 0; e < 4; ++e) {
            const float z0 = __uint_as_float(zw[e] << 16), z1 = __uint_as_float(zw[e] & 0xffff0000u);
            w[e] = pack2(o[i4 * 8 + e * 2] * rs * nw[i4 * 8 + e * 2] * siluf_(z0), o[i4 * 8 + e * 2 + 1] * rs * nw[i4 * 8 + e * 2 + 1] * siluf_(z1));
        }
        *(u32x4*)(mp + i4 * 8) = w;
    }
}


constexpr int RP_Z0 = 0, RP_Z1 = 18432, RP_Z2 = 55296, RP_VEC = 73728, RP_PT = 75008, RP_END = 78080;
constexpr int RP_LIN = 0, RP_LW = 25600;
DI void rwkv_prep_unit(const P& p, int li, int ch, char* lds) {
    const int tid = tidx(), lane = tid & 63, wid = tid >> 6, fr = lane & 15, fq = lane >> 4;
    const int h = ch & 7, n = (ch >> 3) & 63, b = ch >> 9;
    const int t0 = b * SEQ + n * 64;
    const bf16_t* proj = (const bf16_t*)(p.ws + WS_PROJ);
    char* Lfc = lds + RP_Z0; float* Lf = (float*)Lfc;
    char* ApT = lds + RP_Z0; char* AkVT = lds + RP_Z0 + 9216;
    char* Arow = lds + RP_Z1; char* Rrow = Arow + 9216; char* Brow = Arow + 18432; char* Krow = Arow + 27648;
    char* Aak = Arow; char* Arb = Rrow; char* Ark = Brow; char* Trow = Krow; char* BhT = Krow; char* VpT = Aak;
    char* AT = lds + RP_Z2; char* VT = AT + 9216; char* KhT = AT;
    float* tot = (float*)(lds + RP_VEC); float* WC = tot + 256;
    char* lin = lds + RP_LIN; char* LWi = lds + RP_LW;
    float* PT = (float*)(lds + RP_PT);
    {
        const float* mu0 = p.in[I_MU] + (size_t)li * 1696;
        if (tid < 48) {
            const int j0 = tid * 4;
            *(float4*)(PT + j0) = j0 < 160 ? *(const float4*)(mu0 + (C_HW - RW0) + j0) : *(const float4*)(p.in[I_VRESMU] + j0 - 160);
        } else if (tid < 48 + 144) {
            const int q = tid - 48, arr = q >> 4, c4 = (q & 15) * 4, chn = h * 64 + c4;
            const float* src = arr == 0 ? mu0 + (C_R - RW0) + chn : arr == 1 ? mu0 + (C_K - RW0) + chn : arr == 2 ? mu0 + (C_V - RW0) + chn
                             : arr == 3 ? p.in[I_W0] + li * 512 + chn : arr == 4 ? p.in[I_A0] + li * 512 + chn : arr == 5 ? p.in[I_V0] + chn
                             : arr == 6 ? p.in[I_KK] + li * 512 + chn : arr == 7 ? p.in[I_KA] + li * 512 + chn : p.in[I_RK] + li * 512 + chn;
            *(float4*)(PT + 192 + arr * 64 + c4) = *(const float4*)src;
        }
    }
    __syncthreads();
    {
        const int c = tid >> 2, cq = tid & 3, s = n * 64 + c;
        const bf16_t* cur = proj + (size_t)(t0 + c) * EVLD + C_HW + cq * 48;
        const float* mu = p.in[I_MU] + (size_t)li * 1696 + (C_HW - RW0);
        const float* vmu = p.in[I_VRESMU];
#pragma unroll
        for (int i6 = 0; i6 < 6; ++i6) {
            const u32x4 cw4 = *(const u32x4*)(cur + i6 * 8);
            u32x4 pw4 = *(const u32x4*)(cur - (s > 0 ? EVLD : 0) + i6 * 8);
            if (s == 0) pw4 = (u32x4){0u, 0u, 0u, 0u};
            const int j0 = cq * 48 + i6 * 8;
            const float4 ma = *(const float4*)(PT + j0), mb = *(const float4*)(PT + j0 + 4);
            const float mm[8] = {ma.x, ma.y, ma.z, ma.w, mb.x, mb.y, mb.z, mb.w};
            const bool is_t = j0 < 32, is_s = (j0 >= 64) && (j0 < 160);
            const float ca = is_t ? 1.f : 0.f, cb = is_t ? -2.f : 1.f, cc = is_t ? 2.f : -1.f;
            u32x4 w;
#pragma unroll
            for (int e = 0; e < 4; ++e) {
                float o2[2];
#pragma unroll
                for (int q = 0; q < 2; ++q) {
                    const float cv = q ? __uint_as_float(cw4[e] & 0xffff0000u) : __uint_as_float(cw4[e] << 16);
                    const float pv = q ? __uint_as_float(pw4[e] & 0xffff0000u) : __uint_as_float(pw4[e] << 16);
                    const float val = cv + mm[e * 2 + q] * (pv - cv);
                    const float act = ca + cb * __builtin_amdgcn_rcpf(1.f + __expf(cc * val));
                    o2[q] = (is_t || is_s) ? act : val;
                }
                w[e] = pack2(o2[0], o2[1]);
            }
            *(u32x4*)(lin + c * 400 + (cq * 48 + i6 * 8) * 2) = w;
        }
        const bf16_t* LW = (const bf16_t*)(p.ws + WS_W + W_LW) + (size_t)h * 64 * 192;
#pragma unroll
        for (int i6 = 0; i6 < 6; ++i6) *(u32x4*)(LWi + c * 400 + (cq * 48 + i6 * 8) * 2) = *(const u32x4*)(LW + (size_t)c * 192 + cq * 48 + i6 * 8);
    }
    __syncthreads();
    float lw_[16], la_[16], lg_[16], lv_[16];
#pragma unroll
    for (int tj = 0; tj < 4; ++tj) {
        const f32x4 a = tile16(LWi, 400, 16 * tj, lin, 400, 16 * wid, 32);
        const f32x4 bq = tile16(LWi + 64, 400, 16 * tj, lin + 64, 400, 16 * wid, 32);
        const f32x4 cg = tile16(LWi + 128, 400, 16 * tj, lin + 128, 400, 16 * wid, 96);
        const f32x4 dv = tile16(LWi + 320, 400, 16 * tj, lin + 320, 400, 16 * wid, 32);
#pragma unroll
        for (int r = 0; r < 4; ++r) { lw_[tj * 4 + r] = a[r]; la_[tj * 4 + r] = bq[r]; lg_[tj * 4 + r] = cg[r]; lv_[tj * 4 + r] = dv[r]; }
    }
    __syncthreads();
    const int c = 16 * wid + fr;
    float at[16], rt[16], bt[16], kt[16], bh[16], kh[16];
    {
        const int s = n * 64 + c;
        const size_t row = (size_t)(t0 + c);
        const float* mu = p.in[I_MU] + (size_t)li * 1696;
        const int hc = h * 64;
        float rr_[16], kk_[16], lwv[16], aa[16];
        float kn = 0.f, rk = 0.f;
        bf16_t* vf = (bf16_t*)(p.ws + WS_VF);
        bf16_t* gg = (bf16_t*)(p.ws + WS_GG);
#pragma unroll
        for (int tj = 0; tj < 4; ++tj) {
            const int cb = 16 * tj + 4 * fq;
            u32x2 cr = *(const u32x2*)(proj + row * EVLD + C_R + hc + cb), ck = *(const u32x2*)(proj + row * EVLD + C_K + hc + cb), cv = *(const u32x2*)(proj + row * EVLD + C_V + hc + cb);
            const size_t prow = s > 0 ? row - 1 : row;
            u32x2 pr = *(const u32x2*)(proj + prow * EVLD + C_R + hc + cb), pk = *(const u32x2*)(proj + prow * EVLD + C_K + hc + cb), pv = *(const u32x2*)(proj + prow * EVLD + C_V + hc + cb);
            if (s == 0) { pr = (u32x2){0u, 0u}; pk = pr; pv = pr; }
            u32x2 vfw = {0u, 0u};
            if (li == 1) vfw = *(const u32x2*)(vf + row * 512 + hc + cb);
            float vout[4], gout[4];
            const int ch0 = hc + cb;
            const float* pt = PT + 192 + cb;
            const float4 mu_r4 = *(const float4*)(pt), mu_k4 = *(const float4*)(pt + 64), mu_v4 = *(const float4*)(pt + 128);
            const float4 w0_4 = *(const float4*)(pt + 192), a0_4 = *(const float4*)(pt + 256), v0_4 = *(const float4*)(pt + 320);
            const float4 kk_4 = *(const float4*)(pt + 384), ka_4 = *(const float4*)(pt + 448), rk_4 = *(const float4*)(pt + 512);
            const float mur[4] = {mu_r4.x, mu_r4.y, mu_r4.z, mu_r4.w}, muk[4] = {mu_k4.x, mu_k4.y, mu_k4.z, mu_k4.w}, muv[4] = {mu_v4.x, mu_v4.y, mu_v4.z, mu_v4.w};
            const float w0v[4] = {w0_4.x, w0_4.y, w0_4.z, w0_4.w}, a0v[4] = {a0_4.x, a0_4.y, a0_4.z, a0_4.w}, v0v[4] = {v0_4.x, v0_4.y, v0_4.z, v0_4.w};
            const float kkp[4] = {kk_4.x, kk_4.y, kk_4.z, kk_4.w}, kap[4] = {ka_4.x, ka_4.y, ka_4.z, ka_4.w}, rkp[4] = {rk_4.x, rk_4.y, rk_4.z, rk_4.w};
#pragma unroll
            for (int r = 0; r < 4; ++r) {
                const int i = tj * 4 + r;
                const unsigned wcr = r < 2 ? cr.x : cr.y, wck = r < 2 ? ck.x : ck.y, wcv = r < 2 ? cv.x : cv.y;
                const unsigned wpr = r < 2 ? pr.x : pr.y, wpk = r < 2 ? pk.x : pk.y, wpv = r < 2 ? pv.x : pv.y, wvf = r < 2 ? vfw.x : vfw.y;
                const float c_r = (r & 1) ? __uint_as_float(wcr & 0xffff0000u) : __uint_as_float(wcr << 16);
                const float c_k = (r & 1) ? __uint_as_float(wck & 0xffff0000u) : __uint_as_float(wck << 16);
                const float c_v = (r & 1) ? __uint_as_float(wcv & 0xffff0000u) : __uint_as_float(wcv << 16);
                const float p_r = (r & 1) ? __uint_as_float(wpr & 0xffff0000u) : __uint_as_float(wpr << 16);
                const float p_k = (r & 1) ? __uint_as_float(wpk & 0xffff0000u) : __uint_as_float(wpk << 16);
                const float p_v = (r & 1) ? __uint_as_float(wpv & 0xffff0000u) : __uint_as_float(wpv << 16);
                const float rm = c_r + mur[r] * (p_r - c_r);
                const float km = c_k + muk[r] * (p_k - c_k);
                float vm = c_v + muv[r] * (p_v - c_v);
                const float wlog = -softplusf_(-(w0v[r] + lw_[i])) - 0.5f;
                lwv[i] = -__expf(wlog);
                const float a = sigmoidf_(a0v[r] + la_[i]);
                if (li == 1) {
                    const float v1 = (r & 1) ? __uint_as_float(wvf & 0xffff0000u) : __uint_as_float(wvf << 16);
                    vm = vm + (v1 - vm) * sigmoidf_(v0v[r] + lv_[i]);
                }
                const float kkv = km * kkp[r];
                kn += kkv * kkv;
                rr_[i] = rm; kk_[i] = kkv; aa[i] = a;
                kt[i] = km * (1.f + (a - 1.f) * kap[r]);
                rk += rm * kt[i] * rkp[r];
                vout[r] = vm; gout[r] = lg_[i];
            }
            u32x2 w; w.x = pack2(vout[0], vout[1]); w.y = pack2(vout[2], vout[3]);
            *(u32x2*)(vf + row * 512 + hc + cb) = w;
            w.x = pack2(gout[0], gout[1]); w.y = pack2(gout[2], gout[3]);
            *(u32x2*)(gg + row * 512 + hc + cb) = w;
#pragma unroll
            for (int r = 0; r < 4; ++r) *(bf16_t*)(VT + (cb + r) * 144 + c * 2) = f2bf(vout[r]);
            __builtin_amdgcn_sched_barrier(0);
        }
        kn += __shfl_xor(kn, 16); kn += __shfl_xor(kn, 32);
        const float kr = rsqrtf(kn + 1e-6f);
        rk += __shfl_xor(rk, 16); rk += __shfl_xor(rk, 32);
        if (fq == 0) ((float*)(p.ws + WS_RK))[row * 8 + h] = rk;
        float cs[16];
#pragma unroll
        for (int i = 0; i < 16; ++i) {
            float x = lwv[i];
#pragma unroll
            for (int o = 1; o < 16; o <<= 1) { const float y = __shfl_up(x, o, 16); if (fr >= o) x += y; }
            cs[i] = x;
        }
        if (fr == 15) {
#pragma unroll
            for (int i = 0; i < 16; ++i) tot[wid * 64 + 16 * (i >> 2) + 4 * fq + (i & 3)] = cs[i];
        }
        __syncthreads();
#pragma unroll
        for (int i = 0; i < 16; ++i) {
            const int chl = 16 * (i >> 2) + 4 * fq + (i & 3);
            float pre = 0.f, all = 0.f;
#pragma unroll
            for (int w2 = 0; w2 < 4; ++w2) { const float tv = tot[w2 * 64 + chl]; all += tv; if (w2 < wid) pre += tv; }
            const float csi = cs[i] + pre, csm = csi - lwv[i];
            const float kkn = kk_[i] * kr, k2 = kt[i];
            const float e_c = __expf(csi), e_n = __builtin_amdgcn_rcpf(e_c), e_m = __expf(csm), e_h = __expf(all) * e_n;
            at[i] = -kkn * e_m; rt[i] = rr_[i] * e_c;
            const float bp = kkn * aa[i];
            bt[i] = bp * e_n; kt[i] = k2 * e_n; bh[i] = bp * e_h; kh[i] = k2 * e_h;
            if (c == 0) WC[chl] = __expf(all);
            if ((i & 3) == 3) __builtin_amdgcn_sched_barrier(0);
        }
    }
#pragma unroll
    for (int tj = 0; tj < 4; ++tj) {
        const int cb = 16 * tj + 4 * fq;
        u32x2 w;
        w.x = pack2(at[tj * 4], at[tj * 4 + 1]); w.y = pack2(at[tj * 4 + 2], at[tj * 4 + 3]); *(u32x2*)(Arow + c * 144 + cb * 2) = w;
        w.x = pack2(rt[tj * 4], rt[tj * 4 + 1]); w.y = pack2(rt[tj * 4 + 2], rt[tj * 4 + 3]); *(u32x2*)(Rrow + c * 144 + cb * 2) = w;
        w.x = pack2(bt[tj * 4], bt[tj * 4 + 1]); w.y = pack2(bt[tj * 4 + 2], bt[tj * 4 + 3]); *(u32x2*)(Brow + c * 144 + cb * 2) = w;
        w.x = pack2(kt[tj * 4], kt[tj * 4 + 1]); w.y = pack2(kt[tj * 4 + 2], kt[tj * 4 + 3]); *(u32x2*)(Krow + c * 144 + cb * 2) = w;
#pragma unroll
        for (int r = 0; r < 4; ++r) {
            *(bf16_t*)(AT + (cb + r) * 144 + c * 2) = f2bf(at[tj * 4 + r]);
        }
    }
    __syncthreads();
    f32x4 pab[4], pak[4], prb[4], prk[4];
    {
        const int ti = wid;
#pragma unroll
        for (int tj = 0; tj < 4; ++tj) {
            pab[tj] = (f32x4){0.f, 0.f, 0.f, 0.f}; pak[tj] = pab[tj]; prb[tj] = pab[tj]; prk[tj] = pab[tj];
            if (tj <= ti) {
                pab[tj] = tile16(Arow, 144, 16 * ti, Brow, 144, 16 * tj, 64);
                pak[tj] = tile16(Krow, 144, 16 * tj, Arow, 144, 16 * ti, 64);
                prb[tj] = tile16(Brow, 144, 16 * tj, Rrow, 144, 16 * ti, 64);
                prk[tj] = tile16(Krow, 144, 16 * tj, Rrow, 144, 16 * ti, 64);
            }
        }
    }
    __syncthreads();
    {
        const int ti = wid;
#pragma unroll
        for (int tj = 0; tj < 4; ++tj) {
            const int s1 = 16 * tj + fr;
            f32x4 lv;
#pragma unroll
            for (int r = 0; r < 4; ++r) { const int t1 = 16 * ti + 4 * fq + r; lv[r] = (s1 < t1) ? -pab[tj][r] : 0.f; }
            *(f32x4*)&Lf[s1 * 72 + 16 * ti + 4 * fq] = lv;
            const int t2 = 16 * ti + fr;
            float m1[4], m2[4], m3[4];
#pragma unroll
            for (int r = 0; r < 4; ++r) { const int s2 = 16 * tj + 4 * fq + r; m1[r] = (s2 < t2) ? pak[tj][r] : 0.f; m2[r] = (s2 <= t2) ? prb[tj][r] : 0.f; m3[r] = (s2 <= t2) ? prk[tj][r] : 0.f; }
            u32x2 w;
            w.x = pack2(m1[0], m1[1]); w.y = pack2(m1[2], m1[3]); *(u32x2*)(Aak + t2 * 144 + (16 * tj + 4 * fq) * 2) = w;
            w.x = pack2(m2[0], m2[1]); w.y = pack2(m2[2], m2[3]); *(u32x2*)(Arb + t2 * 144 + (16 * tj + 4 * fq) * 2) = w;
            w.x = pack2(m3[0], m3[1]); w.y = pack2(m3[2], m3[3]); *(u32x2*)(Ark + t2 * 144 + (16 * tj + 4 * fq) * 2) = w;
        }
    }
    __syncthreads();
    if (wid == 0) {
        float Tc[64];
#pragma unroll
        for (int i = 0; i < 64; ++i) Tc[i] = (i == lane) ? 1.f : 0.f;
#pragma unroll
        for (int j = 0; j < 63; ++j) {
            const float tj = Tc[j];
#pragma unroll
            for (int i4 = (j + 1) >> 2; i4 < 16; ++i4) {
                const f32x4 l4 = *(const f32x4*)&Lf[j * 72 + i4 * 4];
#pragma unroll
                for (int e = 0; e < 4; ++e) if (i4 * 4 + e > j) Tc[i4 * 4 + e] -= l4[e] * tj;
            }
        }
#pragma unroll
        for (int i = 0; i < 64; ++i) *(bf16_t*)(Trow + i * 144 + lane * 2) = f2bf(Tc[i]);
    }
    __syncthreads();
    {
        const int ti = wid;
#pragma unroll
        for (int tj = 0; tj < 4; ++tj) {
            const f32x4 x = tile16(Trow, 144, 16 * ti, AT, 144, 16 * tj, 64);
            const f32x4 y = tile16(Aak, 144, 16 * ti, VT, 144, 16 * tj, 64);
            u32x2 w;
            w.x = pack2(x[0], x[1]); w.y = pack2(x[2], x[3]); *(u32x2*)(ApT + (16 * tj + fr) * 144 + (16 * ti + 4 * fq) * 2) = w;
            w.x = pack2(y[0], y[1]); w.y = pack2(y[2], y[3]); *(u32x2*)(AkVT + (16 * tj + fr) * 144 + (16 * ti + 4 * fq) * 2) = w;
        }
    }
    __syncthreads();
    {
        const int ti = wid;
#pragma unroll
        for (int tj = 0; tj < 4; ++tj) {
            const f32x4 x = tile16(Trow, 144, 16 * ti, AkVT, 144, 16 * tj, 64);
            u32x2 w; w.x = pack2(x[0], x[1]); w.y = pack2(x[2], x[3]); *(u32x2*)(VpT + (16 * tj + fr) * 144 + (16 * ti + 4 * fq) * 2) = w;
        }
    }
    __syncthreads();
#pragma unroll
    for (int tj = 0; tj < 4; ++tj)
#pragma unroll
        for (int r = 0; r < 4; ++r) {
            const int cb = 16 * tj + 4 * fq + r;
            *(bf16_t*)(BhT + cb * 144 + c * 2) = f2bf(bh[tj * 4 + r]);
            *(bf16_t*)(KhT + cb * 144 + c * 2) = f2bf(kh[tj * 4 + r]);
        }
    __syncthreads();
    {
        unsigned char* opsA = p.ws + WS_HN + (size_t)ch * 16384;
        unsigned char* opsB = p.ws + WS_ROPS + (size_t)ch * 16384;
        const int ti = wid;
#pragma unroll
        for (int tj = 0; tj < 4; ++tj) {
            const f32x4 x = tile16(ApT, 144, 16 * tj, Arb, 144, 16 * ti, 64);
            const f32x4 g = tile16(ApT, 144, 16 * tj, BhT, 144, 16 * ti, 64);
            const int m1 = 16 * ti + fr, mt = m1 >> 5, rr = m1 & 31, hh = fq & 1, jg = fq >> 1;
            const size_t off = ((size_t)((mt * 4 + tj) * 64 + hh * 32 + rr) * 8 + jg * 4) * 2;
            float gd[4];
#pragma unroll
            for (int r = 0; r < 4; ++r) gd[r] = g[r] + ((16 * tj + 4 * fq + r == m1) ? WC[m1] : 0.f);
            u32x2 w;
            w.x = pack2(x[0] + rt[tj * 4], x[1] + rt[tj * 4 + 1]); w.y = pack2(x[2] + rt[tj * 4 + 2], x[3] + rt[tj * 4 + 3]); *(u32x2*)(opsA + off) = w;
            w.x = pack2(gd[0], gd[1]); w.y = pack2(gd[2], gd[3]); *(u32x2*)(opsA + 8192 + off) = w;
            f32x4 y = tile16(Ark, 144, 16 * ti, VT, 144, 16 * tj, 64);
            const f32x4 y2 = tile16(Arb, 144, 16 * ti, VpT, 144, 16 * tj, 64);
            f32x4 kv = tile16(KhT, 144, 16 * ti, VT, 144, 16 * tj, 64);
            const f32x4 kv2 = tile16(BhT, 144, 16 * ti, VpT, 144, 16 * tj, 64);
            const int vcol = 16 * tj + fr, slice = vcol >> 5, r2 = vcol & 31, cb = 16 * ti + 4 * fq, mt2 = cb >> 5, q4 = (cb & 31) >> 2, h2 = q4 & 1, rg = q4 >> 1;
            const size_t off2 = ((size_t)((slice * 2 + mt2) * 64 + h2 * 32 + r2) * 16 + rg * 4) * 2;
            w.x = pack2(y[0] + y2[0], y[1] + y2[1]); w.y = pack2(y[2] + y2[2], y[3] + y2[3]); *(u32x2*)(opsB + off2) = w;
            w.x = pack2(kv[0] + kv2[0], kv[1] + kv2[1]); w.y = pack2(kv[2] + kv2[2], kv[3] + kv2[3]); *(u32x2*)(opsB + 8192 + off2) = w;
        }
    }
}

DI void rwkv_scan_block(const P& p, int bh, char* lds, bool dry = false) {
    const int tid = tidx(), lane = tid & 63, w = tid >> 6, slice = w & 1;
    const int h = bh & 7, b = bh >> 3;
    constexpr int NST = 64 * 2, AH = 3;
    auto issue = [&](int j) {
        const int n = j >> 1, k = j & 1;
        const size_t ch = (size_t)((b * 64 + n) * 8 + h) * 16384;
        const unsigned char* s0 = (k == 0 ? p.ws + WS_ROPS + ch + 8192 : p.ws + WS_ROPS + ch) + tid * 16;
        const unsigned char* s1 = (k == 0 ? p.ws + WS_HN + ch + 8192 : p.ws + WS_HN + ch) + tid * 16;
        char* dst = lds + (j & 3) * 16384 + tid * 16;
        glds16(s0, dst); glds16(s0 + 4096, dst + 4096); glds16(s1, dst + 8192); glds16(s1 + 4096, dst + 12288);
    };
    f32x16 H[2];
#pragma unroll
    for (int i = 0; i < 2; ++i)
#pragma unroll
        for (int r = 0; r < 16; ++r) H[i][r] = 0.f;
    __syncthreads();
#pragma unroll
    for (int j = 0; j < AH; ++j) issue(j);
#pragma unroll 1
    for (int n = 0; n < 64; ++n) {
        bf16x8 Hb[4];
#pragma unroll
        for (int i = 0; i < 2; ++i) { Hb[i * 2] = pack_step(H[i], 0); Hb[i * 2 + 1] = pack_step(H[i], 1); }
#pragma unroll
        for (int k = 0; k < 2; ++k) {
            const int j = n * 2 + k;
            if (n < 63) GS_WAIT(8); else if (k == 0) GS_WAIT(4); else GS_WAIT(0);
            __builtin_amdgcn_s_barrier();
            if (j + AH < NST) issue(j + AH);
            __builtin_amdgcn_sched_barrier(0);
            const char* sl = lds + (j & 3) * 16384;
            if (w < 2) {
                f32x16 acc[2];
#pragma unroll
                for (int mt = 0; mt < 2; ++mt) {
                    const u32x4* up = (const u32x4*)(sl + (slice * 2 + mt) * 2048 + lane * 32);
                    const u32x4 u0 = up[0], u1 = up[1];
#pragma unroll
                    for (int e = 0; e < 4; ++e) {
                        acc[mt][e * 2] = __uint_as_float(u0[e] << 16); acc[mt][e * 2 + 1] = __uint_as_float(u0[e] & 0xffff0000u);
                        acc[mt][8 + e * 2] = __uint_as_float(u1[e] << 16); acc[mt][8 + e * 2 + 1] = __uint_as_float(u1[e] & 0xffff0000u);
                    }
                }
                const bf16x8* fr = (const bf16x8*)(sl + 8192) + lane;
                bf16x8 f8[8];
#pragma unroll
                for (int q = 0; q < 8; ++q) f8[q] = fr[q * 64];
#pragma unroll
                for (int ks = 0; ks < 4; ++ks)
#pragma unroll
                    for (int mt = 0; mt < 2; ++mt) acc[mt] = mfma32(f8[mt * 4 + ks], Hb[ks], acc[mt]);
                if (k == 0) { H[0] = acc[0]; H[1] = acc[1]; }
                else {
                    const size_t ch = (size_t)((b * 64 + n) * 8 + h) * 16384;
                    u32x4* Yf = (u32x4*)(dry ? p.ws + WS_DUMMY + 2097152 + (size_t)(bh & 31) * 16384 : p.ws + WS_ROPS + ch) + (size_t)(slice * 128 + lane) * 2;
#pragma unroll
                    for (int mt = 0; mt < 2; ++mt) {
                        u32x4 o0, o1;
#pragma unroll
                        for (int e = 0; e < 4; ++e) { o0[e] = pack2(acc[mt][e * 2], acc[mt][e * 2 + 1]); o1[e] = pack2(acc[mt][8 + e * 2], acc[mt][8 + e * 2 + 1]); }
                        Yf[mt * 128] = o0; Yf[mt * 128 + 1] = o1;
                    }
                }
            }
        }
    }
    __syncthreads();
}

DI void rwkv_post_unit(const P& p, int li, int ch) {
    const int tid = tidx();
    const int h = ch & 7, n = (ch >> 3) & 63, b = ch >> 9;
    const int t0 = b * SEQ + n * 64;
    const int c = tid >> 2, cq = tid & 3;
    const bf16_t* Yf = (const bf16_t*)(p.ws + WS_ROPS + (size_t)ch * 16384);
    const bf16_t* vf = (const bf16_t*)(p.ws + WS_VF) + (size_t)(t0 + c) * 512 + h * 64 + cq * 16;
    const bf16_t* gg = (const bf16_t*)(p.ws + WS_GG) + (size_t)(t0 + c) * 512 + h * 64 + cq * 16;
    const float rk = ((const float*)(p.ws + WS_RK))[(size_t)(t0 + c) * 8 + h];
    const float* lnw = p.in[I_LNW] + li * 512 + h * 64 + cq * 16;
    const float* lnb = p.in[I_LNB] + li * 512 + h * 64 + cq * 16;
    bf16_t* mp = (bf16_t*)(p.ws + WS_HN) + (size_t)(t0 + c) * 1024 + 512 + h * 64 + cq * 16;
    const int mt = c >> 5, q4 = (c & 31) >> 2, hh = q4 & 1, rg = q4 >> 1, reg = rg * 4 + (c & 3), slice = cq >> 1, rb = (cq & 1) * 16;
    float y[16]; float sm = 0.f;
#pragma unroll
    for (int i = 0; i < 16; ++i) { y[i] = bf2f(Yf[(size_t)((slice * 2 + mt) * 64 + hh * 32 + rb + i) * 16 + reg]); sm += y[i]; }
    sm += __shfl_xor(sm, 1); sm += __shfl_xor(sm, 2);
    const float mean = sm * (1.f / 64.f);
    float vs = 0.f;
#pragma unroll
    for (int i = 0; i < 16; ++i) { y[i] -= mean; vs += y[i] * y[i]; }
    vs += __shfl_xor(vs, 1); vs += __shfl_xor(vs, 2);
    const float rs = rsqrtf(vs * (1.f / 64.f) + 64e-5f);
#pragma unroll
    for (int i8 = 0; i8 < 2; ++i8) {
        const u32x4 vw = *(const u32x4*)(vf + i8 * 8), gw = *(const u32x4*)(gg + i8 * 8);
        u32x4 w;
#pragma unroll
        for (int e = 0; e < 4; ++e) {
            const int i = i8 * 8 + e * 2;
            const float v0 = __uint_as_float(vw[e] << 16), v1 = __uint_as_float(vw[e] & 0xffff0000u), g0 = __uint_as_float(gw[e] << 16), g1 = __uint_as_float(gw[e] & 0xffff0000u);
            w[e] = pack2((y[i] * rs * lnw[i] + lnb[i] + rk * v0) * g0, (y[i + 1] * rs * lnw[i + 1] + lnb[i + 1] + rk * v1) * g1);
        }
        *(u32x4*)(mp + i8 * 8) = w;
    }
}


DI void attn_unit(const P& p, int unit, char* lds) {
    const int tid = tidx(), lane = tid & 63, w = tid >> 6, r_ = lane & 31, hl = lane >> 5;
    const int idx = unit & 31, h = (unit >> 5) & 7, g = (unit >> 8) % 3, b = unit / 768;
    const int lg2 = g * 2, dil = 1 << lg2, L = SEQ >> lg2, ntl = L >> 7;
    const int rs = idx / ntl, qt = idx % ntl;
    const int hg = g * 8 + h;
    const bf16_t* QK = (const bf16_t*)(p.ws + WS_QK);
    const bf16_t* VT = (const bf16_t*)(p.ws + WS_VT) + ((size_t)((b * 24 + hg) * dil + rs) * 64) * L;
    const int qi = 32 * w + r_;
    const int q_idx = 128 * qt + qi;
    const size_t qrow = (size_t)(b * SEQ + q_idx * dil + rs);
    const int kbase0 = 128 * qt - 128;
    char* Kt = lds;
    char* Vt = lds + 32768;
    __syncthreads();
#pragma unroll
    for (int i = 0; i < 8; ++i) {
        const int id = tid + i * 256, row = id >> 3, pc = id & 7, c = pc ^ ((row >> 1) & 7);
        int k_idx = kbase0 + row; if (k_idx < 0) k_idx = 0;
        glds16(QK + (size_t)(b * SEQ + k_idx * dil + rs) * 3072 + 1536 + hg * 64 + c * 8, Kt + id * 16);
    }
#pragma unroll
    for (int i = 0; i < 8; ++i) {
        const int id = tid + i * 256, row = id >> 5, pq = id & 31, q = pq ^ (row & 31);
        int k0 = kbase0 + q * 8; if (k0 < 0) k0 = 0;
        glds16(VT + (size_t)row * L + k0, Vt + id * 16);
    }
    bf16x8 qf[4];
#pragma unroll
    for (int ks = 0; ks < 4; ++ks) qf[ks] = *(const bf16x8*)(QK + qrow * 3072 + hg * 64 + 16 * ks + 8 * hl);
    asm volatile("s_waitcnt vmcnt(0)" ::: "memory");
    __syncthreads();
    f32x16 st[5];
    float mx = -1.0e30f;
#pragma unroll
    for (int kbi = 0; kbi < 5; ++kbi) {
        const int krow = 32 * (w + kbi) + r_;
#pragma unroll
        for (int r = 0; r < 16; ++r) st[kbi][r] = 0.f;
#pragma unroll
        for (int ks = 0; ks < 4; ++ks) {
            const bf16x8 kf = *(const bf16x8*)(Kt + krow * 128 + (((2 * ks + hl) ^ ((krow >> 1) & 7)) * 16));
            st[kbi] = mfma32(kf, qf[ks], st[kbi]);
        }
#pragma unroll
        for (int r = 0; r < 16; ++r) {
            const int kj = 32 * (w + kbi) + (r & 3) + 8 * (r >> 2) + 4 * hl;
            const bool valid = (kj >= qi) && (kj <= qi + 128) && (kbase0 + kj >= 0);
            const float sv = valid ? st[kbi][r] * 0.125f : -1.0e30f;
            st[kbi][r] = sv; mx = fmaxf(mx, sv);
        }
    }
    mx = fmaxf(mx, __shfl_xor(mx, 32));
    float l = 0.f;
#pragma unroll
    for (int kbi = 0; kbi < 5; ++kbi)
#pragma unroll
        for (int r = 0; r < 16; ++r) { const float pv = __expf(st[kbi][r] - mx); st[kbi][r] = pv; l += pv; }
    l += __shfl_xor(l, 32);
    f32x16 ot[2];
#pragma unroll
    for (int dt = 0; dt < 2; ++dt)
#pragma unroll
        for (int r = 0; r < 16; ++r) ot[dt][r] = 0.f;
#pragma unroll
    for (int kbi = 0; kbi < 5; ++kbi)
#pragma unroll
        for (int s2 = 0; s2 < 2; ++s2) {
            const bf16x8 pb = pack_step(st[kbi], s2);
            const int q0 = 4 * (w + kbi) + 2 * s2;
#pragma unroll
            for (int dt = 0; dt < 2; ++dt) {
                const int drow = 32 * dt + r_;
                const u32x2 lo = *(const u32x2*)(Vt + drow * 512 + ((q0 ^ (drow & 31)) * 16) + 8 * hl);
                const u32x2 hi = *(const u32x2*)(Vt + drow * 512 + (((q0 + 1) ^ (drow & 31)) * 16) + 8 * hl);
                u32x4 vw; vw.x = lo.x; vw.y = lo.y; vw.z = hi.x; vw.w = hi.y;
                ot[dt] = mfma32(__builtin_bit_cast(bf16x8, vw), pb, ot[dt]);
            }
        }
    const float inv = 1.f / l;
    bf16_t* og = (bf16_t*)(p.ws + WS_OG) + ((size_t)g * T + qrow) * 512 + h * 64;
#pragma unroll
    for (int dt = 0; dt < 2; ++dt)
#pragma unroll
        for (int rg = 0; rg < 4; ++rg) {
            u32x2 wv; wv.x = pack2(ot[dt][rg * 4] * inv, ot[dt][rg * 4 + 1] * inv); wv.y = pack2(ot[dt][rg * 4 + 2] * inv, ot[dt][rg * 4 + 3] * inv);
            *(u32x2*)(og + 32 * dt + 8 * rg + 4 * hl) = wv;
        }
    if (hl == 0) ((float*)(p.ws + WS_LSE))[((size_t)g * T + qrow) * 8 + h] = mx + __logf(l);
}
DI void phase_attn_merge(const P& p) {
    const bf16_t* og = (const bf16_t*)(p.ws + WS_OG);
    const float* lse = (const float*)(p.ws + WS_LSE);
    bf16_t* o = (bf16_t*)(p.ws + WS_HN);
    for (int i = bidx() * 256 + tidx(); i < T * 64; i += gridDim.x * 256) {
        const int t = i >> 6, c8 = i & 63, h = c8 >> 3;
        const float l0 = lse[(size_t)t * 8 + h], l1 = lse[((size_t)T + t) * 8 + h], l2 = lse[((size_t)2 * T + t) * 8 + h];
        const float m = fmaxf(l0, fmaxf(l1, l2));
        float w0 = __expf(l0 - m), w1 = __expf(l1 - m), w2 = __expf(l2 - m);
        const float inv = 1.f / (w0 + w1 + w2); w0 *= inv; w1 *= inv; w2 *= inv;
        const u32x4 a = *(const u32x4*)(og + (size_t)t * 512 + c8 * 8), bq = *(const u32x4*)(og + ((size_t)T + t) * 512 + c8 * 8), cq = *(const u32x4*)(og + ((size_t)2 * T + t) * 512 + c8 * 8);
        u32x4 r;
#pragma unroll
        for (int e = 0; e < 4; ++e) {
            const float x0 = w0 * __uint_as_float(a[e] << 16) + w1 * __uint_as_float(bq[e] << 16) + w2 * __uint_as_float(cq[e] << 16);
            const float x1 = w0 * __uint_as_float(a[e] & 0xffff0000u) + w1 * __uint_as_float(bq[e] & 0xffff0000u) + w2 * __uint_as_float(cq[e] & 0xffff0000u);
            r[e] = pack2(x0, x1);
        }
        *(u32x4*)(o + (size_t)t * 512 + c8 * 8) = r;
    }
}


#define XB_TMO      128
#define XB_XCNT(j)  (256  + 64 * (j))
#define XB_XSUB(j)  (1280 + 64 * (j))
#define XB_XGEN(j)  (2304 + 64 * (j))
#define XB_TOP      3328
#define XB_TOPGEN   3392
#define XCD_BAR_WORDS 3456
#define XB_SPIN_CAP (1u << 22)
#define LAS __attribute__((address_space(3)))
DI unsigned xb_ld(unsigned* p)              { return __hip_atomic_load(p, __ATOMIC_RELAXED, __HIP_MEMORY_SCOPE_AGENT); }
DI unsigned xb_add(unsigned* p, unsigned v) { return __hip_atomic_fetch_add(p, v, __ATOMIC_RELAXED, __HIP_MEMORY_SCOPE_AGENT); }
DI unsigned xb_xcc_id() { return (unsigned)__builtin_amdgcn_s_getreg((3 << 11) | 20) & 0xFu; }
#define XB_SPIN(cond, bar) do { unsigned _sp = 0; while (cond) { if (_sp < 32u) __builtin_amdgcn_s_sleep(2); else __builtin_amdgcn_s_sleep(24); \
    if ((++_sp & 255u) == 0u) { if (xb_ld(&(bar)[XB_TMO])) break; if (_sp > XB_SPIN_CAP) { atomicAdd(&(bar)[XB_TMO], 1u); break; } } } } while (0)
struct XcdBarrier { unsigned* bar; unsigned x; volatile LAS unsigned* st; };
DI XcdBarrier xcd_barrier_post(unsigned* bar, volatile LAS unsigned* st) {
    XcdBarrier b; b.bar = bar; b.x = xb_xcc_id(); b.st = st;
    if (threadIdx.x == 0) (void)xb_add(&bar[XB_XCNT(b.x)], 1u);
    return b;
}
DI void xcd_barrier_complete(unsigned* bar, unsigned x, unsigned& nloc, unsigned& nx) {
    const unsigned G = gridDim.x * gridDim.y * gridDim.z;
    unsigned sum, cnt, mine, sp = 0u;
    for (;;) {
        sum = 0u; cnt = 0u; mine = 0u;
#pragma unroll
        for (unsigned j = 0; j < 16; ++j) { const unsigned c = xb_ld(&bar[XB_XCNT(j)]); sum += c; cnt += (c > 0u) ? 1u : 0u; mine = (j == x) ? c : mine; }
        if (sum == G) break;
        __builtin_amdgcn_s_sleep(1);
        if ((++sp & 255u) == 0u) { if (xb_ld(&bar[XB_TMO])) break; if (sp > XB_SPIN_CAP) { atomicAdd(&bar[XB_TMO], 1u); break; } }
    }
    nloc = mine > 0u ? mine : 1u; nx = cnt > 0u ? cnt : 1u;
}
DI void xcd_barrier(const XcdBarrier& b) {
    asm volatile("s_waitcnt vmcnt(0)" ::: "memory");
    __syncthreads();
    if (threadIdx.x == 0) {
        unsigned* bar = b.bar;
        __builtin_amdgcn_s_waitcnt(0);
        unsigned nloc = b.st[0], nx = b.st[1];
        if (nloc == 0u) { xcd_barrier_complete(bar, b.x, nloc, nx); b.st[0] = nloc; b.st[1] = nx; }
        const unsigned old = xb_add(&bar[XB_XSUB(b.x)], 1u);
        const unsigned gen = old / nloc;
        if (old + 1u == (gen + 1u) * nloc) {
            __builtin_amdgcn_fence(__ATOMIC_RELEASE, "agent");
            asm volatile("s_waitcnt vmcnt(0)" ::: "memory");
            const unsigned og = xb_add(&bar[XB_TOP], 1u);
            const unsigned tg = og / nx;
            if (og + 1u == (tg + 1u) * nx) xb_add(&bar[XB_TOPGEN], 1u);
            else XB_SPIN(xb_ld(&bar[XB_TOPGEN]) == tg, bar);
            __builtin_amdgcn_fence(__ATOMIC_ACQUIRE, "agent");
            xb_add(&bar[XB_XGEN(b.x)], 1u);
            asm volatile("s_waitcnt vmcnt(0)" ::: "memory");
        } else {
            XB_SPIN(xb_ld(&bar[XB_XGEN(b.x)]) == gen, bar);
            __builtin_amdgcn_fence(__ATOMIC_ACQUIRE, "agent");
            asm volatile("s_waitcnt vmcnt(0)" ::: "memory");
        }
    }
    __syncthreads();
}

constexpr int LDS_BYTES = RP_END;
static_assert(GP_END + 6144 <= LDS_BYTES, "LDS");
__global__ void __launch_bounds__(256, 2) mega(P p) {
    cg::grid_group grid = cg::this_grid();
    extern __shared__ __attribute__((aligned(16))) char lds[];
    if (threadIdx.x < 4) ((volatile LAS unsigned*)(lds + LDS_BYTES))[threadIdx.x] = 0u;
    __syncthreads();
    const XcdBarrier xb = xcd_barrier_post((unsigned*)(p.ws + WS_CTL + CTL_BAR), (volatile LAS unsigned*)(lds + LDS_BYTES));
#define GSYNC() xcd_barrier(xb)
    const bf16_t* HN = (const bf16_t*)(p.ws + WS_HN);
    const bf16_t* Win = (const bf16_t*)(p.ws + WS_W + W_IN);
    const bf16_t* Wout = (const bf16_t*)(p.ws + WS_W + W_OUT);
    phase_rope(p);
    phase_convert_io(p, 0, lds);
    phase_prep<0>(p, p.in[I_EVNORM], 0);
    if (p.ws == nullptr) grid.sync();
    GSYNC();
    volatile LAS unsigned* qword = (volatile LAS unsigned*)(lds + LDS_BYTES + 8);
    for (int layer = 0; layer < 4; ++layer) {
        const int li = layer >> 1;
        if ((layer & 1) == 0) {
            phase_gemm<EPI_EVEN_IN>(p, HN, 1024, Win, 1024, EVPAD / 128, lds);
            GSYNC();
            for (int u = bidx(); u < 1024; u += gridDim.x) gdn_prep_unit(p, li, u, lds);
            GSYNC();
            if (bidx() < 16) gdn_scan_block(p, bidx(), lds);
            {
                unsigned* qctr = (unsigned*)(p.ws + WS_CTL + CTL_QUEUE) + li * 64;
                for (;;) {
                    __syncthreads();
                    if (threadIdx.x == 0) *qword = atomicAdd(qctr, 1u);
                    __syncthreads();
                    const unsigned u = *qword;
                    if (u >= 2048u) break;
                    rwkv_prep_unit(p, li, (int)u, lds);
                }
            }
            GSYNC();
            if (bidx() < 32) rwkv_scan_block(p, bidx(), lds);
            else {
                for (int u = bidx() - 32; u < 1024; u += gridDim.x - 32) gdn_post_unit(p, li, u);
                phase_convert_moe(p, layer, lds, bidx() - 32, gridDim.x - 32);
            }
            GSYNC();
            for (int u = bidx(); u < 2048; u += gridDim.x) rwkv_post_unit(p, li, u);
            GSYNC();
            phase_gemm<EPI_RESID>(p, (const bf16_t*)(p.ws + WS_PROJ), EVLD, Wout, 1024, 8, lds, false, HN, 1024, 512);
        } else {
            phase_gemm<EPI_ODD_IN>(p, HN, 1024, Win, 1024, ODC / 128, lds);
            GSYNC();
            for (int u = bidx(); u < 3072; u += gridDim.x) attn_unit(p, u, lds);
            GSYNC();
            phase_attn_merge(p);
            GSYNC();
            phase_gemm<EPI_RESID>(p, HN, 512, Wout, 512, 8, lds);
        }
        GSYNC();
        phase_router(p, p.in[I_FFNNORM] + layer * 1024, layer, lds);
        GSYNC();
        phase_moe_up(p, layer, lds);
        GSYNC();
        phase_moe_down(p, layer, lds);
        GSYNC();
        if (layer < 3) {
            phase_convert_io(p, layer + 1, lds);
            if ((layer + 1) & 1) phase_convert_moe(p, layer + 1, lds, bidx(), gridDim.x);
            phase_prep<1>(p, ((layer + 1) & 1) ? p.in[I_ODNORM] + ((layer + 1) >> 1) * 1024 : p.in[I_EVNORM] + ((layer + 1) >> 1) * 1024, layer + 1);
            GSYNC();
        }
    }
    phase_prep<3>(p, p.in[I_FINAL], 0);
}

extern "C" void kernel_launch(void* const* d_in, const int* in_sizes, int n_in, void* d_out, int out_size, void* d_ws, size_t ws_size, hipStream_t stream) {
    if (n_in != 34 || out_size != T * D || ws_size < WS_END) { fprintf(stderr, "kernel_launch: unexpected shapes (n_in %d out %d ws %zu need %zu)\n", n_in, out_size, ws_size, (size_t)WS_END); return; }
    static int grid_blocks = 0;
    if (!grid_blocks) {
        int dev = 0, cus = 0, per_cu = 0;
        (void)hipGetDevice(&dev);
        (void)hipDeviceGetAttribute(&cus, hipDeviceAttributeMultiprocessorCount, dev);
        (void)hipFuncSetAttribute((const void*)mega, hipFuncAttributeMaxDynamicSharedMemorySize, LDS_BYTES + 16);
        (void)hipOccupancyMaxActiveBlocksPerMultiprocessor(&per_cu, mega, 256, LDS_BYTES + 16);
        if (per_cu < 1) per_cu = 1;
        if (per_cu > 2) per_cu = 2;
        grid_blocks = cus * per_cu;
    }
    P p{};
    for (int i = 0; i < 34; ++i) p.in[i] = (const float*)d_in[i];
    p.out = (float*)d_out; p.ws = (unsigned char*)d_ws;
    (void)hipMemsetAsync((char*)d_ws + WS_CTL, 0, 65536, stream);
    void* args[] = {&p};
    hipError_t e = hipLaunchCooperativeKernel((void*)mega, dim3(grid_blocks), dim3(256), args, LDS_BYTES + 16, stream);
    if (e != hipSuccess) fprintf(stderr, "cooperative launch failed: %s (grid %d)\n", hipGetErrorString(e), grid_blocks);
}
```

```cpp
#include <hip/hip_runtime.h>
#include <cstdio>
#include <cstdint>
#include <cmath>
#include <hip/hip_cooperative_groups.h>
namespace cg = cooperative_groups;

typedef unsigned short bf16_t;
typedef short bf16x8 __attribute__((ext_vector_type(8)));
typedef float f32x4 __attribute__((ext_vector_type(4)));
typedef unsigned u32x4 __attribute__((ext_vector_type(4)));
typedef unsigned u32x2 __attribute__((ext_vector_type(2)));
#define DI __device__ __forceinline__

constexpr int T = 16384, SEQ = 4096, BATCH = 4, D = 1024;
constexpr int EVC = 3784, EVLD = 3784, EVPAD = 3840;
constexpr int ODC = 4608;
constexpr int RW0 = 2056;
constexpr int C_R = 2056, C_K = 2568, C_V = 3080, C_HW = 3592, C_HA = 3624, C_HG = 3656, C_HV = 3752;
constexpr int NEXP = 16, FF = 256;
constexpr int HROWS = 34816;

constexpr size_t WS_CTL = 0;
constexpr size_t CTL_EGL = 4096;
constexpr size_t CTL_QUEUE = 49152;
constexpr size_t CTL_CNT = 32768;
constexpr size_t CTL_BAR = 16384;
constexpr size_t WS_LIST = 65536;
constexpr size_t WS_GATE = WS_LIST + 16 * 16384 * 4;
constexpr size_t WS_RK = WS_GATE + 16 * 16384 * 4;
constexpr size_t WS_ROPE = WS_RK + (size_t)T * 8 * 4;
constexpr size_t WS_W = WS_ROPE + (size_t)T * 32 * 8;
constexpr size_t W_IN = 0;
constexpr size_t W_OUT = (size_t)4608 * 1024 * 2;
constexpr size_t W_13 = W_OUT + (size_t)1024 * 1024 * 2;
constexpr size_t W_2 = W_13 + (size_t)16 * 512 * 1024 * 2;
constexpr size_t W_LW = W_2 + (size_t)16 * 1024 * 256 * 2;
constexpr size_t W_BYTES = W_LW + (size_t)512 * 192 * 2;
constexpr size_t WS_HN = WS_W + W_BYTES;
constexpr size_t WS_VF = WS_HN + (size_t)T * 1024 * 2;
constexpr size_t WS_R2 = WS_VF + (size_t)T * 512 * 2;
constexpr size_t WS_PROJ = WS_R2;
constexpr size_t WS_GOPS = WS_R2 + (size_t)T * EVLD * 2;
constexpr size_t GOPS_CH = 73728, GO_WF = 0, GO_QF = 16384, GO_UF = 32768, GO_AF = 49152, GO_KF = 57344;
constexpr size_t WS_ROPS = WS_GOPS + 1024 * GOPS_CH;
constexpr size_t WS_QK = WS_R2;
constexpr size_t WS_VT = WS_QK + (size_t)T * 3072 * 2;
constexpr size_t WS_OG = WS_VT + (size_t)T * 1536 * 2;
constexpr size_t WS_LSE = WS_OG + (size_t)3 * T * 512 * 2;
constexpr size_t WS_END3 = WS_LSE + (size_t)3 * T * 8 * 4;
constexpr size_t WS_YS = WS_R2;
constexpr size_t WS_H = WS_YS + (size_t)2 * T * 1024 * 2;
constexpr size_t WS_GG = WS_ROPS + (size_t)2048 * 16384;
constexpr size_t WS_END0 = WS_GG + (size_t)T * 512 * 2;
constexpr size_t WS_END1 = WS_H + (size_t)HROWS * 256 * 2;
constexpr size_t WS_END2 = WS_R2 + (size_t)T * 4608 * 2;
static_assert(WS_END3 <= WS_END0, "odd-layer regions exceed even-layer footprint");
constexpr size_t WS_END = WS_END0 > WS_END1 ? (WS_END0 > WS_END2 ? WS_END0 : WS_END2) : (WS_END1 > WS_END2 ? WS_END1 : WS_END2);

constexpr size_t WS_DUMMY = WS_END0;
struct P {
    const float* in[34];
    float* out;
    unsigned char* ws;
};
enum { I_X = 0, I_POS, I_EVNORM, I_EVWIN, I_VRESDOWN, I_EVWOUT, I_CONVW, I_ALOG, I_DTB, I_GDNNORM, I_MU, I_W0, I_W2, I_A0, I_A2, I_G2,
       I_KK, I_KA, I_RK, I_LNW, I_LNB, I_VRESMU, I_V0, I_V2, I_ODNORM, I_ODWIN, I_ODWOUT, I_FFNNORM, I_WGROUP, I_WEXPERT, I_W1, I_W3, I_MW2, I_FINAL };

DI int tidx() { int t = threadIdx.x; asm volatile("" : "+v"(t)); return t; }
DI int bidx() { int b = blockIdx.x; asm volatile("" : "+s"(b)); return b; }
typedef __bf16 bf2_t __attribute__((ext_vector_type(2)));
typedef float f2_t __attribute__((ext_vector_type(2)));
DI bf16_t f2bf(float x) { return __builtin_bit_cast(bf16_t, (__bf16)x); }
DI float bf2f(bf16_t h) { return __uint_as_float(((unsigned)h) << 16); }
DI unsigned pack2(float lo, float hi) { const f2_t v = {lo, hi}; return __builtin_bit_cast(unsigned, __builtin_convertvector(v, bf2_t)); }
DI float wave_sum(float v) {
#pragma unroll
    for (int o = 32; o > 0; o >>= 1) v += __shfl_xor(v, o);
    return v;
}
DI float wave_max(float v) {
#pragma unroll
    for (int o = 32; o > 0; o >>= 1) v = fmaxf(v, __shfl_xor(v, o));
    return v;
}
DI float sigmoidf_(float x) { return __builtin_amdgcn_rcpf(1.f + __expf(-x)); }
DI float siluf_(float x) { return x * __builtin_amdgcn_rcpf(1.f + __expf(-x)); }
DI float softplusf_(float x) { return fmaxf(x, 0.f) + __logf(1.f + __expf(-fabsf(x))); }

struct ConvJob { const float* src; bf16_t* dst; int K, N, ldd; int mode; };
DI int rowmap(int mode, int n) { return mode == 0 ? n : ((n >> 4) * 32 + (n & 15) + (mode == 2 ? 16 : 0)); }
DI void conv_tile(const ConvJob& j, int tile, float* lds  ) {
    const int ntn = (j.N + 255) / 256;
    const int tk = tile / ntn, tn = tile % ntn;
    const int tid = tidx();
    __syncthreads();
    float4 v[16];
#pragma unroll
    for (int i = 0; i < 16; ++i) {
        const int e = tid + i * 256, k = e >> 6, n4 = (e & 63) * 4;
        const int gk = tk * 64 + k, gn = tn * 256 + n4;
        v[i] = make_float4(0.f, 0.f, 0.f, 0.f);
        if (gn < j.N) v[i] = *(const float4*)(j.src + (size_t)gk * j.N + gn);
    }
#pragma unroll
    for (int i = 0; i < 16; ++i) { const int e = tid + i * 256, k = e >> 6, n4 = (e & 63) * 4; *(float4*)(lds + k * 260 + n4) = v[i]; }
    __syncthreads();
#pragma unroll
    for (int i = 0; i < 8; ++i) {
        const int e = tid + i * 256, n = e & 255, k8 = (e >> 8) * 8;
        const int gn = tn * 256 + n;
        if (gn < j.N) {
            u32x4 w;
            w.x = pack2(lds[(k8 + 0) * 260 + n], lds[(k8 + 1) * 260 + n]); w.y = pack2(lds[(k8 + 2) * 260 + n], lds[(k8 + 3) * 260 + n]);
            w.z = pack2(lds[(k8 + 4) * 260 + n], lds[(k8 + 5) * 260 + n]); w.w = pack2(lds[(k8 + 6) * 260 + n], lds[(k8 + 7) * 260 + n]);
            *(u32x4*)(j.dst + (size_t)rowmap(j.mode, gn) * j.ldd + tk * 64 + k8) = w;
        }
    }
}
DI void phase_convert_io(const P& p, int layer, char* ldsc) {
    float* lds = (float*)ldsc;
    unsigned char* W = p.ws + WS_W;
    const int li = layer >> 1;
    if ((layer & 1) == 0) {
        const ConvJob j0{p.in[I_EVWIN] + (size_t)li * 1024 * 3752, (bf16_t*)(W + W_IN), 1024, 3752, 1024, 0};
        for (int t = bidx(); t < 16 * 15; t += gridDim.x) conv_tile(j0, t, lds);
        if (li == 1) {
            const ConvJob j1{p.in[I_VRESDOWN], (bf16_t*)(W + W_IN) + (size_t)3752 * 1024, 1024, 32, 1024, 0};
            for (int t = bidx(); t < 16; t += gridDim.x) conv_tile(j1, t, lds);
        }
        const ConvJob j2{p.in[I_EVWOUT] + (size_t)li * 1024 * 1024, (bf16_t*)(W + W_OUT), 1024, 1024, 1024, 0};
        for (int t = bidx(); t < 16 * 4; t += gridDim.x) conv_tile(j2, t, lds);
        {
            bf16_t* LW = (bf16_t*)(W + W_LW);
            for (int i = bidx() * 256 + tidx(); i < 512 * 192; i += gridDim.x * 256) {
                const int ch = i / 192, j = i % 192;
                float v;
                if (j < 32) v = p.in[I_W2][((size_t)li * 32 + j) * 512 + ch];
                else if (j < 64) v = p.in[I_A2][((size_t)li * 32 + j - 32) * 512 + ch];
                else if (j < 160) v = p.in[I_G2][((size_t)li * 96 + j - 64) * 512 + ch];
                else v = (li == 1) ? p.in[I_V2][(size_t)(j - 160) * 512 + ch] : 0.f;
                LW[i] = f2bf(v);
            }
        }
        const int r0 = (li == 1) ? 3784 : 3752;
        bf16_t* z = (bf16_t*)(W + W_IN) + (size_t)r0 * 1024;
        const size_t n = (size_t)(EVPAD - r0) * 1024;
        for (size_t i = (size_t)bidx() * 256 + tidx(); i < n; i += (size_t)gridDim.x * 256) z[i] = 0;
    } else {
        const ConvJob j0{p.in[I_ODWIN] + (size_t)li * 1024 * 4608, (bf16_t*)(W + W_IN), 1024, 4608, 1024, 0};
        for (int t = bidx(); t < 16 * 18; t += gridDim.x) conv_tile(j0, t, lds);
        const ConvJob j2{p.in[I_ODWOUT] + (size_t)li * 512 * 1024, (bf16_t*)(W + W_OUT), 512, 1024, 512, 0};
        for (int t = bidx(); t < 8 * 4; t += gridDim.x) conv_tile(j2, t, lds);
    }
}
DI void phase_convert_moe(const P& p, int layer, char* ldsc, int b0, int bs) {
    float* lds = (float*)ldsc;
    unsigned char* W = p.ws + WS_W;
    for (int t = b0; t < 16 * 3 * 16; t += bs) {
        const int e = t / 48, r = t % 48, which = r / 16, tile = r % 16;
        ConvJob j;
        if (which == 0) j = ConvJob{p.in[I_W1] + ((size_t)layer * 16 + e) * 1024 * 256, (bf16_t*)(W + W_13) + (size_t)e * 512 * 1024, 1024, 256, 1024, 1};
        else if (which == 1) j = ConvJob{p.in[I_W3] + ((size_t)layer * 16 + e) * 1024 * 256, (bf16_t*)(W + W_13) + (size_t)e * 512 * 1024, 1024, 256, 1024, 2};
        else j = ConvJob{p.in[I_MW2] + ((size_t)layer * 16 + e) * 256 * 1024, (bf16_t*)(W + W_2) + (size_t)e * 1024 * 256, 256, 1024, 256, 0};
        conv_tile(j, tile, lds);
    }
}

DI void phase_rope(const P& p) {
    float2* tab = (float2*)(p.ws + WS_ROPE);
    const int* pos = (const int*)p.in[I_POS];
    for (int i = bidx() * 256 + tidx(); i < T * 32; i += gridDim.x * 256) {
        const int t = i >> 5, f = i & 31;
        const float inv = powf(10000.0f, -(float)f * (2.0f / 64.0f));
        const float ang = (float)pos[t] * inv;
        float s, c; sincosf(ang, &s, &c);
        tab[i] = make_float2(c, s);
    }
}

template <int MODE>
DI void phase_prep(const P& p, const float* gain, int layer, bool dry = false) {
    const int lane = tidx() & 63, wid = tidx() >> 6;
    const int nw = gridDim.x * 4;
    bf16_t* hn = (bf16_t*)(p.ws + WS_HN);
    const bf16_t* y0 = (const bf16_t*)(p.ws + WS_YS);
    const bf16_t* y1 = y0 + (size_t)T * 1024;
    float4 gq[4];
#pragma unroll
    for (int i = 0; i < 4; ++i) gq[i] = *(const float4*)(gain + i * 256 + lane * 4);
    for (int t = bidx() * 4 + wid; t < T; t += nw) {
        float4 v[4];
        float ss = 0.f;
#pragma unroll
        for (int i = 0; i < 4; ++i) {
            const size_t off = (size_t)t * 1024 + i * 256 + lane * 4;
            if (MODE == 0) v[i] = *(const float4*)(p.in[I_X] + off);
            else v[i] = *(const float4*)(p.out + off);
            if (MODE == 1 || MODE == 3) {
                const u32x2 a = *(const u32x2*)(y0 + off), b = *(const u32x2*)(y1 + off);
                v[i].x += __uint_as_float(a.x << 16) + __uint_as_float(b.x << 16); v[i].y += __uint_as_float(a.x & 0xffff0000u) + __uint_as_float(b.x & 0xffff0000u);
                v[i].z += __uint_as_float(a.y << 16) + __uint_as_float(b.y << 16); v[i].w += __uint_as_float(a.y & 0xffff0000u) + __uint_as_float(b.y & 0xffff0000u);
            }
            ss += v[i].x * v[i].x + v[i].y * v[i].y + v[i].z * v[i].z + v[i].w * v[i].w;
        }
        ss = wave_sum(ss);
        const float rstd = rsqrtf(ss * (1.0f / 1024.0f) + 1e-6f);
        float lg[20];
        if (MODE == 2) {
#pragma unroll
            for (int q = 0; q < 20; ++q) lg[q] = 0.f;
        }
#pragma unroll
        for (int i = 0; i < 4; ++i) {
            const int col = i * 256 + lane * 4;
            const size_t off = (size_t)t * 1024 + col;
            const float4 g = gq[i];
            float4 h; h.x = v[i].x * rstd * g.x; h.y = v[i].y * rstd * g.y; h.z = v[i].z * rstd * g.z; h.w = v[i].w * rstd * g.w;
            float* od = dry ? (float*)(p.ws + WS_DUMMY) + (off & 0x7FFFF) : p.out + off;
            bf16_t* hd = dry ? (bf16_t*)(p.ws + WS_DUMMY + 2097152) + (off & 0x7FFFF) : hn + off;
            if (MODE == 0 || MODE == 1) *(float4*)od = v[i];
            if (MODE == 3) *(float4*)od = h;
            else { u32x2 w; w.x = pack2(h.x, h.y); w.y = pack2(h.z, h.w); *(u32x2*)hd = w; }
            if (MODE == 2) {
                const float hh[4] = {h.x, h.y, h.z, h.w};
                const float* wg = p.in[I_WGROUP] + (size_t)layer * 1024 * 4;
                const float* we = p.in[I_WEXPERT] + (size_t)layer * 4 * 1024 * 4;
#pragma unroll
                for (int e = 0; e < 4; ++e) {
                    const float4 a = *(const float4*)(wg + (size_t)(col + e) * 4);
                    lg[0] += hh[e] * a.x; lg[1] += hh[e] * a.y; lg[2] += hh[e] * a.z; lg[3] += hh[e] * a.w;
#pragma unroll
                    for (int g2 = 0; g2 < 4; ++g2) {
                        const float4 b = *(const float4*)(we + ((size_t)g2 * 1024 + col + e) * 4);
                        lg[4 + g2 * 4 + 0] += hh[e] * b.x; lg[4 + g2 * 4 + 1] += hh[e] * b.y; lg[4 + g2 * 4 + 2] += hh[e] * b.z; lg[4 + g2 * 4 + 3] += hh[e] * b.w;
                    }
                }
            }
        }
        if (MODE == 2) {
#pragma unroll
            for (int q = 0; q < 20; ++q) lg[q] = wave_sum(lg[q]);
            if (lane == 0) {
                int gs = 0; float gm = lg[0];
#pragma unroll
                for (int g2 = 1; g2 < 4; ++g2) if (lg[g2] > gm) { gm = lg[g2]; gs = g2; }
                float den = 0.f;
#pragma unroll
                for (int g2 = 0; g2 < 4; ++g2) den += __expf(lg[g2] - gm);
                const float pg = 1.f / den;
                float el[4];
#pragma unroll
                for (int e = 0; e < 4; ++e) el[e] = gs == 0 ? lg[4 + e] : gs == 1 ? lg[8 + e] : gs == 2 ? lg[12 + e] : lg[16 + e];
                int i1 = 0; float v1 = el[0];
#pragma unroll
                for (int e = 1; e < 4; ++e) if (el[e] > v1) { v1 = el[e]; i1 = e; }
                int i2 = 0; float v2 = -3.4e38f;
#pragma unroll
                for (int e = 0; e < 4; ++e) if (e != i1 && el[e] > v2) { v2 = el[e]; i2 = e; }
                const float e2 = __expf(v2 - v1);
                const float g1 = pg / (1.f + e2), g2v = pg * e2 / (1.f + e2);
                unsigned* cnt = (unsigned*)(p.ws + WS_CTL + CTL_CNT) + layer * 16 * 64;
                int* list = (int*)(p.ws + WS_LIST);
                float* gl = (float*)(p.ws + WS_GATE);
                const int ea = gs * 4 + i1, eb = gs * 4 + i2;
                const unsigned ra = atomicAdd(&cnt[ea * 64], 1u);
                list[ea * 16384 + ra] = t * 2; gl[ea * 16384 + ra] = g1;
                const unsigned rb = atomicAdd(&cnt[eb * 64], 1u);
                list[eb * 16384 + rb] = t * 2 + 1; gl[eb * 16384 + rb] = g2v;
            }
        }
    }
}


DI void phase_router(const P& p, const float* gain, int layer, char* ldsc, bool dry = false) {
    const int tid = tidx(), lane = tid & 63, wid = tid >> 6;
    bf16_t* hn = (bf16_t*)(p.ws + WS_HN);
    const float* wg = p.in[I_WGROUP] + (size_t)layer * 1024 * 4;
    const float* we = p.in[I_WEXPERT] + (size_t)layer * 4 * 1024 * 4;
    unsigned* cnt = dry ? (unsigned*)(p.ws + WS_DUMMY + 3145728) : (unsigned*)(p.ws + WS_CTL + CTL_CNT) + layer * 16 * 64;
    int* list = dry ? (int*)(p.ws + WS_DUMMY) : (int*)(p.ws + WS_LIST);
    float* gl = dry ? (float*)(p.ws + WS_DUMMY + 1048576) : (float*)(p.ws + WS_GATE);
    if (dry) hn = (bf16_t*)(p.ws + WS_DUMMY + 2097152);
    f32x4* WS = (f32x4*)ldsc;
    unsigned* lcnt = (unsigned*)(ldsc + 40960); unsigned* lbase = lcnt + 16; int* e_ent = (int*)(lcnt + 32); unsigned* r_ent = (unsigned*)(e_ent + 32); int* t_ent = (int*)(r_ent + 32); float* g_ent = (float*)(t_ent + 32);
    auto stage = [&](int i, int buf) {
#pragma unroll
        for (int r = 0; r < 5; ++r) {
            const int kk = tid;
            const float* src = (r == 0 ? wg : we + (size_t)(r - 1) * 4096) + (size_t)(i * 256 + kk) * 4;
            WS[buf * 1280 + (r * 4 + (kk & 3)) * 64 + (kk >> 2)] = *(const f32x4*)src;
        }
    };
    for (int tb = bidx() * 16; tb < T; tb += gridDim.x * 16) {
        __syncthreads();
        if (tid < 16) lcnt[tid] = 0u;
        stage(0, 0);
        const int t0 = tb + wid * 4;
        float rstd[4];
#pragma unroll
        for (int q = 0; q < 4; ++q) {
            float ss = 0.f;
#pragma unroll
            for (int i = 0; i < 4; ++i) {
                const float4 x4 = *(const float4*)(p.out + (size_t)(t0 + q) * 1024 + i * 256 + lane * 4);
                ss += x4.x * x4.x + x4.y * x4.y + x4.z * x4.z + x4.w * x4.w;
            }
            ss = wave_sum(ss);
            rstd[q] = rsqrtf(ss * (1.0f / 1024.0f) + 1e-6f);
        }
        float lg[4][20];
#pragma unroll
        for (int q = 0; q < 4; ++q)
#pragma unroll
            for (int j = 0; j < 20; ++j) lg[q][j] = 0.f;
#pragma unroll 1
        for (int i = 0; i < 4; ++i) {
            __syncthreads();
            if (i + 1 < 4) stage(i + 1, (i + 1) & 1);
            const f32x4* W = WS + (i & 1) * 1280;
            const int col = i * 256 + lane * 4;
            const float4 g = *(const float4*)(gain + col);
            float hh[4][4];
#pragma unroll
            for (int q = 0; q < 4; ++q) {
                const float4 x4 = *(const float4*)(p.out + (size_t)(t0 + q) * 1024 + col);
                hh[q][0] = x4.x * rstd[q] * g.x; hh[q][1] = x4.y * rstd[q] * g.y; hh[q][2] = x4.z * rstd[q] * g.z; hh[q][3] = x4.w * rstd[q] * g.w;
                u32x2 w; w.x = pack2(hh[q][0], hh[q][1]); w.y = pack2(hh[q][2], hh[q][3]);
                *(u32x2*)(hn + (dry ? (((size_t)(t0 + q) * 1024 + col) & 0x7FFFF) : ((size_t)(t0 + q) * 1024 + col))) = w;
            }
#pragma unroll
            for (int e = 0; e < 4; ++e) {
                const f32x4 a = W[(0 * 4 + e) * 64 + lane];
#pragma unroll
                for (int q = 0; q < 4; ++q) { lg[q][0] += hh[q][e] * a[0]; lg[q][1] += hh[q][e] * a[1]; lg[q][2] += hh[q][e] * a[2]; lg[q][3] += hh[q][e] * a[3]; }
#pragma unroll
                for (int g2 = 0; g2 < 4; ++g2) {
                    const f32x4 b = W[((1 + g2) * 4 + e) * 64 + lane];
#pragma unroll
                    for (int q = 0; q < 4; ++q) { lg[q][4 + g2 * 4] += hh[q][e] * b[0]; lg[q][5 + g2 * 4] += hh[q][e] * b[1]; lg[q][6 + g2 * 4] += hh[q][e] * b[2]; lg[q][7 + g2 * 4] += hh[q][e] * b[3]; }
                }
            }
        }
#pragma unroll
        for (int q = 0; q < 4; ++q) {
#pragma unroll
            for (int j = 0; j < 20; ++j) lg[q][j] = wave_sum(lg[q][j]);
            if (lane == q) {
                const int t = t0 + q;
                int gs = 0; float gm = lg[q][0];
#pragma unroll
                for (int g2 = 1; g2 < 4; ++g2) if (lg[q][g2] > gm) { gm = lg[q][g2]; gs = g2; }
                float den = 0.f;
#pragma unroll
                for (int g2 = 0; g2 < 4; ++g2) den += __expf(lg[q][g2] - gm);
                const float pg = 1.f / den;
                float el[4];
#pragma unroll
                for (int e = 0; e < 4; ++e) el[e] = gs == 0 ? lg[q][4 + e] : gs == 1 ? lg[q][8 + e] : gs == 2 ? lg[q][12 + e] : lg[q][16 + e];
                int i1 = 0; float v1 = el[0];
#pragma unroll
                for (int e = 1; e < 4; ++e) if (el[e] > v1) { v1 = el[e]; i1 = e; }
                int i2 = 0; float v2 = -3.4e38f;
#pragma unroll
                for (int e = 0; e < 4; ++e) if (e != i1 && el[e] > v2) { v2 = el[e]; i2 = e; }
                const float e2 = __expf(v2 - v1);
                const float g1 = pg / (1.f + e2), g2v = pg * e2 / (1.f + e2);
                const int ea = gs * 4 + i1, eb = gs * 4 + i2;
                const int sl = (wid * 4 + q) * 2;
                e_ent[sl] = ea; r_ent[sl] = atomicAdd(&lcnt[ea], 1u); t_ent[sl] = t * 2; g_ent[sl] = g1;
                e_ent[sl + 1] = eb; r_ent[sl + 1] = atomicAdd(&lcnt[eb], 1u); t_ent[sl + 1] = t * 2 + 1; g_ent[sl + 1] = g2v;
            }
        }
        __syncthreads();
        if (tid < 16) lbase[tid] = lcnt[tid] ? atomicAdd(&cnt[tid * 64], lcnt[tid]) : 0u;
        __syncthreads();
        if (tid < 32) {
            const int e = e_ent[tid];
            const unsigned pos = (lbase[e] + r_ent[tid]) & 16383u;
            list[e * 16384 + pos] = t_ent[tid]; gl[e * 16384 + pos] = g_ent[tid];
        }
    }
}

constexpr int GBK = 64;
typedef __attribute__((address_space(3))) unsigned lds_u32;
struct TileP { const bf16_t* ar[4]; const bf16_t* br[4]; const bf16_t* ar2[4]; };
DI void gemm_core(const TileP& tp, int K, char* lds, f32x4 (&acc)[4][4], int ksplit, bool primed, const TileP& nx, bool have_nx) {
    const bf16_t* const (&ar)[4] = tp.ar; const bf16_t* const (&br)[4] = tp.br; const bf16_t* const (&ar2)[4] = tp.ar2;
    const int tid = tidx(), wid = tid >> 6, lane = tid & 63, wr = wid >> 1, wc = wid & 1, fr = lane & 15, fq = lane >> 4;
    const int scol = ((tid & 7) ^ ((tid >> 3) & 7)) * 8;
#pragma unroll
    for (int n = 0; n < 4; ++n)
#pragma unroll
        for (int m = 0; m < 4; ++m) acc[n][m] = (f32x4){0.f, 0.f, 0.f, 0.f};
    const int nk = K / GBK;
    if (!primed) {
        __syncthreads();
#pragma unroll
        for (int i = 0; i < 4; ++i) {
            __builtin_amdgcn_global_load_lds((const unsigned*)(ar[i] + scol), (lds_u32*)(lds + tid * 16 + i * 4096), 16, 0, 0);
            __builtin_amdgcn_global_load_lds((const unsigned*)(br[i] + scol), (lds_u32*)(lds + 16384 + tid * 16 + i * 4096), 16, 0, 0);
        }
    }
    const int sw = fr & 7;
    for (int kt = 0; kt < nk; ++kt) {
        asm volatile("s_waitcnt vmcnt(0)" ::: "memory");
        __builtin_amdgcn_s_barrier();
        if (kt + 1 < nk) {
            char* nb = lds + ((kt + 1) & 1) * 32768;
            const int ko = (kt + 1) * GBK + scol;
#pragma unroll
            for (int i = 0; i < 4; ++i) {
                __builtin_amdgcn_global_load_lds((const unsigned*)(((kt + 1) * GBK >= ksplit ? ar2[i] : ar[i]) + ko), (lds_u32*)(nb + tid * 16 + i * 4096), 16, 0, 0);
                __builtin_amdgcn_global_load_lds((const unsigned*)(br[i] + ko), (lds_u32*)(nb + 16384 + tid * 16 + i * 4096), 16, 0, 0);
            }
        } else if (have_nx) {
#pragma unroll
            for (int i = 0; i < 4; ++i) {
                __builtin_amdgcn_global_load_lds((const unsigned*)(nx.ar[i] + scol), (lds_u32*)(lds + tid * 16 + i * 4096), 16, 0, 0);
                __builtin_amdgcn_global_load_lds((const unsigned*)(nx.br[i] + scol), (lds_u32*)(lds + 16384 + tid * 16 + i * 4096), 16, 0, 0);
            }
        }
        const char* SA = lds + (kt & 1) * 32768; const char* SB = SA + 16384;
#pragma unroll
        for (int kh = 0; kh < 2; ++kh) {
            bf16x8 af[4], bfr[4];
            const int co = ((kh * 4 + fq) ^ sw) * 16;
#pragma unroll
            for (int m = 0; m < 4; ++m) af[m] = *(const bf16x8*)(SA + (wr * 64 + m * 16 + fr) * 128 + co);
#pragma unroll
            for (int n = 0; n < 4; ++n) bfr[n] = *(const bf16x8*)(SB + (wc * 64 + n * 16 + fr) * 128 + co);
#pragma unroll
            for (int n = 0; n < 4; ++n)
#pragma unroll
                for (int m = 0; m < 4; ++m) acc[n][m] = __builtin_amdgcn_mfma_f32_16x16x32_bf16(bfr[n], af[m], acc[n][m], 0, 0, 0);
        }
    }
}

enum { EPI_EVEN_IN = 0, EPI_ODD_IN, EPI_RESID };
template <int EPI>
DI void phase_gemm(const P& p, const bf16_t* A, int lda, const bf16_t* Bt, int K, int ntn, char* lds, bool dry = false, const bf16_t* A2 = nullptr, int lda2 = 0, int ksplit = 1 << 30) {
    const int tid = tidx(), wid = tid >> 6, lane = tid & 63, wr = wid >> 1, wc = wid & 1, fr = lane & 15, fq = lane >> 4;
    const int ntm = T / 128, ntiles = ntm * ntn;
    auto fill = [&](TileP& t, int tile) {
        const int tn = tile / ntm, tm = tile % ntm, r = tid >> 3;
#pragma unroll
        for (int i = 0; i < 4; ++i) { t.ar[i] = A + (size_t)(tm * 128 + r + 32 * i) * lda; t.br[i] = Bt + (size_t)(tn * 128 + r + 32 * i) * K; t.ar2[i] = A2 ? A2 + (size_t)(tm * 128 + r + 32 * i) * lda2 : t.ar[i]; }
    };
    TileP cur, nxt;
    bool primed = false;
    fill(cur, bidx() < ntiles ? bidx() : 0); nxt = cur;
    for (int tile = bidx(); tile < ntiles; tile += gridDim.x) {
        const int tn = tile / ntm, tm = tile % ntm;
        const bool have_next = tile + (int)gridDim.x < ntiles;
        if (have_next) fill(nxt, tile + gridDim.x);
        f32x4 acc[4][4];
        gemm_core(cur, K, lds, acc, ksplit, primed, nxt, have_next);
        primed = have_next; cur = nxt;
        const int m0 = tm * 128 + wr * 64, n0 = tn * 128 + wc * 64;
        if (EPI == EPI_EVEN_IN) {
            bf16_t* C = (bf16_t*)(p.ws + WS_PROJ);
#pragma unroll
            for (int m = 0; m < 4; ++m)
#pragma unroll
                for (int n = 0; n < 4; ++n) {
                    const int row = m0 + m * 16 + fr, col = n0 + n * 16 + fq * 4;
                    if (col < EVC) { u32x2 w; w.x = pack2(acc[n][m][0], acc[n][m][1]); w.y = pack2(acc[n][m][2], acc[n][m][3]); *(u32x2*)(C + (size_t)row * EVLD + col) = w; }
                }
        } else if (EPI == EPI_ODD_IN) {
            bf16_t* C = (bf16_t*)(p.ws + WS_QK);
            const float2* tab = (const float2*)(p.ws + WS_ROPE);
            if (n0 < 3072) {
#pragma unroll
                for (int m = 0; m < 4; ++m) {
                    const int row = m0 + m * 16 + fr;
#pragma unroll
                    for (int n = 0; n < 2; ++n) {
                        float lo[4], hi[4];
#pragma unroll
                        for (int j = 0; j < 4; ++j) {
                            const float2 cs = tab[(size_t)row * 32 + n * 16 + fq * 4 + j];
                            const float x1 = acc[n][m][j], x2 = acc[n + 2][m][j];
                            lo[j] = x1 * cs.x - x2 * cs.y; hi[j] = x2 * cs.x + x1 * cs.y;
                        }
                        u32x2 w; w.x = pack2(lo[0], lo[1]); w.y = pack2(lo[2], lo[3]);
                        *(u32x2*)(C + (size_t)row * 3072 + n0 + n * 16 + fq * 4) = w;
                        w.x = pack2(hi[0], hi[1]); w.y = pack2(hi[2], hi[3]);
                        *(u32x2*)(C + (size_t)row * 3072 + n0 + (n + 2) * 16 + fq * 4) = w;
                    }
                }
            }
            if (tn * 128 >= 3072) {
                bf16_t* VT = (bf16_t*)(p.ws + WS_VT);
                const int hg0 = (tn * 128 - 3072) >> 6, g = hg0 >> 3, lg2 = g * 2, dil = 1 << lg2, L = SEQ >> lg2, run = 128 >> lg2;
                __syncthreads();
#pragma unroll
                for (int m = 0; m < 4; ++m)
#pragma unroll
                    for (int n = 0; n < 4; ++n)
#pragma unroll
                        for (int j = 0; j < 4; ++j)
                            *(bf16_t*)(lds + 32768 + (wc * 64 + n * 16 + fq * 4 + j) * 272 + (wr * 64 + m * 16 + fr) * 2) = f2bf(acc[n][m][j]);
                __syncthreads();
                const int bb = (tm * 128) >> 12, s0 = (tm * 128) & (SEQ - 1);
#pragma unroll
                for (int q = 0; q < 8; ++q) {
                    const int item = tid + q * 256, dim = item >> 4, o0 = (item & 15) * 8;
                    const int rr = o0 / run, i0 = o0 % run;
                    const char* src = lds + 32768 + dim * 272 + (rr + dil * i0) * 2;
                    float e8[8];
#pragma unroll
                    for (int e = 0; e < 8; ++e) e8[e] = bf2f(*(const bf16_t*)(src + e * dil * 2));
                    u32x4 w; w.x = pack2(e8[0], e8[1]); w.y = pack2(e8[2], e8[3]); w.z = pack2(e8[4], e8[5]); w.w = pack2(e8[6], e8[7]);
                    const int hg = hg0 + (dim >> 6);
                    *(u32x4*)(VT + ((size_t)((bb * 24 + hg) * dil + rr) * 64 + (dim & 63)) * L + (s0 >> lg2) + i0) = w;
                }
            }
        } else {
#pragma unroll
            for (int m = 0; m < 4; ++m)
#pragma unroll
                for (int n = 0; n < 4; ++n) {
                    const size_t qo = (size_t)(m0 + m * 16 + fr) * 1024 + n0 + n * 16 + fq * 4;
                    float* q = dry ? (float*)(p.ws + WS_DUMMY) + (qo & 0x7FFFF) : p.out + qo;
                    float4 v = *(float4*)q;
                    v.x += acc[n][m][0]; v.y += acc[n][m][1]; v.z += acc[n][m][2]; v.w += acc[n][m][3];
                    *(float4*)q = v;
                }
        }
    }
}

DI void phase_moe_up(const P& p, int layer, char* lds) {
    const int tid = tidx(), wid = tid >> 6, lane = tid & 63, wr = wid >> 1, wc = wid & 1, fr = lane & 15, fq = lane >> 4;
    const unsigned* cntb = (const unsigned*)(p.ws + WS_CTL + CTL_CNT) + layer * 16 * 64;
    unsigned cnt[16];
#pragma unroll
    for (int e = 0; e < 16; ++e) cnt[e] = cntb[e * 64];
    const int* list = (const int*)(p.ws + WS_LIST);
    const float* gl = (const float*)(p.ws + WS_GATE);
    const bf16_t* hn = (const bf16_t*)(p.ws + WS_HN);
    const bf16_t* W13 = (const bf16_t*)(p.ws + WS_W + W_13);
    bf16_t* H = (bf16_t*)(p.ws + WS_H);
    int ttot = 0;
#pragma unroll
    for (int e = 0; e < 16; ++e) ttot += ((int)cnt[e] + 127) >> 7;
    const int ntiles = ttot * 4;
    auto locate = [&](int tile, int& e, int& lt, int& ce, int& rbe, int& tn) {
        const int mt = tile >> 2; tn = tile & 3;
        int tbe = 0, acc_t = 0; e = 0;
#pragma unroll
        for (int q = 0; q < 16; ++q) { const int nt = ((int)cnt[q] + 127) >> 7; if (mt >= acc_t) { e = q; tbe = acc_t; } acc_t += nt; }
        lt = mt - tbe; ce = (int)cnt[e]; rbe = tbe * 128;
    };
    auto fill = [&](TileP& t, int tile) {
        int e, lt, ce, rbe, tn; locate(tile, e, lt, ce, rbe, tn);
        const int r = tid >> 3;
#pragma unroll
        for (int i = 0; i < 4; ++i) {
            const int ii = lt * 128 + r + 32 * i;
            const int tk = ii < ce ? (list[e * 16384 + ii] >> 1) : 0;
            t.ar[i] = hn + (size_t)tk * 1024; t.ar2[i] = t.ar[i];
            t.br[i] = W13 + ((size_t)e * 512 + tn * 128 + r + 32 * i) * 1024;
        }
    };
    TileP cur, nxt;
    bool primed = false;
    fill(cur, bidx() < ntiles ? bidx() : 0); nxt = cur;
    for (int tile = bidx(); tile < ntiles; tile += gridDim.x) {
        int e, lt, ce, rbe, tn; locate(tile, e, lt, ce, rbe, tn);
        const bool have_next = tile + (int)gridDim.x < ntiles;
        if (have_next) fill(nxt, tile + gridDim.x);
        f32x4 acc[4][4];
        gemm_core(cur, 1024, lds, acc, 1 << 30, primed, nxt, have_next);
        primed = have_next; cur = nxt;
#pragma unroll
        for (int m = 0; m < 4; ++m) {
            const int li = lt * 128 + wr * 64 + m * 16 + fr;
            if (li < ce) {
                const float g = gl[e * 16384 + li];
                bf16_t* hrow = H + (size_t)(rbe + li) * 256;
#pragma unroll
                for (int n = 0; n < 4; n += 2) {
                    float o[4];
#pragma unroll
                    for (int j = 0; j < 4; ++j) o[j] = siluf_(acc[n][m][j]) * acc[n + 1][m][j] * g;
                    const int f = tn * 64 + wc * 32 + (n >> 1) * 16 + fq * 4;
                    u32x2 w; w.x = pack2(o[0], o[1]); w.y = pack2(o[2], o[3]);
                    *(u32x2*)(hrow + f) = w;
                }
            }
        }
    }
}
DI void phase_moe_down(const P& p, int layer, char* lds) {
    const int tid = tidx(), wid = tid >> 6, lane = tid & 63, wr = wid >> 1, wc = wid & 1, fr = lane & 15, fq = lane >> 4;
    const unsigned* cntb = (const unsigned*)(p.ws + WS_CTL + CTL_CNT) + layer * 16 * 64;
    unsigned cnt[16];
#pragma unroll
    for (int e = 0; e < 16; ++e) cnt[e] = cntb[e * 64];
    const int* list = (const int*)(p.ws + WS_LIST);
    const bf16_t* W2 = (const bf16_t*)(p.ws + WS_W + W_2);
    const bf16_t* H = (const bf16_t*)(p.ws + WS_H);
    bf16_t* ys = (bf16_t*)(p.ws + WS_YS);
    int ttot = 0;
#pragma unroll
    for (int e = 0; e < 16; ++e) ttot += ((int)cnt[e] + 127) >> 7;
    const int ntiles = ttot * 8;
    auto locate = [&](int tile, int& e, int& lt, int& ce, int& rbe, int& tn) {
        const int mt = tile >> 3; tn = tile & 7;
        int tbe = 0, acc_t = 0; e = 0;
#pragma unroll
        for (int q = 0; q < 16; ++q) { const int nt = ((int)cnt[q] + 127) >> 7; if (mt >= acc_t) { e = q; tbe = acc_t; } acc_t += nt; }
        lt = mt - tbe; ce = (int)cnt[e]; rbe = tbe * 128;
    };
    auto fill = [&](TileP& t, int tile) {
        int e, lt, ce, rbe, tn; locate(tile, e, lt, ce, rbe, tn);
        const int r = tid >> 3;
#pragma unroll
        for (int i = 0; i < 4; ++i) { t.ar[i] = H + (size_t)(rbe + lt * 128 + r + 32 * i) * 256; t.ar2[i] = t.ar[i]; t.br[i] = W2 + ((size_t)e * 1024 + tn * 128 + r + 32 * i) * 256; }
    };
    TileP cur, nxt;
    bool primed = false;
    fill(cur, bidx() < ntiles ? bidx() : 0); nxt = cur;
    for (int tile = bidx(); tile < ntiles; tile += gridDim.x) {
        int e, lt, ce, rbe, tn; locate(tile, e, lt, ce, rbe, tn);
        const bool have_next = tile + (int)gridDim.x < ntiles;
        if (have_next) fill(nxt, tile + gridDim.x);
        f32x4 acc[4][4];
        gemm_core(cur, 256, lds, acc, 1 << 30, primed, nxt, have_next);
        primed = have_next; cur = nxt;
#pragma unroll
        for (int m = 0; m < 4; ++m) {
            const int li = lt * 128 + wr * 64 + m * 16 + fr;
            if (li < ce) {
                const int ts = list[e * 16384 + li];
                bf16_t* yrow = ys + ((size_t)(ts & 1) * T + (ts >> 1)) * 1024 + tn * 128 + wc * 64 + fq * 4;
#pragma unroll
                for (int n = 0; n < 4; ++n) { u32x2 w; w.x = pack2(acc[n][m][0], acc[n][m][1]); w.y = pack2(acc[n][m][2], acc[n][m][3]); *(u32x2*)(yrow + n * 16) = w; }
            }
        }
    }
}


typedef float f32x16 __attribute__((ext_vector_type(16)));
DI f32x4 mfma16(bf16x8 a, bf16x8 b, f32x4 c) { return __builtin_amdgcn_mfma_f32_16x16x32_bf16(a, b, c, 0, 0, 0); }
DI f32x16 mfma32(bf16x8 a, bf16x8 b, f32x16 c) { return __builtin_amdgcn_mfma_f32_32x32x16_bf16(a, b, c, 0, 0, 0); }
DI f32x4 tile16(const char* X, int ldx, int row0, const char* Y, int ldy, int col0, int K) {
    const int lane = tidx() & 63, fr = lane & 15, fq = lane >> 4;
    f32x4 acc = {0.f, 0.f, 0.f, 0.f};
#pragma unroll
    for (int k = 0; k < K; k += 32) {
        const bf16x8 a = *(const bf16x8*)(X + (row0 + fr) * ldx + (k + fq * 8) * 2);
        const bf16x8 b = *(const bf16x8*)(Y + (col0 + fr) * ldy + (k + fq * 8) * 2);
        acc = mfma16(a, b, acc);
    }
    return acc;
}
DI bf16x8 pack_step(const f32x16& x, int s) {
    u32x4 r;
    r.x = pack2(x[8 * s + 0], x[8 * s + 1]); r.y = pack2(x[8 * s + 2], x[8 * s + 3]);
    r.z = pack2(x[8 * s + 4], x[8 * s + 5]); r.w = pack2(x[8 * s + 6], x[8 * s + 7]);
    return __builtin_bit_cast(bf16x8, r);
}

constexpr int GP_LF = 0, GP_T = 17408, GP_VEC = GP_T + 9216, GP_U = GP_VEC + 1024, GP_END = GP_U + 36864;
DI void gdn_prep_unit(const P& p, int li, int ch, char* lds) {
    const int tid = tidx(), lane = tid & 63, wid = tid >> 6, fr = lane & 15, fq = lane >> 4;
    const int h = ch & 3, n = (ch >> 2) & 63, b = ch >> 8;
    const int t0 = b * SEQ + n * 64;
    float* Lf = (float*)(lds + GP_LF);
    char* Trow = lds + GP_T;
    float* gcs = (float*)(lds + GP_VEC); float* egc = gcs + 64; float* bet = gcs + 128; float* ekd = gcs + 192;
    char* Qrow = lds + GP_U; char* Krow = Qrow + 17408; char* VbT = lds + GP_U; char* KbgT = VbT + 18432;
    const bf16_t* proj = (const bf16_t*)(p.ws + WS_PROJ);
    unsigned char* ops = p.ws + WS_GOPS + (size_t)ch * GOPS_CH;
    const float* cw = p.in[I_CONVW] + (size_t)li * 4 * 1536;
    const int c = tid >> 2, cq = tid & 3;
    __syncthreads();
    float* cwl = (float*)(lds + GP_END);
    for (int i = tid; i < 4 * 3 * 32; i += 256) {
        const int j = i / 96, r = i % 96, sl = r >> 5, q4 = (r & 31) * 4;
        *(f32x4*)(cwl + (j * 3 + sl) * 128 + q4) = *(const f32x4*)(cw + j * 1536 + sl * 512 + h * 128 + q4);
    }
    __syncthreads();
    unsigned vvp[16];
#pragma unroll 1
    for (int which = 0; which < 3; ++which) {
        const int col0 = which * 512 + h * 128 + cq * 32;
        u32x4 xin[4][4];
#pragma unroll
        for (int j = 0; j < 4; ++j) {
            const int sp = n * 64 + c - 3 + j;
            const bf16_t* src = proj + (size_t)(b * SEQ + (sp < 0 ? 0 : sp)) * EVLD + col0;
#pragma unroll
            for (int i4 = 0; i4 < 4; ++i4) xin[j][i4] = *(const u32x4*)(src + i4 * 8);
        }
        float acc[32];
#pragma unroll
        for (int i = 0; i < 32; ++i) acc[i] = 0.f;
#pragma unroll
        for (int j = 0; j < 4; ++j) {
            const float ok = (n * 64 + c - 3 + j) >= 0 ? 1.f : 0.f;
            const float* wj = cwl + (j * 3 + which) * 128 + cq * 32;
#pragma unroll
            for (int i4 = 0; i4 < 4; ++i4) {
                const f32x4 wa = *(const f32x4*)(wj + i4 * 8), wb = *(const f32x4*)(wj + i4 * 8 + 4);
                const u32x4 w = xin[j][i4];
                acc[i4 * 8 + 0] += ok * wa[0] * __uint_as_float(w[0] << 16); acc[i4 * 8 + 1] += ok * wa[1] * __uint_as_float(w[0] & 0xffff0000u);
                acc[i4 * 8 + 2] += ok * wa[2] * __uint_as_float(w[1] << 16); acc[i4 * 8 + 3] += ok * wa[3] * __uint_as_float(w[1] & 0xffff0000u);
                acc[i4 * 8 + 4] += ok * wb[0] * __uint_as_float(w[2] << 16); acc[i4 * 8 + 5] += ok * wb[1] * __uint_as_float(w[2] & 0xffff0000u);
                acc[i4 * 8 + 6] += ok * wb[2] * __uint_as_float(w[3] << 16); acc[i4 * 8 + 7] += ok * wb[3] * __uint_as_float(w[3] & 0xffff0000u);
            }
        }
        float ss = 0.f;
#pragma unroll
        for (int i = 0; i < 32; ++i) { acc[i] = siluf_(acc[i]); ss += acc[i] * acc[i]; }
        ss += __shfl_xor(ss, 1); ss += __shfl_xor(ss, 2);
        const float rn = which == 2 ? 1.f : rsqrtf(ss + 1e-6f) * (which == 0 ? 0.08838834764831845f : 1.f);
        unsigned pk[16];
#pragma unroll
        for (int i = 0; i < 16; ++i) pk[i] = pack2(acc[2 * i] * rn, acc[2 * i + 1] * rn);
        if (which < 2) {
            char* img = which == 0 ? Qrow : Krow;
#pragma unroll
            for (int i4 = 0; i4 < 4; ++i4) { u32x4 w; w.x = pk[i4 * 4]; w.y = pk[i4 * 4 + 1]; w.z = pk[i4 * 4 + 2]; w.w = pk[i4 * 4 + 3]; *(u32x4*)(img + c * 272 + (cq * 32 + i4 * 8) * 2) = w; }
        } else {
#pragma unroll
            for (int i = 0; i < 16; ++i) vvp[i] = pk[i];
        }
    }
    if (cq == 0) {
        const float a = bf2f(proj[(size_t)(t0 + c) * EVLD + 2048 + h]);
        const float bb = bf2f(proj[(size_t)(t0 + c) * EVLD + 2052 + h]);
        const float Aexp = __expf(p.in[I_ALOG][li * 4 + h]), dtb = p.in[I_DTB][li * 4 + h];
        gcs[c] = -Aexp * softplusf_(a + dtb);
        bet[c] = sigmoidf_(bb);
    }
    __syncthreads();
    if (wid == 0) {
        float x = gcs[lane];
#pragma unroll
        for (int o = 1; o < 64; o <<= 1) { const float y = __shfl_up(x, o); if (lane >= o) x += y; }
        const float gl = __shfl(x, 63);
        gcs[lane] = x; egc[lane] = __expf(x); ekd[lane] = __expf(gl - x);
        if (lane == 63) ((float*)(p.ws + WS_CTL + CTL_EGL))[ch] = __expf(gl);
    }
    __syncthreads();
    {
        const int ti = wid;
#pragma unroll
        for (int tj = 0; tj < 4; ++tj) {
            if (tj <= ti) {
                const f32x4 kk = tile16(Krow, 272, 16 * ti, Krow, 272, 16 * tj, 128);
                const int c2 = 16 * tj + fr;
                f32x4 lv;
#pragma unroll
                for (int r = 0; r < 4; ++r) {
                    const int c1 = 16 * ti + fq * 4 + r;
                    lv[r] = (c1 > c2) ? bet[c1] * kk[r] * __expf(gcs[c1] - gcs[c2]) : 0.f;
                }
                *(f32x4*)&Lf[c2 * 68 + 16 * ti + fq * 4] = lv;
            }
            f32x4 qk = {0.f, 0.f, 0.f, 0.f};
            if (tj <= ti) qk = tile16(Krow, 272, 16 * tj, Qrow, 272, 16 * ti, 128);
            const int c1 = 16 * ti + fr;
            float o4[4];
#pragma unroll
            for (int r = 0; r < 4; ++r) { const int c2 = 16 * tj + fq * 4 + r; o4[r] = (c1 >= c2) ? qk[r] * __expf(gcs[c1] - gcs[c2]) : 0.f; }
            const int mt = c1 >> 5, rr = c1 & 31, hh = fq & 1, jg = fq >> 1;
            u32x2 w; w.x = pack2(o4[0], o4[1]); w.y = pack2(o4[2], o4[3]);
            *(u32x2*)(ops + GO_AF + ((size_t)((mt * 4 + tj) * 64 + hh * 32 + rr) * 8 + jg * 4) * 2) = w;
        }
#pragma unroll
        for (int i = 0; i < 4; ++i) {
            const int idx = tid + i * 256;
            {
                const int mt = idx >> 9, ks = (idx >> 6) & 7, l2 = idx & 63, rr = l2 & 31, hh = l2 >> 5, cc = 32 * mt + rr;
                const float sc = egc[cc];
                const u32x2 lo = *(const u32x2*)(Qrow + cc * 272 + (16 * ks + 4 * hh) * 2), hi = *(const u32x2*)(Qrow + cc * 272 + (16 * ks + 8 + 4 * hh) * 2);
                u32x4 w;
                w.x = pack2(__uint_as_float(lo.x << 16) * sc, __uint_as_float(lo.x & 0xffff0000u) * sc); w.y = pack2(__uint_as_float(lo.y << 16) * sc, __uint_as_float(lo.y & 0xffff0000u) * sc);
                w.z = pack2(__uint_as_float(hi.x << 16) * sc, __uint_as_float(hi.x & 0xffff0000u) * sc); w.w = pack2(__uint_as_float(hi.y << 16) * sc, __uint_as_float(hi.y & 0xffff0000u) * sc);
                *(u32x4*)(ops + GO_QF + (size_t)idx * 16) = w;
            }
            {
                const int mt = idx >> 8, ks = (idx >> 6) & 3, l2 = idx & 63, rr = l2 & 31, hh = l2 >> 5, dk = 32 * mt + rr;
                float e8[8];
#pragma unroll
                for (int j = 0; j < 8; ++j) { const int c2 = 16 * ks + 8 * (j >> 2) + 4 * hh + (j & 3); e8[j] = bf2f(*(const bf16_t*)(Krow + c2 * 272 + dk * 2)) * ekd[c2]; }
                u32x4 w; w.x = pack2(e8[0], e8[1]); w.y = pack2(e8[2], e8[3]); w.z = pack2(e8[4], e8[5]); w.w = pack2(e8[6], e8[7]);
                *(u32x4*)(ops + GO_KF + (size_t)idx * 16) = w;
            }
        }
    }
    __syncthreads();
    {
        const float bc = bet[c], bg = bc * egc[c];
        unsigned kvp[16];
#pragma unroll
        for (int i4 = 0; i4 < 4; ++i4) { const u32x4 w = *(const u32x4*)(Krow + c * 272 + (cq * 32 + i4 * 8) * 2); kvp[i4 * 4] = w.x; kvp[i4 * 4 + 1] = w.y; kvp[i4 * 4 + 2] = w.z; kvp[i4 * 4 + 3] = w.w; }
        __syncthreads();
#pragma unroll
        for (int i = 0; i < 16; ++i) {
            *(bf16_t*)(VbT + (cq * 32 + 2 * i) * 144 + c * 2) = f2bf(__uint_as_float(vvp[i] << 16) * bc);
            *(bf16_t*)(VbT + (cq * 32 + 2 * i + 1) * 144 + c * 2) = f2bf(__uint_as_float(vvp[i] & 0xffff0000u) * bc);
            *(bf16_t*)(KbgT + (cq * 32 + 2 * i) * 144 + c * 2) = f2bf(__uint_as_float(kvp[i] << 16) * bg);
            *(bf16_t*)(KbgT + (cq * 32 + 2 * i + 1) * 144 + c * 2) = f2bf(__uint_as_float(kvp[i] & 0xffff0000u) * bg);
        }
    }
    if (wid == 0) {
        float Tc[64];
#pragma unroll
        for (int i = 0; i < 64; ++i) Tc[i] = (i == lane) ? 1.f : 0.f;
#pragma unroll
        for (int j = 0; j < 63; ++j) {
            const float tj = Tc[j];
#pragma unroll
            for (int i4 = (j + 1) >> 2; i4 < 16; ++i4) {
                const f32x4 l4 = *(const f32x4*)&Lf[j * 68 + i4 * 4];
#pragma unroll
                for (int e = 0; e < 4; ++e) if (i4 * 4 + e > j) Tc[i4 * 4 + e] -= l4[e] * tj;
            }
        }
#pragma unroll
        for (int i = 0; i < 64; ++i) *(bf16_t*)(Trow + i * 144 + lane * 2) = f2bf(Tc[i]);
    }
    __syncthreads();
#pragma unroll
    for (int tq = 0; tq < 2; ++tq) {
        const int tj = wid * 2 + tq;
#pragma unroll
        for (int ti = 0; ti < 4; ++ti) {
            const f32x4 u = tile16(Trow, 144, 16 * ti, VbT, 144, 16 * tj, 64);
            {
                const int dv = 16 * tj + fr, slice = dv >> 5, rr = dv & 31, cb = 16 * ti + fq * 4, mt = cb >> 5, q4 = (cb & 31) >> 2, hh = q4 & 1, rg = q4 >> 1;
                u32x2 w; w.x = pack2(u[0], u[1]); w.y = pack2(u[2], u[3]);
                *(u32x2*)(ops + GO_UF + ((size_t)((slice * 2 + mt) * 64 + hh * 32 + rr) * 16 + rg * 4) * 2) = w;
            }
            const f32x4 wv = tile16(KbgT, 144, 16 * tj, Trow, 144, 16 * ti, 64);
            {
                const int c1 = 16 * ti + fr, mt = c1 >> 5, rr = c1 & 31, hh = fq & 1, jg = fq >> 1;
                u32x2 w; w.x = pack2(wv[0], wv[1]); w.y = pack2(wv[2], wv[3]);
                *(u32x2*)(ops + GO_WF + ((size_t)((mt * 8 + tj) * 64 + hh * 32 + rr) * 8 + jg * 4) * 2) = w;
            }
        }
    }
}

DI void glds16(const void* g, char* l) { __builtin_amdgcn_global_load_lds((const unsigned*)g, (lds_u32*)l, 16, 0, 0); }
#define GS_WAIT(n) asm volatile("s_waitcnt vmcnt(" #n ")" ::: "memory")
DI void gdn_scan_block(const P& p, int bh, char* lds, bool dry = false) {
    const int tid = tidx(), lane = tid & 63, w = tid >> 6;
    const int h = bh & 3, b = bh >> 2;
    const float eglv = ((const float*)(p.ws + WS_CTL + CTL_EGL))[(b * 64 + lane) * 4 + h];
    unsigned char* gbase = p.ws + WS_GOPS + (size_t)(b * 256 + h) * GOPS_CH;
    constexpr int NST = 64 * 9;
    f32x16 S[4];
#pragma unroll
    for (int i = 0; i < 4; ++i)
#pragma unroll
        for (int r = 0; r < 16; ++r) S[i][r] = 0.f;
    __syncthreads();
#pragma unroll
    for (int j = 0; j < 8; ++j) { const unsigned char* src = gbase + j * 8192 + tid * 16; char* dst = lds + j * 8192 + tid * 16; glds16(src, dst); glds16(src + 4096, dst + 4096); }
#pragma unroll 1
    for (int n = 0; n < 64; ++n) {
        const float egl = __shfl(eglv, n);
        bf16x8 Sb[8];
#pragma unroll
        for (int i = 0; i < 4; ++i) { Sb[i * 2] = pack_step(S[i], 0); Sb[i * 2 + 1] = pack_step(S[i], 1); }
        f32x16 av[2], ao[2];
        bf16x8 Vb[4];
#pragma unroll
        for (int k = 0; k < 9; ++k) {
            const int j = n * 9 + k;
            if (n < 63 || k <= 1) GS_WAIT(14); else if (k == 2) GS_WAIT(12); else if (k == 3) GS_WAIT(10); else if (k == 4) GS_WAIT(8); else if (k == 5) GS_WAIT(6);
            else if (k == 6) GS_WAIT(4); else if (k == 7) GS_WAIT(2); else GS_WAIT(0);
            __builtin_amdgcn_s_barrier();
            if (j + 8 < NST) {
                const int k8 = (k + 8) % 9, n8 = (k == 0) ? n : n + 1;
                const unsigned char* src = gbase + (size_t)n8 * 4 * GOPS_CH + k8 * 8192 + tid * 16;
                char* dst = lds + k8 * 8192 + tid * 16;
                glds16(src, dst); glds16(src + 4096, dst + 4096);
            }
            __builtin_amdgcn_sched_barrier(0);
            const char* sl = lds + k * 8192;
            const bf16x8* fr = (const bf16x8*)sl + lane;
            if (k < 2) {
#pragma unroll
                for (int r = 0; r < 16; ++r) av[k][r] = 0.f;
                bf16x8 f8[8];
#pragma unroll
                for (int ks = 0; ks < 8; ++ks) f8[ks] = fr[ks * 64];
                __builtin_amdgcn_sched_barrier(0);
#pragma unroll
                for (int ks = 0; ks < 8; ++ks) av[k] = mfma32(f8[ks], Sb[ks], av[k]);
            } else if (k < 4) {
#pragma unroll
                for (int r = 0; r < 16; ++r) ao[k - 2][r] = 0.f;
                bf16x8 f8[8];
#pragma unroll
                for (int ks = 0; ks < 8; ++ks) f8[ks] = fr[ks * 64];
                __builtin_amdgcn_sched_barrier(0);
#pragma unroll
                for (int ks = 0; ks < 8; ++ks) ao[k - 2] = mfma32(f8[ks], Sb[ks], ao[k - 2]);
            } else if (k < 6) {
                if ((w >> 1) == (k - 4)) {
#pragma unroll
                    for (int mt = 0; mt < 2; ++mt) {
                        const u32x4* up = (const u32x4*)(sl + ((w & 1) * 2 + mt) * 2048 + lane * 32);
                        const u32x4 u0 = up[0], u1 = up[1];
#pragma unroll
                        for (int e = 0; e < 4; ++e) {
                            av[mt][e * 2] = __uint_as_float(u0[e] << 16) - av[mt][e * 2]; av[mt][e * 2 + 1] = __uint_as_float(u0[e] & 0xffff0000u) - av[mt][e * 2 + 1];
                            av[mt][8 + e * 2] = __uint_as_float(u1[e] << 16) - av[mt][8 + e * 2]; av[mt][8 + e * 2 + 1] = __uint_as_float(u1[e] & 0xffff0000u) - av[mt][8 + e * 2 + 1];
                        }
                    }
                }
            } else if (k == 6) {
#pragma unroll
                for (int mt = 0; mt < 2; ++mt) { Vb[mt * 2] = pack_step(av[mt], 0); Vb[mt * 2 + 1] = pack_step(av[mt], 1); }
                bf16x8 f6[6];
#pragma unroll
                for (int ks = 0; ks < 2; ++ks) f6[ks] = fr[ks * 64];
#pragma unroll
                for (int ks = 0; ks < 4; ++ks) f6[2 + ks] = fr[(4 + ks) * 64];
                __builtin_amdgcn_sched_barrier(0);
#pragma unroll
                for (int ks = 0; ks < 4; ++ks) { if (ks < 2) ao[0] = mfma32(f6[ks], Vb[ks], ao[0]); ao[1] = mfma32(f6[2 + ks], Vb[ks], ao[1]); }
            } else {
                bf16x8 f8[8];
#pragma unroll
                for (int q = 0; q < 8; ++q) f8[q] = fr[q * 64];
#pragma unroll
                for (int i2 = 0; i2 < 2; ++i2) {
                    const int i = (k - 7) * 2 + i2;
#pragma unroll
                    for (int r = 0; r < 16; ++r) S[i][r] *= egl;
                }
                __builtin_amdgcn_sched_barrier(0);
#pragma unroll
                for (int ks = 0; ks < 4; ++ks)
#pragma unroll
                    for (int i2 = 0; i2 < 2; ++i2) S[(k - 7) * 2 + i2] = mfma32(f8[i2 * 4 + ks], Vb[ks], S[(k - 7) * 2 + i2]);
                if (k == 8) {
                    u32x4* Of = (u32x4*)((dry ? p.ws + WS_DUMMY + (size_t)(bh & 15) * 65536 : gbase + (size_t)n * 4 * GOPS_CH) + GO_UF) + (size_t)(w * 2 * 64 + lane) * 2;
#pragma unroll
                    for (int mt = 0; mt < 2; ++mt) {
                        u32x4 o0, o1;
#pragma unroll
                        for (int e = 0; e < 4; ++e) { o0[e] = pack2(ao[mt][e * 2], ao[mt][e * 2 + 1]); o1[e] = pack2(ao[mt][8 + e * 2], ao[mt][8 + e * 2 + 1]); }
                        Of[mt * 128] = o0; Of[mt * 128 + 1] = o1;
                    }
                }
            }
        }
    }
    __syncthreads();
}

DI void gdn_post_unit(const P& p, int li, int ch) {
    const int tid = tidx();
    const int h = ch & 3, n = (ch >> 2) & 63, b = ch >> 8;
    const int t0 = b * SEQ + n * 64;
    const int c = tid >> 2, cq = tid & 3;
    const bf16_t* Of = (const bf16_t*)(p.ws + WS_GOPS + (size_t)ch * GOPS_CH + GO_UF);
    const bf16_t* proj = (const bf16_t*)(p.ws + WS_PROJ);
    bf16_t* mix = (bf16_t*)(p.ws + WS_PROJ);
    const float* nw = p.in[I_GDNNORM] + li * 128 + cq * 32;
    const int mt = c >> 5, q4 = (c & 31) >> 2, hh = q4 & 1, rg = q4 >> 1, reg = rg * 4 + (c & 3);
    float o[32]; float ss = 0.f;
#pragma unroll
    for (int r = 0; r < 32; ++r) { o[r] = bf2f(Of[(size_t)((cq * 2 + mt) * 64 + hh * 32 + r) * 16 + reg]); ss += o[r] * o[r]; }
    ss += __shfl_xor(ss, 1); ss += __shfl_xor(ss, 2);
    const float rs = rsqrtf(ss * (1.f / 128.f) + 1e-6f);
    const bf16_t* zp = proj + (size_t)(t0 + c) * EVLD + 1536 + h * 128 + cq * 32;
    bf16_t* mp = mix + (size_t)(t0 + c) * EVLD + h * 128 + cq * 32;
#pragma unroll
    for (int i4 = 0; i4 < 4; ++i4) {
        const u32x4 zw = *(const u32x4*)(zp + i4 * 8);
        u32x4 w;
#pragma unroll
        for (int e = 0; e < 4; ++e) {
            const float z0 = __uint_as_float(zw[e] << 16), z1 = __uint_as_float(zw[e] & 0xffff0000u);
            w[e] = pack2(o[i4 * 8 + e * 2] * rs * nw[i4 * 8 + e * 2] * siluf_(z0), o[i4 * 8 + e * 2 + 1] * rs * nw[i4 * 8 + e * 2 + 1] * siluf_(z1));
        }
        *(u32x4*)(mp + i4 * 8) = w;
    }
}


constexpr int RP_Z0 = 0, RP_Z1 = 18432, RP_Z2 = 55296, RP_VEC = 73728, RP_PT = 75008, RP_END = 78080;
constexpr int RP_LIN = 0, RP_LW = 25600;
DI void rwkv_prep_unit(const P& p, int li, int ch, char* lds) {
    const int tid = tidx(), lane = tid & 63, wid = tid >> 6, fr = lane & 15, fq = lane >> 4;
    const int h = ch & 7, n = (ch >> 3) & 63, b = ch >> 9;
    const int t0 = b * SEQ + n * 64;
    const bf16_t* proj = (const bf16_t*)(p.ws + WS_PROJ);
    char* Lfc = lds + RP_Z0; float* Lf = (float*)Lfc;
    char* ApT = lds + RP_Z0; char* AkVT = lds + RP_Z0 + 9216;
    char* Arow = lds + RP_Z1; char* Rrow = Arow + 9216; char* Brow = Arow + 18432; char* Krow = Arow + 27648;
    char* Aak = Arow; char* Arb = Rrow; char* Ark = Brow; char* Trow = Krow; char* BhT = Krow; char* VpT = Aak;
    char* AT = lds + RP_Z2; char* VT = AT + 9216; char* KhT = AT;
    float* tot = (float*)(lds + RP_VEC); float* WC = tot + 256;
    char* lin = lds + RP_LIN; char* LWi = lds + RP_LW;
    float* PT = (float*)(lds + RP_PT);
    {
        const float* mu0 = p.in[I_MU] + (size_t)li * 1696;
        if (tid < 48) {
            const int j0 = tid * 4;
            *(float4*)(PT + j0) = j0 < 160 ? *(const float4*)(mu0 + (C_HW - RW0) + j0) : *(const float4*)(p.in[I_VRESMU] + j0 - 160);
        } else if (tid < 48 + 144) {
            const int q = tid - 48, arr = q >> 4, c4 = (q & 15) * 4, chn = h * 64 + c4;
            const float* src = arr == 0 ? mu0 + (C_R - RW0) + chn : arr == 1 ? mu0 + (C_K - RW0) + chn : arr == 2 ? mu0 + (C_V - RW0) + chn
                             : arr == 3 ? p.in[I_W0] + li * 512 + chn : arr == 4 ? p.in[I_A0] + li * 512 + chn : arr == 5 ? p.in[I_V0] + chn
                             : arr == 6 ? p.in[I_KK] + li * 512 + chn : arr == 7 ? p.in[I_KA] + li * 512 + chn : p.in[I_RK] + li * 512 + chn;
            *(float4*)(PT + 192 + arr * 64 + c4) = *(const float4*)src;
        }
    }
    __syncthreads();
    {
        const int c = tid >> 2, cq = tid & 3, s = n * 64 + c;
        const bf16_t* cur = proj + (size_t)(t0 + c) * EVLD + C_HW + cq * 48;
        const float* mu = p.in[I_MU] + (size_t)li * 1696 + (C_HW - RW0);
        const float* vmu = p.in[I_VRESMU];
#pragma unroll
        for (int i6 = 0; i6 < 6; ++i6) {
            const u32x4 cw4 = *(const u32x4*)(cur + i6 * 8);
            u32x4 pw4 = *(const u32x4*)(cur - (s > 0 ? EVLD : 0) + i6 * 8);
            if (s == 0) pw4 = (u32x4){0u, 0u, 0u, 0u};
            const int j0 = cq * 48 + i6 * 8;
            const float4 ma = *(const float4*)(PT + j0), mb = *(const float4*)(PT + j0 + 4);
            const float mm[8] = {ma.x, ma.y, ma.z, ma.w, mb.x, mb.y, mb.z, mb.w};
            const bool is_t = j0 < 32, is_s = (j0 >= 64) && (j0 < 160);
            const float ca = is_t ? 1.f : 0.f, cb = is_t ? -2.f : 1.f, cc = is_t ? 2.f : -1.f;
            u32x4 w;
#pragma unroll
            for (int e = 0; e < 4; ++e) {
                float o2[2];
#pragma unroll
                for (int q = 0; q < 2; ++q) {
                    const float cv = q ? __uint_as_float(cw4[e] & 0xffff0000u) : __uint_as_float(cw4[e] << 16);
                    const float pv = q ? __uint_as_float(pw4[e] & 0xffff0000u) : __uint_as_float(pw4[e] << 16);
                    const float val = cv + mm[e * 2 + q] * (pv - cv);
                    const float act = ca + cb * __builtin_amdgcn_rcpf(1.f + __expf(cc * val));
                    o2[q] = (is_t || is_s) ? act : val;
                }
                w[e] = pack2(o2[0], o2[1]);
            }
            *(u32x4*)(lin + c * 400 + (cq * 48 + i6 * 8) * 2) = w;
        }
        const bf16_t* LW = (const bf16_t*)(p.ws + WS_W + W_LW) + (size_t)h * 64 * 192;
#pragma unroll
        for (int i6 = 0; i6 < 6; ++i6) *(u32x4*)(LWi + c * 400 + (cq * 48 + i6 * 8) * 2) = *(const u32x4*)(LW + (size_t)c * 192 + cq * 48 + i6 * 8);
    }
    __syncthreads();
    float lw_[16], la_[16], lg_[16], lv_[16];
#pragma unroll
    for (int tj = 0; tj < 4; ++tj) {
        const f32x4 a = tile16(LWi, 400, 16 * tj, lin, 400, 16 * wid, 32);
        const f32x4 bq = tile16(LWi + 64, 400, 16 * tj, lin + 64, 400, 16 * wid, 32);
        const f32x4 cg = tile16(LWi + 128, 400, 16 * tj, lin + 128, 400, 16 * wid, 96);
        const f32x4 dv = tile16(LWi + 320, 400, 16 * tj, lin + 320, 400, 16 * wid, 32);
#pragma unroll
        for (int r = 0; r < 4; ++r) { lw_[tj * 4 + r] = a[r]; la_[tj * 4 + r] = bq[r]; lg_[tj * 4 + r] = cg[r]; lv_[tj * 4 + r] = dv[r]; }
    }
    __syncthreads();
    const int c = 16 * wid + fr;
    float at[16], rt[16], bt[16], kt[16], bh[16], kh[16];
    {
        const int s = n * 64 + c;
        const size_t row = (size_t)(t0 + c);
        const float* mu = p.in[I_MU] + (size_t)li * 1696;
        const int hc = h * 64;
        float rr_[16], kk_[16], lwv[16], aa[16];
        float kn = 0.f, rk = 0.f;
        bf16_t* vf = (bf16_t*)(p.ws + WS_VF);
        bf16_t* gg = (bf16_t*)(p.ws + WS_GG);
#pragma unroll
        for (int tj = 0; tj < 4; ++tj) {
            const int cb = 16 * tj + 4 * fq;
            u32x2 cr = *(const u32x2*)(proj + row * EVLD + C_R + hc + cb), ck = *(const u32x2*)(proj + row * EVLD + C_K + hc + cb), cv = *(const u32x2*)(proj + row * EVLD + C_V + hc + cb);
            const size_t prow = s > 0 ? row - 1 : row;
            u32x2 pr = *(const u32x2*)(proj + prow * EVLD + C_R + hc + cb), pk = *(const u32x2*)(proj + prow * EVLD + C_K + hc + cb), pv = *(const u32x2*)(proj + prow * EVLD + C_V + hc + cb);
            if (s == 0) { pr = (u32x2){0u, 0u}; pk = pr; pv = pr; }
            u32x2 vfw = {0u, 0u};
            if (li == 1) vfw = *(const u32x2*)(vf + row * 512 + hc + cb);
            float vout[4], gout[4];
            const int ch0 = hc + cb;
            const float* pt = PT + 192 + cb;
            const float4 mu_r4 = *(const float4*)(pt), mu_k4 = *(const float4*)(pt + 64), mu_v4 = *(const float4*)(pt + 128);
            const float4 w0_4 = *(const float4*)(pt + 192), a0_4 = *(const float4*)(pt + 256), v0_4 = *(const float4*)(pt + 320);
            const float4 kk_4 = *(const float4*)(pt + 384), ka_4 = *(const float4*)(pt + 448), rk_4 = *(const float4*)(pt + 512);
            const float mur[4] = {mu_r4.x, mu_r4.y, mu_r4.z, mu_r4.w}, muk[4] = {mu_k4.x, mu_k4.y, mu_k4.z, mu_k4.w}, muv[4] = {mu_v4.x, mu_v4.y, mu_v4.z, mu_v4.w};
            const float w0v[4] = {w0_4.x, w0_4.y, w0_4.z, w0_4.w}, a0v[4] = {a0_4.x, a0_4.y, a0_4.z, a0_4.w}, v0v[4] = {v0_4.x, v0_4.y, v0_4.z, v0_4.w};
            const float kkp[4] = {kk_4.x, kk_4.y, kk_4.z, kk_4.w}, kap[4] = {ka_4.x, ka_4.y, ka_4.z, ka_4.w}, rkp[4] = {rk_4.x, rk_4.y, rk_4.z, rk_4.w};
#pragma unroll
            for (int r = 0; r < 4; ++r) {
                const int i = tj * 4 + r;
                const unsigned wcr = r < 2 ? cr.x : cr.y, wck = r < 2 ? ck.x : ck.y, wcv = r < 2 ? cv.x : cv.y;
                const unsigned wpr = r < 2 ? pr.x : pr.y, wpk = r < 2 ? pk.x : pk.y, wpv = r < 2 ? pv.x : pv.y, wvf = r < 2 ? vfw.x : vfw.y;
                const float c_r = (r & 1) ? __uint_as_float(wcr & 0xffff0000u) : __uint_as_float(wcr << 16);
                const float c_k = (r & 1) ? __uint_as_float(wck & 0xffff0000u) : __uint_as_float(wck << 16);
                const float c_v = (r & 1) ? __uint_as_float(wcv & 0xffff0000u) : __uint_as_float(wcv << 16);
                const float p_r = (r & 1) ? __uint_as_float(wpr & 0xffff0000u) : __uint_as_float(wpr << 16);
                const float p_k = (r & 1) ? __uint_as_float(wpk & 0xffff0000u) : __uint_as_float(wpk << 16);
                const float p_v = (r & 1) ? __uint_as_float(wpv & 0xffff0000u) : __uint_as_float(wpv << 16);
                const float rm = c_r + mur[r] * (p_r - c_r);
                const float km = c_k + muk[r] * (p_k - c_k);
                float vm = c_v + muv[r] * (p_v - c_v);
                const float wlog = -softplusf_(-(w0v[r] + lw_[i])) - 0.5f;
                lwv[i] = -__expf(wlog);
                const float a = sigmoidf_(a0v[r] + la_[i]);
                if (li == 1) {
                    const float v1 = (r & 1) ? __uint_as_float(wvf & 0xffff0000u) : __uint_as_float(wvf << 16);
                    vm = vm + (v1 - vm) * sigmoidf_(v0v[r] + lv_[i]);
                }
                const float kkv = km * kkp[r];
                kn += kkv * kkv;
                rr_[i] = rm; kk_[i] = kkv; aa[i] = a;
                kt[i] = km * (1.f + (a - 1.f) * kap[r]);
                rk += rm * kt[i] * rkp[r];
                vout[r] = vm; gout[r] = lg_[i];
            }
            u32x2 w; w.x = pack2(vout[0], vout[1]); w.y = pack2(vout[2], vout[3]);
            *(u32x2*)(vf + row * 512 + hc + cb) = w;
            w.x = pack2(gout[0], gout[1]); w.y = pack2(gout[2], gout[3]);
            *(u32x2*)(gg + row * 512 + hc + cb) = w;
#pragma unroll
            for (int r = 0; r < 4; ++r) *(bf16_t*)(VT + (cb + r) * 144 + c * 2) = f2bf(vout[r]);
            __builtin_amdgcn_sched_barrier(0);
        }
        kn += __shfl_xor(kn, 16); kn += __shfl_xor(kn, 32);
        const float kr = rsqrtf(kn + 1e-6f);
        rk += __shfl_xor(rk, 16); rk += __shfl_xor(rk, 32);
        if (fq == 0) ((float*)(p.ws + WS_RK))[row * 8 + h] = rk;
        float cs[16];
#pragma unroll
        for (int i = 0; i < 16; ++i) {
            float x = lwv[i];
#pragma unroll
            for (int o = 1; o < 16; o <<= 1) { const float y = __shfl_up(x, o, 16); if (fr >= o) x += y; }
            cs[i] = x;
        }
        if (fr == 15) {
#pragma unroll
            for (int i = 0; i < 16; ++i) tot[wid * 64 + 16 * (i >> 2) + 4 * fq + (i & 3)] = cs[i];
        }
        __syncthreads();
#pragma unroll
        for (int i = 0; i < 16; ++i) {
            const int chl = 16 * (i >> 2) + 4 * fq + (i & 3);
            float pre = 0.f, all = 0.f;
#pragma unroll
            for (int w2 = 0; w2 < 4; ++w2) { const float tv = tot[w2 * 64 + chl]; all += tv; if (w2 < wid) pre += tv; }
            const float csi = cs[i] + pre, csm = csi - lwv[i];
            const float kkn = kk_[i] * kr, k2 = kt[i];
            const float e_c = __expf(csi), e_n = __builtin_amdgcn_rcpf(e_c), e_m = __expf(csm), e_h = __expf(all) * e_n;
            at[i] = -kkn * e_m; rt[i] = rr_[i] * e_c;
            const float bp = kkn * aa[i];
            bt[i] = bp * e_n; kt[i] = k2 * e_n; bh[i] = bp * e_h; kh[i] = k2 * e_h;
            if (c == 0) WC[chl] = __expf(all);
            if ((i & 3) == 3) __builtin_amdgcn_sched_barrier(0);
        }
    }
#pragma unroll
    for (int tj = 0; tj < 4; ++tj) {
        const int cb = 16 * tj + 4 * fq;
        u32x2 w;
        w.x = pack2(at[tj * 4], at[tj * 4 + 1]); w.y = pack2(at[tj * 4 + 2], at[tj * 4 + 3]); *(u32x2*)(Arow + c * 144 + cb * 2) = w;
        w.x = pack2(rt[tj * 4], rt[tj * 4 + 1]); w.y = pack2(rt[tj * 4 + 2], rt[tj * 4 + 3]); *(u32x2*)(Rrow + c * 144 + cb * 2) = w;
        w.x = pack2(bt[tj * 4], bt[tj * 4 + 1]); w.y = pack2(bt[tj * 4 + 2], bt[tj * 4 + 3]); *(u32x2*)(Brow + c * 144 + cb * 2) = w;
        w.x = pack2(kt[tj * 4], kt[tj * 4 + 1]); w.y = pack2(kt[tj * 4 + 2], kt[tj * 4 + 3]); *(u32x2*)(Krow + c * 144 + cb * 2) = w;
#pragma unroll
        for (int r = 0; r < 4; ++r) {
            *(bf16_t*)(AT + (cb + r) * 144 + c * 2) = f2bf(at[tj * 4 + r]);
        }
    }
    __syncthreads();
    f32x4 pab[4], pak[4], prb[4], prk[4];
    {
        const int ti = wid;
#pragma unroll
        for (int tj = 0; tj < 4; ++tj) {
            pab[tj] = (f32x4){0.f, 0.f, 0.f, 0.f}; pak[tj] = pab[tj]; prb[tj] = pab[tj]; prk[tj] = pab[tj];
            if (tj <= ti) {
                pab[tj] = tile16(Arow, 144, 16 * ti, Brow, 144, 16 * tj, 64);
                pak[tj] = tile16(Krow, 144, 16 * tj, Arow, 144, 16 * ti, 64);
                prb[tj] = tile16(Brow, 144, 16 * tj, Rrow, 144, 16 * ti, 64);
                prk[tj] = tile16(Krow, 144, 16 * tj, Rrow, 144, 16 * ti, 64);
            }
        }
    }
    __syncthreads();
    {
        const int ti = wid;
#pragma unroll
        for (int tj = 0; tj < 4; ++tj) {
            const int s1 = 16 * tj + fr;
            f32x4 lv;
#pragma unroll
            for (int r = 0; r < 4; ++r) { const int t1 = 16 * ti + 4 * fq + r; lv[r] = (s1 < t1) ? -pab[tj][r] : 0.f; }
            *(f32x4*)&Lf[s1 * 72 + 16 * ti + 4 * fq] = lv;
            const int t2 = 16 * ti + fr;
            float m1[4], m2[4], m3[4];
#pragma unroll
            for (int r = 0; r < 4; ++r) { const int s2 = 16 * tj + 4 * fq + r; m1[r] = (s2 < t2) ? pak[tj][r] : 0.f; m2[r] = (s2 <= t2) ? prb[tj][r] : 0.f; m3[r] = (s2 <= t2) ? prk[tj][r] : 0.f; }
            u32x2 w;
            w.x = pack2(m1[0], m1[1]); w.y = pack2(m1[2], m1[3]); *(u32x2*)(Aak + t2 * 144 + (16 * tj + 4 * fq) * 2) = w;
            w.x = pack2(m2[0], m2[1]); w.y = pack2(m2[2], m2[3]); *(u32x2*)(Arb + t2 * 144 + (16 * tj + 4 * fq) * 2) = w;
            w.x = pack2(m3[0], m3[1]); w.y = pack2(m3[2], m3[3]); *(u32x2*)(Ark + t2 * 144 + (16 * tj + 4 * fq) * 2) = w;
        }
    }
    __syncthreads();
    if (wid == 0) {
        float Tc[64];
#pragma unroll
        for (int i = 0; i < 64; ++i) Tc[i] = (i == lane) ? 1.f : 0.f;
#pragma unroll
        for (int j = 0; j < 63; ++j) {
            const float tj = Tc[j];
#pragma unroll
            for (int i4 = (j + 1) >> 2; i4 < 16; ++i4) {
                const f32x4 l4 = *(const f32x4*)&Lf[j * 72 + i4 * 4];
#pragma unroll
                for (int e = 0; e < 4; ++e) if (i4 * 4 + e > j) Tc[i4 * 4 + e] -= l4[e] * tj;
            }
        }
#pragma unroll
        for (int i = 0; i < 64; ++i) *(bf16_t*)(Trow + i * 144 + lane * 2) = f2bf(Tc[i]);
    }
    __syncthreads();
    {
        const int ti = wid;
#pragma unroll
        for (int tj = 0; tj < 4; ++tj) {
            const f32x4 x = tile16(Trow, 144, 16 * ti, AT, 144, 16 * tj, 64);
            const f32x4 y = tile16(Aak, 144, 16 * ti, VT, 144, 16 * tj, 64);
            u32x2 w;
            w.x = pack2(x[0], x[1]); w.y = pack2(x[2], x[3]); *(u32x2*)(ApT + (16 * tj + fr) * 144 + (16 * ti + 4 * fq) * 2) = w;
            w.x = pack2(y[0], y[1]); w.y = pack2(y[2], y[3]); *(u32x2*)(AkVT + (16 * tj + fr) * 144 + (16 * ti + 4 * fq) * 2) = w;
        }
    }
    __syncthreads();
    {
        const int ti = wid;
#pragma unroll
        for (int tj = 0; tj < 4; ++tj) {
            const f32x4 x = tile16(Trow, 144, 16 * ti, AkVT, 144, 16 * tj, 64);
            u32x2 w; w.x = pack2(x[0], x[1]); w.y = pack2(x[2], x[3]); *(u32x2*)(VpT + (16 * tj + fr) * 144 + (16 * ti + 4 * fq) * 2) = w;
        }
    }
    __syncthreads();
#pragma unroll
    for (int tj = 0; tj < 4; ++tj)
#pragma unroll
        for (int r = 0; r < 4; ++r) {
            const int cb = 16 * tj + 4 * fq + r;
            *(bf16_t*)(BhT + cb * 144 + c * 2) = f2bf(bh[tj * 4 + r]);
            *(bf16_t*)(KhT + cb * 144 + c * 2) = f2bf(kh[tj * 4 + r]);
        }
    __syncthreads();
    {
        unsigned char* opsA = p.ws + WS_HN + (size_t)ch * 16384;
        unsigned char* opsB = p.ws + WS_ROPS + (size_t)ch * 16384;
        const int ti = wid;
#pragma unroll
        for (int tj = 0; tj < 4; ++tj) {
            const f32x4 x = tile16(ApT, 144, 16 * tj, Arb, 144, 16 * ti, 64);
            const f32x4 g = tile16(ApT, 144, 16 * tj, BhT, 144, 16 * ti, 64);
            const int m1 = 16 * ti + fr, mt = m1 >> 5, rr = m1 & 31, hh = fq & 1, jg = fq >> 1;
            const size_t off = ((size_t)((mt * 4 + tj) * 64 + hh * 32 + rr) * 8 + jg * 4) * 2;
            float gd[4];
#pragma unroll
            for (int r = 0; r < 4; ++r) gd[r] = g[r] + ((16 * tj + 4 * fq + r == m1) ? WC[m1] : 0.f);
            u32x2 w;
            w.x = pack2(x[0] + rt[tj * 4], x[1] + rt[tj * 4 + 1]); w.y = pack2(x[2] + rt[tj * 4 + 2], x[3] + rt[tj * 4 + 3]); *(u32x2*)(opsA + off) = w;
            w.x = pack2(gd[0], gd[1]); w.y = pack2(gd[2], gd[3]); *(u32x2*)(opsA + 8192 + off) = w;
            f32x4 y = tile16(Ark, 144, 16 * ti, VT, 144, 16 * tj, 64);
            const f32x4 y2 = tile16(Arb, 144, 16 * ti, VpT, 144, 16 * tj, 64);
            f32x4 kv = tile16(KhT, 144, 16 * ti, VT, 144, 16 * tj, 64);
            const f32x4 kv2 = tile16(BhT, 144, 16 * ti, VpT, 144, 16 * tj, 64);
            const int vcol = 16 * tj + fr, slice = vcol >> 5, r2 = vcol & 31, cb = 16 * ti + 4 * fq, mt2 = cb >> 5, q4 = (cb & 31) >> 2, h2 = q4 & 1, rg = q4 >> 1;
            const size_t off2 = ((size_t)((slice * 2 + mt2) * 64 + h2 * 32 + r2) * 16 + rg * 4) * 2;
            w.x = pack2(y[0] + y2[0], y[1] + y2[1]); w.y = pack2(y[2] + y2[2], y[3] + y2[3]); *(u32x2*)(opsB + off2) = w;
            w.x = pack2(kv[0] + kv2[0], kv[1] + kv2[1]); w.y = pack2(kv[2] + kv2[2], kv[3] + kv2[3]); *(u32x2*)(opsB + 8192 + off2) = w;
        }
    }
}

DI void rwkv_scan_block(const P& p, int bh, char* lds, bool dry = false) {
    const int tid = tidx(), lane = tid & 63, w = tid >> 6, slice = w & 1;
    const int h = bh & 7, b = bh >> 3;
    constexpr int NST = 64 * 2, AH = 3;
    auto issue = [&](int j) {
        const int n = j >> 1, k = j & 1;
        const size_t ch = (size_t)((b * 64 + n) * 8 + h) * 16384;
        const unsigned char* s0 = (k == 0 ? p.ws + WS_ROPS + ch + 8192 : p.ws + WS_ROPS + ch) + tid * 16;
        const unsigned char* s1 = (k == 0 ? p.ws + WS_HN + ch + 8192 : p.ws + WS_HN + ch) + tid * 16;
        char* dst = lds + (j & 3) * 16384 + tid * 16;
        glds16(s0, dst); glds16(s0 + 4096, dst + 4096); glds16(s1, dst + 8192); glds16(s1 + 4096, dst + 12288);
    };
    f32x16 H[2];
#pragma unroll
    for (int i = 0; i < 2; ++i)
#pragma unroll
        for (int r = 0; r < 16; ++r) H[i][r] = 0.f;
    __syncthreads();
#pragma unroll
    for (int j = 0; j < AH; ++j) issue(j);
#pragma unroll 1
    for (int n = 0; n < 64; ++n) {
        bf16x8 Hb[4];
#pragma unroll
        for (int i = 0; i < 2; ++i) { Hb[i * 2] = pack_step(H[i], 0); Hb[i * 2 + 1] = pack_step(H[i], 1); }
#pragma unroll
        for (int k = 0; k < 2; ++k) {
            const int j = n * 2 + k;
            if (n < 63) GS_WAIT(8); else if (k == 0) GS_WAIT(4); else GS_WAIT(0);
            __builtin_amdgcn_s_barrier();
            if (j + AH < NST) issue(j + AH);
            __builtin_amdgcn_sched_barrier(0);
            const char* sl = lds + (j & 3) * 16384;
            if (w < 2) {
                f32x16 acc[2];
#pragma unroll
                for (int mt = 0; mt < 2; ++mt) {
                    const u32x4* up = (const u32x4*)(sl + (slice * 2 + mt) * 2048 + lane * 32);
                    const u32x4 u0 = up[0], u1 = up[1];
#pragma unroll
                    for (int e = 0; e < 4; ++e) {
                        acc[mt][e * 2] = __uint_as_float(u0[e] << 16); acc[mt][e * 2 + 1] = __uint_as_float(u0[e] & 0xffff0000u);
                        acc[mt][8 + e * 2] = __uint_as_float(u1[e] << 16); acc[mt][8 + e * 2 + 1] = __uint_as_float(u1[e] & 0xffff0000u);
                    }
                }
                const bf16x8* fr = (const bf16x8*)(sl + 8192) + lane;
                bf16x8 f8[8];
#pragma unroll
                for (int q = 0; q < 8; ++q) f8[q] = fr[q * 64];
#pragma unroll
                for (int ks = 0; ks < 4; ++ks)
#pragma unroll
                    for (int mt = 0; mt < 2; ++mt) acc[mt] = mfma32(f8[mt * 4 + ks], Hb[ks], acc[mt]);
                if (k == 0) { H[0] = acc[0]; H[1] = acc[1]; }
                else {
                    const size_t ch = (size_t)((b * 64 + n) * 8 + h) * 16384;
                    u32x4* Yf = (u32x4*)(dry ? p.ws + WS_DUMMY + 2097152 + (size_t)(bh & 31) * 16384 : p.ws + WS_ROPS + ch) + (size_t)(slice * 128 + lane) * 2;
#pragma unroll
                    for (int mt = 0; mt < 2; ++mt) {
                        u32x4 o0, o1;
#pragma unroll
                        for (int e = 0; e < 4; ++e) { o0[e] = pack2(acc[mt][e * 2], acc[mt][e * 2 + 1]); o1[e] = pack2(acc[mt][8 + e * 2], acc[mt][8 + e * 2 + 1]); }
                        Yf[mt * 128] = o0; Yf[mt * 128 + 1] = o1;
                    }
                }
            }
        }
    }
    __syncthreads();
}

DI void rwkv_post_unit(const P& p, int li, int ch) {
    const int tid = tidx();
    const int h = ch & 7, n = (ch >> 3) & 63, b = ch >> 9;
    const int t0 = b * SEQ + n * 64;
    const int c = tid >> 2, cq = tid & 3;
    const bf16_t* Yf = (const bf16_t*)(p.ws + WS_ROPS + (size_t)ch * 16384);
    const bf16_t* vf = (const bf16_t*)(p.ws + WS_VF) + (size_t)(t0 + c) * 512 + h * 64 + cq * 16;
    const bf16_t* gg = (const bf16_t*)(p.ws + WS_GG) + (size_t)(t0 + c) * 512 + h * 64 + cq * 16;
    const float rk = ((const float*)(p.ws + WS_RK))[(size_t)(t0 + c) * 8 + h];
    const float* lnw = p.in[I_LNW] + li * 512 + h * 64 + cq * 16;
    const float* lnb = p.in[I_LNB] + li * 512 + h * 64 + cq * 16;
    bf16_t* mp = (bf16_t*)(p.ws + WS_HN) + (size_t)(t0 + c) * 1024 + 512 + h * 64 + cq * 16;
    const int mt = c >> 5, q4 = (c & 31) >> 2, hh = q4 & 1, rg = q4 >> 1, reg = rg * 4 + (c & 3), slice = cq >> 1, rb = (cq & 1) * 16;
    float y[16]; float sm = 0.f;
#pragma unroll
    for (int i = 0; i < 16; ++i) { y[i] = bf2f(Yf[(size_t)((slice * 2 + mt) * 64 + hh * 32 + rb + i) * 16 + reg]); sm += y[i]; }
    sm += __shfl_xor(sm, 1); sm += __shfl_xor(sm, 2);
    const float mean = sm * (1.f / 64.f);
    float vs = 0.f;
#pragma unroll
    for (int i = 0; i < 16; ++i) { y[i] -= mean; vs += y[i] * y[i]; }
    vs += __shfl_xor(vs, 1); vs += __shfl_xor(vs, 2);
    const float rs = rsqrtf(vs * (1.f / 64.f) + 64e-5f);
#pragma unroll
    for (int i8 = 0; i8 < 2; ++i8) {
        const u32x4 vw = *(const u32x4*)(vf + i8 * 8), gw = *(const u32x4*)(gg + i8 * 8);
        u32x4 w;
#pragma unroll
        for (int e = 0; e < 4; ++e) {
            const int i = i8 * 8 + e * 2;
            const float v0 = __uint_as_float(vw[e] << 16), v1 = __uint_as_float(vw[e] & 0xffff0000u), g0 = __uint_as_float(gw[e] << 16), g1 = __uint_as_float(gw[e] & 0xffff0000u);
            w[e] = pack2((y[i] * rs * lnw[i] + lnb[i] + rk * v0) * g0, (y[i + 1] * rs * lnw[i + 1] + lnb[i + 1] + rk * v1) * g1);
        }
        *(u32x4*)(mp + i8 * 8) = w;
    }
}


DI void attn_unit(const P& p, int unit, char* lds) {
    const int tid = tidx(), lane = tid & 63, w = tid >> 6, r_ = lane & 31, hl = lane >> 5;
    const int idx = unit & 31, h = (unit >> 5) & 7, g = (unit >> 8) % 3, b = unit / 768;
    const int lg2 = g * 2, dil = 1 << lg2, L = SEQ >> lg2, ntl = L >> 7;
    const int rs = idx / ntl, qt = idx % ntl;
    const int hg = g * 8 + h;
    const bf16_t* QK = (const bf16_t*)(p.ws + WS_QK);
    const bf16_t* VT = (const bf16_t*)(p.ws + WS_VT) + ((size_t)((b * 24 + hg) * dil + rs) * 64) * L;
    const int qi = 32 * w + r_;
    const int q_idx = 128 * qt + qi;
    const size_t qrow = (size_t)(b * SEQ + q_idx * dil + rs);
    const int kbase0 = 128 * qt - 128;
    char* Kt = lds;
    char* Vt = lds + 32768;
    __syncthreads();
#pragma unroll
    for (int i = 0; i < 8; ++i) {
        const int id = tid + i * 256, row = id >> 3, pc = id & 7, c = pc ^ ((row >> 1) & 7);
        int k_idx = kbase0 + row; if (k_idx < 0) k_idx = 0;
        glds16(QK + (size_t)(b * SEQ + k_idx * dil + rs) * 3072 + 1536 + hg * 64 + c * 8, Kt + id * 16);
    }
#pragma unroll
    for (int i = 0; i < 8; ++i) {
        const int id = tid + i * 256, row = id >> 5, pq = id & 31, q = pq ^ (row & 31);
        int k0 = kbase0 + q * 8; if (k0 < 0) k0 = 0;
        glds16(VT + (size_t)row * L + k0, Vt + id * 16);
    }
    bf16x8 qf[4];
#pragma unroll
    for (int ks = 0; ks < 4; ++ks) qf[ks] = *(const bf16x8*)(QK + qrow * 3072 + hg * 64 + 16 * ks + 8 * hl);
    asm volatile("s_waitcnt vmcnt(0)" ::: "memory");
    __syncthreads();
    f32x16 st[5];
    float mx = -1.0e30f;
#pragma unroll
    for (int kbi = 0; kbi < 5; ++kbi) {
        const int krow = 32 * (w + kbi) + r_;
#pragma unroll
        for (int r = 0; r < 16; ++r) st[kbi][r] = 0.f;
#pragma unroll
        for (int ks = 0; ks < 4; ++ks) {
            const bf16x8 kf = *(const bf16x8*)(Kt + krow * 128 + (((2 * ks + hl) ^ ((krow >> 1) & 7)) * 16));
            st[kbi] = mfma32(kf, qf[ks], st[kbi]);
        }
#pragma unroll
        for (int r = 0; r < 16; ++r) {
            const int kj = 32 * (w + kbi) + (r & 3) + 8 * (r >> 2) + 4 * hl;
            const bool valid = (kj >= qi) && (kj <= qi + 128) && (kbase0 + kj >= 0);
            const float sv = valid ? st[kbi][r] * 0.125f : -1.0e30f;
            st[kbi][r] = sv; mx = fmaxf(mx, sv);
        }
    }
    mx = fmaxf(mx, __shfl_xor(mx, 32));
    float l = 0.f;
#pragma unroll
    for (int kbi = 0; kbi < 5; ++kbi)
#pragma unroll
        for (int r = 0; r < 16; ++r) { const float pv = __expf(st[kbi][r] - mx); st[kbi][r] = pv; l += pv; }
    l += __shfl_xor(l, 32);
    f32x16 ot[2];
#pragma unroll
    for (int dt = 0; dt < 2; ++dt)
#pragma unroll
        for (int r = 0; r < 16; ++r) ot[dt][r] = 0.f;
#pragma unroll
    for (int kbi = 0; kbi < 5; ++kbi)
#pragma unroll
        for (int s2 = 0; s2 < 2; ++s2) {
            const bf16x8 pb = pack_step(st[kbi], s2);
            const int q0 = 4 * (w + kbi) + 2 * s2;
#pragma unroll
            for (int dt = 0; dt < 2; ++dt) {
                const int drow = 32 * dt + r_;
                const u32x2 lo = *(const u32x2*)(Vt + drow * 512 + ((q0 ^ (drow & 31)) * 16) + 8 * hl);
                const u32x2 hi = *(const u32x2*)(Vt + drow * 512 + (((q0 + 1) ^ (drow & 31)) * 16) + 8 * hl);
                u32x4 vw; vw.x = lo.x; vw.y = lo.y; vw.z = hi.x; vw.w = hi.y;
                ot[dt] = mfma32(__builtin_bit_cast(bf16x8, vw), pb, ot[dt]);
            }
        }
    const float inv = 1.f / l;
    bf16_t* og = (bf16_t*)(p.ws + WS_OG) + ((size_t)g * T + qrow) * 512 + h * 64;
#pragma unroll
    for (int dt = 0; dt < 2; ++dt)
#pragma unroll
        for (int rg = 0; rg < 4; ++rg) {
            u32x2 wv; wv.x = pack2(ot[dt][rg * 4] * inv, ot[dt][rg * 4 + 1] * inv); wv.y = pack2(ot[dt][rg * 4 + 2] * inv, ot[dt][rg * 4 + 3] * inv);
            *(u32x2*)(og + 32 * dt + 8 * rg + 4 * hl) = wv;
        }
    if (hl == 0) ((float*)(p.ws + WS_LSE))[((size_t)g * T + qrow) * 8 + h] = mx + __logf(l);
}
DI void phase_attn_merge(const P& p) {
    const bf16_t* og = (const bf16_t*)(p.ws + WS_OG);
    const float* lse = (const float*)(p.ws + WS_LSE);
    bf16_t* o = (bf16_t*)(p.ws + WS_HN);
    for (int i = bidx() * 256 + tidx(); i < T * 64; i += gridDim.x * 256) {
        const int t = i >> 6, c8 = i & 63, h = c8 >> 3;
        const float l0 = lse[(size_t)t * 8 + h], l1 = lse[((size_t)T + t) * 8 + h], l2 = lse[((size_t)2 * T + t) * 8 + h];
        const float m = fmaxf(l0, fmaxf(l1, l2));
        float w0 = __expf(l0 - m), w1 = __expf(l1 - m), w2 = __expf(l2 - m);
        const float inv = 1.f / (w0 + w1 + w2); w0 *= inv; w1 *= inv; w2 *= inv;
        const u32x4 a = *(const u32x4*)(og + (size_t)t * 512 + c8 * 8), bq = *(const u32x4*)(og + ((size_t)T + t) * 512 + c8 * 8), cq = *(const u32x4*)(og + ((size_t)2 * T + t) * 512 + c8 * 8);
        u32x4 r;
#pragma unroll
        for (int e = 0; e < 4; ++e) {
            const float x0 = w0 * __uint_as_float(a[e] << 16) + w1 * __uint_as_float(bq[e] << 16) + w2 * __uint_as_float(cq[e] << 16);
            const float x1 = w0 * __uint_as_float(a[e] & 0xffff0000u) + w1 * __uint_as_float(bq[e] & 0xffff0000u) + w2 * __uint_as_float(cq[e] & 0xffff0000u);
            r[e] = pack2(x0, x1);
        }
        *(u32x4*)(o + (size_t)t * 512 + c8 * 8) = r;
    }
}


#define XB_TMO      128
#define XB_XCNT(j)  (256  + 64 * (j))
#define XB_XSUB(j)  (1280 + 64 * (j))
#define XB_XGEN(j)  (2304 + 64 * (j))
#define XB_TOP      3328
#define XB_TOPGEN   3392
#define XCD_BAR_WORDS 3456
#define XB_SPIN_CAP (1u << 22)
#define LAS __attribute__((address_space(3)))
DI unsigned xb_ld(unsigned* p)              { return __hip_atomic_load(p, __ATOMIC_RELAXED, __HIP_MEMORY_SCOPE_AGENT); }
DI unsigned xb_add(unsigned* p, unsigned v) { return __hip_atomic_fetch_add(p, v, __ATOMIC_RELAXED, __HIP_MEMORY_SCOPE_AGENT); }
DI unsigned xb_xcc_id() { return (unsigned)__builtin_amdgcn_s_getreg((3 << 11) | 20) & 0xFu; }
#define XB_SPIN(cond, bar) do { unsigned _sp = 0; while (cond) { if (_sp < 32u) __builtin_amdgcn_s_sleep(2); else __builtin_amdgcn_s_sleep(24); \
    if ((++_sp & 255u) == 0u) { if (xb_ld(&(bar)[XB_TMO])) break; if (_sp > XB_SPIN_CAP) { atomicAdd(&(bar)[XB_TMO], 1u); break; } } } } while (0)
struct XcdBarrier { unsigned* bar; unsigned x; volatile LAS unsigned* st; };
DI XcdBarrier xcd_barrier_post(unsigned* bar, volatile LAS unsigned* st) {
    XcdBarrier b; b.bar = bar; b.x = xb_xcc_id(); b.st = st;
    if (threadIdx.x == 0) (void)xb_add(&bar[XB_XCNT(b.x)], 1u);
    return b;
}
DI void xcd_barrier_complete(unsigned* bar, unsigned x, unsigned& nloc, unsigned& nx) {
    const unsigned G = gridDim.x * gridDim.y * gridDim.z;
    unsigned sum, cnt, mine, sp = 0u;
    for (;;) {
        sum = 0u; cnt = 0u; mine = 0u;
#pragma unroll
        for (unsigned j = 0; j < 16; ++j) { const unsigned c = xb_ld(&bar[XB_XCNT(j)]); sum += c; cnt += (c > 0u) ? 1u : 0u; mine = (j == x) ? c : mine; }
        if (sum == G) break;
        __builtin_amdgcn_s_sleep(1);
        if ((++sp & 255u) == 0u) { if (xb_ld(&bar[XB_TMO])) break; if (sp > XB_SPIN_CAP) { atomicAdd(&bar[XB_TMO], 1u); break; } }
    }
    nloc = mine > 0u ? mine : 1u; nx = cnt > 0u ? cnt : 1u;
}
DI void xcd_barrier(const XcdBarrier& b) {
    asm volatile("s_waitcnt vmcnt(0)" ::: "memory");
    __syncthreads();
    if (threadIdx.x == 0) {
        unsigned* bar = b.bar;
        __builtin_amdgcn_s_waitcnt(0);
        unsigned nloc = b.st[0], nx = b.st[1];
        if (nloc == 0u) { xcd_barrier_complete(bar, b.x, nloc, nx); b.st[0] = nloc; b.st[1] = nx; }
        const unsigned old = xb_add(&bar[XB_XSUB(b.x)], 1u);
        const unsigned gen = old / nloc;
        if (old + 1u == (gen + 1u) * nloc) {
            __builtin_amdgcn_fence(__ATOMIC_RELEASE, "agent");
            asm volatile("s_waitcnt vmcnt(0)" ::: "memory");
            const unsigned og = xb_add(&bar[XB_TOP], 1u);
            const unsigned tg = og / nx;
            if (og + 1u == (tg + 1u) * nx) xb_add(&bar[XB_TOPGEN], 1u);
            else XB_SPIN(xb_ld(&bar[XB_TOPGEN]) == tg, bar);
            __builtin_amdgcn_fence(__ATOMIC_ACQUIRE, "agent");
            xb_add(&bar[XB_XGEN(b.x)], 1u);
            asm volatile("s_waitcnt vmcnt(0)" ::: "memory");
        } else {
            XB_SPIN(xb_ld(&bar[XB_XGEN(b.x)]) == gen, bar);
            __builtin_amdgcn_fence(__ATOMIC_ACQUIRE, "agent");
            asm volatile("s_waitcnt vmcnt(0)" ::: "memory");
        }
    }
    __syncthreads();
}

constexpr int LDS_BYTES = RP_END;
static_assert(GP_END + 6144 <= LDS_BYTES, "LDS");
__global__ void __launch_bounds__(256, 2) mega(P p) {
    cg::grid_group grid = cg::this_grid();
    extern __shared__ __attribute__((aligned(16))) char lds[];
    if (threadIdx.x < 4) ((volatile LAS unsigned*)(lds + LDS_BYTES))[threadIdx.x] = 0u;
    __syncthreads();
    const XcdBarrier xb = xcd_barrier_post((unsigned*)(p.ws + WS_CTL + CTL_BAR), (volatile LAS unsigned*)(lds + LDS_BYTES));
#define GSYNC() xcd_barrier(xb)
    const bf16_t* HN = (const bf16_t*)(p.ws + WS_HN);
    const bf16_t* Win = (const bf16_t*)(p.ws + WS_W + W_IN);
    const bf16_t* Wout = (const bf16_t*)(p.ws + WS_W + W_OUT);
    phase_rope(p);
    phase_convert_io(p, 0, lds);
    phase_prep<0>(p, p.in[I_EVNORM], 0);
    if (p.ws == nullptr) grid.sync();
    GSYNC();
    volatile LAS unsigned* qword = (volatile LAS unsigned*)(lds + LDS_BYTES + 8);
    for (int layer = 0; layer < 4; ++layer) {
        const int li = layer >> 1;
        if ((layer & 1) == 0) {
            phase_gemm<EPI_EVEN_IN>(p, HN, 1024, Win, 1024, EVPAD / 128, lds);
            GSYNC();
            for (int u = bidx(); u < 1024; u += gridDim.x) gdn_prep_unit(p, li, u, lds);
            GSYNC();
            if (bidx() < 16) gdn_scan_block(p, bidx(), lds);
            {
                unsigned* qctr = (unsigned*)(p.ws + WS_CTL + CTL_QUEUE) + li * 64;
                for (;;) {
                    __syncthreads();
                    if (threadIdx.x == 0) *qword = atomicAdd(qctr, 1u);
                    __syncthreads();
                    const unsigned u = *qword;
                    if (u >= 2048u) break;
                    rwkv_prep_unit(p, li, (int)u, lds);
                }
            }
            GSYNC();
            if (bidx() < 32) rwkv_scan_block(p, bidx(), lds);
            else {
                for (int u = bidx() - 32; u < 1024; u += gridDim.x - 32) gdn_post_unit(p, li, u);
                phase_convert_moe(p, layer, lds, bidx() - 32, gridDim.x - 32);
            }
            GSYNC();
            for (int u = bidx(); u < 2048; u += gridDim.x) rwkv_post_unit(p, li, u);
            GSYNC();
            phase_gemm<EPI_RESID>(p, (const bf16_t*)(p.ws + WS_PROJ), EVLD, Wout, 1024, 8, lds, false, HN, 1024, 512);
        } else {
            phase_gemm<EPI_ODD_IN>(p, HN, 1024, Win, 1024, ODC / 128, lds);
            GSYNC();
            for (int u = bidx(); u < 3072; u += gridDim.x) attn_unit(p, u, lds);
            GSYNC();
            phase_attn_merge(p);
            GSYNC();
            phase_gemm<EPI_RESID>(p, HN, 512, Wout, 512, 8, lds);
        }
        GSYNC();
        phase_router(p, p.in[I_FFNNORM] + layer * 1024, layer, lds);
        GSYNC();
        phase_moe_up(p, layer, lds);
        GSYNC();
        phase_moe_down(p, layer, lds);
        GSYNC();
        if (layer < 3) {
            phase_convert_io(p, layer + 1, lds);
            if ((layer + 1) & 1) phase_convert_moe(p, layer + 1, lds, bidx(), gridDim.x);
            phase_prep<1>(p, ((layer + 1) & 1) ? p.in[I_ODNORM] + ((layer + 1) >> 1) * 1024 : p.in[I_EVNORM] + ((layer + 1) >> 1) * 1024, layer + 1);
            GSYNC();
        }
    }
    phase_prep<3>(p, p.in[I_FINAL], 0);
}

extern "C" void kernel_launch(void* const* d_in, const int* in_sizes, int n_in, void* d_out, int out_size, void* d_ws, size_t ws_size, hipStream_t stream) {
    if (n_in != 34 || out_size != T * D || ws_size < WS_END) { fprintf(stderr, "kernel_launch: unexpected shapes (n_in %d out %d ws %zu need %zu)\n", n_in, out_size, ws_size, (size_t)WS_END); return; }
    static int grid_blocks = 0;
    if (!grid_blocks) {
        int dev = 0, cus = 0, per_cu = 0;
        (void)hipGetDevice(&dev);
        (void)hipDeviceGetAttribute(&cus, hipDeviceAttributeMultiprocessorCount, dev);
        (void)hipFuncSetAttribute((const void*)mega, hipFuncAttributeMaxDynamicSharedMemorySize, LDS_BYTES + 16);
        (void)hipOccupancyMaxActiveBlocksPerMultiprocessor(&per_cu, mega, 256, LDS_BYTES + 16);
        if (per_cu < 1) per_cu = 1;
        if (per_cu > 2) per_cu = 2;
        grid_blocks = cus * per_cu;
    }
    P p{};
    for (int i = 0; i < 34; ++i) p.in[i] = (const float*)d_in[i];
    p.out = (float*)d_out; p.ws = (unsigned char*)d_ws;
    (void)hipMemsetAsync((char*)d_ws + WS_CTL, 0, 65536, stream);
    void* args[] = {&p};
    hipError_t e = hipLaunchCooperativeKernel((void*)mega, dim3(grid_blocks), dim3(256), args, LDS_BYTES + 16, stream);
    if (e != hipSuccess) fprintf(stderr, "cooperative launch failed: %s (grid %d)\n", hipGetErrorString(e), grid_blocks);
}
```

```cpp
#include <hip/hip_runtime.h>
#include <cstdio>
#include <cstdint>
#include <cmath>
#include <hip/hip_cooperative_groups.h>
namespace cg = cooperative_groups;

typedef unsigned short bf16_t;
typedef short bf16x8 __attribute__((ext_vector_type(8)));
typedef float f32x4 __attribute__((ext_vector_type(4)));
typedef unsigned u32x4 __attribute__((ext_vector_type(4)));
typedef unsigned u32x2 __attribute__((ext_vector_type(2)));
#define DI __device__ __forceinline__

constexpr int T = 16384, SEQ = 4096, BATCH = 4, D = 1024;
constexpr int EVC = 3784, EVLD = 3784, EVPAD = 3840;
constexpr int ODC = 4608;
constexpr int RW0 = 2056;
constexpr int C_R = 2056, C_K = 2568, C_V = 3080, C_HW = 3592, C_HA = 3624, C_HG = 3656, C_HV = 3752;
constexpr int NEXP = 16, FF = 256;
constexpr int HROWS = 34816;

constexpr size_t WS_CTL = 0;
constexpr size_t CTL_EGL = 4096;
constexpr size_t CTL_QUEUE = 49152;
constexpr size_t CTL_CNT = 32768;
constexpr size_t CTL_BAR = 16384;
constexpr size_t WS_LIST = 65536;
constexpr size_t WS_GATE = WS_LIST + 16 * 16384 * 4;
constexpr size_t WS_RK = WS_GATE + 16 * 16384 * 4;
constexpr size_t WS_ROPE = WS_RK + (size_t)T * 8 * 4;
constexpr size_t WS_W = WS_ROPE + (size_t)T * 32 * 8;
constexpr size_t W_IN = 0;
constexpr size_t W_OUT = (size_t)4608 * 1024 * 2;
constexpr size_t W_13 = W_OUT + (size_t)1024 * 1024 * 2;
constexpr size_t W_2 = W_13 + (size_t)16 * 512 * 1024 * 2;
constexpr size_t W_LW = W_2 + (size_t)16 * 1024 * 256 * 2;
constexpr size_t W_BYTES = W_LW + (size_t)512 * 192 * 2;
constexpr size_t WS_HN = WS_W + W_BYTES;
constexpr size_t WS_VF = WS_HN + (size_t)T * 1024 * 2;
constexpr size_t WS_R2 = WS_VF + (size_t)T * 512 * 2;
constexpr size_t WS_PROJ = WS_R2;
constexpr size_t WS_GOPS = WS_R2 + (size_t)T * EVLD * 2;
constexpr size_t GOPS_CH = 73728, GO_WF = 0, GO_QF = 16384, GO_UF = 32768, GO_AF = 49152, GO_KF = 57344;
constexpr size_t WS_ROPS = WS_GOPS + 1024 * GOPS_CH;
constexpr size_t WS_QK = WS_R2;
constexpr size_t WS_VT = WS_QK + (size_t)T * 3072 * 2;
constexpr size_t WS_OG = WS_VT + (size_t)T * 1536 * 2;
constexpr size_t WS_LSE = WS_OG + (size_t)3 * T * 512 * 2;
constexpr size_t WS_END3 = WS_LSE + (size_t)3 * T * 8 * 4;
constexpr size_t WS_YS = WS_R2;
constexpr size_t WS_H = WS_YS + (size_t)2 * T * 1024 * 2;
constexpr size_t WS_GG = WS_ROPS + (size_t)2048 * 16384;
constexpr size_t WS_END0 = WS_GG + (size_t)T * 512 * 2;
constexpr size_t WS_END1 = WS_H + (size_t)HROWS * 256 * 2;
constexpr size_t WS_END2 = WS_R2 + (size_t)T * 4608 * 2;
static_assert(WS_END3 <= WS_END0, "odd-layer regions exceed even-layer footprint");
constexpr size_t WS_END = WS_END0 > WS_END1 ? (WS_END0 > WS_END2 ? WS_END0 : WS_END2) : (WS_END1 > WS_END2 ? WS_END1 : WS_END2);

constexpr size_t WS_DUMMY = WS_END0;
struct P {
    const float* in[34];
    float* out;
    unsigned char* ws;
};
enum { I_X = 0, I_POS, I_EVNORM, I_EVWIN, I_VRESDOWN, I_EVWOUT, I_CONVW, I_ALOG, I_DTB, I_GDNNORM, I_MU, I_W0, I_W2, I_A0, I_A2, I_G2,
       I_KK, I_KA, I_RK, I_LNW, I_LNB, I_VRESMU, I_V0, I_V2, I_ODNORM, I_ODWIN, I_ODWOUT, I_FFNNORM, I_WGROUP, I_WEXPERT, I_W1, I_W3, I_MW2, I_FINAL };

DI int tidx() { int t = threadIdx.x; asm volatile("" : "+v"(t)); return t; }
DI int bidx() { int b = blockIdx.x; asm volatile("" : "+s"(b)); return b; }
typedef __bf16 bf2_t __attribute__((ext_vector_type(2)));
typedef float f2_t __attribute__((ext_vector_type(2)));
DI bf16_t f2bf(float x) { return __builtin_bit_cast(bf16_t, (__bf16)x); }
DI float bf2f(bf16_t h) { return __uint_as_float(((unsigned)h) << 16); }
DI unsigned pack2(float lo, float hi) { const f2_t v = {lo, hi}; return __builtin_bit_cast(unsigned, __builtin_convertvector(v, bf2_t)); }
DI float wave_sum(float v) {
#pragma unroll
    for (int o = 32; o > 0; o >>= 1) v += __shfl_xor(v, o);
    return v;
}
DI float wave_max(float v) {
#pragma unroll
    for (int o = 32; o > 0; o >>= 1) v = fmaxf(v, __shfl_xor(v, o));
    return v;
}
DI float sigmoidf_(float x) { return __builtin_amdgcn_rcpf(1.f + __expf(-x)); }
DI float siluf_(float x) { return x * __builtin_amdgcn_rcpf(1.f + __expf(-x)); }
DI float softplusf_(float x) { return fmaxf(x, 0.f) + __logf(1.f + __expf(-fabsf(x))); }

struct ConvJob { const float* src; bf16_t* dst; int K, N, ldd; int mode; };
DI int rowmap(int mode, int n) { return mode == 0 ? n : ((n >> 4) * 32 + (n & 15) + (mode == 2 ? 16 : 0)); }
DI void conv_tile(const ConvJob& j, int tile, float* lds  ) {
    const int ntn = (j.N + 255) / 256;
    const int tk = tile / ntn, tn = tile % ntn;
    const int tid = tidx();
    __syncthreads();
    float4 v[16];
#pragma unroll
    for (int i = 0; i < 16; ++i) {
        const int e = tid + i * 256, k = e >> 6, n4 = (e & 63) * 4;
        const int gk = tk * 64 + k, gn = tn * 256 + n4;
        v[i] = make_float4(0.f, 0.f, 0.f, 0.f);
        if (gn < j.N) v[i] = *(const float4*)(j.src + (size_t)gk * j.N + gn);
    }
#pragma unroll
    for (int i = 0; i < 16; ++i) { const int e = tid + i * 256, k = e >> 6, n4 = (e & 63) * 4; *(float4*)(lds + k * 260 + n4) = v[i]; }
    __syncthreads();
#pragma unroll
    for (int i = 0; i < 8; ++i) {
        const int e = tid + i * 256, n = e & 255, k8 = (e >> 8) * 8;
        const int gn = tn * 256 + n;
        if (gn < j.N) {
            u32x4 w;
            w.x = pack2(lds[(k8 + 0) * 260 + n], lds[(k8 + 1) * 260 + n]); w.y = pack2(lds[(k8 + 2) * 260 + n], lds[(k8 + 3) * 260 + n]);
            w.z = pack2(lds[(k8 + 4) * 260 + n], lds[(k8 + 5) * 260 + n]); w.w = pack2(lds[(k8 + 6) * 260 + n], lds[(k8 + 7) * 260 + n]);
            *(u32x4*)(j.dst + (size_t)rowmap(j.mode, gn) * j.ldd + tk * 64 + k8) = w;
        }
    }
}
DI void phase_convert_io(const P& p, int layer, char* ldsc) {
    float* lds = (float*)ldsc;
    unsigned char* W = p.ws + WS_W;
    const int li = layer >> 1;
    if ((layer & 1) == 0) {
        const ConvJob j0{p.in[I_EVWIN] + (size_t)li * 1024 * 3752, (bf16_t*)(W + W_IN), 1024, 3752, 1024, 0};
        for (int t = bidx(); t < 16 * 15; t += gridDim.x) conv_tile(j0, t, lds);
        if (li == 1) {
            const ConvJob j1{p.in[I_VRESDOWN], (bf16_t*)(W + W_IN) + (size_t)3752 * 1024, 1024, 32, 1024, 0};
            for (int t = bidx(); t < 16; t += gridDim.x) conv_tile(j1, t, lds);
        }
        const ConvJob j2{p.in[I_EVWOUT] + (size_t)li * 1024 * 1024, (bf16_t*)(W + W_OUT), 1024, 1024, 1024, 0};
        for (int t = bidx(); t < 16 * 4; t += gridDim.x) conv_tile(j2, t, lds);
        {
            bf16_t* LW = (bf16_t*)(W + W_LW);
            for (int i = bidx() * 256 + tidx(); i < 512 * 192; i += gridDim.x * 256) {
                const int ch = i / 192, j = i % 192;
                float v;
                if (j < 32) v = p.in[I_W2][((size_t)li * 32 + j) * 512 + ch];
                else if (j < 64) v = p.in[I_A2][((size_t)li * 32 + j - 32) * 512 + ch];
                else if (j < 160) v = p.in[I_G2][((size_t)li * 96 + j - 64) * 512 + ch];
                else v = (li == 1) ? p.in[I_V2][(size_t)(j - 160) * 512 + ch] : 0.f;
                LW[i] = f2bf(v);
            }
        }
        const int r0 = (li == 1) ? 3784 : 3752;
        bf16_t* z = (bf16_t*)(W + W_IN) + (size_t)r0 * 1024;
        const size_t n = (size_t)(EVPAD - r0) * 1024;
        for (size_t i = (size_t)bidx() * 256 + tidx(); i < n; i += (size_t)gridDim.x * 256) z[i] = 0;
    } else {
        const ConvJob j0{p.in[I_ODWIN] + (size_t)li * 1024 * 4608, (bf16_t*)(W + W_IN), 1024, 4608, 1024, 0};
        for (int t = bidx(); t < 16 * 18; t += gridDim.x) conv_tile(j0, t, lds);
        const ConvJob j2{p.in[I_ODWOUT] + (size_t)li * 512 * 1024, (bf16_t*)(W + W_OUT), 512, 1024, 512, 0};
        for (int t = bidx(); t < 8 * 4; t += gridDim.x) conv_tile(j2, t, lds);
    }
}
DI void phase_convert_moe(const P& p, int layer, char* ldsc, int b0, int bs) {
    float* lds = (float*)ldsc;
    unsigned char* W = p.ws + WS_W;
    for (int t = b0; t < 16 * 3 * 16; t += bs) {
        const int e = t / 48, r = t % 48, which = r / 16, tile = r % 16;
        ConvJob j;
        if (which == 0) j = ConvJob{p.in[I_W1] + ((size_t)layer * 16 + e) * 1024 * 256, (bf16_t*)(W + W_13) + (size_t)e * 512 * 1024, 1024, 256, 1024, 1};
        else if (which == 1) j = ConvJob{p.in[I_W3] + ((size_t)layer * 16 + e) * 1024 * 256, (bf16_t*)(W + W_13) + (size_t)e * 512 * 1024, 1024, 256, 1024, 2};
        else j = ConvJob{p.in[I_MW2] + ((size_t)layer * 16 + e) * 256 * 1024, (bf16_t*)(W + W_2) + (size_t)e * 1024 * 256, 256, 1024, 256, 0};
        conv_tile(j, tile, lds);
    }
}

DI void phase_rope(const P& p) {
    float2* tab = (float2*)(p.ws + WS_ROPE);
    const int* pos = (const int*)p.in[I_POS];
    for (int i = bidx() * 256 + tidx(); i < T * 32; i += gridDim.x * 256) {
        const int t = i >> 5, f = i & 31;
        const float inv = powf(10000.0f, -(float)f * (2.0f / 64.0f));
        const float ang = (float)pos[t] * inv;
        float s, c; sincosf(ang, &s, &c);
        tab[i] = make_float2(c, s);
    }
}

template <int MODE>
DI void phase_prep(const P& p, const float* gain, int layer, bool dry = false) {
    const int lane = tidx() & 63, wid = tidx() >> 6;
    const int nw = gridDim.x * 4;
    bf16_t* hn = (bf16_t*)(p.ws + WS_HN);
    const bf16_t* y0 = (const bf16_t*)(p.ws + WS_YS);
    const bf16_t* y1 = y0 + (size_t)T * 1024;
    float4 gq[4];
#pragma unroll
    for (int i = 0; i < 4; ++i) gq[i] = *(const float4*)(gain + i * 256 + lane * 4);
    for (int t = bidx() * 4 + wid; t < T; t += nw) {
        float4 v[4];
        float ss = 0.f;
#pragma unroll
        for (int i = 0; i < 4; ++i) {
            const size_t off = (size_t)t * 1024 + i * 256 + lane * 4;
            if (MODE == 0) v[i] = *(const float4*)(p.in[I_X] + off);
            else v[i] = *(const float4*)(p.out + off);
            if (MODE == 1 || MODE == 3) {
                const u32x2 a = *(const u32x2*)(y0 + off), b = *(const u32x2*)(y1 + off);
                v[i].x += __uint_as_float(a.x << 16) + __uint_as_float(b.x << 16); v[i].y += __uint_as_float(a.x & 0xffff0000u) + __uint_as_float(b.x & 0xffff0000u);
                v[i].z += __uint_as_float(a.y << 16) + __uint_as_float(b.y << 16); v[i].w += __uint_as_float(a.y & 0xffff0000u) + __uint_as_float(b.y & 0xffff0000u);
            }
            ss += v[i].x * v[i].x + v[i].y * v[i].y + v[i].z * v[i].z + v[i].w * v[i].w;
        }
        ss = wave_sum(ss);
        const float rstd = rsqrtf(ss * (1.0f / 1024.0f) + 1e-6f);
        float lg[20];
        if (MODE == 2) {
#pragma unroll
            for (int q = 0; q < 20; ++q) lg[q] = 0.f;
        }
#pragma unroll
        for (int i = 0; i < 4; ++i) {
            const int col = i * 256 + lane * 4;
            const size_t off = (size_t)t * 1024 + col;
            const float4 g = gq[i];
            float4 h; h.x = v[i].x * rstd * g.x; h.y = v[i].y * rstd * g.y; h.z = v[i].z * rstd * g.z; h.w = v[i].w * rstd * g.w;
            float* od = dry ? (float*)(p.ws + WS_DUMMY) + (off & 0x7FFFF) : p.out + off;
            bf16_t* hd = dry ? (bf16_t*)(p.ws + WS_DUMMY + 2097152) + (off & 0x7FFFF) : hn + off;
            if (MODE == 0 || MODE == 1) *(float4*)od = v[i];
            if (MODE == 3) *(float4*)od = h;
            else { u32x2 w; w.x = pack2(h.x, h.y); w.y = pack2(h.z, h.w); *(u32x2*)hd = w; }
            if (MODE == 2) {
                const float hh[4] = {h.x, h.y, h.z, h.w};
                const float* wg = p.in[I_WGROUP] + (size_t)layer * 1024 * 4;
                const float* we = p.in[I_WEXPERT] + (size_t)layer * 4 * 1024 * 4;
#pragma unroll
                for (int e = 0; e < 4; ++e) {
                    const float4 a = *(const float4*)(wg + (size_t)(col + e) * 4);
                    lg[0] += hh[e] * a.x; lg[1] += hh[e] * a.y; lg[2] += hh[e] * a.z; lg[3] += hh[e] * a.w;
#pragma unroll
                    for (int g2 = 0; g2 < 4; ++g2) {
                        const float4 b = *(const float4*)(we + ((size_t)g2 * 1024 + col + e) * 4);
                        lg[4 + g2 * 4 + 0] += hh[e] * b.x; lg[4 + g2 * 4 + 1] += hh[e] * b.y; lg[4 + g2 * 4 + 2] += hh[e] * b.z; lg[4 + g2 * 4 + 3] += hh[e] * b.w;
                    }
                }
            }
        }
        if (MODE == 2) {
#pragma unroll
            for (int q = 0; q < 20; ++q) lg[q] = wave_sum(lg[q]);
            if (lane == 0) {
                int gs = 0; float gm = lg[0];
#pragma unroll
                for (int g2 = 1; g2 < 4; ++g2) if (lg[g2] > gm) { gm = lg[g2]; gs = g2; }
                float den = 0.f;
#pragma unroll
                for (int g2 = 0; g2 < 4; ++g2) den += __expf(lg[g2] - gm);
                const float pg = 1.f / den;
                float el[4];
#pragma unroll
                for (int e = 0; e < 4; ++e) el[e] = gs == 0 ? lg[4 + e] : gs == 1 ? lg[8 + e] : gs == 2 ? lg[12 + e] : lg[16 + e];
                int i1 = 0; float v1 = el[0];
#pragma unroll
                for (int e = 1; e < 4; ++e) if (el[e] > v1) { v1 = el[e]; i1 = e; }
                int i2 = 0; float v2 = -3.4e38f;
#pragma unroll
                for (int e = 0; e < 4; ++e) if (e != i1 && el[e] > v2) { v2 = el[e]; i2 = e; }
                const float e2 = __expf(v2 - v1);
                const float g1 = pg / (1.f + e2), g2v = pg * e2 / (1.f + e2);
                unsigned* cnt = (unsigned*)(p.ws + WS_CTL + CTL_CNT) + layer * 16 * 64;
                int* list = (int*)(p.ws + WS_LIST);
                float* gl = (float*)(p.ws + WS_GATE);
                const int ea = gs * 4 + i1, eb = gs * 4 + i2;
                const unsigned ra = atomicAdd(&cnt[ea * 64], 1u);
                list[ea * 16384 + ra] = t * 2; gl[ea * 16384 + ra] = g1;
                const unsigned rb = atomicAdd(&cnt[eb * 64], 1u);
                list[eb * 16384 + rb] = t * 2 + 1; gl[eb * 16384 + rb] = g2v;
            }
        }
    }
}


DI void phase_router(const P& p, const float* gain, int layer, char* ldsc, bool dry = false) {
    const int tid = tidx(), lane = tid & 63, wid = tid >> 6;
    bf16_t* hn = (bf16_t*)(p.ws + WS_HN);
    const float* wg = p.in[I_WGROUP] + (size_t)layer * 1024 * 4;
    const float* we = p.in[I_WEXPERT] + (size_t)layer * 4 * 1024 * 4;
    unsigned* cnt = dry ? (unsigned*)(p.ws + WS_DUMMY + 3145728) : (unsigned*)(p.ws + WS_CTL + CTL_CNT) + layer * 16 * 64;
    int* list = dry ? (int*)(p.ws + WS_DUMMY) : (int*)(p.ws + WS_LIST);
    float* gl = dry ? (float*)(p.ws + WS_DUMMY + 1048576) : (float*)(p.ws + WS_GATE);
    if (dry) hn = (bf16_t*)(p.ws + WS_DUMMY + 2097152);
    f32x4* WS = (f32x4*)ldsc;
    unsigned* lcnt = (unsigned*)(ldsc + 40960); unsigned* lbase = lcnt + 16; int* e_ent = (int*)(lcnt + 32); unsigned* r_ent = (unsigned*)(e_ent + 32); int* t_ent = (int*)(r_ent + 32); float* g_ent = (float*)(t_ent + 32);
    auto stage = [&](int i, int buf) {
#pragma unroll
        for (int r = 0; r < 5; ++r) {
            const int kk = tid;
            const float* src = (r == 0 ? wg : we + (size_t)(r - 1) * 4096) + (size_t)(i * 256 + kk) * 4;
            WS[buf * 1280 + (r * 4 + (kk & 3)) * 64 + (kk >> 2)] = *(const f32x4*)src;
        }
    };
    for (int tb = bidx() * 16; tb < T; tb += gridDim.x * 16) {
        __syncthreads();
        if (tid < 16) lcnt[tid] = 0u;
        stage(0, 0);
        const int t0 = tb + wid * 4;
        float rstd[4];
#pragma unroll
        for (int q = 0; q < 4; ++q) {
            float ss = 0.f;
#pragma unroll
            for (int i = 0; i < 4; ++i) {
                const float4 x4 = *(const float4*)(p.out + (size_t)(t0 + q) * 1024 + i * 256 + lane * 4);
                ss += x4.x * x4.x + x4.y * x4.y + x4.z * x4.z + x4.w * x4.w;
            }
            ss = wave_sum(ss);
            rstd[q] = rsqrtf(ss * (1.0f / 1024.0f) + 1e-6f);
        }
        float lg[4][20];
#pragma unroll
        for (int q = 0; q < 4; ++q)
#pragma unroll
            for (int j = 0; j < 20; ++j) lg[q][j] = 0.f;
#pragma unroll 1
        for (int i = 0; i < 4; ++i) {
            __syncthreads();
            if (i + 1 < 4) stage(i + 1, (i + 1) & 1);
            const f32x4* W = WS + (i & 1) * 1280;
            const int col = i * 256 + lane * 4;
            const float4 g = *(const float4*)(gain + col);
            float hh[4][4];
#pragma unroll
            for (int q = 0; q < 4; ++q) {
                const float4 x4 = *(const float4*)(p.out + (size_t)(t0 + q) * 1024 + col);
                hh[q][0] = x4.x * rstd[q] * g.x; hh[q][1] = x4.y * rstd[q] * g.y; hh[q][2] = x4.z * rstd[q] * g.z; hh[q][3] = x4.w * rstd[q] * g.w;
                u32x2 w; w.x = pack2(hh[q][0], hh[q][1]); w.y = pack2(hh[q][2], hh[q][3]);
                *(u32x2*)(hn + (dry ? (((size_t)(t0 + q) * 1024 + col) & 0x7FFFF) : ((size_t)(t0 + q) * 1024 + col))) = w;
            }
#pragma unroll
            for (int e = 0; e < 4; ++e) {
                const f32x4 a = W[(0 * 4 + e) * 64 + lane];
#pragma unroll
                for (int q = 0; q < 4; ++q) { lg[q][0] += hh[q][e] * a[0]; lg[q][1] += hh[q][e] * a[1]; lg[q][2] += hh[q][e] * a[2]; lg[q][3] += hh[q][e] * a[3]; }
#pragma unroll
                for (int g2 = 0; g2 < 4; ++g2) {
                    const f32x4 b = W[((1 + g2) * 4 + e) * 64 + lane];
#pragma unroll
                    for (int q = 0; q < 4; ++q) { lg[q][4 + g2 * 4] += hh[q][e] * b[0]; lg[q][5 + g2 * 4] += hh[q][e] * b[1]; lg[q][6 + g2 * 4] += hh[q][e] * b[2]; lg[q][7 + g2 * 4] += hh[q][e] * b[3]; }
                }
            }
        }
#pragma unroll
        for (int q = 0; q < 4; ++q) {
#pragma unroll
            for (int j = 0; j < 20; ++j) lg[q][j] = wave_sum(lg[q][j]);
            if (lane == q) {
                const int t = t0 + q;
                int gs = 0; float gm = lg[q][0];
#pragma unroll
                for (int g2 = 1; g2 < 4; ++g2) if (lg[q][g2] > gm) { gm = lg[q][g2]; gs = g2; }
                float den = 0.f;
#pragma unroll
                for (int g2 = 0; g2 < 4; ++g2) den += __expf(lg[q][g2] - gm);
                const float pg = 1.f / den;
                float el[4];
#pragma unroll
                for (int e = 0; e < 4; ++e) el[e] = gs == 0 ? lg[q][4 + e] : gs == 1 ? lg[q][8 + e] : gs == 2 ? lg[q][12 + e] : lg[q][16 + e];
                int i1 = 0; float v1 = el[0];
#pragma unroll
                for (int e = 1; e < 4; ++e) if (el[e] > v1) { v1 = el[e]; i1 = e; }
                int i2 = 0; float v2 = -3.4e38f;
#pragma unroll
                for (int e = 0; e < 4; ++e) if (e != i1 && el[e] > v2) { v2 = el[e]; i2 = e; }
                const float e2 = __expf(v2 - v1);
                const float g1 = pg / (1.f + e2), g2v = pg * e2 / (1.f + e2);
                const int ea = gs * 4 + i1, eb = gs * 4 + i2;
                const int sl = (wid * 4 + q) * 2;
                e_ent[sl] = ea; r_ent[sl] = atomicAdd(&lcnt[ea], 1u); t_ent[sl] = t * 2; g_ent[sl] = g1;
                e_ent[sl + 1] = eb; r_ent[sl + 1] = atomicAdd(&lcnt[eb], 1u); t_ent[sl + 1] = t * 2 + 1; g_ent[sl + 1] = g2v;
            }
        }
        __syncthreads();
        if (tid < 16) lbase[tid] = lcnt[tid] ? atomicAdd(&cnt[tid * 64], lcnt[tid]) : 0u;
        __syncthreads();
        if (tid < 32) {
            const int e = e_ent[tid];
            const unsigned pos = (lbase[e] + r_ent[tid]) & 16383u;
            list[e * 16384 + pos] = t_ent[tid]; gl[e * 16384 + pos] = g_ent[tid];
        }
    }
}

constexpr int GBK = 64;
typedef __attribute__((address_space(3))) unsigned lds_u32;
struct TileP { const bf16_t* ar[4]; const bf16_t* br[4]; const bf16_t* ar2[4]; };
DI void gemm_core(const TileP& tp, int K, char* lds, f32x4 (&acc)[4][4], int ksplit, bool primed, const TileP& nx, bool have_nx) {
    const bf16_t* const (&ar)[4] = tp.ar; const bf16_t* const (&br)[4] = tp.br; const bf16_t* const (&ar2)[4] = tp.ar2;
    const int tid = tidx(), wid = tid >> 6, lane = tid & 63, wr = wid >> 1, wc = wid & 1, fr = lane & 15, fq = lane >> 4;
    const int scol = ((tid & 7) ^ ((tid >> 3) & 7)) * 8;
#pragma unroll
    for (int n = 0; n < 4; ++n)
#pragma unroll
        for (int m = 0; m < 4; ++m) acc[n][m] = (f32x4){0.f, 0.f, 0.f, 0.f};
    const int nk = K / GBK;
    if (!primed) {
        __syncthreads();
#pragma unroll
        for (int i = 0; i < 4; ++i) {
            __builtin_amdgcn_global_load_lds((const unsigned*)(ar[i] + scol), (lds_u32*)(lds + tid * 16 + i * 4096), 16, 0, 0);
            __builtin_amdgcn_global_load_lds((const unsigned*)(br[i] + scol), (lds_u32*)(lds + 16384 + tid * 16 + i * 4096), 16, 0, 0);
        }
    }
    const int sw = fr & 7;
    for (int kt = 0; kt < nk; ++kt) {
        asm volatile("s_waitcnt vmcnt(0)" ::: "memory");
        __builtin_amdgcn_s_barrier();
        if (kt + 1 < nk) {
            char* nb = lds + ((kt + 1) & 1) * 32768;
            const int ko = (kt + 1) * GBK + scol;
#pragma unroll
            for (int i = 0; i < 4; ++i) {
                __builtin_amdgcn_global_load_lds((const unsigned*)(((kt + 1) * GBK >= ksplit ? ar2[i] : ar[i]) + ko), (lds_u32*)(nb + tid * 16 + i * 4096), 16, 0, 0);
                __builtin_amdgcn_global_load_lds((const unsigned*)(br[i] + ko), (lds_u32*)(nb + 16384 + tid * 16 + i * 4096), 16, 0, 0);
            }
        } else if (have_nx) {
#pragma unroll
            for (int i = 0; i < 4; ++i) {
                __builtin_amdgcn_global_load_lds((const unsigned*)(nx.ar[i] + scol), (lds_u32*)(lds + tid * 16 + i * 4096), 16, 0, 0);
                __builtin_amdgcn_global_load_lds((const unsigned*)(nx.br[i] + scol), (lds_u32*)(lds + 16384 + tid * 16 + i * 4096), 16, 0, 0);
            }
        }
        const char* SA = lds + (kt & 1) * 32768; const char* SB = SA + 16384;
#pragma unroll
        for (int kh = 0; kh < 2; ++kh) {
            bf16x8 af[4], bfr[4];
            const int co = ((kh * 4 + fq) ^ sw) * 16;
#pragma unroll
            for (int m = 0; m < 4; ++m) af[m] = *(const bf16x8*)(SA + (wr * 64 + m * 16 + fr) * 128 + co);
#pragma unroll
            for (int n = 0; n < 4; ++n) bfr[n] = *(const bf16x8*)(SB + (wc * 64 + n * 16 + fr) * 128 + co);
#pragma unroll
            for (int n = 0; n < 4; ++n)
#pragma unroll
                for (int m = 0; m < 4; ++m) acc[n][m] = __builtin_amdgcn_mfma_f32_16x16x32_bf16(bfr[n], af[m], acc[n][m], 0, 0, 0);
        }
    }
}

enum { EPI_EVEN_IN = 0, EPI_ODD_IN, EPI_RESID };
template <int EPI>
DI void phase_gemm(const P& p, const bf16_t* A, int lda, const bf16_t* Bt, int K, int ntn, char* lds, bool dry = false, const bf16_t* A2 = nullptr, int lda2 = 0, int ksplit = 1 << 30) {
    const int tid = tidx(), wid = tid >> 6, lane = tid & 63, wr = wid >> 1, wc = wid & 1, fr = lane & 15, fq = lane >> 4;
    const int ntm = T / 128, ntiles = ntm * ntn;
    auto fill = [&](TileP& t, int tile) {
        const int tn = tile / ntm, tm = tile % ntm, r = tid >> 3;
#pragma unroll
        for (int i = 0; i < 4; ++i) { t.ar[i] = A + (size_t)(tm * 128 + r + 32 * i) * lda; t.br[i] = Bt + (size_t)(tn * 128 + r + 32 * i) * K; t.ar2[i] = A2 ? A2 + (size_t)(tm * 128 + r + 32 * i) * lda2 : t.ar[i]; }
    };
    TileP cur, nxt;
    bool primed = false;
    fill(cur, bidx() < ntiles ? bidx() : 0); nxt = cur;
    for (int tile = bidx(); tile < ntiles; tile += gridDim.x) {
        const int tn = tile / ntm, tm = tile % ntm;
        const bool have_next = tile + (int)gridDim.x < ntiles;
        if (have_next) fill(nxt, tile + gridDim.x);
        f32x4 acc[4][4];
        gemm_core(cur, K, lds, acc, ksplit, primed, nxt, have_next);
        primed = have_next; cur = nxt;
        const int m0 = tm * 128 + wr * 64, n0 = tn * 128 + wc * 64;
        if (EPI == EPI_EVEN_IN) {
            bf16_t* C = (bf16_t*)(p.ws + WS_PROJ);
#pragma unroll
            for (int m = 0; m < 4; ++m)
#pragma unroll
                for (int n = 0; n < 4; ++n) {
                    const int row = m0 + m * 16 + fr, col = n0 + n * 16 + fq * 4;
                    if (col < EVC) { u32x2 w; w.x = pack2(acc[n][m][0], acc[n][m][1]); w.y = pack2(acc[n][m][2], acc[n][m][3]); *(u32x2*)(C + (size_t)row * EVLD + col) = w; }
                }
        } else if (EPI == EPI_ODD_IN) {
            bf16_t* C = (bf16_t*)(p.ws + WS_QK);
            const float2* tab = (const float2*)(p.ws + WS_ROPE);
            if (n0 < 3072) {
#pragma unroll
                for (int m = 0; m < 4; ++m) {
                    const int row = m0 + m * 16 + fr;
#pragma unroll
                    for (int n = 0; n < 2; ++n) {
                        float lo[4], hi[4];
#pragma unroll
                        for (int j = 0; j < 4; ++j) {
                            const float2 cs = tab[(size_t)row * 32 + n * 16 + fq * 4 + j];
                            const float x1 = acc[n][m][j], x2 = acc[n + 2][m][j];
                            lo[j] = x1 * cs.x - x2 * cs.y; hi[j] = x2 * cs.x + x1 * cs.y;
                        }
                        u32x2 w; w.x = pack2(lo[0], lo[1]); w.y = pack2(lo[2], lo[3]);
                        *(u32x2*)(C + (size_t)row * 3072 + n0 + n * 16 + fq * 4) = w;
                        w.x = pack2(hi[0], hi[1]); w.y = pack2(hi[2], hi[3]);
                        *(u32x2*)(C + (size_t)row * 3072 + n0 + (n + 2) * 16 + fq * 4) = w;
                    }
                }
            }
            if (tn * 128 >= 3072) {
                bf16_t* VT = (bf16_t*)(p.ws + WS_VT);
                const int hg0 = (tn * 128 - 3072) >> 6, g = hg0 >> 3, lg2 = g * 2, dil = 1 << lg2, L = SEQ >> lg2, run = 128 >> lg2;
                __syncthreads();
#pragma unroll
                for (int m = 0; m < 4; ++m)
#pragma unroll
                    for (int n = 0; n < 4; ++n)
#pragma unroll
                        for (int j = 0; j < 4; ++j)
                            *(bf16_t*)(lds + 32768 + (wc * 64 + n * 16 + fq * 4 + j) * 272 + (wr * 64 + m * 16 + fr) * 2) = f2bf(acc[n][m][j]);
                __syncthreads();
                const int bb = (tm * 128) >> 12, s0 = (tm * 128) & (SEQ - 1);
#pragma unroll
                for (int q = 0; q < 8; ++q) {
                    const int item = tid + q * 256, dim = item >> 4, o0 = (item & 15) * 8;
                    const int rr = o0 / run, i0 = o0 % run;
                    const char* src = lds + 32768 + dim * 272 + (rr + dil * i0) * 2;
                    float e8[8];
#pragma unroll
                    for (int e = 0; e < 8; ++e) e8[e] = bf2f(*(const bf16_t*)(src + e * dil * 2));
                    u32x4 w; w.x = pack2(e8[0], e8[1]); w.y = pack2(e8[2], e8[3]); w.z = pack2(e8[4], e8[5]); w.w = pack2(e8[6], e8[7]);
                    const int hg = hg0 + (dim >> 6);
                    *(u32x4*)(VT + ((size_t)((bb * 24 + hg) * dil + rr) * 64 + (dim & 63)) * L + (s0 >> lg2) + i0) = w;
                }
            }
        } else {
#pragma unroll
            for (int m = 0; m < 4; ++m)
#pragma unroll
                for (int n = 0; n < 4; ++n) {
                    const size_t qo = (size_t)(m0 + m * 16 + fr) * 1024 + n0 + n * 16 + fq * 4;
                    float* q = dry ? (float*)(p.ws + WS_DUMMY) + (qo & 0x7FFFF) : p.out + qo;
                    float4 v = *(float4*)q;
                    v.x += acc[n][m][0]; v.y += acc[n][m][1]; v.z += acc[n][m][2]; v.w += acc[n][m][3];
                    *(float4*)q = v;
                }
        }
    }
}

DI void phase_moe_up(const P& p, int layer, char* lds) {
    const int tid = tidx(), wid = tid >> 6, lane = tid & 63, wr = wid >> 1, wc = wid & 1, fr = lane & 15, fq = lane >> 4;
    const unsigned* cntb = (const unsigned*)(p.ws + WS_CTL + CTL_CNT) + layer * 16 * 64;
    unsigned cnt[16];
#pragma unroll
    for (int e = 0; e < 16; ++e) cnt[e] = cntb[e * 64];
    const int* list = (const int*)(p.ws + WS_LIST);
    const float* gl = (const float*)(p.ws + WS_GATE);
    const bf16_t* hn = (const bf16_t*)(p.ws + WS_HN);
    const bf16_t* W13 = (const bf16_t*)(p.ws + WS_W + W_13);
    bf16_t* H = (bf16_t*)(p.ws + WS_H);
    int ttot = 0;
#pragma unroll
    for (int e = 0; e < 16; ++e) ttot += ((int)cnt[e] + 127) >> 7;
    const int ntiles = ttot * 4;
    auto locate = [&](int tile, int& e, int& lt, int& ce, int& rbe, int& tn) {
        const int mt = tile >> 2; tn = tile & 3;
        int tbe = 0, acc_t = 0; e = 0;
#pragma unroll
        for (int q = 0; q < 16; ++q) { const int nt = ((int)cnt[q] + 127) >> 7; if (mt >= acc_t) { e = q; tbe = acc_t; } acc_t += nt; }
        lt = mt - tbe; ce = (int)cnt[e]; rbe = tbe * 128;
    };
    auto fill = [&](TileP& t, int tile) {
        int e, lt, ce, rbe, tn; locate(tile, e, lt, ce, rbe, tn);
        const int r = tid >> 3;
#pragma unroll
        for (int i = 0; i < 4; ++i) {
            const int ii = lt * 128 + r + 32 * i;
            const int tk = ii < ce ? (list[e * 16384 + ii] >> 1) : 0;
            t.ar[i] = hn + (size_t)tk * 1024; t.ar2[i] = t.ar[i];
            t.br[i] = W13 + ((size_t)e * 512 + tn * 128 + r + 32 * i) * 1024;
        }
    };
    TileP cur, nxt;
    bool primed = false;
    fill(cur, bidx() < ntiles ? bidx() : 0); nxt = cur;
    for (int tile = bidx(); tile < ntiles; tile += gridDim.x) {
        int e, lt, ce, rbe, tn; locate(tile, e, lt, ce, rbe, tn);
        const bool have_next = tile + (int)gridDim.x < ntiles;
        if (have_next) fill(nxt, tile + gridDim.x);
        f32x4 acc[4][4];
        gemm_core(cur, 1024, lds, acc, 1 << 30, primed, nxt, have_next);
        primed = have_next; cur = nxt;
#pragma unroll
        for (int m = 0; m < 4; ++m) {
            const int li = lt * 128 + wr * 64 + m * 16 + fr;
            if (li < ce) {
                const float g = gl[e * 16384 + li];
                bf16_t* hrow = H + (size_t)(rbe + li) * 256;
#pragma unroll
                for (int n = 0; n < 4; n += 2) {
                    float o[4];
#pragma unroll
                    for (int j = 0; j < 4; ++j) o[j] = siluf_(acc[n][m][j]) * acc[n + 1][m][j] * g;
                    const int f = tn * 64 + wc * 32 + (n >> 1) * 16 + fq * 4;
                    u32x2 w; w.x = pack2(o[0], o[1]); w.y = pack2(o[2], o[3]);
                    *(u32x2*)(hrow + f) = w;
                }
            }
        }
    }
}
DI void phase_moe_down(const P& p, int layer, char* lds) {
    const int tid = tidx(), wid = tid >> 6, lane = tid & 63, wr = wid >> 1, wc = wid & 1, fr = lane & 15, fq = lane >> 4;
    const unsigned* cntb = (const unsigned*)(p.ws + WS_CTL + CTL_CNT) + layer * 16 * 64;
    unsigned cnt[16];
#pragma unroll
    for (int e = 0; e < 16; ++e) cnt[e] = cntb[e * 64];
    const int* list = (const int*)(p.ws + WS_LIST);
    const bf16_t* W2 = (const bf16_t*)(p.ws + WS_W + W_2);
    const bf16_t* H = (const bf16_t*)(p.ws + WS_H);
    bf16_t* ys = (bf16_t*)(p.ws + WS_YS);
    int ttot = 0;
#pragma unroll
    for (int e = 0; e < 16; ++e) ttot += ((int)cnt[e] + 127) >> 7;
    const int ntiles = ttot * 8;
    auto locate = [&](int tile, int& e, int& lt, int& ce, int& rbe, int& tn) {
        const int mt = tile >> 3; tn = tile & 7;
        int tbe = 0, acc_t = 0; e = 0;
#pragma unroll
        for (int q = 0; q < 16; ++q) { const int nt = ((int)cnt[q] + 127) >> 7; if (mt >= acc_t) { e = q; tbe = acc_t; } acc_t += nt; }
        lt = mt - tbe; ce = (int)cnt[e]; rbe = tbe * 128;
    };
    auto fill = [&](TileP& t, int tile) {
        int e, lt, ce, rbe, tn; locate(tile, e, lt, ce, rbe, tn);
        const int r = tid >> 3;
#pragma unroll
        for (int i = 0; i < 4; ++i) { t.ar[i] = H + (size_t)(rbe + lt * 128 + r + 32 * i) * 256; t.ar2[i] = t.ar[i]; t.br[i] = W2 + ((size_t)e * 1024 + tn * 128 + r + 32 * i) * 256; }
    };
    TileP cur, nxt;
    bool primed = false;
    fill(cur, bidx() < ntiles ? bidx() : 0); nxt = cur;
    for (int tile = bidx(); tile < ntiles; tile += gridDim.x) {
        int e, lt, ce, rbe, tn; locate(tile, e, lt, ce, rbe, tn);
        const bool have_next = tile + (int)gridDim.x < ntiles;
        if (have_next) fill(nxt, tile + gridDim.x);
        f32x4 acc[4][4];
        gemm_core(cur, 256, lds, acc, 1 << 30, primed, nxt, have_next);
        primed = have_next; cur = nxt;
#pragma unroll
        for (int m = 0; m < 4; ++m) {
            const int li = lt * 128 + wr * 64 + m * 16 + fr;
            if (li < ce) {
                const int ts = list[e * 16384 + li];
                bf16_t* yrow = ys + ((size_t)(ts & 1) * T + (ts >> 1)) * 1024 + tn * 128 + wc * 64 + fq * 4;
#pragma unroll
                for (int n = 0; n < 4; ++n) { u32x2 w; w.x = pack2(acc[n][m][0], acc[n][m][1]); w.y = pack2(acc[n][m][2], acc[n][m][3]); *(u32x2*)(yrow + n * 16) = w; }
            }
        }
    }
}


typedef float f32x16 __attribute__((ext_vector_type(16)));
DI f32x4 mfma16(bf16x8 a, bf16x8 b, f32x4 c) { return __builtin_amdgcn_mfma_f32_16x16x32_bf16(a, b, c, 0, 0, 0); }
DI f32x16 mfma32(bf16x8 a, bf16x8 b, f32x16 c) { return __builtin_amdgcn_mfma_f32_32x32x16_bf16(a, b, c, 0, 0, 0); }
DI f32x4 tile16(const char* X, int ldx, int row0, const char* Y, int ldy, int col0, int K) {
    const int lane = tidx() & 63, fr = lane & 15, fq = lane >> 4;
    f32x4 acc = {0.f, 0.f, 0.f, 0.f};
#pragma unroll
    for (int k = 0; k < K; k += 32) {
        const bf16x8 a = *(const bf16x8*)(X + (row0 + fr) * ldx + (k + fq * 8) * 2);
        const bf16x8 b = *(const bf16x8*)(Y + (col0 + fr) * ldy + (k + fq * 8) * 2);
        acc = mfma16(a, b, acc);
    }
    return acc;
}
DI bf16x8 pack_step(const f32x16& x, int s) {
    u32x4 r;
    r.x = pack2(x[8 * s + 0], x[8 * s + 1]); r.y = pack2(x[8 * s + 2], x[8 * s + 3]);
    r.z = pack2(x[8 * s + 4], x[8 * s + 5]); r.w = pack2(x[8 * s + 6], x[8 * s + 7]);
    return __builtin_bit_cast(bf16x8, r);
}

constexpr int GP_LF = 0, GP_T = 17408, GP_VEC = GP_T + 9216, GP_U = GP_VEC + 1024, GP_END = GP_U + 36864;
DI void gdn_prep_unit(const P& p, int li, int ch, char* lds) {
    const int tid = tidx(), lane = tid & 63, wid = tid >> 6, fr = lane & 15, fq = lane >> 4;
    const int h = ch & 3, n = (ch >> 2) & 63, b = ch >> 8;
    const int t0 = b * SEQ + n * 64;
    float* Lf = (float*)(lds + GP_LF);
    char* Trow = lds + GP_T;
    float* gcs = (float*)(lds + GP_VEC); float* egc = gcs + 64; float* bet = gcs + 128; float* ekd = gcs + 192;
    char* Qrow = lds + GP_U; char* Krow = Qrow + 17408; char* VbT = lds + GP_U; char* KbgT = VbT + 18432;
    const bf16_t* proj = (const bf16_t*)(p.ws + WS_PROJ);
    unsigned char* ops = p.ws + WS_GOPS + (size_t)ch * GOPS_CH;
    const float* cw = p.in[I_CONVW] + (size_t)li * 4 * 1536;
    const int c = tid >> 2, cq = tid & 3;
    __syncthreads();
    float* cwl = (float*)(lds + GP_END);
    for (int i = tid; i < 4 * 3 * 32; i += 256) {
        const int j = i / 96, r = i % 96, sl = r >> 5, q4 = (r & 31) * 4;
        *(f32x4*)(cwl + (j * 3 + sl) * 128 + q4) = *(const f32x4*)(cw + j * 1536 + sl * 512 + h * 128 + q4);
    }
    __syncthreads();
    unsigned vvp[16];
#pragma unroll 1
    for (int which = 0; which < 3; ++which) {
        const int col0 = which * 512 + h * 128 + cq * 32;
        u32x4 xin[4][4];
#pragma unroll
        for (int j = 0; j < 4; ++j) {
            const int sp = n * 64 + c - 3 + j;
            const bf16_t* src = proj + (size_t)(b * SEQ + (sp < 0 ? 0 : sp)) * EVLD + col0;
#pragma unroll
            for (int i4 = 0; i4 < 4; ++i4) xin[j][i4] = *(const u32x4*)(src + i4 * 8);
        }
        float acc[32];
#pragma unroll
        for (int i = 0; i < 32; ++i) acc[i] = 0.f;
#pragma unroll
        for (int j = 0; j < 4; ++j) {
            const float ok = (n * 64 + c - 3 + j) >= 0 ? 1.f : 0.f;
            const float* wj = cwl + (j * 3 + which) * 128 + cq * 32;
#pragma unroll
            for (int i4 = 0; i4 < 4; ++i4) {
                const f32x4 wa = *(const f32x4*)(wj + i4 * 8), wb = *(const f32x4*)(wj + i4 * 8 + 4);
                const u32x4 w = xin[j][i4];
                acc[i4 * 8 + 0] += ok * wa[0] * __uint_as_float(w[0] << 16); acc[i4 * 8 + 1] += ok * wa[1] * __uint_as_float(w[0] & 0xffff0000u);
                acc[i4 * 8 + 2] += ok * wa[2] * __uint_as_float(w[1] << 16); acc[i4 * 8 + 3] += ok * wa[3] * __uint_as_float(w[1] & 0xffff0000u);
                acc[i4 * 8 + 4] += ok * wb[0] * __uint_as_float(w[2] << 16); acc[i4 * 8 + 5] += ok * wb[1] * __uint_as_float(w[2] & 0xffff0000u);
                acc[i4 * 8 + 6] += ok * wb[2] * __uint_as_float(w[3] << 16); acc[i4 * 8 + 7] += ok * wb[3] * __uint_as_float(w[3] & 0xffff0000u);
            }
        }
        float ss = 0.f;
#pragma unroll
        for (int i = 0; i < 32; ++i) { acc[i] = siluf_(acc[i]); ss += acc[i] * acc[i]; }
        ss += __shfl_xor(ss, 1); ss += __shfl_xor(ss, 2);
        const float rn = which == 2 ? 1.f : rsqrtf(ss + 1e-6f) * (which == 0 ? 0.08838834764831845f : 1.f);
        unsigned pk[16];
#pragma unroll
        for (int i = 0; i < 16; ++i) pk[i] = pack2(acc[2 * i] * rn, acc[2 * i + 1] * rn);
        if (which < 2) {
            char* img = which == 0 ? Qrow : Krow;
#pragma unroll
            for (int i4 = 0; i4 < 4; ++i4) { u32x4 w; w.x = pk[i4 * 4]; w.y = pk[i4 * 4 + 1]; w.z = pk[i4 * 4 + 2]; w.w = pk[i4 * 4 + 3]; *(u32x4*)(img + c * 272 + (cq * 32 + i4 * 8) * 2) = w; }
        } else {
#pragma unroll
            for (int i = 0; i < 16; ++i) vvp[i] = pk[i];
        }
    }
    if (cq == 0) {
        const float a = bf2f(proj[(size_t)(t0 + c) * EVLD + 2048 + h]);
        const float bb = bf2f(proj[(size_t)(t0 + c) * EVLD + 2052 + h]);
        const float Aexp = __expf(p.in[I_ALOG][li * 4 + h]), dtb = p.in[I_DTB][li * 4 + h];
        gcs[c] = -Aexp * softplusf_(a + dtb);
        bet[c] = sigmoidf_(bb);
    }
    __syncthreads();
    if (wid == 0) {
        float x = gcs[lane];
#pragma unroll
        for (int o = 1; o < 64; o <<= 1) { const float y = __shfl_up(x, o); if (lane >= o) x += y; }
        const float gl = __shfl(x, 63);
        gcs[lane] = x; egc[lane] = __expf(x); ekd[lane] = __expf(gl - x);
        if (lane == 63) ((float*)(p.ws + WS_CTL + CTL_EGL))[ch] = __expf(gl);
    }
    __syncthreads();
    {
        const int ti = wid;
#pragma unroll
        for (int tj = 0; tj < 4; ++tj) {
            if (tj <= ti) {
                const f32x4 kk = tile16(Krow, 272, 16 * ti, Krow, 272, 16 * tj, 128);
                const int c2 = 16 * tj + fr;
                f32x4 lv;
#pragma unroll
                for (int r = 0; r < 4; ++r) {
                    const int c1 = 16 * ti + fq * 4 + r;
                    lv[r] = (c1 > c2) ? bet[c1] * kk[r] * __expf(gcs[c1] - gcs[c2]) : 0.f;
                }
                *(f32x4*)&Lf[c2 * 68 + 16 * ti + fq * 4] = lv;
            }
            f32x4 qk = {0.f, 0.f, 0.f, 0.f};
            if (tj <= ti) qk = tile16(Krow, 272, 16 * tj, Qrow, 272, 16 * ti, 128);
            const int c1 = 16 * ti + fr;
            float o4[4];
#pragma unroll
            for (int r = 0; r < 4; ++r) { const int c2 = 16 * tj + fq * 4 + r; o4[r] = (c1 >= c2) ? qk[r] * __expf(gcs[c1] - gcs[c2]) : 0.f; }
            const int mt = c1 >> 5, rr = c1 & 31, hh = fq & 1, jg = fq >> 1;
            u32x2 w; w.x = pack2(o4[0], o4[1]); w.y = pack2(o4[2], o4[3]);
            *(u32x2*)(ops + GO_AF + ((size_t)((mt * 4 + tj) * 64 + hh * 32 + rr) * 8 + jg * 4) * 2) = w;
        }
#pragma unroll
        for (int i = 0; i < 4; ++i) {
            const int idx = tid + i * 256;
            {
                const int mt = idx >> 9, ks = (idx >> 6) & 7, l2 = idx & 63, rr = l2 & 31, hh = l2 >> 5, cc = 32 * mt + rr;
                const float sc = egc[cc];
                const u32x2 lo = *(const u32x2*)(Qrow + cc * 272 + (16 * ks + 4 * hh) * 2), hi = *(const u32x2*)(Qrow + cc * 272 + (16 * ks + 8 + 4 * hh) * 2);
                u32x4 w;
                w.x = pack2(__uint_as_float(lo.x << 16) * sc, __uint_as_float(lo.x & 0xffff0000u) * sc); w.y = pack2(__uint_as_float(lo.y << 16) * sc, __uint_as_float(lo.y & 0xffff0000u) * sc);
                w.z = pack2(__uint_as_float(hi.x << 16) * sc, __uint_as_float(hi.x & 0xffff0000u) * sc); w.w = pack2(__uint_as_float(hi.y << 16) * sc, __uint_as_float(hi.y & 0xffff0000u) * sc);
                *(u32x4*)(ops + GO_QF + (size_t)idx * 16) = w;
            }
            {
                const int mt = idx >> 8, ks = (idx >> 6) & 3, l2 = idx & 63, rr = l2 & 31, hh = l2 >> 5, dk = 32 * mt + rr;
                float e8[8];
#pragma unroll
                for (int j = 0; j < 8; ++j) { const int c2 = 16 * ks + 8 * (j >> 2) + 4 * hh + (j & 3); e8[j] = bf2f(*(const bf16_t*)(Krow + c2 * 272 + dk * 2)) * ekd[c2]; }
                u32x4 w; w.x = pack2(e8[0], e8[1]); w.y = pack2(e8[2], e8[3]); w.z = pack2(e8[4], e8[5]); w.w = pack2(e8[6], e8[7]);
                *(u32x4*)(ops + GO_KF + (size_t)idx * 16) = w;
            }
        }
    }
    __syncthreads();
    {
        const float bc = bet[c], bg = bc * egc[c];
        unsigned kvp[16];
#pragma unroll
        for (int i4 = 0; i4 < 4; ++i4) { const u32x4 w = *(const u32x4*)(Krow + c * 272 + (cq * 32 + i4 * 8) * 2); kvp[i4 * 4] = w.x; kvp[i4 * 4 + 1] = w.y; kvp[i4 * 4 + 2] = w.z; kvp[i4 * 4 + 3] = w.w; }
        __syncthreads();
#pragma unroll
        for (int i = 0; i < 16; ++i) {
            *(bf16_t*)(VbT + (cq * 32 + 2 * i) * 144 + c * 2) = f2bf(__uint_as_float(vvp[i] << 16) * bc);
            *(bf16_t*)(VbT + (cq * 32 + 2 * i + 1) * 144 + c * 2) = f2bf(__uint_as_float(vvp[i] & 0xffff0000u) * bc);
            *(bf16_t*)(KbgT + (cq * 32 + 2 * i) * 144 + c * 2) = f2bf(__uint_as_float(kvp[i] << 16) * bg);
            *(bf16_t*)(KbgT + (cq * 32 + 2 * i + 1) * 144 + c * 2) = f2bf(__uint_as_float(kvp[i] & 0xffff0000u) * bg);
        }
    }
    {
        char* L21i = lds + GP_END;
        char* T11T = L21i + 2560;
        char* MT = T11T + 2560;
        if (wid < 2) {
            const int o = 32 * wid;
            float Tc[32];
#pragma unroll
            for (int i = 0; i < 32; ++i) Tc[i] = (i == (lane & 31)) ? 1.f : 0.f;
#pragma unroll
            for (int j = 0; j < 31; ++j) {
                const float tj = Tc[j];
#pragma unroll
                for (int i4 = (j + 1) >> 2; i4 < 8; ++i4) {
                    const f32x4 l4 = *(const f32x4*)&Lf[(o + j) * 68 + o + i4 * 4];
#pragma unroll
                    for (int e = 0; e < 4; ++e) if (i4 * 4 + e > j) Tc[i4 * 4 + e] -= l4[e] * tj;
                }
            }
            if (lane < 32) {
#pragma unroll
                for (int i = 0; i < 32; ++i) *(bf16_t*)(Trow + (o + i) * 144 + (o + lane) * 2) = f2bf(Tc[i]);
                if (wid == 0) {
#pragma unroll
                    for (int i = 0; i < 32; ++i) *(bf16_t*)(Trow + i * 144 + (32 + lane) * 2) = 0;
#pragma unroll
                    for (int i4 = 0; i4 < 8; ++i4) { u32x2 w; w.x = pack2(Tc[i4 * 4], Tc[i4 * 4 + 1]); w.y = pack2(Tc[i4 * 4 + 2], Tc[i4 * 4 + 3]); *(u32x2*)(T11T + lane * 80 + i4 * 8) = w; }
                }
            }
        } else {
            const int t2 = tid - 128;
#pragma unroll
            for (int g2 = 0; g2 < 2; ++g2) {
                const int i = t2 & 31, k4 = ((t2 >> 5) + 4 * g2) * 4;
                u32x2 w;
                w.x = pack2(Lf[(k4 + 0) * 68 + 32 + i], Lf[(k4 + 1) * 68 + 32 + i]); w.y = pack2(Lf[(k4 + 2) * 68 + 32 + i], Lf[(k4 + 3) * 68 + 32 + i]);
                *(u32x2*)(L21i + i * 80 + k4 * 2) = w;
            }
        }
        __syncthreads();
        {
            const int r0 = 16 * (wid >> 1), c0 = 16 * (wid & 1);
            const f32x4 mm = tile16(L21i, 80, r0, T11T, 80, c0, 32);
            u32x2 w; w.x = pack2(mm[0], mm[1]); w.y = pack2(mm[2], mm[3]);
            *(u32x2*)(MT + (c0 + fr) * 80 + (r0 + 4 * fq) * 2) = w;
        }
        __syncthreads();
        {
            const int r0 = 16 * (wid >> 1), c0 = 16 * (wid & 1);
            const f32x4 tt = tile16(MT, 80, c0, Trow + 32 * 144 + 64, 144, r0, 32);
            u32x2 w; w.x = pack2(-tt[0], -tt[1]); w.y = pack2(-tt[2], -tt[3]);
            *(u32x2*)(Trow + (32 + r0 + fr) * 144 + (c0 + 4 * fq) * 2) = w;
        }
    }
    __syncthreads();
#pragma unroll
    for (int tq = 0; tq < 2; ++tq) {
        const int tj = wid * 2 + tq;
#pragma unroll
        for (int ti = 0; ti < 4; ++ti) {
            const f32x4 u = tile16(Trow, 144, 16 * ti, VbT, 144, 16 * tj, 64);
            {
                const int dv = 16 * tj + fr, slice = dv >> 5, rr = dv & 31, cb = 16 * ti + fq * 4, mt = cb >> 5, q4 = (cb & 31) >> 2, hh = q4 & 1, rg = q4 >> 1;
                u32x2 w; w.x = pack2(u[0], u[1]); w.y = pack2(u[2], u[3]);
                *(u32x2*)(ops + GO_UF + ((size_t)((slice * 2 + mt) * 64 + hh * 32 + rr) * 16 + rg * 4) * 2) = w;
            }
            const f32x4 wv = tile16(KbgT, 144, 16 * tj, Trow, 144, 16 * ti, 64);
            {
                const int c1 = 16 * ti + fr, mt = c1 >> 5, rr = c1 & 31, hh = fq & 1, jg = fq >> 1;
                u32x2 w; w.x = pack2(wv[0], wv[1]); w.y = pack2(wv[2], wv[3]);
                *(u32x2*)(ops + GO_WF + ((size_t)((mt * 8 + tj) * 64 + hh * 32 + rr) * 8 + jg * 4) * 2) = w;
            }
        }
    }
}

DI void glds16(const void* g, char* l) { __builtin_amdgcn_global_load_lds((const unsigned*)g, (lds_u32*)l, 16, 0, 0); }
#define GS_WAIT(n) asm volatile("s_waitcnt vmcnt(" #n ")" ::: "memory")
DI void gdn_scan_block(const P& p, int bh, char* lds, bool dry = false) {
    const int tid = tidx(), lane = tid & 63, w = tid >> 6;
    const int h = bh & 3, b = bh >> 2;
    const float eglv = ((const float*)(p.ws + WS_CTL + CTL_EGL))[(b * 64 + lane) * 4 + h];
    unsigned char* gbase = p.ws + WS_GOPS + (size_t)(b * 256 + h) * GOPS_CH;
    constexpr int NST = 64 * 9;
    f32x16 S[4];
#pragma unroll
    for (int i = 0; i < 4; ++i)
#pragma unroll
        for (int r = 0; r < 16; ++r) S[i][r] = 0.f;
    __syncthreads();
#pragma unroll
    for (int j = 0; j < 8; ++j) { const unsigned char* src = gbase + j * 8192 + tid * 16; char* dst = lds + j * 8192 + tid * 16; glds16(src, dst); glds16(src + 4096, dst + 4096); }
#pragma unroll 1
    for (int n = 0; n < 64; ++n) {
        const float egl = __shfl(eglv, n);
        bf16x8 Sb[8];
#pragma unroll
        for (int i = 0; i < 4; ++i) { Sb[i * 2] = pack_step(S[i], 0); Sb[i * 2 + 1] = pack_step(S[i], 1); }
        f32x16 av[2], ao[2];
        bf16x8 Vb[4];
#pragma unroll
        for (int k = 0; k < 9; ++k) {
            const int j = n * 9 + k;
            if (n < 63 || k <= 1) GS_WAIT(14); else if (k == 2) GS_WAIT(12); else if (k == 3) GS_WAIT(10); else if (k == 4) GS_WAIT(8); else if (k == 5) GS_WAIT(6);
            else if (k == 6) GS_WAIT(4); else if (k == 7) GS_WAIT(2); else GS_WAIT(0);
            __builtin_amdgcn_s_barrier();
            if (j + 8 < NST) {
                const int k8 = (k + 8) % 9, n8 = (k == 0) ? n : n + 1;
                const unsigned char* src = gbase + (size_t)n8 * 4 * GOPS_CH + k8 * 8192 + tid * 16;
                char* dst = lds + k8 * 8192 + tid * 16;
                glds16(src, dst); glds16(src + 4096, dst + 4096);
            }
            __builtin_amdgcn_sched_barrier(0);
            const char* sl = lds + k * 8192;
            const bf16x8* fr = (const bf16x8*)sl + lane;
            if (k < 2) {
#pragma unroll
                for (int r = 0; r < 16; ++r) av[k][r] = 0.f;
                bf16x8 f8[8];
#pragma unroll
                for (int ks = 0; ks < 8; ++ks) f8[ks] = fr[ks * 64];
                __builtin_amdgcn_sched_barrier(0);
#pragma unroll
                for (int ks = 0; ks < 8; ++ks) av[k] = mfma32(f8[ks], Sb[ks], av[k]);
            } else if (k < 4) {
#pragma unroll
                for (int r = 0; r < 16; ++r) ao[k - 2][r] = 0.f;
                bf16x8 f8[8];
#pragma unroll
                for (int ks = 0; ks < 8; ++ks) f8[ks] = fr[ks * 64];
                __builtin_amdgcn_sched_barrier(0);
#pragma unroll
                for (int ks = 0; ks < 8; ++ks) ao[k - 2] = mfma32(f8[ks], Sb[ks], ao[k - 2]);
            } else if (k < 6) {
                if ((w >> 1) == (k - 4)) {
#pragma unroll
                    for (int mt = 0; mt < 2; ++mt) {
                        const u32x4* up = (const u32x4*)(sl + ((w & 1) * 2 + mt) * 2048 + lane * 32);
                        const u32x4 u0 = up[0], u1 = up[1];
#pragma unroll
                        for (int e = 0; e < 4; ++e) {
                            av[mt][e * 2] = __uint_as_float(u0[e] << 16) - av[mt][e * 2]; av[mt][e * 2 + 1] = __uint_as_float(u0[e] & 0xffff0000u) - av[mt][e * 2 + 1];
                            av[mt][8 + e * 2] = __uint_as_float(u1[e] << 16) - av[mt][8 + e * 2]; av[mt][8 + e * 2 + 1] = __uint_as_float(u1[e] & 0xffff0000u) - av[mt][8 + e * 2 + 1];
                        }
                    }
                }
            } else if (k == 6) {
#pragma unroll
                for (int mt = 0; mt < 2; ++mt) { Vb[mt * 2] = pack_step(av[mt], 0); Vb[mt * 2 + 1] = pack_step(av[mt], 1); }
                bf16x8 f6[6];
#pragma unroll
                for (int ks = 0; ks < 2; ++ks) f6[ks] = fr[ks * 64];
#pragma unroll
                for (int ks = 0; ks < 4; ++ks) f6[2 + ks] = fr[(4 + ks) * 64];
                __builtin_amdgcn_sched_barrier(0);
#pragma unroll
                for (int ks = 0; ks < 4; ++ks) { if (ks < 2) ao[0] = mfma32(f6[ks], Vb[ks], ao[0]); ao[1] = mfma32(f6[2 + ks], Vb[ks], ao[1]); }
            } else {
                bf16x8 f8[8];
#pragma unroll
                for (int q = 0; q < 8; ++q) f8[q] = fr[q * 64];
#pragma unroll
                for (int i2 = 0; i2 < 2; ++i2) {
                    const int i = (k - 7) * 2 + i2;
#pragma unroll
                    for (int r = 0; r < 16; ++r) S[i][r] *= egl;
                }
                __builtin_amdgcn_sched_barrier(0);
#pragma unroll
                for (int ks = 0; ks < 4; ++ks)
#pragma unroll
                    for (int i2 = 0; i2 < 2; ++i2) S[(k - 7) * 2 + i2] = mfma32(f8[i2 * 4 + ks], Vb[ks], S[(k - 7) * 2 + i2]);
                if (k == 8) {
                    u32x4* Of = (u32x4*)((dry ? p.ws + WS_DUMMY + (size_t)(bh & 15) * 65536 : gbase + (size_t)n * 4 * GOPS_CH) + GO_UF) + (size_t)(w * 2 * 64 + lane) * 2;
#pragma unroll
                    for (int mt = 0; mt < 2; ++mt) {
                        u32x4 o0, o1;
#pragma unroll
                        for (int e = 0; e < 4; ++e) { o0[e] = pack2(ao[mt][e * 2], ao[mt][e * 2 + 1]); o1[e] = pack2(ao[mt][8 + e * 2], ao[mt][8 + e * 2 + 1]); }
                        Of[mt * 128] = o0; Of[mt * 128 + 1] = o1;
                    }
                }
            }
        }
    }
    __syncthreads();
}

DI void gdn_post_unit(const P& p, int li, int ch) {
    const int tid = tidx();
    const int h = ch & 3, n = (ch >> 2) & 63, b = ch >> 8;
    const int t0 = b * SEQ + n * 64;
    const int c = tid >> 2, cq = tid & 3;
    const bf16_t* Of = (const bf16_t*)(p.ws + WS_GOPS + (size_t)ch * GOPS_CH + GO_UF);
    const bf16_t* proj = (const bf16_t*)(p.ws + WS_PROJ);
    bf16_t* mix = (bf16_t*)(p.ws + WS_PROJ);
    const float* nw = p.in[I_GDNNORM] + li * 128 + cq * 32;
    const int mt = c >> 5, q4 = (c & 31) >> 2, hh = q4 & 1, rg = q4 >> 1, reg = rg * 4 + (c & 3);
    float o[32]; float ss = 0.f;
#pragma unroll
    for (int r = 0; r < 32; ++r) { o[r] = bf2f(Of[(size_t)((cq * 2 + mt) * 64 + hh * 32 + r) * 16 + reg]); ss += o[r] * o[r]; }
    ss += __shfl_xor(ss, 1); ss += __shfl_xor(ss, 2);
    const float rs = rsqrtf(ss * (1.f / 128.f) + 1e-6f);
    const bf16_t* zp = proj + (size_t)(t0 + c) * EVLD + 1536 + h * 128 + cq * 32;
    bf16_t* mp = mix + (size_t)(t0 + c) * EVLD + h * 128 + cq * 32;
#pragma unroll
    for (int i4 = 0; i4 < 4; ++i4) {
        const u32x4 zw = *(const u32x4*)(zp + i4 * 8);
        u32x4 w;
#pragma unroll
        for (int e = 0; e < 4; ++e) {
            const float z0 = __uint_as_float(zw[e] << 16), z1 = __uint_as_float(zw[e] & 0xffff0000u);
            w[e] = pack2(o[i4 * 8 + e * 2] * rs * nw[i4 * 8 + e * 2] * siluf_(z0), o[i4 * 8 + e * 2 + 1] * rs * nw[i4 * 8 + e * 2 + 1] * siluf_(z1));
        }
        *(u32x4*)(mp + i4 * 8) = w;
    }
}


constexpr int RP_Z0 = 0, RP_Z1 = 18432, RP_Z2 = 55296, RP_VEC = 73728, RP_PT = 75008, RP_T11 = 78080, RP_END = 80640;
constexpr int RP_LIN = 0, RP_LW = 25600;
DI void rwkv_prep_unit(const P& p, int li, int ch, char* lds) {
    const int tid = tidx(), lane = tid & 63, wid = tid >> 6, fr = lane & 15, fq = lane >> 4;
    const int h = ch & 7, n = (ch >> 3) & 63, b = ch >> 9;
    const int t0 = b * SEQ + n * 64;
    const bf16_t* proj = (const bf16_t*)(p.ws + WS_PROJ);
    char* Lfc = lds + RP_Z0; float* Lf = (float*)Lfc;
    char* ApT = lds + RP_Z0; char* AkVT = lds + RP_Z0 + 9216;
    char* Arow = lds + RP_Z1; char* Rrow = Arow + 9216; char* Brow = Arow + 18432; char* Krow = Arow + 27648;
    char* Aak = Arow; char* Arb = Rrow; char* Ark = Brow; char* Trow = Krow; char* BhT = Krow; char* VpT = Aak;
    char* AT = lds + RP_Z2; char* VT = AT + 9216; char* KhT = AT;
    float* tot = (float*)(lds + RP_VEC); float* WC = tot + 256;
    char* lin = lds + RP_LIN; char* LWi = lds + RP_LW;
    float* PT = (float*)(lds + RP_PT);
    {
        const float* mu0 = p.in[I_MU] + (size_t)li * 1696;
        if (tid < 48) {
            const int j0 = tid * 4;
            *(float4*)(PT + j0) = j0 < 160 ? *(const float4*)(mu0 + (C_HW - RW0) + j0) : *(const float4*)(p.in[I_VRESMU] + j0 - 160);
        } else if (tid < 48 + 144) {
            const int q = tid - 48, arr = q >> 4, c4 = (q & 15) * 4, chn = h * 64 + c4;
            const float* src = arr == 0 ? mu0 + (C_R - RW0) + chn : arr == 1 ? mu0 + (C_K - RW0) + chn : arr == 2 ? mu0 + (C_V - RW0) + chn
                             : arr == 3 ? p.in[I_W0] + li * 512 + chn : arr == 4 ? p.in[I_A0] + li * 512 + chn : arr == 5 ? p.in[I_V0] + chn
                             : arr == 6 ? p.in[I_KK] + li * 512 + chn : arr == 7 ? p.in[I_KA] + li * 512 + chn : p.in[I_RK] + li * 512 + chn;
            *(float4*)(PT + 192 + arr * 64 + c4) = *(const float4*)src;
        }
    }
    __syncthreads();
    {
        const int c = tid >> 2, cq = tid & 3, s = n * 64 + c;
        const bf16_t* cur = proj + (size_t)(t0 + c) * EVLD + C_HW + cq * 48;
        const float* mu = p.in[I_MU] + (size_t)li * 1696 + (C_HW - RW0);
        const float* vmu = p.in[I_VRESMU];
#pragma unroll
        for (int i6 = 0; i6 < 6; ++i6) {
            const u32x4 cw4 = *(const u32x4*)(cur + i6 * 8);
            u32x4 pw4 = *(const u32x4*)(cur - (s > 0 ? EVLD : 0) + i6 * 8);
            if (s == 0) pw4 = (u32x4){0u, 0u, 0u, 0u};
            const int j0 = cq * 48 + i6 * 8;
            const float4 ma = *(const float4*)(PT + j0), mb = *(const float4*)(PT + j0 + 4);
            const float mm[8] = {ma.x, ma.y, ma.z, ma.w, mb.x, mb.y, mb.z, mb.w};
            const bool is_t = j0 < 32, is_s = (j0 >= 64) && (j0 < 160);
            const float ca = is_t ? 1.f : 0.f, cb = is_t ? -2.f : 1.f, cc = is_t ? 2.f : -1.f;
            u32x4 w;
#pragma unroll
            for (int e = 0; e < 4; ++e) {
                float o2[2];
#pragma unroll
                for (int q = 0; q < 2; ++q) {
                    const float cv = q ? __uint_as_float(cw4[e] & 0xffff0000u) : __uint_as_float(cw4[e] << 16);
                    const float pv = q ? __uint_as_float(pw4[e] & 0xffff0000u) : __uint_as_float(pw4[e] << 16);
                    const float val = cv + mm[e * 2 + q] * (pv - cv);
                    const float act = ca + cb * __builtin_amdgcn_rcpf(1.f + __expf(cc * val));
                    o2[q] = (is_t || is_s) ? act : val;
                }
                w[e] = pack2(o2[0], o2[1]);
            }
            *(u32x4*)(lin + c * 400 + (cq * 48 + i6 * 8) * 2) = w;
        }
        const bf16_t* LW = (const bf16_t*)(p.ws + WS_W + W_LW) + (size_t)h * 64 * 192;
#pragma unroll
        for (int i6 = 0; i6 < 6; ++i6) *(u32x4*)(LWi + c * 400 + (cq * 48 + i6 * 8) * 2) = *(const u32x4*)(LW + (size_t)c * 192 + cq * 48 + i6 * 8);
    }
    __syncthreads();
    float lw_[16], la_[16], lg_[16], lv_[16];
#pragma unroll
    for (int tj = 0; tj < 4; ++tj) {
        const f32x4 a = tile16(LWi, 400, 16 * tj, lin, 400, 16 * wid, 32);
        const f32x4 bq = tile16(LWi + 64, 400, 16 * tj, lin + 64, 400, 16 * wid, 32);
        const f32x4 cg = tile16(LWi + 128, 400, 16 * tj, lin + 128, 400, 16 * wid, 96);
        const f32x4 dv = tile16(LWi + 320, 400, 16 * tj, lin + 320, 400, 16 * wid, 32);
#pragma unroll
        for (int r = 0; r < 4; ++r) { lw_[tj * 4 + r] = a[r]; la_[tj * 4 + r] = bq[r]; lg_[tj * 4 + r] = cg[r]; lv_[tj * 4 + r] = dv[r]; }
    }
    __syncthreads();
    const int c = 16 * wid + fr;
    float at[16], rt[16], bt[16], kt[16], bh[16], kh[16];
    {
        const int s = n * 64 + c;
        const size_t row = (size_t)(t0 + c);
        const float* mu = p.in[I_MU] + (size_t)li * 1696;
        const int hc = h * 64;
        float rr_[16], kk_[16], lwv[16], aa[16];
        float kn = 0.f, rk = 0.f;
        bf16_t* vf = (bf16_t*)(p.ws + WS_VF);
        bf16_t* gg = (bf16_t*)(p.ws + WS_GG);
#pragma unroll
        for (int tj = 0; tj < 4; ++tj) {
            const int cb = 16 * tj + 4 * fq;
            u32x2 cr = *(const u32x2*)(proj + row * EVLD + C_R + hc + cb), ck = *(const u32x2*)(proj + row * EVLD + C_K + hc + cb), cv = *(const u32x2*)(proj + row * EVLD + C_V + hc + cb);
            const size_t prow = s > 0 ? row - 1 : row;
            u32x2 pr = *(const u32x2*)(proj + prow * EVLD + C_R + hc + cb), pk = *(const u32x2*)(proj + prow * EVLD + C_K + hc + cb), pv = *(const u32x2*)(proj + prow * EVLD + C_V + hc + cb);
            if (s == 0) { pr = (u32x2){0u, 0u}; pk = pr; pv = pr; }
            u32x2 vfw = {0u, 0u};
            if (li == 1) vfw = *(const u32x2*)(vf + row * 512 + hc + cb);
            float vout[4], gout[4];
            const int ch0 = hc + cb;
            const float* pt = PT + 192 + cb;
            const float4 mu_r4 = *(const float4*)(pt), mu_k4 = *(const float4*)(pt + 64), mu_v4 = *(const float4*)(pt + 128);
            const float4 w0_4 = *(const float4*)(pt + 192), a0_4 = *(const float4*)(pt + 256), v0_4 = *(const float4*)(pt + 320);
            const float4 kk_4 = *(const float4*)(pt + 384), ka_4 = *(const float4*)(pt + 448), rk_4 = *(const float4*)(pt + 512);
            const float mur[4] = {mu_r4.x, mu_r4.y, mu_r4.z, mu_r4.w}, muk[4] = {mu_k4.x, mu_k4.y, mu_k4.z, mu_k4.w}, muv[4] = {mu_v4.x, mu_v4.y, mu_v4.z, mu_v4.w};
            const float w0v[4] = {w0_4.x, w0_4.y, w0_4.z, w0_4.w}, a0v[4] = {a0_4.x, a0_4.y, a0_4.z, a0_4.w}, v0v[4] = {v0_4.x, v0_4.y, v0_4.z, v0_4.w};
            const float kkp[4] = {kk_4.x, kk_4.y, kk_4.z, kk_4.w}, kap[4] = {ka_4.x, ka_4.y, ka_4.z, ka_4.w}, rkp[4] = {rk_4.x, rk_4.y, rk_4.z, rk_4.w};
#pragma unroll
            for (int r = 0; r < 4; ++r) {
                const int i = tj * 4 + r;
                const unsigned wcr = r < 2 ? cr.x : cr.y, wck = r < 2 ? ck.x : ck.y, wcv = r < 2 ? cv.x : cv.y;
                const unsigned wpr = r < 2 ? pr.x : pr.y, wpk = r < 2 ? pk.x : pk.y, wpv = r < 2 ? pv.x : pv.y, wvf = r < 2 ? vfw.x : vfw.y;
                const float c_r = (r & 1) ? __uint_as_float(wcr & 0xffff0000u) : __uint_as_float(wcr << 16);
                const float c_k = (r & 1) ? __uint_as_float(wck & 0xffff0000u) : __uint_as_float(wck << 16);
                const float c_v = (r & 1) ? __uint_as_float(wcv & 0xffff0000u) : __uint_as_float(wcv << 16);
                const float p_r = (r & 1) ? __uint_as_float(wpr & 0xffff0000u) : __uint_as_float(wpr << 16);
                const float p_k = (r & 1) ? __uint_as_float(wpk & 0xffff0000u) : __uint_as_float(wpk << 16);
                const float p_v = (r & 1) ? __uint_as_float(wpv & 0xffff0000u) : __uint_as_float(wpv << 16);
                const float rm = c_r + mur[r] * (p_r - c_r);
                const float km = c_k + muk[r] * (p_k - c_k);
                float vm = c_v + muv[r] * (p_v - c_v);
                const float wlog = -softplusf_(-(w0v[r] + lw_[i])) - 0.5f;
                lwv[i] = -__expf(wlog);
                const float a = sigmoidf_(a0v[r] + la_[i]);
                if (li == 1) {
                    const float v1 = (r & 1) ? __uint_as_float(wvf & 0xffff0000u) : __uint_as_float(wvf << 16);
                    vm = vm + (v1 - vm) * sigmoidf_(v0v[r] + lv_[i]);
                }
                const float kkv = km * kkp[r];
                kn += kkv * kkv;
                rr_[i] = rm; kk_[i] = kkv; aa[i] = a;
                kt[i] = km * (1.f + (a - 1.f) * kap[r]);
                rk += rm * kt[i] * rkp[r];
                vout[r] = vm; gout[r] = lg_[i];
            }
            u32x2 w; w.x = pack2(vout[0], vout[1]); w.y = pack2(vout[2], vout[3]);
            *(u32x2*)(vf + row * 512 + hc + cb) = w;
            w.x = pack2(gout[0], gout[1]); w.y = pack2(gout[2], gout[3]);
            *(u32x2*)(gg + row * 512 + hc + cb) = w;
#pragma unroll
            for (int r = 0; r < 4; ++r) *(bf16_t*)(VT + (cb + r) * 144 + c * 2) = f2bf(vout[r]);
            __builtin_amdgcn_sched_barrier(0);
        }
        kn += __shfl_xor(kn, 16); kn += __shfl_xor(kn, 32);
        const float kr = rsqrtf(kn + 1e-6f);
        rk += __shfl_xor(rk, 16); rk += __shfl_xor(rk, 32);
        if (fq == 0) ((float*)(p.ws + WS_RK))[row * 8 + h] = rk;
        float cs[16];
#pragma unroll
        for (int i = 0; i < 16; ++i) {
            float x = lwv[i];
#pragma unroll
            for (int o = 1; o < 16; o <<= 1) { const float y = __shfl_up(x, o, 16); if (fr >= o) x += y; }
            cs[i] = x;
        }
        if (fr == 15) {
#pragma unroll
            for (int i = 0; i < 16; ++i) tot[wid * 64 + 16 * (i >> 2) + 4 * fq + (i & 3)] = cs[i];
        }
        __syncthreads();
#pragma unroll
        for (int i = 0; i < 16; ++i) {
            const int chl = 16 * (i >> 2) + 4 * fq + (i & 3);
            float pre = 0.f, all = 0.f;
#pragma unroll
            for (int w2 = 0; w2 < 4; ++w2) { const float tv = tot[w2 * 64 + chl]; all += tv; if (w2 < wid) pre += tv; }
            const float csi = cs[i] + pre, csm = csi - lwv[i];
            const float kkn = kk_[i] * kr, k2 = kt[i];
            const float e_c = __expf(csi), e_n = __builtin_amdgcn_rcpf(e_c), e_m = __expf(csm), e_h = __expf(all) * e_n;
            at[i] = -kkn * e_m; rt[i] = rr_[i] * e_c;
            const float bp = kkn * aa[i];
            bt[i] = bp * e_n; kt[i] = k2 * e_n; bh[i] = bp * e_h; kh[i] = k2 * e_h;
            if (c == 0) WC[chl] = __expf(all);
            if ((i & 3) == 3) __builtin_amdgcn_sched_barrier(0);
        }
    }
#pragma unroll
    for (int tj = 0; tj < 4; ++tj) {
        const int cb = 16 * tj + 4 * fq;
        u32x2 w;
        w.x = pack2(at[tj * 4], at[tj * 4 + 1]); w.y = pack2(at[tj * 4 + 2], at[tj * 4 + 3]); *(u32x2*)(Arow + c * 144 + cb * 2) = w;
        w.x = pack2(rt[tj * 4], rt[tj * 4 + 1]); w.y = pack2(rt[tj * 4 + 2], rt[tj * 4 + 3]); *(u32x2*)(Rrow + c * 144 + cb * 2) = w;
        w.x = pack2(bt[tj * 4], bt[tj * 4 + 1]); w.y = pack2(bt[tj * 4 + 2], bt[tj * 4 + 3]); *(u32x2*)(Brow + c * 144 + cb * 2) = w;
        w.x = pack2(kt[tj * 4], kt[tj * 4 + 1]); w.y = pack2(kt[tj * 4 + 2], kt[tj * 4 + 3]); *(u32x2*)(Krow + c * 144 + cb * 2) = w;
#pragma unroll
        for (int r = 0; r < 4; ++r) {
            *(bf16_t*)(AT + (cb + r) * 144 + c * 2) = f2bf(at[tj * 4 + r]);
        }
    }
    __syncthreads();
    f32x4 pab[4], pak[4], prb[4], prk[4];
    {
        const int ti = wid;
#pragma unroll
        for (int tj = 0; tj < 4; ++tj) {
            pab[tj] = (f32x4){0.f, 0.f, 0.f, 0.f}; pak[tj] = pab[tj]; prb[tj] = pab[tj]; prk[tj] = pab[tj];
            if (tj <= ti) {
                pab[tj] = tile16(Arow, 144, 16 * ti, Brow, 144, 16 * tj, 64);
                pak[tj] = tile16(Krow, 144, 16 * tj, Arow, 144, 16 * ti, 64);
                prb[tj] = tile16(Brow, 144, 16 * tj, Rrow, 144, 16 * ti, 64);
                prk[tj] = tile16(Krow, 144, 16 * tj, Rrow, 144, 16 * ti, 64);
            }
        }
    }
    __syncthreads();
    {
        const int ti = wid;
#pragma unroll
        for (int tj = 0; tj < 4; ++tj) {
            const int s1 = 16 * tj + fr;
            f32x4 lv;
#pragma unroll
            for (int r = 0; r < 4; ++r) { const int t1 = 16 * ti + 4 * fq + r; lv[r] = (s1 < t1) ? -pab[tj][r] : 0.f; }
            *(f32x4*)&Lf[s1 * 72 + 16 * ti + 4 * fq] = lv;
            const int t2 = 16 * ti + fr;
            float m1[4], m2[4], m3[4];
#pragma unroll
            for (int r = 0; r < 4; ++r) { const int s2 = 16 * tj + 4 * fq + r; m1[r] = (s2 < t2) ? pak[tj][r] : 0.f; m2[r] = (s2 <= t2) ? prb[tj][r] : 0.f; m3[r] = (s2 <= t2) ? prk[tj][r] : 0.f; }
            u32x2 w;
            w.x = pack2(m1[0], m1[1]); w.y = pack2(m1[2], m1[3]); *(u32x2*)(Aak + t2 * 144 + (16 * tj + 4 * fq) * 2) = w;
            w.x = pack2(m2[0], m2[1]); w.y = pack2(m2[2], m2[3]); *(u32x2*)(Arb + t2 * 144 + (16 * tj + 4 * fq) * 2) = w;
            w.x = pack2(m3[0], m3[1]); w.y = pack2(m3[2], m3[3]); *(u32x2*)(Ark + t2 * 144 + (16 * tj + 4 * fq) * 2) = w;
        }
    }
    __syncthreads();
    {
        char* L21i = lds + RP_PT;
        char* T11T = lds + RP_T11;
        char* MT = lds + RP_Z0;
        if (wid < 2) {
            const int o = 32 * wid;
            float Tc[32];
#pragma unroll
            for (int i = 0; i < 32; ++i) Tc[i] = (i == (lane & 31)) ? 1.f : 0.f;
#pragma unroll
            for (int j = 0; j < 31; ++j) {
                const float tj = Tc[j];
#pragma unroll
                for (int i4 = (j + 1) >> 2; i4 < 8; ++i4) {
                    const f32x4 l4 = *(const f32x4*)&Lf[(o + j) * 72 + o + i4 * 4];
#pragma unroll
                    for (int e = 0; e < 4; ++e) if (i4 * 4 + e > j) Tc[i4 * 4 + e] -= l4[e] * tj;
                }
            }
            if (lane < 32) {
#pragma unroll
                for (int i = 0; i < 32; ++i) *(bf16_t*)(Trow + (o + i) * 144 + (o + lane) * 2) = f2bf(Tc[i]);
                if (wid == 0) {
#pragma unroll
                    for (int i = 0; i < 32; ++i) *(bf16_t*)(Trow + i * 144 + (32 + lane) * 2) = 0;
#pragma unroll
                    for (int i4 = 0; i4 < 8; ++i4) { u32x2 w; w.x = pack2(Tc[i4 * 4], Tc[i4 * 4 + 1]); w.y = pack2(Tc[i4 * 4 + 2], Tc[i4 * 4 + 3]); *(u32x2*)(T11T + lane * 80 + i4 * 8) = w; }
                }
            }
        } else {
            const int t2 = tid - 128;
#pragma unroll
            for (int g2 = 0; g2 < 2; ++g2) {
                const int i = t2 & 31, k4 = ((t2 >> 5) + 4 * g2) * 4;
                u32x2 w;
                w.x = pack2(Lf[(k4 + 0) * 72 + 32 + i], Lf[(k4 + 1) * 72 + 32 + i]); w.y = pack2(Lf[(k4 + 2) * 72 + 32 + i], Lf[(k4 + 3) * 72 + 32 + i]);
                *(u32x2*)(L21i + i * 80 + k4 * 2) = w;
            }
        }
        __syncthreads();
        {
            const int r0 = 16 * (wid >> 1), c0 = 16 * (wid & 1);
            const f32x4 mm = tile16(L21i, 80, r0, T11T, 80, c0, 32);
            u32x2 w; w.x = pack2(mm[0], mm[1]); w.y = pack2(mm[2], mm[3]);
            *(u32x2*)(MT + (c0 + fr) * 80 + (r0 + 4 * fq) * 2) = w;
        }
        __syncthreads();
        {
            const int r0 = 16 * (wid >> 1), c0 = 16 * (wid & 1);
            const f32x4 tt = tile16(MT, 80, c0, Trow + 32 * 144 + 64, 144, r0, 32);
            u32x2 w; w.x = pack2(-tt[0], -tt[1]); w.y = pack2(-tt[2], -tt[3]);
            *(u32x2*)(Trow + (32 + r0 + fr) * 144 + (c0 + 4 * fq) * 2) = w;
        }
    }
    __syncthreads();
    {
        const int ti = wid;
#pragma unroll
        for (int tj = 0; tj < 4; ++tj) {
            const f32x4 x = tile16(Trow, 144, 16 * ti, AT, 144, 16 * tj, 64);
            const f32x4 y = tile16(Aak, 144, 16 * ti, VT, 144, 16 * tj, 64);
            u32x2 w;
            w.x = pack2(x[0], x[1]); w.y = pack2(x[2], x[3]); *(u32x2*)(ApT + (16 * tj + fr) * 144 + (16 * ti + 4 * fq) * 2) = w;
            w.x = pack2(y[0], y[1]); w.y = pack2(y[2], y[3]); *(u32x2*)(AkVT + (16 * tj + fr) * 144 + (16 * ti + 4 * fq) * 2) = w;
        }
    }
    __syncthreads();
    {
        const int ti = wid;
#pragma unroll
        for (int tj = 0; tj < 4; ++tj) {
            const f32x4 x = tile16(Trow, 144, 16 * ti, AkVT, 144, 16 * tj, 64);
            u32x2 w; w.x = pack2(x[0], x[1]); w.y = pack2(x[2], x[3]); *(u32x2*)(VpT + (16 * tj + fr) * 144 + (16 * ti + 4 * fq) * 2) = w;
        }
    }
    __syncthreads();
#pragma unroll
    for (int tj = 0; tj < 4; ++tj)
#pragma unroll
        for (int r = 0; r < 4; ++r) {
            const int cb = 16 * tj + 4 * fq + r;
            *(bf16_t*)(BhT + cb * 144 + c * 2) = f2bf(bh[tj * 4 + r]);
            *(bf16_t*)(KhT + cb * 144 + c * 2) = f2bf(kh[tj * 4 + r]);
        }
    __syncthreads();
    {
        unsigned char* opsA = p.ws + WS_HN + (size_t)ch * 16384;
        unsigned char* opsB = p.ws + WS_ROPS + (size_t)ch * 16384;
        const int ti = wid;
#pragma unroll
        for (int tj = 0; tj < 4; ++tj) {
            const f32x4 x = tile16(ApT, 144, 16 * tj, Arb, 144, 16 * ti, 64);
            const f32x4 g = tile16(ApT, 144, 16 * tj, BhT, 144, 16 * ti, 64);
            const int m1 = 16 * ti + fr, mt = m1 >> 5, rr = m1 & 31, hh = fq & 1, jg = fq >> 1;
            const size_t off = ((size_t)((mt * 4 + tj) * 64 + hh * 32 + rr) * 8 + jg * 4) * 2;
            float gd[4];
#pragma unroll
            for (int r = 0; r < 4; ++r) gd[r] = g[r] + ((16 * tj + 4 * fq + r == m1) ? WC[m1] : 0.f);
            u32x2 w;
            w.x = pack2(x[0] + rt[tj * 4], x[1] + rt[tj * 4 + 1]); w.y = pack2(x[2] + rt[tj * 4 + 2], x[3] + rt[tj * 4 + 3]); *(u32x2*)(opsA + off) = w;
            w.x = pack2(gd[0], gd[1]); w.y = pack2(gd[2], gd[3]); *(u32x2*)(opsA + 8192 + off) = w;
            f32x4 y = tile16(Ark, 144, 16 * ti, VT, 144, 16 * tj, 64);
            const f32x4 y2 = tile16(Arb, 144, 16 * ti, VpT, 144, 16 * tj, 64);
            f32x4 kv = tile16(KhT, 144, 16 * ti, VT, 144, 16 * tj, 64);
            const f32x4 kv2 = tile16(BhT, 144, 16 * ti, VpT, 144, 16 * tj, 64);
            const int vcol = 16 * tj + fr, slice = vcol >> 5, r2 = vcol & 31, cb = 16 * ti + 4 * fq, mt2 = cb >> 5, q4 = (cb & 31) >> 2, h2 = q4 & 1, rg = q4 >> 1;
            const size_t off2 = ((size_t)((slice * 2 + mt2) * 64 + h2 * 32 + r2) * 16 + rg * 4) * 2;
            w.x = pack2(y[0] + y2[0], y[1] + y2[1]); w.y = pack2(y[2] + y2[2], y[3] + y2[3]); *(u32x2*)(opsB + off2) = w;
            w.x = pack2(kv[0] + kv2[0], kv[1] + kv2[1]); w.y = pack2(kv[2] + kv2[2], kv[3] + kv2[3]); *(u32x2*)(opsB + 8192 + off2) = w;
        }
    }
}

DI void rwkv_scan_block(const P& p, int bh, char* lds, bool dry = false) {
    const int tid = tidx(), lane = tid & 63, w = tid >> 6, slice = w & 1;
    const int h = bh & 7, b = bh >> 3;
    constexpr int NST = 64 * 2, AH = 3;
    auto issue = [&](int j) {
        const int n = j >> 1, k = j & 1;
        const size_t ch = (size_t)((b * 64 + n) * 8 + h) * 16384;
        const unsigned char* s0 = (k == 0 ? p.ws + WS_ROPS + ch + 8192 : p.ws + WS_ROPS + ch) + tid * 16;
        const unsigned char* s1 = (k == 0 ? p.ws + WS_HN + ch + 8192 : p.ws + WS_HN + ch) + tid * 16;
        char* dst = lds + (j & 3) * 16384 + tid * 16;
        glds16(s0, dst); glds16(s0 + 4096, dst + 4096); glds16(s1, dst + 8192); glds16(s1 + 4096, dst + 12288);
    };
    f32x16 H[2];
#pragma unroll
    for (int i = 0; i < 2; ++i)
#pragma unroll
        for (int r = 0; r < 16; ++r) H[i][r] = 0.f;
    __syncthreads();
#pragma unroll
    for (int j = 0; j < AH; ++j) issue(j);
#pragma unroll 1
    for (int n = 0; n < 64; ++n) {
        bf16x8 Hb[4];
#pragma unroll
        for (int i = 0; i < 2; ++i) { Hb[i * 2] = pack_step(H[i], 0); Hb[i * 2 + 1] = pack_step(H[i], 1); }
#pragma unroll
        for (int k = 0; k < 2; ++k) {
            const int j = n * 2 + k;
            if (n < 63) GS_WAIT(8); else if (k == 0) GS_WAIT(4); else GS_WAIT(0);
            __builtin_amdgcn_s_barrier();
            if (j + AH < NST) issue(j + AH);
            __builtin_amdgcn_sched_barrier(0);
            const char* sl = lds + (j & 3) * 16384;
            if (w < 2) {
                f32x16 acc[2];
#pragma unroll
                for (int mt = 0; mt < 2; ++mt) {
                    const u32x4* up = (const u32x4*)(sl + (slice * 2 + mt) * 2048 + lane * 32);
                    const u32x4 u0 = up[0], u1 = up[1];
#pragma unroll
                    for (int e = 0; e < 4; ++e) {
                        acc[mt][e * 2] = __uint_as_float(u0[e] << 16); acc[mt][e * 2 + 1] = __uint_as_float(u0[e] & 0xffff0000u);
                        acc[mt][8 + e * 2] = __uint_as_float(u1[e] << 16); acc[mt][8 + e * 2 + 1] = __uint_as_float(u1[e] & 0xffff0000u);
                    }
                }
                const bf16x8* fr = (const bf16x8*)(sl + 8192) + lane;
                bf16x8 f8[8];
#pragma unroll
                for (int q = 0; q < 8; ++q) f8[q] = fr[q * 64];
#pragma unroll
                for (int ks = 0; ks < 4; ++ks)
#pragma unroll
                    for (int mt = 0; mt < 2; ++mt) acc[mt] = mfma32(f8[mt * 4 + ks], Hb[ks], acc[mt]);
                if (k == 0) { H[0] = acc[0]; H[1] = acc[1]; }
                else {
                    const size_t ch = (size_t)((b * 64 + n) * 8 + h) * 16384;
                    u32x4* Yf = (u32x4*)(dry ? p.ws + WS_DUMMY + 2097152 + (size_t)(bh & 31) * 16384 : p.ws + WS_ROPS + ch) + (size_t)(slice * 128 + lane) * 2;
#pragma unroll
                    for (int mt = 0; mt < 2; ++mt) {
                        u32x4 o0, o1;
#pragma unroll
                        for (int e = 0; e < 4; ++e) { o0[e] = pack2(acc[mt][e * 2], acc[mt][e * 2 + 1]); o1[e] = pack2(acc[mt][8 + e * 2], acc[mt][8 + e * 2 + 1]); }
                        Yf[mt * 128] = o0; Yf[mt * 128 + 1] = o1;
                    }
                }
            }
        }
    }
    __syncthreads();
}

DI void rwkv_post_unit(const P& p, int li, int ch) {
    const int tid = tidx();
    const int h = ch & 7, n = (ch >> 3) & 63, b = ch >> 9;
    const int t0 = b * SEQ + n * 64;
    const int c = tid >> 2, cq = tid & 3;
    const bf16_t* Yf = (const bf16_t*)(p.ws + WS_ROPS + (size_t)ch * 16384);
    const bf16_t* vf = (const bf16_t*)(p.ws + WS_VF) + (size_t)(t0 + c) * 512 + h * 64 + cq * 16;
    const bf16_t* gg = (const bf16_t*)(p.ws + WS_GG) + (size_t)(t0 + c) * 512 + h * 64 + cq * 16;
    const float rk = ((const float*)(p.ws + WS_RK))[(size_t)(t0 + c) * 8 + h];
    const float* lnw = p.in[I_LNW] + li * 512 + h * 64 + cq * 16;
    const float* lnb = p.in[I_LNB] + li * 512 + h * 64 + cq * 16;
    bf16_t* mp = (bf16_t*)(p.ws + WS_HN) + (size_t)(t0 + c) * 1024 + 512 + h * 64 + cq * 16;
    const int mt = c >> 5, q4 = (c & 31) >> 2, hh = q4 & 1, rg = q4 >> 1, reg = rg * 4 + (c & 3), slice = cq >> 1, rb = (cq & 1) * 16;
    float y[16]; float sm = 0.f;
#pragma unroll
    for (int i = 0; i < 16; ++i) { y[i] = bf2f(Yf[(size_t)((slice * 2 + mt) * 64 + hh * 32 + rb + i) * 16 + reg]); sm += y[i]; }
    sm += __shfl_xor(sm, 1); sm += __shfl_xor(sm, 2);
    const float mean = sm * (1.f / 64.f);
    float vs = 0.f;
#pragma unroll
    for (int i = 0; i < 16; ++i) { y[i] -= mean; vs += y[i] * y[i]; }
    vs += __shfl_xor(vs, 1); vs += __shfl_xor(vs, 2);
    const float rs = rsqrtf(vs * (1.f / 64.f) + 64e-5f);
#pragma unroll
    for (int i8 = 0; i8 < 2; ++i8) {
        const u32x4 vw = *(const u32x4*)(vf + i8 * 8), gw = *(const u32x4*)(gg + i8 * 8);
        u32x4 w;
#pragma unroll
        for (int e = 0; e < 4; ++e) {
            const int i = i8 * 8 + e * 2;
            const float v0 = __uint_as_float(vw[e] << 16), v1 = __uint_as_float(vw[e] & 0xffff0000u), g0 = __uint_as_float(gw[e] << 16), g1 = __uint_as_float(gw[e] & 0xffff0000u);
            w[e] = pack2((y[i] * rs * lnw[i] + lnb[i] + rk * v0) * g0, (y[i + 1] * rs * lnw[i + 1] + lnb[i + 1] + rk * v1) * g1);
        }
        *(u32x4*)(mp + i8 * 8) = w;
    }
}


DI void attn_unit(const P& p, int unit, char* lds) {
    const int tid = tidx(), lane = tid & 63, w = tid >> 6, r_ = lane & 31, hl = lane >> 5;
    const int idx = unit & 31, h = (unit >> 5) & 7, g = (unit >> 8) % 3, b = unit / 768;
    const int lg2 = g * 2, dil = 1 << lg2, L = SEQ >> lg2, ntl = L >> 7;
    const int rs = idx / ntl, qt = idx % ntl;
    const int hg = g * 8 + h;
    const bf16_t* QK = (const bf16_t*)(p.ws + WS_QK);
    const bf16_t* VT = (const bf16_t*)(p.ws + WS_VT) + ((size_t)((b * 24 + hg) * dil + rs) * 64) * L;
    const int qi = 32 * w + r_;
    const int q_idx = 128 * qt + qi;
    const size_t qrow = (size_t)(b * SEQ + q_idx * dil + rs);
    const int kbase0 = 128 * qt - 128;
    char* Kt = lds;
    char* Vt = lds + 32768;
    __syncthreads();
#pragma unroll
    for (int i = 0; i < 8; ++i) {
        const int id = tid + i * 256, row = id >> 3, pc = id & 7, c = pc ^ ((row >> 1) & 7);
        int k_idx = kbase0 + row; if (k_idx < 0) k_idx = 0;
        glds16(QK + (size_t)(b * SEQ + k_idx * dil + rs) * 3072 + 1536 + hg * 64 + c * 8, Kt + id * 16);
    }
#pragma unroll
    for (int i = 0; i < 8; ++i) {
        const int id = tid + i * 256, row = id >> 5, pq = id & 31, q = pq ^ (row & 31);
        int k0 = kbase0 + q * 8; if (k0 < 0) k0 = 0;
        glds16(VT + (size_t)row * L + k0, Vt + id * 16);
    }
    bf16x8 qf[4];
#pragma unroll
    for (int ks = 0; ks < 4; ++ks) qf[ks] = *(const bf16x8*)(QK + qrow * 3072 + hg * 64 + 16 * ks + 8 * hl);
    asm volatile("s_waitcnt vmcnt(0)" ::: "memory");
    __syncthreads();
    f32x16 st[5];
    float mx = -1.0e30f;
#pragma unroll
    for (int kbi = 0; kbi < 5; ++kbi) {
        const int krow = 32 * (w + kbi) + r_;
#pragma unroll
        for (int r = 0; r < 16; ++r) st[kbi][r] = 0.f;
#pragma unroll
        for (int ks = 0; ks < 4; ++ks) {
            const bf16x8 kf = *(const bf16x8*)(Kt + krow * 128 + (((2 * ks + hl) ^ ((krow >> 1) & 7)) * 16));
            st[kbi] = mfma32(kf, qf[ks], st[kbi]);
        }
#pragma unroll
        for (int r = 0; r < 16; ++r) {
            const int kj = 32 * (w + kbi) + (r & 3) + 8 * (r >> 2) + 4 * hl;
            const bool valid = (kj >= qi) && (kj <= qi + 128) && (kbase0 + kj >= 0);
            const float sv = valid ? st[kbi][r] * 0.125f : -1.0e30f;
            st[kbi][r] = sv; mx = fmaxf(mx, sv);
        }
    }
    mx = fmaxf(mx, __shfl_xor(mx, 32));
    float l = 0.f;
#pragma unroll
    for (int kbi = 0; kbi < 5; ++kbi)
#pragma unroll
        for (int r = 0; r < 16; ++r) { const float pv = __expf(st[kbi][r] - mx); st[kbi][r] = pv; l += pv; }
    l += __shfl_xor(l, 32);
    f32x16 ot[2];
#pragma unroll
    for (int dt = 0; dt < 2; ++dt)
#pragma unroll
        for (int r = 0; r < 16; ++r) ot[dt][r] = 0.f;
#pragma unroll
    for (int kbi = 0; kbi < 5; ++kbi)
#pragma unroll
        for (int s2 = 0; s2 < 2; ++s2) {
            const bf16x8 pb = pack_step(st[kbi], s2);
            const int q0 = 4 * (w + kbi) + 2 * s2;
#pragma unroll
            for (int dt = 0; dt < 2; ++dt) {
                const int drow = 32 * dt + r_;
                const u32x2 lo = *(const u32x2*)(Vt + drow * 512 + ((q0 ^ (drow & 31)) * 16) + 8 * hl);
                const u32x2 hi = *(const u32x2*)(Vt + drow * 512 + (((q0 + 1) ^ (drow & 31)) * 16) + 8 * hl);
                u32x4 vw; vw.x = lo.x; vw.y = lo.y; vw.z = hi.x; vw.w = hi.y;
                ot[dt] = mfma32(__builtin_bit_cast(bf16x8, vw), pb, ot[dt]);
            }
        }
    const float inv = 1.f / l;
    bf16_t* og = (bf16_t*)(p.ws + WS_OG) + ((size_t)g * T + qrow) * 512 + h * 64;
#pragma unroll
    for (int dt = 0; dt < 2; ++dt)
#pragma unroll
        for (int rg = 0; rg < 4; ++rg) {
            u32x2 wv; wv.x = pack2(ot[dt][rg * 4] * inv, ot[dt][rg * 4 + 1] * inv); wv.y = pack2(ot[dt][rg * 4 + 2] * inv, ot[dt][rg * 4 + 3] * inv);
            *(u32x2*)(og + 32 * dt + 8 * rg + 4 * hl) = wv;
        }
    if (hl == 0) ((float*)(p.ws + WS_LSE))[((size_t)g * T + qrow) * 8 + h] = mx + __logf(l);
}
DI void phase_attn_merge(const P& p) {
    const bf16_t* og = (const bf16_t*)(p.ws + WS_OG);
    const float* lse = (const float*)(p.ws + WS_LSE);
    bf16_t* o = (bf16_t*)(p.ws + WS_HN);
    for (int i = bidx() * 256 + tidx(); i < T * 64; i += gridDim.x * 256) {
        const int t = i >> 6, c8 = i & 63, h = c8 >> 3;
        const float l0 = lse[(size_t)t * 8 + h], l1 = lse[((size_t)T + t) * 8 + h], l2 = lse[((size_t)2 * T + t) * 8 + h];
        const float m = fmaxf(l0, fmaxf(l1, l2));
        float w0 = __expf(l0 - m), w1 = __expf(l1 - m), w2 = __expf(l2 - m);
        const float inv = 1.f / (w0 + w1 + w2); w0 *= inv; w1 *= inv; w2 *= inv;
        const u32x4 a = *(const u32x4*)(og + (size_t)t * 512 + c8 * 8), bq = *(const u32x4*)(og + ((size_t)T + t) * 512 + c8 * 8), cq = *(const u32x4*)(og + ((size_t)2 * T + t) * 512 + c8 * 8);
        u32x4 r;
#pragma unroll
        for (int e = 0; e < 4; ++e) {
            const float x0 = w0 * __uint_as_float(a[e] << 16) + w1 * __uint_as_float(bq[e] << 16) + w2 * __uint_as_float(cq[e] << 16);
            const float x1 = w0 * __uint_as_float(a[e] & 0xffff0000u) + w1 * __uint_as_float(bq[e] & 0xffff0000u) + w2 * __uint_as_float(cq[e] & 0xffff0000u);
            r[e] = pack2(x0, x1);
        }
        *(u32x4*)(o + (size_t)t * 512 + c8 * 8) = r;
    }
}


#define XB_TMO      128
#define XB_XCNT(j)  (256  + 64 * (j))
#define XB_XSUB(j)  (1280 + 64 * (j))
#define XB_XGEN(j)  (2304 + 64 * (j))
#define XB_TOP      3328
#define XB_TOPGEN   3392
#define XCD_BAR_WORDS 3456
#define XB_SPIN_CAP (1u << 22)
#define LAS __attribute__((address_space(3)))
DI unsigned xb_ld(unsigned* p)              { return __hip_atomic_load(p, __ATOMIC_RELAXED, __HIP_MEMORY_SCOPE_AGENT); }
DI unsigned xb_add(unsigned* p, unsigned v) { return __hip_atomic_fetch_add(p, v, __ATOMIC_RELAXED, __HIP_MEMORY_SCOPE_AGENT); }
DI unsigned xb_xcc_id() { return (unsigned)__builtin_amdgcn_s_getreg((3 << 11) | 20) & 0xFu; }
#define XB_SPIN(cond, bar) do { unsigned _sp = 0; while (cond) { if (_sp < 32u) __builtin_amdgcn_s_sleep(2); else __builtin_amdgcn_s_sleep(24); \
    if ((++_sp & 255u) == 0u) { if (xb_ld(&(bar)[XB_TMO])) break; if (_sp > XB_SPIN_CAP) { atomicAdd(&(bar)[XB_TMO], 1u); break; } } } } while (0)
struct XcdBarrier { unsigned* bar; unsigned x; volatile LAS unsigned* st; };
DI XcdBarrier xcd_barrier_post(unsigned* bar, volatile LAS unsigned* st) {
    XcdBarrier b; b.bar = bar; b.x = xb_xcc_id(); b.st = st;
    if (threadIdx.x == 0) (void)xb_add(&bar[XB_XCNT(b.x)], 1u);
    return b;
}
DI void xcd_barrier_complete(unsigned* bar, unsigned x, unsigned& nloc, unsigned& nx) {
    const unsigned G = gridDim.x * gridDim.y * gridDim.z;
    unsigned sum, cnt, mine, sp = 0u;
    for (;;) {
        sum = 0u; cnt = 0u; mine = 0u;
#pragma unroll
        for (unsigned j = 0; j < 16; ++j) { const unsigned c = xb_ld(&bar[XB_XCNT(j)]); sum += c; cnt += (c > 0u) ? 1u : 0u; mine = (j == x) ? c : mine; }
        if (sum == G) break;
        __builtin_amdgcn_s_sleep(1);
        if ((++sp & 255u) == 0u) { if (xb_ld(&bar[XB_TMO])) break; if (sp > XB_SPIN_CAP) { atomicAdd(&bar[XB_TMO], 1u); break; } }
    }
    nloc = mine > 0u ? mine : 1u; nx = cnt > 0u ? cnt : 1u;
}
DI void xcd_barrier(const XcdBarrier& b) {
    asm volatile("s_waitcnt vmcnt(0)" ::: "memory");
    __syncthreads();
    if (threadIdx.x == 0) {
        unsigned* bar = b.bar;
        __builtin_amdgcn_s_waitcnt(0);
        unsigned nloc = b.st[0], nx = b.st[1];
        if (nloc == 0u) { xcd_barrier_complete(bar, b.x, nloc, nx); b.st[0] = nloc; b.st[1] = nx; }
        const unsigned old = xb_add(&bar[XB_XSUB(b.x)], 1u);
        const unsigned gen = old / nloc;
        if (old + 1u == (gen + 1u) * nloc) {
            __builtin_amdgcn_fence(__ATOMIC_RELEASE, "agent");
            asm volatile("s_waitcnt vmcnt(0)" ::: "memory");
            const unsigned og = xb_add(&bar[XB_TOP], 1u);
            const unsigned tg = og / nx;
            if (og + 1u == (tg + 1u) * nx) xb_add(&bar[XB_TOPGEN], 1u);
            else XB_SPIN(xb_ld(&bar[XB_TOPGEN]) == tg, bar);
            __builtin_amdgcn_fence(__ATOMIC_ACQUIRE, "agent");
            xb_add(&bar[XB_XGEN(b.x)], 1u);
            asm volatile("s_waitcnt vmcnt(0)" ::: "memory");
        } else {
            XB_SPIN(xb_ld(&bar[XB_XGEN(b.x)]) == gen, bar);
            __builtin_amdgcn_fence(__ATOMIC_ACQUIRE, "agent");
            asm volatile("s_waitcnt vmcnt(0)" ::: "memory");
        }
    }
    __syncthreads();
}

constexpr int LDS_BYTES = RP_END;
static_assert(GP_END + 6144 <= LDS_BYTES, "LDS");
__global__ void __launch_bounds__(256, 2) mega(P p) {
    cg::grid_group grid = cg::this_grid();
    extern __shared__ __attribute__((aligned(16))) char lds[];
    if (threadIdx.x < 4) ((volatile LAS unsigned*)(lds + LDS_BYTES))[threadIdx.x] = 0u;
    __syncthreads();
    const XcdBarrier xb = xcd_barrier_post((unsigned*)(p.ws + WS_CTL + CTL_BAR), (volatile LAS unsigned*)(lds + LDS_BYTES));
#define GSYNC() xcd_barrier(xb)
    const bf16_t* HN = (const bf16_t*)(p.ws + WS_HN);
    const bf16_t* Win = (const bf16_t*)(p.ws + WS_W + W_IN);
    const bf16_t* Wout = (const bf16_t*)(p.ws + WS_W + W_OUT);
    phase_rope(p);
    phase_convert_io(p, 0, lds);
    phase_prep<0>(p, p.in[I_EVNORM], 0);
    if (p.ws == nullptr) grid.sync();
    GSYNC();
    volatile LAS unsigned* qword = (volatile LAS unsigned*)(lds + LDS_BYTES + 8);
    for (int layer = 0; layer < 4; ++layer) {
        const int li = layer >> 1;
        if ((layer & 1) == 0) {
            phase_gemm<EPI_EVEN_IN>(p, HN, 1024, Win, 1024, EVPAD / 128, lds);
            GSYNC();
            for (int u = bidx(); u < 1024; u += gridDim.x) gdn_prep_unit(p, li, u, lds);
            GSYNC();
            if (bidx() < 16) gdn_scan_block(p, bidx(), lds);
            {
                unsigned* qctr = (unsigned*)(p.ws + WS_CTL + CTL_QUEUE) + li * 64;
                for (;;) {
                    __syncthreads();
                    if (threadIdx.x == 0) *qword = atomicAdd(qctr, 1u);
                    __syncthreads();
                    const unsigned u = *qword;
                    if (u >= 2048u) break;
                    rwkv_prep_unit(p, li, (int)u, lds);
                }
            }
            GSYNC();
            if (bidx() < 32) rwkv_scan_block(p, bidx(), lds);
            else {
                for (int u = bidx() - 32; u < 1024; u += gridDim.x - 32) gdn_post_unit(p, li, u);
                phase_convert_moe(p, layer, lds, bidx() - 32, gridDim.x - 32);
            }
            GSYNC();
            for (int u = bidx(); u < 2048; u += gridDim.x) rwkv_post_unit(p, li, u);
            GSYNC();
            phase_gemm<EPI_RESID>(p, (const bf16_t*)(p.ws + WS_PROJ), EVLD, Wout, 1024, 8, lds, false, HN, 1024, 512);
        } else {
            phase_gemm<EPI_ODD_IN>(p, HN, 1024, Win, 1024, ODC / 128, lds);
            GSYNC();
            for (int u = bidx(); u < 3072; u += gridDim.x) attn_unit(p, u, lds);
            GSYNC();
            phase_attn_merge(p);
            GSYNC();
            phase_gemm<EPI_RESID>(p, HN, 512, Wout, 512, 8, lds);
        }
        GSYNC();
        phase_router(p, p.in[I_FFNNORM] + layer * 1024, layer, lds);
        GSYNC();
        phase_moe_up(p, layer, lds);
        GSYNC();
        phase_moe_down(p, layer, lds);
        GSYNC();
        if (layer < 3) {
            phase_convert_io(p, layer + 1, lds);
            if ((layer + 1) & 1) phase_convert_moe(p, layer + 1, lds, bidx(), gridDim.x);
            phase_prep<1>(p, ((layer + 1) & 1) ? p.in[I_ODNORM] + ((layer + 1) >> 1) * 1024 : p.in[I_EVNORM] + ((layer + 1) >> 1) * 1024, layer + 1);
            GSYNC();
        }
    }
    phase_prep<3>(p, p.in[I_FINAL], 0);
}

extern "C" void kernel_launch(void* const* d_in, const int* in_sizes, int n_in, void* d_out, int out_size, void* d_ws, size_t ws_size, hipStream_t stream) {
    if (n_in != 34 || out_size != T * D || ws_size < WS_END) { fprintf(stderr, "kernel_launch: unexpected shapes (n_in %d out %d ws %zu need %zu)\n", n_in, out_size, ws_size, (size_t)WS_END); return; }
    static int grid_blocks = 0;
    if (!grid_blocks) {
        int dev = 0, cus = 0, per_cu = 0;
        (void)hipGetDevice(&dev);
        (void)hipDeviceGetAttribute(&cus, hipDeviceAttributeMultiprocessorCount, dev);
        (void)hipFuncSetAttribute((const void*)mega, hipFuncAttributeMaxDynamicSharedMemorySize, LDS_BYTES + 16);
        (void)hipOccupancyMaxActiveBlocksPerMultiprocessor(&per_cu, mega, 256, LDS_BYTES + 16);
        if (per_cu < 1) per_cu = 1;
        if (per_cu > 2) per_cu = 2;
        grid_blocks = cus * per_cu;
    }
    P p{};
    for (int i = 0; i < 34; ++i) p.in[i] = (const float*)d_in[i];
    p.out = (float*)d_out; p.ws = (unsigned char*)d_ws;
    (void)hipMemsetAsync((char*)d_ws + WS_CTL, 0, 65536, stream);
    void* args[] = {&p};
    hipError_t e = hipLaunchCooperativeKernel((void*)mega, dim3(grid_blocks), dim3(256), args, LDS_BYTES + 16, stream);
    if (e != hipSuccess) fprintf(stderr, "cooperative launch failed: %s (grid %d)\n", hipGetErrorString(e), grid_blocks);
}
```

```cpp
#include <hip/hip_runtime.h>
#include <cstdio>
#include <cstdint>
#include <cmath>
#include <hip/hip_cooperative_groups.h>
namespace cg = cooperative_groups;

typedef unsigned short bf16_t;
typedef short bf16x8 __attribute__((ext_vector_type(8)));
typedef float f32x4 __attribute__((ext_vector_type(4)));
typedef unsigned u32x4 __attribute__((ext_vector_type(4)));
typedef unsigned u32x2 __attribute__((ext_vector_type(2)));
#define DI __device__ __forceinline__

constexpr int T = 16384, SEQ = 4096, BATCH = 4, D = 1024;
constexpr int EVC = 3784, EVLD = 3784, EVPAD = 3840;
constexpr int ODC = 4608;
constexpr int RW0 = 2056;
constexpr int C_R = 2056, C_K = 2568, C_V = 3080, C_HW = 3592, C_HA = 3624, C_HG = 3656, C_HV = 3752;
constexpr int NEXP = 16, FF = 256;
constexpr int HROWS = 34816;

constexpr size_t WS_CTL = 0;
constexpr size_t CTL_EGL = 4096;
constexpr size_t CTL_QUEUE = 49152;
constexpr size_t CTL_CNT = 32768;
constexpr size_t CTL_BAR = 16384;
constexpr size_t WS_LIST = 65536;
constexpr size_t WS_GATE = WS_LIST + 16 * 16384 * 4;
constexpr size_t WS_RK = WS_GATE + 16 * 16384 * 4;
constexpr size_t WS_ROPE = WS_RK + (size_t)T * 8 * 4;
constexpr size_t WS_W = WS_ROPE + (size_t)T * 32 * 8;
constexpr size_t W_IN = 0;
constexpr size_t W_OUT = (size_t)4608 * 1024 * 2;
constexpr size_t W_13 = W_OUT + (size_t)1024 * 1024 * 2;
constexpr size_t W_2 = W_13 + (size_t)16 * 512 * 1024 * 2;
constexpr size_t W_LW = W_2 + (size_t)16 * 1024 * 256 * 2;
constexpr size_t W_BYTES = W_LW + (size_t)512 * 192 * 2;
constexpr size_t WS_HN = WS_W + W_BYTES;
constexpr size_t WS_VF = WS_HN + (size_t)T * 1024 * 2;
constexpr size_t WS_R2 = WS_VF + (size_t)T * 512 * 2;
constexpr size_t WS_PROJ = WS_R2;
constexpr size_t WS_GOPS = WS_R2 + (size_t)T * EVLD * 2;
constexpr size_t GOPS_CH = 73728, GO_WF = 0, GO_QF = 16384, GO_UF = 32768, GO_AF = 49152, GO_KF = 57344;
constexpr size_t WS_ROPS = WS_GOPS + 1024 * GOPS_CH;
constexpr size_t WS_QK = WS_R2;
constexpr size_t WS_VT = WS_QK + (size_t)T * 3072 * 2;
constexpr size_t WS_OG = WS_VT + (size_t)T * 1536 * 2;
constexpr size_t WS_LSE = WS_OG + (size_t)3 * T * 512 * 2;
constexpr size_t WS_END3 = WS_LSE + (size_t)3 * T * 8 * 4;
constexpr size_t WS_YS = WS_R2;
constexpr size_t WS_H = WS_YS + (size_t)2 * T * 1024 * 2;
constexpr size_t WS_GG = WS_ROPS + (size_t)2048 * 16384;
constexpr size_t WS_END0 = WS_GG + (size_t)T * 512 * 2;
constexpr size_t WS_END1 = WS_H + (size_t)HROWS * 256 * 2;
constexpr size_t WS_END2 = WS_R2 + (size_t)T * 4608 * 2;
static_assert(WS_END3 <= WS_END0, "odd-layer regions exceed even-layer footprint");
constexpr size_t WS_END = WS_END0 > WS_END1 ? (WS_END0 > WS_END2 ? WS_END0 : WS_END2) : (WS_END1 > WS_END2 ? WS_END1 : WS_END2);

constexpr size_t WS_DUMMY = WS_END0;
struct P {
    const float* in[34];
    float* out;
    unsigned char* ws;
};
enum { I_X = 0, I_POS, I_EVNORM, I_EVWIN, I_VRESDOWN, I_EVWOUT, I_CONVW, I_ALOG, I_DTB, I_GDNNORM, I_MU, I_W0, I_W2, I_A0, I_A2, I_G2,
       I_KK, I_KA, I_RK, I_LNW, I_LNB, I_VRESMU, I_V0, I_V2, I_ODNORM, I_ODWIN, I_ODWOUT, I_FFNNORM, I_WGROUP, I_WEXPERT, I_W1, I_W3, I_MW2, I_FINAL };

DI int tidx() { int t = threadIdx.x; asm volatile("" : "+v"(t)); return t; }
DI int bidx() { int b = blockIdx.x; asm volatile("" : "+s"(b)); return b; }
typedef __bf16 bf2_t __attribute__((ext_vector_type(2)));
typedef float f2_t __attribute__((ext_vector_type(2)));
DI bf16_t f2bf(float x) { return __builtin_bit_cast(bf16_t, (__bf16)x); }
DI float bf2f(bf16_t h) { return __uint_as_float(((unsigned)h) << 16); }
DI unsigned pack2(float lo, float hi) { const f2_t v = {lo, hi}; return __builtin_bit_cast(unsigned, __builtin_convertvector(v, bf2_t)); }
DI float wave_sum(float v) {
#pragma unroll
    for (int o = 32; o > 0; o >>= 1) v += __shfl_xor(v, o);
    return v;
}
DI float wave_max(float v) {
#pragma unroll
    for (int o = 32; o > 0; o >>= 1) v = fmaxf(v, __shfl_xor(v, o));
    return v;
}
DI float sigmoidf_(float x) { return __builtin_amdgcn_rcpf(1.f + __expf(-x)); }
DI float siluf_(float x) { return x * __builtin_amdgcn_rcpf(1.f + __expf(-x)); }
DI float softplusf_(float x) { return fmaxf(x, 0.f) + __logf(1.f + __expf(-fabsf(x))); }

struct ConvJob { const float* src; bf16_t* dst; int K, N, ldd; int mode; };
DI int rowmap(int mode, int n) { return mode == 0 ? n : ((n >> 4) * 32 + (n & 15) + (mode == 2 ? 16 : 0)); }
DI void conv_tile(const ConvJob& j, int tile, float* lds  ) {
    const int ntn = (j.N + 255) / 256;
    const int tk = tile / ntn, tn = tile % ntn;
    const int tid = tidx();
    __syncthreads();
    float4 v[16];
#pragma unroll
    for (int i = 0; i < 16; ++i) {
        const int e = tid + i * 256, k = e >> 6, n4 = (e & 63) * 4;
        const int gk = tk * 64 + k, gn = tn * 256 + n4;
        v[i] = make_float4(0.f, 0.f, 0.f, 0.f);
        if (gn < j.N) v[i] = *(const float4*)(j.src + (size_t)gk * j.N + gn);
    }
#pragma unroll
    for (int i = 0; i < 16; ++i) { const int e = tid + i * 256, k = e >> 6, n4 = (e & 63) * 4; *(float4*)(lds + k * 260 + n4) = v[i]; }
    __syncthreads();
#pragma unroll
    for (int i = 0; i < 8; ++i) {
        const int e = tid + i * 256, n = e & 255, k8 = (e >> 8) * 8;
        const int gn = tn * 256 + n;
        if (gn < j.N) {
            u32x4 w;
            w.x = pack2(lds[(k8 + 0) * 260 + n], lds[(k8 + 1) * 260 + n]); w.y = pack2(lds[(k8 + 2) * 260 + n], lds[(k8 + 3) * 260 + n]);
            w.z = pack2(lds[(k8 + 4) * 260 + n], lds[(k8 + 5) * 260 + n]); w.w = pack2(lds[(k8 + 6) * 260 + n], lds[(k8 + 7) * 260 + n]);
            *(u32x4*)(j.dst + (size_t)rowmap(j.mode, gn) * j.ldd + tk * 64 + k8) = w;
        }
    }
}
DI void phase_convert_io(const P& p, int layer, char* ldsc) {
    float* lds = (float*)ldsc;
    unsigned char* W = p.ws + WS_W;
    const int li = layer >> 1;
    if ((layer & 1) == 0) {
        const ConvJob j0{p.in[I_EVWIN] + (size_t)li * 1024 * 3752, (bf16_t*)(W + W_IN), 1024, 3752, 1024, 0};
        for (int t = bidx(); t < 16 * 15; t += gridDim.x) conv_tile(j0, t, lds);
        if (li == 1) {
            const ConvJob j1{p.in[I_VRESDOWN], (bf16_t*)(W + W_IN) + (size_t)3752 * 1024, 1024, 32, 1024, 0};
            for (int t = bidx(); t < 16; t += gridDim.x) conv_tile(j1, t, lds);
        }
        const ConvJob j2{p.in[I_EVWOUT] + (size_t)li * 1024 * 1024, (bf16_t*)(W + W_OUT), 1024, 1024, 1024, 0};
        for (int t = bidx(); t < 16 * 4; t += gridDim.x) conv_tile(j2, t, lds);
        {
            bf16_t* LW = (bf16_t*)(W + W_LW);
            for (int i = bidx() * 256 + tidx(); i < 512 * 192; i += gridDim.x * 256) {
                const int ch = i / 192, j = i % 192;
                float v;
                if (j < 32) v = p.in[I_W2][((size_t)li * 32 + j) * 512 + ch];
                else if (j < 64) v = p.in[I_A2][((size_t)li * 32 + j - 32) * 512 + ch];
                else if (j < 160) v = p.in[I_G2][((size_t)li * 96 + j - 64) * 512 + ch];
                else v = (li == 1) ? p.in[I_V2][(size_t)(j - 160) * 512 + ch] : 0.f;
                LW[i] = f2bf(v);
            }
        }
        const int r0 = (li == 1) ? 3784 : 3752;
        bf16_t* z = (bf16_t*)(W + W_IN) + (size_t)r0 * 1024;
        const size_t n = (size_t)(EVPAD - r0) * 1024;
        for (size_t i = (size_t)bidx() * 256 + tidx(); i < n; i += (size_t)gridDim.x * 256) z[i] = 0;
    } else {
        const ConvJob j0{p.in[I_ODWIN] + (size_t)li * 1024 * 4608, (bf16_t*)(W + W_IN), 1024, 4608, 1024, 0};
        for (int t = bidx(); t < 16 * 18; t += gridDim.x) conv_tile(j0, t, lds);
        const ConvJob j2{p.in[I_ODWOUT] + (size_t)li * 512 * 1024, (bf16_t*)(W + W_OUT), 512, 1024, 512, 0};
        for (int t = bidx(); t < 8 * 4; t += gridDim.x) conv_tile(j2, t, lds);
    }
}
DI void phase_convert_moe(const P& p, int layer, char* ldsc, int b0, int bs) {
    float* lds = (float*)ldsc;
    unsigned char* W = p.ws + WS_W;
    for (int t = b0; t < 16 * 3 * 16; t += bs) {
        const int e = t / 48, r = t % 48, which = r / 16, tile = r % 16;
        ConvJob j;
        if (which == 0) j = ConvJob{p.in[I_W1] + ((size_t)layer * 16 + e) * 1024 * 256, (bf16_t*)(W + W_13) + (size_t)e * 512 * 1024, 1024, 256, 1024, 1};
        else if (which == 1) j = ConvJob{p.in[I_W3] + ((size_t)layer * 16 + e) * 1024 * 256, (bf16_t*)(W + W_13) + (size_t)e * 512 * 1024, 1024, 256, 1024, 2};
        else j = ConvJob{p.in[I_MW2] + ((size_t)layer * 16 + e) * 256 * 1024, (bf16_t*)(W + W_2) + (size_t)e * 1024 * 256, 256, 1024, 256, 0};
        conv_tile(j, tile, lds);
    }
}

DI void phase_rope(const P& p) {
    float2* tab = (float2*)(p.ws + WS_ROPE);
    const int* pos = (const int*)p.in[I_POS];
    for (int i = bidx() * 256 + tidx(); i < T * 32; i += gridDim.x * 256) {
        const int t = i >> 5, f = i & 31;
        const float inv = powf(10000.0f, -(float)f * (2.0f / 64.0f));
        const float ang = (float)pos[t] * inv;
        float s, c; sincosf(ang, &s, &c);
        tab[i] = make_float2(c, s);
    }
}

template <int MODE>
DI void phase_prep(const P& p, const float* gain, int layer, bool dry = false) {
    const int lane = tidx() & 63, wid = tidx() >> 6;
    const int nw = gridDim.x * 4;
    bf16_t* hn = (bf16_t*)(p.ws + WS_HN);
    const bf16_t* y0 = (const bf16_t*)(p.ws + WS_YS);
    const bf16_t* y1 = y0 + (size_t)T * 1024;
    float4 gq[4];
#pragma unroll
    for (int i = 0; i < 4; ++i) gq[i] = *(const float4*)(gain + i * 256 + lane * 4);
    for (int t = bidx() * 4 + wid; t < T; t += nw) {
        float4 v[4];
        float ss = 0.f;
#pragma unroll
        for (int i = 0; i < 4; ++i) {
            const size_t off = (size_t)t * 1024 + i * 256 + lane * 4;
            if (MODE == 0) v[i] = *(const float4*)(p.in[I_X] + off);
            else v[i] = *(const float4*)(p.out + off);
            if (MODE == 1 || MODE == 3) {
                const u32x2 a = *(const u32x2*)(y0 + off), b = *(const u32x2*)(y1 + off);
                v[i].x += __uint_as_float(a.x << 16) + __uint_as_float(b.x << 16); v[i].y += __uint_as_float(a.x & 0xffff0000u) + __uint_as_float(b.x & 0xffff0000u);
                v[i].z += __uint_as_float(a.y << 16) + __uint_as_float(b.y << 16); v[i].w += __uint_as_float(a.y & 0xffff0000u) + __uint_as_float(b.y & 0xffff0000u);
            }
            ss += v[i].x * v[i].x + v[i].y * v[i].y + v[i].z * v[i].z + v[i].w * v[i].w;
        }
        ss = wave_sum(ss);
        const float rstd = rsqrtf(ss * (1.0f / 1024.0f) + 1e-6f);
        float lg[20];
        if (MODE == 2) {
#pragma unroll
            for (int q = 0; q < 20; ++q) lg[q] = 0.f;
        }
#pragma unroll
        for (int i = 0; i < 4; ++i) {
            const int col = i * 256 + lane * 4;
            const size_t off = (size_t)t * 1024 + col;
            const float4 g = gq[i];
            float4 h; h.x = v[i].x * rstd * g.x; h.y = v[i].y * rstd * g.y; h.z = v[i].z * rstd * g.z; h.w = v[i].w * rstd * g.w;
            float* od = dry ? (float*)(p.ws + WS_DUMMY) + (off & 0x7FFFF) : p.out + off;
            bf16_t* hd = dry ? (bf16_t*)(p.ws + WS_DUMMY + 2097152) + (off & 0x7FFFF) : hn + off;
            if (MODE == 0 || MODE == 1) *(float4*)od = v[i];
            if (MODE == 3) *(float4*)od = h;
            else { u32x2 w; w.x = pack2(h.x, h.y); w.y = pack2(h.z, h.w); *(u32x2*)hd = w; }
            if (MODE == 2) {
                const float hh[4] = {h.x, h.y, h.z, h.w};
                const float* wg = p.in[I_WGROUP] + (size_t)layer * 1024 * 4;
                const float* we = p.in[I_WEXPERT] + (size_t)layer * 4 * 1024 * 4;
#pragma unroll
                for (int e = 0; e < 4; ++e) {
                    const float4 a = *(const float4*)(wg + (size_t)(col + e) * 4);
                    lg[0] += hh[e] * a.x; lg[1] += hh[e] * a.y; lg[2] += hh[e] * a.z; lg[3] += hh[e] * a.w;
#pragma unroll
                    for (int g2 = 0; g2 < 4; ++g2) {
                        const float4 b = *(const float4*)(we + ((size_t)g2 * 1024 + col + e) * 4);
                        lg[4 + g2 * 4 + 0] += hh[e] * b.x; lg[4 + g2 * 4 + 1] += hh[e] * b.y; lg[4 + g2 * 4 + 2] += hh[e] * b.z; lg[4 + g2 * 4 + 3] += hh[e] * b.w;
                    }
                }
            }
        }
        if (MODE == 2) {
#pragma unroll
            for (int q = 0; q < 20; ++q) lg[q] = wave_sum(lg[q]);
            if (lane == 0) {
                int gs = 0; float gm = lg[0];
#pragma unroll
                for (int g2 = 1; g2 < 4; ++g2) if (lg[g2] > gm) { gm = lg[g2]; gs = g2; }
                float den = 0.f;
#pragma unroll
                for (int g2 = 0; g2 < 4; ++g2) den += __expf(lg[g2] - gm);
                const float pg = 1.f / den;
                float el[4];
#pragma unroll
                for (int e = 0; e < 4; ++e) el[e] = gs == 0 ? lg[4 + e] : gs == 1 ? lg[8 + e] : gs == 2 ? lg[12 + e] : lg[16 + e];
                int i1 = 0; float v1 = el[0];
#pragma unroll
                for (int e = 1; e < 4; ++e) if (el[e] > v1) { v1 = el[e]; i1 = e; }
                int i2 = 0; float v2 = -3.4e38f;
#pragma unroll
                for (int e = 0; e < 4; ++e) if (e != i1 && el[e] > v2) { v2 = el[e]; i2 = e; }
                const float e2 = __expf(v2 - v1);
                const float g1 = pg / (1.f + e2), g2v = pg * e2 / (1.f + e2);
                unsigned* cnt = (unsigned*)(p.ws + WS_CTL + CTL_CNT) + layer * 16 * 64;
                int* list = (int*)(p.ws + WS_LIST);
                float* gl = (float*)(p.ws + WS_GATE);
                const int ea = gs * 4 + i1, eb = gs * 4 + i2;
                const unsigned ra = atomicAdd(&cnt[ea * 64], 1u);
                list[ea * 16384 + ra] = t * 2; gl[ea * 16384 + ra] = g1;
                const unsigned rb = atomicAdd(&cnt[eb * 64], 1u);
                list[eb * 16384 + rb] = t * 2 + 1; gl[eb * 16384 + rb] = g2v;
            }
        }
    }
}


DI void phase_router(const P& p, const float* gain, int layer, char* ldsc, bool dry = false) {
    const int tid = tidx(), lane = tid & 63, wid = tid >> 6;
    bf16_t* hn = (bf16_t*)(p.ws + WS_HN);
    const float* wg = p.in[I_WGROUP] + (size_t)layer * 1024 * 4;
    const float* we = p.in[I_WEXPERT] + (size_t)layer * 4 * 1024 * 4;
    unsigned* cnt = dry ? (unsigned*)(p.ws + WS_DUMMY + 3145728) : (unsigned*)(p.ws + WS_CTL + CTL_CNT) + layer * 16 * 64;
    int* list = dry ? (int*)(p.ws + WS_DUMMY) : (int*)(p.ws + WS_LIST);
    float* gl = dry ? (float*)(p.ws + WS_DUMMY + 1048576) : (float*)(p.ws + WS_GATE);
    if (dry) hn = (bf16_t*)(p.ws + WS_DUMMY + 2097152);
    f32x4* WS = (f32x4*)ldsc;
    unsigned* lcnt = (unsigned*)(ldsc + 40960); unsigned* lbase = lcnt + 16; int* e_ent = (int*)(lcnt + 32); unsigned* r_ent = (unsigned*)(e_ent + 32); int* t_ent = (int*)(r_ent + 32); float* g_ent = (float*)(t_ent + 32);
    auto stage = [&](int i, int buf) {
#pragma unroll
        for (int r = 0; r < 5; ++r) {
            const int kk = tid;
            const float* src = (r == 0 ? wg : we + (size_t)(r - 1) * 4096) + (size_t)(i * 256 + kk) * 4;
            WS[buf * 1280 + (r * 4 + (kk & 3)) * 64 + (kk >> 2)] = *(const f32x4*)src;
        }
    };
    for (int tb = bidx() * 16; tb < T; tb += gridDim.x * 16) {
        __syncthreads();
        if (tid < 16) lcnt[tid] = 0u;
        stage(0, 0);
        const int t0 = tb + wid * 4;
        float rstd[4];
#pragma unroll
        for (int q = 0; q < 4; ++q) {
            float ss = 0.f;
#pragma unroll
            for (int i = 0; i < 4; ++i) {
                const float4 x4 = *(const float4*)(p.out + (size_t)(t0 + q) * 1024 + i * 256 + lane * 4);
                ss += x4.x * x4.x + x4.y * x4.y + x4.z * x4.z + x4.w * x4.w;
            }
            ss = wave_sum(ss);
            rstd[q] = rsqrtf(ss * (1.0f / 1024.0f) + 1e-6f);
        }
        float lg[4][20];
#pragma unroll
        for (int q = 0; q < 4; ++q)
#pragma unroll
            for (int j = 0; j < 20; ++j) lg[q][j] = 0.f;
#pragma unroll 1
        for (int i = 0; i < 4; ++i) {
            __syncthreads();
            if (i + 1 < 4) stage(i + 1, (i + 1) & 1);
            const f32x4* W = WS + (i & 1) * 1280;
            const int col = i * 256 + lane * 4;
            const float4 g = *(const float4*)(gain + col);
            float hh[4][4];
#pragma unroll
            for (int q = 0; q < 4; ++q) {
                const float4 x4 = *(const float4*)(p.out + (size_t)(t0 + q) * 1024 + col);
                hh[q][0] = x4.x * rstd[q] * g.x; hh[q][1] = x4.y * rstd[q] * g.y; hh[q][2] = x4.z * rstd[q] * g.z; hh[q][3] = x4.w * rstd[q] * g.w;
                u32x2 w; w.x = pack2(hh[q][0], hh[q][1]); w.y = pack2(hh[q][2], hh[q][3]);
                *(u32x2*)(hn + (dry ? (((size_t)(t0 + q) * 1024 + col) & 0x7FFFF) : ((size_t)(t0 + q) * 1024 + col))) = w;
            }
#pragma unroll
            for (int e = 0; e < 4; ++e) {
                const f32x4 a = W[(0 * 4 + e) * 64 + lane];
#pragma unroll
                for (int q = 0; q < 4; ++q) { lg[q][0] += hh[q][e] * a[0]; lg[q][1] += hh[q][e] * a[1]; lg[q][2] += hh[q][e] * a[2]; lg[q][3] += hh[q][e] * a[3]; }
#pragma unroll
                for (int g2 = 0; g2 < 4; ++g2) {
                    const f32x4 b = W[((1 + g2) * 4 + e) * 64 + lane];
#pragma unroll
                    for (int q = 0; q < 4; ++q) { lg[q][4 + g2 * 4] += hh[q][e] * b[0]; lg[q][5 + g2 * 4] += hh[q][e] * b[1]; lg[q][6 + g2 * 4] += hh[q][e] * b[2]; lg[q][7 + g2 * 4] += hh[q][e] * b[3]; }
                }
            }
        }
#pragma unroll
        for (int q = 0; q < 4; ++q) {
#pragma unroll
            for (int j = 0; j < 20; ++j) lg[q][j] = wave_sum(lg[q][j]);
            if (lane == q) {
                const int t = t0 + q;
                int gs = 0; float gm = lg[q][0];
#pragma unroll
                for (int g2 = 1; g2 < 4; ++g2) if (lg[q][g2] > gm) { gm = lg[q][g2]; gs = g2; }
                float den = 0.f;
#pragma unroll
                for (int g2 = 0; g2 < 4; ++g2) den += __expf(lg[q][g2] - gm);
                const float pg = 1.f / den;
                float el[4];
#pragma unroll
                for (int e = 0; e < 4; ++e) el[e] = gs == 0 ? lg[q][4 + e] : gs == 1 ? lg[q][8 + e] : gs == 2 ? lg[q][12 + e] : lg[q][16 + e];
                int i1 = 0; float v1 = el[0];
#pragma unroll
                for (int e = 1; e < 4; ++e) if (el[e] > v1) { v1 = el[e]; i1 = e; }
                int i2 = 0; float v2 = -3.4e38f;
#pragma unroll
                for (int e = 0; e < 4; ++e) if (e != i1 && el[e] > v2) { v2 = el[e]; i2 = e; }
                const float e2 = __expf(v2 - v1);
                const float g1 = pg / (1.f + e2), g2v = pg * e2 / (1.f + e2);
                const int ea = gs * 4 + i1, eb = gs * 4 + i2;
                const int sl = (wid * 4 + q) * 2;
                e_ent[sl] = ea; r_ent[sl] = atomicAdd(&lcnt[ea], 1u); t_ent[sl] = t * 2; g_ent[sl] = g1;
                e_ent[sl + 1] = eb; r_ent[sl + 1] = atomicAdd(&lcnt[eb], 1u); t_ent[sl + 1] = t * 2 + 1; g_ent[sl + 1] = g2v;
            }
        }
        __syncthreads();
        if (tid < 16) lbase[tid] = lcnt[tid] ? atomicAdd(&cnt[tid * 64], lcnt[tid]) : 0u;
        __syncthreads();
        if (tid < 32) {
            const int e = e_ent[tid];
            const unsigned pos = (lbase[e] + r_ent[tid]) & 16383u;
            list[e * 16384 + pos] = t_ent[tid]; gl[e * 16384 + pos] = g_ent[tid];
        }
    }
}

constexpr int GBK = 64;
typedef __attribute__((address_space(3))) unsigned lds_u32;
struct TileP { const bf16_t* ar[4]; const bf16_t* br[4]; const bf16_t* ar2[4]; };
DI void gemm_core(const TileP& tp, int K, char* lds, f32x4 (&acc)[4][4], int ksplit, bool primed, const TileP& nx, bool have_nx) {
    const bf16_t* const (&ar)[4] = tp.ar; const bf16_t* const (&br)[4] = tp.br; const bf16_t* const (&ar2)[4] = tp.ar2;
    const int tid = tidx(), wid = tid >> 6, lane = tid & 63, wr = wid >> 1, wc = wid & 1, fr = lane & 15, fq = lane >> 4;
    const int scol = ((tid & 7) ^ ((tid >> 3) & 7)) * 8;
#pragma unroll
    for (int n = 0; n < 4; ++n)
#pragma unroll
        for (int m = 0; m < 4; ++m) acc[n][m] = (f32x4){0.f, 0.f, 0.f, 0.f};
    const int nk = K / GBK;
    if (!primed) {
        __syncthreads();
#pragma unroll
        for (int i = 0; i < 4; ++i) {
            __builtin_amdgcn_global_load_lds((const unsigned*)(ar[i] + scol), (lds_u32*)(lds + tid * 16 + i * 4096), 16, 0, 0);
            __builtin_amdgcn_global_load_lds((const unsigned*)(br[i] + scol), (lds_u32*)(lds + 16384 + tid * 16 + i * 4096), 16, 0, 0);
        }
    }
    const int sw = fr & 7;
    for (int kt = 0; kt < nk; ++kt) {
        asm volatile("s_waitcnt vmcnt(0)" ::: "memory");
        __builtin_amdgcn_s_barrier();
        if (kt + 1 < nk) {
            char* nb = lds + ((kt + 1) & 1) * 32768;
            const int ko = (kt + 1) * GBK + scol;
#pragma unroll
            for (int i = 0; i < 4; ++i) {
                __builtin_amdgcn_global_load_lds((const unsigned*)(((kt + 1) * GBK >= ksplit ? ar2[i] : ar[i]) + ko), (lds_u32*)(nb + tid * 16 + i * 4096), 16, 0, 0);
                __builtin_amdgcn_global_load_lds((const unsigned*)(br[i] + ko), (lds_u32*)(nb + 16384 + tid * 16 + i * 4096), 16, 0, 0);
            }
        } else if (have_nx) {
#pragma unroll
            for (int i = 0; i < 4; ++i) {
                __builtin_amdgcn_global_load_lds((const unsigned*)(nx.ar[i] + scol), (lds_u32*)(lds + tid * 16 + i * 4096), 16, 0, 0);
                __builtin_amdgcn_global_load_lds((const unsigned*)(nx.br[i] + scol), (lds_u32*)(lds + 16384 + tid * 16 + i * 4096), 16, 0, 0);
            }
        }
        const char* SA = lds + (kt & 1) * 32768; const char* SB = SA + 16384;
#pragma unroll
        for (int kh = 0; kh < 2; ++kh) {
            bf16x8 af[4], bfr[4];
            const int co = ((kh * 4 + fq) ^ sw) * 16;
#pragma unroll
            for (int m = 0; m < 4; ++m) af[m] = *(const bf16x8*)(SA + (wr * 64 + m * 16 + fr) * 128 + co);
#pragma unroll
            for (int n = 0; n < 4; ++n) bfr[n] = *(const bf16x8*)(SB + (wc * 64 + n * 16 + fr) * 128 + co);
#pragma unroll
            for (int n = 0; n < 4; ++n)
#pragma unroll
                for (int m = 0; m < 4; ++m) acc[n][m] = __builtin_amdgcn_mfma_f32_16x16x32_bf16(bfr[n], af[m], acc[n][m], 0, 0, 0);
        }
    }
}

enum { EPI_EVEN_IN = 0, EPI_ODD_IN, EPI_RESID };
template <int EPI>
DI void phase_gemm(const P& p, const bf16_t* A, int lda, const bf16_t* Bt, int K, int ntn, char* lds, bool dry = false, const bf16_t* A2 = nullptr, int lda2 = 0, int ksplit = 1 << 30) {
    const int tid = tidx(), wid = tid >> 6, lane = tid & 63, wr = wid >> 1, wc = wid & 1, fr = lane & 15, fq = lane >> 4;
    const int ntm = T / 128, ntiles = ntm * ntn;
    auto fill = [&](TileP& t, int tile) {
        const int tn = tile / ntm, tm = tile % ntm, r = tid >> 3;
#pragma unroll
        for (int i = 0; i < 4; ++i) { t.ar[i] = A + (size_t)(tm * 128 + r + 32 * i) * lda; t.br[i] = Bt + (size_t)(tn * 128 + r + 32 * i) * K; t.ar2[i] = A2 ? A2 + (size_t)(tm * 128 + r + 32 * i) * lda2 : t.ar[i]; }
    };
    TileP cur, nxt;
    bool primed = false;
    fill(cur, bidx() < ntiles ? bidx() : 0); nxt = cur;
    for (int tile = bidx(); tile < ntiles; tile += gridDim.x) {
        const int tn = tile / ntm, tm = tile % ntm;
        const bool have_next = tile + (int)gridDim.x < ntiles;
        if (have_next) fill(nxt, tile + gridDim.x);
        f32x4 acc[4][4];
        gemm_core(cur, K, lds, acc, ksplit, primed, nxt, have_next);
        primed = have_next; cur = nxt;
        const int m0 = tm * 128 + wr * 64, n0 = tn * 128 + wc * 64;
        if (EPI == EPI_EVEN_IN) {
            bf16_t* C = (bf16_t*)(p.ws + WS_PROJ);
#pragma unroll
            for (int m = 0; m < 4; ++m)
#pragma unroll
                for (int n = 0; n < 4; ++n) {
                    const int row = m0 + m * 16 + fr, col = n0 + n * 16 + fq * 4;
                    if (col < EVC) { u32x2 w; w.x = pack2(acc[n][m][0], acc[n][m][1]); w.y = pack2(acc[n][m][2], acc[n][m][3]); *(u32x2*)(C + (size_t)row * EVLD + col) = w; }
                }
        } else if (EPI == EPI_ODD_IN) {
            bf16_t* C = (bf16_t*)(p.ws + WS_QK);
            const float2* tab = (const float2*)(p.ws + WS_ROPE);
            if (n0 < 3072) {
#pragma unroll
                for (int m = 0; m < 4; ++m) {
                    const int row = m0 + m * 16 + fr;
#pragma unroll
                    for (int n = 0; n < 2; ++n) {
                        float lo[4], hi[4];
#pragma unroll
                        for (int j = 0; j < 4; ++j) {
                            const float2 cs = tab[(size_t)row * 32 + n * 16 + fq * 4 + j];
                            const float x1 = acc[n][m][j], x2 = acc[n + 2][m][j];
                            lo[j] = x1 * cs.x - x2 * cs.y; hi[j] = x2 * cs.x + x1 * cs.y;
                        }
                        u32x2 w; w.x = pack2(lo[0], lo[1]); w.y = pack2(lo[2], lo[3]);
                        *(u32x2*)(C + (size_t)row * 3072 + n0 + n * 16 + fq * 4) = w;
                        w.x = pack2(hi[0], hi[1]); w.y = pack2(hi[2], hi[3]);
                        *(u32x2*)(C + (size_t)row * 3072 + n0 + (n + 2) * 16 + fq * 4) = w;
                    }
                }
            }
            if (tn * 128 >= 3072) {
                bf16_t* VT = (bf16_t*)(p.ws + WS_VT);
                const int hg0 = (tn * 128 - 3072) >> 6, g = hg0 >> 3, lg2 = g * 2, dil = 1 << lg2, L = SEQ >> lg2, run = 128 >> lg2;
                __syncthreads();
#pragma unroll
                for (int m = 0; m < 4; ++m)
#pragma unroll
                    for (int n = 0; n < 4; ++n)
#pragma unroll
                        for (int j = 0; j < 4; ++j)
                            *(bf16_t*)(lds + 32768 + (wc * 64 + n * 16 + fq * 4 + j) * 272 + (wr * 64 + m * 16 + fr) * 2) = f2bf(acc[n][m][j]);
                __syncthreads();
                const int bb = (tm * 128) >> 12, s0 = (tm * 128) & (SEQ - 1);
#pragma unroll
                for (int q = 0; q < 8; ++q) {
                    const int item = tid + q * 256, dim = item >> 4, o0 = (item & 15) * 8;
                    const int rr = o0 / run, i0 = o0 % run;
                    const char* src = lds + 32768 + dim * 272 + (rr + dil * i0) * 2;
                    float e8[8];
#pragma unroll
                    for (int e = 0; e < 8; ++e) e8[e] = bf2f(*(const bf16_t*)(src + e * dil * 2));
                    u32x4 w; w.x = pack2(e8[0], e8[1]); w.y = pack2(e8[2], e8[3]); w.z = pack2(e8[4], e8[5]); w.w = pack2(e8[6], e8[7]);
                    const int hg = hg0 + (dim >> 6);
                    *(u32x4*)(VT + ((size_t)((bb * 24 + hg) * dil + rr) * 64 + (dim & 63)) * L + (s0 >> lg2) + i0) = w;
                }
            }
        } else {
#pragma unroll
            for (int m = 0; m < 4; ++m)
#pragma unroll
                for (int n = 0; n < 4; ++n) {
                    const size_t qo = (size_t)(m0 + m * 16 + fr) * 1024 + n0 + n * 16 + fq * 4;
                    float* q = dry ? (float*)(p.ws + WS_DUMMY) + (qo & 0x7FFFF) : p.out + qo;
                    float4 v = *(float4*)q;
                    v.x += acc[n][m][0]; v.y += acc[n][m][1]; v.z += acc[n][m][2]; v.w += acc[n][m][3];
                    *(float4*)q = v;
                }
        }
    }
}

DI void phase_moe_up(const P& p, int layer, char* lds) {
    const int tid = tidx(), wid = tid >> 6, lane = tid & 63, wr = wid >> 1, wc = wid & 1, fr = lane & 15, fq = lane >> 4;
    const unsigned* cntb = (const unsigned*)(p.ws + WS_CTL + CTL_CNT) + layer * 16 * 64;
    unsigned cnt[16];
#pragma unroll
    for (int e = 0; e < 16; ++e) cnt[e] = cntb[e * 64];
    const int* list = (const int*)(p.ws + WS_LIST);
    const float* gl = (const float*)(p.ws + WS_GATE);
    const bf16_t* hn = (const bf16_t*)(p.ws + WS_HN);
    const bf16_t* W13 = (const bf16_t*)(p.ws + WS_W + W_13);
    bf16_t* H = (bf16_t*)(p.ws + WS_H);
    int ttot = 0;
#pragma unroll
    for (int e = 0; e < 16; ++e) ttot += ((int)cnt[e] + 127) >> 7;
    const int ntiles = ttot * 4;
    auto locate = [&](int tile, int& e, int& lt, int& ce, int& rbe, int& tn) {
        const int mt = tile >> 2; tn = tile & 3;
        int tbe = 0, acc_t = 0; e = 0;
#pragma unroll
        for (int q = 0; q < 16; ++q) { const int nt = ((int)cnt[q] + 127) >> 7; if (mt >= acc_t) { e = q; tbe = acc_t; } acc_t += nt; }
        lt = mt - tbe; ce = (int)cnt[e]; rbe = tbe * 128;
    };
    auto fill = [&](TileP& t, int tile) {
        int e, lt, ce, rbe, tn; locate(tile, e, lt, ce, rbe, tn);
        const int r = tid >> 3;
#pragma unroll
        for (int i = 0; i < 4; ++i) {
            const int ii = lt * 128 + r + 32 * i;
            const int tk = ii < ce ? (list[e * 16384 + ii] >> 1) : 0;
            t.ar[i] = hn + (size_t)tk * 1024; t.ar2[i] = t.ar[i];
            t.br[i] = W13 + ((size_t)e * 512 + tn * 128 + r + 32 * i) * 1024;
        }
    };
    TileP cur, nxt;
    bool primed = false;
    fill(cur, bidx() < ntiles ? bidx() : 0); nxt = cur;
    for (int tile = bidx(); tile < ntiles; tile += gridDim.x) {
        int e, lt, ce, rbe, tn; locate(tile, e, lt, ce, rbe, tn);
        const bool have_next = tile + (int)gridDim.x < ntiles;
        if (have_next) fill(nxt, tile + gridDim.x);
        f32x4 acc[4][4];
        gemm_core(cur, 1024, lds, acc, 1 << 30, primed, nxt, have_next);
        primed = have_next; cur = nxt;
#pragma unroll
        for (int m = 0; m < 4; ++m) {
            const int li = lt * 128 + wr * 64 + m * 16 + fr;
            if (li < ce) {
                const float g = gl[e * 16384 + li];
                bf16_t* hrow = H + (size_t)(rbe + li) * 256;
#pragma unroll
                for (int n = 0; n < 4; n += 2) {
                    float o[4];
#pragma unroll
                    for (int j = 0; j < 4; ++j) o[j] = siluf_(acc[n][m][j]) * acc[n + 1][m][j] * g;
                    const int f = tn * 64 + wc * 32 + (n >> 1) * 16 + fq * 4;
                    u32x2 w; w.x = pack2(o[0], o[1]); w.y = pack2(o[2], o[3]);
                    *(u32x2*)(hrow + f) = w;
                }
            }
        }
    }
}
DI void phase_moe_down(const P& p, int layer, char* lds) {
    const int tid = tidx(), wid = tid >> 6, lane = tid & 63, wr = wid >> 1, wc = wid & 1, fr = lane & 15, fq = lane >> 4;
    const unsigned* cntb = (const unsigned*)(p.ws + WS_CTL + CTL_CNT) + layer * 16 * 64;
    unsigned cnt[16];
#pragma unroll
    for (int e = 0; e < 16; ++e) cnt[e] = cntb[e * 64];
    const int* list = (const int*)(p.ws + WS_LIST);
    const bf16_t* W2 = (const bf16_t*)(p.ws + WS_W + W_2);
    const bf16_t* H = (const bf16_t*)(p.ws + WS_H);
    bf16_t* ys = (bf16_t*)(p.ws + WS_YS);
    int ttot = 0;
#pragma unroll
    for (int e = 0; e < 16; ++e) ttot += ((int)cnt[e] + 127) >> 7;
    const int ntiles = ttot * 8;
    auto locate = [&](int tile, int& e, int& lt, int& ce, int& rbe, int& tn) {
        const int mt = tile >> 3; tn = tile & 7;
        int tbe = 0, acc_t = 0; e = 0;
#pragma unroll
        for (int q = 0; q < 16; ++q) { const int nt = ((int)cnt[q] + 127) >> 7; if (mt >= acc_t) { e = q; tbe = acc_t; } acc_t += nt; }
        lt = mt - tbe; ce = (int)cnt[e]; rbe = tbe * 128;
    };
    auto fill = [&](TileP& t, int tile) {
        int e, lt, ce, rbe, tn; locate(tile, e, lt, ce, rbe, tn);
        const int r = tid >> 3;
#pragma unroll
        for (int i = 0; i < 4; ++i) { t.ar[i] = H + (size_t)(rbe + lt * 128 + r + 32 * i) * 256; t.ar2[i] = t.ar[i]; t.br[i] = W2 + ((size_t)e * 1024 + tn * 128 + r + 32 * i) * 256; }
    };
    TileP cur, nxt;
    bool primed = false;
    fill(cur, bidx() < ntiles ? bidx() : 0); nxt = cur;
    for (int tile = bidx(); tile < ntiles; tile += gridDim.x) {
        int e, lt, ce, rbe, tn; locate(tile, e, lt, ce, rbe, tn);
        const bool have_next = tile + (int)gridDim.x < ntiles;
        if (have_next) fill(nxt, tile + gridDim.x);
        f32x4 acc[4][4];
        gemm_core(cur, 256, lds, acc, 1 << 30, primed, nxt, have_next);
        primed = have_next; cur = nxt;
#pragma unroll
        for (int m = 0; m < 4; ++m) {
            const int li = lt * 128 + wr * 64 + m * 16 + fr;
            if (li < ce) {
                const int ts = list[e * 16384 + li];
                bf16_t* yrow = ys + ((size_t)(ts & 1) * T + (ts >> 1)) * 1024 + tn * 128 + wc * 64 + fq * 4;
#pragma unroll
                for (int n = 0; n < 4; ++n) { u32x2 w; w.x = pack2(acc[n][m][0], acc[n][m][1]); w.y = pack2(acc[n][m][2], acc[n][m][3]); *(u32x2*)(yrow + n * 16) = w; }
            }
        }
    }
}


typedef float f32x16 __attribute__((ext_vector_type(16)));
DI f32x4 mfma16(bf16x8 a, bf16x8 b, f32x4 c) { return __builtin_amdgcn_mfma_f32_16x16x32_bf16(a, b, c, 0, 0, 0); }
DI f32x16 mfma32(bf16x8 a, bf16x8 b, f32x16 c) { return __builtin_amdgcn_mfma_f32_32x32x16_bf16(a, b, c, 0, 0, 0); }
DI f32x4 tile16(const char* X, int ldx, int row0, const char* Y, int ldy, int col0, int K) {
    const int lane = tidx() & 63, fr = lane & 15, fq = lane >> 4;
    f32x4 acc = {0.f, 0.f, 0.f, 0.f};
#pragma unroll
    for (int k = 0; k < K; k += 32) {
        const bf16x8 a = *(const bf16x8*)(X + (row0 + fr) * ldx + (k + fq * 8) * 2);
        const bf16x8 b = *(const bf16x8*)(Y + (col0 + fr) * ldy + (k + fq * 8) * 2);
        acc = mfma16(a, b, acc);
    }
    return acc;
}
DI bf16x8 pack_step(const f32x16& x, int s) {
    u32x4 r;
    r.x = pack2(x[8 * s + 0], x[8 * s + 1]); r.y = pack2(x[8 * s + 2], x[8 * s + 3]);
    r.z = pack2(x[8 * s + 4], x[8 * s + 5]); r.w = pack2(x[8 * s + 6], x[8 * s + 7]);
    return __builtin_bit_cast(bf16x8, r);
}

constexpr int GP_LF = 0, GP_T = 17408, GP_VEC = GP_T + 9216, GP_U = GP_VEC + 1024, GP_END = GP_U + 36864;
DI void gdn_prep_unit(const P& p, int li, int ch, char* lds) {
    const int tid = tidx(), lane = tid & 63, wid = tid >> 6, fr = lane & 15, fq = lane >> 4;
    const int h = ch & 3, n = (ch >> 2) & 63, b = ch >> 8;
    const int t0 = b * SEQ + n * 64;
    float* Lf = (float*)(lds + GP_LF);
    char* Trow = lds + GP_T;
    float* gcs = (float*)(lds + GP_VEC); float* egc = gcs + 64; float* bet = gcs + 128; float* ekd = gcs + 192;
    char* Qrow = lds + GP_U; char* Krow = Qrow + 17408; char* VbT = lds + GP_U; char* KbgT = VbT + 18432;
    const bf16_t* proj = (const bf16_t*)(p.ws + WS_PROJ);
    unsigned char* ops = p.ws + WS_GOPS + (size_t)ch * GOPS_CH;
    const float* cw = p.in[I_CONVW] + (size_t)li * 4 * 1536;
    const int c = tid >> 2, cq = tid & 3;
    __syncthreads();
    float* cwl = (float*)(lds + GP_END);
    for (int i = tid; i < 4 * 3 * 32; i += 256) {
        const int j = i / 96, r = i % 96, sl = r >> 5, q4 = (r & 31) * 4;
        *(f32x4*)(cwl + (j * 3 + sl) * 128 + q4) = *(const f32x4*)(cw + j * 1536 + sl * 512 + h * 128 + q4);
    }
    __syncthreads();
    unsigned vvp[16];
#pragma unroll 1
    for (int which = 0; which < 3; ++which) {
        const int col0 = which * 512 + h * 128 + cq * 32;
        u32x4 xin[4][4];
#pragma unroll
        for (int j = 0; j < 4; ++j) {
            const int sp = n * 64 + c - 3 + j;
            const bf16_t* src = proj + (size_t)(b * SEQ + (sp < 0 ? 0 : sp)) * EVLD + col0;
#pragma unroll
            for (int i4 = 0; i4 < 4; ++i4) xin[j][i4] = *(const u32x4*)(src + i4 * 8);
        }
        float acc[32];
#pragma unroll
        for (int i = 0; i < 32; ++i) acc[i] = 0.f;
#pragma unroll
        for (int j = 0; j < 4; ++j) {
            const float ok = (n * 64 + c - 3 + j) >= 0 ? 1.f : 0.f;
            const float* wj = cwl + (j * 3 + which) * 128 + cq * 32;
#pragma unroll
            for (int i4 = 0; i4 < 4; ++i4) {
                const f32x4 wa = *(const f32x4*)(wj + i4 * 8), wb = *(const f32x4*)(wj + i4 * 8 + 4);
                const u32x4 w = xin[j][i4];
                acc[i4 * 8 + 0] += ok * wa[0] * __uint_as_float(w[0] << 16); acc[i4 * 8 + 1] += ok * wa[1] * __uint_as_float(w[0] & 0xffff0000u);
                acc[i4 * 8 + 2] += ok * wa[2] * __uint_as_float(w[1] << 16); acc[i4 * 8 + 3] += ok * wa[3] * __uint_as_float(w[1] & 0xffff0000u);
                acc[i4 * 8 + 4] += ok * wb[0] * __uint_as_float(w[2] << 16); acc[i4 * 8 + 5] += ok * wb[1] * __uint_as_float(w[2] & 0xffff0000u);
                acc[i4 * 8 + 6] += ok * wb[2] * __uint_as_float(w[3] << 16); acc[i4 * 8 + 7] += ok * wb[3] * __uint_as_float(w[3] & 0xffff0000u);
            }
        }
        float ss = 0.f;
#pragma unroll
        for (int i = 0; i < 32; ++i) { acc[i] = siluf_(acc[i]); ss += acc[i] * acc[i]; }
        ss += __shfl_xor(ss, 1); ss += __shfl_xor(ss, 2);
        const float rn = which == 2 ? 1.f : rsqrtf(ss + 1e-6f) * (which == 0 ? 0.08838834764831845f : 1.f);
        unsigned pk[16];
#pragma unroll
        for (int i = 0; i < 16; ++i) pk[i] = pack2(acc[2 * i] * rn, acc[2 * i + 1] * rn);
        if (which < 2) {
            char* img = which == 0 ? Qrow : Krow;
#pragma unroll
            for (int i4 = 0; i4 < 4; ++i4) { u32x4 w; w.x = pk[i4 * 4]; w.y = pk[i4 * 4 + 1]; w.z = pk[i4 * 4 + 2]; w.w = pk[i4 * 4 + 3]; *(u32x4*)(img + c * 272 + (cq * 32 + i4 * 8) * 2) = w; }
        } else {
#pragma unroll
            for (int i = 0; i < 16; ++i) vvp[i] = pk[i];
        }
    }
    if (cq == 0) {
        const float a = bf2f(proj[(size_t)(t0 + c) * EVLD + 2048 + h]);
        const float bb = bf2f(proj[(size_t)(t0 + c) * EVLD + 2052 + h]);
        const float Aexp = __expf(p.in[I_ALOG][li * 4 + h]), dtb = p.in[I_DTB][li * 4 + h];
        gcs[c] = -Aexp * softplusf_(a + dtb);
        bet[c] = sigmoidf_(bb);
    }
    __syncthreads();
    if (wid == 0) {
        float x = gcs[lane];
#pragma unroll
        for (int o = 1; o < 64; o <<= 1) { const float y = __shfl_up(x, o); if (lane >= o) x += y; }
        const float gl = __shfl(x, 63);
        gcs[lane] = x; egc[lane] = __expf(x); ekd[lane] = __expf(gl - x);
        if (lane == 63) ((float*)(p.ws + WS_CTL + CTL_EGL))[ch] = __expf(gl);
    }
    __syncthreads();
    {
        const int ti = wid;
#pragma unroll
        for (int tj = 0; tj < 4; ++tj) {
            if (tj <= ti) {
                const f32x4 kk = tile16(Krow, 272, 16 * ti, Krow, 272, 16 * tj, 128);
                const int c2 = 16 * tj + fr;
                f32x4 lv;
#pragma unroll
                for (int r = 0; r < 4; ++r) {
                    const int c1 = 16 * ti + fq * 4 + r;
                    lv[r] = (c1 > c2) ? bet[c1] * kk[r] * __expf(gcs[c1] - gcs[c2]) : 0.f;
                }
                *(f32x4*)&Lf[c2 * 68 + 16 * ti + fq * 4] = lv;
            }
            f32x4 qk = {0.f, 0.f, 0.f, 0.f};
            if (tj <= ti) qk = tile16(Krow, 272, 16 * tj, Qrow, 272, 16 * ti, 128);
            const int c1 = 16 * ti + fr;
            float o4[4];
#pragma unroll
            for (int r = 0; r < 4; ++r) { const int c2 = 16 * tj + fq * 4 + r; o4[r] = (c1 >= c2) ? qk[r] * __expf(gcs[c1] - gcs[c2]) : 0.f; }
            const int mt = c1 >> 5, rr = c1 & 31, hh = fq & 1, jg = fq >> 1;
            u32x2 w; w.x = pack2(o4[0], o4[1]); w.y = pack2(o4[2], o4[3]);
            *(u32x2*)(ops + GO_AF + ((size_t)((mt * 4 + tj) * 64 + hh * 32 + rr) * 8 + jg * 4) * 2) = w;
        }
#pragma unroll
        for (int i = 0; i < 4; ++i) {
            const int idx = tid + i * 256;
            {
                const int mt = idx >> 9, ks = (idx >> 6) & 7, l2 = idx & 63, rr = l2 & 31, hh = l2 >> 5, cc = 32 * mt + rr;
                const float sc = egc[cc];
                const u32x2 lo = *(const u32x2*)(Qrow + cc * 272 + (16 * ks + 4 * hh) * 2), hi = *(const u32x2*)(Qrow + cc * 272 + (16 * ks + 8 + 4 * hh) * 2);
                u32x4 w;
                w.x = pack2(__uint_as_float(lo.x << 16) * sc, __uint_as_float(lo.x & 0xffff0000u) * sc); w.y = pack2(__uint_as_float(lo.y << 16) * sc, __uint_as_float(lo.y & 0xffff0000u) * sc);
                w.z = pack2(__uint_as_float(hi.x << 16) * sc, __uint_as_float(hi.x & 0xffff0000u) * sc); w.w = pack2(__uint_as_float(hi.y << 16) * sc, __uint_as_float(hi.y & 0xffff0000u) * sc);
                *(u32x4*)(ops + GO_QF + (size_t)idx * 16) = w;
            }
            {
                const int mt = idx >> 8, ks = (idx >> 6) & 3, l2 = idx & 63, rr = l2 & 31, hh = l2 >> 5, dk = 32 * mt + rr;
                float e8[8];
#pragma unroll
                for (int j = 0; j < 8; ++j) { const int c2 = 16 * ks + 8 * (j >> 2) + 4 * hh + (j & 3); e8[j] = bf2f(*(const bf16_t*)(Krow + c2 * 272 + dk * 2)) * ekd[c2]; }
                u32x4 w; w.x = pack2(e8[0], e8[1]); w.y = pack2(e8[2], e8[3]); w.z = pack2(e8[4], e8[5]); w.w = pack2(e8[6], e8[7]);
                *(u32x4*)(ops + GO_KF + (size_t)idx * 16) = w;
            }
        }
    }
    __syncthreads();
    {
        const float bc = bet[c], bg = bc * egc[c];
        unsigned kvp[16];
#pragma unroll
        for (int i4 = 0; i4 < 4; ++i4) { const u32x4 w = *(const u32x4*)(Krow + c * 272 + (cq * 32 + i4 * 8) * 2); kvp[i4 * 4] = w.x; kvp[i4 * 4 + 1] = w.y; kvp[i4 * 4 + 2] = w.z; kvp[i4 * 4 + 3] = w.w; }
        __syncthreads();
#pragma unroll
        for (int i = 0; i < 16; ++i) {
            *(bf16_t*)(VbT + (cq * 32 + 2 * i) * 144 + c * 2) = f2bf(__uint_as_float(vvp[i] << 16) * bc);
            *(bf16_t*)(VbT + (cq * 32 + 2 * i + 1) * 144 + c * 2) = f2bf(__uint_as_float(vvp[i] & 0xffff0000u) * bc);
            *(bf16_t*)(KbgT + (cq * 32 + 2 * i) * 144 + c * 2) = f2bf(__uint_as_float(kvp[i] << 16) * bg);
            *(bf16_t*)(KbgT + (cq * 32 + 2 * i + 1) * 144 + c * 2) = f2bf(__uint_as_float(kvp[i] & 0xffff0000u) * bg);
        }
    }
    {
        char* L21i = lds + GP_END;
        char* T11T = L21i + 2560;
        char* MT = T11T + 2560;
        if (wid < 2) {
            const int o = 32 * wid;
            float Tc[32];
#pragma unroll
            for (int i = 0; i < 32; ++i) Tc[i] = (i == (lane & 31)) ? 1.f : 0.f;
#pragma unroll
            for (int j = 0; j < 31; ++j) {
                const float tj = Tc[j];
#pragma unroll
                for (int i4 = (j + 1) >> 2; i4 < 8; ++i4) {
                    const f32x4 l4 = *(const f32x4*)&Lf[(o + j) * 68 + o + i4 * 4];
#pragma unroll
                    for (int e = 0; e < 4; ++e) if (i4 * 4 + e > j) Tc[i4 * 4 + e] -= l4[e] * tj;
                }
            }
            if (lane < 32) {
#pragma unroll
                for (int i = 0; i < 32; ++i) *(bf16_t*)(Trow + (o + i) * 144 + (o + lane) * 2) = f2bf(Tc[i]);
                if (wid == 0) {
#pragma unroll
                    for (int i = 0; i < 32; ++i) *(bf16_t*)(Trow + i * 144 + (32 + lane) * 2) = 0;
#pragma unroll
                    for (int i4 = 0; i4 < 8; ++i4) { u32x2 w; w.x = pack2(Tc[i4 * 4], Tc[i4 * 4 + 1]); w.y = pack2(Tc[i4 * 4 + 2], Tc[i4 * 4 + 3]); *(u32x2*)(T11T + lane * 80 + i4 * 8) = w; }
                }
            }
        } else {
            const int t2 = tid - 128;
#pragma unroll
            for (int g2 = 0; g2 < 2; ++g2) {
                const int i = t2 & 31, k4 = ((t2 >> 5) + 4 * g2) * 4;
                u32x2 w;
                w.x = pack2(Lf[(k4 + 0) * 68 + 32 + i], Lf[(k4 + 1) * 68 + 32 + i]); w.y = pack2(Lf[(k4 + 2) * 68 + 32 + i], Lf[(k4 + 3) * 68 + 32 + i]);
                *(u32x2*)(L21i + i * 80 + k4 * 2) = w;
            }
        }
        __syncthreads();
        {
            const int r0 = 16 * (wid >> 1), c0 = 16 * (wid & 1);
            const f32x4 mm = tile16(L21i, 80, r0, T11T, 80, c0, 32);
            u32x2 w; w.x = pack2(mm[0], mm[1]); w.y = pack2(mm[2], mm[3]);
            *(u32x2*)(MT + (c0 + fr) * 80 + (r0 + 4 * fq) * 2) = w;
        }
        __syncthreads();
        {
            const int r0 = 16 * (wid >> 1), c0 = 16 * (wid & 1);
            const f32x4 tt = tile16(MT, 80, c0, Trow + 32 * 144 + 64, 144, r0, 32);
            u32x2 w; w.x = pack2(-tt[0], -tt[1]); w.y = pack2(-tt[2], -tt[3]);
            *(u32x2*)(Trow + (32 + r0 + fr) * 144 + (c0 + 4 * fq) * 2) = w;
        }
    }
    __syncthreads();
#pragma unroll
    for (int tq = 0; tq < 2; ++tq) {
        const int tj = wid * 2 + tq;
#pragma unroll
        for (int ti = 0; ti < 4; ++ti) {
            const f32x4 u = tile16(Trow, 144, 16 * ti, VbT, 144, 16 * tj, 64);
            {
                const int dv = 16 * tj + fr, slice = dv >> 5, rr = dv & 31, cb = 16 * ti + fq * 4, mt = cb >> 5, q4 = (cb & 31) >> 2, hh = q4 & 1, rg = q4 >> 1;
                u32x2 w; w.x = pack2(u[0], u[1]); w.y = pack2(u[2], u[3]);
                *(u32x2*)(ops + GO_UF + ((size_t)((slice * 2 + mt) * 64 + hh * 32 + rr) * 16 + rg * 4) * 2) = w;
            }
            const f32x4 wv = tile16(KbgT, 144, 16 * tj, Trow, 144, 16 * ti, 64);
            {
                const int c1 = 16 * ti + fr, mt = c1 >> 5, rr = c1 & 31, hh = fq & 1, jg = fq >> 1;
                u32x2 w; w.x = pack2(wv[0], wv[1]); w.y = pack2(wv[2], wv[3]);
                *(u32x2*)(ops + GO_WF + ((size_t)((mt * 8 + tj) * 64 + hh * 32 + rr) * 8 + jg * 4) * 2) = w;
            }
        }
    }
}

DI void glds16(const void* g, char* l) { __builtin_amdgcn_global_load_lds((const unsigned*)g, (lds_u32*)l, 16, 0, 0); }
#define GS_WAIT(n) asm volatile("s_waitcnt vmcnt(" #n ")" ::: "memory")
DI void gdn_scan_block(const P& p, int bh, char* lds, bool dry = false) {
    const int tid = tidx(), lane = tid & 63, w = tid >> 6;
    const int h = bh & 3, b = bh >> 2;
    const float eglv = ((const float*)(p.ws + WS_CTL + CTL_EGL))[(b * 64 + lane) * 4 + h];
    unsigned char* gbase = p.ws + WS_GOPS + (size_t)(b * 256 + h) * GOPS_CH;
    auto issue = [&](int n, int k0, int cntk) {
        for (int k = k0; k < k0 + cntk; ++k) {
            const unsigned char* src = gbase + (size_t)n * 4 * GOPS_CH + k * 8192 + tid * 16;
            char* dst = lds + k * 8192 + tid * 16;
            glds16(src, dst); glds16(src + 4096, dst + 4096);
        }
    };
    f32x16 S[4];
#pragma unroll
    for (int i = 0; i < 4; ++i)
#pragma unroll
        for (int r = 0; r < 16; ++r) S[i][r] = 0.f;
    __syncthreads();
    issue(0, 0, 7);
#pragma unroll 1
    for (int n = 0; n < 64; ++n) {
        const float egl = __shfl(eglv, n);
        bf16x8 Sb[8];
#pragma unroll
        for (int i = 0; i < 4; ++i) { Sb[i * 2] = pack_step(S[i], 0); Sb[i * 2 + 1] = pack_step(S[i], 1); }
        f32x16 av[2], ao[2];
        const bf16x8* fr0 = (const bf16x8*)lds + lane;
        GS_WAIT(10);
        __builtin_amdgcn_s_barrier();
        issue(n, 7, 2);
        __builtin_amdgcn_sched_barrier(0);
#pragma unroll
        for (int mt = 0; mt < 2; ++mt)
#pragma unroll
            for (int r = 0; r < 16; ++r) av[mt][r] = 0.f;
#pragma unroll
        for (int ks = 0; ks < 8; ++ks)
#pragma unroll
            for (int mt = 0; mt < 2; ++mt) av[mt] = mfma32(fr0[mt * 512 + ks * 64], Sb[ks], av[mt]);
        GS_WAIT(10);
        __builtin_amdgcn_s_barrier();
        if (n < 63) issue(n + 1, 0, 2);
        __builtin_amdgcn_sched_barrier(0);
#pragma unroll
        for (int mt = 0; mt < 2; ++mt)
#pragma unroll
            for (int r = 0; r < 16; ++r) ao[mt][r] = 0.f;
#pragma unroll
        for (int ks = 0; ks < 8; ++ks) {
#pragma unroll
            for (int mt = 0; mt < 2; ++mt) ao[mt] = mfma32(fr0[(2 + mt) * 512 + ks * 64], Sb[ks], ao[mt]);
#pragma unroll
            for (int r = 0; r < 8; ++r) S[ks >> 1][(ks & 1) * 8 + r] *= egl;
        }
        if (n < 63) GS_WAIT(8); else GS_WAIT(4);
        __builtin_amdgcn_s_barrier();
        if (n < 63) issue(n + 1, 2, 2);
        __builtin_amdgcn_sched_barrier(0);
        bf16x8 Vb[4];
        {
            const char* sl = lds + (4 + (w >> 1)) * 8192;
#pragma unroll
            for (int mt = 0; mt < 2; ++mt) {
                const u32x4* up = (const u32x4*)(sl + ((w & 1) * 2 + mt) * 2048 + lane * 32);
                const u32x4 u0 = up[0], u1 = up[1];
#pragma unroll
                for (int e = 0; e < 4; ++e) {
                    av[mt][e * 2] = __uint_as_float(u0[e] << 16) - av[mt][e * 2]; av[mt][e * 2 + 1] = __uint_as_float(u0[e] & 0xffff0000u) - av[mt][e * 2 + 1];
                    av[mt][8 + e * 2] = __uint_as_float(u1[e] << 16) - av[mt][8 + e * 2]; av[mt][8 + e * 2 + 1] = __uint_as_float(u1[e] & 0xffff0000u) - av[mt][8 + e * 2 + 1];
                }
                Vb[mt * 2] = pack_step(av[mt], 0); Vb[mt * 2 + 1] = pack_step(av[mt], 1);
            }
#pragma unroll
            for (int ks = 0; ks < 4; ++ks) { if (ks < 2) ao[0] = mfma32(fr0[6 * 512 + ks * 64], Vb[ks], ao[0]); ao[1] = mfma32(fr0[6 * 512 + (4 + ks) * 64], Vb[ks], ao[1]); }
        }
        if (n < 63) GS_WAIT(8); else GS_WAIT(0);
        __builtin_amdgcn_s_barrier();
        if (n < 63) issue(n + 1, 4, 3);
        __builtin_amdgcn_sched_barrier(0);
#pragma unroll
        for (int ks = 0; ks < 4; ++ks)
#pragma unroll
            for (int i = 0; i < 4; ++i) S[i] = mfma32(fr0[(7 + (i >> 1)) * 512 + ((i & 1) * 4 + ks) * 64], Vb[ks], S[i]);
        {
            u32x4* Of = (u32x4*)((dry ? p.ws + WS_DUMMY + (size_t)(bh & 15) * 65536 : gbase + (size_t)n * 4 * GOPS_CH) + GO_UF) + (size_t)(w * 2 * 64 + lane) * 2;
#pragma unroll
            for (int mt = 0; mt < 2; ++mt) {
                u32x4 o0, o1;
#pragma unroll
                for (int e = 0; e < 4; ++e) { o0[e] = pack2(ao[mt][e * 2], ao[mt][e * 2 + 1]); o1[e] = pack2(ao[mt][8 + e * 2], ao[mt][8 + e * 2 + 1]); }
                Of[mt * 128] = o0; Of[mt * 128 + 1] = o1;
            }
        }
    }
    __syncthreads();
}

DI void gdn_post_unit(const P& p, int li, int ch) {
    const int tid = tidx();
    const int h = ch & 3, n = (ch >> 2) & 63, b = ch >> 8;
    const int t0 = b * SEQ + n * 64;
    const int c = tid >> 2, cq = tid & 3;
    const bf16_t* Of = (const bf16_t*)(p.ws + WS_GOPS + (size_t)ch * GOPS_CH + GO_UF);
    const bf16_t* proj = (const bf16_t*)(p.ws + WS_PROJ);
    bf16_t* mix = (bf16_t*)(p.ws + WS_PROJ);
    const float* nw = p.in[I_GDNNORM] + li * 128 + cq * 32;
    const int mt = c >> 5, q4 = (c & 31) >> 2, hh = q4 & 1, rg = q4 >> 1, reg = rg * 4 + (c & 3);
    float o[32]; float ss = 0.f;
#pragma unroll
    for (int r = 0; r < 32; ++r) { o[r] = bf2f(Of[(size_t)((cq * 2 + mt) * 64 + hh * 32 + r) * 16 + reg]); ss += o[r] * o[r]; }
    ss += __shfl_xor(ss, 1); ss += __shfl_xor(ss, 2);
    const float rs = rsqrtf(ss * (1.f / 128.f) + 1e-6f);
    const bf16_t* zp = proj + (size_t)(t0 + c) * EVLD + 1536 + h * 128 + cq * 32;
    bf16_t* mp = mix + (size_t)(t0 + c) * EVLD + h * 128 + cq * 32;
#pragma unroll
    for (int i4 = 0; i4 < 4; ++i4) {
        const u32x4 zw = *(const u32x4*)(zp + i4 * 8);
        u32x4 w;
#pragma unroll
        for (int e = 0; e < 4; ++e) {
            const float z0 = __uint_as_float(zw[e] << 16), z1 = __uint_as_float(zw[e] & 0xffff0000u);
            w[e] = pack2(o[i4 * 8 + e * 2] * rs * nw[i4 * 8 + e * 2] * siluf_(z0), o[i4 * 8 + e * 2 + 1] * rs * nw[i4 * 8 + e * 2 + 1] * siluf_(z1));
        }
        *(u32x4*)(mp + i4 * 8) = w;
    }
}


constexpr int RP_Z0 = 0, RP_Z1 = 18432, RP_Z2 = 55296, RP_VEC = 73728, RP_PT = 75008, RP_T11 = 78080, RP_END = 80640;
constexpr int RP_LIN = 0, RP_LW = 25600;
DI void rwkv_prep_unit(const P& p, int li, int ch, char* lds) {
    const int tid = tidx(), lane = tid & 63, wid = tid >> 6, fr = lane & 15, fq = lane >> 4;
    const int h = ch & 7, n = (ch >> 3) & 63, b = ch >> 9;
    const int t0 = b * SEQ + n * 64;
    const bf16_t* proj = (const bf16_t*)(p.ws + WS_PROJ);
    char* Lfc = lds + RP_Z0; float* Lf = (float*)Lfc;
    char* ApT = lds + RP_Z0; char* AkVT = lds + RP_Z0 + 9216;
    char* Arow = lds + RP_Z1; char* Rrow = Arow + 9216; char* Brow = Arow + 18432; char* Krow = Arow + 27648;
    char* Aak = Arow; char* Arb = Rrow; char* Ark = Brow; char* Trow = Krow; char* BhT = Krow; char* VpT = Aak;
    char* AT = lds + RP_Z2; char* VT = AT + 9216; char* KhT = AT;
    float* tot = (float*)(lds + RP_VEC); float* WC = tot + 256;
    char* lin = lds + RP_LIN; char* LWi = lds + RP_LW;
    float* PT = (float*)(lds + RP_PT);
    {
        const float* mu0 = p.in[I_MU] + (size_t)li * 1696;
        if (tid < 48) {
            const int j0 = tid * 4;
            *(float4*)(PT + j0) = j0 < 160 ? *(const float4*)(mu0 + (C_HW - RW0) + j0) : *(const float4*)(p.in[I_VRESMU] + j0 - 160);
        } else if (tid < 48 + 144) {
            const int q = tid - 48, arr = q >> 4, c4 = (q & 15) * 4, chn = h * 64 + c4;
            const float* src = arr == 0 ? mu0 + (C_R - RW0) + chn : arr == 1 ? mu0 + (C_K - RW0) + chn : arr == 2 ? mu0 + (C_V - RW0) + chn
                             : arr == 3 ? p.in[I_W0] + li * 512 + chn : arr == 4 ? p.in[I_A0] + li * 512 + chn : arr == 5 ? p.in[I_V0] + chn
                             : arr == 6 ? p.in[I_KK] + li * 512 + chn : arr == 7 ? p.in[I_KA] + li * 512 + chn : p.in[I_RK] + li * 512 + chn;
            *(float4*)(PT + 192 + arr * 64 + c4) = *(const float4*)src;
        }
    }
    __syncthreads();
    {
        const int c = tid >> 2, cq = tid & 3, s = n * 64 + c;
        const bf16_t* cur = proj + (size_t)(t0 + c) * EVLD + C_HW + cq * 48;
        const float* mu = p.in[I_MU] + (size_t)li * 1696 + (C_HW - RW0);
        const float* vmu = p.in[I_VRESMU];
#pragma unroll
        for (int i6 = 0; i6 < 6; ++i6) {
            const u32x4 cw4 = *(const u32x4*)(cur + i6 * 8);
            u32x4 pw4 = *(const u32x4*)(cur - (s > 0 ? EVLD : 0) + i6 * 8);
            if (s == 0) pw4 = (u32x4){0u, 0u, 0u, 0u};
            const int j0 = cq * 48 + i6 * 8;
            const float4 ma = *(const float4*)(PT + j0), mb = *(const float4*)(PT + j0 + 4);
            const float mm[8] = {ma.x, ma.y, ma.z, ma.w, mb.x, mb.y, mb.z, mb.w};
            const bool is_t = j0 < 32, is_s = (j0 >= 64) && (j0 < 160);
            const float ca = is_t ? 1.f : 0.f, cb = is_t ? -2.f : 1.f, cc = is_t ? 2.f : -1.f;
            u32x4 w;
#pragma unroll
            for (int e = 0; e < 4; ++e) {
                float o2[2];
#pragma unroll
                for (int q = 0; q < 2; ++q) {
                    const float cv = q ? __uint_as_float(cw4[e] & 0xffff0000u) : __uint_as_float(cw4[e] << 16);
                    const float pv = q ? __uint_as_float(pw4[e] & 0xffff0000u) : __uint_as_float(pw4[e] << 16);
                    const float val = cv + mm[e * 2 + q] * (pv - cv);
                    const float act = ca + cb * __builtin_amdgcn_rcpf(1.f + __expf(cc * val));
                    o2[q] = (is_t || is_s) ? act : val;
                }
                w[e] = pack2(o2[0], o2[1]);
            }
            *(u32x4*)(lin + c * 400 + (cq * 48 + i6 * 8) * 2) = w;
        }
        const bf16_t* LW = (const bf16_t*)(p.ws + WS_W + W_LW) + (size_t)h * 64 * 192;
#pragma unroll
        for (int i6 = 0; i6 < 6; ++i6) *(u32x4*)(LWi + c * 400 + (cq * 48 + i6 * 8) * 2) = *(const u32x4*)(LW + (size_t)c * 192 + cq * 48 + i6 * 8);
    }
    __syncthreads();
    float lw_[16], la_[16], lg_[16], lv_[16];
#pragma unroll
    for (int tj = 0; tj < 4; ++tj) {
        const f32x4 a = tile16(LWi, 400, 16 * tj, lin, 400, 16 * wid, 32);
        const f32x4 bq = tile16(LWi + 64, 400, 16 * tj, lin + 64, 400, 16 * wid, 32);
        const f32x4 cg = tile16(LWi + 128, 400, 16 * tj, lin + 128, 400, 16 * wid, 96);
        const f32x4 dv = tile16(LWi + 320, 400, 16 * tj, lin + 320, 400, 16 * wid, 32);
#pragma unroll
        for (int r = 0; r < 4; ++r) { lw_[tj * 4 + r] = a[r]; la_[tj * 4 + r] = bq[r]; lg_[tj * 4 + r] = cg[r]; lv_[tj * 4 + r] = dv[r]; }
    }
    __syncthreads();
    const int c = 16 * wid + fr;
    float at[16], rt[16], bt[16], kt[16], bh[16], kh[16];
    {
        const int s = n * 64 + c;
        const size_t row = (size_t)(t0 + c);
        const float* mu = p.in[I_MU] + (size_t)li * 1696;
        const int hc = h * 64;
        float rr_[16], kk_[16], lwv[16], aa[16];
        float kn = 0.f, rk = 0.f;
        bf16_t* vf = (bf16_t*)(p.ws + WS_VF);
        bf16_t* gg = (bf16_t*)(p.ws + WS_GG);
#pragma unroll
        for (int tj = 0; tj < 4; ++tj) {
            const int cb = 16 * tj + 4 * fq;
            u32x2 cr = *(const u32x2*)(proj + row * EVLD + C_R + hc + cb), ck = *(const u32x2*)(proj + row * EVLD + C_K + hc + cb), cv = *(const u32x2*)(proj + row * EVLD + C_V + hc + cb);
            const size_t prow = s > 0 ? row - 1 : row;
            u32x2 pr = *(const u32x2*)(proj + prow * EVLD + C_R + hc + cb), pk = *(const u32x2*)(proj + prow * EVLD + C_K + hc + cb), pv = *(const u32x2*)(proj + prow * EVLD + C_V + hc + cb);
            if (s == 0) { pr = (u32x2){0u, 0u}; pk = pr; pv = pr; }
            u32x2 vfw = {0u, 0u};
            if (li == 1) vfw = *(const u32x2*)(vf + row * 512 + hc + cb);
            float vout[4], gout[4];
            const int ch0 = hc + cb;
            const float* pt = PT + 192 + cb;
            const float4 mu_r4 = *(const float4*)(pt), mu_k4 = *(const float4*)(pt + 64), mu_v4 = *(const float4*)(pt + 128);
            const float4 w0_4 = *(const float4*)(pt + 192), a0_4 = *(const float4*)(pt + 256), v0_4 = *(const float4*)(pt + 320);
            const float4 kk_4 = *(const float4*)(pt + 384), ka_4 = *(const float4*)(pt + 448), rk_4 = *(const float4*)(pt + 512);
            const float mur[4] = {mu_r4.x, mu_r4.y, mu_r4.z, mu_r4.w}, muk[4] = {mu_k4.x, mu_k4.y, mu_k4.z, mu_k4.w}, muv[4] = {mu_v4.x, mu_v4.y, mu_v4.z, mu_v4.w};
            const float w0v[4] = {w0_4.x, w0_4.y, w0_4.z, w0_4.w}, a0v[4] = {a0_4.x, a0_4.y, a0_4.z, a0_4.w}, v0v[4] = {v0_4.x, v0_4.y, v0_4.z, v0_4.w};
            const float kkp[4] = {kk_4.x, kk_4.y, kk_4.z, kk_4.w}, kap[4] = {ka_4.x, ka_4.y, ka_4.z, ka_4.w}, rkp[4] = {rk_4.x, rk_4.y, rk_4.z, rk_4.w};
#pragma unroll
            for (int r = 0; r < 4; ++r) {
                const int i = tj * 4 + r;
                const unsigned wcr = r < 2 ? cr.x : cr.y, wck = r < 2 ? ck.x : ck.y, wcv = r < 2 ? cv.x : cv.y;
                const unsigned wpr = r < 2 ? pr.x : pr.y, wpk = r < 2 ? pk.x : pk.y, wpv = r < 2 ? pv.x : pv.y, wvf = r < 2 ? vfw.x : vfw.y;
                const float c_r = (r & 1) ? __uint_as_float(wcr & 0xffff0000u) : __uint_as_float(wcr << 16);
                const float c_k = (r & 1) ? __uint_as_float(wck & 0xffff0000u) : __uint_as_float(wck << 16);
                const float c_v = (r & 1) ? __uint_as_float(wcv & 0xffff0000u) : __uint_as_float(wcv << 16);
                const float p_r = (r & 1) ? __uint_as_float(wpr & 0xffff0000u) : __uint_as_float(wpr << 16);
                const float p_k = (r & 1) ? __uint_as_float(wpk & 0xffff0000u) : __uint_as_float(wpk << 16);
                const float p_v = (r & 1) ? __uint_as_float(wpv & 0xffff0000u) : __uint_as_float(wpv << 16);
                const float rm = c_r + mur[r] * (p_r - c_r);
                const float km = c_k + muk[r] * (p_k - c_k);
                float vm = c_v + muv[r] * (p_v - c_v);
                const float wlog = -softplusf_(-(w0v[r] + lw_[i])) - 0.5f;
                lwv[i] = -__expf(wlog);
                const float a = sigmoidf_(a0v[r] + la_[i]);
                if (li == 1) {
                    const float v1 = (r & 1) ? __uint_as_float(wvf & 0xffff0000u) : __uint_as_float(wvf << 16);
                    vm = vm + (v1 - vm) * sigmoidf_(v0v[r] + lv_[i]);
                }
                const float kkv = km * kkp[r];
                kn += kkv * kkv;
                rr_[i] = rm; kk_[i] = kkv; aa[i] = a;
                kt[i] = km * (1.f + (a - 1.f) * kap[r]);
                rk += rm * kt[i] * rkp[r];
                vout[r] = vm; gout[r] = lg_[i];
            }
            u32x2 w; w.x = pack2(vout[0], vout[1]); w.y = pack2(vout[2], vout[3]);
            *(u32x2*)(vf + row * 512 + hc + cb) = w;
            w.x = pack2(gout[0], gout[1]); w.y = pack2(gout[2], gout[3]);
            *(u32x2*)(gg + row * 512 + hc + cb) = w;
#pragma unroll
            for (int r = 0; r < 4; ++r) *(bf16_t*)(VT + (cb + r) * 144 + c * 2) = f2bf(vout[r]);
            __builtin_amdgcn_sched_barrier(0);
        }
        kn += __shfl_xor(kn, 16); kn += __shfl_xor(kn, 32);
        const float kr = rsqrtf(kn + 1e-6f);
        rk += __shfl_xor(rk, 16); rk += __shfl_xor(rk, 32);
        if (fq == 0) ((float*)(p.ws + WS_RK))[row * 8 + h] = rk;
        float cs[16];
#pragma unroll
        for (int i = 0; i < 16; ++i) {
            float x = lwv[i];
#pragma unroll
            for (int o = 1; o < 16; o <<= 1) { const float y = __shfl_up(x, o, 16); if (fr >= o) x += y; }
            cs[i] = x;
        }
        if (fr == 15) {
#pragma unroll
            for (int i = 0; i < 16; ++i) tot[wid * 64 + 16 * (i >> 2) + 4 * fq + (i & 3)] = cs[i];
        }
        __syncthreads();
#pragma unroll
        for (int i = 0; i < 16; ++i) {
            const int chl = 16 * (i >> 2) + 4 * fq + (i & 3);
            float pre = 0.f, all = 0.f;
#pragma unroll
            for (int w2 = 0; w2 < 4; ++w2) { const float tv = tot[w2 * 64 + chl]; all += tv; if (w2 < wid) pre += tv; }
            const float csi = cs[i] + pre, csm = csi - lwv[i];
            const float kkn = kk_[i] * kr, k2 = kt[i];
            const float e_c = __expf(csi), e_n = __builtin_amdgcn_rcpf(e_c), e_m = __expf(csm), e_h = __expf(all) * e_n;
            at[i] = -kkn * e_m; rt[i] = rr_[i] * e_c;
            const float bp = kkn * aa[i];
            bt[i] = bp * e_n; kt[i] = k2 * e_n; bh[i] = bp * e_h; kh[i] = k2 * e_h;
            if (c == 0) WC[chl] = __expf(all);
            if ((i & 3) == 3) __builtin_amdgcn_sched_barrier(0);
        }
    }
#pragma unroll
    for (int tj = 0; tj < 4; ++tj) {
        const int cb = 16 * tj + 4 * fq;
        u32x2 w;
        w.x = pack2(at[tj * 4], at[tj * 4 + 1]); w.y = pack2(at[tj * 4 + 2], at[tj * 4 + 3]); *(u32x2*)(Arow + c * 144 + cb * 2) = w;
        w.x = pack2(rt[tj * 4], rt[tj * 4 + 1]); w.y = pack2(rt[tj * 4 + 2], rt[tj * 4 + 3]); *(u32x2*)(Rrow + c * 144 + cb * 2) = w;
        w.x = pack2(bt[tj * 4], bt[tj * 4 + 1]); w.y = pack2(bt[tj * 4 + 2], bt[tj * 4 + 3]); *(u32x2*)(Brow + c * 144 + cb * 2) = w;
        w.x = pack2(kt[tj * 4], kt[tj * 4 + 1]); w.y = pack2(kt[tj * 4 + 2], kt[tj * 4 + 3]); *(u32x2*)(Krow + c * 144 + cb * 2) = w;
#pragma unroll
        for (int r = 0; r < 4; ++r) {
            *(bf16_t*)(AT + (cb + r) * 144 + c * 2) = f2bf(at[tj * 4 + r]);
        }
    }
    __syncthreads();
    f32x4 pab[4], pak[4], prb[4], prk[4];
    {
        const int ti = wid;
#pragma unroll
        for (int tj = 0; tj < 4; ++tj) {
            pab[tj] = (f32x4){0.f, 0.f, 0.f, 0.f}; pak[tj] = pab[tj]; prb[tj] = pab[tj]; prk[tj] = pab[tj];
            if (tj <= ti) {
                pab[tj] = tile16(Arow, 144, 16 * ti, Brow, 144, 16 * tj, 64);
                pak[tj] = tile16(Krow, 144, 16 * tj, Arow, 144, 16 * ti, 64);
                prb[tj] = tile16(Brow, 144, 16 * tj, Rrow, 144, 16 * ti, 64);
                prk[tj] = tile16(Krow, 144, 16 * tj, Rrow, 144, 16 * ti, 64);
            }
        }
    }
    __syncthreads();
    {
        const int ti = wid;
#pragma unroll
        for (int tj = 0; tj < 4; ++tj) {
            const int s1 = 16 * tj + fr;
            f32x4 lv;
#pragma unroll
            for (int r = 0; r < 4; ++r) { const int t1 = 16 * ti + 4 * fq + r; lv[r] = (s1 < t1) ? -pab[tj][r] : 0.f; }
            *(f32x4*)&Lf[s1 * 72 + 16 * ti + 4 * fq] = lv;
            const int t2 = 16 * ti + fr;
            float m1[4], m2[4], m3[4];
#pragma unroll
            for (int r = 0; r < 4; ++r) { const int s2 = 16 * tj + 4 * fq + r; m1[r] = (s2 < t2) ? pak[tj][r] : 0.f; m2[r] = (s2 <= t2) ? prb[tj][r] : 0.f; m3[r] = (s2 <= t2) ? prk[tj][r] : 0.f; }
            u32x2 w;
            w.x = pack2(m1[0], m1[1]); w.y = pack2(m1[2], m1[3]); *(u32x2*)(Aak + t2 * 144 + (16 * tj + 4 * fq) * 2) = w;
            w.x = pack2(m2[0], m2[1]); w.y = pack2(m2[2], m2[3]); *(u32x2*)(Arb + t2 * 144 + (16 * tj + 4 * fq) * 2) = w;
            w.x = pack2(m3[0], m3[1]); w.y = pack2(m3[2], m3[3]); *(u32x2*)(Ark + t2 * 144 + (16 * tj + 4 * fq) * 2) = w;
        }
    }
    __syncthreads();
    {
        char* L21i = lds + RP_PT;
        char* T11T = lds + RP_T11;
        char* MT = lds + RP_Z0;
        if (wid < 2) {
            const int o = 32 * wid;
            float Tc[32];
#pragma unroll
            for (int i = 0; i < 32; ++i) Tc[i] = (i == (lane & 31)) ? 1.f : 0.f;
#pragma unroll
            for (int j = 0; j < 31; ++j) {
                const float tj = Tc[j];
#pragma unroll
                for (int i4 = (j + 1) >> 2; i4 < 8; ++i4) {
                    const f32x4 l4 = *(const f32x4*)&Lf[(o + j) * 72 + o + i4 * 4];
#pragma unroll
                    for (int e = 0; e < 4; ++e) if (i4 * 4 + e > j) Tc[i4 * 4 + e] -= l4[e] * tj;
                }
            }
            if (lane < 32) {
#pragma unroll
                for (int i = 0; i < 32; ++i) *(bf16_t*)(Trow + (o + i) * 144 + (o + lane) * 2) = f2bf(Tc[i]);
                if (wid == 0) {
#pragma unroll
                    for (int i = 0; i < 32; ++i) *(bf16_t*)(Trow + i * 144 + (32 + lane) * 2) = 0;
#pragma unroll
                    for (int i4 = 0; i4 < 8; ++i4) { u32x2 w; w.x = pack2(Tc[i4 * 4], Tc[i4 * 4 + 1]); w.y = pack2(Tc[i4 * 4 + 2], Tc[i4 * 4 + 3]); *(u32x2*)(T11T + lane * 80 + i4 * 8) = w; }
                }
            }
        } else {
            const int t2 = tid - 128;
#pragma unroll
            for (int g2 = 0; g2 < 2; ++g2) {
                const int i = t2 & 31, k4 = ((t2 >> 5) + 4 * g2) * 4;
                u32x2 w;
                w.x = pack2(Lf[(k4 + 0) * 72 + 32 + i], Lf[(k4 + 1) * 72 + 32 + i]); w.y = pack2(Lf[(k4 + 2) * 72 + 32 + i], Lf[(k4 + 3) * 72 + 32 + i]);
                *(u32x2*)(L21i + i * 80 + k4 * 2) = w;
            }
        }
        __syncthreads();
        {
            const int r0 = 16 * (wid >> 1), c0 = 16 * (wid & 1);
            const f32x4 mm = tile16(L21i, 80, r0, T11T, 80, c0, 32);
            u32x2 w; w.x = pack2(mm[0], mm[1]); w.y = pack2(mm[2], mm[3]);
            *(u32x2*)(MT + (c0 + fr) * 80 + (r0 + 4 * fq) * 2) = w;
        }
        __syncthreads();
        {
            const int r0 = 16 * (wid >> 1), c0 = 16 * (wid & 1);
            const f32x4 tt = tile16(MT, 80, c0, Trow + 32 * 144 + 64, 144, r0, 32);
            u32x2 w; w.x = pack2(-tt[0], -tt[1]); w.y = pack2(-tt[2], -tt[3]);
            *(u32x2*)(Trow + (32 + r0 + fr) * 144 + (c0 + 4 * fq) * 2) = w;
        }
    }
    __syncthreads();
    {
        const int ti = wid;
#pragma unroll
        for (int tj = 0; tj < 4; ++tj) {
            const f32x4 x = tile16(Trow, 144, 16 * ti, AT, 144, 16 * tj, 64);
            const f32x4 y = tile16(Aak, 144, 16 * ti, VT, 144, 16 * tj, 64);
            u32x2 w;
            w.x = pack2(x[0], x[1]); w.y = pack2(x[2], x[3]); *(u32x2*)(ApT + (16 * tj + fr) * 144 + (16 * ti + 4 * fq) * 2) = w;
            w.x = pack2(y[0], y[1]); w.y = pack2(y[2], y[3]); *(u32x2*)(AkVT + (16 * tj + fr) * 144 + (16 * ti + 4 * fq) * 2) = w;
        }
    }
    __syncthreads();
    {
        const int ti = wid;
#pragma unroll
        for (int tj = 0; tj < 4; ++tj) {
            const f32x4 x = tile16(Trow, 144, 16 * ti, AkVT, 144, 16 * tj, 64);
            u32x2 w; w.x = pack2(x[0], x[1]); w.y = pack2(x[2], x[3]); *(u32x2*)(VpT + (16 * tj + fr) * 144 + (16 * ti + 4 * fq) * 2) = w;
        }
    }
    __syncthreads();
#pragma unroll
    for (int tj = 0; tj < 4; ++tj)
#pragma unroll
        for (int r = 0; r < 4; ++r) {
            const int cb = 16 * tj + 4 * fq + r;
            *(bf16_t*)(BhT + cb * 144 + c * 2) = f2bf(bh[tj * 4 + r]);
            *(bf16_t*)(KhT + cb * 144 + c * 2) = f2bf(kh[tj * 4 + r]);
        }
    __syncthreads();
    {
        unsigned char* opsA = p.ws + WS_HN + (size_t)ch * 16384;
        unsigned char* opsB = p.ws + WS_ROPS + (size_t)ch * 16384;
        const int ti = wid;
#pragma unroll
        for (int tj = 0; tj < 4; ++tj) {
            const f32x4 x = tile16(ApT, 144, 16 * tj, Arb, 144, 16 * ti, 64);
            const f32x4 g = tile16(ApT, 144, 16 * tj, BhT, 144, 16 * ti, 64);
            const int m1 = 16 * ti + fr, mt = m1 >> 5, rr = m1 & 31, hh = fq & 1, jg = fq >> 1;
            const size_t off = ((size_t)((mt * 4 + tj) * 64 + hh * 32 + rr) * 8 + jg * 4) * 2;
            float gd[4];
#pragma unroll
            for (int r = 0; r < 4; ++r) gd[r] = g[r] + ((16 * tj + 4 * fq + r == m1) ? WC[m1] : 0.f);
            u32x2 w;
            w.x = pack2(x[0] + rt[tj * 4], x[1] + rt[tj * 4 + 1]); w.y = pack2(x[2] + rt[tj * 4 + 2], x[3] + rt[tj * 4 + 3]); *(u32x2*)(opsA + off) = w;
            w.x = pack2(gd[0], gd[1]); w.y = pack2(gd[2], gd[3]); *(u32x2*)(opsA + 8192 + off) = w;
            f32x4 y = tile16(Ark, 144, 16 * ti, VT, 144, 16 * tj, 64);
            const f32x4 y2 = tile16(Arb, 144, 16 * ti, VpT, 144, 16 * tj, 64);
            f32x4 kv = tile16(KhT, 144, 16 * ti, VT, 144, 16 * tj, 64);
            const f32x4 kv2 = tile16(BhT, 144, 16 * ti, VpT, 144, 16 * tj, 64);
            const int vcol = 16 * tj + fr, slice = vcol >> 5, r2 = vcol & 31, cb = 16 * ti + 4 * fq, mt2 = cb >> 5, q4 = (cb & 31) >> 2, h2 = q4 & 1, rg = q4 >> 1;
            const size_t off2 = ((size_t)((slice * 2 + mt2) * 64 + h2 * 32 + r2) * 16 + rg * 4) * 2;
            w.x = pack2(y[0] + y2[0], y[1] + y2[1]); w.y = pack2(y[2] + y2[2], y[3] + y2[3]); *(u32x2*)(opsB + off2) = w;
            w.x = pack2(kv[0] + kv2[0], kv[1] + kv2[1]); w.y = pack2(kv[2] + kv2[2], kv[3] + kv2[3]); *(u32x2*)(opsB + 8192 + off2) = w;
        }
    }
}

DI void rwkv_scan_block(const P& p, int bh, char* lds, bool dry = false) {
    const int tid = tidx(), lane = tid & 63, w = tid >> 6, slice = w & 1;
    const int h = bh & 7, b = bh >> 3;
    constexpr int NST = 64 * 2, AH = 3;
    auto issue = [&](int j) {
        const int n = j >> 1, k = j & 1;
        const size_t ch = (size_t)((b * 64 + n) * 8 + h) * 16384;
        const unsigned char* s0 = (k == 0 ? p.ws + WS_ROPS + ch + 8192 : p.ws + WS_ROPS + ch) + tid * 16;
        const unsigned char* s1 = (k == 0 ? p.ws + WS_HN + ch + 8192 : p.ws + WS_HN + ch) + tid * 16;
        char* dst = lds + (j & 3) * 16384 + tid * 16;
        glds16(s0, dst); glds16(s0 + 4096, dst + 4096); glds16(s1, dst + 8192); glds16(s1 + 4096, dst + 12288);
    };
    f32x16 H[2];
#pragma unroll
    for (int i = 0; i < 2; ++i)
#pragma unroll
        for (int r = 0; r < 16; ++r) H[i][r] = 0.f;
    __syncthreads();
#pragma unroll
    for (int j = 0; j < AH; ++j) issue(j);
#pragma unroll 1
    for (int n = 0; n < 64; ++n) {
        bf16x8 Hb[4];
#pragma unroll
        for (int i = 0; i < 2; ++i) { Hb[i * 2] = pack_step(H[i], 0); Hb[i * 2 + 1] = pack_step(H[i], 1); }
#pragma unroll
        for (int k = 0; k < 2; ++k) {
            const int j = n * 2 + k;
            if (n < 63) GS_WAIT(8); else if (k == 0) GS_WAIT(4); else GS_WAIT(0);
            __builtin_amdgcn_s_barrier();
            if (j + AH < NST) issue(j + AH);
            __builtin_amdgcn_sched_barrier(0);
            const char* sl = lds + (j & 3) * 16384;
            if (w < 2) {
                f32x16 acc[2];
#pragma unroll
                for (int mt = 0; mt < 2; ++mt) {
                    const u32x4* up = (const u32x4*)(sl + (slice * 2 + mt) * 2048 + lane * 32);
                    const u32x4 u0 = up[0], u1 = up[1];
#pragma unroll
                    for (int e = 0; e < 4; ++e) {
                        acc[mt][e * 2] = __uint_as_float(u0[e] << 16); acc[mt][e * 2 + 1] = __uint_as_float(u0[e] & 0xffff0000u);
                        acc[mt][8 + e * 2] = __uint_as_float(u1[e] << 16); acc[mt][8 + e * 2 + 1] = __uint_as_float(u1[e] & 0xffff0000u);
                    }
                }
                const bf16x8* fr = (const bf16x8*)(sl + 8192) + lane;
                bf16x8 f8[8];
#pragma unroll
                for (int q = 0; q < 8; ++q) f8[q] = fr[q * 64];
#pragma unroll
                for (int ks = 0; ks < 4; ++ks)
#pragma unroll
                    for (int mt = 0; mt < 2; ++mt) acc[mt] = mfma32(f8[mt * 4 + ks], Hb[ks], acc[mt]);
                if (k == 0) { H[0] = acc[0]; H[1] = acc[1]; }
                else {
                    const size_t ch = (size_t)((b * 64 + n) * 8 + h) * 16384;
                    u32x4* Yf = (u32x4*)(dry ? p.ws + WS_DUMMY + 2097152 + (size_t)(bh & 31) * 16384 : p.ws + WS_ROPS + ch) + (size_t)(slice * 128 + lane) * 2;
#pragma unroll
                    for (int mt = 0; mt < 2; ++mt) {
                        u32x4 o0, o1;
#pragma unroll
                        for (int e = 0; e < 4; ++e) { o0[e] = pack2(acc[mt][e * 2], acc[mt][e * 2 + 1]); o1[e] = pack2(acc[mt][8 + e * 2], acc[mt][8 + e * 2 + 1]); }
                        Yf[mt * 128] = o0; Yf[mt * 128 + 1] = o1;
                    }
                }
            }
        }
    }
    __syncthreads();
}

DI void rwkv_post_unit(const P& p, int li, int ch) {
    const int tid = tidx();
    const int h = ch & 7, n = (ch >> 3) & 63, b = ch >> 9;
    const int t0 = b * SEQ + n * 64;
    const int c = tid >> 2, cq = tid & 3;
    const bf16_t* Yf = (const bf16_t*)(p.ws + WS_ROPS + (size_t)ch * 16384);
    const bf16_t* vf = (const bf16_t*)(p.ws + WS_VF) + (size_t)(t0 + c) * 512 + h * 64 + cq * 16;
    const bf16_t* gg = (const bf16_t*)(p.ws + WS_GG) + (size_t)(t0 + c) * 512 + h * 64 + cq * 16;
    const float rk = ((const float*)(p.ws + WS_RK))[(size_t)(t0 + c) * 8 + h];
    const float* lnw = p.in[I_LNW] + li * 512 + h * 64 + cq * 16;
    const float* lnb = p.in[I_LNB] + li * 512 + h * 64 + cq * 16;
    bf16_t* mp = (bf16_t*)(p.ws + WS_HN) + (size_t)(t0 + c) * 1024 + 512 + h * 64 + cq * 16;
    const int mt = c >> 5, q4 = (c & 31) >> 2, hh = q4 & 1, rg = q4 >> 1, reg = rg * 4 + (c & 3), slice = cq >> 1, rb = (cq & 1) * 16;
    float y[16]; float sm = 0.f;
#pragma unroll
    for (int i = 0; i < 16; ++i) { y[i] = bf2f(Yf[(size_t)((slice * 2 + mt) * 64 + hh * 32 + rb + i) * 16 + reg]); sm += y[i]; }
    sm += __shfl_xor(sm, 1); sm += __shfl_xor(sm, 2);
    const float mean = sm * (1.f / 64.f);
    float vs = 0.f;
#pragma unroll
    for (int i = 0; i < 16; ++i) { y[i] -= mean; vs += y[i] * y[i]; }
    vs += __shfl_xor(vs, 1); vs += __shfl_xor(vs, 2);
    const float rs = rsqrtf(vs * (1.f / 64.f) + 64e-5f);
#pragma unroll
    for (int i8 = 0; i8 < 2; ++i8) {
        const u32x4 vw = *(const u32x4*)(vf + i8 * 8), gw = *(const u32x4*)(gg + i8 * 8);
        u32x4 w;
#pragma unroll
        for (int e = 0; e < 4; ++e) {
            const int i = i8 * 8 + e * 2;
            const float v0 = __uint_as_float(vw[e] << 16), v1 = __uint_as_float(vw[e] & 0xffff0000u), g0 = __uint_as_float(gw[e] << 16), g1 = __uint_as_float(gw[e] & 0xffff0000u);
            w[e] = pack2((y[i] * rs * lnw[i] + lnb[i] + rk * v0) * g0, (y[i + 1] * rs * lnw[i + 1] + lnb[i + 1] + rk * v1) * g1);
        }
        *(u32x4*)(mp + i8 * 8) = w;
    }
}


DI void attn_unit(const P& p, int unit, char* lds) {
    const int tid = tidx(), lane = tid & 63, w = tid >> 6, r_ = lane & 31, hl = lane >> 5;
    const int idx = unit & 31, h = (unit >> 5) & 7, g = (unit >> 8) % 3, b = unit / 768;
    const int lg2 = g * 2, dil = 1 << lg2, L = SEQ >> lg2, ntl = L >> 7;
    const int rs = idx / ntl, qt = idx % ntl;
    const int hg = g * 8 + h;
    const bf16_t* QK = (const bf16_t*)(p.ws + WS_QK);
    const bf16_t* VT = (const bf16_t*)(p.ws + WS_VT) + ((size_t)((b * 24 + hg) * dil + rs) * 64) * L;
    const int qi = 32 * w + r_;
    const int q_idx = 128 * qt + qi;
    const size_t qrow = (size_t)(b * SEQ + q_idx * dil + rs);
    const int kbase0 = 128 * qt - 128;
    char* Kt = lds;
    char* Vt = lds + 32768;
    __syncthreads();
#pragma unroll
    for (int i = 0; i < 8; ++i) {
        const int id = tid + i * 256, row = id >> 3, pc = id & 7, c = pc ^ ((row >> 1) & 7);
        int k_idx = kbase0 + row; if (k_idx < 0) k_idx = 0;
        glds16(QK + (size_t)(b * SEQ + k_idx * dil + rs) * 3072 + 1536 + hg * 64 + c * 8, Kt + id * 16);
    }
#pragma unroll
    for (int i = 0; i < 8; ++i) {
        const int id = tid + i * 256, row = id >> 5, pq = id & 31, q = pq ^ (row & 31);
        int k0 = kbase0 + q * 8; if (k0 < 0) k0 = 0;
        glds16(VT + (size_t)row * L + k0, Vt + id * 16);
    }
    bf16x8 qf[4];
#pragma unroll
    for (int ks = 0; ks < 4; ++ks) qf[ks] = *(const bf16x8*)(QK + qrow * 3072 + hg * 64 + 16 * ks + 8 * hl);
    asm volatile("s_waitcnt vmcnt(0)" ::: "memory");
    __syncthreads();
    f32x16 st[5];
    float mx = -1.0e30f;
#pragma unroll
    for (int kbi = 0; kbi < 5; ++kbi) {
        const int krow = 32 * (w + kbi) + r_;
#pragma unroll
        for (int r = 0; r < 16; ++r) st[kbi][r] = 0.f;
#pragma unroll
        for (int ks = 0; ks < 4; ++ks) {
            const bf16x8 kf = *(const bf16x8*)(Kt + krow * 128 + (((2 * ks + hl) ^ ((krow >> 1) & 7)) * 16));
            st[kbi] = mfma32(kf, qf[ks], st[kbi]);
        }
#pragma unroll
        for (int r = 0; r < 16; ++r) {
            const int kj = 32 * (w + kbi) + (r & 3) + 8 * (r >> 2) + 4 * hl;
            const bool valid = (kj >= qi) && (kj <= qi + 128) && (kbase0 + kj >= 0);
            const float sv = valid ? st[kbi][r] * 0.125f : -1.0e30f;
            st[kbi][r] = sv; mx = fmaxf(mx, sv);
        }
    }
    mx = fmaxf(mx, __shfl_xor(mx, 32));
    float l = 0.f;
#pragma unroll
    for (int kbi = 0; kbi < 5; ++kbi)
#pragma unroll
        for (int r = 0; r < 16; ++r) { const float pv = __expf(st[kbi][r] - mx); st[kbi][r] = pv; l += pv; }
    l += __shfl_xor(l, 32);
    f32x16 ot[2];
#pragma unroll
    for (int dt = 0; dt < 2; ++dt)
#pragma unroll
        for (int r = 0; r < 16; ++r) ot[dt][r] = 0.f;
#pragma unroll
    for (int kbi = 0; kbi < 5; ++kbi)
#pragma unroll
        for (int s2 = 0; s2 < 2; ++s2) {
            const bf16x8 pb = pack_step(st[kbi], s2);
            const int q0 = 4 * (w + kbi) + 2 * s2;
#pragma unroll
            for (int dt = 0; dt < 2; ++dt) {
                const int drow = 32 * dt + r_;
                const u32x2 lo = *(const u32x2*)(Vt + drow * 512 + ((q0 ^ (drow & 31)) * 16) + 8 * hl);
                const u32x2 hi = *(const u32x2*)(Vt + drow * 512 + (((q0 + 1) ^ (drow & 31)) * 16) + 8 * hl);
                u32x4 vw; vw.x = lo.x; vw.y = lo.y; vw.z = hi.x; vw.w = hi.y;
                ot[dt] = mfma32(__builtin_bit_cast(bf16x8, vw), pb, ot[dt]);
            }
        }
    const float inv = 1.f / l;
    bf16_t* og = (bf16_t*)(p.ws + WS_OG) + ((size_t)g * T + qrow) * 512 + h * 64;
#pragma unroll
    for (int dt = 0; dt < 2; ++dt)
#pragma unroll
        for (int rg = 0; rg < 4; ++rg) {
            u32x2 wv; wv.x = pack2(ot[dt][rg * 4] * inv, ot[dt][rg * 4 + 1] * inv); wv.y = pack2(ot[dt][rg * 4 + 2] * inv, ot[dt][rg * 4 + 3] * inv);
            *(u32x2*)(og + 32 * dt + 8 * rg + 4 * hl) = wv;
        }
    if (hl == 0) ((float*)(p.ws + WS_LSE))[((size_t)g * T + qrow) * 8 + h] = mx + __logf(l);
}
DI void phase_attn_merge(const P& p) {
    const bf16_t* og = (const bf16_t*)(p.ws + WS_OG);
    const float* lse = (const float*)(p.ws + WS_LSE);
    bf16_t* o = (bf16_t*)(p.ws + WS_HN);
    for (int i = bidx() * 256 + tidx(); i < T * 64; i += gridDim.x * 256) {
        const int t = i >> 6, c8 = i & 63, h = c8 >> 3;
        const float l0 = lse[(size_t)t * 8 + h], l1 = lse[((size_t)T + t) * 8 + h], l2 = lse[((size_t)2 * T + t) * 8 + h];
        const float m = fmaxf(l0, fmaxf(l1, l2));
        float w0 = __expf(l0 - m), w1 = __expf(l1 - m), w2 = __expf(l2 - m);
        const float inv = 1.f / (w0 + w1 + w2); w0 *= inv; w1 *= inv; w2 *= inv;
        const u32x4 a = *(const u32x4*)(og + (size_t)t * 512 + c8 * 8), bq = *(const u32x4*)(og + ((size_t)T + t) * 512 + c8 * 8), cq = *(const u32x4*)(og + ((size_t)2 * T + t) * 512 + c8 * 8);
        u32x4 r;
#pragma unroll
        for (int e = 0; e < 4; ++e) {
            const float x0 = w0 * __uint_as_float(a[e] << 16) + w1 * __uint_as_float(bq[e] << 16) + w2 * __uint_as_float(cq[e] << 16);
            const float x1 = w0 * __uint_as_float(a[e] & 0xffff0000u) + w1 * __uint_as_float(bq[e] & 0xffff0000u) + w2 * __uint_as_float(cq[e] & 0xffff0000u);
            r[e] = pack2(x0, x1);
        }
        *(u32x4*)(o + (size_t)t * 512 + c8 * 8) = r;
    }
}


#define XB_TMO      128
#define XB_XCNT(j)  (256  + 64 * (j))
#define XB_XSUB(j)  (1280 + 64 * (j))
#define XB_XGEN(j)  (2304 + 64 * (j))
#define XB_TOP      3328
#define XB_TOPGEN   3392
#define XCD_BAR_WORDS 3456
#define XB_SPIN_CAP (1u << 22)
#define LAS __attribute__((address_space(3)))
DI unsigned xb_ld(unsigned* p)              { return __hip_atomic_load(p, __ATOMIC_RELAXED, __HIP_MEMORY_SCOPE_AGENT); }
DI unsigned xb_add(unsigned* p, unsigned v) { return __hip_atomic_fetch_add(p, v, __ATOMIC_RELAXED, __HIP_MEMORY_SCOPE_AGENT); }
DI unsigned xb_xcc_id() { return (unsigned)__builtin_amdgcn_s_getreg((3 << 11) | 20) & 0xFu; }
#define XB_SPIN(cond, bar) do { unsigned _sp = 0; while (cond) { if (_sp < 32u) __builtin_amdgcn_s_sleep(2); else __builtin_amdgcn_s_sleep(24); \
    if ((++_sp & 255u) == 0u) { if (xb_ld(&(bar)[XB_TMO])) break; if (_sp > XB_SPIN_CAP) { atomicAdd(&(bar)[XB_TMO], 1u); break; } } } } while (0)
struct XcdBarrier { unsigned* bar; unsigned x; volatile LAS unsigned* st; };
DI XcdBarrier xcd_barrier_post(unsigned* bar, volatile LAS unsigned* st) {
    XcdBarrier b; b.bar = bar; b.x = xb_xcc_id(); b.st = st;
    if (threadIdx.x == 0) (void)xb_add(&bar[XB_XCNT(b.x)], 1u);
    return b;
}
DI void xcd_barrier_complete(unsigned* bar, unsigned x, unsigned& nloc, unsigned& nx) {
    const unsigned G = gridDim.x * gridDim.y * gridDim.z;
    unsigned sum, cnt, mine, sp = 0u;
    for (;;) {
        sum = 0u; cnt = 0u; mine = 0u;
#pragma unroll
        for (unsigned j = 0; j < 16; ++j) { const unsigned c = xb_ld(&bar[XB_XCNT(j)]); sum += c; cnt += (c > 0u) ? 1u : 0u; mine = (j == x) ? c : mine; }
        if (sum == G) break;
        __builtin_amdgcn_s_sleep(1);
        if ((++sp & 255u) == 0u) { if (xb_ld(&bar[XB_TMO])) break; if (sp > XB_SPIN_CAP) { atomicAdd(&bar[XB_TMO], 1u); break; } }
    }
    nloc = mine > 0u ? mine : 1u; nx = cnt > 0u ? cnt : 1u;
}
DI void xcd_barrier(const XcdBarrier& b) {
    asm volatile("s_waitcnt vmcnt(0)" ::: "memory");
    __syncthreads();
    if (threadIdx.x == 0) {
        unsigned* bar = b.bar;
        __builtin_amdgcn_s_waitcnt(0);
        unsigned nloc = b.st[0], nx = b.st[1];
        if (nloc == 0u) { xcd_barrier_complete(bar, b.x, nloc, nx); b.st[0] = nloc; b.st[1] = nx; }
        const unsigned old = xb_add(&bar[XB_XSUB(b.x)], 1u);
        const unsigned gen = old / nloc;
        if (old + 1u == (gen + 1u) * nloc) {
            __builtin_amdgcn_fence(__ATOMIC_RELEASE, "agent");
            asm volatile("s_waitcnt vmcnt(0)" ::: "memory");
            const unsigned og = xb_add(&bar[XB_TOP], 1u);
            const unsigned tg = og / nx;
            if (og + 1u == (tg + 1u) * nx) xb_add(&bar[XB_TOPGEN], 1u);
            else XB_SPIN(xb_ld(&bar[XB_TOPGEN]) == tg, bar);
            __builtin_amdgcn_fence(__ATOMIC_ACQUIRE, "agent");
            xb_add(&bar[XB_XGEN(b.x)], 1u);
            asm volatile("s_waitcnt vmcnt(0)" ::: "memory");
        } else {
            XB_SPIN(xb_ld(&bar[XB_XGEN(b.x)]) == gen, bar);
            __builtin_amdgcn_fence(__ATOMIC_ACQUIRE, "agent");
            asm volatile("s_waitcnt vmcnt(0)" ::: "memory");
        }
    }
    __syncthreads();
}

constexpr int LDS_BYTES = RP_END;
static_assert(GP_END + 6144 <= LDS_BYTES, "LDS");
__global__ void __launch_bounds__(256, 2) mega(P p) {
    cg::grid_group grid = cg::this_grid();
    extern __shared__ __attribute__((aligned(16))) char lds[];
    if (threadIdx.x < 4) ((volatile LAS unsigned*)(lds + LDS_BYTES))[threadIdx.x] = 0u;
    __syncthreads();
    const XcdBarrier xb = xcd_barrier_post((unsigned*)(p.ws + WS_CTL + CTL_BAR), (volatile LAS unsigned*)(lds + LDS_BYTES));
#define GSYNC() xcd_barrier(xb)
    const bf16_t* HN = (const bf16_t*)(p.ws + WS_HN);
    const bf16_t* Win = (const bf16_t*)(p.ws + WS_W + W_IN);
    const bf16_t* Wout = (const bf16_t*)(p.ws + WS_W + W_OUT);
    phase_rope(p);
    phase_convert_io(p, 0, lds);
    phase_prep<0>(p, p.in[I_EVNORM], 0);
    if (p.ws == nullptr) grid.sync();
    GSYNC();
    volatile LAS unsigned* qword = (volatile LAS unsigned*)(lds + LDS_BYTES + 8);
    for (int layer = 0; layer < 4; ++layer) {
        const int li = layer >> 1;
        if ((layer & 1) == 0) {
            phase_gemm<EPI_EVEN_IN>(p, HN, 1024, Win, 1024, EVPAD / 128, lds);
            GSYNC();
            for (int u = bidx(); u < 1024; u += gridDim.x) gdn_prep_unit(p, li, u, lds);
            GSYNC();
            if (bidx() < 16) gdn_scan_block(p, bidx(), lds);
            {
                unsigned* qctr = (unsigned*)(p.ws + WS_CTL + CTL_QUEUE) + li * 64;
                for (;;) {
                    __syncthreads();
                    if (threadIdx.x == 0) *qword = atomicAdd(qctr, 1u);
                    __syncthreads();
                    const unsigned u = *qword;
                    if (u >= 2048u) break;
                    rwkv_prep_unit(p, li, (int)u, lds);
                }
            }
            GSYNC();
            if (bidx() < 32) rwkv_scan_block(p, bidx(), lds);
            else {
                for (int u = bidx() - 32; u < 1024; u += gridDim.x - 32) gdn_post_unit(p, li, u);
                phase_convert_moe(p, layer, lds, bidx() - 32, gridDim.x - 32);
            }
            GSYNC();
            for (int u = bidx(); u < 2048; u += gridDim.x) rwkv_post_unit(p, li, u);
            GSYNC();
            phase_gemm<EPI_RESID>(p, (const bf16_t*)(p.ws + WS_PROJ), EVLD, Wout, 1024, 8, lds, false, HN, 1024, 512);
        } else {
            phase_gemm<EPI_ODD_IN>(p, HN, 1024, Win, 1024, ODC / 128, lds);
            GSYNC();
            for (int u = bidx(); u < 3072; u += gridDim.x) attn_unit(p, u, lds);
            GSYNC();
            phase_attn_merge(p);
            GSYNC();
            phase_gemm<EPI_RESID>(p, HN, 512, Wout, 512, 8, lds);
        }
        GSYNC();
        phase_router(p, p.in[I_FFNNORM] + layer * 1024, layer, lds);
        GSYNC();
        phase_moe_up(p, layer, lds);
        GSYNC();
        phase_moe_down(p, layer, lds);
        GSYNC();
        if (layer < 3) {
            phase_convert_io(p, layer + 1, lds);
            if ((layer + 1) & 1) phase_convert_moe(p, layer + 1, lds, bidx(), gridDim.x);
            phase_prep<1>(p, ((layer + 1) & 1) ? p.in[I_ODNORM] + ((layer + 1) >> 1) * 1024 : p.in[I_EVNORM] + ((layer + 1) >> 1) * 1024, layer + 1);
            GSYNC();
        }
    }
    phase_prep<3>(p, p.in[I_FINAL], 0);
}

extern "C" void kernel_launch(void* const* d_in, const int* in_sizes, int n_in, void* d_out, int out_size, void* d_ws, size_t ws_size, hipStream_t stream) {
    if (n_in != 34 || out_size != T * D || ws_size < WS_END) { fprintf(stderr, "kernel_launch: unexpected shapes (n_in %d out %d ws %zu need %zu)\n", n_in, out_size, ws_size, (size_t)WS_END); return; }
    static int grid_blocks = 0;
    if (!grid_blocks) {
        int dev = 0, cus = 0, per_cu = 0;
        (void)hipGetDevice(&dev);
        (void)hipDeviceGetAttribute(&cus, hipDeviceAttributeMultiprocessorCount, dev);
        (void)hipFuncSetAttribute((const void*)mega, hipFuncAttributeMaxDynamicSharedMemorySize, LDS_BYTES + 16);
        (void)hipOccupancyMaxActiveBlocksPerMultiprocessor(&per_cu, mega, 256, LDS_BYTES + 16);
        if (per_cu < 1) per_cu = 1;
        if (per_cu > 2) per_cu = 2;
        grid_blocks = cus * per_cu;
    }
    P p{};
    for (int i = 0; i < 34; ++i) p.in[i] = (const float*)d_in[i];
    p.out = (float*)d_out; p.ws = (unsigned char*)d_ws;
    (void)hipMemsetAsync((char*)d_ws + WS_CTL, 0, 65536, stream);
    void* args[] = {&p};
    hipError_t e = hipLaunchCooperativeKernel((void*)mega, dim3(grid_blocks), dim3(256), args, LDS_BYTES + 16, stream);
    if (e != hipSuccess) fprintf(stderr, "cooperative launch failed: %s (grid %d)\n", hipGetErrorString(e), grid_blocks);
}
```

```cpp
#include <hip/hip_runtime.h>
#include <cstdio>
#include <cstdint>
#include <cmath>
#include <hip/hip_cooperative_groups.h>
namespace cg = cooperative_groups;

typedef unsigned short bf16_t;
typedef short bf16x8 __attribute__((ext_vector_type(8)));
typedef float f32x4 __attribute__((ext_vector_type(4)));
typedef unsigned u32x4 __attribute__((ext_vector_type(4)));
typedef unsigned u32x2 __attribute__((ext_vector_type(2)));
#define DI __device__ __forceinline__

constexpr int T = 16384, SEQ = 4096, BATCH = 4, D = 1024;
constexpr int EVC = 3784, EVLD = 3784, EVPAD = 3840;
constexpr int ODC = 4608;
constexpr int RW0 = 2056;
constexpr int C_R = 2056, C_K = 2568, C_V = 3080, C_HW = 3592, C_HA = 3624, C_HG = 3656, C_HV = 3752;
constexpr int NEXP = 16, FF = 256;
constexpr int HROWS = 34816;

constexpr size_t WS_CTL = 0;
constexpr size_t CTL_EGL = 4096;
constexpr size_t CTL_QUEUE = 49152;
constexpr size_t CTL_CNT = 32768;
constexpr size_t CTL_BAR = 16384;
constexpr size_t WS_LIST = 65536;
constexpr size_t WS_GATE = WS_LIST + 16 * 16384 * 4;
constexpr size_t WS_RK = WS_GATE + 16 * 16384 * 4;
constexpr size_t WS_ROPE = WS_RK + (size_t)T * 8 * 4;
constexpr size_t WS_W = WS_ROPE + (size_t)T * 32 * 8;
constexpr size_t W_IN = 0;
constexpr size_t W_OUT = (size_t)4608 * 1024 * 2;
constexpr size_t W_13 = W_OUT + (size_t)1024 * 1024 * 2;
constexpr size_t W_2 = W_13 + (size_t)16 * 512 * 1024 * 2;
constexpr size_t W_LW = W_2 + (size_t)16 * 1024 * 256 * 2;
constexpr size_t W_BYTES = W_LW + (size_t)512 * 192 * 2;
constexpr size_t WS_HN = WS_W + W_BYTES;
constexpr size_t WS_VF = WS_HN + (size_t)T * 1024 * 2;
constexpr size_t WS_R2 = WS_VF + (size_t)T * 512 * 2;
constexpr size_t WS_PROJ = WS_R2;
constexpr size_t WS_GOPS = WS_R2 + (size_t)T * EVLD * 2;
constexpr size_t GOPS_CH = 73728, GO_UF = 0, GO_WF = 16384, GO_QF = 32768, GO_AF = 49152, GO_KF = 57344;
constexpr size_t WS_ROPS = WS_GOPS + 1024 * GOPS_CH;
constexpr size_t WS_QK = WS_R2;
constexpr size_t WS_VT = WS_QK + (size_t)T * 3072 * 2;
constexpr size_t WS_OG = WS_VT + (size_t)T * 1536 * 2;
constexpr size_t WS_LSE = WS_OG + (size_t)3 * T * 512 * 2;
constexpr size_t WS_END3 = WS_LSE + (size_t)3 * T * 8 * 4;
constexpr size_t WS_YS = WS_R2;
constexpr size_t WS_H = WS_YS + (size_t)2 * T * 1024 * 2;
constexpr size_t WS_GG = WS_ROPS + (size_t)2048 * 16384;
constexpr size_t WS_END0 = WS_GG + (size_t)T * 512 * 2;
constexpr size_t WS_END1 = WS_H + (size_t)HROWS * 256 * 2;
constexpr size_t WS_END2 = WS_R2 + (size_t)T * 4608 * 2;
static_assert(WS_END3 <= WS_END0, "odd-layer regions exceed even-layer footprint");
constexpr size_t WS_END = WS_END0 > WS_END1 ? (WS_END0 > WS_END2 ? WS_END0 : WS_END2) : (WS_END1 > WS_END2 ? WS_END1 : WS_END2);

constexpr size_t WS_DUMMY = WS_END0;
struct P {
    const float* in[34];
    float* out;
    unsigned char* ws;
};
enum { I_X = 0, I_POS, I_EVNORM, I_EVWIN, I_VRESDOWN, I_EVWOUT, I_CONVW, I_ALOG, I_DTB, I_GDNNORM, I_MU, I_W0, I_W2, I_A0, I_A2, I_G2,
       I_KK, I_KA, I_RK, I_LNW, I_LNB, I_VRESMU, I_V0, I_V2, I_ODNORM, I_ODWIN, I_ODWOUT, I_FFNNORM, I_WGROUP, I_WEXPERT, I_W1, I_W3, I_MW2, I_FINAL };

DI int tidx() { int t = threadIdx.x; asm volatile("" : "+v"(t)); return t; }
DI int bidx() { int b = blockIdx.x; asm volatile("" : "+s"(b)); return b; }
typedef __bf16 bf2_t __attribute__((ext_vector_type(2)));
typedef float f2_t __attribute__((ext_vector_type(2)));
DI bf16_t f2bf(float x) { return __builtin_bit_cast(bf16_t, (__bf16)x); }
DI float bf2f(bf16_t h) { return __uint_as_float(((unsigned)h) << 16); }
DI unsigned pack2(float lo, float hi) { const f2_t v = {lo, hi}; return __builtin_bit_cast(unsigned, __builtin_convertvector(v, bf2_t)); }
DI float wave_sum(float v) {
#pragma unroll
    for (int o = 32; o > 0; o >>= 1) v += __shfl_xor(v, o);
    return v;
}
DI float wave_max(float v) {
#pragma unroll
    for (int o = 32; o > 0; o >>= 1) v = fmaxf(v, __shfl_xor(v, o));
    return v;
}
DI float sigmoidf_(float x) { return __builtin_amdgcn_rcpf(1.f + __expf(-x)); }
DI float siluf_(float x) { return x * __builtin_amdgcn_rcpf(1.f + __expf(-x)); }
DI float softplusf_(float x) { return fmaxf(x, 0.f) + __logf(1.f + __expf(-fabsf(x))); }

struct ConvJob { const float* src; bf16_t* dst; int K, N, ldd; int mode; };
DI int rowmap(int mode, int n) { return mode == 0 ? n : ((n >> 4) * 32 + (n & 15) + (mode == 2 ? 16 : 0)); }
DI void conv_tile(const ConvJob& j, int tile, float* lds  ) {
    const int ntn = (j.N + 255) / 256;
    const int tk = tile / ntn, tn = tile % ntn;
    const int tid = tidx();
    __syncthreads();
    float4 v[16];
#pragma unroll
    for (int i = 0; i < 16; ++i) {
        const int e = tid + i * 256, k = e >> 6, n4 = (e & 63) * 4;
        const int gk = tk * 64 + k, gn = tn * 256 + n4;
        v[i] = make_float4(0.f, 0.f, 0.f, 0.f);
        if (gn < j.N) v[i] = *(const float4*)(j.src + (size_t)gk * j.N + gn);
    }
#pragma unroll
    for (int i = 0; i < 16; ++i) { const int e = tid + i * 256, k = e >> 6, n4 = (e & 63) * 4; *(float4*)(lds + k * 260 + n4) = v[i]; }
    __syncthreads();
#pragma unroll
    for (int i = 0; i < 8; ++i) {
        const int e = tid + i * 256, n = e & 255, k8 = (e >> 8) * 8;
        const int gn = tn * 256 + n;
        if (gn < j.N) {
            u32x4 w;
            w.x = pack2(lds[(k8 + 0) * 260 + n], lds[(k8 + 1) * 260 + n]); w.y = pack2(lds[(k8 + 2) * 260 + n], lds[(k8 + 3) * 260 + n]);
            w.z = pack2(lds[(k8 + 4) * 260 + n], lds[(k8 + 5) * 260 + n]); w.w = pack2(lds[(k8 + 6) * 260 + n], lds[(k8 + 7) * 260 + n]);
            *(u32x4*)(j.dst + (size_t)rowmap(j.mode, gn) * j.ldd + tk * 64 + k8) = w;
        }
    }
}
DI void phase_convert_io(const P& p, int layer, char* ldsc) {
    float* lds = (float*)ldsc;
    unsigned char* W = p.ws + WS_W;
    const int li = layer >> 1;
    if ((layer & 1) == 0) {
        const ConvJob j0{p.in[I_EVWIN] + (size_t)li * 1024 * 3752, (bf16_t*)(W + W_IN), 1024, 3752, 1024, 0};
        for (int t = bidx(); t < 16 * 15; t += gridDim.x) conv_tile(j0, t, lds);
        if (li == 1) {
            const ConvJob j1{p.in[I_VRESDOWN], (bf16_t*)(W + W_IN) + (size_t)3752 * 1024, 1024, 32, 1024, 0};
            for (int t = bidx(); t < 16; t += gridDim.x) conv_tile(j1, t, lds);
        }
        const ConvJob j2{p.in[I_EVWOUT] + (size_t)li * 1024 * 1024, (bf16_t*)(W + W_OUT), 1024, 1024, 1024, 0};
        for (int t = bidx(); t < 16 * 4; t += gridDim.x) conv_tile(j2, t, lds);
        {
            bf16_t* LW = (bf16_t*)(W + W_LW);
            for (int i = bidx() * 256 + tidx(); i < 512 * 192; i += gridDim.x * 256) {
                const int ch = i / 192, j = i % 192;
                float v;
                if (j < 32) v = p.in[I_W2][((size_t)li * 32 + j) * 512 + ch];
                else if (j < 64) v = p.in[I_A2][((size_t)li * 32 + j - 32) * 512 + ch];
                else if (j < 160) v = p.in[I_G2][((size_t)li * 96 + j - 64) * 512 + ch];
                else v = (li == 1) ? p.in[I_V2][(size_t)(j - 160) * 512 + ch] : 0.f;
                LW[i] = f2bf(v);
            }
        }
        const int r0 = (li == 1) ? 3784 : 3752;
        bf16_t* z = (bf16_t*)(W + W_IN) + (size_t)r0 * 1024;
        const size_t n = (size_t)(EVPAD - r0) * 1024;
        for (size_t i = (size_t)bidx() * 256 + tidx(); i < n; i += (size_t)gridDim.x * 256) z[i] = 0;
    } else {
        const ConvJob j0{p.in[I_ODWIN] + (size_t)li * 1024 * 4608, (bf16_t*)(W + W_IN), 1024, 4608, 1024, 0};
        for (int t = bidx(); t < 16 * 18; t += gridDim.x) conv_tile(j0, t, lds);
        const ConvJob j2{p.in[I_ODWOUT] + (size_t)li * 512 * 1024, (bf16_t*)(W + W_OUT), 512, 1024, 512, 0};
        for (int t = bidx(); t < 8 * 4; t += gridDim.x) conv_tile(j2, t, lds);
    }
}
DI void phase_convert_moe(const P& p, int layer, char* ldsc, int b0, int bs) {
    float* lds = (float*)ldsc;
    unsigned char* W = p.ws + WS_W;
    for (int t = b0; t < 16 * 3 * 16; t += bs) {
        const int e = t / 48, r = t % 48, which = r / 16, tile = r % 16;
        ConvJob j;
        if (which == 0) j = ConvJob{p.in[I_W1] + ((size_t)layer * 16 + e) * 1024 * 256, (bf16_t*)(W + W_13) + (size_t)e * 512 * 1024, 1024, 256, 1024, 1};
        else if (which == 1) j = ConvJob{p.in[I_W3] + ((size_t)layer * 16 + e) * 1024 * 256, (bf16_t*)(W + W_13) + (size_t)e * 512 * 1024, 1024, 256, 1024, 2};
        else j = ConvJob{p.in[I_MW2] + ((size_t)layer * 16 + e) * 256 * 1024, (bf16_t*)(W + W_2) + (size_t)e * 1024 * 256, 256, 1024, 256, 0};
        conv_tile(j, tile, lds);
    }
}

DI void phase_rope(const P& p) {
    float2* tab = (float2*)(p.ws + WS_ROPE);
    const int* pos = (const int*)p.in[I_POS];
    for (int i = bidx() * 256 + tidx(); i < T * 32; i += gridDim.x * 256) {
        const int t = i >> 5, f = i & 31;
        const float inv = powf(10000.0f, -(float)f * (2.0f / 64.0f));
        const float ang = (float)pos[t] * inv;
        float s, c; sincosf(ang, &s, &c);
        tab[i] = make_float2(c, s);
    }
}

template <int MODE>
DI void phase_prep(const P& p, const float* gain, int layer, bool dry = false) {
    const int lane = tidx() & 63, wid = tidx() >> 6;
    const int nw = gridDim.x * 4;
    bf16_t* hn = (bf16_t*)(p.ws + WS_HN);
    const bf16_t* y0 = (const bf16_t*)(p.ws + WS_YS);
    const bf16_t* y1 = y0 + (size_t)T * 1024;
    float4 gq[4];
#pragma unroll
    for (int i = 0; i < 4; ++i) gq[i] = *(const float4*)(gain + i * 256 + lane * 4);
    for (int t = bidx() * 4 + wid; t < T; t += nw) {
        float4 v[4];
        float ss = 0.f;
#pragma unroll
        for (int i = 0; i < 4; ++i) {
            const size_t off = (size_t)t * 1024 + i * 256 + lane * 4;
            if (MODE == 0) v[i] = *(const float4*)(p.in[I_X] + off);
            else v[i] = *(const float4*)(p.out + off);
            if (MODE == 1 || MODE == 3) {
                const u32x2 a = *(const u32x2*)(y0 + off), b = *(const u32x2*)(y1 + off);
                v[i].x += __uint_as_float(a.x << 16) + __uint_as_float(b.x << 16); v[i].y += __uint_as_float(a.x & 0xffff0000u) + __uint_as_float(b.x & 0xffff0000u);
                v[i].z += __uint_as_float(a.y << 16) + __uint_as_float(b.y << 16); v[i].w += __uint_as_float(a.y & 0xffff0000u) + __uint_as_float(b.y & 0xffff0000u);
            }
            ss += v[i].x * v[i].x + v[i].y * v[i].y + v[i].z * v[i].z + v[i].w * v[i].w;
        }
        ss = wave_sum(ss);
        const float rstd = rsqrtf(ss * (1.0f / 1024.0f) + 1e-6f);
        float lg[20];
        if (MODE == 2) {
#pragma unroll
            for (int q = 0; q < 20; ++q) lg[q] = 0.f;
        }
#pragma unroll
        for (int i = 0; i < 4; ++i) {
            const int col = i * 256 + lane * 4;
            const size_t off = (size_t)t * 1024 + col;
            const float4 g = gq[i];
            float4 h; h.x = v[i].x * rstd * g.x; h.y = v[i].y * rstd * g.y; h.z = v[i].z * rstd * g.z; h.w = v[i].w * rstd * g.w;
            float* od = dry ? (float*)(p.ws + WS_DUMMY) + (off & 0x7FFFF) : p.out + off;
            bf16_t* hd = dry ? (bf16_t*)(p.ws + WS_DUMMY + 2097152) + (off & 0x7FFFF) : hn + off;
            if (MODE == 0 || MODE == 1) *(float4*)od = v[i];
            if (MODE == 3) *(float4*)od = h;
            else { u32x2 w; w.x = pack2(h.x, h.y); w.y = pack2(h.z, h.w); *(u32x2*)hd = w; }
            if (MODE == 2) {
                const float hh[4] = {h.x, h.y, h.z, h.w};
                const float* wg = p.in[I_WGROUP] + (size_t)layer * 1024 * 4;
                const float* we = p.in[I_WEXPERT] + (size_t)layer * 4 * 1024 * 4;
#pragma unroll
                for (int e = 0; e < 4; ++e) {
                    const float4 a = *(const float4*)(wg + (size_t)(col + e) * 4);
                    lg[0] += hh[e] * a.x; lg[1] += hh[e] * a.y; lg[2] += hh[e] * a.z; lg[3] += hh[e] * a.w;
#pragma unroll
                    for (int g2 = 0; g2 < 4; ++g2) {
                        const float4 b = *(const float4*)(we + ((size_t)g2 * 1024 + col + e) * 4);
                        lg[4 + g2 * 4 + 0] += hh[e] * b.x; lg[4 + g2 * 4 + 1] += hh[e] * b.y; lg[4 + g2 * 4 + 2] += hh[e] * b.z; lg[4 + g2 * 4 + 3] += hh[e] * b.w;
                    }
                }
            }
        }
        if (MODE == 2) {
#pragma unroll
            for (int q = 0; q < 20; ++q) lg[q] = wave_sum(lg[q]);
            if (lane == 0) {
                int gs = 0; float gm = lg[0];
#pragma unroll
                for (int g2 = 1; g2 < 4; ++g2) if (lg[g2] > gm) { gm = lg[g2]; gs = g2; }
                float den = 0.f;
#pragma unroll
                for (int g2 = 0; g2 < 4; ++g2) den += __expf(lg[g2] - gm);
                const float pg = 1.f / den;
                float el[4];
#pragma unroll
                for (int e = 0; e < 4; ++e) el[e] = gs == 0 ? lg[4 + e] : gs == 1 ? lg[8 + e] : gs == 2 ? lg[12 + e] : lg[16 + e];
                int i1 = 0; float v1 = el[0];
#pragma unroll
                for (int e = 1; e < 4; ++e) if (el[e] > v1) { v1 = el[e]; i1 = e; }
                int i2 = 0; float v2 = -3.4e38f;
#pragma unroll
                for (int e = 0; e < 4; ++e) if (e != i1 && el[e] > v2) { v2 = el[e]; i2 = e; }
                const float e2 = __expf(v2 - v1);
                const float g1 = pg / (1.f + e2), g2v = pg * e2 / (1.f + e2);
                unsigned* cnt = (unsigned*)(p.ws + WS_CTL + CTL_CNT) + layer * 16 * 64;
                int* list = (int*)(p.ws + WS_LIST);
                float* gl = (float*)(p.ws + WS_GATE);
                const int ea = gs * 4 + i1, eb = gs * 4 + i2;
                const unsigned ra = atomicAdd(&cnt[ea * 64], 1u);
                list[ea * 16384 + ra] = t * 2; gl[ea * 16384 + ra] = g1;
                const unsigned rb = atomicAdd(&cnt[eb * 64], 1u);
                list[eb * 16384 + rb] = t * 2 + 1; gl[eb * 16384 + rb] = g2v;
            }
        }
    }
}


DI void phase_router(const P& p, const float* gain, int layer, char* ldsc, bool dry = false) {
    const int tid = tidx(), lane = tid & 63, wid = tid >> 6;
    bf16_t* hn = (bf16_t*)(p.ws + WS_HN);
    const float* wg = p.in[I_WGROUP] + (size_t)layer * 1024 * 4;
    const float* we = p.in[I_WEXPERT] + (size_t)layer * 4 * 1024 * 4;
    unsigned* cnt = dry ? (unsigned*)(p.ws + WS_DUMMY + 3145728) : (unsigned*)(p.ws + WS_CTL + CTL_CNT) + layer * 16 * 64;
    int* list = dry ? (int*)(p.ws + WS_DUMMY) : (int*)(p.ws + WS_LIST);
    float* gl = dry ? (float*)(p.ws + WS_DUMMY + 1048576) : (float*)(p.ws + WS_GATE);
    if (dry) hn = (bf16_t*)(p.ws + WS_DUMMY + 2097152);
    f32x4* WS = (f32x4*)ldsc;
    unsigned* lcnt = (unsigned*)(ldsc + 40960); unsigned* lbase = lcnt + 16; int* e_ent = (int*)(lcnt + 32); unsigned* r_ent = (unsigned*)(e_ent + 32); int* t_ent = (int*)(r_ent + 32); float* g_ent = (float*)(t_ent + 32);
    auto stage = [&](int i, int buf) {
#pragma unroll
        for (int r = 0; r < 5; ++r) {
            const int kk = tid;
            const float* src = (r == 0 ? wg : we + (size_t)(r - 1) * 4096) + (size_t)(i * 256 + kk) * 4;
            WS[buf * 1280 + (r * 4 + (kk & 3)) * 64 + (kk >> 2)] = *(const f32x4*)src;
        }
    };
    for (int tb = bidx() * 16; tb < T; tb += gridDim.x * 16) {
        __syncthreads();
        if (tid < 16) lcnt[tid] = 0u;
        stage(0, 0);
        const int t0 = tb + wid * 4;
        float rstd[4];
#pragma unroll
        for (int q = 0; q < 4; ++q) {
            float ss = 0.f;
#pragma unroll
            for (int i = 0; i < 4; ++i) {
                const float4 x4 = *(const float4*)(p.out + (size_t)(t0 + q) * 1024 + i * 256 + lane * 4);
                ss += x4.x * x4.x + x4.y * x4.y + x4.z * x4.z + x4.w * x4.w;
            }
            ss = wave_sum(ss);
            rstd[q] = rsqrtf(ss * (1.0f / 1024.0f) + 1e-6f);
        }
        float lg[4][20];
#pragma unroll
        for (int q = 0; q < 4; ++q)
#pragma unroll
            for (int j = 0; j < 20; ++j) lg[q][j] = 0.f;
#pragma unroll 1
        for (int i = 0; i < 4; ++i) {
            __syncthreads();
            if (i + 1 < 4) stage(i + 1, (i + 1) & 1);
            const f32x4* W = WS + (i & 1) * 1280;
            const int col = i * 256 + lane * 4;
            const float4 g = *(const float4*)(gain + col);
            float hh[4][4];
#pragma unroll
            for (int q = 0; q < 4; ++q) {
                const float4 x4 = *(const float4*)(p.out + (size_t)(t0 + q) * 1024 + col);
                hh[q][0] = x4.x * rstd[q] * g.x; hh[q][1] = x4.y * rstd[q] * g.y; hh[q][2] = x4.z * rstd[q] * g.z; hh[q][3] = x4.w * rstd[q] * g.w;
                u32x2 w; w.x = pack2(hh[q][0], hh[q][1]); w.y = pack2(hh[q][2], hh[q][3]);
                *(u32x2*)(hn + (dry ? (((size_t)(t0 + q) * 1024 + col) & 0x7FFFF) : ((size_t)(t0 + q) * 1024 + col))) = w;
            }
#pragma unroll
            for (int e = 0; e < 4; ++e) {
                const f32x4 a = W[(0 * 4 + e) * 64 + lane];
#pragma unroll
                for (int q = 0; q < 4; ++q) { lg[q][0] += hh[q][e] * a[0]; lg[q][1] += hh[q][e] * a[1]; lg[q][2] += hh[q][e] * a[2]; lg[q][3] += hh[q][e] * a[3]; }
#pragma unroll
                for (int g2 = 0; g2 < 4; ++g2) {
                    const f32x4 b = W[((1 + g2) * 4 + e) * 64 + lane];
#pragma unroll
                    for (int q = 0; q < 4; ++q) { lg[q][4 + g2 * 4] += hh[q][e] * b[0]; lg[q][5 + g2 * 4] += hh[q][e] * b[1]; lg[q][6 + g2 * 4] += hh[q][e] * b[2]; lg[q][7 + g2 * 4] += hh[q][e] * b[3]; }
                }
            }
        }
#pragma unroll
        for (int q = 0; q < 4; ++q) {
#pragma unroll
            for (int j = 0; j < 20; ++j) lg[q][j] = wave_sum(lg[q][j]);
            if (lane == q) {
                const int t = t0 + q;
                int gs = 0; float gm = lg[q][0];
#pragma unroll
                for (int g2 = 1; g2 < 4; ++g2) if (lg[q][g2] > gm) { gm = lg[q][g2]; gs = g2; }
                float den = 0.f;
#pragma unroll
                for (int g2 = 0; g2 < 4; ++g2) den += __expf(lg[q][g2] - gm);
                const float pg = 1.f / den;
                float el[4];
#pragma unroll
                for (int e = 0; e < 4; ++e) el[e] = gs == 0 ? lg[q][4 + e] : gs == 1 ? lg[q][8 + e] : gs == 2 ? lg[q][12 + e] : lg[q][16 + e];
                int i1 = 0; float v1 = el[0];
#pragma unroll
                for (int e = 1; e < 4; ++e) if (el[e] > v1) { v1 = el[e]; i1 = e; }
                int i2 = 0; float v2 = -3.4e38f;
#pragma unroll
                for (int e = 0; e < 4; ++e) if (e != i1 && el[e] > v2) { v2 = el[e]; i2 = e; }
                const float e2 = __expf(v2 - v1);
                const float g1 = pg / (1.f + e2), g2v = pg * e2 / (1.f + e2);
                const int ea = gs * 4 + i1, eb = gs * 4 + i2;
                const int sl = (wid * 4 + q) * 2;
                e_ent[sl] = ea; r_ent[sl] = atomicAdd(&lcnt[ea], 1u); t_ent[sl] = t * 2; g_ent[sl] = g1;
                e_ent[sl + 1] = eb; r_ent[sl + 1] = atomicAdd(&lcnt[eb], 1u); t_ent[sl + 1] = t * 2 + 1; g_ent[sl + 1] = g2v;
            }
        }
        __syncthreads();
        if (tid < 16) lbase[tid] = lcnt[tid] ? atomicAdd(&cnt[tid * 64], lcnt[tid]) : 0u;
        __syncthreads();
        if (tid < 32) {
            const int e = e_ent[tid];
            const unsigned pos = (lbase[e] + r_ent[tid]) & 16383u;
            list[e * 16384 + pos] = t_ent[tid]; gl[e * 16384 + pos] = g_ent[tid];
        }
    }
}

constexpr int GBK = 64;
typedef __attribute__((address_space(3))) unsigned lds_u32;
struct TileP { const bf16_t* ar[4]; const bf16_t* br[4]; const bf16_t* ar2[4]; };
DI void gemm_core(const TileP& tp, int K, char* lds, f32x4 (&acc)[4][4], int ksplit, bool primed, const TileP& nx, bool have_nx) {
    const bf16_t* const (&ar)[4] = tp.ar; const bf16_t* const (&br)[4] = tp.br; const bf16_t* const (&ar2)[4] = tp.ar2;
    const int tid = tidx(), wid = tid >> 6, lane = tid & 63, wr = wid >> 1, wc = wid & 1, fr = lane & 15, fq = lane >> 4;
    const int scol = ((tid & 7) ^ ((tid >> 3) & 7)) * 8;
#pragma unroll
    for (int n = 0; n < 4; ++n)
#pragma unroll
        for (int m = 0; m < 4; ++m) acc[n][m] = (f32x4){0.f, 0.f, 0.f, 0.f};
    const int nk = K / GBK;
    if (!primed) {
        __syncthreads();
#pragma unroll
        for (int i = 0; i < 4; ++i) {
            __builtin_amdgcn_global_load_lds((const unsigned*)(ar[i] + scol), (lds_u32*)(lds + tid * 16 + i * 4096), 16, 0, 0);
            __builtin_amdgcn_global_load_lds((const unsigned*)(br[i] + scol), (lds_u32*)(lds + 16384 + tid * 16 + i * 4096), 16, 0, 0);
        }
    }
    const int sw = fr & 7;
    for (int kt = 0; kt < nk; ++kt) {
        asm volatile("s_waitcnt vmcnt(0)" ::: "memory");
        __builtin_amdgcn_s_barrier();
        if (kt + 1 < nk) {
            char* nb = lds + ((kt + 1) & 1) * 32768;
            const int ko = (kt + 1) * GBK + scol;
#pragma unroll
            for (int i = 0; i < 4; ++i) {
                __builtin_amdgcn_global_load_lds((const unsigned*)(((kt + 1) * GBK >= ksplit ? ar2[i] : ar[i]) + ko), (lds_u32*)(nb + tid * 16 + i * 4096), 16, 0, 0);
                __builtin_amdgcn_global_load_lds((const unsigned*)(br[i] + ko), (lds_u32*)(nb + 16384 + tid * 16 + i * 4096), 16, 0, 0);
            }
        } else if (have_nx) {
#pragma unroll
            for (int i = 0; i < 4; ++i) {
                __builtin_amdgcn_global_load_lds((const unsigned*)(nx.ar[i] + scol), (lds_u32*)(lds + tid * 16 + i * 4096), 16, 0, 0);
                __builtin_amdgcn_global_load_lds((const unsigned*)(nx.br[i] + scol), (lds_u32*)(lds + 16384 + tid * 16 + i * 4096), 16, 0, 0);
            }
        }
        const char* SA = lds + (kt & 1) * 32768; const char* SB = SA + 16384;
#pragma unroll
        for (int kh = 0; kh < 2; ++kh) {
            bf16x8 af[4], bfr[4];
            const int co = ((kh * 4 + fq) ^ sw) * 16;
#pragma unroll
            for (int m = 0; m < 4; ++m) af[m] = *(const bf16x8*)(SA + (wr * 64 + m * 16 + fr) * 128 + co);
#pragma unroll
            for (int n = 0; n < 4; ++n) bfr[n] = *(const bf16x8*)(SB + (wc * 64 + n * 16 + fr) * 128 + co);
#pragma unroll
            for (int n = 0; n < 4; ++n)
#pragma unroll
                for (int m = 0; m < 4; ++m) acc[n][m] = __builtin_amdgcn_mfma_f32_16x16x32_bf16(bfr[n], af[m], acc[n][m], 0, 0, 0);
        }
    }
}

enum { EPI_EVEN_IN = 0, EPI_ODD_IN, EPI_RESID };
template <int EPI>
DI void phase_gemm(const P& p, const bf16_t* A, int lda, const bf16_t* Bt, int K, int ntn, char* lds, bool dry = false, const bf16_t* A2 = nullptr, int lda2 = 0, int ksplit = 1 << 30) {
    const int tid = tidx(), wid = tid >> 6, lane = tid & 63, wr = wid >> 1, wc = wid & 1, fr = lane & 15, fq = lane >> 4;
    const int ntm = T / 128, ntiles = ntm * ntn;
    auto fill = [&](TileP& t, int tile) {
        const int tn = tile / ntm, tm = tile % ntm, r = tid >> 3;
#pragma unroll
        for (int i = 0; i < 4; ++i) { t.ar[i] = A + (size_t)(tm * 128 + r + 32 * i) * lda; t.br[i] = Bt + (size_t)(tn * 128 + r + 32 * i) * K; t.ar2[i] = A2 ? A2 + (size_t)(tm * 128 + r + 32 * i) * lda2 : t.ar[i]; }
    };
    TileP cur, nxt;
    bool primed = false;
    fill(cur, bidx() < ntiles ? bidx() : 0); nxt = cur;
    for (int tile = bidx(); tile < ntiles; tile += gridDim.x) {
        const int tn = tile / ntm, tm = tile % ntm;
        const bool have_next = tile + (int)gridDim.x < ntiles;
        if (have_next) fill(nxt, tile + gridDim.x);
        f32x4 acc[4][4];
        gemm_core(cur, K, lds, acc, ksplit, primed, nxt, have_next);
        primed = have_next; cur = nxt;
        const int m0 = tm * 128 + wr * 64, n0 = tn * 128 + wc * 64;
        if (EPI == EPI_EVEN_IN) {
            bf16_t* C = (bf16_t*)(p.ws + WS_PROJ);
#pragma unroll
            for (int m = 0; m < 4; ++m)
#pragma unroll
                for (int n = 0; n < 4; ++n) {
                    const int row = m0 + m * 16 + fr, col = n0 + n * 16 + fq * 4;
                    if (col < EVC) { u32x2 w; w.x = pack2(acc[n][m][0], acc[n][m][1]); w.y = pack2(acc[n][m][2], acc[n][m][3]); *(u32x2*)(C + (size_t)row * EVLD + col) = w; }
                }
        } else if (EPI == EPI_ODD_IN) {
            bf16_t* C = (bf16_t*)(p.ws + WS_QK);
            const float2* tab = (const float2*)(p.ws + WS_ROPE);
            if (n0 < 3072) {
#pragma unroll
                for (int m = 0; m < 4; ++m) {
                    const int row = m0 + m * 16 + fr;
#pragma unroll
                    for (int n = 0; n < 2; ++n) {
                        float lo[4], hi[4];
#pragma unroll
                        for (int j = 0; j < 4; ++j) {
                            const float2 cs = tab[(size_t)row * 32 + n * 16 + fq * 4 + j];
                            const float x1 = acc[n][m][j], x2 = acc[n + 2][m][j];
                            lo[j] = x1 * cs.x - x2 * cs.y; hi[j] = x2 * cs.x + x1 * cs.y;
                        }
                        u32x2 w; w.x = pack2(lo[0], lo[1]); w.y = pack2(lo[2], lo[3]);
                        *(u32x2*)(C + (size_t)row * 3072 + n0 + n * 16 + fq * 4) = w;
                        w.x = pack2(hi[0], hi[1]); w.y = pack2(hi[2], hi[3]);
                        *(u32x2*)(C + (size_t)row * 3072 + n0 + (n + 2) * 16 + fq * 4) = w;
                    }
                }
            }
            if (tn * 128 >= 3072) {
                bf16_t* VT = (bf16_t*)(p.ws + WS_VT);
                const int hg0 = (tn * 128 - 3072) >> 6, g = hg0 >> 3, lg2 = g * 2, dil = 1 << lg2, L = SEQ >> lg2, run = 128 >> lg2;
                __syncthreads();
#pragma unroll
                for (int m = 0; m < 4; ++m)
#pragma unroll
                    for (int n = 0; n < 4; ++n)
#pragma unroll
                        for (int j = 0; j < 4; ++j)
                            *(bf16_t*)(lds + 32768 + (wc * 64 + n * 16 + fq * 4 + j) * 272 + (wr * 64 + m * 16 + fr) * 2) = f2bf(acc[n][m][j]);
                __syncthreads();
                const int bb = (tm * 128) >> 12, s0 = (tm * 128) & (SEQ - 1);
#pragma unroll
                for (int q = 0; q < 8; ++q) {
                    const int item = tid + q * 256, dim = item >> 4, o0 = (item & 15) * 8;
                    const int rr = o0 / run, i0 = o0 % run;
                    const char* src = lds + 32768 + dim * 272 + (rr + dil * i0) * 2;
                    float e8[8];
#pragma unroll
                    for (int e = 0; e < 8; ++e) e8[e] = bf2f(*(const bf16_t*)(src + e * dil * 2));
                    u32x4 w; w.x = pack2(e8[0], e8[1]); w.y = pack2(e8[2], e8[3]); w.z = pack2(e8[4], e8[5]); w.w = pack2(e8[6], e8[7]);
                    const int hg = hg0 + (dim >> 6);
                    *(u32x4*)(VT + ((size_t)((bb * 24 + hg) * dil + rr) * 64 + (dim & 63)) * L + (s0 >> lg2) + i0) = w;
                }
            }
        } else {
#pragma unroll
            for (int m = 0; m < 4; ++m)
#pragma unroll
                for (int n = 0; n < 4; ++n) {
                    const size_t qo = (size_t)(m0 + m * 16 + fr) * 1024 + n0 + n * 16 + fq * 4;
                    float* q = dry ? (float*)(p.ws + WS_DUMMY) + (qo & 0x7FFFF) : p.out + qo;
                    float4 v = *(float4*)q;
                    v.x += acc[n][m][0]; v.y += acc[n][m][1]; v.z += acc[n][m][2]; v.w += acc[n][m][3];
                    *(float4*)q = v;
                }
        }
    }
}

DI void phase_moe_up(const P& p, int layer, char* lds) {
    const int tid = tidx(), wid = tid >> 6, lane = tid & 63, wr = wid >> 1, wc = wid & 1, fr = lane & 15, fq = lane >> 4;
    const unsigned* cntb = (const unsigned*)(p.ws + WS_CTL + CTL_CNT) + layer * 16 * 64;
    unsigned cnt[16];
#pragma unroll
    for (int e = 0; e < 16; ++e) cnt[e] = cntb[e * 64];
    const int* list = (const int*)(p.ws + WS_LIST);
    const float* gl = (const float*)(p.ws + WS_GATE);
    const bf16_t* hn = (const bf16_t*)(p.ws + WS_HN);
    const bf16_t* W13 = (const bf16_t*)(p.ws + WS_W + W_13);
    bf16_t* H = (bf16_t*)(p.ws + WS_H);
    int ttot = 0;
#pragma unroll
    for (int e = 0; e < 16; ++e) ttot += ((int)cnt[e] + 127) >> 7;
    const int ntiles = ttot * 4;
    auto locate = [&](int tile, int& e, int& lt, int& ce, int& rbe, int& tn) {
        const int mt = tile >> 2; tn = tile & 3;
        int tbe = 0, acc_t = 0; e = 0;
#pragma unroll
        for (int q = 0; q < 16; ++q) { const int nt = ((int)cnt[q] + 127) >> 7; if (mt >= acc_t) { e = q; tbe = acc_t; } acc_t += nt; }
        lt = mt - tbe; ce = (int)cnt[e]; rbe = tbe * 128;
    };
    auto fill = [&](TileP& t, int tile) {
        int e, lt, ce, rbe, tn; locate(tile, e, lt, ce, rbe, tn);
        const int r = tid >> 3;
#pragma unroll
        for (int i = 0; i < 4; ++i) {
            const int ii = lt * 128 + r + 32 * i;
            const int tk = ii < ce ? (list[e * 16384 + ii] >> 1) : 0;
            t.ar[i] = hn + (size_t)tk * 1024; t.ar2[i] = t.ar[i];
            t.br[i] = W13 + ((size_t)e * 512 + tn * 128 + r + 32 * i) * 1024;
        }
    };
    TileP cur, nxt;
    bool primed = false;
    fill(cur, bidx() < ntiles ? bidx() : 0); nxt = cur;
    for (int tile = bidx(); tile < ntiles; tile += gridDim.x) {
        int e, lt, ce, rbe, tn; locate(tile, e, lt, ce, rbe, tn);
        const bool have_next = tile + (int)gridDim.x < ntiles;
        if (have_next) fill(nxt, tile + gridDim.x);
        f32x4 acc[4][4];
        gemm_core(cur, 1024, lds, acc, 1 << 30, primed, nxt, have_next);
        primed = have_next; cur = nxt;
#pragma unroll
        for (int m = 0; m < 4; ++m) {
            const int li = lt * 128 + wr * 64 + m * 16 + fr;
            if (li < ce) {
                const float g = gl[e * 16384 + li];
                bf16_t* hrow = H + (size_t)(rbe + li) * 256;
#pragma unroll
                for (int n = 0; n < 4; n += 2) {
                    float o[4];
#pragma unroll
                    for (int j = 0; j < 4; ++j) o[j] = siluf_(acc[n][m][j]) * acc[n + 1][m][j] * g;
                    const int f = tn * 64 + wc * 32 + (n >> 1) * 16 + fq * 4;
                    u32x2 w; w.x = pack2(o[0], o[1]); w.y = pack2(o[2], o[3]);
                    *(u32x2*)(hrow + f) = w;
                }
            }
        }
    }
}
DI void phase_moe_down(const P& p, int layer, char* lds) {
    const int tid = tidx(), wid = tid >> 6, lane = tid & 63, wr = wid >> 1, wc = wid & 1, fr = lane & 15, fq = lane >> 4;
    const unsigned* cntb = (const unsigned*)(p.ws + WS_CTL + CTL_CNT) + layer * 16 * 64;
    unsigned cnt[16];
#pragma unroll
    for (int e = 0; e < 16; ++e) cnt[e] = cntb[e * 64];
    const int* list = (const int*)(p.ws + WS_LIST);
    const bf16_t* W2 = (const bf16_t*)(p.ws + WS_W + W_2);
    const bf16_t* H = (const bf16_t*)(p.ws + WS_H);
    bf16_t* ys = (bf16_t*)(p.ws + WS_YS);
    int ttot = 0;
#pragma unroll
    for (int e = 0; e < 16; ++e) ttot += ((int)cnt[e] + 127) >> 7;
    const int ntiles = ttot * 8;
    auto locate = [&](int tile, int& e, int& lt, int& ce, int& rbe, int& tn) {
        const int mt = tile >> 3; tn = tile & 7;
        int tbe = 0, acc_t = 0; e = 0;
#pragma unroll
        for (int q = 0; q < 16; ++q) { const int nt = ((int)cnt[q] + 127) >> 7; if (mt >= acc_t) { e = q; tbe = acc_t; } acc_t += nt; }
        lt = mt - tbe; ce = (int)cnt[e]; rbe = tbe * 128;
    };
    auto fill = [&](TileP& t, int tile) {
        int e, lt, ce, rbe, tn; locate(tile, e, lt, ce, rbe, tn);
        const int r = tid >> 3;
#pragma unroll
        for (int i = 0; i < 4; ++i) { t.ar[i] = H + (size_t)(rbe + lt * 128 + r + 32 * i) * 256; t.ar2[i] = t.ar[i]; t.br[i] = W2 + ((size_t)e * 1024 + tn * 128 + r + 32 * i) * 256; }
    };
    TileP cur, nxt;
    bool primed = false;
    fill(cur, bidx() < ntiles ? bidx() : 0); nxt = cur;
    for (int tile = bidx(); tile < ntiles; tile += gridDim.x) {
        int e, lt, ce, rbe, tn; locate(tile, e, lt, ce, rbe, tn);
        const bool have_next = tile + (int)gridDim.x < ntiles;
        if (have_next) fill(nxt, tile + gridDim.x);
        f32x4 acc[4][4];
        gemm_core(cur, 256, lds, acc, 1 << 30, primed, nxt, have_next);
        primed = have_next; cur = nxt;
#pragma unroll
        for (int m = 0; m < 4; ++m) {
            const int li = lt * 128 + wr * 64 + m * 16 + fr;
            if (li < ce) {
                const int ts = list[e * 16384 + li];
                bf16_t* yrow = ys + ((size_t)(ts & 1) * T + (ts >> 1)) * 1024 + tn * 128 + wc * 64 + fq * 4;
#pragma unroll
                for (int n = 0; n < 4; ++n) { u32x2 w; w.x = pack2(acc[n][m][0], acc[n][m][1]); w.y = pack2(acc[n][m][2], acc[n][m][3]); *(u32x2*)(yrow + n * 16) = w; }
            }
        }
    }
}


typedef float f32x16 __attribute__((ext_vector_type(16)));
DI f32x4 mfma16(bf16x8 a, bf16x8 b, f32x4 c) { return __builtin_amdgcn_mfma_f32_16x16x32_bf16(a, b, c, 0, 0, 0); }
DI f32x16 mfma32(bf16x8 a, bf16x8 b, f32x16 c) { return __builtin_amdgcn_mfma_f32_32x32x16_bf16(a, b, c, 0, 0, 0); }
DI f32x4 tile16(const char* X, int ldx, int row0, const char* Y, int ldy, int col0, int K) {
    const int lane = tidx() & 63, fr = lane & 15, fq = lane >> 4;
    f32x4 acc = {0.f, 0.f, 0.f, 0.f};
#pragma unroll
    for (int k = 0; k < K; k += 32) {
        const bf16x8 a = *(const bf16x8*)(X + (row0 + fr) * ldx + (k + fq * 8) * 2);
        const bf16x8 b = *(const bf16x8*)(Y + (col0 + fr) * ldy + (k + fq * 8) * 2);
        acc = mfma16(a, b, acc);
    }
    return acc;
}
DI bf16x8 pack_step(const f32x16& x, int s) {
    u32x4 r;
    r.x = pack2(x[8 * s + 0], x[8 * s + 1]); r.y = pack2(x[8 * s + 2], x[8 * s + 3]);
    r.z = pack2(x[8 * s + 4], x[8 * s + 5]); r.w = pack2(x[8 * s + 6], x[8 * s + 7]);
    return __builtin_bit_cast(bf16x8, r);
}

constexpr int GP_LF = 0, GP_T = 17408, GP_VEC = GP_T + 9216, GP_U = GP_VEC + 1024, GP_END = GP_U + 36864;
DI void gdn_prep_unit(const P& p, int li, int ch, char* lds) {
    const int tid = tidx(), lane = tid & 63, wid = tid >> 6, fr = lane & 15, fq = lane >> 4;
    const int h = ch & 3, n = (ch >> 2) & 63, b = ch >> 8;
    const int t0 = b * SEQ + n * 64;
    float* Lf = (float*)(lds + GP_LF);
    char* Trow = lds + GP_T;
    float* gcs = (float*)(lds + GP_VEC); float* egc = gcs + 64; float* bet = gcs + 128; float* ekd = gcs + 192;
    char* Qrow = lds + GP_U; char* Krow = Qrow + 17408; char* VbT = lds + GP_U; char* KbgT = VbT + 18432;
    const bf16_t* proj = (const bf16_t*)(p.ws + WS_PROJ);
    unsigned char* ops = p.ws + WS_GOPS + (size_t)ch * GOPS_CH;
    const float* cw = p.in[I_CONVW] + (size_t)li * 4 * 1536;
    const int c = tid >> 2, cq = tid & 3;
    __syncthreads();
    float* cwl = (float*)(lds + GP_END);
    for (int i = tid; i < 4 * 3 * 32; i += 256) {
        const int j = i / 96, r = i % 96, sl = r >> 5, q4 = (r & 31) * 4;
        *(f32x4*)(cwl + (j * 3 + sl) * 128 + q4) = *(const f32x4*)(cw + j * 1536 + sl * 512 + h * 128 + q4);
    }
    __syncthreads();
    unsigned vvp[16];
#pragma unroll 1
    for (int which = 0; which < 3; ++which) {
        const int col0 = which * 512 + h * 128 + cq * 32;
        u32x4 xin[4][4];
#pragma unroll
        for (int j = 0; j < 4; ++j) {
            const int sp = n * 64 + c - 3 + j;
            const bf16_t* src = proj + (size_t)(b * SEQ + (sp < 0 ? 0 : sp)) * EVLD + col0;
#pragma unroll
            for (int i4 = 0; i4 < 4; ++i4) xin[j][i4] = *(const u32x4*)(src + i4 * 8);
        }
        float acc[32];
#pragma unroll
        for (int i = 0; i < 32; ++i) acc[i] = 0.f;
#pragma unroll
        for (int j = 0; j < 4; ++j) {
            const float ok = (n * 64 + c - 3 + j) >= 0 ? 1.f : 0.f;
            const float* wj = cwl + (j * 3 + which) * 128 + cq * 32;
#pragma unroll
            for (int i4 = 0; i4 < 4; ++i4) {
                const f32x4 wa = *(const f32x4*)(wj + i4 * 8), wb = *(const f32x4*)(wj + i4 * 8 + 4);
                const u32x4 w = xin[j][i4];
                acc[i4 * 8 + 0] += ok * wa[0] * __uint_as_float(w[0] << 16); acc[i4 * 8 + 1] += ok * wa[1] * __uint_as_float(w[0] & 0xffff0000u);
                acc[i4 * 8 + 2] += ok * wa[2] * __uint_as_float(w[1] << 16); acc[i4 * 8 + 3] += ok * wa[3] * __uint_as_float(w[1] & 0xffff0000u);
                acc[i4 * 8 + 4] += ok * wb[0] * __uint_as_float(w[2] << 16); acc[i4 * 8 + 5] += ok * wb[1] * __uint_as_float(w[2] & 0xffff0000u);
                acc[i4 * 8 + 6] += ok * wb[2] * __uint_as_float(w[3] << 16); acc[i4 * 8 + 7] += ok * wb[3] * __uint_as_float(w[3] & 0xffff0000u);
            }
        }
        float ss = 0.f;
#pragma unroll
        for (int i = 0; i < 32; ++i) { acc[i] = siluf_(acc[i]); ss += acc[i] * acc[i]; }
        ss += __shfl_xor(ss, 1); ss += __shfl_xor(ss, 2);
        const float rn = which == 2 ? 1.f : rsqrtf(ss + 1e-6f) * (which == 0 ? 0.08838834764831845f : 1.f);
        unsigned pk[16];
#pragma unroll
        for (int i = 0; i < 16; ++i) pk[i] = pack2(acc[2 * i] * rn, acc[2 * i + 1] * rn);
        if (which < 2) {
            char* img = which == 0 ? Qrow : Krow;
#pragma unroll
            for (int i4 = 0; i4 < 4; ++i4) { u32x4 w; w.x = pk[i4 * 4]; w.y = pk[i4 * 4 + 1]; w.z = pk[i4 * 4 + 2]; w.w = pk[i4 * 4 + 3]; *(u32x4*)(img + c * 272 + (cq * 32 + i4 * 8) * 2) = w; }
        } else {
#pragma unroll
            for (int i = 0; i < 16; ++i) vvp[i] = pk[i];
        }
    }
    if (cq == 0) {
        const float a = bf2f(proj[(size_t)(t0 + c) * EVLD + 2048 + h]);
        const float bb = bf2f(proj[(size_t)(t0 + c) * EVLD + 2052 + h]);
        const float Aexp = __expf(p.in[I_ALOG][li * 4 + h]), dtb = p.in[I_DTB][li * 4 + h];
        gcs[c] = -Aexp * softplusf_(a + dtb);
        bet[c] = sigmoidf_(bb);
    }
    __syncthreads();
    if (wid == 0) {
        float x = gcs[lane];
#pragma unroll
        for (int o = 1; o < 64; o <<= 1) { const float y = __shfl_up(x, o); if (lane >= o) x += y; }
        const float gl = __shfl(x, 63);
        gcs[lane] = x; egc[lane] = __expf(x); ekd[lane] = __expf(gl - x);
        if (lane == 63) ((float*)(p.ws + WS_CTL + CTL_EGL))[ch] = __expf(gl);
    }
    __syncthreads();
    {
        const int ti = wid;
#pragma unroll
        for (int tj = 0; tj < 4; ++tj) {
            if (tj <= ti) {
                const f32x4 kk = tile16(Krow, 272, 16 * ti, Krow, 272, 16 * tj, 128);
                const int c2 = 16 * tj + fr;
                f32x4 lv;
#pragma unroll
                for (int r = 0; r < 4; ++r) {
                    const int c1 = 16 * ti + fq * 4 + r;
                    lv[r] = (c1 > c2) ? bet[c1] * kk[r] * __expf(gcs[c1] - gcs[c2]) : 0.f;
                }
                *(f32x4*)&Lf[c2 * 68 + 16 * ti + fq * 4] = lv;
            }
            f32x4 qk = {0.f, 0.f, 0.f, 0.f};
            if (tj <= ti) qk = tile16(Krow, 272, 16 * tj, Qrow, 272, 16 * ti, 128);
            const int c1 = 16 * ti + fr;
            float o4[4];
#pragma unroll
            for (int r = 0; r < 4; ++r) { const int c2 = 16 * tj + fq * 4 + r; o4[r] = (c1 >= c2) ? qk[r] * __expf(gcs[c1] - gcs[c2]) : 0.f; }
            const int mt = c1 >> 5, rr = c1 & 31, hh = fq & 1, jg = fq >> 1;
            u32x2 w; w.x = pack2(o4[0], o4[1]); w.y = pack2(o4[2], o4[3]);
            *(u32x2*)(ops + GO_AF + ((size_t)((mt * 4 + tj) * 64 + hh * 32 + rr) * 8 + jg * 4) * 2) = w;
        }
#pragma unroll
        for (int i = 0; i < 4; ++i) {
            const int idx = tid + i * 256;
            {
                const int mt = idx >> 9, ks = (idx >> 6) & 7, l2 = idx & 63, rr = l2 & 31, hh = l2 >> 5, cc = 32 * mt + rr;
                const float sc = egc[cc];
                const u32x2 lo = *(const u32x2*)(Qrow + cc * 272 + (16 * ks + 4 * hh) * 2), hi = *(const u32x2*)(Qrow + cc * 272 + (16 * ks + 8 + 4 * hh) * 2);
                u32x4 w;
                w.x = pack2(__uint_as_float(lo.x << 16) * sc, __uint_as_float(lo.x & 0xffff0000u) * sc); w.y = pack2(__uint_as_float(lo.y << 16) * sc, __uint_as_float(lo.y & 0xffff0000u) * sc);
                w.z = pack2(__uint_as_float(hi.x << 16) * sc, __uint_as_float(hi.x & 0xffff0000u) * sc); w.w = pack2(__uint_as_float(hi.y << 16) * sc, __uint_as_float(hi.y & 0xffff0000u) * sc);
                *(u32x4*)(ops + GO_QF + (size_t)idx * 16) = w;
            }
            {
                const int mt = idx >> 8, ks = (idx >> 6) & 3, l2 = idx & 63, rr = l2 & 31, hh = l2 >> 5, dk = 32 * mt + rr;
                float e8[8];
#pragma unroll
                for (int j = 0; j < 8; ++j) { const int c2 = 16 * ks + 8 * (j >> 2) + 4 * hh + (j & 3); e8[j] = bf2f(*(const bf16_t*)(Krow + c2 * 272 + dk * 2)) * ekd[c2]; }
                u32x4 w; w.x = pack2(e8[0], e8[1]); w.y = pack2(e8[2], e8[3]); w.z = pack2(e8[4], e8[5]); w.w = pack2(e8[6], e8[7]);
                *(u32x4*)(ops + GO_KF + (size_t)idx * 16) = w;
            }
        }
    }
    __syncthreads();
    {
        const float bc = bet[c], bg = bc * egc[c];
        unsigned kvp[16];
#pragma unroll
        for (int i4 = 0; i4 < 4; ++i4) { const u32x4 w = *(const u32x4*)(Krow + c * 272 + (cq * 32 + i4 * 8) * 2); kvp[i4 * 4] = w.x; kvp[i4 * 4 + 1] = w.y; kvp[i4 * 4 + 2] = w.z; kvp[i4 * 4 + 3] = w.w; }
        __syncthreads();
#pragma unroll
        for (int i = 0; i < 16; ++i) {
            *(bf16_t*)(VbT + (cq * 32 + 2 * i) * 144 + c * 2) = f2bf(__uint_as_float(vvp[i] << 16) * bc);
            *(bf16_t*)(VbT + (cq * 32 + 2 * i + 1) * 144 + c * 2) = f2bf(__uint_as_float(vvp[i] & 0xffff0000u) * bc);
            *(bf16_t*)(KbgT + (cq * 32 + 2 * i) * 144 + c * 2) = f2bf(__uint_as_float(kvp[i] << 16) * bg);
            *(bf16_t*)(KbgT + (cq * 32 + 2 * i + 1) * 144 + c * 2) = f2bf(__uint_as_float(kvp[i] & 0xffff0000u) * bg);
        }
    }
    {
        char* L21i = lds + GP_END;
        char* T11T = L21i + 2560;
        char* MT = T11T + 2560;
        if (wid < 2) {
            const int o = 32 * wid;
            float Tc[32];
#pragma unroll
            for (int i = 0; i < 32; ++i) Tc[i] = (i == (lane & 31)) ? 1.f : 0.f;
#pragma unroll
            for (int j = 0; j < 31; ++j) {
                const float tj = Tc[j];
#pragma unroll
                for (int i4 = (j + 1) >> 2; i4 < 8; ++i4) {
                    const f32x4 l4 = *(const f32x4*)&Lf[(o + j) * 68 + o + i4 * 4];
#pragma unroll
                    for (int e = 0; e < 4; ++e) if (i4 * 4 + e > j) Tc[i4 * 4 + e] -= l4[e] * tj;
                }
            }
            if (lane < 32) {
#pragma unroll
                for (int i = 0; i < 32; ++i) *(bf16_t*)(Trow + (o + i) * 144 + (o + lane) * 2) = f2bf(Tc[i]);
                if (wid == 0) {
#pragma unroll
                    for (int i = 0; i < 32; ++i) *(bf16_t*)(Trow + i * 144 + (32 + lane) * 2) = 0;
#pragma unroll
                    for (int i4 = 0; i4 < 8; ++i4) { u32x2 w; w.x = pack2(Tc[i4 * 4], Tc[i4 * 4 + 1]); w.y = pack2(Tc[i4 * 4 + 2], Tc[i4 * 4 + 3]); *(u32x2*)(T11T + lane * 80 + i4 * 8) = w; }
                }
            }
        } else {
            const int t2 = tid - 128;
#pragma unroll
            for (int g2 = 0; g2 < 2; ++g2) {
                const int i = t2 & 31, k4 = ((t2 >> 5) + 4 * g2) * 4;
                u32x2 w;
                w.x = pack2(Lf[(k4 + 0) * 68 + 32 + i], Lf[(k4 + 1) * 68 + 32 + i]); w.y = pack2(Lf[(k4 + 2) * 68 + 32 + i], Lf[(k4 + 3) * 68 + 32 + i]);
                *(u32x2*)(L21i + i * 80 + k4 * 2) = w;
            }
        }
        __syncthreads();
        {
            const int r0 = 16 * (wid >> 1), c0 = 16 * (wid & 1);
            const f32x4 mm = tile16(L21i, 80, r0, T11T, 80, c0, 32);
            u32x2 w; w.x = pack2(mm[0], mm[1]); w.y = pack2(mm[2], mm[3]);
            *(u32x2*)(MT + (c0 + fr) * 80 + (r0 + 4 * fq) * 2) = w;
        }
        __syncthreads();
        {
            const int r0 = 16 * (wid >> 1), c0 = 16 * (wid & 1);
            const f32x4 tt = tile16(MT, 80, c0, Trow + 32 * 144 + 64, 144, r0, 32);
            u32x2 w; w.x = pack2(-tt[0], -tt[1]); w.y = pack2(-tt[2], -tt[3]);
            *(u32x2*)(Trow + (32 + r0 + fr) * 144 + (c0 + 4 * fq) * 2) = w;
        }
    }
    __syncthreads();
#pragma unroll
    for (int tq = 0; tq < 2; ++tq) {
        const int tj = wid * 2 + tq;
#pragma unroll
        for (int ti = 0; ti < 4; ++ti) {
            const f32x4 u = tile16(Trow, 144, 16 * ti, VbT, 144, 16 * tj, 64);
            {
                const int dv = 16 * tj + fr, slice = dv >> 5, rr = dv & 31, cb = 16 * ti + fq * 4, mt = cb >> 5, q4 = (cb & 31) >> 2, hh = q4 & 1, rg = q4 >> 1;
                u32x2 w; w.x = pack2(u[0], u[1]); w.y = pack2(u[2], u[3]);
                *(u32x2*)(ops + GO_UF + ((size_t)((slice * 2 + mt) * 64 + hh * 32 + rr) * 16 + rg * 4) * 2) = w;
            }
            const f32x4 wv = tile16(KbgT, 144, 16 * tj, Trow, 144, 16 * ti, 64);
            {
                const int c1 = 16 * ti + fr, mt = c1 >> 5, rr = c1 & 31, hh = fq & 1, jg = fq >> 1;
                u32x2 w; w.x = pack2(-wv[0], -wv[1]); w.y = pack2(-wv[2], -wv[3]);
                *(u32x2*)(ops + GO_WF + ((size_t)((mt * 8 + tj) * 64 + hh * 32 + rr) * 8 + jg * 4) * 2) = w;
            }
        }
    }
}

DI void glds16(const void* g, char* l) { __builtin_amdgcn_global_load_lds((const unsigned*)g, (lds_u32*)l, 16, 0, 0); }
#define GS_WAIT(n) asm volatile("s_waitcnt vmcnt(" #n ")" ::: "memory")
DI void gdn_scan_block(const P& p, int bh, char* lds, bool dry = false) {
    const int tid = tidx(), lane = tid & 63, w = tid >> 6;
    const int h = bh & 3, b = bh >> 2;
    const float eglv = ((const float*)(p.ws + WS_CTL + CTL_EGL))[(b * 64 + lane) * 4 + h];
    unsigned char* gbase = p.ws + WS_GOPS + (size_t)(b * 256 + h) * GOPS_CH;
    auto issue = [&](int n, int k0, int cntk) {
        for (int k = k0; k < k0 + cntk; ++k) {
            const unsigned char* src = gbase + (size_t)n * 4 * GOPS_CH + k * 8192 + tid * 16;
            char* dst = lds + k * 8192 + tid * 16;
            glds16(src, dst); glds16(src + 4096, dst + 4096);
        }
    };
    f32x16 S[4];
#pragma unroll
    for (int i = 0; i < 4; ++i)
#pragma unroll
        for (int r = 0; r < 16; ++r) S[i][r] = 0.f;
    __syncthreads();
    issue(0, 0, 7);
#pragma unroll 1
    for (int n = 0; n < 64; ++n) {
        const float egl = __shfl(eglv, n);
        bf16x8 Sb[8];
#pragma unroll
        for (int i = 0; i < 4; ++i) { Sb[i * 2] = pack_step(S[i], 0); Sb[i * 2 + 1] = pack_step(S[i], 1); }
        f32x16 av[2], ao[2];
        const bf16x8* fr0 = (const bf16x8*)lds + lane;
        GS_WAIT(6);
        __builtin_amdgcn_s_barrier();
        issue(n, 7, 2);
        __builtin_amdgcn_sched_barrier(0);
        {
            const char* sl = lds + (w >> 1) * 8192;
#pragma unroll
            for (int mt = 0; mt < 2; ++mt) {
                const u32x4* up = (const u32x4*)(sl + ((w & 1) * 2 + mt) * 2048 + lane * 32);
                const u32x4 u0 = up[0], u1 = up[1];
#pragma unroll
                for (int e = 0; e < 4; ++e) {
                    av[mt][e * 2] = __uint_as_float(u0[e] << 16); av[mt][e * 2 + 1] = __uint_as_float(u0[e] & 0xffff0000u);
                    av[mt][8 + e * 2] = __uint_as_float(u1[e] << 16); av[mt][8 + e * 2 + 1] = __uint_as_float(u1[e] & 0xffff0000u);
                }
            }
        }
#pragma unroll
        for (int ks = 0; ks < 8; ++ks)
#pragma unroll
            for (int mt = 0; mt < 2; ++mt) av[mt] = mfma32(fr0[(2 + mt) * 512 + ks * 64], Sb[ks], av[mt]);
        bf16x8 Vb[4];
#pragma unroll
        for (int mt = 0; mt < 2; ++mt) { Vb[mt * 2] = pack_step(av[mt], 0); Vb[mt * 2 + 1] = pack_step(av[mt], 1); }
        GS_WAIT(4);
        __builtin_amdgcn_s_barrier();
        if (n < 63) issue(n + 1, 0, 4);
        __builtin_amdgcn_sched_barrier(0);
#pragma unroll
        for (int mt = 0; mt < 2; ++mt)
#pragma unroll
            for (int r = 0; r < 16; ++r) ao[mt][r] = 0.f;
#pragma unroll
        for (int ks = 0; ks < 8; ++ks) {
#pragma unroll
            for (int mt = 0; mt < 2; ++mt) ao[mt] = mfma32(fr0[(4 + mt) * 512 + ks * 64], Sb[ks], ao[mt]);
#pragma unroll
            for (int r = 0; r < 8; ++r) S[ks >> 1][(ks & 1) * 8 + r] *= egl;
        }
#pragma unroll
        for (int ks = 0; ks < 4; ++ks) { if (ks < 2) ao[0] = mfma32(fr0[6 * 512 + ks * 64], Vb[ks], ao[0]); ao[1] = mfma32(fr0[6 * 512 + (4 + ks) * 64], Vb[ks], ao[1]); }
        if (n < 63) GS_WAIT(8); else GS_WAIT(0);
        __builtin_amdgcn_s_barrier();
        if (n < 63) issue(n + 1, 4, 3);
        __builtin_amdgcn_sched_barrier(0);
#pragma unroll
        for (int ks = 0; ks < 4; ++ks)
#pragma unroll
            for (int i = 0; i < 4; ++i) S[i] = mfma32(fr0[(7 + (i >> 1)) * 512 + ((i & 1) * 4 + ks) * 64], Vb[ks], S[i]);
        {
            u32x4* Of = (u32x4*)((dry ? p.ws + WS_DUMMY + (size_t)(bh & 15) * 65536 : gbase + (size_t)n * 4 * GOPS_CH) + GO_UF) + (size_t)(w * 2 * 64 + lane) * 2;
#pragma unroll
            for (int mt = 0; mt < 2; ++mt) {
                u32x4 o0, o1;
#pragma unroll
                for (int e = 0; e < 4; ++e) { o0[e] = pack2(ao[mt][e * 2], ao[mt][e * 2 + 1]); o1[e] = pack2(ao[mt][8 + e * 2], ao[mt][8 + e * 2 + 1]); }
                Of[mt * 128] = o0; Of[mt * 128 + 1] = o1;
            }
        }
    }
    __syncthreads();
}

DI void gdn_post_unit(const P& p, int li, int ch) {
    const int tid = tidx();
    const int h = ch & 3, n = (ch >> 2) & 63, b = ch >> 8;
    const int t0 = b * SEQ + n * 64;
    const int c = tid >> 2, cq = tid & 3;
    const bf16_t* Of = (const bf16_t*)(p.ws + WS_GOPS + (size_t)ch * GOPS_CH + GO_UF);
    const bf16_t* proj = (const bf16_t*)(p.ws + WS_PROJ);
    bf16_t* mix = (bf16_t*)(p.ws + WS_PROJ);
    const float* nw = p.in[I_GDNNORM] + li * 128 + cq * 32;
    const int mt = c >> 5, q4 = (c & 31) >> 2, hh = q4 & 1, rg = q4 >> 1, reg = rg * 4 + (c & 3);
    float o[32]; float ss = 0.f;
#pragma unroll
    for (int r = 0; r < 32; ++r) { o[r] = bf2f(Of[(size_t)((cq * 2 + mt) * 64 + hh * 32 + r) * 16 + reg]); ss += o[r] * o[r]; }
    ss += __shfl_xor(ss, 1); ss += __shfl_xor(ss, 2);
    const float rs = rsqrtf(ss * (1.f / 128.f) + 1e-6f);
    const bf16_t* zp = proj + (size_t)(t0 + c) * EVLD + 1536 + h * 128 + cq * 32;
    bf16_t* mp = mix + (size_t)(t0 + c) * EVLD + h * 128 + cq * 32;
#pragma unroll
    for (int i4 = 0; i4 < 4; ++i4) {
        const u32x4 zw = *(const u32x4*)(zp + i4 * 8);
        u32x4 w;
#pragma unroll
        for (int e = 0; e < 4; ++e) {
            const float z0 = __uint_as_float(zw[e] << 16), z1 = __uint_as_float(zw[e] & 0xffff0000u);
            w[e] = pack2(o[i4 * 8 + e * 2] * rs * nw[i4 * 8 + e * 2] * siluf_(z0), o[i4 * 8 + e * 2 + 1] * rs * nw[i4 * 8 + e * 2 + 1] * siluf_(z1));
        }
        *(u32x4*)(mp + i4 * 8) = w;
    }
}


constexpr int RP_Z0 = 0, RP_Z1 = 18432, RP_Z2 = 55296, RP_VEC = 73728, RP_PT = 75008, RP_T11 = 78080, RP_END = 80640;
constexpr int RP_LIN = 0, RP_LW = 25600;
DI void rwkv_prep_unit(const P& p, int li, int ch, char* lds) {
    const int tid = tidx(), lane = tid & 63, wid = tid >> 6, fr = lane & 15, fq = lane >> 4;
    const int h = ch & 7, n = (ch >> 3) & 63, b = ch >> 9;
    const int t0 = b * SEQ + n * 64;
    const bf16_t* proj = (const bf16_t*)(p.ws + WS_PROJ);
    char* Lfc = lds + RP_Z0; float* Lf = (float*)Lfc;
    char* ApT = lds + RP_Z0; char* AkVT = lds + RP_Z0 + 9216;
    char* Arow = lds + RP_Z1; char* Rrow = Arow + 9216; char* Brow = Arow + 18432; char* Krow = Arow + 27648;
    char* Aak = Arow; char* Arb = Rrow; char* Ark = Brow; char* Trow = Krow; char* BhT = Krow; char* VpT = Aak;
    char* AT = lds + RP_Z2; char* VT = AT + 9216; char* KhT = AT;
    float* tot = (float*)(lds + RP_VEC); float* WC = tot + 256;
    char* lin = lds + RP_LIN; char* LWi = lds + RP_LW;
    float* PT = (float*)(lds + RP_PT);
    {
        const float* mu0 = p.in[I_MU] + (size_t)li * 1696;
        if (tid < 48) {
            const int j0 = tid * 4;
            *(float4*)(PT + j0) = j0 < 160 ? *(const float4*)(mu0 + (C_HW - RW0) + j0) : *(const float4*)(p.in[I_VRESMU] + j0 - 160);
        } else if (tid < 48 + 144) {
            const int q = tid - 48, arr = q >> 4, c4 = (q & 15) * 4, chn = h * 64 + c4;
            const float* src = arr == 0 ? mu0 + (C_R - RW0) + chn : arr == 1 ? mu0 + (C_K - RW0) + chn : arr == 2 ? mu0 + (C_V - RW0) + chn
                             : arr == 3 ? p.in[I_W0] + li * 512 + chn : arr == 4 ? p.in[I_A0] + li * 512 + chn : arr == 5 ? p.in[I_V0] + chn
                             : arr == 6 ? p.in[I_KK] + li * 512 + chn : arr == 7 ? p.in[I_KA] + li * 512 + chn : p.in[I_RK] + li * 512 + chn;
            *(float4*)(PT + 192 + arr * 64 + c4) = *(const float4*)src;
        }
    }
    __syncthreads();
    {
        const int c = tid >> 2, cq = tid & 3, s = n * 64 + c;
        const bf16_t* cur = proj + (size_t)(t0 + c) * EVLD + C_HW + cq * 48;
        const float* mu = p.in[I_MU] + (size_t)li * 1696 + (C_HW - RW0);
        const float* vmu = p.in[I_VRESMU];
#pragma unroll
        for (int i6 = 0; i6 < 6; ++i6) {
            const u32x4 cw4 = *(const u32x4*)(cur + i6 * 8);
            u32x4 pw4 = *(const u32x4*)(cur - (s > 0 ? EVLD : 0) + i6 * 8);
            if (s == 0) pw4 = (u32x4){0u, 0u, 0u, 0u};
            const int j0 = cq * 48 + i6 * 8;
            const float4 ma = *(const float4*)(PT + j0), mb = *(const float4*)(PT + j0 + 4);
            const float mm[8] = {ma.x, ma.y, ma.z, ma.w, mb.x, mb.y, mb.z, mb.w};
            const bool is_t = j0 < 32, is_s = (j0 >= 64) && (j0 < 160);
            const float ca = is_t ? 1.f : 0.f, cb = is_t ? -2.f : 1.f, cc = is_t ? 2.f : -1.f;
            u32x4 w;
#pragma unroll
            for (int e = 0; e < 4; ++e) {
                float o2[2];
#pragma unroll
                for (int q = 0; q < 2; ++q) {
                    const float cv = q ? __uint_as_float(cw4[e] & 0xffff0000u) : __uint_as_float(cw4[e] << 16);
                    const float pv = q ? __uint_as_float(pw4[e] & 0xffff0000u) : __uint_as_float(pw4[e] << 16);
                    const float val = cv + mm[e * 2 + q] * (pv - cv);
                    const float act = ca + cb * __builtin_amdgcn_rcpf(1.f + __expf(cc * val));
                    o2[q] = (is_t || is_s) ? act : val;
                }
                w[e] = pack2(o2[0], o2[1]);
            }
            *(u32x4*)(lin + c * 400 + (cq * 48 + i6 * 8) * 2) = w;
        }
        const bf16_t* LW = (const bf16_t*)(p.ws + WS_W + W_LW) + (size_t)h * 64 * 192;
#pragma unroll
        for (int i6 = 0; i6 < 6; ++i6) *(u32x4*)(LWi + c * 400 + (cq * 48 + i6 * 8) * 2) = *(const u32x4*)(LW + (size_t)c * 192 + cq * 48 + i6 * 8);
    }
    __syncthreads();
    float lw_[16], la_[16], lg_[16], lv_[16];
#pragma unroll
    for (int tj = 0; tj < 4; ++tj) {
        const f32x4 a = tile16(LWi, 400, 16 * tj, lin, 400, 16 * wid, 32);
        const f32x4 bq = tile16(LWi + 64, 400, 16 * tj, lin + 64, 400, 16 * wid, 32);
        const f32x4 cg = tile16(LWi + 128, 400, 16 * tj, lin + 128, 400, 16 * wid, 96);
        const f32x4 dv = tile16(LWi + 320, 400, 16 * tj, lin + 320, 400, 16 * wid, 32);
#pragma unroll
        for (int r = 0; r < 4; ++r) { lw_[tj * 4 + r] = a[r]; la_[tj * 4 + r] = bq[r]; lg_[tj * 4 + r] = cg[r]; lv_[tj * 4 + r] = dv[r]; }
    }
    __syncthreads();
    const int c = 16 * wid + fr;
    float at[16], rt[16], bt[16], kt[16], bh[16], kh[16];
    {
        const int s = n * 64 + c;
        const size_t row = (size_t)(t0 + c);
        const float* mu = p.in[I_MU] + (size_t)li * 1696;
        const int hc = h * 64;
        float rr_[16], kk_[16], lwv[16], aa[16];
        float kn = 0.f, rk = 0.f;
        bf16_t* vf = (bf16_t*)(p.ws + WS_VF);
        bf16_t* gg = (bf16_t*)(p.ws + WS_GG);
#pragma unroll
        for (int tj = 0; tj < 4; ++tj) {
            const int cb = 16 * tj + 4 * fq;
            u32x2 cr = *(const u32x2*)(proj + row * EVLD + C_R + hc + cb), ck = *(const u32x2*)(proj + row * EVLD + C_K + hc + cb), cv = *(const u32x2*)(proj + row * EVLD + C_V + hc + cb);
            const size_t prow = s > 0 ? row - 1 : row;
            u32x2 pr = *(const u32x2*)(proj + prow * EVLD + C_R + hc + cb), pk = *(const u32x2*)(proj + prow * EVLD + C_K + hc + cb), pv = *(const u32x2*)(proj + prow * EVLD + C_V + hc + cb);
            if (s == 0) { pr = (u32x2){0u, 0u}; pk = pr; pv = pr; }
            u32x2 vfw = {0u, 0u};
            if (li == 1) vfw = *(const u32x2*)(vf + row * 512 + hc + cb);
            float vout[4], gout[4];
            const int ch0 = hc + cb;
            const float* pt = PT + 192 + cb;
            const float4 mu_r4 = *(const float4*)(pt), mu_k4 = *(const float4*)(pt + 64), mu_v4 = *(const float4*)(pt + 128);
            const float4 w0_4 = *(const float4*)(pt + 192), a0_4 = *(const float4*)(pt + 256), v0_4 = *(const float4*)(pt + 320);
            const float4 kk_4 = *(const float4*)(pt + 384), ka_4 = *(const float4*)(pt + 448), rk_4 = *(const float4*)(pt + 512);
            const float mur[4] = {mu_r4.x, mu_r4.y, mu_r4.z, mu_r4.w}, muk[4] = {mu_k4.x, mu_k4.y, mu_k4.z, mu_k4.w}, muv[4] = {mu_v4.x, mu_v4.y, mu_v4.z, mu_v4.w};
            const float w0v[4] = {w0_4.x, w0_4.y, w0_4.z, w0_4.w}, a0v[4] = {a0_4.x, a0_4.y, a0_4.z, a0_4.w}, v0v[4] = {v0_4.x, v0_4.y, v0_4.z, v0_4.w};
            const float kkp[4] = {kk_4.x, kk_4.y, kk_4.z, kk_4.w}, kap[4] = {ka_4.x, ka_4.y, ka_4.z, ka_4.w}, rkp[4] = {rk_4.x, rk_4.y, rk_4.z, rk_4.w};
#pragma unroll
            for (int r = 0; r < 4; ++r) {
                const int i = tj * 4 + r;
                const unsigned wcr = r < 2 ? cr.x : cr.y, wck = r < 2 ? ck.x : ck.y, wcv = r < 2 ? cv.x : cv.y;
                const unsigned wpr = r < 2 ? pr.x : pr.y, wpk = r < 2 ? pk.x : pk.y, wpv = r < 2 ? pv.x : pv.y, wvf = r < 2 ? vfw.x : vfw.y;
                const float c_r = (r & 1) ? __uint_as_float(wcr & 0xffff0000u) : __uint_as_float(wcr << 16);
                const float c_k = (r & 1) ? __uint_as_float(wck & 0xffff0000u) : __uint_as_float(wck << 16);
                const float c_v = (r & 1) ? __uint_as_float(wcv & 0xffff0000u) : __uint_as_float(wcv << 16);
                const float p_r = (r & 1) ? __uint_as_float(wpr & 0xffff0000u) : __uint_as_float(wpr << 16);
                const float p_k = (r & 1) ? __uint_as_float(wpk & 0xffff0000u) : __uint_as_float(wpk << 16);
                const float p_v = (r & 1) ? __uint_as_float(wpv & 0xffff0000u) : __uint_as_float(wpv << 16);
                const float rm = c_r + mur[r] * (p_r - c_r);
                const float km = c_k + muk[r] * (p_k - c_k);
                float vm = c_v + muv[r] * (p_v - c_v);
                const float wlog = -softplusf_(-(w0v[r] + lw_[i])) - 0.5f;
                lwv[i] = -__expf(wlog);
                const float a = sigmoidf_(a0v[r] + la_[i]);
                if (li == 1) {
                    const float v1 = (r & 1) ? __uint_as_float(wvf & 0xffff0000u) : __uint_as_float(wvf << 16);
                    vm = vm + (v1 - vm) * sigmoidf_(v0v[r] + lv_[i]);
                }
                const float kkv = km * kkp[r];
                kn += kkv * kkv;
                rr_[i] = rm; kk_[i] = kkv; aa[i] = a;
                kt[i] = km * (1.f + (a - 1.f) * kap[r]);
                rk += rm * kt[i] * rkp[r];
                vout[r] = vm; gout[r] = lg_[i];
            }
            u32x2 w; w.x = pack2(vout[0], vout[1]); w.y = pack2(vout[2], vout[3]);
            *(u32x2*)(vf + row * 512 + hc + cb) = w;
            w.x = pack2(gout[0], gout[1]); w.y = pack2(gout[2], gout[3]);
            *(u32x2*)(gg + row * 512 + hc + cb) = w;
#pragma unroll
            for (int r = 0; r < 4; ++r) *(bf16_t*)(VT + (cb + r) * 144 + c * 2) = f2bf(vout[r]);
            __builtin_amdgcn_sched_barrier(0);
        }
        kn += __shfl_xor(kn, 16); kn += __shfl_xor(kn, 32);
        const float kr = rsqrtf(kn + 1e-6f);
        rk += __shfl_xor(rk, 16); rk += __shfl_xor(rk, 32);
        if (fq == 0) ((float*)(p.ws + WS_RK))[row * 8 + h] = rk;
        float cs[16];
#pragma unroll
        for (int i = 0; i < 16; ++i) {
            float x = lwv[i];
#pragma unroll
            for (int o = 1; o < 16; o <<= 1) { const float y = __shfl_up(x, o, 16); if (fr >= o) x += y; }
            cs[i] = x;
        }
        if (fr == 15) {
#pragma unroll
            for (int i = 0; i < 16; ++i) tot[wid * 64 + 16 * (i >> 2) + 4 * fq + (i & 3)] = cs[i];
        }
        __syncthreads();
#pragma unroll
        for (int i = 0; i < 16; ++i) {
            const int chl = 16 * (i >> 2) + 4 * fq + (i & 3);
            float pre = 0.f, all = 0.f;
#pragma unroll
            for (int w2 = 0; w2 < 4; ++w2) { const float tv = tot[w2 * 64 + chl]; all += tv; if (w2 < wid) pre += tv; }
            const float csi = cs[i] + pre, csm = csi - lwv[i];
            const float kkn = kk_[i] * kr, k2 = kt[i];
            const float e_c = __expf(csi), e_n = __builtin_amdgcn_rcpf(e_c), e_m = __expf(csm), e_h = __expf(all) * e_n;
            at[i] = -kkn * e_m; rt[i] = rr_[i] * e_c;
            const float bp = kkn * aa[i];
            bt[i] = bp * e_n; kt[i] = k2 * e_n; bh[i] = bp * e_h; kh[i] = k2 * e_h;
            if (c == 0) WC[chl] = __expf(all);
            if ((i & 3) == 3) __builtin_amdgcn_sched_barrier(0);
        }
    }
#pragma unroll
    for (int tj = 0; tj < 4; ++tj) {
        const int cb = 16 * tj + 4 * fq;
        u32x2 w;
        w.x = pack2(at[tj * 4], at[tj * 4 + 1]); w.y = pack2(at[tj * 4 + 2], at[tj * 4 + 3]); *(u32x2*)(Arow + c * 144 + cb * 2) = w;
        w.x = pack2(rt[tj * 4], rt[tj * 4 + 1]); w.y = pack2(rt[tj * 4 + 2], rt[tj * 4 + 3]); *(u32x2*)(Rrow + c * 144 + cb * 2) = w;
        w.x = pack2(bt[tj * 4], bt[tj * 4 + 1]); w.y = pack2(bt[tj * 4 + 2], bt[tj * 4 + 3]); *(u32x2*)(Brow + c * 144 + cb * 2) = w;
        w.x = pack2(kt[tj * 4], kt[tj * 4 + 1]); w.y = pack2(kt[tj * 4 + 2], kt[tj * 4 + 3]); *(u32x2*)(Krow + c * 144 + cb * 2) = w;
#pragma unroll
        for (int r = 0; r < 4; ++r) {
            *(bf16_t*)(AT + (cb + r) * 144 + c * 2) = f2bf(at[tj * 4 + r]);
        }
    }
    __syncthreads();
    f32x4 pab[4], pak[4], prb[4], prk[4];
    {
        const int ti = wid;
#pragma unroll
        for (int tj = 0; tj < 4; ++tj) {
            pab[tj] = (f32x4){0.f, 0.f, 0.f, 0.f}; pak[tj] = pab[tj]; prb[tj] = pab[tj]; prk[tj] = pab[tj];
            if (tj <= ti) {
                pab[tj] = tile16(Arow, 144, 16 * ti, Brow, 144, 16 * tj, 64);
                pak[tj] = tile16(Krow, 144, 16 * tj, Arow, 144, 16 * ti, 64);
                prb[tj] = tile16(Brow, 144, 16 * tj, Rrow, 144, 16 * ti, 64);
                prk[tj] = tile16(Krow, 144, 16 * tj, Rrow, 144, 16 * ti, 64);
            }
        }
    }
    __syncthreads();
    {
        const int ti = wid;
#pragma unroll
        for (int tj = 0; tj < 4; ++tj) {
            const int s1 = 16 * tj + fr;
            f32x4 lv;
#pragma unroll
            for (int r = 0; r < 4; ++r) { const int t1 = 16 * ti + 4 * fq + r; lv[r] = (s1 < t1) ? -pab[tj][r] : 0.f; }
            *(f32x4*)&Lf[s1 * 72 + 16 * ti + 4 * fq] = lv;
            const int t2 = 16 * ti + fr;
            float m1[4], m2[4], m3[4];
#pragma unroll
            for (int r = 0; r < 4; ++r) { const int s2 = 16 * tj + 4 * fq + r; m1[r] = (s2 < t2) ? pak[tj][r] : 0.f; m2[r] = (s2 <= t2) ? prb[tj][r] : 0.f; m3[r] = (s2 <= t2) ? prk[tj][r] : 0.f; }
            u32x2 w;
            w.x = pack2(m1[0], m1[1]); w.y = pack2(m1[2], m1[3]); *(u32x2*)(Aak + t2 * 144 + (16 * tj + 4 * fq) * 2) = w;
            w.x = pack2(m2[0], m2[1]); w.y = pack2(m2[2], m2[3]); *(u32x2*)(Arb + t2 * 144 + (16 * tj + 4 * fq) * 2) = w;
            w.x = pack2(m3[0], m3[1]); w.y = pack2(m3[2], m3[3]); *(u32x2*)(Ark + t2 * 144 + (16 * tj + 4 * fq) * 2) = w;
        }
    }
    __syncthreads();
    {
        char* L21i = lds + RP_PT;
        char* T11T = lds + RP_T11;
        char* MT = lds + RP_Z0;
        if (wid < 2) {
            const int o = 32 * wid;
            float Tc[32];
#pragma unroll
            for (int i = 0; i < 32; ++i) Tc[i] = (i == (lane & 31)) ? 1.f : 0.f;
#pragma unroll
            for (int j = 0; j < 31; ++j) {
                const float tj = Tc[j];
#pragma unroll
                for (int i4 = (j + 1) >> 2; i4 < 8; ++i4) {
                    const f32x4 l4 = *(const f32x4*)&Lf[(o + j) * 72 + o + i4 * 4];
#pragma unroll
                    for (int e = 0; e < 4; ++e) if (i4 * 4 + e > j) Tc[i4 * 4 + e] -= l4[e] * tj;
                }
            }
            if (lane < 32) {
#pragma unroll
                for (int i = 0; i < 32; ++i) *(bf16_t*)(Trow + (o + i) * 144 + (o + lane) * 2) = f2bf(Tc[i]);
                if (wid == 0) {
#pragma unroll
                    for (int i = 0; i < 32; ++i) *(bf16_t*)(Trow + i * 144 + (32 + lane) * 2) = 0;
#pragma unroll
                    for (int i4 = 0; i4 < 8; ++i4) { u32x2 w; w.x = pack2(Tc[i4 * 4], Tc[i4 * 4 + 1]); w.y = pack2(Tc[i4 * 4 + 2], Tc[i4 * 4 + 3]); *(u32x2*)(T11T + lane * 80 + i4 * 8) = w; }
                }
            }
        } else {
            const int t2 = tid - 128;
#pragma unroll
            for (int g2 = 0; g2 < 2; ++g2) {
                const int i = t2 & 31, k4 = ((t2 >> 5) + 4 * g2) * 4;
                u32x2 w;
                w.x = pack2(Lf[(k4 + 0) * 72 + 32 + i], Lf[(k4 + 1) * 72 + 32 + i]); w.y = pack2(Lf[(k4 + 2) * 72 + 32 + i], Lf[(k4 + 3) * 72 + 32 + i]);
                *(u32x2*)(L21i + i * 80 + k4 * 2) = w;
            }
        }
        __syncthreads();
        {
            const int r0 = 16 * (wid >> 1), c0 = 16 * (wid & 1);
            const f32x4 mm = tile16(L21i, 80, r0, T11T, 80, c0, 32);
            u32x2 w; w.x = pack2(mm[0], mm[1]); w.y = pack2(mm[2], mm[3]);
            *(u32x2*)(MT + (c0 + fr) * 80 + (r0 + 4 * fq) * 2) = w;
        }
        __syncthreads();
        {
            const int r0 = 16 * (wid >> 1), c0 = 16 * (wid & 1);
            const f32x4 tt = tile16(MT, 80, c0, Trow + 32 * 144 + 64, 144, r0, 32);
            u32x2 w; w.x = pack2(-tt[0], -tt[1]); w.y = pack2(-tt[2], -tt[3]);
            *(u32x2*)(Trow + (32 + r0 + fr) * 144 + (c0 + 4 * fq) * 2) = w;
        }
    }
    __syncthreads();
    {
        const int ti = wid;
#pragma unroll
        for (int tj = 0; tj < 4; ++tj) {
            const f32x4 x = tile16(Trow, 144, 16 * ti, AT, 144, 16 * tj, 64);
            const f32x4 y = tile16(Aak, 144, 16 * ti, VT, 144, 16 * tj, 64);
            u32x2 w;
            w.x = pack2(x[0], x[1]); w.y = pack2(x[2], x[3]); *(u32x2*)(ApT + (16 * tj + fr) * 144 + (16 * ti + 4 * fq) * 2) = w;
            w.x = pack2(y[0], y[1]); w.y = pack2(y[2], y[3]); *(u32x2*)(AkVT + (16 * tj + fr) * 144 + (16 * ti + 4 * fq) * 2) = w;
        }
    }
    __syncthreads();
    {
        const int ti = wid;
#pragma unroll
        for (int tj = 0; tj < 4; ++tj) {
            const f32x4 x = tile16(Trow, 144, 16 * ti, AkVT, 144, 16 * tj, 64);
            u32x2 w; w.x = pack2(x[0], x[1]); w.y = pack2(x[2], x[3]); *(u32x2*)(VpT + (16 * tj + fr) * 144 + (16 * ti + 4 * fq) * 2) = w;
        }
    }
    __syncthreads();
#pragma unroll
    for (int tj = 0; tj < 4; ++tj)
#pragma unroll
        for (int r = 0; r < 4; ++r) {
            const int cb = 16 * tj + 4 * fq + r;
            *(bf16_t*)(BhT + cb * 144 + c * 2) = f2bf(bh[tj * 4 + r]);
            *(bf16_t*)(KhT + cb * 144 + c * 2) = f2bf(kh[tj * 4 + r]);
        }
    __syncthreads();
    {
        unsigned char* opsA = p.ws + WS_HN + (size_t)ch * 16384;
        unsigned char* opsB = p.ws + WS_ROPS + (size_t)ch * 16384;
        const int ti = wid;
#pragma unroll
        for (int tj = 0; tj < 4; ++tj) {
            const f32x4 x = tile16(ApT, 144, 16 * tj, Arb, 144, 16 * ti, 64);
            const f32x4 g = tile16(ApT, 144, 16 * tj, BhT, 144, 16 * ti, 64);
            const int m1 = 16 * ti + fr, mt = m1 >> 5, rr = m1 & 31, hh = fq & 1, jg = fq >> 1;
            const size_t off = ((size_t)((mt * 4 + tj) * 64 + hh * 32 + rr) * 8 + jg * 4) * 2;
            float gd[4];
#pragma unroll
            for (int r = 0; r < 4; ++r) gd[r] = g[r] + ((16 * tj + 4 * fq + r == m1) ? WC[m1] : 0.f);
            u32x2 w;
            w.x = pack2(x[0] + rt[tj * 4], x[1] + rt[tj * 4 + 1]); w.y = pack2(x[2] + rt[tj * 4 + 2], x[3] + rt[tj * 4 + 3]); *(u32x2*)(opsA + off) = w;
            w.x = pack2(gd[0], gd[1]); w.y = pack2(gd[2], gd[3]); *(u32x2*)(opsA + 8192 + off) = w;
            f32x4 y = tile16(Ark, 144, 16 * ti, VT, 144, 16 * tj, 64);
            const f32x4 y2 = tile16(Arb, 144, 16 * ti, VpT, 144, 16 * tj, 64);
            f32x4 kv = tile16(KhT, 144, 16 * ti, VT, 144, 16 * tj, 64);
            const f32x4 kv2 = tile16(BhT, 144, 16 * ti, VpT, 144, 16 * tj, 64);
            const int vcol = 16 * tj + fr, slice = vcol >> 5, r2 = vcol & 31, cb = 16 * ti + 4 * fq, mt2 = cb >> 5, q4 = (cb & 31) >> 2, h2 = q4 & 1, rg = q4 >> 1;
            const size_t off2 = ((size_t)((slice * 2 + mt2) * 64 + h2 * 32 + r2) * 16 + rg * 4) * 2;
            w.x = pack2(y[0] + y2[0], y[1] + y2[1]); w.y = pack2(y[2] + y2[2], y[3] + y2[3]); *(u32x2*)(opsB + off2) = w;
            w.x = pack2(kv[0] + kv2[0], kv[1] + kv2[1]); w.y = pack2(kv[2] + kv2[2], kv[3] + kv2[3]); *(u32x2*)(opsB + 8192 + off2) = w;
        }
    }
}

DI void rwkv_scan_block(const P& p, int bh, char* lds, bool dry = false) {
    const int tid = tidx(), lane = tid & 63, w = tid >> 6, slice = w & 1;
    const int h = bh & 7, b = bh >> 3;
    constexpr int NST = 64 * 2, AH = 3;
    auto issue = [&](int j) {
        const int n = j >> 1, k = j & 1;
        const size_t ch = (size_t)((b * 64 + n) * 8 + h) * 16384;
        const unsigned char* s0 = (k == 0 ? p.ws + WS_ROPS + ch + 8192 : p.ws + WS_ROPS + ch) + tid * 16;
        const unsigned char* s1 = (k == 0 ? p.ws + WS_HN + ch + 8192 : p.ws + WS_HN + ch) + tid * 16;
        char* dst = lds + (j & 3) * 16384 + tid * 16;
        glds16(s0, dst); glds16(s0 + 4096, dst + 4096); glds16(s1, dst + 8192); glds16(s1 + 4096, dst + 12288);
    };
    f32x16 H[2];
#pragma unroll
    for (int i = 0; i < 2; ++i)
#pragma unroll
        for (int r = 0; r < 16; ++r) H[i][r] = 0.f;
    __syncthreads();
#pragma unroll
    for (int j = 0; j < AH; ++j) issue(j);
#pragma unroll 1
    for (int n = 0; n < 64; ++n) {
        bf16x8 Hb[4];
#pragma unroll
        for (int i = 0; i < 2; ++i) { Hb[i * 2] = pack_step(H[i], 0); Hb[i * 2 + 1] = pack_step(H[i], 1); }
#pragma unroll
        for (int k = 0; k < 2; ++k) {
            const int j = n * 2 + k;
            if (n < 63) GS_WAIT(8); else if (k == 0) GS_WAIT(4); else GS_WAIT(0);
            __builtin_amdgcn_s_barrier();
            if (j + AH < NST) issue(j + AH);
            __builtin_amdgcn_sched_barrier(0);
            const char* sl = lds + (j & 3) * 16384;
            if (w < 2) {
                f32x16 acc[2];
#pragma unroll
                for (int mt = 0; mt < 2; ++mt) {
                    const u32x4* up = (const u32x4*)(sl + (slice * 2 + mt) * 2048 + lane * 32);
                    const u32x4 u0 = up[0], u1 = up[1];
#pragma unroll
                    for (int e = 0; e < 4; ++e) {
                        acc[mt][e * 2] = __uint_as_float(u0[e] << 16); acc[mt][e * 2 + 1] = __uint_as_float(u0[e] & 0xffff0000u);
                        acc[mt][8 + e * 2] = __uint_as_float(u1[e] << 16); acc[mt][8 + e * 2 + 1] = __uint_as_float(u1[e] & 0xffff0000u);
                    }
                }
                const bf16x8* fr = (const bf16x8*)(sl + 8192) + lane;
                bf16x8 f8[8];
#pragma unroll
                for (int q = 0; q < 8; ++q) f8[q] = fr[q * 64];
#pragma unroll
                for (int ks = 0; ks < 4; ++ks)
#pragma unroll
                    for (int mt = 0; mt < 2; ++mt) acc[mt] = mfma32(f8[mt * 4 + ks], Hb[ks], acc[mt]);
                if (k == 0) { H[0] = acc[0]; H[1] = acc[1]; }
                else {
                    const size_t ch = (size_t)((b * 64 + n) * 8 + h) * 16384;
                    u32x4* Yf = (u32x4*)(dry ? p.ws + WS_DUMMY + 2097152 + (size_t)(bh & 31) * 16384 : p.ws + WS_ROPS + ch) + (size_t)(slice * 128 + lane) * 2;
#pragma unroll
                    for (int mt = 0; mt < 2; ++mt) {
                        u32x4 o0, o1;
#pragma unroll
                        for (int e = 0; e < 4; ++e) { o0[e] = pack2(acc[mt][e * 2], acc[mt][e * 2 + 1]); o1[e] = pack2(acc[mt][8 + e * 2], acc[mt][8 + e * 2 + 1]); }
                        Yf[mt * 128] = o0; Yf[mt * 128 + 1] = o1;
                    }
                }
            }
        }
    }
    __syncthreads();
}

DI void rwkv_post_unit(const P& p, int li, int ch) {
    const int tid = tidx();
    const int h = ch & 7, n = (ch >> 3) & 63, b = ch >> 9;
    const int t0 = b * SEQ + n * 64;
    const int c = tid >> 2, cq = tid & 3;
    const bf16_t* Yf = (const bf16_t*)(p.ws + WS_ROPS + (size_t)ch * 16384);
    const bf16_t* vf = (const bf16_t*)(p.ws + WS_VF) + (size_t)(t0 + c) * 512 + h * 64 + cq * 16;
    const bf16_t* gg = (const bf16_t*)(p.ws + WS_GG) + (size_t)(t0 + c) * 512 + h * 64 + cq * 16;
    const float rk = ((const float*)(p.ws + WS_RK))[(size_t)(t0 + c) * 8 + h];
    const float* lnw = p.in[I_LNW] + li * 512 + h * 64 + cq * 16;
    const float* lnb = p.in[I_LNB] + li * 512 + h * 64 + cq * 16;
    bf16_t* mp = (bf16_t*)(p.ws + WS_HN) + (size_t)(t0 + c) * 1024 + 512 + h * 64 + cq * 16;
    const int mt = c >> 5, q4 = (c & 31) >> 2, hh = q4 & 1, rg = q4 >> 1, reg = rg * 4 + (c & 3), slice = cq >> 1, rb = (cq & 1) * 16;
    float y[16]; float sm = 0.f;
#pragma unroll
    for (int i = 0; i < 16; ++i) { y[i] = bf2f(Yf[(size_t)((slice * 2 + mt) * 64 + hh * 32 + rb + i) * 16 + reg]); sm += y[i]; }
    sm += __shfl_xor(sm, 1); sm += __shfl_xor(sm, 2);
    const float mean = sm * (1.f / 64.f);
    float vs = 0.f;
#pragma unroll
    for (int i = 0; i < 16; ++i) { y[i] -= mean; vs += y[i] * y[i]; }
    vs += __shfl_xor(vs, 1); vs += __shfl_xor(vs, 2);
    const float rs = rsqrtf(vs * (1.f / 64.f) + 64e-5f);
#pragma unroll
    for (int i8 = 0; i8 < 2; ++i8) {
        const u32x4 vw = *(const u32x4*)(vf + i8 * 8), gw = *(const u32x4*)(gg + i8 * 8);
        u32x4 w;
#pragma unroll
        for (int e = 0; e < 4; ++e) {
            const int i = i8 * 8 + e * 2;
            const float v0 = __uint_as_float(vw[e] << 16), v1 = __uint_as_float(vw[e] & 0xffff0000u), g0 = __uint_as_float(gw[e] << 16), g1 = __uint_as_float(gw[e] & 0xffff0000u);
            w[e] = pack2((y[i] * rs * lnw[i] + lnb[i] + rk * v0) * g0, (y[i + 1] * rs * lnw[i + 1] + lnb[i + 1] + rk * v1) * g1);
        }
        *(u32x4*)(mp + i8 * 8) = w;
    }
}


DI void attn_unit(const P& p, int unit, char* lds) {
    const int tid = tidx(), lane = tid & 63, w = tid >> 6, r_ = lane & 31, hl = lane >> 5;
    const int idx = unit & 31, h = (unit >> 5) & 7, g = (unit >> 8) % 3, b = unit / 768;
    const int lg2 = g * 2, dil = 1 << lg2, L = SEQ >> lg2, ntl = L >> 7;
    const int rs = idx / ntl, qt = idx % ntl;
    const int hg = g * 8 + h;
    const bf16_t* QK = (const bf16_t*)(p.ws + WS_QK);
    const bf16_t* VT = (const bf16_t*)(p.ws + WS_VT) + ((size_t)((b * 24 + hg) * dil + rs) * 64) * L;
    const int qi = 32 * w + r_;
    const int q_idx = 128 * qt + qi;
    const size_t qrow = (size_t)(b * SEQ + q_idx * dil + rs);
    const int kbase0 = 128 * qt - 128;
    char* Kt = lds;
    char* Vt = lds + 32768;
    __syncthreads();
#pragma unroll
    for (int i = 0; i < 8; ++i) {
        const int id = tid + i * 256, row = id >> 3, pc = id & 7, c = pc ^ ((row >> 1) & 7);
        int k_idx = kbase0 + row; if (k_idx < 0) k_idx = 0;
        glds16(QK + (size_t)(b * SEQ + k_idx * dil + rs) * 3072 + 1536 + hg * 64 + c * 8, Kt + id * 16);
    }
#pragma unroll
    for (int i = 0; i < 8; ++i) {
        const int id = tid + i * 256, row = id >> 5, pq = id & 31, q = pq ^ (row & 31);
        int k0 = kbase0 + q * 8; if (k0 < 0) k0 = 0;
        glds16(VT + (size_t)row * L + k0, Vt + id * 16);
    }
    bf16x8 qf[4];
#pragma unroll
    for (int ks = 0; ks < 4; ++ks) qf[ks] = *(const bf16x8*)(QK + qrow * 3072 + hg * 64 + 16 * ks + 8 * hl);
    asm volatile("s_waitcnt vmcnt(0)" ::: "memory");
    __syncthreads();
    f32x16 st[5];
    float mx = -1.0e30f;
#pragma unroll
    for (int kbi = 0; kbi < 5; ++kbi) {
        const int krow = 32 * (w + kbi) + r_;
#pragma unroll
        for (int r = 0; r < 16; ++r) st[kbi][r] = 0.f;
#pragma unroll
        for (int ks = 0; ks < 4; ++ks) {
            const bf16x8 kf = *(const bf16x8*)(Kt + krow * 128 + (((2 * ks + hl) ^ ((krow >> 1) & 7)) * 16));
            st[kbi] = mfma32(kf, qf[ks], st[kbi]);
        }
#pragma unroll
        for (int r = 0; r < 16; ++r) {
            const int kj = 32 * (w + kbi) + (r & 3) + 8 * (r >> 2) + 4 * hl;
            const bool valid = (kj >= qi) && (kj <= qi + 128) && (kbase0 + kj >= 0);
            const float sv = valid ? st[kbi][r] * 0.125f : -1.0e30f;
            st[kbi][r] = sv; mx = fmaxf(mx, sv);
        }
    }
    mx = fmaxf(mx, __shfl_xor(mx, 32));
    float l = 0.f;
#pragma unroll
    for (int kbi = 0; kbi < 5; ++kbi)
#pragma unroll
        for (int r = 0; r < 16; ++r) { const float pv = __expf(st[kbi][r] - mx); st[kbi][r] = pv; l += pv; }
    l += __shfl_xor(l, 32);
    f32x16 ot[2];
#pragma unroll
    for (int dt = 0; dt < 2; ++dt)
#pragma unroll
        for (int r = 0; r < 16; ++r) ot[dt][r] = 0.f;
#pragma unroll
    for (int kbi = 0; kbi < 5; ++kbi)
#pragma unroll
        for (int s2 = 0; s2 < 2; ++s2) {
            const bf16x8 pb = pack_step(st[kbi], s2);
            const int q0 = 4 * (w + kbi) + 2 * s2;
#pragma unroll
            for (int dt = 0; dt < 2; ++dt) {
                const int drow = 32 * dt + r_;
                const u32x2 lo = *(const u32x2*)(Vt + drow * 512 + ((q0 ^ (drow & 31)) * 16) + 8 * hl);
                const u32x2 hi = *(const u32x2*)(Vt + drow * 512 + (((q0 + 1) ^ (drow & 31)) * 16) + 8 * hl);
                u32x4 vw; vw.x = lo.x; vw.y = lo.y; vw.z = hi.x; vw.w = hi.y;
                ot[dt] = mfma32(__builtin_bit_cast(bf16x8, vw), pb, ot[dt]);
            }
        }
    const float inv = 1.f / l;
    bf16_t* og = (bf16_t*)(p.ws + WS_OG) + ((size_t)g * T + qrow) * 512 + h * 64;
#pragma unroll
    for (int dt = 0; dt < 2; ++dt)
#pragma unroll
        for (int rg = 0; rg < 4; ++rg) {
            u32x2 wv; wv.x = pack2(ot[dt][rg * 4] * inv, ot[dt][rg * 4 + 1] * inv); wv.y = pack2(ot[dt][rg * 4 + 2] * inv, ot[dt][rg * 4 + 3] * inv);
            *(u32x2*)(og + 32 * dt + 8 * rg + 4 * hl) = wv;
        }
    if (hl == 0) ((float*)(p.ws + WS_LSE))[((size_t)g * T + qrow) * 8 + h] = mx + __logf(l);
}
DI void phase_attn_merge(const P& p) {
    const bf16_t* og = (const bf16_t*)(p.ws + WS_OG);
    const float* lse = (const float*)(p.ws + WS_LSE);
    bf16_t* o = (bf16_t*)(p.ws + WS_HN);
    for (int i = bidx() * 256 + tidx(); i < T * 64; i += gridDim.x * 256) {
        const int t = i >> 6, c8 = i & 63, h = c8 >> 3;
        const float l0 = lse[(size_t)t * 8 + h], l1 = lse[((size_t)T + t) * 8 + h], l2 = lse[((size_t)2 * T + t) * 8 + h];
        const float m = fmaxf(l0, fmaxf(l1, l2));
        float w0 = __expf(l0 - m), w1 = __expf(l1 - m), w2 = __expf(l2 - m);
        const float inv = 1.f / (w0 + w1 + w2); w0 *= inv; w1 *= inv; w2 *= inv;
        const u32x4 a = *(const u32x4*)(og + (size_t)t * 512 + c8 * 8), bq = *(const u32x4*)(og + ((size_t)T + t) * 512 + c8 * 8), cq = *(const u32x4*)(og + ((size_t)2 * T + t) * 512 + c8 * 8);
        u32x4 r;
#pragma unroll
        for (int e = 0; e < 4; ++e) {
            const float x0 = w0 * __uint_as_float(a[e] << 16) + w1 * __uint_as_float(bq[e] << 16) + w2 * __uint_as_float(cq[e] << 16);
            const float x1 = w0 * __uint_as_float(a[e] & 0xffff0000u) + w1 * __uint_as_float(bq[e] & 0xffff0000u) + w2 * __uint_as_float(cq[e] & 0xffff0000u);
            r[e] = pack2(x0, x1);
        }
        *(u32x4*)(o + (size_t)t * 512 + c8 * 8) = r;
    }
}


#define XB_TMO      128
#define XB_XCNT(j)  (256  + 64 * (j))
#define XB_XSUB(j)  (1280 + 64 * (j))
#define XB_XGEN(j)  (2304 + 64 * (j))
#define XB_TOP      3328
#define XB_TOPGEN   3392
#define XCD_BAR_WORDS 3456
#define XB_SPIN_CAP (1u << 22)
#define LAS __attribute__((address_space(3)))
DI unsigned xb_ld(unsigned* p)              { return __hip_atomic_load(p, __ATOMIC_RELAXED, __HIP_MEMORY_SCOPE_AGENT); }
DI unsigned xb_add(unsigned* p, unsigned v) { return __hip_atomic_fetch_add(p, v, __ATOMIC_RELAXED, __HIP_MEMORY_SCOPE_AGENT); }
DI unsigned xb_xcc_id() { return (unsigned)__builtin_amdgcn_s_getreg((3 << 11) | 20) & 0xFu; }
#define XB_SPIN(cond, bar) do { unsigned _sp = 0; while (cond) { if (_sp < 32u) __builtin_amdgcn_s_sleep(2); else __builtin_amdgcn_s_sleep(24); \
    if ((++_sp & 255u) == 0u) { if (xb_ld(&(bar)[XB_TMO])) break; if (_sp > XB_SPIN_CAP) { atomicAdd(&(bar)[XB_TMO], 1u); break; } } } } while (0)
struct XcdBarrier { unsigned* bar; unsigned x; volatile LAS unsigned* st; };
DI XcdBarrier xcd_barrier_post(unsigned* bar, volatile LAS unsigned* st) {
    XcdBarrier b; b.bar = bar; b.x = xb_xcc_id(); b.st = st;
    if (threadIdx.x == 0) (void)xb_add(&bar[XB_XCNT(b.x)], 1u);
    return b;
}
DI void xcd_barrier_complete(unsigned* bar, unsigned x, unsigned& nloc, unsigned& nx) {
    const unsigned G = gridDim.x * gridDim.y * gridDim.z;
    unsigned sum, cnt, mine, sp = 0u;
    for (;;) {
        sum = 0u; cnt = 0u; mine = 0u;
#pragma unroll
        for (unsigned j = 0; j < 16; ++j) { const unsigned c = xb_ld(&bar[XB_XCNT(j)]); sum += c; cnt += (c > 0u) ? 1u : 0u; mine = (j == x) ? c : mine; }
        if (sum == G) break;
        __builtin_amdgcn_s_sleep(1);
        if ((++sp & 255u) == 0u) { if (xb_ld(&bar[XB_TMO])) break; if (sp > XB_SPIN_CAP) { atomicAdd(&bar[XB_TMO], 1u); break; } }
    }
    nloc = mine > 0u ? mine : 1u; nx = cnt > 0u ? cnt : 1u;
}
DI void xcd_barrier(const XcdBarrier& b) {
    asm volatile("s_waitcnt vmcnt(0)" ::: "memory");
    __syncthreads();
    if (threadIdx.x == 0) {
        unsigned* bar = b.bar;
        __builtin_amdgcn_s_waitcnt(0);
        unsigned nloc = b.st[0], nx = b.st[1];
        if (nloc == 0u) { xcd_barrier_complete(bar, b.x, nloc, nx); b.st[0] = nloc; b.st[1] = nx; }
        const unsigned old = xb_add(&bar[XB_XSUB(b.x)], 1u);
        const unsigned gen = old / nloc;
        if (old + 1u == (gen + 1u) * nloc) {
            __builtin_amdgcn_fence(__ATOMIC_RELEASE, "agent");
            asm volatile("s_waitcnt vmcnt(0)" ::: "memory");
            const unsigned og = xb_add(&bar[XB_TOP], 1u);
            const unsigned tg = og / nx;
            if (og + 1u == (tg + 1u) * nx) xb_add(&bar[XB_TOPGEN], 1u);
            else XB_SPIN(xb_ld(&bar[XB_TOPGEN]) == tg, bar);
            __builtin_amdgcn_fence(__ATOMIC_ACQUIRE, "agent");
            xb_add(&bar[XB_XGEN(b.x)], 1u);
            asm volatile("s_waitcnt vmcnt(0)" ::: "memory");
        } else {
            XB_SPIN(xb_ld(&bar[XB_XGEN(b.x)]) == gen, bar);
            __builtin_amdgcn_fence(__ATOMIC_ACQUIRE, "agent");
            asm volatile("s_waitcnt vmcnt(0)" ::: "memory");
        }
    }
    __syncthreads();
}

constexpr int LDS_BYTES = RP_END;
static_assert(GP_END + 6144 <= LDS_BYTES, "LDS");
__global__ void __launch_bounds__(256, 2) mega(P p) {
    cg::grid_group grid = cg::this_grid();
    extern __shared__ __attribute__((aligned(16))) char lds[];
    if (threadIdx.x < 4) ((volatile LAS unsigned*)(lds + LDS_BYTES))[threadIdx.x] = 0u;
    __syncthreads();
    const XcdBarrier xb = xcd_barrier_post((unsigned*)(p.ws + WS_CTL + CTL_BAR), (volatile LAS unsigned*)(lds + LDS_BYTES));
#define GSYNC() xcd_barrier(xb)
    const bf16_t* HN = (const bf16_t*)(p.ws + WS_HN);
    const bf16_t* Win = (const bf16_t*)(p.ws + WS_W + W_IN);
    const bf16_t* Wout = (const bf16_t*)(p.ws + WS_W + W_OUT);
    phase_rope(p);
    phase_convert_io(p, 0, lds);
    phase_prep<0>(p, p.in[I_EVNORM], 0);
    if (p.ws == nullptr) grid.sync();
    GSYNC();
    volatile LAS unsigned* qword = (volatile LAS unsigned*)(lds + LDS_BYTES + 8);
    for (int layer = 0; layer < 4; ++layer) {
        const int li = layer >> 1;
        if ((layer & 1) == 0) {
            phase_gemm<EPI_EVEN_IN>(p, HN, 1024, Win, 1024, EVPAD / 128, lds);
            GSYNC();
            for (int u = bidx(); u < 1024; u += gridDim.x) gdn_prep_unit(p, li, u, lds);
            GSYNC();
            if (bidx() < 16) gdn_scan_block(p, bidx(), lds);
            {
                unsigned* qctr = (unsigned*)(p.ws + WS_CTL + CTL_QUEUE) + li * 64;
                for (;;) {
                    __syncthreads();
                    if (threadIdx.x == 0) *qword = atomicAdd(qctr, 1u);
                    __syncthreads();
                    const unsigned u = *qword;
                    if (u >= 2048u) break;
                    rwkv_prep_unit(p, li, (int)u, lds);
                }
            }
            GSYNC();
            if (bidx() < 32) rwkv_scan_block(p, bidx(), lds);
            else {
                for (int u = bidx() - 32; u < 1024; u += gridDim.x - 32) gdn_post_unit(p, li, u);
                phase_convert_moe(p, layer, lds, bidx() - 32, gridDim.x - 32);
            }
            GSYNC();
            for (int u = bidx(); u < 2048; u += gridDim.x) rwkv_post_unit(p, li, u);
            GSYNC();
            phase_gemm<EPI_RESID>(p, (const bf16_t*)(p.ws + WS_PROJ), EVLD, Wout, 1024, 8, lds, false, HN, 1024, 512);
        } else {
            phase_gemm<EPI_ODD_IN>(p, HN, 1024, Win, 1024, ODC / 128, lds);
            GSYNC();
            for (int u = bidx(); u < 3072; u += gridDim.x) attn_unit(p, u, lds);
            GSYNC();
            phase_attn_merge(p);
            GSYNC();
            phase_gemm<EPI_RESID>(p, HN, 512, Wout, 512, 8, lds);
        }
        GSYNC();
        phase_router(p, p.in[I_FFNNORM] + layer * 1024, layer, lds);
        GSYNC();
        phase_moe_up(p, layer, lds);
        GSYNC();
        phase_moe_down(p, layer, lds);
        GSYNC();
        if (layer < 3) {
            phase_convert_io(p, layer + 1, lds);
            if ((layer + 1) & 1) phase_convert_moe(p, layer + 1, lds, bidx(), gridDim.x);
            phase_prep<1>(p, ((layer + 1) & 1) ? p.in[I_ODNORM] + ((layer + 1) >> 1) * 1024 : p.in[I_EVNORM] + ((layer + 1) >> 1) * 1024, layer + 1);
            GSYNC();
        }
    }
    phase_prep<3>(p, p.in[I_FINAL], 0);
}

extern "C" void kernel_launch(void* const* d_in, const int* in_sizes, int n_in, void* d_out, int out_size, void* d_ws, size_t ws_size, hipStream_t stream) {
    if (n_in != 34 || out_size != T * D || ws_size < WS_END) { fprintf(stderr, "kernel_launch: unexpected shapes (n_in %d out %d ws %zu need %zu)\n", n_in, out_size, ws_size, (size_t)WS_END); return; }
    static int grid_blocks = 0;
    if (!grid_blocks) {
        int dev = 0, cus = 0, per_cu = 0;
        (void)hipGetDevice(&dev);
        (void)hipDeviceGetAttribute(&cus, hipDeviceAttributeMultiprocessorCount, dev);
        (void)hipFuncSetAttribute((const void*)mega, hipFuncAttributeMaxDynamicSharedMemorySize, LDS_BYTES + 16);
        (void)hipOccupancyMaxActiveBlocksPerMultiprocessor(&per_cu, mega, 256, LDS_BYTES + 16);
        if (per_cu < 1) per_cu = 1;
        if (per_cu > 2) per_cu = 2;
        grid_blocks = cus * per_cu;
    }
    P p{};
    for (int i = 0; i < 34; ++i) p.in[i] = (const float*)d_in[i];
    p.out = (float*)d_out; p.ws = (unsigned char*)d_ws;
    (void)hipMemsetAsync((char*)d_ws + WS_CTL, 0, 65536, stream);
    void* args[] = {&p};
    hipError_t e = hipLaunchCooperativeKernel((void*)mega, dim3(grid_blocks), dim3(256), args, LDS_BYTES + 16, stream);
    if (e != hipSuccess) fprintf(stderr, "cooperative launch failed: %s (grid %d)\n", hipGetErrorString(e), grid_blocks);
}
```

```cpp
#include <hip/hip_runtime.h>
#include <cstdio>
#include <cstdint>
#include <cmath>
#include <hip/hip_cooperative_groups.h>
namespace cg = cooperative_groups;

typedef unsigned short bf16_t;
typedef short bf16x8 __attribute__((ext_vector_type(8)));
typedef float f32x4 __attribute__((ext_vector_type(4)));
typedef unsigned u32x4 __attribute__((ext_vector_type(4)));
typedef unsigned u32x2 __attribute__((ext_vector_type(2)));
#define DI __device__ __forceinline__

constexpr int T = 16384, SEQ = 4096, BATCH = 4, D = 1024;
constexpr int EVC = 3784, EVLD = 3784, EVPAD = 3840;
constexpr int ODC = 4608;
constexpr int RW0 = 2056;
constexpr int C_R = 2056, C_K = 2568, C_V = 3080, C_HW = 3592, C_HA = 3624, C_HG = 3656, C_HV = 3752;
constexpr int NEXP = 16, FF = 256;
constexpr int HROWS = 34816;

constexpr size_t WS_CTL = 0;
constexpr size_t CTL_EGL = 4096;
constexpr size_t CTL_QUEUE = 49152;
constexpr size_t CTL_CNT = 32768;
constexpr size_t CTL_BAR = 16384;
constexpr size_t WS_LIST = 65536;
constexpr size_t WS_GATE = WS_LIST + 16 * 16384 * 4;
constexpr size_t WS_RK = WS_GATE + 16 * 16384 * 4;
constexpr size_t WS_SSQ = WS_RK + (size_t)T * 8 * 4;
constexpr size_t WS_ROPE = WS_SSQ + (size_t)16 * T * 4;
constexpr size_t WS_W = WS_ROPE + (size_t)T * 32 * 8;
constexpr size_t W_IN = 0;
constexpr size_t W_OUT = (size_t)4608 * 1024 * 2;
constexpr size_t W_13 = W_OUT + (size_t)1024 * 1024 * 2;
constexpr size_t W_2 = W_13 + (size_t)16 * 512 * 1024 * 2;
constexpr size_t W_LW = W_2 + (size_t)16 * 1024 * 256 * 2;
constexpr size_t W_BYTES = W_LW + (size_t)512 * 192 * 2;
constexpr size_t WS_HN = WS_W + W_BYTES;
constexpr size_t WS_VF = WS_HN + (size_t)T * 1024 * 2;
constexpr size_t WS_R2 = WS_VF + (size_t)T * 512 * 2;
constexpr size_t WS_PROJ = WS_R2;
constexpr size_t WS_GOPS = WS_R2 + (size_t)T * EVLD * 2;
constexpr size_t GOPS_CH = 73728, GO_UF = 0, GO_WF = 16384, GO_QF = 32768, GO_AF = 49152, GO_KF = 57344;
constexpr size_t WS_ROPS = WS_GOPS + 1024 * GOPS_CH;
constexpr size_t WS_QK = WS_R2;
constexpr size_t WS_VT = WS_QK + (size_t)T * 3072 * 2;
constexpr size_t WS_OG = WS_VT + (size_t)T * 1536 * 2;
constexpr size_t WS_LSE = WS_OG + (size_t)3 * T * 512 * 2;
constexpr size_t WS_END3 = WS_LSE + (size_t)3 * T * 8 * 4;
constexpr size_t WS_YS = WS_R2;
constexpr size_t WS_H = WS_YS + (size_t)2 * T * 1024 * 2;
constexpr size_t WS_GG = WS_ROPS + (size_t)2048 * 16384;
constexpr size_t WS_END0 = WS_GG + (size_t)T * 512 * 2;
constexpr size_t WS_END1 = WS_H + (size_t)HROWS * 256 * 2;
constexpr size_t WS_END2 = WS_R2 + (size_t)T * 4608 * 2;
static_assert(WS_END3 <= WS_END0, "odd-layer regions exceed even-layer footprint");
constexpr size_t WS_END = WS_END0 > WS_END1 ? (WS_END0 > WS_END2 ? WS_END0 : WS_END2) : (WS_END1 > WS_END2 ? WS_END1 : WS_END2);

constexpr size_t WS_DUMMY = WS_END0;
struct P {
    const float* in[34];
    float* out;
    unsigned char* ws;
};
enum { I_X = 0, I_POS, I_EVNORM, I_EVWIN, I_VRESDOWN, I_EVWOUT, I_CONVW, I_ALOG, I_DTB, I_GDNNORM, I_MU, I_W0, I_W2, I_A0, I_A2, I_G2,
       I_KK, I_KA, I_RK, I_LNW, I_LNB, I_VRESMU, I_V0, I_V2, I_ODNORM, I_ODWIN, I_ODWOUT, I_FFNNORM, I_WGROUP, I_WEXPERT, I_W1, I_W3, I_MW2, I_FINAL };

DI int tidx() { int t = threadIdx.x; asm volatile("" : "+v"(t)); return t; }
DI int bidx() { int b = blockIdx.x; asm volatile("" : "+s"(b)); return b; }
typedef __bf16 bf2_t __attribute__((ext_vector_type(2)));
typedef float f2_t __attribute__((ext_vector_type(2)));
DI bf16_t f2bf(float x) { return __builtin_bit_cast(bf16_t, (__bf16)x); }
DI float bf2f(bf16_t h) { return __uint_as_float(((unsigned)h) << 16); }
DI unsigned pack2(float lo, float hi) { const f2_t v = {lo, hi}; return __builtin_bit_cast(unsigned, __builtin_convertvector(v, bf2_t)); }
DI float wave_sum(float v) {
#pragma unroll
    for (int o = 32; o > 0; o >>= 1) v += __shfl_xor(v, o);
    return v;
}
DI float wave_max(float v) {
#pragma unroll
    for (int o = 32; o > 0; o >>= 1) v = fmaxf(v, __shfl_xor(v, o));
    return v;
}
DI float sigmoidf_(float x) { return __builtin_amdgcn_rcpf(1.f + __expf(-x)); }
DI float siluf_(float x) { return x * __builtin_amdgcn_rcpf(1.f + __expf(-x)); }
DI float softplusf_(float x) { return fmaxf(x, 0.f) + __logf(1.f + __expf(-fabsf(x))); }

struct ConvJob { const float* src; bf16_t* dst; int K, N, ldd; int mode; };
DI int rowmap(int mode, int n) { return mode == 0 ? n : ((n >> 4) * 32 + (n & 15) + (mode == 2 ? 16 : 0)); }
DI void conv_tile(const ConvJob& j, int tile, float* lds  ) {
    const int ntn = (j.N + 255) / 256;
    const int tk = tile / ntn, tn = tile % ntn;
    const int tid = tidx();
    __syncthreads();
    float4 v[16];
#pragma unroll
    for (int i = 0; i < 16; ++i) {
        const int e = tid + i * 256, k = e >> 6, n4 = (e & 63) * 4;
        const int gk = tk * 64 + k, gn = tn * 256 + n4;
        v[i] = make_float4(0.f, 0.f, 0.f, 0.f);
        if (gn < j.N) v[i] = *(const float4*)(j.src + (size_t)gk * j.N + gn);
    }
#pragma unroll
    for (int i = 0; i < 16; ++i) { const int e = tid + i * 256, k = e >> 6, n4 = (e & 63) * 4; *(float4*)(lds + k * 260 + n4) = v[i]; }
    __syncthreads();
#pragma unroll
    for (int i = 0; i < 8; ++i) {
        const int e = tid + i * 256, n = e & 255, k8 = (e >> 8) * 8;
        const int gn = tn * 256 + n;
        if (gn < j.N) {
            u32x4 w;
            w.x = pack2(lds[(k8 + 0) * 260 + n], lds[(k8 + 1) * 260 + n]); w.y = pack2(lds[(k8 + 2) * 260 + n], lds[(k8 + 3) * 260 + n]);
            w.z = pack2(lds[(k8 + 4) * 260 + n], lds[(k8 + 5) * 260 + n]); w.w = pack2(lds[(k8 + 6) * 260 + n], lds[(k8 + 7) * 260 + n]);
            *(u32x4*)(j.dst + (size_t)rowmap(j.mode, gn) * j.ldd + tk * 64 + k8) = w;
        }
    }
}
DI void phase_convert_io(const P& p, int layer, char* ldsc) {
    float* lds = (float*)ldsc;
    unsigned char* W = p.ws + WS_W;
    const int li = layer >> 1;
    if ((layer & 1) == 0) {
        const ConvJob j0{p.in[I_EVWIN] + (size_t)li * 1024 * 3752, (bf16_t*)(W + W_IN), 1024, 3752, 1024, 0};
        for (int t = bidx(); t < 16 * 15; t += gridDim.x) conv_tile(j0, t, lds);
        if (li == 1) {
            const ConvJob j1{p.in[I_VRESDOWN], (bf16_t*)(W + W_IN) + (size_t)3752 * 1024, 1024, 32, 1024, 0};
            for (int t = bidx(); t < 16; t += gridDim.x) conv_tile(j1, t, lds);
        }
        const ConvJob j2{p.in[I_EVWOUT] + (size_t)li * 1024 * 1024, (bf16_t*)(W + W_OUT), 1024, 1024, 1024, 0};
        for (int t = bidx(); t < 16 * 4; t += gridDim.x) conv_tile(j2, t, lds);
        {
            bf16_t* LW = (bf16_t*)(W + W_LW);
            for (int i = bidx() * 256 + tidx(); i < 512 * 192; i += gridDim.x * 256) {
                const int ch = i / 192, j = i % 192;
                float v;
                if (j < 32) v = p.in[I_W2][((size_t)li * 32 + j) * 512 + ch];
                else if (j < 64) v = p.in[I_A2][((size_t)li * 32 + j - 32) * 512 + ch];
                else if (j < 160) v = p.in[I_G2][((size_t)li * 96 + j - 64) * 512 + ch];
                else v = (li == 1) ? p.in[I_V2][(size_t)(j - 160) * 512 + ch] : 0.f;
                LW[i] = f2bf(v);
            }
        }
        const int r0 = (li == 1) ? 3784 : 3752;
        bf16_t* z = (bf16_t*)(W + W_IN) + (size_t)r0 * 1024;
        const size_t n = (size_t)(EVPAD - r0) * 1024;
        for (size_t i = (size_t)bidx() * 256 + tidx(); i < n; i += (size_t)gridDim.x * 256) z[i] = 0;
    } else {
        const ConvJob j0{p.in[I_ODWIN] + (size_t)li * 1024 * 4608, (bf16_t*)(W + W_IN), 1024, 4608, 1024, 0};
        for (int t = bidx(); t < 16 * 18; t += gridDim.x) conv_tile(j0, t, lds);
        const ConvJob j2{p.in[I_ODWOUT] + (size_t)li * 512 * 1024, (bf16_t*)(W + W_OUT), 512, 1024, 512, 0};
        for (int t = bidx(); t < 8 * 4; t += gridDim.x) conv_tile(j2, t, lds);
    }
}
DI void phase_convert_moe(const P& p, int layer, char* ldsc, int b0, int bs) {
    float* lds = (float*)ldsc;
    unsigned char* W = p.ws + WS_W;
    for (int t = b0; t < 16 * 3 * 16; t += bs) {
        const int e = t / 48, r = t % 48, which = r / 16, tile = r % 16;
        ConvJob j;
        if (which == 0) j = ConvJob{p.in[I_W1] + ((size_t)layer * 16 + e) * 1024 * 256, (bf16_t*)(W + W_13) + (size_t)e * 512 * 1024, 1024, 256, 1024, 1};
        else if (which == 1) j = ConvJob{p.in[I_W3] + ((size_t)layer * 16 + e) * 1024 * 256, (bf16_t*)(W + W_13) + (size_t)e * 512 * 1024, 1024, 256, 1024, 2};
        else j = ConvJob{p.in[I_MW2] + ((size_t)layer * 16 + e) * 256 * 1024, (bf16_t*)(W + W_2) + (size_t)e * 1024 * 256, 256, 1024, 256, 0};
        conv_tile(j, tile, lds);
    }
}

DI void phase_rope(const P& p) {
    float2* tab = (float2*)(p.ws + WS_ROPE);
    const int* pos = (const int*)p.in[I_POS];
    for (int i = bidx() * 256 + tidx(); i < T * 32; i += gridDim.x * 256) {
        const int t = i >> 5, f = i & 31;
        const float inv = powf(10000.0f, -(float)f * (2.0f / 64.0f));
        const float ang = (float)pos[t] * inv;
        float s, c; sincosf(ang, &s, &c);
        tab[i] = make_float2(c, s);
    }
}

template <int MODE>
DI void phase_prep(const P& p, const float* gain, int layer, bool dry = false) {
    const int lane = tidx() & 63, wid = tidx() >> 6;
    const int nw = gridDim.x * 4;
    bf16_t* hn = (bf16_t*)(p.ws + WS_HN);
    const bf16_t* y0 = (const bf16_t*)(p.ws + WS_YS);
    const bf16_t* y1 = y0 + (size_t)T * 1024;
    float4 gq[4];
#pragma unroll
    for (int i = 0; i < 4; ++i) gq[i] = *(const float4*)(gain + i * 256 + lane * 4);
    for (int t = bidx() * 4 + wid; t < T; t += nw) {
        float4 v[4];
        float ss = 0.f;
#pragma unroll
        for (int i = 0; i < 4; ++i) {
            const size_t off = (size_t)t * 1024 + i * 256 + lane * 4;
            if (MODE == 0) v[i] = *(const float4*)(p.in[I_X] + off);
            else v[i] = *(const float4*)(p.out + off);
            if (MODE == 1 || MODE == 3) {
                const u32x2 a = *(const u32x2*)(y0 + off), b = *(const u32x2*)(y1 + off);
                v[i].x += __uint_as_float(a.x << 16) + __uint_as_float(b.x << 16); v[i].y += __uint_as_float(a.x & 0xffff0000u) + __uint_as_float(b.x & 0xffff0000u);
                v[i].z += __uint_as_float(a.y << 16) + __uint_as_float(b.y << 16); v[i].w += __uint_as_float(a.y & 0xffff0000u) + __uint_as_float(b.y & 0xffff0000u);
            }
            ss += v[i].x * v[i].x + v[i].y * v[i].y + v[i].z * v[i].z + v[i].w * v[i].w;
        }
        ss = wave_sum(ss);
        const float rstd = rsqrtf(ss * (1.0f / 1024.0f) + 1e-6f);
        float lg[20];
        if (MODE == 2) {
#pragma unroll
            for (int q = 0; q < 20; ++q) lg[q] = 0.f;
        }
#pragma unroll
        for (int i = 0; i < 4; ++i) {
            const int col = i * 256 + lane * 4;
            const size_t off = (size_t)t * 1024 + col;
            const float4 g = gq[i];
            float4 h; h.x = v[i].x * rstd * g.x; h.y = v[i].y * rstd * g.y; h.z = v[i].z * rstd * g.z; h.w = v[i].w * rstd * g.w;
            float* od = dry ? (float*)(p.ws + WS_DUMMY) + (off & 0x7FFFF) : p.out + off;
            bf16_t* hd = dry ? (bf16_t*)(p.ws + WS_DUMMY + 2097152) + (off & 0x7FFFF) : hn + off;
            if (MODE == 0 || MODE == 1) *(float4*)od = v[i];
            if (MODE == 3) *(float4*)od = h;
            else { u32x2 w; w.x = pack2(h.x, h.y); w.y = pack2(h.z, h.w); *(u32x2*)hd = w; }
            if (MODE == 2) {
                const float hh[4] = {h.x, h.y, h.z, h.w};
                const float* wg = p.in[I_WGROUP] + (size_t)layer * 1024 * 4;
                const float* we = p.in[I_WEXPERT] + (size_t)layer * 4 * 1024 * 4;
#pragma unroll
                for (int e = 0; e < 4; ++e) {
                    const float4 a = *(const float4*)(wg + (size_t)(col + e) * 4);
                    lg[0] += hh[e] * a.x; lg[1] += hh[e] * a.y; lg[2] += hh[e] * a.z; lg[3] += hh[e] * a.w;
#pragma unroll
                    for (int g2 = 0; g2 < 4; ++g2) {
                        const float4 b = *(const float4*)(we + ((size_t)g2 * 1024 + col + e) * 4);
                        lg[4 + g2 * 4 + 0] += hh[e] * b.x; lg[4 + g2 * 4 + 1] += hh[e] * b.y; lg[4 + g2 * 4 + 2] += hh[e] * b.z; lg[4 + g2 * 4 + 3] += hh[e] * b.w;
                    }
                }
            }
        }
        if (MODE == 2) {
#pragma unroll
            for (int q = 0; q < 20; ++q) lg[q] = wave_sum(lg[q]);
            if (lane == 0) {
                int gs = 0; float gm = lg[0];
#pragma unroll
                for (int g2 = 1; g2 < 4; ++g2) if (lg[g2] > gm) { gm = lg[g2]; gs = g2; }
                float den = 0.f;
#pragma unroll
                for (int g2 = 0; g2 < 4; ++g2) den += __expf(lg[g2] - gm);
                const float pg = 1.f / den;
                float el[4];
#pragma unroll
                for (int e = 0; e < 4; ++e) el[e] = gs == 0 ? lg[4 + e] : gs == 1 ? lg[8 + e] : gs == 2 ? lg[12 + e] : lg[16 + e];
                int i1 = 0; float v1 = el[0];
#pragma unroll
                for (int e = 1; e < 4; ++e) if (el[e] > v1) { v1 = el[e]; i1 = e; }
                int i2 = 0; float v2 = -3.4e38f;
#pragma unroll
                for (int e = 0; e < 4; ++e) if (e != i1 && el[e] > v2) { v2 = el[e]; i2 = e; }
                const float e2 = __expf(v2 - v1);
                const float g1 = pg / (1.f + e2), g2v = pg * e2 / (1.f + e2);
                unsigned* cnt = (unsigned*)(p.ws + WS_CTL + CTL_CNT) + layer * 16 * 64;
                int* list = (int*)(p.ws + WS_LIST);
                float* gl = (float*)(p.ws + WS_GATE);
                const int ea = gs * 4 + i1, eb = gs * 4 + i2;
                const unsigned ra = atomicAdd(&cnt[ea * 64], 1u);
                list[ea * 16384 + ra] = t * 2; gl[ea * 16384 + ra] = g1;
                const unsigned rb = atomicAdd(&cnt[eb * 64], 1u);
                list[eb * 16384 + rb] = t * 2 + 1; gl[eb * 16384 + rb] = g2v;
            }
        }
    }
}


DI void phase_router(const P& p, const float* gain, int layer, char* ldsc, bool dry = false) {
    const int tid = tidx(), lane = tid & 63, wid = tid >> 6;
    bf16_t* hn = (bf16_t*)(p.ws + WS_HN);
    const float* wg = p.in[I_WGROUP] + (size_t)layer * 1024 * 4;
    const float* we = p.in[I_WEXPERT] + (size_t)layer * 4 * 1024 * 4;
    unsigned* cnt = dry ? (unsigned*)(p.ws + WS_DUMMY + 3145728) : (unsigned*)(p.ws + WS_CTL + CTL_CNT) + layer * 16 * 64;
    int* list = dry ? (int*)(p.ws + WS_DUMMY) : (int*)(p.ws + WS_LIST);
    float* gl = dry ? (float*)(p.ws + WS_DUMMY + 1048576) : (float*)(p.ws + WS_GATE);
    if (dry) hn = (bf16_t*)(p.ws + WS_DUMMY + 2097152);
    f32x4* WS = (f32x4*)ldsc;
    unsigned* lcnt = (unsigned*)(ldsc + 40960); unsigned* lbase = lcnt + 16; int* e_ent = (int*)(lcnt + 32); unsigned* r_ent = (unsigned*)(e_ent + 32); int* t_ent = (int*)(r_ent + 32); float* g_ent = (float*)(t_ent + 32);
    auto stage = [&](int i, int buf) {
#pragma unroll
        for (int r = 0; r < 5; ++r) {
            const int kk = tid;
            const float* src = (r == 0 ? wg : we + (size_t)(r - 1) * 4096) + (size_t)(i * 256 + kk) * 4;
            WS[buf * 1280 + (r * 4 + (kk & 3)) * 64 + (kk >> 2)] = *(const f32x4*)src;
        }
    };
    for (int tb = bidx() * 16; tb < T; tb += gridDim.x * 16) {
        __syncthreads();
        if (tid < 16) lcnt[tid] = 0u;
        stage(0, 0);
        const int t0 = tb + wid * 4;
        float rstd[4];
        {
            const float pq = ((const float*)(p.ws + WS_SSQ))[(size_t)(lane & 15) * T + t0 + (lane >> 4)];
            float ss = pq;
            ss += __shfl_xor(ss, 1); ss += __shfl_xor(ss, 2); ss += __shfl_xor(ss, 4); ss += __shfl_xor(ss, 8);
#pragma unroll
            for (int q = 0; q < 4; ++q) rstd[q] = rsqrtf(__shfl(ss, q * 16) * (1.0f / 1024.0f) + 1e-6f);
        }
        float lg[4][20];
#pragma unroll
        for (int q = 0; q < 4; ++q)
#pragma unroll
            for (int j = 0; j < 20; ++j) lg[q][j] = 0.f;
#pragma unroll 1
        for (int i = 0; i < 4; ++i) {
            __syncthreads();
            if (i + 1 < 4) stage(i + 1, (i + 1) & 1);
            const f32x4* W = WS + (i & 1) * 1280;
            const int col = i * 256 + lane * 4;
            const float4 g = *(const float4*)(gain + col);
            float hh[4][4];
#pragma unroll
            for (int q = 0; q < 4; ++q) {
                const float4 x4 = *(const float4*)(p.out + (size_t)(t0 + q) * 1024 + col);
                hh[q][0] = x4.x * rstd[q] * g.x; hh[q][1] = x4.y * rstd[q] * g.y; hh[q][2] = x4.z * rstd[q] * g.z; hh[q][3] = x4.w * rstd[q] * g.w;
                u32x2 w; w.x = pack2(hh[q][0], hh[q][1]); w.y = pack2(hh[q][2], hh[q][3]);
                *(u32x2*)(hn + (dry ? (((size_t)(t0 + q) * 1024 + col) & 0x7FFFF) : ((size_t)(t0 + q) * 1024 + col))) = w;
            }
#pragma unroll
            for (int e = 0; e < 4; ++e) {
                const f32x4 a = W[(0 * 4 + e) * 64 + lane];
#pragma unroll
                for (int q = 0; q < 4; ++q) { lg[q][0] += hh[q][e] * a[0]; lg[q][1] += hh[q][e] * a[1]; lg[q][2] += hh[q][e] * a[2]; lg[q][3] += hh[q][e] * a[3]; }
#pragma unroll
                for (int g2 = 0; g2 < 4; ++g2) {
                    const f32x4 b = W[((1 + g2) * 4 + e) * 64 + lane];
#pragma unroll
                    for (int q = 0; q < 4; ++q) { lg[q][4 + g2 * 4] += hh[q][e] * b[0]; lg[q][5 + g2 * 4] += hh[q][e] * b[1]; lg[q][6 + g2 * 4] += hh[q][e] * b[2]; lg[q][7 + g2 * 4] += hh[q][e] * b[3]; }
                }
            }
        }
#pragma unroll
        for (int q = 0; q < 4; ++q) {
#pragma unroll
            for (int j = 0; j < 20; ++j) lg[q][j] = wave_sum(lg[q][j]);
            if (lane == q) {
                const int t = t0 + q;
                int gs = 0; float gm = lg[q][0];
#pragma unroll
                for (int g2 = 1; g2 < 4; ++g2) if (lg[q][g2] > gm) { gm = lg[q][g2]; gs = g2; }
                float den = 0.f;
#pragma unroll
                for (int g2 = 0; g2 < 4; ++g2) den += __expf(lg[q][g2] - gm);
                const float pg = 1.f / den;
                float el[4];
#pragma unroll
                for (int e = 0; e < 4; ++e) el[e] = gs == 0 ? lg[q][4 + e] : gs == 1 ? lg[q][8 + e] : gs == 2 ? lg[q][12 + e] : lg[q][16 + e];
                int i1 = 0; float v1 = el[0];
#pragma unroll
                for (int e = 1; e < 4; ++e) if (el[e] > v1) { v1 = el[e]; i1 = e; }
                int i2 = 0; float v2 = -3.4e38f;
#pragma unroll
                for (int e = 0; e < 4; ++e) if (e != i1 && el[e] > v2) { v2 = el[e]; i2 = e; }
                const float e2 = __expf(v2 - v1);
                const float g1 = pg / (1.f + e2), g2v = pg * e2 / (1.f + e2);
                const int ea = gs * 4 + i1, eb = gs * 4 + i2;
                const int sl = (wid * 4 + q) * 2;
                e_ent[sl] = ea; r_ent[sl] = atomicAdd(&lcnt[ea], 1u); t_ent[sl] = t * 2; g_ent[sl] = g1;
                e_ent[sl + 1] = eb; r_ent[sl + 1] = atomicAdd(&lcnt[eb], 1u); t_ent[sl + 1] = t * 2 + 1; g_ent[sl + 1] = g2v;
            }
        }
        __syncthreads();
        if (tid < 16) lbase[tid] = lcnt[tid] ? atomicAdd(&cnt[tid * 64], lcnt[tid]) : 0u;
        __syncthreads();
        if (tid < 32) {
            const int e = e_ent[tid];
            const unsigned pos = (lbase[e] + r_ent[tid]) & 16383u;
            list[e * 16384 + pos] = t_ent[tid]; gl[e * 16384 + pos] = g_ent[tid];
        }
    }
}

constexpr int GBK = 64;
typedef __attribute__((address_space(3))) unsigned lds_u32;
struct TileP { const bf16_t* ar[4]; const bf16_t* br[4]; const bf16_t* ar2[4]; };
DI void gemm_core(const TileP& tp, int K, char* lds, f32x4 (&acc)[4][4], int ksplit, bool primed, const TileP& nx, bool have_nx) {
    const bf16_t* const (&ar)[4] = tp.ar; const bf16_t* const (&br)[4] = tp.br; const bf16_t* const (&ar2)[4] = tp.ar2;
    const int tid = tidx(), wid = tid >> 6, lane = tid & 63, wr = wid >> 1, wc = wid & 1, fr = lane & 15, fq = lane >> 4;
    const int scol = ((tid & 7) ^ ((tid >> 3) & 7)) * 8;
#pragma unroll
    for (int n = 0; n < 4; ++n)
#pragma unroll
        for (int m = 0; m < 4; ++m) acc[n][m] = (f32x4){0.f, 0.f, 0.f, 0.f};
    const int nk = K / GBK;
    if (!primed) {
        __syncthreads();
#pragma unroll
        for (int i = 0; i < 4; ++i) {
            __builtin_amdgcn_global_load_lds((const unsigned*)(ar[i] + scol), (lds_u32*)(lds + tid * 16 + i * 4096), 16, 0, 0);
            __builtin_amdgcn_global_load_lds((const unsigned*)(br[i] + scol), (lds_u32*)(lds + 16384 + tid * 16 + i * 4096), 16, 0, 0);
        }
    }
    const int sw = fr & 7;
    for (int kt = 0; kt < nk; ++kt) {
        asm volatile("s_waitcnt vmcnt(0)" ::: "memory");
        __builtin_amdgcn_s_barrier();
        if (kt + 1 < nk) {
            char* nb = lds + ((kt + 1) & 1) * 32768;
            const int ko = (kt + 1) * GBK + scol;
#pragma unroll
            for (int i = 0; i < 4; ++i) {
                __builtin_amdgcn_global_load_lds((const unsigned*)(((kt + 1) * GBK >= ksplit ? ar2[i] : ar[i]) + ko), (lds_u32*)(nb + tid * 16 + i * 4096), 16, 0, 0);
                __builtin_amdgcn_global_load_lds((const unsigned*)(br[i] + ko), (lds_u32*)(nb + 16384 + tid * 16 + i * 4096), 16, 0, 0);
            }
        } else if (have_nx) {
#pragma unroll
            for (int i = 0; i < 4; ++i) {
                __builtin_amdgcn_global_load_lds((const unsigned*)(nx.ar[i] + scol), (lds_u32*)(lds + tid * 16 + i * 4096), 16, 0, 0);
                __builtin_amdgcn_global_load_lds((const unsigned*)(nx.br[i] + scol), (lds_u32*)(lds + 16384 + tid * 16 + i * 4096), 16, 0, 0);
            }
        }
        const char* SA = lds + (kt & 1) * 32768; const char* SB = SA + 16384;
#pragma unroll
        for (int kh = 0; kh < 2; ++kh) {
            bf16x8 af[4], bfr[4];
            const int co = ((kh * 4 + fq) ^ sw) * 16;
#pragma unroll
            for (int m = 0; m < 4; ++m) af[m] = *(const bf16x8*)(SA + (wr * 64 + m * 16 + fr) * 128 + co);
#pragma unroll
            for (int n = 0; n < 4; ++n) bfr[n] = *(const bf16x8*)(SB + (wc * 64 + n * 16 + fr) * 128 + co);
#pragma unroll
            for (int n = 0; n < 4; ++n)
#pragma unroll
                for (int m = 0; m < 4; ++m) acc[n][m] = __builtin_amdgcn_mfma_f32_16x16x32_bf16(bfr[n], af[m], acc[n][m], 0, 0, 0);
        }
    }
}

enum { EPI_EVEN_IN = 0, EPI_ODD_IN, EPI_RESID };
template <int EPI>
DI void phase_gemm(const P& p, const bf16_t* A, int lda, const bf16_t* Bt, int K, int ntn, char* lds, bool dry = false, const bf16_t* A2 = nullptr, int lda2 = 0, int ksplit = 1 << 30) {
    const int tid = tidx(), wid = tid >> 6, lane = tid & 63, wr = wid >> 1, wc = wid & 1, fr = lane & 15, fq = lane >> 4;
    const int ntm = T / 128, ntiles = ntm * ntn;
    auto fill = [&](TileP& t, int tile) {
        const int tn = tile / ntm, tm = tile % ntm, r = tid >> 3;
#pragma unroll
        for (int i = 0; i < 4; ++i) { t.ar[i] = A + (size_t)(tm * 128 + r + 32 * i) * lda; t.br[i] = Bt + (size_t)(tn * 128 + r + 32 * i) * K; t.ar2[i] = A2 ? A2 + (size_t)(tm * 128 + r + 32 * i) * lda2 : t.ar[i]; }
    };
    TileP cur, nxt;
    bool primed = false;
    fill(cur, bidx() < ntiles ? bidx() : 0); nxt = cur;
    for (int tile = bidx(); tile < ntiles; tile += gridDim.x) {
        const int tn = tile / ntm, tm = tile % ntm;
        const bool have_next = tile + (int)gridDim.x < ntiles;
        if (have_next) fill(nxt, tile + gridDim.x);
        f32x4 acc[4][4];
        gemm_core(cur, K, lds, acc, ksplit, primed, nxt, have_next);
        primed = have_next; cur = nxt;
        const int m0 = tm * 128 + wr * 64, n0 = tn * 128 + wc * 64;
        if (EPI == EPI_EVEN_IN) {
            bf16_t* C = (bf16_t*)(p.ws + WS_PROJ);
#pragma unroll
            for (int m = 0; m < 4; ++m)
#pragma unroll
                for (int n = 0; n < 4; ++n) {
                    const int row = m0 + m * 16 + fr, col = n0 + n * 16 + fq * 4;
                    if (col < EVC) { u32x2 w; w.x = pack2(acc[n][m][0], acc[n][m][1]); w.y = pack2(acc[n][m][2], acc[n][m][3]); *(u32x2*)(C + (size_t)row * EVLD + col) = w; }
                }
        } else if (EPI == EPI_ODD_IN) {
            bf16_t* C = (bf16_t*)(p.ws + WS_QK);
            const float2* tab = (const float2*)(p.ws + WS_ROPE);
            if (n0 < 3072) {
#pragma unroll
                for (int m = 0; m < 4; ++m) {
                    const int row = m0 + m * 16 + fr;
#pragma unroll
                    for (int n = 0; n < 2; ++n) {
                        float lo[4], hi[4];
#pragma unroll
                        for (int j = 0; j < 4; ++j) {
                            const float2 cs = tab[(size_t)row * 32 + n * 16 + fq * 4 + j];
                            const float x1 = acc[n][m][j], x2 = acc[n + 2][m][j];
                            lo[j] = x1 * cs.x - x2 * cs.y; hi[j] = x2 * cs.x + x1 * cs.y;
                        }
                        u32x2 w; w.x = pack2(lo[0], lo[1]); w.y = pack2(lo[2], lo[3]);
                        *(u32x2*)(C + (size_t)row * 3072 + n0 + n * 16 + fq * 4) = w;
                        w.x = pack2(hi[0], hi[1]); w.y = pack2(hi[2], hi[3]);
                        *(u32x2*)(C + (size_t)row * 3072 + n0 + (n + 2) * 16 + fq * 4) = w;
                    }
                }
            }
            if (tn * 128 >= 3072) {
                bf16_t* VT = (bf16_t*)(p.ws + WS_VT);
                const int hg0 = (tn * 128 - 3072) >> 6, g = hg0 >> 3, lg2 = g * 2, dil = 1 << lg2, L = SEQ >> lg2, run = 128 >> lg2;
                __syncthreads();
#pragma unroll
                for (int m = 0; m < 4; ++m)
#pragma unroll
                    for (int n = 0; n < 4; ++n)
#pragma unroll
                        for (int j = 0; j < 4; ++j)
                            *(bf16_t*)(lds + 32768 + (wc * 64 + n * 16 + fq * 4 + j) * 272 + (wr * 64 + m * 16 + fr) * 2) = f2bf(acc[n][m][j]);
                __syncthreads();
                const int bb = (tm * 128) >> 12, s0 = (tm * 128) & (SEQ - 1);
#pragma unroll
                for (int q = 0; q < 8; ++q) {
                    const int item = tid + q * 256, dim = item >> 4, o0 = (item & 15) * 8;
                    const int rr = o0 / run, i0 = o0 % run;
                    const char* src = lds + 32768 + dim * 272 + (rr + dil * i0) * 2;
                    float e8[8];
#pragma unroll
                    for (int e = 0; e < 8; ++e) e8[e] = bf2f(*(const bf16_t*)(src + e * dil * 2));
                    u32x4 w; w.x = pack2(e8[0], e8[1]); w.y = pack2(e8[2], e8[3]); w.z = pack2(e8[4], e8[5]); w.w = pack2(e8[6], e8[7]);
                    const int hg = hg0 + (dim >> 6);
                    *(u32x4*)(VT + ((size_t)((bb * 24 + hg) * dil + rr) * 64 + (dim & 63)) * L + (s0 >> lg2) + i0) = w;
                }
            }
        } else {
            float* ssq = (float*)(p.ws + WS_SSQ) + (size_t)(tn * 2 + wc) * T;
#pragma unroll
            for (int m = 0; m < 4; ++m) {
                float ss = 0.f;
#pragma unroll
                for (int n = 0; n < 4; ++n) {
                    const size_t qo = (size_t)(m0 + m * 16 + fr) * 1024 + n0 + n * 16 + fq * 4;
                    float* q = dry ? (float*)(p.ws + WS_DUMMY) + (qo & 0x7FFFF) : p.out + qo;
                    float4 v = *(float4*)q;
                    v.x += acc[n][m][0]; v.y += acc[n][m][1]; v.z += acc[n][m][2]; v.w += acc[n][m][3];
                    *(float4*)q = v;
                    ss += v.x * v.x + v.y * v.y + v.z * v.z + v.w * v.w;
                }
                ss += __shfl_xor(ss, 16); ss += __shfl_xor(ss, 32);
                if (fq == 0 && !dry) ssq[m0 + m * 16 + fr] = ss;
            }
        }
    }
}

DI void phase_moe_up(const P& p, int layer, char* lds) {
    const int tid = tidx(), wid = tid >> 6, lane = tid & 63, wr = wid >> 1, wc = wid & 1, fr = lane & 15, fq = lane >> 4;
    const unsigned* cntb = (const unsigned*)(p.ws + WS_CTL + CTL_CNT) + layer * 16 * 64;
    unsigned cnt[16];
#pragma unroll
    for (int e = 0; e < 16; ++e) cnt[e] = cntb[e * 64];
    const int* list = (const int*)(p.ws + WS_LIST);
    const float* gl = (const float*)(p.ws + WS_GATE);
    const bf16_t* hn = (const bf16_t*)(p.ws + WS_HN);
    const bf16_t* W13 = (const bf16_t*)(p.ws + WS_W + W_13);
    bf16_t* H = (bf16_t*)(p.ws + WS_H);
    int ttot = 0;
#pragma unroll
    for (int e = 0; e < 16; ++e) ttot += ((int)cnt[e] + 127) >> 7;
    const int ntiles = ttot * 4;
    auto locate = [&](int tile, int& e, int& lt, int& ce, int& rbe, int& tn) {
        const int mt = tile >> 2; tn = tile & 3;
        int tbe = 0, acc_t = 0; e = 0;
#pragma unroll
        for (int q = 0; q < 16; ++q) { const int nt = ((int)cnt[q] + 127) >> 7; if (mt >= acc_t) { e = q; tbe = acc_t; } acc_t += nt; }
        lt = mt - tbe; ce = (int)cnt[e]; rbe = tbe * 128;
    };
    auto fill = [&](TileP& t, int tile) {
        int e, lt, ce, rbe, tn; locate(tile, e, lt, ce, rbe, tn);
        const int r = tid >> 3;
#pragma unroll
        for (int i = 0; i < 4; ++i) {
            const int ii = lt * 128 + r + 32 * i;
            const int tk = ii < ce ? (list[e * 16384 + ii] >> 1) : 0;
            t.ar[i] = hn + (size_t)tk * 1024; t.ar2[i] = t.ar[i];
            t.br[i] = W13 + ((size_t)e * 512 + tn * 128 + r + 32 * i) * 1024;
        }
    };
    TileP cur, nxt;
    bool primed = false;
    fill(cur, bidx() < ntiles ? bidx() : 0); nxt = cur;
    for (int tile = bidx(); tile < ntiles; tile += gridDim.x) {
        int e, lt, ce, rbe, tn; locate(tile, e, lt, ce, rbe, tn);
        const bool have_next = tile + (int)gridDim.x < ntiles;
        if (have_next) fill(nxt, tile + gridDim.x);
        f32x4 acc[4][4];
        gemm_core(cur, 1024, lds, acc, 1 << 30, primed, nxt, have_next);
        primed = have_next; cur = nxt;
#pragma unroll
        for (int m = 0; m < 4; ++m) {
            const int li = lt * 128 + wr * 64 + m * 16 + fr;
            if (li < ce) {
                const float g = gl[e * 16384 + li];
                bf16_t* hrow = H + (size_t)(rbe + li) * 256;
#pragma unroll
                for (int n = 0; n < 4; n += 2) {
                    float o[4];
#pragma unroll
                    for (int j = 0; j < 4; ++j) o[j] = siluf_(acc[n][m][j]) * acc[n + 1][m][j] * g;
                    const int f = tn * 64 + wc * 32 + (n >> 1) * 16 + fq * 4;
                    u32x2 w; w.x = pack2(o[0], o[1]); w.y = pack2(o[2], o[3]);
                    *(u32x2*)(hrow + f) = w;
                }
            }
        }
    }
}
DI void phase_moe_down(const P& p, int layer, char* lds) {
    const int tid = tidx(), wid = tid >> 6, lane = tid & 63, wr = wid >> 1, wc = wid & 1, fr = lane & 15, fq = lane >> 4;
    const unsigned* cntb = (const unsigned*)(p.ws + WS_CTL + CTL_CNT) + layer * 16 * 64;
    unsigned cnt[16];
#pragma unroll
    for (int e = 0; e < 16; ++e) cnt[e] = cntb[e * 64];
    const int* list = (const int*)(p.ws + WS_LIST);
    const bf16_t* W2 = (const bf16_t*)(p.ws + WS_W + W_2);
    const bf16_t* H = (const bf16_t*)(p.ws + WS_H);
    bf16_t* ys = (bf16_t*)(p.ws + WS_YS);
    int ttot = 0;
#pragma unroll
    for (int e = 0; e < 16; ++e) ttot += ((int)cnt[e] + 127) >> 7;
    const int ntiles = ttot * 8;
    auto locate = [&](int tile, int& e, int& lt, int& ce, int& rbe, int& tn) {
        const int mt = tile >> 3; tn = tile & 7;
        int tbe = 0, acc_t = 0; e = 0;
#pragma unroll
        for (int q = 0; q < 16; ++q) { const int nt = ((int)cnt[q] + 127) >> 7; if (mt >= acc_t) { e = q; tbe = acc_t; } acc_t += nt; }
        lt = mt - tbe; ce = (int)cnt[e]; rbe = tbe * 128;
    };
    auto fill = [&](TileP& t, int tile) {
        int e, lt, ce, rbe, tn; locate(tile, e, lt, ce, rbe, tn);
        const int r = tid >> 3;
#pragma unroll
        for (int i = 0; i < 4; ++i) { t.ar[i] = H + (size_t)(rbe + lt * 128 + r + 32 * i) * 256; t.ar2[i] = t.ar[i]; t.br[i] = W2 + ((size_t)e * 1024 + tn * 128 + r + 32 * i) * 256; }
    };
    TileP cur, nxt;
    bool primed = false;
    fill(cur, bidx() < ntiles ? bidx() : 0); nxt = cur;
    for (int tile = bidx(); tile < ntiles; tile += gridDim.x) {
        int e, lt, ce, rbe, tn; locate(tile, e, lt, ce, rbe, tn);
        const bool have_next = tile + (int)gridDim.x < ntiles;
        if (have_next) fill(nxt, tile + gridDim.x);
        f32x4 acc[4][4];
        gemm_core(cur, 256, lds, acc, 1 << 30, primed, nxt, have_next);
        primed = have_next; cur = nxt;
#pragma unroll
        for (int m = 0; m < 4; ++m) {
            const int li = lt * 128 + wr * 64 + m * 16 + fr;
            if (li < ce) {
                const int ts = list[e * 16384 + li];
                bf16_t* yrow = ys + ((size_t)(ts & 1) * T + (ts >> 1)) * 1024 + tn * 128 + wc * 64 + fq * 4;
#pragma unroll
                for (int n = 0; n < 4; ++n) { u32x2 w; w.x = pack2(acc[n][m][0], acc[n][m][1]); w.y = pack2(acc[n][m][2], acc[n][m][3]); *(u32x2*)(yrow + n * 16) = w; }
            }
        }
    }
}


typedef float f32x16 __attribute__((ext_vector_type(16)));
DI f32x4 mfma16(bf16x8 a, bf16x8 b, f32x4 c) { return __builtin_amdgcn_mfma_f32_16x16x32_bf16(a, b, c, 0, 0, 0); }
DI f32x16 mfma32(bf16x8 a, bf16x8 b, f32x16 c) { return __builtin_amdgcn_mfma_f32_32x32x16_bf16(a, b, c, 0, 0, 0); }
DI f32x4 tile16(const char* X, int ldx, int row0, const char* Y, int ldy, int col0, int K) {
    const int lane = tidx() & 63, fr = lane & 15, fq = lane >> 4;
    f32x4 acc = {0.f, 0.f, 0.f, 0.f};
#pragma unroll
    for (int k = 0; k < K; k += 32) {
        const bf16x8 a = *(const bf16x8*)(X + (row0 + fr) * ldx + (k + fq * 8) * 2);
        const bf16x8 b = *(const bf16x8*)(Y + (col0 + fr) * ldy + (k + fq * 8) * 2);
        acc = mfma16(a, b, acc);
    }
    return acc;
}
DI bf16x8 pack_step(const f32x16& x, int s) {
    u32x4 r;
    r.x = pack2(x[8 * s + 0], x[8 * s + 1]); r.y = pack2(x[8 * s + 2], x[8 * s + 3]);
    r.z = pack2(x[8 * s + 4], x[8 * s + 5]); r.w = pack2(x[8 * s + 6], x[8 * s + 7]);
    return __builtin_bit_cast(bf16x8, r);
}

constexpr int GP_LF = 0, GP_T = 17408, GP_VEC = GP_T + 9216, GP_U = GP_VEC + 1024, GP_END = GP_U + 36864;
DI void gdn_prep_unit(const P& p, int li, int ch, char* lds) {
    const int tid = tidx(), lane = tid & 63, wid = tid >> 6, fr = lane & 15, fq = lane >> 4;
    const int h = ch & 3, n = (ch >> 2) & 63, b = ch >> 8;
    const int t0 = b * SEQ + n * 64;
    float* Lf = (float*)(lds + GP_LF);
    char* Trow = lds + GP_T;
    float* gcs = (float*)(lds + GP_VEC); float* egc = gcs + 64; float* bet = gcs + 128; float* ekd = gcs + 192;
    char* Qrow = lds + GP_U; char* Krow = Qrow + 17408; char* VbT = lds + GP_U; char* KbgT = VbT + 18432;
    const bf16_t* proj = (const bf16_t*)(p.ws + WS_PROJ);
    unsigned char* ops = p.ws + WS_GOPS + (size_t)ch * GOPS_CH;
    const float* cw = p.in[I_CONVW] + (size_t)li * 4 * 1536;
    const int c = tid >> 2, cq = tid & 3;
    __syncthreads();
    float* cwl = (float*)(lds + GP_END);
    for (int i = tid; i < 4 * 3 * 32; i += 256) {
        const int j = i / 96, r = i % 96, sl = r >> 5, q4 = (r & 31) * 4;
        *(f32x4*)(cwl + (j * 3 + sl) * 128 + q4) = *(const f32x4*)(cw + j * 1536 + sl * 512 + h * 128 + q4);
    }
    __syncthreads();
    unsigned vvp[16];
#pragma unroll 1
    for (int which = 0; which < 3; ++which) {
        const int col0 = which * 512 + h * 128 + cq * 32;
        u32x4 xin[4][4];
#pragma unroll
        for (int j = 0; j < 4; ++j) {
            const int sp = n * 64 + c - 3 + j;
            const bf16_t* src = proj + (size_t)(b * SEQ + (sp < 0 ? 0 : sp)) * EVLD + col0;
#pragma unroll
            for (int i4 = 0; i4 < 4; ++i4) xin[j][i4] = *(const u32x4*)(src + i4 * 8);
        }
        float acc[32];
#pragma unroll
        for (int i = 0; i < 32; ++i) acc[i] = 0.f;
#pragma unroll
        for (int j = 0; j < 4; ++j) {
            const float ok = (n * 64 + c - 3 + j) >= 0 ? 1.f : 0.f;
            const float* wj = cwl + (j * 3 + which) * 128 + cq * 32;
#pragma unroll
            for (int i4 = 0; i4 < 4; ++i4) {
                const f32x4 wa = *(const f32x4*)(wj + i4 * 8), wb = *(const f32x4*)(wj + i4 * 8 + 4);
                const u32x4 w = xin[j][i4];
                acc[i4 * 8 + 0] += ok * wa[0] * __uint_as_float(w[0] << 16); acc[i4 * 8 + 1] += ok * wa[1] * __uint_as_float(w[0] & 0xffff0000u);
                acc[i4 * 8 + 2] += ok * wa[2] * __uint_as_float(w[1] << 16); acc[i4 * 8 + 3] += ok * wa[3] * __uint_as_float(w[1] & 0xffff0000u);
                acc[i4 * 8 + 4] += ok * wb[0] * __uint_as_float(w[2] << 16); acc[i4 * 8 + 5] += ok * wb[1] * __uint_as_float(w[2] & 0xffff0000u);
                acc[i4 * 8 + 6] += ok * wb[2] * __uint_as_float(w[3] << 16); acc[i4 * 8 + 7] += ok * wb[3] * __uint_as_float(w[3] & 0xffff0000u);
            }
        }
        float ss = 0.f;
#pragma unroll
        for (int i = 0; i < 32; ++i) { acc[i] = siluf_(acc[i]); ss += acc[i] * acc[i]; }
        ss += __shfl_xor(ss, 1); ss += __shfl_xor(ss, 2);
        const float rn = which == 2 ? 1.f : rsqrtf(ss + 1e-6f) * (which == 0 ? 0.08838834764831845f : 1.f);
        unsigned pk[16];
#pragma unroll
        for (int i = 0; i < 16; ++i) pk[i] = pack2(acc[2 * i] * rn, acc[2 * i + 1] * rn);
        if (which < 2) {
            char* img = which == 0 ? Qrow : Krow;
#pragma unroll
            for (int i4 = 0; i4 < 4; ++i4) { u32x4 w; w.x = pk[i4 * 4]; w.y = pk[i4 * 4 + 1]; w.z = pk[i4 * 4 + 2]; w.w = pk[i4 * 4 + 3]; *(u32x4*)(img + c * 272 + (cq * 32 + i4 * 8) * 2) = w; }
        } else {
#pragma unroll
            for (int i = 0; i < 16; ++i) vvp[i] = pk[i];
        }
    }
    if (cq == 0) {
        const float a = bf2f(proj[(size_t)(t0 + c) * EVLD + 2048 + h]);
        const float bb = bf2f(proj[(size_t)(t0 + c) * EVLD + 2052 + h]);
        const float Aexp = __expf(p.in[I_ALOG][li * 4 + h]), dtb = p.in[I_DTB][li * 4 + h];
        gcs[c] = -Aexp * softplusf_(a + dtb);
        bet[c] = sigmoidf_(bb);
    }
    __syncthreads();
    if (wid == 0) {
        float x = gcs[lane];
#pragma unroll
        for (int o = 1; o < 64; o <<= 1) { const float y = __shfl_up(x, o); if (lane >= o) x += y; }
        const float gl = __shfl(x, 63);
        gcs[lane] = x; egc[lane] = __expf(x); ekd[lane] = __expf(gl - x);
        if (lane == 63) ((float*)(p.ws + WS_CTL + CTL_EGL))[ch] = __expf(gl);
    }
    __syncthreads();
    {
        const int ti = wid;
#pragma unroll
        for (int tj = 0; tj < 4; ++tj) {
            if (tj <= ti) {
                const f32x4 kk = tile16(Krow, 272, 16 * ti, Krow, 272, 16 * tj, 128);
                const int c2 = 16 * tj + fr;
                f32x4 lv;
#pragma unroll
                for (int r = 0; r < 4; ++r) {
                    const int c1 = 16 * ti + fq * 4 + r;
                    lv[r] = (c1 > c2) ? bet[c1] * kk[r] * __expf(gcs[c1] - gcs[c2]) : 0.f;
                }
                *(f32x4*)&Lf[c2 * 68 + 16 * ti + fq * 4] = lv;
            }
            f32x4 qk = {0.f, 0.f, 0.f, 0.f};
            if (tj <= ti) qk = tile16(Krow, 272, 16 * tj, Qrow, 272, 16 * ti, 128);
            const int c1 = 16 * ti + fr;
            float o4[4];
#pragma unroll
            for (int r = 0; r < 4; ++r) { const int c2 = 16 * tj + fq * 4 + r; o4[r] = (c1 >= c2) ? qk[r] * __expf(gcs[c1] - gcs[c2]) : 0.f; }
            const int mt = c1 >> 5, rr = c1 & 31, hh = fq & 1, jg = fq >> 1;
            u32x2 w; w.x = pack2(o4[0], o4[1]); w.y = pack2(o4[2], o4[3]);
            *(u32x2*)(ops + GO_AF + ((size_t)((mt * 4 + tj) * 64 + hh * 32 + rr) * 8 + jg * 4) * 2) = w;
        }
#pragma unroll
        for (int i = 0; i < 4; ++i) {
            const int idx = tid + i * 256;
            {
                const int mt = idx >> 9, ks = (idx >> 6) & 7, l2 = idx & 63, rr = l2 & 31, hh = l2 >> 5, cc = 32 * mt + rr;
                const float sc = egc[cc];
                const u32x2 lo = *(const u32x2*)(Qrow + cc * 272 + (16 * ks + 4 * hh) * 2), hi = *(const u32x2*)(Qrow + cc * 272 + (16 * ks + 8 + 4 * hh) * 2);
                u32x4 w;
                w.x = pack2(__uint_as_float(lo.x << 16) * sc, __uint_as_float(lo.x & 0xffff0000u) * sc); w.y = pack2(__uint_as_float(lo.y << 16) * sc, __uint_as_float(lo.y & 0xffff0000u) * sc);
                w.z = pack2(__uint_as_float(hi.x << 16) * sc, __uint_as_float(hi.x & 0xffff0000u) * sc); w.w = pack2(__uint_as_float(hi.y << 16) * sc, __uint_as_float(hi.y & 0xffff0000u) * sc);
                *(u32x4*)(ops + GO_QF + (size_t)idx * 16) = w;
            }
            {
                const int mt = idx >> 8, ks = (idx >> 6) & 3, l2 = idx & 63, rr = l2 & 31, hh = l2 >> 5, dk = 32 * mt + rr;
                float e8[8];
#pragma unroll
                for (int j = 0; j < 8; ++j) { const int c2 = 16 * ks + 8 * (j >> 2) + 4 * hh + (j & 3); e8[j] = bf2f(*(const bf16_t*)(Krow + c2 * 272 + dk * 2)) * ekd[c2]; }
                u32x4 w; w.x = pack2(e8[0], e8[1]); w.y = pack2(e8[2], e8[3]); w.z = pack2(e8[4], e8[5]); w.w = pack2(e8[6], e8[7]);
                *(u32x4*)(ops + GO_KF + (size_t)idx * 16) = w;
            }
        }
    }
    __syncthreads();
    {
        const float bc = bet[c], bg = bc * egc[c];
        unsigned kvp[16];
#pragma unroll
        for (int i4 = 0; i4 < 4; ++i4) { const u32x4 w = *(const u32x4*)(Krow + c * 272 + (cq * 32 + i4 * 8) * 2); kvp[i4 * 4] = w.x; kvp[i4 * 4 + 1] = w.y; kvp[i4 * 4 + 2] = w.z; kvp[i4 * 4 + 3] = w.w; }
        __syncthreads();
#pragma unroll
        for (int i = 0; i < 16; ++i) {
            *(bf16_t*)(VbT + (cq * 32 + 2 * i) * 144 + c * 2) = f2bf(__uint_as_float(vvp[i] << 16) * bc);
            *(bf16_t*)(VbT + (cq * 32 + 2 * i + 1) * 144 + c * 2) = f2bf(__uint_as_float(vvp[i] & 0xffff0000u) * bc);
            *(bf16_t*)(KbgT + (cq * 32 + 2 * i) * 144 + c * 2) = f2bf(__uint_as_float(kvp[i] << 16) * bg);
            *(bf16_t*)(KbgT + (cq * 32 + 2 * i + 1) * 144 + c * 2) = f2bf(__uint_as_float(kvp[i] & 0xffff0000u) * bg);
        }
    }
    {
        char* L21i = lds + GP_END;
        char* T11T = L21i + 2560;
        char* MT = T11T + 2560;
        if (wid < 2) {
            const int o = 32 * wid;
            float Tc[32];
#pragma unroll
            for (int i = 0; i < 32; ++i) Tc[i] = (i == (lane & 31)) ? 1.f : 0.f;
#pragma unroll
            for (int j = 0; j < 31; ++j) {
                const float tj = Tc[j];
#pragma unroll
                for (int i4 = (j + 1) >> 2; i4 < 8; ++i4) {
                    const f32x4 l4 = *(const f32x4*)&Lf[(o + j) * 68 + o + i4 * 4];
#pragma unroll
                    for (int e = 0; e < 4; ++e) if (i4 * 4 + e > j) Tc[i4 * 4 + e] -= l4[e] * tj;
                }
            }
            if (lane < 32) {
#pragma unroll
                for (int i = 0; i < 32; ++i) *(bf16_t*)(Trow + (o + i) * 144 + (o + lane) * 2) = f2bf(Tc[i]);
                if (wid == 0) {
#pragma unroll
                    for (int i = 0; i < 32; ++i) *(bf16_t*)(Trow + i * 144 + (32 + lane) * 2) = 0;
#pragma unroll
                    for (int i4 = 0; i4 < 8; ++i4) { u32x2 w; w.x = pack2(Tc[i4 * 4], Tc[i4 * 4 + 1]); w.y = pack2(Tc[i4 * 4 + 2], Tc[i4 * 4 + 3]); *(u32x2*)(T11T + lane * 80 + i4 * 8) = w; }
                }
            }
        } else {
            const int t2 = tid - 128;
#pragma unroll
            for (int g2 = 0; g2 < 2; ++g2) {
                const int i = t2 & 31, k4 = ((t2 >> 5) + 4 * g2) * 4;
                u32x2 w;
                w.x = pack2(Lf[(k4 + 0) * 68 + 32 + i], Lf[(k4 + 1) * 68 + 32 + i]); w.y = pack2(Lf[(k4 + 2) * 68 + 32 + i], Lf[(k4 + 3) * 68 + 32 + i]);
                *(u32x2*)(L21i + i * 80 + k4 * 2) = w;
            }
        }
        __syncthreads();
        {
            const int r0 = 16 * (wid >> 1), c0 = 16 * (wid & 1);
            const f32x4 mm = tile16(L21i, 80, r0, T11T, 80, c0, 32);
            u32x2 w; w.x = pack2(mm[0], mm[1]); w.y = pack2(mm[2], mm[3]);
            *(u32x2*)(MT + (c0 + fr) * 80 + (r0 + 4 * fq) * 2) = w;
        }
        __syncthreads();
        {
            const int r0 = 16 * (wid >> 1), c0 = 16 * (wid & 1);
            const f32x4 tt = tile16(MT, 80, c0, Trow + 32 * 144 + 64, 144, r0, 32);
            u32x2 w; w.x = pack2(-tt[0], -tt[1]); w.y = pack2(-tt[2], -tt[3]);
            *(u32x2*)(Trow + (32 + r0 + fr) * 144 + (c0 + 4 * fq) * 2) = w;
        }
    }
    __syncthreads();
#pragma unroll
    for (int tq = 0; tq < 2; ++tq) {
        const int tj = wid * 2 + tq;
#pragma unroll
        for (int ti = 0; ti < 4; ++ti) {
            const f32x4 u = tile16(Trow, 144, 16 * ti, VbT, 144, 16 * tj, 64);
            {
                const int dv = 16 * tj + fr, slice = dv >> 5, rr = dv & 31, cb = 16 * ti + fq * 4, mt = cb >> 5, q4 = (cb & 31) >> 2, hh = q4 & 1, rg = q4 >> 1;
                u32x2 w; w.x = pack2(u[0], u[1]); w.y = pack2(u[2], u[3]);
                *(u32x2*)(ops + GO_UF + ((size_t)((slice * 2 + mt) * 64 + hh * 32 + rr) * 16 + rg * 4) * 2) = w;
            }
            const f32x4 wv = tile16(KbgT, 144, 16 * tj, Trow, 144, 16 * ti, 64);
            {
                const int c1 = 16 * ti + fr, mt = c1 >> 5, rr = c1 & 31, hh = fq & 1, jg = fq >> 1;
                u32x2 w; w.x = pack2(-wv[0], -wv[1]); w.y = pack2(-wv[2], -wv[3]);
                *(u32x2*)(ops + GO_WF + ((size_t)((mt * 8 + tj) * 64 + hh * 32 + rr) * 8 + jg * 4) * 2) = w;
            }
        }
    }
}

DI void glds16(const void* g, char* l) { __builtin_amdgcn_global_load_lds((const unsigned*)g, (lds_u32*)l, 16, 0, 0); }
#define GS_WAIT(n) asm volatile("s_waitcnt vmcnt(" #n ")" ::: "memory")
DI void gdn_scan_block(const P& p, int bh, char* lds, bool dry = false) {
    const int tid = tidx(), lane = tid & 63, w = tid >> 6;
    const int h = bh & 3, b = bh >> 2;
    const float eglv = ((const float*)(p.ws + WS_CTL + CTL_EGL))[(b * 64 + lane) * 4 + h];
    unsigned char* gbase = p.ws + WS_GOPS + (size_t)(b * 256 + h) * GOPS_CH;
    auto issue = [&](int n, int k0, int cntk) {
        for (int k = k0; k < k0 + cntk; ++k) {
            const unsigned char* src = gbase + (size_t)n * 4 * GOPS_CH + k * 8192 + tid * 16;
            char* dst = lds + k * 8192 + tid * 16;
            glds16(src, dst); glds16(src + 4096, dst + 4096);
        }
    };
    f32x16 S[4];
#pragma unroll
    for (int i = 0; i < 4; ++i)
#pragma unroll
        for (int r = 0; r < 16; ++r) S[i][r] = 0.f;
    __syncthreads();
    issue(0, 0, 7);
#pragma unroll 1
    for (int n = 0; n < 64; ++n) {
        const float egl = __shfl(eglv, n);
        bf16x8 Sb[8];
#pragma unroll
        for (int i = 0; i < 4; ++i) { Sb[i * 2] = pack_step(S[i], 0); Sb[i * 2 + 1] = pack_step(S[i], 1); }
        f32x16 av[2], ao[2];
        const bf16x8* fr0 = (const bf16x8*)lds + lane;
        GS_WAIT(6);
        __builtin_amdgcn_s_barrier();
        issue(n, 7, 2);
        __builtin_amdgcn_sched_barrier(0);
        {
            const char* sl = lds + (w >> 1) * 8192;
#pragma unroll
            for (int mt = 0; mt < 2; ++mt) {
                const u32x4* up = (const u32x4*)(sl + ((w & 1) * 2 + mt) * 2048 + lane * 32);
                const u32x4 u0 = up[0], u1 = up[1];
#pragma unroll
                for (int e = 0; e < 4; ++e) {
                    av[mt][e * 2] = __uint_as_float(u0[e] << 16); av[mt][e * 2 + 1] = __uint_as_float(u0[e] & 0xffff0000u);
                    av[mt][8 + e * 2] = __uint_as_float(u1[e] << 16); av[mt][8 + e * 2 + 1] = __uint_as_float(u1[e] & 0xffff0000u);
                }
            }
        }
#pragma unroll
        for (int ks = 0; ks < 8; ++ks)
#pragma unroll
            for (int mt = 0; mt < 2; ++mt) av[mt] = mfma32(fr0[(2 + mt) * 512 + ks * 64], Sb[ks], av[mt]);
        bf16x8 Vb[4];
#pragma unroll
        for (int mt = 0; mt < 2; ++mt) { Vb[mt * 2] = pack_step(av[mt], 0); Vb[mt * 2 + 1] = pack_step(av[mt], 1); }
        GS_WAIT(4);
        __builtin_amdgcn_s_barrier();
        if (n < 63) issue(n + 1, 0, 4);
        __builtin_amdgcn_sched_barrier(0);
#pragma unroll
        for (int mt = 0; mt < 2; ++mt)
#pragma unroll
            for (int r = 0; r < 16; ++r) ao[mt][r] = 0.f;
#pragma unroll
        for (int ks = 0; ks < 8; ++ks) {
#pragma unroll
            for (int mt = 0; mt < 2; ++mt) ao[mt] = mfma32(fr0[(4 + mt) * 512 + ks * 64], Sb[ks], ao[mt]);
#pragma unroll
            for (int r = 0; r < 8; ++r) S[ks >> 1][(ks & 1) * 8 + r] *= egl;
        }
#pragma unroll
        for (int ks = 0; ks < 4; ++ks) { if (ks < 2) ao[0] = mfma32(fr0[6 * 512 + ks * 64], Vb[ks], ao[0]); ao[1] = mfma32(fr0[6 * 512 + (4 + ks) * 64], Vb[ks], ao[1]); }
        if (n < 63) GS_WAIT(8); else GS_WAIT(0);
        __builtin_amdgcn_s_barrier();
        if (n < 63) issue(n + 1, 4, 3);
        __builtin_amdgcn_sched_barrier(0);
#pragma unroll
        for (int ks = 0; ks < 4; ++ks)
#pragma unroll
            for (int i = 0; i < 4; ++i) S[i] = mfma32(fr0[(7 + (i >> 1)) * 512 + ((i & 1) * 4 + ks) * 64], Vb[ks], S[i]);
        {
            u32x4* Of = (u32x4*)((dry ? p.ws + WS_DUMMY + (size_t)(bh & 15) * 65536 : gbase + (size_t)n * 4 * GOPS_CH) + GO_UF) + (size_t)(w * 2 * 64 + lane) * 2;
#pragma unroll
            for (int mt = 0; mt < 2; ++mt) {
                u32x4 o0, o1;
#pragma unroll
                for (int e = 0; e < 4; ++e) { o0[e] = pack2(ao[mt][e * 2], ao[mt][e * 2 + 1]); o1[e] = pack2(ao[mt][8 + e * 2], ao[mt][8 + e * 2 + 1]); }
                Of[mt * 128] = o0; Of[mt * 128 + 1] = o1;
            }
        }
    }
    __syncthreads();
}

DI void gdn_post_unit(const P& p, int li, int ch) {
    const int tid = tidx();
    const int h = ch & 3, n = (ch >> 2) & 63, b = ch >> 8;
    const int t0 = b * SEQ + n * 64;
    const int c = tid >> 2, cq = tid & 3;
    const bf16_t* Of = (const bf16_t*)(p.ws + WS_GOPS + (size_t)ch * GOPS_CH + GO_UF);
    const bf16_t* proj = (const bf16_t*)(p.ws + WS_PROJ);
    bf16_t* mix = (bf16_t*)(p.ws + WS_PROJ);
    const float* nw = p.in[I_GDNNORM] + li * 128 + cq * 32;
    const int mt = c >> 5, q4 = (c & 31) >> 2, hh = q4 & 1, rg = q4 >> 1, reg = rg * 4 + (c & 3);
    float o[32]; float ss = 0.f;
#pragma unroll
    for (int r = 0; r < 32; ++r) { o[r] = bf2f(Of[(size_t)((cq * 2 + mt) * 64 + hh * 32 + r) * 16 + reg]); ss += o[r] * o[r]; }
    ss += __shfl_xor(ss, 1); ss += __shfl_xor(ss, 2);
    const float rs = rsqrtf(ss * (1.f / 128.f) + 1e-6f);
    const bf16_t* zp = proj + (size_t)(t0 + c) * EVLD + 1536 + h * 128 + cq * 32;
    bf16_t* mp = mix + (size_t)(t0 + c) * EVLD + h * 128 + cq * 32;
#pragma unroll
    for (int i4 = 0; i4 < 4; ++i4) {
        const u32x4 zw = *(const u32x4*)(zp + i4 * 8);
        u32x4 w;
#pragma unroll
        for (int e = 0; e < 4; ++e) {
            const float z0 = __uint_as_float(zw[e] << 16), z1 = __uint_as_float(zw[e] & 0xffff0000u);
            w[e] = pack2(o[i4 * 8 + e * 2] * rs * nw[i4 * 8 + e * 2] * siluf_(z0), o[i4 * 8 + e * 2 + 1] * rs * nw[i4 * 8 + e * 2 + 1] * siluf_(z1));
        }
        *(u32x4*)(mp + i4 * 8) = w;
    }
}


constexpr int RP_Z0 = 0, RP_Z1 = 18432, RP_Z2 = 55296, RP_VEC = 73728, RP_PT = 75008, RP_T11 = 78080, RP_END = 80640;
constexpr int RP_LIN = 0, RP_LW = 25600;
DI void rwkv_prep_unit(const P& p, int li, int ch, char* lds) {
    const int tid = tidx(), lane = tid & 63, wid = tid >> 6, fr = lane & 15, fq = lane >> 4;
    const int h = ch & 7, n = (ch >> 3) & 63, b = ch >> 9;
    const int t0 = b * SEQ + n * 64;
    const bf16_t* proj = (const bf16_t*)(p.ws + WS_PROJ);
    char* Lfc = lds + RP_Z0; float* Lf = (float*)Lfc;
    char* ApT = lds + RP_Z0; char* AkVT = lds + RP_Z0 + 9216;
    char* Arow = lds + RP_Z1; char* Rrow = Arow + 9216; char* Brow = Arow + 18432; char* Krow = Arow + 27648;
    char* Aak = Arow; char* Arb = Rrow; char* Ark = Brow; char* Trow = Krow; char* BhT = Krow; char* VpT = Aak;
    char* AT = lds + RP_Z2; char* VT = AT + 9216; char* KhT = AT;
    float* tot = (float*)(lds + RP_VEC); float* WC = tot + 256;
    char* lin = lds + RP_LIN; char* LWi = lds + RP_LW;
    float* PT = (float*)(lds + RP_PT);
    {
        const float* mu0 = p.in[I_MU] + (size_t)li * 1696;
        if (tid < 48) {
            const int j0 = tid * 4;
            *(float4*)(PT + j0) = j0 < 160 ? *(const float4*)(mu0 + (C_HW - RW0) + j0) : *(const float4*)(p.in[I_VRESMU] + j0 - 160);
        } else if (tid < 48 + 144) {
            const int q = tid - 48, arr = q >> 4, c4 = (q & 15) * 4, chn = h * 64 + c4;
            const float* src = arr == 0 ? mu0 + (C_R - RW0) + chn : arr == 1 ? mu0 + (C_K - RW0) + chn : arr == 2 ? mu0 + (C_V - RW0) + chn
                             : arr == 3 ? p.in[I_W0] + li * 512 + chn : arr == 4 ? p.in[I_A0] + li * 512 + chn : arr == 5 ? p.in[I_V0] + chn
                             : arr == 6 ? p.in[I_KK] + li * 512 + chn : arr == 7 ? p.in[I_KA] + li * 512 + chn : p.in[I_RK] + li * 512 + chn;
            *(float4*)(PT + 192 + arr * 64 + c4) = *(const float4*)src;
        }
    }
    __syncthreads();
    {
        const int c = tid >> 2, cq = tid & 3, s = n * 64 + c;
        const bf16_t* cur = proj + (size_t)(t0 + c) * EVLD + C_HW + cq * 48;
        const float* mu = p.in[I_MU] + (size_t)li * 1696 + (C_HW - RW0);
        const float* vmu = p.in[I_VRESMU];
#pragma unroll
        for (int i6 = 0; i6 < 6; ++i6) {
            const u32x4 cw4 = *(const u32x4*)(cur + i6 * 8);
            u32x4 pw4 = *(const u32x4*)(cur - (s > 0 ? EVLD : 0) + i6 * 8);
            if (s == 0) pw4 = (u32x4){0u, 0u, 0u, 0u};
            const int j0 = cq * 48 + i6 * 8;
            const float4 ma = *(const float4*)(PT + j0), mb = *(const float4*)(PT + j0 + 4);
            const float mm[8] = {ma.x, ma.y, ma.z, ma.w, mb.x, mb.y, mb.z, mb.w};
            const bool is_t = j0 < 32, is_s = (j0 >= 64) && (j0 < 160);
            const float ca = is_t ? 1.f : 0.f, cb = is_t ? -2.f : 1.f, cc = is_t ? 2.f : -1.f;
            u32x4 w;
#pragma unroll
            for (int e = 0; e < 4; ++e) {
                float o2[2];
#pragma unroll
                for (int q = 0; q < 2; ++q) {
                    const float cv = q ? __uint_as_float(cw4[e] & 0xffff0000u) : __uint_as_float(cw4[e] << 16);
                    const float pv = q ? __uint_as_float(pw4[e] & 0xffff0000u) : __uint_as_float(pw4[e] << 16);
                    const float val = cv + mm[e * 2 + q] * (pv - cv);
                    const float act = ca + cb * __builtin_amdgcn_rcpf(1.f + __expf(cc * val));
                    o2[q] = (is_t || is_s) ? act : val;
                }
                w[e] = pack2(o2[0], o2[1]);
            }
            *(u32x4*)(lin + c * 400 + (cq * 48 + i6 * 8) * 2) = w;
        }
        const bf16_t* LW = (const bf16_t*)(p.ws + WS_W + W_LW) + (size_t)h * 64 * 192;
#pragma unroll
        for (int i6 = 0; i6 < 6; ++i6) *(u32x4*)(LWi + c * 400 + (cq * 48 + i6 * 8) * 2) = *(const u32x4*)(LW + (size_t)c * 192 + cq * 48 + i6 * 8);
    }
    __syncthreads();
    float lw_[16], la_[16], lg_[16], lv_[16];
#pragma unroll
    for (int tj = 0; tj < 4; ++tj) {
        const f32x4 a = tile16(LWi, 400, 16 * tj, lin, 400, 16 * wid, 32);
        const f32x4 bq = tile16(LWi + 64, 400, 16 * tj, lin + 64, 400, 16 * wid, 32);
        const f32x4 cg = tile16(LWi + 128, 400, 16 * tj, lin + 128, 400, 16 * wid, 96);
        const f32x4 dv = tile16(LWi + 320, 400, 16 * tj, lin + 320, 400, 16 * wid, 32);
#pragma unroll
        for (int r = 0; r < 4; ++r) { lw_[tj * 4 + r] = a[r]; la_[tj * 4 + r] = bq[r]; lg_[tj * 4 + r] = cg[r]; lv_[tj * 4 + r] = dv[r]; }
    }
    __syncthreads();
    const int c = 16 * wid + fr;
    float at[16], rt[16], bt[16], kt[16], bh[16], kh[16];
    {
        const int s = n * 64 + c;
        const size_t row = (size_t)(t0 + c);
        const float* mu = p.in[I_MU] + (size_t)li * 1696;
        const int hc = h * 64;
        float rr_[16], kk_[16], lwv[16], aa[16];
        float kn = 0.f, rk = 0.f;
        bf16_t* vf = (bf16_t*)(p.ws + WS_VF);
        bf16_t* gg = (bf16_t*)(p.ws + WS_GG);
#pragma unroll
        for (int tj = 0; tj < 4; ++tj) {
            const int cb = 16 * tj + 4 * fq;
            u32x2 cr = *(const u32x2*)(proj + row * EVLD + C_R + hc + cb), ck = *(const u32x2*)(proj + row * EVLD + C_K + hc + cb), cv = *(const u32x2*)(proj + row * EVLD + C_V + hc + cb);
            const size_t prow = s > 0 ? row - 1 : row;
            u32x2 pr = *(const u32x2*)(proj + prow * EVLD + C_R + hc + cb), pk = *(const u32x2*)(proj + prow * EVLD + C_K + hc + cb), pv = *(const u32x2*)(proj + prow * EVLD + C_V + hc + cb);
            if (s == 0) { pr = (u32x2){0u, 0u}; pk = pr; pv = pr; }
            u32x2 vfw = {0u, 0u};
            if (li == 1) vfw = *(const u32x2*)(vf + row * 512 + hc + cb);
            float vout[4], gout[4];
            const int ch0 = hc + cb;
            const float* pt = PT + 192 + cb;
            const float4 mu_r4 = *(const float4*)(pt), mu_k4 = *(const float4*)(pt + 64), mu_v4 = *(const float4*)(pt + 128);
            const float4 w0_4 = *(const float4*)(pt + 192), a0_4 = *(const float4*)(pt + 256), v0_4 = *(const float4*)(pt + 320);
            const float4 kk_4 = *(const float4*)(pt + 384), ka_4 = *(const float4*)(pt + 448), rk_4 = *(const float4*)(pt + 512);
            const float mur[4] = {mu_r4.x, mu_r4.y, mu_r4.z, mu_r4.w}, muk[4] = {mu_k4.x, mu_k4.y, mu_k4.z, mu_k4.w}, muv[4] = {mu_v4.x, mu_v4.y, mu_v4.z, mu_v4.w};
            const float w0v[4] = {w0_4.x, w0_4.y, w0_4.z, w0_4.w}, a0v[4] = {a0_4.x, a0_4.y, a0_4.z, a0_4.w}, v0v[4] = {v0_4.x, v0_4.y, v0_4.z, v0_4.w};
            const float kkp[4] = {kk_4.x, kk_4.y, kk_4.z, kk_4.w}, kap[4] = {ka_4.x, ka_4.y, ka_4.z, ka_4.w}, rkp[4] = {rk_4.x, rk_4.y, rk_4.z, rk_4.w};
#pragma unroll
            for (int r = 0; r < 4; ++r) {
                const int i = tj * 4 + r;
                const unsigned wcr = r < 2 ? cr.x : cr.y, wck = r < 2 ? ck.x : ck.y, wcv = r < 2 ? cv.x : cv.y;
                const unsigned wpr = r < 2 ? pr.x : pr.y, wpk = r < 2 ? pk.x : pk.y, wpv = r < 2 ? pv.x : pv.y, wvf = r < 2 ? vfw.x : vfw.y;
                const float c_r = (r & 1) ? __uint_as_float(wcr & 0xffff0000u) : __uint_as_float(wcr << 16);
                const float c_k = (r & 1) ? __uint_as_float(wck & 0xffff0000u) : __uint_as_float(wck << 16);
                const float c_v = (r & 1) ? __uint_as_float(wcv & 0xffff0000u) : __uint_as_float(wcv << 16);
                const float p_r = (r & 1) ? __uint_as_float(wpr & 0xffff0000u) : __uint_as_float(wpr << 16);
                const float p_k = (r & 1) ? __uint_as_float(wpk & 0xffff0000u) : __uint_as_float(wpk << 16);
                const float p_v = (r & 1) ? __uint_as_float(wpv & 0xffff0000u) : __uint_as_float(wpv << 16);
                const float rm = c_r + mur[r] * (p_r - c_r);
                const float km = c_k + muk[r] * (p_k - c_k);
                float vm = c_v + muv[r] * (p_v - c_v);
                const float wlog = -softplusf_(-(w0v[r] + lw_[i])) - 0.5f;
                lwv[i] = -__expf(wlog);
                const float a = sigmoidf_(a0v[r] + la_[i]);
                if (li == 1) {
                    const float v1 = (r & 1) ? __uint_as_float(wvf & 0xffff0000u) : __uint_as_float(wvf << 16);
                    vm = vm + (v1 - vm) * sigmoidf_(v0v[r] + lv_[i]);
                }
                const float kkv = km * kkp[r];
                kn += kkv * kkv;
                rr_[i] = rm; kk_[i] = kkv; aa[i] = a;
                kt[i] = km * (1.f + (a - 1.f) * kap[r]);
                rk += rm * kt[i] * rkp[r];
                vout[r] = vm; gout[r] = lg_[i];
            }
            u32x2 w; w.x = pack2(vout[0], vout[1]); w.y = pack2(vout[2], vout[3]);
            *(u32x2*)(vf + row * 512 + hc + cb) = w;
            w.x = pack2(gout[0], gout[1]); w.y = pack2(gout[2], gout[3]);
            *(u32x2*)(gg + row * 512 + hc + cb) = w;
#pragma unroll
            for (int r = 0; r < 4; ++r) *(bf16_t*)(VT + (cb + r) * 144 + c * 2) = f2bf(vout[r]);
            __builtin_amdgcn_sched_barrier(0);
        }
        kn += __shfl_xor(kn, 16); kn += __shfl_xor(kn, 32);
        const float kr = rsqrtf(kn + 1e-6f);
        rk += __shfl_xor(rk, 16); rk += __shfl_xor(rk, 32);
        if (fq == 0) ((float*)(p.ws + WS_RK))[row * 8 + h] = rk;
        float cs[16];
#pragma unroll
        for (int i = 0; i < 16; ++i) {
            float x = lwv[i];
#pragma unroll
            for (int o = 1; o < 16; o <<= 1) { const float y = __shfl_up(x, o, 16); if (fr >= o) x += y; }
            cs[i] = x;
        }
        if (fr == 15) {
#pragma unroll
            for (int i = 0; i < 16; ++i) tot[wid * 64 + 16 * (i >> 2) + 4 * fq + (i & 3)] = cs[i];
        }
        __syncthreads();
#pragma unroll
        for (int i = 0; i < 16; ++i) {
            const int chl = 16 * (i >> 2) + 4 * fq + (i & 3);
            float pre = 0.f, all = 0.f;
#pragma unroll
            for (int w2 = 0; w2 < 4; ++w2) { const float tv = tot[w2 * 64 + chl]; all += tv; if (w2 < wid) pre += tv; }
            const float csi = cs[i] + pre, csm = csi - lwv[i];
            const float kkn = kk_[i] * kr, k2 = kt[i];
            const float e_c = __expf(csi), e_n = __builtin_amdgcn_rcpf(e_c), e_m = __expf(csm), e_h = __expf(all) * e_n;
            at[i] = -kkn * e_m; rt[i] = rr_[i] * e_c;
            const float bp = kkn * aa[i];
            bt[i] = bp * e_n; kt[i] = k2 * e_n; bh[i] = bp * e_h; kh[i] = k2 * e_h;
            if (c == 0) WC[chl] = __expf(all);
            if ((i & 3) == 3) __builtin_amdgcn_sched_barrier(0);
        }
    }
#pragma unroll
    for (int tj = 0; tj < 4; ++tj) {
        const int cb = 16 * tj + 4 * fq;
        u32x2 w;
        w.x = pack2(at[tj * 4], at[tj * 4 + 1]); w.y = pack2(at[tj * 4 + 2], at[tj * 4 + 3]); *(u32x2*)(Arow + c * 144 + cb * 2) = w;
        w.x = pack2(rt[tj * 4], rt[tj * 4 + 1]); w.y = pack2(rt[tj * 4 + 2], rt[tj * 4 + 3]); *(u32x2*)(Rrow + c * 144 + cb * 2) = w;
        w.x = pack2(bt[tj * 4], bt[tj * 4 + 1]); w.y = pack2(bt[tj * 4 + 2], bt[tj * 4 + 3]); *(u32x2*)(Brow + c * 144 + cb * 2) = w;
        w.x = pack2(kt[tj * 4], kt[tj * 4 + 1]); w.y = pack2(kt[tj * 4 + 2], kt[tj * 4 + 3]); *(u32x2*)(Krow + c * 144 + cb * 2) = w;
#pragma unroll
        for (int r = 0; r < 4; ++r) {
            *(bf16_t*)(AT + (cb + r) * 144 + c * 2) = f2bf(at[tj * 4 + r]);
        }
    }
    __syncthreads();
    f32x4 pab[4], pak[4], prb[4], prk[4];
    {
        const int ti = wid;
#pragma unroll
        for (int tj = 0; tj < 4; ++tj) {
            pab[tj] = (f32x4){0.f, 0.f, 0.f, 0.f}; pak[tj] = pab[tj]; prb[tj] = pab[tj]; prk[tj] = pab[tj];
            if (tj <= ti) {
                pab[tj] = tile16(Arow, 144, 16 * ti, Brow, 144, 16 * tj, 64);
                pak[tj] = tile16(Krow, 144, 16 * tj, Arow, 144, 16 * ti, 64);
                prb[tj] = tile16(Brow, 144, 16 * tj, Rrow, 144, 16 * ti, 64);
                prk[tj] = tile16(Krow, 144, 16 * tj, Rrow, 144, 16 * ti, 64);
            }
        }
    }
    __syncthreads();
    {
        const int ti = wid;
#pragma unroll
        for (int tj = 0; tj < 4; ++tj) {
            const int s1 = 16 * tj + fr;
            f32x4 lv;
#pragma unroll
            for (int r = 0; r < 4; ++r) { const int t1 = 16 * ti + 4 * fq + r; lv[r] = (s1 < t1) ? -pab[tj][r] : 0.f; }
            *(f32x4*)&Lf[s1 * 72 + 16 * ti + 4 * fq] = lv;
            const int t2 = 16 * ti + fr;
            float m1[4], m2[4], m3[4];
#pragma unroll
            for (int r = 0; r < 4; ++r) { const int s2 = 16 * tj + 4 * fq + r; m1[r] = (s2 < t2) ? pak[tj][r] : 0.f; m2[r] = (s2 <= t2) ? prb[tj][r] : 0.f; m3[r] = (s2 <= t2) ? prk[tj][r] : 0.f; }
            u32x2 w;
            w.x = pack2(m1[0], m1[1]); w.y = pack2(m1[2], m1[3]); *(u32x2*)(Aak + t2 * 144 + (16 * tj + 4 * fq) * 2) = w;
            w.x = pack2(m2[0], m2[1]); w.y = pack2(m2[2], m2[3]); *(u32x2*)(Arb + t2 * 144 + (16 * tj + 4 * fq) * 2) = w;
            w.x = pack2(m3[0], m3[1]); w.y = pack2(m3[2], m3[3]); *(u32x2*)(Ark + t2 * 144 + (16 * tj + 4 * fq) * 2) = w;
        }
    }
    __syncthreads();
    {
        char* L21i = lds + RP_PT;
        char* T11T = lds + RP_T11;
        char* MT = lds + RP_Z0;
        if (wid < 2) {
            const int o = 32 * wid;
            float Tc[32];
#pragma unroll
            for (int i = 0; i < 32; ++i) Tc[i] = (i == (lane & 31)) ? 1.f : 0.f;
#pragma unroll
            for (int j = 0; j < 31; ++j) {
                const float tj = Tc[j];
#pragma unroll
                for (int i4 = (j + 1) >> 2; i4 < 8; ++i4) {
                    const f32x4 l4 = *(const f32x4*)&Lf[(o + j) * 72 + o + i4 * 4];
#pragma unroll
                    for (int e = 0; e < 4; ++e) if (i4 * 4 + e > j) Tc[i4 * 4 + e] -= l4[e] * tj;
                }
            }
            if (lane < 32) {
#pragma unroll
                for (int i = 0; i < 32; ++i) *(bf16_t*)(Trow + (o + i) * 144 + (o + lane) * 2) = f2bf(Tc[i]);
                if (wid == 0) {
#pragma unroll
                    for (int i = 0; i < 32; ++i) *(bf16_t*)(Trow + i * 144 + (32 + lane) * 2) = 0;
#pragma unroll
                    for (int i4 = 0; i4 < 8; ++i4) { u32x2 w; w.x = pack2(Tc[i4 * 4], Tc[i4 * 4 + 1]); w.y = pack2(Tc[i4 * 4 + 2], Tc[i4 * 4 + 3]); *(u32x2*)(T11T + lane * 80 + i4 * 8) = w; }
                }
            }
        } else {
            const int t2 = tid - 128;
#pragma unroll
            for (int g2 = 0; g2 < 2; ++g2) {
                const int i = t2 & 31, k4 = ((t2 >> 5) + 4 * g2) * 4;
                u32x2 w;
                w.x = pack2(Lf[(k4 + 0) * 72 + 32 + i], Lf[(k4 + 1) * 72 + 32 + i]); w.y = pack2(Lf[(k4 + 2) * 72 + 32 + i], Lf[(k4 + 3) * 72 + 32 + i]);
                *(u32x2*)(L21i + i * 80 + k4 * 2) = w;
            }
        }
        __syncthreads();
        {
            const int r0 = 16 * (wid >> 1), c0 = 16 * (wid & 1);
            const f32x4 mm = tile16(L21i, 80, r0, T11T, 80, c0, 32);
            u32x2 w; w.x = pack2(mm[0], mm[1]); w.y = pack2(mm[2], mm[3]);
            *(u32x2*)(MT + (c0 + fr) * 80 + (r0 + 4 * fq) * 2) = w;
        }
        __syncthreads();
        {
            const int r0 = 16 * (wid >> 1), c0 = 16 * (wid & 1);
            const f32x4 tt = tile16(MT, 80, c0, Trow + 32 * 144 + 64, 144, r0, 32);
            u32x2 w; w.x = pack2(-tt[0], -tt[1]); w.y = pack2(-tt[2], -tt[3]);
            *(u32x2*)(Trow + (32 + r0 + fr) * 144 + (c0 + 4 * fq) * 2) = w;
        }
    }
    __syncthreads();
    {
        const int ti = wid;
#pragma unroll
        for (int tj = 0; tj < 4; ++tj) {
            const f32x4 x = tile16(Trow, 144, 16 * ti, AT, 144, 16 * tj, 64);
            const f32x4 y = tile16(Aak, 144, 16 * ti, VT, 144, 16 * tj, 64);
            u32x2 w;
            w.x = pack2(x[0], x[1]); w.y = pack2(x[2], x[3]); *(u32x2*)(ApT + (16 * tj + fr) * 144 + (16 * ti + 4 * fq) * 2) = w;
            w.x = pack2(y[0], y[1]); w.y = pack2(y[2], y[3]); *(u32x2*)(AkVT + (16 * tj + fr) * 144 + (16 * ti + 4 * fq) * 2) = w;
        }
    }
    __syncthreads();
    {
        const int ti = wid;
#pragma unroll
        for (int tj = 0; tj < 4; ++tj) {
            const f32x4 x = tile16(Trow, 144, 16 * ti, AkVT, 144, 16 * tj, 64);
            u32x2 w; w.x = pack2(x[0], x[1]); w.y = pack2(x[2], x[3]); *(u32x2*)(VpT + (16 * tj + fr) * 144 + (16 * ti + 4 * fq) * 2) = w;
        }
    }
    __syncthreads();
#pragma unroll
    for (int tj = 0; tj < 4; ++tj)
#pragma unroll
        for (int r = 0; r < 4; ++r) {
            const int cb = 16 * tj + 4 * fq + r;
            *(bf16_t*)(BhT + cb * 144 + c * 2) = f2bf(bh[tj * 4 + r]);
            *(bf16_t*)(KhT + cb * 144 + c * 2) = f2bf(kh[tj * 4 + r]);
        }
    __syncthreads();
    {
        unsigned char* opsA = p.ws + WS_HN + (size_t)ch * 16384;
        unsigned char* opsB = p.ws + WS_ROPS + (size_t)ch * 16384;
        const int ti = wid;
#pragma unroll
        for (int tj = 0; tj < 4; ++tj) {
            const f32x4 x = tile16(ApT, 144, 16 * tj, Arb, 144, 16 * ti, 64);
            const f32x4 g = tile16(ApT, 144, 16 * tj, BhT, 144, 16 * ti, 64);
            const int m1 = 16 * ti + fr, mt = m1 >> 5, rr = m1 & 31, hh = fq & 1, jg = fq >> 1;
            const size_t off = ((size_t)((mt * 4 + tj) * 64 + hh * 32 + rr) * 8 + jg * 4) * 2;
            float gd[4];
#pragma unroll
            for (int r = 0; r < 4; ++r) gd[r] = g[r] + ((16 * tj + 4 * fq + r == m1) ? WC[m1] : 0.f);
            u32x2 w;
            w.x = pack2(x[0] + rt[tj * 4], x[1] + rt[tj * 4 + 1]); w.y = pack2(x[2] + rt[tj * 4 + 2], x[3] + rt[tj * 4 + 3]); *(u32x2*)(opsA + off) = w;
            w.x = pack2(gd[0], gd[1]); w.y = pack2(gd[2], gd[3]); *(u32x2*)(opsA + 8192 + off) = w;
            f32x4 y = tile16(Ark, 144, 16 * ti, VT, 144, 16 * tj, 64);
            const f32x4 y2 = tile16(Arb, 144, 16 * ti, VpT, 144, 16 * tj, 64);
            f32x4 kv = tile16(KhT, 144, 16 * ti, VT, 144, 16 * tj, 64);
            const f32x4 kv2 = tile16(BhT, 144, 16 * ti, VpT, 144, 16 * tj, 64);
            const int vcol = 16 * tj + fr, slice = vcol >> 5, r2 = vcol & 31, cb = 16 * ti + 4 * fq, mt2 = cb >> 5, q4 = (cb & 31) >> 2, h2 = q4 & 1, rg = q4 >> 1;
            const size_t off2 = ((size_t)((slice * 2 + mt2) * 64 + h2 * 32 + r2) * 16 + rg * 4) * 2;
            w.x = pack2(y[0] + y2[0], y[1] + y2[1]); w.y = pack2(y[2] + y2[2], y[3] + y2[3]); *(u32x2*)(opsB + off2) = w;
            w.x = pack2(kv[0] + kv2[0], kv[1] + kv2[1]); w.y = pack2(kv[2] + kv2[2], kv[3] + kv2[3]); *(u32x2*)(opsB + 8192 + off2) = w;
        }
    }
}

DI void rwkv_scan_block(const P& p, int bh, char* lds, bool dry = false) {
    const int tid = tidx(), lane = tid & 63, w = tid >> 6, slice = w & 1;
    const int h = bh & 7, b = bh >> 3;
    constexpr int NST = 64 * 2, AH = 3;
    auto issue = [&](int j) {
        const int n = j >> 1, k = j & 1;
        const size_t ch = (size_t)((b * 64 + n) * 8 + h) * 16384;
        const unsigned char* s0 = (k == 0 ? p.ws + WS_ROPS + ch + 8192 : p.ws + WS_ROPS + ch) + tid * 16;
        const unsigned char* s1 = (k == 0 ? p.ws + WS_HN + ch + 8192 : p.ws + WS_HN + ch) + tid * 16;
        char* dst = lds + (j & 3) * 16384 + tid * 16;
        glds16(s0, dst); glds16(s0 + 4096, dst + 4096); glds16(s1, dst + 8192); glds16(s1 + 4096, dst + 12288);
    };
    f32x16 H[2];
#pragma unroll
    for (int i = 0; i < 2; ++i)
#pragma unroll
        for (int r = 0; r < 16; ++r) H[i][r] = 0.f;
    __syncthreads();
#pragma unroll
    for (int j = 0; j < AH; ++j) issue(j);
#pragma unroll 1
    for (int n = 0; n < 64; ++n) {
        bf16x8 Hb[4];
#pragma unroll
        for (int i = 0; i < 2; ++i) { Hb[i * 2] = pack_step(H[i], 0); Hb[i * 2 + 1] = pack_step(H[i], 1); }
#pragma unroll
        for (int k = 0; k < 2; ++k) {
            const int j = n * 2 + k;
            if (n < 63) GS_WAIT(8); else if (k == 0) GS_WAIT(4); else GS_WAIT(0);
            __builtin_amdgcn_s_barrier();
            if (j + AH < NST) issue(j + AH);
            __builtin_amdgcn_sched_barrier(0);
            const char* sl = lds + (j & 3) * 16384;
            if (w < 2) {
                f32x16 acc[2];
#pragma unroll
                for (int mt = 0; mt < 2; ++mt) {
                    const u32x4* up = (const u32x4*)(sl + (slice * 2 + mt) * 2048 + lane * 32);
                    const u32x4 u0 = up[0], u1 = up[1];
#pragma unroll
                    for (int e = 0; e < 4; ++e) {
                        acc[mt][e * 2] = __uint_as_float(u0[e] << 16); acc[mt][e * 2 + 1] = __uint_as_float(u0[e] & 0xffff0000u);
                        acc[mt][8 + e * 2] = __uint_as_float(u1[e] << 16); acc[mt][8 + e * 2 + 1] = __uint_as_float(u1[e] & 0xffff0000u);
                    }
                }
                const bf16x8* fr = (const bf16x8*)(sl + 8192) + lane;
                bf16x8 f8[8];
#pragma unroll
                for (int q = 0; q < 8; ++q) f8[q] = fr[q * 64];
#pragma unroll
                for (int ks = 0; ks < 4; ++ks)
#pragma unroll
                    for (int mt = 0; mt < 2; ++mt) acc[mt] = mfma32(f8[mt * 4 + ks], Hb[ks], acc[mt]);
                if (k == 0) { H[0] = acc[0]; H[1] = acc[1]; }
                else {
                    const size_t ch = (size_t)((b * 64 + n) * 8 + h) * 16384;
                    u32x4* Yf = (u32x4*)(dry ? p.ws + WS_DUMMY + 2097152 + (size_t)(bh & 31) * 16384 : p.ws + WS_ROPS + ch) + (size_t)(slice * 128 + lane) * 2;
#pragma unroll
                    for (int mt = 0; mt < 2; ++mt) {
                        u32x4 o0, o1;
#pragma unroll
                        for (int e = 0; e < 4; ++e) { o0[e] = pack2(acc[mt][e * 2], acc[mt][e * 2 + 1]); o1[e] = pack2(acc[mt][8 + e * 2], acc[mt][8 + e * 2 + 1]); }
                        Yf[mt * 128] = o0; Yf[mt * 128 + 1] = o1;
                    }
                }
            }
        }
    }
    __syncthreads();
}

DI void rwkv_post_unit(const P& p, int li, int ch) {
    const int tid = tidx();
    const int h = ch & 7, n = (ch >> 3) & 63, b = ch >> 9;
    const int t0 = b * SEQ + n * 64;
    const int c = tid >> 2, cq = tid & 3;
    const bf16_t* Yf = (const bf16_t*)(p.ws + WS_ROPS + (size_t)ch * 16384);
    const bf16_t* vf = (const bf16_t*)(p.ws + WS_VF) + (size_t)(t0 + c) * 512 + h * 64 + cq * 16;
    const bf16_t* gg = (const bf16_t*)(p.ws + WS_GG) + (size_t)(t0 + c) * 512 + h * 64 + cq * 16;
    const float rk = ((const float*)(p.ws + WS_RK))[(size_t)(t0 + c) * 8 + h];
    const float* lnw = p.in[I_LNW] + li * 512 + h * 64 + cq * 16;
    const float* lnb = p.in[I_LNB] + li * 512 + h * 64 + cq * 16;
    bf16_t* mp = (bf16_t*)(p.ws + WS_HN) + (size_t)(t0 + c) * 1024 + 512 + h * 64 + cq * 16;
    const int mt = c >> 5, q4 = (c & 31) >> 2, hh = q4 & 1, rg = q4 >> 1, reg = rg * 4 + (c & 3), slice = cq >> 1, rb = (cq & 1) * 16;
    float y[16]; float sm = 0.f;
#pragma unroll
    for (int i = 0; i < 16; ++i) { y[i] = bf2f(Yf[(size_t)((slice * 2 + mt) * 64 + hh * 32 + rb + i) * 16 + reg]); sm += y[i]; }
    sm += __shfl_xor(sm, 1); sm += __shfl_xor(sm, 2);
    const float mean = sm * (1.f / 64.f);
    float vs = 0.f;
#pragma unroll
    for (int i = 0; i < 16; ++i) { y[i] -= mean; vs += y[i] * y[i]; }
    vs += __shfl_xor(vs, 1); vs += __shfl_xor(vs, 2);
    const float rs = rsqrtf(vs * (1.f / 64.f) + 64e-5f);
#pragma unroll
    for (int i8 = 0; i8 < 2; ++i8) {
        const u32x4 vw = *(const u32x4*)(vf + i8 * 8), gw = *(const u32x4*)(gg + i8 * 8);
        u32x4 w;
#pragma unroll
        for (int e = 0; e < 4; ++e) {
            const int i = i8 * 8 + e * 2;
            const float v0 = __uint_as_float(vw[e] << 16), v1 = __uint_as_float(vw[e] & 0xffff0000u), g0 = __uint_as_float(gw[e] << 16), g1 = __uint_as_float(gw[e] & 0xffff0000u);
            w[e] = pack2((y[i] * rs * lnw[i] + lnb[i] + rk * v0) * g0, (y[i + 1] * rs * lnw[i + 1] + lnb[i + 1] + rk * v1) * g1);
        }
        *(u32x4*)(mp + i8 * 8) = w;
    }
}


DI void attn_unit(const P& p, int unit, char* lds) {
    const int tid = tidx(), lane = tid & 63, w = tid >> 6, r_ = lane & 31, hl = lane >> 5;
    const int idx = unit & 31, h = (unit >> 5) & 7, g = (unit >> 8) % 3, b = unit / 768;
    const int lg2 = g * 2, dil = 1 << lg2, L = SEQ >> lg2, ntl = L >> 7;
    const int rs = idx / ntl, qt = idx % ntl;
    const int hg = g * 8 + h;
    const bf16_t* QK = (const bf16_t*)(p.ws + WS_QK);
    const bf16_t* VT = (const bf16_t*)(p.ws + WS_VT) + ((size_t)((b * 24 + hg) * dil + rs) * 64) * L;
    const int qi = 32 * w + r_;
    const int q_idx = 128 * qt + qi;
    const size_t qrow = (size_t)(b * SEQ + q_idx * dil + rs);
    const int kbase0 = 128 * qt - 128;
    char* Kt = lds;
    char* Vt = lds + 32768;
    __syncthreads();
#pragma unroll
    for (int i = 0; i < 8; ++i) {
        const int id = tid + i * 256, row = id >> 3, pc = id & 7, c = pc ^ ((row >> 1) & 7);
        int k_idx = kbase0 + row; if (k_idx < 0) k_idx = 0;
        glds16(QK + (size_t)(b * SEQ + k_idx * dil + rs) * 3072 + 1536 + hg * 64 + c * 8, Kt + id * 16);
    }
#pragma unroll
    for (int i = 0; i < 8; ++i) {
        const int id = tid + i * 256, row = id >> 5, pq = id & 31, q = pq ^ (row & 31);
        int k0 = kbase0 + q * 8; if (k0 < 0) k0 = 0;
        glds16(VT + (size_t)row * L + k0, Vt + id * 16);
    }
    bf16x8 qf[4];
#pragma unroll
    for (int ks = 0; ks < 4; ++ks) qf[ks] = *(const bf16x8*)(QK + qrow * 3072 + hg * 64 + 16 * ks + 8 * hl);
    asm volatile("s_waitcnt vmcnt(0)" ::: "memory");
    __syncthreads();
    f32x16 st[5];
    float mx = -1.0e30f;
#pragma unroll
    for (int kbi = 0; kbi < 5; ++kbi) {
        const int krow = 32 * (w + kbi) + r_;
#pragma unroll
        for (int r = 0; r < 16; ++r) st[kbi][r] = 0.f;
#pragma unroll
        for (int ks = 0; ks < 4; ++ks) {
            const bf16x8 kf = *(const bf16x8*)(Kt + krow * 128 + (((2 * ks + hl) ^ ((krow >> 1) & 7)) * 16));
            st[kbi] = mfma32(kf, qf[ks], st[kbi]);
        }
#pragma unroll
        for (int r = 0; r < 16; ++r) {
            const int kj = 32 * (w + kbi) + (r & 3) + 8 * (r >> 2) + 4 * hl;
            const bool valid = (kj >= qi) && (kj <= qi + 128) && (kbase0 + kj >= 0);
            const float sv = valid ? st[kbi][r] * 0.125f : -1.0e30f;
            st[kbi][r] = sv; mx = fmaxf(mx, sv);
        }
    }
    mx = fmaxf(mx, __shfl_xor(mx, 32));
    float l = 0.f;
#pragma unroll
    for (int kbi = 0; kbi < 5; ++kbi)
#pragma unroll
        for (int r = 0; r < 16; ++r) { const float pv = __expf(st[kbi][r] - mx); st[kbi][r] = pv; l += pv; }
    l += __shfl_xor(l, 32);
    f32x16 ot[2];
#pragma unroll
    for (int dt = 0; dt < 2; ++dt)
#pragma unroll
        for (int r = 0; r < 16; ++r) ot[dt][r] = 0.f;
#pragma unroll
    for (int kbi = 0; kbi < 5; ++kbi)
#pragma unroll
        for (int s2 = 0; s2 < 2; ++s2) {
            const bf16x8 pb = pack_step(st[kbi], s2);
            const int q0 = 4 * (w + kbi) + 2 * s2;
#pragma unroll
            for (int dt = 0; dt < 2; ++dt) {
                const int drow = 32 * dt + r_;
                const u32x2 lo = *(const u32x2*)(Vt + drow * 512 + ((q0 ^ (drow & 31)) * 16) + 8 * hl);
                const u32x2 hi = *(const u32x2*)(Vt + drow * 512 + (((q0 + 1) ^ (drow & 31)) * 16) + 8 * hl);
                u32x4 vw; vw.x = lo.x; vw.y = lo.y; vw.z = hi.x; vw.w = hi.y;
                ot[dt] = mfma32(__builtin_bit_cast(bf16x8, vw), pb, ot[dt]);
            }
        }
    const float inv = 1.f / l;
    bf16_t* og = (bf16_t*)(p.ws + WS_OG) + ((size_t)g * T + qrow) * 512 + h * 64;
#pragma unroll
    for (int dt = 0; dt < 2; ++dt)
#pragma unroll
        for (int rg = 0; rg < 4; ++rg) {
            u32x2 wv; wv.x = pack2(ot[dt][rg * 4] * inv, ot[dt][rg * 4 + 1] * inv); wv.y = pack2(ot[dt][rg * 4 + 2] * inv, ot[dt][rg * 4 + 3] * inv);
            *(u32x2*)(og + 32 * dt + 8 * rg + 4 * hl) = wv;
        }
    if (hl == 0) ((float*)(p.ws + WS_LSE))[((size_t)g * T + qrow) * 8 + h] = mx + __logf(l);
}
DI void phase_attn_merge(const P& p) {
    const bf16_t* og = (const bf16_t*)(p.ws + WS_OG);
    const float* lse = (const float*)(p.ws + WS_LSE);
    bf16_t* o = (bf16_t*)(p.ws + WS_HN);
    for (int i = bidx() * 256 + tidx(); i < T * 64; i += gridDim.x * 256) {
        const int t = i >> 6, c8 = i & 63, h = c8 >> 3;
        const float l0 = lse[(size_t)t * 8 + h], l1 = lse[((size_t)T + t) * 8 + h], l2 = lse[((size_t)2 * T + t) * 8 + h];
        const float m = fmaxf(l0, fmaxf(l1, l2));
        float w0 = __expf(l0 - m), w1 = __expf(l1 - m), w2 = __expf(l2 - m);
        const float inv = 1.f / (w0 + w1 + w2); w0 *= inv; w1 *= inv; w2 *= inv;
        const u32x4 a = *(const u32x4*)(og + (size_t)t * 512 + c8 * 8), bq = *(const u32x4*)(og + ((size_t)T + t) * 512 + c8 * 8), cq = *(const u32x4*)(og + ((size_t)2 * T + t) * 512 + c8 * 8);
        u32x4 r;
#pragma unroll
        for (int e = 0; e < 4; ++e) {
            const float x0 = w0 * __uint_as_float(a[e] << 16) + w1 * __uint_as_float(bq[e] << 16) + w2 * __uint_as_float(cq[e] << 16);
            const float x1 = w0 * __uint_as_float(a[e] & 0xffff0000u) + w1 * __uint_as_float(bq[e] & 0xffff0000u) + w2 * __uint_as_float(cq[e] & 0xffff0000u);
            r[e] = pack2(x0, x1);
        }
        *(u32x4*)(o + (size_t)t * 512 + c8 * 8) = r;
    }
}


#define XB_TMO      128
#define XB_XCNT(j)  (256  + 64 * (j))
#define XB_XSUB(j)  (1280 + 64 * (j))
#define XB_XGEN(j)  (2304 + 64 * (j))
#define XB_TOP      3328
#define XB_TOPGEN   3392
#define XCD_BAR_WORDS 3456
#define XB_SPIN_CAP (1u << 22)
#define LAS __attribute__((address_space(3)))
DI unsigned xb_ld(unsigned* p)              { return __hip_atomic_load(p, __ATOMIC_RELAXED, __HIP_MEMORY_SCOPE_AGENT); }
DI unsigned xb_add(unsigned* p, unsigned v) { return __hip_atomic_fetch_add(p, v, __ATOMIC_RELAXED, __HIP_MEMORY_SCOPE_AGENT); }
DI unsigned xb_xcc_id() { return (unsigned)__builtin_amdgcn_s_getreg((3 << 11) | 20) & 0xFu; }
#define XB_SPIN(cond, bar) do { unsigned _sp = 0; while (cond) { if (_sp < 32u) __builtin_amdgcn_s_sleep(2); else __builtin_amdgcn_s_sleep(24); \
    if ((++_sp & 255u) == 0u) { if (xb_ld(&(bar)[XB_TMO])) break; if (_sp > XB_SPIN_CAP) { atomicAdd(&(bar)[XB_TMO], 1u); break; } } } } while (0)
struct XcdBarrier { unsigned* bar; unsigned x; volatile LAS unsigned* st; };
DI XcdBarrier xcd_barrier_post(unsigned* bar, volatile LAS unsigned* st) {
    XcdBarrier b; b.bar = bar; b.x = xb_xcc_id(); b.st = st;
    if (threadIdx.x == 0) (void)xb_add(&bar[XB_XCNT(b.x)], 1u);
    return b;
}
DI void xcd_barrier_complete(unsigned* bar, unsigned x, unsigned& nloc, unsigned& nx) {
    const unsigned G = gridDim.x * gridDim.y * gridDim.z;
    unsigned sum, cnt, mine, sp = 0u;
    for (;;) {
        sum = 0u; cnt = 0u; mine = 0u;
#pragma unroll
        for (unsigned j = 0; j < 16; ++j) { const unsigned c = xb_ld(&bar[XB_XCNT(j)]); sum += c; cnt += (c > 0u) ? 1u : 0u; mine = (j == x) ? c : mine; }
        if (sum == G) break;
        __builtin_amdgcn_s_sleep(1);
        if ((++sp & 255u) == 0u) { if (xb_ld(&bar[XB_TMO])) break; if (sp > XB_SPIN_CAP) { atomicAdd(&bar[XB_TMO], 1u); break; } }
    }
    nloc = mine > 0u ? mine : 1u; nx = cnt > 0u ? cnt : 1u;
}
DI void xcd_barrier(const XcdBarrier& b) {
    asm volatile("s_waitcnt vmcnt(0)" ::: "memory");
    __syncthreads();
    if (threadIdx.x == 0) {
        unsigned* bar = b.bar;
        __builtin_amdgcn_s_waitcnt(0);
        unsigned nloc = b.st[0], nx = b.st[1];
        if (nloc == 0u) { xcd_barrier_complete(bar, b.x, nloc, nx); b.st[0] = nloc; b.st[1] = nx; }
        const unsigned old = xb_add(&bar[XB_XSUB(b.x)], 1u);
        const unsigned gen = old / nloc;
        if (old + 1u == (gen + 1u) * nloc) {
            __builtin_amdgcn_fence(__ATOMIC_RELEASE, "agent");
            asm volatile("s_waitcnt vmcnt(0)" ::: "memory");
            const unsigned og = xb_add(&bar[XB_TOP], 1u);
            const unsigned tg = og / nx;
            if (og + 1u == (tg + 1u) * nx) xb_add(&bar[XB_TOPGEN], 1u);
            else XB_SPIN(xb_ld(&bar[XB_TOPGEN]) == tg, bar);
            __builtin_amdgcn_fence(__ATOMIC_ACQUIRE, "agent");
            xb_add(&bar[XB_XGEN(b.x)], 1u);
            asm volatile("s_waitcnt vmcnt(0)" ::: "memory");
        } else {
            XB_SPIN(xb_ld(&bar[XB_XGEN(b.x)]) == gen, bar);
            __builtin_amdgcn_fence(__ATOMIC_ACQUIRE, "agent");
            asm volatile("s_waitcnt vmcnt(0)" ::: "memory");
        }
    }
    __syncthreads();
}

constexpr int LDS_BYTES = RP_END;
static_assert(GP_END + 6144 <= LDS_BYTES, "LDS");
__global__ void __launch_bounds__(256, 2) mega(P p) {
    cg::grid_group grid = cg::this_grid();
    extern __shared__ __attribute__((aligned(16))) char lds[];
    if (threadIdx.x < 4) ((volatile LAS unsigned*)(lds + LDS_BYTES))[threadIdx.x] = 0u;
    __syncthreads();
    const XcdBarrier xb = xcd_barrier_post((unsigned*)(p.ws + WS_CTL + CTL_BAR), (volatile LAS unsigned*)(lds + LDS_BYTES));
#define GSYNC() xcd_barrier(xb)
    const bf16_t* HN = (const bf16_t*)(p.ws + WS_HN);
    const bf16_t* Win = (const bf16_t*)(p.ws + WS_W + W_IN);
    const bf16_t* Wout = (const bf16_t*)(p.ws + WS_W + W_OUT);
    phase_rope(p);
    phase_convert_io(p, 0, lds);
    phase_prep<0>(p, p.in[I_EVNORM], 0);
    if (p.ws == nullptr) grid.sync();
    GSYNC();
    volatile LAS unsigned* qword = (volatile LAS unsigned*)(lds + LDS_BYTES + 8);
    for (int layer = 0; layer < 4; ++layer) {
        const int li = layer >> 1;
        if ((layer & 1) == 0) {
            phase_gemm<EPI_EVEN_IN>(p, HN, 1024, Win, 1024, EVPAD / 128, lds);
            GSYNC();
            for (int u = bidx(); u < 1024; u += gridDim.x) gdn_prep_unit(p, li, u, lds);
            GSYNC();
            if (bidx() < 16) gdn_scan_block(p, bidx(), lds);
            {
                unsigned* qctr = (unsigned*)(p.ws + WS_CTL + CTL_QUEUE) + li * 64;
                for (;;) {
                    __syncthreads();
                    if (threadIdx.x == 0) *qword = atomicAdd(qctr, 1u);
                    __syncthreads();
                    const unsigned u = *qword;
                    if (u >= 2048u) break;
                    rwkv_prep_unit(p, li, (int)u, lds);
                }
            }
            GSYNC();
            if (bidx() < 32) rwkv_scan_block(p, bidx(), lds);
            else {
                for (int u = bidx() - 32; u < 1024; u += gridDim.x - 32) gdn_post_unit(p, li, u);
                phase_convert_moe(p, layer, lds, bidx() - 32, gridDim.x - 32);
            }
            GSYNC();
            for (int u = bidx(); u < 2048; u += gridDim.x) rwkv_post_unit(p, li, u);
            GSYNC();
            phase_gemm<EPI_RESID>(p, (const bf16_t*)(p.ws + WS_PROJ), EVLD, Wout, 1024, 8, lds, false, HN, 1024, 512);
        } else {
            phase_gemm<EPI_ODD_IN>(p, HN, 1024, Win, 1024, ODC / 128, lds);
            GSYNC();
            for (int u = bidx(); u < 3072; u += gridDim.x) attn_unit(p, u, lds);
            GSYNC();
            phase_attn_merge(p);
            GSYNC();
            phase_gemm<EPI_RESID>(p, HN, 512, Wout, 512, 8, lds);
        }
        GSYNC();
        phase_router(p, p.in[I_FFNNORM] + layer * 1024, layer, lds);
        GSYNC();
        phase_moe_up(p, layer, lds);
        GSYNC();
        phase_moe_down(p, layer, lds);
        GSYNC();
        if (layer < 3) {
            phase_convert_io(p, layer + 1, lds);
            if ((layer + 1) & 1) phase_convert_moe(p, layer + 1, lds, bidx(), gridDim.x);
            phase_prep<1>(p, ((layer + 1) & 1) ? p.in[I_ODNORM] + ((layer + 1) >> 1) * 1024 : p.in[I_EVNORM] + ((layer + 1) >> 1) * 1024, layer + 1);
            GSYNC();
        }
    }
    phase_prep<3>(p, p.in[I_FINAL], 0);
}

extern "C" void kernel_launch(void* const* d_in, const int* in_sizes, int n_in, void* d_out, int out_size, void* d_ws, size_t ws_size, hipStream_t stream) {
    if (n_in != 34 || out_size != T * D || ws_size < WS_END) { fprintf(stderr, "kernel_launch: unexpected shapes (n_in %d out %d ws %zu need %zu)\n", n_in, out_size, ws_size, (size_t)WS_END); return; }
    static int grid_blocks = 0;
    if (!grid_blocks) {
        int dev = 0, cus = 0, per_cu = 0;
        (void)hipGetDevice(&dev);
        (void)hipDeviceGetAttribute(&cus, hipDeviceAttributeMultiprocessorCount, dev);
        (void)hipFuncSetAttribute((const void*)mega, hipFuncAttributeMaxDynamicSharedMemorySize, LDS_BYTES + 16);
        (void)hipOccupancyMaxActiveBlocksPerMultiprocessor(&per_cu, mega, 256, LDS_BYTES + 16);
        if (per_cu < 1) per_cu = 1;
        if (per_cu > 2) per_cu = 2;
        grid_blocks = cus * per_cu;
    }
    P p{};
    for (int i = 0; i < 34; ++i) p.in[i] = (const float*)d_in[i];
    p.out = (float*)d_out; p.ws = (unsigned char*)d_ws;
    (void)hipMemsetAsync((char*)d_ws + WS_CTL, 0, 65536, stream);
    void* args[] = {&p};
    hipError_t e = hipLaunchCooperativeKernel((void*)mega, dim3(grid_blocks), dim3(256), args, LDS_BYTES + 16, stream);
    if (e != hipSuccess) fprintf(stderr, "cooperative launch failed: %s (grid %d)\n", hipGetErrorString(e), grid_blocks);
}
```

```cpp
#include <hip/hip_runtime.h>
#include <cstdio>
#include <cstdint>
#include <cmath>
#include <hip/hip_cooperative_groups.h>
namespace cg = cooperative_groups;

typedef unsigned short bf16_t;
typedef short bf16x8 __attribute__((ext_vector_type(8)));
typedef float f32x4 __attribute__((ext_vector_type(4)));
typedef unsigned u32x4 __attribute__((ext_vector_type(4)));
typedef unsigned u32x2 __attribute__((ext_vector_type(2)));
#define DI __device__ __forceinline__

constexpr int T = 16384, SEQ = 4096, BATCH = 4, D = 1024;
constexpr int EVC = 3784, EVLD = 3784, EVPAD = 3840;
constexpr int ODC = 4608;
constexpr int RW0 = 2056;
constexpr int C_R = 2056, C_K = 2568, C_V = 3080, C_HW = 3592, C_HA = 3624, C_HG = 3656, C_HV = 3752;
constexpr int NEXP = 16, FF = 256;
constexpr int HROWS = 34816;

constexpr size_t WS_CTL = 0;
constexpr size_t CTL_EGL = 4096;
constexpr size_t CTL_QUEUE = 49152;
constexpr size_t CTL_CNT = 32768;
constexpr size_t CTL_BAR = 16384;
constexpr size_t WS_LIST = 65536;
constexpr size_t WS_GATE = WS_LIST + 16 * 16384 * 4;
constexpr size_t WS_RK = WS_GATE + 16 * 16384 * 4;
constexpr size_t WS_SSQ = WS_RK + (size_t)T * 8 * 4;
constexpr size_t WS_ROPE = WS_SSQ + (size_t)16 * T * 4;
constexpr size_t WS_W = WS_ROPE + (size_t)T * 32 * 8;
constexpr size_t W_IN = 0;
constexpr size_t W_OUT = (size_t)4608 * 1024 * 2;
constexpr size_t W_13 = W_OUT + (size_t)1024 * 1024 * 2;
constexpr size_t W_2 = W_13 + (size_t)16 * 512 * 1024 * 2;
constexpr size_t W_LW = W_2 + (size_t)16 * 1024 * 256 * 2;
constexpr size_t W_BYTES = W_LW + (size_t)512 * 192 * 2;
constexpr size_t WS_HN = WS_W + W_BYTES;
constexpr size_t WS_VF = WS_HN + (size_t)T * 1024 * 2;
constexpr size_t WS_R2 = WS_VF + (size_t)T * 512 * 2;
constexpr size_t WS_PROJ = WS_R2;
constexpr size_t WS_GOPS = WS_R2 + (size_t)T * EVLD * 2;
constexpr size_t GOPS_CH = 73728, GO_UF = 0, GO_WF = 16384, GO_QF = 32768, GO_AF = 49152, GO_KF = 57344;
constexpr size_t WS_ROPS = WS_GOPS + 1024 * GOPS_CH;
constexpr size_t WS_QK = WS_R2;
constexpr size_t WS_VT = WS_QK + (size_t)T * 3072 * 2;
constexpr size_t WS_OG = WS_VT + (size_t)T * 1536 * 2;
constexpr size_t WS_LSE = WS_OG + (size_t)3 * T * 512 * 2;
constexpr size_t WS_END3 = WS_LSE + (size_t)3 * T * 8 * 4;
constexpr size_t WS_YS = WS_R2;
constexpr size_t WS_H = WS_YS + (size_t)2 * T * 1024 * 2;
constexpr size_t WS_GG = WS_ROPS + (size_t)2048 * 16384;
constexpr size_t WS_END0 = WS_GG + (size_t)T * 512 * 2;
constexpr size_t WS_END1 = WS_H + (size_t)HROWS * 256 * 2;
constexpr size_t WS_END2 = WS_R2 + (size_t)T * 4608 * 2;
static_assert(WS_END3 <= WS_END0, "odd-layer regions exceed even-layer footprint");
constexpr size_t WS_END = WS_END0 > WS_END1 ? (WS_END0 > WS_END2 ? WS_END0 : WS_END2) : (WS_END1 > WS_END2 ? WS_END1 : WS_END2);

constexpr size_t WS_DUMMY = WS_END0;
struct P {
    const float* in[34];
    float* out;
    unsigned char* ws;
};
enum { I_X = 0, I_POS, I_EVNORM, I_EVWIN, I_VRESDOWN, I_EVWOUT, I_CONVW, I_ALOG, I_DTB, I_GDNNORM, I_MU, I_W0, I_W2, I_A0, I_A2, I_G2,
       I_KK, I_KA, I_RK, I_LNW, I_LNB, I_VRESMU, I_V0, I_V2, I_ODNORM, I_ODWIN, I_ODWOUT, I_FFNNORM, I_WGROUP, I_WEXPERT, I_W1, I_W3, I_MW2, I_FINAL };

DI int tidx() { int t = threadIdx.x; asm volatile("" : "+v"(t)); return t; }
DI int bidx() { int b = blockIdx.x; asm volatile("" : "+s"(b)); return b; }
typedef __bf16 bf2_t __attribute__((ext_vector_type(2)));
typedef float f2_t __attribute__((ext_vector_type(2)));
DI bf16_t f2bf(float x) { return __builtin_bit_cast(bf16_t, (__bf16)x); }
DI float bf2f(bf16_t h) { return __uint_as_float(((unsigned)h) << 16); }
DI unsigned pack2(float lo, float hi) { const f2_t v = {lo, hi}; return __builtin_bit_cast(unsigned, __builtin_convertvector(v, bf2_t)); }
DI float wave_sum(float v) {
#pragma unroll
    for (int o = 32; o > 0; o >>= 1) v += __shfl_xor(v, o);
    return v;
}
DI float wave_max(float v) {
#pragma unroll
    for (int o = 32; o > 0; o >>= 1) v = fmaxf(v, __shfl_xor(v, o));
    return v;
}
DI float sigmoidf_(float x) { return __builtin_amdgcn_rcpf(1.f + __expf(-x)); }
DI float siluf_(float x) { return x * __builtin_amdgcn_rcpf(1.f + __expf(-x)); }
DI float softplusf_(float x) { return fmaxf(x, 0.f) + __logf(1.f + __expf(-fabsf(x))); }

struct ConvJob { const float* src; bf16_t* dst; int K, N, ldd; int mode; };
DI int rowmap(int mode, int n) { return mode == 0 ? n : ((n >> 4) * 32 + (n & 15) + (mode == 2 ? 16 : 0)); }
DI void conv_tile(const ConvJob& j, int tile, float* lds  ) {
    const int ntn = (j.N + 255) / 256;
    const int tk = tile / ntn, tn = tile % ntn;
    const int tid = tidx();
    __syncthreads();
    float4 v[16];
#pragma unroll
    for (int i = 0; i < 16; ++i) {
        const int e = tid + i * 256, k = e >> 6, n4 = (e & 63) * 4;
        const int gk = tk * 64 + k, gn = tn * 256 + n4;
        v[i] = make_float4(0.f, 0.f, 0.f, 0.f);
        if (gn < j.N) v[i] = *(const float4*)(j.src + (size_t)gk * j.N + gn);
    }
#pragma unroll
    for (int i = 0; i < 16; ++i) { const int e = tid + i * 256, k = e >> 6, n4 = (e & 63) * 4; *(float4*)(lds + k * 260 + n4) = v[i]; }
    __syncthreads();
#pragma unroll
    for (int i = 0; i < 8; ++i) {
        const int e = tid + i * 256, n = e & 255, k8 = (e >> 8) * 8;
        const int gn = tn * 256 + n;
        if (gn < j.N) {
            u32x4 w;
            w.x = pack2(lds[(k8 + 0) * 260 + n], lds[(k8 + 1) * 260 + n]); w.y = pack2(lds[(k8 + 2) * 260 + n], lds[(k8 + 3) * 260 + n]);
            w.z = pack2(lds[(k8 + 4) * 260 + n], lds[(k8 + 5) * 260 + n]); w.w = pack2(lds[(k8 + 6) * 260 + n], lds[(k8 + 7) * 260 + n]);
            *(u32x4*)(j.dst + (size_t)rowmap(j.mode, gn) * j.ldd + tk * 64 + k8) = w;
        }
    }
}
DI void phase_convert_io(const P& p, int layer, char* ldsc) {
    float* lds = (float*)ldsc;
    unsigned char* W = p.ws + WS_W;
    const int li = layer >> 1;
    if ((layer & 1) == 0) {
        const ConvJob j0{p.in[I_EVWIN] + (size_t)li * 1024 * 3752, (bf16_t*)(W + W_IN), 1024, 3752, 1024, 0};
        for (int t = bidx(); t < 16 * 15; t += gridDim.x) conv_tile(j0, t, lds);
        if (li == 1) {
            const ConvJob j1{p.in[I_VRESDOWN], (bf16_t*)(W + W_IN) + (size_t)3752 * 1024, 1024, 32, 1024, 0};
            for (int t = bidx(); t < 16; t += gridDim.x) conv_tile(j1, t, lds);
        }
        const ConvJob j2{p.in[I_EVWOUT] + (size_t)li * 1024 * 1024, (bf16_t*)(W + W_OUT), 1024, 1024, 1024, 0};
        for (int t = bidx(); t < 16 * 4; t += gridDim.x) conv_tile(j2, t, lds);
        {
            bf16_t* LW = (bf16_t*)(W + W_LW);
            for (int i = bidx() * 256 + tidx(); i < 512 * 192; i += gridDim.x * 256) {
                const int ch = i / 192, j = i % 192;
                float v;
                if (j < 32) v = p.in[I_W2][((size_t)li * 32 + j) * 512 + ch];
                else if (j < 64) v = p.in[I_A2][((size_t)li * 32 + j - 32) * 512 + ch];
                else if (j < 160) v = p.in[I_G2][((size_t)li * 96 + j - 64) * 512 + ch];
                else v = (li == 1) ? p.in[I_V2][(size_t)(j - 160) * 512 + ch] : 0.f;
                LW[i] = f2bf(v);
            }
        }
        const int r0 = (li == 1) ? 3784 : 3752;
        bf16_t* z = (bf16_t*)(W + W_IN) + (size_t)r0 * 1024;
        const size_t n = (size_t)(EVPAD - r0) * 1024;
        for (size_t i = (size_t)bidx() * 256 + tidx(); i < n; i += (size_t)gridDim.x * 256) z[i] = 0;
    } else {
        const ConvJob j0{p.in[I_ODWIN] + (size_t)li * 1024 * 4608, (bf16_t*)(W + W_IN), 1024, 4608, 1024, 0};
        for (int t = bidx(); t < 16 * 18; t += gridDim.x) conv_tile(j0, t, lds);
        const ConvJob j2{p.in[I_ODWOUT] + (size_t)li * 512 * 1024, (bf16_t*)(W + W_OUT), 512, 1024, 512, 0};
        for (int t = bidx(); t < 8 * 4; t += gridDim.x) conv_tile(j2, t, lds);
    }
}
DI void phase_convert_moe(const P& p, int layer, char* ldsc, int b0, int bs) {
    float* lds = (float*)ldsc;
    unsigned char* W = p.ws + WS_W;
    for (int t = b0; t < 16 * 3 * 16; t += bs) {
        const int e = t / 48, r = t % 48, which = r / 16, tile = r % 16;
        ConvJob j;
        if (which == 0) j = ConvJob{p.in[I_W1] + ((size_t)layer * 16 + e) * 1024 * 256, (bf16_t*)(W + W_13) + (size_t)e * 512 * 1024, 1024, 256, 1024, 1};
        else if (which == 1) j = ConvJob{p.in[I_W3] + ((size_t)layer * 16 + e) * 1024 * 256, (bf16_t*)(W + W_13) + (size_t)e * 512 * 1024, 1024, 256, 1024, 2};
        else j = ConvJob{p.in[I_MW2] + ((size_t)layer * 16 + e) * 256 * 1024, (bf16_t*)(W + W_2) + (size_t)e * 1024 * 256, 256, 1024, 256, 0};
        conv_tile(j, tile, lds);
    }
}

DI void phase_rope(const P& p) {
    float2* tab = (float2*)(p.ws + WS_ROPE);
    const int* pos = (const int*)p.in[I_POS];
    for (int i = bidx() * 256 + tidx(); i < T * 32; i += gridDim.x * 256) {
        const int t = i >> 5, f = i & 31;
        const float inv = powf(10000.0f, -(float)f * (2.0f / 64.0f));
        const float ang = (float)pos[t] * inv;
        float s, c; sincosf(ang, &s, &c);
        tab[i] = make_float2(c, s);
    }
}

template <int MODE>
DI void phase_prep(const P& p, const float* gain, int layer, bool dry = false) {
    const int lane = tidx() & 63, wid = tidx() >> 6;
    const int nw = gridDim.x * 4;
    bf16_t* hn = (bf16_t*)(p.ws + WS_HN);
    const bf16_t* y0 = (const bf16_t*)(p.ws + WS_YS);
    const bf16_t* y1 = y0 + (size_t)T * 1024;
    float4 gq[4];
#pragma unroll
    for (int i = 0; i < 4; ++i) gq[i] = *(const float4*)(gain + i * 256 + lane * 4);
    for (int t = bidx() * 4 + wid; t < T; t += nw) {
        float4 v[4];
        float ss = 0.f;
#pragma unroll
        for (int i = 0; i < 4; ++i) {
            const size_t off = (size_t)t * 1024 + i * 256 + lane * 4;
            if (MODE == 0) v[i] = *(const float4*)(p.in[I_X] + off);
            else v[i] = *(const float4*)(p.out + off);
            if (MODE == 1 || MODE == 3) {
                const u32x2 a = *(const u32x2*)(y0 + off), b = *(const u32x2*)(y1 + off);
                v[i].x += __uint_as_float(a.x << 16) + __uint_as_float(b.x << 16); v[i].y += __uint_as_float(a.x & 0xffff0000u) + __uint_as_float(b.x & 0xffff0000u);
                v[i].z += __uint_as_float(a.y << 16) + __uint_as_float(b.y << 16); v[i].w += __uint_as_float(a.y & 0xffff0000u) + __uint_as_float(b.y & 0xffff0000u);
            }
            ss += v[i].x * v[i].x + v[i].y * v[i].y + v[i].z * v[i].z + v[i].w * v[i].w;
        }
        ss = wave_sum(ss);
        const float rstd = rsqrtf(ss * (1.0f / 1024.0f) + 1e-6f);
        float lg[20];
        if (MODE == 2) {
#pragma unroll
            for (int q = 0; q < 20; ++q) lg[q] = 0.f;
        }
#pragma unroll
        for (int i = 0; i < 4; ++i) {
            const int col = i * 256 + lane * 4;
            const size_t off = (size_t)t * 1024 + col;
            const float4 g = gq[i];
            float4 h; h.x = v[i].x * rstd * g.x; h.y = v[i].y * rstd * g.y; h.z = v[i].z * rstd * g.z; h.w = v[i].w * rstd * g.w;
            float* od = dry ? (float*)(p.ws + WS_DUMMY) + (off & 0x7FFFF) : p.out + off;
            bf16_t* hd = dry ? (bf16_t*)(p.ws + WS_DUMMY + 2097152) + (off & 0x7FFFF) : hn + off;
            if (MODE == 0 || MODE == 1) *(float4*)od = v[i];
            if (MODE == 3) *(float4*)od = h;
            else { u32x2 w; w.x = pack2(h.x, h.y); w.y = pack2(h.z, h.w); *(u32x2*)hd = w; }
            if (MODE == 2) {
                const float hh[4] = {h.x, h.y, h.z, h.w};
                const float* wg = p.in[I_WGROUP] + (size_t)layer * 1024 * 4;
                const float* we = p.in[I_WEXPERT] + (size_t)layer * 4 * 1024 * 4;
#pragma unroll
                for (int e = 0; e < 4; ++e) {
                    const float4 a = *(const float4*)(wg + (size_t)(col + e) * 4);
                    lg[0] += hh[e] * a.x; lg[1] += hh[e] * a.y; lg[2] += hh[e] * a.z; lg[3] += hh[e] * a.w;
#pragma unroll
                    for (int g2 = 0; g2 < 4; ++g2) {
                        const float4 b = *(const float4*)(we + ((size_t)g2 * 1024 + col + e) * 4);
                        lg[4 + g2 * 4 + 0] += hh[e] * b.x; lg[4 + g2 * 4 + 1] += hh[e] * b.y; lg[4 + g2 * 4 + 2] += hh[e] * b.z; lg[4 + g2 * 4 + 3] += hh[e] * b.w;
                    }
                }
            }
        }
        if (MODE == 2) {
#pragma unroll
            for (int q = 0; q < 20; ++q) lg[q] = wave_sum(lg[q]);
            if (lane == 0) {
                int gs = 0; float gm = lg[0];
#pragma unroll
                for (int g2 = 1; g2 < 4; ++g2) if (lg[g2] > gm) { gm = lg[g2]; gs = g2; }
                float den = 0.f;
#pragma unroll
                for (int g2 = 0; g2 < 4; ++g2) den += __expf(lg[g2] - gm);
                const float pg = 1.f / den;
                float el[4];
#pragma unroll
                for (int e = 0; e < 4; ++e) el[e] = gs == 0 ? lg[4 + e] : gs == 1 ? lg[8 + e] : gs == 2 ? lg[12 + e] : lg[16 + e];
                int i1 = 0; float v1 = el[0];
#pragma unroll
                for (int e = 1; e < 4; ++e) if (el[e] > v1) { v1 = el[e]; i1 = e; }
                int i2 = 0; float v2 = -3.4e38f;
#pragma unroll
                for (int e = 0; e < 4; ++e) if (e != i1 && el[e] > v2) { v2 = el[e]; i2 = e; }
                const float e2 = __expf(v2 - v1);
                const float g1 = pg / (1.f + e2), g2v = pg * e2 / (1.f + e2);
                unsigned* cnt = (unsigned*)(p.ws + WS_CTL + CTL_CNT) + layer * 16 * 64;
                int* list = (int*)(p.ws + WS_LIST);
                float* gl = (float*)(p.ws + WS_GATE);
                const int ea = gs * 4 + i1, eb = gs * 4 + i2;
                const unsigned ra = atomicAdd(&cnt[ea * 64], 1u);
                list[ea * 16384 + ra] = t * 2; gl[ea * 16384 + ra] = g1;
                const unsigned rb = atomicAdd(&cnt[eb * 64], 1u);
                list[eb * 16384 + rb] = t * 2 + 1; gl[eb * 16384 + rb] = g2v;
            }
        }
    }
}


DI void phase_router(const P& p, const float* gain, int layer, char* ldsc, bool dry = false) {
    const int tid = tidx(), lane = tid & 63, wid = tid >> 6;
    bf16_t* hn = (bf16_t*)(p.ws + WS_HN);
    const float* wg = p.in[I_WGROUP] + (size_t)layer * 1024 * 4;
    const float* we = p.in[I_WEXPERT] + (size_t)layer * 4 * 1024 * 4;
    unsigned* cnt = dry ? (unsigned*)(p.ws + WS_DUMMY + 3145728) : (unsigned*)(p.ws + WS_CTL + CTL_CNT) + layer * 16 * 64;
    int* list = dry ? (int*)(p.ws + WS_DUMMY) : (int*)(p.ws + WS_LIST);
    float* gl = dry ? (float*)(p.ws + WS_DUMMY + 1048576) : (float*)(p.ws + WS_GATE);
    if (dry) hn = (bf16_t*)(p.ws + WS_DUMMY + 2097152);
    f32x4* WS = (f32x4*)ldsc;
    unsigned* lcnt = (unsigned*)(ldsc + 40960); unsigned* lbase = lcnt + 16; int* e_ent = (int*)(lcnt + 32); unsigned* r_ent = (unsigned*)(e_ent + 32); int* t_ent = (int*)(r_ent + 32); float* g_ent = (float*)(t_ent + 32);
    auto stage = [&](int i, int buf) {
#pragma unroll
        for (int r = 0; r < 5; ++r) {
            const int kk = tid;
            const float* src = (r == 0 ? wg : we + (size_t)(r - 1) * 4096) + (size_t)(i * 256 + kk) * 4;
            WS[buf * 1280 + (r * 4 + (kk & 3)) * 64 + (kk >> 2)] = *(const f32x4*)src;
        }
    };
    for (int tb = bidx() * 16; tb < T; tb += gridDim.x * 16) {
        __syncthreads();
        if (tid < 16) lcnt[tid] = 0u;
        stage(0, 0);
        const int t0 = tb + wid * 4;
        float rstd[4];
        {
            const float pq = ((const float*)(p.ws + WS_SSQ))[(size_t)(lane & 15) * T + t0 + (lane >> 4)];
            float ss = pq;
            ss += __shfl_xor(ss, 1); ss += __shfl_xor(ss, 2); ss += __shfl_xor(ss, 4); ss += __shfl_xor(ss, 8);
#pragma unroll
            for (int q = 0; q < 4; ++q) rstd[q] = rsqrtf(__shfl(ss, q * 16) * (1.0f / 1024.0f) + 1e-6f);
        }
        float lg[4][20];
#pragma unroll
        for (int q = 0; q < 4; ++q)
#pragma unroll
            for (int j = 0; j < 20; ++j) lg[q][j] = 0.f;
#pragma unroll 1
        for (int i = 0; i < 4; ++i) {
            __syncthreads();
            if (i + 1 < 4) stage(i + 1, (i + 1) & 1);
            const f32x4* W = WS + (i & 1) * 1280;
            const int col = i * 256 + lane * 4;
            const float4 g = *(const float4*)(gain + col);
            float hh[4][4];
#pragma unroll
            for (int q = 0; q < 4; ++q) {
                const float4 x4 = *(const float4*)(p.out + (size_t)(t0 + q) * 1024 + col);
                hh[q][0] = x4.x * rstd[q] * g.x; hh[q][1] = x4.y * rstd[q] * g.y; hh[q][2] = x4.z * rstd[q] * g.z; hh[q][3] = x4.w * rstd[q] * g.w;
                u32x2 w; w.x = pack2(hh[q][0], hh[q][1]); w.y = pack2(hh[q][2], hh[q][3]);
                *(u32x2*)(hn + (dry ? (((size_t)(t0 + q) * 1024 + col) & 0x7FFFF) : ((size_t)(t0 + q) * 1024 + col))) = w;
            }
#pragma unroll
            for (int e = 0; e < 4; ++e) {
                const f32x4 a = W[(0 * 4 + e) * 64 + lane];
#pragma unroll
                for (int q = 0; q < 4; ++q) { lg[q][0] += hh[q][e] * a[0]; lg[q][1] += hh[q][e] * a[1]; lg[q][2] += hh[q][e] * a[2]; lg[q][3] += hh[q][e] * a[3]; }
#pragma unroll
                for (int g2 = 0; g2 < 4; ++g2) {
                    const f32x4 b = W[((1 + g2) * 4 + e) * 64 + lane];
#pragma unroll
                    for (int q = 0; q < 4; ++q) { lg[q][4 + g2 * 4] += hh[q][e] * b[0]; lg[q][5 + g2 * 4] += hh[q][e] * b[1]; lg[q][6 + g2 * 4] += hh[q][e] * b[2]; lg[q][7 + g2 * 4] += hh[q][e] * b[3]; }
                }
            }
        }
#pragma unroll
        for (int q = 0; q < 4; ++q) {
#pragma unroll
            for (int j = 0; j < 20; ++j) lg[q][j] = wave_sum(lg[q][j]);
            if (lane == q) {
                const int t = t0 + q;
                int gs = 0; float gm = lg[q][0];
#pragma unroll
                for (int g2 = 1; g2 < 4; ++g2) if (lg[q][g2] > gm) { gm = lg[q][g2]; gs = g2; }
                float den = 0.f;
#pragma unroll
                for (int g2 = 0; g2 < 4; ++g2) den += __expf(lg[q][g2] - gm);
                const float pg = 1.f / den;
                float el[4];
#pragma unroll
                for (int e = 0; e < 4; ++e) el[e] = gs == 0 ? lg[q][4 + e] : gs == 1 ? lg[q][8 + e] : gs == 2 ? lg[q][12 + e] : lg[q][16 + e];
                int i1 = 0; float v1 = el[0];
#pragma unroll
                for (int e = 1; e < 4; ++e) if (el[e] > v1) { v1 = el[e]; i1 = e; }
                int i2 = 0; float v2 = -3.4e38f;
#pragma unroll
                for (int e = 0; e < 4; ++e) if (e != i1 && el[e] > v2) { v2 = el[e]; i2 = e; }
                const float e2 = __expf(v2 - v1);
                const float g1 = pg / (1.f + e2), g2v = pg * e2 / (1.f + e2);
                const int ea = gs * 4 + i1, eb = gs * 4 + i2;
                const int sl = (wid * 4 + q) * 2;
                e_ent[sl] = ea; r_ent[sl] = atomicAdd(&lcnt[ea], 1u); t_ent[sl] = t * 2; g_ent[sl] = g1;
                e_ent[sl + 1] = eb; r_ent[sl + 1] = atomicAdd(&lcnt[eb], 1u); t_ent[sl + 1] = t * 2 + 1; g_ent[sl + 1] = g2v;
            }
        }
        __syncthreads();
        if (tid < 16) lbase[tid] = lcnt[tid] ? atomicAdd(&cnt[tid * 64], lcnt[tid]) : 0u;
        __syncthreads();
        if (tid < 32) {
            const int e = e_ent[tid];
            const unsigned pos = (lbase[e] + r_ent[tid]) & 16383u;
            list[e * 16384 + pos] = t_ent[tid]; gl[e * 16384 + pos] = g_ent[tid];
        }
    }
}

constexpr int GBK = 64;
typedef __attribute__((address_space(3))) unsigned lds_u32;
struct TileP { int arow[4]; unsigned bo[4]; };
struct GOps { const char* A; unsigned la; const char* A2; unsigned la2; const char* B; };
DI void gemm_core(const GOps& o, const TileP& tp, int K, char* lds, f32x4 (&acc)[4][4], int ksplit, bool primed, const TileP& nx, bool have_nx) {
    const int tid = tidx(), wid = tid >> 6, lane = tid & 63, wr = wid >> 1, wc = wid & 1, fr = lane & 15, fq = lane >> 4;
    const unsigned scol = ((tid & 7) ^ ((tid >> 3) & 7)) * 16;
#pragma unroll
    for (int n = 0; n < 4; ++n)
#pragma unroll
        for (int m = 0; m < 4; ++m) acc[n][m] = (f32x4){0.f, 0.f, 0.f, 0.f};
    const int nk = K / GBK;
    if (!primed) {
        __syncthreads();
#pragma unroll
        for (int i = 0; i < 4; ++i) {
            __builtin_amdgcn_global_load_lds((const unsigned*)(o.A + (__umul24(tp.arow[i], o.la) + scol)), (lds_u32*)(lds + tid * 16 + i * 4096), 16, 0, 0);
            __builtin_amdgcn_global_load_lds((const unsigned*)(o.B + (tp.bo[i] + scol)), (lds_u32*)(lds + 16384 + tid * 16 + i * 4096), 16, 0, 0);
        }
    }
    const int sw = fr & 7;
    const unsigned aoff = (wr * 64 + fr) * 128, boff = (wc * 64 + fr) * 128, co0 = (fq ^ sw) * 16, co1 = ((4 + fq) ^ sw) * 16;
    bf16x8 a0[4], b0[4], a1[4], b1[4];
#define G_ISSUE(kt_)                                                                                                                        \
    if ((kt_) + 1 < nk) {                                                                                                                   \
        char* nb = lds + (((kt_) + 1) & 1) * 32768;                                                                                         \
        const unsigned ko = ((kt_) + 1) * (GBK * 2) + scol;                                                                                 \
        const bool hi = ((kt_) + 1) * GBK >= ksplit;                                                                                        \
        const char* Ab = hi ? o.A2 : o.A; const unsigned la = hi ? o.la2 : o.la;                                                            \
        _Pragma("unroll") for (int i = 0; i < 4; ++i) {                                                                                     \
            __builtin_amdgcn_global_load_lds((const unsigned*)(Ab + (__umul24(tp.arow[i], la) + ko)), (lds_u32*)(nb + tid * 16 + i * 4096), 16, 0, 0);   \
            __builtin_amdgcn_global_load_lds((const unsigned*)(o.B + (tp.bo[i] + ko)), (lds_u32*)(nb + 16384 + tid * 16 + i * 4096), 16, 0, 0);      \
        }                                                                                                                                   \
    } else if (have_nx) {        \
        _Pragma("unroll") for (int i = 0; i < 4; ++i) {                                                                                     \
            __builtin_amdgcn_global_load_lds((const unsigned*)(o.A + (__umul24(nx.arow[i], o.la) + scol)), (lds_u32*)(lds + tid * 16 + i * 4096), 16, 0, 0);          \
            __builtin_amdgcn_global_load_lds((const unsigned*)(o.B + (nx.bo[i] + scol)), (lds_u32*)(lds + 16384 + tid * 16 + i * 4096), 16, 0, 0);  \
        }                                                                                                                                   \
    }
#define G_READ(A_, B_, AD_)                                                                                                                 \
    asm volatile("ds_read_b128 %0, %8\n\tds_read_b128 %1, %8 offset:2048\n\tds_read_b128 %2, %8 offset:4096\n\tds_read_b128 %3, %8 offset:6144\n\t"       \
                 "ds_read_b128 %4, %9 offset:16384\n\tds_read_b128 %5, %9 offset:18432\n\tds_read_b128 %6, %9 offset:20480\n\tds_read_b128 %7, %9 offset:22528" \
                 : "=&v"(A_[0]), "=&v"(A_[1]), "=&v"(A_[2]), "=&v"(A_[3]), "=&v"(B_[0]), "=&v"(B_[1]), "=&v"(B_[2]), "=&v"(B_[3]) : "v"((AD_) + aoff), "v"((AD_) + boff) : "memory");
#define G_WAIT(A_, B_, N_)                                                                                                                  \
    asm volatile("s_waitcnt lgkmcnt(" #N_ ")" : "+v"(A_[0]), "+v"(A_[1]), "+v"(A_[2]), "+v"(A_[3]), "+v"(B_[0]), "+v"(B_[1]), "+v"(B_[2]), "+v"(B_[3]) :: "memory");
#define G_MMA(A_, B_)                                                                                                                       \
    _Pragma("unroll") for (int n = 0; n < 4; ++n)                                                                                           \
        _Pragma("unroll") for (int m = 0; m < 4; ++m) acc[n][m] = __builtin_amdgcn_mfma_f32_16x16x32_bf16(B_[n], A_[m], acc[n][m], 0, 0, 0);
    const unsigned lbase = (unsigned)(size_t)(lds_u32*)lds;
    __builtin_amdgcn_s_waitcnt(0x0070);
    __builtin_amdgcn_s_barrier();
    G_ISSUE(0)
    G_READ(a0, b0, lbase + co0)
    G_READ(a1, b1, lbase + co1)
    G_WAIT(a0, b0, 8)
    __builtin_amdgcn_sched_barrier(0);
    G_MMA(a0, b0)
    __builtin_amdgcn_sched_barrier(0);
    G_WAIT(a1, b1, 0)
#pragma unroll 1
    for (int kt = 1; kt < nk; ++kt) {
        __builtin_amdgcn_s_waitcnt(0x0070);
        __builtin_amdgcn_s_barrier();
        G_ISSUE(kt)
        const unsigned S = lbase + (kt & 1) * 32768;
        G_READ(a0, b0, S + co0)
        __builtin_amdgcn_sched_barrier(0);
        G_MMA(a1, b1)
        __builtin_amdgcn_sched_barrier(0);
        G_READ(a1, b1, S + co1)
        G_WAIT(a0, b0, 8)
        __builtin_amdgcn_sched_barrier(0);
        G_MMA(a0, b0)
        __builtin_amdgcn_sched_barrier(0);
        G_WAIT(a1, b1, 0)
    }
    G_MMA(a1, b1)
#undef G_ISSUE
#undef G_READ
#undef G_WAIT
#undef G_MMA
}

enum { EPI_EVEN_IN = 0, EPI_ODD_IN, EPI_RESID };
template <int EPI>
DI void phase_gemm(const P& p, const bf16_t* A, int lda, const bf16_t* Bt, int K, int ntn, char* lds, bool dry = false, const bf16_t* A2 = nullptr, int lda2 = 0, int ksplit = 1 << 30) {
    const int tid = tidx(), wid = tid >> 6, lane = tid & 63, wr = wid >> 1, wc = wid & 1, fr = lane & 15, fq = lane >> 4;
    const int ntm = T / 128, ntiles = ntm * ntn;
    auto fill = [&](TileP& t, int tile) {
        const int tn = tile / ntm, tm = tile % ntm, r = tid >> 3;
#pragma unroll
        for (int i = 0; i < 4; ++i) { t.arow[i] = tm * 128 + r + 32 * i; t.bo[i] = (unsigned)(tn * 128 + r + 32 * i) * (unsigned)(K * 2); }
    };
    const GOps gop{(const char*)A, (unsigned)lda * 2u, (const char*)(A2 ? A2 : A), (unsigned)(A2 ? lda2 : lda) * 2u, (const char*)Bt};
    TileP cur, nxt;
    bool primed = false;
    fill(cur, bidx() < ntiles ? bidx() : 0); nxt = cur;
    for (int tile = bidx(); tile < ntiles; tile += gridDim.x) {
        const int tn = tile / ntm, tm = tile % ntm;
        const bool have_next = tile + (int)gridDim.x < ntiles;
        if (have_next) fill(nxt, tile + gridDim.x);
        f32x4 acc[4][4];
        gemm_core(gop, cur, K, lds, acc, ksplit, primed, nxt, have_next);
        primed = have_next; cur = nxt;
        const int m0 = tm * 128 + wr * 64, n0 = tn * 128 + wc * 64;
        if (EPI == EPI_EVEN_IN) {
            bf16_t* C = (bf16_t*)(p.ws + WS_PROJ);
#pragma unroll
            for (int m = 0; m < 4; ++m)
#pragma unroll
                for (int n = 0; n < 4; ++n) {
                    const int row = m0 + m * 16 + fr, col = n0 + n * 16 + fq * 4;
                    if (col < EVC) { u32x2 w; w.x = pack2(acc[n][m][0], acc[n][m][1]); w.y = pack2(acc[n][m][2], acc[n][m][3]); *(u32x2*)(C + (size_t)row * EVLD + col) = w; }
                }
        } else if (EPI == EPI_ODD_IN) {
            bf16_t* C = (bf16_t*)(p.ws + WS_QK);
            const float2* tab = (const float2*)(p.ws + WS_ROPE);
            if (n0 < 3072) {
#pragma unroll
                for (int m = 0; m < 4; ++m) {
                    const int row = m0 + m * 16 + fr;
#pragma unroll
                    for (int n = 0; n < 2; ++n) {
                        float lo[4], hi[4];
#pragma unroll
                        for (int j = 0; j < 4; ++j) {
                            const float2 cs = tab[(size_t)row * 32 + n * 16 + fq * 4 + j];
                            const float x1 = acc[n][m][j], x2 = acc[n + 2][m][j];
                            lo[j] = x1 * cs.x - x2 * cs.y; hi[j] = x2 * cs.x + x1 * cs.y;
                        }
                        u32x2 w; w.x = pack2(lo[0], lo[1]); w.y = pack2(lo[2], lo[3]);
                        *(u32x2*)(C + (size_t)row * 3072 + n0 + n * 16 + fq * 4) = w;
                        w.x = pack2(hi[0], hi[1]); w.y = pack2(hi[2], hi[3]);
                        *(u32x2*)(C + (size_t)row * 3072 + n0 + (n + 2) * 16 + fq * 4) = w;
                    }
                }
            }
            if (tn * 128 >= 3072) {
                bf16_t* VT = (bf16_t*)(p.ws + WS_VT);
                const int hg0 = (tn * 128 - 3072) >> 6, g = hg0 >> 3, lg2 = g * 2, dil = 1 << lg2, L = SEQ >> lg2, run = 128 >> lg2;
                __syncthreads();
#pragma unroll
                for (int m = 0; m < 4; ++m)
#pragma unroll
                    for (int n = 0; n < 4; ++n)
#pragma unroll
                        for (int j = 0; j < 4; ++j)
                            *(bf16_t*)(lds + 32768 + (wc * 64 + n * 16 + fq * 4 + j) * 272 + (wr * 64 + m * 16 + fr) * 2) = f2bf(acc[n][m][j]);
                __syncthreads();
                const int bb = (tm * 128) >> 12, s0 = (tm * 128) & (SEQ - 1);
#pragma unroll
                for (int q = 0; q < 8; ++q) {
                    const int item = tid + q * 256, dim = item >> 4, o0 = (item & 15) * 8;
                    const int rr = o0 / run, i0 = o0 % run;
                    const char* src = lds + 32768 + dim * 272 + (rr + dil * i0) * 2;
                    float e8[8];
#pragma unroll
                    for (int e = 0; e < 8; ++e) e8[e] = bf2f(*(const bf16_t*)(src + e * dil * 2));
                    u32x4 w; w.x = pack2(e8[0], e8[1]); w.y = pack2(e8[2], e8[3]); w.z = pack2(e8[4], e8[5]); w.w = pack2(e8[6], e8[7]);
                    const int hg = hg0 + (dim >> 6);
                    *(u32x4*)(VT + ((size_t)((bb * 24 + hg) * dil + rr) * 64 + (dim & 63)) * L + (s0 >> lg2) + i0) = w;
                }
            }
        } else {
            float* ssq = (float*)(p.ws + WS_SSQ) + (size_t)(tn * 2 + wc) * T;
#pragma unroll
            for (int m = 0; m < 4; ++m) {
                float ss = 0.f;
#pragma unroll
                for (int n = 0; n < 4; ++n) {
                    const size_t qo = (size_t)(m0 + m * 16 + fr) * 1024 + n0 + n * 16 + fq * 4;
                    float* q = dry ? (float*)(p.ws + WS_DUMMY) + (qo & 0x7FFFF) : p.out + qo;
                    float4 v = *(float4*)q;
                    v.x += acc[n][m][0]; v.y += acc[n][m][1]; v.z += acc[n][m][2]; v.w += acc[n][m][3];
                    *(float4*)q = v;
                    ss += v.x * v.x + v.y * v.y + v.z * v.z + v.w * v.w;
                }
                ss += __shfl_xor(ss, 16); ss += __shfl_xor(ss, 32);
                if (fq == 0 && !dry) ssq[m0 + m * 16 + fr] = ss;
            }
        }
    }
}

DI void phase_moe_up(const P& p, int layer, char* lds) {
    const int tid = tidx(), wid = tid >> 6, lane = tid & 63, wr = wid >> 1, wc = wid & 1, fr = lane & 15, fq = lane >> 4;
    const unsigned* cntb = (const unsigned*)(p.ws + WS_CTL + CTL_CNT) + layer * 16 * 64;
    unsigned cnt[16];
#pragma unroll
    for (int e = 0; e < 16; ++e) cnt[e] = cntb[e * 64];
    const int* list = (const int*)(p.ws + WS_LIST);
    const float* gl = (const float*)(p.ws + WS_GATE);
    const bf16_t* hn = (const bf16_t*)(p.ws + WS_HN);
    const bf16_t* W13 = (const bf16_t*)(p.ws + WS_W + W_13);
    bf16_t* H = (bf16_t*)(p.ws + WS_H);
    int ttot = 0;
#pragma unroll
    for (int e = 0; e < 16; ++e) ttot += ((int)cnt[e] + 127) >> 7;
    const int ntiles = ttot * 4;
    auto locate = [&](int tile, int& e, int& lt, int& ce, int& rbe, int& tn) {
        const int mt = tile >> 2; tn = tile & 3;
        int tbe = 0, acc_t = 0; e = 0;
#pragma unroll
        for (int q = 0; q < 16; ++q) { const int nt = ((int)cnt[q] + 127) >> 7; if (mt >= acc_t) { e = q; tbe = acc_t; } acc_t += nt; }
        lt = mt - tbe; ce = (int)cnt[e]; rbe = tbe * 128;
    };
    auto fill = [&](TileP& t, int tile) {
        int e, lt, ce, rbe, tn; locate(tile, e, lt, ce, rbe, tn);
        const int r = tid >> 3;
#pragma unroll
        for (int i = 0; i < 4; ++i) {
            const int ii = lt * 128 + r + 32 * i;
            const int tk = ii < ce ? (list[e * 16384 + ii] >> 1) : 0;
            t.arow[i] = tk;
            t.bo[i] = (unsigned)(e * 512 + tn * 128 + r + 32 * i) * 2048u;
        }
    };
    const GOps gop{(const char*)hn, 2048u, (const char*)hn, 2048u, (const char*)W13};
    TileP cur, nxt;
    bool primed = false;
    fill(cur, bidx() < ntiles ? bidx() : 0); nxt = cur;
    for (int tile = bidx(); tile < ntiles; tile += gridDim.x) {
        int e, lt, ce, rbe, tn; locate(tile, e, lt, ce, rbe, tn);
        const bool have_next = tile + (int)gridDim.x < ntiles;
        if (have_next) fill(nxt, tile + gridDim.x);
        f32x4 acc[4][4];
        gemm_core(gop, cur, 1024, lds, acc, 1 << 30, primed, nxt, have_next);
        primed = have_next; cur = nxt;
#pragma unroll
        for (int m = 0; m < 4; ++m) {
            const int li = lt * 128 + wr * 64 + m * 16 + fr;
            if (li < ce) {
                const float g = gl[e * 16384 + li];
                bf16_t* hrow = H + (size_t)(rbe + li) * 256;
#pragma unroll
                for (int n = 0; n < 4; n += 2) {
                    float o[4];
#pragma unroll
                    for (int j = 0; j < 4; ++j) o[j] = siluf_(acc[n][m][j]) * acc[n + 1][m][j] * g;
                    const int f = tn * 64 + wc * 32 + (n >> 1) * 16 + fq * 4;
                    u32x2 w; w.x = pack2(o[0], o[1]); w.y = pack2(o[2], o[3]);
                    *(u32x2*)(hrow + f) = w;
                }
            }
        }
    }
}
DI void phase_moe_down(const P& p, int layer, char* lds) {
    const int tid = tidx(), wid = tid >> 6, lane = tid & 63, wr = wid >> 1, wc = wid & 1, fr = lane & 15, fq = lane >> 4;
    const unsigned* cntb = (const unsigned*)(p.ws + WS_CTL + CTL_CNT) + layer * 16 * 64;
    unsigned cnt[16];
#pragma unroll
    for (int e = 0; e < 16; ++e) cnt[e] = cntb[e * 64];
    const int* list = (const int*)(p.ws + WS_LIST);
    const bf16_t* W2 = (const bf16_t*)(p.ws + WS_W + W_2);
    const bf16_t* H = (const bf16_t*)(p.ws + WS_H);
    bf16_t* ys = (bf16_t*)(p.ws + WS_YS);
    int ttot = 0;
#pragma unroll
    for (int e = 0; e < 16; ++e) ttot += ((int)cnt[e] + 127) >> 7;
    const int ntiles = ttot * 8;
    auto locate = [&](int tile, int& e, int& lt, int& ce, int& rbe, int& tn) {
        const int mt = tile >> 3; tn = tile & 7;
        int tbe = 0, acc_t = 0; e = 0;
#pragma unroll
        for (int q = 0; q < 16; ++q) { const int nt = ((int)cnt[q] + 127) >> 7; if (mt >= acc_t) { e = q; tbe = acc_t; } acc_t += nt; }
        lt = mt - tbe; ce = (int)cnt[e]; rbe = tbe * 128;
    };
    auto fill = [&](TileP& t, int tile) {
        int e, lt, ce, rbe, tn; locate(tile, e, lt, ce, rbe, tn);
        const int r = tid >> 3;
#pragma unroll
        for (int i = 0; i < 4; ++i) { t.arow[i] = rbe + lt * 128 + r + 32 * i; t.bo[i] = (unsigned)(e * 1024 + tn * 128 + r + 32 * i) * 512u; }
    };
    const GOps gop{(const char*)H, 512u, (const char*)H, 512u, (const char*)W2};
    TileP cur, nxt;
    bool primed = false;
    fill(cur, bidx() < ntiles ? bidx() : 0); nxt = cur;
    for (int tile = bidx(); tile < ntiles; tile += gridDim.x) {
        int e, lt, ce, rbe, tn; locate(tile, e, lt, ce, rbe, tn);
        const bool have_next = tile + (int)gridDim.x < ntiles;
        if (have_next) fill(nxt, tile + gridDim.x);
        f32x4 acc[4][4];
        gemm_core(gop, cur, 256, lds, acc, 1 << 30, primed, nxt, have_next);
        primed = have_next; cur = nxt;
#pragma unroll
        for (int m = 0; m < 4; ++m) {
            const int li = lt * 128 + wr * 64 + m * 16 + fr;
            if (li < ce) {
                const int ts = list[e * 16384 + li];
                bf16_t* yrow = ys + ((size_t)(ts & 1) * T + (ts >> 1)) * 1024 + tn * 128 + wc * 64 + fq * 4;
#pragma unroll
                for (int n = 0; n < 4; ++n) { u32x2 w; w.x = pack2(acc[n][m][0], acc[n][m][1]); w.y = pack2(acc[n][m][2], acc[n][m][3]); *(u32x2*)(yrow + n * 16) = w; }
            }
        }
    }
}


typedef float f32x16 __attribute__((ext_vector_type(16)));
DI f32x4 mfma16(bf16x8 a, bf16x8 b, f32x4 c) { return __builtin_amdgcn_mfma_f32_16x16x32_bf16(a, b, c, 0, 0, 0); }
DI f32x16 mfma32(bf16x8 a, bf16x8 b, f32x16 c) { return __builtin_amdgcn_mfma_f32_32x32x16_bf16(a, b, c, 0, 0, 0); }
DI f32x4 tile16(const char* X, int ldx, int row0, const char* Y, int ldy, int col0, int K) {
    const int lane = tidx() & 63, fr = lane & 15, fq = lane >> 4;
    f32x4 acc = {0.f, 0.f, 0.f, 0.f};
#pragma unroll
    for (int k = 0; k < K; k += 32) {
        const bf16x8 a = *(const bf16x8*)(X + (row0 + fr) * ldx + (k + fq * 8) * 2);
        const bf16x8 b = *(const bf16x8*)(Y + (col0 + fr) * ldy + (k + fq * 8) * 2);
        acc = mfma16(a, b, acc);
    }
    return acc;
}
DI bf16x8 pack_step(const f32x16& x, int s) {
    u32x4 r;
    r.x = pack2(x[8 * s + 0], x[8 * s + 1]); r.y = pack2(x[8 * s + 2], x[8 * s + 3]);
    r.z = pack2(x[8 * s + 4], x[8 * s + 5]); r.w = pack2(x[8 * s + 6], x[8 * s + 7]);
    return __builtin_bit_cast(bf16x8, r);
}

constexpr int GP_LF = 0, GP_T = 17408, GP_VEC = GP_T + 9216, GP_U = GP_VEC + 1024, GP_END = GP_U + 36864;
DI void gdn_prep_unit(const P& p, int li, int ch, char* lds) {
    const int tid = tidx(), lane = tid & 63, wid = tid >> 6, fr = lane & 15, fq = lane >> 4;
    const int h = ch & 3, n = (ch >> 2) & 63, b = ch >> 8;
    const int t0 = b * SEQ + n * 64;
    float* Lf = (float*)(lds + GP_LF);
    char* Trow = lds + GP_T;
    float* gcs = (float*)(lds + GP_VEC); float* egc = gcs + 64; float* bet = gcs + 128; float* ekd = gcs + 192;
    char* Qrow = lds + GP_U; char* Krow = Qrow + 17408; char* VbT = lds + GP_U; char* KbgT = VbT + 18432;
    const bf16_t* proj = (const bf16_t*)(p.ws + WS_PROJ);
    unsigned char* ops = p.ws + WS_GOPS + (size_t)ch * GOPS_CH;
    const float* cw = p.in[I_CONVW] + (size_t)li * 4 * 1536;
    const int c = tid >> 2, cq = tid & 3;
    __syncthreads();
    float* cwl = (float*)(lds + GP_END);
    for (int i = tid; i < 4 * 3 * 32; i += 256) {
        const int j = i / 96, r = i % 96, sl = r >> 5, q4 = (r & 31) * 4;
        *(f32x4*)(cwl + (j * 3 + sl) * 128 + q4) = *(const f32x4*)(cw + j * 1536 + sl * 512 + h * 128 + q4);
    }
    __syncthreads();
    unsigned vvp[16];
#pragma unroll 1
    for (int which = 0; which < 3; ++which) {
        const int col0 = which * 512 + h * 128 + cq * 32;
        u32x4 xin[4][4];
#pragma unroll
        for (int j = 0; j < 4; ++j) {
            const int sp = n * 64 + c - 3 + j;
            const bf16_t* src = proj + (size_t)(b * SEQ + (sp < 0 ? 0 : sp)) * EVLD + col0;
#pragma unroll
            for (int i4 = 0; i4 < 4; ++i4) xin[j][i4] = *(const u32x4*)(src + i4 * 8);
        }
        float acc[32];
#pragma unroll
        for (int i = 0; i < 32; ++i) acc[i] = 0.f;
#pragma unroll
        for (int j = 0; j < 4; ++j) {
            const float ok = (n * 64 + c - 3 + j) >= 0 ? 1.f : 0.f;
            const float* wj = cwl + (j * 3 + which) * 128 + cq * 32;
#pragma unroll
            for (int i4 = 0; i4 < 4; ++i4) {
                const f32x4 wa = *(const f32x4*)(wj + i4 * 8), wb = *(const f32x4*)(wj + i4 * 8 + 4);
                const u32x4 w = xin[j][i4];
                acc[i4 * 8 + 0] += ok * wa[0] * __uint_as_float(w[0] << 16); acc[i4 * 8 + 1] += ok * wa[1] * __uint_as_float(w[0] & 0xffff0000u);
                acc[i4 * 8 + 2] += ok * wa[2] * __uint_as_float(w[1] << 16); acc[i4 * 8 + 3] += ok * wa[3] * __uint_as_float(w[1] & 0xffff0000u);
                acc[i4 * 8 + 4] += ok * wb[0] * __uint_as_float(w[2] << 16); acc[i4 * 8 + 5] += ok * wb[1] * __uint_as_float(w[2] & 0xffff0000u);
                acc[i4 * 8 + 6] += ok * wb[2] * __uint_as_float(w[3] << 16); acc[i4 * 8 + 7] += ok * wb[3] * __uint_as_float(w[3] & 0xffff0000u);
            }
        }
        float ss = 0.f;
#pragma unroll
        for (int i = 0; i < 32; ++i) { acc[i] = siluf_(acc[i]); ss += acc[i] * acc[i]; }
        ss += __shfl_xor(ss, 1); ss += __shfl_xor(ss, 2);
        const float rn = which == 2 ? 1.f : rsqrtf(ss + 1e-6f) * (which == 0 ? 0.08838834764831845f : 1.f);
        unsigned pk[16];
#pragma unroll
        for (int i = 0; i < 16; ++i) pk[i] = pack2(acc[2 * i] * rn, acc[2 * i + 1] * rn);
        if (which < 2) {
            char* img = which == 0 ? Qrow : Krow;
#pragma unroll
            for (int i4 = 0; i4 < 4; ++i4) { u32x4 w; w.x = pk[i4 * 4]; w.y = pk[i4 * 4 + 1]; w.z = pk[i4 * 4 + 2]; w.w = pk[i4 * 4 + 3]; *(u32x4*)(img + c * 272 + (cq * 32 + i4 * 8) * 2) = w; }
        } else {
#pragma unroll
            for (int i = 0; i < 16; ++i) vvp[i] = pk[i];
        }
    }
    if (cq == 0) {
        const float a = bf2f(proj[(size_t)(t0 + c) * EVLD + 2048 + h]);
        const float bb = bf2f(proj[(size_t)(t0 + c) * EVLD + 2052 + h]);
        const float Aexp = __expf(p.in[I_ALOG][li * 4 + h]), dtb = p.in[I_DTB][li * 4 + h];
        gcs[c] = -Aexp * softplusf_(a + dtb);
        bet[c] = sigmoidf_(bb);
    }
    __syncthreads();
    if (wid == 0) {
        float x = gcs[lane];
#pragma unroll
        for (int o = 1; o < 64; o <<= 1) { const float y = __shfl_up(x, o); if (lane >= o) x += y; }
        const float gl = __shfl(x, 63);
        gcs[lane] = x; egc[lane] = __expf(x); ekd[lane] = __expf(gl - x);
        if (lane == 63) ((float*)(p.ws + WS_CTL + CTL_EGL))[ch] = __expf(gl);
    }
    __syncthreads();
    {
        const int ti = wid;
#pragma unroll
        for (int tj = 0; tj < 4; ++tj) {
            if (tj <= ti) {
                const f32x4 kk = tile16(Krow, 272, 16 * ti, Krow, 272, 16 * tj, 128);
                const int c2 = 16 * tj + fr;
                f32x4 lv;
#pragma unroll
                for (int r = 0; r < 4; ++r) {
                    const int c1 = 16 * ti + fq * 4 + r;
                    lv[r] = (c1 > c2) ? bet[c1] * kk[r] * __expf(gcs[c1] - gcs[c2]) : 0.f;
                }
                *(f32x4*)&Lf[c2 * 68 + 16 * ti + fq * 4] = lv;
            }
            f32x4 qk = {0.f, 0.f, 0.f, 0.f};
            if (tj <= ti) qk = tile16(Krow, 272, 16 * tj, Qrow, 272, 16 * ti, 128);
            const int c1 = 16 * ti + fr;
            float o4[4];
#pragma unroll
            for (int r = 0; r < 4; ++r) { const int c2 = 16 * tj + fq * 4 + r; o4[r] = (c1 >= c2) ? qk[r] * __expf(gcs[c1] - gcs[c2]) : 0.f; }
            const int mt = c1 >> 5, rr = c1 & 31, hh = fq & 1, jg = fq >> 1;
            u32x2 w; w.x = pack2(o4[0], o4[1]); w.y = pack2(o4[2], o4[3]);
            *(u32x2*)(ops + GO_AF + ((size_t)((mt * 4 + tj) * 64 + hh * 32 + rr) * 8 + jg * 4) * 2) = w;
        }
#pragma unroll
        for (int i = 0; i < 4; ++i) {
            const int idx = tid + i * 256;
            {
                const int mt = idx >> 9, ks = (idx >> 6) & 7, l2 = idx & 63, rr = l2 & 31, hh = l2 >> 5, cc = 32 * mt + rr;
                const float sc = egc[cc];
                const u32x2 lo = *(const u32x2*)(Qrow + cc * 272 + (16 * ks + 4 * hh) * 2), hi = *(const u32x2*)(Qrow + cc * 272 + (16 * ks + 8 + 4 * hh) * 2);
                u32x4 w;
                w.x = pack2(__uint_as_float(lo.x << 16) * sc, __uint_as_float(lo.x & 0xffff0000u) * sc); w.y = pack2(__uint_as_float(lo.y << 16) * sc, __uint_as_float(lo.y & 0xffff0000u) * sc);
                w.z = pack2(__uint_as_float(hi.x << 16) * sc, __uint_as_float(hi.x & 0xffff0000u) * sc); w.w = pack2(__uint_as_float(hi.y << 16) * sc, __uint_as_float(hi.y & 0xffff0000u) * sc);
                *(u32x4*)(ops + GO_QF + (size_t)idx * 16) = w;
            }
            {
                const int mt = idx >> 8, ks = (idx >> 6) & 3, l2 = idx & 63, rr = l2 & 31, hh = l2 >> 5, dk = 32 * mt + rr;
                float e8[8];
#pragma unroll
                for (int j = 0; j < 8; ++j) { const int c2 = 16 * ks + 8 * (j >> 2) + 4 * hh + (j & 3); e8[j] = bf2f(*(const bf16_t*)(Krow + c2 * 272 + dk * 2)) * ekd[c2]; }
                u32x4 w; w.x = pack2(e8[0], e8[1]); w.y = pack2(e8[2], e8[3]); w.z = pack2(e8[4], e8[5]); w.w = pack2(e8[6], e8[7]);
                *(u32x4*)(ops + GO_KF + (size_t)idx * 16) = w;
            }
        }
    }
    __syncthreads();
    {
        const float bc = bet[c], bg = bc * egc[c];
        unsigned kvp[16];
#pragma unroll
        for (int i4 = 0; i4 < 4; ++i4) { const u32x4 w = *(const u32x4*)(Krow + c * 272 + (cq * 32 + i4 * 8) * 2); kvp[i4 * 4] = w.x; kvp[i4 * 4 + 1] = w.y; kvp[i4 * 4 + 2] = w.z; kvp[i4 * 4 + 3] = w.w; }
        __syncthreads();
#pragma unroll
        for (int i = 0; i < 16; ++i) {
            *(bf16_t*)(VbT + (cq * 32 + 2 * i) * 144 + c * 2) = f2bf(__uint_as_float(vvp[i] << 16) * bc);
            *(bf16_t*)(VbT + (cq * 32 + 2 * i + 1) * 144 + c * 2) = f2bf(__uint_as_float(vvp[i] & 0xffff0000u) * bc);
            *(bf16_t*)(KbgT + (cq * 32 + 2 * i) * 144 + c * 2) = f2bf(__uint_as_float(kvp[i] << 16) * bg);
            *(bf16_t*)(KbgT + (cq * 32 + 2 * i + 1) * 144 + c * 2) = f2bf(__uint_as_float(kvp[i] & 0xffff0000u) * bg);
        }
    }
    {
        char* L21i = lds + GP_END;
        char* T11T = L21i + 2560;
        char* MT = T11T + 2560;
        if (wid < 2) {
            const int o = 32 * wid;
            float Tc[32];
#pragma unroll
            for (int i = 0; i < 32; ++i) Tc[i] = (i == (lane & 31)) ? 1.f : 0.f;
#pragma unroll
            for (int j = 0; j < 31; ++j) {
                const float tj = Tc[j];
#pragma unroll
                for (int i4 = (j + 1) >> 2; i4 < 8; ++i4) {
                    const f32x4 l4 = *(const f32x4*)&Lf[(o + j) * 68 + o + i4 * 4];
#pragma unroll
                    for (int e = 0; e < 4; ++e) if (i4 * 4 + e > j) Tc[i4 * 4 + e] -= l4[e] * tj;
                }
            }
            if (lane < 32) {
#pragma unroll
                for (int i = 0; i < 32; ++i) *(bf16_t*)(Trow + (o + i) * 144 + (o + lane) * 2) = f2bf(Tc[i]);
                if (wid == 0) {
#pragma unroll
                    for (int i = 0; i < 32; ++i) *(bf16_t*)(Trow + i * 144 + (32 + lane) * 2) = 0;
#pragma unroll
                    for (int i4 = 0; i4 < 8; ++i4) { u32x2 w; w.x = pack2(Tc[i4 * 4], Tc[i4 * 4 + 1]); w.y = pack2(Tc[i4 * 4 + 2], Tc[i4 * 4 + 3]); *(u32x2*)(T11T + lane * 80 + i4 * 8) = w; }
                }
            }
        } else {
            const int t2 = tid - 128;
#pragma unroll
            for (int g2 = 0; g2 < 2; ++g2) {
                const int i = t2 & 31, k4 = ((t2 >> 5) + 4 * g2) * 4;
                u32x2 w;
                w.x = pack2(Lf[(k4 + 0) * 68 + 32 + i], Lf[(k4 + 1) * 68 + 32 + i]); w.y = pack2(Lf[(k4 + 2) * 68 + 32 + i], Lf[(k4 + 3) * 68 + 32 + i]);
                *(u32x2*)(L21i + i * 80 + k4 * 2) = w;
            }
        }
        __syncthreads();
        {
            const int r0 = 16 * (wid >> 1), c0 = 16 * (wid & 1);
            const f32x4 mm = tile16(L21i, 80, r0, T11T, 80, c0, 32);
            u32x2 w; w.x = pack2(mm[0], mm[1]); w.y = pack2(mm[2], mm[3]);
            *(u32x2*)(MT + (c0 + fr) * 80 + (r0 + 4 * fq) * 2) = w;
        }
        __syncthreads();
        {
            const int r0 = 16 * (wid >> 1), c0 = 16 * (wid & 1);
            const f32x4 tt = tile16(MT, 80, c0, Trow + 32 * 144 + 64, 144, r0, 32);
            u32x2 w; w.x = pack2(-tt[0], -tt[1]); w.y = pack2(-tt[2], -tt[3]);
            *(u32x2*)(Trow + (32 + r0 + fr) * 144 + (c0 + 4 * fq) * 2) = w;
        }
    }
    __syncthreads();
#pragma unroll
    for (int tq = 0; tq < 2; ++tq) {
        const int tj = wid * 2 + tq;
#pragma unroll
        for (int ti = 0; ti < 4; ++ti) {
            const f32x4 u = tile16(Trow, 144, 16 * ti, VbT, 144, 16 * tj, 64);
            {
                const int dv = 16 * tj + fr, slice = dv >> 5, rr = dv & 31, cb = 16 * ti + fq * 4, mt = cb >> 5, q4 = (cb & 31) >> 2, hh = q4 & 1, rg = q4 >> 1;
                u32x2 w; w.x = pack2(u[0], u[1]); w.y = pack2(u[2], u[3]);
                *(u32x2*)(ops + GO_UF + ((size_t)((slice * 2 + mt) * 64 + hh * 32 + rr) * 16 + rg * 4) * 2) = w;
            }
            const f32x4 wv = tile16(KbgT, 144, 16 * tj, Trow, 144, 16 * ti, 64);
            {
                const int c1 = 16 * ti + fr, mt = c1 >> 5, rr = c1 & 31, hh = fq & 1, jg = fq >> 1;
                u32x2 w; w.x = pack2(-wv[0], -wv[1]); w.y = pack2(-wv[2], -wv[3]);
                *(u32x2*)(ops + GO_WF + ((size_t)((mt * 8 + tj) * 64 + hh * 32 + rr) * 8 + jg * 4) * 2) = w;
            }
        }
    }
}

DI void glds16(const void* g, char* l) { __builtin_amdgcn_global_load_lds((const unsigned*)g, (lds_u32*)l, 16, 0, 0); }
#define GS_WAIT(n) asm volatile("s_waitcnt vmcnt(" #n ")" ::: "memory")
DI void gdn_scan_block(const P& p, int bh, char* lds, bool dry = false) {
    const int tid = tidx(), lane = tid & 63, w = tid >> 6;
    const int h = bh & 3, b = bh >> 2;
    const float eglv = ((const float*)(p.ws + WS_CTL + CTL_EGL))[(b * 64 + lane) * 4 + h];
    unsigned char* gbase = p.ws + WS_GOPS + (size_t)(b * 256 + h) * GOPS_CH;
    auto issue = [&](int n, int k0, int cntk) {
        for (int k = k0; k < k0 + cntk; ++k) {
            const unsigned char* src = gbase + (size_t)n * 4 * GOPS_CH + k * 8192 + tid * 16;
            char* dst = lds + k * 8192 + tid * 16;
            glds16(src, dst); glds16(src + 4096, dst + 4096);
        }
    };
    f32x16 S[4];
#pragma unroll
    for (int i = 0; i < 4; ++i)
#pragma unroll
        for (int r = 0; r < 16; ++r) S[i][r] = 0.f;
    __syncthreads();
    issue(0, 0, 7);
#pragma unroll 1
    for (int n = 0; n < 64; ++n) {
        const float egl = __shfl(eglv, n);
        bf16x8 Sb[8];
#pragma unroll
        for (int i = 0; i < 4; ++i) { Sb[i * 2] = pack_step(S[i], 0); Sb[i * 2 + 1] = pack_step(S[i], 1); }
        f32x16 av[2], ao[2];
        const bf16x8* fr0 = (const bf16x8*)lds + lane;
        GS_WAIT(6);
        __builtin_amdgcn_s_barrier();
        issue(n, 7, 2);
        __builtin_amdgcn_sched_barrier(0);
        {
            const char* sl = lds + (w >> 1) * 8192;
#pragma unroll
            for (int mt = 0; mt < 2; ++mt) {
                const u32x4* up = (const u32x4*)(sl + ((w & 1) * 2 + mt) * 2048 + lane * 32);
                const u32x4 u0 = up[0], u1 = up[1];
#pragma unroll
                for (int e = 0; e < 4; ++e) {
                    av[mt][e * 2] = __uint_as_float(u0[e] << 16); av[mt][e * 2 + 1] = __uint_as_float(u0[e] & 0xffff0000u);
                    av[mt][8 + e * 2] = __uint_as_float(u1[e] << 16); av[mt][8 + e * 2 + 1] = __uint_as_float(u1[e] & 0xffff0000u);
                }
            }
        }
#pragma unroll
        for (int ks = 0; ks < 8; ++ks)
#pragma unroll
            for (int mt = 0; mt < 2; ++mt) av[mt] = mfma32(fr0[(2 + mt) * 512 + ks * 64], Sb[ks], av[mt]);
        bf16x8 Vb[4];
#pragma unroll
        for (int mt = 0; mt < 2; ++mt) { Vb[mt * 2] = pack_step(av[mt], 0); Vb[mt * 2 + 1] = pack_step(av[mt], 1); }
        GS_WAIT(4);
        __builtin_amdgcn_s_barrier();
        if (n < 63) issue(n + 1, 0, 4);
        __builtin_amdgcn_sched_barrier(0);
#pragma unroll
        for (int mt = 0; mt < 2; ++mt)
#pragma unroll
            for (int r = 0; r < 16; ++r) ao[mt][r] = 0.f;
#pragma unroll
        for (int ks = 0; ks < 8; ++ks) {
#pragma unroll
            for (int mt = 0; mt < 2; ++mt) ao[mt] = mfma32(fr0[(4 + mt) * 512 + ks * 64], Sb[ks], ao[mt]);
#pragma unroll
            for (int r = 0; r < 8; ++r) S[ks >> 1][(ks & 1) * 8 + r] *= egl;
        }
#pragma unroll
        for (int ks = 0; ks < 4; ++ks) { if (ks < 2) ao[0] = mfma32(fr0[6 * 512 + ks * 64], Vb[ks], ao[0]); ao[1] = mfma32(fr0[6 * 512 + (4 + ks) * 64], Vb[ks], ao[1]); }
        if (n < 63) GS_WAIT(8); else GS_WAIT(0);
        __builtin_amdgcn_s_barrier();
        if (n < 63) issue(n + 1, 4, 3);
        __builtin_amdgcn_sched_barrier(0);
#pragma unroll
        for (int ks = 0; ks < 4; ++ks)
#pragma unroll
            for (int i = 0; i < 4; ++i) S[i] = mfma32(fr0[(7 + (i >> 1)) * 512 + ((i & 1) * 4 + ks) * 64], Vb[ks], S[i]);
        {
            u32x4* Of = (u32x4*)((dry ? p.ws + WS_DUMMY + (size_t)(bh & 15) * 65536 : gbase + (size_t)n * 4 * GOPS_CH) + GO_UF) + (size_t)(w * 2 * 64 + lane) * 2;
#pragma unroll
            for (int mt = 0; mt < 2; ++mt) {
                u32x4 o0, o1;
#pragma unroll
                for (int e = 0; e < 4; ++e) { o0[e] = pack2(ao[mt][e * 2], ao[mt][e * 2 + 1]); o1[e] = pack2(ao[mt][8 + e * 2], ao[mt][8 + e * 2 + 1]); }
                Of[mt * 128] = o0; Of[mt * 128 + 1] = o1;
            }
        }
    }
    __syncthreads();
}

DI void gdn_post_unit(const P& p, int li, int ch) {
    const int tid = tidx();
    const int h = ch & 3, n = (ch >> 2) & 63, b = ch >> 8;
    const int t0 = b * SEQ + n * 64;
    const int c = tid >> 2, cq = tid & 3;
    const bf16_t* Of = (const bf16_t*)(p.ws + WS_GOPS + (size_t)ch * GOPS_CH + GO_UF);
    const bf16_t* proj = (const bf16_t*)(p.ws + WS_PROJ);
    bf16_t* mix = (bf16_t*)(p.ws + WS_PROJ);
    const float* nw = p.in[I_GDNNORM] + li * 128 + cq * 32;
    const int mt = c >> 5, q4 = (c & 31) >> 2, hh = q4 & 1, rg = q4 >> 1, reg = rg * 4 + (c & 3);
    float o[32]; float ss = 0.f;
#pragma unroll
    for (int r = 0; r < 32; ++r) { o[r] = bf2f(Of[(size_t)((cq * 2 + mt) * 64 + hh * 32 + r) * 16 + reg]); ss += o[r] * o[r]; }
    ss += __shfl_xor(ss, 1); ss += __shfl_xor(ss, 2);
    const float rs = rsqrtf(ss * (1.f / 128.f) + 1e-6f);
    const bf16_t* zp = proj + (size_t)(t0 + c) * EVLD + 1536 + h * 128 + cq * 32;
    bf16_t* mp = mix + (size_t)(t0 + c) * EVLD + h * 128 + cq * 32;
#pragma unroll
    for (int i4 = 0; i4 < 4; ++i4) {
        const u32x4 zw = *(const u32x4*)(zp + i4 * 8);
        u32x4 w;
#pragma unroll
        for (int e = 0; e < 4; ++e) {
            const float z0 = __uint_as_float(zw[e] << 16), z1 = __uint_as_float(zw[e] & 0xffff0000u);
            w[e] = pack2(o[i4 * 8 + e * 2] * rs * nw[i4 * 8 + e * 2] * siluf_(z0), o[i4 * 8 + e * 2 + 1] * rs * nw[i4 * 8 + e * 2 + 1] * siluf_(z1));
        }
        *(u32x4*)(mp + i4 * 8) = w;
    }
}


constexpr int RP_Z0 = 0, RP_Z1 = 18432, RP_Z2 = 55296, RP_VEC = 73728, RP_PT = 75008, RP_T11 = 78080, RP_END = 80640;
constexpr int RP_LIN = 0, RP_LW = 25600;
DI void rwkv_prep_unit(const P& p, int li, int ch, char* lds) {
    const int tid = tidx(), lane = tid & 63, wid = tid >> 6, fr = lane & 15, fq = lane >> 4;
    const int h = ch & 7, n = (ch >> 3) & 63, b = ch >> 9;
    const int t0 = b * SEQ + n * 64;
    const bf16_t* proj = (const bf16_t*)(p.ws + WS_PROJ);
    char* Lfc = lds + RP_Z0; float* Lf = (float*)Lfc;
    char* ApT = lds + RP_Z0; char* AkVT = lds + RP_Z0 + 9216;
    char* Arow = lds + RP_Z1; char* Rrow = Arow + 9216; char* Brow = Arow + 18432; char* Krow = Arow + 27648;
    char* Aak = Arow; char* Arb = Rrow; char* Ark = Brow; char* Trow = Krow; char* BhT = Krow; char* VpT = Aak;
    char* AT = lds + RP_Z2; char* VT = AT + 9216; char* KhT = AT;
    float* tot = (float*)(lds + RP_VEC); float* WC = tot + 256;
    char* lin = lds + RP_LIN; char* LWi = lds + RP_LW;
    float* PT = (float*)(lds + RP_PT);
    {
        const float* mu0 = p.in[I_MU] + (size_t)li * 1696;
        if (tid < 48) {
            const int j0 = tid * 4;
            *(float4*)(PT + j0) = j0 < 160 ? *(const float4*)(mu0 + (C_HW - RW0) + j0) : *(const float4*)(p.in[I_VRESMU] + j0 - 160);
        } else if (tid < 48 + 144) {
            const int q = tid - 48, arr = q >> 4, c4 = (q & 15) * 4, chn = h * 64 + c4;
            const float* src = arr == 0 ? mu0 + (C_R - RW0) + chn : arr == 1 ? mu0 + (C_K - RW0) + chn : arr == 2 ? mu0 + (C_V - RW0) + chn
                             : arr == 3 ? p.in[I_W0] + li * 512 + chn : arr == 4 ? p.in[I_A0] + li * 512 + chn : arr == 5 ? p.in[I_V0] + chn
                             : arr == 6 ? p.in[I_KK] + li * 512 + chn : arr == 7 ? p.in[I_KA] + li * 512 + chn : p.in[I_RK] + li * 512 + chn;
            *(float4*)(PT + 192 + arr * 64 + c4) = *(const float4*)src;
        }
    }
    __syncthreads();
    {
        const int c = tid >> 2, cq = tid & 3, s = n * 64 + c;
        const bf16_t* cur = proj + (size_t)(t0 + c) * EVLD + C_HW + cq * 48;
        const float* mu = p.in[I_MU] + (size_t)li * 1696 + (C_HW - RW0);
        const float* vmu = p.in[I_VRESMU];
#pragma unroll
        for (int i6 = 0; i6 < 6; ++i6) {
            const u32x4 cw4 = *(const u32x4*)(cur + i6 * 8);
            u32x4 pw4 = *(const u32x4*)(cur - (s > 0 ? EVLD : 0) + i6 * 8);
            if (s == 0) pw4 = (u32x4){0u, 0u, 0u, 0u};
            const int j0 = cq * 48 + i6 * 8;
            const float4 ma = *(const float4*)(PT + j0), mb = *(const float4*)(PT + j0 + 4);
            const float mm[8] = {ma.x, ma.y, ma.z, ma.w, mb.x, mb.y, mb.z, mb.w};
            const bool is_t = j0 < 32, is_s = (j0 >= 64) && (j0 < 160);
            const float ca = is_t ? 1.f : 0.f, cb = is_t ? -2.f : 1.f, cc = is_t ? 2.f : -1.f;
            u32x4 w;
#pragma unroll
            for (int e = 0; e < 4; ++e) {
                float o2[2];
#pragma unroll
                for (int q = 0; q < 2; ++q) {
                    const float cv = q ? __uint_as_float(cw4[e] & 0xffff0000u) : __uint_as_float(cw4[e] << 16);
                    const float pv = q ? __uint_as_float(pw4[e] & 0xffff0000u) : __uint_as_float(pw4[e] << 16);
                    const float val = cv + mm[e * 2 + q] * (pv - cv);
                    const float act = ca + cb * __builtin_amdgcn_rcpf(1.f + __expf(cc * val));
                    o2[q] = (is_t || is_s) ? act : val;
                }
                w[e] = pack2(o2[0], o2[1]);
            }
            *(u32x4*)(lin + c * 400 + (cq * 48 + i6 * 8) * 2) = w;
        }
        const bf16_t* LW = (const bf16_t*)(p.ws + WS_W + W_LW) + (size_t)h * 64 * 192;
#pragma unroll
        for (int i6 = 0; i6 < 6; ++i6) *(u32x4*)(LWi + c * 400 + (cq * 48 + i6 * 8) * 2) = *(const u32x4*)(LW + (size_t)c * 192 + cq * 48 + i6 * 8);
    }
    __syncthreads();
    float lw_[16], la_[16], lg_[16], lv_[16];
#pragma unroll
    for (int tj = 0; tj < 4; ++tj) {
        const f32x4 a = tile16(LWi, 400, 16 * tj, lin, 400, 16 * wid, 32);
        const f32x4 bq = tile16(LWi + 64, 400, 16 * tj, lin + 64, 400, 16 * wid, 32);
        const f32x4 cg = tile16(LWi + 128, 400, 16 * tj, lin + 128, 400, 16 * wid, 96);
        const f32x4 dv = tile16(LWi + 320, 400, 16 * tj, lin + 320, 400, 16 * wid, 32);
#pragma unroll
        for (int r = 0; r < 4; ++r) { lw_[tj * 4 + r] = a[r]; la_[tj * 4 + r] = bq[r]; lg_[tj * 4 + r] = cg[r]; lv_[tj * 4 + r] = dv[r]; }
    }
    __syncthreads();
    const int c = 16 * wid + fr;
    float at[16], rt[16], bt[16], kt[16], bh[16], kh[16];
    {
        const int s = n * 64 + c;
        const size_t row = (size_t)(t0 + c);
        const float* mu = p.in[I_MU] + (size_t)li * 1696;
        const int hc = h * 64;
        float rr_[16], kk_[16], lwv[16], aa[16];
        float kn = 0.f, rk = 0.f;
        bf16_t* vf = (bf16_t*)(p.ws + WS_VF);
        bf16_t* gg = (bf16_t*)(p.ws + WS_GG);
#pragma unroll
        for (int tj = 0; tj < 4; ++tj) {
            const int cb = 16 * tj + 4 * fq;
            u32x2 cr = *(const u32x2*)(proj + row * EVLD + C_R + hc + cb), ck = *(const u32x2*)(proj + row * EVLD + C_K + hc + cb), cv = *(const u32x2*)(proj + row * EVLD + C_V + hc + cb);
            const size_t prow = s > 0 ? row - 1 : row;
            u32x2 pr = *(const u32x2*)(proj + prow * EVLD + C_R + hc + cb), pk = *(const u32x2*)(proj + prow * EVLD + C_K + hc + cb), pv = *(const u32x2*)(proj + prow * EVLD + C_V + hc + cb);
            if (s == 0) { pr = (u32x2){0u, 0u}; pk = pr; pv = pr; }
            u32x2 vfw = {0u, 0u};
            if (li == 1) vfw = *(const u32x2*)(vf + row * 512 + hc + cb);
            float vout[4], gout[4];
            const int ch0 = hc + cb;
            const float* pt = PT + 192 + cb;
            const float4 mu_r4 = *(const float4*)(pt), mu_k4 = *(const float4*)(pt + 64), mu_v4 = *(const float4*)(pt + 128);
            const float4 w0_4 = *(const float4*)(pt + 192), a0_4 = *(const float4*)(pt + 256), v0_4 = *(const float4*)(pt + 320);
            const float4 kk_4 = *(const float4*)(pt + 384), ka_4 = *(const float4*)(pt + 448), rk_4 = *(const float4*)(pt + 512);
            const float mur[4] = {mu_r4.x, mu_r4.y, mu_r4.z, mu_r4.w}, muk[4] = {mu_k4.x, mu_k4.y, mu_k4.z, mu_k4.w}, muv[4] = {mu_v4.x, mu_v4.y, mu_v4.z, mu_v4.w};
            const float w0v[4] = {w0_4.x, w0_4.y, w0_4.z, w0_4.w}, a0v[4] = {a0_4.x, a0_4.y, a0_4.z, a0_4.w}, v0v[4] = {v0_4.x, v0_4.y, v0_4.z, v0_4.w};
            const float kkp[4] = {kk_4.x, kk_4.y, kk_4.z, kk_4.w}, kap[4] = {ka_4.x, ka_4.y, ka_4.z, ka_4.w}, rkp[4] = {rk_4.x, rk_4.y, rk_4.z, rk_4.w};
#pragma unroll
            for (int r = 0; r < 4; ++r) {
                const int i = tj * 4 + r;
                const unsigned wcr = r < 2 ? cr.x : cr.y, wck = r < 2 ? ck.x : ck.y, wcv = r < 2 ? cv.x : cv.y;
                const unsigned wpr = r < 2 ? pr.x : pr.y, wpk = r < 2 ? pk.x : pk.y, wpv = r < 2 ? pv.x : pv.y, wvf = r < 2 ? vfw.x : vfw.y;
                const float c_r = (r & 1) ? __uint_as_float(wcr & 0xffff0000u) : __uint_as_float(wcr << 16);
                const float c_k = (r & 1) ? __uint_as_float(wck & 0xffff0000u) : __uint_as_float(wck << 16);
                const float c_v = (r & 1) ? __uint_as_float(wcv & 0xffff0000u) : __uint_as_float(wcv << 16);
                const float p_r = (r & 1) ? __uint_as_float(wpr & 0xffff0000u) : __uint_as_float(wpr << 16);
                const float p_k = (r & 1) ? __uint_as_float(wpk & 0xffff0000u) : __uint_as_float(wpk << 16);
                const float p_v = (r & 1) ? __uint_as_float(wpv & 0xffff0000u) : __uint_as_float(wpv << 16);
                const float rm = c_r + mur[r] * (p_r - c_r);
                const float km = c_k + muk[r] * (p_k - c_k);
                float vm = c_v + muv[r] * (p_v - c_v);
                const float wlog = -softplusf_(-(w0v[r] + lw_[i])) - 0.5f;
                lwv[i] = -__expf(wlog);
                const float a = sigmoidf_(a0v[r] + la_[i]);
                if (li == 1) {
                    const float v1 = (r & 1) ? __uint_as_float(wvf & 0xffff0000u) : __uint_as_float(wvf << 16);
                    vm = vm + (v1 - vm) * sigmoidf_(v0v[r] + lv_[i]);
                }
                const float kkv = km * kkp[r];
                kn += kkv * kkv;
                rr_[i] = rm; kk_[i] = kkv; aa[i] = a;
                kt[i] = km * (1.f + (a - 1.f) * kap[r]);
                rk += rm * kt[i] * rkp[r];
                vout[r] = vm; gout[r] = lg_[i];
            }
            u32x2 w; w.x = pack2(vout[0], vout[1]); w.y = pack2(vout[2], vout[3]);
            *(u32x2*)(vf + row * 512 + hc + cb) = w;
            w.x = pack2(gout[0], gout[1]); w.y = pack2(gout[2], gout[3]);
            *(u32x2*)(gg + row * 512 + hc + cb) = w;
#pragma unroll
            for (int r = 0; r < 4; ++r) *(bf16_t*)(VT + (cb + r) * 144 + c * 2) = f2bf(vout[r]);
            __builtin_amdgcn_sched_barrier(0);
        }
        kn += __shfl_xor(kn, 16); kn += __shfl_xor(kn, 32);
        const float kr = rsqrtf(kn + 1e-6f);
        rk += __shfl_xor(rk, 16); rk += __shfl_xor(rk, 32);
        if (fq == 0) ((float*)(p.ws + WS_RK))[row * 8 + h] = rk;
        float cs[16];
#pragma unroll
        for (int i = 0; i < 16; ++i) {
            float x = lwv[i];
#pragma unroll
            for (int o = 1; o < 16; o <<= 1) { const float y = __shfl_up(x, o, 16); if (fr >= o) x += y; }
            cs[i] = x;
        }
        if (fr == 15) {
#pragma unroll
            for (int i = 0; i < 16; ++i) tot[wid * 64 + 16 * (i >> 2) + 4 * fq + (i & 3)] = cs[i];
        }
        __syncthreads();
#pragma unroll
        for (int i = 0; i < 16; ++i) {
            const int chl = 16 * (i >> 2) + 4 * fq + (i & 3);
            float pre = 0.f, all = 0.f;
#pragma unroll
            for (int w2 = 0; w2 < 4; ++w2) { const float tv = tot[w2 * 64 + chl]; all += tv; if (w2 < wid) pre += tv; }
            const float csi = cs[i] + pre, csm = csi - lwv[i];
            const float kkn = kk_[i] * kr, k2 = kt[i];
            const float e_c = __expf(csi), e_n = __builtin_amdgcn_rcpf(e_c), e_m = __expf(csm), e_h = __expf(all) * e_n;
            at[i] = -kkn * e_m; rt[i] = rr_[i] * e_c;
            const float bp = kkn * aa[i];
            bt[i] = bp * e_n; kt[i] = k2 * e_n; bh[i] = bp * e_h; kh[i] = k2 * e_h;
            if (c == 0) WC[chl] = __expf(all);
            if ((i & 3) == 3) __builtin_amdgcn_sched_barrier(0);
        }
    }
#pragma unroll
    for (int tj = 0; tj < 4; ++tj) {
        const int cb = 16 * tj + 4 * fq;
        u32x2 w;
        w.x = pack2(at[tj * 4], at[tj * 4 + 1]); w.y = pack2(at[tj * 4 + 2], at[tj * 4 + 3]); *(u32x2*)(Arow + c * 144 + cb * 2) = w;
        w.x = pack2(rt[tj * 4], rt[tj * 4 + 1]); w.y = pack2(rt[tj * 4 + 2], rt[tj * 4 + 3]); *(u32x2*)(Rrow + c * 144 + cb * 2) = w;
        w.x = pack2(bt[tj * 4], bt[tj * 4 + 1]); w.y = pack2(bt[tj * 4 + 2], bt[tj * 4 + 3]); *(u32x2*)(Brow + c * 144 + cb * 2) = w;
        w.x = pack2(kt[tj * 4], kt[tj * 4 + 1]); w.y = pack2(kt[tj * 4 + 2], kt[tj * 4 + 3]); *(u32x2*)(Krow + c * 144 + cb * 2) = w;
#pragma unroll
        for (int r = 0; r < 4; ++r) {
            *(bf16_t*)(AT + (cb + r) * 144 + c * 2) = f2bf(at[tj * 4 + r]);
        }
    }
    __syncthreads();
    f32x4 pab[4], pak[4], prb[4], prk[4];
    {
        const int ti = wid;
#pragma unroll
        for (int tj = 0; tj < 4; ++tj) {
            pab[tj] = (f32x4){0.f, 0.f, 0.f, 0.f}; pak[tj] = pab[tj]; prb[tj] = pab[tj]; prk[tj] = pab[tj];
            if (tj <= ti) {
                pab[tj] = tile16(Arow, 144, 16 * ti, Brow, 144, 16 * tj, 64);
                pak[tj] = tile16(Krow, 144, 16 * tj, Arow, 144, 16 * ti, 64);
                prb[tj] = tile16(Brow, 144, 16 * tj, Rrow, 144, 16 * ti, 64);
                prk[tj] = tile16(Krow, 144, 16 * tj, Rrow, 144, 16 * ti, 64);
            }
        }
    }
    __syncthreads();
    {
        const int ti = wid;
#pragma unroll
        for (int tj = 0; tj < 4; ++tj) {
            const int s1 = 16 * tj + fr;
            f32x4 lv;
#pragma unroll
            for (int r = 0; r < 4; ++r) { const int t1 = 16 * ti + 4 * fq + r; lv[r] = (s1 < t1) ? -pab[tj][r] : 0.f; }
            *(f32x4*)&Lf[s1 * 72 + 16 * ti + 4 * fq] = lv;
            const int t2 = 16 * ti + fr;
            float m1[4], m2[4], m3[4];
#pragma unroll
            for (int r = 0; r < 4; ++r) { const int s2 = 16 * tj + 4 * fq + r; m1[r] = (s2 < t2) ? pak[tj][r] : 0.f; m2[r] = (s2 <= t2) ? prb[tj][r] : 0.f; m3[r] = (s2 <= t2) ? prk[tj][r] : 0.f; }
            u32x2 w;
            w.x = pack2(m1[0], m1[1]); w.y = pack2(m1[2], m1[3]); *(u32x2*)(Aak + t2 * 144 + (16 * tj + 4 * fq) * 2) = w;
            w.x = pack2(m2[0], m2[1]); w.y = pack2(m2[2], m2[3]); *(u32x2*)(Arb + t2 * 144 + (16 * tj + 4 * fq) * 2) = w;
            w.x = pack2(m3[0], m3[1]); w.y = pack2(m3[2], m3[3]); *(u32x2*)(Ark + t2 * 144 + (16 * tj + 4 * fq) * 2) = w;
        }
    }
    __syncthreads();
    {
        char* L21i = lds + RP_PT;
        char* T11T = lds + RP_T11;
        char* MT = lds + RP_Z0;
        if (wid < 2) {
            const int o = 32 * wid;
            float Tc[32];
#pragma unroll
            for (int i = 0; i < 32; ++i) Tc[i] = (i == (lane & 31)) ? 1.f : 0.f;
#pragma unroll
            for (int j = 0; j < 31; ++j) {
                const float tj = Tc[j];
#pragma unroll
                for (int i4 = (j + 1) >> 2; i4 < 8; ++i4) {
                    const f32x4 l4 = *(const f32x4*)&Lf[(o + j) * 72 + o + i4 * 4];
#pragma unroll
                    for (int e = 0; e < 4; ++e) if (i4 * 4 + e > j) Tc[i4 * 4 + e] -= l4[e] * tj;
                }
            }
            if (lane < 32) {
#pragma unroll
                for (int i = 0; i < 32; ++i) *(bf16_t*)(Trow + (o + i) * 144 + (o + lane) * 2) = f2bf(Tc[i]);
                if (wid == 0) {
#pragma unroll
                    for (int i = 0; i < 32; ++i) *(bf16_t*)(Trow + i * 144 + (32 + lane) * 2) = 0;
#pragma unroll
                    for (int i4 = 0; i4 < 8; ++i4) { u32x2 w; w.x = pack2(Tc[i4 * 4], Tc[i4 * 4 + 1]); w.y = pack2(Tc[i4 * 4 + 2], Tc[i4 * 4 + 3]); *(u32x2*)(T11T + lane * 80 + i4 * 8) = w; }
                }
            }
        } else {
            const int t2 = tid - 128;
#pragma unroll
            for (int g2 = 0; g2 < 2; ++g2) {
                const int i = t2 & 31, k4 = ((t2 >> 5) + 4 * g2) * 4;
                u32x2 w;
                w.x = pack2(Lf[(k4 + 0) * 72 + 32 + i], Lf[(k4 + 1) * 72 + 32 + i]); w.y = pack2(Lf[(k4 + 2) * 72 + 32 + i], Lf[(k4 + 3) * 72 + 32 + i]);
                *(u32x2*)(L21i + i * 80 + k4 * 2) = w;
            }
        }
        __syncthreads();
        {
            const int r0 = 16 * (wid >> 1), c0 = 16 * (wid & 1);
            const f32x4 mm = tile16(L21i, 80, r0, T11T, 80, c0, 32);
            u32x2 w; w.x = pack2(mm[0], mm[1]); w.y = pack2(mm[2], mm[3]);
            *(u32x2*)(MT + (c0 + fr) * 80 + (r0 + 4 * fq) * 2) = w;
        }
        __syncthreads();
        {
            const int r0 = 16 * (wid >> 1), c0 = 16 * (wid & 1);
            const f32x4 tt = tile16(MT, 80, c0, Trow + 32 * 144 + 64, 144, r0, 32);
            u32x2 w; w.x = pack2(-tt[0], -tt[1]); w.y = pack2(-tt[2], -tt[3]);
            *(u32x2*)(Trow + (32 + r0 + fr) * 144 + (c0 + 4 * fq) * 2) = w;
        }
    }
    __syncthreads();
    {
        const int ti = wid;
#pragma unroll
        for (int tj = 0; tj < 4; ++tj) {
            const f32x4 x = tile16(Trow, 144, 16 * ti, AT, 144, 16 * tj, 64);
            const f32x4 y = tile16(Aak, 144, 16 * ti, VT, 144, 16 * tj, 64);
            u32x2 w;
            w.x = pack2(x[0], x[1]); w.y = pack2(x[2], x[3]); *(u32x2*)(ApT + (16 * tj + fr) * 144 + (16 * ti + 4 * fq) * 2) = w;
            w.x = pack2(y[0], y[1]); w.y = pack2(y[2], y[3]); *(u32x2*)(AkVT + (16 * tj + fr) * 144 + (16 * ti + 4 * fq) * 2) = w;
        }
    }
    __syncthreads();
    {
        const int ti = wid;
#pragma unroll
        for (int tj = 0; tj < 4; ++tj) {
            const f32x4 x = tile16(Trow, 144, 16 * ti, AkVT, 144, 16 * tj, 64);
            u32x2 w; w.x = pack2(x[0], x[1]); w.y = pack2(x[2], x[3]); *(u32x2*)(VpT + (16 * tj + fr) * 144 + (16 * ti + 4 * fq) * 2) = w;
        }
    }
    __syncthreads();
#pragma unroll
    for (int tj = 0; tj < 4; ++tj)
#pragma unroll
        for (int r = 0; r < 4; ++r) {
            const int cb = 16 * tj + 4 * fq + r;
            *(bf16_t*)(BhT + cb * 144 + c * 2) = f2bf(bh[tj * 4 + r]);
            *(bf16_t*)(KhT + cb * 144 + c * 2) = f2bf(kh[tj * 4 + r]);
        }
    __syncthreads();
    {
        unsigned char* opsA = p.ws + WS_HN + (size_t)ch * 16384;
        unsigned char* opsB = p.ws + WS_ROPS + (size_t)ch * 16384;
        const int ti = wid;
#pragma unroll
        for (int tj = 0; tj < 4; ++tj) {
            const f32x4 x = tile16(ApT, 144, 16 * tj, Arb, 144, 16 * ti, 64);
            const f32x4 g = tile16(ApT, 144, 16 * tj, BhT, 144, 16 * ti, 64);
            const int m1 = 16 * ti + fr, mt = m1 >> 5, rr = m1 & 31, hh = fq & 1, jg = fq >> 1;
            const size_t off = ((size_t)((mt * 4 + tj) * 64 + hh * 32 + rr) * 8 + jg * 4) * 2;
            float gd[4];
#pragma unroll
            for (int r = 0; r < 4; ++r) gd[r] = g[r] + ((16 * tj + 4 * fq + r == m1) ? WC[m1] : 0.f);
            u32x2 w;
            w.x = pack2(x[0] + rt[tj * 4], x[1] + rt[tj * 4 + 1]); w.y = pack2(x[2] + rt[tj * 4 + 2], x[3] + rt[tj * 4 + 3]); *(u32x2*)(opsA + off) = w;
            w.x = pack2(gd[0], gd[1]); w.y = pack2(gd[2], gd[3]); *(u32x2*)(opsA + 8192 + off) = w;
            f32x4 y = tile16(Ark, 144, 16 * ti, VT, 144, 16 * tj, 64);
            const f32x4 y2 = tile16(Arb, 144, 16 * ti, VpT, 144, 16 * tj, 64);
            f32x4 kv = tile16(KhT, 144, 16 * ti, VT, 144, 16 * tj, 64);
            const f32x4 kv2 = tile16(BhT, 144, 16 * ti, VpT, 144, 16 * tj, 64);
            const int vcol = 16 * tj + fr, slice = vcol >> 5, r2 = vcol & 31, cb = 16 * ti + 4 * fq, mt2 = cb >> 5, q4 = (cb & 31) >> 2, h2 = q4 & 1, rg = q4 >> 1;
            const size_t off2 = ((size_t)((slice * 2 + mt2) * 64 + h2 * 32 + r2) * 16 + rg * 4) * 2;
            w.x = pack2(y[0] + y2[0], y[1] + y2[1]); w.y = pack2(y[2] + y2[2], y[3] + y2[3]); *(u32x2*)(opsB + off2) = w;
            w.x = pack2(kv[0] + kv2[0], kv[1] + kv2[1]); w.y = pack2(kv[2] + kv2[2], kv[3] + kv2[3]); *(u32x2*)(opsB + 8192 + off2) = w;
        }
    }
}

DI void rwkv_scan_block(const P& p, int bh, char* lds, bool dry = false) {
    const int tid = tidx(), lane = tid & 63, w = tid >> 6, slice = w & 1;
    const int h = bh & 7, b = bh >> 3;
    constexpr int NST = 64 * 2, AH = 3;
    auto issue = [&](int j) {
        const int n = j >> 1, k = j & 1;
        const size_t ch = (size_t)((b * 64 + n) * 8 + h) * 16384;
        const unsigned char* s0 = (k == 0 ? p.ws + WS_ROPS + ch + 8192 : p.ws + WS_ROPS + ch) + tid * 16;
        const unsigned char* s1 = (k == 0 ? p.ws + WS_HN + ch + 8192 : p.ws + WS_HN + ch) + tid * 16;
        char* dst = lds + (j & 3) * 16384 + tid * 16;
        glds16(s0, dst); glds16(s0 + 4096, dst + 4096); glds16(s1, dst + 8192); glds16(s1 + 4096, dst + 12288);
    };
    f32x16 H[2];
#pragma unroll
    for (int i = 0; i < 2; ++i)
#pragma unroll
        for (int r = 0; r < 16; ++r) H[i][r] = 0.f;
    __syncthreads();
#pragma unroll
    for (int j = 0; j < AH; ++j) issue(j);
#pragma unroll 1
    for (int n = 0; n < 64; ++n) {
        bf16x8 Hb[4];
#pragma unroll
        for (int i = 0; i < 2; ++i) { Hb[i * 2] = pack_step(H[i], 0); Hb[i * 2 + 1] = pack_step(H[i], 1); }
#pragma unroll
        for (int k = 0; k < 2; ++k) {
            const int j = n * 2 + k;
            if (n < 63) GS_WAIT(8); else if (k == 0) GS_WAIT(4); else GS_WAIT(0);
            __builtin_amdgcn_s_barrier();
            if (j + AH < NST) issue(j + AH);
            __builtin_amdgcn_sched_barrier(0);
            const char* sl = lds + (j & 3) * 16384;
            if (w < 2) {
                f32x16 acc[2];
#pragma unroll
                for (int mt = 0; mt < 2; ++mt) {
                    const u32x4* up = (const u32x4*)(sl + (slice * 2 + mt) * 2048 + lane * 32);
                    const u32x4 u0 = up[0], u1 = up[1];
#pragma unroll
                    for (int e = 0; e < 4; ++e) {
                        acc[mt][e * 2] = __uint_as_float(u0[e] << 16); acc[mt][e * 2 + 1] = __uint_as_float(u0[e] & 0xffff0000u);
                        acc[mt][8 + e * 2] = __uint_as_float(u1[e] << 16); acc[mt][8 + e * 2 + 1] = __uint_as_float(u1[e] & 0xffff0000u);
                    }
                }
                const bf16x8* fr = (const bf16x8*)(sl + 8192) + lane;
                bf16x8 f8[8];
#pragma unroll
                for (int q = 0; q < 8; ++q) f8[q] = fr[q * 64];
#pragma unroll
                for (int ks = 0; ks < 4; ++ks)
#pragma unroll
                    for (int mt = 0; mt < 2; ++mt) acc[mt] = mfma32(f8[mt * 4 + ks], Hb[ks], acc[mt]);
                if (k == 0) { H[0] = acc[0]; H[1] = acc[1]; }
                else {
                    const size_t ch = (size_t)((b * 64 + n) * 8 + h) * 16384;
                    u32x4* Yf = (u32x4*)(dry ? p.ws + WS_DUMMY + 2097152 + (size_t)(bh & 31) * 16384 : p.ws + WS_ROPS + ch) + (size_t)(slice * 128 + lane) * 2;
#pragma unroll
                    for (int mt = 0; mt < 2; ++mt) {
                        u32x4 o0, o1;
#pragma unroll
                        for (int e = 0; e < 4; ++e) { o0[e] = pack2(acc[mt][e * 2], acc[mt][e * 2 + 1]); o1[e] = pack2(acc[mt][8 + e * 2], acc[mt][8 + e * 2 + 1]); }
                        Yf[mt * 128] = o0; Yf[mt * 128 + 1] = o1;
                    }
                }
            }
        }
    }
    __syncthreads();
}

DI void rwkv_post_unit(const P& p, int li, int ch) {
    const int tid = tidx();
    const int h = ch & 7, n = (ch >> 3) & 63, b = ch >> 9;
    const int t0 = b * SEQ + n * 64;
    const int c = tid >> 2, cq = tid & 3;
    const bf16_t* Yf = (const bf16_t*)(p.ws + WS_ROPS + (size_t)ch * 16384);
    const bf16_t* vf = (const bf16_t*)(p.ws + WS_VF) + (size_t)(t0 + c) * 512 + h * 64 + cq * 16;
    const bf16_t* gg = (const bf16_t*)(p.ws + WS_GG) + (size_t)(t0 + c) * 512 + h * 64 + cq * 16;
    const float rk = ((const float*)(p.ws + WS_RK))[(size_t)(t0 + c) * 8 + h];
    const float* lnw = p.in[I_LNW] + li * 512 + h * 64 + cq * 16;
    const float* lnb = p.in[I_LNB] + li * 512 + h * 64 + cq * 16;
    bf16_t* mp = (bf16_t*)(p.ws + WS_HN) + (size_t)(t0 + c) * 1024 + 512 + h * 64 + cq * 16;
    const int mt = c >> 5, q4 = (c & 31) >> 2, hh = q4 & 1, rg = q4 >> 1, reg = rg * 4 + (c & 3), slice = cq >> 1, rb = (cq & 1) * 16;
    float y[16]; float sm = 0.f;
#pragma unroll
    for (int i = 0; i < 16; ++i) { y[i] = bf2f(Yf[(size_t)((slice * 2 + mt) * 64 + hh * 32 + rb + i) * 16 + reg]); sm += y[i]; }
    sm += __shfl_xor(sm, 1); sm += __shfl_xor(sm, 2);
    const float mean = sm * (1.f / 64.f);
    float vs = 0.f;
#pragma unroll
    for (int i = 0; i < 16; ++i) { y[i] -= mean; vs += y[i] * y[i]; }
    vs += __shfl_xor(vs, 1); vs += __shfl_xor(vs, 2);
    const float rs = rsqrtf(vs * (1.f / 64.f) + 64e-5f);
#pragma unroll
    for (int i8 = 0; i8 < 2; ++i8) {
        const u32x4 vw = *(const u32x4*)(vf + i8 * 8), gw = *(const u32x4*)(gg + i8 * 8);
        u32x4 w;
#pragma unroll
        for (int e = 0; e < 4; ++e) {
            const int i = i8 * 8 + e * 2;
            const float v0 = __uint_as_float(vw[e] << 16), v1 = __uint_as_float(vw[e] & 0xffff0000u), g0 = __uint_as_float(gw[e] << 16), g1 = __uint_as_float(gw[e] & 0xffff0000u);
            w[e] = pack2((y[i] * rs * lnw[i] + lnb[i] + rk * v0) * g0, (y[i + 1] * rs * lnw[i + 1] + lnb[i + 1] + rk * v1) * g1);
        }
        *(u32x4*)(mp + i8 * 8) = w;
    }
}


DI void attn_unit(const P& p, int unit, char* lds) {
    const int tid = tidx(), lane = tid & 63, w = tid >> 6, r_ = lane & 31, hl = lane >> 5;
    const int idx = unit & 31, h = (unit >> 5) & 7, g = (unit >> 8) % 3, b = unit / 768;
    const int lg2 = g * 2, dil = 1 << lg2, L = SEQ >> lg2, ntl = L >> 7;
    const int rs = idx / ntl, qt = idx % ntl;
    const int hg = g * 8 + h;
    const bf16_t* QK = (const bf16_t*)(p.ws + WS_QK);
    const bf16_t* VT = (const bf16_t*)(p.ws + WS_VT) + ((size_t)((b * 24 + hg) * dil + rs) * 64) * L;
    const int qi = 32 * w + r_;
    const int q_idx = 128 * qt + qi;
    const size_t qrow = (size_t)(b * SEQ + q_idx * dil + rs);
    const int kbase0 = 128 * qt - 128;
    char* Kt = lds;
    char* Vt = lds + 32768;
    __syncthreads();
#pragma unroll
    for (int i = 0; i < 8; ++i) {
        const int id = tid + i * 256, row = id >> 3, pc = id & 7, c = pc ^ ((row >> 1) & 7);
        int k_idx = kbase0 + row; if (k_idx < 0) k_idx = 0;
        glds16(QK + (size_t)(b * SEQ + k_idx * dil + rs) * 3072 + 1536 + hg * 64 + c * 8, Kt + id * 16);
    }
#pragma unroll
    for (int i = 0; i < 8; ++i) {
        const int id = tid + i * 256, row = id >> 5, pq = id & 31, q = pq ^ (row & 31);
        int k0 = kbase0 + q * 8; if (k0 < 0) k0 = 0;
        glds16(VT + (size_t)row * L + k0, Vt + id * 16);
    }
    bf16x8 qf[4];
#pragma unroll
    for (int ks = 0; ks < 4; ++ks) qf[ks] = *(const bf16x8*)(QK + qrow * 3072 + hg * 64 + 16 * ks + 8 * hl);
    asm volatile("s_waitcnt vmcnt(0)" ::: "memory");
    __syncthreads();
    f32x16 st[5];
    float mx = -1.0e30f;
#pragma unroll
    for (int kbi = 0; kbi < 5; ++kbi) {
        const int krow = 32 * (w + kbi) + r_;
#pragma unroll
        for (int r = 0; r < 16; ++r) st[kbi][r] = 0.f;
#pragma unroll
        for (int ks = 0; ks < 4; ++ks) {
            const bf16x8 kf = *(const bf16x8*)(Kt + krow * 128 + (((2 * ks + hl) ^ ((krow >> 1) & 7)) * 16));
            st[kbi] = mfma32(kf, qf[ks], st[kbi]);
        }
#pragma unroll
        for (int r = 0; r < 16; ++r) {
            const int kj = 32 * (w + kbi) + (r & 3) + 8 * (r >> 2) + 4 * hl;
            const bool valid = (kj >= qi) && (kj <= qi + 128) && (kbase0 + kj >= 0);
            const float sv = valid ? st[kbi][r] * 0.125f : -1.0e30f;
            st[kbi][r] = sv; mx = fmaxf(mx, sv);
        }
    }
    mx = fmaxf(mx, __shfl_xor(mx, 32));
    float l = 0.f;
#pragma unroll
    for (int kbi = 0; kbi < 5; ++kbi)
#pragma unroll
        for (int r = 0; r < 16; ++r) { const float pv = __expf(st[kbi][r] - mx); st[kbi][r] = pv; l += pv; }
    l += __shfl_xor(l, 32);
    f32x16 ot[2];
#pragma unroll
    for (int dt = 0; dt < 2; ++dt)
#pragma unroll
        for (int r = 0; r < 16; ++r) ot[dt][r] = 0.f;
#pragma unroll
    for (int kbi = 0; kbi < 5; ++kbi)
#pragma unroll
        for (int s2 = 0; s2 < 2; ++s2) {
            const bf16x8 pb = pack_step(st[kbi], s2);
            const int q0 = 4 * (w + kbi) + 2 * s2;
#pragma unroll
            for (int dt = 0; dt < 2; ++dt) {
                const int drow = 32 * dt + r_;
                const u32x2 lo = *(const u32x2*)(Vt + drow * 512 + ((q0 ^ (drow & 31)) * 16) + 8 * hl);
                const u32x2 hi = *(const u32x2*)(Vt + drow * 512 + (((q0 + 1) ^ (drow & 31)) * 16) + 8 * hl);
                u32x4 vw; vw.x = lo.x; vw.y = lo.y; vw.z = hi.x; vw.w = hi.y;
                ot[dt] = mfma32(__builtin_bit_cast(bf16x8, vw), pb, ot[dt]);
            }
        }
    const float inv = 1.f / l;
    bf16_t* og = (bf16_t*)(p.ws + WS_OG) + ((size_t)g * T + qrow) * 512 + h * 64;
#pragma unroll
    for (int dt = 0; dt < 2; ++dt)
#pragma unroll
        for (int rg = 0; rg < 4; ++rg) {
            u32x2 wv; wv.x = pack2(ot[dt][rg * 4] * inv, ot[dt][rg * 4 + 1] * inv); wv.y = pack2(ot[dt][rg * 4 + 2] * inv, ot[dt][rg * 4 + 3] * inv);
            *(u32x2*)(og + 32 * dt + 8 * rg + 4 * hl) = wv;
        }
    if (hl == 0) ((float*)(p.ws + WS_LSE))[((size_t)g * T + qrow) * 8 + h] = mx + __logf(l);
}
DI void phase_attn_merge(const P& p) {
    const bf16_t* og = (const bf16_t*)(p.ws + WS_OG);
    const float* lse = (const float*)(p.ws + WS_LSE);
    bf16_t* o = (bf16_t*)(p.ws + WS_HN);
    for (int i = bidx() * 256 + tidx(); i < T * 64; i += gridDim.x * 256) {
        const int t = i >> 6, c8 = i & 63, h = c8 >> 3;
        const float l0 = lse[(size_t)t * 8 + h], l1 = lse[((size_t)T + t) * 8 + h], l2 = lse[((size_t)2 * T + t) * 8 + h];
        const float m = fmaxf(l0, fmaxf(l1, l2));
        float w0 = __expf(l0 - m), w1 = __expf(l1 - m), w2 = __expf(l2 - m);
        const float inv = 1.f / (w0 + w1 + w2); w0 *= inv; w1 *= inv; w2 *= inv;
        const u32x4 a = *(const u32x4*)(og + (size_t)t * 512 + c8 * 8), bq = *(const u32x4*)(og + ((size_t)T + t) * 512 + c8 * 8), cq = *(const u32x4*)(og + ((size_t)2 * T + t) * 512 + c8 * 8);
        u32x4 r;
#pragma unroll
        for (int e = 0; e < 4; ++e) {
            const float x0 = w0 * __uint_as_float(a[e] << 16) + w1 * __uint_as_float(bq[e] << 16) + w2 * __uint_as_float(cq[e] << 16);
            const float x1 = w0 * __uint_as_float(a[e] & 0xffff0000u) + w1 * __uint_as_float(bq[e] & 0xffff0000u) + w2 * __uint_as_float(cq[e] & 0xffff0000u);
            r[e] = pack2(x0, x1);
        }
        *(u32x4*)(o + (size_t)t * 512 + c8 * 8) = r;
    }
}


#define XB_TMO      128
#define XB_XCNT(j)  (256  + 64 * (j))
#define XB_XSUB(j)  (1280 + 64 * (j))
#define XB_XGEN(j)  (2304 + 64 * (j))
#define XB_TOP      3328
#define XB_TOPGEN   3392
#define XCD_BAR_WORDS 3456
#define XB_SPIN_CAP (1u << 22)
#define LAS __attribute__((address_space(3)))
DI unsigned xb_ld(unsigned* p)              { return __hip_atomic_load(p, __ATOMIC_RELAXED, __HIP_MEMORY_SCOPE_AGENT); }
DI unsigned xb_add(unsigned* p, unsigned v) { return __hip_atomic_fetch_add(p, v, __ATOMIC_RELAXED, __HIP_MEMORY_SCOPE_AGENT); }
DI unsigned xb_xcc_id() { return (unsigned)__builtin_amdgcn_s_getreg((3 << 11) | 20) & 0xFu; }
#define XB_SPIN(cond, bar) do { unsigned _sp = 0; while (cond) { if (_sp < 32u) __builtin_amdgcn_s_sleep(2); else __builtin_amdgcn_s_sleep(24); \
    if ((++_sp & 255u) == 0u) { if (xb_ld(&(bar)[XB_TMO])) break; if (_sp > XB_SPIN_CAP) { atomicAdd(&(bar)[XB_TMO], 1u); break; } } } } while (0)
struct XcdBarrier { unsigned* bar; unsigned x; volatile LAS unsigned* st; };
DI XcdBarrier xcd_barrier_post(unsigned* bar, volatile LAS unsigned* st) {
    XcdBarrier b; b.bar = bar; b.x = xb_xcc_id(); b.st = st;
    if (threadIdx.x == 0) (void)xb_add(&bar[XB_XCNT(b.x)], 1u);
    return b;
}
DI void xcd_barrier_complete(unsigned* bar, unsigned x, unsigned& nloc, unsigned& nx) {
    const unsigned G = gridDim.x * gridDim.y * gridDim.z;
    unsigned sum, cnt, mine, sp = 0u;
    for (;;) {
        sum = 0u; cnt = 0u; mine = 0u;
#pragma unroll
        for (unsigned j = 0; j < 16; ++j) { const unsigned c = xb_ld(&bar[XB_XCNT(j)]); sum += c; cnt += (c > 0u) ? 1u : 0u; mine = (j == x) ? c : mine; }
        if (sum == G) break;
        __builtin_amdgcn_s_sleep(1);
        if ((++sp & 255u) == 0u) { if (xb_ld(&bar[XB_TMO])) break; if (sp > XB_SPIN_CAP) { atomicAdd(&bar[XB_TMO], 1u); break; } }
    }
    nloc = mine > 0u ? mine : 1u; nx = cnt > 0u ? cnt : 1u;
}
DI void xcd_barrier(const XcdBarrier& b) {
    asm volatile("s_waitcnt vmcnt(0)" ::: "memory");
    __syncthreads();
    if (threadIdx.x == 0) {
        unsigned* bar = b.bar; unsigned bx = b.x;
        asm volatile("" : "+s"(bar), "+s"(bx));
        __builtin_amdgcn_s_waitcnt(0);
        unsigned nloc = b.st[0], nx = b.st[1];
        if (nloc == 0u) { xcd_barrier_complete(bar, bx, nloc, nx); b.st[0] = nloc; b.st[1] = nx; }
        const unsigned old = xb_add(&bar[XB_XSUB(bx)], 1u);
        const unsigned gen = old / nloc;
        if (old + 1u == (gen + 1u) * nloc) {
            __builtin_amdgcn_fence(__ATOMIC_RELEASE, "agent");
            asm volatile("s_waitcnt vmcnt(0)" ::: "memory");
            const unsigned og = xb_add(&bar[XB_TOP], 1u);
            const unsigned tg = og / nx;
            if (og + 1u == (tg + 1u) * nx) xb_add(&bar[XB_TOPGEN], 1u);
            else XB_SPIN(xb_ld(&bar[XB_TOPGEN]) == tg, bar);
            __builtin_amdgcn_fence(__ATOMIC_ACQUIRE, "agent");
            xb_add(&bar[XB_XGEN(bx)], 1u);
            asm volatile("s_waitcnt vmcnt(0)" ::: "memory");
        } else {
            XB_SPIN(xb_ld(&bar[XB_XGEN(bx)]) == gen, bar);
            __builtin_amdgcn_fence(__ATOMIC_ACQUIRE, "agent");
            asm volatile("s_waitcnt vmcnt(0)" ::: "memory");
        }
    }
    __syncthreads();
}

constexpr int LDS_BYTES = RP_END;
static_assert(GP_END + 6144 <= LDS_BYTES, "LDS");
__global__ void __launch_bounds__(256, 2) mega(P p) {
    cg::grid_group grid = cg::this_grid();
    extern __shared__ __attribute__((aligned(16))) char lds[];
    if (threadIdx.x < 4) ((volatile LAS unsigned*)(lds + LDS_BYTES))[threadIdx.x] = 0u;
    __syncthreads();
    const XcdBarrier xb = xcd_barrier_post((unsigned*)(p.ws + WS_CTL + CTL_BAR), (volatile LAS unsigned*)(lds + LDS_BYTES));
#define GSYNC() xcd_barrier(xb)
    const bf16_t* HN = (const bf16_t*)(p.ws + WS_HN);
    const bf16_t* Win = (const bf16_t*)(p.ws + WS_W + W_IN);
    const bf16_t* Wout = (const bf16_t*)(p.ws + WS_W + W_OUT);
    phase_rope(p);
    phase_convert_io(p, 0, lds);
    phase_prep<0>(p, p.in[I_EVNORM], 0);
    if (p.ws == nullptr) grid.sync();
    GSYNC();
    volatile LAS unsigned* qword = (volatile LAS unsigned*)(lds + LDS_BYTES + 8);
    for (int layer = 0; layer < 4; ++layer) {
        const int li = layer >> 1;
        if ((layer & 1) == 0) {
            phase_gemm<EPI_EVEN_IN>(p, HN, 1024, Win, 1024, EVPAD / 128, lds);
            GSYNC();
            for (int u = bidx(); u < 1024; u += gridDim.x) gdn_prep_unit(p, li, u, lds);
            GSYNC();
            if (bidx() < 16) gdn_scan_block(p, bidx(), lds);
            {
                unsigned* qctr = (unsigned*)(p.ws + WS_CTL + CTL_QUEUE) + li * 64;
                for (;;) {
                    __syncthreads();
                    if (threadIdx.x == 0) *qword = atomicAdd(qctr, 1u);
                    __syncthreads();
                    const unsigned u = *qword;
                    if (u >= 2048u) break;
                    rwkv_prep_unit(p, li, (int)u, lds);
                }
            }
            GSYNC();
            if (bidx() < 32) rwkv_scan_block(p, bidx(), lds);
            else {
                for (int u = bidx() - 32; u < 1024; u += gridDim.x - 32) gdn_post_unit(p, li, u);
                phase_convert_moe(p, layer, lds, bidx() - 32, gridDim.x - 32);
            }
            GSYNC();
            for (int u = bidx(); u < 2048; u += gridDim.x) rwkv_post_unit(p, li, u);
            GSYNC();
            phase_gemm<EPI_RESID>(p, (const bf16_t*)(p.ws + WS_PROJ), EVLD, Wout, 1024, 8, lds, false, HN, 1024, 512);
        } else {
            phase_gemm<EPI_ODD_IN>(p, HN, 1024, Win, 1024, ODC / 128, lds);
            GSYNC();
            for (int u = bidx(); u < 3072; u += gridDim.x) attn_unit(p, u, lds);
            GSYNC();
            phase_attn_merge(p);
            GSYNC();
            phase_gemm<EPI_RESID>(p, HN, 512, Wout, 512, 8, lds);
        }
        GSYNC();
        phase_router(p, p.in[I_FFNNORM] + layer * 1024, layer, lds);
        GSYNC();
        phase_moe_up(p, layer, lds);
        GSYNC();
        phase_moe_down(p, layer, lds);
        GSYNC();
        if (layer < 3) {
            phase_convert_io(p, layer + 1, lds);
            if ((layer + 1) & 1) phase_convert_moe(p, layer + 1, lds, bidx(), gridDim.x);
            phase_prep<1>(p, ((layer + 1) & 1) ? p.in[I_ODNORM] + ((layer + 1) >> 1) * 1024 : p.in[I_EVNORM] + ((layer + 1) >> 1) * 1024, layer + 1);
            GSYNC();
        }
    }
    phase_prep<3>(p, p.in[I_FINAL], 0);
}

extern "C" void kernel_launch(void* const* d_in, const int* in_sizes, int n_in, void* d_out, int out_size, void* d_ws, size_t ws_size, hipStream_t stream) {
    if (n_in != 34 || out_size != T * D || ws_size < WS_END) { fprintf(stderr, "kernel_launch: unexpected shapes (n_in %d out %d ws %zu need %zu)\n", n_in, out_size, ws_size, (size_t)WS_END); return; }
    static int grid_blocks = 0;
    if (!grid_blocks) {
        int dev = 0, cus = 0, per_cu = 0;
        (void)hipGetDevice(&dev);
        (void)hipDeviceGetAttribute(&cus, hipDeviceAttributeMultiprocessorCount, dev);
        (void)hipFuncSetAttribute((const void*)mega, hipFuncAttributeMaxDynamicSharedMemorySize, LDS_BYTES + 16);
        (void)hipOccupancyMaxActiveBlocksPerMultiprocessor(&per_cu, mega, 256, LDS_BYTES + 16);
        if (per_cu < 1) per_cu = 1;
        if (per_cu > 2) per_cu = 2;
        grid_blocks = cus * per_cu;
    }
    P p{};
    for (int i = 0; i < 34; ++i) p.in[i] = (const float*)d_in[i];
    p.out = (float*)d_out; p.ws = (unsigned char*)d_ws;
    (void)hipMemsetAsync((char*)d_ws + WS_CTL, 0, 65536, stream);
    void* args[] = {&p};
    hipError_t e = hipLaunchCooperativeKernel((void*)mega, dim3(grid_blocks), dim3(256), args, LDS_BYTES + 16, stream);
    if (e != hipSuccess) fprintf(stderr, "cooperative launch failed: %s (grid %d)\n", hipGetErrorString(e), grid_blocks);
}
```

```cpp
#include <hip/hip_runtime.h>
#include <cstdio>
#include <cstdint>
#include <cmath>
#include <hip/hip_cooperative_groups.h>
namespace cg = cooperative_groups;

typedef unsigned short bf16_t;
typedef short bf16x8 __attribute__((ext_vector_type(8)));
typedef float f32x4 __attribute__((ext_vector_type(4)));
typedef unsigned u32x4 __attribute__((ext_vector_type(4)));
typedef unsigned u32x2 __attribute__((ext_vector_type(2)));
#define DI __device__ __forceinline__

constexpr int T = 16384, SEQ = 4096, BATCH = 4, D = 1024;
constexpr int EVC = 3784, EVLD = 3784, EVPAD = 3840;
constexpr int ODC = 4608;
constexpr int RW0 = 2056;
constexpr int C_R = 2056, C_K = 2568, C_V = 3080, C_HW = 3592, C_HA = 3624, C_HG = 3656, C_HV = 3752;
constexpr int NEXP = 16, FF = 256;
constexpr int HROWS = 34816;

constexpr size_t WS_CTL = 0;
constexpr size_t CTL_EGL = 4096;
constexpr size_t CTL_QUEUE = 49152;
constexpr size_t CTL_CNT = 32768;
constexpr size_t CTL_BAR = 16384;
constexpr size_t WS_LIST = 65536;
constexpr size_t WS_GATE = WS_LIST + 16 * 16384 * 4;
constexpr size_t WS_RK = WS_GATE + 16 * 16384 * 4;
constexpr size_t WS_SSQ = WS_RK + (size_t)T * 8 * 4;
constexpr size_t WS_ROPE = WS_SSQ + (size_t)16 * T * 4;
constexpr size_t WS_W = WS_ROPE + (size_t)T * 32 * 8;
constexpr size_t W_IN = 0;
constexpr size_t W_OUT = (size_t)4608 * 1024 * 2;
constexpr size_t W_13 = W_OUT + (size_t)1024 * 1024 * 2;
constexpr size_t W_2 = W_13 + (size_t)16 * 512 * 1024 * 2;
constexpr size_t W_LW = W_2 + (size_t)16 * 1024 * 256 * 2;
constexpr size_t W_BYTES = W_LW + (size_t)512 * 192 * 2;
constexpr size_t WS_HN = WS_W + W_BYTES;
constexpr size_t WS_VF = WS_HN + (size_t)T * 1024 * 2;
constexpr size_t WS_R2 = WS_VF + (size_t)T * 512 * 2;
constexpr size_t WS_PROJ = WS_R2;
constexpr size_t WS_GOPS = WS_R2 + (size_t)T * EVLD * 2;
constexpr size_t GOPS_CH = 73728, GO_UF = 0, GO_WF = 16384, GO_QF = 32768, GO_AF = 49152, GO_KF = 57344;
constexpr size_t WS_ROPS = WS_GOPS + 1024 * GOPS_CH;
constexpr size_t WS_QK = WS_R2;
constexpr size_t WS_VT = WS_QK + (size_t)T * 3072 * 2;
constexpr size_t WS_OG = WS_VT + (size_t)T * 1536 * 2;
constexpr size_t WS_LSE = WS_OG + (size_t)3 * T * 512 * 2;
constexpr size_t WS_END3 = WS_LSE + (size_t)3 * T * 8 * 4;
constexpr size_t WS_YS = WS_R2;
constexpr size_t WS_H = WS_YS + (size_t)2 * T * 1024 * 2;
constexpr size_t WS_GG = WS_ROPS + (size_t)2048 * 16384;
constexpr size_t WS_END0 = WS_GG + (size_t)T * 512 * 2;
constexpr size_t WS_END1 = WS_H + (size_t)HROWS * 256 * 2;
constexpr size_t WS_END2 = WS_R2 + (size_t)T * 4608 * 2;
static_assert(WS_END3 <= WS_END0, "odd-layer regions exceed even-layer footprint");
constexpr size_t WS_END = WS_END0 > WS_END1 ? (WS_END0 > WS_END2 ? WS_END0 : WS_END2) : (WS_END1 > WS_END2 ? WS_END1 : WS_END2);

constexpr size_t WS_DUMMY = WS_END0;
struct P {
    const float* in[34];
    float* out;
    unsigned char* ws;
};
enum { I_X = 0, I_POS, I_EVNORM, I_EVWIN, I_VRESDOWN, I_EVWOUT, I_CONVW, I_ALOG, I_DTB, I_GDNNORM, I_MU, I_W0, I_W2, I_A0, I_A2, I_G2,
       I_KK, I_KA, I_RK, I_LNW, I_LNB, I_VRESMU, I_V0, I_V2, I_ODNORM, I_ODWIN, I_ODWOUT, I_FFNNORM, I_WGROUP, I_WEXPERT, I_W1, I_W3, I_MW2, I_FINAL };

DI int tidx() { int t = threadIdx.x; asm volatile("" : "+v"(t)); return t; }
DI int bidx() { int b = blockIdx.x; asm volatile("" : "+s"(b)); return b; }
typedef __bf16 bf2_t __attribute__((ext_vector_type(2)));
typedef float f2_t __attribute__((ext_vector_type(2)));
DI bf16_t f2bf(float x) { return __builtin_bit_cast(bf16_t, (__bf16)x); }
DI float bf2f(bf16_t h) { return __uint_as_float(((unsigned)h) << 16); }
DI unsigned pack2(float lo, float hi) { const f2_t v = {lo, hi}; return __builtin_bit_cast(unsigned, __builtin_convertvector(v, bf2_t)); }
DI float wave_sum(float v) {
#pragma unroll
    for (int o = 32; o > 0; o >>= 1) v += __shfl_xor(v, o);
    return v;
}
DI float wave_max(float v) {
#pragma unroll
    for (int o = 32; o > 0; o >>= 1) v = fmaxf(v, __shfl_xor(v, o));
    return v;
}
DI float sigmoidf_(float x) { return __builtin_amdgcn_rcpf(1.f + __expf(-x)); }
DI float siluf_(float x) { return x * __builtin_amdgcn_rcpf(1.f + __expf(-x)); }
DI float softplusf_(float x) { return fmaxf(x, 0.f) + __logf(1.f + __expf(-fabsf(x))); }

struct ConvJob { const float* src; bf16_t* dst; int K, N, ldd; int mode; };
DI int rowmap(int mode, int n) { return mode == 0 ? n : ((n >> 4) * 32 + (n & 15) + (mode == 2 ? 16 : 0)); }
DI void conv_tile(const ConvJob& j, int tile, float* lds  ) {
    const int ntn = (j.N + 255) / 256;
    const int tk = tile / ntn, tn = tile % ntn;
    const int tid = tidx();
    __syncthreads();
    float4 v[16];
#pragma unroll
    for (int i = 0; i < 16; ++i) {
        const int e = tid + i * 256, k = e >> 6, n4 = (e & 63) * 4;
        const int gk = tk * 64 + k, gn = tn * 256 + n4;
        v[i] = make_float4(0.f, 0.f, 0.f, 0.f);
        if (gn < j.N) v[i] = *(const float4*)(j.src + (size_t)gk * j.N + gn);
    }
#pragma unroll
    for (int i = 0; i < 16; ++i) { const int e = tid + i * 256, k = e >> 6, n4 = (e & 63) * 4; *(float4*)(lds + k * 260 + n4) = v[i]; }
    __syncthreads();
#pragma unroll
    for (int i = 0; i < 8; ++i) {
        const int e = tid + i * 256, n = e & 255, k8 = (e >> 8) * 8;
        const int gn = tn * 256 + n;
        if (gn < j.N) {
            u32x4 w;
            w.x = pack2(lds[(k8 + 0) * 260 + n], lds[(k8 + 1) * 260 + n]); w.y = pack2(lds[(k8 + 2) * 260 + n], lds[(k8 + 3) * 260 + n]);
            w.z = pack2(lds[(k8 + 4) * 260 + n], lds[(k8 + 5) * 260 + n]); w.w = pack2(lds[(k8 + 6) * 260 + n], lds[(k8 + 7) * 260 + n]);
            *(u32x4*)(j.dst + (size_t)rowmap(j.mode, gn) * j.ldd + tk * 64 + k8) = w;
        }
    }
}
DI void phase_convert_io(const P& p, int layer, char* ldsc) {
    float* lds = (float*)ldsc;
    unsigned char* W = p.ws + WS_W;
    const int li = layer >> 1;
    if ((layer & 1) == 0) {
        const ConvJob j0{p.in[I_EVWIN] + (size_t)li * 1024 * 3752, (bf16_t*)(W + W_IN), 1024, 3752, 1024, 0};
        for (int t = bidx(); t < 16 * 15; t += gridDim.x) conv_tile(j0, t, lds);
        if (li == 1) {
            const ConvJob j1{p.in[I_VRESDOWN], (bf16_t*)(W + W_IN) + (size_t)3752 * 1024, 1024, 32, 1024, 0};
            for (int t = bidx(); t < 16; t += gridDim.x) conv_tile(j1, t, lds);
        }
        const ConvJob j2{p.in[I_EVWOUT] + (size_t)li * 1024 * 1024, (bf16_t*)(W + W_OUT), 1024, 1024, 1024, 0};
        for (int t = bidx(); t < 16 * 4; t += gridDim.x) conv_tile(j2, t, lds);
        {
            bf16_t* LW = (bf16_t*)(W + W_LW);
            for (int i = bidx() * 256 + tidx(); i < 512 * 192; i += gridDim.x * 256) {
                const int ch = i / 192, j = i % 192;
                float v;
                if (j < 32) v = p.in[I_W2][((size_t)li * 32 + j) * 512 + ch];
                else if (j < 64) v = p.in[I_A2][((size_t)li * 32 + j - 32) * 512 + ch];
                else if (j < 160) v = p.in[I_G2][((size_t)li * 96 + j - 64) * 512 + ch];
                else v = (li == 1) ? p.in[I_V2][(size_t)(j - 160) * 512 + ch] : 0.f;
                LW[i] = f2bf(v);
            }
        }
        const int r0 = (li == 1) ? 3784 : 3752;
        bf16_t* z = (bf16_t*)(W + W_IN) + (size_t)r0 * 1024;
        const size_t n = (size_t)(EVPAD - r0) * 1024;
        for (size_t i = (size_t)bidx() * 256 + tidx(); i < n; i += (size_t)gridDim.x * 256) z[i] = 0;
    } else {
        const ConvJob j0{p.in[I_ODWIN] + (size_t)li * 1024 * 4608, (bf16_t*)(W + W_IN), 1024, 4608, 1024, 0};
        for (int t = bidx(); t < 16 * 18; t += gridDim.x) conv_tile(j0, t, lds);
        const ConvJob j2{p.in[I_ODWOUT] + (size_t)li * 512 * 1024, (bf16_t*)(W + W_OUT), 512, 1024, 512, 0};
        for (int t = bidx(); t < 8 * 4; t += gridDim.x) conv_tile(j2, t, lds);
    }
}
DI void phase_convert_moe(const P& p, int layer, char* ldsc, int b0, int bs) {
    float* lds = (float*)ldsc;
    unsigned char* W = p.ws + WS_W;
    for (int t = b0; t < 16 * 3 * 16; t += bs) {
        const int e = t / 48, r = t % 48, which = r / 16, tile = r % 16;
        ConvJob j;
        if (which == 0) j = ConvJob{p.in[I_W1] + ((size_t)layer * 16 + e) * 1024 * 256, (bf16_t*)(W + W_13) + (size_t)e * 512 * 1024, 1024, 256, 1024, 1};
        else if (which == 1) j = ConvJob{p.in[I_W3] + ((size_t)layer * 16 + e) * 1024 * 256, (bf16_t*)(W + W_13) + (size_t)e * 512 * 1024, 1024, 256, 1024, 2};
        else j = ConvJob{p.in[I_MW2] + ((size_t)layer * 16 + e) * 256 * 1024, (bf16_t*)(W + W_2) + (size_t)e * 1024 * 256, 256, 1024, 256, 0};
        conv_tile(j, tile, lds);
    }
}

DI void phase_rope(const P& p) {
    float2* tab = (float2*)(p.ws + WS_ROPE);
    const int* pos = (const int*)p.in[I_POS];
    for (int i = bidx() * 256 + tidx(); i < T * 32; i += gridDim.x * 256) {
        const int t = i >> 5, f = i & 31;
        const float inv = powf(10000.0f, -(float)f * (2.0f / 64.0f));
        const float ang = (float)pos[t] * inv;
        float s, c; sincosf(ang, &s, &c);
        tab[i] = make_float2(c, s);
    }
}

template <int MODE>
DI void phase_prep(const P& p, const float* gain, int layer, bool dry = false) {
    const int lane = tidx() & 63, wid = tidx() >> 6;
    const int nw = gridDim.x * 4;
    bf16_t* hn = (bf16_t*)(p.ws + WS_HN);
    const bf16_t* y0 = (const bf16_t*)(p.ws + WS_YS);
    const bf16_t* y1 = y0 + (size_t)T * 1024;
    float4 gq[4];
#pragma unroll
    for (int i = 0; i < 4; ++i) gq[i] = *(const float4*)(gain + i * 256 + lane * 4);
    for (int t = bidx() * 4 + wid; t < T; t += nw) {
        float4 v[4];
        float ss = 0.f;
#pragma unroll
        for (int i = 0; i < 4; ++i) {
            const size_t off = (size_t)t * 1024 + i * 256 + lane * 4;
            if (MODE == 0) v[i] = *(const float4*)(p.in[I_X] + off);
            else v[i] = *(const float4*)(p.out + off);
            if (MODE == 1 || MODE == 3) {
                const u32x2 a = *(const u32x2*)(y0 + off), b = *(const u32x2*)(y1 + off);
                v[i].x += __uint_as_float(a.x << 16) + __uint_as_float(b.x << 16); v[i].y += __uint_as_float(a.x & 0xffff0000u) + __uint_as_float(b.x & 0xffff0000u);
                v[i].z += __uint_as_float(a.y << 16) + __uint_as_float(b.y << 16); v[i].w += __uint_as_float(a.y & 0xffff0000u) + __uint_as_float(b.y & 0xffff0000u);
            }
            ss += v[i].x * v[i].x + v[i].y * v[i].y + v[i].z * v[i].z + v[i].w * v[i].w;
        }
        ss = wave_sum(ss);
        const float rstd = rsqrtf(ss * (1.0f / 1024.0f) + 1e-6f);
        float lg[20];
        if (MODE == 2) {
#pragma unroll
            for (int q = 0; q < 20; ++q) lg[q] = 0.f;
        }
#pragma unroll
        for (int i = 0; i < 4; ++i) {
            const int col = i * 256 + lane * 4;
            const size_t off = (size_t)t * 1024 + col;
            const float4 g = gq[i];
            float4 h; h.x = v[i].x * rstd * g.x; h.y = v[i].y * rstd * g.y; h.z = v[i].z * rstd * g.z; h.w = v[i].w * rstd * g.w;
            float* od = dry ? (float*)(p.ws + WS_DUMMY) + (off & 0x7FFFF) : p.out + off;
            bf16_t* hd = dry ? (bf16_t*)(p.ws + WS_DUMMY + 2097152) + (off & 0x7FFFF) : hn + off;
            if (MODE == 0 || MODE == 1) *(float4*)od = v[i];
            if (MODE == 3) *(float4*)od = h;
            else { u32x2 w; w.x = pack2(h.x, h.y); w.y = pack2(h.z, h.w); *(u32x2*)hd = w; }
            if (MODE == 2) {
                const float hh[4] = {h.x, h.y, h.z, h.w};
                const float* wg = p.in[I_WGROUP] + (size_t)layer * 1024 * 4;
                const float* we = p.in[I_WEXPERT] + (size_t)layer * 4 * 1024 * 4;
#pragma unroll
                for (int e = 0; e < 4; ++e) {
                    const float4 a = *(const float4*)(wg + (size_t)(col + e) * 4);
                    lg[0] += hh[e] * a.x; lg[1] += hh[e] * a.y; lg[2] += hh[e] * a.z; lg[3] += hh[e] * a.w;
#pragma unroll
                    for (int g2 = 0; g2 < 4; ++g2) {
                        const float4 b = *(const float4*)(we + ((size_t)g2 * 1024 + col + e) * 4);
                        lg[4 + g2 * 4 + 0] += hh[e] * b.x; lg[4 + g2 * 4 + 1] += hh[e] * b.y; lg[4 + g2 * 4 + 2] += hh[e] * b.z; lg[4 + g2 * 4 + 3] += hh[e] * b.w;
                    }
                }
            }
        }
        if (MODE == 2) {
#pragma unroll
            for (int q = 0; q < 20; ++q) lg[q] = wave_sum(lg[q]);
            if (lane == 0) {
                int gs = 0; float gm = lg[0];
#pragma unroll
                for (int g2 = 1; g2 < 4; ++g2) if (lg[g2] > gm) { gm = lg[g2]; gs = g2; }
                float den = 0.f;
#pragma unroll
                for (int g2 = 0; g2 < 4; ++g2) den += __expf(lg[g2] - gm);
                const float pg = 1.f / den;
                float el[4];
#pragma unroll
                for (int e = 0; e < 4; ++e) el[e] = gs == 0 ? lg[4 + e] : gs == 1 ? lg[8 + e] : gs == 2 ? lg[12 + e] : lg[16 + e];
                int i1 = 0; float v1 = el[0];
#pragma unroll
                for (int e = 1; e < 4; ++e) if (el[e] > v1) { v1 = el[e]; i1 = e; }
                int i2 = 0; float v2 = -3.4e38f;
#pragma unroll
                for (int e = 0; e < 4; ++e) if (e != i1 && el[e] > v2) { v2 = el[e]; i2 = e; }
                const float e2 = __expf(v2 - v1);
                const float g1 = pg / (1.f + e2), g2v = pg * e2 / (1.f + e2);
                unsigned* cnt = (unsigned*)(p.ws + WS_CTL + CTL_CNT) + layer * 16 * 64;
                int* list = (int*)(p.ws + WS_LIST);
                float* gl = (float*)(p.ws + WS_GATE);
                const int ea = gs * 4 + i1, eb = gs * 4 + i2;
                const unsigned ra = atomicAdd(&cnt[ea * 64], 1u);
                list[ea * 16384 + ra] = t * 2; gl[ea * 16384 + ra] = g1;
                const unsigned rb = atomicAdd(&cnt[eb * 64], 1u);
                list[eb * 16384 + rb] = t * 2 + 1; gl[eb * 16384 + rb] = g2v;
            }
        }
    }
}


typedef __attribute__((address_space(3))) unsigned lds_u32;
DI void g_dma(unsigned m0v, unsigned voff, const char* sbase) {
    asm volatile("s_mov_b32 m0, %0\n\ts_nop 0\n\tglobal_load_lds_dwordx4 %1, %2" :: "s"(m0v), "v"(voff), "s"(sbase) : "memory", "m0");
}
DI void phase_router(const P& p, const float* gain, int layer, char* ldsc) {
    const int tid = tidx(), lane = tid & 63, wid = tid >> 6;
    bf16_t* hn = (bf16_t*)(p.ws + WS_HN);
    const float* wg = p.in[I_WGROUP] + (size_t)layer * 1024 * 4;
    const float* we = p.in[I_WEXPERT] + (size_t)layer * 4 * 1024 * 4;
    unsigned* cnt = (unsigned*)(p.ws + WS_CTL + CTL_CNT) + layer * 16 * 64;
    int* list = (int*)(p.ws + WS_LIST);
    float* gl = (float*)(p.ws + WS_GATE);
    f32x4* WS = (f32x4*)ldsc;
    unsigned* lcnt = (unsigned*)(ldsc + 40960); unsigned* lbase = lcnt + 16; int* e_ent = (int*)(lcnt + 32); unsigned* r_ent = (unsigned*)(e_ent + 32); int* t_ent = (int*)(r_ent + 32); float* g_ent = (float*)(t_ent + 32);
    const unsigned wsb = (unsigned)__builtin_amdgcn_readfirstlane((int)((unsigned)(size_t)(lds_u32*)ldsc + wid * 1024));
    auto stage = [&](int i, int buf) {
        const unsigned voff = (unsigned)(i * 256 + lane * 4 + wid) * 16u;
#pragma unroll
        for (int r = 0; r < 5; ++r) g_dma(wsb + (unsigned)(buf * 1280 + r * 256) * 16u, voff, (const char*)(r == 0 ? wg : we + (size_t)(r - 1) * 4096));
    };
    float4 xq[4];
#pragma unroll
    for (int q = 0; q < 4; ++q) xq[q] = *(const float4*)(p.out + (size_t)(bidx() * 16 + wid * 4 + q) * 1024 + lane * 4);
    for (int tb = bidx() * 16; tb < T; tb += gridDim.x * 16) {
        const int t0 = tb + wid * 4;
        __syncthreads();
        if (tid < 16) lcnt[tid] = 0u;
        stage(0, 0);
        float rstd[4];
        {
            const float pq = ((const float*)(p.ws + WS_SSQ))[(size_t)(lane & 15) * T + t0 + (lane >> 4)];
            float ss = pq;
            ss += __shfl_xor(ss, 1); ss += __shfl_xor(ss, 2); ss += __shfl_xor(ss, 4); ss += __shfl_xor(ss, 8);
#pragma unroll
            for (int q = 0; q < 4; ++q) rstd[q] = rsqrtf(__shfl(ss, q * 16) * (1.0f / 1024.0f) + 1e-6f);
        }
        float lg[4][20];
#pragma unroll
        for (int q = 0; q < 4; ++q)
#pragma unroll
            for (int j = 0; j < 20; ++j) lg[q][j] = 0.f;
        asm volatile("s_waitcnt vmcnt(0)" ::: "memory");
#pragma unroll 1
        for (int i = 0; i < 4; ++i) {
            if (i > 0) asm volatile("s_waitcnt vmcnt(4)" ::: "memory");
            __syncthreads();
            if (i + 1 < 4) stage(i + 1, (i + 1) & 1);
            const f32x4* W = WS + (i & 1) * 1280;
            const int col = i * 256 + lane * 4;
            const float4 g = *(const float4*)(gain + col);
            float hh[4][4];
#pragma unroll
            for (int q = 0; q < 4; ++q) {
                hh[q][0] = xq[q].x * rstd[q] * g.x; hh[q][1] = xq[q].y * rstd[q] * g.y; hh[q][2] = xq[q].z * rstd[q] * g.z; hh[q][3] = xq[q].w * rstd[q] * g.w;
            }
            {
                int tn0 = i + 1 < 4 ? t0 : t0 + (int)gridDim.x * 16; const int cn = ((i + 1) & 3) * 256 + lane * 4;
                tn0 = tn0 < T ? tn0 : t0;
#pragma unroll
                for (int q = 0; q < 4; ++q) xq[q] = *(const float4*)(p.out + (size_t)(tn0 + q) * 1024 + cn);
            }
#pragma unroll
            for (int q = 0; q < 4; ++q) {
                u32x2 w; w.x = pack2(hh[q][0], hh[q][1]); w.y = pack2(hh[q][2], hh[q][3]);
                *(u32x2*)(hn + (size_t)(t0 + q) * 1024 + col) = w;
            }
#pragma unroll
            for (int e = 0; e < 4; ++e) {
                const f32x4 a = W[(0 * 4 + e) * 64 + lane];
#pragma unroll
                for (int q = 0; q < 4; ++q) { lg[q][0] += hh[q][e] * a[0]; lg[q][1] += hh[q][e] * a[1]; lg[q][2] += hh[q][e] * a[2]; lg[q][3] += hh[q][e] * a[3]; }
#pragma unroll
                for (int g2 = 0; g2 < 4; ++g2) {
                    const f32x4 b = W[((1 + g2) * 4 + e) * 64 + lane];
#pragma unroll
                    for (int q = 0; q < 4; ++q) { lg[q][4 + g2 * 4] += hh[q][e] * b[0]; lg[q][5 + g2 * 4] += hh[q][e] * b[1]; lg[q][6 + g2 * 4] += hh[q][e] * b[2]; lg[q][7 + g2 * 4] += hh[q][e] * b[3]; }
                }
            }
        }
#pragma unroll
        for (int q = 0; q < 4; ++q) {
#pragma unroll
            for (int j = 0; j < 20; ++j) lg[q][j] = wave_sum(lg[q][j]);
            if (lane == q) {
                const int t = t0 + q;
                int gs = 0; float gm = lg[q][0];
#pragma unroll
                for (int g2 = 1; g2 < 4; ++g2) if (lg[q][g2] > gm) { gm = lg[q][g2]; gs = g2; }
                float den = 0.f;
#pragma unroll
                for (int g2 = 0; g2 < 4; ++g2) den += __expf(lg[q][g2] - gm);
                const float pg = 1.f / den;
                float el[4];
#pragma unroll
                for (int e = 0; e < 4; ++e) el[e] = gs == 0 ? lg[q][4 + e] : gs == 1 ? lg[q][8 + e] : gs == 2 ? lg[q][12 + e] : lg[q][16 + e];
                int i1 = 0; float v1 = el[0];
#pragma unroll
                for (int e = 1; e < 4; ++e) if (el[e] > v1) { v1 = el[e]; i1 = e; }
                int i2 = 0; float v2 = -3.4e38f;
#pragma unroll
                for (int e = 0; e < 4; ++e) if (e != i1 && el[e] > v2) { v2 = el[e]; i2 = e; }
                const float e2 = __expf(v2 - v1);
                const float g1 = pg / (1.f + e2), g2v = pg * e2 / (1.f + e2);
                const int ea = gs * 4 + i1, eb = gs * 4 + i2;
                const int sl = (wid * 4 + q) * 2;
                e_ent[sl] = ea; r_ent[sl] = atomicAdd(&lcnt[ea], 1u); t_ent[sl] = t * 2; g_ent[sl] = g1;
                e_ent[sl + 1] = eb; r_ent[sl + 1] = atomicAdd(&lcnt[eb], 1u); t_ent[sl + 1] = t * 2 + 1; g_ent[sl + 1] = g2v;
            }
        }
        __syncthreads();
        if (tid < 16) lbase[tid] = lcnt[tid] ? atomicAdd(&cnt[tid * 64], lcnt[tid]) : 0u;
        __syncthreads();
        if (tid < 32) {
            const int e = e_ent[tid];
            const unsigned pos = (lbase[e] + r_ent[tid]) & 16383u;
            list[e * 16384 + pos] = t_ent[tid]; gl[e * 16384 + pos] = g_ent[tid];
        }
    }
}

constexpr int GBK = 64;
struct TileP { int arow[4]; unsigned bo[4]; };
struct GOps { const char* A; unsigned la; const char* A2; unsigned la2; const char* B; };
DI void gemm_core(const GOps& o, const TileP& tp, int K, char* lds, f32x4 (&acc)[4][4], int ksplit, bool primed, const TileP& nx, bool have_nx) {
    const int tid = tidx(), wid = tid >> 6, lane = tid & 63, wr = wid >> 1, wc = wid & 1, fr = lane & 15, fq = lane >> 4;
    const unsigned scol = ((tid & 7) ^ ((tid >> 3) & 7)) * 16;
#pragma unroll
    for (int n = 0; n < 4; ++n)
#pragma unroll
        for (int m = 0; m < 4; ++m) acc[n][m] = (f32x4){0.f, 0.f, 0.f, 0.f};
    const int nk = K / GBK;
    if (!primed) {
        __syncthreads();
#pragma unroll
        for (int i = 0; i < 4; ++i) {
            __builtin_amdgcn_global_load_lds((const unsigned*)(o.A + (__umul24(tp.arow[i], o.la) + scol)), (lds_u32*)(lds + tid * 16 + i * 4096), 16, 0, 0);
            __builtin_amdgcn_global_load_lds((const unsigned*)(o.B + (tp.bo[i] + scol)), (lds_u32*)(lds + 16384 + tid * 16 + i * 4096), 16, 0, 0);
        }
    }
    const int sw = fr & 7;
    const unsigned aoff = (wr * 64 + fr) * 128, boff = (wc * 64 + fr) * 128, co0 = (fq ^ sw) * 16, co1 = ((4 + fq) ^ sw) * 16;
    bf16x8 a0[4], b0[4], a1[4], b1[4];
#define G_ISSUE(kt_)                                                                                                                        \
    if ((kt_) + 1 < nk) {                                                                                                                   \
        char* nb = lds + (((kt_) + 1) & 1) * 32768;                                                                                         \
        const unsigned ko = ((kt_) + 1) * (GBK * 2) + scol;                                                                                 \
        const bool hi = ((kt_) + 1) * GBK >= ksplit;                                                                                        \
        const char* Ab = hi ? o.A2 : o.A; const unsigned la = hi ? o.la2 : o.la;                                                            \
        _Pragma("unroll") for (int i = 0; i < 4; ++i) {                                                                                     \
            __builtin_amdgcn_global_load_lds((const unsigned*)(Ab + (__umul24(tp.arow[i], la) + ko)), (lds_u32*)(nb + tid * 16 + i * 4096), 16, 0, 0);   \
            __builtin_amdgcn_global_load_lds((const unsigned*)(o.B + (tp.bo[i] + ko)), (lds_u32*)(nb + 16384 + tid * 16 + i * 4096), 16, 0, 0);      \
        }                                                                                                                                   \
    } else if (have_nx) {        \
        _Pragma("unroll") for (int i = 0; i < 4; ++i) {                                                                                     \
            __builtin_amdgcn_global_load_lds((const unsigned*)(o.A + (__umul24(nx.arow[i], o.la) + scol)), (lds_u32*)(lds + tid * 16 + i * 4096), 16, 0, 0);          \
            __builtin_amdgcn_global_load_lds((const unsigned*)(o.B + (nx.bo[i] + scol)), (lds_u32*)(lds + 16384 + tid * 16 + i * 4096), 16, 0, 0);  \
        }                                                                                                                                   \
    }
#define G_READ(A_, B_, AD_)                                                                                                                 \
    asm volatile("ds_read_b128 %0, %8\n\tds_read_b128 %1, %8 offset:2048\n\tds_read_b128 %2, %8 offset:4096\n\tds_read_b128 %3, %8 offset:6144\n\t"       \
                 "ds_read_b128 %4, %9 offset:16384\n\tds_read_b128 %5, %9 offset:18432\n\tds_read_b128 %6, %9 offset:20480\n\tds_read_b128 %7, %9 offset:22528" \
                 : "=&v"(A_[0]), "=&v"(A_[1]), "=&v"(A_[2]), "=&v"(A_[3]), "=&v"(B_[0]), "=&v"(B_[1]), "=&v"(B_[2]), "=&v"(B_[3]) : "v"((AD_) + aoff), "v"((AD_) + boff) : "memory");
#define G_WAIT(A_, B_, N_)                                                                                                                  \
    asm volatile("s_waitcnt lgkmcnt(" #N_ ")" : "+v"(A_[0]), "+v"(A_[1]), "+v"(A_[2]), "+v"(A_[3]), "+v"(B_[0]), "+v"(B_[1]), "+v"(B_[2]), "+v"(B_[3]) :: "memory");
#define G_MMA(A_, B_)                                                                                                                       \
    _Pragma("unroll") for (int n = 0; n < 4; ++n)                                                                                           \
        _Pragma("unroll") for (int m = 0; m < 4; ++m) acc[n][m] = __builtin_amdgcn_mfma_f32_16x16x32_bf16(B_[n], A_[m], acc[n][m], 0, 0, 0);
    const unsigned lbase = (unsigned)(size_t)(lds_u32*)lds;
    __builtin_amdgcn_s_waitcnt(0x0070);
    __builtin_amdgcn_s_barrier();
    G_ISSUE(0)
    G_READ(a0, b0, lbase + co0)
    G_READ(a1, b1, lbase + co1)
    G_WAIT(a0, b0, 8)
    __builtin_amdgcn_sched_barrier(0);
    G_MMA(a0, b0)
    __builtin_amdgcn_sched_barrier(0);
    G_WAIT(a1, b1, 0)
#pragma unroll 1
    for (int kt = 1; kt < nk; ++kt) {
        __builtin_amdgcn_s_waitcnt(0x0070);
        __builtin_amdgcn_s_barrier();
        G_ISSUE(kt)
        const unsigned S = lbase + (kt & 1) * 32768;
        G_READ(a0, b0, S + co0)
        __builtin_amdgcn_sched_barrier(0);
        G_MMA(a1, b1)
        __builtin_amdgcn_sched_barrier(0);
        G_READ(a1, b1, S + co1)
        G_WAIT(a0, b0, 8)
        __builtin_amdgcn_sched_barrier(0);
        G_MMA(a0, b0)
        __builtin_amdgcn_sched_barrier(0);
        G_WAIT(a1, b1, 0)
    }
    G_MMA(a1, b1)
#undef G_ISSUE
#undef G_READ
#undef G_WAIT
#undef G_MMA
}

enum { EPI_EVEN_IN = 0, EPI_ODD_IN, EPI_RESID };
template <int EPI>
DI void phase_gemm(const P& p, const bf16_t* A, int lda, const bf16_t* Bt, int K, int ntn, char* lds, bool dry = false, const bf16_t* A2 = nullptr, int lda2 = 0, int ksplit = 1 << 30) {
    const int tid = tidx(), wid = tid >> 6, lane = tid & 63, wr = wid >> 1, wc = wid & 1, fr = lane & 15, fq = lane >> 4;
    const int ntm = T / 128, ntiles = ntm * ntn;
    auto fill = [&](TileP& t, int tile) {
        const int tn = tile / ntm, tm = tile % ntm, r = tid >> 3;
#pragma unroll
        for (int i = 0; i < 4; ++i) { t.arow[i] = tm * 128 + r + 32 * i; t.bo[i] = (unsigned)(tn * 128 + r + 32 * i) * (unsigned)(K * 2); }
    };
    const GOps gop{(const char*)A, (unsigned)lda * 2u, (const char*)(A2 ? A2 : A), (unsigned)(A2 ? lda2 : lda) * 2u, (const char*)Bt};
    TileP cur, nxt;
    bool primed = false;
    fill(cur, bidx() < ntiles ? bidx() : 0); nxt = cur;
    for (int tile = bidx(); tile < ntiles; tile += gridDim.x) {
        const int tn = tile / ntm, tm = tile % ntm;
        const bool have_next = tile + (int)gridDim.x < ntiles;
        if (have_next) fill(nxt, tile + gridDim.x);
        f32x4 acc[4][4];
        gemm_core(gop, cur, K, lds, acc, ksplit, primed, nxt, have_next);
        primed = have_next; cur = nxt;
        const int m0 = tm * 128 + wr * 64, n0 = tn * 128 + wc * 64;
        if (EPI == EPI_EVEN_IN) {
            bf16_t* C = (bf16_t*)(p.ws + WS_PROJ);
#pragma unroll
            for (int m = 0; m < 4; ++m)
#pragma unroll
                for (int n = 0; n < 4; ++n) {
                    const int row = m0 + m * 16 + fr, col = n0 + n * 16 + fq * 4;
                    if (col < EVC) { u32x2 w; w.x = pack2(acc[n][m][0], acc[n][m][1]); w.y = pack2(acc[n][m][2], acc[n][m][3]); *(u32x2*)(C + (size_t)row * EVLD + col) = w; }
                }
        } else if (EPI == EPI_ODD_IN) {
            bf16_t* C = (bf16_t*)(p.ws + WS_QK);
            const float2* tab = (const float2*)(p.ws + WS_ROPE);
            if (n0 < 3072) {
#pragma unroll
                for (int m = 0; m < 4; ++m) {
                    const int row = m0 + m * 16 + fr;
#pragma unroll
                    for (int n = 0; n < 2; ++n) {
                        float lo[4], hi[4];
#pragma unroll
                        for (int j = 0; j < 4; ++j) {
                            const float2 cs = tab[(size_t)row * 32 + n * 16 + fq * 4 + j];
                            const float x1 = acc[n][m][j], x2 = acc[n + 2][m][j];
                            lo[j] = x1 * cs.x - x2 * cs.y; hi[j] = x2 * cs.x + x1 * cs.y;
                        }
                        u32x2 w; w.x = pack2(lo[0], lo[1]); w.y = pack2(lo[2], lo[3]);
                        *(u32x2*)(C + (size_t)row * 3072 + n0 + n * 16 + fq * 4) = w;
                        w.x = pack2(hi[0], hi[1]); w.y = pack2(hi[2], hi[3]);
                        *(u32x2*)(C + (size_t)row * 3072 + n0 + (n + 2) * 16 + fq * 4) = w;
                    }
                }
            }
            if (tn * 128 >= 3072) {
                bf16_t* VT = (bf16_t*)(p.ws + WS_VT);
                const int hg0 = (tn * 128 - 3072) >> 6, g = hg0 >> 3, lg2 = g * 2, dil = 1 << lg2, L = SEQ >> lg2, run = 128 >> lg2;
                __syncthreads();
#pragma unroll
                for (int m = 0; m < 4; ++m)
#pragma unroll
                    for (int n = 0; n < 4; ++n)
#pragma unroll
                        for (int j = 0; j < 4; ++j)
                            *(bf16_t*)(lds + 32768 + (wc * 64 + n * 16 + fq * 4 + j) * 272 + (wr * 64 + m * 16 + fr) * 2) = f2bf(acc[n][m][j]);
                __syncthreads();
                const int bb = (tm * 128) >> 12, s0 = (tm * 128) & (SEQ - 1);
#pragma unroll
                for (int q = 0; q < 8; ++q) {
                    const int item = tid + q * 256, dim = item >> 4, o0 = (item & 15) * 8;
                    const int rr = o0 / run, i0 = o0 % run;
                    const char* src = lds + 32768 + dim * 272 + (rr + dil * i0) * 2;
                    float e8[8];
#pragma unroll
                    for (int e = 0; e < 8; ++e) e8[e] = bf2f(*(const bf16_t*)(src + e * dil * 2));
                    u32x4 w; w.x = pack2(e8[0], e8[1]); w.y = pack2(e8[2], e8[3]); w.z = pack2(e8[4], e8[5]); w.w = pack2(e8[6], e8[7]);
                    const int hg = hg0 + (dim >> 6);
                    *(u32x4*)(VT + ((size_t)((bb * 24 + hg) * dil + rr) * 64 + (dim & 63)) * L + (s0 >> lg2) + i0) = w;
                }
            }
        } else {
            float* ssq = (float*)(p.ws + WS_SSQ) + (size_t)(tn * 2 + wc) * T;
#pragma unroll
            for (int m = 0; m < 4; ++m) {
                float ss = 0.f;
#pragma unroll
                for (int n = 0; n < 4; ++n) {
                    const size_t qo = (size_t)(m0 + m * 16 + fr) * 1024 + n0 + n * 16 + fq * 4;
                    float* q = dry ? (float*)(p.ws + WS_DUMMY) + (qo & 0x7FFFF) : p.out + qo;
                    float4 v = *(float4*)q;
                    v.x += acc[n][m][0]; v.y += acc[n][m][1]; v.z += acc[n][m][2]; v.w += acc[n][m][3];
                    *(float4*)q = v;
                    ss += v.x * v.x + v.y * v.y + v.z * v.z + v.w * v.w;
                }
                ss += __shfl_xor(ss, 16); ss += __shfl_xor(ss, 32);
                if (fq == 0 && !dry) ssq[m0 + m * 16 + fr] = ss;
            }
        }
    }
}

DI void phase_moe_up(const P& p, int layer, char* lds) {
    const int tid = tidx(), wid = tid >> 6, lane = tid & 63, wr = wid >> 1, wc = wid & 1, fr = lane & 15, fq = lane >> 4;
    const unsigned* cntb = (const unsigned*)(p.ws + WS_CTL + CTL_CNT) + layer * 16 * 64;
    unsigned cnt[16];
#pragma unroll
    for (int e = 0; e < 16; ++e) cnt[e] = cntb[e * 64];
    const int* list = (const int*)(p.ws + WS_LIST);
    const float* gl = (const float*)(p.ws + WS_GATE);
    const bf16_t* hn = (const bf16_t*)(p.ws + WS_HN);
    const bf16_t* W13 = (const bf16_t*)(p.ws + WS_W + W_13);
    bf16_t* H = (bf16_t*)(p.ws + WS_H);
    int ttot = 0;
#pragma unroll
    for (int e = 0; e < 16; ++e) ttot += ((int)cnt[e] + 127) >> 7;
    const int ntiles = ttot * 4;
    auto locate = [&](int tile, int& e, int& lt, int& ce, int& rbe, int& tn) {
        const int mt = tile >> 2; tn = tile & 3;
        int tbe = 0, acc_t = 0; e = 0;
#pragma unroll
        for (int q = 0; q < 16; ++q) { const int nt = ((int)cnt[q] + 127) >> 7; if (mt >= acc_t) { e = q; tbe = acc_t; } acc_t += nt; }
        lt = mt - tbe; ce = (int)cnt[e]; rbe = tbe * 128;
    };
    auto fill = [&](TileP& t, int tile) {
        int e, lt, ce, rbe, tn; locate(tile, e, lt, ce, rbe, tn);
        const int r = tid >> 3;
#pragma unroll
        for (int i = 0; i < 4; ++i) {
            const int ii = lt * 128 + r + 32 * i;
            const int tk = ii < ce ? (list[e * 16384 + ii] >> 1) : 0;
            t.arow[i] = tk;
            t.bo[i] = (unsigned)(e * 512 + tn * 128 + r + 32 * i) * 2048u;
        }
    };
    const GOps gop{(const char*)hn, 2048u, (const char*)hn, 2048u, (const char*)W13};
    TileP cur, nxt;
    bool primed = false;
    fill(cur, bidx() < ntiles ? bidx() : 0); nxt = cur;
    for (int tile = bidx(); tile < ntiles; tile += gridDim.x) {
        int e, lt, ce, rbe, tn; locate(tile, e, lt, ce, rbe, tn);
        const bool have_next = tile + (int)gridDim.x < ntiles;
        if (have_next) fill(nxt, tile + gridDim.x);
        f32x4 acc[4][4];
        gemm_core(gop, cur, 1024, lds, acc, 1 << 30, primed, nxt, have_next);
        primed = have_next; cur = nxt;
#pragma unroll
        for (int m = 0; m < 4; ++m) {
            const int li = lt * 128 + wr * 64 + m * 16 + fr;
            if (li < ce) {
                const float g = gl[e * 16384 + li];
                bf16_t* hrow = H + (size_t)(rbe + li) * 256;
#pragma unroll
                for (int n = 0; n < 4; n += 2) {
                    float o[4];
#pragma unroll
                    for (int j = 0; j < 4; ++j) o[j] = siluf_(acc[n][m][j]) * acc[n + 1][m][j] * g;
                    const int f = tn * 64 + wc * 32 + (n >> 1) * 16 + fq * 4;
                    u32x2 w; w.x = pack2(o[0], o[1]); w.y = pack2(o[2], o[3]);
                    *(u32x2*)(hrow + f) = w;
                }
            }
        }
    }
}
DI void phase_moe_down(const P& p, int layer, char* lds) {
    const int tid = tidx(), wid = tid >> 6, lane = tid & 63, wr = wid >> 1, wc = wid & 1, fr = lane & 15, fq = lane >> 4;
    const unsigned* cntb = (const unsigned*)(p.ws + WS_CTL + CTL_CNT) + layer * 16 * 64;
    unsigned cnt[16];
#pragma unroll
    for (int e = 0; e < 16; ++e) cnt[e] = cntb[e * 64];
    const int* list = (const int*)(p.ws + WS_LIST);
    const bf16_t* W2 = (const bf16_t*)(p.ws + WS_W + W_2);
    const bf16_t* H = (const bf16_t*)(p.ws + WS_H);
    bf16_t* ys = (bf16_t*)(p.ws + WS_YS);
    int ttot = 0;
#pragma unroll
    for (int e = 0; e < 16; ++e) ttot += ((int)cnt[e] + 127) >> 7;
    const int ntiles = ttot * 8;
    auto locate = [&](int tile, int& e, int& lt, int& ce, int& rbe, int& tn) {
        const int mt = tile >> 3; tn = tile & 7;
        int tbe = 0, acc_t = 0; e = 0;
#pragma unroll
        for (int q = 0; q < 16; ++q) { const int nt = ((int)cnt[q] + 127) >> 7; if (mt >= acc_t) { e = q; tbe = acc_t; } acc_t += nt; }
        lt = mt - tbe; ce = (int)cnt[e]; rbe = tbe * 128;
    };
    auto fill = [&](TileP& t, int tile) {
        int e, lt, ce, rbe, tn; locate(tile, e, lt, ce, rbe, tn);
        const int r = tid >> 3;
#pragma unroll
        for (int i = 0; i < 4; ++i) { t.arow[i] = rbe + lt * 128 + r + 32 * i; t.bo[i] = (unsigned)(e * 1024 + tn * 128 + r + 32 * i) * 512u; }
    };
    const GOps gop{(const char*)H, 512u, (const char*)H, 512u, (const char*)W2};
    TileP cur, nxt;
    bool primed = false;
    fill(cur, bidx() < ntiles ? bidx() : 0); nxt = cur;
    for (int tile = bidx(); tile < ntiles; tile += gridDim.x) {
        int e, lt, ce, rbe, tn; locate(tile, e, lt, ce, rbe, tn);
        const bool have_next = tile + (int)gridDim.x < ntiles;
        if (have_next) fill(nxt, tile + gridDim.x);
        f32x4 acc[4][4];
        gemm_core(gop, cur, 256, lds, acc, 1 << 30, primed, nxt, have_next);
        primed = have_next; cur = nxt;
#pragma unroll
        for (int m = 0; m < 4; ++m) {
            const int li = lt * 128 + wr * 64 + m * 16 + fr;
            if (li < ce) {
                const int ts = list[e * 16384 + li];
                bf16_t* yrow = ys + ((size_t)(ts & 1) * T + (ts >> 1)) * 1024 + tn * 128 + wc * 64 + fq * 4;
#pragma unroll
                for (int n = 0; n < 4; ++n) { u32x2 w; w.x = pack2(acc[n][m][0], acc[n][m][1]); w.y = pack2(acc[n][m][2], acc[n][m][3]); *(u32x2*)(yrow + n * 16) = w; }
            }
        }
    }
}


typedef float f32x16 __attribute__((ext_vector_type(16)));
DI f32x4 mfma16(bf16x8 a, bf16x8 b, f32x4 c) { return __builtin_amdgcn_mfma_f32_16x16x32_bf16(a, b, c, 0, 0, 0); }
DI f32x16 mfma32(bf16x8 a, bf16x8 b, f32x16 c) { return __builtin_amdgcn_mfma_f32_32x32x16_bf16(a, b, c, 0, 0, 0); }
DI f32x4 tile16(const char* X, int ldx, int row0, const char* Y, int ldy, int col0, int K) {
    const int lane = tidx() & 63, fr = lane & 15, fq = lane >> 4;
    f32x4 acc = {0.f, 0.f, 0.f, 0.f};
#pragma unroll
    for (int k = 0; k < K; k += 32) {
        const bf16x8 a = *(const bf16x8*)(X + (row0 + fr) * ldx + (k + fq * 8) * 2);
        const bf16x8 b = *(const bf16x8*)(Y + (col0 + fr) * ldy + (k + fq * 8) * 2);
        acc = mfma16(a, b, acc);
    }
    return acc;
}
DI bf16x8 pack_step(const f32x16& x, int s) {
    u32x4 r;
    r.x = pack2(x[8 * s + 0], x[8 * s + 1]); r.y = pack2(x[8 * s + 2], x[8 * s + 3]);
    r.z = pack2(x[8 * s + 4], x[8 * s + 5]); r.w = pack2(x[8 * s + 6], x[8 * s + 7]);
    return __builtin_bit_cast(bf16x8, r);
}

constexpr int GP_LF = 0, GP_T = 17408, GP_VEC = GP_T + 9216, GP_U = GP_VEC + 1024, GP_END = GP_U + 36864;
DI void gdn_prep_unit(const P& p, int li, int ch, char* lds) {
    const int tid = tidx(), lane = tid & 63, wid = tid >> 6, fr = lane & 15, fq = lane >> 4;
    const int h = ch & 3, n = (ch >> 2) & 63, b = ch >> 8;
    const int t0 = b * SEQ + n * 64;
    float* Lf = (float*)(lds + GP_LF);
    char* Trow = lds + GP_T;
    float* gcs = (float*)(lds + GP_VEC); float* egc = gcs + 64; float* bet = gcs + 128; float* ekd = gcs + 192;
    char* Qrow = lds + GP_U; char* Krow = Qrow + 17408; char* VbT = lds + GP_U; char* KbgT = VbT + 18432;
    const bf16_t* proj = (const bf16_t*)(p.ws + WS_PROJ);
    unsigned char* ops = p.ws + WS_GOPS + (size_t)ch * GOPS_CH;
    const float* cw = p.in[I_CONVW] + (size_t)li * 4 * 1536;
    const int c = tid >> 2, cq = tid & 3;
    __syncthreads();
    float* cwl = (float*)(lds + GP_END);
    for (int i = tid; i < 4 * 3 * 32; i += 256) {
        const int j = i / 96, r = i % 96, sl = r >> 5, q4 = (r & 31) * 4;
        *(f32x4*)(cwl + (j * 3 + sl) * 128 + q4) = *(const f32x4*)(cw + j * 1536 + sl * 512 + h * 128 + q4);
    }
    __syncthreads();
    unsigned vvp[16];
#pragma unroll 1
    for (int which = 0; which < 3; ++which) {
        const int col0 = which * 512 + h * 128 + cq * 32;
        u32x4 xin[4][4];
#pragma unroll
        for (int j = 0; j < 4; ++j) {
            const int sp = n * 64 + c - 3 + j;
            const bf16_t* src = proj + (size_t)(b * SEQ + (sp < 0 ? 0 : sp)) * EVLD + col0;
#pragma unroll
            for (int i4 = 0; i4 < 4; ++i4) xin[j][i4] = *(const u32x4*)(src + i4 * 8);
        }
        float acc[32];
#pragma unroll
        for (int i = 0; i < 32; ++i) acc[i] = 0.f;
#pragma unroll
        for (int j = 0; j < 4; ++j) {
            const float ok = (n * 64 + c - 3 + j) >= 0 ? 1.f : 0.f;
            const float* wj = cwl + (j * 3 + which) * 128 + cq * 32;
#pragma unroll
            for (int i4 = 0; i4 < 4; ++i4) {
                const f32x4 wa = *(const f32x4*)(wj + i4 * 8), wb = *(const f32x4*)(wj + i4 * 8 + 4);
                const u32x4 w = xin[j][i4];
                acc[i4 * 8 + 0] += ok * wa[0] * __uint_as_float(w[0] << 16); acc[i4 * 8 + 1] += ok * wa[1] * __uint_as_float(w[0] & 0xffff0000u);
                acc[i4 * 8 + 2] += ok * wa[2] * __uint_as_float(w[1] << 16); acc[i4 * 8 + 3] += ok * wa[3] * __uint_as_float(w[1] & 0xffff0000u);
                acc[i4 * 8 + 4] += ok * wb[0] * __uint_as_float(w[2] << 16); acc[i4 * 8 + 5] += ok * wb[1] * __uint_as_float(w[2] & 0xffff0000u);
                acc[i4 * 8 + 6] += ok * wb[2] * __uint_as_float(w[3] << 16); acc[i4 * 8 + 7] += ok * wb[3] * __uint_as_float(w[3] & 0xffff0000u);
            }
        }
        float ss = 0.f;
#pragma unroll
        for (int i = 0; i < 32; ++i) { acc[i] = siluf_(acc[i]); ss += acc[i] * acc[i]; }
        ss += __shfl_xor(ss, 1); ss += __shfl_xor(ss, 2);
        const float rn = which == 2 ? 1.f : rsqrtf(ss + 1e-6f) * (which == 0 ? 0.08838834764831845f : 1.f);
        unsigned pk[16];
#pragma unroll
        for (int i = 0; i < 16; ++i) pk[i] = pack2(acc[2 * i] * rn, acc[2 * i + 1] * rn);
        if (which < 2) {
            char* img = which == 0 ? Qrow : Krow;
#pragma unroll
            for (int i4 = 0; i4 < 4; ++i4) { u32x4 w; w.x = pk[i4 * 4]; w.y = pk[i4 * 4 + 1]; w.z = pk[i4 * 4 + 2]; w.w = pk[i4 * 4 + 3]; *(u32x4*)(img + c * 272 + (cq * 32 + i4 * 8) * 2) = w; }
        } else {
#pragma unroll
            for (int i = 0; i < 16; ++i) vvp[i] = pk[i];
        }
    }
    if (cq == 0) {
        const float a = bf2f(proj[(size_t)(t0 + c) * EVLD + 2048 + h]);
        const float bb = bf2f(proj[(size_t)(t0 + c) * EVLD + 2052 + h]);
        const float Aexp = __expf(p.in[I_ALOG][li * 4 + h]), dtb = p.in[I_DTB][li * 4 + h];
        gcs[c] = -Aexp * softplusf_(a + dtb);
        bet[c] = sigmoidf_(bb);
    }
    __syncthreads();
    if (wid == 0) {
        float x = gcs[lane];
#pragma unroll
        for (int o = 1; o < 64; o <<= 1) { const float y = __shfl_up(x, o); if (lane >= o) x += y; }
        const float gl = __shfl(x, 63);
        gcs[lane] = x; egc[lane] = __expf(x); ekd[lane] = __expf(gl - x);
        if (lane == 63) ((float*)(p.ws + WS_CTL + CTL_EGL))[ch] = __expf(gl);
    }
    __syncthreads();
    {
        const int ti = wid;
#pragma unroll
        for (int tj = 0; tj < 4; ++tj) {
            if (tj <= ti) {
                const f32x4 kk = tile16(Krow, 272, 16 * ti, Krow, 272, 16 * tj, 128);
                const int c2 = 16 * tj + fr;
                f32x4 lv;
#pragma unroll
                for (int r = 0; r < 4; ++r) {
                    const int c1 = 16 * ti + fq * 4 + r;
                    lv[r] = (c1 > c2) ? bet[c1] * kk[r] * __expf(gcs[c1] - gcs[c2]) : 0.f;
                }
                *(f32x4*)&Lf[c2 * 68 + 16 * ti + fq * 4] = lv;
            }
            f32x4 qk = {0.f, 0.f, 0.f, 0.f};
            if (tj <= ti) qk = tile16(Krow, 272, 16 * tj, Qrow, 272, 16 * ti, 128);
            const int c1 = 16 * ti + fr;
            float o4[4];
#pragma unroll
            for (int r = 0; r < 4; ++r) { const int c2 = 16 * tj + fq * 4 + r; o4[r] = (c1 >= c2) ? qk[r] * __expf(gcs[c1] - gcs[c2]) : 0.f; }
            const int mt = c1 >> 5, rr = c1 & 31, hh = fq & 1, jg = fq >> 1;
            u32x2 w; w.x = pack2(o4[0], o4[1]); w.y = pack2(o4[2], o4[3]);
            *(u32x2*)(ops + GO_AF + ((size_t)((mt * 4 + tj) * 64 + hh * 32 + rr) * 8 + jg * 4) * 2) = w;
        }
#pragma unroll
        for (int i = 0; i < 4; ++i) {
            const int idx = tid + i * 256;
            {
                const int mt = idx >> 9, ks = (idx >> 6) & 7, l2 = idx & 63, rr = l2 & 31, hh = l2 >> 5, cc = 32 * mt + rr;
                const float sc = egc[cc];
                const u32x2 lo = *(const u32x2*)(Qrow + cc * 272 + (16 * ks + 4 * hh) * 2), hi = *(const u32x2*)(Qrow + cc * 272 + (16 * ks + 8 + 4 * hh) * 2);
                u32x4 w;
                w.x = pack2(__uint_as_float(lo.x << 16) * sc, __uint_as_float(lo.x & 0xffff0000u) * sc); w.y = pack2(__uint_as_float(lo.y << 16) * sc, __uint_as_float(lo.y & 0xffff0000u) * sc);
                w.z = pack2(__uint_as_float(hi.x << 16) * sc, __uint_as_float(hi.x & 0xffff0000u) * sc); w.w = pack2(__uint_as_float(hi.y << 16) * sc, __uint_as_float(hi.y & 0xffff0000u) * sc);
                *(u32x4*)(ops + GO_QF + (size_t)idx * 16) = w;
            }
            {
                const int mt = idx >> 8, ks = (idx >> 6) & 3, l2 = idx & 63, rr = l2 & 31, hh = l2 >> 5, dk = 32 * mt + rr;
                float e8[8];
#pragma unroll
                for (int j = 0; j < 8; ++j) { const int c2 = 16 * ks + 8 * (j >> 2) + 4 * hh + (j & 3); e8[j] = bf2f(*(const bf16_t*)(Krow + c2 * 272 + dk * 2)) * ekd[c2]; }
                u32x4 w; w.x = pack2(e8[0], e8[1]); w.y = pack2(e8[2], e8[3]); w.z = pack2(e8[4], e8[5]); w.w = pack2(e8[6], e8[7]);
                *(u32x4*)(ops + GO_KF + (size_t)idx * 16) = w;
            }
        }
    }
    __syncthreads();
    {
        const float bc = bet[c], bg = bc * egc[c];
        unsigned kvp[16];
#pragma unroll
        for (int i4 = 0; i4 < 4; ++i4) { const u32x4 w = *(const u32x4*)(Krow + c * 272 + (cq * 32 + i4 * 8) * 2); kvp[i4 * 4] = w.x; kvp[i4 * 4 + 1] = w.y; kvp[i4 * 4 + 2] = w.z; kvp[i4 * 4 + 3] = w.w; }
        __syncthreads();
#pragma unroll
        for (int i = 0; i < 16; ++i) {
            *(bf16_t*)(VbT + (cq * 32 + 2 * i) * 144 + c * 2) = f2bf(__uint_as_float(vvp[i] << 16) * bc);
            *(bf16_t*)(VbT + (cq * 32 + 2 * i + 1) * 144 + c * 2) = f2bf(__uint_as_float(vvp[i] & 0xffff0000u) * bc);
            *(bf16_t*)(KbgT + (cq * 32 + 2 * i) * 144 + c * 2) = f2bf(__uint_as_float(kvp[i] << 16) * bg);
            *(bf16_t*)(KbgT + (cq * 32 + 2 * i + 1) * 144 + c * 2) = f2bf(__uint_as_float(kvp[i] & 0xffff0000u) * bg);
        }
    }
    {
        char* L21i = lds + GP_END;
        char* T11T = L21i + 2560;
        char* MT = T11T + 2560;
        if (wid < 2) {
            const int o = 32 * wid;
            float Tc[32];
#pragma unroll
            for (int i = 0; i < 32; ++i) Tc[i] = (i == (lane & 31)) ? 1.f : 0.f;
#pragma unroll
            for (int j = 0; j < 31; ++j) {
                const float tj = Tc[j];
#pragma unroll
                for (int i4 = (j + 1) >> 2; i4 < 8; ++i4) {
                    const f32x4 l4 = *(const f32x4*)&Lf[(o + j) * 68 + o + i4 * 4];
#pragma unroll
                    for (int e = 0; e < 4; ++e) if (i4 * 4 + e > j) Tc[i4 * 4 + e] -= l4[e] * tj;
                }
            }
            if (lane < 32) {
#pragma unroll
                for (int i = 0; i < 32; ++i) *(bf16_t*)(Trow + (o + i) * 144 + (o + lane) * 2) = f2bf(Tc[i]);
                if (wid == 0) {
#pragma unroll
                    for (int i = 0; i < 32; ++i) *(bf16_t*)(Trow + i * 144 + (32 + lane) * 2) = 0;
#pragma unroll
                    for (int i4 = 0; i4 < 8; ++i4) { u32x2 w; w.x = pack2(Tc[i4 * 4], Tc[i4 * 4 + 1]); w.y = pack2(Tc[i4 * 4 + 2], Tc[i4 * 4 + 3]); *(u32x2*)(T11T + lane * 80 + i4 * 8) = w; }
                }
            }
        } else {
            const int t2 = tid - 128;
#pragma unroll
            for (int g2 = 0; g2 < 2; ++g2) {
                const int i = t2 & 31, k4 = ((t2 >> 5) + 4 * g2) * 4;
                u32x2 w;
                w.x = pack2(Lf[(k4 + 0) * 68 + 32 + i], Lf[(k4 + 1) * 68 + 32 + i]); w.y = pack2(Lf[(k4 + 2) * 68 + 32 + i], Lf[(k4 + 3) * 68 + 32 + i]);
                *(u32x2*)(L21i + i * 80 + k4 * 2) = w;
            }
        }
        __syncthreads();
        {
            const int r0 = 16 * (wid >> 1), c0 = 16 * (wid & 1);
            const f32x4 mm = tile16(L21i, 80, r0, T11T, 80, c0, 32);
            u32x2 w; w.x = pack2(mm[0], mm[1]); w.y = pack2(mm[2], mm[3]);
            *(u32x2*)(MT + (c0 + fr) * 80 + (r0 + 4 * fq) * 2) = w;
        }
        __syncthreads();
        {
            const int r0 = 16 * (wid >> 1), c0 = 16 * (wid & 1);
            const f32x4 tt = tile16(MT, 80, c0, Trow + 32 * 144 + 64, 144, r0, 32);
            u32x2 w; w.x = pack2(-tt[0], -tt[1]); w.y = pack2(-tt[2], -tt[3]);
            *(u32x2*)(Trow + (32 + r0 + fr) * 144 + (c0 + 4 * fq) * 2) = w;
        }
    }
    __syncthreads();
#pragma unroll
    for (int tq = 0; tq < 2; ++tq) {
        const int tj = wid * 2 + tq;
#pragma unroll
        for (int ti = 0; ti < 4; ++ti) {
            const f32x4 u = tile16(Trow, 144, 16 * ti, VbT, 144, 16 * tj, 64);
            {
                const int dv = 16 * tj + fr, slice = dv >> 5, rr = dv & 31, cb = 16 * ti + fq * 4, mt = cb >> 5, q4 = (cb & 31) >> 2, hh = q4 & 1, rg = q4 >> 1;
                u32x2 w; w.x = pack2(u[0], u[1]); w.y = pack2(u[2], u[3]);
                *(u32x2*)(ops + GO_UF + ((size_t)((slice * 2 + mt) * 64 + hh * 32 + rr) * 16 + rg * 4) * 2) = w;
            }
            const f32x4 wv = tile16(KbgT, 144, 16 * tj, Trow, 144, 16 * ti, 64);
            {
                const int c1 = 16 * ti + fr, mt = c1 >> 5, rr = c1 & 31, hh = fq & 1, jg = fq >> 1;
                u32x2 w; w.x = pack2(-wv[0], -wv[1]); w.y = pack2(-wv[2], -wv[3]);
                *(u32x2*)(ops + GO_WF + ((size_t)((mt * 8 + tj) * 64 + hh * 32 + rr) * 8 + jg * 4) * 2) = w;
            }
        }
    }
}

DI void glds16(const void* g, char* l) { __builtin_amdgcn_global_load_lds((const unsigned*)g, (lds_u32*)l, 16, 0, 0); }
#define GS_WAIT(n) asm volatile("s_waitcnt vmcnt(" #n ")" ::: "memory")
DI void gdn_scan_block(const P& p, int bh, char* lds, bool dry = false) {
    const int tid = tidx(), lane = tid & 63, w = tid >> 6;
    const int h = bh & 3, b = bh >> 2;
    const float eglv = ((const float*)(p.ws + WS_CTL + CTL_EGL))[(b * 64 + lane) * 4 + h];
    unsigned char* gbase = p.ws + WS_GOPS + (size_t)(b * 256 + h) * GOPS_CH;
    auto issue = [&](int n, int k0, int cntk) {
        for (int k = k0; k < k0 + cntk; ++k) {
            const unsigned char* src = gbase + (size_t)n * 4 * GOPS_CH + k * 8192 + tid * 16;
            char* dst = lds + k * 8192 + tid * 16;
            glds16(src, dst); glds16(src + 4096, dst + 4096);
        }
    };
    f32x16 S[4];
#pragma unroll
    for (int i = 0; i < 4; ++i)
#pragma unroll
        for (int r = 0; r < 16; ++r) S[i][r] = 0.f;
    __syncthreads();
    issue(0, 0, 7);
#pragma unroll 1
    for (int n = 0; n < 64; ++n) {
        const float egl = __shfl(eglv, n);
        bf16x8 Sb[8];
#pragma unroll
        for (int i = 0; i < 4; ++i) { Sb[i * 2] = pack_step(S[i], 0); Sb[i * 2 + 1] = pack_step(S[i], 1); }
        f32x16 av[2], ao[2];
        const bf16x8* fr0 = (const bf16x8*)lds + lane;
        GS_WAIT(6);
        __builtin_amdgcn_s_barrier();
        issue(n, 7, 2);
        __builtin_amdgcn_sched_barrier(0);
        {
            const char* sl = lds + (w >> 1) * 8192;
#pragma unroll
            for (int mt = 0; mt < 2; ++mt) {
                const u32x4* up = (const u32x4*)(sl + ((w & 1) * 2 + mt) * 2048 + lane * 32);
                const u32x4 u0 = up[0], u1 = up[1];
#pragma unroll
                for (int e = 0; e < 4; ++e) {
                    av[mt][e * 2] = __uint_as_float(u0[e] << 16); av[mt][e * 2 + 1] = __uint_as_float(u0[e] & 0xffff0000u);
                    av[mt][8 + e * 2] = __uint_as_float(u1[e] << 16); av[mt][8 + e * 2 + 1] = __uint_as_float(u1[e] & 0xffff0000u);
                }
            }
        }
#pragma unroll
        for (int ks = 0; ks < 8; ++ks)
#pragma unroll
            for (int mt = 0; mt < 2; ++mt) av[mt] = mfma32(fr0[(2 + mt) * 512 + ks * 64], Sb[ks], av[mt]);
        bf16x8 Vb[4];
#pragma unroll
        for (int mt = 0; mt < 2; ++mt) { Vb[mt * 2] = pack_step(av[mt], 0); Vb[mt * 2 + 1] = pack_step(av[mt], 1); }
        GS_WAIT(4);
        __builtin_amdgcn_s_barrier();
        if (n < 63) issue(n + 1, 0, 4);
        __builtin_amdgcn_sched_barrier(0);
#pragma unroll
        for (int mt = 0; mt < 2; ++mt)
#pragma unroll
            for (int r = 0; r < 16; ++r) ao[mt][r] = 0.f;
#pragma unroll
        for (int ks = 0; ks < 8; ++ks) {
#pragma unroll
            for (int mt = 0; mt < 2; ++mt) ao[mt] = mfma32(fr0[(4 + mt) * 512 + ks * 64], Sb[ks], ao[mt]);
#pragma unroll
            for (int r = 0; r < 8; ++r) S[ks >> 1][(ks & 1) * 8 + r] *= egl;
        }
#pragma unroll
        for (int ks = 0; ks < 4; ++ks) { if (ks < 2) ao[0] = mfma32(fr0[6 * 512 + ks * 64], Vb[ks], ao[0]); ao[1] = mfma32(fr0[6 * 512 + (4 + ks) * 64], Vb[ks], ao[1]); }
        if (n < 63) GS_WAIT(8); else GS_WAIT(0);
        __builtin_amdgcn_s_barrier();
        if (n < 63) issue(n + 1, 4, 3);
        __builtin_amdgcn_sched_barrier(0);
#pragma unroll
        for (int ks = 0; ks < 4; ++ks)
#pragma unroll
            for (int i = 0; i < 4; ++i) S[i] = mfma32(fr0[(7 + (i >> 1)) * 512 + ((i & 1) * 4 + ks) * 64], Vb[ks], S[i]);
        {
            u32x4* Of = (u32x4*)((dry ? p.ws + WS_DUMMY + (size_t)(bh & 15) * 65536 : gbase + (size_t)n * 4 * GOPS_CH) + GO_UF) + (size_t)(w * 2 * 64 + lane) * 2;
#pragma unroll
            for (int mt = 0; mt < 2; ++mt) {
                u32x4 o0, o1;
#pragma unroll
                for (int e = 0; e < 4; ++e) { o0[e] = pack2(ao[mt][e * 2], ao[mt][e * 2 + 1]); o1[e] = pack2(ao[mt][8 + e * 2], ao[mt][8 + e * 2 + 1]); }
                Of[mt * 128] = o0; Of[mt * 128 + 1] = o1;
            }
        }
    }
    __syncthreads();
}

DI void gdn_post_unit(const P& p, int li, int ch) {
    const int tid = tidx();
    const int h = ch & 3, n = (ch >> 2) & 63, b = ch >> 8;
    const int t0 = b * SEQ + n * 64;
    const int c = tid >> 2, cq = tid & 3;
    const bf16_t* Of = (const bf16_t*)(p.ws + WS_GOPS + (size_t)ch * GOPS_CH + GO_UF);
    const bf16_t* proj = (const bf16_t*)(p.ws + WS_PROJ);
    bf16_t* mix = (bf16_t*)(p.ws + WS_PROJ);
    const float* nw = p.in[I_GDNNORM] + li * 128 + cq * 32;
    const int mt = c >> 5, q4 = (c & 31) >> 2, hh = q4 & 1, rg = q4 >> 1, reg = rg * 4 + (c & 3);
    float o[32]; float ss = 0.f;
#pragma unroll
    for (int r = 0; r < 32; ++r) { o[r] = bf2f(Of[(size_t)((cq * 2 + mt) * 64 + hh * 32 + r) * 16 + reg]); ss += o[r] * o[r]; }
    ss += __shfl_xor(ss, 1); ss += __shfl_xor(ss, 2);
    const float rs = rsqrtf(ss * (1.f / 128.f) + 1e-6f);
    const bf16_t* zp = proj + (size_t)(t0 + c) * EVLD + 1536 + h * 128 + cq * 32;
    bf16_t* mp = mix + (size_t)(t0 + c) * EVLD + h * 128 + cq * 32;
#pragma unroll
    for (int i4 = 0; i4 < 4; ++i4) {
        const u32x4 zw = *(const u32x4*)(zp + i4 * 8);
        u32x4 w;
#pragma unroll
        for (int e = 0; e < 4; ++e) {
            const float z0 = __uint_as_float(zw[e] << 16), z1 = __uint_as_float(zw[e] & 0xffff0000u);
            w[e] = pack2(o[i4 * 8 + e * 2] * rs * nw[i4 * 8 + e * 2] * siluf_(z0), o[i4 * 8 + e * 2 + 1] * rs * nw[i4 * 8 + e * 2 + 1] * siluf_(z1));
        }
        *(u32x4*)(mp + i4 * 8) = w;
    }
}


constexpr int RP_Z0 = 0, RP_Z1 = 18432, RP_Z2 = 55296, RP_VEC = 73728, RP_PT = 75008, RP_T11 = 78080, RP_END = 80640;
constexpr int RP_LIN = 0, RP_LW = 25600;
DI void rwkv_prep_unit(const P& p, int li, int ch, char* lds) {
    const int tid = tidx(), lane = tid & 63, wid = tid >> 6, fr = lane & 15, fq = lane >> 4;
    const int h = ch & 7, n = (ch >> 3) & 63, b = ch >> 9;
    const int t0 = b * SEQ + n * 64;
    const bf16_t* proj = (const bf16_t*)(p.ws + WS_PROJ);
    char* Lfc = lds + RP_Z0; float* Lf = (float*)Lfc;
    char* ApT = lds + RP_Z0; char* AkVT = lds + RP_Z0 + 9216;
    char* Arow = lds + RP_Z1; char* Rrow = Arow + 9216; char* Brow = Arow + 18432; char* Krow = Arow + 27648;
    char* Aak = Arow; char* Arb = Rrow; char* Ark = Brow; char* Trow = Krow; char* BhT = Krow; char* VpT = Aak;
    char* AT = lds + RP_Z2; char* VT = AT + 9216; char* KhT = AT;
    float* tot = (float*)(lds + RP_VEC); float* WC = tot + 256;
    char* lin = lds + RP_LIN; char* LWi = lds + RP_LW;
    float* PT = (float*)(lds + RP_PT);
    {
        const float* mu0 = p.in[I_MU] + (size_t)li * 1696;
        if (tid < 48) {
            const int j0 = tid * 4;
            *(float4*)(PT + j0) = j0 < 160 ? *(const float4*)(mu0 + (C_HW - RW0) + j0) : *(const float4*)(p.in[I_VRESMU] + j0 - 160);
        } else if (tid < 48 + 144) {
            const int q = tid - 48, arr = q >> 4, c4 = (q & 15) * 4, chn = h * 64 + c4;
            const float* src = arr == 0 ? mu0 + (C_R - RW0) + chn : arr == 1 ? mu0 + (C_K - RW0) + chn : arr == 2 ? mu0 + (C_V - RW0) + chn
                             : arr == 3 ? p.in[I_W0] + li * 512 + chn : arr == 4 ? p.in[I_A0] + li * 512 + chn : arr == 5 ? p.in[I_V0] + chn
                             : arr == 6 ? p.in[I_KK] + li * 512 + chn : arr == 7 ? p.in[I_KA] + li * 512 + chn : p.in[I_RK] + li * 512 + chn;
            *(float4*)(PT + 192 + arr * 64 + c4) = *(const float4*)src;
        }
    }
    __syncthreads();
    {
        const int c = tid >> 2, cq = tid & 3, s = n * 64 + c;
        const bf16_t* cur = proj + (size_t)(t0 + c) * EVLD + C_HW + cq * 48;
        const float* mu = p.in[I_MU] + (size_t)li * 1696 + (C_HW - RW0);
        const float* vmu = p.in[I_VRESMU];
#pragma unroll
        for (int i6 = 0; i6 < 6; ++i6) {
            const u32x4 cw4 = *(const u32x4*)(cur + i6 * 8);
            u32x4 pw4 = *(const u32x4*)(cur - (s > 0 ? EVLD : 0) + i6 * 8);
            if (s == 0) pw4 = (u32x4){0u, 0u, 0u, 0u};
            const int j0 = cq * 48 + i6 * 8;
            const float4 ma = *(const float4*)(PT + j0), mb = *(const float4*)(PT + j0 + 4);
            const float mm[8] = {ma.x, ma.y, ma.z, ma.w, mb.x, mb.y, mb.z, mb.w};
            const bool is_t = j0 < 32, is_s = (j0 >= 64) && (j0 < 160);
            const float ca = is_t ? 1.f : 0.f, cb = is_t ? -2.f : 1.f, cc = is_t ? 2.f : -1.f;
            u32x4 w;
#pragma unroll
            for (int e = 0; e < 4; ++e) {
                float o2[2];
#pragma unroll
                for (int q = 0; q < 2; ++q) {
                    const float cv = q ? __uint_as_float(cw4[e] & 0xffff0000u) : __uint_as_float(cw4[e] << 16);
                    const float pv = q ? __uint_as_float(pw4[e] & 0xffff0000u) : __uint_as_float(pw4[e] << 16);
                    const float val = cv + mm[e * 2 + q] * (pv - cv);
                    const float act = ca + cb * __builtin_amdgcn_rcpf(1.f + __expf(cc * val));
                    o2[q] = (is_t || is_s) ? act : val;
                }
                w[e] = pack2(o2[0], o2[1]);
            }
            *(u32x4*)(lin + c * 400 + (cq * 48 + i6 * 8) * 2) = w;
        }
        const bf16_t* LW = (const bf16_t*)(p.ws + WS_W + W_LW) + (size_t)h * 64 * 192;
#pragma unroll
        for (int i6 = 0; i6 < 6; ++i6) *(u32x4*)(LWi + c * 400 + (cq * 48 + i6 * 8) * 2) = *(const u32x4*)(LW + (size_t)c * 192 + cq * 48 + i6 * 8);
    }
    __syncthreads();
    float lw_[16], la_[16], lg_[16], lv_[16];
#pragma unroll
    for (int tj = 0; tj < 4; ++tj) {
        const f32x4 a = tile16(LWi, 400, 16 * tj, lin, 400, 16 * wid, 32);
        const f32x4 bq = tile16(LWi + 64, 400, 16 * tj, lin + 64, 400, 16 * wid, 32);
        const f32x4 cg = tile16(LWi + 128, 400, 16 * tj, lin + 128, 400, 16 * wid, 96);
        const f32x4 dv = tile16(LWi + 320, 400, 16 * tj, lin + 320, 400, 16 * wid, 32);
#pragma unroll
        for (int r = 0; r < 4; ++r) { lw_[tj * 4 + r] = a[r]; la_[tj * 4 + r] = bq[r]; lg_[tj * 4 + r] = cg[r]; lv_[tj * 4 + r] = dv[r]; }
    }
    __syncthreads();
    const int c = 16 * wid + fr;
    float at[16], rt[16], bt[16], kt[16], bh[16], kh[16];
    {
        const int s = n * 64 + c;
        const size_t row = (size_t)(t0 + c);
        const float* mu = p.in[I_MU] + (size_t)li * 1696;
        const int hc = h * 64;
        float rr_[16], kk_[16], lwv[16], aa[16];
        float kn = 0.f, rk = 0.f;
        bf16_t* vf = (bf16_t*)(p.ws + WS_VF);
        bf16_t* gg = (bf16_t*)(p.ws + WS_GG);
#pragma unroll
        for (int tj = 0; tj < 4; ++tj) {
            const int cb = 16 * tj + 4 * fq;
            u32x2 cr = *(const u32x2*)(proj + row * EVLD + C_R + hc + cb), ck = *(const u32x2*)(proj + row * EVLD + C_K + hc + cb), cv = *(const u32x2*)(proj + row * EVLD + C_V + hc + cb);
            const size_t prow = s > 0 ? row - 1 : row;
            u32x2 pr = *(const u32x2*)(proj + prow * EVLD + C_R + hc + cb), pk = *(const u32x2*)(proj + prow * EVLD + C_K + hc + cb), pv = *(const u32x2*)(proj + prow * EVLD + C_V + hc + cb);
            if (s == 0) { pr = (u32x2){0u, 0u}; pk = pr; pv = pr; }
            u32x2 vfw = {0u, 0u};
            if (li == 1) vfw = *(const u32x2*)(vf + row * 512 + hc + cb);
            float vout[4], gout[4];
            const int ch0 = hc + cb;
            const float* pt = PT + 192 + cb;
            const float4 mu_r4 = *(const float4*)(pt), mu_k4 = *(const float4*)(pt + 64), mu_v4 = *(const float4*)(pt + 128);
            const float4 w0_4 = *(const float4*)(pt + 192), a0_4 = *(const float4*)(pt + 256), v0_4 = *(const float4*)(pt + 320);
            const float4 kk_4 = *(const float4*)(pt + 384), ka_4 = *(const float4*)(pt + 448), rk_4 = *(const float4*)(pt + 512);
            const float mur[4] = {mu_r4.x, mu_r4.y, mu_r4.z, mu_r4.w}, muk[4] = {mu_k4.x, mu_k4.y, mu_k4.z, mu_k4.w}, muv[4] = {mu_v4.x, mu_v4.y, mu_v4.z, mu_v4.w};
            const float w0v[4] = {w0_4.x, w0_4.y, w0_4.z, w0_4.w}, a0v[4] = {a0_4.x, a0_4.y, a0_4.z, a0_4.w}, v0v[4] = {v0_4.x, v0_4.y, v0_4.z, v0_4.w};
            const float kkp[4] = {kk_4.x, kk_4.y, kk_4.z, kk_4.w}, kap[4] = {ka_4.x, ka_4.y, ka_4.z, ka_4.w}, rkp[4] = {rk_4.x, rk_4.y, rk_4.z, rk_4.w};
#pragma unroll
            for (int r = 0; r < 4; ++r) {
                const int i = tj * 4 + r;
                const unsigned wcr = r < 2 ? cr.x : cr.y, wck = r < 2 ? ck.x : ck.y, wcv = r < 2 ? cv.x : cv.y;
                const unsigned wpr = r < 2 ? pr.x : pr.y, wpk = r < 2 ? pk.x : pk.y, wpv = r < 2 ? pv.x : pv.y, wvf = r < 2 ? vfw.x : vfw.y;
                const float c_r = (r & 1) ? __uint_as_float(wcr & 0xffff0000u) : __uint_as_float(wcr << 16);
                const float c_k = (r & 1) ? __uint_as_float(wck & 0xffff0000u) : __uint_as_float(wck << 16);
                const float c_v = (r & 1) ? __uint_as_float(wcv & 0xffff0000u) : __uint_as_float(wcv << 16);
                const float p_r = (r & 1) ? __uint_as_float(wpr & 0xffff0000u) : __uint_as_float(wpr << 16);
                const float p_k = (r & 1) ? __uint_as_float(wpk & 0xffff0000u) : __uint_as_float(wpk << 16);
                const float p_v = (r & 1) ? __uint_as_float(wpv & 0xffff0000u) : __uint_as_float(wpv << 16);
                const float rm = c_r + mur[r] * (p_r - c_r);
                const float km = c_k + muk[r] * (p_k - c_k);
                float vm = c_v + muv[r] * (p_v - c_v);
                const float wlog = -softplusf_(-(w0v[r] + lw_[i])) - 0.5f;
                lwv[i] = -__expf(wlog);
                const float a = sigmoidf_(a0v[r] + la_[i]);
                if (li == 1) {
                    const float v1 = (r & 1) ? __uint_as_float(wvf & 0xffff0000u) : __uint_as_float(wvf << 16);
                    vm = vm + (v1 - vm) * sigmoidf_(v0v[r] + lv_[i]);
                }
                const float kkv = km * kkp[r];
                kn += kkv * kkv;
                rr_[i] = rm; kk_[i] = kkv; aa[i] = a;
                kt[i] = km * (1.f + (a - 1.f) * kap[r]);
                rk += rm * kt[i] * rkp[r];
                vout[r] = vm; gout[r] = lg_[i];
            }
            u32x2 w; w.x = pack2(vout[0], vout[1]); w.y = pack2(vout[2], vout[3]);
            *(u32x2*)(vf + row * 512 + hc + cb) = w;
            w.x = pack2(gout[0], gout[1]); w.y = pack2(gout[2], gout[3]);
            *(u32x2*)(gg + row * 512 + hc + cb) = w;
#pragma unroll
            for (int r = 0; r < 4; ++r) *(bf16_t*)(VT + (cb + r) * 144 + c * 2) = f2bf(vout[r]);
            __builtin_amdgcn_sched_barrier(0);
        }
        kn += __shfl_xor(kn, 16); kn += __shfl_xor(kn, 32);
        const float kr = rsqrtf(kn + 1e-6f);
        rk += __shfl_xor(rk, 16); rk += __shfl_xor(rk, 32);
        if (fq == 0) ((float*)(p.ws + WS_RK))[row * 8 + h] = rk;
        float cs[16];
#pragma unroll
        for (int i = 0; i < 16; ++i) {
            float x = lwv[i];
#pragma unroll
            for (int o = 1; o < 16; o <<= 1) { const float y = __shfl_up(x, o, 16); if (fr >= o) x += y; }
            cs[i] = x;
        }
        if (fr == 15) {
#pragma unroll
            for (int i = 0; i < 16; ++i) tot[wid * 64 + 16 * (i >> 2) + 4 * fq + (i & 3)] = cs[i];
        }
        __syncthreads();
#pragma unroll
        for (int i = 0; i < 16; ++i) {
            const int chl = 16 * (i >> 2) + 4 * fq + (i & 3);
            float pre = 0.f, all = 0.f;
#pragma unroll
            for (int w2 = 0; w2 < 4; ++w2) { const float tv = tot[w2 * 64 + chl]; all += tv; if (w2 < wid) pre += tv; }
            const float csi = cs[i] + pre, csm = csi - lwv[i];
            const float kkn = kk_[i] * kr, k2 = kt[i];
            const float e_c = __expf(csi), e_n = __builtin_amdgcn_rcpf(e_c), e_m = __expf(csm), e_h = __expf(all) * e_n;
            at[i] = -kkn * e_m; rt[i] = rr_[i] * e_c;
            const float bp = kkn * aa[i];
            bt[i] = bp * e_n; kt[i] = k2 * e_n; bh[i] = bp * e_h; kh[i] = k2 * e_h;
            if (c == 0) WC[chl] = __expf(all);
            if ((i & 3) == 3) __builtin_amdgcn_sched_barrier(0);
        }
    }
#pragma unroll
    for (int tj = 0; tj < 4; ++tj) {
        const int cb = 16 * tj + 4 * fq;
        u32x2 w;
        w.x = pack2(at[tj * 4], at[tj * 4 + 1]); w.y = pack2(at[tj * 4 + 2], at[tj * 4 + 3]); *(u32x2*)(Arow + c * 144 + cb * 2) = w;
        w.x = pack2(rt[tj * 4], rt[tj * 4 + 1]); w.y = pack2(rt[tj * 4 + 2], rt[tj * 4 + 3]); *(u32x2*)(Rrow + c * 144 + cb * 2) = w;
        w.x = pack2(bt[tj * 4], bt[tj * 4 + 1]); w.y = pack2(bt[tj * 4 + 2], bt[tj * 4 + 3]); *(u32x2*)(Brow + c * 144 + cb * 2) = w;
        w.x = pack2(kt[tj * 4], kt[tj * 4 + 1]); w.y = pack2(kt[tj * 4 + 2], kt[tj * 4 + 3]); *(u32x2*)(Krow + c * 144 + cb * 2) = w;
#pragma unroll
        for (int r = 0; r < 4; ++r) {
            *(bf16_t*)(AT + (cb + r) * 144 + c * 2) = f2bf(at[tj * 4 + r]);
        }
    }
    __syncthreads();
    f32x4 pab[4], pak[4], prb[4], prk[4];
    {
        const int ti = wid;
#pragma unroll
        for (int tj = 0; tj < 4; ++tj) {
            pab[tj] = (f32x4){0.f, 0.f, 0.f, 0.f}; pak[tj] = pab[tj]; prb[tj] = pab[tj]; prk[tj] = pab[tj];
            if (tj <= ti) {
                pab[tj] = tile16(Arow, 144, 16 * ti, Brow, 144, 16 * tj, 64);
                pak[tj] = tile16(Krow, 144, 16 * tj, Arow, 144, 16 * ti, 64);
                prb[tj] = tile16(Brow, 144, 16 * tj, Rrow, 144, 16 * ti, 64);
                prk[tj] = tile16(Krow, 144, 16 * tj, Rrow, 144, 16 * ti, 64);
            }
        }
    }
    __syncthreads();
    {
        const int ti = wid;
#pragma unroll
        for (int tj = 0; tj < 4; ++tj) {
            const int s1 = 16 * tj + fr;
            f32x4 lv;
#pragma unroll
            for (int r = 0; r < 4; ++r) { const int t1 = 16 * ti + 4 * fq + r; lv[r] = (s1 < t1) ? -pab[tj][r] : 0.f; }
            *(f32x4*)&Lf[s1 * 72 + 16 * ti + 4 * fq] = lv;
            const int t2 = 16 * ti + fr;
            float m1[4], m2[4], m3[4];
#pragma unroll
            for (int r = 0; r < 4; ++r) { const int s2 = 16 * tj + 4 * fq + r; m1[r] = (s2 < t2) ? pak[tj][r] : 0.f; m2[r] = (s2 <= t2) ? prb[tj][r] : 0.f; m3[r] = (s2 <= t2) ? prk[tj][r] : 0.f; }
            u32x2 w;
            w.x = pack2(m1[0], m1[1]); w.y = pack2(m1[2], m1[3]); *(u32x2*)(Aak + t2 * 144 + (16 * tj + 4 * fq) * 2) = w;
            w.x = pack2(m2[0], m2[1]); w.y = pack2(m2[2], m2[3]); *(u32x2*)(Arb + t2 * 144 + (16 * tj + 4 * fq) * 2) = w;
            w.x = pack2(m3[0], m3[1]); w.y = pack2(m3[2], m3[3]); *(u32x2*)(Ark + t2 * 144 + (16 * tj + 4 * fq) * 2) = w;
        }
    }
    __syncthreads();
    {
        char* L21i = lds + RP_PT;
        char* T11T = lds + RP_T11;
        char* MT = lds + RP_Z0;
        if (wid < 2) {
            const int o = 32 * wid;
            float Tc[32];
#pragma unroll
            for (int i = 0; i < 32; ++i) Tc[i] = (i == (lane & 31)) ? 1.f : 0.f;
#pragma unroll
            for (int j = 0; j < 31; ++j) {
                const float tj = Tc[j];
#pragma unroll
                for (int i4 = (j + 1) >> 2; i4 < 8; ++i4) {
                    const f32x4 l4 = *(const f32x4*)&Lf[(o + j) * 72 + o + i4 * 4];
#pragma unroll
                    for (int e = 0; e < 4; ++e) if (i4 * 4 + e > j) Tc[i4 * 4 + e] -= l4[e] * tj;
                }
            }
            if (lane < 32) {
#pragma unroll
                for (int i = 0; i < 32; ++i) *(bf16_t*)(Trow + (o + i) * 144 + (o + lane) * 2) = f2bf(Tc[i]);
                if (wid == 0) {
#pragma unroll
                    for (int i = 0; i < 32; ++i) *(bf16_t*)(Trow + i * 144 + (32 + lane) * 2) = 0;
#pragma unroll
                    for (int i4 = 0; i4 < 8; ++i4) { u32x2 w; w.x = pack2(Tc[i4 * 4], Tc[i4 * 4 + 1]); w.y = pack2(Tc[i4 * 4 + 2], Tc[i4 * 4 + 3]); *(u32x2*)(T11T + lane * 80 + i4 * 8) = w; }
                }
            }
        } else {
            const int t2 = tid - 128;
#pragma unroll
            for (int g2 = 0; g2 < 2; ++g2) {
                const int i = t2 & 31, k4 = ((t2 >> 5) + 4 * g2) * 4;
                u32x2 w;
                w.x = pack2(Lf[(k4 + 0) * 72 + 32 + i], Lf[(k4 + 1) * 72 + 32 + i]); w.y = pack2(Lf[(k4 + 2) * 72 + 32 + i], Lf[(k4 + 3) * 72 + 32 + i]);
                *(u32x2*)(L21i + i * 80 + k4 * 2) = w;
            }
        }
        __syncthreads();
        {
            const int r0 = 16 * (wid >> 1), c0 = 16 * (wid & 1);
            const f32x4 mm = tile16(L21i, 80, r0, T11T, 80, c0, 32);
            u32x2 w; w.x = pack2(mm[0], mm[1]); w.y = pack2(mm[2], mm[3]);
            *(u32x2*)(MT + (c0 + fr) * 80 + (r0 + 4 * fq) * 2) = w;
        }
        __syncthreads();
        {
            const int r0 = 16 * (wid >> 1), c0 = 16 * (wid & 1);
            const f32x4 tt = tile16(MT, 80, c0, Trow + 32 * 144 + 64, 144, r0, 32);
            u32x2 w; w.x = pack2(-tt[0], -tt[1]); w.y = pack2(-tt[2], -tt[3]);
            *(u32x2*)(Trow + (32 + r0 + fr) * 144 + (c0 + 4 * fq) * 2) = w;
        }
    }
    __syncthreads();
    {
        const int ti = wid;
#pragma unroll
        for (int tj = 0; tj < 4; ++tj) {
            const f32x4 x = tile16(Trow, 144, 16 * ti, AT, 144, 16 * tj, 64);
            const f32x4 y = tile16(Aak, 144, 16 * ti, VT, 144, 16 * tj, 64);
            u32x2 w;
            w.x = pack2(x[0], x[1]); w.y = pack2(x[2], x[3]); *(u32x2*)(ApT + (16 * tj + fr) * 144 + (16 * ti + 4 * fq) * 2) = w;
            w.x = pack2(y[0], y[1]); w.y = pack2(y[2], y[3]); *(u32x2*)(AkVT + (16 * tj + fr) * 144 + (16 * ti + 4 * fq) * 2) = w;
        }
    }
    __syncthreads();
    {
        const int ti = wid;
#pragma unroll
        for (int tj = 0; tj < 4; ++tj) {
            const f32x4 x = tile16(Trow, 144, 16 * ti, AkVT, 144, 16 * tj, 64);
            u32x2 w; w.x = pack2(x[0], x[1]); w.y = pack2(x[2], x[3]); *(u32x2*)(VpT + (16 * tj + fr) * 144 + (16 * ti + 4 * fq) * 2) = w;
        }
    }
    __syncthreads();
#pragma unroll
    for (int tj = 0; tj < 4; ++tj)
#pragma unroll
        for (int r = 0; r < 4; ++r) {
            const int cb = 16 * tj + 4 * fq + r;
            *(bf16_t*)(BhT + cb * 144 + c * 2) = f2bf(bh[tj * 4 + r]);
            *(bf16_t*)(KhT + cb * 144 + c * 2) = f2bf(kh[tj * 4 + r]);
        }
    __syncthreads();
    {
        unsigned char* opsA = p.ws + WS_HN + (size_t)ch * 16384;
        unsigned char* opsB = p.ws + WS_ROPS + (size_t)ch * 16384;
        const int ti = wid;
#pragma unroll
        for (int tj = 0; tj < 4; ++tj) {
            const f32x4 x = tile16(ApT, 144, 16 * tj, Arb, 144, 16 * ti, 64);
            const f32x4 g = tile16(ApT, 144, 16 * tj, BhT, 144, 16 * ti, 64);
            const int m1 = 16 * ti + fr, mt = m1 >> 5, rr = m1 & 31, hh = fq & 1, jg = fq >> 1;
            const size_t off = ((size_t)((mt * 4 + tj) * 64 + hh * 32 + rr) * 8 + jg * 4) * 2;
            float gd[4];
#pragma unroll
            for (int r = 0; r < 4; ++r) gd[r] = g[r] + ((16 * tj + 4 * fq + r == m1) ? WC[m1] : 0.f);
            u32x2 w;
            w.x = pack2(x[0] + rt[tj * 4], x[1] + rt[tj * 4 + 1]); w.y = pack2(x[2] + rt[tj * 4 + 2], x[3] + rt[tj * 4 + 3]); *(u32x2*)(opsA + off) = w;
            w.x = pack2(gd[0], gd[1]); w.y = pack2(gd[2], gd[3]); *(u32x2*)(opsA + 8192 + off) = w;
            f32x4 y = tile16(Ark, 144, 16 * ti, VT, 144, 16 * tj, 64);
            const f32x4 y2 = tile16(Arb, 144, 16 * ti, VpT, 144, 16 * tj, 64);
            f32x4 kv = tile16(KhT, 144, 16 * ti, VT, 144, 16 * tj, 64);
            const f32x4 kv2 = tile16(BhT, 144, 16 * ti, VpT, 144, 16 * tj, 64);
            const int vcol = 16 * tj + fr, slice = vcol >> 5, r2 = vcol & 31, cb = 16 * ti + 4 * fq, mt2 = cb >> 5, q4 = (cb & 31) >> 2, h2 = q4 & 1, rg = q4 >> 1;
            const size_t off2 = ((size_t)((slice * 2 + mt2) * 64 + h2 * 32 + r2) * 16 + rg * 4) * 2;
            w.x = pack2(y[0] + y2[0], y[1] + y2[1]); w.y = pack2(y[2] + y2[2], y[3] + y2[3]); *(u32x2*)(opsB + off2) = w;
            w.x = pack2(kv[0] + kv2[0], kv[1] + kv2[1]); w.y = pack2(kv[2] + kv2[2], kv[3] + kv2[3]); *(u32x2*)(opsB + 8192 + off2) = w;
        }
    }
}

DI void rwkv_scan_block(const P& p, int bh, char* lds, bool dry = false) {
    const int tid = tidx(), lane = tid & 63, w = tid >> 6, slice = w & 1;
    const int h = bh & 7, b = bh >> 3;
    constexpr int NST = 64 * 2, AH = 3;
    auto issue = [&](int j) {
        const int n = j >> 1, k = j & 1;
        const size_t ch = (size_t)((b * 64 + n) * 8 + h) * 16384;
        const unsigned char* s0 = (k == 0 ? p.ws + WS_ROPS + ch + 8192 : p.ws + WS_ROPS + ch) + tid * 16;
        const unsigned char* s1 = (k == 0 ? p.ws + WS_HN + ch + 8192 : p.ws + WS_HN + ch) + tid * 16;
        char* dst = lds + (j & 3) * 16384 + tid * 16;
        glds16(s0, dst); glds16(s0 + 4096, dst + 4096); glds16(s1, dst + 8192); glds16(s1 + 4096, dst + 12288);
    };
    f32x16 H[2];
#pragma unroll
    for (int i = 0; i < 2; ++i)
#pragma unroll
        for (int r = 0; r < 16; ++r) H[i][r] = 0.f;
    __syncthreads();
#pragma unroll
    for (int j = 0; j < AH; ++j) issue(j);
#pragma unroll 1
    for (int n = 0; n < 64; ++n) {
        bf16x8 Hb[4];
#pragma unroll
        for (int i = 0; i < 2; ++i) { Hb[i * 2] = pack_step(H[i], 0); Hb[i * 2 + 1] = pack_step(H[i], 1); }
#pragma unroll
        for (int k = 0; k < 2; ++k) {
            const int j = n * 2 + k;
            if (n < 63) GS_WAIT(8); else if (k == 0) GS_WAIT(4); else GS_WAIT(0);
            __builtin_amdgcn_s_barrier();
            if (j + AH < NST) issue(j + AH);
            __builtin_amdgcn_sched_barrier(0);
            const char* sl = lds + (j & 3) * 16384;
            if (w < 2) {
                f32x16 acc[2];
#pragma unroll
                for (int mt = 0; mt < 2; ++mt) {
                    const u32x4* up = (const u32x4*)(sl + (slice * 2 + mt) * 2048 + lane * 32);
                    const u32x4 u0 = up[0], u1 = up[1];
#pragma unroll
                    for (int e = 0; e < 4; ++e) {
                        acc[mt][e * 2] = __uint_as_float(u0[e] << 16); acc[mt][e * 2 + 1] = __uint_as_float(u0[e] & 0xffff0000u);
                        acc[mt][8 + e * 2] = __uint_as_float(u1[e] << 16); acc[mt][8 + e * 2 + 1] = __uint_as_float(u1[e] & 0xffff0000u);
                    }
                }
                const bf16x8* fr = (const bf16x8*)(sl + 8192) + lane;
                bf16x8 f8[8];
#pragma unroll
                for (int q = 0; q < 8; ++q) f8[q] = fr[q * 64];
#pragma unroll
                for (int ks = 0; ks < 4; ++ks)
#pragma unroll
                    for (int mt = 0; mt < 2; ++mt) acc[mt] = mfma32(f8[mt * 4 + ks], Hb[ks], acc[mt]);
                if (k == 0) { H[0] = acc[0]; H[1] = acc[1]; }
                else {
                    const size_t ch = (size_t)((b * 64 + n) * 8 + h) * 16384;
                    u32x4* Yf = (u32x4*)(dry ? p.ws + WS_DUMMY + 2097152 + (size_t)(bh & 31) * 16384 : p.ws + WS_ROPS + ch) + (size_t)(slice * 128 + lane) * 2;
#pragma unroll
                    for (int mt = 0; mt < 2; ++mt) {
                        u32x4 o0, o1;
#pragma unroll
                        for (int e = 0; e < 4; ++e) { o0[e] = pack2(acc[mt][e * 2], acc[mt][e * 2 + 1]); o1[e] = pack2(acc[mt][8 + e * 2], acc[mt][8 + e * 2 + 1]); }
                        Yf[mt * 128] = o0; Yf[mt * 128 + 1] = o1;
                    }
                }
            }
        }
    }
    __syncthreads();
}

DI void rwkv_post_unit(const P& p, int li, int ch) {
    const int tid = tidx();
    const int h = ch & 7, n = (ch >> 3) & 63, b = ch >> 9;
    const int t0 = b * SEQ + n * 64;
    const int c = tid >> 2, cq = tid & 3;
    const bf16_t* Yf = (const bf16_t*)(p.ws + WS_ROPS + (size_t)ch * 16384);
    const bf16_t* vf = (const bf16_t*)(p.ws + WS_VF) + (size_t)(t0 + c) * 512 + h * 64 + cq * 16;
    const bf16_t* gg = (const bf16_t*)(p.ws + WS_GG) + (size_t)(t0 + c) * 512 + h * 64 + cq * 16;
    const float rk = ((const float*)(p.ws + WS_RK))[(size_t)(t0 + c) * 8 + h];
    const float* lnw = p.in[I_LNW] + li * 512 + h * 64 + cq * 16;
    const float* lnb = p.in[I_LNB] + li * 512 + h * 64 + cq * 16;
    bf16_t* mp = (bf16_t*)(p.ws + WS_HN) + (size_t)(t0 + c) * 1024 + 512 + h * 64 + cq * 16;
    const int mt = c >> 5, q4 = (c & 31) >> 2, hh = q4 & 1, rg = q4 >> 1, reg = rg * 4 + (c & 3), slice = cq >> 1, rb = (cq & 1) * 16;
    float y[16]; float sm = 0.f;
#pragma unroll
    for (int i = 0; i < 16; ++i) { y[i] = bf2f(Yf[(size_t)((slice * 2 + mt) * 64 + hh * 32 + rb + i) * 16 + reg]); sm += y[i]; }
    sm += __shfl_xor(sm, 1); sm += __shfl_xor(sm, 2);
    const float mean = sm * (1.f / 64.f);
    float vs = 0.f;
#pragma unroll
    for (int i = 0; i < 16; ++i) { y[i] -= mean; vs += y[i] * y[i]; }
    vs += __shfl_xor(vs, 1); vs += __shfl_xor(vs, 2);
    const float rs = rsqrtf(vs * (1.f / 64.f) + 64e-5f);
#pragma unroll
    for (int i8 = 0; i8 < 2; ++i8) {
        const u32x4 vw = *(const u32x4*)(vf + i8 * 8), gw = *(const u32x4*)(gg + i8 * 8);
        u32x4 w;
#pragma unroll
        for (int e = 0; e < 4; ++e) {
            const int i = i8 * 8 + e * 2;
            const float v0 = __uint_as_float(vw[e] << 16), v1 = __uint_as_float(vw[e] & 0xffff0000u), g0 = __uint_as_float(gw[e] << 16), g1 = __uint_as_float(gw[e] & 0xffff0000u);
            w[e] = pack2((y[i] * rs * lnw[i] + lnb[i] + rk * v0) * g0, (y[i + 1] * rs * lnw[i + 1] + lnb[i + 1] + rk * v1) * g1);
        }
        *(u32x4*)(mp + i8 * 8) = w;
    }
}


DI void attn_unit(const P& p, int unit, char* lds) {
    const int tid = tidx(), lane = tid & 63, w = tid >> 6, r_ = lane & 31, hl = lane >> 5;
    const int idx = unit & 31, h = (unit >> 5) & 7, g = (unit >> 8) % 3, b = unit / 768;
    const int lg2 = g * 2, dil = 1 << lg2, L = SEQ >> lg2, ntl = L >> 7;
    const int rs = idx / ntl, qt = idx % ntl;
    const int hg = g * 8 + h;
    const bf16_t* QK = (const bf16_t*)(p.ws + WS_QK);
    const bf16_t* VT = (const bf16_t*)(p.ws + WS_VT) + ((size_t)((b * 24 + hg) * dil + rs) * 64) * L;
    const int qi = 32 * w + r_;
    const int q_idx = 128 * qt + qi;
    const size_t qrow = (size_t)(b * SEQ + q_idx * dil + rs);
    const int kbase0 = 128 * qt - 128;
    char* Kt = lds;
    char* Vt = lds + 32768;
    __syncthreads();
#pragma unroll
    for (int i = 0; i < 8; ++i) {
        const int id = tid + i * 256, row = id >> 3, pc = id & 7, c = pc ^ ((row >> 1) & 7);
        int k_idx = kbase0 + row; if (k_idx < 0) k_idx = 0;
        glds16(QK + (size_t)(b * SEQ + k_idx * dil + rs) * 3072 + 1536 + hg * 64 + c * 8, Kt + id * 16);
    }
#pragma unroll
    for (int i = 0; i < 8; ++i) {
        const int id = tid + i * 256, row = id >> 5, pq = id & 31, q = pq ^ (row & 31);
        int k0 = kbase0 + q * 8; if (k0 < 0) k0 = 0;
        glds16(VT + (size_t)row * L + k0, Vt + id * 16);
    }
    bf16x8 qf[4];
#pragma unroll
    for (int ks = 0; ks < 4; ++ks) qf[ks] = *(const bf16x8*)(QK + qrow * 3072 + hg * 64 + 16 * ks + 8 * hl);
    asm volatile("s_waitcnt vmcnt(0)" ::: "memory");
    __syncthreads();
    f32x16 st[5];
    float mx = -1.0e30f;
#pragma unroll
    for (int kbi = 0; kbi < 5; ++kbi) {
        const int krow = 32 * (w + kbi) + r_;
#pragma unroll
        for (int r = 0; r < 16; ++r) st[kbi][r] = 0.f;
#pragma unroll
        for (int ks = 0; ks < 4; ++ks) {
            const bf16x8 kf = *(const bf16x8*)(Kt + krow * 128 + (((2 * ks + hl) ^ ((krow >> 1) & 7)) * 16));
            st[kbi] = mfma32(kf, qf[ks], st[kbi]);
        }
#pragma unroll
        for (int r = 0; r < 16; ++r) {
            const int kj = 32 * (w + kbi) + (r & 3) + 8 * (r >> 2) + 4 * hl;
            const bool valid = (kj >= qi) && (kj <= qi + 128) && (kbase0 + kj >= 0);
            const float sv = valid ? st[kbi][r] * 0.125f : -1.0e30f;
            st[kbi][r] = sv; mx = fmaxf(mx, sv);
        }
    }
    mx = fmaxf(mx, __shfl_xor(mx, 32));
    float l = 0.f;
#pragma unroll
    for (int kbi = 0; kbi < 5; ++kbi)
#pragma unroll
        for (int r = 0; r < 16; ++r) { const float pv = __expf(st[kbi][r] - mx); st[kbi][r] = pv; l += pv; }
    l += __shfl_xor(l, 32);
    f32x16 ot[2];
#pragma unroll
    for (int dt = 0; dt < 2; ++dt)
#pragma unroll
        for (int r = 0; r < 16; ++r) ot[dt][r] = 0.f;
#pragma unroll
    for (int kbi = 0; kbi < 5; ++kbi)
#pragma unroll
        for (int s2 = 0; s2 < 2; ++s2) {
            const bf16x8 pb = pack_step(st[kbi], s2);
            const int q0 = 4 * (w + kbi) + 2 * s2;
#pragma unroll
            for (int dt = 0; dt < 2; ++dt) {
                const int drow = 32 * dt + r_;
                const u32x2 lo = *(const u32x2*)(Vt + drow * 512 + ((q0 ^ (drow & 31)) * 16) + 8 * hl);
                const u32x2 hi = *(const u32x2*)(Vt + drow * 512 + (((q0 + 1) ^ (drow & 31)) * 16) + 8 * hl);
                u32x4 vw; vw.x = lo.x; vw.y = lo.y; vw.z = hi.x; vw.w = hi.y;
                ot[dt] = mfma32(__builtin_bit_cast(bf16x8, vw), pb, ot[dt]);
            }
        }
    const float inv = 1.f / l;
    bf16_t* og = (bf16_t*)(p.ws + WS_OG) + ((size_t)g * T + qrow) * 512 + h * 64;
#pragma unroll
    for (int dt = 0; dt < 2; ++dt)
#pragma unroll
        for (int rg = 0; rg < 4; ++rg) {
            u32x2 wv; wv.x = pack2(ot[dt][rg * 4] * inv, ot[dt][rg * 4 + 1] * inv); wv.y = pack2(ot[dt][rg * 4 + 2] * inv, ot[dt][rg * 4 + 3] * inv);
            *(u32x2*)(og + 32 * dt + 8 * rg + 4 * hl) = wv;
        }
    if (hl == 0) ((float*)(p.ws + WS_LSE))[((size_t)g * T + qrow) * 8 + h] = mx + __logf(l);
}
DI void phase_attn_merge(const P& p) {
    const bf16_t* og = (const bf16_t*)(p.ws + WS_OG);
    const float* lse = (const float*)(p.ws + WS_LSE);
    bf16_t* o = (bf16_t*)(p.ws + WS_HN);
    for (int i = bidx() * 256 + tidx(); i < T * 64; i += gridDim.x * 256) {
        const int t = i >> 6, c8 = i & 63, h = c8 >> 3;
        const float l0 = lse[(size_t)t * 8 + h], l1 = lse[((size_t)T + t) * 8 + h], l2 = lse[((size_t)2 * T + t) * 8 + h];
        const float m = fmaxf(l0, fmaxf(l1, l2));
        float w0 = __expf(l0 - m), w1 = __expf(l1 - m), w2 = __expf(l2 - m);
        const float inv = 1.f / (w0 + w1 + w2); w0 *= inv; w1 *= inv; w2 *= inv;
        const u32x4 a = *(const u32x4*)(og + (size_t)t * 512 + c8 * 8), bq = *(const u32x4*)(og + ((size_t)T + t) * 512 + c8 * 8), cq = *(const u32x4*)(og + ((size_t)2 * T + t) * 512 + c8 * 8);
        u32x4 r;
#pragma unroll
        for (int e = 0; e < 4; ++e) {
            const float x0 = w0 * __uint_as_float(a[e] << 16) + w1 * __uint_as_float(bq[e] << 16) + w2 * __uint_as_float(cq[e] << 16);
            const float x1 = w0 * __uint_as_float(a[e] & 0xffff0000u) + w1 * __uint_as_float(bq[e] & 0xffff0000u) + w2 * __uint_as_float(cq[e] & 0xffff0000u);
            r[e] = pack2(x0, x1);
        }
        *(u32x4*)(o + (size_t)t * 512 + c8 * 8) = r;
    }
}


#define XB_TMO      128
#define XB_XCNT(j)  (256  + 64 * (j))
#define XB_XSUB(j)  (1280 + 64 * (j))
#define XB_XGEN(j)  (2304 + 64 * (j))
#define XB_TOP      3328
#define XB_TOPGEN   3392
#define XCD_BAR_WORDS 3456
#define XB_SPIN_CAP (1u << 22)
#define LAS __attribute__((address_space(3)))
DI unsigned xb_ld(unsigned* p)              { return __hip_atomic_load(p, __ATOMIC_RELAXED, __HIP_MEMORY_SCOPE_AGENT); }
DI unsigned xb_add(unsigned* p, unsigned v) { return __hip_atomic_fetch_add(p, v, __ATOMIC_RELAXED, __HIP_MEMORY_SCOPE_AGENT); }
DI unsigned xb_xcc_id() { return (unsigned)__builtin_amdgcn_s_getreg((3 << 11) | 20) & 0xFu; }
#define XB_SPIN(cond, bar) do { unsigned _sp = 0; while (cond) { if (_sp < 32u) __builtin_amdgcn_s_sleep(2); else __builtin_amdgcn_s_sleep(24); \
    if ((++_sp & 255u) == 0u) { if (xb_ld(&(bar)[XB_TMO])) break; if (_sp > XB_SPIN_CAP) { atomicAdd(&(bar)[XB_TMO], 1u); break; } } } } while (0)
struct XcdBarrier { unsigned* bar; unsigned x; volatile LAS unsigned* st; };
DI XcdBarrier xcd_barrier_post(unsigned* bar, volatile LAS unsigned* st) {
    XcdBarrier b; b.bar = bar; b.x = xb_xcc_id(); b.st = st;
    if (threadIdx.x == 0) (void)xb_add(&bar[XB_XCNT(b.x)], 1u);
    return b;
}
DI void xcd_barrier_complete(unsigned* bar, unsigned x, unsigned& nloc, unsigned& nx) {
    const unsigned G = gridDim.x * gridDim.y * gridDim.z;
    unsigned sum, cnt, mine, sp = 0u;
    for (;;) {
        sum = 0u; cnt = 0u; mine = 0u;
#pragma unroll
        for (unsigned j = 0; j < 16; ++j) { const unsigned c = xb_ld(&bar[XB_XCNT(j)]); sum += c; cnt += (c > 0u) ? 1u : 0u; mine = (j == x) ? c : mine; }
        if (sum == G) break;
        __builtin_amdgcn_s_sleep(1);
        if ((++sp & 255u) == 0u) { if (xb_ld(&bar[XB_TMO])) break; if (sp > XB_SPIN_CAP) { atomicAdd(&bar[XB_TMO], 1u); break; } }
    }
    nloc = mine > 0u ? mine : 1u; nx = cnt > 0u ? cnt : 1u;
}
DI void xcd_barrier(const XcdBarrier& b) {
    asm volatile("s_waitcnt vmcnt(0)" ::: "memory");
    __syncthreads();
    if (threadIdx.x == 0) {
        unsigned* bar = b.bar; unsigned bx = b.x;
        asm volatile("" : "+s"(bar), "+s"(bx));
        __builtin_amdgcn_s_waitcnt(0);
        unsigned nloc = b.st[0], nx = b.st[1];
        if (nloc == 0u) { xcd_barrier_complete(bar, bx, nloc, nx); b.st[0] = nloc; b.st[1] = nx; }
        const unsigned old = xb_add(&bar[XB_XSUB(bx)], 1u);
        const unsigned gen = old / nloc;
        if (old + 1u == (gen + 1u) * nloc) {
            __builtin_amdgcn_fence(__ATOMIC_RELEASE, "agent");
            asm volatile("s_waitcnt vmcnt(0)" ::: "memory");
            const unsigned og = xb_add(&bar[XB_TOP], 1u);
            const unsigned tg = og / nx;
            if (og + 1u == (tg + 1u) * nx) xb_add(&bar[XB_TOPGEN], 1u);
            else XB_SPIN(xb_ld(&bar[XB_TOPGEN]) == tg, bar);
            __builtin_amdgcn_fence(__ATOMIC_ACQUIRE, "agent");
            xb_add(&bar[XB_XGEN(bx)], 1u);
            asm volatile("s_waitcnt vmcnt(0)" ::: "memory");
        } else {
            XB_SPIN(xb_ld(&bar[XB_XGEN(bx)]) == gen, bar);
            __builtin_amdgcn_fence(__ATOMIC_ACQUIRE, "agent");
            asm volatile("s_waitcnt vmcnt(0)" ::: "memory");
        }
    }
    __syncthreads();
}

constexpr int LDS_BYTES = RP_END;
static_assert(GP_END + 6144 <= LDS_BYTES, "LDS");
__global__ void __launch_bounds__(256, 2) mega(P p) {
    cg::grid_group grid = cg::this_grid();
    extern __shared__ __attribute__((aligned(16))) char lds[];
    if (threadIdx.x < 4) ((volatile LAS unsigned*)(lds + LDS_BYTES))[threadIdx.x] = 0u;
    __syncthreads();
    const XcdBarrier xb = xcd_barrier_post((unsigned*)(p.ws + WS_CTL + CTL_BAR), (volatile LAS unsigned*)(lds + LDS_BYTES));
#define GSYNC() xcd_barrier(xb)
    const bf16_t* HN = (const bf16_t*)(p.ws + WS_HN);
    const bf16_t* Win = (const bf16_t*)(p.ws + WS_W + W_IN);
    const bf16_t* Wout = (const bf16_t*)(p.ws + WS_W + W_OUT);
    phase_rope(p);
    phase_convert_io(p, 0, lds);
    phase_prep<0>(p, p.in[I_EVNORM], 0);
    if (p.ws == nullptr) grid.sync();
    GSYNC();
    volatile LAS unsigned* qword = (volatile LAS unsigned*)(lds + LDS_BYTES + 8);
    for (int layer = 0; layer < 4; ++layer) {
        const int li = layer >> 1;
        if ((layer & 1) == 0) {
            phase_gemm<EPI_EVEN_IN>(p, HN, 1024, Win, 1024, EVPAD / 128, lds);
            GSYNC();
            for (int u = bidx(); u < 1024; u += gridDim.x) gdn_prep_unit(p, li, u, lds);
            GSYNC();
            if (bidx() < 16) gdn_scan_block(p, bidx(), lds);
            {
                unsigned* qctr = (unsigned*)(p.ws + WS_CTL + CTL_QUEUE) + li * 64;
                for (;;) {
                    __syncthreads();
                    if (threadIdx.x == 0) *qword = atomicAdd(qctr, 1u);
                    __syncthreads();
                    const unsigned u = *qword;
                    if (u >= 2048u) break;
                    rwkv_prep_unit(p, li, (int)u, lds);
                }
            }
            GSYNC();
            if (bidx() < 32) rwkv_scan_block(p, bidx(), lds);
            else {
                for (int u = bidx() - 32; u < 1024; u += gridDim.x - 32) gdn_post_unit(p, li, u);
                phase_convert_moe(p, layer, lds, bidx() - 32, gridDim.x - 32);
            }
            GSYNC();
            for (int u = bidx(); u < 2048; u += gridDim.x) rwkv_post_unit(p, li, u);
            GSYNC();
            phase_gemm<EPI_RESID>(p, (const bf16_t*)(p.ws + WS_PROJ), EVLD, Wout, 1024, 8, lds, false, HN, 1024, 512);
        } else {
            phase_gemm<EPI_ODD_IN>(p, HN, 1024, Win, 1024, ODC / 128, lds);
            GSYNC();
            for (int u = bidx(); u < 3072; u += gridDim.x) attn_unit(p, u, lds);
            GSYNC();
            phase_attn_merge(p);
            GSYNC();
            phase_gemm<EPI_RESID>(p, HN, 512, Wout, 512, 8, lds);
        }
        GSYNC();
        phase_router(p, p.in[I_FFNNORM] + layer * 1024, layer, lds);
        GSYNC();
        phase_moe_up(p, layer, lds);
        GSYNC();
        phase_moe_down(p, layer, lds);
        GSYNC();
        if (layer < 3) {
            phase_convert_io(p, layer + 1, lds);
            if ((layer + 1) & 1) phase_convert_moe(p, layer + 1, lds, bidx(), gridDim.x);
            phase_prep<1>(p, ((layer + 1) & 1) ? p.in[I_ODNORM] + ((layer + 1) >> 1) * 1024 : p.in[I_EVNORM] + ((layer + 1) >> 1) * 1024, layer + 1);
            GSYNC();
        }
    }
    phase_prep<3>(p, p.in[I_FINAL], 0);
}

extern "C" void kernel_launch(void* const* d_in, const int* in_sizes, int n_in, void* d_out, int out_size, void* d_ws, size_t ws_size, hipStream_t stream) {
    if (n_in != 34 || out_size != T * D || ws_size < WS_END) { fprintf(stderr, "kernel_launch: unexpected shapes (n_in %d out %d ws %zu need %zu)\n", n_in, out_size, ws_size, (size_t)WS_END); return; }
    static int grid_blocks = 0;
    if (!grid_blocks) {
        int dev = 0, cus = 0, per_cu = 0;
        (void)hipGetDevice(&dev);
        (void)hipDeviceGetAttribute(&cus, hipDeviceAttributeMultiprocessorCount, dev);
        (void)hipFuncSetAttribute((const void*)mega, hipFuncAttributeMaxDynamicSharedMemorySize, LDS_BYTES + 16);
        (void)hipOccupancyMaxActiveBlocksPerMultiprocessor(&per_cu, mega, 256, LDS_BYTES + 16);
        if (per_cu < 1) per_cu = 1;
        if (per_cu > 2) per_cu = 2;
        grid_blocks = cus * per_cu;
    }
    P p{};
    for (int i = 0; i < 34; ++i) p.in[i] = (const float*)d_in[i];
    p.out = (float*)d_out; p.ws = (unsigned char*)d_ws;
    (void)hipMemsetAsync((char*)d_ws + WS_CTL, 0, 65536, stream);
    void* args[] = {&p};
    hipError_t e = hipLaunchCooperativeKernel((void*)mega, dim3(grid_blocks), dim3(256), args, LDS_BYTES + 16, stream);
    if (e != hipSuccess) fprintf(stderr, "cooperative launch failed: %s (grid %d)\n", hipGetErrorString(e), grid_blocks);
}
```

```cpp
#include <hip/hip_runtime.h>
#include <cstdio>
#include <cstdint>
#include <cmath>
#include <hip/hip_cooperative_groups.h>
namespace cg = cooperative_groups;

typedef unsigned short bf16_t;
typedef short bf16x8 __attribute__((ext_vector_type(8)));
typedef float f32x4 __attribute__((ext_vector_type(4)));
typedef unsigned u32x4 __attribute__((ext_vector_type(4)));
typedef unsigned u32x2 __attribute__((ext_vector_type(2)));
#define DI __device__ __forceinline__

constexpr int T = 16384, SEQ = 4096, BATCH = 4, D = 1024;
constexpr int EVC = 3784, EVLD = 3784, EVPAD = 3840;
constexpr int ODC = 4608;
constexpr int RW0 = 2056;
constexpr int C_R = 2056, C_K = 2568, C_V = 3080, C_HW = 3592, C_HA = 3624, C_HG = 3656, C_HV = 3752;
constexpr int NEXP = 16, FF = 256;
constexpr int HROWS = 34816;

constexpr size_t WS_CTL = 0;
constexpr size_t CTL_EGL = 4096;
constexpr size_t CTL_QUEUE = 49152;
constexpr size_t CTL_CNT = 32768;
constexpr size_t CTL_BAR = 16384;
constexpr size_t WS_LIST = 65536;
constexpr size_t WS_GATE = WS_LIST + 16 * 16384 * 4;
constexpr size_t WS_RK = WS_GATE + 16 * 16384 * 4;
constexpr size_t WS_SSQ = WS_RK + (size_t)T * 8 * 4;
constexpr size_t WS_ROPE = WS_SSQ + (size_t)16 * T * 4;
constexpr size_t WS_W = WS_ROPE + (size_t)T * 32 * 8;
constexpr size_t W_IN = 0;
constexpr size_t W_OUT = (size_t)4608 * 1024 * 2;
constexpr size_t W_13 = W_OUT + (size_t)1024 * 1024 * 2;
constexpr size_t W_2 = W_13 + (size_t)16 * 512 * 1024 * 2;
constexpr size_t W_LW = W_2 + (size_t)16 * 1024 * 256 * 2;
constexpr size_t W_BYTES = W_LW + (size_t)512 * 192 * 2;
constexpr size_t WS_XB = WS_W + W_BYTES;
constexpr size_t WS_HN = WS_XB;
constexpr size_t WS_VF = WS_HN + (size_t)T * 1024 * 2;
constexpr size_t WS_R2 = WS_VF + (size_t)T * 512 * 2;
constexpr size_t WS_PROJ = WS_R2;
constexpr size_t WS_GOPS = WS_R2 + (size_t)T * EVLD * 2;
constexpr size_t GOPS_CH = 73728, GO_UF = 0, GO_WF = 16384, GO_QF = 32768, GO_AF = 49152, GO_KF = 57344;
constexpr size_t WS_ROPS = WS_GOPS + 1024 * GOPS_CH;
constexpr size_t WS_QK = WS_R2;
constexpr size_t WS_VT = WS_QK + (size_t)T * 3072 * 2;
constexpr size_t WS_OG = WS_VT + (size_t)T * 1536 * 2;
constexpr size_t WS_LSE = WS_OG + (size_t)3 * T * 512 * 2;
constexpr size_t WS_END3 = WS_LSE + (size_t)3 * T * 8 * 4;
constexpr size_t WS_YS = WS_R2;
constexpr size_t WS_H = WS_YS + (size_t)2 * T * 1024 * 2;
constexpr size_t WS_GG = WS_ROPS + (size_t)2048 * 16384;
constexpr size_t WS_END0 = WS_GG + (size_t)T * 512 * 2;
constexpr size_t WS_END1 = WS_H + (size_t)HROWS * 256 * 2;
constexpr size_t WS_END2 = WS_R2 + (size_t)T * 4608 * 2;
static_assert(WS_END3 <= WS_END0, "odd-layer regions exceed even-layer footprint");
constexpr size_t WS_END = WS_END0 > WS_END1 ? (WS_END0 > WS_END2 ? WS_END0 : WS_END2) : (WS_END1 > WS_END2 ? WS_END1 : WS_END2);

constexpr size_t WS_DUMMY = WS_END0;
struct P {
    const float* in[34];
    float* out;
    unsigned char* ws;
};
enum { I_X = 0, I_POS, I_EVNORM, I_EVWIN, I_VRESDOWN, I_EVWOUT, I_CONVW, I_ALOG, I_DTB, I_GDNNORM, I_MU, I_W0, I_W2, I_A0, I_A2, I_G2,
       I_KK, I_KA, I_RK, I_LNW, I_LNB, I_VRESMU, I_V0, I_V2, I_ODNORM, I_ODWIN, I_ODWOUT, I_FFNNORM, I_WGROUP, I_WEXPERT, I_W1, I_W3, I_MW2, I_FINAL };

DI int tidx() { int t = threadIdx.x; asm volatile("" : "+v"(t)); return t; }
DI int bidx() { int b = blockIdx.x; asm volatile("" : "+s"(b)); return b; }
typedef __bf16 bf2_t __attribute__((ext_vector_type(2)));
typedef float f2_t __attribute__((ext_vector_type(2)));
DI bf16_t f2bf(float x) { return __builtin_bit_cast(bf16_t, (__bf16)x); }
DI float bf2f(bf16_t h) { return __uint_as_float(((unsigned)h) << 16); }
DI unsigned pack2(float lo, float hi) { const f2_t v = {lo, hi}; return __builtin_bit_cast(unsigned, __builtin_convertvector(v, bf2_t)); }
DI float wave_sum(float v) {
#pragma unroll
    for (int o = 32; o > 0; o >>= 1) v += __shfl_xor(v, o);
    return v;
}
DI float wave_max(float v) {
#pragma unroll
    for (int o = 32; o > 0; o >>= 1) v = fmaxf(v, __shfl_xor(v, o));
    return v;
}
DI float sigmoidf_(float x) { return __builtin_amdgcn_rcpf(1.f + __expf(-x)); }
DI float siluf_(float x) { return x * __builtin_amdgcn_rcpf(1.f + __expf(-x)); }
DI float softplusf_(float x) { return fmaxf(x, 0.f) + __logf(1.f + __expf(-fabsf(x))); }

struct ConvJob { const float* src; bf16_t* dst; int K, N, ldd; int mode; };
DI int rowmap(int mode, int n) { return mode == 0 ? n : ((n >> 4) * 32 + (n & 15) + (mode == 2 ? 16 : 0)); }
DI void conv_tile(const ConvJob& j, int tile, float* lds  ) {
    const int ntn = (j.N + 255) / 256;
    const int tk = tile / ntn, tn = tile % ntn;
    const int tid = tidx();
    __syncthreads();
    float4 v[16];
#pragma unroll
    for (int i = 0; i < 16; ++i) {
        const int e = tid + i * 256, k = e >> 6, n4 = (e & 63) * 4;
        const int gk = tk * 64 + k, gn = tn * 256 + n4;
        v[i] = make_float4(0.f, 0.f, 0.f, 0.f);
        if (gn < j.N) v[i] = *(const float4*)(j.src + (size_t)gk * j.N + gn);
    }
#pragma unroll
    for (int i = 0; i < 16; ++i) { const int e = tid + i * 256, k = e >> 6, n4 = (e & 63) * 4; *(float4*)(lds + k * 260 + n4) = v[i]; }
    __syncthreads();
#pragma unroll
    for (int i = 0; i < 8; ++i) {
        const int e = tid + i * 256, n = e & 255, k8 = (e >> 8) * 8;
        const int gn = tn * 256 + n;
        if (gn < j.N) {
            u32x4 w;
            w.x = pack2(lds[(k8 + 0) * 260 + n], lds[(k8 + 1) * 260 + n]); w.y = pack2(lds[(k8 + 2) * 260 + n], lds[(k8 + 3) * 260 + n]);
            w.z = pack2(lds[(k8 + 4) * 260 + n], lds[(k8 + 5) * 260 + n]); w.w = pack2(lds[(k8 + 6) * 260 + n], lds[(k8 + 7) * 260 + n]);
            *(u32x4*)(j.dst + (size_t)rowmap(j.mode, gn) * j.ldd + tk * 64 + k8) = w;
        }
    }
}
DI void phase_convert_io(const P& p, int layer, char* ldsc) {
    float* lds = (float*)ldsc;
    unsigned char* W = p.ws + WS_W;
    const int li = layer >> 1;
    if ((layer & 1) == 0) {
        const ConvJob j0{p.in[I_EVWIN] + (size_t)li * 1024 * 3752, (bf16_t*)(W + W_IN), 1024, 3752, 1024, 0};
        for (int t = bidx(); t < 16 * 15; t += gridDim.x) conv_tile(j0, t, lds);
        if (li == 1) {
            const ConvJob j1{p.in[I_VRESDOWN], (bf16_t*)(W + W_IN) + (size_t)3752 * 1024, 1024, 32, 1024, 0};
            for (int t = bidx(); t < 16; t += gridDim.x) conv_tile(j1, t, lds);
        }
        const ConvJob j2{p.in[I_EVWOUT] + (size_t)li * 1024 * 1024, (bf16_t*)(W + W_OUT), 1024, 1024, 1024, 0};
        for (int t = bidx(); t < 16 * 4; t += gridDim.x) conv_tile(j2, t, lds);
        {
            bf16_t* LW = (bf16_t*)(W + W_LW);
            for (int i = bidx() * 256 + tidx(); i < 512 * 192; i += gridDim.x * 256) {
                const int ch = i / 192, j = i % 192;
                float v;
                if (j < 32) v = p.in[I_W2][((size_t)li * 32 + j) * 512 + ch];
                else if (j < 64) v = p.in[I_A2][((size_t)li * 32 + j - 32) * 512 + ch];
                else if (j < 160) v = p.in[I_G2][((size_t)li * 96 + j - 64) * 512 + ch];
                else v = (li == 1) ? p.in[I_V2][(size_t)(j - 160) * 512 + ch] : 0.f;
                LW[i] = f2bf(v);
            }
        }
        const int r0 = (li == 1) ? 3784 : 3752;
        bf16_t* z = (bf16_t*)(W + W_IN) + (size_t)r0 * 1024;
        const size_t n = (size_t)(EVPAD - r0) * 1024;
        for (size_t i = (size_t)bidx() * 256 + tidx(); i < n; i += (size_t)gridDim.x * 256) z[i] = 0;
    } else {
        const ConvJob j0{p.in[I_ODWIN] + (size_t)li * 1024 * 4608, (bf16_t*)(W + W_IN), 1024, 4608, 1024, 0};
        for (int t = bidx(); t < 16 * 18; t += gridDim.x) conv_tile(j0, t, lds);
        const ConvJob j2{p.in[I_ODWOUT] + (size_t)li * 512 * 1024, (bf16_t*)(W + W_OUT), 512, 1024, 512, 0};
        for (int t = bidx(); t < 8 * 4; t += gridDim.x) conv_tile(j2, t, lds);
    }
}
DI void phase_convert_moe(const P& p, int layer, char* ldsc, int b0, int bs) {
    float* lds = (float*)ldsc;
    unsigned char* W = p.ws + WS_W;
    for (int t = b0; t < 16 * 3 * 16; t += bs) {
        const int e = t / 48, r = t % 48, which = r / 16, tile = r % 16;
        ConvJob j;
        if (which == 0) j = ConvJob{p.in[I_W1] + ((size_t)layer * 16 + e) * 1024 * 256, (bf16_t*)(W + W_13) + (size_t)e * 512 * 1024, 1024, 256, 1024, 1};
        else if (which == 1) j = ConvJob{p.in[I_W3] + ((size_t)layer * 16 + e) * 1024 * 256, (bf16_t*)(W + W_13) + (size_t)e * 512 * 1024, 1024, 256, 1024, 2};
        else j = ConvJob{p.in[I_MW2] + ((size_t)layer * 16 + e) * 256 * 1024, (bf16_t*)(W + W_2) + (size_t)e * 1024 * 256, 256, 1024, 256, 0};
        conv_tile(j, tile, lds);
    }
}

DI void phase_rope(const P& p) {
    float2* tab = (float2*)(p.ws + WS_ROPE);
    const int* pos = (const int*)p.in[I_POS];
    for (int i = bidx() * 256 + tidx(); i < T * 32; i += gridDim.x * 256) {
        const int t = i >> 5, f = i & 31;
        const float inv = powf(10000.0f, -(float)f * (2.0f / 64.0f));
        const float ang = (float)pos[t] * inv;
        float s, c; sincosf(ang, &s, &c);
        tab[i] = make_float2(c, s);
    }
}

template <int MODE>
DI void phase_prep(const P& p, const float* gain, int layer) {
    const int lane = tidx() & 63, wid = tidx() >> 6;
    const int nw = gridDim.x * 4;
    bf16_t* hn = (bf16_t*)p.out;
    bf16_t* xb = (bf16_t*)(p.ws + WS_XB);
    const bf16_t* y0 = (const bf16_t*)(p.ws + WS_YS);
    const bf16_t* y1 = y0 + (size_t)T * 1024;
    float4 gq[4];
#pragma unroll
    for (int i = 0; i < 4; ++i) gq[i] = *(const float4*)(gain + i * 256 + lane * 4);
    for (int t = bidx() * 4 + wid; t < T; t += nw) {
        float4 v[4];
        float ss = 0.f;
#pragma unroll
        for (int i = 0; i < 4; ++i) {
            const size_t off = (size_t)t * 1024 + i * 256 + lane * 4;
            if (MODE == 0) v[i] = *(const float4*)(p.in[I_X] + off);
            else { const u32x2 xx = *(const u32x2*)(xb + off); v[i].x = __uint_as_float(xx.x << 16); v[i].y = __uint_as_float(xx.x & 0xffff0000u); v[i].z = __uint_as_float(xx.y << 16); v[i].w = __uint_as_float(xx.y & 0xffff0000u); }
            if (MODE == 1 || MODE == 3) {
                const u32x2 a = *(const u32x2*)(y0 + off), b = *(const u32x2*)(y1 + off);
                v[i].x += __uint_as_float(a.x << 16) + __uint_as_float(b.x << 16); v[i].y += __uint_as_float(a.x & 0xffff0000u) + __uint_as_float(b.x & 0xffff0000u);
                v[i].z += __uint_as_float(a.y << 16) + __uint_as_float(b.y << 16); v[i].w += __uint_as_float(a.y & 0xffff0000u) + __uint_as_float(b.y & 0xffff0000u);
            }
            ss += v[i].x * v[i].x + v[i].y * v[i].y + v[i].z * v[i].z + v[i].w * v[i].w;
        }
        ss = wave_sum(ss);
        const float rstd = rsqrtf(ss * (1.0f / 1024.0f) + 1e-6f);
        float lg[20];
        if (MODE == 2) {
#pragma unroll
            for (int q = 0; q < 20; ++q) lg[q] = 0.f;
        }
#pragma unroll
        for (int i = 0; i < 4; ++i) {
            const int col = i * 256 + lane * 4;
            const size_t off = (size_t)t * 1024 + col;
            const float4 g = gq[i];
            float4 h; h.x = v[i].x * rstd * g.x; h.y = v[i].y * rstd * g.y; h.z = v[i].z * rstd * g.z; h.w = v[i].w * rstd * g.w;
            bf16_t* hd = hn + off;
            if (MODE == 0 || MODE == 1) { u32x2 w; w.x = pack2(v[i].x, v[i].y); w.y = pack2(v[i].z, v[i].w); *(u32x2*)(xb + off) = w; }
            if (MODE == 3) *(float4*)(p.out + off) = h;
            else { u32x2 w; w.x = pack2(h.x, h.y); w.y = pack2(h.z, h.w); *(u32x2*)hd = w; }
            if (MODE == 2) {
                const float hh[4] = {h.x, h.y, h.z, h.w};
                const float* wg = p.in[I_WGROUP] + (size_t)layer * 1024 * 4;
                const float* we = p.in[I_WEXPERT] + (size_t)layer * 4 * 1024 * 4;
#pragma unroll
                for (int e = 0; e < 4; ++e) {
                    const float4 a = *(const float4*)(wg + (size_t)(col + e) * 4);
                    lg[0] += hh[e] * a.x; lg[1] += hh[e] * a.y; lg[2] += hh[e] * a.z; lg[3] += hh[e] * a.w;
#pragma unroll
                    for (int g2 = 0; g2 < 4; ++g2) {
                        const float4 b = *(const float4*)(we + ((size_t)g2 * 1024 + col + e) * 4);
                        lg[4 + g2 * 4 + 0] += hh[e] * b.x; lg[4 + g2 * 4 + 1] += hh[e] * b.y; lg[4 + g2 * 4 + 2] += hh[e] * b.z; lg[4 + g2 * 4 + 3] += hh[e] * b.w;
                    }
                }
            }
        }
        if (MODE == 2) {
#pragma unroll
            for (int q = 0; q < 20; ++q) lg[q] = wave_sum(lg[q]);
            if (lane == 0) {
                int gs = 0; float gm = lg[0];
#pragma unroll
                for (int g2 = 1; g2 < 4; ++g2) if (lg[g2] > gm) { gm = lg[g2]; gs = g2; }
                float den = 0.f;
#pragma unroll
                for (int g2 = 0; g2 < 4; ++g2) den += __expf(lg[g2] - gm);
                const float pg = 1.f / den;
                float el[4];
#pragma unroll
                for (int e = 0; e < 4; ++e) el[e] = gs == 0 ? lg[4 + e] : gs == 1 ? lg[8 + e] : gs == 2 ? lg[12 + e] : lg[16 + e];
                int i1 = 0; float v1 = el[0];
#pragma unroll
                for (int e = 1; e < 4; ++e) if (el[e] > v1) { v1 = el[e]; i1 = e; }
                int i2 = 0; float v2 = -3.4e38f;
#pragma unroll
                for (int e = 0; e < 4; ++e) if (e != i1 && el[e] > v2) { v2 = el[e]; i2 = e; }
                const float e2 = __expf(v2 - v1);
                const float g1 = pg / (1.f + e2), g2v = pg * e2 / (1.f + e2);
                unsigned* cnt = (unsigned*)(p.ws + WS_CTL + CTL_CNT) + layer * 16 * 64;
                int* list = (int*)(p.ws + WS_LIST);
                float* gl = (float*)(p.ws + WS_GATE);
                const int ea = gs * 4 + i1, eb = gs * 4 + i2;
                const unsigned ra = atomicAdd(&cnt[ea * 64], 1u);
                list[ea * 16384 + ra] = t * 2; gl[ea * 16384 + ra] = g1;
                const unsigned rb = atomicAdd(&cnt[eb * 64], 1u);
                list[eb * 16384 + rb] = t * 2 + 1; gl[eb * 16384 + rb] = g2v;
            }
        }
    }
}


typedef __attribute__((address_space(3))) unsigned lds_u32;
DI void g_dma(unsigned m0v, unsigned voff, const char* sbase) {
    asm volatile("s_mov_b32 m0, %0\n\ts_nop 0\n\tglobal_load_lds_dwordx4 %1, %2" :: "s"(m0v), "v"(voff), "s"(sbase) : "memory", "m0");
}
DI void phase_router(const P& p, const float* gain, int layer, char* ldsc) {
    const int tid = tidx(), lane = tid & 63, wid = tid >> 6;
    bf16_t* hn = (bf16_t*)p.out;
    const bf16_t* xb = (const bf16_t*)(p.ws + WS_XB);
    const float* wg = p.in[I_WGROUP] + (size_t)layer * 1024 * 4;
    const float* we = p.in[I_WEXPERT] + (size_t)layer * 4 * 1024 * 4;
    unsigned* cnt = (unsigned*)(p.ws + WS_CTL + CTL_CNT) + layer * 16 * 64;
    int* list = (int*)(p.ws + WS_LIST);
    float* gl = (float*)(p.ws + WS_GATE);
    f32x4* WS = (f32x4*)ldsc;
    unsigned* lcnt = (unsigned*)(ldsc + 40960); unsigned* lbase = lcnt + 16; int* e_ent = (int*)(lcnt + 32); unsigned* r_ent = (unsigned*)(e_ent + 32); int* t_ent = (int*)(r_ent + 32); float* g_ent = (float*)(t_ent + 32);
    const unsigned wsb = (unsigned)__builtin_amdgcn_readfirstlane((int)((unsigned)(size_t)(lds_u32*)ldsc + wid * 1024));
    auto stage = [&](int i, int buf) {
        const unsigned voff = (unsigned)(i * 256 + lane * 4 + wid) * 16u;
#pragma unroll
        for (int r = 0; r < 5; ++r) g_dma(wsb + (unsigned)(buf * 1280 + r * 256) * 16u, voff, (const char*)(r == 0 ? wg : we + (size_t)(r - 1) * 4096));
    };
    u32x2 xq[4];
#pragma unroll
    for (int q = 0; q < 4; ++q) xq[q] = *(const u32x2*)(xb + (size_t)(bidx() * 16 + wid * 4 + q) * 1024 + lane * 4);
    for (int tb = bidx() * 16; tb < T; tb += gridDim.x * 16) {
        const int t0 = tb + wid * 4;
        __syncthreads();
        if (tid < 16) lcnt[tid] = 0u;
        stage(0, 0);
        float rstd[4];
        {
            const float pq = ((const float*)(p.ws + WS_SSQ))[(size_t)(lane & 15) * T + t0 + (lane >> 4)];
            float ss = pq;
            ss += __shfl_xor(ss, 1); ss += __shfl_xor(ss, 2); ss += __shfl_xor(ss, 4); ss += __shfl_xor(ss, 8);
#pragma unroll
            for (int q = 0; q < 4; ++q) rstd[q] = rsqrtf(__shfl(ss, q * 16) * (1.0f / 1024.0f) + 1e-6f);
        }
        float lg[4][20];
#pragma unroll
        for (int q = 0; q < 4; ++q)
#pragma unroll
            for (int j = 0; j < 20; ++j) lg[q][j] = 0.f;
        asm volatile("s_waitcnt vmcnt(0)" ::: "memory");
#pragma unroll 1
        for (int i = 0; i < 4; ++i) {
            if (i > 0) asm volatile("s_waitcnt vmcnt(4)" ::: "memory");
            __syncthreads();
            if (i + 1 < 4) stage(i + 1, (i + 1) & 1);
            const f32x4* W = WS + (i & 1) * 1280;
            const int col = i * 256 + lane * 4;
            const float4 g = *(const float4*)(gain + col);
            float hh[4][4];
#pragma unroll
            for (int q = 0; q < 4; ++q) {
                hh[q][0] = __uint_as_float(xq[q].x << 16) * rstd[q] * g.x; hh[q][1] = __uint_as_float(xq[q].x & 0xffff0000u) * rstd[q] * g.y; hh[q][2] = __uint_as_float(xq[q].y << 16) * rstd[q] * g.z; hh[q][3] = __uint_as_float(xq[q].y & 0xffff0000u) * rstd[q] * g.w;
            }
            {
                int tn0 = i + 1 < 4 ? t0 : t0 + (int)gridDim.x * 16; const int cn = ((i + 1) & 3) * 256 + lane * 4;
                tn0 = tn0 < T ? tn0 : t0;
#pragma unroll
                for (int q = 0; q < 4; ++q) xq[q] = *(const u32x2*)(xb + (size_t)(tn0 + q) * 1024 + cn);
            }
#pragma unroll
            for (int q = 0; q < 4; ++q) {
                u32x2 w; w.x = pack2(hh[q][0], hh[q][1]); w.y = pack2(hh[q][2], hh[q][3]);
                *(u32x2*)(hn + (size_t)(t0 + q) * 1024 + col) = w;
            }
#pragma unroll
            for (int e = 0; e < 4; ++e) {
                const f32x4 a = W[(0 * 4 + e) * 64 + lane];
#pragma unroll
                for (int q = 0; q < 4; ++q) { lg[q][0] += hh[q][e] * a[0]; lg[q][1] += hh[q][e] * a[1]; lg[q][2] += hh[q][e] * a[2]; lg[q][3] += hh[q][e] * a[3]; }
#pragma unroll
                for (int g2 = 0; g2 < 4; ++g2) {
                    const f32x4 b = W[((1 + g2) * 4 + e) * 64 + lane];
#pragma unroll
                    for (int q = 0; q < 4; ++q) { lg[q][4 + g2 * 4] += hh[q][e] * b[0]; lg[q][5 + g2 * 4] += hh[q][e] * b[1]; lg[q][6 + g2 * 4] += hh[q][e] * b[2]; lg[q][7 + g2 * 4] += hh[q][e] * b[3]; }
                }
            }
        }
#pragma unroll
        for (int q = 0; q < 4; ++q) {
#pragma unroll
            for (int j = 0; j < 20; ++j) lg[q][j] = wave_sum(lg[q][j]);
            if (lane == q) {
                const int t = t0 + q;
                int gs = 0; float gm = lg[q][0];
#pragma unroll
                for (int g2 = 1; g2 < 4; ++g2) if (lg[q][g2] > gm) { gm = lg[q][g2]; gs = g2; }
                float den = 0.f;
#pragma unroll
                for (int g2 = 0; g2 < 4; ++g2) den += __expf(lg[q][g2] - gm);
                const float pg = 1.f / den;
                float el[4];
#pragma unroll
                for (int e = 0; e < 4; ++e) el[e] = gs == 0 ? lg[q][4 + e] : gs == 1 ? lg[q][8 + e] : gs == 2 ? lg[q][12 + e] : lg[q][16 + e];
                int i1 = 0; float v1 = el[0];
#pragma unroll
                for (int e = 1; e < 4; ++e) if (el[e] > v1) { v1 = el[e]; i1 = e; }
                int i2 = 0; float v2 = -3.4e38f;
#pragma unroll
                for (int e = 0; e < 4; ++e) if (e != i1 && el[e] > v2) { v2 = el[e]; i2 = e; }
                const float e2 = __expf(v2 - v1);
                const float g1 = pg / (1.f + e2), g2v = pg * e2 / (1.f + e2);
                const int ea = gs * 4 + i1, eb = gs * 4 + i2;
                const int sl = (wid * 4 + q) * 2;
                e_ent[sl] = ea; r_ent[sl] = atomicAdd(&lcnt[ea], 1u); t_ent[sl] = t * 2; g_ent[sl] = g1;
                e_ent[sl + 1] = eb; r_ent[sl + 1] = atomicAdd(&lcnt[eb], 1u); t_ent[sl + 1] = t * 2 + 1; g_ent[sl + 1] = g2v;
            }
        }
        __syncthreads();
        if (tid < 16) lbase[tid] = lcnt[tid] ? atomicAdd(&cnt[tid * 64], lcnt[tid]) : 0u;
        __syncthreads();
        if (tid < 32) {
            const int e = e_ent[tid];
            const unsigned pos = (lbase[e] + r_ent[tid]) & 16383u;
            list[e * 16384 + pos] = t_ent[tid]; gl[e * 16384 + pos] = g_ent[tid];
        }
    }
}

constexpr int GBK = 64;
struct TileP { int arow[4]; unsigned bo[4]; };
struct GOps { const char* A; unsigned la; const char* A2; unsigned la2; const char* B; };
DI void gemm_core(const GOps& o, const TileP& tp, int K, char* lds, f32x4 (&acc)[4][4], int ksplit, bool primed, const TileP& nx, bool have_nx) {
    const int tid = tidx(), wid = tid >> 6, lane = tid & 63, wr = wid >> 1, wc = wid & 1, fr = lane & 15, fq = lane >> 4;
    const unsigned scol = ((tid & 7) ^ ((tid >> 3) & 7)) * 16;
#pragma unroll
    for (int n = 0; n < 4; ++n)
#pragma unroll
        for (int m = 0; m < 4; ++m) acc[n][m] = (f32x4){0.f, 0.f, 0.f, 0.f};
    const int nk = K / GBK;
    if (!primed) {
        __syncthreads();
#pragma unroll
        for (int i = 0; i < 4; ++i) {
            __builtin_amdgcn_global_load_lds((const unsigned*)(o.A + (__umul24(tp.arow[i], o.la) + scol)), (lds_u32*)(lds + tid * 16 + i * 4096), 16, 0, 0);
            __builtin_amdgcn_global_load_lds((const unsigned*)(o.B + (tp.bo[i] + scol)), (lds_u32*)(lds + 16384 + tid * 16 + i * 4096), 16, 0, 0);
        }
    }
    const int sw = fr & 7;
    const unsigned aoff = (wr * 64 + fr) * 128, boff = (wc * 64 + fr) * 128, co0 = (fq ^ sw) * 16, co1 = ((4 + fq) ^ sw) * 16;
    bf16x8 a0[4], b0[4], a1[4], b1[4];
#define G_ISSUE(kt_)                                                                                                                        \
    if ((kt_) + 1 < nk) {                                                                                                                   \
        char* nb = lds + (((kt_) + 1) & 1) * 32768;                                                                                         \
        const unsigned ko = ((kt_) + 1) * (GBK * 2) + scol;                                                                                 \
        const bool hi = ((kt_) + 1) * GBK >= ksplit;                                                                                        \
        const char* Ab = hi ? o.A2 : o.A; const unsigned la = hi ? o.la2 : o.la;                                                            \
        _Pragma("unroll") for (int i = 0; i < 4; ++i) {                                                                                     \
            __builtin_amdgcn_global_load_lds((const unsigned*)(Ab + (__umul24(tp.arow[i], la) + ko)), (lds_u32*)(nb + tid * 16 + i * 4096), 16, 0, 0);   \
            __builtin_amdgcn_global_load_lds((const unsigned*)(o.B + (tp.bo[i] + ko)), (lds_u32*)(nb + 16384 + tid * 16 + i * 4096), 16, 0, 0);      \
        }                                                                                                                                   \
    } else if (have_nx) {        \
        _Pragma("unroll") for (int i = 0; i < 4; ++i) {                                                                                     \
            __builtin_amdgcn_global_load_lds((const unsigned*)(o.A + (__umul24(nx.arow[i], o.la) + scol)), (lds_u32*)(lds + tid * 16 + i * 4096), 16, 0, 0);          \
            __builtin_amdgcn_global_load_lds((const unsigned*)(o.B + (nx.bo[i] + scol)), (lds_u32*)(lds + 16384 + tid * 16 + i * 4096), 16, 0, 0);  \
        }                                                                                                                                   \
    }
#define G_READ(A_, B_, AD_)                                                                                                                 \
    asm volatile("ds_read_b128 %0, %8\n\tds_read_b128 %1, %8 offset:2048\n\tds_read_b128 %2, %8 offset:4096\n\tds_read_b128 %3, %8 offset:6144\n\t"       \
                 "ds_read_b128 %4, %9 offset:16384\n\tds_read_b128 %5, %9 offset:18432\n\tds_read_b128 %6, %9 offset:20480\n\tds_read_b128 %7, %9 offset:22528" \
                 : "=&v"(A_[0]), "=&v"(A_[1]), "=&v"(A_[2]), "=&v"(A_[3]), "=&v"(B_[0]), "=&v"(B_[1]), "=&v"(B_[2]), "=&v"(B_[3]) : "v"((AD_) + aoff), "v"((AD_) + boff) : "memory");
#define G_WAIT(A_, B_, N_)                                                                                                                  \
    asm volatile("s_waitcnt lgkmcnt(" #N_ ")" : "+v"(A_[0]), "+v"(A_[1]), "+v"(A_[2]), "+v"(A_[3]), "+v"(B_[0]), "+v"(B_[1]), "+v"(B_[2]), "+v"(B_[3]) :: "memory");
#define G_MMA(A_, B_)                                                                                                                       \
    _Pragma("unroll") for (int n = 0; n < 4; ++n)                                                                                           \
        _Pragma("unroll") for (int m = 0; m < 4; ++m) acc[n][m] = __builtin_amdgcn_mfma_f32_16x16x32_bf16(B_[n], A_[m], acc[n][m], 0, 0, 0);
    const unsigned lbase = (unsigned)(size_t)(lds_u32*)lds;
    __builtin_amdgcn_s_waitcnt(0x0070);
    __builtin_amdgcn_s_barrier();
    G_ISSUE(0)
    G_READ(a0, b0, lbase + co0)
    G_READ(a1, b1, lbase + co1)
    G_WAIT(a0, b0, 8)
    __builtin_amdgcn_sched_barrier(0);
    G_MMA(a0, b0)
    __builtin_amdgcn_sched_barrier(0);
    G_WAIT(a1, b1, 0)
#pragma unroll 1
    for (int kt = 1; kt < nk; ++kt) {
        __builtin_amdgcn_s_waitcnt(0x0070);
        __builtin_amdgcn_s_barrier();
        G_ISSUE(kt)
        const unsigned S = lbase + (kt & 1) * 32768;
        G_READ(a0, b0, S + co0)
        __builtin_amdgcn_sched_barrier(0);
        G_MMA(a1, b1)
        __builtin_amdgcn_sched_barrier(0);
        G_READ(a1, b1, S + co1)
        G_WAIT(a0, b0, 8)
        __builtin_amdgcn_sched_barrier(0);
        G_MMA(a0, b0)
        __builtin_amdgcn_sched_barrier(0);
        G_WAIT(a1, b1, 0)
    }
    G_MMA(a1, b1)
#undef G_ISSUE
#undef G_READ
#undef G_WAIT
#undef G_MMA
}

enum { EPI_EVEN_IN = 0, EPI_ODD_IN, EPI_RESID };
template <int EPI>
DI void phase_gemm(const P& p, const bf16_t* A, int lda, const bf16_t* Bt, int K, int ntn, char* lds, bool dry = false, const bf16_t* A2 = nullptr, int lda2 = 0, int ksplit = 1 << 30) {
    const int tid = tidx(), wid = tid >> 6, lane = tid & 63, wr = wid >> 1, wc = wid & 1, fr = lane & 15, fq = lane >> 4;
    const int ntm = T / 128, ntiles = ntm * ntn;
    auto fill = [&](TileP& t, int tile) {
        const int tn = tile / ntm, tm = tile % ntm, r = tid >> 3;
#pragma unroll
        for (int i = 0; i < 4; ++i) { t.arow[i] = tm * 128 + r + 32 * i; t.bo[i] = (unsigned)(tn * 128 + r + 32 * i) * (unsigned)(K * 2); }
    };
    const GOps gop{(const char*)A, (unsigned)lda * 2u, (const char*)(A2 ? A2 : A), (unsigned)(A2 ? lda2 : lda) * 2u, (const char*)Bt};
    TileP cur, nxt;
    bool primed = false;
    fill(cur, bidx() < ntiles ? bidx() : 0); nxt = cur;
    for (int tile = bidx(); tile < ntiles; tile += gridDim.x) {
        const int tn = tile / ntm, tm = tile % ntm;
        const bool have_next = tile + (int)gridDim.x < ntiles;
        if (have_next) fill(nxt, tile + gridDim.x);
        f32x4 acc[4][4];
        gemm_core(gop, cur, K, lds, acc, ksplit, primed, nxt, have_next);
        primed = have_next; cur = nxt;
        const int m0 = tm * 128 + wr * 64, n0 = tn * 128 + wc * 64;
        if (EPI == EPI_EVEN_IN) {
            bf16_t* C = (bf16_t*)(p.ws + WS_PROJ);
#pragma unroll
            for (int m = 0; m < 4; ++m)
#pragma unroll
                for (int n = 0; n < 4; ++n) {
                    const int row = m0 + m * 16 + fr, col = n0 + n * 16 + fq * 4;
                    if (col < EVC) { u32x2 w; w.x = pack2(acc[n][m][0], acc[n][m][1]); w.y = pack2(acc[n][m][2], acc[n][m][3]); *(u32x2*)(C + (size_t)row * EVLD + col) = w; }
                }
        } else if (EPI == EPI_ODD_IN) {
            bf16_t* C = (bf16_t*)(p.ws + WS_QK);
            const float2* tab = (const float2*)(p.ws + WS_ROPE);
            if (n0 < 3072) {
#pragma unroll
                for (int m = 0; m < 4; ++m) {
                    const int row = m0 + m * 16 + fr;
#pragma unroll
                    for (int n = 0; n < 2; ++n) {
                        float lo[4], hi[4];
#pragma unroll
                        for (int j = 0; j < 4; ++j) {
                            const float2 cs = tab[(size_t)row * 32 + n * 16 + fq * 4 + j];
                            const float x1 = acc[n][m][j], x2 = acc[n + 2][m][j];
                            lo[j] = x1 * cs.x - x2 * cs.y; hi[j] = x2 * cs.x + x1 * cs.y;
                        }
                        u32x2 w; w.x = pack2(lo[0], lo[1]); w.y = pack2(lo[2], lo[3]);
                        *(u32x2*)(C + (size_t)row * 3072 + n0 + n * 16 + fq * 4) = w;
                        w.x = pack2(hi[0], hi[1]); w.y = pack2(hi[2], hi[3]);
                        *(u32x2*)(C + (size_t)row * 3072 + n0 + (n + 2) * 16 + fq * 4) = w;
                    }
                }
            }
            if (tn * 128 >= 3072) {
                bf16_t* VT = (bf16_t*)(p.ws + WS_VT);
                const int hg0 = (tn * 128 - 3072) >> 6, g = hg0 >> 3, lg2 = g * 2, dil = 1 << lg2, L = SEQ >> lg2, run = 128 >> lg2;
                __syncthreads();
#pragma unroll
                for (int m = 0; m < 4; ++m)
#pragma unroll
                    for (int n = 0; n < 4; ++n)
#pragma unroll
                        for (int j = 0; j < 4; ++j)
                            *(bf16_t*)(lds + 32768 + (wc * 64 + n * 16 + fq * 4 + j) * 272 + (wr * 64 + m * 16 + fr) * 2) = f2bf(acc[n][m][j]);
                __syncthreads();
                const int bb = (tm * 128) >> 12, s0 = (tm * 128) & (SEQ - 1);
#pragma unroll
                for (int q = 0; q < 8; ++q) {
                    const int item = tid + q * 256, dim = item >> 4, o0 = (item & 15) * 8;
                    const int rr = o0 / run, i0 = o0 % run;
                    const char* src = lds + 32768 + dim * 272 + (rr + dil * i0) * 2;
                    float e8[8];
#pragma unroll
                    for (int e = 0; e < 8; ++e) e8[e] = bf2f(*(const bf16_t*)(src + e * dil * 2));
                    u32x4 w; w.x = pack2(e8[0], e8[1]); w.y = pack2(e8[2], e8[3]); w.z = pack2(e8[4], e8[5]); w.w = pack2(e8[6], e8[7]);
                    const int hg = hg0 + (dim >> 6);
                    *(u32x4*)(VT + ((size_t)((bb * 24 + hg) * dil + rr) * 64 + (dim & 63)) * L + (s0 >> lg2) + i0) = w;
                }
            }
        } else {
            float* ssq = (float*)(p.ws + WS_SSQ) + (size_t)(tn * 2 + wc) * T;
#pragma unroll
            for (int m = 0; m < 4; ++m) {
                float ss = 0.f;
#pragma unroll
                for (int n = 0; n < 4; ++n) {
                    const size_t qo = (size_t)(m0 + m * 16 + fr) * 1024 + n0 + n * 16 + fq * 4;
                    bf16_t* q = dry ? (bf16_t*)(p.ws + WS_DUMMY) + (qo & 0x7FFFF) : (bf16_t*)(p.ws + WS_XB) + qo;
                    const u32x2 xx = *(const u32x2*)q;
                    float4 v;
                    v.x = __uint_as_float(xx.x << 16) + acc[n][m][0]; v.y = __uint_as_float(xx.x & 0xffff0000u) + acc[n][m][1]; v.z = __uint_as_float(xx.y << 16) + acc[n][m][2]; v.w = __uint_as_float(xx.y & 0xffff0000u) + acc[n][m][3];
                    u32x2 w; w.x = pack2(v.x, v.y); w.y = pack2(v.z, v.w);
                    *(u32x2*)q = w;
                    ss += v.x * v.x + v.y * v.y + v.z * v.z + v.w * v.w;
                }
                ss += __shfl_xor(ss, 16); ss += __shfl_xor(ss, 32);
                if (fq == 0 && !dry) ssq[m0 + m * 16 + fr] = ss;
            }
        }
    }
}

DI void phase_moe_up(const P& p, int layer, char* lds) {
    const int tid = tidx(), wid = tid >> 6, lane = tid & 63, wr = wid >> 1, wc = wid & 1, fr = lane & 15, fq = lane >> 4;
    const unsigned* cntb = (const unsigned*)(p.ws + WS_CTL + CTL_CNT) + layer * 16 * 64;
    unsigned cnt[16];
#pragma unroll
    for (int e = 0; e < 16; ++e) cnt[e] = cntb[e * 64];
    const int* list = (const int*)(p.ws + WS_LIST);
    const float* gl = (const float*)(p.ws + WS_GATE);
    const bf16_t* hn = (const bf16_t*)p.out;
    const bf16_t* W13 = (const bf16_t*)(p.ws + WS_W + W_13);
    bf16_t* H = (bf16_t*)(p.ws + WS_H);
    int ttot = 0;
#pragma unroll
    for (int e = 0; e < 16; ++e) ttot += ((int)cnt[e] + 127) >> 7;
    const int ntiles = ttot * 4;
    auto locate = [&](int tile, int& e, int& lt, int& ce, int& rbe, int& tn) {
        const int mt = tile >> 2; tn = tile & 3;
        int tbe = 0, acc_t = 0; e = 0;
#pragma unroll
        for (int q = 0; q < 16; ++q) { const int nt = ((int)cnt[q] + 127) >> 7; if (mt >= acc_t) { e = q; tbe = acc_t; } acc_t += nt; }
        lt = mt - tbe; ce = (int)cnt[e]; rbe = tbe * 128;
    };
    auto fill = [&](TileP& t, int tile) {
        int e, lt, ce, rbe, tn; locate(tile, e, lt, ce, rbe, tn);
        const int r = tid >> 3;
#pragma unroll
        for (int i = 0; i < 4; ++i) {
            const int ii = lt * 128 + r + 32 * i;
            const int tk = ii < ce ? (list[e * 16384 + ii] >> 1) : 0;
            t.arow[i] = tk;
            t.bo[i] = (unsigned)(e * 512 + tn * 128 + r + 32 * i) * 2048u;
        }
    };
    const GOps gop{(const char*)hn, 2048u, (const char*)hn, 2048u, (const char*)W13};
    TileP cur, nxt;
    bool primed = false;
    fill(cur, bidx() < ntiles ? bidx() : 0); nxt = cur;
    for (int tile = bidx(); tile < ntiles; tile += gridDim.x) {
        int e, lt, ce, rbe, tn; locate(tile, e, lt, ce, rbe, tn);
        const bool have_next = tile + (int)gridDim.x < ntiles;
        if (have_next) fill(nxt, tile + gridDim.x);
        f32x4 acc[4][4];
        gemm_core(gop, cur, 1024, lds, acc, 1 << 30, primed, nxt, have_next);
        primed = have_next; cur = nxt;
#pragma unroll
        for (int m = 0; m < 4; ++m) {
            const int li = lt * 128 + wr * 64 + m * 16 + fr;
            if (li < ce) {
                const float g = gl[e * 16384 + li];
                bf16_t* hrow = H + (size_t)(rbe + li) * 256;
#pragma unroll
                for (int n = 0; n < 4; n += 2) {
                    float o[4];
#pragma unroll
                    for (int j = 0; j < 4; ++j) o[j] = siluf_(acc[n][m][j]) * acc[n + 1][m][j] * g;
                    const int f = tn * 64 + wc * 32 + (n >> 1) * 16 + fq * 4;
                    u32x2 w; w.x = pack2(o[0], o[1]); w.y = pack2(o[2], o[3]);
                    *(u32x2*)(hrow + f) = w;
                }
            }
        }
    }
}
DI void phase_moe_down(const P& p, int layer, char* lds) {
    const int tid = tidx(), wid = tid >> 6, lane = tid & 63, wr = wid >> 1, wc = wid & 1, fr = lane & 15, fq = lane >> 4;
    const unsigned* cntb = (const unsigned*)(p.ws + WS_CTL + CTL_CNT) + layer * 16 * 64;
    unsigned cnt[16];
#pragma unroll
    for (int e = 0; e < 16; ++e) cnt[e] = cntb[e * 64];
    const int* list = (const int*)(p.ws + WS_LIST);
    const bf16_t* W2 = (const bf16_t*)(p.ws + WS_W + W_2);
    const bf16_t* H = (const bf16_t*)(p.ws + WS_H);
    bf16_t* ys = (bf16_t*)(p.ws + WS_YS);
    int ttot = 0;
#pragma unroll
    for (int e = 0; e < 16; ++e) ttot += ((int)cnt[e] + 127) >> 7;
    const int ntiles = ttot * 8;
    auto locate = [&](int tile, int& e, int& lt, int& ce, int& rbe, int& tn) {
        const int mt = tile >> 3; tn = tile & 7;
        int tbe = 0, acc_t = 0; e = 0;
#pragma unroll
        for (int q = 0; q < 16; ++q) { const int nt = ((int)cnt[q] + 127) >> 7; if (mt >= acc_t) { e = q; tbe = acc_t; } acc_t += nt; }
        lt = mt - tbe; ce = (int)cnt[e]; rbe = tbe * 128;
    };
    auto fill = [&](TileP& t, int tile) {
        int e, lt, ce, rbe, tn; locate(tile, e, lt, ce, rbe, tn);
        const int r = tid >> 3;
#pragma unroll
        for (int i = 0; i < 4; ++i) { t.arow[i] = rbe + lt * 128 + r + 32 * i; t.bo[i] = (unsigned)(e * 1024 + tn * 128 + r + 32 * i) * 512u; }
    };
    const GOps gop{(const char*)H, 512u, (const char*)H, 512u, (const char*)W2};
    TileP cur, nxt;
    bool primed = false;
    fill(cur, bidx() < ntiles ? bidx() : 0); nxt = cur;
    for (int tile = bidx(); tile < ntiles; tile += gridDim.x) {
        int e, lt, ce, rbe, tn; locate(tile, e, lt, ce, rbe, tn);
        const bool have_next = tile + (int)gridDim.x < ntiles;
        if (have_next) fill(nxt, tile + gridDim.x);
        f32x4 acc[4][4];
        gemm_core(gop, cur, 256, lds, acc, 1 << 30, primed, nxt, have_next);
        primed = have_next; cur = nxt;
#pragma unroll
        for (int m = 0; m < 4; ++m) {
            const int li = lt * 128 + wr * 64 + m * 16 + fr;
            if (li < ce) {
                const int ts = list[e * 16384 + li];
                bf16_t* yrow = ys + ((size_t)(ts & 1) * T + (ts >> 1)) * 1024 + tn * 128 + wc * 64 + fq * 4;
#pragma unroll
                for (int n = 0; n < 4; ++n) { u32x2 w; w.x = pack2(acc[n][m][0], acc[n][m][1]); w.y = pack2(acc[n][m][2], acc[n][m][3]); *(u32x2*)(yrow + n * 16) = w; }
            }
        }
    }
}


typedef float f32x16 __attribute__((ext_vector_type(16)));
DI f32x4 mfma16(bf16x8 a, bf16x8 b, f32x4 c) { return __builtin_amdgcn_mfma_f32_16x16x32_bf16(a, b, c, 0, 0, 0); }
DI f32x16 mfma32(bf16x8 a, bf16x8 b, f32x16 c) { return __builtin_amdgcn_mfma_f32_32x32x16_bf16(a, b, c, 0, 0, 0); }
DI f32x4 tile16(const char* X, int ldx, int row0, const char* Y, int ldy, int col0, int K) {
    const int lane = tidx() & 63, fr = lane & 15, fq = lane >> 4;
    f32x4 acc = {0.f, 0.f, 0.f, 0.f};
#pragma unroll
    for (int k = 0; k < K; k += 32) {
        const bf16x8 a = *(const bf16x8*)(X + (row0 + fr) * ldx + (k + fq * 8) * 2);
        const bf16x8 b = *(const bf16x8*)(Y + (col0 + fr) * ldy + (k + fq * 8) * 2);
        acc = mfma16(a, b, acc);
    }
    return acc;
}
DI bf16x8 pack_step(const f32x16& x, int s) {
    u32x4 r;
    r.x = pack2(x[8 * s + 0], x[8 * s + 1]); r.y = pack2(x[8 * s + 2], x[8 * s + 3]);
    r.z = pack2(x[8 * s + 4], x[8 * s + 5]); r.w = pack2(x[8 * s + 6], x[8 * s + 7]);
    return __builtin_bit_cast(bf16x8, r);
}

constexpr int GP_LF = 0, GP_T = 17408, GP_VEC = GP_T + 9216, GP_U = GP_VEC + 1024, GP_END = GP_U + 36864;
DI void gdn_prep_unit(const P& p, int li, int ch, char* lds) {
    const int tid = tidx(), lane = tid & 63, wid = tid >> 6, fr = lane & 15, fq = lane >> 4;
    const int h = ch & 3, n = (ch >> 2) & 63, b = ch >> 8;
    const int t0 = b * SEQ + n * 64;
    float* Lf = (float*)(lds + GP_LF);
    char* Trow = lds + GP_T;
    float* gcs = (float*)(lds + GP_VEC); float* egc = gcs + 64; float* bet = gcs + 128; float* ekd = gcs + 192;
    char* Qrow = lds + GP_U; char* Krow = Qrow + 17408; char* VbT = lds + GP_U; char* KbgT = VbT + 18432;
    const bf16_t* proj = (const bf16_t*)(p.ws + WS_PROJ);
    unsigned char* ops = p.ws + WS_GOPS + (size_t)ch * GOPS_CH;
    const float* cw = p.in[I_CONVW] + (size_t)li * 4 * 1536;
    const int c = tid >> 2, cq = tid & 3;
    __syncthreads();
    float* cwl = (float*)(lds + GP_END);
    for (int i = tid; i < 4 * 3 * 32; i += 256) {
        const int j = i / 96, r = i % 96, sl = r >> 5, q4 = (r & 31) * 4;
        *(f32x4*)(cwl + (j * 3 + sl) * 128 + q4) = *(const f32x4*)(cw + j * 1536 + sl * 512 + h * 128 + q4);
    }
    __syncthreads();
    unsigned vvp[16];
#pragma unroll 1
    for (int which = 0; which < 3; ++which) {
        const int col0 = which * 512 + h * 128 + cq * 32;
        u32x4 xin[4][4];
#pragma unroll
        for (int j = 0; j < 4; ++j) {
            const int sp = n * 64 + c - 3 + j;
            const bf16_t* src = proj + (size_t)(b * SEQ + (sp < 0 ? 0 : sp)) * EVLD + col0;
#pragma unroll
            for (int i4 = 0; i4 < 4; ++i4) xin[j][i4] = *(const u32x4*)(src + i4 * 8);
        }
        float acc[32];
#pragma unroll
        for (int i = 0; i < 32; ++i) acc[i] = 0.f;
#pragma unroll
        for (int j = 0; j < 4; ++j) {
            const float ok = (n * 64 + c - 3 + j) >= 0 ? 1.f : 0.f;
            const float* wj = cwl + (j * 3 + which) * 128 + cq * 32;
#pragma unroll
            for (int i4 = 0; i4 < 4; ++i4) {
                const f32x4 wa = *(const f32x4*)(wj + i4 * 8), wb = *(const f32x4*)(wj + i4 * 8 + 4);
                const u32x4 w = xin[j][i4];
                acc[i4 * 8 + 0] += ok * wa[0] * __uint_as_float(w[0] << 16); acc[i4 * 8 + 1] += ok * wa[1] * __uint_as_float(w[0] & 0xffff0000u);
                acc[i4 * 8 + 2] += ok * wa[2] * __uint_as_float(w[1] << 16); acc[i4 * 8 + 3] += ok * wa[3] * __uint_as_float(w[1] & 0xffff0000u);
                acc[i4 * 8 + 4] += ok * wb[0] * __uint_as_float(w[2] << 16); acc[i4 * 8 + 5] += ok * wb[1] * __uint_as_float(w[2] & 0xffff0000u);
                acc[i4 * 8 + 6] += ok * wb[2] * __uint_as_float(w[3] << 16); acc[i4 * 8 + 7] += ok * wb[3] * __uint_as_float(w[3] & 0xffff0000u);
            }
        }
        float ss = 0.f;
#pragma unroll
        for (int i = 0; i < 32; ++i) { acc[i] = siluf_(acc[i]); ss += acc[i] * acc[i]; }
        ss += __shfl_xor(ss, 1); ss += __shfl_xor(ss, 2);
        const float rn = which == 2 ? 1.f : rsqrtf(ss + 1e-6f) * (which == 0 ? 0.08838834764831845f : 1.f);
        unsigned pk[16];
#pragma unroll
        for (int i = 0; i < 16; ++i) pk[i] = pack2(acc[2 * i] * rn, acc[2 * i + 1] * rn);
        if (which < 2) {
            char* img = which == 0 ? Qrow : Krow;
#pragma unroll
            for (int i4 = 0; i4 < 4; ++i4) { u32x4 w; w.x = pk[i4 * 4]; w.y = pk[i4 * 4 + 1]; w.z = pk[i4 * 4 + 2]; w.w = pk[i4 * 4 + 3]; *(u32x4*)(img + c * 272 + (cq * 32 + i4 * 8) * 2) = w; }
        } else {
#pragma unroll
            for (int i = 0; i < 16; ++i) vvp[i] = pk[i];
        }
    }
    if (cq == 0) {
        const float a = bf2f(proj[(size_t)(t0 + c) * EVLD + 2048 + h]);
        const float bb = bf2f(proj[(size_t)(t0 + c) * EVLD + 2052 + h]);
        const float Aexp = __expf(p.in[I_ALOG][li * 4 + h]), dtb = p.in[I_DTB][li * 4 + h];
        gcs[c] = -Aexp * softplusf_(a + dtb);
        bet[c] = sigmoidf_(bb);
    }
    __syncthreads();
    if (wid == 0) {
        float x = gcs[lane];
#pragma unroll
        for (int o = 1; o < 64; o <<= 1) { const float y = __shfl_up(x, o); if (lane >= o) x += y; }
        const float gl = __shfl(x, 63);
        gcs[lane] = x; egc[lane] = __expf(x); ekd[lane] = __expf(gl - x);
        if (lane == 63) ((float*)(p.ws + WS_CTL + CTL_EGL))[ch] = __expf(gl);
    }
    __syncthreads();
    {
        const int ti = wid;
#pragma unroll
        for (int tj = 0; tj < 4; ++tj) {
            if (tj <= ti) {
                const f32x4 kk = tile16(Krow, 272, 16 * ti, Krow, 272, 16 * tj, 128);
                const int c2 = 16 * tj + fr;
                f32x4 lv;
#pragma unroll
                for (int r = 0; r < 4; ++r) {
                    const int c1 = 16 * ti + fq * 4 + r;
                    lv[r] = (c1 > c2) ? bet[c1] * kk[r] * __expf(gcs[c1] - gcs[c2]) : 0.f;
                }
                *(f32x4*)&Lf[c2 * 68 + 16 * ti + fq * 4] = lv;
            }
            f32x4 qk = {0.f, 0.f, 0.f, 0.f};
            if (tj <= ti) qk = tile16(Krow, 272, 16 * tj, Qrow, 272, 16 * ti, 128);
            const int c1 = 16 * ti + fr;
            float o4[4];
#pragma unroll
            for (int r = 0; r < 4; ++r) { const int c2 = 16 * tj + fq * 4 + r; o4[r] = (c1 >= c2) ? qk[r] * __expf(gcs[c1] - gcs[c2]) : 0.f; }
            const int mt = c1 >> 5, rr = c1 & 31, hh = fq & 1, jg = fq >> 1;
            u32x2 w; w.x = pack2(o4[0], o4[1]); w.y = pack2(o4[2], o4[3]);
            *(u32x2*)(ops + GO_AF + ((size_t)((mt * 4 + tj) * 64 + hh * 32 + rr) * 8 + jg * 4) * 2) = w;
        }
#pragma unroll
        for (int i = 0; i < 4; ++i) {
            const int idx = tid + i * 256;
            {
                const int mt = idx >> 9, ks = (idx >> 6) & 7, l2 = idx & 63, rr = l2 & 31, hh = l2 >> 5, cc = 32 * mt + rr;
                const float sc = egc[cc];
                const u32x2 lo = *(const u32x2*)(Qrow + cc * 272 + (16 * ks + 4 * hh) * 2), hi = *(const u32x2*)(Qrow + cc * 272 + (16 * ks + 8 + 4 * hh) * 2);
                u32x4 w;
                w.x = pack2(__uint_as_float(lo.x << 16) * sc, __uint_as_float(lo.x & 0xffff0000u) * sc); w.y = pack2(__uint_as_float(lo.y << 16) * sc, __uint_as_float(lo.y & 0xffff0000u) * sc);
                w.z = pack2(__uint_as_float(hi.x << 16) * sc, __uint_as_float(hi.x & 0xffff0000u) * sc); w.w = pack2(__uint_as_float(hi.y << 16) * sc, __uint_as_float(hi.y & 0xffff0000u) * sc);
                *(u32x4*)(ops + GO_QF + (size_t)idx * 16) = w;
            }
            {
                const int mt = idx >> 8, ks = (idx >> 6) & 3, l2 = idx & 63, rr = l2 & 31, hh = l2 >> 5, dk = 32 * mt + rr;
                float e8[8];
#pragma unroll
                for (int j = 0; j < 8; ++j) { const int c2 = 16 * ks + 8 * (j >> 2) + 4 * hh + (j & 3); e8[j] = bf2f(*(const bf16_t*)(Krow + c2 * 272 + dk * 2)) * ekd[c2]; }
                u32x4 w; w.x = pack2(e8[0], e8[1]); w.y = pack2(e8[2], e8[3]); w.z = pack2(e8[4], e8[5]); w.w = pack2(e8[6], e8[7]);
                *(u32x4*)(ops + GO_KF + (size_t)idx * 16) = w;
            }
        }
    }
    __syncthreads();
    {
        const float bc = bet[c], bg = bc * egc[c];
        unsigned kvp[16];
#pragma unroll
        for (int i4 = 0; i4 < 4; ++i4) { const u32x4 w = *(const u32x4*)(Krow + c * 272 + (cq * 32 + i4 * 8) * 2); kvp[i4 * 4] = w.x; kvp[i4 * 4 + 1] = w.y; kvp[i4 * 4 + 2] = w.z; kvp[i4 * 4 + 3] = w.w; }
        __syncthreads();
#pragma unroll
        for (int i = 0; i < 16; ++i) {
            *(bf16_t*)(VbT + (cq * 32 + 2 * i) * 144 + c * 2) = f2bf(__uint_as_float(vvp[i] << 16) * bc);
            *(bf16_t*)(VbT + (cq * 32 + 2 * i + 1) * 144 + c * 2) = f2bf(__uint_as_float(vvp[i] & 0xffff0000u) * bc);
            *(bf16_t*)(KbgT + (cq * 32 + 2 * i) * 144 + c * 2) = f2bf(__uint_as_float(kvp[i] << 16) * bg);
            *(bf16_t*)(KbgT + (cq * 32 + 2 * i + 1) * 144 + c * 2) = f2bf(__uint_as_float(kvp[i] & 0xffff0000u) * bg);
        }
    }
    {
        char* L21i = lds + GP_END;
        char* T11T = L21i + 2560;
        char* MT = T11T + 2560;
        if (wid < 2) {
            const int o = 32 * wid;
            float Tc[32];
#pragma unroll
            for (int i = 0; i < 32; ++i) Tc[i] = (i == (lane & 31)) ? 1.f : 0.f;
#pragma unroll
            for (int j = 0; j < 31; ++j) {
                const float tj = Tc[j];
#pragma unroll
                for (int i4 = (j + 1) >> 2; i4 < 8; ++i4) {
                    const f32x4 l4 = *(const f32x4*)&Lf[(o + j) * 68 + o + i4 * 4];
#pragma unroll
                    for (int e = 0; e < 4; ++e) if (i4 * 4 + e > j) Tc[i4 * 4 + e] -= l4[e] * tj;
                }
            }
            if (lane < 32) {
#pragma unroll
                for (int i = 0; i < 32; ++i) *(bf16_t*)(Trow + (o + i) * 144 + (o + lane) * 2) = f2bf(Tc[i]);
                if (wid == 0) {
#pragma unroll
                    for (int i = 0; i < 32; ++i) *(bf16_t*)(Trow + i * 144 + (32 + lane) * 2) = 0;
#pragma unroll
                    for (int i4 = 0; i4 < 8; ++i4) { u32x2 w; w.x = pack2(Tc[i4 * 4], Tc[i4 * 4 + 1]); w.y = pack2(Tc[i4 * 4 + 2], Tc[i4 * 4 + 3]); *(u32x2*)(T11T + lane * 80 + i4 * 8) = w; }
                }
            }
        } else {
            const int t2 = tid - 128;
#pragma unroll
            for (int g2 = 0; g2 < 2; ++g2) {
                const int i = t2 & 31, k4 = ((t2 >> 5) + 4 * g2) * 4;
                u32x2 w;
                w.x = pack2(Lf[(k4 + 0) * 68 + 32 + i], Lf[(k4 + 1) * 68 + 32 + i]); w.y = pack2(Lf[(k4 + 2) * 68 + 32 + i], Lf[(k4 + 3) * 68 + 32 + i]);
                *(u32x2*)(L21i + i * 80 + k4 * 2) = w;
            }
        }
        __syncthreads();
        {
            const int r0 = 16 * (wid >> 1), c0 = 16 * (wid & 1);
            const f32x4 mm = tile16(L21i, 80, r0, T11T, 80, c0, 32);
            u32x2 w; w.x = pack2(mm[0], mm[1]); w.y = pack2(mm[2], mm[3]);
            *(u32x2*)(MT + (c0 + fr) * 80 + (r0 + 4 * fq) * 2) = w;
        }
        __syncthreads();
        {
            const int r0 = 16 * (wid >> 1), c0 = 16 * (wid & 1);
            const f32x4 tt = tile16(MT, 80, c0, Trow + 32 * 144 + 64, 144, r0, 32);
            u32x2 w; w.x = pack2(-tt[0], -tt[1]); w.y = pack2(-tt[2], -tt[3]);
            *(u32x2*)(Trow + (32 + r0 + fr) * 144 + (c0 + 4 * fq) * 2) = w;
        }
    }
    __syncthreads();
#pragma unroll
    for (int tq = 0; tq < 2; ++tq) {
        const int tj = wid * 2 + tq;
#pragma unroll
        for (int ti = 0; ti < 4; ++ti) {
            const f32x4 u = tile16(Trow, 144, 16 * ti, VbT, 144, 16 * tj, 64);
            {
                const int dv = 16 * tj + fr, slice = dv >> 5, rr = dv & 31, cb = 16 * ti + fq * 4, mt = cb >> 5, q4 = (cb & 31) >> 2, hh = q4 & 1, rg = q4 >> 1;
                u32x2 w; w.x = pack2(u[0], u[1]); w.y = pack2(u[2], u[3]);
                *(u32x2*)(ops + GO_UF + ((size_t)((slice * 2 + mt) * 64 + hh * 32 + rr) * 16 + rg * 4) * 2) = w;
            }
            const f32x4 wv = tile16(KbgT, 144, 16 * tj, Trow, 144, 16 * ti, 64);
            {
                const int c1 = 16 * ti + fr, mt = c1 >> 5, rr = c1 & 31, hh = fq & 1, jg = fq >> 1;
                u32x2 w; w.x = pack2(-wv[0], -wv[1]); w.y = pack2(-wv[2], -wv[3]);
                *(u32x2*)(ops + GO_WF + ((size_t)((mt * 8 + tj) * 64 + hh * 32 + rr) * 8 + jg * 4) * 2) = w;
            }
        }
    }
}

DI void glds16(const void* g, char* l) { __builtin_amdgcn_global_load_lds((const unsigned*)g, (lds_u32*)l, 16, 0, 0); }
#define GS_WAIT(n) asm volatile("s_waitcnt vmcnt(" #n ")" ::: "memory")
DI void gdn_scan_block(const P& p, int bh, char* lds, bool dry = false) {
    const int tid = tidx(), lane = tid & 63, w = tid >> 6;
    const int h = bh & 3, b = bh >> 2;
    const float eglv = ((const float*)(p.ws + WS_CTL + CTL_EGL))[(b * 64 + lane) * 4 + h];
    unsigned char* gbase = p.ws + WS_GOPS + (size_t)(b * 256 + h) * GOPS_CH;
    auto issue = [&](int n, int k0, int cntk) {
        for (int k = k0; k < k0 + cntk; ++k) {
            const unsigned char* src = gbase + (size_t)n * 4 * GOPS_CH + k * 8192 + tid * 16;
            char* dst = lds + k * 8192 + tid * 16;
            glds16(src, dst); glds16(src + 4096, dst + 4096);
        }
    };
    f32x16 S[4];
#pragma unroll
    for (int i = 0; i < 4; ++i)
#pragma unroll
        for (int r = 0; r < 16; ++r) S[i][r] = 0.f;
    __syncthreads();
    issue(0, 0, 7);
#pragma unroll 1
    for (int n = 0; n < 64; ++n) {
        const float egl = __shfl(eglv, n);
        bf16x8 Sb[8];
#pragma unroll
        for (int i = 0; i < 4; ++i) { Sb[i * 2] = pack_step(S[i], 0); Sb[i * 2 + 1] = pack_step(S[i], 1); }
        f32x16 av[2], ao[2];
        const bf16x8* fr0 = (const bf16x8*)lds + lane;
        GS_WAIT(6);
        __builtin_amdgcn_s_barrier();
        issue(n, 7, 2);
        __builtin_amdgcn_sched_barrier(0);
        {
            const char* sl = lds + (w >> 1) * 8192;
#pragma unroll
            for (int mt = 0; mt < 2; ++mt) {
                const u32x4* up = (const u32x4*)(sl + ((w & 1) * 2 + mt) * 2048 + lane * 32);
                const u32x4 u0 = up[0], u1 = up[1];
#pragma unroll
                for (int e = 0; e < 4; ++e) {
                    av[mt][e * 2] = __uint_as_float(u0[e] << 16); av[mt][e * 2 + 1] = __uint_as_float(u0[e] & 0xffff0000u);
                    av[mt][8 + e * 2] = __uint_as_float(u1[e] << 16); av[mt][8 + e * 2 + 1] = __uint_as_float(u1[e] & 0xffff0000u);
                }
            }
        }
#pragma unroll
        for (int ks = 0; ks < 8; ++ks)
#pragma unroll
            for (int mt = 0; mt < 2; ++mt) av[mt] = mfma32(fr0[(2 + mt) * 512 + ks * 64], Sb[ks], av[mt]);
        bf16x8 Vb[4];
#pragma unroll
        for (int mt = 0; mt < 2; ++mt) { Vb[mt * 2] = pack_step(av[mt], 0); Vb[mt * 2 + 1] = pack_step(av[mt], 1); }
        GS_WAIT(4);
        __builtin_amdgcn_s_barrier();
        if (n < 63) issue(n + 1, 0, 4);
        __builtin_amdgcn_sched_barrier(0);
#pragma unroll
        for (int mt = 0; mt < 2; ++mt)
#pragma unroll
            for (int r = 0; r < 16; ++r) ao[mt][r] = 0.f;
#pragma unroll
        for (int ks = 0; ks < 8; ++ks) {
#pragma unroll
            for (int mt = 0; mt < 2; ++mt) ao[mt] = mfma32(fr0[(4 + mt) * 512 + ks * 64], Sb[ks], ao[mt]);
#pragma unroll
            for (int r = 0; r < 8; ++r) S[ks >> 1][(ks & 1) * 8 + r] *= egl;
        }
#pragma unroll
        for (int ks = 0; ks < 4; ++ks) { if (ks < 2) ao[0] = mfma32(fr0[6 * 512 + ks * 64], Vb[ks], ao[0]); ao[1] = mfma32(fr0[6 * 512 + (4 + ks) * 64], Vb[ks], ao[1]); }
        if (n < 63) GS_WAIT(8); else GS_WAIT(0);
        __builtin_amdgcn_s_barrier();
        if (n < 63) issue(n + 1, 4, 3);
        __builtin_amdgcn_sched_barrier(0);
#pragma unroll
        for (int ks = 0; ks < 4; ++ks)
#pragma unroll
            for (int i = 0; i < 4; ++i) S[i] = mfma32(fr0[(7 + (i >> 1)) * 512 + ((i & 1) * 4 + ks) * 64], Vb[ks], S[i]);
        {
            u32x4* Of = (u32x4*)((dry ? p.ws + WS_DUMMY + (size_t)(bh & 15) * 65536 : gbase + (size_t)n * 4 * GOPS_CH) + GO_UF) + (size_t)(w * 2 * 64 + lane) * 2;
#pragma unroll
            for (int mt = 0; mt < 2; ++mt) {
                u32x4 o0, o1;
#pragma unroll
                for (int e = 0; e < 4; ++e) { o0[e] = pack2(ao[mt][e * 2], ao[mt][e * 2 + 1]); o1[e] = pack2(ao[mt][8 + e * 2], ao[mt][8 + e * 2 + 1]); }
                Of[mt * 128] = o0; Of[mt * 128 + 1] = o1;
            }
        }
    }
    __syncthreads();
}

DI void gdn_post_unit(const P& p, int li, int ch) {
    const int tid = tidx();
    const int h = ch & 3, n = (ch >> 2) & 63, b = ch >> 8;
    const int t0 = b * SEQ + n * 64;
    const int c = tid >> 2, cq = tid & 3;
    const bf16_t* Of = (const bf16_t*)(p.ws + WS_GOPS + (size_t)ch * GOPS_CH + GO_UF);
    const bf16_t* proj = (const bf16_t*)(p.ws + WS_PROJ);
    bf16_t* mix = (bf16_t*)(p.ws + WS_PROJ);
    const float* nw = p.in[I_GDNNORM] + li * 128 + cq * 32;
    const int mt = c >> 5, q4 = (c & 31) >> 2, hh = q4 & 1, rg = q4 >> 1, reg = rg * 4 + (c & 3);
    float o[32]; float ss = 0.f;
#pragma unroll
    for (int r = 0; r < 32; ++r) { o[r] = bf2f(Of[(size_t)((cq * 2 + mt) * 64 + hh * 32 + r) * 16 + reg]); ss += o[r] * o[r]; }
    ss += __shfl_xor(ss, 1); ss += __shfl_xor(ss, 2);
    const float rs = rsqrtf(ss * (1.f / 128.f) + 1e-6f);
    const bf16_t* zp = proj + (size_t)(t0 + c) * EVLD + 1536 + h * 128 + cq * 32;
    bf16_t* mp = mix + (size_t)(t0 + c) * EVLD + h * 128 + cq * 32;
#pragma unroll
    for (int i4 = 0; i4 < 4; ++i4) {
        const u32x4 zw = *(const u32x4*)(zp + i4 * 8);
        u32x4 w;
#pragma unroll
        for (int e = 0; e < 4; ++e) {
            const float z0 = __uint_as_float(zw[e] << 16), z1 = __uint_as_float(zw[e] & 0xffff0000u);
            w[e] = pack2(o[i4 * 8 + e * 2] * rs * nw[i4 * 8 + e * 2] * siluf_(z0), o[i4 * 8 + e * 2 + 1] * rs * nw[i4 * 8 + e * 2 + 1] * siluf_(z1));
        }
        *(u32x4*)(mp + i4 * 8) = w;
    }
}


constexpr int RP_Z0 = 0, RP_Z1 = 18432, RP_Z2 = 55296, RP_VEC = 73728, RP_PT = 75008, RP_T11 = 78080, RP_END = 80640;
constexpr int RP_LIN = 0, RP_LW = 25600;
DI void rwkv_prep_unit(const P& p, int li, int ch, char* lds) {
    const int tid = tidx(), lane = tid & 63, wid = tid >> 6, fr = lane & 15, fq = lane >> 4;
    const int h = ch & 7, n = (ch >> 3) & 63, b = ch >> 9;
    const int t0 = b * SEQ + n * 64;
    const bf16_t* proj = (const bf16_t*)(p.ws + WS_PROJ);
    char* Lfc = lds + RP_Z0; float* Lf = (float*)Lfc;
    char* ApT = lds + RP_Z0; char* AkVT = lds + RP_Z0 + 9216;
    char* Arow = lds + RP_Z1; char* Rrow = Arow + 9216; char* Brow = Arow + 18432; char* Krow = Arow + 27648;
    char* Aak = Arow; char* Arb = Rrow; char* Ark = Brow; char* Trow = Krow; char* BhT = Krow; char* VpT = Aak;
    char* AT = lds + RP_Z2; char* VT = AT + 9216; char* KhT = AT;
    float* tot = (float*)(lds + RP_VEC); float* WC = tot + 256;
    char* lin = lds + RP_LIN; char* LWi = lds + RP_LW;
    float* PT = (float*)(lds + RP_PT);
    {
        const float* mu0 = p.in[I_MU] + (size_t)li * 1696;
        if (tid < 48) {
            const int j0 = tid * 4;
            *(float4*)(PT + j0) = j0 < 160 ? *(const float4*)(mu0 + (C_HW - RW0) + j0) : *(const float4*)(p.in[I_VRESMU] + j0 - 160);
        } else if (tid < 48 + 144) {
            const int q = tid - 48, arr = q >> 4, c4 = (q & 15) * 4, chn = h * 64 + c4;
            const float* src = arr == 0 ? mu0 + (C_R - RW0) + chn : arr == 1 ? mu0 + (C_K - RW0) + chn : arr == 2 ? mu0 + (C_V - RW0) + chn
                             : arr == 3 ? p.in[I_W0] + li * 512 + chn : arr == 4 ? p.in[I_A0] + li * 512 + chn : arr == 5 ? p.in[I_V0] + chn
                             : arr == 6 ? p.in[I_KK] + li * 512 + chn : arr == 7 ? p.in[I_KA] + li * 512 + chn : p.in[I_RK] + li * 512 + chn;
            *(float4*)(PT + 192 + arr * 64 + c4) = *(const float4*)src;
        }
    }
    __syncthreads();
    {
        const int c = tid >> 2, cq = tid & 3, s = n * 64 + c;
        const bf16_t* cur = proj + (size_t)(t0 + c) * EVLD + C_HW + cq * 48;
        const float* mu = p.in[I_MU] + (size_t)li * 1696 + (C_HW - RW0);
        const float* vmu = p.in[I_VRESMU];
#pragma unroll
        for (int i6 = 0; i6 < 6; ++i6) {
            const u32x4 cw4 = *(const u32x4*)(cur + i6 * 8);
            u32x4 pw4 = *(const u32x4*)(cur - (s > 0 ? EVLD : 0) + i6 * 8);
            if (s == 0) pw4 = (u32x4){0u, 0u, 0u, 0u};
            const int j0 = cq * 48 + i6 * 8;
            const float4 ma = *(const float4*)(PT + j0), mb = *(const float4*)(PT + j0 + 4);
            const float mm[8] = {ma.x, ma.y, ma.z, ma.w, mb.x, mb.y, mb.z, mb.w};
            const bool is_t = j0 < 32, is_s = (j0 >= 64) && (j0 < 160);
            const float ca = is_t ? 1.f : 0.f, cb = is_t ? -2.f : 1.f, cc = is_t ? 2.f : -1.f;
            u32x4 w;
#pragma unroll
            for (int e = 0; e < 4; ++e) {
                float o2[2];
#pragma unroll
                for (int q = 0; q < 2; ++q) {
                    const float cv = q ? __uint_as_float(cw4[e] & 0xffff0000u) : __uint_as_float(cw4[e] << 16);
                    const float pv = q ? __uint_as_float(pw4[e] & 0xffff0000u) : __uint_as_float(pw4[e] << 16);
                    const float val = cv + mm[e * 2 + q] * (pv - cv);
                    const float act = ca + cb * __builtin_amdgcn_rcpf(1.f + __expf(cc * val));
                    o2[q] = (is_t || is_s) ? act : val;
                }
                w[e] = pack2(o2[0], o2[1]);
            }
            *(u32x4*)(lin + c * 400 + (cq * 48 + i6 * 8) * 2) = w;
        }
        const bf16_t* LW = (const bf16_t*)(p.ws + WS_W + W_LW) + (size_t)h * 64 * 192;
#pragma unroll
        for (int i6 = 0; i6 < 6; ++i6) *(u32x4*)(LWi + c * 400 + (cq * 48 + i6 * 8) * 2) = *(const u32x4*)(LW + (size_t)c * 192 + cq * 48 + i6 * 8);
    }
    __syncthreads();
    float lw_[16], la_[16], lg_[16], lv_[16];
#pragma unroll
    for (int tj = 0; tj < 4; ++tj) {
        const f32x4 a = tile16(LWi, 400, 16 * tj, lin, 400, 16 * wid, 32);
        const f32x4 bq = tile16(LWi + 64, 400, 16 * tj, lin + 64, 400, 16 * wid, 32);
        const f32x4 cg = tile16(LWi + 128, 400, 16 * tj, lin + 128, 400, 16 * wid, 96);
        const f32x4 dv = tile16(LWi + 320, 400, 16 * tj, lin + 320, 400, 16 * wid, 32);
#pragma unroll
        for (int r = 0; r < 4; ++r) { lw_[tj * 4 + r] = a[r]; la_[tj * 4 + r] = bq[r]; lg_[tj * 4 + r] = cg[r]; lv_[tj * 4 + r] = dv[r]; }
    }
    __syncthreads();
    const int c = 16 * wid + fr;
    float at[16], rt[16], bt[16], kt[16], bh[16], kh[16];
    {
        const int s = n * 64 + c;
        const size_t row = (size_t)(t0 + c);
        const float* mu = p.in[I_MU] + (size_t)li * 1696;
        const int hc = h * 64;
        float rr_[16], kk_[16], lwv[16], aa[16];
        float kn = 0.f, rk = 0.f;
        bf16_t* vf = (bf16_t*)(p.ws + WS_VF);
        bf16_t* gg = (bf16_t*)(p.ws + WS_GG);
#pragma unroll
        for (int tj = 0; tj < 4; ++tj) {
            const int cb = 16 * tj + 4 * fq;
            u32x2 cr = *(const u32x2*)(proj + row * EVLD + C_R + hc + cb), ck = *(const u32x2*)(proj + row * EVLD + C_K + hc + cb), cv = *(const u32x2*)(proj + row * EVLD + C_V + hc + cb);
            const size_t prow = s > 0 ? row - 1 : row;
            u32x2 pr = *(const u32x2*)(proj + prow * EVLD + C_R + hc + cb), pk = *(const u32x2*)(proj + prow * EVLD + C_K + hc + cb), pv = *(const u32x2*)(proj + prow * EVLD + C_V + hc + cb);
            if (s == 0) { pr = (u32x2){0u, 0u}; pk = pr; pv = pr; }
            u32x2 vfw = {0u, 0u};
            if (li == 1) vfw = *(const u32x2*)(vf + row * 512 + hc + cb);
            float vout[4], gout[4];
            const int ch0 = hc + cb;
            const float* pt = PT + 192 + cb;
            const float4 mu_r4 = *(const float4*)(pt), mu_k4 = *(const float4*)(pt + 64), mu_v4 = *(const float4*)(pt + 128);
            const float4 w0_4 = *(const float4*)(pt + 192), a0_4 = *(const float4*)(pt + 256), v0_4 = *(const float4*)(pt + 320);
            const float4 kk_4 = *(const float4*)(pt + 384), ka_4 = *(const float4*)(pt + 448), rk_4 = *(const float4*)(pt + 512);
            const float mur[4] = {mu_r4.x, mu_r4.y, mu_r4.z, mu_r4.w}, muk[4] = {mu_k4.x, mu_k4.y, mu_k4.z, mu_k4.w}, muv[4] = {mu_v4.x, mu_v4.y, mu_v4.z, mu_v4.w};
            const float w0v[4] = {w0_4.x, w0_4.y, w0_4.z, w0_4.w}, a0v[4] = {a0_4.x, a0_4.y, a0_4.z, a0_4.w}, v0v[4] = {v0_4.x, v0_4.y, v0_4.z, v0_4.w};
            const float kkp[4] = {kk_4.x, kk_4.y, kk_4.z, kk_4.w}, kap[4] = {ka_4.x, ka_4.y, ka_4.z, ka_4.w}, rkp[4] = {rk_4.x, rk_4.y, rk_4.z, rk_4.w};
#pragma unroll
            for (int r = 0; r < 4; ++r) {
                const int i = tj * 4 + r;
                const unsigned wcr = r < 2 ? cr.x : cr.y, wck = r < 2 ? ck.x : ck.y, wcv = r < 2 ? cv.x : cv.y;
                const unsigned wpr = r < 2 ? pr.x : pr.y, wpk = r < 2 ? pk.x : pk.y, wpv = r < 2 ? pv.x : pv.y, wvf = r < 2 ? vfw.x : vfw.y;
                const float c_r = (r & 1) ? __uint_as_float(wcr & 0xffff0000u) : __uint_as_float(wcr << 16);
                const float c_k = (r & 1) ? __uint_as_float(wck & 0xffff0000u) : __uint_as_float(wck << 16);
                const float c_v = (r & 1) ? __uint_as_float(wcv & 0xffff0000u) : __uint_as_float(wcv << 16);
                const float p_r = (r & 1) ? __uint_as_float(wpr & 0xffff0000u) : __uint_as_float(wpr << 16);
                const float p_k = (r & 1) ? __uint_as_float(wpk & 0xffff0000u) : __uint_as_float(wpk << 16);
                const float p_v = (r & 1) ? __uint_as_float(wpv & 0xffff0000u) : __uint_as_float(wpv << 16);
                const float rm = c_r + mur[r] * (p_r - c_r);
                const float km = c_k + muk[r] * (p_k - c_k);
                float vm = c_v + muv[r] * (p_v - c_v);
                const float wlog = -softplusf_(-(w0v[r] + lw_[i])) - 0.5f;
                lwv[i] = -__expf(wlog);
                const float a = sigmoidf_(a0v[r] + la_[i]);
                if (li == 1) {
                    const float v1 = (r & 1) ? __uint_as_float(wvf & 0xffff0000u) : __uint_as_float(wvf << 16);
                    vm = vm + (v1 - vm) * sigmoidf_(v0v[r] + lv_[i]);
                }
                const float kkv = km * kkp[r];
                kn += kkv * kkv;
                rr_[i] = rm; kk_[i] = kkv; aa[i] = a;
                kt[i] = km * (1.f + (a - 1.f) * kap[r]);
                rk += rm * kt[i] * rkp[r];
                vout[r] = vm; gout[r] = lg_[i];
            }
            u32x2 w; w.x = pack2(vout[0], vout[1]); w.y = pack2(vout[2], vout[3]);
            *(u32x2*)(vf + row * 512 + hc + cb) = w;
            w.x = pack2(gout[0], gout[1]); w.y = pack2(gout[2], gout[3]);
            *(u32x2*)(gg + row * 512 + hc + cb) = w;
#pragma unroll
            for (int r = 0; r < 4; ++r) *(bf16_t*)(VT + (cb + r) * 144 + c * 2) = f2bf(vout[r]);
            __builtin_amdgcn_sched_barrier(0);
        }
        kn += __shfl_xor(kn, 16); kn += __shfl_xor(kn, 32);
        const float kr = rsqrtf(kn + 1e-6f);
        rk += __shfl_xor(rk, 16); rk += __shfl_xor(rk, 32);
        if (fq == 0) ((float*)(p.ws + WS_RK))[row * 8 + h] = rk;
        float cs[16];
#pragma unroll
        for (int i = 0; i < 16; ++i) {
            float x = lwv[i];
#pragma unroll
            for (int o = 1; o < 16; o <<= 1) { const float y = __shfl_up(x, o, 16); if (fr >= o) x += y; }
            cs[i] = x;
        }
        if (fr == 15) {
#pragma unroll
            for (int i = 0; i < 16; ++i) tot[wid * 64 + 16 * (i >> 2) + 4 * fq + (i & 3)] = cs[i];
        }
        __syncthreads();
#pragma unroll
        for (int i = 0; i < 16; ++i) {
            const int chl = 16 * (i >> 2) + 4 * fq + (i & 3);
            float pre = 0.f, all = 0.f;
#pragma unroll
            for (int w2 = 0; w2 < 4; ++w2) { const float tv = tot[w2 * 64 + chl]; all += tv; if (w2 < wid) pre += tv; }
            const float csi = cs[i] + pre, csm = csi - lwv[i];
            const float kkn = kk_[i] * kr, k2 = kt[i];
            const float e_c = __expf(csi), e_n = __builtin_amdgcn_rcpf(e_c), e_m = __expf(csm), e_h = __expf(all) * e_n;
            at[i] = -kkn * e_m; rt[i] = rr_[i] * e_c;
            const float bp = kkn * aa[i];
            bt[i] = bp * e_n; kt[i] = k2 * e_n; bh[i] = bp * e_h; kh[i] = k2 * e_h;
            if (c == 0) WC[chl] = __expf(all);
            if ((i & 3) == 3) __builtin_amdgcn_sched_barrier(0);
        }
    }
#pragma unroll
    for (int tj = 0; tj < 4; ++tj) {
        const int cb = 16 * tj + 4 * fq;
        u32x2 w;
        w.x = pack2(at[tj * 4], at[tj * 4 + 1]); w.y = pack2(at[tj * 4 + 2], at[tj * 4 + 3]); *(u32x2*)(Arow + c * 144 + cb * 2) = w;
        w.x = pack2(rt[tj * 4], rt[tj * 4 + 1]); w.y = pack2(rt[tj * 4 + 2], rt[tj * 4 + 3]); *(u32x2*)(Rrow + c * 144 + cb * 2) = w;
        w.x = pack2(bt[tj * 4], bt[tj * 4 + 1]); w.y = pack2(bt[tj * 4 + 2], bt[tj * 4 + 3]); *(u32x2*)(Brow + c * 144 + cb * 2) = w;
        w.x = pack2(kt[tj * 4], kt[tj * 4 + 1]); w.y = pack2(kt[tj * 4 + 2], kt[tj * 4 + 3]); *(u32x2*)(Krow + c * 144 + cb * 2) = w;
#pragma unroll
        for (int r = 0; r < 4; ++r) {
            *(bf16_t*)(AT + (cb + r) * 144 + c * 2) = f2bf(at[tj * 4 + r]);
        }
    }
    __syncthreads();
    f32x4 pab[4], pak[4], prb[4], prk[4];
    {
        const int ti = wid;
#pragma unroll
        for (int tj = 0; tj < 4; ++tj) {
            pab[tj] = (f32x4){0.f, 0.f, 0.f, 0.f}; pak[tj] = pab[tj]; prb[tj] = pab[tj]; prk[tj] = pab[tj];
            if (tj <= ti) {
                pab[tj] = tile16(Arow, 144, 16 * ti, Brow, 144, 16 * tj, 64);
                pak[tj] = tile16(Krow, 144, 16 * tj, Arow, 144, 16 * ti, 64);
                prb[tj] = tile16(Brow, 144, 16 * tj, Rrow, 144, 16 * ti, 64);
                prk[tj] = tile16(Krow, 144, 16 * tj, Rrow, 144, 16 * ti, 64);
            }
        }
    }
    __syncthreads();
    {
        const int ti = wid;
#pragma unroll
        for (int tj = 0; tj < 4; ++tj) {
            const int s1 = 16 * tj + fr;
            f32x4 lv;
#pragma unroll
            for (int r = 0; r < 4; ++r) { const int t1 = 16 * ti + 4 * fq + r; lv[r] = (s1 < t1) ? -pab[tj][r] : 0.f; }
            *(f32x4*)&Lf[s1 * 72 + 16 * ti + 4 * fq] = lv;
            const int t2 = 16 * ti + fr;
            float m1[4], m2[4], m3[4];
#pragma unroll
            for (int r = 0; r < 4; ++r) { const int s2 = 16 * tj + 4 * fq + r; m1[r] = (s2 < t2) ? pak[tj][r] : 0.f; m2[r] = (s2 <= t2) ? prb[tj][r] : 0.f; m3[r] = (s2 <= t2) ? prk[tj][r] : 0.f; }
            u32x2 w;
            w.x = pack2(m1[0], m1[1]); w.y = pack2(m1[2], m1[3]); *(u32x2*)(Aak + t2 * 144 + (16 * tj + 4 * fq) * 2) = w;
            w.x = pack2(m2[0], m2[1]); w.y = pack2(m2[2], m2[3]); *(u32x2*)(Arb + t2 * 144 + (16 * tj + 4 * fq) * 2) = w;
            w.x = pack2(m3[0], m3[1]); w.y = pack2(m3[2], m3[3]); *(u32x2*)(Ark + t2 * 144 + (16 * tj + 4 * fq) * 2) = w;
        }
    }
    __syncthreads();
    {
        char* L21i = lds + RP_PT;
        char* T11T = lds + RP_T11;
        char* MT = lds + RP_Z0;
        if (wid < 2) {
            const int o = 32 * wid;
            float Tc[32];
#pragma unroll
            for (int i = 0; i < 32; ++i) Tc[i] = (i == (lane & 31)) ? 1.f : 0.f;
#pragma unroll
            for (int j = 0; j < 31; ++j) {
                const float tj = Tc[j];
#pragma unroll
                for (int i4 = (j + 1) >> 2; i4 < 8; ++i4) {
                    const f32x4 l4 = *(const f32x4*)&Lf[(o + j) * 72 + o + i4 * 4];
#pragma unroll
                    for (int e = 0; e < 4; ++e) if (i4 * 4 + e > j) Tc[i4 * 4 + e] -= l4[e] * tj;
                }
            }
            if (lane < 32) {
#pragma unroll
                for (int i = 0; i < 32; ++i) *(bf16_t*)(Trow + (o + i) * 144 + (o + lane) * 2) = f2bf(Tc[i]);
                if (wid == 0) {
#pragma unroll
                    for (int i = 0; i < 32; ++i) *(bf16_t*)(Trow + i * 144 + (32 + lane) * 2) = 0;
#pragma unroll
                    for (int i4 = 0; i4 < 8; ++i4) { u32x2 w; w.x = pack2(Tc[i4 * 4], Tc[i4 * 4 + 1]); w.y = pack2(Tc[i4 * 4 + 2], Tc[i4 * 4 + 3]); *(u32x2*)(T11T + lane * 80 + i4 * 8) = w; }
                }
            }
        } else {
            const int t2 = tid - 128;
#pragma unroll
            for (int g2 = 0; g2 < 2; ++g2) {
                const int i = t2 & 31, k4 = ((t2 >> 5) + 4 * g2) * 4;
                u32x2 w;
                w.x = pack2(Lf[(k4 + 0) * 72 + 32 + i], Lf[(k4 + 1) * 72 + 32 + i]); w.y = pack2(Lf[(k4 + 2) * 72 + 32 + i], Lf[(k4 + 3) * 72 + 32 + i]);
                *(u32x2*)(L21i + i * 80 + k4 * 2) = w;
            }
        }
        __syncthreads();
        {
            const int r0 = 16 * (wid >> 1), c0 = 16 * (wid & 1);
            const f32x4 mm = tile16(L21i, 80, r0, T11T, 80, c0, 32);
            u32x2 w; w.x = pack2(mm[0], mm[1]); w.y = pack2(mm[2], mm[3]);
            *(u32x2*)(MT + (c0 + fr) * 80 + (r0 + 4 * fq) * 2) = w;
        }
        __syncthreads();
        {
            const int r0 = 16 * (wid >> 1), c0 = 16 * (wid & 1);
            const f32x4 tt = tile16(MT, 80, c0, Trow + 32 * 144 + 64, 144, r0, 32);
            u32x2 w; w.x = pack2(-tt[0], -tt[1]); w.y = pack2(-tt[2], -tt[3]);
            *(u32x2*)(Trow + (32 + r0 + fr) * 144 + (c0 + 4 * fq) * 2) = w;
        }
    }
    __syncthreads();
    {
        const int ti = wid;
#pragma unroll
        for (int tj = 0; tj < 4; ++tj) {
            const f32x4 x = tile16(Trow, 144, 16 * ti, AT, 144, 16 * tj, 64);
            const f32x4 y = tile16(Aak, 144, 16 * ti, VT, 144, 16 * tj, 64);
            u32x2 w;
            w.x = pack2(x[0], x[1]); w.y = pack2(x[2], x[3]); *(u32x2*)(ApT + (16 * tj + fr) * 144 + (16 * ti + 4 * fq) * 2) = w;
            w.x = pack2(y[0], y[1]); w.y = pack2(y[2], y[3]); *(u32x2*)(AkVT + (16 * tj + fr) * 144 + (16 * ti + 4 * fq) * 2) = w;
        }
    }
    __syncthreads();
    {
        const int ti = wid;
#pragma unroll
        for (int tj = 0; tj < 4; ++tj) {
            const f32x4 x = tile16(Trow, 144, 16 * ti, AkVT, 144, 16 * tj, 64);
            u32x2 w; w.x = pack2(x[0], x[1]); w.y = pack2(x[2], x[3]); *(u32x2*)(VpT + (16 * tj + fr) * 144 + (16 * ti + 4 * fq) * 2) = w;
        }
    }
    __syncthreads();
#pragma unroll
    for (int tj = 0; tj < 4; ++tj)
#pragma unroll
        for (int r = 0; r < 4; ++r) {
            const int cb = 16 * tj + 4 * fq + r;
            *(bf16_t*)(BhT + cb * 144 + c * 2) = f2bf(bh[tj * 4 + r]);
            *(bf16_t*)(KhT + cb * 144 + c * 2) = f2bf(kh[tj * 4 + r]);
        }
    __syncthreads();
    {
        unsigned char* opsA = (unsigned char*)p.out + (size_t)ch * 16384;
        unsigned char* opsB = p.ws + WS_ROPS + (size_t)ch * 16384;
        const int ti = wid;
#pragma unroll
        for (int tj = 0; tj < 4; ++tj) {
            const f32x4 x = tile16(ApT, 144, 16 * tj, Arb, 144, 16 * ti, 64);
            const f32x4 g = tile16(ApT, 144, 16 * tj, BhT, 144, 16 * ti, 64);
            const int m1 = 16 * ti + fr, mt = m1 >> 5, rr = m1 & 31, hh = fq & 1, jg = fq >> 1;
            const size_t off = ((size_t)((mt * 4 + tj) * 64 + hh * 32 + rr) * 8 + jg * 4) * 2;
            float gd[4];
#pragma unroll
            for (int r = 0; r < 4; ++r) gd[r] = g[r] + ((16 * tj + 4 * fq + r == m1) ? WC[m1] : 0.f);
            u32x2 w;
            w.x = pack2(x[0] + rt[tj * 4], x[1] + rt[tj * 4 + 1]); w.y = pack2(x[2] + rt[tj * 4 + 2], x[3] + rt[tj * 4 + 3]); *(u32x2*)(opsA + off) = w;
            w.x = pack2(gd[0], gd[1]); w.y = pack2(gd[2], gd[3]); *(u32x2*)(opsA + 8192 + off) = w;
            f32x4 y = tile16(Ark, 144, 16 * ti, VT, 144, 16 * tj, 64);
            const f32x4 y2 = tile16(Arb, 144, 16 * ti, VpT, 144, 16 * tj, 64);
            f32x4 kv = tile16(KhT, 144, 16 * ti, VT, 144, 16 * tj, 64);
            const f32x4 kv2 = tile16(BhT, 144, 16 * ti, VpT, 144, 16 * tj, 64);
            const int vcol = 16 * tj + fr, slice = vcol >> 5, r2 = vcol & 31, cb = 16 * ti + 4 * fq, mt2 = cb >> 5, q4 = (cb & 31) >> 2, h2 = q4 & 1, rg = q4 >> 1;
            const size_t off2 = ((size_t)((slice * 2 + mt2) * 64 + h2 * 32 + r2) * 16 + rg * 4) * 2;
            w.x = pack2(y[0] + y2[0], y[1] + y2[1]); w.y = pack2(y[2] + y2[2], y[3] + y2[3]); *(u32x2*)(opsB + off2) = w;
            w.x = pack2(kv[0] + kv2[0], kv[1] + kv2[1]); w.y = pack2(kv[2] + kv2[2], kv[3] + kv2[3]); *(u32x2*)(opsB + 8192 + off2) = w;
        }
    }
}

DI void rwkv_scan_block(const P& p, int bh, char* lds, bool dry = false) {
    const int tid = tidx(), lane = tid & 63, w = tid >> 6, slice = w & 1;
    const int h = bh & 7, b = bh >> 3;
    constexpr int NST = 64 * 2, AH = 3;
    auto issue = [&](int j) {
        const int n = j >> 1, k = j & 1;
        const size_t ch = (size_t)((b * 64 + n) * 8 + h) * 16384;
        const unsigned char* s0 = (k == 0 ? p.ws + WS_ROPS + ch + 8192 : p.ws + WS_ROPS + ch) + tid * 16;
        const unsigned char* s1 = (k == 0 ? (const unsigned char*)p.out + ch + 8192 : (const unsigned char*)p.out + ch) + tid * 16;
        char* dst = lds + (j & 3) * 16384 + tid * 16;
        glds16(s0, dst); glds16(s0 + 4096, dst + 4096); glds16(s1, dst + 8192); glds16(s1 + 4096, dst + 12288);
    };
    f32x16 H[2];
#pragma unroll
    for (int i = 0; i < 2; ++i)
#pragma unroll
        for (int r = 0; r < 16; ++r) H[i][r] = 0.f;
    __syncthreads();
#pragma unroll
    for (int j = 0; j < AH; ++j) issue(j);
#pragma unroll 1
    for (int n = 0; n < 64; ++n) {
        bf16x8 Hb[4];
#pragma unroll
        for (int i = 0; i < 2; ++i) { Hb[i * 2] = pack_step(H[i], 0); Hb[i * 2 + 1] = pack_step(H[i], 1); }
#pragma unroll
        for (int k = 0; k < 2; ++k) {
            const int j = n * 2 + k;
            if (n < 63) GS_WAIT(8); else if (k == 0) GS_WAIT(4); else GS_WAIT(0);
            __builtin_amdgcn_s_barrier();
            if (j + AH < NST) issue(j + AH);
            __builtin_amdgcn_sched_barrier(0);
            const char* sl = lds + (j & 3) * 16384;
            if (w < 2) {
                f32x16 acc[2];
#pragma unroll
                for (int mt = 0; mt < 2; ++mt) {
                    const u32x4* up = (const u32x4*)(sl + (slice * 2 + mt) * 2048 + lane * 32);
                    const u32x4 u0 = up[0], u1 = up[1];
#pragma unroll
                    for (int e = 0; e < 4; ++e) {
                        acc[mt][e * 2] = __uint_as_float(u0[e] << 16); acc[mt][e * 2 + 1] = __uint_as_float(u0[e] & 0xffff0000u);
                        acc[mt][8 + e * 2] = __uint_as_float(u1[e] << 16); acc[mt][8 + e * 2 + 1] = __uint_as_float(u1[e] & 0xffff0000u);
                    }
                }
                const bf16x8* fr = (const bf16x8*)(sl + 8192) + lane;
                bf16x8 f8[8];
#pragma unroll
                for (int q = 0; q < 8; ++q) f8[q] = fr[q * 64];
#pragma unroll
                for (int ks = 0; ks < 4; ++ks)
#pragma unroll
                    for (int mt = 0; mt < 2; ++mt) acc[mt] = mfma32(f8[mt * 4 + ks], Hb[ks], acc[mt]);
                if (k == 0) { H[0] = acc[0]; H[1] = acc[1]; }
                else {
                    const size_t ch = (size_t)((b * 64 + n) * 8 + h) * 16384;
                    u32x4* Yf = (u32x4*)(dry ? p.ws + WS_DUMMY + 2097152 + (size_t)(bh & 31) * 16384 : p.ws + WS_ROPS + ch) + (size_t)(slice * 128 + lane) * 2;
#pragma unroll
                    for (int mt = 0; mt < 2; ++mt) {
                        u32x4 o0, o1;
#pragma unroll
                        for (int e = 0; e < 4; ++e) { o0[e] = pack2(acc[mt][e * 2], acc[mt][e * 2 + 1]); o1[e] = pack2(acc[mt][8 + e * 2], acc[mt][8 + e * 2 + 1]); }
                        Yf[mt * 128] = o0; Yf[mt * 128 + 1] = o1;
                    }
                }
            }
        }
    }
    __syncthreads();
}

DI void rwkv_post_unit(const P& p, int li, int ch) {
    const int tid = tidx();
    const int h = ch & 7, n = (ch >> 3) & 63, b = ch >> 9;
    const int t0 = b * SEQ + n * 64;
    const int c = tid >> 2, cq = tid & 3;
    const bf16_t* Yf = (const bf16_t*)(p.ws + WS_ROPS + (size_t)ch * 16384);
    const bf16_t* vf = (const bf16_t*)(p.ws + WS_VF) + (size_t)(t0 + c) * 512 + h * 64 + cq * 16;
    const bf16_t* gg = (const bf16_t*)(p.ws + WS_GG) + (size_t)(t0 + c) * 512 + h * 64 + cq * 16;
    const float rk = ((const float*)(p.ws + WS_RK))[(size_t)(t0 + c) * 8 + h];
    const float* lnw = p.in[I_LNW] + li * 512 + h * 64 + cq * 16;
    const float* lnb = p.in[I_LNB] + li * 512 + h * 64 + cq * 16;
    bf16_t* mp = (bf16_t*)p.out + (size_t)(t0 + c) * 1024 + 512 + h * 64 + cq * 16;
    const int mt = c >> 5, q4 = (c & 31) >> 2, hh = q4 & 1, rg = q4 >> 1, reg = rg * 4 + (c & 3), slice = cq >> 1, rb = (cq & 1) * 16;
    float y[16]; float sm = 0.f;
#pragma unroll
    for (int i = 0; i < 16; ++i) { y[i] = bf2f(Yf[(size_t)((slice * 2 + mt) * 64 + hh * 32 + rb + i) * 16 + reg]); sm += y[i]; }
    sm += __shfl_xor(sm, 1); sm += __shfl_xor(sm, 2);
    const float mean = sm * (1.f / 64.f);
    float vs = 0.f;
#pragma unroll
    for (int i = 0; i < 16; ++i) { y[i] -= mean; vs += y[i] * y[i]; }
    vs += __shfl_xor(vs, 1); vs += __shfl_xor(vs, 2);
    const float rs = rsqrtf(vs * (1.f / 64.f) + 64e-5f);
#pragma unroll
    for (int i8 = 0; i8 < 2; ++i8) {
        const u32x4 vw = *(const u32x4*)(vf + i8 * 8), gw = *(const u32x4*)(gg + i8 * 8);
        u32x4 w;
#pragma unroll
        for (int e = 0; e < 4; ++e) {
            const int i = i8 * 8 + e * 2;
            const float v0 = __uint_as_float(vw[e] << 16), v1 = __uint_as_float(vw[e] & 0xffff0000u), g0 = __uint_as_float(gw[e] << 16), g1 = __uint_as_float(gw[e] & 0xffff0000u);
            w[e] = pack2((y[i] * rs * lnw[i] + lnb[i] + rk * v0) * g0, (y[i + 1] * rs * lnw[i + 1] + lnb[i + 1] + rk * v1) * g1);
        }
        *(u32x4*)(mp + i8 * 8) = w;
    }
}


DI void attn_unit(const P& p, int unit, char* lds) {
    const int tid = tidx(), lane = tid & 63, w = tid >> 6, r_ = lane & 31, hl = lane >> 5;
    const int idx = unit & 31, h = (unit >> 5) & 7, g = (unit >> 8) % 3, b = unit / 768;
    const int lg2 = g * 2, dil = 1 << lg2, L = SEQ >> lg2, ntl = L >> 7;
    const int rs = idx / ntl, qt = idx % ntl;
    const int hg = g * 8 + h;
    const bf16_t* QK = (const bf16_t*)(p.ws + WS_QK);
    const bf16_t* VT = (const bf16_t*)(p.ws + WS_VT) + ((size_t)((b * 24 + hg) * dil + rs) * 64) * L;
    const int qi = 32 * w + r_;
    const int q_idx = 128 * qt + qi;
    const size_t qrow = (size_t)(b * SEQ + q_idx * dil + rs);
    const int kbase0 = 128 * qt - 128;
    char* Kt = lds;
    char* Vt = lds + 32768;
    __syncthreads();
#pragma unroll
    for (int i = 0; i < 8; ++i) {
        const int id = tid + i * 256, row = id >> 3, pc = id & 7, c = pc ^ ((row >> 1) & 7);
        int k_idx = kbase0 + row; if (k_idx < 0) k_idx = 0;
        glds16(QK + (size_t)(b * SEQ + k_idx * dil + rs) * 3072 + 1536 + hg * 64 + c * 8, Kt + id * 16);
    }
#pragma unroll
    for (int i = 0; i < 8; ++i) {
        const int id = tid + i * 256, row = id >> 5, pq = id & 31, q = pq ^ (row & 31);
        int k0 = kbase0 + q * 8; if (k0 < 0) k0 = 0;
        glds16(VT + (size_t)row * L + k0, Vt + id * 16);
    }
    bf16x8 qf[4];
#pragma unroll
    for (int ks = 0; ks < 4; ++ks) qf[ks] = *(const bf16x8*)(QK + qrow * 3072 + hg * 64 + 16 * ks + 8 * hl);
    asm volatile("s_waitcnt vmcnt(0)" ::: "memory");
    __syncthreads();
    f32x16 st[5];
    float mx = -1.0e30f;
#pragma unroll
    for (int kbi = 0; kbi < 5; ++kbi) {
        const int krow = 32 * (w + kbi) + r_;
#pragma unroll
        for (int r = 0; r < 16; ++r) st[kbi][r] = 0.f;
#pragma unroll
        for (int ks = 0; ks < 4; ++ks) {
            const bf16x8 kf = *(const bf16x8*)(Kt + krow * 128 + (((2 * ks + hl) ^ ((krow >> 1) & 7)) * 16));
            st[kbi] = mfma32(kf, qf[ks], st[kbi]);
        }
#pragma unroll
        for (int r = 0; r < 16; ++r) {
            const int kj = 32 * (w + kbi) + (r & 3) + 8 * (r >> 2) + 4 * hl;
            const bool valid = (kj >= qi) && (kj <= qi + 128) && (kbase0 + kj >= 0);
            const float sv = valid ? st[kbi][r] * 0.125f : -1.0e30f;
            st[kbi][r] = sv; mx = fmaxf(mx, sv);
        }
    }
    mx = fmaxf(mx, __shfl_xor(mx, 32));
    float l = 0.f;
#pragma unroll
    for (int kbi = 0; kbi < 5; ++kbi)
#pragma unroll
        for (int r = 0; r < 16; ++r) { const float pv = __expf(st[kbi][r] - mx); st[kbi][r] = pv; l += pv; }
    l += __shfl_xor(l, 32);
    f32x16 ot[2];
#pragma unroll
    for (int dt = 0; dt < 2; ++dt)
#pragma unroll
        for (int r = 0; r < 16; ++r) ot[dt][r] = 0.f;
#pragma unroll
    for (int kbi = 0; kbi < 5; ++kbi)
#pragma unroll
        for (int s2 = 0; s2 < 2; ++s2) {
            const bf16x8 pb = pack_step(st[kbi], s2);
            const int q0 = 4 * (w + kbi) + 2 * s2;
#pragma unroll
            for (int dt = 0; dt < 2; ++dt) {
                const int drow = 32 * dt + r_;
                const u32x2 lo = *(const u32x2*)(Vt + drow * 512 + ((q0 ^ (drow & 31)) * 16) + 8 * hl);
                const u32x2 hi = *(const u32x2*)(Vt + drow * 512 + (((q0 + 1) ^ (drow & 31)) * 16) + 8 * hl);
                u32x4 vw; vw.x = lo.x; vw.y = lo.y; vw.z = hi.x; vw.w = hi.y;
                ot[dt] = mfma32(__builtin_bit_cast(bf16x8, vw), pb, ot[dt]);
            }
        }
    const float inv = 1.f / l;
    bf16_t* og = (bf16_t*)(p.ws + WS_OG) + ((size_t)g * T + qrow) * 512 + h * 64;
#pragma unroll
    for (int dt = 0; dt < 2; ++dt)
#pragma unroll
        for (int rg = 0; rg < 4; ++rg) {
            u32x2 wv; wv.x = pack2(ot[dt][rg * 4] * inv, ot[dt][rg * 4 + 1] * inv); wv.y = pack2(ot[dt][rg * 4 + 2] * inv, ot[dt][rg * 4 + 3] * inv);
            *(u32x2*)(og + 32 * dt + 8 * rg + 4 * hl) = wv;
        }
    if (hl == 0) ((float*)(p.ws + WS_LSE))[((size_t)g * T + qrow) * 8 + h] = mx + __logf(l);
}
DI void phase_attn_merge(const P& p) {
    const bf16_t* og = (const bf16_t*)(p.ws + WS_OG);
    const float* lse = (const float*)(p.ws + WS_LSE);
    bf16_t* o = (bf16_t*)p.out;
    for (int i = bidx() * 256 + tidx(); i < T * 64; i += gridDim.x * 256) {
        const int t = i >> 6, c8 = i & 63, h = c8 >> 3;
        const float l0 = lse[(size_t)t * 8 + h], l1 = lse[((size_t)T + t) * 8 + h], l2 = lse[((size_t)2 * T + t) * 8 + h];
        const float m = fmaxf(l0, fmaxf(l1, l2));
        float w0 = __expf(l0 - m), w1 = __expf(l1 - m), w2 = __expf(l2 - m);
        const float inv = 1.f / (w0 + w1 + w2); w0 *= inv; w1 *= inv; w2 *= inv;
        const u32x4 a = *(const u32x4*)(og + (size_t)t * 512 + c8 * 8), bq = *(const u32x4*)(og + ((size_t)T + t) * 512 + c8 * 8), cq = *(const u32x4*)(og + ((size_t)2 * T + t) * 512 + c8 * 8);
        u32x4 r;
#pragma unroll
        for (int e = 0; e < 4; ++e) {
            const float x0 = w0 * __uint_as_float(a[e] << 16) + w1 * __uint_as_float(bq[e] << 16) + w2 * __uint_as_float(cq[e] << 16);
            const float x1 = w0 * __uint_as_float(a[e] & 0xffff0000u) + w1 * __uint_as_float(bq[e] & 0xffff0000u) + w2 * __uint_as_float(cq[e] & 0xffff0000u);
            r[e] = pack2(x0, x1);
        }
        *(u32x4*)(o + (size_t)t * 512 + c8 * 8) = r;
    }
}


#define XB_TMO      128
#define XB_XCNT(j)  (256  + 64 * (j))
#define XB_XSUB(j)  (1280 + 64 * (j))
#define XB_XGEN(j)  (2304 + 64 * (j))
#define XB_TOP      3328
#define XB_TOPGEN   3392
#define XCD_BAR_WORDS 3456
#define XB_SPIN_CAP (1u << 22)
#define LAS __attribute__((address_space(3)))
DI unsigned xb_ld(unsigned* p)              { return __hip_atomic_load(p, __ATOMIC_RELAXED, __HIP_MEMORY_SCOPE_AGENT); }
DI unsigned xb_add(unsigned* p, unsigned v) { return __hip_atomic_fetch_add(p, v, __ATOMIC_RELAXED, __HIP_MEMORY_SCOPE_AGENT); }
DI unsigned xb_xcc_id() { return (unsigned)__builtin_amdgcn_s_getreg((3 << 11) | 20) & 0xFu; }
#define XB_SPIN(cond, bar) do { unsigned _sp = 0; while (cond) { if (_sp < 32u) __builtin_amdgcn_s_sleep(2); else __builtin_amdgcn_s_sleep(24); \
    if ((++_sp & 255u) == 0u) { if (xb_ld(&(bar)[XB_TMO])) break; if (_sp > XB_SPIN_CAP) { atomicAdd(&(bar)[XB_TMO], 1u); break; } } } } while (0)
struct XcdBarrier { unsigned* bar; unsigned x; volatile LAS unsigned* st; };
DI XcdBarrier xcd_barrier_post(unsigned* bar, volatile LAS unsigned* st) {
    XcdBarrier b; b.bar = bar; b.x = xb_xcc_id(); b.st = st;
    if (threadIdx.x == 0) (void)xb_add(&bar[XB_XCNT(b.x)], 1u);
    return b;
}
DI void xcd_barrier_complete(unsigned* bar, unsigned x, unsigned& nloc, unsigned& nx) {
    const unsigned G = gridDim.x * gridDim.y * gridDim.z;
    unsigned sum, cnt, mine, sp = 0u;
    for (;;) {
        sum = 0u; cnt = 0u; mine = 0u;
#pragma unroll
        for (unsigned j = 0; j < 16; ++j) { const unsigned c = xb_ld(&bar[XB_XCNT(j)]); sum += c; cnt += (c > 0u) ? 1u : 0u; mine = (j == x) ? c : mine; }
        if (sum == G) break;
        __builtin_amdgcn_s_sleep(1);
        if ((++sp & 255u) == 0u) { if (xb_ld(&bar[XB_TMO])) break; if (sp > XB_SPIN_CAP) { atomicAdd(&bar[XB_TMO], 1u); break; } }
    }
    nloc = mine > 0u ? mine : 1u; nx = cnt > 0u ? cnt : 1u;
}
DI void xcd_barrier(const XcdBarrier& b) {
    asm volatile("s_waitcnt vmcnt(0)" ::: "memory");
    __syncthreads();
    if (threadIdx.x == 0) {
        unsigned* bar = b.bar; unsigned bx = b.x;
        asm volatile("" : "+s"(bar), "+s"(bx));
        __builtin_amdgcn_s_waitcnt(0);
        unsigned nloc = b.st[0], nx = b.st[1];
        if (nloc == 0u) { xcd_barrier_complete(bar, bx, nloc, nx); b.st[0] = nloc; b.st[1] = nx; }
        const unsigned old = xb_add(&bar[XB_XSUB(bx)], 1u);
        const unsigned gen = old / nloc;
        if (old + 1u == (gen + 1u) * nloc) {
            __builtin_amdgcn_fence(__ATOMIC_RELEASE, "agent");
            asm volatile("s_waitcnt vmcnt(0)" ::: "memory");
            const unsigned og = xb_add(&bar[XB_TOP], 1u);
            const unsigned tg = og / nx;
            if (og + 1u == (tg + 1u) * nx) xb_add(&bar[XB_TOPGEN], 1u);
            else XB_SPIN(xb_ld(&bar[XB_TOPGEN]) == tg, bar);
            __builtin_amdgcn_fence(__ATOMIC_ACQUIRE, "agent");
            xb_add(&bar[XB_XGEN(bx)], 1u);
            asm volatile("s_waitcnt vmcnt(0)" ::: "memory");
        } else {
            XB_SPIN(xb_ld(&bar[XB_XGEN(bx)]) == gen, bar);
            __builtin_amdgcn_fence(__ATOMIC_ACQUIRE, "agent");
            asm volatile("s_waitcnt vmcnt(0)" ::: "memory");
        }
    }
    __syncthreads();
}

constexpr int LDS_BYTES = RP_END;
static_assert(GP_END + 6144 <= LDS_BYTES, "LDS");
__global__ void __launch_bounds__(256, 2) mega(P p) {
    cg::grid_group grid = cg::this_grid();
    extern __shared__ __attribute__((aligned(16))) char lds[];
    if (threadIdx.x < 4) ((volatile LAS unsigned*)(lds + LDS_BYTES))[threadIdx.x] = 0u;
    __syncthreads();
    const XcdBarrier xb = xcd_barrier_post((unsigned*)(p.ws + WS_CTL + CTL_BAR), (volatile LAS unsigned*)(lds + LDS_BYTES));
#define GSYNC() xcd_barrier(xb)
    const bf16_t* HN = (const bf16_t*)p.out;
    const bf16_t* Win = (const bf16_t*)(p.ws + WS_W + W_IN);
    const bf16_t* Wout = (const bf16_t*)(p.ws + WS_W + W_OUT);
    phase_rope(p);
    phase_convert_io(p, 0, lds);
    phase_prep<0>(p, p.in[I_EVNORM], 0);
    if (p.ws == nullptr) grid.sync();
    GSYNC();
    volatile LAS unsigned* qword = (volatile LAS unsigned*)(lds + LDS_BYTES + 8);
    for (int layer = 0; layer < 4; ++layer) {
        const int li = layer >> 1;
        if ((layer & 1) == 0) {
            phase_gemm<EPI_EVEN_IN>(p, HN, 1024, Win, 1024, EVPAD / 128, lds);
            GSYNC();
            for (int u = bidx(); u < 1024; u += gridDim.x) gdn_prep_unit(p, li, u, lds);
            GSYNC();
            if (bidx() < 16) gdn_scan_block(p, bidx(), lds);
            {
                unsigned* qctr = (unsigned*)(p.ws + WS_CTL + CTL_QUEUE) + li * 64;
                for (;;) {
                    __syncthreads();
                    if (threadIdx.x == 0) *qword = atomicAdd(qctr, 1u);
                    __syncthreads();
                    const unsigned u = *qword;
                    if (u >= 2048u) break;
                    rwkv_prep_unit(p, li, (int)u, lds);
                }
            }
            GSYNC();
            if (bidx() < 32) rwkv_scan_block(p, bidx(), lds);
            else {
                for (int u = bidx() - 32; u < 1024; u += gridDim.x - 32) gdn_post_unit(p, li, u);
                phase_convert_moe(p, layer, lds, bidx() - 32, gridDim.x - 32);
            }
            GSYNC();
            for (int u = bidx(); u < 2048; u += gridDim.x) rwkv_post_unit(p, li, u);
            GSYNC();
            phase_gemm<EPI_RESID>(p, (const bf16_t*)(p.ws + WS_PROJ), EVLD, Wout, 1024, 8, lds, false, HN, 1024, 512);
        } else {
            phase_gemm<EPI_ODD_IN>(p, HN, 1024, Win, 1024, ODC / 128, lds);
            GSYNC();
            for (int u = bidx(); u < 3072; u += gridDim.x) attn_unit(p, u, lds);
            GSYNC();
            phase_attn_merge(p);
            GSYNC();
            phase_gemm<EPI_RESID>(p, HN, 512, Wout, 512, 8, lds);
        }
        GSYNC();
        phase_router(p, p.in[I_FFNNORM] + layer * 1024, layer, lds);
        GSYNC();
        phase_moe_up(p, layer, lds);
        GSYNC();
        phase_moe_down(p, layer, lds);
        GSYNC();
        if (layer < 3) {
            phase_convert_io(p, layer + 1, lds);
            if ((layer + 1) & 1) phase_convert_moe(p, layer + 1, lds, bidx(), gridDim.x);
            phase_prep<1>(p, ((layer + 1) & 1) ? p.in[I_ODNORM] + ((layer + 1) >> 1) * 1024 : p.in[I_EVNORM] + ((layer + 1) >> 1) * 1024, layer + 1);
            GSYNC();
        }
    }
    phase_prep<3>(p, p.in[I_FINAL], 0);
}

extern "C" void kernel_launch(void* const* d_in, const int* in_sizes, int n_in, void* d_out, int out_size, void* d_ws, size_t ws_size, hipStream_t stream) {
    if (n_in != 34 || out_size != T * D || ws_size < WS_END) { fprintf(stderr, "kernel_launch: unexpected shapes (n_in %d out %d ws %zu need %zu)\n", n_in, out_size, ws_size, (size_t)WS_END); return; }
    static int grid_blocks = 0;
    if (!grid_blocks) {
        int dev = 0, cus = 0, per_cu = 0;
        (void)hipGetDevice(&dev);
        (void)hipDeviceGetAttribute(&cus, hipDeviceAttributeMultiprocessorCount, dev);
        (void)hipFuncSetAttribute((const void*)mega, hipFuncAttributeMaxDynamicSharedMemorySize, LDS_BYTES + 16);
        (void)hipOccupancyMaxActiveBlocksPerMultiprocessor(&per_cu, mega, 256, LDS_BYTES + 16);
        if (per_cu < 1) per_cu = 1;
        if (per_cu > 2) per_cu = 2;
        grid_blocks = cus * per_cu;
    }
    P p{};
    for (int i = 0; i < 34; ++i) p.in[i] = (const float*)d_in[i];
    p.out = (float*)d_out; p.ws = (unsigned char*)d_ws;
    (void)hipMemsetAsync((char*)d_ws + WS_CTL, 0, 65536, stream);
    void* args[] = {&p};
    hipError_t e = hipLaunchCooperativeKernel((void*)mega, dim3(grid_blocks), dim3(256), args, LDS_BYTES + 16, stream);
    if (e != hipSuccess) fprintf(stderr, "cooperative launch failed: %s (grid %d)\n", hipGetErrorString(e), grid_blocks);
}
```

```cpp
#include <hip/hip_runtime.h>
#include <cstdio>
#include <cstdint>
#include <cmath>
#include <hip/hip_cooperative_groups.h>
namespace cg = cooperative_groups;

typedef unsigned short bf16_t;
typedef short bf16x8 __attribute__((ext_vector_type(8)));
typedef float f32x4 __attribute__((ext_vector_type(4)));
typedef unsigned u32x4 __attribute__((ext_vector_type(4)));
typedef unsigned u32x2 __attribute__((ext_vector_type(2)));
#define DI __device__ __forceinline__

constexpr int T = 16384, SEQ = 4096, BATCH = 4, D = 1024;
constexpr int EVC = 3784, EVLD = 3784, EVPAD = 3840;
constexpr int ODC = 4608;
constexpr int RW0 = 2056;
constexpr int C_R = 2056, C_K = 2568, C_V = 3080, C_HW = 3592, C_HA = 3624, C_HG = 3656, C_HV = 3752;
constexpr int NEXP = 16, FF = 256;
constexpr int HROWS = 34816;

constexpr size_t WS_CTL = 0;
constexpr size_t CTL_EGL = 4096;
constexpr size_t CTL_QUEUE = 49152;
constexpr size_t CTL_CNT = 32768;
constexpr size_t CTL_BAR = 16384;
constexpr size_t WS_LIST = 65536;
constexpr size_t WS_GATE = WS_LIST + 16 * 16384 * 4;
constexpr size_t WS_RK = WS_GATE + 16 * 16384 * 4;
constexpr size_t WS_SSQ = WS_RK + (size_t)T * 8 * 4;
constexpr size_t WS_ROPE = WS_SSQ + (size_t)16 * T * 4;
constexpr size_t WS_W = WS_ROPE + (size_t)T * 32 * 8;
constexpr size_t W_IN = 0;
constexpr size_t W_OUT = (size_t)4608 * 1024 * 2;
constexpr size_t W_13 = W_OUT + (size_t)1024 * 1024 * 2;
constexpr size_t W_2 = W_13 + (size_t)16 * 512 * 1024 * 2;
constexpr size_t W_LW = W_2 + (size_t)16 * 1024 * 256 * 2;
constexpr size_t W_BYTES = W_LW + (size_t)512 * 192 * 2;
constexpr size_t WS_XB = WS_W + W_BYTES;
constexpr size_t WS_HN = WS_XB;
constexpr size_t WS_VF = WS_HN + (size_t)T * 1024 * 2;
constexpr size_t WS_R2 = WS_VF + (size_t)T * 512 * 2;
constexpr size_t WS_PROJ = WS_R2;
constexpr size_t WS_GOPS = WS_R2 + (size_t)T * EVLD * 2;
constexpr size_t GOPS_CH = 73728, GO_UF = 0, GO_WF = 16384, GO_QF = 32768, GO_AF = 49152, GO_KF = 57344;
constexpr size_t WS_ROPS = WS_GOPS + 1024 * GOPS_CH;
constexpr size_t WS_QK = WS_R2;
constexpr size_t WS_VT = WS_QK + (size_t)T * 3072 * 2;
constexpr size_t WS_OG = WS_VT + (size_t)T * 1536 * 2;
constexpr size_t WS_LSE = WS_OG + (size_t)3 * T * 512 * 2;
constexpr size_t WS_END3 = WS_LSE + (size_t)3 * T * 8 * 4;
constexpr size_t WS_YS = WS_R2;
constexpr size_t WS_H = WS_YS + (size_t)2 * T * 1024 * 2;
constexpr size_t WS_GG = WS_ROPS + (size_t)2048 * 16384;
constexpr size_t WS_END0 = WS_GG + (size_t)T * 512 * 2;
constexpr size_t WS_END1 = WS_H + (size_t)HROWS * 256 * 2;
constexpr size_t WS_END2 = WS_R2 + (size_t)T * 4608 * 2;
static_assert(WS_END3 <= WS_END0, "odd-layer regions exceed even-layer footprint");
constexpr size_t WS_END = WS_END0 > WS_END1 ? (WS_END0 > WS_END2 ? WS_END0 : WS_END2) : (WS_END1 > WS_END2 ? WS_END1 : WS_END2);

constexpr size_t WS_DUMMY = WS_END0;
struct P {
    const float* in[34];
    float* out;
    unsigned char* ws;
};
enum { I_X = 0, I_POS, I_EVNORM, I_EVWIN, I_VRESDOWN, I_EVWOUT, I_CONVW, I_ALOG, I_DTB, I_GDNNORM, I_MU, I_W0, I_W2, I_A0, I_A2, I_G2,
       I_KK, I_KA, I_RK, I_LNW, I_LNB, I_VRESMU, I_V0, I_V2, I_ODNORM, I_ODWIN, I_ODWOUT, I_FFNNORM, I_WGROUP, I_WEXPERT, I_W1, I_W3, I_MW2, I_FINAL };

DI int tidx() { int t = threadIdx.x; asm volatile("" : "+v"(t)); return t; }
DI int bidx() { int b = blockIdx.x; asm volatile("" : "+s"(b)); return b; }
typedef __bf16 bf2_t __attribute__((ext_vector_type(2)));
typedef float f2_t __attribute__((ext_vector_type(2)));
DI bf16_t f2bf(float x) { return __builtin_bit_cast(bf16_t, (__bf16)x); }
DI float bf2f(bf16_t h) { return __uint_as_float(((unsigned)h) << 16); }
DI unsigned pack2(float lo, float hi) { const f2_t v = {lo, hi}; return __builtin_bit_cast(unsigned, __builtin_convertvector(v, bf2_t)); }
DI float wave_sum(float v) {
#pragma unroll
    for (int o = 32; o > 0; o >>= 1) v += __shfl_xor(v, o);
    return v;
}
DI float wave_max(float v) {
#pragma unroll
    for (int o = 32; o > 0; o >>= 1) v = fmaxf(v, __shfl_xor(v, o));
    return v;
}
DI float sigmoidf_(float x) { return __builtin_amdgcn_rcpf(1.f + __expf(-x)); }
DI float siluf_(float x) { return x * __builtin_amdgcn_rcpf(1.f + __expf(-x)); }
DI float softplusf_(float x) { return fmaxf(x, 0.f) + __logf(1.f + __expf(-fabsf(x))); }

struct ConvJob { const float* src; bf16_t* dst; int K, N, ldd; int mode; };
DI int rowmap(int mode, int n) { return mode == 0 ? n : ((n >> 4) * 32 + (n & 15) + (mode == 2 ? 16 : 0)); }
DI void conv_tile(const ConvJob& j, int tile, float* lds  ) {
    const int ntn = (j.N + 255) / 256;
    const int tk = tile / ntn, tn = tile % ntn;
    const int tid = tidx();
    __syncthreads();
    float4 v[16];
#pragma unroll
    for (int i = 0; i < 16; ++i) {
        const int e = tid + i * 256, k = e >> 6, n4 = (e & 63) * 4;
        const int gk = tk * 64 + k, gn = tn * 256 + n4;
        v[i] = make_float4(0.f, 0.f, 0.f, 0.f);
        if (gn < j.N) v[i] = *(const float4*)(j.src + (size_t)gk * j.N + gn);
    }
#pragma unroll
    for (int i = 0; i < 16; ++i) { const int e = tid + i * 256, k = e >> 6, n4 = (e & 63) * 4; *(float4*)(lds + k * 260 + n4) = v[i]; }
    __syncthreads();
#pragma unroll
    for (int i = 0; i < 8; ++i) {
        const int e = tid + i * 256, n = e & 255, k8 = (e >> 8) * 8;
        const int gn = tn * 256 + n;
        if (gn < j.N) {
            u32x4 w;
            w.x = pack2(lds[(k8 + 0) * 260 + n], lds[(k8 + 1) * 260 + n]); w.y = pack2(lds[(k8 + 2) * 260 + n], lds[(k8 + 3) * 260 + n]);
            w.z = pack2(lds[(k8 + 4) * 260 + n], lds[(k8 + 5) * 260 + n]); w.w = pack2(lds[(k8 + 6) * 260 + n], lds[(k8 + 7) * 260 + n]);
            *(u32x4*)(j.dst + (size_t)rowmap(j.mode, gn) * j.ldd + tk * 64 + k8) = w;
        }
    }
}
DI void phase_convert_io(const P& p, int layer, char* ldsc) {
    float* lds = (float*)ldsc;
    unsigned char* W = p.ws + WS_W;
    const int li = layer >> 1;
    if ((layer & 1) == 0) {
        const ConvJob j0{p.in[I_EVWIN] + (size_t)li * 1024 * 3752, (bf16_t*)(W + W_IN), 1024, 3752, 1024, 0};
        for (int t = bidx(); t < 16 * 15; t += gridDim.x) conv_tile(j0, t, lds);
        if (li == 1) {
            const ConvJob j1{p.in[I_VRESDOWN], (bf16_t*)(W + W_IN) + (size_t)3752 * 1024, 1024, 32, 1024, 0};
            for (int t = bidx(); t < 16; t += gridDim.x) conv_tile(j1, t, lds);
        }
        const ConvJob j2{p.in[I_EVWOUT] + (size_t)li * 1024 * 1024, (bf16_t*)(W + W_OUT), 1024, 1024, 1024, 0};
        for (int t = bidx(); t < 16 * 4; t += gridDim.x) conv_tile(j2, t, lds);
        {
            bf16_t* LW = (bf16_t*)(W + W_LW);
            for (int i = bidx() * 256 + tidx(); i < 512 * 192; i += gridDim.x * 256) {
                const int ch = i / 192, j = i % 192;
                float v;
                if (j < 32) v = p.in[I_W2][((size_t)li * 32 + j) * 512 + ch];
                else if (j < 64) v = p.in[I_A2][((size_t)li * 32 + j - 32) * 512 + ch];
                else if (j < 160) v = p.in[I_G2][((size_t)li * 96 + j - 64) * 512 + ch];
                else v = (li == 1) ? p.in[I_V2][(size_t)(j - 160) * 512 + ch] : 0.f;
                LW[i] = f2bf(v);
            }
        }
        const int r0 = (li == 1) ? 3784 : 3752;
        bf16_t* z = (bf16_t*)(W + W_IN) + (size_t)r0 * 1024;
        const size_t n = (size_t)(EVPAD - r0) * 1024;
        for (size_t i = (size_t)bidx() * 256 + tidx(); i < n; i += (size_t)gridDim.x * 256) z[i] = 0;
    } else {
        const ConvJob j0{p.in[I_ODWIN] + (size_t)li * 1024 * 4608, (bf16_t*)(W + W_IN), 1024, 4608, 1024, 0};
        for (int t = bidx(); t < 16 * 18; t += gridDim.x) conv_tile(j0, t, lds);
        const ConvJob j2{p.in[I_ODWOUT] + (size_t)li * 512 * 1024, (bf16_t*)(W + W_OUT), 512, 1024, 512, 0};
        for (int t = bidx(); t < 8 * 4; t += gridDim.x) conv_tile(j2, t, lds);
    }
}
DI void phase_convert_moe(const P& p, int layer, char* ldsc, int b0, int bs) {
    float* lds = (float*)ldsc;
    unsigned char* W = p.ws + WS_W;
    for (int t = b0; t < 16 * 3 * 16; t += bs) {
        const int e = t / 48, r = t % 48, which = r / 16, tile = r % 16;
        ConvJob j;
        if (which == 0) j = ConvJob{p.in[I_W1] + ((size_t)layer * 16 + e) * 1024 * 256, (bf16_t*)(W + W_13) + (size_t)e * 512 * 1024, 1024, 256, 1024, 1};
        else if (which == 1) j = ConvJob{p.in[I_W3] + ((size_t)layer * 16 + e) * 1024 * 256, (bf16_t*)(W + W_13) + (size_t)e * 512 * 1024, 1024, 256, 1024, 2};
        else j = ConvJob{p.in[I_MW2] + ((size_t)layer * 16 + e) * 256 * 1024, (bf16_t*)(W + W_2) + (size_t)e * 1024 * 256, 256, 1024, 256, 0};
        conv_tile(j, tile, lds);
    }
}

DI void phase_rope(const P& p) {
    float2* tab = (float2*)(p.ws + WS_ROPE);
    const int* pos = (const int*)p.in[I_POS];
    for (int i = bidx() * 256 + tidx(); i < T * 32; i += gridDim.x * 256) {
        const int t = i >> 5, f = i & 31;
        const float inv = powf(10000.0f, -(float)f * (2.0f / 64.0f));
        const float ang = (float)pos[t] * inv;
        float s, c; sincosf(ang, &s, &c);
        tab[i] = make_float2(c, s);
    }
}

template <int MODE>
DI void phase_prep(const P& p, const float* gain, int layer) {
    const int lane = tidx() & 63, wid = tidx() >> 6;
    const int nw = gridDim.x * 4;
    bf16_t* hn = (bf16_t*)p.out;
    bf16_t* xb = (bf16_t*)(p.ws + WS_XB);
    const bf16_t* y0 = (const bf16_t*)(p.ws + WS_YS);
    const bf16_t* y1 = y0 + (size_t)T * 1024;
    float4 gq[4];
#pragma unroll
    for (int i = 0; i < 4; ++i) gq[i] = *(const float4*)(gain + i * 256 + lane * 4);
    for (int t = bidx() * 4 + wid; t < T; t += nw) {
        float4 v[4];
        float ss = 0.f;
#pragma unroll
        for (int i = 0; i < 4; ++i) {
            const size_t off = (size_t)t * 1024 + i * 256 + lane * 4;
            if (MODE == 0) v[i] = *(const float4*)(p.in[I_X] + off);
            else { const u32x2 xx = *(const u32x2*)(xb + off); v[i].x = __uint_as_float(xx.x << 16); v[i].y = __uint_as_float(xx.x & 0xffff0000u); v[i].z = __uint_as_float(xx.y << 16); v[i].w = __uint_as_float(xx.y & 0xffff0000u); }
            if (MODE == 1 || MODE == 3) {
                const u32x2 a = *(const u32x2*)(y0 + off), b = *(const u32x2*)(y1 + off);
                v[i].x += __uint_as_float(a.x << 16) + __uint_as_float(b.x << 16); v[i].y += __uint_as_float(a.x & 0xffff0000u) + __uint_as_float(b.x & 0xffff0000u);
                v[i].z += __uint_as_float(a.y << 16) + __uint_as_float(b.y << 16); v[i].w += __uint_as_float(a.y & 0xffff0000u) + __uint_as_float(b.y & 0xffff0000u);
            }
            ss += v[i].x * v[i].x + v[i].y * v[i].y + v[i].z * v[i].z + v[i].w * v[i].w;
        }
        ss = wave_sum(ss);
        const float rstd = rsqrtf(ss * (1.0f / 1024.0f) + 1e-6f);
        float lg[20];
        if (MODE == 2) {
#pragma unroll
            for (int q = 0; q < 20; ++q) lg[q] = 0.f;
        }
#pragma unroll
        for (int i = 0; i < 4; ++i) {
            const int col = i * 256 + lane * 4;
            const size_t off = (size_t)t * 1024 + col;
            const float4 g = gq[i];
            float4 h; h.x = v[i].x * rstd * g.x; h.y = v[i].y * rstd * g.y; h.z = v[i].z * rstd * g.z; h.w = v[i].w * rstd * g.w;
            bf16_t* hd = hn + off;
            if (MODE == 0 || MODE == 1) { u32x2 w; w.x = pack2(v[i].x, v[i].y); w.y = pack2(v[i].z, v[i].w); *(u32x2*)(xb + off) = w; }
            if (MODE == 3) *(float4*)(p.out + off) = h;
            else { u32x2 w; w.x = pack2(h.x, h.y); w.y = pack2(h.z, h.w); *(u32x2*)hd = w; }
            if (MODE == 2) {
                const float hh[4] = {h.x, h.y, h.z, h.w};
                const float* wg = p.in[I_WGROUP] + (size_t)layer * 1024 * 4;
                const float* we = p.in[I_WEXPERT] + (size_t)layer * 4 * 1024 * 4;
#pragma unroll
                for (int e = 0; e < 4; ++e) {
                    const float4 a = *(const float4*)(wg + (size_t)(col + e) * 4);
                    lg[0] += hh[e] * a.x; lg[1] += hh[e] * a.y; lg[2] += hh[e] * a.z; lg[3] += hh[e] * a.w;
#pragma unroll
                    for (int g2 = 0; g2 < 4; ++g2) {
                        const float4 b = *(const float4*)(we + ((size_t)g2 * 1024 + col + e) * 4);
                        lg[4 + g2 * 4 + 0] += hh[e] * b.x; lg[4 + g2 * 4 + 1] += hh[e] * b.y; lg[4 + g2 * 4 + 2] += hh[e] * b.z; lg[4 + g2 * 4 + 3] += hh[e] * b.w;
                    }
                }
            }
        }
        if (MODE == 2) {
#pragma unroll
            for (int q = 0; q < 20; ++q) lg[q] = wave_sum(lg[q]);
            if (lane == 0) {
                int gs = 0; float gm = lg[0];
#pragma unroll
                for (int g2 = 1; g2 < 4; ++g2) if (lg[g2] > gm) { gm = lg[g2]; gs = g2; }
                float den = 0.f;
#pragma unroll
                for (int g2 = 0; g2 < 4; ++g2) den += __expf(lg[g2] - gm);
                const float pg = 1.f / den;
                float el[4];
#pragma unroll
                for (int e = 0; e < 4; ++e) el[e] = gs == 0 ? lg[4 + e] : gs == 1 ? lg[8 + e] : gs == 2 ? lg[12 + e] : lg[16 + e];
                int i1 = 0; float v1 = el[0];
#pragma unroll
                for (int e = 1; e < 4; ++e) if (el[e] > v1) { v1 = el[e]; i1 = e; }
                int i2 = 0; float v2 = -3.4e38f;
#pragma unroll
                for (int e = 0; e < 4; ++e) if (e != i1 && el[e] > v2) { v2 = el[e]; i2 = e; }
                const float e2 = __expf(v2 - v1);
                const float g1 = pg / (1.f + e2), g2v = pg * e2 / (1.f + e2);
                unsigned* cnt = (unsigned*)(p.ws + WS_CTL + CTL_CNT) + layer * 16 * 64;
                int* list = (int*)(p.ws + WS_LIST);
                float* gl = (float*)(p.ws + WS_GATE);
                const int ea = gs * 4 + i1, eb = gs * 4 + i2;
                const unsigned ra = atomicAdd(&cnt[ea * 64], 1u);
                list[ea * 16384 + ra] = t * 2; gl[ea * 16384 + ra] = g1;
                const unsigned rb = atomicAdd(&cnt[eb * 64], 1u);
                list[eb * 16384 + rb] = t * 2 + 1; gl[eb * 16384 + rb] = g2v;
            }
        }
    }
}


typedef __attribute__((address_space(3))) unsigned lds_u32;
DI void g_dma(unsigned m0v, unsigned voff, const char* sbase) {
    asm volatile("s_mov_b32 m0, %0\n\ts_nop 0\n\tglobal_load_lds_dwordx4 %1, %2" :: "s"(m0v), "v"(voff), "s"(sbase) : "memory", "m0");
}
DI void phase_router(const P& p, const float* gain, int layer, char* ldsc) {
    const int tid = tidx(), lane = tid & 63, wid = tid >> 6;
    bf16_t* hn = (bf16_t*)p.out;
    const bf16_t* xb = (const bf16_t*)(p.ws + WS_XB);
    const float* wg = p.in[I_WGROUP] + (size_t)layer * 1024 * 4;
    const float* we = p.in[I_WEXPERT] + (size_t)layer * 4 * 1024 * 4;
    unsigned* cnt = (unsigned*)(p.ws + WS_CTL + CTL_CNT) + layer * 16 * 64;
    int* list = (int*)(p.ws + WS_LIST);
    float* gl = (float*)(p.ws + WS_GATE);
    f32x4* WS = (f32x4*)ldsc;
    unsigned* lcnt = (unsigned*)(ldsc + 40960); unsigned* lbase = lcnt + 16; int* e_ent = (int*)(lcnt + 32); unsigned* r_ent = (unsigned*)(e_ent + 32); int* t_ent = (int*)(r_ent + 32); float* g_ent = (float*)(t_ent + 32);
    const unsigned wsb = (unsigned)__builtin_amdgcn_readfirstlane((int)((unsigned)(size_t)(lds_u32*)ldsc + wid * 1024));
    auto stage = [&](int i, int buf) {
        const unsigned voff = (unsigned)(i * 256 + lane * 4 + wid) * 16u;
#pragma unroll
        for (int r = 0; r < 5; ++r) g_dma(wsb + (unsigned)(buf * 1280 + r * 256) * 16u, voff, (const char*)(r == 0 ? wg : we + (size_t)(r - 1) * 4096));
    };
    u32x2 xq[4];
#pragma unroll
    for (int q = 0; q < 4; ++q) xq[q] = *(const u32x2*)(xb + (size_t)(bidx() * 16 + wid * 4 + q) * 1024 + lane * 4);
    for (int tb = bidx() * 16; tb < T; tb += gridDim.x * 16) {
        const int t0 = tb + wid * 4;
        __syncthreads();
        if (tid < 16) lcnt[tid] = 0u;
        stage(0, 0);
        float rstd[4];
        {
            const float pq = ((const float*)(p.ws + WS_SSQ))[(size_t)(lane & 15) * T + t0 + (lane >> 4)];
            float ss = pq;
            ss += __shfl_xor(ss, 1); ss += __shfl_xor(ss, 2); ss += __shfl_xor(ss, 4); ss += __shfl_xor(ss, 8);
#pragma unroll
            for (int q = 0; q < 4; ++q) rstd[q] = rsqrtf(__shfl(ss, q * 16) * (1.0f / 1024.0f) + 1e-6f);
        }
        float lg[4][20];
#pragma unroll
        for (int q = 0; q < 4; ++q)
#pragma unroll
            for (int j = 0; j < 20; ++j) lg[q][j] = 0.f;
        asm volatile("s_waitcnt vmcnt(0)" ::: "memory");
#pragma unroll 1
        for (int i = 0; i < 4; ++i) {
            if (i > 0) asm volatile("s_waitcnt vmcnt(4)" ::: "memory");
            __syncthreads();
            if (i + 1 < 4) stage(i + 1, (i + 1) & 1);
            const f32x4* W = WS + (i & 1) * 1280;
            const int col = i * 256 + lane * 4;
            const float4 g = *(const float4*)(gain + col);
            float hh[4][4];
#pragma unroll
            for (int q = 0; q < 4; ++q) {
                hh[q][0] = __uint_as_float(xq[q].x << 16) * rstd[q] * g.x; hh[q][1] = __uint_as_float(xq[q].x & 0xffff0000u) * rstd[q] * g.y; hh[q][2] = __uint_as_float(xq[q].y << 16) * rstd[q] * g.z; hh[q][3] = __uint_as_float(xq[q].y & 0xffff0000u) * rstd[q] * g.w;
            }
            {
                int tn0 = i + 1 < 4 ? t0 : t0 + (int)gridDim.x * 16; const int cn = ((i + 1) & 3) * 256 + lane * 4;
                tn0 = tn0 < T ? tn0 : t0;
#pragma unroll
                for (int q = 0; q < 4; ++q) xq[q] = *(const u32x2*)(xb + (size_t)(tn0 + q) * 1024 + cn);
            }
#pragma unroll
            for (int q = 0; q < 4; ++q) {
                u32x2 w; w.x = pack2(hh[q][0], hh[q][1]); w.y = pack2(hh[q][2], hh[q][3]);
                *(u32x2*)(hn + (size_t)(t0 + q) * 1024 + col) = w;
            }
#pragma unroll
            for (int e = 0; e < 4; ++e) {
                const f32x4 a = W[(0 * 4 + e) * 64 + lane];
#pragma unroll
                for (int q = 0; q < 4; ++q) { lg[q][0] += hh[q][e] * a[0]; lg[q][1] += hh[q][e] * a[1]; lg[q][2] += hh[q][e] * a[2]; lg[q][3] += hh[q][e] * a[3]; }
#pragma unroll
                for (int g2 = 0; g2 < 4; ++g2) {
                    const f32x4 b = W[((1 + g2) * 4 + e) * 64 + lane];
#pragma unroll
                    for (int q = 0; q < 4; ++q) { lg[q][4 + g2 * 4] += hh[q][e] * b[0]; lg[q][5 + g2 * 4] += hh[q][e] * b[1]; lg[q][6 + g2 * 4] += hh[q][e] * b[2]; lg[q][7 + g2 * 4] += hh[q][e] * b[3]; }
                }
            }
        }
#pragma unroll
        for (int q = 0; q < 4; ++q) {
#pragma unroll
            for (int j = 0; j < 20; ++j) lg[q][j] = wave_sum(lg[q][j]);
            if (lane == q) {
                const int t = t0 + q;
                int gs = 0; float gm = lg[q][0];
#pragma unroll
                for (int g2 = 1; g2 < 4; ++g2) if (lg[q][g2] > gm) { gm = lg[q][g2]; gs = g2; }
                float den = 0.f;
#pragma unroll
                for (int g2 = 0; g2 < 4; ++g2) den += __expf(lg[q][g2] - gm);
                const float pg = 1.f / den;
                float el[4];
#pragma unroll
                for (int e = 0; e < 4; ++e) el[e] = gs == 0 ? lg[q][4 + e] : gs == 1 ? lg[q][8 + e] : gs == 2 ? lg[q][12 + e] : lg[q][16 + e];
                int i1 = 0; float v1 = el[0];
#pragma unroll
                for (int e = 1; e < 4; ++e) if (el[e] > v1) { v1 = el[e]; i1 = e; }
                int i2 = 0; float v2 = -3.4e38f;
#pragma unroll
                for (int e = 0; e < 4; ++e) if (e != i1 && el[e] > v2) { v2 = el[e]; i2 = e; }
                const float e2 = __expf(v2 - v1);
                const float g1 = pg / (1.f + e2), g2v = pg * e2 / (1.f + e2);
                const int ea = gs * 4 + i1, eb = gs * 4 + i2;
                const int sl = (wid * 4 + q) * 2;
                e_ent[sl] = ea; r_ent[sl] = atomicAdd(&lcnt[ea], 1u); t_ent[sl] = t * 2; g_ent[sl] = g1;
                e_ent[sl + 1] = eb; r_ent[sl + 1] = atomicAdd(&lcnt[eb], 1u); t_ent[sl + 1] = t * 2 + 1; g_ent[sl + 1] = g2v;
            }
        }
        __syncthreads();
        if (tid < 16) lbase[tid] = lcnt[tid] ? atomicAdd(&cnt[tid * 64], lcnt[tid]) : 0u;
        __syncthreads();
        if (tid < 32) {
            const int e = e_ent[tid];
            const unsigned pos = (lbase[e] + r_ent[tid]) & 16383u;
            list[e * 16384 + pos] = t_ent[tid]; gl[e * 16384 + pos] = g_ent[tid];
        }
    }
}

constexpr int GBK = 64;
struct TileP { int arow[4]; unsigned bo[4]; };
struct GOps { const char* A; unsigned la; const char* A2; unsigned la2; const char* B; };
DI void gemm_core(const GOps& o, const TileP& tp, int K, char* lds, f32x4 (&acc)[4][4], int ksplit, bool primed, const TileP& nx, bool have_nx) {
    const int tid = tidx(), wid = tid >> 6, lane = tid & 63, wr = wid >> 1, wc = wid & 1, fr = lane & 15, fq = lane >> 4;
    const unsigned scol = ((tid & 7) ^ ((tid >> 3) & 7)) * 16;
#pragma unroll
    for (int n = 0; n < 4; ++n)
#pragma unroll
        for (int m = 0; m < 4; ++m) acc[n][m] = (f32x4){0.f, 0.f, 0.f, 0.f};
    const int nk = K / GBK;
    if (!primed) {
        __syncthreads();
#pragma unroll
        for (int i = 0; i < 4; ++i) {
            __builtin_amdgcn_global_load_lds((const unsigned*)(o.A + (__umul24(tp.arow[i], o.la) + scol)), (lds_u32*)(lds + tid * 16 + i * 4096), 16, 0, 0);
            __builtin_amdgcn_global_load_lds((const unsigned*)(o.B + (tp.bo[i] + scol)), (lds_u32*)(lds + 16384 + tid * 16 + i * 4096), 16, 0, 0);
        }
    }
    const int sw = fr & 7;
    const unsigned aoff = (wr * 64 + fr) * 128, boff = (wc * 64 + fr) * 128, co0 = (fq ^ sw) * 16, co1 = ((4 + fq) ^ sw) * 16;
    bf16x8 a0[4], b0[4], a1[4], b1[4];
#define G_ISSUE(kt_)                                                                                                                        \
    if ((kt_) + 1 < nk) {                                                                                                                   \
        char* nb = lds + (((kt_) + 1) & 1) * 32768;                                                                                         \
        const unsigned ko = ((kt_) + 1) * (GBK * 2) + scol;                                                                                 \
        const bool hi = ((kt_) + 1) * GBK >= ksplit;                                                                                        \
        const char* Ab = hi ? o.A2 : o.A; const unsigned la = hi ? o.la2 : o.la;                                                            \
        _Pragma("unroll") for (int i = 0; i < 4; ++i) {                                                                                     \
            __builtin_amdgcn_global_load_lds((const unsigned*)(Ab + (__umul24(tp.arow[i], la) + ko)), (lds_u32*)(nb + tid * 16 + i * 4096), 16, 0, 0);   \
            __builtin_amdgcn_global_load_lds((const unsigned*)(o.B + (tp.bo[i] + ko)), (lds_u32*)(nb + 16384 + tid * 16 + i * 4096), 16, 0, 0);      \
        }                                                                                                                                   \
    } else if (have_nx) {        \
        _Pragma("unroll") for (int i = 0; i < 4; ++i) {                                                                                     \
            __builtin_amdgcn_global_load_lds((const unsigned*)(o.A + (__umul24(nx.arow[i], o.la) + scol)), (lds_u32*)(lds + tid * 16 + i * 4096), 16, 0, 0);          \
            __builtin_amdgcn_global_load_lds((const unsigned*)(o.B + (nx.bo[i] + scol)), (lds_u32*)(lds + 16384 + tid * 16 + i * 4096), 16, 0, 0);  \
        }                                                                                                                                   \
    }
#define G_READ(A_, B_, AD_)                                                                                                                 \
    asm volatile("ds_read_b128 %0, %8\n\tds_read_b128 %1, %8 offset:2048\n\tds_read_b128 %2, %8 offset:4096\n\tds_read_b128 %3, %8 offset:6144\n\t"       \
                 "ds_read_b128 %4, %9 offset:16384\n\tds_read_b128 %5, %9 offset:18432\n\tds_read_b128 %6, %9 offset:20480\n\tds_read_b128 %7, %9 offset:22528" \
                 : "=&v"(A_[0]), "=&v"(A_[1]), "=&v"(A_[2]), "=&v"(A_[3]), "=&v"(B_[0]), "=&v"(B_[1]), "=&v"(B_[2]), "=&v"(B_[3]) : "v"((AD_) + aoff), "v"((AD_) + boff) : "memory");
#define G_WAIT(A_, B_, N_)                                                                                                                  \
    asm volatile("s_waitcnt lgkmcnt(" #N_ ")" : "+v"(A_[0]), "+v"(A_[1]), "+v"(A_[2]), "+v"(A_[3]), "+v"(B_[0]), "+v"(B_[1]), "+v"(B_[2]), "+v"(B_[3]) :: "memory");
#define G_MMA(A_, B_)                                                                                                                       \
    _Pragma("unroll") for (int n = 0; n < 4; ++n)                                                                                           \
        _Pragma("unroll") for (int m = 0; m < 4; ++m) acc[n][m] = __builtin_amdgcn_mfma_f32_16x16x32_bf16(B_[n], A_[m], acc[n][m], 0, 0, 0);
    const unsigned lbase = (unsigned)(size_t)(lds_u32*)lds;
    __builtin_amdgcn_s_waitcnt(0x0070);
    __builtin_amdgcn_s_barrier();
    G_ISSUE(0)
    G_READ(a0, b0, lbase + co0)
    G_READ(a1, b1, lbase + co1)
    G_WAIT(a0, b0, 8)
    __builtin_amdgcn_sched_barrier(0);
    G_MMA(a0, b0)
    __builtin_amdgcn_sched_barrier(0);
    G_WAIT(a1, b1, 0)
#pragma unroll 1
    for (int kt = 1; kt < nk; ++kt) {
        __builtin_amdgcn_s_waitcnt(0x0070);
        __builtin_amdgcn_s_barrier();
        G_ISSUE(kt)
        const unsigned S = lbase + (kt & 1) * 32768;
        G_READ(a0, b0, S + co0)
        __builtin_amdgcn_sched_barrier(0);
        G_MMA(a1, b1)
        __builtin_amdgcn_sched_barrier(0);
        G_READ(a1, b1, S + co1)
        G_WAIT(a0, b0, 8)
        __builtin_amdgcn_sched_barrier(0);
        G_MMA(a0, b0)
        __builtin_amdgcn_sched_barrier(0);
        G_WAIT(a1, b1, 0)
    }
    G_MMA(a1, b1)
#undef G_ISSUE
#undef G_READ
#undef G_WAIT
#undef G_MMA
}

enum { EPI_EVEN_IN = 0, EPI_ODD_IN, EPI_RESID };
template <int EPI>
DI void phase_gemm(const P& p, const bf16_t* A, int lda, const bf16_t* Bt, int K, int ntn, char* lds, bool dry = false, const bf16_t* A2 = nullptr, int lda2 = 0, int ksplit = 1 << 30) {
    const int tid = tidx(), wid = tid >> 6, lane = tid & 63, wr = wid >> 1, wc = wid & 1, fr = lane & 15, fq = lane >> 4;
    const int ntm = T / 128, ntiles = ntm * ntn;
    auto fill = [&](TileP& t, int tile) {
        const int tn = tile / ntm, tm = tile % ntm, r = tid >> 3;
#pragma unroll
        for (int i = 0; i < 4; ++i) { t.arow[i] = tm * 128 + r + 32 * i; t.bo[i] = (unsigned)(tn * 128 + r + 32 * i) * (unsigned)(K * 2); }
    };
    const GOps gop{(const char*)A, (unsigned)lda * 2u, (const char*)(A2 ? A2 : A), (unsigned)(A2 ? lda2 : lda) * 2u, (const char*)Bt};
    TileP cur, nxt;
    bool primed = false;
    fill(cur, bidx() < ntiles ? bidx() : 0); nxt = cur;
    for (int tile = bidx(); tile < ntiles; tile += gridDim.x) {
        const int tn = tile / ntm, tm = tile % ntm;
        const bool have_next = tile + (int)gridDim.x < ntiles;
        if (have_next) fill(nxt, tile + gridDim.x);
        f32x4 acc[4][4];
        gemm_core(gop, cur, K, lds, acc, ksplit, primed, nxt, have_next);
        primed = have_next; cur = nxt;
        const int m0 = tm * 128 + wr * 64, n0 = tn * 128 + wc * 64;
        if (EPI == EPI_EVEN_IN) {
            bf16_t* C = (bf16_t*)(p.ws + WS_PROJ);
#pragma unroll
            for (int m = 0; m < 4; ++m)
#pragma unroll
                for (int n = 0; n < 4; ++n) {
                    const int row = m0 + m * 16 + fr, col = n0 + n * 16 + fq * 4;
                    if (col < EVC) { u32x2 w; w.x = pack2(acc[n][m][0], acc[n][m][1]); w.y = pack2(acc[n][m][2], acc[n][m][3]); *(u32x2*)(C + (size_t)row * EVLD + col) = w; }
                }
        } else if (EPI == EPI_ODD_IN) {
            bf16_t* C = (bf16_t*)(p.ws + WS_QK);
            const float2* tab = (const float2*)(p.ws + WS_ROPE);
            if (n0 < 3072) {
#pragma unroll
                for (int m = 0; m < 4; ++m) {
                    const int row = m0 + m * 16 + fr;
#pragma unroll
                    for (int n = 0; n < 2; ++n) {
                        float lo[4], hi[4];
#pragma unroll
                        for (int j = 0; j < 4; ++j) {
                            const float2 cs = tab[(size_t)row * 32 + n * 16 + fq * 4 + j];
                            const float x1 = acc[n][m][j], x2 = acc[n + 2][m][j];
                            lo[j] = x1 * cs.x - x2 * cs.y; hi[j] = x2 * cs.x + x1 * cs.y;
                        }
                        u32x2 w; w.x = pack2(lo[0], lo[1]); w.y = pack2(lo[2], lo[3]);
                        *(u32x2*)(C + (size_t)row * 3072 + n0 + n * 16 + fq * 4) = w;
                        w.x = pack2(hi[0], hi[1]); w.y = pack2(hi[2], hi[3]);
                        *(u32x2*)(C + (size_t)row * 3072 + n0 + (n + 2) * 16 + fq * 4) = w;
                    }
                }
            }
            if (tn * 128 >= 3072) {
                bf16_t* VT = (bf16_t*)(p.ws + WS_VT);
                const int hg0 = (tn * 128 - 3072) >> 6, g = hg0 >> 3, lg2 = g * 2, dil = 1 << lg2, L = SEQ >> lg2, run = 128 >> lg2;
                __syncthreads();
#pragma unroll
                for (int m = 0; m < 4; ++m)
#pragma unroll
                    for (int n = 0; n < 4; ++n)
#pragma unroll
                        for (int j = 0; j < 4; ++j)
                            *(bf16_t*)(lds + 32768 + (wc * 64 + n * 16 + fq * 4 + j) * 272 + (wr * 64 + m * 16 + fr) * 2) = f2bf(acc[n][m][j]);
                __syncthreads();
                const int bb = (tm * 128) >> 12, s0 = (tm * 128) & (SEQ - 1);
#pragma unroll
                for (int q = 0; q < 8; ++q) {
                    const int item = tid + q * 256, dim = item >> 4, o0 = (item & 15) * 8;
                    const int rr = o0 / run, i0 = o0 % run;
                    const char* src = lds + 32768 + dim * 272 + (rr + dil * i0) * 2;
                    float e8[8];
#pragma unroll
                    for (int e = 0; e < 8; ++e) e8[e] = bf2f(*(const bf16_t*)(src + e * dil * 2));
                    u32x4 w; w.x = pack2(e8[0], e8[1]); w.y = pack2(e8[2], e8[3]); w.z = pack2(e8[4], e8[5]); w.w = pack2(e8[6], e8[7]);
                    const int hg = hg0 + (dim >> 6);
                    *(u32x4*)(VT + ((size_t)((bb * 24 + hg) * dil + rr) * 64 + (dim & 63)) * L + (s0 >> lg2) + i0) = w;
                }
            }
        } else {
            float* ssq = (float*)(p.ws + WS_SSQ) + (size_t)(tn * 2 + wc) * T;
#pragma unroll
            for (int m = 0; m < 4; ++m) {
                float ss = 0.f;
#pragma unroll
                for (int n = 0; n < 4; ++n) {
                    const size_t qo = (size_t)(m0 + m * 16 + fr) * 1024 + n0 + n * 16 + fq * 4;
                    bf16_t* q = dry ? (bf16_t*)(p.ws + WS_DUMMY) + (qo & 0x7FFFF) : (bf16_t*)(p.ws + WS_XB) + qo;
                    const u32x2 xx = *(const u32x2*)q;
                    float4 v;
                    v.x = __uint_as_float(xx.x << 16) + acc[n][m][0]; v.y = __uint_as_float(xx.x & 0xffff0000u) + acc[n][m][1]; v.z = __uint_as_float(xx.y << 16) + acc[n][m][2]; v.w = __uint_as_float(xx.y & 0xffff0000u) + acc[n][m][3];
                    u32x2 w; w.x = pack2(v.x, v.y); w.y = pack2(v.z, v.w);
                    *(u32x2*)q = w;
                    ss += v.x * v.x + v.y * v.y + v.z * v.z + v.w * v.w;
                }
                ss += __shfl_xor(ss, 16); ss += __shfl_xor(ss, 32);
                if (fq == 0 && !dry) ssq[m0 + m * 16 + fr] = ss;
            }
        }
    }
}

DI void phase_moe_up(const P& p, int layer, char* lds) {
    const int tid = tidx(), wid = tid >> 6, lane = tid & 63, wr = wid >> 1, wc = wid & 1, fr = lane & 15, fq = lane >> 4;
    const unsigned* cntb = (const unsigned*)(p.ws + WS_CTL + CTL_CNT) + layer * 16 * 64;
    unsigned cnt[16];
#pragma unroll
    for (int e = 0; e < 16; ++e) cnt[e] = cntb[e * 64];
    const int* list = (const int*)(p.ws + WS_LIST);
    const float* gl = (const float*)(p.ws + WS_GATE);
    const bf16_t* hn = (const bf16_t*)p.out;
    const bf16_t* W13 = (const bf16_t*)(p.ws + WS_W + W_13);
    bf16_t* H = (bf16_t*)(p.ws + WS_H);
    int ttot = 0;
#pragma unroll
    for (int e = 0; e < 16; ++e) ttot += ((int)cnt[e] + 127) >> 7;
    const int ntiles = ttot * 4;
    auto locate = [&](int tile, int& e, int& lt, int& ce, int& rbe, int& tn) {
        const int mt = tile >> 2; tn = tile & 3;
        int tbe = 0, acc_t = 0; e = 0;
#pragma unroll
        for (int q = 0; q < 16; ++q) { const int nt = ((int)cnt[q] + 127) >> 7; if (mt >= acc_t) { e = q; tbe = acc_t; } acc_t += nt; }
        lt = mt - tbe; ce = (int)cnt[e]; rbe = tbe * 128;
    };
    auto fill = [&](TileP& t, int tile) {
        int e, lt, ce, rbe, tn; locate(tile, e, lt, ce, rbe, tn);
        const int r = tid >> 3;
#pragma unroll
        for (int i = 0; i < 4; ++i) {
            const int ii = lt * 128 + r + 32 * i;
            const int tk = ii < ce ? (list[e * 16384 + ii] >> 1) : 0;
            t.arow[i] = tk;
            t.bo[i] = (unsigned)(e * 512 + tn * 128 + r + 32 * i) * 2048u;
        }
    };
    const GOps gop{(const char*)hn, 2048u, (const char*)hn, 2048u, (const char*)W13};
    TileP cur, nxt;
    bool primed = false;
    fill(cur, bidx() < ntiles ? bidx() : 0); nxt = cur;
    for (int tile = bidx(); tile < ntiles; tile += gridDim.x) {
        int e, lt, ce, rbe, tn; locate(tile, e, lt, ce, rbe, tn);
        const bool have_next = tile + (int)gridDim.x < ntiles;
        if (have_next) fill(nxt, tile + gridDim.x);
        f32x4 acc[4][4];
        gemm_core(gop, cur, 1024, lds, acc, 1 << 30, primed, nxt, have_next);
        primed = have_next; cur = nxt;
#pragma unroll
        for (int m = 0; m < 4; ++m) {
            const int li = lt * 128 + wr * 64 + m * 16 + fr;
            if (li < ce) {
                const float g = gl[e * 16384 + li];
                bf16_t* hrow = H + (size_t)(rbe + li) * 256;
#pragma unroll
                for (int n = 0; n < 4; n += 2) {
                    float o[4];
#pragma unroll
                    for (int j = 0; j < 4; ++j) o[j] = siluf_(acc[n][m][j]) * acc[n + 1][m][j] * g;
                    const int f = tn * 64 + wc * 32 + (n >> 1) * 16 + fq * 4;
                    u32x2 w; w.x = pack2(o[0], o[1]); w.y = pack2(o[2], o[3]);
                    *(u32x2*)(hrow + f) = w;
                }
            }
        }
    }
}
DI void phase_moe_down(const P& p, int layer, char* lds) {
    const int tid = tidx(), wid = tid >> 6, lane = tid & 63, wr = wid >> 1, wc = wid & 1, fr = lane & 15, fq = lane >> 4;
    const unsigned* cntb = (const unsigned*)(p.ws + WS_CTL + CTL_CNT) + layer * 16 * 64;
    unsigned cnt[16];
#pragma unroll
    for (int e = 0; e < 16; ++e) cnt[e] = cntb[e * 64];
    const int* list = (const int*)(p.ws + WS_LIST);
    const bf16_t* W2 = (const bf16_t*)(p.ws + WS_W + W_2);
    const bf16_t* H = (const bf16_t*)(p.ws + WS_H);
    bf16_t* ys = (bf16_t*)(p.ws + WS_YS);
    int ttot = 0;
#pragma unroll
    for (int e = 0; e < 16; ++e) ttot += ((int)cnt[e] + 127) >> 7;
    const int ntiles = ttot * 8;
    auto locate = [&](int tile, int& e, int& lt, int& ce, int& rbe, int& tn) {
        const int mt = tile >> 3; tn = tile & 7;
        int tbe = 0, acc_t = 0; e = 0;
#pragma unroll
        for (int q = 0; q < 16; ++q) { const int nt = ((int)cnt[q] + 127) >> 7; if (mt >= acc_t) { e = q; tbe = acc_t; } acc_t += nt; }
        lt = mt - tbe; ce = (int)cnt[e]; rbe = tbe * 128;
    };
    auto fill = [&](TileP& t, int tile) {
        int e, lt, ce, rbe, tn; locate(tile, e, lt, ce, rbe, tn);
        const int r = tid >> 3;
#pragma unroll
        for (int i = 0; i < 4; ++i) { t.arow[i] = rbe + lt * 128 + r + 32 * i; t.bo[i] = (unsigned)(e * 1024 + tn * 128 + r + 32 * i) * 512u; }
    };
    const GOps gop{(const char*)H, 512u, (const char*)H, 512u, (const char*)W2};
    TileP cur, nxt;
    bool primed = false;
    fill(cur, bidx() < ntiles ? bidx() : 0); nxt = cur;
    for (int tile = bidx(); tile < ntiles; tile += gridDim.x) {
        int e, lt, ce, rbe, tn; locate(tile, e, lt, ce, rbe, tn);
        const bool have_next = tile + (int)gridDim.x < ntiles;
        if (have_next) fill(nxt, tile + gridDim.x);
        f32x4 acc[4][4];
        gemm_core(gop, cur, 256, lds, acc, 1 << 30, primed, nxt, have_next);
        primed = have_next; cur = nxt;
#pragma unroll
        for (int m = 0; m < 4; ++m) {
            const int li = lt * 128 + wr * 64 + m * 16 + fr;
            if (li < ce) {
                const int ts = list[e * 16384 + li];
                bf16_t* yrow = ys + ((size_t)(ts & 1) * T + (ts >> 1)) * 1024 + tn * 128 + wc * 64 + fq * 4;
#pragma unroll
                for (int n = 0; n < 4; ++n) { u32x2 w; w.x = pack2(acc[n][m][0], acc[n][m][1]); w.y = pack2(acc[n][m][2], acc[n][m][3]); *(u32x2*)(yrow + n * 16) = w; }
            }
        }
    }
}


typedef float f32x16 __attribute__((ext_vector_type(16)));
DI f32x4 mfma16(bf16x8 a, bf16x8 b, f32x4 c) { return __builtin_amdgcn_mfma_f32_16x16x32_bf16(a, b, c, 0, 0, 0); }
DI f32x16 mfma32(bf16x8 a, bf16x8 b, f32x16 c) { return __builtin_amdgcn_mfma_f32_32x32x16_bf16(a, b, c, 0, 0, 0); }
DI f32x4 tile16(const char* X, int ldx, int row0, const char* Y, int ldy, int col0, int K) {
    const int lane = tidx() & 63, fr = lane & 15, fq = lane >> 4;
    f32x4 acc = {0.f, 0.f, 0.f, 0.f};
#pragma unroll
    for (int k = 0; k < K; k += 32) {
        const bf16x8 a = *(const bf16x8*)(X + (row0 + fr) * ldx + (k + fq * 8) * 2);
        const bf16x8 b = *(const bf16x8*)(Y + (col0 + fr) * ldy + (k + fq * 8) * 2);
        acc = mfma16(a, b, acc);
    }
    return acc;
}
DI bf16x8 pack_step(const f32x16& x, int s) {
    u32x4 r;
    r.x = pack2(x[8 * s + 0], x[8 * s + 1]); r.y = pack2(x[8 * s + 2], x[8 * s + 3]);
    r.z = pack2(x[8 * s + 4], x[8 * s + 5]); r.w = pack2(x[8 * s + 6], x[8 * s + 7]);
    return __builtin_bit_cast(bf16x8, r);
}

constexpr int GP_LF = 0, GP_T = 17408, GP_VEC = GP_T + 9216, GP_U = GP_VEC + 1024, GP_END = GP_U + 36864;
DI void gdn_prep_unit(const P& p, int li, int ch, char* lds) {
    const int tid = tidx(), lane = tid & 63, wid = tid >> 6, fr = lane & 15, fq = lane >> 4;
    const int h = ch & 3, n = (ch >> 2) & 63, b = ch >> 8;
    const int t0 = b * SEQ + n * 64;
    float* Lf = (float*)(lds + GP_LF);
    char* Trow = lds + GP_T;
    float* gcs = (float*)(lds + GP_VEC); float* egc = gcs + 64; float* bet = gcs + 128; float* ekd = gcs + 192;
    char* Qrow = lds + GP_U; char* Krow = Qrow + 17408; char* VbT = lds + GP_U; char* KbgT = VbT + 18432;
    const bf16_t* proj = (const bf16_t*)(p.ws + WS_PROJ);
    unsigned char* ops = p.ws + WS_GOPS + (size_t)ch * GOPS_CH;
    const float* cw = p.in[I_CONVW] + (size_t)li * 4 * 1536;
    const int c = tid >> 2, cq = tid & 3;
    __syncthreads();
    float* cwl = (float*)(lds + GP_END);
    for (int i = tid; i < 4 * 3 * 32; i += 256) {
        const int j = i / 96, r = i % 96, sl = r >> 5, q4 = (r & 31) * 4;
        *(f32x4*)(cwl + (j * 3 + sl) * 128 + q4) = *(const f32x4*)(cw + j * 1536 + sl * 512 + h * 128 + q4);
    }
    __syncthreads();
    unsigned vvp[16];
#pragma unroll 1
    for (int which = 0; which < 3; ++which) {
        const int col0 = which * 512 + h * 128 + cq * 32;
        u32x4 xin[4][4];
#pragma unroll
        for (int j = 0; j < 4; ++j) {
            const int sp = n * 64 + c - 3 + j;
            const bf16_t* src = proj + (size_t)(b * SEQ + (sp < 0 ? 0 : sp)) * EVLD + col0;
#pragma unroll
            for (int i4 = 0; i4 < 4; ++i4) xin[j][i4] = *(const u32x4*)(src + i4 * 8);
        }
        float acc[32];
#pragma unroll
        for (int i = 0; i < 32; ++i) acc[i] = 0.f;
#pragma unroll
        for (int j = 0; j < 4; ++j) {
            const float ok = (n * 64 + c - 3 + j) >= 0 ? 1.f : 0.f;
            const float* wj = cwl + (j * 3 + which) * 128 + cq * 32;
#pragma unroll
            for (int i4 = 0; i4 < 4; ++i4) {
                const f32x4 wa = *(const f32x4*)(wj + i4 * 8), wb = *(const f32x4*)(wj + i4 * 8 + 4);
                const u32x4 w = xin[j][i4];
                acc[i4 * 8 + 0] += ok * wa[0] * __uint_as_float(w[0] << 16); acc[i4 * 8 + 1] += ok * wa[1] * __uint_as_float(w[0] & 0xffff0000u);
                acc[i4 * 8 + 2] += ok * wa[2] * __uint_as_float(w[1] << 16); acc[i4 * 8 + 3] += ok * wa[3] * __uint_as_float(w[1] & 0xffff0000u);
                acc[i4 * 8 + 4] += ok * wb[0] * __uint_as_float(w[2] << 16); acc[i4 * 8 + 5] += ok * wb[1] * __uint_as_float(w[2] & 0xffff0000u);
                acc[i4 * 8 + 6] += ok * wb[2] * __uint_as_float(w[3] << 16); acc[i4 * 8 + 7] += ok * wb[3] * __uint_as_float(w[3] & 0xffff0000u);
            }
        }
        float ss = 0.f;
#pragma unroll
        for (int i = 0; i < 32; ++i) { acc[i] = siluf_(acc[i]); ss += acc[i] * acc[i]; }
        ss += __shfl_xor(ss, 1); ss += __shfl_xor(ss, 2);
        const float rn = which == 2 ? 1.f : rsqrtf(ss + 1e-6f) * (which == 0 ? 0.08838834764831845f : 1.f);
        unsigned pk[16];
#pragma unroll
        for (int i = 0; i < 16; ++i) pk[i] = pack2(acc[2 * i] * rn, acc[2 * i + 1] * rn);
        if (which < 2) {
            char* img = which == 0 ? Qrow : Krow;
#pragma unroll
            for (int i4 = 0; i4 < 4; ++i4) { u32x4 w; w.x = pk[i4 * 4]; w.y = pk[i4 * 4 + 1]; w.z = pk[i4 * 4 + 2]; w.w = pk[i4 * 4 + 3]; *(u32x4*)(img + c * 272 + (cq * 32 + i4 * 8) * 2) = w; }
        } else {
#pragma unroll
            for (int i = 0; i < 16; ++i) vvp[i] = pk[i];
        }
    }
    if (cq == 0) {
        const float a = bf2f(proj[(size_t)(t0 + c) * EVLD + 2048 + h]);
        const float bb = bf2f(proj[(size_t)(t0 + c) * EVLD + 2052 + h]);
        const float Aexp = __expf(p.in[I_ALOG][li * 4 + h]), dtb = p.in[I_DTB][li * 4 + h];
        gcs[c] = -Aexp * softplusf_(a + dtb);
        bet[c] = sigmoidf_(bb);
    }
    __syncthreads();
    if (wid == 0) {
        float x = gcs[lane];
#pragma unroll
        for (int o = 1; o < 64; o <<= 1) { const float y = __shfl_up(x, o); if (lane >= o) x += y; }
        const float gl = __shfl(x, 63);
        gcs[lane] = x; egc[lane] = __expf(x); ekd[lane] = __expf(gl - x);
        if (lane == 63) ((float*)(p.ws + WS_CTL + CTL_EGL))[ch] = __expf(gl);
    }
    __syncthreads();
    {
        const int ti = wid;
#pragma unroll
        for (int tj = 0; tj < 4; ++tj) {
            if (tj <= ti) {
                const f32x4 kk = tile16(Krow, 272, 16 * ti, Krow, 272, 16 * tj, 128);
                const int c2 = 16 * tj + fr;
                f32x4 lv;
#pragma unroll
                for (int r = 0; r < 4; ++r) {
                    const int c1 = 16 * ti + fq * 4 + r;
                    lv[r] = (c1 > c2) ? bet[c1] * kk[r] * __expf(gcs[c1] - gcs[c2]) : 0.f;
                }
                *(f32x4*)&Lf[c2 * 68 + 16 * ti + fq * 4] = lv;
            }
            f32x4 qk = {0.f, 0.f, 0.f, 0.f};
            if (tj <= ti) qk = tile16(Krow, 272, 16 * tj, Qrow, 272, 16 * ti, 128);
            const int c1 = 16 * ti + fr;
            float o4[4];
#pragma unroll
            for (int r = 0; r < 4; ++r) { const int c2 = 16 * tj + fq * 4 + r; o4[r] = (c1 >= c2) ? qk[r] * __expf(gcs[c1] - gcs[c2]) : 0.f; }
            const int mt = c1 >> 5, rr = c1 & 31, hh = fq & 1, jg = fq >> 1;
            u32x2 w; w.x = pack2(o4[0], o4[1]); w.y = pack2(o4[2], o4[3]);
            *(u32x2*)(ops + GO_AF + ((size_t)((mt * 4 + tj) * 64 + hh * 32 + rr) * 8 + jg * 4) * 2) = w;
        }
#pragma unroll
        for (int i = 0; i < 4; ++i) {
            const int idx = tid + i * 256;
            {
                const int mt = idx >> 9, ks = (idx >> 6) & 7, l2 = idx & 63, rr = l2 & 31, hh = l2 >> 5, cc = 32 * mt + rr;
                const float sc = egc[cc];
                const u32x2 lo = *(const u32x2*)(Qrow + cc * 272 + (16 * ks + 4 * hh) * 2), hi = *(const u32x2*)(Qrow + cc * 272 + (16 * ks + 8 + 4 * hh) * 2);
                u32x4 w;
                w.x = pack2(__uint_as_float(lo.x << 16) * sc, __uint_as_float(lo.x & 0xffff0000u) * sc); w.y = pack2(__uint_as_float(lo.y << 16) * sc, __uint_as_float(lo.y & 0xffff0000u) * sc);
                w.z = pack2(__uint_as_float(hi.x << 16) * sc, __uint_as_float(hi.x & 0xffff0000u) * sc); w.w = pack2(__uint_as_float(hi.y << 16) * sc, __uint_as_float(hi.y & 0xffff0000u) * sc);
                *(u32x4*)(ops + GO_QF + (size_t)idx * 16) = w;
            }
            {
                const int mt = idx >> 8, ks = (idx >> 6) & 3, l2 = idx & 63, rr = l2 & 31, hh = l2 >> 5, dk = 32 * mt + rr;
                float e8[8];
#pragma unroll
                for (int j = 0; j < 8; ++j) { const int c2 = 16 * ks + 8 * (j >> 2) + 4 * hh + (j & 3); e8[j] = bf2f(*(const bf16_t*)(Krow + c2 * 272 + dk * 2)) * ekd[c2]; }
                u32x4 w; w.x = pack2(e8[0], e8[1]); w.y = pack2(e8[2], e8[3]); w.z = pack2(e8[4], e8[5]); w.w = pack2(e8[6], e8[7]);
                *(u32x4*)(ops + GO_KF + (size_t)idx * 16) = w;
            }
        }
    }
    __syncthreads();
    {
        const float bc = bet[c], bg = bc * egc[c];
        unsigned kvp[16];
#pragma unroll
        for (int i4 = 0; i4 < 4; ++i4) { const u32x4 w = *(const u32x4*)(Krow + c * 272 + (cq * 32 + i4 * 8) * 2); kvp[i4 * 4] = w.x; kvp[i4 * 4 + 1] = w.y; kvp[i4 * 4 + 2] = w.z; kvp[i4 * 4 + 3] = w.w; }
        __syncthreads();
#pragma unroll
        for (int i = 0; i < 16; ++i) {
            *(bf16_t*)(VbT + (cq * 32 + 2 * i) * 144 + c * 2) = f2bf(__uint_as_float(vvp[i] << 16) * bc);
            *(bf16_t*)(VbT + (cq * 32 + 2 * i + 1) * 144 + c * 2) = f2bf(__uint_as_float(vvp[i] & 0xffff0000u) * bc);
            *(bf16_t*)(KbgT + (cq * 32 + 2 * i) * 144 + c * 2) = f2bf(__uint_as_float(kvp[i] << 16) * bg);
            *(bf16_t*)(KbgT + (cq * 32 + 2 * i + 1) * 144 + c * 2) = f2bf(__uint_as_float(kvp[i] & 0xffff0000u) * bg);
        }
    }
    {
        char* L21i = lds + GP_END;
        char* T11T = L21i + 2560;
        char* MT = T11T + 2560;
        if (wid < 2) {
            const int o = 32 * wid;
            float Tc[32];
#pragma unroll
            for (int i = 0; i < 32; ++i) Tc[i] = (i == (lane & 31)) ? 1.f : 0.f;
#pragma unroll
            for (int j = 0; j < 31; ++j) {
                const float tj = Tc[j];
#pragma unroll
                for (int i4 = (j + 1) >> 2; i4 < 8; ++i4) {
                    const f32x4 l4 = *(const f32x4*)&Lf[(o + j) * 68 + o + i4 * 4];
#pragma unroll
                    for (int e = 0; e < 4; ++e) if (i4 * 4 + e > j) Tc[i4 * 4 + e] -= l4[e] * tj;
                }
            }
            if (lane < 32) {
#pragma unroll
                for (int i = 0; i < 32; ++i) *(bf16_t*)(Trow + (o + i) * 144 + (o + lane) * 2) = f2bf(Tc[i]);
                if (wid == 0) {
#pragma unroll
                    for (int i = 0; i < 32; ++i) *(bf16_t*)(Trow + i * 144 + (32 + lane) * 2) = 0;
#pragma unroll
                    for (int i4 = 0; i4 < 8; ++i4) { u32x2 w; w.x = pack2(Tc[i4 * 4], Tc[i4 * 4 + 1]); w.y = pack2(Tc[i4 * 4 + 2], Tc[i4 * 4 + 3]); *(u32x2*)(T11T + lane * 80 + i4 * 8) = w; }
                }
            }
        } else {
            const int t2 = tid - 128;
#pragma unroll
            for (int g2 = 0; g2 < 2; ++g2) {
                const int i = t2 & 31, k4 = ((t2 >> 5) + 4 * g2) * 4;
                u32x2 w;
                w.x = pack2(Lf[(k4 + 0) * 68 + 32 + i], Lf[(k4 + 1) * 68 + 32 + i]); w.y = pack2(Lf[(k4 + 2) * 68 + 32 + i], Lf[(k4 + 3) * 68 + 32 + i]);
                *(u32x2*)(L21i + i * 80 + k4 * 2) = w;
            }
        }
        __syncthreads();
        {
            const int r0 = 16 * (wid >> 1), c0 = 16 * (wid & 1);
            const f32x4 mm = tile16(L21i, 80, r0, T11T, 80, c0, 32);
            u32x2 w; w.x = pack2(mm[0], mm[1]); w.y = pack2(mm[2], mm[3]);
            *(u32x2*)(MT + (c0 + fr) * 80 + (r0 + 4 * fq) * 2) = w;
        }
        __syncthreads();
        {
            const int r0 = 16 * (wid >> 1), c0 = 16 * (wid & 1);
            const f32x4 tt = tile16(MT, 80, c0, Trow + 32 * 144 + 64, 144, r0, 32);
            u32x2 w; w.x = pack2(-tt[0], -tt[1]); w.y = pack2(-tt[2], -tt[3]);
            *(u32x2*)(Trow + (32 + r0 + fr) * 144 + (c0 + 4 * fq) * 2) = w;
        }
    }
    __syncthreads();
#pragma unroll
    for (int tq = 0; tq < 2; ++tq) {
        const int tj = wid * 2 + tq;
#pragma unroll
        for (int ti = 0; ti < 4; ++ti) {
            const f32x4 u = tile16(Trow, 144, 16 * ti, VbT, 144, 16 * tj, 64);
            {
                const int dv = 16 * tj + fr, slice = dv >> 5, rr = dv & 31, cb = 16 * ti + fq * 4, mt = cb >> 5, q4 = (cb & 31) >> 2, hh = q4 & 1, rg = q4 >> 1;
                u32x2 w; w.x = pack2(u[0], u[1]); w.y = pack2(u[2], u[3]);
                *(u32x2*)(ops + GO_UF + ((size_t)((slice * 2 + mt) * 64 + hh * 32 + rr) * 16 + rg * 4) * 2) = w;
            }
            const f32x4 wv = tile16(KbgT, 144, 16 * tj, Trow, 144, 16 * ti, 64);
            {
                const int c1 = 16 * ti + fr, mt = c1 >> 5, rr = c1 & 31, hh = fq & 1, jg = fq >> 1;
                u32x2 w; w.x = pack2(-wv[0], -wv[1]); w.y = pack2(-wv[2], -wv[3]);
                *(u32x2*)(ops + GO_WF + ((size_t)((mt * 8 + tj) * 64 + hh * 32 + rr) * 8 + jg * 4) * 2) = w;
            }
        }
    }
}

DI void glds16(const void* g, char* l) { __builtin_amdgcn_global_load_lds((const unsigned*)g, (lds_u32*)l, 16, 0, 0); }
DI void fr_rd(bf16x8& f, unsigned addr) { asm volatile("ds_read_b128 %0, %1" : "=v"(f) : "v"(addr) : "memory"); }
template <int N> DI void fr_wait(bf16x8& f) { asm volatile("s_waitcnt lgkmcnt(%1)" : "+v"(f) : "n"(N) : "memory"); }
template <int REM> DI void fr_waitc(bf16x8& f) { if (REM >= 3) fr_wait<3>(f); else if (REM == 2) fr_wait<2>(f); else if (REM == 1) fr_wait<1>(f); else fr_wait<0>(f); }
#define GS_WAIT(n) asm volatile("s_waitcnt vmcnt(" #n ")" ::: "memory")
DI void gdn_scan_block(const P& p, int bh, char* lds, bool dry = false) {
    const int tid = tidx(), lane = tid & 63, w = tid >> 6;
    const int h = bh & 3, b = bh >> 2;
    const float eglv = ((const float*)(p.ws + WS_CTL + CTL_EGL))[(b * 64 + lane) * 4 + h];
    unsigned char* gbase = p.ws + WS_GOPS + (size_t)(b * 256 + h) * GOPS_CH;
    auto issue = [&](int n, int k0, int cntk) {
        for (int k = k0; k < k0 + cntk; ++k) {
            const unsigned char* src = gbase + (size_t)n * 4 * GOPS_CH + k * 8192 + tid * 16;
            char* dst = lds + k * 8192 + tid * 16;
            glds16(src, dst); glds16(src + 4096, dst + 4096);
        }
    };
    const unsigned la = (unsigned)(size_t)(lds_u32*)lds + lane * 16;
    f32x16 S[4];
#pragma unroll
    for (int i = 0; i < 4; ++i)
#pragma unroll
        for (int r = 0; r < 16; ++r) S[i][r] = 0.f;
    __syncthreads();
    issue(0, 0, 7);
#pragma unroll 1
    for (int n = 0; n < 64; ++n) {
        const float egl = __shfl(eglv, n);
        bf16x8 Sb[8];
#pragma unroll
        for (int i = 0; i < 4; ++i) { Sb[i * 2] = pack_step(S[i], 0); Sb[i * 2 + 1] = pack_step(S[i], 1); }
        f32x16 av[2], ao[2];
        GS_WAIT(6);
        __builtin_amdgcn_s_barrier();
        issue(n, 7, 2);
        __builtin_amdgcn_sched_barrier(0);
        {
            const char* sl = lds + (w >> 1) * 8192;
#pragma unroll
            for (int mt = 0; mt < 2; ++mt) {
                const u32x4* up = (const u32x4*)(sl + ((w & 1) * 2 + mt) * 2048 + lane * 32);
                const u32x4 u0 = up[0], u1 = up[1];
#pragma unroll
                for (int e = 0; e < 4; ++e) {
                    av[mt][e * 2] = __uint_as_float(u0[e] << 16); av[mt][e * 2 + 1] = __uint_as_float(u0[e] & 0xffff0000u);
                    av[mt][8 + e * 2] = __uint_as_float(u1[e] << 16); av[mt][8 + e * 2 + 1] = __uint_as_float(u1[e] & 0xffff0000u);
                }
            }
        }
        bf16x8 F[4];
#define GS_O0(j) (unsigned)((2 + ((j) & 1)) * 8192 + ((j) >> 1) * 1024)
#pragma unroll
        for (int j = 0; j < 4; ++j) fr_rd(F[j], la + GS_O0(j));
#pragma unroll
        for (int j = 0; j < 16; ++j) {
            if (j <= 12) fr_wait<3>(F[j & 3]); else if (j == 13) fr_wait<2>(F[j & 3]); else if (j == 14) fr_wait<1>(F[j & 3]); else fr_wait<0>(F[j & 3]);
            av[j & 1] = mfma32(F[j & 3], Sb[j >> 1], av[j & 1]);
            if (j + 4 < 16) fr_rd(F[j & 3], la + GS_O0(j + 4));
        }
        bf16x8 Vb[4];
#pragma unroll
        for (int mt = 0; mt < 2; ++mt) { Vb[mt * 2] = pack_step(av[mt], 0); Vb[mt * 2 + 1] = pack_step(av[mt], 1); }
        GS_WAIT(4);
        __builtin_amdgcn_s_barrier();
        if (n < 63) issue(n + 1, 0, 4);
        __builtin_amdgcn_sched_barrier(0);
#pragma unroll
        for (int mt = 0; mt < 2; ++mt)
#pragma unroll
            for (int r = 0; r < 16; ++r) ao[mt][r] = 0.f;
#define GS_O1(j) (unsigned)((j) < 16 ? (4 + ((j) & 1)) * 8192 + ((j) >> 1) * 1024 : 6 * 8192 + ((j) == 16 ? 0 : (j) == 17 ? 4 : (j) == 18 ? 1 : (j) == 19 ? 5 : (j) == 20 ? 6 : 7) * 1024)
#pragma unroll
        for (int j = 0; j < 4; ++j) fr_rd(F[j], la + GS_O1(j));
#pragma unroll
        for (int j = 0; j < 22; ++j) {
            if (j <= 18) fr_wait<3>(F[j & 3]); else if (j == 19) fr_wait<2>(F[j & 3]); else if (j == 20) fr_wait<1>(F[j & 3]); else fr_wait<0>(F[j & 3]);
            if (j < 16) {
                ao[j & 1] = mfma32(F[j & 3], Sb[j >> 1], ao[j & 1]);
                if (j & 1) {
                    const int ks = j >> 1;
#pragma unroll
                    for (int r = 0; r < 8; ++r) S[ks >> 1][(ks & 1) * 8 + r] *= egl;
                }
            } else {
                const int oi = (j == 16 || j == 18) ? 0 : 1, kv = j <= 17 ? 0 : j <= 19 ? 1 : j == 20 ? 2 : 3;
                ao[oi] = mfma32(F[j & 3], Vb[kv], ao[oi]);
            }
            if (j + 4 < 22) fr_rd(F[j & 3], la + GS_O1(j + 4));
        }
        if (n < 63) GS_WAIT(8); else GS_WAIT(0);
        __builtin_amdgcn_s_barrier();
        if (n < 63) issue(n + 1, 4, 3);
        __builtin_amdgcn_sched_barrier(0);
#define GS_O2(j) (unsigned)((7 + (((j) & 3) >> 1)) * 8192 + ((((j) & 3) & 1) * 4 + ((j) >> 2)) * 1024)
#pragma unroll
        for (int j = 0; j < 4; ++j) fr_rd(F[j], la + GS_O2(j));
#pragma unroll
        for (int j = 0; j < 16; ++j) {
            if (j <= 12) fr_wait<3>(F[j & 3]); else if (j == 13) fr_wait<2>(F[j & 3]); else if (j == 14) fr_wait<1>(F[j & 3]); else fr_wait<0>(F[j & 3]);
            S[j & 3] = mfma32(F[j & 3], Vb[j >> 2], S[j & 3]);
            if (j + 4 < 16) fr_rd(F[j & 3], la + GS_O2(j + 4));
        }
        {
            u32x4* Of = (u32x4*)((dry ? p.ws + WS_DUMMY + (size_t)(bh & 15) * 65536 : gbase + (size_t)n * 4 * GOPS_CH) + GO_UF) + (size_t)(w * 2 * 64 + lane) * 2;
#pragma unroll
            for (int mt = 0; mt < 2; ++mt) {
                u32x4 o0, o1;
#pragma unroll
                for (int e = 0; e < 4; ++e) { o0[e] = pack2(ao[mt][e * 2], ao[mt][e * 2 + 1]); o1[e] = pack2(ao[mt][8 + e * 2], ao[mt][8 + e * 2 + 1]); }
                Of[mt * 128] = o0; Of[mt * 128 + 1] = o1;
            }
        }
    }
    __syncthreads();
}

DI void gdn_post_unit(const P& p, int li, int ch) {
    const int tid = tidx();
    const int h = ch & 3, n = (ch >> 2) & 63, b = ch >> 8;
    const int t0 = b * SEQ + n * 64;
    const int c = tid >> 2, cq = tid & 3;
    const bf16_t* Of = (const bf16_t*)(p.ws + WS_GOPS + (size_t)ch * GOPS_CH + GO_UF);
    const bf16_t* proj = (const bf16_t*)(p.ws + WS_PROJ);
    bf16_t* mix = (bf16_t*)(p.ws + WS_PROJ);
    const float* nw = p.in[I_GDNNORM] + li * 128 + cq * 32;
    const int mt = c >> 5, q4 = (c & 31) >> 2, hh = q4 & 1, rg = q4 >> 1, reg = rg * 4 + (c & 3);
    float o[32]; float ss = 0.f;
#pragma unroll
    for (int r = 0; r < 32; ++r) { o[r] = bf2f(Of[(size_t)((cq * 2 + mt) * 64 + hh * 32 + r) * 16 + reg]); ss += o[r] * o[r]; }
    ss += __shfl_xor(ss, 1); ss += __shfl_xor(ss, 2);
    const float rs = rsqrtf(ss * (1.f / 128.f) + 1e-6f);
    const bf16_t* zp = proj + (size_t)(t0 + c) * EVLD + 1536 + h * 128 + cq * 32;
    bf16_t* mp = mix + (size_t)(t0 + c) * EVLD + h * 128 + cq * 32;
#pragma unroll
    for (int i4 = 0; i4 < 4; ++i4) {
        const u32x4 zw = *(const u32x4*)(zp + i4 * 8);
        u32x4 w;
#pragma unroll
        for (int e = 0; e < 4; ++e) {
            const float z0 = __uint_as_float(zw[e] << 16), z1 = __uint_as_float(zw[e] & 0xffff0000u);
            w[e] = pack2(o[i4 * 8 + e * 2] * rs * nw[i4 * 8 + e * 2] * siluf_(z0), o[i4 * 8 + e * 2 + 1] * rs * nw[i4 * 8 + e * 2 + 1] * siluf_(z1));
        }
        *(u32x4*)(mp + i4 * 8) = w;
    }
}


constexpr int RP_Z0 = 0, RP_Z1 = 18432, RP_Z2 = 55296, RP_VEC = 73728, RP_PT = 75008, RP_T11 = 78080, RP_END = 80640;
constexpr int RP_LIN = 0, RP_LW = 25600;
DI void rwkv_prep_unit(const P& p, int li, int ch, char* lds) {
    const int tid = tidx(), lane = tid & 63, wid = tid >> 6, fr = lane & 15, fq = lane >> 4;
    const int h = ch & 7, n = (ch >> 3) & 63, b = ch >> 9;
    const int t0 = b * SEQ + n * 64;
    const bf16_t* proj = (const bf16_t*)(p.ws + WS_PROJ);
    char* Lfc = lds + RP_Z0; float* Lf = (float*)Lfc;
    char* ApT = lds + RP_Z0; char* AkVT = lds + RP_Z0 + 9216;
    char* Arow = lds + RP_Z1; char* Rrow = Arow + 9216; char* Brow = Arow + 18432; char* Krow = Arow + 27648;
    char* Aak = Arow; char* Arb = Rrow; char* Ark = Brow; char* Trow = Krow; char* BhT = Krow; char* VpT = Aak;
    char* AT = lds + RP_Z2; char* VT = AT + 9216; char* KhT = AT;
    float* tot = (float*)(lds + RP_VEC); float* WC = tot + 256;
    char* lin = lds + RP_LIN; char* LWi = lds + RP_LW;
    float* PT = (float*)(lds + RP_PT);
    {
        const float* mu0 = p.in[I_MU] + (size_t)li * 1696;
        if (tid < 48) {
            const int j0 = tid * 4;
            *(float4*)(PT + j0) = j0 < 160 ? *(const float4*)(mu0 + (C_HW - RW0) + j0) : *(const float4*)(p.in[I_VRESMU] + j0 - 160);
        } else if (tid < 48 + 144) {
            const int q = tid - 48, arr = q >> 4, c4 = (q & 15) * 4, chn = h * 64 + c4;
            const float* src = arr == 0 ? mu0 + (C_R - RW0) + chn : arr == 1 ? mu0 + (C_K - RW0) + chn : arr == 2 ? mu0 + (C_V - RW0) + chn
                             : arr == 3 ? p.in[I_W0] + li * 512 + chn : arr == 4 ? p.in[I_A0] + li * 512 + chn : arr == 5 ? p.in[I_V0] + chn
                             : arr == 6 ? p.in[I_KK] + li * 512 + chn : arr == 7 ? p.in[I_KA] + li * 512 + chn : p.in[I_RK] + li * 512 + chn;
            *(float4*)(PT + 192 + arr * 64 + c4) = *(const float4*)src;
        }
    }
    __syncthreads();
    {
        const int c = tid >> 2, cq = tid & 3, s = n * 64 + c;
        const bf16_t* cur = proj + (size_t)(t0 + c) * EVLD + C_HW + cq * 48;
        const float* mu = p.in[I_MU] + (size_t)li * 1696 + (C_HW - RW0);
        const float* vmu = p.in[I_VRESMU];
#pragma unroll
        for (int i6 = 0; i6 < 6; ++i6) {
            const u32x4 cw4 = *(const u32x4*)(cur + i6 * 8);
            u32x4 pw4 = *(const u32x4*)(cur - (s > 0 ? EVLD : 0) + i6 * 8);
            if (s == 0) pw4 = (u32x4){0u, 0u, 0u, 0u};
            const int j0 = cq * 48 + i6 * 8;
            const float4 ma = *(const float4*)(PT + j0), mb = *(const float4*)(PT + j0 + 4);
            const float mm[8] = {ma.x, ma.y, ma.z, ma.w, mb.x, mb.y, mb.z, mb.w};
            const bool is_t = j0 < 32, is_s = (j0 >= 64) && (j0 < 160);
            const float ca = is_t ? 1.f : 0.f, cb = is_t ? -2.f : 1.f, cc = is_t ? 2.f : -1.f;
            u32x4 w;
#pragma unroll
            for (int e = 0; e < 4; ++e) {
                float o2[2];
#pragma unroll
                for (int q = 0; q < 2; ++q) {
                    const float cv = q ? __uint_as_float(cw4[e] & 0xffff0000u) : __uint_as_float(cw4[e] << 16);
                    const float pv = q ? __uint_as_float(pw4[e] & 0xffff0000u) : __uint_as_float(pw4[e] << 16);
                    const float val = cv + mm[e * 2 + q] * (pv - cv);
                    const float act = ca + cb * __builtin_amdgcn_rcpf(1.f + __expf(cc * val));
                    o2[q] = (is_t || is_s) ? act : val;
                }
                w[e] = pack2(o2[0], o2[1]);
            }
            *(u32x4*)(lin + c * 400 + (cq * 48 + i6 * 8) * 2) = w;
        }
        const bf16_t* LW = (const bf16_t*)(p.ws + WS_W + W_LW) + (size_t)h * 64 * 192;
#pragma unroll
        for (int i6 = 0; i6 < 6; ++i6) *(u32x4*)(LWi + c * 400 + (cq * 48 + i6 * 8) * 2) = *(const u32x4*)(LW + (size_t)c * 192 + cq * 48 + i6 * 8);
    }
    __syncthreads();
    float lw_[16], la_[16], lg_[16], lv_[16];
#pragma unroll
    for (int tj = 0; tj < 4; ++tj) {
        const f32x4 a = tile16(LWi, 400, 16 * tj, lin, 400, 16 * wid, 32);
        const f32x4 bq = tile16(LWi + 64, 400, 16 * tj, lin + 64, 400, 16 * wid, 32);
        const f32x4 cg = tile16(LWi + 128, 400, 16 * tj, lin + 128, 400, 16 * wid, 96);
        const f32x4 dv = tile16(LWi + 320, 400, 16 * tj, lin + 320, 400, 16 * wid, 32);
#pragma unroll
        for (int r = 0; r < 4; ++r) { lw_[tj * 4 + r] = a[r]; la_[tj * 4 + r] = bq[r]; lg_[tj * 4 + r] = cg[r]; lv_[tj * 4 + r] = dv[r]; }
    }
    __syncthreads();
    const int c = 16 * wid + fr;
    float at[16], rt[16], bt[16], kt[16], bh[16], kh[16];
    {
        const int s = n * 64 + c;
        const size_t row = (size_t)(t0 + c);
        const float* mu = p.in[I_MU] + (size_t)li * 1696;
        const int hc = h * 64;
        float rr_[16], kk_[16], lwv[16], aa[16];
        float kn = 0.f, rk = 0.f;
        bf16_t* vf = (bf16_t*)(p.ws + WS_VF);
        bf16_t* gg = (bf16_t*)(p.ws + WS_GG);
#pragma unroll
        for (int tj = 0; tj < 4; ++tj) {
            const int cb = 16 * tj + 4 * fq;
            u32x2 cr = *(const u32x2*)(proj + row * EVLD + C_R + hc + cb), ck = *(const u32x2*)(proj + row * EVLD + C_K + hc + cb), cv = *(const u32x2*)(proj + row * EVLD + C_V + hc + cb);
            const size_t prow = s > 0 ? row - 1 : row;
            u32x2 pr = *(const u32x2*)(proj + prow * EVLD + C_R + hc + cb), pk = *(const u32x2*)(proj + prow * EVLD + C_K + hc + cb), pv = *(const u32x2*)(proj + prow * EVLD + C_V + hc + cb);
            if (s == 0) { pr = (u32x2){0u, 0u}; pk = pr; pv = pr; }
            u32x2 vfw = {0u, 0u};
            if (li == 1) vfw = *(const u32x2*)(vf + row * 512 + hc + cb);
            float vout[4], gout[4];
            const int ch0 = hc + cb;
            const float* pt = PT + 192 + cb;
            const float4 mu_r4 = *(const float4*)(pt), mu_k4 = *(const float4*)(pt + 64), mu_v4 = *(const float4*)(pt + 128);
            const float4 w0_4 = *(const float4*)(pt + 192), a0_4 = *(const float4*)(pt + 256), v0_4 = *(const float4*)(pt + 320);
            const float4 kk_4 = *(const float4*)(pt + 384), ka_4 = *(const float4*)(pt + 448), rk_4 = *(const float4*)(pt + 512);
            const float mur[4] = {mu_r4.x, mu_r4.y, mu_r4.z, mu_r4.w}, muk[4] = {mu_k4.x, mu_k4.y, mu_k4.z, mu_k4.w}, muv[4] = {mu_v4.x, mu_v4.y, mu_v4.z, mu_v4.w};
            const float w0v[4] = {w0_4.x, w0_4.y, w0_4.z, w0_4.w}, a0v[4] = {a0_4.x, a0_4.y, a0_4.z, a0_4.w}, v0v[4] = {v0_4.x, v0_4.y, v0_4.z, v0_4.w};
            const float kkp[4] = {kk_4.x, kk_4.y, kk_4.z, kk_4.w}, kap[4] = {ka_4.x, ka_4.y, ka_4.z, ka_4.w}, rkp[4] = {rk_4.x, rk_4.y, rk_4.z, rk_4.w};
#pragma unroll
            for (int r = 0; r < 4; ++r) {
                const int i = tj * 4 + r;
                const unsigned wcr = r < 2 ? cr.x : cr.y, wck = r < 2 ? ck.x : ck.y, wcv = r < 2 ? cv.x : cv.y;
                const unsigned wpr = r < 2 ? pr.x : pr.y, wpk = r < 2 ? pk.x : pk.y, wpv = r < 2 ? pv.x : pv.y, wvf = r < 2 ? vfw.x : vfw.y;
                const float c_r = (r & 1) ? __uint_as_float(wcr & 0xffff0000u) : __uint_as_float(wcr << 16);
                const float c_k = (r & 1) ? __uint_as_float(wck & 0xffff0000u) : __uint_as_float(wck << 16);
                const float c_v = (r & 1) ? __uint_as_float(wcv & 0xffff0000u) : __uint_as_float(wcv << 16);
                const float p_r = (r & 1) ? __uint_as_float(wpr & 0xffff0000u) : __uint_as_float(wpr << 16);
                const float p_k = (r & 1) ? __uint_as_float(wpk & 0xffff0000u) : __uint_as_float(wpk << 16);
                const float p_v = (r & 1) ? __uint_as_float(wpv & 0xffff0000u) : __uint_as_float(wpv << 16);
                const float rm = c_r + mur[r] * (p_r - c_r);
                const float km = c_k + muk[r] * (p_k - c_k);
                float vm = c_v + muv[r] * (p_v - c_v);
                const float wlog = -softplusf_(-(w0v[r] + lw_[i])) - 0.5f;
                lwv[i] = -__expf(wlog);
                const float a = sigmoidf_(a0v[r] + la_[i]);
                if (li == 1) {
                    const float v1 = (r & 1) ? __uint_as_float(wvf & 0xffff0000u) : __uint_as_float(wvf << 16);
                    vm = vm + (v1 - vm) * sigmoidf_(v0v[r] + lv_[i]);
                }
                const float kkv = km * kkp[r];
                kn += kkv * kkv;
                rr_[i] = rm; kk_[i] = kkv; aa[i] = a;
                kt[i] = km * (1.f + (a - 1.f) * kap[r]);
                rk += rm * kt[i] * rkp[r];
                vout[r] = vm; gout[r] = lg_[i];
            }
            u32x2 w; w.x = pack2(vout[0], vout[1]); w.y = pack2(vout[2], vout[3]);
            *(u32x2*)(vf + row * 512 + hc + cb) = w;
            w.x = pack2(gout[0], gout[1]); w.y = pack2(gout[2], gout[3]);
            *(u32x2*)(gg + row * 512 + hc + cb) = w;
#pragma unroll
            for (int r = 0; r < 4; ++r) *(bf16_t*)(VT + (cb + r) * 144 + c * 2) = f2bf(vout[r]);
            __builtin_amdgcn_sched_barrier(0);
        }
        kn += __shfl_xor(kn, 16); kn += __shfl_xor(kn, 32);
        const float kr = rsqrtf(kn + 1e-6f);
        rk += __shfl_xor(rk, 16); rk += __shfl_xor(rk, 32);
        if (fq == 0) ((float*)(p.ws + WS_RK))[row * 8 + h] = rk;
        float cs[16];
#pragma unroll
        for (int i = 0; i < 16; ++i) {
            float x = lwv[i];
#pragma unroll
            for (int o = 1; o < 16; o <<= 1) { const float y = __shfl_up(x, o, 16); if (fr >= o) x += y; }
            cs[i] = x;
        }
        if (fr == 15) {
#pragma unroll
            for (int i = 0; i < 16; ++i) tot[wid * 64 + 16 * (i >> 2) + 4 * fq + (i & 3)] = cs[i];
        }
        __syncthreads();
#pragma unroll
        for (int i = 0; i < 16; ++i) {
            const int chl = 16 * (i >> 2) + 4 * fq + (i & 3);
            float pre = 0.f, all = 0.f;
#pragma unroll
            for (int w2 = 0; w2 < 4; ++w2) { const float tv = tot[w2 * 64 + chl]; all += tv; if (w2 < wid) pre += tv; }
            const float csi = cs[i] + pre, csm = csi - lwv[i];
            const float kkn = kk_[i] * kr, k2 = kt[i];
            const float e_c = __expf(csi), e_n = __builtin_amdgcn_rcpf(e_c), e_m = __expf(csm), e_h = __expf(all) * e_n;
            at[i] = -kkn * e_m; rt[i] = rr_[i] * e_c;
            const float bp = kkn * aa[i];
            bt[i] = bp * e_n; kt[i] = k2 * e_n; bh[i] = bp * e_h; kh[i] = k2 * e_h;
            if (c == 0) WC[chl] = __expf(all);
            if ((i & 3) == 3) __builtin_amdgcn_sched_barrier(0);
        }
    }
#pragma unroll
    for (int tj = 0; tj < 4; ++tj) {
        const int cb = 16 * tj + 4 * fq;
        u32x2 w;
        w.x = pack2(at[tj * 4], at[tj * 4 + 1]); w.y = pack2(at[tj * 4 + 2], at[tj * 4 + 3]); *(u32x2*)(Arow + c * 144 + cb * 2) = w;
        w.x = pack2(rt[tj * 4], rt[tj * 4 + 1]); w.y = pack2(rt[tj * 4 + 2], rt[tj * 4 + 3]); *(u32x2*)(Rrow + c * 144 + cb * 2) = w;
        w.x = pack2(bt[tj * 4], bt[tj * 4 + 1]); w.y = pack2(bt[tj * 4 + 2], bt[tj * 4 + 3]); *(u32x2*)(Brow + c * 144 + cb * 2) = w;
        w.x = pack2(kt[tj * 4], kt[tj * 4 + 1]); w.y = pack2(kt[tj * 4 + 2], kt[tj * 4 + 3]); *(u32x2*)(Krow + c * 144 + cb * 2) = w;
#pragma unroll
        for (int r = 0; r < 4; ++r) {
            *(bf16_t*)(AT + (cb + r) * 144 + c * 2) = f2bf(at[tj * 4 + r]);
        }
    }
    __syncthreads();
    f32x4 pab[4], pak[4], prb[4], prk[4];
    {
        const int ti = wid;
#pragma unroll
        for (int tj = 0; tj < 4; ++tj) {
            pab[tj] = (f32x4){0.f, 0.f, 0.f, 0.f}; pak[tj] = pab[tj]; prb[tj] = pab[tj]; prk[tj] = pab[tj];
            if (tj <= ti) {
                pab[tj] = tile16(Arow, 144, 16 * ti, Brow, 144, 16 * tj, 64);
                pak[tj] = tile16(Krow, 144, 16 * tj, Arow, 144, 16 * ti, 64);
                prb[tj] = tile16(Brow, 144, 16 * tj, Rrow, 144, 16 * ti, 64);
                prk[tj] = tile16(Krow, 144, 16 * tj, Rrow, 144, 16 * ti, 64);
            }
        }
    }
    __syncthreads();
    {
        const int ti = wid;
#pragma unroll
        for (int tj = 0; tj < 4; ++tj) {
            const int s1 = 16 * tj + fr;
            f32x4 lv;
#pragma unroll
            for (int r = 0; r < 4; ++r) { const int t1 = 16 * ti + 4 * fq + r; lv[r] = (s1 < t1) ? -pab[tj][r] : 0.f; }
            *(f32x4*)&Lf[s1 * 72 + 16 * ti + 4 * fq] = lv;
            const int t2 = 16 * ti + fr;
            float m1[4], m2[4], m3[4];
#pragma unroll
            for (int r = 0; r < 4; ++r) { const int s2 = 16 * tj + 4 * fq + r; m1[r] = (s2 < t2) ? pak[tj][r] : 0.f; m2[r] = (s2 <= t2) ? prb[tj][r] : 0.f; m3[r] = (s2 <= t2) ? prk[tj][r] : 0.f; }
            u32x2 w;
            w.x = pack2(m1[0], m1[1]); w.y = pack2(m1[2], m1[3]); *(u32x2*)(Aak + t2 * 144 + (16 * tj + 4 * fq) * 2) = w;
            w.x = pack2(m2[0], m2[1]); w.y = pack2(m2[2], m2[3]); *(u32x2*)(Arb + t2 * 144 + (16 * tj + 4 * fq) * 2) = w;
            w.x = pack2(m3[0], m3[1]); w.y = pack2(m3[2], m3[3]); *(u32x2*)(Ark + t2 * 144 + (16 * tj + 4 * fq) * 2) = w;
        }
    }
    __syncthreads();
    {
        char* L21i = lds + RP_PT;
        char* T11T = lds + RP_T11;
        char* MT = lds + RP_Z0;
        if (wid < 2) {
            const int o = 32 * wid;
            float Tc[32];
#pragma unroll
            for (int i = 0; i < 32; ++i) Tc[i] = (i == (lane & 31)) ? 1.f : 0.f;
#pragma unroll
            for (int j = 0; j < 31; ++j) {
                const float tj = Tc[j];
#pragma unroll
                for (int i4 = (j + 1) >> 2; i4 < 8; ++i4) {
                    const f32x4 l4 = *(const f32x4*)&Lf[(o + j) * 72 + o + i4 * 4];
#pragma unroll
                    for (int e = 0; e < 4; ++e) if (i4 * 4 + e > j) Tc[i4 * 4 + e] -= l4[e] * tj;
                }
            }
            if (lane < 32) {
#pragma unroll
                for (int i = 0; i < 32; ++i) *(bf16_t*)(Trow + (o + i) * 144 + (o + lane) * 2) = f2bf(Tc[i]);
                if (wid == 0) {
#pragma unroll
                    for (int i = 0; i < 32; ++i) *(bf16_t*)(Trow + i * 144 + (32 + lane) * 2) = 0;
#pragma unroll
                    for (int i4 = 0; i4 < 8; ++i4) { u32x2 w; w.x = pack2(Tc[i4 * 4], Tc[i4 * 4 + 1]); w.y = pack2(Tc[i4 * 4 + 2], Tc[i4 * 4 + 3]); *(u32x2*)(T11T + lane * 80 + i4 * 8) = w; }
                }
            }
        } else {
            const int t2 = tid - 128;
#pragma unroll
            for (int g2 = 0; g2 < 2; ++g2) {
                const int i = t2 & 31, k4 = ((t2 >> 5) + 4 * g2) * 4;
                u32x2 w;
                w.x = pack2(Lf[(k4 + 0) * 72 + 32 + i], Lf[(k4 + 1) * 72 + 32 + i]); w.y = pack2(Lf[(k4 + 2) * 72 + 32 + i], Lf[(k4 + 3) * 72 + 32 + i]);
                *(u32x2*)(L21i + i * 80 + k4 * 2) = w;
            }
        }
        __syncthreads();
        {
            const int r0 = 16 * (wid >> 1), c0 = 16 * (wid & 1);
            const f32x4 mm = tile16(L21i, 80, r0, T11T, 80, c0, 32);
            u32x2 w; w.x = pack2(mm[0], mm[1]); w.y = pack2(mm[2], mm[3]);
            *(u32x2*)(MT + (c0 + fr) * 80 + (r0 + 4 * fq) * 2) = w;
        }
        __syncthreads();
        {
            const int r0 = 16 * (wid >> 1), c0 = 16 * (wid & 1);
            const f32x4 tt = tile16(MT, 80, c0, Trow + 32 * 144 + 64, 144, r0, 32);
            u32x2 w; w.x = pack2(-tt[0], -tt[1]); w.y = pack2(-tt[2], -tt[3]);
            *(u32x2*)(Trow + (32 + r0 + fr) * 144 + (c0 + 4 * fq) * 2) = w;
        }
    }
    __syncthreads();
    {
        const int ti = wid;
#pragma unroll
        for (int tj = 0; tj < 4; ++tj) {
            const f32x4 x = tile16(Trow, 144, 16 * ti, AT, 144, 16 * tj, 64);
            const f32x4 y = tile16(Aak, 144, 16 * ti, VT, 144, 16 * tj, 64);
            u32x2 w;
            w.x = pack2(x[0], x[1]); w.y = pack2(x[2], x[3]); *(u32x2*)(ApT + (16 * tj + fr) * 144 + (16 * ti + 4 * fq) * 2) = w;
            w.x = pack2(y[0], y[1]); w.y = pack2(y[2], y[3]); *(u32x2*)(AkVT + (16 * tj + fr) * 144 + (16 * ti + 4 * fq) * 2) = w;
        }
    }
    __syncthreads();
    {
        const int ti = wid;
#pragma unroll
        for (int tj = 0; tj < 4; ++tj) {
            const f32x4 x = tile16(Trow, 144, 16 * ti, AkVT, 144, 16 * tj, 64);
            u32x2 w; w.x = pack2(x[0], x[1]); w.y = pack2(x[2], x[3]); *(u32x2*)(VpT + (16 * tj + fr) * 144 + (16 * ti + 4 * fq) * 2) = w;
        }
    }
    __syncthreads();
#pragma unroll
    for (int tj = 0; tj < 4; ++tj)
#pragma unroll
        for (int r = 0; r < 4; ++r) {
            const int cb = 16 * tj + 4 * fq + r;
            *(bf16_t*)(BhT + cb * 144 + c * 2) = f2bf(bh[tj * 4 + r]);
            *(bf16_t*)(KhT + cb * 144 + c * 2) = f2bf(kh[tj * 4 + r]);
        }
    __syncthreads();
    {
        unsigned char* opsA = (unsigned char*)p.out + (size_t)ch * 16384;
        unsigned char* opsB = p.ws + WS_ROPS + (size_t)ch * 16384;
        const int ti = wid;
#pragma unroll
        for (int tj = 0; tj < 4; ++tj) {
            const f32x4 x = tile16(ApT, 144, 16 * tj, Arb, 144, 16 * ti, 64);
            const f32x4 g = tile16(ApT, 144, 16 * tj, BhT, 144, 16 * ti, 64);
            const int m1 = 16 * ti + fr, mt = m1 >> 5, rr = m1 & 31, hh = fq & 1, jg = fq >> 1;
            const size_t off = ((size_t)((mt * 4 + tj) * 64 + hh * 32 + rr) * 8 + jg * 4) * 2;
            float gd[4];
#pragma unroll
            for (int r = 0; r < 4; ++r) gd[r] = g[r] + ((16 * tj + 4 * fq + r == m1) ? WC[m1] : 0.f);
            u32x2 w;
            w.x = pack2(x[0] + rt[tj * 4], x[1] + rt[tj * 4 + 1]); w.y = pack2(x[2] + rt[tj * 4 + 2], x[3] + rt[tj * 4 + 3]); *(u32x2*)(opsA + off) = w;
            w.x = pack2(gd[0], gd[1]); w.y = pack2(gd[2], gd[3]); *(u32x2*)(opsA + 8192 + off) = w;
            f32x4 y = tile16(Ark, 144, 16 * ti, VT, 144, 16 * tj, 64);
            const f32x4 y2 = tile16(Arb, 144, 16 * ti, VpT, 144, 16 * tj, 64);
            f32x4 kv = tile16(KhT, 144, 16 * ti, VT, 144, 16 * tj, 64);
            const f32x4 kv2 = tile16(BhT, 144, 16 * ti, VpT, 144, 16 * tj, 64);
            const int vcol = 16 * tj + fr, slice = vcol >> 5, r2 = vcol & 31, cb = 16 * ti + 4 * fq, mt2 = cb >> 5, q4 = (cb & 31) >> 2, h2 = q4 & 1, rg = q4 >> 1;
            const size_t off2 = ((size_t)((slice * 2 + mt2) * 64 + h2 * 32 + r2) * 16 + rg * 4) * 2;
            w.x = pack2(y[0] + y2[0], y[1] + y2[1]); w.y = pack2(y[2] + y2[2], y[3] + y2[3]); *(u32x2*)(opsB + off2) = w;
            w.x = pack2(kv[0] + kv2[0], kv[1] + kv2[1]); w.y = pack2(kv[2] + kv2[2], kv[3] + kv2[3]); *(u32x2*)(opsB + 8192 + off2) = w;
        }
    }
}

DI void rwkv_scan_block(const P& p, int bh, char* lds, bool dry = false) {
    const int tid = tidx(), lane = tid & 63, w = tid >> 6, slice = w & 1;
    const int h = bh & 7, b = bh >> 3;
    constexpr int NST = 64 * 2, AH = 3;
    auto issue = [&](int j) {
        const int n = j >> 1, k = j & 1;
        const size_t ch = (size_t)((b * 64 + n) * 8 + h) * 16384;
        const unsigned char* s0 = (k == 0 ? p.ws + WS_ROPS + ch + 8192 : p.ws + WS_ROPS + ch) + tid * 16;
        const unsigned char* s1 = (k == 0 ? (const unsigned char*)p.out + ch + 8192 : (const unsigned char*)p.out + ch) + tid * 16;
        char* dst = lds + (j & 3) * 16384 + tid * 16;
        glds16(s0, dst); glds16(s0 + 4096, dst + 4096); glds16(s1, dst + 8192); glds16(s1 + 4096, dst + 12288);
    };
    const unsigned la = (unsigned)(size_t)(lds_u32*)lds + lane * 16;
    f32x16 H[2];
#pragma unroll
    for (int i = 0; i < 2; ++i)
#pragma unroll
        for (int r = 0; r < 16; ++r) H[i][r] = 0.f;
    __syncthreads();
#pragma unroll
    for (int j = 0; j < AH; ++j) issue(j);
#pragma unroll 1
    for (int n = 0; n < 64; ++n) {
        bf16x8 Hb[4];
#pragma unroll
        for (int i = 0; i < 2; ++i) { Hb[i * 2] = pack_step(H[i], 0); Hb[i * 2 + 1] = pack_step(H[i], 1); }
#pragma unroll
        for (int k = 0; k < 2; ++k) {
            const int j = n * 2 + k;
            if (n < 63) GS_WAIT(8); else if (k == 0) GS_WAIT(4); else GS_WAIT(0);
            __builtin_amdgcn_s_barrier();
            if (j + AH < NST) issue(j + AH);
            __builtin_amdgcn_sched_barrier(0);
            const char* sl = lds + (j & 3) * 16384;
            if (w < 2) {
                f32x16 acc[2];
                bf16x8 F[4];
                const unsigned fa = la + (unsigned)((j & 3) * 16384 + 8192);
#define RS_O(i) (unsigned)((((i) & 1) * 4 + ((i) >> 1)) * 1024)
#pragma unroll
                for (int i = 0; i < 4; ++i) fr_rd(F[i], fa + RS_O(i));
#pragma unroll
                for (int mt = 0; mt < 2; ++mt) {
                    const u32x4* up = (const u32x4*)(sl + (slice * 2 + mt) * 2048 + lane * 32);
                    const u32x4 u0 = up[0], u1 = up[1];
#pragma unroll
                    for (int e = 0; e < 4; ++e) {
                        acc[mt][e * 2] = __uint_as_float(u0[e] << 16); acc[mt][e * 2 + 1] = __uint_as_float(u0[e] & 0xffff0000u);
                        acc[mt][8 + e * 2] = __uint_as_float(u1[e] << 16); acc[mt][8 + e * 2 + 1] = __uint_as_float(u1[e] & 0xffff0000u);
                    }
                }
#pragma unroll
                for (int i = 0; i < 8; ++i) {
                    if (i <= 4) fr_wait<3>(F[i & 3]); else if (i == 5) fr_wait<2>(F[i & 3]); else if (i == 6) fr_wait<1>(F[i & 3]); else fr_wait<0>(F[i & 3]);
                    acc[i & 1] = mfma32(F[i & 3], Hb[i >> 1], acc[i & 1]);
                    if (i + 4 < 8) fr_rd(F[i & 3], fa + RS_O(i + 4));
                }
                if (k == 0) { H[0] = acc[0]; H[1] = acc[1]; }
                else {
                    const size_t ch = (size_t)((b * 64 + n) * 8 + h) * 16384;
                    u32x4* Yf = (u32x4*)(dry ? p.ws + WS_DUMMY + 2097152 + (size_t)(bh & 31) * 16384 : p.ws + WS_ROPS + ch) + (size_t)(slice * 128 + lane) * 2;
#pragma unroll
                    for (int mt = 0; mt < 2; ++mt) {
                        u32x4 o0, o1;
#pragma unroll
                        for (int e = 0; e < 4; ++e) { o0[e] = pack2(acc[mt][e * 2], acc[mt][e * 2 + 1]); o1[e] = pack2(acc[mt][8 + e * 2], acc[mt][8 + e * 2 + 1]); }
                        Yf[mt * 128] = o0; Yf[mt * 128 + 1] = o1;
                    }
                }
            }
        }
    }
    __syncthreads();
}

DI void rwkv_post_unit(const P& p, int li, int ch) {
    const int tid = tidx();
    const int h = ch & 7, n = (ch >> 3) & 63, b = ch >> 9;
    const int t0 = b * SEQ + n * 64;
    const int c = tid >> 2, cq = tid & 3;
    const bf16_t* Yf = (const bf16_t*)(p.ws + WS_ROPS + (size_t)ch * 16384);
    const bf16_t* vf = (const bf16_t*)(p.ws + WS_VF) + (size_t)(t0 + c) * 512 + h * 64 + cq * 16;
    const bf16_t* gg = (const bf16_t*)(p.ws + WS_GG) + (size_t)(t0 + c) * 512 + h * 64 + cq * 16;
    const float rk = ((const float*)(p.ws + WS_RK))[(size_t)(t0 + c) * 8 + h];
    const float* lnw = p.in[I_LNW] + li * 512 + h * 64 + cq * 16;
    const float* lnb = p.in[I_LNB] + li * 512 + h * 64 + cq * 16;
    bf16_t* mp = (bf16_t*)p.out + (size_t)(t0 + c) * 1024 + 512 + h * 64 + cq * 16;
    const int mt = c >> 5, q4 = (c & 31) >> 2, hh = q4 & 1, rg = q4 >> 1, reg = rg * 4 + (c & 3), slice = cq >> 1, rb = (cq & 1) * 16;
    float y[16]; float sm = 0.f;
#pragma unroll
    for (int i = 0; i < 16; ++i) { y[i] = bf2f(Yf[(size_t)((slice * 2 + mt) * 64 + hh * 32 + rb + i) * 16 + reg]); sm += y[i]; }
    sm += __shfl_xor(sm, 1); sm += __shfl_xor(sm, 2);
    const float mean = sm * (1.f / 64.f);
    float vs = 0.f;
#pragma unroll
    for (int i = 0; i < 16; ++i) { y[i] -= mean; vs += y[i] * y[i]; }
    vs += __shfl_xor(vs, 1); vs += __shfl_xor(vs, 2);
    const float rs = rsqrtf(vs * (1.f / 64.f) + 64e-5f);
#pragma unroll
    for (int i8 = 0; i8 < 2; ++i8) {
        const u32x4 vw = *(const u32x4*)(vf + i8 * 8), gw = *(const u32x4*)(gg + i8 * 8);
        u32x4 w;
#pragma unroll
        for (int e = 0; e < 4; ++e) {
            const int i = i8 * 8 + e * 2;
            const float v0 = __uint_as_float(vw[e] << 16), v1 = __uint_as_float(vw[e] & 0xffff0000u), g0 = __uint_as_float(gw[e] << 16), g1 = __uint_as_float(gw[e] & 0xffff0000u);
            w[e] = pack2((y[i] * rs * lnw[i] + lnb[i] + rk * v0) * g0, (y[i + 1] * rs * lnw[i + 1] + lnb[i + 1] + rk * v1) * g1);
        }
        *(u32x4*)(mp + i8 * 8) = w;
    }
}


DI void attn_unit(const P& p, int unit, char* lds) {
    const int tid = tidx(), lane = tid & 63, w = tid >> 6, r_ = lane & 31, hl = lane >> 5;
    const int idx = unit & 31, h = (unit >> 5) & 7, g = (unit >> 8) % 3, b = unit / 768;
    const int lg2 = g * 2, dil = 1 << lg2, L = SEQ >> lg2, ntl = L >> 7;
    const int rs = idx / ntl, qt = idx % ntl;
    const int hg = g * 8 + h;
    const bf16_t* QK = (const bf16_t*)(p.ws + WS_QK);
    const bf16_t* VT = (const bf16_t*)(p.ws + WS_VT) + ((size_t)((b * 24 + hg) * dil + rs) * 64) * L;
    const int qi = 32 * w + r_;
    const int q_idx = 128 * qt + qi;
    const size_t qrow = (size_t)(b * SEQ + q_idx * dil + rs);
    const int kbase0 = 128 * qt - 128;
    char* Kt = lds;
    char* Vt = lds + 32768;
    __syncthreads();
#pragma unroll
    for (int i = 0; i < 8; ++i) {
        const int id = tid + i * 256, row = id >> 3, pc = id & 7, c = pc ^ ((row >> 1) & 7);
        int k_idx = kbase0 + row; if (k_idx < 0) k_idx = 0;
        glds16(QK + (size_t)(b * SEQ + k_idx * dil + rs) * 3072 + 1536 + hg * 64 + c * 8, Kt + id * 16);
    }
#pragma unroll
    for (int i = 0; i < 8; ++i) {
        const int id = tid + i * 256, row = id >> 5, pq = id & 31, q = pq ^ (row & 31);
        int k0 = kbase0 + q * 8; if (k0 < 0) k0 = 0;
        glds16(VT + (size_t)row * L + k0, Vt + id * 16);
    }
    bf16x8 qf[4];
#pragma unroll
    for (int ks = 0; ks < 4; ++ks) qf[ks] = *(const bf16x8*)(QK + qrow * 3072 + hg * 64 + 16 * ks + 8 * hl);
    asm volatile("s_waitcnt vmcnt(0)" ::: "memory");
    __syncthreads();
    f32x16 st[5];
    float mx = -1.0e30f;
#pragma unroll
    for (int kbi = 0; kbi < 5; ++kbi) {
        const int krow = 32 * (w + kbi) + r_;
#pragma unroll
        for (int r = 0; r < 16; ++r) st[kbi][r] = 0.f;
#pragma unroll
        for (int ks = 0; ks < 4; ++ks) {
            const bf16x8 kf = *(const bf16x8*)(Kt + krow * 128 + (((2 * ks + hl) ^ ((krow >> 1) & 7)) * 16));
            st[kbi] = mfma32(kf, qf[ks], st[kbi]);
        }
#pragma unroll
        for (int r = 0; r < 16; ++r) {
            const int kj = 32 * (w + kbi) + (r & 3) + 8 * (r >> 2) + 4 * hl;
            const bool valid = (kj >= qi) && (kj <= qi + 128) && (kbase0 + kj >= 0);
            const float sv = valid ? st[kbi][r] * 0.125f : -1.0e30f;
            st[kbi][r] = sv; mx = fmaxf(mx, sv);
        }
    }
    mx = fmaxf(mx, __shfl_xor(mx, 32));
    float l = 0.f;
#pragma unroll
    for (int kbi = 0; kbi < 5; ++kbi)
#pragma unroll
        for (int r = 0; r < 16; ++r) { const float pv = __expf(st[kbi][r] - mx); st[kbi][r] = pv; l += pv; }
    l += __shfl_xor(l, 32);
    f32x16 ot[2];
#pragma unroll
    for (int dt = 0; dt < 2; ++dt)
#pragma unroll
        for (int r = 0; r < 16; ++r) ot[dt][r] = 0.f;
#pragma unroll
    for (int kbi = 0; kbi < 5; ++kbi)
#pragma unroll
        for (int s2 = 0; s2 < 2; ++s2) {
            const bf16x8 pb = pack_step(st[kbi], s2);
            const int q0 = 4 * (w + kbi) + 2 * s2;
#pragma unroll
            for (int dt = 0; dt < 2; ++dt) {
                const int drow = 32 * dt + r_;
                const u32x2 lo = *(const u32x2*)(Vt + drow * 512 + ((q0 ^ (drow & 31)) * 16) + 8 * hl);
                const u32x2 hi = *(const u32x2*)(Vt + drow * 512 + (((q0 + 1) ^ (drow & 31)) * 16) + 8 * hl);
                u32x4 vw; vw.x = lo.x; vw.y = lo.y; vw.z = hi.x; vw.w = hi.y;
                ot[dt] = mfma32(__builtin_bit_cast(bf16x8, vw), pb, ot[dt]);
            }
        }
    const float inv = 1.f / l;
    bf16_t* og = (bf16_t*)(p.ws + WS_OG) + ((size_t)g * T + qrow) * 512 + h * 64;
#pragma unroll
    for (int dt = 0; dt < 2; ++dt)
#pragma unroll
        for (int rg = 0; rg < 4; ++rg) {
            u32x2 wv; wv.x = pack2(ot[dt][rg * 4] * inv, ot[dt][rg * 4 + 1] * inv); wv.y = pack2(ot[dt][rg * 4 + 2] * inv, ot[dt][rg * 4 + 3] * inv);
            *(u32x2*)(og + 32 * dt + 8 * rg + 4 * hl) = wv;
        }
    if (hl == 0) ((float*)(p.ws + WS_LSE))[((size_t)g * T + qrow) * 8 + h] = mx + __logf(l);
}
DI void phase_attn_merge(const P& p) {
    const bf16_t* og = (const bf16_t*)(p.ws + WS_OG);
    const float* lse = (const float*)(p.ws + WS_LSE);
    bf16_t* o = (bf16_t*)p.out;
    for (int i = bidx() * 256 + tidx(); i < T * 64; i += gridDim.x * 256) {
        const int t = i >> 6, c8 = i & 63, h = c8 >> 3;
        const float l0 = lse[(size_t)t * 8 + h], l1 = lse[((size_t)T + t) * 8 + h], l2 = lse[((size_t)2 * T + t) * 8 + h];
        const float m = fmaxf(l0, fmaxf(l1, l2));
        float w0 = __expf(l0 - m), w1 = __expf(l1 - m), w2 = __expf(l2 - m);
        const float inv = 1.f / (w0 + w1 + w2); w0 *= inv; w1 *= inv; w2 *= inv;
        const u32x4 a = *(const u32x4*)(og + (size_t)t * 512 + c8 * 8), bq = *(const u32x4*)(og + ((size_t)T + t) * 512 + c8 * 8), cq = *(const u32x4*)(og + ((size_t)2 * T + t) * 512 + c8 * 8);
        u32x4 r;
#pragma unroll
        for (int e = 0; e < 4; ++e) {
            const float x0 = w0 * __uint_as_float(a[e] << 16) + w1 * __uint_as_float(bq[e] << 16) + w2 * __uint_as_float(cq[e] << 16);
            const float x1 = w0 * __uint_as_float(a[e] & 0xffff0000u) + w1 * __uint_as_float(bq[e] & 0xffff0000u) + w2 * __uint_as_float(cq[e] & 0xffff0000u);
            r[e] = pack2(x0, x1);
        }
        *(u32x4*)(o + (size_t)t * 512 + c8 * 8) = r;
    }
}


#define XB_TMO      128
#define XB_XCNT(j)  (256  + 64 * (j))
#define XB_XSUB(j)  (1280 + 64 * (j))
#define XB_XGEN(j)  (2304 + 64 * (j))
#define XB_TOP      3328
#define XB_TOPGEN   3392
#define XCD_BAR_WORDS 3456
#define XB_SPIN_CAP (1u << 22)
#define LAS __attribute__((address_space(3)))
DI unsigned xb_ld(unsigned* p)              { return __hip_atomic_load(p, __ATOMIC_RELAXED, __HIP_MEMORY_SCOPE_AGENT); }
DI unsigned xb_add(unsigned* p, unsigned v) { return __hip_atomic_fetch_add(p, v, __ATOMIC_RELAXED, __HIP_MEMORY_SCOPE_AGENT); }
DI unsigned xb_xcc_id() { return (unsigned)__builtin_amdgcn_s_getreg((3 << 11) | 20) & 0xFu; }
#define XB_SPIN(cond, bar) do { unsigned _sp = 0; while (cond) { if (_sp < 32u) __builtin_amdgcn_s_sleep(2); else __builtin_amdgcn_s_sleep(24); \
    if ((++_sp & 255u) == 0u) { if (xb_ld(&(bar)[XB_TMO])) break; if (_sp > XB_SPIN_CAP) { atomicAdd(&(bar)[XB_TMO], 1u); break; } } } } while (0)
struct XcdBarrier { unsigned* bar; unsigned x; volatile LAS unsigned* st; };
DI XcdBarrier xcd_barrier_post(unsigned* bar, volatile LAS unsigned* st) {
    XcdBarrier b; b.bar = bar; b.x = xb_xcc_id(); b.st = st;
    if (threadIdx.x == 0) (void)xb_add(&bar[XB_XCNT(b.x)], 1u);
    return b;
}
DI void xcd_barrier_complete(unsigned* bar, unsigned x, unsigned& nloc, unsigned& nx) {
    const unsigned G = gridDim.x * gridDim.y * gridDim.z;
    unsigned sum, cnt, mine, sp = 0u;
    for (;;) {
        sum = 0u; cnt = 0u; mine = 0u;
#pragma unroll
        for (unsigned j = 0; j < 16; ++j) { const unsigned c = xb_ld(&bar[XB_XCNT(j)]); sum += c; cnt += (c > 0u) ? 1u : 0u; mine = (j == x) ? c : mine; }
        if (sum == G) break;
        __builtin_amdgcn_s_sleep(1);
        if ((++sp & 255u) == 0u) { if (xb_ld(&bar[XB_TMO])) break; if (sp > XB_SPIN_CAP) { atomicAdd(&bar[XB_TMO], 1u); break; } }
    }
    nloc = mine > 0u ? mine : 1u; nx = cnt > 0u ? cnt : 1u;
}
DI void xcd_barrier(const XcdBarrier& b) {
    asm volatile("s_waitcnt vmcnt(0)" ::: "memory");
    __syncthreads();
    if (threadIdx.x == 0) {
        unsigned* bar = b.bar; unsigned bx = b.x;
        asm volatile("" : "+s"(bar), "+s"(bx));
        __builtin_amdgcn_s_waitcnt(0);
        unsigned nloc = b.st[0], nx = b.st[1];
        if (nloc == 0u) { xcd_barrier_complete(bar, bx, nloc, nx); b.st[0] = nloc; b.st[1] = nx; }
        const unsigned old = xb_add(&bar[XB_XSUB(bx)], 1u);
        const unsigned gen = old / nloc;
        if (old + 1u == (gen + 1u) * nloc) {
            __builtin_amdgcn_fence(__ATOMIC_RELEASE, "agent");
            asm volatile("s_waitcnt vmcnt(0)" ::: "memory");
            const unsigned og = xb_add(&bar[XB_TOP], 1u);
            const unsigned tg = og / nx;
            if (og + 1u == (tg + 1u) * nx) xb_add(&bar[XB_TOPGEN], 1u);
            else XB_SPIN(xb_ld(&bar[XB_TOPGEN]) == tg, bar);
            __builtin_amdgcn_fence(__ATOMIC_ACQUIRE, "agent");
            xb_add(&bar[XB_XGEN(bx)], 1u);
            asm volatile("s_waitcnt vmcnt(0)" ::: "memory");
        } else {
            XB_SPIN(xb_ld(&bar[XB_XGEN(bx)]) == gen, bar);
            __builtin_amdgcn_fence(__ATOMIC_ACQUIRE, "agent");
            asm volatile("s_waitcnt vmcnt(0)" ::: "memory");
        }
    }
    __syncthreads();
}

constexpr int LDS_BYTES = RP_END;
static_assert(GP_END + 6144 <= LDS_BYTES, "LDS");
__global__ void __launch_bounds__(256, 2) __attribute__((amdgpu_waves_per_eu(2, 2))) mega(P p) {
    cg::grid_group grid = cg::this_grid();
    extern __shared__ __attribute__((aligned(16))) char lds[];
    if (threadIdx.x < 4) ((volatile LAS unsigned*)(lds + LDS_BYTES))[threadIdx.x] = 0u;
    __syncthreads();
    const XcdBarrier xb = xcd_barrier_post((unsigned*)(p.ws + WS_CTL + CTL_BAR), (volatile LAS unsigned*)(lds + LDS_BYTES));
#define GSYNC() xcd_barrier(xb)
    const bf16_t* HN = (const bf16_t*)p.out;
    const bf16_t* Win = (const bf16_t*)(p.ws + WS_W + W_IN);
    const bf16_t* Wout = (const bf16_t*)(p.ws + WS_W + W_OUT);
    phase_rope(p);
    phase_convert_io(p, 0, lds);
    phase_prep<0>(p, p.in[I_EVNORM], 0);
    if (p.ws == nullptr) grid.sync();
    GSYNC();
    volatile LAS unsigned* qword = (volatile LAS unsigned*)(lds + LDS_BYTES + 8);
    for (int layer = 0; layer < 4; ++layer) {
        const int li = layer >> 1;
        if ((layer & 1) == 0) {
            phase_gemm<EPI_EVEN_IN>(p, HN, 1024, Win, 1024, EVPAD / 128, lds);
            GSYNC();
            for (int u = bidx(); u < 1024; u += gridDim.x) gdn_prep_unit(p, li, u, lds);
            GSYNC();
            if (bidx() < 16) gdn_scan_block(p, bidx(), lds);
            {
                unsigned* qctr = (unsigned*)(p.ws + WS_CTL + CTL_QUEUE) + li * 64;
                for (;;) {
                    __syncthreads();
                    if (threadIdx.x == 0) *qword = atomicAdd(qctr, 1u);
                    __syncthreads();
                    const unsigned u = *qword;
                    if (u >= 2048u) break;
                    rwkv_prep_unit(p, li, (int)u, lds);
                }
            }
            GSYNC();
            if (bidx() < 32) rwkv_scan_block(p, bidx(), lds);
            else {
                for (int u = bidx() - 32; u < 1024; u += gridDim.x - 32) gdn_post_unit(p, li, u);
                phase_convert_moe(p, layer, lds, bidx() - 32, gridDim.x - 32);
            }
            GSYNC();
            for (int u = bidx(); u < 2048; u += gridDim.x) rwkv_post_unit(p, li, u);
            GSYNC();
            phase_gemm<EPI_RESID>(p, (const bf16_t*)(p.ws + WS_PROJ), EVLD, Wout, 1024, 8, lds, false, HN, 1024, 512);
        } else {
            phase_gemm<EPI_ODD_IN>(p, HN, 1024, Win, 1024, ODC / 128, lds);
            GSYNC();
            for (int u = bidx(); u < 3072; u += gridDim.x) attn_unit(p, u, lds);
            GSYNC();
            phase_attn_merge(p);
            GSYNC();
            phase_gemm<EPI_RESID>(p, HN, 512, Wout, 512, 8, lds);
        }
        GSYNC();
        phase_router(p, p.in[I_FFNNORM] + layer * 1024, layer, lds);
        GSYNC();
        phase_moe_up(p, layer, lds);
        GSYNC();
        phase_moe_down(p, layer, lds);
        GSYNC();
        if (layer < 3) {
            phase_convert_io(p, layer + 1, lds);
            if ((layer + 1) & 1) phase_convert_moe(p, layer + 1, lds, bidx(), gridDim.x);
            phase_prep<1>(p, ((layer + 1) & 1) ? p.in[I_ODNORM] + ((layer + 1) >> 1) * 1024 : p.in[I_EVNORM] + ((layer + 1) >> 1) * 1024, layer + 1);
            GSYNC();
        }
    }
    phase_prep<3>(p, p.in[I_FINAL], 0);
}

extern "C" void kernel_launch(void* const* d_in, const int* in_sizes, int n_in, void* d_out, int out_size, void* d_ws, size_t ws_size, hipStream_t stream) {
    if (n_in != 34 || out_size != T * D || ws_size < WS_END) { fprintf(stderr, "kernel_launch: unexpected shapes (n_in %d out %d ws %zu need %zu)\n", n_in, out_size, ws_size, (size_t)WS_END); return; }
    static int grid_blocks = 0;
    if (!grid_blocks) {
        int dev = 0, cus = 0, per_cu = 0;
        (void)hipGetDevice(&dev);
        (void)hipDeviceGetAttribute(&cus, hipDeviceAttributeMultiprocessorCount, dev);
        (void)hipFuncSetAttribute((const void*)mega, hipFuncAttributeMaxDynamicSharedMemorySize, LDS_BYTES + 16);
        (void)hipOccupancyMaxActiveBlocksPerMultiprocessor(&per_cu, mega, 256, LDS_BYTES + 16);
        if (per_cu < 1) per_cu = 1;
        if (per_cu > 2) per_cu = 2;
        grid_blocks = cus * per_cu;
    }
    P p{};
    for (int i = 0; i < 34; ++i) p.in[i] = (const float*)d_in[i];
    p.out = (float*)d_out; p.ws = (unsigned char*)d_ws;
    (void)hipMemsetAsync((char*)d_ws + WS_CTL, 0, 65536, stream);
    void* args[] = {&p};
    hipError_t e = hipLaunchCooperativeKernel((void*)mega, dim3(grid_blocks), dim3(256), args, LDS_BYTES + 16, stream);
    if (e != hipSuccess) fprintf(stderr, "cooperative launch failed: %s (grid %d)\n", hipGetErrorString(e), grid_blocks);
}
```

```cpp
#include <hip/hip_runtime.h>
#include <cstdio>
#include <cstdint>
#include <cmath>
#include <hip/hip_cooperative_groups.h>
namespace cg = cooperative_groups;

typedef unsigned short bf16_t;
typedef short bf16x8 __attribute__((ext_vector_type(8)));
typedef float f32x4 __attribute__((ext_vector_type(4)));
typedef unsigned u32x4 __attribute__((ext_vector_type(4)));
typedef unsigned u32x2 __attribute__((ext_vector_type(2)));
#define DI __device__ __forceinline__

constexpr int T = 16384, SEQ = 4096, BATCH = 4, D = 1024;
constexpr int EVC = 3784, EVLD = 3784, EVPAD = 3840;
constexpr int ODC = 4608;
constexpr int RW0 = 2056;
constexpr int C_R = 2056, C_K = 2568, C_V = 3080, C_HW = 3592, C_HA = 3624, C_HG = 3656, C_HV = 3752;
constexpr int NEXP = 16, FF = 256;
constexpr int HROWS = 34816;

constexpr size_t WS_CTL = 0;
constexpr size_t CTL_EGL = 4096;
constexpr size_t CTL_QUEUE = 49152;
constexpr size_t CTL_CNT = 32768;
constexpr size_t CTL_BAR = 16384;
constexpr size_t WS_LIST = 65536;
constexpr size_t WS_GATE = WS_LIST + 16 * 16384 * 4;
constexpr size_t WS_RK = WS_GATE + 16 * 16384 * 4;
constexpr size_t WS_SSQ = WS_RK + (size_t)T * 8 * 4;
constexpr size_t WS_ROPE = WS_SSQ + (size_t)16 * T * 4;
constexpr size_t WS_W = WS_ROPE + (size_t)T * 32 * 8;
constexpr size_t W_IN = 0;
constexpr size_t W_OUT = (size_t)4608 * 1024 * 2;
constexpr size_t W_13 = W_OUT + (size_t)1024 * 1024 * 2;
constexpr size_t W_2 = W_13 + (size_t)16 * 512 * 1024 * 2;
constexpr size_t W_LW = W_2 + (size_t)16 * 1024 * 256 * 2;
constexpr size_t W_BYTES = W_LW + (size_t)512 * 192 * 2;
constexpr size_t WS_XB = WS_W + W_BYTES;
constexpr size_t WS_HN = WS_XB;
constexpr size_t WS_VF = WS_HN + (size_t)T * 1024 * 2;
constexpr size_t WS_R2 = WS_VF + (size_t)T * 512 * 2;
constexpr size_t WS_PROJ = WS_R2;
constexpr size_t WS_GOPS = WS_R2 + (size_t)T * EVLD * 2;
constexpr size_t GOPS_CH = 73728, GO_UF = 0, GO_WF = 16384, GO_QF = 32768, GO_AF = 49152, GO_KF = 57344;
constexpr size_t WS_ROPS = WS_GOPS + 1024 * GOPS_CH;
constexpr size_t WS_QK = WS_R2;
constexpr size_t WS_VT = WS_QK + (size_t)T * 3072 * 2;
constexpr size_t WS_OG = WS_VT + (size_t)T * 1536 * 2;
constexpr size_t WS_LSE = WS_OG + (size_t)3 * T * 512 * 2;
constexpr size_t WS_END3 = WS_LSE + (size_t)3 * T * 8 * 4;
constexpr size_t WS_YS = WS_R2;
constexpr size_t WS_H = WS_YS + (size_t)2 * T * 1024 * 2;
constexpr size_t WS_GG = WS_ROPS + (size_t)2048 * 16384;
constexpr size_t WS_END0 = WS_GG + (size_t)T * 512 * 2;
constexpr size_t WS_END1 = WS_H + (size_t)HROWS * 256 * 2;
constexpr size_t WS_END2 = WS_R2 + (size_t)T * 4608 * 2;
static_assert(WS_END3 <= WS_END0, "odd-layer regions exceed even-layer footprint");
constexpr size_t WS_END = WS_END0 > WS_END1 ? (WS_END0 > WS_END2 ? WS_END0 : WS_END2) : (WS_END1 > WS_END2 ? WS_END1 : WS_END2);

constexpr size_t WS_RSL = WS_END;
constexpr size_t WS_RSIN = WS_RSL + 16 * 16384 * 4;
constexpr size_t WS_NEED = WS_RSIN + (size_t)T * 4;
constexpr size_t WS_DUMMY = WS_END0;
struct P {
    const float* in[34];
    float* out;
    unsigned char* ws;
};
enum { I_X = 0, I_POS, I_EVNORM, I_EVWIN, I_VRESDOWN, I_EVWOUT, I_CONVW, I_ALOG, I_DTB, I_GDNNORM, I_MU, I_W0, I_W2, I_A0, I_A2, I_G2,
       I_KK, I_KA, I_RK, I_LNW, I_LNB, I_VRESMU, I_V0, I_V2, I_ODNORM, I_ODWIN, I_ODWOUT, I_FFNNORM, I_WGROUP, I_WEXPERT, I_W1, I_W3, I_MW2, I_FINAL };

DI int tidx() { int t = threadIdx.x; asm volatile("" : "+v"(t)); return t; }
DI int bidx() { int b = blockIdx.x; asm volatile("" : "+s"(b)); return b; }
typedef __bf16 bf2_t __attribute__((ext_vector_type(2)));
typedef float f2_t __attribute__((ext_vector_type(2)));
DI bf16_t f2bf(float x) { return __builtin_bit_cast(bf16_t, (__bf16)x); }
DI float bf2f(bf16_t h) { return __uint_as_float(((unsigned)h) << 16); }
DI unsigned pack2(float lo, float hi) { const f2_t v = {lo, hi}; return __builtin_bit_cast(unsigned, __builtin_convertvector(v, bf2_t)); }
DI float wave_sum(float v) {
#pragma unroll
    for (int o = 32; o > 0; o >>= 1) v += __shfl_xor(v, o);
    return v;
}
DI float wave_max(float v) {
#pragma unroll
    for (int o = 32; o > 0; o >>= 1) v = fmaxf(v, __shfl_xor(v, o));
    return v;
}
DI float sigmoidf_(float x) { return __builtin_amdgcn_rcpf(1.f + __expf(-x)); }
DI float siluf_(float x) { return x * __builtin_amdgcn_rcpf(1.f + __expf(-x)); }
DI float softplusf_(float x) { return fmaxf(x, 0.f) + __logf(1.f + __expf(-fabsf(x))); }

struct ConvJob { const float* src; bf16_t* dst; int K, N, ldd; int mode; const float* ks = nullptr; };
DI int rowmap(int mode, int n) { return mode == 0 ? n : ((n >> 4) * 32 + (n & 15) + (mode == 2 ? 16 : 0)); }
DI void conv_tile(const ConvJob& j, int tile, float* lds  ) {
    const int ntn = (j.N + 255) / 256;
    const int tk = tile / ntn, tn = tile % ntn;
    const int tid = tidx();
    __syncthreads();
    float4 v[16];
#pragma unroll
    for (int i = 0; i < 16; ++i) {
        const int e = tid + i * 256, k = e >> 6, n4 = (e & 63) * 4;
        const int gk = tk * 64 + k, gn = tn * 256 + n4;
        v[i] = make_float4(0.f, 0.f, 0.f, 0.f);
        if (gn < j.N) v[i] = *(const float4*)(j.src + (size_t)gk * j.N + gn);
    }
    if (j.ks) {
        float sc[16];
#pragma unroll
        for (int i = 0; i < 16; ++i) sc[i] = j.ks[tk * 64 + (tid >> 6) + 4 * i];
#pragma unroll
        for (int i = 0; i < 16; ++i) { v[i].x *= sc[i]; v[i].y *= sc[i]; v[i].z *= sc[i]; v[i].w *= sc[i]; }
    }
#pragma unroll
    for (int i = 0; i < 16; ++i) { const int e = tid + i * 256, k = e >> 6, n4 = (e & 63) * 4; *(float4*)(lds + k * 260 + n4) = v[i]; }
    __syncthreads();
#pragma unroll
    for (int i = 0; i < 8; ++i) {
        const int n = tid, k8 = i * 8;
        const int gn = tn * 256 + n;
        if (gn < j.N) {
            u32x4 w;
            w.x = pack2(lds[(k8 + 0) * 260 + n], lds[(k8 + 1) * 260 + n]); w.y = pack2(lds[(k8 + 2) * 260 + n], lds[(k8 + 3) * 260 + n]);
            w.z = pack2(lds[(k8 + 4) * 260 + n], lds[(k8 + 5) * 260 + n]); w.w = pack2(lds[(k8 + 6) * 260 + n], lds[(k8 + 7) * 260 + n]);
            *(u32x4*)(j.dst + (size_t)rowmap(j.mode, gn) * j.ldd + tk * 64 + k8) = w;
        }
    }
}
DI void phase_convert_io(const P& p, int layer, char* ldsc) {
    float* lds = (float*)ldsc;
    unsigned char* W = p.ws + WS_W;
    const int li = layer >> 1;
    if ((layer & 1) == 0) {
        const float* ng = p.in[I_EVNORM] + li * 1024;
        const ConvJob j0{p.in[I_EVWIN] + (size_t)li * 1024 * 3752, (bf16_t*)(W + W_IN), 1024, 3752, 1024, 0, ng};
        for (int t = bidx(); t < 16 * 15; t += gridDim.x) conv_tile(j0, t, lds);
        if (li == 1) {
            const ConvJob j1{p.in[I_VRESDOWN], (bf16_t*)(W + W_IN) + (size_t)3752 * 1024, 1024, 32, 1024, 0, ng};
            for (int t = bidx(); t < 16; t += gridDim.x) conv_tile(j1, t, lds);
        }
        const ConvJob j2{p.in[I_EVWOUT] + (size_t)li * 1024 * 1024, (bf16_t*)(W + W_OUT), 1024, 1024, 1024, 0};
        for (int t = bidx(); t < 16 * 4; t += gridDim.x) conv_tile(j2, t, lds);
        {
            bf16_t* LW = (bf16_t*)(W + W_LW);
            for (int i = bidx() * 256 + tidx(); i < 512 * 192; i += gridDim.x * 256) {
                const int ch = i / 192, j = i % 192;
                float v;
                if (j < 32) v = p.in[I_W2][((size_t)li * 32 + j) * 512 + ch];
                else if (j < 64) v = p.in[I_A2][((size_t)li * 32 + j - 32) * 512 + ch];
                else if (j < 160) v = p.in[I_G2][((size_t)li * 96 + j - 64) * 512 + ch];
                else v = (li == 1) ? p.in[I_V2][(size_t)(j - 160) * 512 + ch] : 0.f;
                LW[i] = f2bf(v);
            }
        }
        const int r0 = (li == 1) ? 3784 : 3752;
        bf16_t* z = (bf16_t*)(W + W_IN) + (size_t)r0 * 1024;
        const size_t n = (size_t)(EVPAD - r0) * 1024;
        for (size_t i = (size_t)bidx() * 256 + tidx(); i < n; i += (size_t)gridDim.x * 256) z[i] = 0;
    } else {
        const ConvJob j0{p.in[I_ODWIN] + (size_t)li * 1024 * 4608, (bf16_t*)(W + W_IN), 1024, 4608, 1024, 0, p.in[I_ODNORM] + li * 1024};
        for (int t = bidx(); t < 16 * 18; t += gridDim.x) conv_tile(j0, t, lds);
        const ConvJob j2{p.in[I_ODWOUT] + (size_t)li * 512 * 1024, (bf16_t*)(W + W_OUT), 512, 1024, 512, 0};
        for (int t = bidx(); t < 8 * 4; t += gridDim.x) conv_tile(j2, t, lds);
    }
}
DI void phase_convert_moe(const P& p, int layer, char* ldsc, int b0, int bs) {
    float* lds = (float*)ldsc;
    unsigned char* W = p.ws + WS_W;
    for (int t = b0; t < 16 * 3 * 16; t += bs) {
        const int e = t / 48, r = t % 48, which = r / 16, tile = r % 16;
        ConvJob j;
        const float* fg = p.in[I_FFNNORM] + layer * 1024;
        if (which == 0) j = ConvJob{p.in[I_W1] + ((size_t)layer * 16 + e) * 1024 * 256, (bf16_t*)(W + W_13) + (size_t)e * 512 * 1024, 1024, 256, 1024, 1, fg};
        else if (which == 1) j = ConvJob{p.in[I_W3] + ((size_t)layer * 16 + e) * 1024 * 256, (bf16_t*)(W + W_13) + (size_t)e * 512 * 1024, 1024, 256, 1024, 2, fg};
        else j = ConvJob{p.in[I_MW2] + ((size_t)layer * 16 + e) * 256 * 1024, (bf16_t*)(W + W_2) + (size_t)e * 1024 * 256, 256, 1024, 256, 0};
        conv_tile(j, tile, lds);
    }
}

DI void phase_rope(const P& p) {
    float2* tab = (float2*)(p.ws + WS_ROPE);
    const int* pos = (const int*)p.in[I_POS];
    for (int i = bidx() * 256 + tidx(); i < T * 32; i += gridDim.x * 256) {
        const int t = i >> 5, f = i & 31;
        const float inv = powf(10000.0f, -(float)f * (2.0f / 64.0f));
        const float ang = (float)pos[t] * inv;
        float s, c; sincosf(ang, &s, &c);
        tab[i] = make_float2(c, s);
    }
}

template <int MODE>
DI void phase_prep(const P& p, const float* gain, int layer) {
    const int lane = tidx() & 63, wid = tidx() >> 6;
    const int nw = gridDim.x * 4;
    bf16_t* hn = (bf16_t*)p.out;
    bf16_t* xb = (bf16_t*)(p.ws + WS_XB);
    const bf16_t* y0 = (const bf16_t*)(p.ws + WS_YS);
    const bf16_t* y1 = y0 + (size_t)T * 1024;
    float4 gq[4];
#pragma unroll
    for (int i = 0; i < 4; ++i) gq[i] = *(const float4*)(gain + i * 256 + lane * 4);
    for (int t = bidx() * 4 + wid; t < T; t += nw) {
        float4 v[4];
        float ss = 0.f;
#pragma unroll
        for (int i = 0; i < 4; ++i) {
            const size_t off = (size_t)t * 1024 + i * 256 + lane * 4;
            if (MODE == 0) v[i] = *(const float4*)(p.in[I_X] + off);
            else { const u32x2 xx = *(const u32x2*)(xb + off); v[i].x = __uint_as_float(xx.x << 16); v[i].y = __uint_as_float(xx.x & 0xffff0000u); v[i].z = __uint_as_float(xx.y << 16); v[i].w = __uint_as_float(xx.y & 0xffff0000u); }
            if (MODE == 1 || MODE == 3) {
                const u32x2 a = *(const u32x2*)(y0 + off), b = *(const u32x2*)(y1 + off);
                v[i].x += __uint_as_float(a.x << 16) + __uint_as_float(b.x << 16); v[i].y += __uint_as_float(a.x & 0xffff0000u) + __uint_as_float(b.x & 0xffff0000u);
                v[i].z += __uint_as_float(a.y << 16) + __uint_as_float(b.y << 16); v[i].w += __uint_as_float(a.y & 0xffff0000u) + __uint_as_float(b.y & 0xffff0000u);
            }
            ss += v[i].x * v[i].x + v[i].y * v[i].y + v[i].z * v[i].z + v[i].w * v[i].w;
        }
        ss = wave_sum(ss);
        const float rstd = rsqrtf(ss * (1.0f / 1024.0f) + 1e-6f);
        if ((MODE == 0 || MODE == 1) && lane == 0) ((float*)(p.ws + WS_RSIN))[t] = rstd;
        float lg[20];
        if (MODE == 2) {
#pragma unroll
            for (int q = 0; q < 20; ++q) lg[q] = 0.f;
        }
#pragma unroll
        for (int i = 0; i < 4; ++i) {
            const int col = i * 256 + lane * 4;
            const size_t off = (size_t)t * 1024 + col;
            const float4 g = gq[i];
            float4 h; h.x = v[i].x * rstd * g.x; h.y = v[i].y * rstd * g.y; h.z = v[i].z * rstd * g.z; h.w = v[i].w * rstd * g.w;
            bf16_t* hd = hn + off;
            if (MODE == 0 || MODE == 1) { u32x2 w; w.x = pack2(v[i].x, v[i].y); w.y = pack2(v[i].z, v[i].w); *(u32x2*)(xb + off) = w; }
            if (MODE == 3) *(float4*)(p.out + off) = h;
            else if (MODE == 2) { u32x2 w; w.x = pack2(h.x, h.y); w.y = pack2(h.z, h.w); *(u32x2*)hd = w; }
            if (MODE == 2) {
                const float hh[4] = {h.x, h.y, h.z, h.w};
                const float* wg = p.in[I_WGROUP] + (size_t)layer * 1024 * 4;
                const float* we = p.in[I_WEXPERT] + (size_t)layer * 4 * 1024 * 4;
#pragma unroll
                for (int e = 0; e < 4; ++e) {
                    const float4 a = *(const float4*)(wg + (size_t)(col + e) * 4);
                    lg[0] += hh[e] * a.x; lg[1] += hh[e] * a.y; lg[2] += hh[e] * a.z; lg[3] += hh[e] * a.w;
#pragma unroll
                    for (int g2 = 0; g2 < 4; ++g2) {
                        const float4 b = *(const float4*)(we + ((size_t)g2 * 1024 + col + e) * 4);
                        lg[4 + g2 * 4 + 0] += hh[e] * b.x; lg[4 + g2 * 4 + 1] += hh[e] * b.y; lg[4 + g2 * 4 + 2] += hh[e] * b.z; lg[4 + g2 * 4 + 3] += hh[e] * b.w;
                    }
                }
            }
        }
        if (MODE == 2) {
#pragma unroll
            for (int q = 0; q < 20; ++q) lg[q] = wave_sum(lg[q]);
            if (lane == 0) {
                int gs = 0; float gm = lg[0];
#pragma unroll
                for (int g2 = 1; g2 < 4; ++g2) if (lg[g2] > gm) { gm = lg[g2]; gs = g2; }
                float den = 0.f;
#pragma unroll
                for (int g2 = 0; g2 < 4; ++g2) den += __expf(lg[g2] - gm);
                const float pg = 1.f / den;
                float el[4];
#pragma unroll
                for (int e = 0; e < 4; ++e) el[e] = gs == 0 ? lg[4 + e] : gs == 1 ? lg[8 + e] : gs == 2 ? lg[12 + e] : lg[16 + e];
                int i1 = 0; float v1 = el[0];
#pragma unroll
                for (int e = 1; e < 4; ++e) if (el[e] > v1) { v1 = el[e]; i1 = e; }
                int i2 = 0; float v2 = -3.4e38f;
#pragma unroll
                for (int e = 0; e < 4; ++e) if (e != i1 && el[e] > v2) { v2 = el[e]; i2 = e; }
                const float e2 = __expf(v2 - v1);
                const float g1 = pg / (1.f + e2), g2v = pg * e2 / (1.f + e2);
                unsigned* cnt = (unsigned*)(p.ws + WS_CTL + CTL_CNT) + layer * 16 * 64;
                int* list = (int*)(p.ws + WS_LIST);
                float* gl = (float*)(p.ws + WS_GATE);
                const int ea = gs * 4 + i1, eb = gs * 4 + i2;
                const unsigned ra = atomicAdd(&cnt[ea * 64], 1u);
                list[ea * 16384 + ra] = t * 2; gl[ea * 16384 + ra] = g1;
                const unsigned rb = atomicAdd(&cnt[eb * 64], 1u);
                list[eb * 16384 + rb] = t * 2 + 1; gl[eb * 16384 + rb] = g2v;
            }
        }
    }
}


typedef __attribute__((address_space(3))) unsigned lds_u32;
DI void g_dma(unsigned m0v, unsigned voff, const char* sbase) {
    asm volatile("s_mov_b32 m0, %0\n\ts_nop 0\n\tglobal_load_lds_dwordx4 %1, %2" :: "s"(m0v), "v"(voff), "s"(sbase) : "memory", "m0");
}
DI void phase_router(const P& p, const float* gain, int layer, char* ldsc) {
    const int tid = tidx(), lane = tid & 63, wid = tid >> 6;
    const bf16_t* xb = (const bf16_t*)(p.ws + WS_XB);
    const float* wg = p.in[I_WGROUP] + (size_t)layer * 1024 * 4;
    const float* we = p.in[I_WEXPERT] + (size_t)layer * 4 * 1024 * 4;
    unsigned* cnt = (unsigned*)(p.ws + WS_CTL + CTL_CNT) + layer * 16 * 64;
    int* list = (int*)(p.ws + WS_LIST);
    float* gl = (float*)(p.ws + WS_GATE);
    float* rsl = (float*)(p.ws + WS_RSL);
    f32x4* WS = (f32x4*)ldsc;
    unsigned* lcnt = (unsigned*)(ldsc + 40960); unsigned* lbase = lcnt + 16; int* e_ent = (int*)(lcnt + 32); unsigned* r_ent = (unsigned*)(e_ent + 32); int* t_ent = (int*)(r_ent + 32); float* g_ent = (float*)(t_ent + 32); float* rs_ent = g_ent + 32;
    const unsigned wsb = (unsigned)__builtin_amdgcn_readfirstlane((int)((unsigned)(size_t)(lds_u32*)ldsc + wid * 1024));
    auto stage = [&](int i, int buf) {
        const unsigned voff = (unsigned)(i * 256 + lane * 4 + wid) * 16u;
#pragma unroll
        for (int r = 0; r < 5; ++r) g_dma(wsb + (unsigned)(buf * 1280 + r * 256) * 16u, voff, (const char*)(r == 0 ? wg : we + (size_t)(r - 1) * 4096));
    };
    u32x2 xq[4];
#pragma unroll
    for (int q = 0; q < 4; ++q) xq[q] = *(const u32x2*)(xb + (size_t)(bidx() * 16 + wid * 4 + q) * 1024 + lane * 4);
    for (int tb = bidx() * 16; tb < T; tb += gridDim.x * 16) {
        const int t0 = tb + wid * 4;
        __syncthreads();
        if (tid < 16) lcnt[tid] = 0u;
        stage(0, 0);
        float rstd[4];
        {
            const float pq = ((const float*)(p.ws + WS_SSQ))[(size_t)(lane & 15) * T + t0 + (lane >> 4)];
            float ss = pq;
            ss += __shfl_xor(ss, 1); ss += __shfl_xor(ss, 2); ss += __shfl_xor(ss, 4); ss += __shfl_xor(ss, 8);
#pragma unroll
            for (int q = 0; q < 4; ++q) rstd[q] = rsqrtf(__shfl(ss, q * 16) * (1.0f / 1024.0f) + 1e-6f);
        }
        float lg[4][20];
#pragma unroll
        for (int q = 0; q < 4; ++q)
#pragma unroll
            for (int j = 0; j < 20; ++j) lg[q][j] = 0.f;
#pragma unroll 1
        for (int i = 0; i < 4; ++i) {
            asm volatile("s_waitcnt vmcnt(0)" ::: "memory");
            __syncthreads();
            if (i + 1 < 4) stage(i + 1, (i + 1) & 1);
            const f32x4* W = WS + (i & 1) * 1280;
            const int col = i * 256 + lane * 4;
            const float4 g = *(const float4*)(gain + col);
            float hh[4][4];
#pragma unroll
            for (int q = 0; q < 4; ++q) {
                hh[q][0] = __uint_as_float(xq[q].x << 16) * rstd[q] * g.x; hh[q][1] = __uint_as_float(xq[q].x & 0xffff0000u) * rstd[q] * g.y; hh[q][2] = __uint_as_float(xq[q].y << 16) * rstd[q] * g.z; hh[q][3] = __uint_as_float(xq[q].y & 0xffff0000u) * rstd[q] * g.w;
            }
            {
                int tn0 = i + 1 < 4 ? t0 : t0 + (int)gridDim.x * 16; const int cn = ((i + 1) & 3) * 256 + lane * 4;
                tn0 = tn0 < T ? tn0 : t0;
#pragma unroll
                for (int q = 0; q < 4; ++q) xq[q] = *(const u32x2*)(xb + (size_t)(tn0 + q) * 1024 + cn);
            }
#pragma unroll
            for (int e = 0; e < 4; ++e) {
                const f32x4 a = W[(0 * 4 + e) * 64 + lane];
#pragma unroll
                for (int q = 0; q < 4; ++q) { lg[q][0] += hh[q][e] * a[0]; lg[q][1] += hh[q][e] * a[1]; lg[q][2] += hh[q][e] * a[2]; lg[q][3] += hh[q][e] * a[3]; }
#pragma unroll
                for (int g2 = 0; g2 < 4; ++g2) {
                    const f32x4 b = W[((1 + g2) * 4 + e) * 64 + lane];
#pragma unroll
                    for (int q = 0; q < 4; ++q) { lg[q][4 + g2 * 4] += hh[q][e] * b[0]; lg[q][5 + g2 * 4] += hh[q][e] * b[1]; lg[q][6 + g2 * 4] += hh[q][e] * b[2]; lg[q][7 + g2 * 4] += hh[q][e] * b[3]; }
                }
            }
        }
#pragma unroll
        for (int q = 0; q < 4; ++q) {
#pragma unroll
            for (int j = 0; j < 20; ++j) lg[q][j] = wave_sum(lg[q][j]);
            if (lane == q) {
                const int t = t0 + q;
                int gs = 0; float gm = lg[q][0];
#pragma unroll
                for (int g2 = 1; g2 < 4; ++g2) if (lg[q][g2] > gm) { gm = lg[q][g2]; gs = g2; }
                float den = 0.f;
#pragma unroll
                for (int g2 = 0; g2 < 4; ++g2) den += __expf(lg[q][g2] - gm);
                const float pg = 1.f / den;
                float el[4];
#pragma unroll
                for (int e = 0; e < 4; ++e) el[e] = gs == 0 ? lg[q][4 + e] : gs == 1 ? lg[q][8 + e] : gs == 2 ? lg[q][12 + e] : lg[q][16 + e];
                int i1 = 0; float v1 = el[0];
#pragma unroll
                for (int e = 1; e < 4; ++e) if (el[e] > v1) { v1 = el[e]; i1 = e; }
                int i2 = 0; float v2 = -3.4e38f;
#pragma unroll
                for (int e = 0; e < 4; ++e) if (e != i1 && el[e] > v2) { v2 = el[e]; i2 = e; }
                const float e2 = __expf(v2 - v1);
                const float g1 = pg / (1.f + e2), g2v = pg * e2 / (1.f + e2);
                const int ea = gs * 4 + i1, eb = gs * 4 + i2;
                const int sl = (wid * 4 + q) * 2;
                e_ent[sl] = ea; r_ent[sl] = atomicAdd(&lcnt[ea], 1u); t_ent[sl] = t * 2; g_ent[sl] = g1; rs_ent[sl] = rstd[q];
                e_ent[sl + 1] = eb; r_ent[sl + 1] = atomicAdd(&lcnt[eb], 1u); t_ent[sl + 1] = t * 2 + 1; g_ent[sl + 1] = g2v; rs_ent[sl + 1] = rstd[q];
            }
        }
        __syncthreads();
        if (tid < 16) lbase[tid] = lcnt[tid] ? atomicAdd(&cnt[tid * 64], lcnt[tid]) : 0u;
        __syncthreads();
        if (tid < 32) {
            const int e = e_ent[tid];
            const unsigned pos = (lbase[e] + r_ent[tid]) & 16383u;
            list[e * 16384 + pos] = t_ent[tid]; gl[e * 16384 + pos] = g_ent[tid]; rsl[e * 16384 + pos] = rs_ent[tid];
        }
    }
}

constexpr int GBK = 64;
struct TileP { int arow[4]; unsigned bo[4]; };
struct GOps { const char* A; unsigned la; const char* A2; unsigned la2; const char* B; };
DI void gemm_core(const GOps& o, const TileP& tp, int K, char* lds, f32x4 (&acc)[4][4], int ksplit, bool primed, const TileP& nx, bool have_nx) {
    const int tid = tidx(), wid = tid >> 6, lane = tid & 63, wr = wid >> 1, wc = wid & 1, fr = lane & 15, fq = lane >> 4;
    const unsigned scol = ((tid & 7) ^ ((tid >> 3) & 7)) * 16;
#pragma unroll
    for (int n = 0; n < 4; ++n)
#pragma unroll
        for (int m = 0; m < 4; ++m) acc[n][m] = (f32x4){0.f, 0.f, 0.f, 0.f};
    const int nk = K / GBK;
    if (!primed) {
        __syncthreads();
#pragma unroll
        for (int i = 0; i < 4; ++i) {
            __builtin_amdgcn_global_load_lds((const unsigned*)(o.A + (__umul24(tp.arow[i], o.la) + scol)), (lds_u32*)(lds + tid * 16 + i * 4096), 16, 0, 0);
            __builtin_amdgcn_global_load_lds((const unsigned*)(o.B + (tp.bo[i] + scol)), (lds_u32*)(lds + 16384 + tid * 16 + i * 4096), 16, 0, 0);
        }
    }
    const int sw = fr & 7;
    const unsigned aoff = (wr * 64 + fr) * 128, boff = (wc * 64 + fr) * 128, co0 = (fq ^ sw) * 16, co1 = ((4 + fq) ^ sw) * 16;
    bf16x8 a0[4], b0[4], a1[4], b1[4];
#define G_ISSUE(kt_)                                                                                                                        \
    if ((kt_) + 1 < nk) {                                                                                                                   \
        char* nb = lds + (((kt_) + 1) & 1) * 32768;                                                                                         \
        const unsigned ko = ((kt_) + 1) * (GBK * 2) + scol;                                                                                 \
        const bool hi = ((kt_) + 1) * GBK >= ksplit;                                                                                        \
        const char* Ab = hi ? o.A2 : o.A; const unsigned la = hi ? o.la2 : o.la;                                                            \
        _Pragma("unroll") for (int i = 0; i < 4; ++i) {                                                                                     \
            __builtin_amdgcn_global_load_lds((const unsigned*)(Ab + (__umul24(tp.arow[i], la) + ko)), (lds_u32*)(nb + tid * 16 + i * 4096), 16, 0, 0);   \
            __builtin_amdgcn_global_load_lds((const unsigned*)(o.B + (tp.bo[i] + ko)), (lds_u32*)(nb + 16384 + tid * 16 + i * 4096), 16, 0, 0);      \
        }                                                                                                                                   \
    } else if (have_nx) {        \
        _Pragma("unroll") for (int i = 0; i < 4; ++i) {                                                                                     \
            __builtin_amdgcn_global_load_lds((const unsigned*)(o.A + (__umul24(nx.arow[i], o.la) + scol)), (lds_u32*)(lds + tid * 16 + i * 4096), 16, 0, 0);          \
            __builtin_amdgcn_global_load_lds((const unsigned*)(o.B + (nx.bo[i] + scol)), (lds_u32*)(lds + 16384 + tid * 16 + i * 4096), 16, 0, 0);  \
        }                                                                                                                                   \
    }
#define G_READ(A_, B_, AD_)                                                                                                                 \
    asm volatile("ds_read_b128 %0, %8\n\tds_read_b128 %1, %8 offset:2048\n\tds_read_b128 %2, %8 offset:4096\n\tds_read_b128 %3, %8 offset:6144\n\t"       \
                 "ds_read_b128 %4, %9 offset:16384\n\tds_read_b128 %5, %9 offset:18432\n\tds_read_b128 %6, %9 offset:20480\n\tds_read_b128 %7, %9 offset:22528" \
                 : "=&v"(A_[0]), "=&v"(A_[1]), "=&v"(A_[2]), "=&v"(A_[3]), "=&v"(B_[0]), "=&v"(B_[1]), "=&v"(B_[2]), "=&v"(B_[3]) : "v"((AD_) + aoff), "v"((AD_) + boff) : "memory");
#define G_WAIT(A_, B_, N_)                                                                                                                  \
    asm volatile("s_waitcnt lgkmcnt(" #N_ ")" : "+v"(A_[0]), "+v"(A_[1]), "+v"(A_[2]), "+v"(A_[3]), "+v"(B_[0]), "+v"(B_[1]), "+v"(B_[2]), "+v"(B_[3]) :: "memory");
#define G_MMA(A_, B_)                                                                                                                       \
    _Pragma("unroll") for (int n = 0; n < 4; ++n)                                                                                           \
        _Pragma("unroll") for (int m = 0; m < 4; ++m) acc[n][m] = __builtin_amdgcn_mfma_f32_16x16x32_bf16(B_[n], A_[m], acc[n][m], 0, 0, 0);
    const unsigned lbase = (unsigned)(size_t)(lds_u32*)lds;
    __builtin_amdgcn_s_waitcnt(0x0070);
    __builtin_amdgcn_s_barrier();
    G_ISSUE(0)
    G_READ(a0, b0, lbase + co0)
    G_READ(a1, b1, lbase + co1)
    G_WAIT(a0, b0, 8)
    __builtin_amdgcn_sched_barrier(0);
    G_MMA(a0, b0)
    __builtin_amdgcn_sched_barrier(0);
    G_WAIT(a1, b1, 0)
#pragma unroll 1
    for (int kt = 1; kt < nk; ++kt) {
        __builtin_amdgcn_s_waitcnt(0x0070);
        __builtin_amdgcn_s_barrier();
        G_ISSUE(kt)
        const unsigned S = lbase + (kt & 1) * 32768;
        G_READ(a0, b0, S + co0)
        __builtin_amdgcn_sched_barrier(0);
        G_MMA(a1, b1)
        __builtin_amdgcn_sched_barrier(0);
        G_READ(a1, b1, S + co1)
        G_WAIT(a0, b0, 8)
        __builtin_amdgcn_sched_barrier(0);
        G_MMA(a0, b0)
        __builtin_amdgcn_sched_barrier(0);
        G_WAIT(a1, b1, 0)
    }
    G_MMA(a1, b1)
#undef G_ISSUE
#undef G_READ
#undef G_WAIT
#undef G_MMA
}

enum { EPI_EVEN_IN = 0, EPI_ODD_IN, EPI_RESID };
template <int EPI>
DI void phase_gemm(const P& p, const bf16_t* A, int lda, const bf16_t* Bt, int K, int ntn, char* lds, bool dry = false, const bf16_t* A2 = nullptr, int lda2 = 0, int ksplit = 1 << 30) {
    const int tid = tidx(), wid = tid >> 6, lane = tid & 63, wr = wid >> 1, wc = wid & 1, fr = lane & 15, fq = lane >> 4;
    const int ntm = T / 128, ntiles = ntm * ntn;
    auto fill = [&](TileP& t, int tile) {
        const int tn = tile / ntm, tm = tile % ntm, r = tid >> 3;
#pragma unroll
        for (int i = 0; i < 4; ++i) { t.arow[i] = tm * 128 + r + 32 * i; t.bo[i] = (unsigned)(tn * 128 + r + 32 * i) * (unsigned)(K * 2); }
    };
    const GOps gop{(const char*)A, (unsigned)lda * 2u, (const char*)(A2 ? A2 : A), (unsigned)(A2 ? lda2 : lda) * 2u, (const char*)Bt};
    TileP cur, nxt;
    bool primed = false;
    fill(cur, bidx() < ntiles ? bidx() : 0); nxt = cur;
    for (int tile = bidx(); tile < ntiles; tile += gridDim.x) {
        const int tn = tile / ntm, tm = tile % ntm;
        const bool have_next = tile + (int)gridDim.x < ntiles;
        if (have_next) fill(nxt, tile + gridDim.x);
        f32x4 acc[4][4];
        const int m0 = tm * 128 + wr * 64, n0 = tn * 128 + wc * 64;
        float rsr[4];
        if (EPI != EPI_RESID) {
#pragma unroll
            for (int m = 0; m < 4; ++m) rsr[m] = ((const float*)(p.ws + WS_RSIN))[m0 + m * 16 + fr];
        }
        gemm_core(gop, cur, K, lds, acc, ksplit, primed, nxt, have_next);
        primed = have_next; cur = nxt;
        if (EPI != EPI_RESID) {
#pragma unroll
            for (int m = 0; m < 4; ++m)
#pragma unroll
                for (int n = 0; n < 4; ++n) acc[n][m] *= rsr[m];
        }
        if (EPI == EPI_EVEN_IN) {
            bf16_t* C = (bf16_t*)(p.ws + WS_PROJ);
#pragma unroll
            for (int m = 0; m < 4; ++m)
#pragma unroll
                for (int n = 0; n < 4; ++n) {
                    const int row = m0 + m * 16 + fr, col = n0 + n * 16 + fq * 4;
                    if (col < EVC) { u32x2 w; w.x = pack2(acc[n][m][0], acc[n][m][1]); w.y = pack2(acc[n][m][2], acc[n][m][3]); *(u32x2*)(C + (size_t)row * EVLD + col) = w; }
                }
        } else if (EPI == EPI_ODD_IN) {
            bf16_t* C = (bf16_t*)(p.ws + WS_QK);
            const float2* tab = (const float2*)(p.ws + WS_ROPE);
            if (n0 < 3072) {
#pragma unroll
                for (int m = 0; m < 4; ++m) {
                    const int row = m0 + m * 16 + fr;
#pragma unroll
                    for (int n = 0; n < 2; ++n) {
                        float lo[4], hi[4];
#pragma unroll
                        for (int j = 0; j < 4; ++j) {
                            const float2 cs = tab[(size_t)row * 32 + n * 16 + fq * 4 + j];
                            const float x1 = acc[n][m][j], x2 = acc[n + 2][m][j];
                            lo[j] = x1 * cs.x - x2 * cs.y; hi[j] = x2 * cs.x + x1 * cs.y;
                        }
                        u32x2 w; w.x = pack2(lo[0], lo[1]); w.y = pack2(lo[2], lo[3]);
                        *(u32x2*)(C + (size_t)row * 3072 + n0 + n * 16 + fq * 4) = w;
                        w.x = pack2(hi[0], hi[1]); w.y = pack2(hi[2], hi[3]);
                        *(u32x2*)(C + (size_t)row * 3072 + n0 + (n + 2) * 16 + fq * 4) = w;
                    }
                }
            }
            if (tn * 128 >= 3072) {
                bf16_t* VT = (bf16_t*)(p.ws + WS_VT);
                const int hg0 = (tn * 128 - 3072) >> 6, g = hg0 >> 3, lg2 = g * 2, dil = 1 << lg2, L = SEQ >> lg2, run = 128 >> lg2;
                __syncthreads();
#pragma unroll
                for (int m = 0; m < 4; ++m)
#pragma unroll
                    for (int n = 0; n < 4; ++n)
#pragma unroll
                        for (int j = 0; j < 4; ++j)
                            *(bf16_t*)(lds + 32768 + (wc * 64 + n * 16 + fq * 4 + j) * 272 + (wr * 64 + m * 16 + fr) * 2) = f2bf(acc[n][m][j]);
                __syncthreads();
                const int bb = (tm * 128) >> 12, s0 = (tm * 128) & (SEQ - 1);
#pragma unroll
                for (int q = 0; q < 8; ++q) {
                    const int item = tid + q * 256, dim = item >> 4, o0 = (item & 15) * 8;
                    const int rr = o0 / run, i0 = o0 % run;
                    const char* src = lds + 32768 + dim * 272 + (rr + dil * i0) * 2;
                    float e8[8];
#pragma unroll
                    for (int e = 0; e < 8; ++e) e8[e] = bf2f(*(const bf16_t*)(src + e * dil * 2));
                    u32x4 w; w.x = pack2(e8[0], e8[1]); w.y = pack2(e8[2], e8[3]); w.z = pack2(e8[4], e8[5]); w.w = pack2(e8[6], e8[7]);
                    const int hg = hg0 + (dim >> 6);
                    *(u32x4*)(VT + ((size_t)((bb * 24 + hg) * dil + rr) * 64 + (dim & 63)) * L + (s0 >> lg2) + i0) = w;
                }
            }
        } else {
            float* ssq = (float*)(p.ws + WS_SSQ) + (size_t)(tn * 2 + wc) * T;
#pragma unroll
            for (int m = 0; m < 4; ++m) {
                float ss = 0.f;
#pragma unroll
                for (int n = 0; n < 4; ++n) {
                    const size_t qo = (size_t)(m0 + m * 16 + fr) * 1024 + n0 + n * 16 + fq * 4;
                    bf16_t* q = dry ? (bf16_t*)(p.ws + WS_DUMMY) + (qo & 0x7FFFF) : (bf16_t*)(p.ws + WS_XB) + qo;
                    const u32x2 xx = *(const u32x2*)q;
                    float4 v;
                    v.x = __uint_as_float(xx.x << 16) + acc[n][m][0]; v.y = __uint_as_float(xx.x & 0xffff0000u) + acc[n][m][1]; v.z = __uint_as_float(xx.y << 16) + acc[n][m][2]; v.w = __uint_as_float(xx.y & 0xffff0000u) + acc[n][m][3];
                    u32x2 w; w.x = pack2(v.x, v.y); w.y = pack2(v.z, v.w);
                    *(u32x2*)q = w;
                    ss += v.x * v.x + v.y * v.y + v.z * v.z + v.w * v.w;
                }
                ss += __shfl_xor(ss, 16); ss += __shfl_xor(ss, 32);
                if (fq == 0 && !dry) ssq[m0 + m * 16 + fr] = ss;
            }
        }
    }
}

DI void phase_moe_up(const P& p, int layer, char* lds) {
    const int tid = tidx(), wid = tid >> 6, lane = tid & 63, wr = wid >> 1, wc = wid & 1, fr = lane & 15, fq = lane >> 4;
    const unsigned* cntb = (const unsigned*)(p.ws + WS_CTL + CTL_CNT) + layer * 16 * 64;
    unsigned cnt[16];
#pragma unroll
    for (int e = 0; e < 16; ++e) cnt[e] = cntb[e * 64];
    const int* list = (const int*)(p.ws + WS_LIST);
    const float* gl = (const float*)(p.ws + WS_GATE);
    const bf16_t* hn = (const bf16_t*)(p.ws + WS_XB);
    const float* rsl = (const float*)(p.ws + WS_RSL);
    const bf16_t* W13 = (const bf16_t*)(p.ws + WS_W + W_13);
    bf16_t* H = (bf16_t*)(p.ws + WS_H);
    int ttot = 0;
#pragma unroll
    for (int e = 0; e < 16; ++e) ttot += ((int)cnt[e] + 127) >> 7;
    const int ntiles = ttot * 4;
    auto locate = [&](int tile, int& e, int& lt, int& ce, int& rbe, int& tn) {
        const int mt = tile >> 2; tn = tile & 3;
        int tbe = 0, acc_t = 0; e = 0;
#pragma unroll
        for (int q = 0; q < 16; ++q) { const int nt = ((int)cnt[q] + 127) >> 7; if (mt >= acc_t) { e = q; tbe = acc_t; } acc_t += nt; }
        lt = mt - tbe; ce = (int)cnt[e]; rbe = tbe * 128;
    };
    auto fill = [&](TileP& t, int tile) {
        int e, lt, ce, rbe, tn; locate(tile, e, lt, ce, rbe, tn);
        const int r = tid >> 3;
#pragma unroll
        for (int i = 0; i < 4; ++i) {
            const int ii = lt * 128 + r + 32 * i;
            const int tk = ii < ce ? (list[e * 16384 + ii] >> 1) : 0;
            t.arow[i] = tk;
            t.bo[i] = (unsigned)(e * 512 + tn * 128 + r + 32 * i) * 2048u;
        }
    };
    const GOps gop{(const char*)hn, 2048u, (const char*)hn, 2048u, (const char*)W13};
    TileP cur, nxt;
    bool primed = false;
    fill(cur, bidx() < ntiles ? bidx() : 0); nxt = cur;
    for (int tile = bidx(); tile < ntiles; tile += gridDim.x) {
        int e, lt, ce, rbe, tn; locate(tile, e, lt, ce, rbe, tn);
        const bool have_next = tile + (int)gridDim.x < ntiles;
        if (have_next) fill(nxt, tile + gridDim.x);
        f32x4 acc[4][4];
        gemm_core(gop, cur, 1024, lds, acc, 1 << 30, primed, nxt, have_next);
        primed = have_next; cur = nxt;
#pragma unroll
        for (int m = 0; m < 4; ++m) {
            const int li = lt * 128 + wr * 64 + m * 16 + fr;
            if (li < ce) {
                const float g = gl[e * 16384 + li], rs = rsl[e * 16384 + li];
                bf16_t* hrow = H + (size_t)(rbe + li) * 256;
#pragma unroll
                for (int n = 0; n < 4; n += 2) {
                    float o[4];
#pragma unroll
                    for (int j = 0; j < 4; ++j) o[j] = siluf_(acc[n][m][j] * rs) * (acc[n + 1][m][j] * rs) * g;
                    const int f = tn * 64 + wc * 32 + (n >> 1) * 16 + fq * 4;
                    u32x2 w; w.x = pack2(o[0], o[1]); w.y = pack2(o[2], o[3]);
                    *(u32x2*)(hrow + f) = w;
                }
            }
        }
    }
}
DI void phase_moe_down(const P& p, int layer, char* lds) {
    const int tid = tidx(), wid = tid >> 6, lane = tid & 63, wr = wid >> 1, wc = wid & 1, fr = lane & 15, fq = lane >> 4;
    const unsigned* cntb = (const unsigned*)(p.ws + WS_CTL + CTL_CNT) + layer * 16 * 64;
    unsigned cnt[16];
#pragma unroll
    for (int e = 0; e < 16; ++e) cnt[e] = cntb[e * 64];
    const int* list = (const int*)(p.ws + WS_LIST);
    const bf16_t* W2 = (const bf16_t*)(p.ws + WS_W + W_2);
    const bf16_t* H = (const bf16_t*)(p.ws + WS_H);
    bf16_t* ys = (bf16_t*)(p.ws + WS_YS);
    int ttot = 0;
#pragma unroll
    for (int e = 0; e < 16; ++e) ttot += ((int)cnt[e] + 127) >> 7;
    const int ntiles = ttot * 8;
    auto locate = [&](int tile, int& e, int& lt, int& ce, int& rbe, int& tn) {
        const int mt = tile >> 3; tn = tile & 7;
        int tbe = 0, acc_t = 0; e = 0;
#pragma unroll
        for (int q = 0; q < 16; ++q) { const int nt = ((int)cnt[q] + 127) >> 7; if (mt >= acc_t) { e = q; tbe = acc_t; } acc_t += nt; }
        lt = mt - tbe; ce = (int)cnt[e]; rbe = tbe * 128;
    };
    auto fill = [&](TileP& t, int tile) {
        int e, lt, ce, rbe, tn; locate(tile, e, lt, ce, rbe, tn);
        const int r = tid >> 3;
#pragma unroll
        for (int i = 0; i < 4; ++i) { t.arow[i] = rbe + lt * 128 + r + 32 * i; t.bo[i] = (unsigned)(e * 1024 + tn * 128 + r + 32 * i) * 512u; }
    };
    const GOps gop{(const char*)H, 512u, (const char*)H, 512u, (const char*)W2};
    TileP cur, nxt;
    bool primed = false;
    fill(cur, bidx() < ntiles ? bidx() : 0); nxt = cur;
    for (int tile = bidx(); tile < ntiles; tile += gridDim.x) {
        int e, lt, ce, rbe, tn; locate(tile, e, lt, ce, rbe, tn);
        const bool have_next = tile + (int)gridDim.x < ntiles;
        if (have_next) fill(nxt, tile + gridDim.x);
        f32x4 acc[4][4];
        gemm_core(gop, cur, 256, lds, acc, 1 << 30, primed, nxt, have_next);
        primed = have_next; cur = nxt;
#pragma unroll
        for (int m = 0; m < 4; ++m) {
            const int li = lt * 128 + wr * 64 + m * 16 + fr;
            if (li < ce) {
                const int ts = list[e * 16384 + li];
                bf16_t* yrow = ys + ((size_t)(ts & 1) * T + (ts >> 1)) * 1024 + tn * 128 + wc * 64 + fq * 4;
#pragma unroll
                for (int n = 0; n < 4; ++n) { u32x2 w; w.x = pack2(acc[n][m][0], acc[n][m][1]); w.y = pack2(acc[n][m][2], acc[n][m][3]); *(u32x2*)(yrow + n * 16) = w; }
            }
        }
    }
}


typedef float f32x16 __attribute__((ext_vector_type(16)));
DI f32x4 mfma16(bf16x8 a, bf16x8 b, f32x4 c) { return __builtin_amdgcn_mfma_f32_16x16x32_bf16(a, b, c, 0, 0, 0); }
DI f32x16 mfma32(bf16x8 a, bf16x8 b, f32x16 c) { return __builtin_amdgcn_mfma_f32_32x32x16_bf16(a, b, c, 0, 0, 0); }
DI f32x4 tile16(const char* X, int ldx, int row0, const char* Y, int ldy, int col0, int K) {
    const int lane = tidx() & 63, fr = lane & 15, fq = lane >> 4;
    const char* xp = X + (row0 + fr) * ldx + fq * 16; const char* yp = Y + (col0 + fr) * ldy + fq * 16;
    bf16x8 a[4], b[4];
#pragma unroll
    for (int s = 0; s < 4; ++s) if (s * 32 < K) { a[s] = *(const bf16x8*)(xp + s * 64); b[s] = *(const bf16x8*)(yp + s * 64); }
    f32x4 acc = {0.f, 0.f, 0.f, 0.f};
#pragma unroll
    for (int s = 0; s < 4; ++s) if (s * 32 < K) acc = mfma16(a[s], b[s], acc);
    return acc;
}
DI bf16x8 pack_step(const f32x16& x, int s) {
    u32x4 r;
    r.x = pack2(x[8 * s + 0], x[8 * s + 1]); r.y = pack2(x[8 * s + 2], x[8 * s + 3]);
    r.z = pack2(x[8 * s + 4], x[8 * s + 5]); r.w = pack2(x[8 * s + 6], x[8 * s + 7]);
    return __builtin_bit_cast(bf16x8, r);
}

constexpr int GP_LF = 0, GP_T = 17408, GP_VEC = GP_T + 9216, GP_U = GP_VEC + 1024, GP_END = GP_U + 36864;
DI void gdn_prep_unit(const P& p, int li, int ch, char* lds) {
    const int tid = tidx(), lane = tid & 63, wid = tid >> 6, fr = lane & 15, fq = lane >> 4;
    const int h = ch & 3, n = (ch >> 2) & 63, b = ch >> 8;
    const int t0 = b * SEQ + n * 64;
    float* Lf = (float*)(lds + GP_LF);
    char* Trow = lds + GP_T;
    float* gcs = (float*)(lds + GP_VEC); float* egc = gcs + 64; float* bet = gcs + 128; float* ekd = gcs + 192;
    char* Qrow = lds + GP_U; char* Krow = Qrow + 17408; char* VbT = lds + GP_U; char* KbgT = VbT + 18432;
    const bf16_t* proj = (const bf16_t*)(p.ws + WS_PROJ);
    unsigned char* ops = p.ws + WS_GOPS + (size_t)ch * GOPS_CH;
    const float* cw = p.in[I_CONVW] + (size_t)li * 4 * 1536;
    const int c = tid >> 2, cq = tid & 3;
    __syncthreads();
    float* cwl = (float*)(lds + GP_END);
    for (int i = tid; i < 4 * 3 * 32; i += 256) {
        const int j = i / 96, r = i % 96, sl = r >> 5, q4 = (r & 31) * 4;
        *(f32x4*)(cwl + (j * 3 + sl) * 128 + q4) = *(const f32x4*)(cw + j * 1536 + sl * 512 + h * 128 + q4);
    }
    __syncthreads();
    unsigned vvp[16];
#pragma unroll 1
    for (int which = 0; which < 3; ++which) {
        const int col0 = which * 512 + h * 128 + cq * 32;
        u32x4 xin[4][4];
#pragma unroll
        for (int j = 0; j < 4; ++j) {
            const int sp = n * 64 + c - 3 + j;
            const bf16_t* src = proj + (size_t)(b * SEQ + (sp < 0 ? 0 : sp)) * EVLD + col0;
#pragma unroll
            for (int i4 = 0; i4 < 4; ++i4) xin[j][i4] = *(const u32x4*)(src + i4 * 8);
        }
        float acc[32];
#pragma unroll
        for (int i = 0; i < 32; ++i) acc[i] = 0.f;
#pragma unroll
        for (int j = 0; j < 4; ++j) {
            const float ok = (n * 64 + c - 3 + j) >= 0 ? 1.f : 0.f;
            const float* wj = cwl + (j * 3 + which) * 128 + cq * 32;
#pragma unroll
            for (int i4 = 0; i4 < 4; ++i4) {
                const f32x4 wa = *(const f32x4*)(wj + i4 * 8), wb = *(const f32x4*)(wj + i4 * 8 + 4);
                const u32x4 w = xin[j][i4];
                acc[i4 * 8 + 0] += ok * wa[0] * __uint_as_float(w[0] << 16); acc[i4 * 8 + 1] += ok * wa[1] * __uint_as_float(w[0] & 0xffff0000u);
                acc[i4 * 8 + 2] += ok * wa[2] * __uint_as_float(w[1] << 16); acc[i4 * 8 + 3] += ok * wa[3] * __uint_as_float(w[1] & 0xffff0000u);
                acc[i4 * 8 + 4] += ok * wb[0] * __uint_as_float(w[2] << 16); acc[i4 * 8 + 5] += ok * wb[1] * __uint_as_float(w[2] & 0xffff0000u);
                acc[i4 * 8 + 6] += ok * wb[2] * __uint_as_float(w[3] << 16); acc[i4 * 8 + 7] += ok * wb[3] * __uint_as_float(w[3] & 0xffff0000u);
            }
        }
        float ss = 0.f;
#pragma unroll
        for (int i = 0; i < 32; ++i) { acc[i] = siluf_(acc[i]); ss += acc[i] * acc[i]; }
        ss += __shfl_xor(ss, 1); ss += __shfl_xor(ss, 2);
        const float rn = which == 2 ? 1.f : rsqrtf(ss + 1e-6f) * (which == 0 ? 0.08838834764831845f : 1.f);
        unsigned pk[16];
#pragma unroll
        for (int i = 0; i < 16; ++i) pk[i] = pack2(acc[2 * i] * rn, acc[2 * i + 1] * rn);
        if (which < 2) {
            char* img = which == 0 ? Qrow : Krow;
#pragma unroll
            for (int i4 = 0; i4 < 4; ++i4) { u32x4 w; w.x = pk[i4 * 4]; w.y = pk[i4 * 4 + 1]; w.z = pk[i4 * 4 + 2]; w.w = pk[i4 * 4 + 3]; *(u32x4*)(img + c * 272 + (cq * 32 + i4 * 8) * 2) = w; }
        } else {
#pragma unroll
            for (int i = 0; i < 16; ++i) vvp[i] = pk[i];
        }
    }
    if (cq == 0) {
        const float a = bf2f(proj[(size_t)(t0 + c) * EVLD + 2048 + h]);
        const float bb = bf2f(proj[(size_t)(t0 + c) * EVLD + 2052 + h]);
        const float Aexp = __expf(p.in[I_ALOG][li * 4 + h]), dtb = p.in[I_DTB][li * 4 + h];
        gcs[c] = -Aexp * softplusf_(a + dtb);
        bet[c] = sigmoidf_(bb);
    }
    __syncthreads();
    if (wid == 0) {
        float x = gcs[lane];
#pragma unroll
        for (int o = 1; o < 64; o <<= 1) { const float y = __shfl_up(x, o); if (lane >= o) x += y; }
        const float gl = __shfl(x, 63);
        gcs[lane] = x; egc[lane] = __expf(x); ekd[lane] = __expf(gl - x);
        if (lane == 63) ((float*)(p.ws + WS_CTL + CTL_EGL))[ch] = __expf(gl);
    }
    __syncthreads();
    {
        const int ti = wid;
#pragma unroll
        for (int tj = 0; tj < 4; ++tj) {
            if (tj <= ti) {
                const f32x4 kk = tile16(Krow, 272, 16 * ti, Krow, 272, 16 * tj, 128);
                const int c2 = 16 * tj + fr;
                f32x4 lv;
#pragma unroll
                for (int r = 0; r < 4; ++r) {
                    const int c1 = 16 * ti + fq * 4 + r;
                    lv[r] = (c1 > c2) ? bet[c1] * kk[r] * __expf(gcs[c1] - gcs[c2]) : 0.f;
                }
                *(f32x4*)&Lf[c2 * 68 + 16 * ti + fq * 4] = lv;
            }
            f32x4 qk = {0.f, 0.f, 0.f, 0.f};
            if (tj <= ti) qk = tile16(Krow, 272, 16 * tj, Qrow, 272, 16 * ti, 128);
            const int c1 = 16 * ti + fr;
            float o4[4];
#pragma unroll
            for (int r = 0; r < 4; ++r) { const int c2 = 16 * tj + fq * 4 + r; o4[r] = (c1 >= c2) ? qk[r] * __expf(gcs[c1] - gcs[c2]) : 0.f; }
            const int mt = c1 >> 5, rr = c1 & 31, hh = fq & 1, jg = fq >> 1;
            u32x2 w; w.x = pack2(o4[0], o4[1]); w.y = pack2(o4[2], o4[3]);
            *(u32x2*)(ops + GO_AF + ((size_t)((mt * 4 + tj) * 64 + hh * 32 + rr) * 8 + jg * 4) * 2) = w;
        }
#pragma unroll
        for (int i = 0; i < 4; ++i) {
            const int idx = tid + i * 256;
            {
                const int mt = idx >> 9, ks = (idx >> 6) & 7, l2 = idx & 63, rr = l2 & 31, hh = l2 >> 5, cc = 32 * mt + rr;
                const float sc = egc[cc];
                const u32x2 lo = *(const u32x2*)(Qrow + cc * 272 + (16 * ks + 4 * hh) * 2), hi = *(const u32x2*)(Qrow + cc * 272 + (16 * ks + 8 + 4 * hh) * 2);
                u32x4 w;
                w.x = pack2(__uint_as_float(lo.x << 16) * sc, __uint_as_float(lo.x & 0xffff0000u) * sc); w.y = pack2(__uint_as_float(lo.y << 16) * sc, __uint_as_float(lo.y & 0xffff0000u) * sc);
                w.z = pack2(__uint_as_float(hi.x << 16) * sc, __uint_as_float(hi.x & 0xffff0000u) * sc); w.w = pack2(__uint_as_float(hi.y << 16) * sc, __uint_as_float(hi.y & 0xffff0000u) * sc);
                *(u32x4*)(ops + GO_QF + (size_t)idx * 16) = w;
            }
            {
                const int mt = idx >> 8, ks = (idx >> 6) & 3, l2 = idx & 63, rr = l2 & 31, hh = l2 >> 5, dk = 32 * mt + rr;
                float e8[8];
#pragma unroll
                for (int j = 0; j < 8; ++j) { const int c2 = 16 * ks + 8 * (j >> 2) + 4 * hh + (j & 3); e8[j] = bf2f(*(const bf16_t*)(Krow + c2 * 272 + dk * 2)) * ekd[c2]; }
                u32x4 w; w.x = pack2(e8[0], e8[1]); w.y = pack2(e8[2], e8[3]); w.z = pack2(e8[4], e8[5]); w.w = pack2(e8[6], e8[7]);
                *(u32x4*)(ops + GO_KF + (size_t)idx * 16) = w;
            }
        }
    }
    __syncthreads();
    {
        const float bc = bet[c], bg = bc * egc[c];
        unsigned kvp[16];
#pragma unroll
        for (int i4 = 0; i4 < 4; ++i4) { const u32x4 w = *(const u32x4*)(Krow + c * 272 + (cq * 32 + i4 * 8) * 2); kvp[i4 * 4] = w.x; kvp[i4 * 4 + 1] = w.y; kvp[i4 * 4 + 2] = w.z; kvp[i4 * 4 + 3] = w.w; }
        __syncthreads();
#pragma unroll
        for (int i = 0; i < 16; ++i) {
            *(bf16_t*)(VbT + (cq * 32 + 2 * i) * 144 + c * 2) = f2bf(__uint_as_float(vvp[i] << 16) * bc);
            *(bf16_t*)(VbT + (cq * 32 + 2 * i + 1) * 144 + c * 2) = f2bf(__uint_as_float(vvp[i] & 0xffff0000u) * bc);
            *(bf16_t*)(KbgT + (cq * 32 + 2 * i) * 144 + c * 2) = f2bf(__uint_as_float(kvp[i] << 16) * bg);
            *(bf16_t*)(KbgT + (cq * 32 + 2 * i + 1) * 144 + c * 2) = f2bf(__uint_as_float(kvp[i] & 0xffff0000u) * bg);
        }
    }
    {
        char* L21i = lds + GP_END;
        char* T11T = L21i + 2560;
        char* MT = T11T + 2560;
        if (wid < 2) {
            const int o = 32 * wid;
            float Tc[32];
#pragma unroll
            for (int i = 0; i < 32; ++i) Tc[i] = (i == (lane & 31)) ? 1.f : 0.f;
#pragma unroll
            for (int j = 0; j < 31; ++j) {
                const float tj = Tc[j];
#pragma unroll
                for (int i4 = (j + 1) >> 2; i4 < 8; ++i4) {
                    const f32x4 l4 = *(const f32x4*)&Lf[(o + j) * 68 + o + i4 * 4];
#pragma unroll
                    for (int e = 0; e < 4; ++e) if (i4 * 4 + e > j) Tc[i4 * 4 + e] -= l4[e] * tj;
                }
            }
            if (lane < 32) {
#pragma unroll
                for (int i = 0; i < 32; ++i) *(bf16_t*)(Trow + (o + i) * 144 + (o + lane) * 2) = f2bf(Tc[i]);
                if (wid == 0) {
#pragma unroll
                    for (int i = 0; i < 32; ++i) *(bf16_t*)(Trow + i * 144 + (32 + lane) * 2) = 0;
#pragma unroll
                    for (int i4 = 0; i4 < 8; ++i4) { u32x2 w; w.x = pack2(Tc[i4 * 4], Tc[i4 * 4 + 1]); w.y = pack2(Tc[i4 * 4 + 2], Tc[i4 * 4 + 3]); *(u32x2*)(T11T + lane * 80 + i4 * 8) = w; }
                }
            }
        } else {
            const int t2 = tid - 128;
#pragma unroll
            for (int g2 = 0; g2 < 2; ++g2) {
                const int i = t2 & 31, k4 = ((t2 >> 5) + 4 * g2) * 4;
                u32x2 w;
                w.x = pack2(Lf[(k4 + 0) * 68 + 32 + i], Lf[(k4 + 1) * 68 + 32 + i]); w.y = pack2(Lf[(k4 + 2) * 68 + 32 + i], Lf[(k4 + 3) * 68 + 32 + i]);
                *(u32x2*)(L21i + i * 80 + k4 * 2) = w;
            }
        }
        __syncthreads();
        {
            const int r0 = 16 * (wid >> 1), c0 = 16 * (wid & 1);
            const f32x4 mm = tile16(L21i, 80, r0, T11T, 80, c0, 32);
            u32x2 w; w.x = pack2(mm[0], mm[1]); w.y = pack2(mm[2], mm[3]);
            *(u32x2*)(MT + (c0 + fr) * 80 + (r0 + 4 * fq) * 2) = w;
        }
        __syncthreads();
        {
            const int r0 = 16 * (wid >> 1), c0 = 16 * (wid & 1);
            const f32x4 tt = tile16(MT, 80, c0, Trow + 32 * 144 + 64, 144, r0, 32);
            u32x2 w; w.x = pack2(-tt[0], -tt[1]); w.y = pack2(-tt[2], -tt[3]);
            *(u32x2*)(Trow + (32 + r0 + fr) * 144 + (c0 + 4 * fq) * 2) = w;
        }
    }
    __syncthreads();
#pragma unroll
    for (int tq = 0; tq < 2; ++tq) {
        const int tj = wid * 2 + tq;
#pragma unroll
        for (int ti = 0; ti < 4; ++ti) {
            const f32x4 u = tile16(Trow, 144, 16 * ti, VbT, 144, 16 * tj, 64);
            {
                const int dv = 16 * tj + fr, slice = dv >> 5, rr = dv & 31, cb = 16 * ti + fq * 4, mt = cb >> 5, q4 = (cb & 31) >> 2, hh = q4 & 1, rg = q4 >> 1;
                u32x2 w; w.x = pack2(u[0], u[1]); w.y = pack2(u[2], u[3]);
                *(u32x2*)(ops + GO_UF + ((size_t)((slice * 2 + mt) * 64 + hh * 32 + rr) * 16 + rg * 4) * 2) = w;
            }
            const f32x4 wv = tile16(KbgT, 144, 16 * tj, Trow, 144, 16 * ti, 64);
            {
                const int c1 = 16 * ti + fr, mt = c1 >> 5, rr = c1 & 31, hh = fq & 1, jg = fq >> 1;
                u32x2 w; w.x = pack2(-wv[0], -wv[1]); w.y = pack2(-wv[2], -wv[3]);
                *(u32x2*)(ops + GO_WF + ((size_t)((mt * 8 + tj) * 64 + hh * 32 + rr) * 8 + jg * 4) * 2) = w;
            }
        }
    }
}

DI void glds16(const void* g, char* l) { __builtin_amdgcn_global_load_lds((const unsigned*)g, (lds_u32*)l, 16, 0, 0); }
DI void fr_rd(bf16x8& f, unsigned addr) { asm volatile("ds_read_b128 %0, %1" : "=v"(f) : "v"(addr) : "memory"); }
template <int N> DI void fr_wait(bf16x8& f) { asm volatile("s_waitcnt lgkmcnt(%1)" : "+v"(f) : "n"(N) : "memory"); }
template <int REM> DI void fr_waitc(bf16x8& f) { if (REM >= 3) fr_wait<3>(f); else if (REM == 2) fr_wait<2>(f); else if (REM == 1) fr_wait<1>(f); else fr_wait<0>(f); }
#define GS_WAIT(n) asm volatile("s_waitcnt vmcnt(" #n ")" ::: "memory")
DI void gdn_scan_block(const P& p, int bh, char* lds, bool dry = false) {
    const int tid = tidx(), lane = tid & 63, w = tid >> 6;
    const int h = bh & 3, b = bh >> 2;
    const float eglv = ((const float*)(p.ws + WS_CTL + CTL_EGL))[(b * 64 + lane) * 4 + h];
    unsigned char* gbase = p.ws + WS_GOPS + (size_t)(b * 256 + h) * GOPS_CH;
    auto issue = [&](int n, int k0, int cntk) {
        for (int k = k0; k < k0 + cntk; ++k) {
            const unsigned char* src = gbase + (size_t)n * 4 * GOPS_CH + k * 8192 + tid * 16;
            char* dst = lds + k * 8192 + tid * 16;
            glds16(src, dst); glds16(src + 4096, dst + 4096);
        }
    };
    const unsigned la = (unsigned)(size_t)(lds_u32*)lds + lane * 16;
    f32x16 S[4];
#pragma unroll
    for (int i = 0; i < 4; ++i)
#pragma unroll
        for (int r = 0; r < 16; ++r) S[i][r] = 0.f;
    __syncthreads();
    issue(0, 0, 7);
#pragma unroll 1
    for (int n = 0; n < 64; ++n) {
        const float egl = __shfl(eglv, n);
        bf16x8 Sb[8];
#pragma unroll
        for (int i = 0; i < 4; ++i) { Sb[i * 2] = pack_step(S[i], 0); Sb[i * 2 + 1] = pack_step(S[i], 1); }
        f32x16 av[2], ao[2];
        GS_WAIT(6);
        __builtin_amdgcn_s_barrier();
        issue(n, 7, 2);
        __builtin_amdgcn_sched_barrier(0);
        {
            const char* sl = lds + (w >> 1) * 8192;
#pragma unroll
            for (int mt = 0; mt < 2; ++mt) {
                const u32x4* up = (const u32x4*)(sl + ((w & 1) * 2 + mt) * 2048 + lane * 32);
                const u32x4 u0 = up[0], u1 = up[1];
#pragma unroll
                for (int e = 0; e < 4; ++e) {
                    av[mt][e * 2] = __uint_as_float(u0[e] << 16); av[mt][e * 2 + 1] = __uint_as_float(u0[e] & 0xffff0000u);
                    av[mt][8 + e * 2] = __uint_as_float(u1[e] << 16); av[mt][8 + e * 2 + 1] = __uint_as_float(u1[e] & 0xffff0000u);
                }
            }
        }
        bf16x8 F[4];
#define GS_O0(j) (unsigned)((2 + ((j) & 1)) * 8192 + ((j) >> 1) * 1024)
#pragma unroll
        for (int j = 0; j < 4; ++j) fr_rd(F[j], la + GS_O0(j));
#pragma unroll
        for (int j = 0; j < 16; ++j) {
            if (j <= 12) fr_wait<3>(F[j & 3]); else if (j == 13) fr_wait<2>(F[j & 3]); else if (j == 14) fr_wait<1>(F[j & 3]); else fr_wait<0>(F[j & 3]);
            av[j & 1] = mfma32(F[j & 3], Sb[j >> 1], av[j & 1]);
            if (j + 4 < 16) fr_rd(F[j & 3], la + GS_O0(j + 4));
        }
        bf16x8 Vb[4];
#pragma unroll
        for (int mt = 0; mt < 2; ++mt) { Vb[mt * 2] = pack_step(av[mt], 0); Vb[mt * 2 + 1] = pack_step(av[mt], 1); }
        GS_WAIT(4);
        __builtin_amdgcn_s_barrier();
        if (n < 63) issue(n + 1, 0, 4);
        __builtin_amdgcn_sched_barrier(0);
#pragma unroll
        for (int mt = 0; mt < 2; ++mt)
#pragma unroll
            for (int r = 0; r < 16; ++r) ao[mt][r] = 0.f;
#define GS_O1(j) (unsigned)((j) < 16 ? (4 + ((j) & 1)) * 8192 + ((j) >> 1) * 1024 : 6 * 8192 + ((j) == 16 ? 0 : (j) == 17 ? 4 : (j) == 18 ? 1 : (j) == 19 ? 5 : (j) == 20 ? 6 : 7) * 1024)
#pragma unroll
        for (int j = 0; j < 4; ++j) fr_rd(F[j], la + GS_O1(j));
#pragma unroll
        for (int j = 0; j < 22; ++j) {
            if (j <= 18) fr_wait<3>(F[j & 3]); else if (j == 19) fr_wait<2>(F[j & 3]); else if (j == 20) fr_wait<1>(F[j & 3]); else fr_wait<0>(F[j & 3]);
            if (j < 16) {
                ao[j & 1] = mfma32(F[j & 3], Sb[j >> 1], ao[j & 1]);
                if (j & 1) {
                    const int ks = j >> 1;
#pragma unroll
                    for (int r = 0; r < 8; ++r) S[ks >> 1][(ks & 1) * 8 + r] *= egl;
                }
            } else {
                const int oi = (j == 16 || j == 18) ? 0 : 1, kv = j <= 17 ? 0 : j <= 19 ? 1 : j == 20 ? 2 : 3;
                ao[oi] = mfma32(F[j & 3], Vb[kv], ao[oi]);
            }
            if (j + 4 < 22) fr_rd(F[j & 3], la + GS_O1(j + 4));
        }
        if (n < 63) GS_WAIT(8); else GS_WAIT(0);
        __builtin_amdgcn_s_barrier();
        if (n < 63) issue(n + 1, 4, 3);
        __builtin_amdgcn_sched_barrier(0);
#define GS_O2(j) (unsigned)((7 + (((j) & 3) >> 1)) * 8192 + ((((j) & 3) & 1) * 4 + ((j) >> 2)) * 1024)
#pragma unroll
        for (int j = 0; j < 4; ++j) fr_rd(F[j], la + GS_O2(j));
#pragma unroll
        for (int j = 0; j < 16; ++j) {
            if (j <= 12) fr_wait<3>(F[j & 3]); else if (j == 13) fr_wait<2>(F[j & 3]); else if (j == 14) fr_wait<1>(F[j & 3]); else fr_wait<0>(F[j & 3]);
            S[j & 3] = mfma32(F[j & 3], Vb[j >> 2], S[j & 3]);
            if (j + 4 < 16) fr_rd(F[j & 3], la + GS_O2(j + 4));
        }
        {
            u32x4* Of = (u32x4*)((dry ? p.ws + WS_DUMMY + (size_t)(bh & 15) * 65536 : gbase + (size_t)n * 4 * GOPS_CH) + GO_UF) + (size_t)(w * 2 * 64 + lane) * 2;
#pragma unroll
            for (int mt = 0; mt < 2; ++mt) {
                u32x4 o0, o1;
#pragma unroll
                for (int e = 0; e < 4; ++e) { o0[e] = pack2(ao[mt][e * 2], ao[mt][e * 2 + 1]); o1[e] = pack2(ao[mt][8 + e * 2], ao[mt][8 + e * 2 + 1]); }
                Of[mt * 128] = o0; Of[mt * 128 + 1] = o1;
            }
        }
    }
    __syncthreads();
}

DI void gdn_post_unit(const P& p, int li, int ch) {
    const int tid = tidx();
    const int h = ch & 3, n = (ch >> 2) & 63, b = ch >> 8;
    const int t0 = b * SEQ + n * 64;
    const int c = tid >> 2, cq = tid & 3;
    const bf16_t* Of = (const bf16_t*)(p.ws + WS_GOPS + (size_t)ch * GOPS_CH + GO_UF);
    const bf16_t* proj = (const bf16_t*)(p.ws + WS_PROJ);
    bf16_t* mix = (bf16_t*)(p.ws + WS_PROJ);
    const float* nw = p.in[I_GDNNORM] + li * 128 + cq * 32;
    const int mt = c >> 5, q4 = (c & 31) >> 2, hh = q4 & 1, rg = q4 >> 1, reg = rg * 4 + (c & 3);
    float o[32]; float ss = 0.f;
#pragma unroll
    for (int r = 0; r < 32; ++r) { o[r] = bf2f(Of[(size_t)((cq * 2 + mt) * 64 + hh * 32 + r) * 16 + reg]); ss += o[r] * o[r]; }
    ss += __shfl_xor(ss, 1); ss += __shfl_xor(ss, 2);
    const float rs = rsqrtf(ss * (1.f / 128.f) + 1e-6f);
    const bf16_t* zp = proj + (size_t)(t0 + c) * EVLD + 1536 + h * 128 + cq * 32;
    bf16_t* mp = mix + (size_t)(t0 + c) * EVLD + h * 128 + cq * 32;
#pragma unroll
    for (int i4 = 0; i4 < 4; ++i4) {
        const u32x4 zw = *(const u32x4*)(zp + i4 * 8);
        u32x4 w;
#pragma unroll
        for (int e = 0; e < 4; ++e) {
            const float z0 = __uint_as_float(zw[e] << 16), z1 = __uint_as_float(zw[e] & 0xffff0000u);
            w[e] = pack2(o[i4 * 8 + e * 2] * rs * nw[i4 * 8 + e * 2] * siluf_(z0), o[i4 * 8 + e * 2 + 1] * rs * nw[i4 * 8 + e * 2 + 1] * siluf_(z1));
        }
        *(u32x4*)(mp + i4 * 8) = w;
    }
}


constexpr int RP_Z0 = 0, RP_Z1 = 18432, RP_Z2 = 55296, RP_VEC = 73728, RP_PT = 75008, RP_T11 = 78080, RP_END = 80640;
constexpr int RP_LIN = 0, RP_LW = 25600;
DI void rwkv_prep_unit(const P& p, int li, int ch, char* lds) {
    const int tid = tidx(), lane = tid & 63, wid = tid >> 6, fr = lane & 15, fq = lane >> 4;
    const int h = ch & 7, n = (ch >> 3) & 63, b = ch >> 9;
    const int t0 = b * SEQ + n * 64;
    const bf16_t* proj = (const bf16_t*)(p.ws + WS_PROJ);
    char* Lfc = lds + RP_Z0; float* Lf = (float*)Lfc;
    char* ApT = lds + RP_Z0; char* AkVT = lds + RP_Z0 + 9216;
    char* Arow = lds + RP_Z1; char* Rrow = Arow + 9216; char* Brow = Arow + 18432; char* Krow = Arow + 27648;
    char* Aak = Arow; char* Arb = Rrow; char* Ark = Brow; char* Trow = Krow; char* BhT = Krow; char* VpT = Aak;
    char* AT = lds + RP_Z2; char* VT = AT + 9216; char* KhT = AT;
    float* tot = (float*)(lds + RP_VEC); float* WC = tot + 256;
    char* lin = lds + RP_LIN; char* LWi = lds + RP_LW;
    float* PT = (float*)(lds + RP_PT);
    {
        const float* mu0 = p.in[I_MU] + (size_t)li * 1696;
        if (tid < 48) {
            const int j0 = tid * 4;
            *(float4*)(PT + j0) = j0 < 160 ? *(const float4*)(mu0 + (C_HW - RW0) + j0) : *(const float4*)(p.in[I_VRESMU] + j0 - 160);
        } else if (tid < 48 + 144) {
            const int q = tid - 48, arr = q >> 4, c4 = (q & 15) * 4, chn = h * 64 + c4;
            const float* src = arr == 0 ? mu0 + (C_R - RW0) + chn : arr == 1 ? mu0 + (C_K - RW0) + chn : arr == 2 ? mu0 + (C_V - RW0) + chn
                             : arr == 3 ? p.in[I_W0] + li * 512 + chn : arr == 4 ? p.in[I_A0] + li * 512 + chn : arr == 5 ? p.in[I_V0] + chn
                             : arr == 6 ? p.in[I_KK] + li * 512 + chn : arr == 7 ? p.in[I_KA] + li * 512 + chn : p.in[I_RK] + li * 512 + chn;
            *(float4*)(PT + 192 + arr * 64 + c4) = *(const float4*)src;
        }
    }
    __syncthreads();
    {
        const int c = tid >> 2, cq = tid & 3, s = n * 64 + c;
        const bf16_t* cur = proj + (size_t)(t0 + c) * EVLD + C_HW + cq * 48;
        const float* mu = p.in[I_MU] + (size_t)li * 1696 + (C_HW - RW0);
        const float* vmu = p.in[I_VRESMU];
#pragma unroll
        for (int i6 = 0; i6 < 6; ++i6) {
            const u32x4 cw4 = *(const u32x4*)(cur + i6 * 8);
            u32x4 pw4 = *(const u32x4*)(cur - (s > 0 ? EVLD : 0) + i6 * 8);
            if (s == 0) pw4 = (u32x4){0u, 0u, 0u, 0u};
            const int j0 = cq * 48 + i6 * 8;
            const float4 ma = *(const float4*)(PT + j0), mb = *(const float4*)(PT + j0 + 4);
            const float mm[8] = {ma.x, ma.y, ma.z, ma.w, mb.x, mb.y, mb.z, mb.w};
            const bool is_t = j0 < 32, is_s = (j0 >= 64) && (j0 < 160);
            const float ca = is_t ? 1.f : 0.f, cb = is_t ? -2.f : 1.f, cc = is_t ? 2.f : -1.f;
            u32x4 w;
#pragma unroll
            for (int e = 0; e < 4; ++e) {
                float o2[2];
#pragma unroll
                for (int q = 0; q < 2; ++q) {
                    const float cv = q ? __uint_as_float(cw4[e] & 0xffff0000u) : __uint_as_float(cw4[e] << 16);
                    const float pv = q ? __uint_as_float(pw4[e] & 0xffff0000u) : __uint_as_float(pw4[e] << 16);
                    const float val = cv + mm[e * 2 + q] * (pv - cv);
                    const float act = ca + cb * __builtin_amdgcn_rcpf(1.f + __expf(cc * val));
                    o2[q] = (is_t || is_s) ? act : val;
                }
                w[e] = pack2(o2[0], o2[1]);
            }
            *(u32x4*)(lin + c * 400 + (cq * 48 + i6 * 8) * 2) = w;
        }
        const bf16_t* LW = (const bf16_t*)(p.ws + WS_W + W_LW) + (size_t)h * 64 * 192;
#pragma unroll
        for (int i6 = 0; i6 < 6; ++i6) *(u32x4*)(LWi + c * 400 + (cq * 48 + i6 * 8) * 2) = *(const u32x4*)(LW + (size_t)c * 192 + cq * 48 + i6 * 8);
    }
    __syncthreads();
    float lw_[16], la_[16], lg_[16], lv_[16];
#pragma unroll
    for (int tj = 0; tj < 4; ++tj) {
        const f32x4 a = tile16(LWi, 400, 16 * tj, lin, 400, 16 * wid, 32);
        const f32x4 bq = tile16(LWi + 64, 400, 16 * tj, lin + 64, 400, 16 * wid, 32);
        const f32x4 cg = tile16(LWi + 128, 400, 16 * tj, lin + 128, 400, 16 * wid, 96);
        const f32x4 dv = tile16(LWi + 320, 400, 16 * tj, lin + 320, 400, 16 * wid, 32);
#pragma unroll
        for (int r = 0; r < 4; ++r) { lw_[tj * 4 + r] = a[r]; la_[tj * 4 + r] = bq[r]; lg_[tj * 4 + r] = cg[r]; lv_[tj * 4 + r] = dv[r]; }
    }
    __syncthreads();
    const int c = 16 * wid + fr;
    float at[16], rt[16], bt[16], kt[16], bh[16], kh[16];
    {
        const int s = n * 64 + c;
        const size_t row = (size_t)(t0 + c);
        const float* mu = p.in[I_MU] + (size_t)li * 1696;
        const int hc = h * 64;
        float rr_[16], kk_[16], lwv[16], aa[16];
        float kn = 0.f, rk = 0.f;
        bf16_t* vf = (bf16_t*)(p.ws + WS_VF);
        bf16_t* gg = (bf16_t*)(p.ws + WS_GG);
#pragma unroll
        for (int tj = 0; tj < 4; ++tj) {
            const int cb = 16 * tj + 4 * fq;
            u32x2 cr = *(const u32x2*)(proj + row * EVLD + C_R + hc + cb), ck = *(const u32x2*)(proj + row * EVLD + C_K + hc + cb), cv = *(const u32x2*)(proj + row * EVLD + C_V + hc + cb);
            const size_t prow = s > 0 ? row - 1 : row;
            u32x2 pr = *(const u32x2*)(proj + prow * EVLD + C_R + hc + cb), pk = *(const u32x2*)(proj + prow * EVLD + C_K + hc + cb), pv = *(const u32x2*)(proj + prow * EVLD + C_V + hc + cb);
            if (s == 0) { pr = (u32x2){0u, 0u}; pk = pr; pv = pr; }
            u32x2 vfw = {0u, 0u};
            if (li == 1) vfw = *(const u32x2*)(vf + row * 512 + hc + cb);
            float vout[4], gout[4];
            const int ch0 = hc + cb;
            const float* pt = PT + 192 + cb;
            const float4 mu_r4 = *(const float4*)(pt), mu_k4 = *(const float4*)(pt + 64), mu_v4 = *(const float4*)(pt + 128);
            const float4 w0_4 = *(const float4*)(pt + 192), a0_4 = *(const float4*)(pt + 256), v0_4 = *(const float4*)(pt + 320);
            const float4 kk_4 = *(const float4*)(pt + 384), ka_4 = *(const float4*)(pt + 448), rk_4 = *(const float4*)(pt + 512);
            const float mur[4] = {mu_r4.x, mu_r4.y, mu_r4.z, mu_r4.w}, muk[4] = {mu_k4.x, mu_k4.y, mu_k4.z, mu_k4.w}, muv[4] = {mu_v4.x, mu_v4.y, mu_v4.z, mu_v4.w};
            const float w0v[4] = {w0_4.x, w0_4.y, w0_4.z, w0_4.w}, a0v[4] = {a0_4.x, a0_4.y, a0_4.z, a0_4.w}, v0v[4] = {v0_4.x, v0_4.y, v0_4.z, v0_4.w};
            const float kkp[4] = {kk_4.x, kk_4.y, kk_4.z, kk_4.w}, kap[4] = {ka_4.x, ka_4.y, ka_4.z, ka_4.w}, rkp[4] = {rk_4.x, rk_4.y, rk_4.z, rk_4.w};
#pragma unroll
            for (int r = 0; r < 4; ++r) {
                const int i = tj * 4 + r;
                const unsigned wcr = r < 2 ? cr.x : cr.y, wck = r < 2 ? ck.x : ck.y, wcv = r < 2 ? cv.x : cv.y;
                const unsigned wpr = r < 2 ? pr.x : pr.y, wpk = r < 2 ? pk.x : pk.y, wpv = r < 2 ? pv.x : pv.y, wvf = r < 2 ? vfw.x : vfw.y;
                const float c_r = (r & 1) ? __uint_as_float(wcr & 0xffff0000u) : __uint_as_float(wcr << 16);
                const float c_k = (r & 1) ? __uint_as_float(wck & 0xffff0000u) : __uint_as_float(wck << 16);
                const float c_v = (r & 1) ? __uint_as_float(wcv & 0xffff0000u) : __uint_as_float(wcv << 16);
                const float p_r = (r & 1) ? __uint_as_float(wpr & 0xffff0000u) : __uint_as_float(wpr << 16);
                const float p_k = (r & 1) ? __uint_as_float(wpk & 0xffff0000u) : __uint_as_float(wpk << 16);
                const float p_v = (r & 1) ? __uint_as_float(wpv & 0xffff0000u) : __uint_as_float(wpv << 16);
                const float rm = c_r + mur[r] * (p_r - c_r);
                const float km = c_k + muk[r] * (p_k - c_k);
                float vm = c_v + muv[r] * (p_v - c_v);
                const float wlog = -softplusf_(-(w0v[r] + lw_[i])) - 0.5f;
                lwv[i] = -__expf(wlog);
                const float a = sigmoidf_(a0v[r] + la_[i]);
                if (li == 1) {
                    const float v1 = (r & 1) ? __uint_as_float(wvf & 0xffff0000u) : __uint_as_float(wvf << 16);
                    vm = vm + (v1 - vm) * sigmoidf_(v0v[r] + lv_[i]);
                }
                const float kkv = km * kkp[r];
                kn += kkv * kkv;
                rr_[i] = rm; kk_[i] = kkv; aa[i] = a;
                kt[i] = km * (1.f + (a - 1.f) * kap[r]);
                rk += rm * kt[i] * rkp[r];
                vout[r] = vm; gout[r] = lg_[i];
            }
            u32x2 w; w.x = pack2(vout[0], vout[1]); w.y = pack2(vout[2], vout[3]);
            *(u32x2*)(vf + row * 512 + hc + cb) = w;
            w.x = pack2(gout[0], gout[1]); w.y = pack2(gout[2], gout[3]);
            *(u32x2*)(gg + row * 512 + hc + cb) = w;
#pragma unroll
            for (int r = 0; r < 4; ++r) *(bf16_t*)(VT + (cb + r) * 144 + c * 2) = f2bf(vout[r]);
            __builtin_amdgcn_sched_barrier(0);
        }
        kn += __shfl_xor(kn, 16); kn += __shfl_xor(kn, 32);
        const float kr = rsqrtf(kn + 1e-6f);
        rk += __shfl_xor(rk, 16); rk += __shfl_xor(rk, 32);
        if (fq == 0) ((float*)(p.ws + WS_RK))[row * 8 + h] = rk;
        float cs[16];
#pragma unroll
        for (int i = 0; i < 16; ++i) {
            float x = lwv[i];
#pragma unroll
            for (int o = 1; o < 16; o <<= 1) { const float y = __shfl_up(x, o, 16); if (fr >= o) x += y; }
            cs[i] = x;
        }
        if (fr == 15) {
#pragma unroll
            for (int i = 0; i < 16; ++i) tot[wid * 64 + 16 * (i >> 2) + 4 * fq + (i & 3)] = cs[i];
        }
        __syncthreads();
#pragma unroll
        for (int i = 0; i < 16; ++i) {
            const int chl = 16 * (i >> 2) + 4 * fq + (i & 3);
            float pre = 0.f, all = 0.f;
#pragma unroll
            for (int w2 = 0; w2 < 4; ++w2) { const float tv = tot[w2 * 64 + chl]; all += tv; if (w2 < wid) pre += tv; }
            const float csi = cs[i] + pre, csm = csi - lwv[i];
            const float kkn = kk_[i] * kr, k2 = kt[i];
            const float e_c = __expf(csi), e_n = __builtin_amdgcn_rcpf(e_c), e_m = __expf(csm), e_h = __expf(all) * e_n;
            at[i] = -kkn * e_m; rt[i] = rr_[i] * e_c;
            const float bp = kkn * aa[i];
            bt[i] = bp * e_n; kt[i] = k2 * e_n; bh[i] = bp * e_h; kh[i] = k2 * e_h;
            if (c == 0) WC[chl] = __expf(all);
            if ((i & 3) == 3) __builtin_amdgcn_sched_barrier(0);
        }
    }
#pragma unroll
    for (int tj = 0; tj < 4; ++tj) {
        const int cb = 16 * tj + 4 * fq;
        u32x2 w;
        w.x = pack2(at[tj * 4], at[tj * 4 + 1]); w.y = pack2(at[tj * 4 + 2], at[tj * 4 + 3]); *(u32x2*)(Arow + c * 144 + cb * 2) = w;
        w.x = pack2(rt[tj * 4], rt[tj * 4 + 1]); w.y = pack2(rt[tj * 4 + 2], rt[tj * 4 + 3]); *(u32x2*)(Rrow + c * 144 + cb * 2) = w;
        w.x = pack2(bt[tj * 4], bt[tj * 4 + 1]); w.y = pack2(bt[tj * 4 + 2], bt[tj * 4 + 3]); *(u32x2*)(Brow + c * 144 + cb * 2) = w;
        w.x = pack2(kt[tj * 4], kt[tj * 4 + 1]); w.y = pack2(kt[tj * 4 + 2], kt[tj * 4 + 3]); *(u32x2*)(Krow + c * 144 + cb * 2) = w;
#pragma unroll
        for (int r = 0; r < 4; ++r) {
            *(bf16_t*)(AT + (cb + r) * 144 + c * 2) = f2bf(at[tj * 4 + r]);
        }
    }
    __syncthreads();
    f32x4 pab[4], pak[4], prb[4], prk[4];
    {
        const int ti = wid;
#pragma unroll
        for (int tj = 0; tj < 4; ++tj) {
            pab[tj] = (f32x4){0.f, 0.f, 0.f, 0.f}; pak[tj] = pab[tj]; prb[tj] = pab[tj]; prk[tj] = pab[tj];
            if (tj <= ti) {
                pab[tj] = tile16(Arow, 144, 16 * ti, Brow, 144, 16 * tj, 64);
                pak[tj] = tile16(Krow, 144, 16 * tj, Arow, 144, 16 * ti, 64);
                prb[tj] = tile16(Brow, 144, 16 * tj, Rrow, 144, 16 * ti, 64);
                prk[tj] = tile16(Krow, 144, 16 * tj, Rrow, 144, 16 * ti, 64);
            }
        }
    }
    __syncthreads();
    {
        const int ti = wid;
#pragma unroll
        for (int tj = 0; tj < 4; ++tj) {
            const int s1 = 16 * tj + fr;
            f32x4 lv;
#pragma unroll
            for (int r = 0; r < 4; ++r) { const int t1 = 16 * ti + 4 * fq + r; lv[r] = (s1 < t1) ? -pab[tj][r] : 0.f; }
            *(f32x4*)&Lf[s1 * 72 + 16 * ti + 4 * fq] = lv;
            const int t2 = 16 * ti + fr;
            float m1[4], m2[4], m3[4];
#pragma unroll
            for (int r = 0; r < 4; ++r) { const int s2 = 16 * tj + 4 * fq + r; m1[r] = (s2 < t2) ? pak[tj][r] : 0.f; m2[r] = (s2 <= t2) ? prb[tj][r] : 0.f; m3[r] = (s2 <= t2) ? prk[tj][r] : 0.f; }
            u32x2 w;
            w.x = pack2(m1[0], m1[1]); w.y = pack2(m1[2], m1[3]); *(u32x2*)(Aak + t2 * 144 + (16 * tj + 4 * fq) * 2) = w;
            w.x = pack2(m2[0], m2[1]); w.y = pack2(m2[2], m2[3]); *(u32x2*)(Arb + t2 * 144 + (16 * tj + 4 * fq) * 2) = w;
            w.x = pack2(m3[0], m3[1]); w.y = pack2(m3[2], m3[3]); *(u32x2*)(Ark + t2 * 144 + (16 * tj + 4 * fq) * 2) = w;
        }
    }
    __syncthreads();
    {
        char* L21i = lds + RP_PT;
        char* T11T = lds + RP_T11;
        char* MT = lds + RP_Z0;
        if (wid < 2) {
            const int o = 32 * wid;
            float Tc[32];
#pragma unroll
            for (int i = 0; i < 32; ++i) Tc[i] = (i == (lane & 31)) ? 1.f : 0.f;
#pragma unroll
            for (int j = 0; j < 31; ++j) {
                const float tj = Tc[j];
#pragma unroll
                for (int i4 = (j + 1) >> 2; i4 < 8; ++i4) {
                    const f32x4 l4 = *(const f32x4*)&Lf[(o + j) * 72 + o + i4 * 4];
#pragma unroll
                    for (int e = 0; e < 4; ++e) if (i4 * 4 + e > j) Tc[i4 * 4 + e] -= l4[e] * tj;
                }
            }
            if (lane < 32) {
#pragma unroll
                for (int i = 0; i < 32; ++i) *(bf16_t*)(Trow + (o + i) * 144 + (o + lane) * 2) = f2bf(Tc[i]);
                if (wid == 0) {
#pragma unroll
                    for (int i = 0; i < 32; ++i) *(bf16_t*)(Trow + i * 144 + (32 + lane) * 2) = 0;
#pragma unroll
                    for (int i4 = 0; i4 < 8; ++i4) { u32x2 w; w.x = pack2(Tc[i4 * 4], Tc[i4 * 4 + 1]); w.y = pack2(Tc[i4 * 4 + 2], Tc[i4 * 4 + 3]); *(u32x2*)(T11T + lane * 80 + i4 * 8) = w; }
                }
            }
        } else {
            const int t2 = tid - 128;
#pragma unroll
            for (int g2 = 0; g2 < 2; ++g2) {
                const int i = t2 & 31, k4 = ((t2 >> 5) + 4 * g2) * 4;
                u32x2 w;
                w.x = pack2(Lf[(k4 + 0) * 72 + 32 + i], Lf[(k4 + 1) * 72 + 32 + i]); w.y = pack2(Lf[(k4 + 2) * 72 + 32 + i], Lf[(k4 + 3) * 72 + 32 + i]);
                *(u32x2*)(L21i + i * 80 + k4 * 2) = w;
            }
        }
        __syncthreads();
        {
            const int r0 = 16 * (wid >> 1), c0 = 16 * (wid & 1);
            const f32x4 mm = tile16(L21i, 80, r0, T11T, 80, c0, 32);
            u32x2 w; w.x = pack2(mm[0], mm[1]); w.y = pack2(mm[2], mm[3]);
            *(u32x2*)(MT + (c0 + fr) * 80 + (r0 + 4 * fq) * 2) = w;
        }
        __syncthreads();
        {
            const int r0 = 16 * (wid >> 1), c0 = 16 * (wid & 1);
            const f32x4 tt = tile16(MT, 80, c0, Trow + 32 * 144 + 64, 144, r0, 32);
            u32x2 w; w.x = pack2(-tt[0], -tt[1]); w.y = pack2(-tt[2], -tt[3]);
            *(u32x2*)(Trow + (32 + r0 + fr) * 144 + (c0 + 4 * fq) * 2) = w;
        }
    }
    __syncthreads();
    {
        const int ti = wid;
#pragma unroll
        for (int tj = 0; tj < 4; ++tj) {
            const f32x4 x = tile16(Trow, 144, 16 * ti, AT, 144, 16 * tj, 64);
            const f32x4 y = tile16(Aak, 144, 16 * ti, VT, 144, 16 * tj, 64);
            u32x2 w;
            w.x = pack2(x[0], x[1]); w.y = pack2(x[2], x[3]); *(u32x2*)(ApT + (16 * tj + fr) * 144 + (16 * ti + 4 * fq) * 2) = w;
            w.x = pack2(y[0], y[1]); w.y = pack2(y[2], y[3]); *(u32x2*)(AkVT + (16 * tj + fr) * 144 + (16 * ti + 4 * fq) * 2) = w;
        }
    }
    __syncthreads();
    {
        const int ti = wid;
#pragma unroll
        for (int tj = 0; tj < 4; ++tj) {
            const f32x4 x = tile16(Trow, 144, 16 * ti, AkVT, 144, 16 * tj, 64);
            u32x2 w; w.x = pack2(x[0], x[1]); w.y = pack2(x[2], x[3]); *(u32x2*)(VpT + (16 * tj + fr) * 144 + (16 * ti + 4 * fq) * 2) = w;
        }
    }
    __syncthreads();
#pragma unroll
    for (int tj = 0; tj < 4; ++tj)
#pragma unroll
        for (int r = 0; r < 4; ++r) {
            const int cb = 16 * tj + 4 * fq + r;
            *(bf16_t*)(BhT + cb * 144 + c * 2) = f2bf(bh[tj * 4 + r]);
            *(bf16_t*)(KhT + cb * 144 + c * 2) = f2bf(kh[tj * 4 + r]);
        }
    __syncthreads();
    {
        unsigned char* opsA = (unsigned char*)p.out + (size_t)ch * 16384;
        unsigned char* opsB = p.ws + WS_ROPS + (size_t)ch * 16384;
        const int ti = wid;
#pragma unroll
        for (int tj = 0; tj < 4; ++tj) {
            const f32x4 x = tile16(ApT, 144, 16 * tj, Arb, 144, 16 * ti, 64);
            const f32x4 g = tile16(ApT, 144, 16 * tj, BhT, 144, 16 * ti, 64);
            const int m1 = 16 * ti + fr, mt = m1 >> 5, rr = m1 & 31, hh = fq & 1, jg = fq >> 1;
            const size_t off = ((size_t)((mt * 4 + tj) * 64 + hh * 32 + rr) * 8 + jg * 4) * 2;
            float gd[4];
#pragma unroll
            for (int r = 0; r < 4; ++r) gd[r] = g[r] + ((16 * tj + 4 * fq + r == m1) ? WC[m1] : 0.f);
            u32x2 w;
            w.x = pack2(x[0] + rt[tj * 4], x[1] + rt[tj * 4 + 1]); w.y = pack2(x[2] + rt[tj * 4 + 2], x[3] + rt[tj * 4 + 3]); *(u32x2*)(opsA + off) = w;
            w.x = pack2(gd[0], gd[1]); w.y = pack2(gd[2], gd[3]); *(u32x2*)(opsA + 8192 + off) = w;
            f32x4 y = tile16(Ark, 144, 16 * ti, VT, 144, 16 * tj, 64);
            const f32x4 y2 = tile16(Arb, 144, 16 * ti, VpT, 144, 16 * tj, 64);
            f32x4 kv = tile16(KhT, 144, 16 * ti, VT, 144, 16 * tj, 64);
            const f32x4 kv2 = tile16(BhT, 144, 16 * ti, VpT, 144, 16 * tj, 64);
            const int vcol = 16 * tj + fr, slice = vcol >> 5, r2 = vcol & 31, cb = 16 * ti + 4 * fq, mt2 = cb >> 5, q4 = (cb & 31) >> 2, h2 = q4 & 1, rg = q4 >> 1;
            const size_t off2 = ((size_t)((slice * 2 + mt2) * 64 + h2 * 32 + r2) * 16 + rg * 4) * 2;
            w.x = pack2(y[0] + y2[0], y[1] + y2[1]); w.y = pack2(y[2] + y2[2], y[3] + y2[3]); *(u32x2*)(opsB + off2) = w;
            w.x = pack2(kv[0] + kv2[0], kv[1] + kv2[1]); w.y = pack2(kv[2] + kv2[2], kv[3] + kv2[3]); *(u32x2*)(opsB + 8192 + off2) = w;
        }
    }
}

DI void rwkv_scan_block(const P& p, int bh, char* lds, bool dry = false) {
    const int tid = tidx(), lane = tid & 63, w = tid >> 6, slice = w & 1;
    const int h = bh & 7, b = bh >> 3;
    constexpr int NST = 64 * 2, AH = 3;
    auto issue = [&](int j) {
        const int n = j >> 1, k = j & 1;
        const size_t ch = (size_t)((b * 64 + n) * 8 + h) * 16384;
        const unsigned char* s0 = (k == 0 ? p.ws + WS_ROPS + ch + 8192 : p.ws + WS_ROPS + ch) + tid * 16;
        const unsigned char* s1 = (k == 0 ? (const unsigned char*)p.out + ch + 8192 : (const unsigned char*)p.out + ch) + tid * 16;
        char* dst = lds + (j & 3) * 16384 + tid * 16;
        glds16(s0, dst); glds16(s0 + 4096, dst + 4096); glds16(s1, dst + 8192); glds16(s1 + 4096, dst + 12288);
    };
    const unsigned la = (unsigned)(size_t)(lds_u32*)lds + lane * 16;
    f32x16 H[2];
#pragma unroll
    for (int i = 0; i < 2; ++i)
#pragma unroll
        for (int r = 0; r < 16; ++r) H[i][r] = 0.f;
    __syncthreads();
#pragma unroll
    for (int j = 0; j < AH; ++j) issue(j);
#pragma unroll 1
    for (int n = 0; n < 64; ++n) {
        bf16x8 Hb[4];
#pragma unroll
        for (int i = 0; i < 2; ++i) { Hb[i * 2] = pack_step(H[i], 0); Hb[i * 2 + 1] = pack_step(H[i], 1); }
#pragma unroll
        for (int k = 0; k < 2; ++k) {
            const int j = n * 2 + k;
            if (n < 63) GS_WAIT(8); else if (k == 0) GS_WAIT(4); else GS_WAIT(0);
            __builtin_amdgcn_s_barrier();
            if (j + AH < NST) issue(j + AH);
            __builtin_amdgcn_sched_barrier(0);
            const char* sl = lds + (j & 3) * 16384;
            if (w < 2) {
                f32x16 acc[2];
                bf16x8 F[4];
                const unsigned fa = la + (unsigned)((j & 3) * 16384 + 8192);
#define RS_O(i) (unsigned)((((i) & 1) * 4 + ((i) >> 1)) * 1024)
#pragma unroll
                for (int i = 0; i < 4; ++i) fr_rd(F[i], fa + RS_O(i));
#pragma unroll
                for (int mt = 0; mt < 2; ++mt) {
                    const u32x4* up = (const u32x4*)(sl + (slice * 2 + mt) * 2048 + lane * 32);
                    const u32x4 u0 = up[0], u1 = up[1];
#pragma unroll
                    for (int e = 0; e < 4; ++e) {
                        acc[mt][e * 2] = __uint_as_float(u0[e] << 16); acc[mt][e * 2 + 1] = __uint_as_float(u0[e] & 0xffff0000u);
                        acc[mt][8 + e * 2] = __uint_as_float(u1[e] << 16); acc[mt][8 + e * 2 + 1] = __uint_as_float(u1[e] & 0xffff0000u);
                    }
                }
#pragma unroll
                for (int i = 0; i < 8; ++i) {
                    if (i <= 4) fr_wait<3>(F[i & 3]); else if (i == 5) fr_wait<2>(F[i & 3]); else if (i == 6) fr_wait<1>(F[i & 3]); else fr_wait<0>(F[i & 3]);
                    acc[i & 1] = mfma32(F[i & 3], Hb[i >> 1], acc[i & 1]);
                    if (i + 4 < 8) fr_rd(F[i & 3], fa + RS_O(i + 4));
                }
                if (k == 0) { H[0] = acc[0]; H[1] = acc[1]; }
                else {
                    const size_t ch = (size_t)((b * 64 + n) * 8 + h) * 16384;
                    u32x4* Yf = (u32x4*)(dry ? p.ws + WS_DUMMY + 2097152 + (size_t)(bh & 31) * 16384 : p.ws + WS_ROPS + ch) + (size_t)(slice * 128 + lane) * 2;
#pragma unroll
                    for (int mt = 0; mt < 2; ++mt) {
                        u32x4 o0, o1;
#pragma unroll
                        for (int e = 0; e < 4; ++e) { o0[e] = pack2(acc[mt][e * 2], acc[mt][e * 2 + 1]); o1[e] = pack2(acc[mt][8 + e * 2], acc[mt][8 + e * 2 + 1]); }
                        Yf[mt * 128] = o0; Yf[mt * 128 + 1] = o1;
                    }
                }
            }
        }
    }
    __syncthreads();
}

DI void rwkv_post_unit(const P& p, int li, int ch) {
    const int tid = tidx();
    const int h = ch & 7, n = (ch >> 3) & 63, b = ch >> 9;
    const int t0 = b * SEQ + n * 64;
    const int c = tid >> 2, cq = tid & 3;
    const bf16_t* Yf = (const bf16_t*)(p.ws + WS_ROPS + (size_t)ch * 16384);
    const bf16_t* vf = (const bf16_t*)(p.ws + WS_VF) + (size_t)(t0 + c) * 512 + h * 64 + cq * 16;
    const bf16_t* gg = (const bf16_t*)(p.ws + WS_GG) + (size_t)(t0 + c) * 512 + h * 64 + cq * 16;
    const float rk = ((const float*)(p.ws + WS_RK))[(size_t)(t0 + c) * 8 + h];
    const float* lnw = p.in[I_LNW] + li * 512 + h * 64 + cq * 16;
    const float* lnb = p.in[I_LNB] + li * 512 + h * 64 + cq * 16;
    bf16_t* mp = (bf16_t*)p.out + (size_t)(t0 + c) * 1024 + 512 + h * 64 + cq * 16;
    const int mt = c >> 5, q4 = (c & 31) >> 2, hh = q4 & 1, rg = q4 >> 1, reg = rg * 4 + (c & 3), slice = cq >> 1, rb = (cq & 1) * 16;
    float y[16]; float sm = 0.f;
#pragma unroll
    for (int i = 0; i < 16; ++i) { y[i] = bf2f(Yf[(size_t)((slice * 2 + mt) * 64 + hh * 32 + rb + i) * 16 + reg]); sm += y[i]; }
    sm += __shfl_xor(sm, 1); sm += __shfl_xor(sm, 2);
    const float mean = sm * (1.f / 64.f);
    float vs = 0.f;
#pragma unroll
    for (int i = 0; i < 16; ++i) { y[i] -= mean; vs += y[i] * y[i]; }
    vs += __shfl_xor(vs, 1); vs += __shfl_xor(vs, 2);
    const float rs = rsqrtf(vs * (1.f / 64.f) + 64e-5f);
#pragma unroll
    for (int i8 = 0; i8 < 2; ++i8) {
        const u32x4 vw = *(const u32x4*)(vf + i8 * 8), gw = *(const u32x4*)(gg + i8 * 8);
        u32x4 w;
#pragma unroll
        for (int e = 0; e < 4; ++e) {
            const int i = i8 * 8 + e * 2;
            const float v0 = __uint_as_float(vw[e] << 16), v1 = __uint_as_float(vw[e] & 0xffff0000u), g0 = __uint_as_float(gw[e] << 16), g1 = __uint_as_float(gw[e] & 0xffff0000u);
            w[e] = pack2((y[i] * rs * lnw[i] + lnb[i] + rk * v0) * g0, (y[i + 1] * rs * lnw[i + 1] + lnb[i + 1] + rk * v1) * g1);
        }
        *(u32x4*)(mp + i8 * 8) = w;
    }
}


DI void attn_unit(const P& p, int unit, char* lds) {
    const int tid = tidx(), lane = tid & 63, w = tid >> 6, r_ = lane & 31, hl = lane >> 5;
    const int idx = unit & 31, h = (unit >> 5) & 7, g = (unit >> 8) % 3, b = unit / 768;
    const int lg2 = g * 2, dil = 1 << lg2, L = SEQ >> lg2, ntl = L >> 7;
    const int rs = idx / ntl, qt = idx % ntl;
    const int hg = g * 8 + h;
    const bf16_t* QK = (const bf16_t*)(p.ws + WS_QK);
    const bf16_t* VT = (const bf16_t*)(p.ws + WS_VT) + ((size_t)((b * 24 + hg) * dil + rs) * 64) * L;
    const int qi = 32 * w + r_;
    const int q_idx = 128 * qt + qi;
    const size_t qrow = (size_t)(b * SEQ + q_idx * dil + rs);
    const int kbase0 = 128 * qt - 128;
    char* Kt = lds;
    char* Vt = lds + 32768;
    __syncthreads();
#pragma unroll
    for (int i = 0; i < 8; ++i) {
        const int id = tid + i * 256, row = id >> 3, pc = id & 7, c = pc ^ ((row >> 1) & 7);
        int k_idx = kbase0 + row; if (k_idx < 0) k_idx = 0;
        glds16(QK + (size_t)(b * SEQ + k_idx * dil + rs) * 3072 + 1536 + hg * 64 + c * 8, Kt + id * 16);
    }
#pragma unroll
    for (int i = 0; i < 8; ++i) {
        const int id = tid + i * 256, row = id >> 5, pq = id & 31, q = pq ^ (row & 31);
        int k0 = kbase0 + q * 8; if (k0 < 0) k0 = 0;
        glds16(VT + (size_t)row * L + k0, Vt + id * 16);
    }
    bf16x8 qf[4];
#pragma unroll
    for (int ks = 0; ks < 4; ++ks) qf[ks] = *(const bf16x8*)(QK + qrow * 3072 + hg * 64 + 16 * ks + 8 * hl);
    asm volatile("s_waitcnt vmcnt(0)" ::: "memory");
    __syncthreads();
    f32x16 st[5];
    float mx = -1.0e30f;
#pragma unroll
    for (int kbi = 0; kbi < 5; ++kbi) {
        const int krow = 32 * (w + kbi) + r_;
#pragma unroll
        for (int r = 0; r < 16; ++r) st[kbi][r] = 0.f;
#pragma unroll
        for (int ks = 0; ks < 4; ++ks) {
            const bf16x8 kf = *(const bf16x8*)(Kt + krow * 128 + (((2 * ks + hl) ^ ((krow >> 1) & 7)) * 16));
            st[kbi] = mfma32(kf, qf[ks], st[kbi]);
        }
#pragma unroll
        for (int r = 0; r < 16; ++r) {
            const int kj = 32 * (w + kbi) + (r & 3) + 8 * (r >> 2) + 4 * hl;
            const bool valid = (kj >= qi) && (kj <= qi + 128) && (kbase0 + kj >= 0);
            const float sv = valid ? st[kbi][r] * 0.125f : -1.0e30f;
            st[kbi][r] = sv; mx = fmaxf(mx, sv);
        }
    }
    mx = fmaxf(mx, __shfl_xor(mx, 32));
    float l = 0.f;
#pragma unroll
    for (int kbi = 0; kbi < 5; ++kbi)
#pragma unroll
        for (int r = 0; r < 16; ++r) { const float pv = __expf(st[kbi][r] - mx); st[kbi][r] = pv; l += pv; }
    l += __shfl_xor(l, 32);
    f32x16 ot[2];
#pragma unroll
    for (int dt = 0; dt < 2; ++dt)
#pragma unroll
        for (int r = 0; r < 16; ++r) ot[dt][r] = 0.f;
#pragma unroll
    for (int kbi = 0; kbi < 5; ++kbi)
#pragma unroll
        for (int s2 = 0; s2 < 2; ++s2) {
            const bf16x8 pb = pack_step(st[kbi], s2);
            const int q0 = 4 * (w + kbi) + 2 * s2;
#pragma unroll
            for (int dt = 0; dt < 2; ++dt) {
                const int drow = 32 * dt + r_;
                const u32x2 lo = *(const u32x2*)(Vt + drow * 512 + ((q0 ^ (drow & 31)) * 16) + 8 * hl);
                const u32x2 hi = *(const u32x2*)(Vt + drow * 512 + (((q0 + 1) ^ (drow & 31)) * 16) + 8 * hl);
                u32x4 vw; vw.x = lo.x; vw.y = lo.y; vw.z = hi.x; vw.w = hi.y;
                ot[dt] = mfma32(__builtin_bit_cast(bf16x8, vw), pb, ot[dt]);
            }
        }
    const float inv = 1.f / l;
    bf16_t* og = (bf16_t*)(p.ws + WS_OG) + ((size_t)g * T + qrow) * 512 + h * 64;
#pragma unroll
    for (int dt = 0; dt < 2; ++dt)
#pragma unroll
        for (int rg = 0; rg < 4; ++rg) {
            u32x2 wv; wv.x = pack2(ot[dt][rg * 4] * inv, ot[dt][rg * 4 + 1] * inv); wv.y = pack2(ot[dt][rg * 4 + 2] * inv, ot[dt][rg * 4 + 3] * inv);
            *(u32x2*)(og + 32 * dt + 8 * rg + 4 * hl) = wv;
        }
    if (hl == 0) ((float*)(p.ws + WS_LSE))[((size_t)g * T + qrow) * 8 + h] = mx + __logf(l);
}
DI void phase_attn_merge(const P& p) {
    const bf16_t* og = (const bf16_t*)(p.ws + WS_OG);
    const float* lse = (const float*)(p.ws + WS_LSE);
    bf16_t* o = (bf16_t*)p.out;
    for (int i = bidx() * 256 + tidx(); i < T * 64; i += gridDim.x * 256) {
        const int t = i >> 6, c8 = i & 63, h = c8 >> 3;
        const float l0 = lse[(size_t)t * 8 + h], l1 = lse[((size_t)T + t) * 8 + h], l2 = lse[((size_t)2 * T + t) * 8 + h];
        const float m = fmaxf(l0, fmaxf(l1, l2));
        float w0 = __expf(l0 - m), w1 = __expf(l1 - m), w2 = __expf(l2 - m);
        const float inv = 1.f / (w0 + w1 + w2); w0 *= inv; w1 *= inv; w2 *= inv;
        const u32x4 a = *(const u32x4*)(og + (size_t)t * 512 + c8 * 8), bq = *(const u32x4*)(og + ((size_t)T + t) * 512 + c8 * 8), cq = *(const u32x4*)(og + ((size_t)2 * T + t) * 512 + c8 * 8);
        u32x4 r;
#pragma unroll
        for (int e = 0; e < 4; ++e) {
            const float x0 = w0 * __uint_as_float(a[e] << 16) + w1 * __uint_as_float(bq[e] << 16) + w2 * __uint_as_float(cq[e] << 16);
            const float x1 = w0 * __uint_as_float(a[e] & 0xffff0000u) + w1 * __uint_as_float(bq[e] & 0xffff0000u) + w2 * __uint_as_float(cq[e] & 0xffff0000u);
            r[e] = pack2(x0, x1);
        }
        *(u32x4*)(o + (size_t)t * 512 + c8 * 8) = r;
    }
}


#define XB_TMO      128
#define XB_XCNT(j)  (256  + 64 * (j))
#define XB_XSUB(j)  (1280 + 64 * (j))
#define XB_XGEN(j)  (2304 + 64 * (j))
#define XB_TOP      3328
#define XB_TOPGEN   3392
#define XCD_BAR_WORDS 3456
#define XB_SPIN_CAP (1u << 22)
#define LAS __attribute__((address_space(3)))
DI unsigned xb_ld(unsigned* p)              { return __hip_atomic_load(p, __ATOMIC_RELAXED, __HIP_MEMORY_SCOPE_AGENT); }
DI unsigned xb_add(unsigned* p, unsigned v) { return __hip_atomic_fetch_add(p, v, __ATOMIC_RELAXED, __HIP_MEMORY_SCOPE_AGENT); }
DI unsigned xb_xcc_id() { return (unsigned)__builtin_amdgcn_s_getreg((3 << 11) | 20) & 0xFu; }
#define XB_SPIN(cond, bar) do { unsigned _sp = 0; while (cond) { if (_sp < 32u) __builtin_amdgcn_s_sleep(2); else __builtin_amdgcn_s_sleep(24); \
    if ((++_sp & 255u) == 0u) { if (xb_ld(&(bar)[XB_TMO])) break; if (_sp > XB_SPIN_CAP) { atomicAdd(&(bar)[XB_TMO], 1u); break; } } } } while (0)
struct XcdBarrier { unsigned* bar; unsigned x; volatile LAS unsigned* st; };
DI XcdBarrier xcd_barrier_post(unsigned* bar, volatile LAS unsigned* st) {
    XcdBarrier b; b.bar = bar; b.x = xb_xcc_id(); b.st = st;
    if (threadIdx.x == 0) (void)xb_add(&bar[XB_XCNT(b.x)], 1u);
    return b;
}
DI void xcd_barrier_complete(unsigned* bar, unsigned x, unsigned& nloc, unsigned& nx) {
    const unsigned G = gridDim.x * gridDim.y * gridDim.z;
    unsigned sum, cnt, mine, sp = 0u;
    for (;;) {
        sum = 0u; cnt = 0u; mine = 0u;
#pragma unroll
        for (unsigned j = 0; j < 16; ++j) { const unsigned c = xb_ld(&bar[XB_XCNT(j)]); sum += c; cnt += (c > 0u) ? 1u : 0u; mine = (j == x) ? c : mine; }
        if (sum == G) break;
        __builtin_amdgcn_s_sleep(1);
        if ((++sp & 255u) == 0u) { if (xb_ld(&bar[XB_TMO])) break; if (sp > XB_SPIN_CAP) { atomicAdd(&bar[XB_TMO], 1u); break; } }
    }
    nloc = mine > 0u ? mine : 1u; nx = cnt > 0u ? cnt : 1u;
}
DI void xcd_barrier(const XcdBarrier& b) {
    asm volatile("s_waitcnt vmcnt(0)" ::: "memory");
    __syncthreads();
    if (threadIdx.x == 0) {
        unsigned* bar = b.bar; unsigned bx = b.x;
        asm volatile("" : "+s"(bar), "+s"(bx));
        __builtin_amdgcn_s_waitcnt(0);
        unsigned nloc = b.st[0], nx = b.st[1];
        if (nloc == 0u) { xcd_barrier_complete(bar, bx, nloc, nx); b.st[0] = nloc; b.st[1] = nx; }
        const unsigned old = xb_add(&bar[XB_XSUB(bx)], 1u);
        const unsigned gen = old / nloc;
        if (old + 1u == (gen + 1u) * nloc) {
            __builtin_amdgcn_fence(__ATOMIC_RELEASE, "agent");
            asm volatile("s_waitcnt vmcnt(0)" ::: "memory");
            const unsigned og = xb_add(&bar[XB_TOP], 1u);
            const unsigned tg = og / nx;
            if (og + 1u == (tg + 1u) * nx) xb_add(&bar[XB_TOPGEN], 1u);
            else XB_SPIN(xb_ld(&bar[XB_TOPGEN]) == tg, bar);
            __builtin_amdgcn_fence(__ATOMIC_ACQUIRE, "agent");
            xb_add(&bar[XB_XGEN(bx)], 1u);
            asm volatile("s_waitcnt vmcnt(0)" ::: "memory");
        } else {
            XB_SPIN(xb_ld(&bar[XB_XGEN(bx)]) == gen, bar);
            __builtin_amdgcn_fence(__ATOMIC_ACQUIRE, "agent");
            asm volatile("s_waitcnt vmcnt(0)" ::: "memory");
        }
    }
    __syncthreads();
}

constexpr int LDS_BYTES = RP_END;
static_assert(GP_END + 6144 <= LDS_BYTES, "LDS");
__global__ void __launch_bounds__(256, 2) __attribute__((amdgpu_waves_per_eu(2, 2))) mega(P p) {
    cg::grid_group grid = cg::this_grid();
    extern __shared__ __attribute__((aligned(16))) char lds[];
    if (threadIdx.x < 4) ((volatile LAS unsigned*)(lds + LDS_BYTES))[threadIdx.x] = 0u;
    __syncthreads();
    const XcdBarrier xb = xcd_barrier_post((unsigned*)(p.ws + WS_CTL + CTL_BAR), (volatile LAS unsigned*)(lds + LDS_BYTES));
#define GSYNC() xcd_barrier(xb)
    const bf16_t* HN = (const bf16_t*)p.out;
    const bf16_t* XB = (const bf16_t*)(p.ws + WS_XB);
    const bf16_t* Win = (const bf16_t*)(p.ws + WS_W + W_IN);
    const bf16_t* Wout = (const bf16_t*)(p.ws + WS_W + W_OUT);
    phase_rope(p);
    phase_convert_io(p, 0, lds);
    phase_prep<0>(p, p.in[I_EVNORM], 0);
    if (p.ws == nullptr) grid.sync();
    GSYNC();
    volatile LAS unsigned* qword = (volatile LAS unsigned*)(lds + LDS_BYTES + 8);
    for (int layer = 0; layer < 4; ++layer) {
        const int li = layer >> 1;
        if ((layer & 1) == 0) {
            phase_gemm<EPI_EVEN_IN>(p, XB, 1024, Win, 1024, EVPAD / 128, lds);
            GSYNC();
            for (int u = bidx(); u < 1024; u += gridDim.x) gdn_prep_unit(p, li, u, lds);
            GSYNC();
            if (bidx() < 16) gdn_scan_block(p, bidx(), lds);
            {
                unsigned* qctr = (unsigned*)(p.ws + WS_CTL + CTL_QUEUE) + li * 64;
                for (;;) {
                    __syncthreads();
                    if (threadIdx.x == 0) *qword = atomicAdd(qctr, 1u);
                    __syncthreads();
                    const unsigned u = *qword;
                    if (u >= 2048u) break;
                    rwkv_prep_unit(p, li, (int)u, lds);
                }
            }
            GSYNC();
            if (bidx() < 32) rwkv_scan_block(p, bidx(), lds);
            else {
                for (int u = bidx() - 32; u < 1024; u += gridDim.x - 32) gdn_post_unit(p, li, u);
                phase_convert_moe(p, layer, lds, bidx() - 32, gridDim.x - 32);
            }
            GSYNC();
            for (int u = bidx(); u < 2048; u += gridDim.x) rwkv_post_unit(p, li, u);
            GSYNC();
            phase_gemm<EPI_RESID>(p, (const bf16_t*)(p.ws + WS_PROJ), EVLD, Wout, 1024, 8, lds, false, HN, 1024, 512);
        } else {
            phase_gemm<EPI_ODD_IN>(p, XB, 1024, Win, 1024, ODC / 128, lds);
            GSYNC();
            for (int u = bidx(); u < 3072; u += gridDim.x) attn_unit(p, u, lds);
            GSYNC();
            phase_attn_merge(p);
            GSYNC();
            phase_gemm<EPI_RESID>(p, HN, 512, Wout, 512, 8, lds);
        }
        GSYNC();
        phase_router(p, p.in[I_FFNNORM] + layer * 1024, layer, lds);
        GSYNC();
        phase_moe_up(p, layer, lds);
        GSYNC();
        phase_moe_down(p, layer, lds);
        GSYNC();
        if (layer < 3) {
            phase_convert_io(p, layer + 1, lds);
            if ((layer + 1) & 1) phase_convert_moe(p, layer + 1, lds, bidx(), gridDim.x);
            phase_prep<1>(p, ((layer + 1) & 1) ? p.in[I_ODNORM] + ((layer + 1) >> 1) * 1024 : p.in[I_EVNORM] + ((layer + 1) >> 1) * 1024, layer + 1);
            GSYNC();
        }
    }
    phase_prep<3>(p, p.in[I_FINAL], 0);
}

extern "C" void kernel_launch(void* const* d_in, const int* in_sizes, int n_in, void* d_out, int out_size, void* d_ws, size_t ws_size, hipStream_t stream) {
    if (n_in != 34 || out_size != T * D || ws_size < WS_NEED) { fprintf(stderr, "kernel_launch: unexpected shapes (n_in %d out %d ws %zu need %zu)\n", n_in, out_size, ws_size, (size_t)WS_NEED); return; }
    static int grid_blocks = 0;
    if (!grid_blocks) {
        int dev = 0, cus = 0, per_cu = 0;
        (void)hipGetDevice(&dev);
        (void)hipDeviceGetAttribute(&cus, hipDeviceAttributeMultiprocessorCount, dev);
        (void)hipFuncSetAttribute((const void*)mega, hipFuncAttributeMaxDynamicSharedMemorySize, LDS_BYTES + 16);
        (void)hipOccupancyMaxActiveBlocksPerMultiprocessor(&per_cu, mega, 256, LDS_BYTES + 16);
        if (per_cu < 1) per_cu = 1;
        if (per_cu > 2) per_cu = 2;
        grid_blocks = cus * per_cu;
    }
    P p{};
    for (int i = 0; i < 34; ++i) p.in[i] = (const float*)d_in[i];
    p.out = (float*)d_out; p.ws = (unsigned char*)d_ws;
    (void)hipMemsetAsync((char*)d_ws + WS_CTL, 0, 65536, stream);
    void* args[] = {&p};
    hipError_t e = hipLaunchCooperativeKernel((void*)mega, dim3(grid_blocks), dim3(256), args, LDS_BYTES + 16, stream);
    if (e != hipSuccess) fprintf(stderr, "cooperative launch failed: %s (grid %d)\n", hipGetErrorString(e), grid_blocks);
}
```

```cpp
#include <hip/hip_runtime.h>
#include <cstdio>
#include <cstdint>
#include <cmath>
#include <hip/hip_cooperative_groups.h>
namespace cg = cooperative_groups;

typedef unsigned short bf16_t;
typedef short bf16x8 __attribute__((ext_vector_type(8)));
typedef float f32x4 __attribute__((ext_vector_type(4)));
typedef unsigned u32x4 __attribute__((ext_vector_type(4)));
typedef unsigned u32x2 __attribute__((ext_vector_type(2)));
#define DI __device__ __forceinline__

constexpr int T = 16384, SEQ = 4096, BATCH = 4, D = 1024;
constexpr int EVC = 3784, EVLD = 3784, EVPAD = 3840;
constexpr int ODC = 4608;
constexpr int RW0 = 2056;
constexpr int C_R = 2056, C_K = 2568, C_V = 3080, C_HW = 3592, C_HA = 3624, C_HG = 3656, C_HV = 3752;
constexpr int NEXP = 16, FF = 256;
constexpr int HROWS = 34816;

constexpr size_t WS_CTL = 0;
constexpr size_t CTL_EGL = 4096;
constexpr size_t CTL_CUTAB = 8192;
constexpr size_t CTL_QUEUE = 49152;
constexpr size_t CTL_CNT = 32768;
constexpr size_t CTL_BAR = 16384;
constexpr size_t WS_LIST = 65536;
constexpr size_t WS_GATE = WS_LIST + 16 * 16384 * 4;
constexpr size_t WS_RK = WS_GATE + 16 * 16384 * 4;
constexpr size_t WS_SSQ = WS_RK + (size_t)T * 8 * 4;
constexpr size_t WS_ROPE = WS_SSQ + (size_t)16 * T * 4;
constexpr size_t WS_W = WS_ROPE + (size_t)T * 32 * 8;
constexpr size_t W_IN = 0;
constexpr size_t W_OUT = (size_t)4608 * 1024 * 2;
constexpr size_t W_13 = W_OUT + (size_t)1024 * 1024 * 2;
constexpr size_t W_2 = W_13 + (size_t)16 * 512 * 1024 * 2;
constexpr size_t W_LW = W_2 + (size_t)16 * 1024 * 256 * 2;
constexpr size_t W_BYTES = W_LW + (size_t)512 * 192 * 2;
constexpr size_t WS_XB = WS_W + W_BYTES;
constexpr size_t WS_HN = WS_XB;
constexpr size_t WS_VF = WS_HN + (size_t)T * 1024 * 2;
constexpr size_t WS_R2 = WS_VF + (size_t)T * 512 * 2;
constexpr size_t WS_PROJ = WS_R2;
constexpr size_t WS_GOPS = WS_R2 + (size_t)T * EVLD * 2;
constexpr size_t GOPS_CH = 73728, GO_UF = 0, GO_WF = 16384, GO_QF = 32768, GO_AF = 49152, GO_KF = 57344;
constexpr size_t WS_ROPS = WS_GOPS + 1024 * GOPS_CH;
constexpr size_t WS_QK = WS_R2;
constexpr size_t WS_VT = WS_QK + (size_t)T * 3072 * 2;
constexpr size_t WS_OG = WS_VT + (size_t)T * 1536 * 2;
constexpr size_t WS_LSE = WS_OG + (size_t)3 * T * 512 * 2;
constexpr size_t WS_END3 = WS_LSE + (size_t)3 * T * 8 * 4;
constexpr size_t WS_YS = WS_R2;
constexpr size_t WS_H = WS_YS + (size_t)2 * T * 1024 * 2;
constexpr size_t WS_GG = WS_ROPS + (size_t)2048 * 16384;
constexpr size_t WS_END0 = WS_GG + (size_t)T * 512 * 2;
constexpr size_t WS_END1 = WS_H + (size_t)HROWS * 256 * 2;
constexpr size_t WS_END2 = WS_R2 + (size_t)T * 4608 * 2;
static_assert(WS_END3 <= WS_END0, "odd-layer regions exceed even-layer footprint");
constexpr size_t WS_END = WS_END0 > WS_END1 ? (WS_END0 > WS_END2 ? WS_END0 : WS_END2) : (WS_END1 > WS_END2 ? WS_END1 : WS_END2);

constexpr size_t WS_RSL = WS_END;
constexpr size_t WS_RSIN = WS_RSL + 16 * 16384 * 4;
constexpr size_t WS_NEED = WS_RSIN + (size_t)T * 4;
constexpr size_t WS_DUMMY = WS_END0;
struct P {
    const float* in[34];
    float* out;
    unsigned char* ws;
};
enum { I_X = 0, I_POS, I_EVNORM, I_EVWIN, I_VRESDOWN, I_EVWOUT, I_CONVW, I_ALOG, I_DTB, I_GDNNORM, I_MU, I_W0, I_W2, I_A0, I_A2, I_G2,
       I_KK, I_KA, I_RK, I_LNW, I_LNB, I_VRESMU, I_V0, I_V2, I_ODNORM, I_ODWIN, I_ODWOUT, I_FFNNORM, I_WGROUP, I_WEXPERT, I_W1, I_W3, I_MW2, I_FINAL };

DI int tidx() { int t = threadIdx.x; asm volatile("" : "+v"(t)); return t; }
DI int bidx() { int b = blockIdx.x; asm volatile("" : "+s"(b)); return b; }
typedef __bf16 bf2_t __attribute__((ext_vector_type(2)));
typedef float f2_t __attribute__((ext_vector_type(2)));
DI bf16_t f2bf(float x) { return __builtin_bit_cast(bf16_t, (__bf16)x); }
DI float bf2f(bf16_t h) { return __uint_as_float(((unsigned)h) << 16); }
DI unsigned pack2(float lo, float hi) { const f2_t v = {lo, hi}; return __builtin_bit_cast(unsigned, __builtin_convertvector(v, bf2_t)); }
DI float wave_sum(float v) {
#pragma unroll
    for (int o = 32; o > 0; o >>= 1) v += __shfl_xor(v, o);
    return v;
}
DI float wave_max(float v) {
#pragma unroll
    for (int o = 32; o > 0; o >>= 1) v = fmaxf(v, __shfl_xor(v, o));
    return v;
}
DI float sigmoidf_(float x) { return __builtin_amdgcn_rcpf(1.f + __expf(-x)); }
DI float siluf_(float x) { return x * __builtin_amdgcn_rcpf(1.f + __expf(-x)); }
DI float softplusf_(float x) { return fmaxf(x, 0.f) + __logf(1.f + __expf(-fabsf(x))); }

struct ConvJob { const float* src; bf16_t* dst; int K, N, ldd; int mode; const float* ks = nullptr; };
DI int rowmap(int mode, int n) { return mode == 0 ? n : ((n >> 4) * 32 + (n & 15) + (mode == 2 ? 16 : 0)); }
DI void conv_tile(const ConvJob& j, int tile, float* lds  ) {
    const int ntn = (j.N + 255) / 256;
    const int tk = tile / ntn, tn = tile % ntn;
    const int tid = tidx();
    __syncthreads();
    float4 v[16];
#pragma unroll
    for (int i = 0; i < 16; ++i) {
        const int e = tid + i * 256, k = e >> 6, n4 = (e & 63) * 4;
        const int gk = tk * 64 + k, gn = tn * 256 + n4;
        v[i] = make_float4(0.f, 0.f, 0.f, 0.f);
        if (gn < j.N) v[i] = *(const float4*)(j.src + (size_t)gk * j.N + gn);
    }
    if (j.ks) {
        float sc[16];
#pragma unroll
        for (int i = 0; i < 16; ++i) sc[i] = j.ks[tk * 64 + (tid >> 6) + 4 * i];
#pragma unroll
        for (int i = 0; i < 16; ++i) { v[i].x *= sc[i]; v[i].y *= sc[i]; v[i].z *= sc[i]; v[i].w *= sc[i]; }
    }
#pragma unroll
    for (int i = 0; i < 16; ++i) { const int e = tid + i * 256, k = e >> 6, n4 = (e & 63) * 4; *(float4*)(lds + k * 260 + n4) = v[i]; }
    __syncthreads();
#pragma unroll
    for (int i = 0; i < 8; ++i) {
        const int n = tid, k8 = i * 8;
        const int gn = tn * 256 + n;
        if (gn < j.N) {
            u32x4 w;
            w.x = pack2(lds[(k8 + 0) * 260 + n], lds[(k8 + 1) * 260 + n]); w.y = pack2(lds[(k8 + 2) * 260 + n], lds[(k8 + 3) * 260 + n]);
            w.z = pack2(lds[(k8 + 4) * 260 + n], lds[(k8 + 5) * 260 + n]); w.w = pack2(lds[(k8 + 6) * 260 + n], lds[(k8 + 7) * 260 + n]);
            *(u32x4*)(j.dst + (size_t)rowmap(j.mode, gn) * j.ldd + tk * 64 + k8) = w;
        }
    }
}
DI void phase_convert_io(const P& p, int layer, char* ldsc) {
    float* lds = (float*)ldsc;
    unsigned char* W = p.ws + WS_W;
    const int li = layer >> 1;
    if ((layer & 1) == 0) {
        const float* ng = p.in[I_EVNORM] + li * 1024;
        const ConvJob j0{p.in[I_EVWIN] + (size_t)li * 1024 * 3752, (bf16_t*)(W + W_IN), 1024, 3752, 1024, 0, ng};
        for (int t = bidx(); t < 16 * 15; t += gridDim.x) conv_tile(j0, t, lds);
        if (li == 1) {
            const ConvJob j1{p.in[I_VRESDOWN], (bf16_t*)(W + W_IN) + (size_t)3752 * 1024, 1024, 32, 1024, 0, ng};
            for (int t = bidx(); t < 16; t += gridDim.x) conv_tile(j1, t, lds);
        }
        const ConvJob j2{p.in[I_EVWOUT] + (size_t)li * 1024 * 1024, (bf16_t*)(W + W_OUT), 1024, 1024, 1024, 0};
        for (int t = bidx(); t < 16 * 4; t += gridDim.x) conv_tile(j2, t, lds);
        {
            bf16_t* LW = (bf16_t*)(W + W_LW);
            for (int i = bidx() * 256 + tidx(); i < 512 * 192; i += gridDim.x * 256) {
                const int ch = i / 192, j = i % 192;
                float v;
                if (j < 32) v = p.in[I_W2][((size_t)li * 32 + j) * 512 + ch];
                else if (j < 64) v = p.in[I_A2][((size_t)li * 32 + j - 32) * 512 + ch];
                else if (j < 160) v = p.in[I_G2][((size_t)li * 96 + j - 64) * 512 + ch];
                else v = (li == 1) ? p.in[I_V2][(size_t)(j - 160) * 512 + ch] : 0.f;
                LW[i] = f2bf(v);
            }
        }
        const int r0 = (li == 1) ? 3784 : 3752;
        bf16_t* z = (bf16_t*)(W + W_IN) + (size_t)r0 * 1024;
        const size_t n = (size_t)(EVPAD - r0) * 1024;
        for (size_t i = (size_t)bidx() * 256 + tidx(); i < n; i += (size_t)gridDim.x * 256) z[i] = 0;
    } else {
        const ConvJob j0{p.in[I_ODWIN] + (size_t)li * 1024 * 4608, (bf16_t*)(W + W_IN), 1024, 4608, 1024, 0, p.in[I_ODNORM] + li * 1024};
        for (int t = bidx(); t < 16 * 18; t += gridDim.x) conv_tile(j0, t, lds);
        const ConvJob j2{p.in[I_ODWOUT] + (size_t)li * 512 * 1024, (bf16_t*)(W + W_OUT), 512, 1024, 512, 0};
        for (int t = bidx(); t < 8 * 4; t += gridDim.x) conv_tile(j2, t, lds);
    }
}
DI void phase_convert_moe(const P& p, int layer, char* ldsc, int b0, int bs) {
    float* lds = (float*)ldsc;
    unsigned char* W = p.ws + WS_W;
    for (int t = b0; t < 16 * 3 * 16; t += bs) {
        const int e = t / 48, r = t % 48, which = r / 16, tile = r % 16;
        ConvJob j;
        const float* fg = p.in[I_FFNNORM] + layer * 1024;
        if (which == 0) j = ConvJob{p.in[I_W1] + ((size_t)layer * 16 + e) * 1024 * 256, (bf16_t*)(W + W_13) + (size_t)e * 512 * 1024, 1024, 256, 1024, 1, fg};
        else if (which == 1) j = ConvJob{p.in[I_W3] + ((size_t)layer * 16 + e) * 1024 * 256, (bf16_t*)(W + W_13) + (size_t)e * 512 * 1024, 1024, 256, 1024, 2, fg};
        else j = ConvJob{p.in[I_MW2] + ((size_t)layer * 16 + e) * 256 * 1024, (bf16_t*)(W + W_2) + (size_t)e * 1024 * 256, 256, 1024, 256, 0};
        conv_tile(j, tile, lds);
    }
}

DI void phase_rope(const P& p) {
    float2* tab = (float2*)(p.ws + WS_ROPE);
    const int* pos = (const int*)p.in[I_POS];
    for (int i = bidx() * 256 + tidx(); i < T * 32; i += gridDim.x * 256) {
        const int t = i >> 5, f = i & 31;
        const float inv = powf(10000.0f, -(float)f * (2.0f / 64.0f));
        const float ang = (float)pos[t] * inv;
        float s, c; sincosf(ang, &s, &c);
        tab[i] = make_float2(c, s);
    }
}

template <int MODE>
DI void phase_prep(const P& p, const float* gain, int layer) {
    const int lane = tidx() & 63, wid = tidx() >> 6;
    const int nw = gridDim.x * 4;
    bf16_t* hn = (bf16_t*)p.out;
    bf16_t* xb = (bf16_t*)(p.ws + WS_XB);
    const bf16_t* y0 = (const bf16_t*)(p.ws + WS_YS);
    const bf16_t* y1 = y0 + (size_t)T * 1024;
    float4 gq[4];
#pragma unroll
    for (int i = 0; i < 4; ++i) gq[i] = *(const float4*)(gain + i * 256 + lane * 4);
    for (int t = bidx() * 4 + wid; t < T; t += nw) {
        float4 v[4];
        float ss = 0.f;
#pragma unroll
        for (int i = 0; i < 4; ++i) {
            const size_t off = (size_t)t * 1024 + i * 256 + lane * 4;
            if (MODE == 0) v[i] = *(const float4*)(p.in[I_X] + off);
            else { const u32x2 xx = *(const u32x2*)(xb + off); v[i].x = __uint_as_float(xx.x << 16); v[i].y = __uint_as_float(xx.x & 0xffff0000u); v[i].z = __uint_as_float(xx.y << 16); v[i].w = __uint_as_float(xx.y & 0xffff0000u); }
            if (MODE == 1 || MODE == 3) {
                const u32x2 a = *(const u32x2*)(y0 + off), b = *(const u32x2*)(y1 + off);
                v[i].x += __uint_as_float(a.x << 16) + __uint_as_float(b.x << 16); v[i].y += __uint_as_float(a.x & 0xffff0000u) + __uint_as_float(b.x & 0xffff0000u);
                v[i].z += __uint_as_float(a.y << 16) + __uint_as_float(b.y << 16); v[i].w += __uint_as_float(a.y & 0xffff0000u) + __uint_as_float(b.y & 0xffff0000u);
            }
            ss += v[i].x * v[i].x + v[i].y * v[i].y + v[i].z * v[i].z + v[i].w * v[i].w;
        }
        ss = wave_sum(ss);
        const float rstd = rsqrtf(ss * (1.0f / 1024.0f) + 1e-6f);
        if ((MODE == 0 || MODE == 1) && lane == 0) ((float*)(p.ws + WS_RSIN))[t] = rstd;
        float lg[20];
        if (MODE == 2) {
#pragma unroll
            for (int q = 0; q < 20; ++q) lg[q] = 0.f;
        }
#pragma unroll
        for (int i = 0; i < 4; ++i) {
            const int col = i * 256 + lane * 4;
            const size_t off = (size_t)t * 1024 + col;
            const float4 g = gq[i];
            float4 h; h.x = v[i].x * rstd * g.x; h.y = v[i].y * rstd * g.y; h.z = v[i].z * rstd * g.z; h.w = v[i].w * rstd * g.w;
            bf16_t* hd = hn + off;
            if (MODE == 0 || MODE == 1) { u32x2 w; w.x = pack2(v[i].x, v[i].y); w.y = pack2(v[i].z, v[i].w); *(u32x2*)(xb + off) = w; }
            if (MODE == 3) *(float4*)(p.out + off) = h;
            else if (MODE == 2) { u32x2 w; w.x = pack2(h.x, h.y); w.y = pack2(h.z, h.w); *(u32x2*)hd = w; }
            if (MODE == 2) {
                const float hh[4] = {h.x, h.y, h.z, h.w};
                const float* wg = p.in[I_WGROUP] + (size_t)layer * 1024 * 4;
                const float* we = p.in[I_WEXPERT] + (size_t)layer * 4 * 1024 * 4;
#pragma unroll
                for (int e = 0; e < 4; ++e) {
                    const float4 a = *(const float4*)(wg + (size_t)(col + e) * 4);
                    lg[0] += hh[e] * a.x; lg[1] += hh[e] * a.y; lg[2] += hh[e] * a.z; lg[3] += hh[e] * a.w;
#pragma unroll
                    for (int g2 = 0; g2 < 4; ++g2) {
                        const float4 b = *(const float4*)(we + ((size_t)g2 * 1024 + col + e) * 4);
                        lg[4 + g2 * 4 + 0] += hh[e] * b.x; lg[4 + g2 * 4 + 1] += hh[e] * b.y; lg[4 + g2 * 4 + 2] += hh[e] * b.z; lg[4 + g2 * 4 + 3] += hh[e] * b.w;
                    }
                }
            }
        }
        if (MODE == 2) {
#pragma unroll
            for (int q = 0; q < 20; ++q) lg[q] = wave_sum(lg[q]);
            if (lane == 0) {
                int gs = 0; float gm = lg[0];
#pragma unroll
                for (int g2 = 1; g2 < 4; ++g2) if (lg[g2] > gm) { gm = lg[g2]; gs = g2; }
                float den = 0.f;
#pragma unroll
                for (int g2 = 0; g2 < 4; ++g2) den += __expf(lg[g2] - gm);
                const float pg = 1.f / den;
                float el[4];
#pragma unroll
                for (int e = 0; e < 4; ++e) el[e] = gs == 0 ? lg[4 + e] : gs == 1 ? lg[8 + e] : gs == 2 ? lg[12 + e] : lg[16 + e];
                int i1 = 0; float v1 = el[0];
#pragma unroll
                for (int e = 1; e < 4; ++e) if (el[e] > v1) { v1 = el[e]; i1 = e; }
                int i2 = 0; float v2 = -3.4e38f;
#pragma unroll
                for (int e = 0; e < 4; ++e) if (e != i1 && el[e] > v2) { v2 = el[e]; i2 = e; }
                const float e2 = __expf(v2 - v1);
                const float g1 = pg / (1.f + e2), g2v = pg * e2 / (1.f + e2);
                unsigned* cnt = (unsigned*)(p.ws + WS_CTL + CTL_CNT) + layer * 16 * 64;
                int* list = (int*)(p.ws + WS_LIST);
                float* gl = (float*)(p.ws + WS_GATE);
                const int ea = gs * 4 + i1, eb = gs * 4 + i2;
                const unsigned ra = atomicAdd(&cnt[ea * 64], 1u);
                list[ea * 16384 + ra] = t * 2; gl[ea * 16384 + ra] = g1;
                const unsigned rb = atomicAdd(&cnt[eb * 64], 1u);
                list[eb * 16384 + rb] = t * 2 + 1; gl[eb * 16384 + rb] = g2v;
            }
        }
    }
}


typedef __attribute__((address_space(3))) unsigned lds_u32;
DI void g_dma(unsigned m0v, unsigned voff, const char* sbase) {
    asm volatile("s_mov_b32 m0, %0\n\ts_nop 0\n\tglobal_load_lds_dwordx4 %1, %2" :: "s"(m0v), "v"(voff), "s"(sbase) : "memory", "m0");
}
DI void phase_router(const P& p, const float* gain, int layer, char* ldsc) {
    const int tid = tidx(), lane = tid & 63, wid = tid >> 6;
    const bf16_t* xb = (const bf16_t*)(p.ws + WS_XB);
    const float* wg = p.in[I_WGROUP] + (size_t)layer * 1024 * 4;
    const float* we = p.in[I_WEXPERT] + (size_t)layer * 4 * 1024 * 4;
    unsigned* cnt = (unsigned*)(p.ws + WS_CTL + CTL_CNT) + layer * 16 * 64;
    int* list = (int*)(p.ws + WS_LIST);
    float* gl = (float*)(p.ws + WS_GATE);
    float* rsl = (float*)(p.ws + WS_RSL);
    f32x4* WS = (f32x4*)ldsc;
    unsigned* lcnt = (unsigned*)(ldsc + 40960); unsigned* lbase = lcnt + 16; int* e_ent = (int*)(lcnt + 32); unsigned* r_ent = (unsigned*)(e_ent + 32); int* t_ent = (int*)(r_ent + 32); float* g_ent = (float*)(t_ent + 32); float* rs_ent = g_ent + 32;
    const unsigned wsb = (unsigned)__builtin_amdgcn_readfirstlane((int)((unsigned)(size_t)(lds_u32*)ldsc + wid * 1024));
    auto stage = [&](int i, int buf) {
        const unsigned voff = (unsigned)(i * 256 + lane * 4 + wid) * 16u;
#pragma unroll
        for (int r = 0; r < 5; ++r) g_dma(wsb + (unsigned)(buf * 1280 + r * 256) * 16u, voff, (const char*)(r == 0 ? wg : we + (size_t)(r - 1) * 4096));
    };
    u32x2 xq[4];
#pragma unroll
    for (int q = 0; q < 4; ++q) xq[q] = *(const u32x2*)(xb + (size_t)(bidx() * 16 + wid * 4 + q) * 1024 + lane * 4);
    for (int tb = bidx() * 16; tb < T; tb += gridDim.x * 16) {
        const int t0 = tb + wid * 4;
        __syncthreads();
        if (tid < 16) lcnt[tid] = 0u;
        stage(0, 0);
        float rstd[4];
        {
            const float pq = ((const float*)(p.ws + WS_SSQ))[(size_t)(lane & 15) * T + t0 + (lane >> 4)];
            float ss = pq;
            ss += __shfl_xor(ss, 1); ss += __shfl_xor(ss, 2); ss += __shfl_xor(ss, 4); ss += __shfl_xor(ss, 8);
#pragma unroll
            for (int q = 0; q < 4; ++q) rstd[q] = rsqrtf(__shfl(ss, q * 16) * (1.0f / 1024.0f) + 1e-6f);
        }
        float lg[4][20];
#pragma unroll
        for (int q = 0; q < 4; ++q)
#pragma unroll
            for (int j = 0; j < 20; ++j) lg[q][j] = 0.f;
#pragma unroll 1
        for (int i = 0; i < 4; ++i) {
            asm volatile("s_waitcnt vmcnt(0)" ::: "memory");
            __syncthreads();
            if (i + 1 < 4) stage(i + 1, (i + 1) & 1);
            const f32x4* W = WS + (i & 1) * 1280;
            const int col = i * 256 + lane * 4;
            const float4 g = *(const float4*)(gain + col);
            float hh[4][4];
#pragma unroll
            for (int q = 0; q < 4; ++q) {
                hh[q][0] = __uint_as_float(xq[q].x << 16) * rstd[q] * g.x; hh[q][1] = __uint_as_float(xq[q].x & 0xffff0000u) * rstd[q] * g.y; hh[q][2] = __uint_as_float(xq[q].y << 16) * rstd[q] * g.z; hh[q][3] = __uint_as_float(xq[q].y & 0xffff0000u) * rstd[q] * g.w;
            }
            {
                int tn0 = i + 1 < 4 ? t0 : t0 + (int)gridDim.x * 16; const int cn = ((i + 1) & 3) * 256 + lane * 4;
                tn0 = tn0 < T ? tn0 : t0;
#pragma unroll
                for (int q = 0; q < 4; ++q) xq[q] = *(const u32x2*)(xb + (size_t)(tn0 + q) * 1024 + cn);
            }
#pragma unroll
            for (int e = 0; e < 4; ++e) {
                const f32x4 a = W[(0 * 4 + e) * 64 + lane];
#pragma unroll
                for (int q = 0; q < 4; ++q) { lg[q][0] += hh[q][e] * a[0]; lg[q][1] += hh[q][e] * a[1]; lg[q][2] += hh[q][e] * a[2]; lg[q][3] += hh[q][e] * a[3]; }
#pragma unroll
                for (int g2 = 0; g2 < 4; ++g2) {
                    const f32x4 b = W[((1 + g2) * 4 + e) * 64 + lane];
#pragma unroll
                    for (int q = 0; q < 4; ++q) { lg[q][4 + g2 * 4] += hh[q][e] * b[0]; lg[q][5 + g2 * 4] += hh[q][e] * b[1]; lg[q][6 + g2 * 4] += hh[q][e] * b[2]; lg[q][7 + g2 * 4] += hh[q][e] * b[3]; }
                }
            }
        }
#pragma unroll
        for (int q = 0; q < 4; ++q) {
#pragma unroll
            for (int j = 0; j < 20; ++j) lg[q][j] = wave_sum(lg[q][j]);
            if (lane == q) {
                const int t = t0 + q;
                int gs = 0; float gm = lg[q][0];
#pragma unroll
                for (int g2 = 1; g2 < 4; ++g2) if (lg[q][g2] > gm) { gm = lg[q][g2]; gs = g2; }
                float den = 0.f;
#pragma unroll
                for (int g2 = 0; g2 < 4; ++g2) den += __expf(lg[q][g2] - gm);
                const float pg = 1.f / den;
                float el[4];
#pragma unroll
                for (int e = 0; e < 4; ++e) el[e] = gs == 0 ? lg[q][4 + e] : gs == 1 ? lg[q][8 + e] : gs == 2 ? lg[q][12 + e] : lg[q][16 + e];
                int i1 = 0; float v1 = el[0];
#pragma unroll
                for (int e = 1; e < 4; ++e) if (el[e] > v1) { v1 = el[e]; i1 = e; }
                int i2 = 0; float v2 = -3.4e38f;
#pragma unroll
                for (int e = 0; e < 4; ++e) if (e != i1 && el[e] > v2) { v2 = el[e]; i2 = e; }
                const float e2 = __expf(v2 - v1);
                const float g1 = pg / (1.f + e2), g2v = pg * e2 / (1.f + e2);
                const int ea = gs * 4 + i1, eb = gs * 4 + i2;
                const int sl = (wid * 4 + q) * 2;
                e_ent[sl] = ea; r_ent[sl] = atomicAdd(&lcnt[ea], 1u); t_ent[sl] = t * 2; g_ent[sl] = g1; rs_ent[sl] = rstd[q];
                e_ent[sl + 1] = eb; r_ent[sl + 1] = atomicAdd(&lcnt[eb], 1u); t_ent[sl + 1] = t * 2 + 1; g_ent[sl + 1] = g2v; rs_ent[sl + 1] = rstd[q];
            }
        }
        __syncthreads();
        if (tid < 16) lbase[tid] = lcnt[tid] ? atomicAdd(&cnt[tid * 64], lcnt[tid]) : 0u;
        __syncthreads();
        if (tid < 32) {
            const int e = e_ent[tid];
            const unsigned pos = (lbase[e] + r_ent[tid]) & 16383u;
            list[e * 16384 + pos] = t_ent[tid]; gl[e * 16384 + pos] = g_ent[tid]; rsl[e * 16384 + pos] = rs_ent[tid];
        }
    }
}

constexpr int GBK = 64;
struct TileP { int arow[4]; unsigned bo[4]; };
struct GOps { const char* A; unsigned la; const char* A2; unsigned la2; const char* B; };
DI void gemm_core(const GOps& o, const TileP& tp, int K, char* lds, f32x4 (&acc)[4][4], int ksplit, bool primed, const TileP& nx, bool have_nx) {
    const int tid = tidx(), wid = tid >> 6, lane = tid & 63, wr = wid >> 1, wc = wid & 1, fr = lane & 15, fq = lane >> 4;
    const unsigned scol = ((tid & 7) ^ ((tid >> 3) & 7)) * 16;
#pragma unroll
    for (int n = 0; n < 4; ++n)
#pragma unroll
        for (int m = 0; m < 4; ++m) acc[n][m] = (f32x4){0.f, 0.f, 0.f, 0.f};
    const int nk = K / GBK;
    if (!primed) {
        __syncthreads();
#pragma unroll
        for (int i = 0; i < 4; ++i) {
            __builtin_amdgcn_global_load_lds((const unsigned*)(o.A + (__umul24(tp.arow[i], o.la) + scol)), (lds_u32*)(lds + tid * 16 + i * 4096), 16, 0, 0);
            __builtin_amdgcn_global_load_lds((const unsigned*)(o.B + (tp.bo[i] + scol)), (lds_u32*)(lds + 16384 + tid * 16 + i * 4096), 16, 0, 0);
        }
    }
    const int sw = fr & 7;
    const unsigned aoff = (wr * 64 + fr) * 128, boff = (wc * 64 + fr) * 128, co0 = (fq ^ sw) * 16, co1 = ((4 + fq) ^ sw) * 16;
    bf16x8 a0[4], b0[4], a1[4], b1[4];
#define G_ISSUE(kt_)                                                                                                                        \
    if ((kt_) + 1 < nk) {                                                                                                                   \
        char* nb = lds + (((kt_) + 1) & 1) * 32768;                                                                                         \
        const unsigned ko = ((kt_) + 1) * (GBK * 2) + scol;                                                                                 \
        const bool hi = ((kt_) + 1) * GBK >= ksplit;                                                                                        \
        const char* Ab = hi ? o.A2 : o.A; const unsigned la = hi ? o.la2 : o.la;                                                            \
        _Pragma("unroll") for (int i = 0; i < 4; ++i) {                                                                                     \
            __builtin_amdgcn_global_load_lds((const unsigned*)(Ab + (__umul24(tp.arow[i], la) + ko)), (lds_u32*)(nb + tid * 16 + i * 4096), 16, 0, 0);   \
            __builtin_amdgcn_global_load_lds((const unsigned*)(o.B + (tp.bo[i] + ko)), (lds_u32*)(nb + 16384 + tid * 16 + i * 4096), 16, 0, 0);      \
        }                                                                                                                                   \
    } else if (have_nx) {        \
        _Pragma("unroll") for (int i = 0; i < 4; ++i) {                                                                                     \
            __builtin_amdgcn_global_load_lds((const unsigned*)(o.A + (__umul24(nx.arow[i], o.la) + scol)), (lds_u32*)(lds + tid * 16 + i * 4096), 16, 0, 0);          \
            __builtin_amdgcn_global_load_lds((const unsigned*)(o.B + (nx.bo[i] + scol)), (lds_u32*)(lds + 16384 + tid * 16 + i * 4096), 16, 0, 0);  \
        }                                                                                                                                   \
    }
#define G_READ(A_, B_, AD_)                                                                                                                 \
    asm volatile("ds_read_b128 %0, %8\n\tds_read_b128 %1, %8 offset:2048\n\tds_read_b128 %2, %8 offset:4096\n\tds_read_b128 %3, %8 offset:6144\n\t"       \
                 "ds_read_b128 %4, %9 offset:16384\n\tds_read_b128 %5, %9 offset:18432\n\tds_read_b128 %6, %9 offset:20480\n\tds_read_b128 %7, %9 offset:22528" \
                 : "=&v"(A_[0]), "=&v"(A_[1]), "=&v"(A_[2]), "=&v"(A_[3]), "=&v"(B_[0]), "=&v"(B_[1]), "=&v"(B_[2]), "=&v"(B_[3]) : "v"((AD_) + aoff), "v"((AD_) + boff) : "memory");
#define G_WAIT(A_, B_, N_)                                                                                                                  \
    asm volatile("s_waitcnt lgkmcnt(" #N_ ")" : "+v"(A_[0]), "+v"(A_[1]), "+v"(A_[2]), "+v"(A_[3]), "+v"(B_[0]), "+v"(B_[1]), "+v"(B_[2]), "+v"(B_[3]) :: "memory");
#define G_MMA(A_, B_)                                                                                                                       \
    _Pragma("unroll") for (int n = 0; n < 4; ++n)                                                                                           \
        _Pragma("unroll") for (int m = 0; m < 4; ++m) acc[n][m] = __builtin_amdgcn_mfma_f32_16x16x32_bf16(B_[n], A_[m], acc[n][m], 0, 0, 0);
    const unsigned lbase = (unsigned)(size_t)(lds_u32*)lds;
    __builtin_amdgcn_s_waitcnt(0x0070);
    __builtin_amdgcn_s_barrier();
    G_ISSUE(0)
    G_READ(a0, b0, lbase + co0)
    G_READ(a1, b1, lbase + co1)
    G_WAIT(a0, b0, 8)
    __builtin_amdgcn_sched_barrier(0);
    G_MMA(a0, b0)
    __builtin_amdgcn_sched_barrier(0);
    G_WAIT(a1, b1, 0)
#pragma unroll 1
    for (int kt = 1; kt < nk; ++kt) {
        __builtin_amdgcn_s_waitcnt(0x0070);
        __builtin_amdgcn_s_barrier();
        G_ISSUE(kt)
        const unsigned S = lbase + (kt & 1) * 32768;
        G_READ(a0, b0, S + co0)
        __builtin_amdgcn_sched_barrier(0);
        G_MMA(a1, b1)
        __builtin_amdgcn_sched_barrier(0);
        G_READ(a1, b1, S + co1)
        G_WAIT(a0, b0, 8)
        __builtin_amdgcn_sched_barrier(0);
        G_MMA(a0, b0)
        __builtin_amdgcn_sched_barrier(0);
        G_WAIT(a1, b1, 0)
    }
    G_MMA(a1, b1)
#undef G_ISSUE
#undef G_READ
#undef G_WAIT
#undef G_MMA
}

enum { EPI_EVEN_IN = 0, EPI_ODD_IN, EPI_RESID };
template <int EPI>
DI void phase_gemm(const P& p, const bf16_t* A, int lda, const bf16_t* Bt, int K, int ntn, char* lds, bool dry = false, const bf16_t* A2 = nullptr, int lda2 = 0, int ksplit = 1 << 30) {
    const int tid = tidx(), wid = tid >> 6, lane = tid & 63, wr = wid >> 1, wc = wid & 1, fr = lane & 15, fq = lane >> 4;
    const int ntm = T / 128, ntiles = ntm * ntn;
    auto fill = [&](TileP& t, int tile) {
        const int tn = tile / ntm, tm = tile % ntm, r = tid >> 3;
#pragma unroll
        for (int i = 0; i < 4; ++i) { t.arow[i] = tm * 128 + r + 32 * i; t.bo[i] = (unsigned)(tn * 128 + r + 32 * i) * (unsigned)(K * 2); }
    };
    const GOps gop{(const char*)A, (unsigned)lda * 2u, (const char*)(A2 ? A2 : A), (unsigned)(A2 ? lda2 : lda) * 2u, (const char*)Bt};
    TileP cur, nxt;
    bool primed = false;
    fill(cur, bidx() < ntiles ? bidx() : 0); nxt = cur;
    for (int tile = bidx(); tile < ntiles; tile += gridDim.x) {
        const int tn = tile / ntm, tm = tile % ntm;
        const bool have_next = tile + (int)gridDim.x < ntiles;
        if (have_next) fill(nxt, tile + gridDim.x);
        f32x4 acc[4][4];
        const int m0 = tm * 128 + wr * 64, n0 = tn * 128 + wc * 64;
        float rsr[4];
        if (EPI != EPI_RESID) {
#pragma unroll
            for (int m = 0; m < 4; ++m) rsr[m] = ((const float*)(p.ws + WS_RSIN))[m0 + m * 16 + fr];
        }
        gemm_core(gop, cur, K, lds, acc, ksplit, primed, nxt, have_next);
        primed = have_next; cur = nxt;
        if (EPI != EPI_RESID) {
#pragma unroll
            for (int m = 0; m < 4; ++m)
#pragma unroll
                for (int n = 0; n < 4; ++n) acc[n][m] *= rsr[m];
        }
        if (EPI == EPI_EVEN_IN) {
            bf16_t* C = (bf16_t*)(p.ws + WS_PROJ);
#pragma unroll
            for (int m = 0; m < 4; ++m)
#pragma unroll
                for (int n = 0; n < 4; ++n) {
                    const int row = m0 + m * 16 + fr, col = n0 + n * 16 + fq * 4;
                    if (col < EVC) { u32x2 w; w.x = pack2(acc[n][m][0], acc[n][m][1]); w.y = pack2(acc[n][m][2], acc[n][m][3]); *(u32x2*)(C + (size_t)row * EVLD + col) = w; }
                }
        } else if (EPI == EPI_ODD_IN) {
            bf16_t* C = (bf16_t*)(p.ws + WS_QK);
            const float2* tab = (const float2*)(p.ws + WS_ROPE);
            if (n0 < 3072) {
#pragma unroll
                for (int m = 0; m < 4; ++m) {
                    const int row = m0 + m * 16 + fr;
#pragma unroll
                    for (int n = 0; n < 2; ++n) {
                        float lo[4], hi[4];
#pragma unroll
                        for (int j = 0; j < 4; ++j) {
                            const float2 cs = tab[(size_t)row * 32 + n * 16 + fq * 4 + j];
                            const float x1 = acc[n][m][j], x2 = acc[n + 2][m][j];
                            lo[j] = x1 * cs.x - x2 * cs.y; hi[j] = x2 * cs.x + x1 * cs.y;
                        }
                        u32x2 w; w.x = pack2(lo[0], lo[1]); w.y = pack2(lo[2], lo[3]);
                        *(u32x2*)(C + (size_t)row * 3072 + n0 + n * 16 + fq * 4) = w;
                        w.x = pack2(hi[0], hi[1]); w.y = pack2(hi[2], hi[3]);
                        *(u32x2*)(C + (size_t)row * 3072 + n0 + (n + 2) * 16 + fq * 4) = w;
                    }
                }
            }
            if (tn * 128 >= 3072) {
                bf16_t* VT = (bf16_t*)(p.ws + WS_VT);
                const int hg0 = (tn * 128 - 3072) >> 6, g = hg0 >> 3, lg2 = g * 2, dil = 1 << lg2, L = SEQ >> lg2, run = 128 >> lg2;
                __syncthreads();
#pragma unroll
                for (int m = 0; m < 4; ++m)
#pragma unroll
                    for (int n = 0; n < 4; ++n)
#pragma unroll
                        for (int j = 0; j < 4; ++j)
                            *(bf16_t*)(lds + 32768 + (wc * 64 + n * 16 + fq * 4 + j) * 272 + (wr * 64 + m * 16 + fr) * 2) = f2bf(acc[n][m][j]);
                __syncthreads();
                const int bb = (tm * 128) >> 12, s0 = (tm * 128) & (SEQ - 1);
#pragma unroll
                for (int q = 0; q < 8; ++q) {
                    const int item = tid + q * 256, dim = item >> 4, o0 = (item & 15) * 8;
                    const int rr = o0 / run, i0 = o0 % run;
                    const char* src = lds + 32768 + dim * 272 + (rr + dil * i0) * 2;
                    float e8[8];
#pragma unroll
                    for (int e = 0; e < 8; ++e) e8[e] = bf2f(*(const bf16_t*)(src + e * dil * 2));
                    u32x4 w; w.x = pack2(e8[0], e8[1]); w.y = pack2(e8[2], e8[3]); w.z = pack2(e8[4], e8[5]); w.w = pack2(e8[6], e8[7]);
                    const int hg = hg0 + (dim >> 6);
                    *(u32x4*)(VT + ((size_t)((bb * 24 + hg) * dil + rr) * 64 + (dim & 63)) * L + (s0 >> lg2) + i0) = w;
                }
            }
        } else {
            float* ssq = (float*)(p.ws + WS_SSQ) + (size_t)(tn * 2 + wc) * T;
#pragma unroll
            for (int m = 0; m < 4; ++m) {
                float ss = 0.f;
#pragma unroll
                for (int n = 0; n < 4; ++n) {
                    const size_t qo = (size_t)(m0 + m * 16 + fr) * 1024 + n0 + n * 16 + fq * 4;
                    bf16_t* q = dry ? (bf16_t*)(p.ws + WS_DUMMY) + (qo & 0x7FFFF) : (bf16_t*)(p.ws + WS_XB) + qo;
                    const u32x2 xx = *(const u32x2*)q;
                    float4 v;
                    v.x = __uint_as_float(xx.x << 16) + acc[n][m][0]; v.y = __uint_as_float(xx.x & 0xffff0000u) + acc[n][m][1]; v.z = __uint_as_float(xx.y << 16) + acc[n][m][2]; v.w = __uint_as_float(xx.y & 0xffff0000u) + acc[n][m][3];
                    u32x2 w; w.x = pack2(v.x, v.y); w.y = pack2(v.z, v.w);
                    *(u32x2*)q = w;
                    ss += v.x * v.x + v.y * v.y + v.z * v.z + v.w * v.w;
                }
                ss += __shfl_xor(ss, 16); ss += __shfl_xor(ss, 32);
                if (fq == 0 && !dry) ssq[m0 + m * 16 + fr] = ss;
            }
        }
    }
}

DI void phase_moe_up(const P& p, int layer, char* lds) {
    const int tid = tidx(), wid = tid >> 6, lane = tid & 63, wr = wid >> 1, wc = wid & 1, fr = lane & 15, fq = lane >> 4;
    const unsigned* cntb = (const unsigned*)(p.ws + WS_CTL + CTL_CNT) + layer * 16 * 64;
    unsigned cnt[16];
#pragma unroll
    for (int e = 0; e < 16; ++e) cnt[e] = cntb[e * 64];
    const int* list = (const int*)(p.ws + WS_LIST);
    const float* gl = (const float*)(p.ws + WS_GATE);
    const bf16_t* hn = (const bf16_t*)(p.ws + WS_XB);
    const float* rsl = (const float*)(p.ws + WS_RSL);
    const bf16_t* W13 = (const bf16_t*)(p.ws + WS_W + W_13);
    bf16_t* H = (bf16_t*)(p.ws + WS_H);
    int ttot = 0;
#pragma unroll
    for (int e = 0; e < 16; ++e) ttot += ((int)cnt[e] + 127) >> 7;
    const int ntiles = ttot * 4;
    auto locate = [&](int tile, int& e, int& lt, int& ce, int& rbe, int& tn) {
        const int mt = tile >> 2; tn = tile & 3;
        int tbe = 0, acc_t = 0; e = 0;
#pragma unroll
        for (int q = 0; q < 16; ++q) { const int nt = ((int)cnt[q] + 127) >> 7; if (mt >= acc_t) { e = q; tbe = acc_t; } acc_t += nt; }
        lt = mt - tbe; ce = (int)cnt[e]; rbe = tbe * 128;
    };
    auto fill = [&](TileP& t, int tile) {
        int e, lt, ce, rbe, tn; locate(tile, e, lt, ce, rbe, tn);
        const int r = tid >> 3;
#pragma unroll
        for (int i = 0; i < 4; ++i) {
            const int ii = lt * 128 + r + 32 * i;
            const int tk = ii < ce ? (list[e * 16384 + ii] >> 1) : 0;
            t.arow[i] = tk;
            t.bo[i] = (unsigned)(e * 512 + tn * 128 + r + 32 * i) * 2048u;
        }
    };
    const GOps gop{(const char*)hn, 2048u, (const char*)hn, 2048u, (const char*)W13};
    TileP cur, nxt;
    bool primed = false;
    fill(cur, bidx() < ntiles ? bidx() : 0); nxt = cur;
    for (int tile = bidx(); tile < ntiles; tile += gridDim.x) {
        int e, lt, ce, rbe, tn; locate(tile, e, lt, ce, rbe, tn);
        const bool have_next = tile + (int)gridDim.x < ntiles;
        if (have_next) fill(nxt, tile + gridDim.x);
        f32x4 acc[4][4];
        gemm_core(gop, cur, 1024, lds, acc, 1 << 30, primed, nxt, have_next);
        primed = have_next; cur = nxt;
#pragma unroll
        for (int m = 0; m < 4; ++m) {
            const int li = lt * 128 + wr * 64 + m * 16 + fr;
            if (li < ce) {
                const float g = gl[e * 16384 + li], rs = rsl[e * 16384 + li];
                bf16_t* hrow = H + (size_t)(rbe + li) * 256;
#pragma unroll
                for (int n = 0; n < 4; n += 2) {
                    float o[4];
#pragma unroll
                    for (int j = 0; j < 4; ++j) o[j] = siluf_(acc[n][m][j] * rs) * (acc[n + 1][m][j] * rs) * g;
                    const int f = tn * 64 + wc * 32 + (n >> 1) * 16 + fq * 4;
                    u32x2 w; w.x = pack2(o[0], o[1]); w.y = pack2(o[2], o[3]);
                    *(u32x2*)(hrow + f) = w;
                }
            }
        }
    }
}
DI void phase_moe_down(const P& p, int layer, char* lds) {
    const int tid = tidx(), wid = tid >> 6, lane = tid & 63, wr = wid >> 1, wc = wid & 1, fr = lane & 15, fq = lane >> 4;
    const unsigned* cntb = (const unsigned*)(p.ws + WS_CTL + CTL_CNT) + layer * 16 * 64;
    unsigned cnt[16];
#pragma unroll
    for (int e = 0; e < 16; ++e) cnt[e] = cntb[e * 64];
    const int* list = (const int*)(p.ws + WS_LIST);
    const bf16_t* W2 = (const bf16_t*)(p.ws + WS_W + W_2);
    const bf16_t* H = (const bf16_t*)(p.ws + WS_H);
    bf16_t* ys = (bf16_t*)(p.ws + WS_YS);
    int ttot = 0;
#pragma unroll
    for (int e = 0; e < 16; ++e) ttot += ((int)cnt[e] + 127) >> 7;
    const int ntiles = ttot * 8;
    auto locate = [&](int tile, int& e, int& lt, int& ce, int& rbe, int& tn) {
        const int mt = tile >> 3; tn = tile & 7;
        int tbe = 0, acc_t = 0; e = 0;
#pragma unroll
        for (int q = 0; q < 16; ++q) { const int nt = ((int)cnt[q] + 127) >> 7; if (mt >= acc_t) { e = q; tbe = acc_t; } acc_t += nt; }
        lt = mt - tbe; ce = (int)cnt[e]; rbe = tbe * 128;
    };
    auto fill = [&](TileP& t, int tile) {
        int e, lt, ce, rbe, tn; locate(tile, e, lt, ce, rbe, tn);
        const int r = tid >> 3;
#pragma unroll
        for (int i = 0; i < 4; ++i) { t.arow[i] = rbe + lt * 128 + r + 32 * i; t.bo[i] = (unsigned)(e * 1024 + tn * 128 + r + 32 * i) * 512u; }
    };
    const GOps gop{(const char*)H, 512u, (const char*)H, 512u, (const char*)W2};
    TileP cur, nxt;
    bool primed = false;
    fill(cur, bidx() < ntiles ? bidx() : 0); nxt = cur;
    for (int tile = bidx(); tile < ntiles; tile += gridDim.x) {
        int e, lt, ce, rbe, tn; locate(tile, e, lt, ce, rbe, tn);
        const bool have_next = tile + (int)gridDim.x < ntiles;
        if (have_next) fill(nxt, tile + gridDim.x);
        f32x4 acc[4][4];
        gemm_core(gop, cur, 256, lds, acc, 1 << 30, primed, nxt, have_next);
        primed = have_next; cur = nxt;
#pragma unroll
        for (int m = 0; m < 4; ++m) {
            const int li = lt * 128 + wr * 64 + m * 16 + fr;
            if (li < ce) {
                const int ts = list[e * 16384 + li];
                bf16_t* yrow = ys + ((size_t)(ts & 1) * T + (ts >> 1)) * 1024 + tn * 128 + wc * 64 + fq * 4;
#pragma unroll
                for (int n = 0; n < 4; ++n) { u32x2 w; w.x = pack2(acc[n][m][0], acc[n][m][1]); w.y = pack2(acc[n][m][2], acc[n][m][3]); *(u32x2*)(yrow + n * 16) = w; }
            }
        }
    }
}


typedef float f32x16 __attribute__((ext_vector_type(16)));
DI f32x4 mfma16(bf16x8 a, bf16x8 b, f32x4 c) { return __builtin_amdgcn_mfma_f32_16x16x32_bf16(a, b, c, 0, 0, 0); }
DI f32x16 mfma32(bf16x8 a, bf16x8 b, f32x16 c) { return __builtin_amdgcn_mfma_f32_32x32x16_bf16(a, b, c, 0, 0, 0); }
DI f32x4 tile16(const char* X, int ldx, int row0, const char* Y, int ldy, int col0, int K) {
    const int lane = tidx() & 63, fr = lane & 15, fq = lane >> 4;
    const char* xp = X + (row0 + fr) * ldx + fq * 16; const char* yp = Y + (col0 + fr) * ldy + fq * 16;
    bf16x8 a[4], b[4];
#pragma unroll
    for (int s = 0; s < 4; ++s) if (s * 32 < K) { a[s] = *(const bf16x8*)(xp + s * 64); b[s] = *(const bf16x8*)(yp + s * 64); }
    f32x4 acc = {0.f, 0.f, 0.f, 0.f};
#pragma unroll
    for (int s = 0; s < 4; ++s) if (s * 32 < K) acc = mfma16(a[s], b[s], acc);
    return acc;
}
DI bf16x8 pack_step(const f32x16& x, int s) {
    u32x4 r;
    r.x = pack2(x[8 * s + 0], x[8 * s + 1]); r.y = pack2(x[8 * s + 2], x[8 * s + 3]);
    r.z = pack2(x[8 * s + 4], x[8 * s + 5]); r.w = pack2(x[8 * s + 6], x[8 * s + 7]);
    return __builtin_bit_cast(bf16x8, r);
}

constexpr int GP_LF = 0, GP_T = 17408, GP_VEC = GP_T + 9216, GP_U = GP_VEC + 1024, GP_END = GP_U + 36864;
DI void gdn_prep_unit(const P& p, int li, int ch, char* lds) {
    const int tid = tidx(), lane = tid & 63, wid = tid >> 6, fr = lane & 15, fq = lane >> 4;
    const int h = ch & 3, n = (ch >> 2) & 63, b = ch >> 8;
    const int t0 = b * SEQ + n * 64;
    float* Lf = (float*)(lds + GP_LF);
    char* Trow = lds + GP_T;
    float* gcs = (float*)(lds + GP_VEC); float* egc = gcs + 64; float* bet = gcs + 128; float* ekd = gcs + 192;
    char* Qrow = lds + GP_U; char* Krow = Qrow + 17408; char* VbT = lds + GP_U; char* KbgT = VbT + 18432;
    const bf16_t* proj = (const bf16_t*)(p.ws + WS_PROJ);
    unsigned char* ops = p.ws + WS_GOPS + (size_t)ch * GOPS_CH;
    const float* cw = p.in[I_CONVW] + (size_t)li * 4 * 1536;
    const int c = tid >> 2, cq = tid & 3;
    __syncthreads();
    float* cwl = (float*)(lds + GP_END);
    for (int i = tid; i < 4 * 3 * 32; i += 256) {
        const int j = i / 96, r = i % 96, sl = r >> 5, q4 = (r & 31) * 4;
        *(f32x4*)(cwl + (j * 3 + sl) * 128 + q4) = *(const f32x4*)(cw + j * 1536 + sl * 512 + h * 128 + q4);
    }
    __syncthreads();
    unsigned vvp[16];
#pragma unroll 1
    for (int which = 0; which < 3; ++which) {
        const int col0 = which * 512 + h * 128 + cq * 32;
        u32x4 xin[4][4];
#pragma unroll
        for (int j = 0; j < 4; ++j) {
            const int sp = n * 64 + c - 3 + j;
            const bf16_t* src = proj + (size_t)(b * SEQ + (sp < 0 ? 0 : sp)) * EVLD + col0;
#pragma unroll
            for (int i4 = 0; i4 < 4; ++i4) xin[j][i4] = *(const u32x4*)(src + i4 * 8);
        }
        float acc[32];
#pragma unroll
        for (int i = 0; i < 32; ++i) acc[i] = 0.f;
#pragma unroll
        for (int j = 0; j < 4; ++j) {
            const float ok = (n * 64 + c - 3 + j) >= 0 ? 1.f : 0.f;
            const float* wj = cwl + (j * 3 + which) * 128 + cq * 32;
#pragma unroll
            for (int i4 = 0; i4 < 4; ++i4) {
                const f32x4 wa = *(const f32x4*)(wj + i4 * 8), wb = *(const f32x4*)(wj + i4 * 8 + 4);
                const u32x4 w = xin[j][i4];
                acc[i4 * 8 + 0] += ok * wa[0] * __uint_as_float(w[0] << 16); acc[i4 * 8 + 1] += ok * wa[1] * __uint_as_float(w[0] & 0xffff0000u);
                acc[i4 * 8 + 2] += ok * wa[2] * __uint_as_float(w[1] << 16); acc[i4 * 8 + 3] += ok * wa[3] * __uint_as_float(w[1] & 0xffff0000u);
                acc[i4 * 8 + 4] += ok * wb[0] * __uint_as_float(w[2] << 16); acc[i4 * 8 + 5] += ok * wb[1] * __uint_as_float(w[2] & 0xffff0000u);
                acc[i4 * 8 + 6] += ok * wb[2] * __uint_as_float(w[3] << 16); acc[i4 * 8 + 7] += ok * wb[3] * __uint_as_float(w[3] & 0xffff0000u);
            }
        }
        float ss = 0.f;
#pragma unroll
        for (int i = 0; i < 32; ++i) { acc[i] = siluf_(acc[i]); ss += acc[i] * acc[i]; }
        ss += __shfl_xor(ss, 1); ss += __shfl_xor(ss, 2);
        const float rn = which == 2 ? 1.f : rsqrtf(ss + 1e-6f) * (which == 0 ? 0.08838834764831845f : 1.f);
        unsigned pk[16];
#pragma unroll
        for (int i = 0; i < 16; ++i) pk[i] = pack2(acc[2 * i] * rn, acc[2 * i + 1] * rn);
        if (which < 2) {
            char* img = which == 0 ? Qrow : Krow;
#pragma unroll
            for (int i4 = 0; i4 < 4; ++i4) { u32x4 w; w.x = pk[i4 * 4]; w.y = pk[i4 * 4 + 1]; w.z = pk[i4 * 4 + 2]; w.w = pk[i4 * 4 + 3]; *(u32x4*)(img + c * 272 + (cq * 32 + i4 * 8) * 2) = w; }
        } else {
#pragma unroll
            for (int i = 0; i < 16; ++i) vvp[i] = pk[i];
        }
    }
    if (cq == 0) {
        const float a = bf2f(proj[(size_t)(t0 + c) * EVLD + 2048 + h]);
        const float bb = bf2f(proj[(size_t)(t0 + c) * EVLD + 2052 + h]);
        const float Aexp = __expf(p.in[I_ALOG][li * 4 + h]), dtb = p.in[I_DTB][li * 4 + h];
        gcs[c] = -Aexp * softplusf_(a + dtb);
        bet[c] = sigmoidf_(bb);
    }
    __syncthreads();
    if (wid == 0) {
        float x = gcs[lane];
#pragma unroll
        for (int o = 1; o < 64; o <<= 1) { const float y = __shfl_up(x, o); if (lane >= o) x += y; }
        const float gl = __shfl(x, 63);
        gcs[lane] = x; egc[lane] = __expf(x); ekd[lane] = __expf(gl - x);
        if (lane == 63) ((float*)(p.ws + WS_CTL + CTL_EGL))[ch] = __expf(gl);
    }
    __syncthreads();
    {
        const int ti = wid;
#pragma unroll
        for (int tj = 0; tj < 4; ++tj) {
            if (tj <= ti) {
                const f32x4 kk = tile16(Krow, 272, 16 * ti, Krow, 272, 16 * tj, 128);
                const int c2 = 16 * tj + fr;
                f32x4 lv;
#pragma unroll
                for (int r = 0; r < 4; ++r) {
                    const int c1 = 16 * ti + fq * 4 + r;
                    lv[r] = (c1 > c2) ? bet[c1] * kk[r] * __expf(gcs[c1] - gcs[c2]) : 0.f;
                }
                *(f32x4*)&Lf[c2 * 68 + 16 * ti + fq * 4] = lv;
            }
            f32x4 qk = {0.f, 0.f, 0.f, 0.f};
            if (tj <= ti) qk = tile16(Krow, 272, 16 * tj, Qrow, 272, 16 * ti, 128);
            const int c1 = 16 * ti + fr;
            float o4[4];
#pragma unroll
            for (int r = 0; r < 4; ++r) { const int c2 = 16 * tj + fq * 4 + r; o4[r] = (c1 >= c2) ? qk[r] * __expf(gcs[c1] - gcs[c2]) : 0.f; }
            const int mt = c1 >> 5, rr = c1 & 31, hh = fq & 1, jg = fq >> 1;
            u32x2 w; w.x = pack2(o4[0], o4[1]); w.y = pack2(o4[2], o4[3]);
            *(u32x2*)(ops + GO_AF + ((size_t)((mt * 4 + tj) * 64 + hh * 32 + rr) * 8 + jg * 4) * 2) = w;
        }
#pragma unroll
        for (int i = 0; i < 4; ++i) {
            const int idx = tid + i * 256;
            {
                const int mt = idx >> 9, ks = (idx >> 6) & 7, l2 = idx & 63, rr = l2 & 31, hh = l2 >> 5, cc = 32 * mt + rr;
                const float sc = egc[cc];
                const u32x2 lo = *(const u32x2*)(Qrow + cc * 272 + (16 * ks + 4 * hh) * 2), hi = *(const u32x2*)(Qrow + cc * 272 + (16 * ks + 8 + 4 * hh) * 2);
                u32x4 w;
                w.x = pack2(__uint_as_float(lo.x << 16) * sc, __uint_as_float(lo.x & 0xffff0000u) * sc); w.y = pack2(__uint_as_float(lo.y << 16) * sc, __uint_as_float(lo.y & 0xffff0000u) * sc);
                w.z = pack2(__uint_as_float(hi.x << 16) * sc, __uint_as_float(hi.x & 0xffff0000u) * sc); w.w = pack2(__uint_as_float(hi.y << 16) * sc, __uint_as_float(hi.y & 0xffff0000u) * sc);
                *(u32x4*)(ops + GO_QF + (size_t)idx * 16) = w;
            }
            {
                const int mt = idx >> 8, ks = (idx >> 6) & 3, l2 = idx & 63, rr = l2 & 31, hh = l2 >> 5, dk = 32 * mt + rr;
                float e8[8];
#pragma unroll
                for (int j = 0; j < 8; ++j) { const int c2 = 16 * ks + 8 * (j >> 2) + 4 * hh + (j & 3); e8[j] = bf2f(*(const bf16_t*)(Krow + c2 * 272 + dk * 2)) * ekd[c2]; }
                u32x4 w; w.x = pack2(e8[0], e8[1]); w.y = pack2(e8[2], e8[3]); w.z = pack2(e8[4], e8[5]); w.w = pack2(e8[6], e8[7]);
                *(u32x4*)(ops + GO_KF + (size_t)idx * 16) = w;
            }
        }
    }
    __syncthreads();
    {
        const float bc = bet[c], bg = bc * egc[c];
        unsigned kvp[16];
#pragma unroll
        for (int i4 = 0; i4 < 4; ++i4) { const u32x4 w = *(const u32x4*)(Krow + c * 272 + (cq * 32 + i4 * 8) * 2); kvp[i4 * 4] = w.x; kvp[i4 * 4 + 1] = w.y; kvp[i4 * 4 + 2] = w.z; kvp[i4 * 4 + 3] = w.w; }
        __syncthreads();
#pragma unroll
        for (int i = 0; i < 16; ++i) {
            *(bf16_t*)(VbT + (cq * 32 + 2 * i) * 144 + c * 2) = f2bf(__uint_as_float(vvp[i] << 16) * bc);
            *(bf16_t*)(VbT + (cq * 32 + 2 * i + 1) * 144 + c * 2) = f2bf(__uint_as_float(vvp[i] & 0xffff0000u) * bc);
            *(bf16_t*)(KbgT + (cq * 32 + 2 * i) * 144 + c * 2) = f2bf(__uint_as_float(kvp[i] << 16) * bg);
            *(bf16_t*)(KbgT + (cq * 32 + 2 * i + 1) * 144 + c * 2) = f2bf(__uint_as_float(kvp[i] & 0xffff0000u) * bg);
        }
    }
    {
        char* L21i = lds + GP_END;
        char* T11T = L21i + 2560;
        char* MT = T11T + 2560;
        if (wid < 2) {
            const int o = 32 * wid;
            float Tc[32];
#pragma unroll
            for (int i = 0; i < 32; ++i) Tc[i] = (i == (lane & 31)) ? 1.f : 0.f;
#pragma unroll
            for (int j = 0; j < 31; ++j) {
                const float tj = Tc[j];
#pragma unroll
                for (int i4 = (j + 1) >> 2; i4 < 8; ++i4) {
                    const f32x4 l4 = *(const f32x4*)&Lf[(o + j) * 68 + o + i4 * 4];
#pragma unroll
                    for (int e = 0; e < 4; ++e) if (i4 * 4 + e > j) Tc[i4 * 4 + e] -= l4[e] * tj;
                }
            }
            if (lane < 32) {
#pragma unroll
                for (int i = 0; i < 32; ++i) *(bf16_t*)(Trow + (o + i) * 144 + (o + lane) * 2) = f2bf(Tc[i]);
                if (wid == 0) {
#pragma unroll
                    for (int i = 0; i < 32; ++i) *(bf16_t*)(Trow + i * 144 + (32 + lane) * 2) = 0;
#pragma unroll
                    for (int i4 = 0; i4 < 8; ++i4) { u32x2 w; w.x = pack2(Tc[i4 * 4], Tc[i4 * 4 + 1]); w.y = pack2(Tc[i4 * 4 + 2], Tc[i4 * 4 + 3]); *(u32x2*)(T11T + lane * 80 + i4 * 8) = w; }
                }
            }
        } else {
            const int t2 = tid - 128;
#pragma unroll
            for (int g2 = 0; g2 < 2; ++g2) {
                const int i = t2 & 31, k4 = ((t2 >> 5) + 4 * g2) * 4;
                u32x2 w;
                w.x = pack2(Lf[(k4 + 0) * 68 + 32 + i], Lf[(k4 + 1) * 68 + 32 + i]); w.y = pack2(Lf[(k4 + 2) * 68 + 32 + i], Lf[(k4 + 3) * 68 + 32 + i]);
                *(u32x2*)(L21i + i * 80 + k4 * 2) = w;
            }
        }
        __syncthreads();
        {
            const int r0 = 16 * (wid >> 1), c0 = 16 * (wid & 1);
            const f32x4 mm = tile16(L21i, 80, r0, T11T, 80, c0, 32);
            u32x2 w; w.x = pack2(mm[0], mm[1]); w.y = pack2(mm[2], mm[3]);
            *(u32x2*)(MT + (c0 + fr) * 80 + (r0 + 4 * fq) * 2) = w;
        }
        __syncthreads();
        {
            const int r0 = 16 * (wid >> 1), c0 = 16 * (wid & 1);
            const f32x4 tt = tile16(MT, 80, c0, Trow + 32 * 144 + 64, 144, r0, 32);
            u32x2 w; w.x = pack2(-tt[0], -tt[1]); w.y = pack2(-tt[2], -tt[3]);
            *(u32x2*)(Trow + (32 + r0 + fr) * 144 + (c0 + 4 * fq) * 2) = w;
        }
    }
    __syncthreads();
#pragma unroll
    for (int tq = 0; tq < 2; ++tq) {
        const int tj = wid * 2 + tq;
#pragma unroll
        for (int ti = 0; ti < 4; ++ti) {
            const f32x4 u = tile16(Trow, 144, 16 * ti, VbT, 144, 16 * tj, 64);
            {
                const int dv = 16 * tj + fr, slice = dv >> 5, rr = dv & 31, cb = 16 * ti + fq * 4, mt = cb >> 5, q4 = (cb & 31) >> 2, hh = q4 & 1, rg = q4 >> 1;
                u32x2 w; w.x = pack2(u[0], u[1]); w.y = pack2(u[2], u[3]);
                *(u32x2*)(ops + GO_UF + ((size_t)((slice * 2 + mt) * 64 + hh * 32 + rr) * 16 + rg * 4) * 2) = w;
            }
            const f32x4 wv = tile16(KbgT, 144, 16 * tj, Trow, 144, 16 * ti, 64);
            {
                const int c1 = 16 * ti + fr, mt = c1 >> 5, rr = c1 & 31, hh = fq & 1, jg = fq >> 1;
                u32x2 w; w.x = pack2(-wv[0], -wv[1]); w.y = pack2(-wv[2], -wv[3]);
                *(u32x2*)(ops + GO_WF + ((size_t)((mt * 8 + tj) * 64 + hh * 32 + rr) * 8 + jg * 4) * 2) = w;
            }
        }
    }
}

DI void glds16(const void* g, char* l) { __builtin_amdgcn_global_load_lds((const unsigned*)g, (lds_u32*)l, 16, 0, 0); }
DI void fr_rd(bf16x8& f, unsigned addr) { asm volatile("ds_read_b128 %0, %1" : "=v"(f) : "v"(addr) : "memory"); }
template <int N> DI void fr_wait(bf16x8& f) { asm volatile("s_waitcnt lgkmcnt(%1)" : "+v"(f) : "n"(N) : "memory"); }
template <int REM> DI void fr_waitc(bf16x8& f) { if (REM >= 3) fr_wait<3>(f); else if (REM == 2) fr_wait<2>(f); else if (REM == 1) fr_wait<1>(f); else fr_wait<0>(f); }
#define GS_WAIT(n) asm volatile("s_waitcnt vmcnt(" #n ")" ::: "memory")
DI void gdn_scan_block(const P& p, int bh, char* lds, bool dry = false) {
    const int tid = tidx(), lane = tid & 63, w = tid >> 6;
    const int h = bh & 3, b = bh >> 2;
    const float eglv = ((const float*)(p.ws + WS_CTL + CTL_EGL))[(b * 64 + lane) * 4 + h];
    unsigned char* gbase = p.ws + WS_GOPS + (size_t)(b * 256 + h) * GOPS_CH;
    auto issue = [&](int n, int k0, int cntk) {
        for (int k = k0; k < k0 + cntk; ++k) {
            const unsigned char* src = gbase + (size_t)n * 4 * GOPS_CH + k * 8192 + tid * 16;
            char* dst = lds + k * 8192 + tid * 16;
            glds16(src, dst); glds16(src + 4096, dst + 4096);
        }
    };
    const unsigned la = (unsigned)(size_t)(lds_u32*)lds + lane * 16;
    f32x16 S[4];
#pragma unroll
    for (int i = 0; i < 4; ++i)
#pragma unroll
        for (int r = 0; r < 16; ++r) S[i][r] = 0.f;
    __syncthreads();
    issue(0, 0, 7);
#pragma unroll 1
    for (int n = 0; n < 64; ++n) {
        const float egl = __shfl(eglv, n);
        bf16x8 Sb[8];
#pragma unroll
        for (int i = 0; i < 4; ++i) { Sb[i * 2] = pack_step(S[i], 0); Sb[i * 2 + 1] = pack_step(S[i], 1); }
        f32x16 av[2], ao[2];
        GS_WAIT(6);
        __builtin_amdgcn_s_barrier();
        issue(n, 7, 2);
        __builtin_amdgcn_sched_barrier(0);
        {
            const char* sl = lds + (w >> 1) * 8192;
#pragma unroll
            for (int mt = 0; mt < 2; ++mt) {
                const u32x4* up = (const u32x4*)(sl + ((w & 1) * 2 + mt) * 2048 + lane * 32);
                const u32x4 u0 = up[0], u1 = up[1];
#pragma unroll
                for (int e = 0; e < 4; ++e) {
                    av[mt][e * 2] = __uint_as_float(u0[e] << 16); av[mt][e * 2 + 1] = __uint_as_float(u0[e] & 0xffff0000u);
                    av[mt][8 + e * 2] = __uint_as_float(u1[e] << 16); av[mt][8 + e * 2 + 1] = __uint_as_float(u1[e] & 0xffff0000u);
                }
            }
        }
        bf16x8 F[4];
#define GS_O0(j) (unsigned)((2 + ((j) & 1)) * 8192 + ((j) >> 1) * 1024)
#pragma unroll
        for (int j = 0; j < 4; ++j) fr_rd(F[j], la + GS_O0(j));
#pragma unroll
        for (int j = 0; j < 16; ++j) {
            if (j <= 12) fr_wait<3>(F[j & 3]); else if (j == 13) fr_wait<2>(F[j & 3]); else if (j == 14) fr_wait<1>(F[j & 3]); else fr_wait<0>(F[j & 3]);
            av[j & 1] = mfma32(F[j & 3], Sb[j >> 1], av[j & 1]);
            if (j + 4 < 16) fr_rd(F[j & 3], la + GS_O0(j + 4));
        }
        bf16x8 Vb[4];
#pragma unroll
        for (int mt = 0; mt < 2; ++mt) { Vb[mt * 2] = pack_step(av[mt], 0); Vb[mt * 2 + 1] = pack_step(av[mt], 1); }
        GS_WAIT(4);
        __builtin_amdgcn_s_barrier();
        if (n < 63) issue(n + 1, 0, 4);
        __builtin_amdgcn_sched_barrier(0);
#pragma unroll
        for (int mt = 0; mt < 2; ++mt)
#pragma unroll
            for (int r = 0; r < 16; ++r) ao[mt][r] = 0.f;
#define GS_O1(j) (unsigned)((j) < 16 ? (4 + ((j) & 1)) * 8192 + ((j) >> 1) * 1024 : 6 * 8192 + ((j) == 16 ? 0 : (j) == 17 ? 4 : (j) == 18 ? 1 : (j) == 19 ? 5 : (j) == 20 ? 6 : 7) * 1024)
#pragma unroll
        for (int j = 0; j < 4; ++j) fr_rd(F[j], la + GS_O1(j));
#pragma unroll
        for (int j = 0; j < 22; ++j) {
            if (j <= 18) fr_wait<3>(F[j & 3]); else if (j == 19) fr_wait<2>(F[j & 3]); else if (j == 20) fr_wait<1>(F[j & 3]); else fr_wait<0>(F[j & 3]);
            if (j < 16) {
                ao[j & 1] = mfma32(F[j & 3], Sb[j >> 1], ao[j & 1]);
                if (j & 1) {
                    const int ks = j >> 1;
#pragma unroll
                    for (int r = 0; r < 8; ++r) S[ks >> 1][(ks & 1) * 8 + r] *= egl;
                }
            } else {
                const int oi = (j == 16 || j == 18) ? 0 : 1, kv = j <= 17 ? 0 : j <= 19 ? 1 : j == 20 ? 2 : 3;
                ao[oi] = mfma32(F[j & 3], Vb[kv], ao[oi]);
            }
            if (j + 4 < 22) fr_rd(F[j & 3], la + GS_O1(j + 4));
        }
        if (n < 63) GS_WAIT(8); else GS_WAIT(0);
        __builtin_amdgcn_s_barrier();
        if (n < 63) issue(n + 1, 4, 3);
        __builtin_amdgcn_sched_barrier(0);
#define GS_O2(j) (unsigned)((7 + (((j) & 3) >> 1)) * 8192 + ((((j) & 3) & 1) * 4 + ((j) >> 2)) * 1024)
#pragma unroll
        for (int j = 0; j < 4; ++j) fr_rd(F[j], la + GS_O2(j));
#pragma unroll
        for (int j = 0; j < 16; ++j) {
            if (j <= 12) fr_wait<3>(F[j & 3]); else if (j == 13) fr_wait<2>(F[j & 3]); else if (j == 14) fr_wait<1>(F[j & 3]); else fr_wait<0>(F[j & 3]);
            S[j & 3] = mfma32(F[j & 3], Vb[j >> 2], S[j & 3]);
            if (j + 4 < 16) fr_rd(F[j & 3], la + GS_O2(j + 4));
        }
        {
            u32x4* Of = (u32x4*)((dry ? p.ws + WS_DUMMY + (size_t)(bh & 15) * 65536 : gbase + (size_t)n * 4 * GOPS_CH) + GO_UF) + (size_t)(w * 2 * 64 + lane) * 2;
#pragma unroll
            for (int mt = 0; mt < 2; ++mt) {
                u32x4 o0, o1;
#pragma unroll
                for (int e = 0; e < 4; ++e) { o0[e] = pack2(ao[mt][e * 2], ao[mt][e * 2 + 1]); o1[e] = pack2(ao[mt][8 + e * 2], ao[mt][8 + e * 2 + 1]); }
                Of[mt * 128] = o0; Of[mt * 128 + 1] = o1;
            }
        }
    }
    __syncthreads();
}

DI void gdn_post_unit(const P& p, int li, int ch) {
    const int tid = tidx();
    const int h = ch & 3, n = (ch >> 2) & 63, b = ch >> 8;
    const int t0 = b * SEQ + n * 64;
    const int c = tid >> 2, cq = tid & 3;
    const bf16_t* Of = (const bf16_t*)(p.ws + WS_GOPS + (size_t)ch * GOPS_CH + GO_UF);
    const bf16_t* proj = (const bf16_t*)(p.ws + WS_PROJ);
    bf16_t* mix = (bf16_t*)(p.ws + WS_PROJ);
    const float* nw = p.in[I_GDNNORM] + li * 128 + cq * 32;
    const int mt = c >> 5, q4 = (c & 31) >> 2, hh = q4 & 1, rg = q4 >> 1, reg = rg * 4 + (c & 3);
    float o[32]; float ss = 0.f;
#pragma unroll
    for (int r = 0; r < 32; ++r) { o[r] = bf2f(Of[(size_t)((cq * 2 + mt) * 64 + hh * 32 + r) * 16 + reg]); ss += o[r] * o[r]; }
    ss += __shfl_xor(ss, 1); ss += __shfl_xor(ss, 2);
    const float rs = rsqrtf(ss * (1.f / 128.f) + 1e-6f);
    const bf16_t* zp = proj + (size_t)(t0 + c) * EVLD + 1536 + h * 128 + cq * 32;
    bf16_t* mp = mix + (size_t)(t0 + c) * EVLD + h * 128 + cq * 32;
#pragma unroll
    for (int i4 = 0; i4 < 4; ++i4) {
        const u32x4 zw = *(const u32x4*)(zp + i4 * 8);
        u32x4 w;
#pragma unroll
        for (int e = 0; e < 4; ++e) {
            const float z0 = __uint_as_float(zw[e] << 16), z1 = __uint_as_float(zw[e] & 0xffff0000u);
            w[e] = pack2(o[i4 * 8 + e * 2] * rs * nw[i4 * 8 + e * 2] * siluf_(z0), o[i4 * 8 + e * 2 + 1] * rs * nw[i4 * 8 + e * 2 + 1] * siluf_(z1));
        }
        *(u32x4*)(mp + i4 * 8) = w;
    }
}


constexpr int RP_Z0 = 0, RP_Z1 = 18432, RP_Z2 = 55296, RP_VEC = 73728, RP_PT = 75008, RP_T11 = 78080, RP_END = 80640;
constexpr int RP_LIN = 0, RP_LW = 25600;
DI void rwkv_prep_unit(const P& p, int li, int ch, char* lds) {
    const int tid = tidx(), lane = tid & 63, wid = tid >> 6, fr = lane & 15, fq = lane >> 4;
    const int h = ch & 7, n = (ch >> 3) & 63, b = ch >> 9;
    const int t0 = b * SEQ + n * 64;
    const bf16_t* proj = (const bf16_t*)(p.ws + WS_PROJ);
    char* Lfc = lds + RP_Z0; float* Lf = (float*)Lfc;
    char* ApT = lds + RP_Z0; char* AkVT = lds + RP_Z0 + 9216;
    char* Arow = lds + RP_Z1; char* Rrow = Arow + 9216; char* Brow = Arow + 18432; char* Krow = Arow + 27648;
    char* Aak = Arow; char* Arb = Rrow; char* Ark = Brow; char* Trow = Krow; char* BhT = Krow; char* VpT = Aak;
    char* AT = lds + RP_Z2; char* VT = AT + 9216; char* KhT = AT;
    float* tot = (float*)(lds + RP_VEC); float* WC = tot + 256;
    char* lin = lds + RP_LIN; char* LWi = lds + RP_LW;
    float* PT = (float*)(lds + RP_PT);
    {
        const float* mu0 = p.in[I_MU] + (size_t)li * 1696;
        if (tid < 48) {
            const int j0 = tid * 4;
            *(float4*)(PT + j0) = j0 < 160 ? *(const float4*)(mu0 + (C_HW - RW0) + j0) : *(const float4*)(p.in[I_VRESMU] + j0 - 160);
        } else if (tid < 48 + 144) {
            const int q = tid - 48, arr = q >> 4, c4 = (q & 15) * 4, chn = h * 64 + c4;
            const float* src = arr == 0 ? mu0 + (C_R - RW0) + chn : arr == 1 ? mu0 + (C_K - RW0) + chn : arr == 2 ? mu0 + (C_V - RW0) + chn
                             : arr == 3 ? p.in[I_W0] + li * 512 + chn : arr == 4 ? p.in[I_A0] + li * 512 + chn : arr == 5 ? p.in[I_V0] + chn
                             : arr == 6 ? p.in[I_KK] + li * 512 + chn : arr == 7 ? p.in[I_KA] + li * 512 + chn : p.in[I_RK] + li * 512 + chn;
            *(float4*)(PT + 192 + arr * 64 + c4) = *(const float4*)src;
        }
    }
    __syncthreads();
    {
        const int c = tid >> 2, cq = tid & 3, s = n * 64 + c;
        const bf16_t* cur = proj + (size_t)(t0 + c) * EVLD + C_HW + cq * 48;
        const float* mu = p.in[I_MU] + (size_t)li * 1696 + (C_HW - RW0);
        const float* vmu = p.in[I_VRESMU];
#pragma unroll
        for (int i6 = 0; i6 < 6; ++i6) {
            const u32x4 cw4 = *(const u32x4*)(cur + i6 * 8);
            u32x4 pw4 = *(const u32x4*)(cur - (s > 0 ? EVLD : 0) + i6 * 8);
            if (s == 0) pw4 = (u32x4){0u, 0u, 0u, 0u};
            const int j0 = cq * 48 + i6 * 8;
            const float4 ma = *(const float4*)(PT + j0), mb = *(const float4*)(PT + j0 + 4);
            const float mm[8] = {ma.x, ma.y, ma.z, ma.w, mb.x, mb.y, mb.z, mb.w};
            const bool is_t = j0 < 32, is_s = (j0 >= 64) && (j0 < 160);
            const float ca = is_t ? 1.f : 0.f, cb = is_t ? -2.f : 1.f, cc = is_t ? 2.f : -1.f;
            u32x4 w;
#pragma unroll
            for (int e = 0; e < 4; ++e) {
                float o2[2];
#pragma unroll
                for (int q = 0; q < 2; ++q) {
                    const float cv = q ? __uint_as_float(cw4[e] & 0xffff0000u) : __uint_as_float(cw4[e] << 16);
                    const float pv = q ? __uint_as_float(pw4[e] & 0xffff0000u) : __uint_as_float(pw4[e] << 16);
                    const float val = cv + mm[e * 2 + q] * (pv - cv);
                    const float act = ca + cb * __builtin_amdgcn_rcpf(1.f + __expf(cc * val));
                    o2[q] = (is_t || is_s) ? act : val;
                }
                w[e] = pack2(o2[0], o2[1]);
            }
            *(u32x4*)(lin + c * 400 + (cq * 48 + i6 * 8) * 2) = w;
        }
        const bf16_t* LW = (const bf16_t*)(p.ws + WS_W + W_LW) + (size_t)h * 64 * 192;
#pragma unroll
        for (int i6 = 0; i6 < 6; ++i6) *(u32x4*)(LWi + c * 400 + (cq * 48 + i6 * 8) * 2) = *(const u32x4*)(LW + (size_t)c * 192 + cq * 48 + i6 * 8);
    }
    __syncthreads();
    float lw_[16], la_[16], lg_[16], lv_[16];
#pragma unroll
    for (int tj = 0; tj < 4; ++tj) {
        const f32x4 a = tile16(LWi, 400, 16 * tj, lin, 400, 16 * wid, 32);
        const f32x4 bq = tile16(LWi + 64, 400, 16 * tj, lin + 64, 400, 16 * wid, 32);
        const f32x4 cg = tile16(LWi + 128, 400, 16 * tj, lin + 128, 400, 16 * wid, 96);
        const f32x4 dv = tile16(LWi + 320, 400, 16 * tj, lin + 320, 400, 16 * wid, 32);
#pragma unroll
        for (int r = 0; r < 4; ++r) { lw_[tj * 4 + r] = a[r]; la_[tj * 4 + r] = bq[r]; lg_[tj * 4 + r] = cg[r]; lv_[tj * 4 + r] = dv[r]; }
    }
    __syncthreads();
    const int c = 16 * wid + fr;
    float at[16], rt[16], bt[16], kt[16], bh[16], kh[16];
    {
        const int s = n * 64 + c;
        const size_t row = (size_t)(t0 + c);
        const float* mu = p.in[I_MU] + (size_t)li * 1696;
        const int hc = h * 64;
        float rr_[16], kk_[16], lwv[16], aa[16];
        float kn = 0.f, rk = 0.f;
        bf16_t* vf = (bf16_t*)(p.ws + WS_VF);
        bf16_t* gg = (bf16_t*)(p.ws + WS_GG);
#pragma unroll
        for (int tj = 0; tj < 4; ++tj) {
            const int cb = 16 * tj + 4 * fq;
            u32x2 cr = *(const u32x2*)(proj + row * EVLD + C_R + hc + cb), ck = *(const u32x2*)(proj + row * EVLD + C_K + hc + cb), cv = *(const u32x2*)(proj + row * EVLD + C_V + hc + cb);
            const size_t prow = s > 0 ? row - 1 : row;
            u32x2 pr = *(const u32x2*)(proj + prow * EVLD + C_R + hc + cb), pk = *(const u32x2*)(proj + prow * EVLD + C_K + hc + cb), pv = *(const u32x2*)(proj + prow * EVLD + C_V + hc + cb);
            if (s == 0) { pr = (u32x2){0u, 0u}; pk = pr; pv = pr; }
            u32x2 vfw = {0u, 0u};
            if (li == 1) vfw = *(const u32x2*)(vf + row * 512 + hc + cb);
            float vout[4], gout[4];
            const int ch0 = hc + cb;
            const float* pt = PT + 192 + cb;
            const float4 mu_r4 = *(const float4*)(pt), mu_k4 = *(const float4*)(pt + 64), mu_v4 = *(const float4*)(pt + 128);
            const float4 w0_4 = *(const float4*)(pt + 192), a0_4 = *(const float4*)(pt + 256), v0_4 = *(const float4*)(pt + 320);
            const float4 kk_4 = *(const float4*)(pt + 384), ka_4 = *(const float4*)(pt + 448), rk_4 = *(const float4*)(pt + 512);
            const float mur[4] = {mu_r4.x, mu_r4.y, mu_r4.z, mu_r4.w}, muk[4] = {mu_k4.x, mu_k4.y, mu_k4.z, mu_k4.w}, muv[4] = {mu_v4.x, mu_v4.y, mu_v4.z, mu_v4.w};
            const float w0v[4] = {w0_4.x, w0_4.y, w0_4.z, w0_4.w}, a0v[4] = {a0_4.x, a0_4.y, a0_4.z, a0_4.w}, v0v[4] = {v0_4.x, v0_4.y, v0_4.z, v0_4.w};
            const float kkp[4] = {kk_4.x, kk_4.y, kk_4.z, kk_4.w}, kap[4] = {ka_4.x, ka_4.y, ka_4.z, ka_4.w}, rkp[4] = {rk_4.x, rk_4.y, rk_4.z, rk_4.w};
#pragma unroll
            for (int r = 0; r < 4; ++r) {
                const int i = tj * 4 + r;
                const unsigned wcr = r < 2 ? cr.x : cr.y, wck = r < 2 ? ck.x : ck.y, wcv = r < 2 ? cv.x : cv.y;
                const unsigned wpr = r < 2 ? pr.x : pr.y, wpk = r < 2 ? pk.x : pk.y, wpv = r < 2 ? pv.x : pv.y, wvf = r < 2 ? vfw.x : vfw.y;
                const float c_r = (r & 1) ? __uint_as_float(wcr & 0xffff0000u) : __uint_as_float(wcr << 16);
                const float c_k = (r & 1) ? __uint_as_float(wck & 0xffff0000u) : __uint_as_float(wck << 16);
                const float c_v = (r & 1) ? __uint_as_float(wcv & 0xffff0000u) : __uint_as_float(wcv << 16);
                const float p_r = (r & 1) ? __uint_as_float(wpr & 0xffff0000u) : __uint_as_float(wpr << 16);
                const float p_k = (r & 1) ? __uint_as_float(wpk & 0xffff0000u) : __uint_as_float(wpk << 16);
                const float p_v = (r & 1) ? __uint_as_float(wpv & 0xffff0000u) : __uint_as_float(wpv << 16);
                const float rm = c_r + mur[r] * (p_r - c_r);
                const float km = c_k + muk[r] * (p_k - c_k);
                float vm = c_v + muv[r] * (p_v - c_v);
                const float wlog = -softplusf_(-(w0v[r] + lw_[i])) - 0.5f;
                lwv[i] = -__expf(wlog);
                const float a = sigmoidf_(a0v[r] + la_[i]);
                if (li == 1) {
                    const float v1 = (r & 1) ? __uint_as_float(wvf & 0xffff0000u) : __uint_as_float(wvf << 16);
                    vm = vm + (v1 - vm) * sigmoidf_(v0v[r] + lv_[i]);
                }
                const float kkv = km * kkp[r];
                kn += kkv * kkv;
                rr_[i] = rm; kk_[i] = kkv; aa[i] = a;
                kt[i] = km * (1.f + (a - 1.f) * kap[r]);
                rk += rm * kt[i] * rkp[r];
                vout[r] = vm; gout[r] = lg_[i];
            }
            u32x2 w; w.x = pack2(vout[0], vout[1]); w.y = pack2(vout[2], vout[3]);
            *(u32x2*)(vf + row * 512 + hc + cb) = w;
            w.x = pack2(gout[0], gout[1]); w.y = pack2(gout[2], gout[3]);
            *(u32x2*)(gg + row * 512 + hc + cb) = w;
#pragma unroll
            for (int r = 0; r < 4; ++r) *(bf16_t*)(VT + (cb + r) * 144 + c * 2) = f2bf(vout[r]);
            __builtin_amdgcn_sched_barrier(0);
        }
        kn += __shfl_xor(kn, 16); kn += __shfl_xor(kn, 32);
        const float kr = rsqrtf(kn + 1e-6f);
        rk += __shfl_xor(rk, 16); rk += __shfl_xor(rk, 32);
        if (fq == 0) ((float*)(p.ws + WS_RK))[row * 8 + h] = rk;
        float cs[16];
#pragma unroll
        for (int i = 0; i < 16; ++i) {
            float x = lwv[i];
#pragma unroll
            for (int o = 1; o < 16; o <<= 1) { const float y = __shfl_up(x, o, 16); if (fr >= o) x += y; }
            cs[i] = x;
        }
        if (fr == 15) {
#pragma unroll
            for (int i = 0; i < 16; ++i) tot[wid * 64 + 16 * (i >> 2) + 4 * fq + (i & 3)] = cs[i];
        }
        __syncthreads();
#pragma unroll
        for (int i = 0; i < 16; ++i) {
            const int chl = 16 * (i >> 2) + 4 * fq + (i & 3);
            float pre = 0.f, all = 0.f;
#pragma unroll
            for (int w2 = 0; w2 < 4; ++w2) { const float tv = tot[w2 * 64 + chl]; all += tv; if (w2 < wid) pre += tv; }
            const float csi = cs[i] + pre, csm = csi - lwv[i];
            const float kkn = kk_[i] * kr, k2 = kt[i];
            const float e_c = __expf(csi), e_n = __builtin_amdgcn_rcpf(e_c), e_m = __expf(csm), e_h = __expf(all) * e_n;
            at[i] = -kkn * e_m; rt[i] = rr_[i] * e_c;
            const float bp = kkn * aa[i];
            bt[i] = bp * e_n; kt[i] = k2 * e_n; bh[i] = bp * e_h; kh[i] = k2 * e_h;
            if (c == 0) WC[chl] = __expf(all);
            if ((i & 3) == 3) __builtin_amdgcn_sched_barrier(0);
        }
    }
#pragma unroll
    for (int tj = 0; tj < 4; ++tj) {
        const int cb = 16 * tj + 4 * fq;
        u32x2 w;
        w.x = pack2(at[tj * 4], at[tj * 4 + 1]); w.y = pack2(at[tj * 4 + 2], at[tj * 4 + 3]); *(u32x2*)(Arow + c * 144 + cb * 2) = w;
        w.x = pack2(rt[tj * 4], rt[tj * 4 + 1]); w.y = pack2(rt[tj * 4 + 2], rt[tj * 4 + 3]); *(u32x2*)(Rrow + c * 144 + cb * 2) = w;
        w.x = pack2(bt[tj * 4], bt[tj * 4 + 1]); w.y = pack2(bt[tj * 4 + 2], bt[tj * 4 + 3]); *(u32x2*)(Brow + c * 144 + cb * 2) = w;
        w.x = pack2(kt[tj * 4], kt[tj * 4 + 1]); w.y = pack2(kt[tj * 4 + 2], kt[tj * 4 + 3]); *(u32x2*)(Krow + c * 144 + cb * 2) = w;
#pragma unroll
        for (int r = 0; r < 4; ++r) {
            *(bf16_t*)(AT + (cb + r) * 144 + c * 2) = f2bf(at[tj * 4 + r]);
        }
    }
    __syncthreads();
    f32x4 pab[4], pak[4], prb[4], prk[4];
    {
        const int ti = wid;
#pragma unroll
        for (int tj = 0; tj < 4; ++tj) {
            pab[tj] = (f32x4){0.f, 0.f, 0.f, 0.f}; pak[tj] = pab[tj]; prb[tj] = pab[tj]; prk[tj] = pab[tj];
            if (tj <= ti) {
                pab[tj] = tile16(Arow, 144, 16 * ti, Brow, 144, 16 * tj, 64);
                pak[tj] = tile16(Krow, 144, 16 * tj, Arow, 144, 16 * ti, 64);
                prb[tj] = tile16(Brow, 144, 16 * tj, Rrow, 144, 16 * ti, 64);
                prk[tj] = tile16(Krow, 144, 16 * tj, Rrow, 144, 16 * ti, 64);
            }
        }
    }
    __syncthreads();
    {
        const int ti = wid;
#pragma unroll
        for (int tj = 0; tj < 4; ++tj) {
            const int s1 = 16 * tj + fr;
            f32x4 lv;
#pragma unroll
            for (int r = 0; r < 4; ++r) { const int t1 = 16 * ti + 4 * fq + r; lv[r] = (s1 < t1) ? -pab[tj][r] : 0.f; }
            *(f32x4*)&Lf[s1 * 72 + 16 * ti + 4 * fq] = lv;
            const int t2 = 16 * ti + fr;
            float m1[4], m2[4], m3[4];
#pragma unroll
            for (int r = 0; r < 4; ++r) { const int s2 = 16 * tj + 4 * fq + r; m1[r] = (s2 < t2) ? pak[tj][r] : 0.f; m2[r] = (s2 <= t2) ? prb[tj][r] : 0.f; m3[r] = (s2 <= t2) ? prk[tj][r] : 0.f; }
            u32x2 w;
            w.x = pack2(m1[0], m1[1]); w.y = pack2(m1[2], m1[3]); *(u32x2*)(Aak + t2 * 144 + (16 * tj + 4 * fq) * 2) = w;
            w.x = pack2(m2[0], m2[1]); w.y = pack2(m2[2], m2[3]); *(u32x2*)(Arb + t2 * 144 + (16 * tj + 4 * fq) * 2) = w;
            w.x = pack2(m3[0], m3[1]); w.y = pack2(m3[2], m3[3]); *(u32x2*)(Ark + t2 * 144 + (16 * tj + 4 * fq) * 2) = w;
        }
    }
    __syncthreads();
    {
        char* L21i = lds + RP_PT;
        char* T11T = lds + RP_T11;
        char* MT = lds + RP_Z0;
        if (wid < 2) {
            const int o = 32 * wid;
            float Tc[32];
#pragma unroll
            for (int i = 0; i < 32; ++i) Tc[i] = (i == (lane & 31)) ? 1.f : 0.f;
#pragma unroll
            for (int j = 0; j < 31; ++j) {
                const float tj = Tc[j];
#pragma unroll
                for (int i4 = (j + 1) >> 2; i4 < 8; ++i4) {
                    const f32x4 l4 = *(const f32x4*)&Lf[(o + j) * 72 + o + i4 * 4];
#pragma unroll
                    for (int e = 0; e < 4; ++e) if (i4 * 4 + e > j) Tc[i4 * 4 + e] -= l4[e] * tj;
                }
            }
            if (lane < 32) {
#pragma unroll
                for (int i = 0; i < 32; ++i) *(bf16_t*)(Trow + (o + i) * 144 + (o + lane) * 2) = f2bf(Tc[i]);
                if (wid == 0) {
#pragma unroll
                    for (int i = 0; i < 32; ++i) *(bf16_t*)(Trow + i * 144 + (32 + lane) * 2) = 0;
#pragma unroll
                    for (int i4 = 0; i4 < 8; ++i4) { u32x2 w; w.x = pack2(Tc[i4 * 4], Tc[i4 * 4 + 1]); w.y = pack2(Tc[i4 * 4 + 2], Tc[i4 * 4 + 3]); *(u32x2*)(T11T + lane * 80 + i4 * 8) = w; }
                }
            }
        } else {
            const int t2 = tid - 128;
#pragma unroll
            for (int g2 = 0; g2 < 2; ++g2) {
                const int i = t2 & 31, k4 = ((t2 >> 5) + 4 * g2) * 4;
                u32x2 w;
                w.x = pack2(Lf[(k4 + 0) * 72 + 32 + i], Lf[(k4 + 1) * 72 + 32 + i]); w.y = pack2(Lf[(k4 + 2) * 72 + 32 + i], Lf[(k4 + 3) * 72 + 32 + i]);
                *(u32x2*)(L21i + i * 80 + k4 * 2) = w;
            }
        }
        __syncthreads();
        {
            const int r0 = 16 * (wid >> 1), c0 = 16 * (wid & 1);
            const f32x4 mm = tile16(L21i, 80, r0, T11T, 80, c0, 32);
            u32x2 w; w.x = pack2(mm[0], mm[1]); w.y = pack2(mm[2], mm[3]);
            *(u32x2*)(MT + (c0 + fr) * 80 + (r0 + 4 * fq) * 2) = w;
        }
        __syncthreads();
        {
            const int r0 = 16 * (wid >> 1), c0 = 16 * (wid & 1);
            const f32x4 tt = tile16(MT, 80, c0, Trow + 32 * 144 + 64, 144, r0, 32);
            u32x2 w; w.x = pack2(-tt[0], -tt[1]); w.y = pack2(-tt[2], -tt[3]);
            *(u32x2*)(Trow + (32 + r0 + fr) * 144 + (c0 + 4 * fq) * 2) = w;
        }
    }
    __syncthreads();
    {
        const int ti = wid;
#pragma unroll
        for (int tj = 0; tj < 4; ++tj) {
            const f32x4 x = tile16(Trow, 144, 16 * ti, AT, 144, 16 * tj, 64);
            const f32x4 y = tile16(Aak, 144, 16 * ti, VT, 144, 16 * tj, 64);
            u32x2 w;
            w.x = pack2(x[0], x[1]); w.y = pack2(x[2], x[3]); *(u32x2*)(ApT + (16 * tj + fr) * 144 + (16 * ti + 4 * fq) * 2) = w;
            w.x = pack2(y[0], y[1]); w.y = pack2(y[2], y[3]); *(u32x2*)(AkVT + (16 * tj + fr) * 144 + (16 * ti + 4 * fq) * 2) = w;
        }
    }
    __syncthreads();
    {
        const int ti = wid;
#pragma unroll
        for (int tj = 0; tj < 4; ++tj) {
            const f32x4 x = tile16(Trow, 144, 16 * ti, AkVT, 144, 16 * tj, 64);
            u32x2 w; w.x = pack2(x[0], x[1]); w.y = pack2(x[2], x[3]); *(u32x2*)(VpT + (16 * tj + fr) * 144 + (16 * ti + 4 * fq) * 2) = w;
        }
    }
    __syncthreads();
#pragma unroll
    for (int tj = 0; tj < 4; ++tj)
#pragma unroll
        for (int r = 0; r < 4; ++r) {
            const int cb = 16 * tj + 4 * fq + r;
            *(bf16_t*)(BhT + cb * 144 + c * 2) = f2bf(bh[tj * 4 + r]);
            *(bf16_t*)(KhT + cb * 144 + c * 2) = f2bf(kh[tj * 4 + r]);
        }
    __syncthreads();
    {
        unsigned char* opsA = (unsigned char*)p.out + (size_t)ch * 16384;
        unsigned char* opsB = p.ws + WS_ROPS + (size_t)ch * 16384;
        const int ti = wid;
#pragma unroll
        for (int tj = 0; tj < 4; ++tj) {
            const f32x4 x = tile16(ApT, 144, 16 * tj, Arb, 144, 16 * ti, 64);
            const f32x4 g = tile16(ApT, 144, 16 * tj, BhT, 144, 16 * ti, 64);
            const int m1 = 16 * ti + fr, mt = m1 >> 5, rr = m1 & 31, hh = fq & 1, jg = fq >> 1;
            const size_t off = ((size_t)((mt * 4 + tj) * 64 + hh * 32 + rr) * 8 + jg * 4) * 2;
            float gd[4];
#pragma unroll
            for (int r = 0; r < 4; ++r) gd[r] = g[r] + ((16 * tj + 4 * fq + r == m1) ? WC[m1] : 0.f);
            u32x2 w;
            w.x = pack2(x[0] + rt[tj * 4], x[1] + rt[tj * 4 + 1]); w.y = pack2(x[2] + rt[tj * 4 + 2], x[3] + rt[tj * 4 + 3]); *(u32x2*)(opsA + off) = w;
            w.x = pack2(gd[0], gd[1]); w.y = pack2(gd[2], gd[3]); *(u32x2*)(opsA + 8192 + off) = w;
            f32x4 y = tile16(Ark, 144, 16 * ti, VT, 144, 16 * tj, 64);
            const f32x4 y2 = tile16(Arb, 144, 16 * ti, VpT, 144, 16 * tj, 64);
            f32x4 kv = tile16(KhT, 144, 16 * ti, VT, 144, 16 * tj, 64);
            const f32x4 kv2 = tile16(BhT, 144, 16 * ti, VpT, 144, 16 * tj, 64);
            const int vcol = 16 * tj + fr, slice = vcol >> 5, r2 = vcol & 31, cb = 16 * ti + 4 * fq, mt2 = cb >> 5, q4 = (cb & 31) >> 2, h2 = q4 & 1, rg = q4 >> 1;
            const size_t off2 = ((size_t)((slice * 2 + mt2) * 64 + h2 * 32 + r2) * 16 + rg * 4) * 2;
            w.x = pack2(y[0] + y2[0], y[1] + y2[1]); w.y = pack2(y[2] + y2[2], y[3] + y2[3]); *(u32x2*)(opsB + off2) = w;
            w.x = pack2(kv[0] + kv2[0], kv[1] + kv2[1]); w.y = pack2(kv[2] + kv2[2], kv[3] + kv2[3]); *(u32x2*)(opsB + 8192 + off2) = w;
        }
    }
}

DI void rwkv_scan_block(const P& p, int bh, char* lds, bool dry = false) {
    const int tid = tidx(), lane = tid & 63, w = tid >> 6, slice = w & 1;
    const int h = bh & 7, b = bh >> 3;
    constexpr int NST = 64 * 2, AH = 3;
    auto issue = [&](int j) {
        const int n = j >> 1, k = j & 1;
        const size_t ch = (size_t)((b * 64 + n) * 8 + h) * 16384;
        const unsigned char* s0 = (k == 0 ? p.ws + WS_ROPS + ch + 8192 : p.ws + WS_ROPS + ch) + tid * 16;
        const unsigned char* s1 = (k == 0 ? (const unsigned char*)p.out + ch + 8192 : (const unsigned char*)p.out + ch) + tid * 16;
        char* dst = lds + (j & 3) * 16384 + tid * 16;
        glds16(s0, dst); glds16(s0 + 4096, dst + 4096); glds16(s1, dst + 8192); glds16(s1 + 4096, dst + 12288);
    };
    const unsigned la = (unsigned)(size_t)(lds_u32*)lds + lane * 16;
    f32x16 H[2];
#pragma unroll
    for (int i = 0; i < 2; ++i)
#pragma unroll
        for (int r = 0; r < 16; ++r) H[i][r] = 0.f;
    __syncthreads();
#pragma unroll
    for (int j = 0; j < AH; ++j) issue(j);
#pragma unroll 1
    for (int n = 0; n < 64; ++n) {
        bf16x8 Hb[4];
#pragma unroll
        for (int i = 0; i < 2; ++i) { Hb[i * 2] = pack_step(H[i], 0); Hb[i * 2 + 1] = pack_step(H[i], 1); }
#pragma unroll
        for (int k = 0; k < 2; ++k) {
            const int j = n * 2 + k;
            if (n < 63) GS_WAIT(8); else if (k == 0) GS_WAIT(4); else GS_WAIT(0);
            __builtin_amdgcn_s_barrier();
            if (j + AH < NST) issue(j + AH);
            __builtin_amdgcn_sched_barrier(0);
            const char* sl = lds + (j & 3) * 16384;
            if (w < 2) {
                f32x16 acc[2];
                bf16x8 F[4];
                const unsigned fa = la + (unsigned)((j & 3) * 16384 + 8192);
#define RS_O(i) (unsigned)((((i) & 1) * 4 + ((i) >> 1)) * 1024)
#pragma unroll
                for (int i = 0; i < 4; ++i) fr_rd(F[i], fa + RS_O(i));
#pragma unroll
                for (int mt = 0; mt < 2; ++mt) {
                    const u32x4* up = (const u32x4*)(sl + (slice * 2 + mt) * 2048 + lane * 32);
                    const u32x4 u0 = up[0], u1 = up[1];
#pragma unroll
                    for (int e = 0; e < 4; ++e) {
                        acc[mt][e * 2] = __uint_as_float(u0[e] << 16); acc[mt][e * 2 + 1] = __uint_as_float(u0[e] & 0xffff0000u);
                        acc[mt][8 + e * 2] = __uint_as_float(u1[e] << 16); acc[mt][8 + e * 2 + 1] = __uint_as_float(u1[e] & 0xffff0000u);
                    }
                }
#pragma unroll
                for (int i = 0; i < 8; ++i) {
                    if (i <= 4) fr_wait<3>(F[i & 3]); else if (i == 5) fr_wait<2>(F[i & 3]); else if (i == 6) fr_wait<1>(F[i & 3]); else fr_wait<0>(F[i & 3]);
                    acc[i & 1] = mfma32(F[i & 3], Hb[i >> 1], acc[i & 1]);
                    if (i + 4 < 8) fr_rd(F[i & 3], fa + RS_O(i + 4));
                }
                if (k == 0) { H[0] = acc[0]; H[1] = acc[1]; }
                else {
                    const size_t ch = (size_t)((b * 64 + n) * 8 + h) * 16384;
                    u32x4* Yf = (u32x4*)(dry ? p.ws + WS_DUMMY + 2097152 + (size_t)(bh & 31) * 16384 : p.ws + WS_ROPS + ch) + (size_t)(slice * 128 + lane) * 2;
#pragma unroll
                    for (int mt = 0; mt < 2; ++mt) {
                        u32x4 o0, o1;
#pragma unroll
                        for (int e = 0; e < 4; ++e) { o0[e] = pack2(acc[mt][e * 2], acc[mt][e * 2 + 1]); o1[e] = pack2(acc[mt][8 + e * 2], acc[mt][8 + e * 2 + 1]); }
                        Yf[mt * 128] = o0; Yf[mt * 128 + 1] = o1;
                    }
                }
            }
        }
    }
    __syncthreads();
}

DI void rwkv_post_unit(const P& p, int li, int ch) {
    const int tid = tidx();
    const int h = ch & 7, n = (ch >> 3) & 63, b = ch >> 9;
    const int t0 = b * SEQ + n * 64;
    const int c = tid >> 2, cq = tid & 3;
    const bf16_t* Yf = (const bf16_t*)(p.ws + WS_ROPS + (size_t)ch * 16384);
    const bf16_t* vf = (const bf16_t*)(p.ws + WS_VF) + (size_t)(t0 + c) * 512 + h * 64 + cq * 16;
    const bf16_t* gg = (const bf16_t*)(p.ws + WS_GG) + (size_t)(t0 + c) * 512 + h * 64 + cq * 16;
    const float rk = ((const float*)(p.ws + WS_RK))[(size_t)(t0 + c) * 8 + h];
    const float* lnw = p.in[I_LNW] + li * 512 + h * 64 + cq * 16;
    const float* lnb = p.in[I_LNB] + li * 512 + h * 64 + cq * 16;
    bf16_t* mp = (bf16_t*)p.out + (size_t)(t0 + c) * 1024 + 512 + h * 64 + cq * 16;
    const int mt = c >> 5, q4 = (c & 31) >> 2, hh = q4 & 1, rg = q4 >> 1, reg = rg * 4 + (c & 3), slice = cq >> 1, rb = (cq & 1) * 16;
    float y[16]; float sm = 0.f;
#pragma unroll
    for (int i = 0; i < 16; ++i) { y[i] = bf2f(Yf[(size_t)((slice * 2 + mt) * 64 + hh * 32 + rb + i) * 16 + reg]); sm += y[i]; }
    sm += __shfl_xor(sm, 1); sm += __shfl_xor(sm, 2);
    const float mean = sm * (1.f / 64.f);
    float vs = 0.f;
#pragma unroll
    for (int i = 0; i < 16; ++i) { y[i] -= mean; vs += y[i] * y[i]; }
    vs += __shfl_xor(vs, 1); vs += __shfl_xor(vs, 2);
    const float rs = rsqrtf(vs * (1.f / 64.f) + 64e-5f);
#pragma unroll
    for (int i8 = 0; i8 < 2; ++i8) {
        const u32x4 vw = *(const u32x4*)(vf + i8 * 8), gw = *(const u32x4*)(gg + i8 * 8);
        u32x4 w;
#pragma unroll
        for (int e = 0; e < 4; ++e) {
            const int i = i8 * 8 + e * 2;
            const float v0 = __uint_as_float(vw[e] << 16), v1 = __uint_as_float(vw[e] & 0xffff0000u), g0 = __uint_as_float(gw[e] << 16), g1 = __uint_as_float(gw[e] & 0xffff0000u);
            w[e] = pack2((y[i] * rs * lnw[i] + lnb[i] + rk * v0) * g0, (y[i + 1] * rs * lnw[i + 1] + lnb[i + 1] + rk * v1) * g1);
        }
        *(u32x4*)(mp + i8 * 8) = w;
    }
}


DI void attn_unit(const P& p, int unit, char* lds) {
    const int tid = tidx(), lane = tid & 63, w = tid >> 6, r_ = lane & 31, hl = lane >> 5;
    const int idx = unit & 31, h = (unit >> 5) & 7, g = (unit >> 8) % 3, b = unit / 768;
    const int lg2 = g * 2, dil = 1 << lg2, L = SEQ >> lg2, ntl = L >> 7;
    const int rs = idx / ntl, qt = idx % ntl;
    const int hg = g * 8 + h;
    const bf16_t* QK = (const bf16_t*)(p.ws + WS_QK);
    const bf16_t* VT = (const bf16_t*)(p.ws + WS_VT) + ((size_t)((b * 24 + hg) * dil + rs) * 64) * L;
    const int qi = 32 * w + r_;
    const int q_idx = 128 * qt + qi;
    const size_t qrow = (size_t)(b * SEQ + q_idx * dil + rs);
    const int kbase0 = 128 * qt - 128;
    char* Kt = lds;
    char* Vt = lds + 32768;
    __syncthreads();
#pragma unroll
    for (int i = 0; i < 8; ++i) {
        const int id = tid + i * 256, row = id >> 3, pc = id & 7, c = pc ^ ((row >> 1) & 7);
        int k_idx = kbase0 + row; if (k_idx < 0) k_idx = 0;
        glds16(QK + (size_t)(b * SEQ + k_idx * dil + rs) * 3072 + 1536 + hg * 64 + c * 8, Kt + id * 16);
    }
#pragma unroll
    for (int i = 0; i < 8; ++i) {
        const int id = tid + i * 256, row = id >> 5, pq = id & 31, q = pq ^ (row & 31);
        int k0 = kbase0 + q * 8; if (k0 < 0) k0 = 0;
        glds16(VT + (size_t)row * L + k0, Vt + id * 16);
    }
    bf16x8 qf[4];
#pragma unroll
    for (int ks = 0; ks < 4; ++ks) qf[ks] = *(const bf16x8*)(QK + qrow * 3072 + hg * 64 + 16 * ks + 8 * hl);
    asm volatile("s_waitcnt vmcnt(0)" ::: "memory");
    __syncthreads();
    f32x16 st[5];
    float mx = -1.0e30f;
#pragma unroll
    for (int kbi = 0; kbi < 5; ++kbi) {
        const int krow = 32 * (w + kbi) + r_;
#pragma unroll
        for (int r = 0; r < 16; ++r) st[kbi][r] = 0.f;
#pragma unroll
        for (int ks = 0; ks < 4; ++ks) {
            const bf16x8 kf = *(const bf16x8*)(Kt + krow * 128 + (((2 * ks + hl) ^ ((krow >> 1) & 7)) * 16));
            st[kbi] = mfma32(kf, qf[ks], st[kbi]);
        }
#pragma unroll
        for (int r = 0; r < 16; ++r) {
            const int kj = 32 * (w + kbi) + (r & 3) + 8 * (r >> 2) + 4 * hl;
            const bool valid = (kj >= qi) && (kj <= qi + 128) && (kbase0 + kj >= 0);
            const float sv = valid ? st[kbi][r] * 0.125f : -1.0e30f;
            st[kbi][r] = sv; mx = fmaxf(mx, sv);
        }
    }
    mx = fmaxf(mx, __shfl_xor(mx, 32));
    float l = 0.f;
#pragma unroll
    for (int kbi = 0; kbi < 5; ++kbi)
#pragma unroll
        for (int r = 0; r < 16; ++r) { const float pv = __expf(st[kbi][r] - mx); st[kbi][r] = pv; l += pv; }
    l += __shfl_xor(l, 32);
    f32x16 ot[2];
#pragma unroll
    for (int dt = 0; dt < 2; ++dt)
#pragma unroll
        for (int r = 0; r < 16; ++r) ot[dt][r] = 0.f;
#pragma unroll
    for (int kbi = 0; kbi < 5; ++kbi)
#pragma unroll
        for (int s2 = 0; s2 < 2; ++s2) {
            const bf16x8 pb = pack_step(st[kbi], s2);
            const int q0 = 4 * (w + kbi) + 2 * s2;
#pragma unroll
            for (int dt = 0; dt < 2; ++dt) {
                const int drow = 32 * dt + r_;
                const u32x2 lo = *(const u32x2*)(Vt + drow * 512 + ((q0 ^ (drow & 31)) * 16) + 8 * hl);
                const u32x2 hi = *(const u32x2*)(Vt + drow * 512 + (((q0 + 1) ^ (drow & 31)) * 16) + 8 * hl);
                u32x4 vw; vw.x = lo.x; vw.y = lo.y; vw.z = hi.x; vw.w = hi.y;
                ot[dt] = mfma32(__builtin_bit_cast(bf16x8, vw), pb, ot[dt]);
            }
        }
    const float inv = 1.f / l;
    bf16_t* og = (bf16_t*)(p.ws + WS_OG) + ((size_t)g * T + qrow) * 512 + h * 64;
#pragma unroll
    for (int dt = 0; dt < 2; ++dt)
#pragma unroll
        for (int rg = 0; rg < 4; ++rg) {
            u32x2 wv; wv.x = pack2(ot[dt][rg * 4] * inv, ot[dt][rg * 4 + 1] * inv); wv.y = pack2(ot[dt][rg * 4 + 2] * inv, ot[dt][rg * 4 + 3] * inv);
            *(u32x2*)(og + 32 * dt + 8 * rg + 4 * hl) = wv;
        }
    if (hl == 0) ((float*)(p.ws + WS_LSE))[((size_t)g * T + qrow) * 8 + h] = mx + __logf(l);
}
DI void phase_attn_merge(const P& p) {
    const bf16_t* og = (const bf16_t*)(p.ws + WS_OG);
    const float* lse = (const float*)(p.ws + WS_LSE);
    bf16_t* o = (bf16_t*)p.out;
    for (int i = bidx() * 256 + tidx(); i < T * 64; i += gridDim.x * 256) {
        const int t = i >> 6, c8 = i & 63, h = c8 >> 3;
        const float l0 = lse[(size_t)t * 8 + h], l1 = lse[((size_t)T + t) * 8 + h], l2 = lse[((size_t)2 * T + t) * 8 + h];
        const float m = fmaxf(l0, fmaxf(l1, l2));
        float w0 = __expf(l0 - m), w1 = __expf(l1 - m), w2 = __expf(l2 - m);
        const float inv = 1.f / (w0 + w1 + w2); w0 *= inv; w1 *= inv; w2 *= inv;
        const u32x4 a = *(const u32x4*)(og + (size_t)t * 512 + c8 * 8), bq = *(const u32x4*)(og + ((size_t)T + t) * 512 + c8 * 8), cq = *(const u32x4*)(og + ((size_t)2 * T + t) * 512 + c8 * 8);
        u32x4 r;
#pragma unroll
        for (int e = 0; e < 4; ++e) {
            const float x0 = w0 * __uint_as_float(a[e] << 16) + w1 * __uint_as_float(bq[e] << 16) + w2 * __uint_as_float(cq[e] << 16);
            const float x1 = w0 * __uint_as_float(a[e] & 0xffff0000u) + w1 * __uint_as_float(bq[e] & 0xffff0000u) + w2 * __uint_as_float(cq[e] & 0xffff0000u);
            r[e] = pack2(x0, x1);
        }
        *(u32x4*)(o + (size_t)t * 512 + c8 * 8) = r;
    }
}


#define XB_TMO      128
#define XB_XCNT(j)  (256  + 64 * (j))
#define XB_XSUB(j)  (1280 + 64 * (j))
#define XB_XGEN(j)  (2304 + 64 * (j))
#define XB_TOP      3328
#define XB_TOPGEN   3392
#define XCD_BAR_WORDS 3456
#define XB_SPIN_CAP (1u << 22)
#define LAS __attribute__((address_space(3)))
DI unsigned xb_ld(unsigned* p)              { return __hip_atomic_load(p, __ATOMIC_RELAXED, __HIP_MEMORY_SCOPE_AGENT); }
DI unsigned xb_add(unsigned* p, unsigned v) { return __hip_atomic_fetch_add(p, v, __ATOMIC_RELAXED, __HIP_MEMORY_SCOPE_AGENT); }
DI unsigned xb_xcc_id() { return (unsigned)__builtin_amdgcn_s_getreg((3 << 11) | 20) & 0xFu; }
#define XB_SPIN(cond, bar) do { unsigned _sp = 0; while (cond) { if (_sp < 32u) __builtin_amdgcn_s_sleep(2); else __builtin_amdgcn_s_sleep(24); \
    if ((++_sp & 255u) == 0u) { if (xb_ld(&(bar)[XB_TMO])) break; if (_sp > XB_SPIN_CAP) { atomicAdd(&(bar)[XB_TMO], 1u); break; } } } } while (0)
struct XcdBarrier { unsigned* bar; unsigned x; volatile LAS unsigned* st; };
DI XcdBarrier xcd_barrier_post(unsigned* bar, volatile LAS unsigned* st) {
    XcdBarrier b; b.bar = bar; b.x = xb_xcc_id(); b.st = st;
    if (threadIdx.x == 0) (void)xb_add(&bar[XB_XCNT(b.x)], 1u);
    return b;
}
DI void xcd_barrier_complete(unsigned* bar, unsigned x, unsigned& nloc, unsigned& nx) {
    const unsigned G = gridDim.x * gridDim.y * gridDim.z;
    unsigned sum, cnt, mine, sp = 0u;
    for (;;) {
        sum = 0u; cnt = 0u; mine = 0u;
#pragma unroll
        for (unsigned j = 0; j < 16; ++j) { const unsigned c = xb_ld(&bar[XB_XCNT(j)]); sum += c; cnt += (c > 0u) ? 1u : 0u; mine = (j == x) ? c : mine; }
        if (sum == G) break;
        __builtin_amdgcn_s_sleep(1);
        if ((++sp & 255u) == 0u) { if (xb_ld(&bar[XB_TMO])) break; if (sp > XB_SPIN_CAP) { atomicAdd(&bar[XB_TMO], 1u); break; } }
    }
    nloc = mine > 0u ? mine : 1u; nx = cnt > 0u ? cnt : 1u;
}
DI void xcd_barrier(const XcdBarrier& b) {
    asm volatile("s_waitcnt vmcnt(0)" ::: "memory");
    __syncthreads();
    if (threadIdx.x == 0) {
        unsigned* bar = b.bar; unsigned bx = b.x;
        asm volatile("" : "+s"(bar), "+s"(bx));
        __builtin_amdgcn_s_waitcnt(0);
        unsigned nloc = b.st[0], nx = b.st[1];
        if (nloc == 0u) { xcd_barrier_complete(bar, bx, nloc, nx); b.st[0] = nloc; b.st[1] = nx; }
        const unsigned old = xb_add(&bar[XB_XSUB(bx)], 1u);
        const unsigned gen = old / nloc;
        if (old + 1u == (gen + 1u) * nloc) {
            __builtin_amdgcn_fence(__ATOMIC_RELEASE, "agent");
            asm volatile("s_waitcnt vmcnt(0)" ::: "memory");
            const unsigned og = xb_add(&bar[XB_TOP], 1u);
            const unsigned tg = og / nx;
            if (og + 1u == (tg + 1u) * nx) xb_add(&bar[XB_TOPGEN], 1u);
            else XB_SPIN(xb_ld(&bar[XB_TOPGEN]) == tg, bar);
            __builtin_amdgcn_fence(__ATOMIC_ACQUIRE, "agent");
            xb_add(&bar[XB_XGEN(bx)], 1u);
            asm volatile("s_waitcnt vmcnt(0)" ::: "memory");
        } else {
            XB_SPIN(xb_ld(&bar[XB_XGEN(bx)]) == gen, bar);
            __builtin_amdgcn_fence(__ATOMIC_ACQUIRE, "agent");
            asm volatile("s_waitcnt vmcnt(0)" ::: "memory");
        }
    }
    __syncthreads();
}

constexpr int LDS_BYTES = RP_END;
static_assert(GP_END + 6144 <= LDS_BYTES, "LDS");
__global__ void __launch_bounds__(256, 2) __attribute__((amdgpu_waves_per_eu(2, 2))) mega(P p) {
    cg::grid_group grid = cg::this_grid();
    extern __shared__ __attribute__((aligned(16))) char lds[];
    if (threadIdx.x < 4) ((volatile LAS unsigned*)(lds + LDS_BYTES))[threadIdx.x] = 0u;
    __syncthreads();
    const XcdBarrier xb = xcd_barrier_post((unsigned*)(p.ws + WS_CTL + CTL_BAR), (volatile LAS unsigned*)(lds + LDS_BYTES));
#define GSYNC() xcd_barrier(xb)
    const bf16_t* HN = (const bf16_t*)p.out;
    const bf16_t* XB = (const bf16_t*)(p.ws + WS_XB);
    const bf16_t* Win = (const bf16_t*)(p.ws + WS_W + W_IN);
    const bf16_t* Wout = (const bf16_t*)(p.ws + WS_W + W_OUT);
    {
        const unsigned hw = (unsigned)__builtin_amdgcn_s_getreg((31 << 11) | 4);
        const unsigned key = 1u + ((xb.x << 16) | (hw & 0xFF00u));
        if (threadIdx.x == 0) ((unsigned*)(p.ws + WS_CTL + CTL_CUTAB))[bidx()] = key;
    }
    phase_rope(p);
    phase_convert_io(p, 0, lds);
    phase_prep<0>(p, p.in[I_EVNORM], 0);
    if (p.ws == nullptr) grid.sync();
    GSYNC();
    volatile LAS unsigned* qword = (volatile LAS unsigned*)(lds + LDS_BYTES + 8);
    int idle2, idle3, rank3, nact3;
    {
        const unsigned* cut = (const unsigned*)(p.ws + WS_CTL + CTL_CUTAB);
        unsigned* keys = (unsigned*)lds; unsigned* cntw = keys + 2048;
        const int G = (int)gridDim.x < 2048 ? (int)gridDim.x : 2048;
        __syncthreads();
        for (int j = threadIdx.x; j < G; j += 256) keys[j] = cut[j];
        if (threadIdx.x < 4) cntw[threadIdx.x] = 0u;
        __syncthreads();
        const unsigned mine = keys[bidx() < G ? bidx() : 0];
        for (int j = threadIdx.x; j < G; j += 256) {
            bool sh16 = false, sh32 = false;
            for (int k = 0; k < 32 && k < G; ++k) { const bool eq = keys[k] == keys[j] && k != j; if (eq) { sh32 = true; if (k < 16) sh16 = true; } }
            const bool act3 = j >= 32 && !sh32;
            if (act3) { atomicAdd(&cntw[0], 1u); if (j < bidx()) atomicAdd(&cntw[1], 1u); }
            if (j == bidx()) { cntw[2] = (j >= 16 && sh16) ? 1u : 0u; cntw[3] = (j >= 32 && sh32) ? 1u : 0u; }
        }
        (void)mine;
        __syncthreads();
        nact3 = __builtin_amdgcn_readfirstlane((int)cntw[0]); rank3 = __builtin_amdgcn_readfirstlane((int)cntw[1]);
        idle2 = __builtin_amdgcn_readfirstlane((int)cntw[2]); idle3 = __builtin_amdgcn_readfirstlane((int)cntw[3]);
        if (nact3 < 1) { nact3 = 1; }
        __syncthreads();
    }
    for (int layer = 0; layer < 4; ++layer) {
        const int li = layer >> 1;
        if ((layer & 1) == 0) {
            phase_gemm<EPI_EVEN_IN>(p, XB, 1024, Win, 1024, EVPAD / 128, lds);
            GSYNC();
            for (int u = bidx(); u < 1024; u += gridDim.x) gdn_prep_unit(p, li, u, lds);
            GSYNC();
            if (bidx() < 16) gdn_scan_block(p, bidx(), lds);
            if (!idle2) {
                unsigned* qctr = (unsigned*)(p.ws + WS_CTL + CTL_QUEUE) + li * 64;
                for (;;) {
                    __syncthreads();
                    if (threadIdx.x == 0) *qword = atomicAdd(qctr, 1u);
                    __syncthreads();
                    const unsigned u = *qword;
                    if (u >= 2048u) break;
                    rwkv_prep_unit(p, li, (int)u, lds);
                }
            }
            GSYNC();
            if (bidx() < 32) rwkv_scan_block(p, bidx(), lds);
            else if (!idle3) {
                for (int u = rank3; u < 1024; u += nact3) gdn_post_unit(p, li, u);
                phase_convert_moe(p, layer, lds, rank3, nact3);
            }
            GSYNC();
            for (int u = bidx(); u < 2048; u += gridDim.x) rwkv_post_unit(p, li, u);
            GSYNC();
            phase_gemm<EPI_RESID>(p, (const bf16_t*)(p.ws + WS_PROJ), EVLD, Wout, 1024, 8, lds, false, HN, 1024, 512);
        } else {
            phase_gemm<EPI_ODD_IN>(p, XB, 1024, Win, 1024, ODC / 128, lds);
            GSYNC();
            for (int u = bidx(); u < 3072; u += gridDim.x) attn_unit(p, u, lds);
            GSYNC();
            phase_attn_merge(p);
            GSYNC();
            phase_gemm<EPI_RESID>(p, HN, 512, Wout, 512, 8, lds);
        }
        GSYNC();
        phase_router(p, p.in[I_FFNNORM] + layer * 1024, layer, lds);
        GSYNC();
        phase_moe_up(p, layer, lds);
        GSYNC();
        phase_moe_down(p, layer, lds);
        GSYNC();
        if (layer < 3) {
            phase_convert_io(p, layer + 1, lds);
            if ((layer + 1) & 1) phase_convert_moe(p, layer + 1, lds, bidx(), gridDim.x);
            phase_prep<1>(p, ((layer + 1) & 1) ? p.in[I_ODNORM] + ((layer + 1) >> 1) * 1024 : p.in[I_EVNORM] + ((layer + 1) >> 1) * 1024, layer + 1);
            GSYNC();
        }
    }
    phase_prep<3>(p, p.in[I_FINAL], 0);
}

extern "C" void kernel_launch(void* const* d_in, const int* in_sizes, int n_in, void* d_out, int out_size, void* d_ws, size_t ws_size, hipStream_t stream) {
    if (n_in != 34 || out_size != T * D || ws_size < WS_NEED) { fprintf(stderr, "kernel_launch: unexpected shapes (n_in %d out %d ws %zu need %zu)\n", n_in, out_size, ws_size, (size_t)WS_NEED); return; }
    static int grid_blocks = 0;
    if (!grid_blocks) {
        int dev = 0, cus = 0, per_cu = 0;
        (void)hipGetDevice(&dev);
        (void)hipDeviceGetAttribute(&cus, hipDeviceAttributeMultiprocessorCount, dev);
        (void)hipFuncSetAttribute((const void*)mega, hipFuncAttributeMaxDynamicSharedMemorySize, LDS_BYTES + 16);
        (void)hipOccupancyMaxActiveBlocksPerMultiprocessor(&per_cu, mega, 256, LDS_BYTES + 16);
        if (per_cu < 1) per_cu = 1;
        if (per_cu > 2) per_cu = 2;
        grid_blocks = cus * per_cu;
    }
    P p{};
    for (int i = 0; i < 34; ++i) p.in[i] = (const float*)d_in[i];
    p.out = (float*)d_out; p.ws = (unsigned char*)d_ws;
    (void)hipMemsetAsync((char*)d_ws + WS_CTL, 0, 65536, stream);
    void* args[] = {&p};
    hipError_t e = hipLaunchCooperativeKernel((void*)mega, dim3(grid_blocks), dim3(256), args, LDS_BYTES + 16, stream);
    if (e != hipSuccess) fprintf(stderr, "cooperative launch failed: %s (grid %d)\n", hipGetErrorString(e), grid_blocks);
}
```

```cpp
#include <hip/hip_runtime.h>
#include <cstdio>
#include <cstdint>
#include <cmath>
#include <hip/hip_cooperative_groups.h>
namespace cg = cooperative_groups;

typedef unsigned short bf16_t;
typedef short bf16x8 __attribute__((ext_vector_type(8)));
typedef float f32x4 __attribute__((ext_vector_type(4)));
typedef unsigned u32x4 __attribute__((ext_vector_type(4)));
typedef unsigned u32x2 __attribute__((ext_vector_type(2)));
#define DI __device__ __forceinline__

constexpr int T = 16384, SEQ = 4096, BATCH = 4, D = 1024;
constexpr int EVC = 3784, EVLD = 3784, EVPAD = 3840;
constexpr int ODC = 4608;
constexpr int RW0 = 2056;
constexpr int C_R = 2056, C_K = 2568, C_V = 3080, C_HW = 3592, C_HA = 3624, C_HG = 3656, C_HV = 3752;
constexpr int NEXP = 16, FF = 256;
constexpr int HROWS = 34816;

constexpr size_t WS_CTL = 0;
constexpr size_t CTL_EGL = 4096;
constexpr size_t CTL_CUTAB = 8192;
constexpr size_t CTL_QUEUE = 49152;
constexpr size_t CTL_CNT = 32768;
constexpr size_t CTL_BAR = 16384;
constexpr size_t WS_LIST = 65536;
constexpr size_t WS_GATE = WS_LIST + 16 * 16384 * 4;
constexpr size_t WS_RK = WS_GATE + 16 * 16384 * 4;
constexpr size_t WS_SSQ = WS_RK + (size_t)T * 8 * 4;
constexpr size_t WS_ROPE = WS_SSQ + (size_t)16 * T * 4;
constexpr size_t WS_W = WS_ROPE + (size_t)T * 32 * 8;
constexpr size_t W_IN = 0;
constexpr size_t W_OUT = (size_t)4608 * 1024 * 2;
constexpr size_t W_13 = W_OUT + (size_t)1024 * 1024 * 2;
constexpr size_t W_2 = W_13 + (size_t)16 * 512 * 1024 * 2;
constexpr size_t W_LW = W_2 + (size_t)16 * 1024 * 256 * 2;
constexpr size_t W_BYTES = W_LW + (size_t)512 * 192 * 2;
constexpr size_t WS_XB = WS_W + W_BYTES;
constexpr size_t WS_HN = WS_XB;
constexpr size_t WS_VF = WS_HN + (size_t)T * 1024 * 2;
constexpr size_t WS_R2 = WS_VF + (size_t)T * 512 * 2;
constexpr size_t WS_PROJ = WS_R2;
constexpr size_t WS_GOPS = WS_R2 + (size_t)T * EVLD * 2;
constexpr size_t GOPS_CH = 73728, GO_UF = 0, GO_WF = 16384, GO_QF = 32768, GO_AF = 49152, GO_KF = 57344;
constexpr size_t WS_ROPS = WS_GOPS + 1024 * GOPS_CH;
constexpr size_t WS_QK = WS_R2;
constexpr size_t WS_VT = WS_QK + (size_t)T * 3072 * 2;
constexpr size_t WS_OG = WS_VT + (size_t)T * 1536 * 2;
constexpr size_t WS_LSE = WS_OG + (size_t)3 * T * 512 * 2;
constexpr size_t WS_END3 = WS_LSE + (size_t)3 * T * 8 * 4;
constexpr size_t WS_YS = WS_R2;
constexpr size_t WS_H = WS_YS + (size_t)2 * T * 1024 * 2;
constexpr size_t WS_GG = WS_ROPS + (size_t)2048 * 16384;
constexpr size_t WS_END0 = WS_GG + (size_t)T * 512 * 2;
constexpr size_t WS_END1 = WS_H + (size_t)HROWS * 256 * 2;
constexpr size_t WS_END2 = WS_R2 + (size_t)T * 4608 * 2;
static_assert(WS_END3 <= WS_END0, "odd-layer regions exceed even-layer footprint");
constexpr size_t WS_END = WS_END0 > WS_END1 ? (WS_END0 > WS_END2 ? WS_END0 : WS_END2) : (WS_END1 > WS_END2 ? WS_END1 : WS_END2);

constexpr size_t WS_RSL = WS_END;
constexpr size_t WS_RSIN = WS_RSL + 16 * 16384 * 4;
constexpr size_t WS_NEED = WS_RSIN + (size_t)T * 4;
constexpr size_t WS_DUMMY = WS_END0;
struct P {
    const float* in[34];
    float* out;
    unsigned char* ws;
};
enum { I_X = 0, I_POS, I_EVNORM, I_EVWIN, I_VRESDOWN, I_EVWOUT, I_CONVW, I_ALOG, I_DTB, I_GDNNORM, I_MU, I_W0, I_W2, I_A0, I_A2, I_G2,
       I_KK, I_KA, I_RK, I_LNW, I_LNB, I_VRESMU, I_V0, I_V2, I_ODNORM, I_ODWIN, I_ODWOUT, I_FFNNORM, I_WGROUP, I_WEXPERT, I_W1, I_W3, I_MW2, I_FINAL };

DI int tidx() { int t = threadIdx.x; asm volatile("" : "+v"(t)); return t; }
DI int bidx() { int b = blockIdx.x; asm volatile("" : "+s"(b)); return b; }
typedef __bf16 bf2_t __attribute__((ext_vector_type(2)));
typedef float f2_t __attribute__((ext_vector_type(2)));
DI bf16_t f2bf(float x) { return __builtin_bit_cast(bf16_t, (__bf16)x); }
DI float bf2f(bf16_t h) { return __uint_as_float(((unsigned)h) << 16); }
DI unsigned pack2(float lo, float hi) { const f2_t v = {lo, hi}; return __builtin_bit_cast(unsigned, __builtin_convertvector(v, bf2_t)); }
DI float wave_sum(float v) {
#pragma unroll
    for (int o = 32; o > 0; o >>= 1) v += __shfl_xor(v, o);
    return v;
}
DI float wave_max(float v) {
#pragma unroll
    for (int o = 32; o > 0; o >>= 1) v = fmaxf(v, __shfl_xor(v, o));
    return v;
}
DI float sigmoidf_(float x) { return __builtin_amdgcn_rcpf(1.f + __expf(-x)); }
DI float siluf_(float x) { return x * __builtin_amdgcn_rcpf(1.f + __expf(-x)); }
DI float softplusf_(float x) { return fmaxf(x, 0.f) + __logf(1.f + __expf(-fabsf(x))); }

struct ConvJob { const float* src; bf16_t* dst; int K, N, ldd; int mode; const float* ks = nullptr; };
DI int rowmap(int mode, int n) { return mode == 0 ? n : ((n >> 4) * 32 + (n & 15) + (mode == 2 ? 16 : 0)); }
DI void conv_tile(const ConvJob& j, int tile, float* lds  ) {
    const int ntn = (j.N + 255) / 256;
    const int tk = tile / ntn, tn = tile % ntn;
    const int tid = tidx();
    __syncthreads();
    float4 v[16];
#pragma unroll
    for (int i = 0; i < 16; ++i) {
        const int e = tid + i * 256, k = e >> 6, n4 = (e & 63) * 4;
        const int gk = tk * 64 + k, gn = tn * 256 + n4;
        v[i] = make_float4(0.f, 0.f, 0.f, 0.f);
        if (gn < j.N) v[i] = *(const float4*)(j.src + (size_t)gk * j.N + gn);
    }
    if (j.ks) {
        float sc[16];
#pragma unroll
        for (int i = 0; i < 16; ++i) sc[i] = j.ks[tk * 64 + (tid >> 6) + 4 * i];
#pragma unroll
        for (int i = 0; i < 16; ++i) { v[i].x *= sc[i]; v[i].y *= sc[i]; v[i].z *= sc[i]; v[i].w *= sc[i]; }
    }
#pragma unroll
    for (int i = 0; i < 16; ++i) { const int e = tid + i * 256, k = e >> 6, n4 = (e & 63) * 4; *(float4*)(lds + k * 260 + n4) = v[i]; }
    __syncthreads();
#pragma unroll
    for (int i = 0; i < 8; ++i) {
        const int n = tid, k8 = i * 8;
        const int gn = tn * 256 + n;
        if (gn < j.N) {
            u32x4 w;
            w.x = pack2(lds[(k8 + 0) * 260 + n], lds[(k8 + 1) * 260 + n]); w.y = pack2(lds[(k8 + 2) * 260 + n], lds[(k8 + 3) * 260 + n]);
            w.z = pack2(lds[(k8 + 4) * 260 + n], lds[(k8 + 5) * 260 + n]); w.w = pack2(lds[(k8 + 6) * 260 + n], lds[(k8 + 7) * 260 + n]);
            *(u32x4*)(j.dst + (size_t)rowmap(j.mode, gn) * j.ldd + tk * 64 + k8) = w;
        }
    }
}
DI void phase_convert_io(const P& p, int layer, char* ldsc) {
    float* lds = (float*)ldsc;
    unsigned char* W = p.ws + WS_W;
    const int li = layer >> 1;
    if ((layer & 1) == 0) {
        const float* ng = p.in[I_EVNORM] + li * 1024;
        const ConvJob j0{p.in[I_EVWIN] + (size_t)li * 1024 * 3752, (bf16_t*)(W + W_IN), 1024, 3752, 1024, 0, ng};
        for (int t = bidx(); t < 16 * 15; t += gridDim.x) conv_tile(j0, t, lds);
        if (li == 1) {
            const ConvJob j1{p.in[I_VRESDOWN], (bf16_t*)(W + W_IN) + (size_t)3752 * 1024, 1024, 32, 1024, 0, ng};
            for (int t = bidx(); t < 16; t += gridDim.x) conv_tile(j1, t, lds);
        }
        const ConvJob j2{p.in[I_EVWOUT] + (size_t)li * 1024 * 1024, (bf16_t*)(W + W_OUT), 1024, 1024, 1024, 0};
        for (int t = bidx(); t < 16 * 4; t += gridDim.x) conv_tile(j2, t, lds);
        {
            bf16_t* LW = (bf16_t*)(W + W_LW);
            for (int i = bidx() * 256 + tidx(); i < 512 * 192; i += gridDim.x * 256) {
                const int ch = i / 192, j = i % 192;
                float v;
                if (j < 32) v = p.in[I_W2][((size_t)li * 32 + j) * 512 + ch];
                else if (j < 64) v = p.in[I_A2][((size_t)li * 32 + j - 32) * 512 + ch];
                else if (j < 160) v = p.in[I_G2][((size_t)li * 96 + j - 64) * 512 + ch];
                else v = (li == 1) ? p.in[I_V2][(size_t)(j - 160) * 512 + ch] : 0.f;
                LW[i] = f2bf(v);
            }
        }
        const int r0 = (li == 1) ? 3784 : 3752;
        bf16_t* z = (bf16_t*)(W + W_IN) + (size_t)r0 * 1024;
        const size_t n = (size_t)(EVPAD - r0) * 1024;
        for (size_t i = (size_t)bidx() * 256 + tidx(); i < n; i += (size_t)gridDim.x * 256) z[i] = 0;
    } else {
        const ConvJob j0{p.in[I_ODWIN] + (size_t)li * 1024 * 4608, (bf16_t*)(W + W_IN), 1024, 4608, 1024, 0, p.in[I_ODNORM] + li * 1024};
        for (int t = bidx(); t < 16 * 18; t += gridDim.x) conv_tile(j0, t, lds);
        const ConvJob j2{p.in[I_ODWOUT] + (size_t)li * 512 * 1024, (bf16_t*)(W + W_OUT), 512, 1024, 512, 0};
        for (int t = bidx(); t < 8 * 4; t += gridDim.x) conv_tile(j2, t, lds);
    }
}
DI unsigned char* moe_w(const P& p, int layer) { return (layer & 1) ? (unsigned char*)p.out + ((size_t)32 << 20) - W_13 : p.ws + WS_W; }
DI void convert_moe_tile(const P& p, int layer, char* ldsc, int t);
DI void phase_convert_moe(const P& p, int layer, char* ldsc, int b0, int bs) {
    for (int t = b0; t < 16 * 3 * 16; t += bs) convert_moe_tile(p, layer, ldsc, t);
}
DI void convert_moe_tile(const P& p, int layer, char* ldsc, int t) {
    float* lds = (float*)ldsc;
    unsigned char* W = moe_w(p, layer);
    {
        const int e = t / 48, r = t % 48, which = r / 16, tile = r % 16;
        ConvJob j;
        const float* fg = p.in[I_FFNNORM] + layer * 1024;
        if (which == 0) j = ConvJob{p.in[I_W1] + ((size_t)layer * 16 + e) * 1024 * 256, (bf16_t*)(W + W_13) + (size_t)e * 512 * 1024, 1024, 256, 1024, 1, fg};
        else if (which == 1) j = ConvJob{p.in[I_W3] + ((size_t)layer * 16 + e) * 1024 * 256, (bf16_t*)(W + W_13) + (size_t)e * 512 * 1024, 1024, 256, 1024, 2, fg};
        else j = ConvJob{p.in[I_MW2] + ((size_t)layer * 16 + e) * 256 * 1024, (bf16_t*)(W + W_2) + (size_t)e * 1024 * 256, 256, 1024, 256, 0};
        conv_tile(j, tile, lds);
    }
}

DI void phase_rope(const P& p) {
    float2* tab = (float2*)(p.ws + WS_ROPE);
    const int* pos = (const int*)p.in[I_POS];
    for (int i = bidx() * 256 + tidx(); i < T * 32; i += gridDim.x * 256) {
        const int t = i >> 5, f = i & 31;
        const float inv = powf(10000.0f, -(float)f * (2.0f / 64.0f));
        const float ang = (float)pos[t] * inv;
        float s, c; sincosf(ang, &s, &c);
        tab[i] = make_float2(c, s);
    }
}

template <int MODE>
DI void phase_prep(const P& p, const float* gain, int layer) {
    const int lane = tidx() & 63, wid = tidx() >> 6;
    const int nw = gridDim.x * 4;
    bf16_t* hn = (bf16_t*)p.out;
    bf16_t* xb = (bf16_t*)(p.ws + WS_XB);
    const bf16_t* y0 = (const bf16_t*)(p.ws + WS_YS);
    const bf16_t* y1 = y0 + (size_t)T * 1024;
    float4 gq[4];
#pragma unroll
    for (int i = 0; i < 4; ++i) gq[i] = *(const float4*)(gain + i * 256 + lane * 4);
    for (int t = bidx() * 4 + wid; t < T; t += nw) {
        float4 v[4];
        float ss = 0.f;
#pragma unroll
        for (int i = 0; i < 4; ++i) {
            const size_t off = (size_t)t * 1024 + i * 256 + lane * 4;
            if (MODE == 0) v[i] = *(const float4*)(p.in[I_X] + off);
            else { const u32x2 xx = *(const u32x2*)(xb + off); v[i].x = __uint_as_float(xx.x << 16); v[i].y = __uint_as_float(xx.x & 0xffff0000u); v[i].z = __uint_as_float(xx.y << 16); v[i].w = __uint_as_float(xx.y & 0xffff0000u); }
            if (MODE == 1 || MODE == 3) {
                const u32x2 a = *(const u32x2*)(y0 + off), b = *(const u32x2*)(y1 + off);
                v[i].x += __uint_as_float(a.x << 16) + __uint_as_float(b.x << 16); v[i].y += __uint_as_float(a.x & 0xffff0000u) + __uint_as_float(b.x & 0xffff0000u);
                v[i].z += __uint_as_float(a.y << 16) + __uint_as_float(b.y << 16); v[i].w += __uint_as_float(a.y & 0xffff0000u) + __uint_as_float(b.y & 0xffff0000u);
            }
            ss += v[i].x * v[i].x + v[i].y * v[i].y + v[i].z * v[i].z + v[i].w * v[i].w;
        }
        ss = wave_sum(ss);
        const float rstd = rsqrtf(ss * (1.0f / 1024.0f) + 1e-6f);
        if ((MODE == 0 || MODE == 1) && lane == 0) ((float*)(p.ws + WS_RSIN))[t] = rstd;
        float lg[20];
        if (MODE == 2) {
#pragma unroll
            for (int q = 0; q < 20; ++q) lg[q] = 0.f;
        }
#pragma unroll
        for (int i = 0; i < 4; ++i) {
            const int col = i * 256 + lane * 4;
            const size_t off = (size_t)t * 1024 + col;
            const float4 g = gq[i];
            float4 h; h.x = v[i].x * rstd * g.x; h.y = v[i].y * rstd * g.y; h.z = v[i].z * rstd * g.z; h.w = v[i].w * rstd * g.w;
            bf16_t* hd = hn + off;
            if (MODE == 0 || MODE == 1) { u32x2 w; w.x = pack2(v[i].x, v[i].y); w.y = pack2(v[i].z, v[i].w); *(u32x2*)(xb + off) = w; }
            if (MODE == 3) *(float4*)(p.out + off) = h;
            else if (MODE == 2) { u32x2 w; w.x = pack2(h.x, h.y); w.y = pack2(h.z, h.w); *(u32x2*)hd = w; }
            if (MODE == 2) {
                const float hh[4] = {h.x, h.y, h.z, h.w};
                const float* wg = p.in[I_WGROUP] + (size_t)layer * 1024 * 4;
                const float* we = p.in[I_WEXPERT] + (size_t)layer * 4 * 1024 * 4;
#pragma unroll
                for (int e = 0; e < 4; ++e) {
                    const float4 a = *(const float4*)(wg + (size_t)(col + e) * 4);
                    lg[0] += hh[e] * a.x; lg[1] += hh[e] * a.y; lg[2] += hh[e] * a.z; lg[3] += hh[e] * a.w;
#pragma unroll
                    for (int g2 = 0; g2 < 4; ++g2) {
                        const float4 b = *(const float4*)(we + ((size_t)g2 * 1024 + col + e) * 4);
                        lg[4 + g2 * 4 + 0] += hh[e] * b.x; lg[4 + g2 * 4 + 1] += hh[e] * b.y; lg[4 + g2 * 4 + 2] += hh[e] * b.z; lg[4 + g2 * 4 + 3] += hh[e] * b.w;
                    }
                }
            }
        }
        if (MODE == 2) {
#pragma unroll
            for (int q = 0; q < 20; ++q) lg[q] = wave_sum(lg[q]);
            if (lane == 0) {
                int gs = 0; float gm = lg[0];
#pragma unroll
                for (int g2 = 1; g2 < 4; ++g2) if (lg[g2] > gm) { gm = lg[g2]; gs = g2; }
                float den = 0.f;
#pragma unroll
                for (int g2 = 0; g2 < 4; ++g2) den += __expf(lg[g2] - gm);
                const float pg = 1.f / den;
                float el[4];
#pragma unroll
                for (int e = 0; e < 4; ++e) el[e] = gs == 0 ? lg[4 + e] : gs == 1 ? lg[8 + e] : gs == 2 ? lg[12 + e] : lg[16 + e];
                int i1 = 0; float v1 = el[0];
#pragma unroll
                for (int e = 1; e < 4; ++e) if (el[e] > v1) { v1 = el[e]; i1 = e; }
                int i2 = 0; float v2 = -3.4e38f;
#pragma unroll
                for (int e = 0; e < 4; ++e) if (e != i1 && el[e] > v2) { v2 = el[e]; i2 = e; }
                const float e2 = __expf(v2 - v1);
                const float g1 = pg / (1.f + e2), g2v = pg * e2 / (1.f + e2);
                unsigned* cnt = (unsigned*)(p.ws + WS_CTL + CTL_CNT) + layer * 16 * 64;
                int* list = (int*)(p.ws + WS_LIST);
                float* gl = (float*)(p.ws + WS_GATE);
                const int ea = gs * 4 + i1, eb = gs * 4 + i2;
                const unsigned ra = atomicAdd(&cnt[ea * 64], 1u);
                list[ea * 16384 + ra] = t * 2; gl[ea * 16384 + ra] = g1;
                const unsigned rb = atomicAdd(&cnt[eb * 64], 1u);
                list[eb * 16384 + rb] = t * 2 + 1; gl[eb * 16384 + rb] = g2v;
            }
        }
    }
}


typedef __attribute__((address_space(3))) unsigned lds_u32;
DI void g_dma(unsigned m0v, unsigned voff, const char* sbase) {
    asm volatile("s_mov_b32 m0, %0\n\ts_nop 0\n\tglobal_load_lds_dwordx4 %1, %2" :: "s"(m0v), "v"(voff), "s"(sbase) : "memory", "m0");
}
DI void phase_router(const P& p, const float* gain, int layer, char* ldsc) {
    const int tid = tidx(), lane = tid & 63, wid = tid >> 6;
    const bf16_t* xb = (const bf16_t*)(p.ws + WS_XB);
    const float* wg = p.in[I_WGROUP] + (size_t)layer * 1024 * 4;
    const float* we = p.in[I_WEXPERT] + (size_t)layer * 4 * 1024 * 4;
    unsigned* cnt = (unsigned*)(p.ws + WS_CTL + CTL_CNT) + layer * 16 * 64;
    int* list = (int*)(p.ws + WS_LIST);
    float* gl = (float*)(p.ws + WS_GATE);
    float* rsl = (float*)(p.ws + WS_RSL);
    f32x4* WS = (f32x4*)ldsc;
    unsigned* lcnt = (unsigned*)(ldsc + 40960); unsigned* lbase = lcnt + 16; int* e_ent = (int*)(lcnt + 32); unsigned* r_ent = (unsigned*)(e_ent + 32); int* t_ent = (int*)(r_ent + 32); float* g_ent = (float*)(t_ent + 32); float* rs_ent = g_ent + 32;
    const unsigned wsb = (unsigned)__builtin_amdgcn_readfirstlane((int)((unsigned)(size_t)(lds_u32*)ldsc + wid * 1024));
    auto stage = [&](int i, int buf) {
        const unsigned voff = (unsigned)(i * 256 + lane * 4 + wid) * 16u;
#pragma unroll
        for (int r = 0; r < 5; ++r) g_dma(wsb + (unsigned)(buf * 1280 + r * 256) * 16u, voff, (const char*)(r == 0 ? wg : we + (size_t)(r - 1) * 4096));
    };
    u32x2 xq[4];
#pragma unroll
    for (int q = 0; q < 4; ++q) xq[q] = *(const u32x2*)(xb + (size_t)(bidx() * 16 + wid * 4 + q) * 1024 + lane * 4);
    for (int tb = bidx() * 16; tb < T; tb += gridDim.x * 16) {
        const int t0 = tb + wid * 4;
        __syncthreads();
        if (tid < 16) lcnt[tid] = 0u;
        stage(0, 0);
        float rstd[4];
        {
            const float pq = ((const float*)(p.ws + WS_SSQ))[(size_t)(lane & 15) * T + t0 + (lane >> 4)];
            float ss = pq;
            ss += __shfl_xor(ss, 1); ss += __shfl_xor(ss, 2); ss += __shfl_xor(ss, 4); ss += __shfl_xor(ss, 8);
#pragma unroll
            for (int q = 0; q < 4; ++q) rstd[q] = rsqrtf(__shfl(ss, q * 16) * (1.0f / 1024.0f) + 1e-6f);
        }
        float lg[4][20];
#pragma unroll
        for (int q = 0; q < 4; ++q)
#pragma unroll
            for (int j = 0; j < 20; ++j) lg[q][j] = 0.f;
#pragma unroll 1
        for (int i = 0; i < 4; ++i) {
            asm volatile("s_waitcnt vmcnt(0)" ::: "memory");
            __syncthreads();
            if (i + 1 < 4) stage(i + 1, (i + 1) & 1);
            const f32x4* W = WS + (i & 1) * 1280;
            const int col = i * 256 + lane * 4;
            const float4 g = *(const float4*)(gain + col);
            float hh[4][4];
#pragma unroll
            for (int q = 0; q < 4; ++q) {
                hh[q][0] = __uint_as_float(xq[q].x << 16) * rstd[q] * g.x; hh[q][1] = __uint_as_float(xq[q].x & 0xffff0000u) * rstd[q] * g.y; hh[q][2] = __uint_as_float(xq[q].y << 16) * rstd[q] * g.z; hh[q][3] = __uint_as_float(xq[q].y & 0xffff0000u) * rstd[q] * g.w;
            }
            {
                int tn0 = i + 1 < 4 ? t0 : t0 + (int)gridDim.x * 16; const int cn = ((i + 1) & 3) * 256 + lane * 4;
                tn0 = tn0 < T ? tn0 : t0;
#pragma unroll
                for (int q = 0; q < 4; ++q) xq[q] = *(const u32x2*)(xb + (size_t)(tn0 + q) * 1024 + cn);
            }
#pragma unroll
            for (int e = 0; e < 4; ++e) {
                const f32x4 a = W[(0 * 4 + e) * 64 + lane];
#pragma unroll
                for (int q = 0; q < 4; ++q) { lg[q][0] += hh[q][e] * a[0]; lg[q][1] += hh[q][e] * a[1]; lg[q][2] += hh[q][e] * a[2]; lg[q][3] += hh[q][e] * a[3]; }
#pragma unroll
                for (int g2 = 0; g2 < 4; ++g2) {
                    const f32x4 b = W[((1 + g2) * 4 + e) * 64 + lane];
#pragma unroll
                    for (int q = 0; q < 4; ++q) { lg[q][4 + g2 * 4] += hh[q][e] * b[0]; lg[q][5 + g2 * 4] += hh[q][e] * b[1]; lg[q][6 + g2 * 4] += hh[q][e] * b[2]; lg[q][7 + g2 * 4] += hh[q][e] * b[3]; }
                }
            }
        }
#pragma unroll
        for (int q = 0; q < 4; ++q) {
#pragma unroll
            for (int j = 0; j < 20; ++j) lg[q][j] = wave_sum(lg[q][j]);
            if (lane == q) {
                const int t = t0 + q;
                int gs = 0; float gm = lg[q][0];
#pragma unroll
                for (int g2 = 1; g2 < 4; ++g2) if (lg[q][g2] > gm) { gm = lg[q][g2]; gs = g2; }
                float den = 0.f;
#pragma unroll
                for (int g2 = 0; g2 < 4; ++g2) den += __expf(lg[q][g2] - gm);
                const float pg = 1.f / den;
                float el[4];
#pragma unroll
                for (int e = 0; e < 4; ++e) el[e] = gs == 0 ? lg[q][4 + e] : gs == 1 ? lg[q][8 + e] : gs == 2 ? lg[q][12 + e] : lg[q][16 + e];
                int i1 = 0; float v1 = el[0];
#pragma unroll
                for (int e = 1; e < 4; ++e) if (el[e] > v1) { v1 = el[e]; i1 = e; }
                int i2 = 0; float v2 = -3.4e38f;
#pragma unroll
                for (int e = 0; e < 4; ++e) if (e != i1 && el[e] > v2) { v2 = el[e]; i2 = e; }
                const float e2 = __expf(v2 - v1);
                const float g1 = pg / (1.f + e2), g2v = pg * e2 / (1.f + e2);
                const int ea = gs * 4 + i1, eb = gs * 4 + i2;
                const int sl = (wid * 4 + q) * 2;
                e_ent[sl] = ea; r_ent[sl] = atomicAdd(&lcnt[ea], 1u); t_ent[sl] = t * 2; g_ent[sl] = g1; rs_ent[sl] = rstd[q];
                e_ent[sl + 1] = eb; r_ent[sl + 1] = atomicAdd(&lcnt[eb], 1u); t_ent[sl + 1] = t * 2 + 1; g_ent[sl + 1] = g2v; rs_ent[sl + 1] = rstd[q];
            }
        }
        __syncthreads();
        if (tid < 16) lbase[tid] = lcnt[tid] ? atomicAdd(&cnt[tid * 64], lcnt[tid]) : 0u;
        __syncthreads();
        if (tid < 32) {
            const int e = e_ent[tid];
            const unsigned pos = (lbase[e] + r_ent[tid]) & 16383u;
            list[e * 16384 + pos] = t_ent[tid]; gl[e * 16384 + pos] = g_ent[tid]; rsl[e * 16384 + pos] = rs_ent[tid];
        }
    }
}

constexpr int GBK = 64;
struct TileP { int arow[4]; unsigned bo[4]; };
struct GOps { const char* A; unsigned la; const char* A2; unsigned la2; const char* B; };
DI void gemm_core(const GOps& o, const TileP& tp, int K, char* lds, f32x4 (&acc)[4][4], int ksplit, bool primed, const TileP& nx, bool have_nx) {
    const int tid = tidx(), wid = tid >> 6, lane = tid & 63, wr = wid >> 1, wc = wid & 1, fr = lane & 15, fq = lane >> 4;
    const unsigned scol = ((tid & 7) ^ ((tid >> 3) & 7)) * 16;
#pragma unroll
    for (int n = 0; n < 4; ++n)
#pragma unroll
        for (int m = 0; m < 4; ++m) acc[n][m] = (f32x4){0.f, 0.f, 0.f, 0.f};
    const int nk = K / GBK;
    if (!primed) {
        __syncthreads();
#pragma unroll
        for (int i = 0; i < 4; ++i) {
            __builtin_amdgcn_global_load_lds((const unsigned*)(o.A + (__umul24(tp.arow[i], o.la) + scol)), (lds_u32*)(lds + tid * 16 + i * 4096), 16, 0, 0);
            __builtin_amdgcn_global_load_lds((const unsigned*)(o.B + (tp.bo[i] + scol)), (lds_u32*)(lds + 16384 + tid * 16 + i * 4096), 16, 0, 0);
        }
    }
    const int sw = fr & 7;
    const unsigned aoff = (wr * 64 + fr) * 128, boff = (wc * 64 + fr) * 128, co0 = (fq ^ sw) * 16, co1 = ((4 + fq) ^ sw) * 16;
    bf16x8 a0[4], b0[4], a1[4], b1[4];
#define G_ISSUE(kt_)                                                                                                                        \
    if ((kt_) + 1 < nk) {                                                                                                                   \
        char* nb = lds + (((kt_) + 1) & 1) * 32768;                                                                                         \
        const unsigned ko = ((kt_) + 1) * (GBK * 2) + scol;                                                                                 \
        const bool hi = ((kt_) + 1) * GBK >= ksplit;                                                                                        \
        const char* Ab = hi ? o.A2 : o.A; const unsigned la = hi ? o.la2 : o.la;                                                            \
        _Pragma("unroll") for (int i = 0; i < 4; ++i) {                                                                                     \
            __builtin_amdgcn_global_load_lds((const unsigned*)(Ab + (__umul24(tp.arow[i], la) + ko)), (lds_u32*)(nb + tid * 16 + i * 4096), 16, 0, 0);   \
            __builtin_amdgcn_global_load_lds((const unsigned*)(o.B + (tp.bo[i] + ko)), (lds_u32*)(nb + 16384 + tid * 16 + i * 4096), 16, 0, 0);      \
        }                                                                                                                                   \
    } else if (have_nx) {        \
        _Pragma("unroll") for (int i = 0; i < 4; ++i) {                                                                                     \
            __builtin_amdgcn_global_load_lds((const unsigned*)(o.A + (__umul24(nx.arow[i], o.la) + scol)), (lds_u32*)(lds + tid * 16 + i * 4096), 16, 0, 0);          \
            __builtin_amdgcn_global_load_lds((const unsigned*)(o.B + (nx.bo[i] + scol)), (lds_u32*)(lds + 16384 + tid * 16 + i * 4096), 16, 0, 0);  \
        }                                                                                                                                   \
    }
#define G_READ(A_, B_, AD_)                                                                                                                 \
    asm volatile("ds_read_b128 %0, %8\n\tds_read_b128 %1, %8 offset:2048\n\tds_read_b128 %2, %8 offset:4096\n\tds_read_b128 %3, %8 offset:6144\n\t"       \
                 "ds_read_b128 %4, %9 offset:16384\n\tds_read_b128 %5, %9 offset:18432\n\tds_read_b128 %6, %9 offset:20480\n\tds_read_b128 %7, %9 offset:22528" \
                 : "=&v"(A_[0]), "=&v"(A_[1]), "=&v"(A_[2]), "=&v"(A_[3]), "=&v"(B_[0]), "=&v"(B_[1]), "=&v"(B_[2]), "=&v"(B_[3]) : "v"((AD_) + aoff), "v"((AD_) + boff) : "memory");
#define G_WAIT(A_, B_, N_)                                                                                                                  \
    asm volatile("s_waitcnt lgkmcnt(" #N_ ")" : "+v"(A_[0]), "+v"(A_[1]), "+v"(A_[2]), "+v"(A_[3]), "+v"(B_[0]), "+v"(B_[1]), "+v"(B_[2]), "+v"(B_[3]) :: "memory");
#define G_MMA(A_, B_)                                                                                                                       \
    _Pragma("unroll") for (int n = 0; n < 4; ++n)                                                                                           \
        _Pragma("unroll") for (int m = 0; m < 4; ++m) acc[n][m] = __builtin_amdgcn_mfma_f32_16x16x32_bf16(B_[n], A_[m], acc[n][m], 0, 0, 0);
    const unsigned lbase = (unsigned)(size_t)(lds_u32*)lds;
    __builtin_amdgcn_s_waitcnt(0x0070);
    __builtin_amdgcn_s_barrier();
    G_ISSUE(0)
    G_READ(a0, b0, lbase + co0)
    G_READ(a1, b1, lbase + co1)
    G_WAIT(a0, b0, 8)
    __builtin_amdgcn_sched_barrier(0);
    G_MMA(a0, b0)
    __builtin_amdgcn_sched_barrier(0);
    G_WAIT(a1, b1, 0)
#pragma unroll 1
    for (int kt = 1; kt < nk; ++kt) {
        __builtin_amdgcn_s_waitcnt(0x0070);
        __builtin_amdgcn_s_barrier();
        G_ISSUE(kt)
        const unsigned S = lbase + (kt & 1) * 32768;
        G_READ(a0, b0, S + co0)
        __builtin_amdgcn_sched_barrier(0);
        G_MMA(a1, b1)
        __builtin_amdgcn_sched_barrier(0);
        G_READ(a1, b1, S + co1)
        G_WAIT(a0, b0, 8)
        __builtin_amdgcn_sched_barrier(0);
        G_MMA(a0, b0)
        __builtin_amdgcn_sched_barrier(0);
        G_WAIT(a1, b1, 0)
    }
    G_MMA(a1, b1)
#undef G_ISSUE
#undef G_READ
#undef G_WAIT
#undef G_MMA
}

enum { EPI_EVEN_IN = 0, EPI_ODD_IN, EPI_RESID };
template <int EPI>
DI void phase_gemm(const P& p, const bf16_t* A, int lda, const bf16_t* Bt, int K, int ntn, char* lds, bool dry = false, const bf16_t* A2 = nullptr, int lda2 = 0, int ksplit = 1 << 30) {
    const int tid = tidx(), wid = tid >> 6, lane = tid & 63, wr = wid >> 1, wc = wid & 1, fr = lane & 15, fq = lane >> 4;
    const int ntm = T / 128, ntiles = ntm * ntn;
    auto fill = [&](TileP& t, int tile) {
        const int tn = tile / ntm, tm = tile % ntm, r = tid >> 3;
#pragma unroll
        for (int i = 0; i < 4; ++i) { t.arow[i] = tm * 128 + r + 32 * i; t.bo[i] = (unsigned)(tn * 128 + r + 32 * i) * (unsigned)(K * 2); }
    };
    const GOps gop{(const char*)A, (unsigned)lda * 2u, (const char*)(A2 ? A2 : A), (unsigned)(A2 ? lda2 : lda) * 2u, (const char*)Bt};
    TileP cur, nxt;
    bool primed = false;
    fill(cur, bidx() < ntiles ? bidx() : 0); nxt = cur;
    for (int tile = bidx(); tile < ntiles; tile += gridDim.x) {
        const int tn = tile / ntm, tm = tile % ntm;
        const bool have_next = tile + (int)gridDim.x < ntiles;
        if (have_next) fill(nxt, tile + gridDim.x);
        f32x4 acc[4][4];
        const int m0 = tm * 128 + wr * 64, n0 = tn * 128 + wc * 64;
        float rsr[4];
        if (EPI != EPI_RESID) {
#pragma unroll
            for (int m = 0; m < 4; ++m) rsr[m] = ((const float*)(p.ws + WS_RSIN))[m0 + m * 16 + fr];
        }
        gemm_core(gop, cur, K, lds, acc, ksplit, primed, nxt, have_next);
        primed = have_next; cur = nxt;
        if (EPI != EPI_RESID) {
#pragma unroll
            for (int m = 0; m < 4; ++m)
#pragma unroll
                for (int n = 0; n < 4; ++n) acc[n][m] *= rsr[m];
        }
        if (EPI == EPI_EVEN_IN) {
            bf16_t* C = (bf16_t*)(p.ws + WS_PROJ);
#pragma unroll
            for (int m = 0; m < 4; ++m)
#pragma unroll
                for (int n = 0; n < 4; ++n) {
                    const int row = m0 + m * 16 + fr, col = n0 + n * 16 + fq * 4;
                    if (col < EVC) { u32x2 w; w.x = pack2(acc[n][m][0], acc[n][m][1]); w.y = pack2(acc[n][m][2], acc[n][m][3]); *(u32x2*)(C + (size_t)row * EVLD + col) = w; }
                }
        } else if (EPI == EPI_ODD_IN) {
            bf16_t* C = (bf16_t*)(p.ws + WS_QK);
            const float2* tab = (const float2*)(p.ws + WS_ROPE);
            if (n0 < 3072) {
#pragma unroll
                for (int m = 0; m < 4; ++m) {
                    const int row = m0 + m * 16 + fr;
#pragma unroll
                    for (int n = 0; n < 2; ++n) {
                        float lo[4], hi[4];
#pragma unroll
                        for (int j = 0; j < 4; ++j) {
                            const float2 cs = tab[(size_t)row * 32 + n * 16 + fq * 4 + j];
                            const float x1 = acc[n][m][j], x2 = acc[n + 2][m][j];
                            lo[j] = x1 * cs.x - x2 * cs.y; hi[j] = x2 * cs.x + x1 * cs.y;
                        }
                        u32x2 w; w.x = pack2(lo[0], lo[1]); w.y = pack2(lo[2], lo[3]);
                        *(u32x2*)(C + (size_t)row * 3072 + n0 + n * 16 + fq * 4) = w;
                        w.x = pack2(hi[0], hi[1]); w.y = pack2(hi[2], hi[3]);
                        *(u32x2*)(C + (size_t)row * 3072 + n0 + (n + 2) * 16 + fq * 4) = w;
                    }
                }
            }
            if (tn * 128 >= 3072) {
                bf16_t* VT = (bf16_t*)(p.ws + WS_VT);
                const int hg0 = (tn * 128 - 3072) >> 6, g = hg0 >> 3, lg2 = g * 2, dil = 1 << lg2, L = SEQ >> lg2, run = 128 >> lg2;
                __syncthreads();
#pragma unroll
                for (int m = 0; m < 4; ++m)
#pragma unroll
                    for (int n = 0; n < 4; ++n)
#pragma unroll
                        for (int j = 0; j < 4; ++j)
                            *(bf16_t*)(lds + 32768 + (wc * 64 + n * 16 + fq * 4 + j) * 272 + (wr * 64 + m * 16 + fr) * 2) = f2bf(acc[n][m][j]);
                __syncthreads();
                const int bb = (tm * 128) >> 12, s0 = (tm * 128) & (SEQ - 1);
#pragma unroll
                for (int q = 0; q < 8; ++q) {
                    const int item = tid + q * 256, dim = item >> 4, o0 = (item & 15) * 8;
                    const int rr = o0 / run, i0 = o0 % run;
                    const char* src = lds + 32768 + dim * 272 + (rr + dil * i0) * 2;
                    float e8[8];
#pragma unroll
                    for (int e = 0; e < 8; ++e) e8[e] = bf2f(*(const bf16_t*)(src + e * dil * 2));
                    u32x4 w; w.x = pack2(e8[0], e8[1]); w.y = pack2(e8[2], e8[3]); w.z = pack2(e8[4], e8[5]); w.w = pack2(e8[6], e8[7]);
                    const int hg = hg0 + (dim >> 6);
                    *(u32x4*)(VT + ((size_t)((bb * 24 + hg) * dil + rr) * 64 + (dim & 63)) * L + (s0 >> lg2) + i0) = w;
                }
            }
        } else {
            float* ssq = (float*)(p.ws + WS_SSQ) + (size_t)(tn * 2 + wc) * T;
#pragma unroll
            for (int m = 0; m < 4; ++m) {
                float ss = 0.f;
#pragma unroll
                for (int n = 0; n < 4; ++n) {
                    const size_t qo = (size_t)(m0 + m * 16 + fr) * 1024 + n0 + n * 16 + fq * 4;
                    bf16_t* q = dry ? (bf16_t*)(p.ws + WS_DUMMY) + (qo & 0x7FFFF) : (bf16_t*)(p.ws + WS_XB) + qo;
                    const u32x2 xx = *(const u32x2*)q;
                    float4 v;
                    v.x = __uint_as_float(xx.x << 16) + acc[n][m][0]; v.y = __uint_as_float(xx.x & 0xffff0000u) + acc[n][m][1]; v.z = __uint_as_float(xx.y << 16) + acc[n][m][2]; v.w = __uint_as_float(xx.y & 0xffff0000u) + acc[n][m][3];
                    u32x2 w; w.x = pack2(v.x, v.y); w.y = pack2(v.z, v.w);
                    *(u32x2*)q = w;
                    ss += v.x * v.x + v.y * v.y + v.z * v.z + v.w * v.w;
                }
                ss += __shfl_xor(ss, 16); ss += __shfl_xor(ss, 32);
                if (fq == 0 && !dry) ssq[m0 + m * 16 + fr] = ss;
            }
        }
    }
}

DI void phase_moe_up(const P& p, int layer, char* lds) {
    const int tid = tidx(), wid = tid >> 6, lane = tid & 63, wr = wid >> 1, wc = wid & 1, fr = lane & 15, fq = lane >> 4;
    const unsigned* cntb = (const unsigned*)(p.ws + WS_CTL + CTL_CNT) + layer * 16 * 64;
    unsigned cnt[16];
#pragma unroll
    for (int e = 0; e < 16; ++e) cnt[e] = cntb[e * 64];
    const int* list = (const int*)(p.ws + WS_LIST);
    const float* gl = (const float*)(p.ws + WS_GATE);
    const bf16_t* hn = (const bf16_t*)(p.ws + WS_XB);
    const float* rsl = (const float*)(p.ws + WS_RSL);
    const bf16_t* W13 = (const bf16_t*)(moe_w(p, layer) + W_13);
    bf16_t* H = (bf16_t*)(p.ws + WS_H);
    int ttot = 0;
#pragma unroll
    for (int e = 0; e < 16; ++e) ttot += ((int)cnt[e] + 127) >> 7;
    const int ntiles = ttot * 4;
    auto locate = [&](int tile, int& e, int& lt, int& ce, int& rbe, int& tn) {
        const int mt = tile >> 2; tn = tile & 3;
        int tbe = 0, acc_t = 0; e = 0;
#pragma unroll
        for (int q = 0; q < 16; ++q) { const int nt = ((int)cnt[q] + 127) >> 7; if (mt >= acc_t) { e = q; tbe = acc_t; } acc_t += nt; }
        lt = mt - tbe; ce = (int)cnt[e]; rbe = tbe * 128;
    };
    auto fill = [&](TileP& t, int tile) {
        int e, lt, ce, rbe, tn; locate(tile, e, lt, ce, rbe, tn);
        const int r = tid >> 3;
#pragma unroll
        for (int i = 0; i < 4; ++i) {
            const int ii = lt * 128 + r + 32 * i;
            const int tk = ii < ce ? (list[e * 16384 + ii] >> 1) : 0;
            t.arow[i] = tk;
            t.bo[i] = (unsigned)(e * 512 + tn * 128 + r + 32 * i) * 2048u;
        }
    };
    const GOps gop{(const char*)hn, 2048u, (const char*)hn, 2048u, (const char*)W13};
    TileP cur, nxt;
    bool primed = false;
    fill(cur, bidx() < ntiles ? bidx() : 0); nxt = cur;
    for (int tile = bidx(); tile < ntiles; tile += gridDim.x) {
        int e, lt, ce, rbe, tn; locate(tile, e, lt, ce, rbe, tn);
        const bool have_next = tile + (int)gridDim.x < ntiles;
        if (have_next) fill(nxt, tile + gridDim.x);
        f32x4 acc[4][4];
        gemm_core(gop, cur, 1024, lds, acc, 1 << 30, primed, nxt, have_next);
        primed = have_next; cur = nxt;
#pragma unroll
        for (int m = 0; m < 4; ++m) {
            const int li = lt * 128 + wr * 64 + m * 16 + fr;
            if (li < ce) {
                const float g = gl[e * 16384 + li], rs = rsl[e * 16384 + li];
                bf16_t* hrow = H + (size_t)(rbe + li) * 256;
#pragma unroll
                for (int n = 0; n < 4; n += 2) {
                    float o[4];
#pragma unroll
                    for (int j = 0; j < 4; ++j) o[j] = siluf_(acc[n][m][j] * rs) * (acc[n + 1][m][j] * rs) * g;
                    const int f = tn * 64 + wc * 32 + (n >> 1) * 16 + fq * 4;
                    u32x2 w; w.x = pack2(o[0], o[1]); w.y = pack2(o[2], o[3]);
                    *(u32x2*)(hrow + f) = w;
                }
            }
        }
    }
}
DI void phase_moe_down(const P& p, int layer, char* lds) {
    const int tid = tidx(), wid = tid >> 6, lane = tid & 63, wr = wid >> 1, wc = wid & 1, fr = lane & 15, fq = lane >> 4;
    const unsigned* cntb = (const unsigned*)(p.ws + WS_CTL + CTL_CNT) + layer * 16 * 64;
    unsigned cnt[16];
#pragma unroll
    for (int e = 0; e < 16; ++e) cnt[e] = cntb[e * 64];
    const int* list = (const int*)(p.ws + WS_LIST);
    const bf16_t* W2 = (const bf16_t*)(moe_w(p, layer) + W_2);
    const bf16_t* H = (const bf16_t*)(p.ws + WS_H);
    bf16_t* ys = (bf16_t*)(p.ws + WS_YS);
    int ttot = 0;
#pragma unroll
    for (int e = 0; e < 16; ++e) ttot += ((int)cnt[e] + 127) >> 7;
    const int ntiles = ttot * 8;
    auto locate = [&](int tile, int& e, int& lt, int& ce, int& rbe, int& tn) {
        const int mt = tile >> 3; tn = tile & 7;
        int tbe = 0, acc_t = 0; e = 0;
#pragma unroll
        for (int q = 0; q < 16; ++q) { const int nt = ((int)cnt[q] + 127) >> 7; if (mt >= acc_t) { e = q; tbe = acc_t; } acc_t += nt; }
        lt = mt - tbe; ce = (int)cnt[e]; rbe = tbe * 128;
    };
    auto fill = [&](TileP& t, int tile) {
        int e, lt, ce, rbe, tn; locate(tile, e, lt, ce, rbe, tn);
        const int r = tid >> 3;
#pragma unroll
        for (int i = 0; i < 4; ++i) { t.arow[i] = rbe + lt * 128 + r + 32 * i; t.bo[i] = (unsigned)(e * 1024 + tn * 128 + r + 32 * i) * 512u; }
    };
    const GOps gop{(const char*)H, 512u, (const char*)H, 512u, (const char*)W2};
    TileP cur, nxt;
    bool primed = false;
    fill(cur, bidx() < ntiles ? bidx() : 0); nxt = cur;
    for (int tile = bidx(); tile < ntiles; tile += gridDim.x) {
        int e, lt, ce, rbe, tn; locate(tile, e, lt, ce, rbe, tn);
        const bool have_next = tile + (int)gridDim.x < ntiles;
        if (have_next) fill(nxt, tile + gridDim.x);
        f32x4 acc[4][4];
        gemm_core(gop, cur, 256, lds, acc, 1 << 30, primed, nxt, have_next);
        primed = have_next; cur = nxt;
#pragma unroll
        for (int m = 0; m < 4; ++m) {
            const int li = lt * 128 + wr * 64 + m * 16 + fr;
            if (li < ce) {
                const int ts = list[e * 16384 + li];
                bf16_t* yrow = ys + ((size_t)(ts & 1) * T + (ts >> 1)) * 1024 + tn * 128 + wc * 64 + fq * 4;
#pragma unroll
                for (int n = 0; n < 4; ++n) { u32x2 w; w.x = pack2(acc[n][m][0], acc[n][m][1]); w.y = pack2(acc[n][m][2], acc[n][m][3]); *(u32x2*)(yrow + n * 16) = w; }
            }
        }
    }
}


typedef float f32x16 __attribute__((ext_vector_type(16)));
DI f32x4 mfma16(bf16x8 a, bf16x8 b, f32x4 c) { return __builtin_amdgcn_mfma_f32_16x16x32_bf16(a, b, c, 0, 0, 0); }
DI f32x16 mfma32(bf16x8 a, bf16x8 b, f32x16 c) { return __builtin_amdgcn_mfma_f32_32x32x16_bf16(a, b, c, 0, 0, 0); }
DI f32x4 tile16(const char* X, int ldx, int row0, const char* Y, int ldy, int col0, int K) {
    const int lane = tidx() & 63, fr = lane & 15, fq = lane >> 4;
    const char* xp = X + (row0 + fr) * ldx + fq * 16; const char* yp = Y + (col0 + fr) * ldy + fq * 16;
    bf16x8 a[4], b[4];
#pragma unroll
    for (int s = 0; s < 4; ++s) if (s * 32 < K) { a[s] = *(const bf16x8*)(xp + s * 64); b[s] = *(const bf16x8*)(yp + s * 64); }
    f32x4 acc = {0.f, 0.f, 0.f, 0.f};
#pragma unroll
    for (int s = 0; s < 4; ++s) if (s * 32 < K) acc = mfma16(a[s], b[s], acc);
    return acc;
}
DI bf16x8 pack_step(const f32x16& x, int s) {
    u32x4 r;
    r.x = pack2(x[8 * s + 0], x[8 * s + 1]); r.y = pack2(x[8 * s + 2], x[8 * s + 3]);
    r.z = pack2(x[8 * s + 4], x[8 * s + 5]); r.w = pack2(x[8 * s + 6], x[8 * s + 7]);
    return __builtin_bit_cast(bf16x8, r);
}

constexpr int GP_LF = 0, GP_T = 17408, GP_VEC = GP_T + 9216, GP_U = GP_VEC + 1024, GP_END = GP_U + 36864;
DI void gdn_prep_unit(const P& p, int li, int ch, char* lds) {
    const int tid = tidx(), lane = tid & 63, wid = tid >> 6, fr = lane & 15, fq = lane >> 4;
    const int h = ch & 3, n = (ch >> 2) & 63, b = ch >> 8;
    const int t0 = b * SEQ + n * 64;
    float* Lf = (float*)(lds + GP_LF);
    char* Trow = lds + GP_T;
    float* gcs = (float*)(lds + GP_VEC); float* egc = gcs + 64; float* bet = gcs + 128; float* ekd = gcs + 192;
    char* Qrow = lds + GP_U; char* Krow = Qrow + 17408; char* VbT = lds + GP_U; char* KbgT = VbT + 18432;
    const bf16_t* proj = (const bf16_t*)(p.ws + WS_PROJ);
    unsigned char* ops = p.ws + WS_GOPS + (size_t)ch * GOPS_CH;
    const float* cw = p.in[I_CONVW] + (size_t)li * 4 * 1536;
    const int c = tid >> 2, cq = tid & 3;
    __syncthreads();
    float* cwl = (float*)(lds + GP_END);
    for (int i = tid; i < 4 * 3 * 32; i += 256) {
        const int j = i / 96, r = i % 96, sl = r >> 5, q4 = (r & 31) * 4;
        *(f32x4*)(cwl + (j * 3 + sl) * 128 + q4) = *(const f32x4*)(cw + j * 1536 + sl * 512 + h * 128 + q4);
    }
    __syncthreads();
    unsigned vvp[16];
#pragma unroll 1
    for (int which = 0; which < 3; ++which) {
        const int col0 = which * 512 + h * 128 + cq * 32;
        u32x4 xin[4][4];
#pragma unroll
        for (int j = 0; j < 4; ++j) {
            const int sp = n * 64 + c - 3 + j;
            const bf16_t* src = proj + (size_t)(b * SEQ + (sp < 0 ? 0 : sp)) * EVLD + col0;
#pragma unroll
            for (int i4 = 0; i4 < 4; ++i4) xin[j][i4] = *(const u32x4*)(src + i4 * 8);
        }
        float acc[32];
#pragma unroll
        for (int i = 0; i < 32; ++i) acc[i] = 0.f;
#pragma unroll
        for (int j = 0; j < 4; ++j) {
            const float ok = (n * 64 + c - 3 + j) >= 0 ? 1.f : 0.f;
            const float* wj = cwl + (j * 3 + which) * 128 + cq * 32;
#pragma unroll
            for (int i4 = 0; i4 < 4; ++i4) {
                const f32x4 wa = *(const f32x4*)(wj + i4 * 8), wb = *(const f32x4*)(wj + i4 * 8 + 4);
                const u32x4 w = xin[j][i4];
                acc[i4 * 8 + 0] += ok * wa[0] * __uint_as_float(w[0] << 16); acc[i4 * 8 + 1] += ok * wa[1] * __uint_as_float(w[0] & 0xffff0000u);
                acc[i4 * 8 + 2] += ok * wa[2] * __uint_as_float(w[1] << 16); acc[i4 * 8 + 3] += ok * wa[3] * __uint_as_float(w[1] & 0xffff0000u);
                acc[i4 * 8 + 4] += ok * wb[0] * __uint_as_float(w[2] << 16); acc[i4 * 8 + 5] += ok * wb[1] * __uint_as_float(w[2] & 0xffff0000u);
                acc[i4 * 8 + 6] += ok * wb[2] * __uint_as_float(w[3] << 16); acc[i4 * 8 + 7] += ok * wb[3] * __uint_as_float(w[3] & 0xffff0000u);
            }
        }
        float ss = 0.f;
#pragma unroll
        for (int i = 0; i < 32; ++i) { acc[i] = siluf_(acc[i]); ss += acc[i] * acc[i]; }
        ss += __shfl_xor(ss, 1); ss += __shfl_xor(ss, 2);
        const float rn = which == 2 ? 1.f : rsqrtf(ss + 1e-6f) * (which == 0 ? 0.08838834764831845f : 1.f);
        unsigned pk[16];
#pragma unroll
        for (int i = 0; i < 16; ++i) pk[i] = pack2(acc[2 * i] * rn, acc[2 * i + 1] * rn);
        if (which < 2) {
            char* img = which == 0 ? Qrow : Krow;
#pragma unroll
            for (int i4 = 0; i4 < 4; ++i4) { u32x4 w; w.x = pk[i4 * 4]; w.y = pk[i4 * 4 + 1]; w.z = pk[i4 * 4 + 2]; w.w = pk[i4 * 4 + 3]; *(u32x4*)(img + c * 272 + (cq * 32 + i4 * 8) * 2) = w; }
        } else {
#pragma unroll
            for (int i = 0; i < 16; ++i) vvp[i] = pk[i];
        }
    }
    if (cq == 0) {
        const float a = bf2f(proj[(size_t)(t0 + c) * EVLD + 2048 + h]);
        const float bb = bf2f(proj[(size_t)(t0 + c) * EVLD + 2052 + h]);
        const float Aexp = __expf(p.in[I_ALOG][li * 4 + h]), dtb = p.in[I_DTB][li * 4 + h];
        gcs[c] = -Aexp * softplusf_(a + dtb);
        bet[c] = sigmoidf_(bb);
    }
    __syncthreads();
    if (wid == 0) {
        float x = gcs[lane];
#pragma unroll
        for (int o = 1; o < 64; o <<= 1) { const float y = __shfl_up(x, o); if (lane >= o) x += y; }
        const float gl = __shfl(x, 63);
        gcs[lane] = x; egc[lane] = __expf(x); ekd[lane] = __expf(gl - x);
        if (lane == 63) ((float*)(p.ws + WS_CTL + CTL_EGL))[ch] = __expf(gl);
    }
    __syncthreads();
    {
        const int ti = wid;
#pragma unroll
        for (int tj = 0; tj < 4; ++tj) {
            if (tj <= ti) {
                const f32x4 kk = tile16(Krow, 272, 16 * ti, Krow, 272, 16 * tj, 128);
                const int c2 = 16 * tj + fr;
                f32x4 lv;
#pragma unroll
                for (int r = 0; r < 4; ++r) {
                    const int c1 = 16 * ti + fq * 4 + r;
                    lv[r] = (c1 > c2) ? bet[c1] * kk[r] * __expf(gcs[c1] - gcs[c2]) : 0.f;
                }
                *(f32x4*)&Lf[c2 * 68 + 16 * ti + fq * 4] = lv;
            }
            f32x4 qk = {0.f, 0.f, 0.f, 0.f};
            if (tj <= ti) qk = tile16(Krow, 272, 16 * tj, Qrow, 272, 16 * ti, 128);
            const int c1 = 16 * ti + fr;
            float o4[4];
#pragma unroll
            for (int r = 0; r < 4; ++r) { const int c2 = 16 * tj + fq * 4 + r; o4[r] = (c1 >= c2) ? qk[r] * __expf(gcs[c1] - gcs[c2]) : 0.f; }
            const int mt = c1 >> 5, rr = c1 & 31, hh = fq & 1, jg = fq >> 1;
            u32x2 w; w.x = pack2(o4[0], o4[1]); w.y = pack2(o4[2], o4[3]);
            *(u32x2*)(ops + GO_AF + ((size_t)((mt * 4 + tj) * 64 + hh * 32 + rr) * 8 + jg * 4) * 2) = w;
        }
#pragma unroll
        for (int i = 0; i < 4; ++i) {
            const int idx = tid + i * 256;
            {
                const int mt = idx >> 9, ks = (idx >> 6) & 7, l2 = idx & 63, rr = l2 & 31, hh = l2 >> 5, cc = 32 * mt + rr;
                const float sc = egc[cc];
                const u32x2 lo = *(const u32x2*)(Qrow + cc * 272 + (16 * ks + 4 * hh) * 2), hi = *(const u32x2*)(Qrow + cc * 272 + (16 * ks + 8 + 4 * hh) * 2);
                u32x4 w;
                w.x = pack2(__uint_as_float(lo.x << 16) * sc, __uint_as_float(lo.x & 0xffff0000u) * sc); w.y = pack2(__uint_as_float(lo.y << 16) * sc, __uint_as_float(lo.y & 0xffff0000u) * sc);
                w.z = pack2(__uint_as_float(hi.x << 16) * sc, __uint_as_float(hi.x & 0xffff0000u) * sc); w.w = pack2(__uint_as_float(hi.y << 16) * sc, __uint_as_float(hi.y & 0xffff0000u) * sc);
                *(u32x4*)(ops + GO_QF + (size_t)idx * 16) = w;
            }
            {
                const int mt = idx >> 8, ks = (idx >> 6) & 3, l2 = idx & 63, rr = l2 & 31, hh = l2 >> 5, dk = 32 * mt + rr;
                float e8[8];
#pragma unroll
                for (int j = 0; j < 8; ++j) { const int c2 = 16 * ks + 8 * (j >> 2) + 4 * hh + (j & 3); e8[j] = bf2f(*(const bf16_t*)(Krow + c2 * 272 + dk * 2)) * ekd[c2]; }
                u32x4 w; w.x = pack2(e8[0], e8[1]); w.y = pack2(e8[2], e8[3]); w.z = pack2(e8[4], e8[5]); w.w = pack2(e8[6], e8[7]);
                *(u32x4*)(ops + GO_KF + (size_t)idx * 16) = w;
            }
        }
    }
    __syncthreads();
    {
        const float bc = bet[c], bg = bc * egc[c];
        unsigned kvp[16];
#pragma unroll
        for (int i4 = 0; i4 < 4; ++i4) { const u32x4 w = *(const u32x4*)(Krow + c * 272 + (cq * 32 + i4 * 8) * 2); kvp[i4 * 4] = w.x; kvp[i4 * 4 + 1] = w.y; kvp[i4 * 4 + 2] = w.z; kvp[i4 * 4 + 3] = w.w; }
        __syncthreads();
#pragma unroll
        for (int i = 0; i < 16; ++i) {
            *(bf16_t*)(VbT + (cq * 32 + 2 * i) * 144 + c * 2) = f2bf(__uint_as_float(vvp[i] << 16) * bc);
            *(bf16_t*)(VbT + (cq * 32 + 2 * i + 1) * 144 + c * 2) = f2bf(__uint_as_float(vvp[i] & 0xffff0000u) * bc);
            *(bf16_t*)(KbgT + (cq * 32 + 2 * i) * 144 + c * 2) = f2bf(__uint_as_float(kvp[i] << 16) * bg);
            *(bf16_t*)(KbgT + (cq * 32 + 2 * i + 1) * 144 + c * 2) = f2bf(__uint_as_float(kvp[i] & 0xffff0000u) * bg);
        }
    }
    {
        char* L21i = lds + GP_END;
        char* T11T = L21i + 2560;
        char* MT = T11T + 2560;
        if (wid < 2) {
            const int o = 32 * wid;
            float Tc[32];
#pragma unroll
            for (int i = 0; i < 32; ++i) Tc[i] = (i == (lane & 31)) ? 1.f : 0.f;
#pragma unroll
            for (int j = 0; j < 31; ++j) {
                const float tj = Tc[j];
#pragma unroll
                for (int i4 = (j + 1) >> 2; i4 < 8; ++i4) {
                    const f32x4 l4 = *(const f32x4*)&Lf[(o + j) * 68 + o + i4 * 4];
#pragma unroll
                    for (int e = 0; e < 4; ++e) if (i4 * 4 + e > j) Tc[i4 * 4 + e] -= l4[e] * tj;
                }
            }
            if (lane < 32) {
#pragma unroll
                for (int i = 0; i < 32; ++i) *(bf16_t*)(Trow + (o + i) * 144 + (o + lane) * 2) = f2bf(Tc[i]);
                if (wid == 0) {
#pragma unroll
                    for (int i = 0; i < 32; ++i) *(bf16_t*)(Trow + i * 144 + (32 + lane) * 2) = 0;
#pragma unroll
                    for (int i4 = 0; i4 < 8; ++i4) { u32x2 w; w.x = pack2(Tc[i4 * 4], Tc[i4 * 4 + 1]); w.y = pack2(Tc[i4 * 4 + 2], Tc[i4 * 4 + 3]); *(u32x2*)(T11T + lane * 80 + i4 * 8) = w; }
                }
            }
        } else {
            const int t2 = tid - 128;
#pragma unroll
            for (int g2 = 0; g2 < 2; ++g2) {
                const int i = t2 & 31, k4 = ((t2 >> 5) + 4 * g2) * 4;
                u32x2 w;
                w.x = pack2(Lf[(k4 + 0) * 68 + 32 + i], Lf[(k4 + 1) * 68 + 32 + i]); w.y = pack2(Lf[(k4 + 2) * 68 + 32 + i], Lf[(k4 + 3) * 68 + 32 + i]);
                *(u32x2*)(L21i + i * 80 + k4 * 2) = w;
            }
        }
        __syncthreads();
        {
            const int r0 = 16 * (wid >> 1), c0 = 16 * (wid & 1);
            const f32x4 mm = tile16(L21i, 80, r0, T11T, 80, c0, 32);
            u32x2 w; w.x = pack2(mm[0], mm[1]); w.y = pack2(mm[2], mm[3]);
            *(u32x2*)(MT + (c0 + fr) * 80 + (r0 + 4 * fq) * 2) = w;
        }
        __syncthreads();
        {
            const int r0 = 16 * (wid >> 1), c0 = 16 * (wid & 1);
            const f32x4 tt = tile16(MT, 80, c0, Trow + 32 * 144 + 64, 144, r0, 32);
            u32x2 w; w.x = pack2(-tt[0], -tt[1]); w.y = pack2(-tt[2], -tt[3]);
            *(u32x2*)(Trow + (32 + r0 + fr) * 144 + (c0 + 4 * fq) * 2) = w;
        }
    }
    __syncthreads();
#pragma unroll
    for (int tq = 0; tq < 2; ++tq) {
        const int tj = wid * 2 + tq;
#pragma unroll
        for (int ti = 0; ti < 4; ++ti) {
            const f32x4 u = tile16(Trow, 144, 16 * ti, VbT, 144, 16 * tj, 64);
            {
                const int dv = 16 * tj + fr, slice = dv >> 5, rr = dv & 31, cb = 16 * ti + fq * 4, mt = cb >> 5, q4 = (cb & 31) >> 2, hh = q4 & 1, rg = q4 >> 1;
                u32x2 w; w.x = pack2(u[0], u[1]); w.y = pack2(u[2], u[3]);
                *(u32x2*)(ops + GO_UF + ((size_t)((slice * 2 + mt) * 64 + hh * 32 + rr) * 16 + rg * 4) * 2) = w;
            }
            const f32x4 wv = tile16(KbgT, 144, 16 * tj, Trow, 144, 16 * ti, 64);
            {
                const int c1 = 16 * ti + fr, mt = c1 >> 5, rr = c1 & 31, hh = fq & 1, jg = fq >> 1;
                u32x2 w; w.x = pack2(-wv[0], -wv[1]); w.y = pack2(-wv[2], -wv[3]);
                *(u32x2*)(ops + GO_WF + ((size_t)((mt * 8 + tj) * 64 + hh * 32 + rr) * 8 + jg * 4) * 2) = w;
            }
        }
    }
}

DI void glds16(const void* g, char* l) { __builtin_amdgcn_global_load_lds((const unsigned*)g, (lds_u32*)l, 16, 0, 0); }
DI void fr_rd(bf16x8& f, unsigned addr) { asm volatile("ds_read_b128 %0, %1" : "=v"(f) : "v"(addr) : "memory"); }
template <int N> DI void fr_wait(bf16x8& f) { asm volatile("s_waitcnt lgkmcnt(%1)" : "+v"(f) : "n"(N) : "memory"); }
template <int REM> DI void fr_waitc(bf16x8& f) { if (REM >= 3) fr_wait<3>(f); else if (REM == 2) fr_wait<2>(f); else if (REM == 1) fr_wait<1>(f); else fr_wait<0>(f); }
#define GS_WAIT(n) asm volatile("s_waitcnt vmcnt(" #n ")" ::: "memory")
DI void gdn_scan_block(const P& p, int bh, char* lds, bool dry = false) {
    const int tid = tidx(), lane = tid & 63, w = tid >> 6;
    const int h = bh & 3, b = bh >> 2;
    const float eglv = ((const float*)(p.ws + WS_CTL + CTL_EGL))[(b * 64 + lane) * 4 + h];
    unsigned char* gbase = p.ws + WS_GOPS + (size_t)(b * 256 + h) * GOPS_CH;
    auto issue = [&](int n, int k0, int cntk) {
        for (int k = k0; k < k0 + cntk; ++k) {
            const unsigned char* src = gbase + (size_t)n * 4 * GOPS_CH + k * 8192 + tid * 16;
            char* dst = lds + k * 8192 + tid * 16;
            glds16(src, dst); glds16(src + 4096, dst + 4096);
        }
    };
    const unsigned la = (unsigned)(size_t)(lds_u32*)lds + lane * 16;
    f32x16 S[4];
#pragma unroll
    for (int i = 0; i < 4; ++i)
#pragma unroll
        for (int r = 0; r < 16; ++r) S[i][r] = 0.f;
    __syncthreads();
    issue(0, 0, 7);
#pragma unroll 1
    for (int n = 0; n < 64; ++n) {
        const float egl = __shfl(eglv, n);
        bf16x8 Sb[8];
#pragma unroll
        for (int i = 0; i < 4; ++i) { Sb[i * 2] = pack_step(S[i], 0); Sb[i * 2 + 1] = pack_step(S[i], 1); }
        f32x16 av[2], ao[2];
        GS_WAIT(6);
        __builtin_amdgcn_s_barrier();
        issue(n, 7, 2);
        __builtin_amdgcn_sched_barrier(0);
        {
            const char* sl = lds + (w >> 1) * 8192;
#pragma unroll
            for (int mt = 0; mt < 2; ++mt) {
                const u32x4* up = (const u32x4*)(sl + ((w & 1) * 2 + mt) * 2048 + lane * 32);
                const u32x4 u0 = up[0], u1 = up[1];
#pragma unroll
                for (int e = 0; e < 4; ++e) {
                    av[mt][e * 2] = __uint_as_float(u0[e] << 16); av[mt][e * 2 + 1] = __uint_as_float(u0[e] & 0xffff0000u);
                    av[mt][8 + e * 2] = __uint_as_float(u1[e] << 16); av[mt][8 + e * 2 + 1] = __uint_as_float(u1[e] & 0xffff0000u);
                }
            }
        }
        bf16x8 F[4];
#define GS_O0(j) (unsigned)((2 + ((j) & 1)) * 8192 + ((j) >> 1) * 1024)
#pragma unroll
        for (int j = 0; j < 4; ++j) fr_rd(F[j], la + GS_O0(j));
#pragma unroll
        for (int j = 0; j < 16; ++j) {
            if (j <= 12) fr_wait<3>(F[j & 3]); else if (j == 13) fr_wait<2>(F[j & 3]); else if (j == 14) fr_wait<1>(F[j & 3]); else fr_wait<0>(F[j & 3]);
            av[j & 1] = mfma32(F[j & 3], Sb[j >> 1], av[j & 1]);
            if (j + 4 < 16) fr_rd(F[j & 3], la + GS_O0(j + 4));
        }
        bf16x8 Vb[4];
#pragma unroll
        for (int mt = 0; mt < 2; ++mt) { Vb[mt * 2] = pack_step(av[mt], 0); Vb[mt * 2 + 1] = pack_step(av[mt], 1); }
        GS_WAIT(4);
        __builtin_amdgcn_s_barrier();
        if (n < 63) issue(n + 1, 0, 4);
        __builtin_amdgcn_sched_barrier(0);
#pragma unroll
        for (int mt = 0; mt < 2; ++mt)
#pragma unroll
            for (int r = 0; r < 16; ++r) ao[mt][r] = 0.f;
#define GS_O1(j) (unsigned)((j) < 16 ? (4 + ((j) & 1)) * 8192 + ((j) >> 1) * 1024 : 6 * 8192 + ((j) == 16 ? 0 : (j) == 17 ? 4 : (j) == 18 ? 1 : (j) == 19 ? 5 : (j) == 20 ? 6 : 7) * 1024)
#pragma unroll
        for (int j = 0; j < 4; ++j) fr_rd(F[j], la + GS_O1(j));
#pragma unroll
        for (int j = 0; j < 22; ++j) {
            if (j <= 18) fr_wait<3>(F[j & 3]); else if (j == 19) fr_wait<2>(F[j & 3]); else if (j == 20) fr_wait<1>(F[j & 3]); else fr_wait<0>(F[j & 3]);
            if (j < 16) {
                ao[j & 1] = mfma32(F[j & 3], Sb[j >> 1], ao[j & 1]);
                if (j & 1) {
                    const int ks = j >> 1;
#pragma unroll
                    for (int r = 0; r < 8; ++r) S[ks >> 1][(ks & 1) * 8 + r] *= egl;
                }
            } else {
                const int oi = (j == 16 || j == 18) ? 0 : 1, kv = j <= 17 ? 0 : j <= 19 ? 1 : j == 20 ? 2 : 3;
                ao[oi] = mfma32(F[j & 3], Vb[kv], ao[oi]);
            }
            if (j + 4 < 22) fr_rd(F[j & 3], la + GS_O1(j + 4));
        }
        if (n < 63) GS_WAIT(8); else GS_WAIT(0);
        __builtin_amdgcn_s_barrier();
        if (n < 63) issue(n + 1, 4, 3);
        __builtin_amdgcn_sched_barrier(0);
#define GS_O2(j) (unsigned)((7 + (((j) & 3) >> 1)) * 8192 + ((((j) & 3) & 1) * 4 + ((j) >> 2)) * 1024)
#pragma unroll
        for (int j = 0; j < 4; ++j) fr_rd(F[j], la + GS_O2(j));
#pragma unroll
        for (int j = 0; j < 16; ++j) {
            if (j <= 12) fr_wait<3>(F[j & 3]); else if (j == 13) fr_wait<2>(F[j & 3]); else if (j == 14) fr_wait<1>(F[j & 3]); else fr_wait<0>(F[j & 3]);
            S[j & 3] = mfma32(F[j & 3], Vb[j >> 2], S[j & 3]);
            if (j + 4 < 16) fr_rd(F[j & 3], la + GS_O2(j + 4));
        }
        {
            u32x4* Of = (u32x4*)((dry ? p.ws + WS_DUMMY + (size_t)(bh & 15) * 65536 : gbase + (size_t)n * 4 * GOPS_CH) + GO_UF) + (size_t)(w * 2 * 64 + lane) * 2;
#pragma unroll
            for (int mt = 0; mt < 2; ++mt) {
                u32x4 o0, o1;
#pragma unroll
                for (int e = 0; e < 4; ++e) { o0[e] = pack2(ao[mt][e * 2], ao[mt][e * 2 + 1]); o1[e] = pack2(ao[mt][8 + e * 2], ao[mt][8 + e * 2 + 1]); }
                Of[mt * 128] = o0; Of[mt * 128 + 1] = o1;
            }
        }
    }
    __syncthreads();
}

DI void gdn_post_unit(const P& p, int li, int ch) {
    const int tid = tidx();
    const int h = ch & 3, n = (ch >> 2) & 63, b = ch >> 8;
    const int t0 = b * SEQ + n * 64;
    const int c = tid >> 2, cq = tid & 3;
    const bf16_t* Of = (const bf16_t*)(p.ws + WS_GOPS + (size_t)ch * GOPS_CH + GO_UF);
    const bf16_t* proj = (const bf16_t*)(p.ws + WS_PROJ);
    bf16_t* mix = (bf16_t*)(p.ws + WS_PROJ);
    const float* nw = p.in[I_GDNNORM] + li * 128 + cq * 32;
    const int mt = c >> 5, q4 = (c & 31) >> 2, hh = q4 & 1, rg = q4 >> 1, reg = rg * 4 + (c & 3);
    float o[32]; float ss = 0.f;
#pragma unroll
    for (int r = 0; r < 32; ++r) { o[r] = bf2f(Of[(size_t)((cq * 2 + mt) * 64 + hh * 32 + r) * 16 + reg]); ss += o[r] * o[r]; }
    ss += __shfl_xor(ss, 1); ss += __shfl_xor(ss, 2);
    const float rs = rsqrtf(ss * (1.f / 128.f) + 1e-6f);
    const bf16_t* zp = proj + (size_t)(t0 + c) * EVLD + 1536 + h * 128 + cq * 32;
    bf16_t* mp = mix + (size_t)(t0 + c) * EVLD + h * 128 + cq * 32;
#pragma unroll
    for (int i4 = 0; i4 < 4; ++i4) {
        const u32x4 zw = *(const u32x4*)(zp + i4 * 8);
        u32x4 w;
#pragma unroll
        for (int e = 0; e < 4; ++e) {
            const float z0 = __uint_as_float(zw[e] << 16), z1 = __uint_as_float(zw[e] & 0xffff0000u);
            w[e] = pack2(o[i4 * 8 + e * 2] * rs * nw[i4 * 8 + e * 2] * siluf_(z0), o[i4 * 8 + e * 2 + 1] * rs * nw[i4 * 8 + e * 2 + 1] * siluf_(z1));
        }
        *(u32x4*)(mp + i4 * 8) = w;
    }
}


constexpr int RP_Z0 = 0, RP_Z1 = 18432, RP_Z2 = 55296, RP_VEC = 73728, RP_PT = 75008, RP_T11 = 78080, RP_END = 80640;
constexpr int RP_LIN = 0, RP_LW = 25600;
DI void rwkv_prep_unit(const P& p, int li, int ch, char* lds) {
    const int tid = tidx(), lane = tid & 63, wid = tid >> 6, fr = lane & 15, fq = lane >> 4;
    const int h = ch & 7, n = (ch >> 3) & 63, b = ch >> 9;
    const int t0 = b * SEQ + n * 64;
    const bf16_t* proj = (const bf16_t*)(p.ws + WS_PROJ);
    char* Lfc = lds + RP_Z0; float* Lf = (float*)Lfc;
    char* ApT = lds + RP_Z0; char* AkVT = lds + RP_Z0 + 9216;
    char* Arow = lds + RP_Z1; char* Rrow = Arow + 9216; char* Brow = Arow + 18432; char* Krow = Arow + 27648;
    char* Aak = Arow; char* Arb = Rrow; char* Ark = Brow; char* Trow = Krow; char* BhT = Krow; char* VpT = Aak;
    char* AT = lds + RP_Z2; char* VT = AT + 9216; char* KhT = AT;
    float* tot = (float*)(lds + RP_VEC); float* WC = tot + 256;
    char* lin = lds + RP_LIN; char* LWi = lds + RP_LW;
    float* PT = (float*)(lds + RP_PT);
    {
        const float* mu0 = p.in[I_MU] + (size_t)li * 1696;
        if (tid < 48) {
            const int j0 = tid * 4;
            *(float4*)(PT + j0) = j0 < 160 ? *(const float4*)(mu0 + (C_HW - RW0) + j0) : *(const float4*)(p.in[I_VRESMU] + j0 - 160);
        } else if (tid < 48 + 144) {
            const int q = tid - 48, arr = q >> 4, c4 = (q & 15) * 4, chn = h * 64 + c4;
            const float* src = arr == 0 ? mu0 + (C_R - RW0) + chn : arr == 1 ? mu0 + (C_K - RW0) + chn : arr == 2 ? mu0 + (C_V - RW0) + chn
                             : arr == 3 ? p.in[I_W0] + li * 512 + chn : arr == 4 ? p.in[I_A0] + li * 512 + chn : arr == 5 ? p.in[I_V0] + chn
                             : arr == 6 ? p.in[I_KK] + li * 512 + chn : arr == 7 ? p.in[I_KA] + li * 512 + chn : p.in[I_RK] + li * 512 + chn;
            *(float4*)(PT + 192 + arr * 64 + c4) = *(const float4*)src;
        }
    }
    __syncthreads();
    {
        const int c = tid >> 2, cq = tid & 3, s = n * 64 + c;
        const bf16_t* cur = proj + (size_t)(t0 + c) * EVLD + C_HW + cq * 48;
        const float* mu = p.in[I_MU] + (size_t)li * 1696 + (C_HW - RW0);
        const float* vmu = p.in[I_VRESMU];
#pragma unroll
        for (int i6 = 0; i6 < 6; ++i6) {
            const u32x4 cw4 = *(const u32x4*)(cur + i6 * 8);
            u32x4 pw4 = *(const u32x4*)(cur - (s > 0 ? EVLD : 0) + i6 * 8);
            if (s == 0) pw4 = (u32x4){0u, 0u, 0u, 0u};
            const int j0 = cq * 48 + i6 * 8;
            const float4 ma = *(const float4*)(PT + j0), mb = *(const float4*)(PT + j0 + 4);
            const float mm[8] = {ma.x, ma.y, ma.z, ma.w, mb.x, mb.y, mb.z, mb.w};
            const bool is_t = j0 < 32, is_s = (j0 >= 64) && (j0 < 160);
            const float ca = is_t ? 1.f : 0.f, cb = is_t ? -2.f : 1.f, cc = is_t ? 2.f : -1.f;
            u32x4 w;
#pragma unroll
            for (int e = 0; e < 4; ++e) {
                float o2[2];
#pragma unroll
                for (int q = 0; q < 2; ++q) {
                    const float cv = q ? __uint_as_float(cw4[e] & 0xffff0000u) : __uint_as_float(cw4[e] << 16);
                    const float pv = q ? __uint_as_float(pw4[e] & 0xffff0000u) : __uint_as_float(pw4[e] << 16);
                    const float val = cv + mm[e * 2 + q] * (pv - cv);
                    const float act = ca + cb * __builtin_amdgcn_rcpf(1.f + __expf(cc * val));
                    o2[q] = (is_t || is_s) ? act : val;
                }
                w[e] = pack2(o2[0], o2[1]);
            }
            *(u32x4*)(lin + c * 400 + (cq * 48 + i6 * 8) * 2) = w;
        }
        const bf16_t* LW = (const bf16_t*)(p.ws + WS_W + W_LW) + (size_t)h * 64 * 192;
#pragma unroll
        for (int i6 = 0; i6 < 6; ++i6) *(u32x4*)(LWi + c * 400 + (cq * 48 + i6 * 8) * 2) = *(const u32x4*)(LW + (size_t)c * 192 + cq * 48 + i6 * 8);
    }
    __syncthreads();
    float lw_[16], la_[16], lg_[16], lv_[16];
#pragma unroll
    for (int tj = 0; tj < 4; ++tj) {
        const f32x4 a = tile16(LWi, 400, 16 * tj, lin, 400, 16 * wid, 32);
        const f32x4 bq = tile16(LWi + 64, 400, 16 * tj, lin + 64, 400, 16 * wid, 32);
        const f32x4 cg = tile16(LWi + 128, 400, 16 * tj, lin + 128, 400, 16 * wid, 96);
        const f32x4 dv = tile16(LWi + 320, 400, 16 * tj, lin + 320, 400, 16 * wid, 32);
#pragma unroll
        for (int r = 0; r < 4; ++r) { lw_[tj * 4 + r] = a[r]; la_[tj * 4 + r] = bq[r]; lg_[tj * 4 + r] = cg[r]; lv_[tj * 4 + r] = dv[r]; }
    }
    __syncthreads();
    const int c = 16 * wid + fr;
    float at[16], rt[16], bt[16], kt[16], bh[16], kh[16];
    {
        const int s = n * 64 + c;
        const size_t row = (size_t)(t0 + c);
        const float* mu = p.in[I_MU] + (size_t)li * 1696;
        const int hc = h * 64;
        float rr_[16], kk_[16], lwv[16], aa[16];
        float kn = 0.f, rk = 0.f;
        bf16_t* vf = (bf16_t*)(p.ws + WS_VF);
        bf16_t* gg = (bf16_t*)(p.ws + WS_GG);
#pragma unroll
        for (int tj = 0; tj < 4; ++tj) {
            const int cb = 16 * tj + 4 * fq;
            u32x2 cr = *(const u32x2*)(proj + row * EVLD + C_R + hc + cb), ck = *(const u32x2*)(proj + row * EVLD + C_K + hc + cb), cv = *(const u32x2*)(proj + row * EVLD + C_V + hc + cb);
            const size_t prow = s > 0 ? row - 1 : row;
            u32x2 pr = *(const u32x2*)(proj + prow * EVLD + C_R + hc + cb), pk = *(const u32x2*)(proj + prow * EVLD + C_K + hc + cb), pv = *(const u32x2*)(proj + prow * EVLD + C_V + hc + cb);
            if (s == 0) { pr = (u32x2){0u, 0u}; pk = pr; pv = pr; }
            u32x2 vfw = {0u, 0u};
            if (li == 1) vfw = *(const u32x2*)(vf + row * 512 + hc + cb);
            float vout[4], gout[4];
            const int ch0 = hc + cb;
            const float* pt = PT + 192 + cb;
            const float4 mu_r4 = *(const float4*)(pt), mu_k4 = *(const float4*)(pt + 64), mu_v4 = *(const float4*)(pt + 128);
            const float4 w0_4 = *(const float4*)(pt + 192), a0_4 = *(const float4*)(pt + 256), v0_4 = *(const float4*)(pt + 320);
            const float4 kk_4 = *(const float4*)(pt + 384), ka_4 = *(const float4*)(pt + 448), rk_4 = *(const float4*)(pt + 512);
            const float mur[4] = {mu_r4.x, mu_r4.y, mu_r4.z, mu_r4.w}, muk[4] = {mu_k4.x, mu_k4.y, mu_k4.z, mu_k4.w}, muv[4] = {mu_v4.x, mu_v4.y, mu_v4.z, mu_v4.w};
            const float w0v[4] = {w0_4.x, w0_4.y, w0_4.z, w0_4.w}, a0v[4] = {a0_4.x, a0_4.y, a0_4.z, a0_4.w}, v0v[4] = {v0_4.x, v0_4.y, v0_4.z, v0_4.w};
            const float kkp[4] = {kk_4.x, kk_4.y, kk_4.z, kk_4.w}, kap[4] = {ka_4.x, ka_4.y, ka_4.z, ka_4.w}, rkp[4] = {rk_4.x, rk_4.y, rk_4.z, rk_4.w};
#pragma unroll
            for (int r = 0; r < 4; ++r) {
                const int i = tj * 4 + r;
                const unsigned wcr = r < 2 ? cr.x : cr.y, wck = r < 2 ? ck.x : ck.y, wcv = r < 2 ? cv.x : cv.y;
                const unsigned wpr = r < 2 ? pr.x : pr.y, wpk = r < 2 ? pk.x : pk.y, wpv = r < 2 ? pv.x : pv.y, wvf = r < 2 ? vfw.x : vfw.y;
                const float c_r = (r & 1) ? __uint_as_float(wcr & 0xffff0000u) : __uint_as_float(wcr << 16);
                const float c_k = (r & 1) ? __uint_as_float(wck & 0xffff0000u) : __uint_as_float(wck << 16);
                const float c_v = (r & 1) ? __uint_as_float(wcv & 0xffff0000u) : __uint_as_float(wcv << 16);
                const float p_r = (r & 1) ? __uint_as_float(wpr & 0xffff0000u) : __uint_as_float(wpr << 16);
                const float p_k = (r & 1) ? __uint_as_float(wpk & 0xffff0000u) : __uint_as_float(wpk << 16);
                const float p_v = (r & 1) ? __uint_as_float(wpv & 0xffff0000u) : __uint_as_float(wpv << 16);
                const float rm = c_r + mur[r] * (p_r - c_r);
                const float km = c_k + muk[r] * (p_k - c_k);
                float vm = c_v + muv[r] * (p_v - c_v);
                const float wlog = -softplusf_(-(w0v[r] + lw_[i])) - 0.5f;
                lwv[i] = -__expf(wlog);
                const float a = sigmoidf_(a0v[r] + la_[i]);
                if (li == 1) {
                    const float v1 = (r & 1) ? __uint_as_float(wvf & 0xffff0000u) : __uint_as_float(wvf << 16);
                    vm = vm + (v1 - vm) * sigmoidf_(v0v[r] + lv_[i]);
                }
                const float kkv = km * kkp[r];
                kn += kkv * kkv;
                rr_[i] = rm; kk_[i] = kkv; aa[i] = a;
                kt[i] = km * (1.f + (a - 1.f) * kap[r]);
                rk += rm * kt[i] * rkp[r];
                vout[r] = vm; gout[r] = lg_[i];
            }
            u32x2 w; w.x = pack2(vout[0], vout[1]); w.y = pack2(vout[2], vout[3]);
            *(u32x2*)(vf + row * 512 + hc + cb) = w;
            w.x = pack2(gout[0], gout[1]); w.y = pack2(gout[2], gout[3]);
            *(u32x2*)(gg + row * 512 + hc + cb) = w;
#pragma unroll
            for (int r = 0; r < 4; ++r) *(bf16_t*)(VT + (cb + r) * 144 + c * 2) = f2bf(vout[r]);
            __builtin_amdgcn_sched_barrier(0);
        }
        kn += __shfl_xor(kn, 16); kn += __shfl_xor(kn, 32);
        const float kr = rsqrtf(kn + 1e-6f);
        rk += __shfl_xor(rk, 16); rk += __shfl_xor(rk, 32);
        if (fq == 0) ((float*)(p.ws + WS_RK))[row * 8 + h] = rk;
        float cs[16];
#pragma unroll
        for (int i = 0; i < 16; ++i) {
            float x = lwv[i];
#pragma unroll
            for (int o = 1; o < 16; o <<= 1) { const float y = __shfl_up(x, o, 16); if (fr >= o) x += y; }
            cs[i] = x;
        }
        if (fr == 15) {
#pragma unroll
            for (int i = 0; i < 16; ++i) tot[wid * 64 + 16 * (i >> 2) + 4 * fq + (i & 3)] = cs[i];
        }
        __syncthreads();
#pragma unroll
        for (int i = 0; i < 16; ++i) {
            const int chl = 16 * (i >> 2) + 4 * fq + (i & 3);
            float pre = 0.f, all = 0.f;
#pragma unroll
            for (int w2 = 0; w2 < 4; ++w2) { const float tv = tot[w2 * 64 + chl]; all += tv; if (w2 < wid) pre += tv; }
            const float csi = cs[i] + pre, csm = csi - lwv[i];
            const float kkn = kk_[i] * kr, k2 = kt[i];
            const float e_c = __expf(csi), e_n = __builtin_amdgcn_rcpf(e_c), e_m = __expf(csm), e_h = __expf(all) * e_n;
            at[i] = -kkn * e_m; rt[i] = rr_[i] * e_c;
            const float bp = kkn * aa[i];
            bt[i] = bp * e_n; kt[i] = k2 * e_n; bh[i] = bp * e_h; kh[i] = k2 * e_h;
            if (c == 0) WC[chl] = __expf(all);
            if ((i & 3) == 3) __builtin_amdgcn_sched_barrier(0);
        }
    }
#pragma unroll
    for (int tj = 0; tj < 4; ++tj) {
        const int cb = 16 * tj + 4 * fq;
        u32x2 w;
        w.x = pack2(at[tj * 4], at[tj * 4 + 1]); w.y = pack2(at[tj * 4 + 2], at[tj * 4 + 3]); *(u32x2*)(Arow + c * 144 + cb * 2) = w;
        w.x = pack2(rt[tj * 4], rt[tj * 4 + 1]); w.y = pack2(rt[tj * 4 + 2], rt[tj * 4 + 3]); *(u32x2*)(Rrow + c * 144 + cb * 2) = w;
        w.x = pack2(bt[tj * 4], bt[tj * 4 + 1]); w.y = pack2(bt[tj * 4 + 2], bt[tj * 4 + 3]); *(u32x2*)(Brow + c * 144 + cb * 2) = w;
        w.x = pack2(kt[tj * 4], kt[tj * 4 + 1]); w.y = pack2(kt[tj * 4 + 2], kt[tj * 4 + 3]); *(u32x2*)(Krow + c * 144 + cb * 2) = w;
#pragma unroll
        for (int r = 0; r < 4; ++r) {
            *(bf16_t*)(AT + (cb + r) * 144 + c * 2) = f2bf(at[tj * 4 + r]);
        }
    }
    __syncthreads();
    f32x4 pab[4], pak[4], prb[4], prk[4];
    {
        const int ti = wid;
#pragma unroll
        for (int tj = 0; tj < 4; ++tj) {
            pab[tj] = (f32x4){0.f, 0.f, 0.f, 0.f}; pak[tj] = pab[tj]; prb[tj] = pab[tj]; prk[tj] = pab[tj];
            if (tj <= ti) {
                pab[tj] = tile16(Arow, 144, 16 * ti, Brow, 144, 16 * tj, 64);
                pak[tj] = tile16(Krow, 144, 16 * tj, Arow, 144, 16 * ti, 64);
                prb[tj] = tile16(Brow, 144, 16 * tj, Rrow, 144, 16 * ti, 64);
                prk[tj] = tile16(Krow, 144, 16 * tj, Rrow, 144, 16 * ti, 64);
            }
        }
    }
    __syncthreads();
    {
        const int ti = wid;
#pragma unroll
        for (int tj = 0; tj < 4; ++tj) {
            const int s1 = 16 * tj + fr;
            f32x4 lv;
#pragma unroll
            for (int r = 0; r < 4; ++r) { const int t1 = 16 * ti + 4 * fq + r; lv[r] = (s1 < t1) ? -pab[tj][r] : 0.f; }
            *(f32x4*)&Lf[s1 * 72 + 16 * ti + 4 * fq] = lv;
            const int t2 = 16 * ti + fr;
            float m1[4], m2[4], m3[4];
#pragma unroll
            for (int r = 0; r < 4; ++r) { const int s2 = 16 * tj + 4 * fq + r; m1[r] = (s2 < t2) ? pak[tj][r] : 0.f; m2[r] = (s2 <= t2) ? prb[tj][r] : 0.f; m3[r] = (s2 <= t2) ? prk[tj][r] : 0.f; }
            u32x2 w;
            w.x = pack2(m1[0], m1[1]); w.y = pack2(m1[2], m1[3]); *(u32x2*)(Aak + t2 * 144 + (16 * tj + 4 * fq) * 2) = w;
            w.x = pack2(m2[0], m2[1]); w.y = pack2(m2[2], m2[3]); *(u32x2*)(Arb + t2 * 144 + (16 * tj + 4 * fq) * 2) = w;
            w.x = pack2(m3[0], m3[1]); w.y = pack2(m3[2], m3[3]); *(u32x2*)(Ark + t2 * 144 + (16 * tj + 4 * fq) * 2) = w;
        }
    }
    __syncthreads();
    {
        char* L21i = lds + RP_PT;
        char* T11T = lds + RP_T11;
        char* MT = lds + RP_Z0;
        if (wid < 2) {
            const int o = 32 * wid;
            float Tc[32];
#pragma unroll
            for (int i = 0; i < 32; ++i) Tc[i] = (i == (lane & 31)) ? 1.f : 0.f;
#pragma unroll
            for (int j = 0; j < 31; ++j) {
                const float tj = Tc[j];
#pragma unroll
                for (int i4 = (j + 1) >> 2; i4 < 8; ++i4) {
                    const f32x4 l4 = *(const f32x4*)&Lf[(o + j) * 72 + o + i4 * 4];
#pragma unroll
                    for (int e = 0; e < 4; ++e) if (i4 * 4 + e > j) Tc[i4 * 4 + e] -= l4[e] * tj;
                }
            }
            if (lane < 32) {
#pragma unroll
                for (int i = 0; i < 32; ++i) *(bf16_t*)(Trow + (o + i) * 144 + (o + lane) * 2) = f2bf(Tc[i]);
                if (wid == 0) {
#pragma unroll
                    for (int i = 0; i < 32; ++i) *(bf16_t*)(Trow + i * 144 + (32 + lane) * 2) = 0;
#pragma unroll
                    for (int i4 = 0; i4 < 8; ++i4) { u32x2 w; w.x = pack2(Tc[i4 * 4], Tc[i4 * 4 + 1]); w.y = pack2(Tc[i4 * 4 + 2], Tc[i4 * 4 + 3]); *(u32x2*)(T11T + lane * 80 + i4 * 8) = w; }
                }
            }
        } else {
            const int t2 = tid - 128;
#pragma unroll
            for (int g2 = 0; g2 < 2; ++g2) {
                const int i = t2 & 31, k4 = ((t2 >> 5) + 4 * g2) * 4;
                u32x2 w;
                w.x = pack2(Lf[(k4 + 0) * 72 + 32 + i], Lf[(k4 + 1) * 72 + 32 + i]); w.y = pack2(Lf[(k4 + 2) * 72 + 32 + i], Lf[(k4 + 3) * 72 + 32 + i]);
                *(u32x2*)(L21i + i * 80 + k4 * 2) = w;
            }
        }
        __syncthreads();
        {
            const int r0 = 16 * (wid >> 1), c0 = 16 * (wid & 1);
            const f32x4 mm = tile16(L21i, 80, r0, T11T, 80, c0, 32);
            u32x2 w; w.x = pack2(mm[0], mm[1]); w.y = pack2(mm[2], mm[3]);
            *(u32x2*)(MT + (c0 + fr) * 80 + (r0 + 4 * fq) * 2) = w;
        }
        __syncthreads();
        {
            const int r0 = 16 * (wid >> 1), c0 = 16 * (wid & 1);
            const f32x4 tt = tile16(MT, 80, c0, Trow + 32 * 144 + 64, 144, r0, 32);
            u32x2 w; w.x = pack2(-tt[0], -tt[1]); w.y = pack2(-tt[2], -tt[3]);
            *(u32x2*)(Trow + (32 + r0 + fr) * 144 + (c0 + 4 * fq) * 2) = w;
        }
    }
    __syncthreads();
    {
        const int ti = wid;
#pragma unroll
        for (int tj = 0; tj < 4; ++tj) {
            const f32x4 x = tile16(Trow, 144, 16 * ti, AT, 144, 16 * tj, 64);
            const f32x4 y = tile16(Aak, 144, 16 * ti, VT, 144, 16 * tj, 64);
            u32x2 w;
            w.x = pack2(x[0], x[1]); w.y = pack2(x[2], x[3]); *(u32x2*)(ApT + (16 * tj + fr) * 144 + (16 * ti + 4 * fq) * 2) = w;
            w.x = pack2(y[0], y[1]); w.y = pack2(y[2], y[3]); *(u32x2*)(AkVT + (16 * tj + fr) * 144 + (16 * ti + 4 * fq) * 2) = w;
        }
    }
    __syncthreads();
    {
        const int ti = wid;
#pragma unroll
        for (int tj = 0; tj < 4; ++tj) {
            const f32x4 x = tile16(Trow, 144, 16 * ti, AkVT, 144, 16 * tj, 64);
            u32x2 w; w.x = pack2(x[0], x[1]); w.y = pack2(x[2], x[3]); *(u32x2*)(VpT + (16 * tj + fr) * 144 + (16 * ti + 4 * fq) * 2) = w;
        }
    }
    __syncthreads();
#pragma unroll
    for (int tj = 0; tj < 4; ++tj)
#pragma unroll
        for (int r = 0; r < 4; ++r) {
            const int cb = 16 * tj + 4 * fq + r;
            *(bf16_t*)(BhT + cb * 144 + c * 2) = f2bf(bh[tj * 4 + r]);
            *(bf16_t*)(KhT + cb * 144 + c * 2) = f2bf(kh[tj * 4 + r]);
        }
    __syncthreads();
    {
        unsigned char* opsA = (unsigned char*)p.out + (size_t)ch * 16384;
        unsigned char* opsB = p.ws + WS_ROPS + (size_t)ch * 16384;
        const int ti = wid;
#pragma unroll
        for (int tj = 0; tj < 4; ++tj) {
            const f32x4 x = tile16(ApT, 144, 16 * tj, Arb, 144, 16 * ti, 64);
            const f32x4 g = tile16(ApT, 144, 16 * tj, BhT, 144, 16 * ti, 64);
            const int m1 = 16 * ti + fr, mt = m1 >> 5, rr = m1 & 31, hh = fq & 1, jg = fq >> 1;
            const size_t off = ((size_t)((mt * 4 + tj) * 64 + hh * 32 + rr) * 8 + jg * 4) * 2;
            float gd[4];
#pragma unroll
            for (int r = 0; r < 4; ++r) gd[r] = g[r] + ((16 * tj + 4 * fq + r == m1) ? WC[m1] : 0.f);
            u32x2 w;
            w.x = pack2(x[0] + rt[tj * 4], x[1] + rt[tj * 4 + 1]); w.y = pack2(x[2] + rt[tj * 4 + 2], x[3] + rt[tj * 4 + 3]); *(u32x2*)(opsA + off) = w;
            w.x = pack2(gd[0], gd[1]); w.y = pack2(gd[2], gd[3]); *(u32x2*)(opsA + 8192 + off) = w;
            f32x4 y = tile16(Ark, 144, 16 * ti, VT, 144, 16 * tj, 64);
            const f32x4 y2 = tile16(Arb, 144, 16 * ti, VpT, 144, 16 * tj, 64);
            f32x4 kv = tile16(KhT, 144, 16 * ti, VT, 144, 16 * tj, 64);
            const f32x4 kv2 = tile16(BhT, 144, 16 * ti, VpT, 144, 16 * tj, 64);
            const int vcol = 16 * tj + fr, slice = vcol >> 5, r2 = vcol & 31, cb = 16 * ti + 4 * fq, mt2 = cb >> 5, q4 = (cb & 31) >> 2, h2 = q4 & 1, rg = q4 >> 1;
            const size_t off2 = ((size_t)((slice * 2 + mt2) * 64 + h2 * 32 + r2) * 16 + rg * 4) * 2;
            w.x = pack2(y[0] + y2[0], y[1] + y2[1]); w.y = pack2(y[2] + y2[2], y[3] + y2[3]); *(u32x2*)(opsB + off2) = w;
            w.x = pack2(kv[0] + kv2[0], kv[1] + kv2[1]); w.y = pack2(kv[2] + kv2[2], kv[3] + kv2[3]); *(u32x2*)(opsB + 8192 + off2) = w;
        }
    }
}

DI void rwkv_scan_block(const P& p, int bh, char* lds, bool dry = false) {
    const int tid = tidx(), lane = tid & 63, w = tid >> 6, slice = w & 1;
    const int h = bh & 7, b = bh >> 3;
    constexpr int NST = 64 * 2, AH = 3;
    auto issue = [&](int j) {
        const int n = j >> 1, k = j & 1;
        const size_t ch = (size_t)((b * 64 + n) * 8 + h) * 16384;
        const unsigned char* s0 = (k == 0 ? p.ws + WS_ROPS + ch + 8192 : p.ws + WS_ROPS + ch) + tid * 16;
        const unsigned char* s1 = (k == 0 ? (const unsigned char*)p.out + ch + 8192 : (const unsigned char*)p.out + ch) + tid * 16;
        char* dst = lds + (j & 3) * 16384 + tid * 16;
        glds16(s0, dst); glds16(s0 + 4096, dst + 4096); glds16(s1, dst + 8192); glds16(s1 + 4096, dst + 12288);
    };
    const unsigned la = (unsigned)(size_t)(lds_u32*)lds + lane * 16;
    f32x16 H[2];
#pragma unroll
    for (int i = 0; i < 2; ++i)
#pragma unroll
        for (int r = 0; r < 16; ++r) H[i][r] = 0.f;
    __syncthreads();
#pragma unroll
    for (int j = 0; j < AH; ++j) issue(j);
#pragma unroll 1
    for (int n = 0; n < 64; ++n) {
        bf16x8 Hb[4];
#pragma unroll
        for (int i = 0; i < 2; ++i) { Hb[i * 2] = pack_step(H[i], 0); Hb[i * 2 + 1] = pack_step(H[i], 1); }
#pragma unroll
        for (int k = 0; k < 2; ++k) {
            const int j = n * 2 + k;
            if (n < 63) GS_WAIT(8); else if (k == 0) GS_WAIT(4); else GS_WAIT(0);
            __builtin_amdgcn_s_barrier();
            if (j + AH < NST) issue(j + AH);
            __builtin_amdgcn_sched_barrier(0);
            const char* sl = lds + (j & 3) * 16384;
            if (w < 2) {
                f32x16 acc[2];
                bf16x8 F[4];
                const unsigned fa = la + (unsigned)((j & 3) * 16384 + 8192);
#define RS_O(i) (unsigned)((((i) & 1) * 4 + ((i) >> 1)) * 1024)
#pragma unroll
                for (int i = 0; i < 4; ++i) fr_rd(F[i], fa + RS_O(i));
#pragma unroll
                for (int mt = 0; mt < 2; ++mt) {
                    const u32x4* up = (const u32x4*)(sl + (slice * 2 + mt) * 2048 + lane * 32);
                    const u32x4 u0 = up[0], u1 = up[1];
#pragma unroll
                    for (int e = 0; e < 4; ++e) {
                        acc[mt][e * 2] = __uint_as_float(u0[e] << 16); acc[mt][e * 2 + 1] = __uint_as_float(u0[e] & 0xffff0000u);
                        acc[mt][8 + e * 2] = __uint_as_float(u1[e] << 16); acc[mt][8 + e * 2 + 1] = __uint_as_float(u1[e] & 0xffff0000u);
                    }
                }
#pragma unroll
                for (int i = 0; i < 8; ++i) {
                    if (i <= 4) fr_wait<3>(F[i & 3]); else if (i == 5) fr_wait<2>(F[i & 3]); else if (i == 6) fr_wait<1>(F[i & 3]); else fr_wait<0>(F[i & 3]);
                    acc[i & 1] = mfma32(F[i & 3], Hb[i >> 1], acc[i & 1]);
                    if (i + 4 < 8) fr_rd(F[i & 3], fa + RS_O(i + 4));
                }
                if (k == 0) { H[0] = acc[0]; H[1] = acc[1]; }
                else {
                    const size_t ch = (size_t)((b * 64 + n) * 8 + h) * 16384;
                    u32x4* Yf = (u32x4*)(dry ? p.ws + WS_DUMMY + 2097152 + (size_t)(bh & 31) * 16384 : p.ws + WS_ROPS + ch) + (size_t)(slice * 128 + lane) * 2;
#pragma unroll
                    for (int mt = 0; mt < 2; ++mt) {
                        u32x4 o0, o1;
#pragma unroll
                        for (int e = 0; e < 4; ++e) { o0[e] = pack2(acc[mt][e * 2], acc[mt][e * 2 + 1]); o1[e] = pack2(acc[mt][8 + e * 2], acc[mt][8 + e * 2 + 1]); }
                        Yf[mt * 128] = o0; Yf[mt * 128 + 1] = o1;
                    }
                }
            }
        }
    }
    __syncthreads();
}

DI void rwkv_post_unit(const P& p, int li, int ch) {
    const int tid = tidx();
    const int h = ch & 7, n = (ch >> 3) & 63, b = ch >> 9;
    const int t0 = b * SEQ + n * 64;
    const int c = tid >> 2, cq = tid & 3;
    const bf16_t* Yf = (const bf16_t*)(p.ws + WS_ROPS + (size_t)ch * 16384);
    const bf16_t* vf = (const bf16_t*)(p.ws + WS_VF) + (size_t)(t0 + c) * 512 + h * 64 + cq * 16;
    const bf16_t* gg = (const bf16_t*)(p.ws + WS_GG) + (size_t)(t0 + c) * 512 + h * 64 + cq * 16;
    const float rk = ((const float*)(p.ws + WS_RK))[(size_t)(t0 + c) * 8 + h];
    const float* lnw = p.in[I_LNW] + li * 512 + h * 64 + cq * 16;
    const float* lnb = p.in[I_LNB] + li * 512 + h * 64 + cq * 16;
    bf16_t* mp = (bf16_t*)p.out + (size_t)(t0 + c) * 1024 + 512 + h * 64 + cq * 16;
    const int mt = c >> 5, q4 = (c & 31) >> 2, hh = q4 & 1, rg = q4 >> 1, reg = rg * 4 + (c & 3), slice = cq >> 1, rb = (cq & 1) * 16;
    float y[16]; float sm = 0.f;
#pragma unroll
    for (int i = 0; i < 16; ++i) { y[i] = bf2f(Yf[(size_t)((slice * 2 + mt) * 64 + hh * 32 + rb + i) * 16 + reg]); sm += y[i]; }
    sm += __shfl_xor(sm, 1); sm += __shfl_xor(sm, 2);
    const float mean = sm * (1.f / 64.f);
    float vs = 0.f;
#pragma unroll
    for (int i = 0; i < 16; ++i) { y[i] -= mean; vs += y[i] * y[i]; }
    vs += __shfl_xor(vs, 1); vs += __shfl_xor(vs, 2);
    const float rs = rsqrtf(vs * (1.f / 64.f) + 64e-5f);
#pragma unroll
    for (int i8 = 0; i8 < 2; ++i8) {
        const u32x4 vw = *(const u32x4*)(vf + i8 * 8), gw = *(const u32x4*)(gg + i8 * 8);
        u32x4 w;
#pragma unroll
        for (int e = 0; e < 4; ++e) {
            const int i = i8 * 8 + e * 2;
            const float v0 = __uint_as_float(vw[e] << 16), v1 = __uint_as_float(vw[e] & 0xffff0000u), g0 = __uint_as_float(gw[e] << 16), g1 = __uint_as_float(gw[e] & 0xffff0000u);
            w[e] = pack2((y[i] * rs * lnw[i] + lnb[i] + rk * v0) * g0, (y[i + 1] * rs * lnw[i + 1] + lnb[i + 1] + rk * v1) * g1);
        }
        *(u32x4*)(mp + i8 * 8) = w;
    }
}


DI void attn_unit(const P& p, int unit, char* lds) {
    const int tid = tidx(), lane = tid & 63, w = tid >> 6, r_ = lane & 31, hl = lane >> 5;
    const int idx = unit & 31, h = (unit >> 5) & 7, g = (unit >> 8) % 3, b = unit / 768;
    const int lg2 = g * 2, dil = 1 << lg2, L = SEQ >> lg2, ntl = L >> 7;
    const int rs = idx / ntl, qt = idx % ntl;
    const int hg = g * 8 + h;
    const bf16_t* QK = (const bf16_t*)(p.ws + WS_QK);
    const bf16_t* VT = (const bf16_t*)(p.ws + WS_VT) + ((size_t)((b * 24 + hg) * dil + rs) * 64) * L;
    const int qi = 32 * w + r_;
    const int q_idx = 128 * qt + qi;
    const size_t qrow = (size_t)(b * SEQ + q_idx * dil + rs);
    const int kbase0 = 128 * qt - 128;
    char* Kt = lds;
    char* Vt = lds + 32768;
    __syncthreads();
#pragma unroll
    for (int i = 0; i < 8; ++i) {
        const int id = tid + i * 256, row = id >> 3, pc = id & 7, c = pc ^ ((row >> 1) & 7);
        int k_idx = kbase0 + row; if (k_idx < 0) k_idx = 0;
        glds16(QK + (size_t)(b * SEQ + k_idx * dil + rs) * 3072 + 1536 + hg * 64 + c * 8, Kt + id * 16);
    }
#pragma unroll
    for (int i = 0; i < 8; ++i) {
        const int id = tid + i * 256, row = id >> 5, pq = id & 31, q = pq ^ (row & 31);
        int k0 = kbase0 + q * 8; if (k0 < 0) k0 = 0;
        glds16(VT + (size_t)row * L + k0, Vt + id * 16);
    }
    bf16x8 qf[4];
#pragma unroll
    for (int ks = 0; ks < 4; ++ks) qf[ks] = *(const bf16x8*)(QK + qrow * 3072 + hg * 64 + 16 * ks + 8 * hl);
    asm volatile("s_waitcnt vmcnt(0)" ::: "memory");
    __syncthreads();
    f32x16 st[5];
    float mx = -1.0e30f;
#pragma unroll
    for (int kbi = 0; kbi < 5; ++kbi) {
        const int krow = 32 * (w + kbi) + r_;
#pragma unroll
        for (int r = 0; r < 16; ++r) st[kbi][r] = 0.f;
#pragma unroll
        for (int ks = 0; ks < 4; ++ks) {
            const bf16x8 kf = *(const bf16x8*)(Kt + krow * 128 + (((2 * ks + hl) ^ ((krow >> 1) & 7)) * 16));
            st[kbi] = mfma32(kf, qf[ks], st[kbi]);
        }
#pragma unroll
        for (int r = 0; r < 16; ++r) {
            const int kj = 32 * (w + kbi) + (r & 3) + 8 * (r >> 2) + 4 * hl;
            const bool valid = (kj >= qi) && (kj <= qi + 128) && (kbase0 + kj >= 0);
            const float sv = valid ? st[kbi][r] * 0.125f : -1.0e30f;
            st[kbi][r] = sv; mx = fmaxf(mx, sv);
        }
    }
    mx = fmaxf(mx, __shfl_xor(mx, 32));
    float l = 0.f;
#pragma unroll
    for (int kbi = 0; kbi < 5; ++kbi)
#pragma unroll
        for (int r = 0; r < 16; ++r) { const float pv = __expf(st[kbi][r] - mx); st[kbi][r] = pv; l += pv; }
    l += __shfl_xor(l, 32);
    f32x16 ot[2];
#pragma unroll
    for (int dt = 0; dt < 2; ++dt)
#pragma unroll
        for (int r = 0; r < 16; ++r) ot[dt][r] = 0.f;
#pragma unroll
    for (int kbi = 0; kbi < 5; ++kbi)
#pragma unroll
        for (int s2 = 0; s2 < 2; ++s2) {
            const bf16x8 pb = pack_step(st[kbi], s2);
            const int q0 = 4 * (w + kbi) + 2 * s2;
#pragma unroll
            for (int dt = 0; dt < 2; ++dt) {
                const int drow = 32 * dt + r_;
                const u32x2 lo = *(const u32x2*)(Vt + drow * 512 + ((q0 ^ (drow & 31)) * 16) + 8 * hl);
                const u32x2 hi = *(const u32x2*)(Vt + drow * 512 + (((q0 + 1) ^ (drow & 31)) * 16) + 8 * hl);
                u32x4 vw; vw.x = lo.x; vw.y = lo.y; vw.z = hi.x; vw.w = hi.y;
                ot[dt] = mfma32(__builtin_bit_cast(bf16x8, vw), pb, ot[dt]);
            }
        }
    const float inv = 1.f / l;
    bf16_t* og = (bf16_t*)(p.ws + WS_OG) + ((size_t)g * T + qrow) * 512 + h * 64;
#pragma unroll
    for (int dt = 0; dt < 2; ++dt)
#pragma unroll
        for (int rg = 0; rg < 4; ++rg) {
            u32x2 wv; wv.x = pack2(ot[dt][rg * 4] * inv, ot[dt][rg * 4 + 1] * inv); wv.y = pack2(ot[dt][rg * 4 + 2] * inv, ot[dt][rg * 4 + 3] * inv);
            *(u32x2*)(og + 32 * dt + 8 * rg + 4 * hl) = wv;
        }
    if (hl == 0) ((float*)(p.ws + WS_LSE))[((size_t)g * T + qrow) * 8 + h] = mx + __logf(l);
}
DI void phase_attn_merge(const P& p) {
    const bf16_t* og = (const bf16_t*)(p.ws + WS_OG);
    const float* lse = (const float*)(p.ws + WS_LSE);
    bf16_t* o = (bf16_t*)p.out;
    for (int i = bidx() * 256 + tidx(); i < T * 64; i += gridDim.x * 256) {
        const int t = i >> 6, c8 = i & 63, h = c8 >> 3;
        const float l0 = lse[(size_t)t * 8 + h], l1 = lse[((size_t)T + t) * 8 + h], l2 = lse[((size_t)2 * T + t) * 8 + h];
        const float m = fmaxf(l0, fmaxf(l1, l2));
        float w0 = __expf(l0 - m), w1 = __expf(l1 - m), w2 = __expf(l2 - m);
        const float inv = 1.f / (w0 + w1 + w2); w0 *= inv; w1 *= inv; w2 *= inv;
        const u32x4 a = *(const u32x4*)(og + (size_t)t * 512 + c8 * 8), bq = *(const u32x4*)(og + ((size_t)T + t) * 512 + c8 * 8), cq = *(const u32x4*)(og + ((size_t)2 * T + t) * 512 + c8 * 8);
        u32x4 r;
#pragma unroll
        for (int e = 0; e < 4; ++e) {
            const float x0 = w0 * __uint_as_float(a[e] << 16) + w1 * __uint_as_float(bq[e] << 16) + w2 * __uint_as_float(cq[e] << 16);
            const float x1 = w0 * __uint_as_float(a[e] & 0xffff0000u) + w1 * __uint_as_float(bq[e] & 0xffff0000u) + w2 * __uint_as_float(cq[e] & 0xffff0000u);
            r[e] = pack2(x0, x1);
        }
        *(u32x4*)(o + (size_t)t * 512 + c8 * 8) = r;
    }
}


#define XB_TMO      128
#define XB_XCNT(j)  (256  + 64 * (j))
#define XB_XSUB(j)  (1280 + 64 * (j))
#define XB_XGEN(j)  (2304 + 64 * (j))
#define XB_TOP      3328
#define XB_TOPGEN   3392
#define XCD_BAR_WORDS 3456
#define XB_SPIN_CAP (1u << 22)
#define LAS __attribute__((address_space(3)))
DI unsigned xb_ld(unsigned* p)              { return __hip_atomic_load(p, __ATOMIC_RELAXED, __HIP_MEMORY_SCOPE_AGENT); }
DI unsigned xb_add(unsigned* p, unsigned v) { return __hip_atomic_fetch_add(p, v, __ATOMIC_RELAXED, __HIP_MEMORY_SCOPE_AGENT); }
DI unsigned xb_xcc_id() { return (unsigned)__builtin_amdgcn_s_getreg((3 << 11) | 20) & 0xFu; }
#define XB_SPIN(cond, bar) do { unsigned _sp = 0; while (cond) { if (_sp < 32u) __builtin_amdgcn_s_sleep(2); else __builtin_amdgcn_s_sleep(24); \
    if ((++_sp & 255u) == 0u) { if (xb_ld(&(bar)[XB_TMO])) break; if (_sp > XB_SPIN_CAP) { atomicAdd(&(bar)[XB_TMO], 1u); break; } } } } while (0)
struct XcdBarrier { unsigned* bar; unsigned x; volatile LAS unsigned* st; };
DI XcdBarrier xcd_barrier_post(unsigned* bar, volatile LAS unsigned* st) {
    XcdBarrier b; b.bar = bar; b.x = xb_xcc_id(); b.st = st;
    if (threadIdx.x == 0) (void)xb_add(&bar[XB_XCNT(b.x)], 1u);
    return b;
}
DI void xcd_barrier_complete(unsigned* bar, unsigned x, unsigned& nloc, unsigned& nx) {
    const unsigned G = gridDim.x * gridDim.y * gridDim.z;
    unsigned sum, cnt, mine, sp = 0u;
    for (;;) {
        sum = 0u; cnt = 0u; mine = 0u;
#pragma unroll
        for (unsigned j = 0; j < 16; ++j) { const unsigned c = xb_ld(&bar[XB_XCNT(j)]); sum += c; cnt += (c > 0u) ? 1u : 0u; mine = (j == x) ? c : mine; }
        if (sum == G) break;
        __builtin_amdgcn_s_sleep(1);
        if ((++sp & 255u) == 0u) { if (xb_ld(&bar[XB_TMO])) break; if (sp > XB_SPIN_CAP) { atomicAdd(&bar[XB_TMO], 1u); break; } }
    }
    nloc = mine > 0u ? mine : 1u; nx = cnt > 0u ? cnt : 1u;
}
DI void xcd_barrier(const XcdBarrier& b) {
    asm volatile("s_waitcnt vmcnt(0)" ::: "memory");
    __syncthreads();
    if (threadIdx.x == 0) {
        unsigned* bar = b.bar; unsigned bx = b.x;
        asm volatile("" : "+s"(bar), "+s"(bx));
        __builtin_amdgcn_s_waitcnt(0);
        unsigned nloc = b.st[0], nx = b.st[1];
        if (nloc == 0u) { xcd_barrier_complete(bar, bx, nloc, nx); b.st[0] = nloc; b.st[1] = nx; }
        const unsigned old = xb_add(&bar[XB_XSUB(bx)], 1u);
        const unsigned gen = old / nloc;
        if (old + 1u == (gen + 1u) * nloc) {
            __builtin_amdgcn_fence(__ATOMIC_RELEASE, "agent");
            asm volatile("s_waitcnt vmcnt(0)" ::: "memory");
            const unsigned og = xb_add(&bar[XB_TOP], 1u);
            const unsigned tg = og / nx;
            if (og + 1u == (tg + 1u) * nx) xb_add(&bar[XB_TOPGEN], 1u);
            else XB_SPIN(xb_ld(&bar[XB_TOPGEN]) == tg, bar);
            __builtin_amdgcn_fence(__ATOMIC_ACQUIRE, "agent");
            xb_add(&bar[XB_XGEN(bx)], 1u);
            asm volatile("s_waitcnt vmcnt(0)" ::: "memory");
        } else {
            XB_SPIN(xb_ld(&bar[XB_XGEN(bx)]) == gen, bar);
            __builtin_amdgcn_fence(__ATOMIC_ACQUIRE, "agent");
            asm volatile("s_waitcnt vmcnt(0)" ::: "memory");
        }
    }
    __syncthreads();
}

constexpr int LDS_BYTES = RP_END;
static_assert(GP_END + 6144 <= LDS_BYTES, "LDS");
__global__ void __launch_bounds__(256, 2) __attribute__((amdgpu_waves_per_eu(2, 2))) mega(P p) {
    cg::grid_group grid = cg::this_grid();
    extern __shared__ __attribute__((aligned(16))) char lds[];
    if (threadIdx.x < 4) ((volatile LAS unsigned*)(lds + LDS_BYTES))[threadIdx.x] = 0u;
    __syncthreads();
    const XcdBarrier xb = xcd_barrier_post((unsigned*)(p.ws + WS_CTL + CTL_BAR), (volatile LAS unsigned*)(lds + LDS_BYTES));
#define GSYNC() xcd_barrier(xb)
    const bf16_t* HN = (const bf16_t*)p.out;
    const bf16_t* XB = (const bf16_t*)(p.ws + WS_XB);
    const bf16_t* Win = (const bf16_t*)(p.ws + WS_W + W_IN);
    const bf16_t* Wout = (const bf16_t*)(p.ws + WS_W + W_OUT);
    {
        const unsigned hw = (unsigned)__builtin_amdgcn_s_getreg((31 << 11) | 4);
        const unsigned key = 1u + ((xb.x << 16) | (hw & 0xFF00u));
        if (threadIdx.x == 0) ((unsigned*)(p.ws + WS_CTL + CTL_CUTAB))[bidx()] = key;
    }
    phase_rope(p);
    phase_convert_io(p, 0, lds);
    phase_prep<0>(p, p.in[I_EVNORM], 0);
    if (p.ws == nullptr) grid.sync();
    GSYNC();
    volatile LAS unsigned* qword = (volatile LAS unsigned*)(lds + LDS_BYTES + 8);
    int idle2, idle3, rank3, nact3;
    {
        const unsigned* cut = (const unsigned*)(p.ws + WS_CTL + CTL_CUTAB);
        unsigned* keys = (unsigned*)lds; unsigned* cntw = keys + 2048;
        const int G = (int)gridDim.x < 2048 ? (int)gridDim.x : 2048;
        __syncthreads();
        for (int j = threadIdx.x; j < G; j += 256) keys[j] = cut[j];
        if (threadIdx.x < 4) cntw[threadIdx.x] = 0u;
        __syncthreads();
        const unsigned mine = keys[bidx() < G ? bidx() : 0];
        for (int j = threadIdx.x; j < G; j += 256) {
            bool sh16 = false, sh32 = false;
            for (int k = 0; k < 32 && k < G; ++k) { const bool eq = keys[k] == keys[j] && k != j; if (eq) { sh32 = true; if (k < 16) sh16 = true; } }
            const bool act3 = j >= 32 && !sh32;
            if (act3) { atomicAdd(&cntw[0], 1u); if (j < bidx()) atomicAdd(&cntw[1], 1u); }
            if (j == bidx()) { cntw[2] = (j >= 16 && sh16) ? 1u : 0u; cntw[3] = (j >= 32 && sh32) ? 1u : 0u; }
        }
        (void)mine;
        __syncthreads();
        nact3 = __builtin_amdgcn_readfirstlane((int)cntw[0]); rank3 = __builtin_amdgcn_readfirstlane((int)cntw[1]);
        idle2 = __builtin_amdgcn_readfirstlane((int)cntw[2]); idle3 = __builtin_amdgcn_readfirstlane((int)cntw[3]);
        if (nact3 < 1) { nact3 = 1; }
        __syncthreads();
    }
    for (int layer = 0; layer < 4; ++layer) {
        const int li = layer >> 1;
        if ((layer & 1) == 0) {
            phase_gemm<EPI_EVEN_IN>(p, XB, 1024, Win, 1024, EVPAD / 128, lds);
            GSYNC();
            for (int u = bidx(); u < 1024; u += gridDim.x) gdn_prep_unit(p, li, u, lds);
            GSYNC();
            if (bidx() < 16) gdn_scan_block(p, bidx(), lds);
            if (!idle2) {
                unsigned* qctr = (unsigned*)(p.ws + WS_CTL + CTL_QUEUE) + li * 64;
                for (;;) {
                    __syncthreads();
                    if (threadIdx.x == 0) *qword = atomicAdd(qctr, 1u);
                    __syncthreads();
                    const unsigned u = *qword;
                    if (u >= 2048u + 768u) break;
                    if (u < 2048u) rwkv_prep_unit(p, li, (int)u, lds);
                    else convert_moe_tile(p, layer + 1, lds, (int)u - 2048);
                }
            }
            GSYNC();
            if (bidx() < 32) rwkv_scan_block(p, bidx(), lds);
            else if (!idle3) {
                for (int u = rank3; u < 1024; u += nact3) gdn_post_unit(p, li, u);
                phase_convert_moe(p, layer, lds, rank3, nact3);
            }
            GSYNC();
            for (int u = bidx(); u < 2048; u += gridDim.x) rwkv_post_unit(p, li, u);
            GSYNC();
            phase_gemm<EPI_RESID>(p, (const bf16_t*)(p.ws + WS_PROJ), EVLD, Wout, 1024, 8, lds, false, HN, 1024, 512);
        } else {
            phase_gemm<EPI_ODD_IN>(p, XB, 1024, Win, 1024, ODC / 128, lds);
            GSYNC();
            for (int u = bidx(); u < 3072; u += gridDim.x) attn_unit(p, u, lds);
            GSYNC();
            phase_attn_merge(p);
            GSYNC();
            phase_gemm<EPI_RESID>(p, HN, 512, Wout, 512, 8, lds);
        }
        GSYNC();
        phase_router(p, p.in[I_FFNNORM] + layer * 1024, layer, lds);
        GSYNC();
        phase_moe_up(p, layer, lds);
        GSYNC();
        phase_moe_down(p, layer, lds);
        GSYNC();
        if (layer < 3) {
            phase_convert_io(p, layer + 1, lds);
            phase_prep<1>(p, ((layer + 1) & 1) ? p.in[I_ODNORM] + ((layer + 1) >> 1) * 1024 : p.in[I_EVNORM] + ((layer + 1) >> 1) * 1024, layer + 1);
            GSYNC();
        }
    }
    phase_prep<3>(p, p.in[I_FINAL], 0);
}

extern "C" void kernel_launch(void* const* d_in, const int* in_sizes, int n_in, void* d_out, int out_size, void* d_ws, size_t ws_size, hipStream_t stream) {
    if (n_in != 34 || out_size != T * D || ws_size < WS_NEED) { fprintf(stderr, "kernel_launch: unexpected shapes (n_in %d out %d ws %zu need %zu)\n", n_in, out_size, ws_size, (size_t)WS_NEED); return; }
    static int grid_blocks = 0;
    if (!grid_blocks) {
        int dev = 0, cus = 0, per_cu = 0;
        (void)hipGetDevice(&dev);
        (void)hipDeviceGetAttribute(&cus, hipDeviceAttributeMultiprocessorCount, dev);
        (void)hipFuncSetAttribute((const void*)mega, hipFuncAttributeMaxDynamicSharedMemorySize, LDS_BYTES + 16);
        (void)hipOccupancyMaxActiveBlocksPerMultiprocessor(&per_cu, mega, 256, LDS_BYTES + 16);
        if (per_cu < 1) per_cu = 1;
        if (per_cu > 2) per_cu = 2;
        grid_blocks = cus * per_cu;
    }
    P p{};
    for (int i = 0; i < 34; ++i) p.in[i] = (const float*)d_in[i];
    p.out = (float*)d_out; p.ws = (unsigned char*)d_ws;
    (void)hipMemsetAsync((char*)d_ws + WS_CTL, 0, 65536, stream);
    void* args[] = {&p};
    hipError_t e = hipLaunchCooperativeKernel((void*)mega, dim3(grid_blocks), dim3(256), args, LDS_BYTES + 16, stream);
    if (e != hipSuccess) fprintf(stderr, "cooperative launch failed: %s (grid %d)\n", hipGetErrorString(e), grid_blocks);
}
```

```cpp
#include <hip/hip_runtime.h>
#include <cstdio>
#include <cstdint>
#include <cmath>
#include <hip/hip_cooperative_groups.h>
namespace cg = cooperative_groups;

typedef unsigned short bf16_t;
typedef short bf16x8 __attribute__((ext_vector_type(8)));
typedef float f32x4 __attribute__((ext_vector_type(4)));
typedef unsigned u32x4 __attribute__((ext_vector_type(4)));
typedef unsigned u32x2 __attribute__((ext_vector_type(2)));
#define DI __device__ __forceinline__

constexpr int T = 16384, SEQ = 4096, BATCH = 4, D = 1024;
constexpr int EVC = 3784, EVLD = 3784, EVPAD = 3840;
constexpr int ODC = 4608;
constexpr int RW0 = 2056;
constexpr int C_R = 2056, C_K = 2568, C_V = 3080, C_HW = 3592, C_HA = 3624, C_HG = 3656, C_HV = 3752;
constexpr int NEXP = 16, FF = 256;
constexpr int HROWS = 34816;

constexpr size_t WS_CTL = 0;
constexpr size_t CTL_EGL = 4096;
constexpr size_t CTL_CUTAB = 8192;
constexpr size_t CTL_QUEUE = 49152;
constexpr size_t CTL_CNT = 32768;
constexpr size_t CTL_BAR = 16384;
constexpr size_t WS_LIST = 65536;
constexpr size_t WS_GATE = WS_LIST + 16 * 16384 * 4;
constexpr size_t WS_RK = WS_GATE + 16 * 16384 * 4;
constexpr size_t WS_SSQ = WS_RK + (size_t)T * 8 * 4;
constexpr size_t WS_ROPE = WS_SSQ + (size_t)16 * T * 4;
constexpr size_t WS_W = WS_ROPE + (size_t)T * 32 * 8;
constexpr size_t W_IN = 0;
constexpr size_t W_OUT = (size_t)4608 * 1024 * 2;
constexpr size_t W_13 = W_OUT + (size_t)1024 * 1024 * 2;
constexpr size_t W_2 = W_13 + (size_t)16 * 512 * 1024 * 2;
constexpr size_t W_LW = W_2 + (size_t)16 * 1024 * 256 * 2;
constexpr size_t W_BYTES = W_LW + (size_t)512 * 192 * 2;
constexpr size_t WS_XB = WS_W + W_BYTES;
constexpr size_t WS_HN = WS_XB;
constexpr size_t WS_VF = WS_HN + (size_t)T * 1024 * 2;
constexpr size_t WS_R2 = WS_VF + (size_t)T * 512 * 2;
constexpr size_t WS_PROJ = WS_R2;
constexpr size_t WS_GOPS = WS_R2 + (size_t)T * EVLD * 2;
constexpr size_t GOPS_CH = 73728, GO_UF = 0, GO_WF = 16384, GO_QF = 32768, GO_AF = 49152, GO_KF = 57344;
constexpr size_t WS_ROPS = WS_GOPS + 1024 * GOPS_CH;
constexpr size_t WS_QK = WS_R2;
constexpr size_t WS_VT = WS_QK + (size_t)T * 3072 * 2;
constexpr size_t WS_OG = WS_VT + (size_t)T * 1536 * 2;
constexpr size_t WS_LSE = WS_OG + (size_t)3 * T * 512 * 2;
constexpr size_t WS_END3 = WS_LSE + (size_t)3 * T * 8 * 4;
constexpr size_t WS_YS = WS_R2;
constexpr size_t WS_H = WS_YS + (size_t)2 * T * 1024 * 2;
constexpr size_t WS_GG = WS_ROPS + (size_t)2048 * 16384;
constexpr size_t WS_END0 = WS_GG + (size_t)T * 512 * 2;
constexpr size_t WS_END1 = WS_H + (size_t)HROWS * 256 * 2;
constexpr size_t WS_END2 = WS_R2 + (size_t)T * 4608 * 2;
static_assert(WS_END3 <= WS_END0, "odd-layer regions exceed even-layer footprint");
constexpr size_t WS_END = WS_END0 > WS_END1 ? (WS_END0 > WS_END2 ? WS_END0 : WS_END2) : (WS_END1 > WS_END2 ? WS_END1 : WS_END2);

constexpr size_t WS_RSL = WS_END;
constexpr size_t WS_RSIN = WS_RSL + 16 * 16384 * 4;
constexpr size_t WS_NEED = WS_RSIN + (size_t)T * 4;
constexpr size_t WS_DUMMY = WS_END0;
struct P {
    const float* in[34];
    float* out;
    unsigned char* ws;
};
enum { I_X = 0, I_POS, I_EVNORM, I_EVWIN, I_VRESDOWN, I_EVWOUT, I_CONVW, I_ALOG, I_DTB, I_GDNNORM, I_MU, I_W0, I_W2, I_A0, I_A2, I_G2,
       I_KK, I_KA, I_RK, I_LNW, I_LNB, I_VRESMU, I_V0, I_V2, I_ODNORM, I_ODWIN, I_ODWOUT, I_FFNNORM, I_WGROUP, I_WEXPERT, I_W1, I_W3, I_MW2, I_FINAL };

DI int tidx() { int t = threadIdx.x; asm volatile("" : "+v"(t)); return t; }
DI int bidx() { int b = blockIdx.x; asm volatile("" : "+s"(b)); return b; }
typedef __bf16 bf2_t __attribute__((ext_vector_type(2)));
typedef float f2_t __attribute__((ext_vector_type(2)));
DI bf16_t f2bf(float x) { return __builtin_bit_cast(bf16_t, (__bf16)x); }
DI float bf2f(bf16_t h) { return __uint_as_float(((unsigned)h) << 16); }
DI unsigned pack2(float lo, float hi) { const f2_t v = {lo, hi}; return __builtin_bit_cast(unsigned, __builtin_convertvector(v, bf2_t)); }
DI float wave_sum(float v) {
#pragma unroll
    for (int o = 32; o > 0; o >>= 1) v += __shfl_xor(v, o);
    return v;
}
DI float wave_max(float v) {
#pragma unroll
    for (int o = 32; o > 0; o >>= 1) v = fmaxf(v, __shfl_xor(v, o));
    return v;
}
DI float sigmoidf_(float x) { return __builtin_amdgcn_rcpf(1.f + __expf(-x)); }
DI float siluf_(float x) { return x * __builtin_amdgcn_rcpf(1.f + __expf(-x)); }
DI float softplusf_(float x) { return fmaxf(x, 0.f) + __logf(1.f + __expf(-fabsf(x))); }

struct ConvJob { const float* src; bf16_t* dst; int K, N, ldd; int mode; const float* ks = nullptr; };
DI int rowmap(int mode, int n) { return mode == 0 ? n : ((n >> 4) * 32 + (n & 15) + (mode == 2 ? 16 : 0)); }
DI void conv_tile(const ConvJob& j, int tile, float* lds  ) {
    const int ntn = (j.N + 255) / 256;
    const int tk = tile / ntn, tn = tile % ntn;
    const int tid = tidx();
    __syncthreads();
    float4 v[16];
#pragma unroll
    for (int i = 0; i < 16; ++i) {
        const int e = tid + i * 256, k = e >> 6, n4 = (e & 63) * 4;
        const int gk = tk * 64 + k, gn = tn * 256 + n4;
        v[i] = make_float4(0.f, 0.f, 0.f, 0.f);
        if (gn < j.N) v[i] = *(const float4*)(j.src + (size_t)gk * j.N + gn);
    }
    if (j.ks) {
        float sc[16];
#pragma unroll
        for (int i = 0; i < 16; ++i) sc[i] = j.ks[tk * 64 + (tid >> 6) + 4 * i];
#pragma unroll
        for (int i = 0; i < 16; ++i) { v[i].x *= sc[i]; v[i].y *= sc[i]; v[i].z *= sc[i]; v[i].w *= sc[i]; }
    }
#pragma unroll
    for (int i = 0; i < 16; ++i) { const int e = tid + i * 256, k = e >> 6, n4 = (e & 63) * 4; *(float4*)(lds + k * 260 + n4) = v[i]; }
    __syncthreads();
#pragma unroll
    for (int i = 0; i < 8; ++i) {
        const int n = tid, k8 = i * 8;
        const int gn = tn * 256 + n;
        if (gn < j.N) {
            u32x4 w;
            w.x = pack2(lds[(k8 + 0) * 260 + n], lds[(k8 + 1) * 260 + n]); w.y = pack2(lds[(k8 + 2) * 260 + n], lds[(k8 + 3) * 260 + n]);
            w.z = pack2(lds[(k8 + 4) * 260 + n], lds[(k8 + 5) * 260 + n]); w.w = pack2(lds[(k8 + 6) * 260 + n], lds[(k8 + 7) * 260 + n]);
            *(u32x4*)(j.dst + (size_t)rowmap(j.mode, gn) * j.ldd + tk * 64 + k8) = w;
        }
    }
}
DI void phase_convert_io(const P& p, int layer, char* ldsc, int b0, int bs) {
    float* lds = (float*)ldsc;
    unsigned char* W = p.ws + WS_W;
    const int li = layer >> 1;
    if ((layer & 1) == 0) {
        const float* ng = p.in[I_EVNORM] + li * 1024;
        const ConvJob j0{p.in[I_EVWIN] + (size_t)li * 1024 * 3752, (bf16_t*)(W + W_IN), 1024, 3752, 1024, 0, ng};
        for (int t = b0; t < 16 * 15; t += bs) conv_tile(j0, t, lds);
        if (li == 1) {
            const ConvJob j1{p.in[I_VRESDOWN], (bf16_t*)(W + W_IN) + (size_t)3752 * 1024, 1024, 32, 1024, 0, ng};
            for (int t = b0; t < 16; t += bs) conv_tile(j1, t, lds);
        }
        const ConvJob j2{p.in[I_EVWOUT] + (size_t)li * 1024 * 1024, (bf16_t*)(W + W_OUT), 1024, 1024, 1024, 0};
        for (int t = b0; t < 16 * 4; t += bs) conv_tile(j2, t, lds);
        {
            bf16_t* LW = (bf16_t*)(W + W_LW);
            for (int i = b0 * 256 + tidx(); i < 512 * 192; i += bs * 256) {
                const int ch = i / 192, j = i % 192;
                float v;
                if (j < 32) v = p.in[I_W2][((size_t)li * 32 + j) * 512 + ch];
                else if (j < 64) v = p.in[I_A2][((size_t)li * 32 + j - 32) * 512 + ch];
                else if (j < 160) v = p.in[I_G2][((size_t)li * 96 + j - 64) * 512 + ch];
                else v = (li == 1) ? p.in[I_V2][(size_t)(j - 160) * 512 + ch] : 0.f;
                LW[i] = f2bf(v);
            }
        }
        const int r0 = (li == 1) ? 3784 : 3752;
        bf16_t* z = (bf16_t*)(W + W_IN) + (size_t)r0 * 1024;
        const size_t n = (size_t)(EVPAD - r0) * 1024;
        for (size_t i = (size_t)b0 * 256 + tidx(); i < n; i += (size_t)bs * 256) z[i] = 0;
    } else {
        const ConvJob j0{p.in[I_ODWIN] + (size_t)li * 1024 * 4608, (bf16_t*)(W + W_IN), 1024, 4608, 1024, 0, p.in[I_ODNORM] + li * 1024};
        for (int t = b0; t < 16 * 18; t += bs) conv_tile(j0, t, lds);
        const ConvJob j2{p.in[I_ODWOUT] + (size_t)li * 512 * 1024, (bf16_t*)(W + W_OUT), 512, 1024, 512, 0};
        for (int t = b0; t < 8 * 4; t += bs) conv_tile(j2, t, lds);
    }
}
DI unsigned char* moe_w(const P& p, int layer) { return (layer & 1) ? (unsigned char*)p.out + ((size_t)32 << 20) - W_13 : p.ws + WS_W; }
DI void convert_moe_tile(const P& p, int layer, char* ldsc, int t);
DI void phase_convert_moe(const P& p, int layer, char* ldsc, int b0, int bs) {
    for (int t = b0; t < 16 * 3 * 16; t += bs) convert_moe_tile(p, layer, ldsc, t);
}
DI void convert_moe_tile(const P& p, int layer, char* ldsc, int t) {
    float* lds = (float*)ldsc;
    unsigned char* W = moe_w(p, layer);
    {
        const int e = t / 48, r = t % 48, which = r / 16, tile = r % 16;
        ConvJob j;
        const float* fg = p.in[I_FFNNORM] + layer * 1024;
        if (which == 0) j = ConvJob{p.in[I_W1] + ((size_t)layer * 16 + e) * 1024 * 256, (bf16_t*)(W + W_13) + (size_t)e * 512 * 1024, 1024, 256, 1024, 1, fg};
        else if (which == 1) j = ConvJob{p.in[I_W3] + ((size_t)layer * 16 + e) * 1024 * 256, (bf16_t*)(W + W_13) + (size_t)e * 512 * 1024, 1024, 256, 1024, 2, fg};
        else j = ConvJob{p.in[I_MW2] + ((size_t)layer * 16 + e) * 256 * 1024, (bf16_t*)(W + W_2) + (size_t)e * 1024 * 256, 256, 1024, 256, 0};
        conv_tile(j, tile, lds);
    }
}

DI void phase_rope(const P& p) {
    float2* tab = (float2*)(p.ws + WS_ROPE);
    const int* pos = (const int*)p.in[I_POS];
    for (int i = bidx() * 256 + tidx(); i < T * 32; i += gridDim.x * 256) {
        const int t = i >> 5, f = i & 31;
        const float inv = powf(10000.0f, -(float)f * (2.0f / 64.0f));
        const float ang = (float)pos[t] * inv;
        float s, c; sincosf(ang, &s, &c);
        tab[i] = make_float2(c, s);
    }
}

template <int MODE>
DI void phase_prep(const P& p, const float* gain, int layer) {
    const int lane = tidx() & 63, wid = tidx() >> 6;
    const int nw = gridDim.x * 4;
    bf16_t* hn = (bf16_t*)p.out;
    bf16_t* xb = (bf16_t*)(p.ws + WS_XB);
    const bf16_t* y0 = (const bf16_t*)(p.ws + WS_YS);
    const bf16_t* y1 = y0 + (size_t)T * 1024;
    float4 gq[4];
#pragma unroll
    for (int i = 0; i < 4; ++i) gq[i] = *(const float4*)(gain + i * 256 + lane * 4);
    for (int t = bidx() * 4 + wid; t < T; t += nw) {
        float4 v[4];
        float ss = 0.f;
#pragma unroll
        for (int i = 0; i < 4; ++i) {
            const size_t off = (size_t)t * 1024 + i * 256 + lane * 4;
            if (MODE == 0) v[i] = *(const float4*)(p.in[I_X] + off);
            else { const u32x2 xx = *(const u32x2*)(xb + off); v[i].x = __uint_as_float(xx.x << 16); v[i].y = __uint_as_float(xx.x & 0xffff0000u); v[i].z = __uint_as_float(xx.y << 16); v[i].w = __uint_as_float(xx.y & 0xffff0000u); }
            if (MODE == 1 || MODE == 3) {
                const u32x2 a = *(const u32x2*)(y0 + off), b = *(const u32x2*)(y1 + off);
                v[i].x += __uint_as_float(a.x << 16) + __uint_as_float(b.x << 16); v[i].y += __uint_as_float(a.x & 0xffff0000u) + __uint_as_float(b.x & 0xffff0000u);
                v[i].z += __uint_as_float(a.y << 16) + __uint_as_float(b.y << 16); v[i].w += __uint_as_float(a.y & 0xffff0000u) + __uint_as_float(b.y & 0xffff0000u);
            }
            ss += v[i].x * v[i].x + v[i].y * v[i].y + v[i].z * v[i].z + v[i].w * v[i].w;
        }
        ss = wave_sum(ss);
        const float rstd = rsqrtf(ss * (1.0f / 1024.0f) + 1e-6f);
        if ((MODE == 0 || MODE == 1) && lane == 0) ((float*)(p.ws + WS_RSIN))[t] = rstd;
        float lg[20];
        if (MODE == 2) {
#pragma unroll
            for (int q = 0; q < 20; ++q) lg[q] = 0.f;
        }
#pragma unroll
        for (int i = 0; i < 4; ++i) {
            const int col = i * 256 + lane * 4;
            const size_t off = (size_t)t * 1024 + col;
            const float4 g = gq[i];
            float4 h; h.x = v[i].x * rstd * g.x; h.y = v[i].y * rstd * g.y; h.z = v[i].z * rstd * g.z; h.w = v[i].w * rstd * g.w;
            bf16_t* hd = hn + off;
            if (MODE == 0 || MODE == 1) { u32x2 w; w.x = pack2(v[i].x, v[i].y); w.y = pack2(v[i].z, v[i].w); *(u32x2*)(xb + off) = w; }
            if (MODE == 3) *(float4*)(p.out + off) = h;
            else if (MODE == 2) { u32x2 w; w.x = pack2(h.x, h.y); w.y = pack2(h.z, h.w); *(u32x2*)hd = w; }
            if (MODE == 2) {
                const float hh[4] = {h.x, h.y, h.z, h.w};
                const float* wg = p.in[I_WGROUP] + (size_t)layer * 1024 * 4;
                const float* we = p.in[I_WEXPERT] + (size_t)layer * 4 * 1024 * 4;
#pragma unroll
                for (int e = 0; e < 4; ++e) {
                    const float4 a = *(const float4*)(wg + (size_t)(col + e) * 4);
                    lg[0] += hh[e] * a.x; lg[1] += hh[e] * a.y; lg[2] += hh[e] * a.z; lg[3] += hh[e] * a.w;
#pragma unroll
                    for (int g2 = 0; g2 < 4; ++g2) {
                        const float4 b = *(const float4*)(we + ((size_t)g2 * 1024 + col + e) * 4);
                        lg[4 + g2 * 4 + 0] += hh[e] * b.x; lg[4 + g2 * 4 + 1] += hh[e] * b.y; lg[4 + g2 * 4 + 2] += hh[e] * b.z; lg[4 + g2 * 4 + 3] += hh[e] * b.w;
                    }
                }
            }
        }
        if (MODE == 2) {
#pragma unroll
            for (int q = 0; q < 20; ++q) lg[q] = wave_sum(lg[q]);
            if (lane == 0) {
                int gs = 0; float gm = lg[0];
#pragma unroll
                for (int g2 = 1; g2 < 4; ++g2) if (lg[g2] > gm) { gm = lg[g2]; gs = g2; }
                float den = 0.f;
#pragma unroll
                for (int g2 = 0; g2 < 4; ++g2) den += __expf(lg[g2] - gm);
                const float pg = 1.f / den;
                float el[4];
#pragma unroll
                for (int e = 0; e < 4; ++e) el[e] = gs == 0 ? lg[4 + e] : gs == 1 ? lg[8 + e] : gs == 2 ? lg[12 + e] : lg[16 + e];
                int i1 = 0; float v1 = el[0];
#pragma unroll
                for (int e = 1; e < 4; ++e) if (el[e] > v1) { v1 = el[e]; i1 = e; }
                int i2 = 0; float v2 = -3.4e38f;
#pragma unroll
                for (int e = 0; e < 4; ++e) if (e != i1 && el[e] > v2) { v2 = el[e]; i2 = e; }
                const float e2 = __expf(v2 - v1);
                const float g1 = pg / (1.f + e2), g2v = pg * e2 / (1.f + e2);
                unsigned* cnt = (unsigned*)(p.ws + WS_CTL + CTL_CNT) + layer * 16 * 64;
                int* list = (int*)(p.ws + WS_LIST);
                float* gl = (float*)(p.ws + WS_GATE);
                const int ea = gs * 4 + i1, eb = gs * 4 + i2;
                const unsigned ra = atomicAdd(&cnt[ea * 64], 1u);
                list[ea * 16384 + ra] = t * 2; gl[ea * 16384 + ra] = g1;
                const unsigned rb = atomicAdd(&cnt[eb * 64], 1u);
                list[eb * 16384 + rb] = t * 2 + 1; gl[eb * 16384 + rb] = g2v;
            }
        }
    }
}


typedef __attribute__((address_space(3))) unsigned lds_u32;
DI void g_dma(unsigned m0v, unsigned voff, const char* sbase) {
    asm volatile("s_mov_b32 m0, %0\n\ts_nop 0\n\tglobal_load_lds_dwordx4 %1, %2" :: "s"(m0v), "v"(voff), "s"(sbase) : "memory", "m0");
}
DI void phase_router(const P& p, const float* gain, int layer, char* ldsc) {
    const int tid = tidx(), lane = tid & 63, wid = tid >> 6;
    const bf16_t* xb = (const bf16_t*)(p.ws + WS_XB);
    const float* wg = p.in[I_WGROUP] + (size_t)layer * 1024 * 4;
    const float* we = p.in[I_WEXPERT] + (size_t)layer * 4 * 1024 * 4;
    unsigned* cnt = (unsigned*)(p.ws + WS_CTL + CTL_CNT) + layer * 16 * 64;
    int* list = (int*)(p.ws + WS_LIST);
    float* gl = (float*)(p.ws + WS_GATE);
    float* rsl = (float*)(p.ws + WS_RSL);
    f32x4* WS = (f32x4*)ldsc;
    unsigned* lcnt = (unsigned*)(ldsc + 40960); unsigned* lbase = lcnt + 16; int* e_ent = (int*)(lcnt + 32); unsigned* r_ent = (unsigned*)(e_ent + 32); int* t_ent = (int*)(r_ent + 32); float* g_ent = (float*)(t_ent + 32); float* rs_ent = g_ent + 32;
    const unsigned wsb = (unsigned)__builtin_amdgcn_readfirstlane((int)((unsigned)(size_t)(lds_u32*)ldsc + wid * 1024));
    auto stage = [&](int i, int buf) {
        const unsigned voff = (unsigned)(i * 256 + lane * 4 + wid) * 16u;
#pragma unroll
        for (int r = 0; r < 5; ++r) g_dma(wsb + (unsigned)(buf * 1280 + r * 256) * 16u, voff, (const char*)(r == 0 ? wg : we + (size_t)(r - 1) * 4096));
    };
    u32x2 xq[4];
#pragma unroll
    for (int q = 0; q < 4; ++q) xq[q] = *(const u32x2*)(xb + (size_t)(bidx() * 16 + wid * 4 + q) * 1024 + lane * 4);
    for (int tb = bidx() * 16; tb < T; tb += gridDim.x * 16) {
        const int t0 = tb + wid * 4;
        __syncthreads();
        if (tid < 16) lcnt[tid] = 0u;
        stage(0, 0);
        float rstd[4];
        {
            const float pq = ((const float*)(p.ws + WS_SSQ))[(size_t)(lane & 15) * T + t0 + (lane >> 4)];
            float ss = pq;
            ss += __shfl_xor(ss, 1); ss += __shfl_xor(ss, 2); ss += __shfl_xor(ss, 4); ss += __shfl_xor(ss, 8);
#pragma unroll
            for (int q = 0; q < 4; ++q) rstd[q] = rsqrtf(__shfl(ss, q * 16) * (1.0f / 1024.0f) + 1e-6f);
        }
        float lg[4][20];
#pragma unroll
        for (int q = 0; q < 4; ++q)
#pragma unroll
            for (int j = 0; j < 20; ++j) lg[q][j] = 0.f;
#pragma unroll 1
        for (int i = 0; i < 4; ++i) {
            asm volatile("s_waitcnt vmcnt(0)" ::: "memory");
            __syncthreads();
            if (i + 1 < 4) stage(i + 1, (i + 1) & 1);
            const f32x4* W = WS + (i & 1) * 1280;
            const int col = i * 256 + lane * 4;
            const float4 g = *(const float4*)(gain + col);
            float hh[4][4];
#pragma unroll
            for (int q = 0; q < 4; ++q) {
                hh[q][0] = __uint_as_float(xq[q].x << 16) * rstd[q] * g.x; hh[q][1] = __uint_as_float(xq[q].x & 0xffff0000u) * rstd[q] * g.y; hh[q][2] = __uint_as_float(xq[q].y << 16) * rstd[q] * g.z; hh[q][3] = __uint_as_float(xq[q].y & 0xffff0000u) * rstd[q] * g.w;
            }
            {
                int tn0 = i + 1 < 4 ? t0 : t0 + (int)gridDim.x * 16; const int cn = ((i + 1) & 3) * 256 + lane * 4;
                tn0 = tn0 < T ? tn0 : t0;
#pragma unroll
                for (int q = 0; q < 4; ++q) xq[q] = *(const u32x2*)(xb + (size_t)(tn0 + q) * 1024 + cn);
            }
#pragma unroll
            for (int e = 0; e < 4; ++e) {
                const f32x4 a = W[(0 * 4 + e) * 64 + lane];
#pragma unroll
                for (int q = 0; q < 4; ++q) { lg[q][0] += hh[q][e] * a[0]; lg[q][1] += hh[q][e] * a[1]; lg[q][2] += hh[q][e] * a[2]; lg[q][3] += hh[q][e] * a[3]; }
#pragma unroll
                for (int g2 = 0; g2 < 4; ++g2) {
                    const f32x4 b = W[((1 + g2) * 4 + e) * 64 + lane];
#pragma unroll
                    for (int q = 0; q < 4; ++q) { lg[q][4 + g2 * 4] += hh[q][e] * b[0]; lg[q][5 + g2 * 4] += hh[q][e] * b[1]; lg[q][6 + g2 * 4] += hh[q][e] * b[2]; lg[q][7 + g2 * 4] += hh[q][e] * b[3]; }
                }
            }
        }
#pragma unroll
        for (int q = 0; q < 4; ++q) {
#pragma unroll
            for (int j = 0; j < 20; ++j) lg[q][j] = wave_sum(lg[q][j]);
            if (lane == q) {
                const int t = t0 + q;
                int gs = 0; float gm = lg[q][0];
#pragma unroll
                for (int g2 = 1; g2 < 4; ++g2) if (lg[q][g2] > gm) { gm = lg[q][g2]; gs = g2; }
                float den = 0.f;
#pragma unroll
                for (int g2 = 0; g2 < 4; ++g2) den += __expf(lg[q][g2] - gm);
                const float pg = 1.f / den;
                float el[4];
#pragma unroll
                for (int e = 0; e < 4; ++e) el[e] = gs == 0 ? lg[q][4 + e] : gs == 1 ? lg[q][8 + e] : gs == 2 ? lg[q][12 + e] : lg[q][16 + e];
                int i1 = 0; float v1 = el[0];
#pragma unroll
                for (int e = 1; e < 4; ++e) if (el[e] > v1) { v1 = el[e]; i1 = e; }
                int i2 = 0; float v2 = -3.4e38f;
#pragma unroll
                for (int e = 0; e < 4; ++e) if (e != i1 && el[e] > v2) { v2 = el[e]; i2 = e; }
                const float e2 = __expf(v2 - v1);
                const float g1 = pg / (1.f + e2), g2v = pg * e2 / (1.f + e2);
                const int ea = gs * 4 + i1, eb = gs * 4 + i2;
                const int sl = (wid * 4 + q) * 2;
                e_ent[sl] = ea; r_ent[sl] = atomicAdd(&lcnt[ea], 1u); t_ent[sl] = t * 2; g_ent[sl] = g1; rs_ent[sl] = rstd[q];
                e_ent[sl + 1] = eb; r_ent[sl + 1] = atomicAdd(&lcnt[eb], 1u); t_ent[sl + 1] = t * 2 + 1; g_ent[sl + 1] = g2v; rs_ent[sl + 1] = rstd[q];
            }
        }
        __syncthreads();
        if (tid < 16) lbase[tid] = lcnt[tid] ? atomicAdd(&cnt[tid * 64], lcnt[tid]) : 0u;
        __syncthreads();
        if (tid < 32) {
            const int e = e_ent[tid];
            const unsigned pos = (lbase[e] + r_ent[tid]) & 16383u;
            list[e * 16384 + pos] = t_ent[tid]; gl[e * 16384 + pos] = g_ent[tid]; rsl[e * 16384 + pos] = rs_ent[tid];
        }
    }
}

constexpr int GBK = 64;
struct TileP { int arow[4]; unsigned bo[4]; };
struct GOps { const char* A; unsigned la; const char* A2; unsigned la2; const char* B; };
DI void gemm_core(const GOps& o, const TileP& tp, int K, char* lds, f32x4 (&acc)[4][4], int ksplit, bool primed, const TileP& nx, bool have_nx) {
    const int tid = tidx(), wid = tid >> 6, lane = tid & 63, wr = wid >> 1, wc = wid & 1, fr = lane & 15, fq = lane >> 4;
    const unsigned scol = ((tid & 7) ^ ((tid >> 3) & 7)) * 16;
#pragma unroll
    for (int n = 0; n < 4; ++n)
#pragma unroll
        for (int m = 0; m < 4; ++m) acc[n][m] = (f32x4){0.f, 0.f, 0.f, 0.f};
    const int nk = K / GBK;
    if (!primed) {
        __syncthreads();
#pragma unroll
        for (int i = 0; i < 4; ++i) {
            __builtin_amdgcn_global_load_lds((const unsigned*)(o.A + (__umul24(tp.arow[i], o.la) + scol)), (lds_u32*)(lds + tid * 16 + i * 4096), 16, 0, 0);
            __builtin_amdgcn_global_load_lds((const unsigned*)(o.B + (tp.bo[i] + scol)), (lds_u32*)(lds + 16384 + tid * 16 + i * 4096), 16, 0, 0);
        }
    }
    const int sw = fr & 7;
    const unsigned aoff = (wr * 64 + fr) * 128, boff = (wc * 64 + fr) * 128, co0 = (fq ^ sw) * 16, co1 = ((4 + fq) ^ sw) * 16;
    bf16x8 a0[4], b0[4], a1[4], b1[4];
#define G_ISSUE(kt_)                                                                                                                        \
    if ((kt_) + 1 < nk) {                                                                                                                   \
        char* nb = lds + (((kt_) + 1) & 1) * 32768;                                                                                         \
        const unsigned ko = ((kt_) + 1) * (GBK * 2) + scol;                                                                                 \
        const bool hi = ((kt_) + 1) * GBK >= ksplit;                                                                                        \
        const char* Ab = hi ? o.A2 : o.A; const unsigned la = hi ? o.la2 : o.la;                                                            \
        _Pragma("unroll") for (int i = 0; i < 4; ++i) {                                                                                     \
            __builtin_amdgcn_global_load_lds((const unsigned*)(Ab + (__umul24(tp.arow[i], la) + ko)), (lds_u32*)(nb + tid * 16 + i * 4096), 16, 0, 0);   \
            __builtin_amdgcn_global_load_lds((const unsigned*)(o.B + (tp.bo[i] + ko)), (lds_u32*)(nb + 16384 + tid * 16 + i * 4096), 16, 0, 0);      \
        }                                                                                                                                   \
    } else if (have_nx) {        \
        _Pragma("unroll") for (int i = 0; i < 4; ++i) {                                                                                     \
            __builtin_amdgcn_global_load_lds((const unsigned*)(o.A + (__umul24(nx.arow[i], o.la) + scol)), (lds_u32*)(lds + tid * 16 + i * 4096), 16, 0, 0);          \
            __builtin_amdgcn_global_load_lds((const unsigned*)(o.B + (nx.bo[i] + scol)), (lds_u32*)(lds + 16384 + tid * 16 + i * 4096), 16, 0, 0);  \
        }                                                                                                                                   \
    }
#define G_READ(A_, B_, AD_)                                                                                                                 \
    asm volatile("ds_read_b128 %0, %8\n\tds_read_b128 %1, %8 offset:2048\n\tds_read_b128 %2, %8 offset:4096\n\tds_read_b128 %3, %8 offset:6144\n\t"       \
                 "ds_read_b128 %4, %9 offset:16384\n\tds_read_b128 %5, %9 offset:18432\n\tds_read_b128 %6, %9 offset:20480\n\tds_read_b128 %7, %9 offset:22528" \
                 : "=&v"(A_[0]), "=&v"(A_[1]), "=&v"(A_[2]), "=&v"(A_[3]), "=&v"(B_[0]), "=&v"(B_[1]), "=&v"(B_[2]), "=&v"(B_[3]) : "v"((AD_) + aoff), "v"((AD_) + boff) : "memory");
#define G_WAIT(A_, B_, N_)                                                                                                                  \
    asm volatile("s_waitcnt lgkmcnt(" #N_ ")" : "+v"(A_[0]), "+v"(A_[1]), "+v"(A_[2]), "+v"(A_[3]), "+v"(B_[0]), "+v"(B_[1]), "+v"(B_[2]), "+v"(B_[3]) :: "memory");
#define G_MMA(A_, B_)                                                                                                                       \
    _Pragma("unroll") for (int n = 0; n < 4; ++n)                                                                                           \
        _Pragma("unroll") for (int m = 0; m < 4; ++m) acc[n][m] = __builtin_amdgcn_mfma_f32_16x16x32_bf16(B_[n], A_[m], acc[n][m], 0, 0, 0);
    const unsigned lbase = (unsigned)(size_t)(lds_u32*)lds;
    __builtin_amdgcn_s_waitcnt(0x0070);
    __builtin_amdgcn_s_barrier();
    G_ISSUE(0)
    G_READ(a0, b0, lbase + co0)
    G_READ(a1, b1, lbase + co1)
    G_WAIT(a0, b0, 8)
    __builtin_amdgcn_sched_barrier(0);
    G_MMA(a0, b0)
    __builtin_amdgcn_sched_barrier(0);
    G_WAIT(a1, b1, 0)
#pragma unroll 1
    for (int kt = 1; kt < nk; ++kt) {
        __builtin_amdgcn_s_waitcnt(0x0070);
        __builtin_amdgcn_s_barrier();
        G_ISSUE(kt)
        const unsigned S = lbase + (kt & 1) * 32768;
        G_READ(a0, b0, S + co0)
        __builtin_amdgcn_sched_barrier(0);
        G_MMA(a1, b1)
        __builtin_amdgcn_sched_barrier(0);
        G_READ(a1, b1, S + co1)
        G_WAIT(a0, b0, 8)
        __builtin_amdgcn_sched_barrier(0);
        G_MMA(a0, b0)
        __builtin_amdgcn_sched_barrier(0);
        G_WAIT(a1, b1, 0)
    }
    G_MMA(a1, b1)
#undef G_ISSUE
#undef G_READ
#undef G_WAIT
#undef G_MMA
}

enum { EPI_EVEN_IN = 0, EPI_ODD_IN, EPI_RESID };
template <int EPI>
DI void phase_gemm(const P& p, const bf16_t* A, int lda, const bf16_t* Bt, int K, int ntn, char* lds, bool dry = false, const bf16_t* A2 = nullptr, int lda2 = 0, int ksplit = 1 << 30) {
    const int tid = tidx(), wid = tid >> 6, lane = tid & 63, wr = wid >> 1, wc = wid & 1, fr = lane & 15, fq = lane >> 4;
    const int ntm = T / 128, ntiles = ntm * ntn;
    auto fill = [&](TileP& t, int tile) {
        const int tn = tile / ntm, tm = tile % ntm, r = tid >> 3;
#pragma unroll
        for (int i = 0; i < 4; ++i) { t.arow[i] = tm * 128 + r + 32 * i; t.bo[i] = (unsigned)(tn * 128 + r + 32 * i) * (unsigned)(K * 2); }
    };
    const GOps gop{(const char*)A, (unsigned)lda * 2u, (const char*)(A2 ? A2 : A), (unsigned)(A2 ? lda2 : lda) * 2u, (const char*)Bt};
    TileP cur, nxt;
    bool primed = false;
    fill(cur, bidx() < ntiles ? bidx() : 0); nxt = cur;
    for (int tile = bidx(); tile < ntiles; tile += gridDim.x) {
        const int tn = tile / ntm, tm = tile % ntm;
        const bool have_next = tile + (int)gridDim.x < ntiles;
        if (have_next) fill(nxt, tile + gridDim.x);
        f32x4 acc[4][4];
        const int m0 = tm * 128 + wr * 64, n0 = tn * 128 + wc * 64;
        float rsr[4];
        if (EPI != EPI_RESID) {
#pragma unroll
            for (int m = 0; m < 4; ++m) rsr[m] = ((const float*)(p.ws + WS_RSIN))[m0 + m * 16 + fr];
        }
        gemm_core(gop, cur, K, lds, acc, ksplit, primed, nxt, have_next);
        primed = have_next; cur = nxt;
        if (EPI != EPI_RESID) {
#pragma unroll
            for (int m = 0; m < 4; ++m)
#pragma unroll
                for (int n = 0; n < 4; ++n) acc[n][m] *= rsr[m];
        }
        if (EPI == EPI_EVEN_IN) {
            bf16_t* C = (bf16_t*)(p.ws + WS_PROJ);
#pragma unroll
            for (int m = 0; m < 4; ++m)
#pragma unroll
                for (int n = 0; n < 4; ++n) {
                    const int row = m0 + m * 16 + fr, col = n0 + n * 16 + fq * 4;
                    if (col < EVC) { u32x2 w; w.x = pack2(acc[n][m][0], acc[n][m][1]); w.y = pack2(acc[n][m][2], acc[n][m][3]); *(u32x2*)(C + (size_t)row * EVLD + col) = w; }
                }
        } else if (EPI == EPI_ODD_IN) {
            bf16_t* C = (bf16_t*)(p.ws + WS_QK);
            const float2* tab = (const float2*)(p.ws + WS_ROPE);
            if (n0 < 3072) {
#pragma unroll
                for (int m = 0; m < 4; ++m) {
                    const int row = m0 + m * 16 + fr;
#pragma unroll
                    for (int n = 0; n < 2; ++n) {
                        float lo[4], hi[4];
#pragma unroll
                        for (int j = 0; j < 4; ++j) {
                            const float2 cs = tab[(size_t)row * 32 + n * 16 + fq * 4 + j];
                            const float x1 = acc[n][m][j], x2 = acc[n + 2][m][j];
                            lo[j] = x1 * cs.x - x2 * cs.y; hi[j] = x2 * cs.x + x1 * cs.y;
                        }
                        u32x2 w; w.x = pack2(lo[0], lo[1]); w.y = pack2(lo[2], lo[3]);
                        *(u32x2*)(C + (size_t)row * 3072 + n0 + n * 16 + fq * 4) = w;
                        w.x = pack2(hi[0], hi[1]); w.y = pack2(hi[2], hi[3]);
                        *(u32x2*)(C + (size_t)row * 3072 + n0 + (n + 2) * 16 + fq * 4) = w;
                    }
                }
            }
            if (tn * 128 >= 3072) {
                bf16_t* VT = (bf16_t*)(p.ws + WS_VT);
                const int hg0 = (tn * 128 - 3072) >> 6, g = hg0 >> 3, lg2 = g * 2, dil = 1 << lg2, L = SEQ >> lg2, run = 128 >> lg2;
                __syncthreads();
#pragma unroll
                for (int m = 0; m < 4; ++m)
#pragma unroll
                    for (int n = 0; n < 4; ++n)
#pragma unroll
                        for (int j = 0; j < 4; ++j)
                            *(bf16_t*)(lds + 32768 + (wc * 64 + n * 16 + fq * 4 + j) * 272 + (wr * 64 + m * 16 + fr) * 2) = f2bf(acc[n][m][j]);
                __syncthreads();
                const int bb = (tm * 128) >> 12, s0 = (tm * 128) & (SEQ - 1);
#pragma unroll
                for (int q = 0; q < 8; ++q) {
                    const int item = tid + q * 256, dim = item >> 4, o0 = (item & 15) * 8;
                    const int rr = o0 / run, i0 = o0 % run;
                    const char* src = lds + 32768 + dim * 272 + (rr + dil * i0) * 2;
                    float e8[8];
#pragma unroll
                    for (int e = 0; e < 8; ++e) e8[e] = bf2f(*(const bf16_t*)(src + e * dil * 2));
                    u32x4 w; w.x = pack2(e8[0], e8[1]); w.y = pack2(e8[2], e8[3]); w.z = pack2(e8[4], e8[5]); w.w = pack2(e8[6], e8[7]);
                    const int hg = hg0 + (dim >> 6);
                    *(u32x4*)(VT + ((size_t)((bb * 24 + hg) * dil + rr) * 64 + (dim & 63)) * L + (s0 >> lg2) + i0) = w;
                }
            }
        } else {
            float* ssq = (float*)(p.ws + WS_SSQ) + (size_t)(tn * 2 + wc) * T;
#pragma unroll
            for (int m = 0; m < 4; ++m) {
                float ss = 0.f;
#pragma unroll
                for (int n = 0; n < 4; ++n) {
                    const size_t qo = (size_t)(m0 + m * 16 + fr) * 1024 + n0 + n * 16 + fq * 4;
                    bf16_t* q = dry ? (bf16_t*)(p.ws + WS_DUMMY) + (qo & 0x7FFFF) : (bf16_t*)(p.ws + WS_XB) + qo;
                    const u32x2 xx = *(const u32x2*)q;
                    float4 v;
                    v.x = __uint_as_float(xx.x << 16) + acc[n][m][0]; v.y = __uint_as_float(xx.x & 0xffff0000u) + acc[n][m][1]; v.z = __uint_as_float(xx.y << 16) + acc[n][m][2]; v.w = __uint_as_float(xx.y & 0xffff0000u) + acc[n][m][3];
                    u32x2 w; w.x = pack2(v.x, v.y); w.y = pack2(v.z, v.w);
                    *(u32x2*)q = w;
                    ss += v.x * v.x + v.y * v.y + v.z * v.z + v.w * v.w;
                }
                ss += __shfl_xor(ss, 16); ss += __shfl_xor(ss, 32);
                if (fq == 0 && !dry) ssq[m0 + m * 16 + fr] = ss;
            }
        }
    }
}

DI int phase_moe_up(const P& p, int layer, char* lds) {
    const int tid = tidx(), wid = tid >> 6, lane = tid & 63, wr = wid >> 1, wc = wid & 1, fr = lane & 15, fq = lane >> 4;
    const unsigned* cntb = (const unsigned*)(p.ws + WS_CTL + CTL_CNT) + layer * 16 * 64;
    unsigned cnt[16];
#pragma unroll
    for (int e = 0; e < 16; ++e) cnt[e] = cntb[e * 64];
    const int* list = (const int*)(p.ws + WS_LIST);
    const float* gl = (const float*)(p.ws + WS_GATE);
    const bf16_t* hn = (const bf16_t*)(p.ws + WS_XB);
    const float* rsl = (const float*)(p.ws + WS_RSL);
    const bf16_t* W13 = (const bf16_t*)(moe_w(p, layer) + W_13);
    bf16_t* H = (bf16_t*)(p.ws + WS_H);
    int ttot = 0;
#pragma unroll
    for (int e = 0; e < 16; ++e) ttot += ((int)cnt[e] + 127) >> 7;
    const int ntiles = ttot * 4;
    auto locate = [&](int tile, int& e, int& lt, int& ce, int& rbe, int& tn) {
        const int mt = tile >> 2; tn = tile & 3;
        int tbe = 0, acc_t = 0; e = 0;
#pragma unroll
        for (int q = 0; q < 16; ++q) { const int nt = ((int)cnt[q] + 127) >> 7; if (mt >= acc_t) { e = q; tbe = acc_t; } acc_t += nt; }
        lt = mt - tbe; ce = (int)cnt[e]; rbe = tbe * 128;
    };
    auto fill = [&](TileP& t, int tile) {
        int e, lt, ce, rbe, tn; locate(tile, e, lt, ce, rbe, tn);
        const int r = tid >> 3;
#pragma unroll
        for (int i = 0; i < 4; ++i) {
            const int ii = lt * 128 + r + 32 * i;
            const int tk = ii < ce ? (list[e * 16384 + ii] >> 1) : 0;
            t.arow[i] = tk;
            t.bo[i] = (unsigned)(e * 512 + tn * 128 + r + 32 * i) * 2048u;
        }
    };
    const GOps gop{(const char*)hn, 2048u, (const char*)hn, 2048u, (const char*)W13};
    TileP cur, nxt;
    bool primed = false;
    fill(cur, bidx() < ntiles ? bidx() : 0); nxt = cur;
    for (int tile = bidx(); tile < ntiles; tile += gridDim.x) {
        int e, lt, ce, rbe, tn; locate(tile, e, lt, ce, rbe, tn);
        const bool have_next = tile + (int)gridDim.x < ntiles;
        if (have_next) fill(nxt, tile + gridDim.x);
        f32x4 acc[4][4];
        gemm_core(gop, cur, 1024, lds, acc, 1 << 30, primed, nxt, have_next);
        primed = have_next; cur = nxt;
#pragma unroll
        for (int m = 0; m < 4; ++m) {
            const int li = lt * 128 + wr * 64 + m * 16 + fr;
            if (li < ce) {
                const float g = gl[e * 16384 + li], rs = rsl[e * 16384 + li];
                bf16_t* hrow = H + (size_t)(rbe + li) * 256;
#pragma unroll
                for (int n = 0; n < 4; n += 2) {
                    float o[4];
#pragma unroll
                    for (int j = 0; j < 4; ++j) o[j] = siluf_(acc[n][m][j] * rs) * (acc[n + 1][m][j] * rs) * g;
                    const int f = tn * 64 + wc * 32 + (n >> 1) * 16 + fq * 4;
                    u32x2 w; w.x = pack2(o[0], o[1]); w.y = pack2(o[2], o[3]);
                    *(u32x2*)(hrow + f) = w;
                }
            }
        }
    }
    return ntiles;
}
DI void phase_moe_down(const P& p, int layer, char* lds) {
    const int tid = tidx(), wid = tid >> 6, lane = tid & 63, wr = wid >> 1, wc = wid & 1, fr = lane & 15, fq = lane >> 4;
    const unsigned* cntb = (const unsigned*)(p.ws + WS_CTL + CTL_CNT) + layer * 16 * 64;
    unsigned cnt[16];
#pragma unroll
    for (int e = 0; e < 16; ++e) cnt[e] = cntb[e * 64];
    const int* list = (const int*)(p.ws + WS_LIST);
    const bf16_t* W2 = (const bf16_t*)(moe_w(p, layer) + W_2);
    const bf16_t* H = (const bf16_t*)(p.ws + WS_H);
    bf16_t* ys = (bf16_t*)(p.ws + WS_YS);
    int ttot = 0;
#pragma unroll
    for (int e = 0; e < 16; ++e) ttot += ((int)cnt[e] + 127) >> 7;
    const int ntiles = ttot * 8;
    auto locate = [&](int tile, int& e, int& lt, int& ce, int& rbe, int& tn) {
        const int mt = tile >> 3; tn = tile & 7;
        int tbe = 0, acc_t = 0; e = 0;
#pragma unroll
        for (int q = 0; q < 16; ++q) { const int nt = ((int)cnt[q] + 127) >> 7; if (mt >= acc_t) { e = q; tbe = acc_t; } acc_t += nt; }
        lt = mt - tbe; ce = (int)cnt[e]; rbe = tbe * 128;
    };
    auto fill = [&](TileP& t, int tile) {
        int e, lt, ce, rbe, tn; locate(tile, e, lt, ce, rbe, tn);
        const int r = tid >> 3;
#pragma unroll
        for (int i = 0; i < 4; ++i) { t.arow[i] = rbe + lt * 128 + r + 32 * i; t.bo[i] = (unsigned)(e * 1024 + tn * 128 + r + 32 * i) * 512u; }
    };
    const GOps gop{(const char*)H, 512u, (const char*)H, 512u, (const char*)W2};
    TileP cur, nxt;
    bool primed = false;
    fill(cur, bidx() < ntiles ? bidx() : 0); nxt = cur;
    for (int tile = bidx(); tile < ntiles; tile += gridDim.x) {
        int e, lt, ce, rbe, tn; locate(tile, e, lt, ce, rbe, tn);
        const bool have_next = tile + (int)gridDim.x < ntiles;
        if (have_next) fill(nxt, tile + gridDim.x);
        f32x4 acc[4][4];
        gemm_core(gop, cur, 256, lds, acc, 1 << 30, primed, nxt, have_next);
        primed = have_next; cur = nxt;
#pragma unroll
        for (int m = 0; m < 4; ++m) {
            const int li = lt * 128 + wr * 64 + m * 16 + fr;
            if (li < ce) {
                const int ts = list[e * 16384 + li];
                bf16_t* yrow = ys + ((size_t)(ts & 1) * T + (ts >> 1)) * 1024 + tn * 128 + wc * 64 + fq * 4;
#pragma unroll
                for (int n = 0; n < 4; ++n) { u32x2 w; w.x = pack2(acc[n][m][0], acc[n][m][1]); w.y = pack2(acc[n][m][2], acc[n][m][3]); *(u32x2*)(yrow + n * 16) = w; }
            }
        }
    }
}


typedef float f32x16 __attribute__((ext_vector_type(16)));
DI f32x4 mfma16(bf16x8 a, bf16x8 b, f32x4 c) { return __builtin_amdgcn_mfma_f32_16x16x32_bf16(a, b, c, 0, 0, 0); }
DI f32x16 mfma32(bf16x8 a, bf16x8 b, f32x16 c) { return __builtin_amdgcn_mfma_f32_32x32x16_bf16(a, b, c, 0, 0, 0); }
DI f32x4 tile16(const char* X, int ldx, int row0, const char* Y, int ldy, int col0, int K) {
    const int lane = tidx() & 63, fr = lane & 15, fq = lane >> 4;
    const char* xp = X + (row0 + fr) * ldx + fq * 16; const char* yp = Y + (col0 + fr) * ldy + fq * 16;
    bf16x8 a[4], b[4];
#pragma unroll
    for (int s = 0; s < 4; ++s) if (s * 32 < K) { a[s] = *(const bf16x8*)(xp + s * 64); b[s] = *(const bf16x8*)(yp + s * 64); }
    f32x4 acc = {0.f, 0.f, 0.f, 0.f};
#pragma unroll
    for (int s = 0; s < 4; ++s) if (s * 32 < K) acc = mfma16(a[s], b[s], acc);
    return acc;
}
DI bf16x8 pack_step(const f32x16& x, int s) {
    u32x4 r;
    r.x = pack2(x[8 * s + 0], x[8 * s + 1]); r.y = pack2(x[8 * s + 2], x[8 * s + 3]);
    r.z = pack2(x[8 * s + 4], x[8 * s + 5]); r.w = pack2(x[8 * s + 6], x[8 * s + 7]);
    return __builtin_bit_cast(bf16x8, r);
}

constexpr int GP_LF = 0, GP_T = 17408, GP_VEC = GP_T + 9216, GP_U = GP_VEC + 1024, GP_END = GP_U + 36864;
DI void gdn_prep_unit(const P& p, int li, int ch, char* lds) {
    const int tid = tidx(), lane = tid & 63, wid = tid >> 6, fr = lane & 15, fq = lane >> 4;
    const int h = ch & 3, n = (ch >> 2) & 63, b = ch >> 8;
    const int t0 = b * SEQ + n * 64;
    float* Lf = (float*)(lds + GP_LF);
    char* Trow = lds + GP_T;
    float* gcs = (float*)(lds + GP_VEC); float* egc = gcs + 64; float* bet = gcs + 128; float* ekd = gcs + 192;
    char* Qrow = lds + GP_U; char* Krow = Qrow + 17408; char* VbT = lds + GP_U; char* KbgT = VbT + 18432;
    const bf16_t* proj = (const bf16_t*)(p.ws + WS_PROJ);
    unsigned char* ops = p.ws + WS_GOPS + (size_t)ch * GOPS_CH;
    const float* cw = p.in[I_CONVW] + (size_t)li * 4 * 1536;
    const int c = tid >> 2, cq = tid & 3;
    __syncthreads();
    float* cwl = (float*)(lds + GP_END);
    for (int i = tid; i < 4 * 3 * 32; i += 256) {
        const int j = i / 96, r = i % 96, sl = r >> 5, q4 = (r & 31) * 4;
        *(f32x4*)(cwl + (j * 3 + sl) * 128 + q4) = *(const f32x4*)(cw + j * 1536 + sl * 512 + h * 128 + q4);
    }
    __syncthreads();
    unsigned vvp[16];
#pragma unroll 1
    for (int which = 0; which < 3; ++which) {
        const int col0 = which * 512 + h * 128 + cq * 32;
        u32x4 xin[4][4];
#pragma unroll
        for (int j = 0; j < 4; ++j) {
            const int sp = n * 64 + c - 3 + j;
            const bf16_t* src = proj + (size_t)(b * SEQ + (sp < 0 ? 0 : sp)) * EVLD + col0;
#pragma unroll
            for (int i4 = 0; i4 < 4; ++i4) xin[j][i4] = *(const u32x4*)(src + i4 * 8);
        }
        float acc[32];
#pragma unroll
        for (int i = 0; i < 32; ++i) acc[i] = 0.f;
#pragma unroll
        for (int j = 0; j < 4; ++j) {
            const float ok = (n * 64 + c - 3 + j) >= 0 ? 1.f : 0.f;
            const float* wj = cwl + (j * 3 + which) * 128 + cq * 32;
#pragma unroll
            for (int i4 = 0; i4 < 4; ++i4) {
                const f32x4 wa = *(const f32x4*)(wj + i4 * 8), wb = *(const f32x4*)(wj + i4 * 8 + 4);
                const u32x4 w = xin[j][i4];
                acc[i4 * 8 + 0] += ok * wa[0] * __uint_as_float(w[0] << 16); acc[i4 * 8 + 1] += ok * wa[1] * __uint_as_float(w[0] & 0xffff0000u);
                acc[i4 * 8 + 2] += ok * wa[2] * __uint_as_float(w[1] << 16); acc[i4 * 8 + 3] += ok * wa[3] * __uint_as_float(w[1] & 0xffff0000u);
                acc[i4 * 8 + 4] += ok * wb[0] * __uint_as_float(w[2] << 16); acc[i4 * 8 + 5] += ok * wb[1] * __uint_as_float(w[2] & 0xffff0000u);
                acc[i4 * 8 + 6] += ok * wb[2] * __uint_as_float(w[3] << 16); acc[i4 * 8 + 7] += ok * wb[3] * __uint_as_float(w[3] & 0xffff0000u);
            }
        }
        float ss = 0.f;
#pragma unroll
        for (int i = 0; i < 32; ++i) { acc[i] = siluf_(acc[i]); ss += acc[i] * acc[i]; }
        ss += __shfl_xor(ss, 1); ss += __shfl_xor(ss, 2);
        const float rn = which == 2 ? 1.f : rsqrtf(ss + 1e-6f) * (which == 0 ? 0.08838834764831845f : 1.f);
        unsigned pk[16];
#pragma unroll
        for (int i = 0; i < 16; ++i) pk[i] = pack2(acc[2 * i] * rn, acc[2 * i + 1] * rn);
        if (which < 2) {
            char* img = which == 0 ? Qrow : Krow;
#pragma unroll
            for (int i4 = 0; i4 < 4; ++i4) { u32x4 w; w.x = pk[i4 * 4]; w.y = pk[i4 * 4 + 1]; w.z = pk[i4 * 4 + 2]; w.w = pk[i4 * 4 + 3]; *(u32x4*)(img + c * 272 + (cq * 32 + i4 * 8) * 2) = w; }
        } else {
#pragma unroll
            for (int i = 0; i < 16; ++i) vvp[i] = pk[i];
        }
    }
    if (cq == 0) {
        const float a = bf2f(proj[(size_t)(t0 + c) * EVLD + 2048 + h]);
        const float bb = bf2f(proj[(size_t)(t0 + c) * EVLD + 2052 + h]);
        const float Aexp = __expf(p.in[I_ALOG][li * 4 + h]), dtb = p.in[I_DTB][li * 4 + h];
        gcs[c] = -Aexp * softplusf_(a + dtb);
        bet[c] = sigmoidf_(bb);
    }
    __syncthreads();
    if (wid == 0) {
        float x = gcs[lane];
#pragma unroll
        for (int o = 1; o < 64; o <<= 1) { const float y = __shfl_up(x, o); if (lane >= o) x += y; }
        const float gl = __shfl(x, 63);
        gcs[lane] = x; egc[lane] = __expf(x); ekd[lane] = __expf(gl - x);
        if (lane == 63) ((float*)(p.ws + WS_CTL + CTL_EGL))[ch] = __expf(gl);
    }
    __syncthreads();
    {
        const int ti = wid;
#pragma unroll
        for (int tj = 0; tj < 4; ++tj) {
            if (tj <= ti) {
                const f32x4 kk = tile16(Krow, 272, 16 * ti, Krow, 272, 16 * tj, 128);
                const int c2 = 16 * tj + fr;
                f32x4 lv;
#pragma unroll
                for (int r = 0; r < 4; ++r) {
                    const int c1 = 16 * ti + fq * 4 + r;
                    lv[r] = (c1 > c2) ? bet[c1] * kk[r] * __expf(gcs[c1] - gcs[c2]) : 0.f;
                }
                *(f32x4*)&Lf[c2 * 68 + 16 * ti + fq * 4] = lv;
            }
            f32x4 qk = {0.f, 0.f, 0.f, 0.f};
            if (tj <= ti) qk = tile16(Krow, 272, 16 * tj, Qrow, 272, 16 * ti, 128);
            const int c1 = 16 * ti + fr;
            float o4[4];
#pragma unroll
            for (int r = 0; r < 4; ++r) { const int c2 = 16 * tj + fq * 4 + r; o4[r] = (c1 >= c2) ? qk[r] * __expf(gcs[c1] - gcs[c2]) : 0.f; }
            const int mt = c1 >> 5, rr = c1 & 31, hh = fq & 1, jg = fq >> 1;
            u32x2 w; w.x = pack2(o4[0], o4[1]); w.y = pack2(o4[2], o4[3]);
            *(u32x2*)(ops + GO_AF + ((size_t)((mt * 4 + tj) * 64 + hh * 32 + rr) * 8 + jg * 4) * 2) = w;
        }
#pragma unroll
        for (int i = 0; i < 4; ++i) {
            const int idx = tid + i * 256;
            {
                const int mt = idx >> 9, ks = (idx >> 6) & 7, l2 = idx & 63, rr = l2 & 31, hh = l2 >> 5, cc = 32 * mt + rr;
                const float sc = egc[cc];
                const u32x2 lo = *(const u32x2*)(Qrow + cc * 272 + (16 * ks + 4 * hh) * 2), hi = *(const u32x2*)(Qrow + cc * 272 + (16 * ks + 8 + 4 * hh) * 2);
                u32x4 w;
                w.x = pack2(__uint_as_float(lo.x << 16) * sc, __uint_as_float(lo.x & 0xffff0000u) * sc); w.y = pack2(__uint_as_float(lo.y << 16) * sc, __uint_as_float(lo.y & 0xffff0000u) * sc);
                w.z = pack2(__uint_as_float(hi.x << 16) * sc, __uint_as_float(hi.x & 0xffff0000u) * sc); w.w = pack2(__uint_as_float(hi.y << 16) * sc, __uint_as_float(hi.y & 0xffff0000u) * sc);
                *(u32x4*)(ops + GO_QF + (size_t)idx * 16) = w;
            }
            {
                const int mt = idx >> 8, ks = (idx >> 6) & 3, l2 = idx & 63, rr = l2 & 31, hh = l2 >> 5, dk = 32 * mt + rr;
                float e8[8];
#pragma unroll
                for (int j = 0; j < 8; ++j) { const int c2 = 16 * ks + 8 * (j >> 2) + 4 * hh + (j & 3); e8[j] = bf2f(*(const bf16_t*)(Krow + c2 * 272 + dk * 2)) * ekd[c2]; }
                u32x4 w; w.x = pack2(e8[0], e8[1]); w.y = pack2(e8[2], e8[3]); w.z = pack2(e8[4], e8[5]); w.w = pack2(e8[6], e8[7]);
                *(u32x4*)(ops + GO_KF + (size_t)idx * 16) = w;
            }
        }
    }
    __syncthreads();
    {
        const float bc = bet[c], bg = bc * egc[c];
        unsigned kvp[16];
#pragma unroll
        for (int i4 = 0; i4 < 4; ++i4) { const u32x4 w = *(const u32x4*)(Krow + c * 272 + (cq * 32 + i4 * 8) * 2); kvp[i4 * 4] = w.x; kvp[i4 * 4 + 1] = w.y; kvp[i4 * 4 + 2] = w.z; kvp[i4 * 4 + 3] = w.w; }
        __syncthreads();
#pragma unroll
        for (int i = 0; i < 16; ++i) {
            *(bf16_t*)(VbT + (cq * 32 + 2 * i) * 144 + c * 2) = f2bf(__uint_as_float(vvp[i] << 16) * bc);
            *(bf16_t*)(VbT + (cq * 32 + 2 * i + 1) * 144 + c * 2) = f2bf(__uint_as_float(vvp[i] & 0xffff0000u) * bc);
            *(bf16_t*)(KbgT + (cq * 32 + 2 * i) * 144 + c * 2) = f2bf(__uint_as_float(kvp[i] << 16) * bg);
            *(bf16_t*)(KbgT + (cq * 32 + 2 * i + 1) * 144 + c * 2) = f2bf(__uint_as_float(kvp[i] & 0xffff0000u) * bg);
        }
    }
    {
        char* L21i = lds + GP_END;
        char* T11T = L21i + 2560;
        char* MT = T11T + 2560;
        if (wid < 2) {
            const int o = 32 * wid;
            float Tc[32];
#pragma unroll
            for (int i = 0; i < 32; ++i) Tc[i] = (i == (lane & 31)) ? 1.f : 0.f;
#pragma unroll
            for (int j = 0; j < 31; ++j) {
                const float tj = Tc[j];
#pragma unroll
                for (int i4 = (j + 1) >> 2; i4 < 8; ++i4) {
                    const f32x4 l4 = *(const f32x4*)&Lf[(o + j) * 68 + o + i4 * 4];
#pragma unroll
                    for (int e = 0; e < 4; ++e) if (i4 * 4 + e > j) Tc[i4 * 4 + e] -= l4[e] * tj;
                }
            }
            if (lane < 32) {
#pragma unroll
                for (int i = 0; i < 32; ++i) *(bf16_t*)(Trow + (o + i) * 144 + (o + lane) * 2) = f2bf(Tc[i]);
                if (wid == 0) {
#pragma unroll
                    for (int i = 0; i < 32; ++i) *(bf16_t*)(Trow + i * 144 + (32 + lane) * 2) = 0;
#pragma unroll
                    for (int i4 = 0; i4 < 8; ++i4) { u32x2 w; w.x = pack2(Tc[i4 * 4], Tc[i4 * 4 + 1]); w.y = pack2(Tc[i4 * 4 + 2], Tc[i4 * 4 + 3]); *(u32x2*)(T11T + lane * 80 + i4 * 8) = w; }
                }
            }
        } else {
            const int t2 = tid - 128;
#pragma unroll
            for (int g2 = 0; g2 < 2; ++g2) {
                const int i = t2 & 31, k4 = ((t2 >> 5) + 4 * g2) * 4;
                u32x2 w;
                w.x = pack2(Lf[(k4 + 0) * 68 + 32 + i], Lf[(k4 + 1) * 68 + 32 + i]); w.y = pack2(Lf[(k4 + 2) * 68 + 32 + i], Lf[(k4 + 3) * 68 + 32 + i]);
                *(u32x2*)(L21i + i * 80 + k4 * 2) = w;
            }
        }
        __syncthreads();
        {
            const int r0 = 16 * (wid >> 1), c0 = 16 * (wid & 1);
            const f32x4 mm = tile16(L21i, 80, r0, T11T, 80, c0, 32);
            u32x2 w; w.x = pack2(mm[0], mm[1]); w.y = pack2(mm[2], mm[3]);
            *(u32x2*)(MT + (c0 + fr) * 80 + (r0 + 4 * fq) * 2) = w;
        }
        __syncthreads();
        {
            const int r0 = 16 * (wid >> 1), c0 = 16 * (wid & 1);
            const f32x4 tt = tile16(MT, 80, c0, Trow + 32 * 144 + 64, 144, r0, 32);
            u32x2 w; w.x = pack2(-tt[0], -tt[1]); w.y = pack2(-tt[2], -tt[3]);
            *(u32x2*)(Trow + (32 + r0 + fr) * 144 + (c0 + 4 * fq) * 2) = w;
        }
    }
    __syncthreads();
#pragma unroll
    for (int tq = 0; tq < 2; ++tq) {
        const int tj = wid * 2 + tq;
#pragma unroll
        for (int ti = 0; ti < 4; ++ti) {
            const f32x4 u = tile16(Trow, 144, 16 * ti, VbT, 144, 16 * tj, 64);
            {
                const int dv = 16 * tj + fr, slice = dv >> 5, rr = dv & 31, cb = 16 * ti + fq * 4, mt = cb >> 5, q4 = (cb & 31) >> 2, hh = q4 & 1, rg = q4 >> 1;
                u32x2 w; w.x = pack2(u[0], u[1]); w.y = pack2(u[2], u[3]);
                *(u32x2*)(ops + GO_UF + ((size_t)((slice * 2 + mt) * 64 + hh * 32 + rr) * 16 + rg * 4) * 2) = w;
            }
            const f32x4 wv = tile16(KbgT, 144, 16 * tj, Trow, 144, 16 * ti, 64);
            {
                const int c1 = 16 * ti + fr, mt = c1 >> 5, rr = c1 & 31, hh = fq & 1, jg = fq >> 1;
                u32x2 w; w.x = pack2(-wv[0], -wv[1]); w.y = pack2(-wv[2], -wv[3]);
                *(u32x2*)(ops + GO_WF + ((size_t)((mt * 8 + tj) * 64 + hh * 32 + rr) * 8 + jg * 4) * 2) = w;
            }
        }
    }
}

DI void glds16(const void* g, char* l) { __builtin_amdgcn_global_load_lds((const unsigned*)g, (lds_u32*)l, 16, 0, 0); }
DI void fr_rd(bf16x8& f, unsigned addr) { asm volatile("ds_read_b128 %0, %1" : "=v"(f) : "v"(addr) : "memory"); }
template <int N> DI void fr_wait(bf16x8& f) { asm volatile("s_waitcnt lgkmcnt(%1)" : "+v"(f) : "n"(N) : "memory"); }
template <int REM> DI void fr_waitc(bf16x8& f) { if (REM >= 3) fr_wait<3>(f); else if (REM == 2) fr_wait<2>(f); else if (REM == 1) fr_wait<1>(f); else fr_wait<0>(f); }
#define GS_WAIT(n) asm volatile("s_waitcnt vmcnt(" #n ")" ::: "memory")
DI void gdn_scan_block(const P& p, int bh, char* lds, bool dry = false) {
    const int tid = tidx(), lane = tid & 63, w = tid >> 6;
    const int h = bh & 3, b = bh >> 2;
    const float eglv = ((const float*)(p.ws + WS_CTL + CTL_EGL))[(b * 64 + lane) * 4 + h];
    unsigned char* gbase = p.ws + WS_GOPS + (size_t)(b * 256 + h) * GOPS_CH;
    auto issue = [&](int n, int k0, int cntk) {
        for (int k = k0; k < k0 + cntk; ++k) {
            const unsigned char* src = gbase + (size_t)n * 4 * GOPS_CH + k * 8192 + tid * 16;
            char* dst = lds + k * 8192 + tid * 16;
            glds16(src, dst); glds16(src + 4096, dst + 4096);
        }
    };
    const unsigned la = (unsigned)(size_t)(lds_u32*)lds + lane * 16;
    f32x16 S[4];
#pragma unroll
    for (int i = 0; i < 4; ++i)
#pragma unroll
        for (int r = 0; r < 16; ++r) S[i][r] = 0.f;
    __syncthreads();
    issue(0, 0, 7);
#pragma unroll 1
    for (int n = 0; n < 64; ++n) {
        const float egl = __shfl(eglv, n);
        bf16x8 Sb[8];
#pragma unroll
        for (int i = 0; i < 4; ++i) { Sb[i * 2] = pack_step(S[i], 0); Sb[i * 2 + 1] = pack_step(S[i], 1); }
        f32x16 av[2], ao[2];
        GS_WAIT(6);
        __builtin_amdgcn_s_barrier();
        issue(n, 7, 2);
        __builtin_amdgcn_sched_barrier(0);
        {
            const char* sl = lds + (w >> 1) * 8192;
#pragma unroll
            for (int mt = 0; mt < 2; ++mt) {
                const u32x4* up = (const u32x4*)(sl + ((w & 1) * 2 + mt) * 2048 + lane * 32);
                const u32x4 u0 = up[0], u1 = up[1];
#pragma unroll
                for (int e = 0; e < 4; ++e) {
                    av[mt][e * 2] = __uint_as_float(u0[e] << 16); av[mt][e * 2 + 1] = __uint_as_float(u0[e] & 0xffff0000u);
                    av[mt][8 + e * 2] = __uint_as_float(u1[e] << 16); av[mt][8 + e * 2 + 1] = __uint_as_float(u1[e] & 0xffff0000u);
                }
            }
        }
        bf16x8 F[4];
#define GS_O0(j) (unsigned)((2 + ((j) & 1)) * 8192 + ((j) >> 1) * 1024)
#pragma unroll
        for (int j = 0; j < 4; ++j) fr_rd(F[j], la + GS_O0(j));
#pragma unroll
        for (int j = 0; j < 16; ++j) {
            if (j <= 12) fr_wait<3>(F[j & 3]); else if (j == 13) fr_wait<2>(F[j & 3]); else if (j == 14) fr_wait<1>(F[j & 3]); else fr_wait<0>(F[j & 3]);
            av[j & 1] = mfma32(F[j & 3], Sb[j >> 1], av[j & 1]);
            if (j + 4 < 16) fr_rd(F[j & 3], la + GS_O0(j + 4));
        }
        bf16x8 Vb[4];
#pragma unroll
        for (int mt = 0; mt < 2; ++mt) { Vb[mt * 2] = pack_step(av[mt], 0); Vb[mt * 2 + 1] = pack_step(av[mt], 1); }
        GS_WAIT(4);
        __builtin_amdgcn_s_barrier();
        if (n < 63) issue(n + 1, 0, 4);
        __builtin_amdgcn_sched_barrier(0);
#pragma unroll
        for (int mt = 0; mt < 2; ++mt)
#pragma unroll
            for (int r = 0; r < 16; ++r) ao[mt][r] = 0.f;
#define GS_O1(j) (unsigned)((j) < 16 ? (4 + ((j) & 1)) * 8192 + ((j) >> 1) * 1024 : 6 * 8192 + ((j) == 16 ? 0 : (j) == 17 ? 4 : (j) == 18 ? 1 : (j) == 19 ? 5 : (j) == 20 ? 6 : 7) * 1024)
#pragma unroll
        for (int j = 0; j < 4; ++j) fr_rd(F[j], la + GS_O1(j));
#pragma unroll
        for (int j = 0; j < 22; ++j) {
            if (j <= 18) fr_wait<3>(F[j & 3]); else if (j == 19) fr_wait<2>(F[j & 3]); else if (j == 20) fr_wait<1>(F[j & 3]); else fr_wait<0>(F[j & 3]);
            if (j < 16) {
                ao[j & 1] = mfma32(F[j & 3], Sb[j >> 1], ao[j & 1]);
                if (j & 1) {
                    const int ks = j >> 1;
#pragma unroll
                    for (int r = 0; r < 8; ++r) S[ks >> 1][(ks & 1) * 8 + r] *= egl;
                }
            } else {
                const int oi = (j == 16 || j == 18) ? 0 : 1, kv = j <= 17 ? 0 : j <= 19 ? 1 : j == 20 ? 2 : 3;
                ao[oi] = mfma32(F[j & 3], Vb[kv], ao[oi]);
            }
            if (j + 4 < 22) fr_rd(F[j & 3], la + GS_O1(j + 4));
        }
        if (n < 63) GS_WAIT(8); else GS_WAIT(0);
        __builtin_amdgcn_s_barrier();
        if (n < 63) issue(n + 1, 4, 3);
        __builtin_amdgcn_sched_barrier(0);
#define GS_O2(j) (unsigned)((7 + (((j) & 3) >> 1)) * 8192 + ((((j) & 3) & 1) * 4 + ((j) >> 2)) * 1024)
#pragma unroll
        for (int j = 0; j < 4; ++j) fr_rd(F[j], la + GS_O2(j));
#pragma unroll
        for (int j = 0; j < 16; ++j) {
            if (j <= 12) fr_wait<3>(F[j & 3]); else if (j == 13) fr_wait<2>(F[j & 3]); else if (j == 14) fr_wait<1>(F[j & 3]); else fr_wait<0>(F[j & 3]);
            S[j & 3] = mfma32(F[j & 3], Vb[j >> 2], S[j & 3]);
            if (j + 4 < 16) fr_rd(F[j & 3], la + GS_O2(j + 4));
        }
        {
            u32x4* Of = (u32x4*)((dry ? p.ws + WS_DUMMY + (size_t)(bh & 15) * 65536 : gbase + (size_t)n * 4 * GOPS_CH) + GO_UF) + (size_t)(w * 2 * 64 + lane) * 2;
#pragma unroll
            for (int mt = 0; mt < 2; ++mt) {
                u32x4 o0, o1;
#pragma unroll
                for (int e = 0; e < 4; ++e) { o0[e] = pack2(ao[mt][e * 2], ao[mt][e * 2 + 1]); o1[e] = pack2(ao[mt][8 + e * 2], ao[mt][8 + e * 2 + 1]); }
                Of[mt * 128] = o0; Of[mt * 128 + 1] = o1;
            }
        }
    }
    __syncthreads();
}

DI void gdn_post_unit(const P& p, int li, int ch) {
    const int tid = tidx();
    const int h = ch & 3, n = (ch >> 2) & 63, b = ch >> 8;
    const int t0 = b * SEQ + n * 64;
    const int c = tid >> 2, cq = tid & 3;
    const bf16_t* Of = (const bf16_t*)(p.ws + WS_GOPS + (size_t)ch * GOPS_CH + GO_UF);
    const bf16_t* proj = (const bf16_t*)(p.ws + WS_PROJ);
    bf16_t* mix = (bf16_t*)(p.ws + WS_PROJ);
    const float* nw = p.in[I_GDNNORM] + li * 128 + cq * 32;
    const int mt = c >> 5, q4 = (c & 31) >> 2, hh = q4 & 1, rg = q4 >> 1, reg = rg * 4 + (c & 3);
    float o[32]; float ss = 0.f;
#pragma unroll
    for (int r = 0; r < 32; ++r) { o[r] = bf2f(Of[(size_t)((cq * 2 + mt) * 64 + hh * 32 + r) * 16 + reg]); ss += o[r] * o[r]; }
    ss += __shfl_xor(ss, 1); ss += __shfl_xor(ss, 2);
    const float rs = rsqrtf(ss * (1.f / 128.f) + 1e-6f);
    const bf16_t* zp = proj + (size_t)(t0 + c) * EVLD + 1536 + h * 128 + cq * 32;
    bf16_t* mp = mix + (size_t)(t0 + c) * EVLD + h * 128 + cq * 32;
#pragma unroll
    for (int i4 = 0; i4 < 4; ++i4) {
        const u32x4 zw = *(const u32x4*)(zp + i4 * 8);
        u32x4 w;
#pragma unroll
        for (int e = 0; e < 4; ++e) {
            const float z0 = __uint_as_float(zw[e] << 16), z1 = __uint_as_float(zw[e] & 0xffff0000u);
            w[e] = pack2(o[i4 * 8 + e * 2] * rs * nw[i4 * 8 + e * 2] * siluf_(z0), o[i4 * 8 + e * 2 + 1] * rs * nw[i4 * 8 + e * 2 + 1] * siluf_(z1));
        }
        *(u32x4*)(mp + i4 * 8) = w;
    }
}


constexpr int RP_Z0 = 0, RP_Z1 = 18432, RP_Z2 = 55296, RP_VEC = 73728, RP_PT = 75008, RP_T11 = 78080, RP_END = 80640;
constexpr int RP_LIN = 0, RP_LW = 25600;
DI void rwkv_prep_unit(const P& p, int li, int ch, char* lds) {
    const int tid = tidx(), lane = tid & 63, wid = tid >> 6, fr = lane & 15, fq = lane >> 4;
    const int h = ch & 7, n = (ch >> 3) & 63, b = ch >> 9;
    const int t0 = b * SEQ + n * 64;
    const bf16_t* proj = (const bf16_t*)(p.ws + WS_PROJ);
    char* Lfc = lds + RP_Z0; float* Lf = (float*)Lfc;
    char* ApT = lds + RP_Z0; char* AkVT = lds + RP_Z0 + 9216;
    char* Arow = lds + RP_Z1; char* Rrow = Arow + 9216; char* Brow = Arow + 18432; char* Krow = Arow + 27648;
    char* Aak = Arow; char* Arb = Rrow; char* Ark = Brow; char* Trow = Krow; char* BhT = Krow; char* VpT = Aak;
    char* AT = lds + RP_Z2; char* VT = AT + 9216; char* KhT = AT;
    float* tot = (float*)(lds + RP_VEC); float* WC = tot + 256;
    char* lin = lds + RP_LIN; char* LWi = lds + RP_LW;
    float* PT = (float*)(lds + RP_PT);
    {
        const float* mu0 = p.in[I_MU] + (size_t)li * 1696;
        if (tid < 48) {
            const int j0 = tid * 4;
            *(float4*)(PT + j0) = j0 < 160 ? *(const float4*)(mu0 + (C_HW - RW0) + j0) : *(const float4*)(p.in[I_VRESMU] + j0 - 160);
        } else if (tid < 48 + 144) {
            const int q = tid - 48, arr = q >> 4, c4 = (q & 15) * 4, chn = h * 64 + c4;
            const float* src = arr == 0 ? mu0 + (C_R - RW0) + chn : arr == 1 ? mu0 + (C_K - RW0) + chn : arr == 2 ? mu0 + (C_V - RW0) + chn
                             : arr == 3 ? p.in[I_W0] + li * 512 + chn : arr == 4 ? p.in[I_A0] + li * 512 + chn : arr == 5 ? p.in[I_V0] + chn
                             : arr == 6 ? p.in[I_KK] + li * 512 + chn : arr == 7 ? p.in[I_KA] + li * 512 + chn : p.in[I_RK] + li * 512 + chn;
            *(float4*)(PT + 192 + arr * 64 + c4) = *(const float4*)src;
        }
    }
    __syncthreads();
    {
        const int c = tid >> 2, cq = tid & 3, s = n * 64 + c;
        const bf16_t* cur = proj + (size_t)(t0 + c) * EVLD + C_HW + cq * 48;
        const float* mu = p.in[I_MU] + (size_t)li * 1696 + (C_HW - RW0);
        const float* vmu = p.in[I_VRESMU];
#pragma unroll
        for (int i6 = 0; i6 < 6; ++i6) {
            const u32x4 cw4 = *(const u32x4*)(cur + i6 * 8);
            u32x4 pw4 = *(const u32x4*)(cur - (s > 0 ? EVLD : 0) + i6 * 8);
            if (s == 0) pw4 = (u32x4){0u, 0u, 0u, 0u};
            const int j0 = cq * 48 + i6 * 8;
            const float4 ma = *(const float4*)(PT + j0), mb = *(const float4*)(PT + j0 + 4);
            const float mm[8] = {ma.x, ma.y, ma.z, ma.w, mb.x, mb.y, mb.z, mb.w};
            const bool is_t = j0 < 32, is_s = (j0 >= 64) && (j0 < 160);
            const float ca = is_t ? 1.f : 0.f, cb = is_t ? -2.f : 1.f, cc = is_t ? 2.f : -1.f;
            u32x4 w;
#pragma unroll
            for (int e = 0; e < 4; ++e) {
                float o2[2];
#pragma unroll
                for (int q = 0; q < 2; ++q) {
                    const float cv = q ? __uint_as_float(cw4[e] & 0xffff0000u) : __uint_as_float(cw4[e] << 16);
                    const float pv = q ? __uint_as_float(pw4[e] & 0xffff0000u) : __uint_as_float(pw4[e] << 16);
                    const float val = cv + mm[e * 2 + q] * (pv - cv);
                    const float act = ca + cb * __builtin_amdgcn_rcpf(1.f + __expf(cc * val));
                    o2[q] = (is_t || is_s) ? act : val;
                }
                w[e] = pack2(o2[0], o2[1]);
            }
            *(u32x4*)(lin + c * 400 + (cq * 48 + i6 * 8) * 2) = w;
        }
        const bf16_t* LW = (const bf16_t*)(p.ws + WS_W + W_LW) + (size_t)h * 64 * 192;
#pragma unroll
        for (int i6 = 0; i6 < 6; ++i6) *(u32x4*)(LWi + c * 400 + (cq * 48 + i6 * 8) * 2) = *(const u32x4*)(LW + (size_t)c * 192 + cq * 48 + i6 * 8);
    }
    __syncthreads();
    float lw_[16], la_[16], lg_[16], lv_[16];
#pragma unroll
    for (int tj = 0; tj < 4; ++tj) {
        const f32x4 a = tile16(LWi, 400, 16 * tj, lin, 400, 16 * wid, 32);
        const f32x4 bq = tile16(LWi + 64, 400, 16 * tj, lin + 64, 400, 16 * wid, 32);
        const f32x4 cg = tile16(LWi + 128, 400, 16 * tj, lin + 128, 400, 16 * wid, 96);
        const f32x4 dv = tile16(LWi + 320, 400, 16 * tj, lin + 320, 400, 16 * wid, 32);
#pragma unroll
        for (int r = 0; r < 4; ++r) { lw_[tj * 4 + r] = a[r]; la_[tj * 4 + r] = bq[r]; lg_[tj * 4 + r] = cg[r]; lv_[tj * 4 + r] = dv[r]; }
    }
    __syncthreads();
    const int c = 16 * wid + fr;
    float at[16], rt[16], bt[16], kt[16], bh[16], kh[16];
    {
        const int s = n * 64 + c;
        const size_t row = (size_t)(t0 + c);
        const float* mu = p.in[I_MU] + (size_t)li * 1696;
        const int hc = h * 64;
        float rr_[16], kk_[16], lwv[16], aa[16];
        float kn = 0.f, rk = 0.f;
        bf16_t* vf = (bf16_t*)(p.ws + WS_VF);
        bf16_t* gg = (bf16_t*)(p.ws + WS_GG);
#pragma unroll
        for (int tj = 0; tj < 4; ++tj) {
            const int cb = 16 * tj + 4 * fq;
            u32x2 cr = *(const u32x2*)(proj + row * EVLD + C_R + hc + cb), ck = *(const u32x2*)(proj + row * EVLD + C_K + hc + cb), cv = *(const u32x2*)(proj + row * EVLD + C_V + hc + cb);
            const size_t prow = s > 0 ? row - 1 : row;
            u32x2 pr = *(const u32x2*)(proj + prow * EVLD + C_R + hc + cb), pk = *(const u32x2*)(proj + prow * EVLD + C_K + hc + cb), pv = *(const u32x2*)(proj + prow * EVLD + C_V + hc + cb);
            if (s == 0) { pr = (u32x2){0u, 0u}; pk = pr; pv = pr; }
            u32x2 vfw = {0u, 0u};
            if (li == 1) vfw = *(const u32x2*)(vf + row * 512 + hc + cb);
            float vout[4], gout[4];
            const int ch0 = hc + cb;
            const float* pt = PT + 192 + cb;
            const float4 mu_r4 = *(const float4*)(pt), mu_k4 = *(const float4*)(pt + 64), mu_v4 = *(const float4*)(pt + 128);
            const float4 w0_4 = *(const float4*)(pt + 192), a0_4 = *(const float4*)(pt + 256), v0_4 = *(const float4*)(pt + 320);
            const float4 kk_4 = *(const float4*)(pt + 384), ka_4 = *(const float4*)(pt + 448), rk_4 = *(const float4*)(pt + 512);
            const float mur[4] = {mu_r4.x, mu_r4.y, mu_r4.z, mu_r4.w}, muk[4] = {mu_k4.x, mu_k4.y, mu_k4.z, mu_k4.w}, muv[4] = {mu_v4.x, mu_v4.y, mu_v4.z, mu_v4.w};
            const float w0v[4] = {w0_4.x, w0_4.y, w0_4.z, w0_4.w}, a0v[4] = {a0_4.x, a0_4.y, a0_4.z, a0_4.w}, v0v[4] = {v0_4.x, v0_4.y, v0_4.z, v0_4.w};
            const float kkp[4] = {kk_4.x, kk_4.y, kk_4.z, kk_4.w}, kap[4] = {ka_4.x, ka_4.y, ka_4.z, ka_4.w}, rkp[4] = {rk_4.x, rk_4.y, rk_4.z, rk_4.w};
#pragma unroll
            for (int r = 0; r < 4; ++r) {
                const int i = tj * 4 + r;
                const unsigned wcr = r < 2 ? cr.x : cr.y, wck = r < 2 ? ck.x : ck.y, wcv = r < 2 ? cv.x : cv.y;
                const unsigned wpr = r < 2 ? pr.x : pr.y, wpk = r < 2 ? pk.x : pk.y, wpv = r < 2 ? pv.x : pv.y, wvf = r < 2 ? vfw.x : vfw.y;
                const float c_r = (r & 1) ? __uint_as_float(wcr & 0xffff0000u) : __uint_as_float(wcr << 16);
                const float c_k = (r & 1) ? __uint_as_float(wck & 0xffff0000u) : __uint_as_float(wck << 16);
                const float c_v = (r & 1) ? __uint_as_float(wcv & 0xffff0000u) : __uint_as_float(wcv << 16);
                const float p_r = (r & 1) ? __uint_as_float(wpr & 0xffff0000u) : __uint_as_float(wpr << 16);
                const float p_k = (r & 1) ? __uint_as_float(wpk & 0xffff0000u) : __uint_as_float(wpk << 16);
                const float p_v = (r & 1) ? __uint_as_float(wpv & 0xffff0000u) : __uint_as_float(wpv << 16);
                const float rm = c_r + mur[r] * (p_r - c_r);
                const float km = c_k + muk[r] * (p_k - c_k);
                float vm = c_v + muv[r] * (p_v - c_v);
                const float wlog = -softplusf_(-(w0v[r] + lw_[i])) - 0.5f;
                lwv[i] = -__expf(wlog);
                const float a = sigmoidf_(a0v[r] + la_[i]);
                if (li == 1) {
                    const float v1 = (r & 1) ? __uint_as_float(wvf & 0xffff0000u) : __uint_as_float(wvf << 16);
                    vm = vm + (v1 - vm) * sigmoidf_(v0v[r] + lv_[i]);
                }
                const float kkv = km * kkp[r];
                kn += kkv * kkv;
                rr_[i] = rm; kk_[i] = kkv; aa[i] = a;
                kt[i] = km * (1.f + (a - 1.f) * kap[r]);
                rk += rm * kt[i] * rkp[r];
                vout[r] = vm; gout[r] = lg_[i];
            }
            u32x2 w; w.x = pack2(vout[0], vout[1]); w.y = pack2(vout[2], vout[3]);
            *(u32x2*)(vf + row * 512 + hc + cb) = w;
            w.x = pack2(gout[0], gout[1]); w.y = pack2(gout[2], gout[3]);
            *(u32x2*)(gg + row * 512 + hc + cb) = w;
#pragma unroll
            for (int r = 0; r < 4; ++r) *(bf16_t*)(VT + (cb + r) * 144 + c * 2) = f2bf(vout[r]);
            __builtin_amdgcn_sched_barrier(0);
        }
        kn += __shfl_xor(kn, 16); kn += __shfl_xor(kn, 32);
        const float kr = rsqrtf(kn + 1e-6f);
        rk += __shfl_xor(rk, 16); rk += __shfl_xor(rk, 32);
        if (fq == 0) ((float*)(p.ws + WS_RK))[row * 8 + h] = rk;
        float cs[16];
#pragma unroll
        for (int i = 0; i < 16; ++i) {
            float x = lwv[i];
#pragma unroll
            for (int o = 1; o < 16; o <<= 1) { const float y = __shfl_up(x, o, 16); if (fr >= o) x += y; }
            cs[i] = x;
        }
        if (fr == 15) {
#pragma unroll
            for (int i = 0; i < 16; ++i) tot[wid * 64 + 16 * (i >> 2) + 4 * fq + (i & 3)] = cs[i];
        }
        __syncthreads();
#pragma unroll
        for (int i = 0; i < 16; ++i) {
            const int chl = 16 * (i >> 2) + 4 * fq + (i & 3);
            float pre = 0.f, all = 0.f;
#pragma unroll
            for (int w2 = 0; w2 < 4; ++w2) { const float tv = tot[w2 * 64 + chl]; all += tv; if (w2 < wid) pre += tv; }
            const float csi = cs[i] + pre, csm = csi - lwv[i];
            const float kkn = kk_[i] * kr, k2 = kt[i];
            const float e_c = __expf(csi), e_n = __builtin_amdgcn_rcpf(e_c), e_m = __expf(csm), e_h = __expf(all) * e_n;
            at[i] = -kkn * e_m; rt[i] = rr_[i] * e_c;
            const float bp = kkn * aa[i];
            bt[i] = bp * e_n; kt[i] = k2 * e_n; bh[i] = bp * e_h; kh[i] = k2 * e_h;
            if (c == 0) WC[chl] = __expf(all);
            if ((i & 3) == 3) __builtin_amdgcn_sched_barrier(0);
        }
    }
#pragma unroll
    for (int tj = 0; tj < 4; ++tj) {
        const int cb = 16 * tj + 4 * fq;
        u32x2 w;
        w.x = pack2(at[tj * 4], at[tj * 4 + 1]); w.y = pack2(at[tj * 4 + 2], at[tj * 4 + 3]); *(u32x2*)(Arow + c * 144 + cb * 2) = w;
        w.x = pack2(rt[tj * 4], rt[tj * 4 + 1]); w.y = pack2(rt[tj * 4 + 2], rt[tj * 4 + 3]); *(u32x2*)(Rrow + c * 144 + cb * 2) = w;
        w.x = pack2(bt[tj * 4], bt[tj * 4 + 1]); w.y = pack2(bt[tj * 4 + 2], bt[tj * 4 + 3]); *(u32x2*)(Brow + c * 144 + cb * 2) = w;
        w.x = pack2(kt[tj * 4], kt[tj * 4 + 1]); w.y = pack2(kt[tj * 4 + 2], kt[tj * 4 + 3]); *(u32x2*)(Krow + c * 144 + cb * 2) = w;
#pragma unroll
        for (int r = 0; r < 4; ++r) {
            *(bf16_t*)(AT + (cb + r) * 144 + c * 2) = f2bf(at[tj * 4 + r]);
        }
    }
    __syncthreads();
    f32x4 pab[4], pak[4], prb[4], prk[4];
    {
        const int ti = wid;
#pragma unroll
        for (int tj = 0; tj < 4; ++tj) {
            pab[tj] = (f32x4){0.f, 0.f, 0.f, 0.f}; pak[tj] = pab[tj]; prb[tj] = pab[tj]; prk[tj] = pab[tj];
            if (tj <= ti) {
                pab[tj] = tile16(Arow, 144, 16 * ti, Brow, 144, 16 * tj, 64);
                pak[tj] = tile16(Krow, 144, 16 * tj, Arow, 144, 16 * ti, 64);
                prb[tj] = tile16(Brow, 144, 16 * tj, Rrow, 144, 16 * ti, 64);
                prk[tj] = tile16(Krow, 144, 16 * tj, Rrow, 144, 16 * ti, 64);
            }
        }
    }
    __syncthreads();
    {
        const int ti = wid;
#pragma unroll
        for (int tj = 0; tj < 4; ++tj) {
            const int s1 = 16 * tj + fr;
            f32x4 lv;
#pragma unroll
            for (int r = 0; r < 4; ++r) { const int t1 = 16 * ti + 4 * fq + r; lv[r] = (s1 < t1) ? -pab[tj][r] : 0.f; }
            *(f32x4*)&Lf[s1 * 72 + 16 * ti + 4 * fq] = lv;
            const int t2 = 16 * ti + fr;
            float m1[4], m2[4], m3[4];
#pragma unroll
            for (int r = 0; r < 4; ++r) { const int s2 = 16 * tj + 4 * fq + r; m1[r] = (s2 < t2) ? pak[tj][r] : 0.f; m2[r] = (s2 <= t2) ? prb[tj][r] : 0.f; m3[r] = (s2 <= t2) ? prk[tj][r] : 0.f; }
            u32x2 w;
            w.x = pack2(m1[0], m1[1]); w.y = pack2(m1[2], m1[3]); *(u32x2*)(Aak + t2 * 144 + (16 * tj + 4 * fq) * 2) = w;
            w.x = pack2(m2[0], m2[1]); w.y = pack2(m2[2], m2[3]); *(u32x2*)(Arb + t2 * 144 + (16 * tj + 4 * fq) * 2) = w;
            w.x = pack2(m3[0], m3[1]); w.y = pack2(m3[2], m3[3]); *(u32x2*)(Ark + t2 * 144 + (16 * tj + 4 * fq) * 2) = w;
        }
    }
    __syncthreads();
    {
        char* L21i = lds + RP_PT;
        char* T11T = lds + RP_T11;
        char* MT = lds + RP_Z0;
        if (wid < 2) {
            const int o = 32 * wid;
            float Tc[32];
#pragma unroll
            for (int i = 0; i < 32; ++i) Tc[i] = (i == (lane & 31)) ? 1.f : 0.f;
#pragma unroll
            for (int j = 0; j < 31; ++j) {
                const float tj = Tc[j];
#pragma unroll
                for (int i4 = (j + 1) >> 2; i4 < 8; ++i4) {
                    const f32x4 l4 = *(const f32x4*)&Lf[(o + j) * 72 + o + i4 * 4];
#pragma unroll
                    for (int e = 0; e < 4; ++e) if (i4 * 4 + e > j) Tc[i4 * 4 + e] -= l4[e] * tj;
                }
            }
            if (lane < 32) {
#pragma unroll
                for (int i = 0; i < 32; ++i) *(bf16_t*)(Trow + (o + i) * 144 + (o + lane) * 2) = f2bf(Tc[i]);
                if (wid == 0) {
#pragma unroll
                    for (int i = 0; i < 32; ++i) *(bf16_t*)(Trow + i * 144 + (32 + lane) * 2) = 0;
#pragma unroll
                    for (int i4 = 0; i4 < 8; ++i4) { u32x2 w; w.x = pack2(Tc[i4 * 4], Tc[i4 * 4 + 1]); w.y = pack2(Tc[i4 * 4 + 2], Tc[i4 * 4 + 3]); *(u32x2*)(T11T + lane * 80 + i4 * 8) = w; }
                }
            }
        } else {
            const int t2 = tid - 128;
#pragma unroll
            for (int g2 = 0; g2 < 2; ++g2) {
                const int i = t2 & 31, k4 = ((t2 >> 5) + 4 * g2) * 4;
                u32x2 w;
                w.x = pack2(Lf[(k4 + 0) * 72 + 32 + i], Lf[(k4 + 1) * 72 + 32 + i]); w.y = pack2(Lf[(k4 + 2) * 72 + 32 + i], Lf[(k4 + 3) * 72 + 32 + i]);
                *(u32x2*)(L21i + i * 80 + k4 * 2) = w;
            }
        }
        __syncthreads();
        {
            const int r0 = 16 * (wid >> 1), c0 = 16 * (wid & 1);
            const f32x4 mm = tile16(L21i, 80, r0, T11T, 80, c0, 32);
            u32x2 w; w.x = pack2(mm[0], mm[1]); w.y = pack2(mm[2], mm[3]);
            *(u32x2*)(MT + (c0 + fr) * 80 + (r0 + 4 * fq) * 2) = w;
        }
        __syncthreads();
        {
            const int r0 = 16 * (wid >> 1), c0 = 16 * (wid & 1);
            const f32x4 tt = tile16(MT, 80, c0, Trow + 32 * 144 + 64, 144, r0, 32);
            u32x2 w; w.x = pack2(-tt[0], -tt[1]); w.y = pack2(-tt[2], -tt[3]);
            *(u32x2*)(Trow + (32 + r0 + fr) * 144 + (c0 + 4 * fq) * 2) = w;
        }
    }
    __syncthreads();
    {
        const int ti = wid;
#pragma unroll
        for (int tj = 0; tj < 4; ++tj) {
            const f32x4 x = tile16(Trow, 144, 16 * ti, AT, 144, 16 * tj, 64);
            const f32x4 y = tile16(Aak, 144, 16 * ti, VT, 144, 16 * tj, 64);
            u32x2 w;
            w.x = pack2(x[0], x[1]); w.y = pack2(x[2], x[3]); *(u32x2*)(ApT + (16 * tj + fr) * 144 + (16 * ti + 4 * fq) * 2) = w;
            w.x = pack2(y[0], y[1]); w.y = pack2(y[2], y[3]); *(u32x2*)(AkVT + (16 * tj + fr) * 144 + (16 * ti + 4 * fq) * 2) = w;
        }
    }
    __syncthreads();
    {
        const int ti = wid;
#pragma unroll
        for (int tj = 0; tj < 4; ++tj) {
            const f32x4 x = tile16(Trow, 144, 16 * ti, AkVT, 144, 16 * tj, 64);
            u32x2 w; w.x = pack2(x[0], x[1]); w.y = pack2(x[2], x[3]); *(u32x2*)(VpT + (16 * tj + fr) * 144 + (16 * ti + 4 * fq) * 2) = w;
        }
    }
    __syncthreads();
#pragma unroll
    for (int tj = 0; tj < 4; ++tj)
#pragma unroll
        for (int r = 0; r < 4; ++r) {
            const int cb = 16 * tj + 4 * fq + r;
            *(bf16_t*)(BhT + cb * 144 + c * 2) = f2bf(bh[tj * 4 + r]);
            *(bf16_t*)(KhT + cb * 144 + c * 2) = f2bf(kh[tj * 4 + r]);
        }
    __syncthreads();
    {
        unsigned char* opsA = (unsigned char*)p.out + (size_t)ch * 16384;
        unsigned char* opsB = p.ws + WS_ROPS + (size_t)ch * 16384;
        const int ti = wid;
#pragma unroll
        for (int tj = 0; tj < 4; ++tj) {
            const f32x4 x = tile16(ApT, 144, 16 * tj, Arb, 144, 16 * ti, 64);
            const f32x4 g = tile16(ApT, 144, 16 * tj, BhT, 144, 16 * ti, 64);
            const int m1 = 16 * ti + fr, mt = m1 >> 5, rr = m1 & 31, hh = fq & 1, jg = fq >> 1;
            const size_t off = ((size_t)((mt * 4 + tj) * 64 + hh * 32 + rr) * 8 + jg * 4) * 2;
            float gd[4];
#pragma unroll
            for (int r = 0; r < 4; ++r) gd[r] = g[r] + ((16 * tj + 4 * fq + r == m1) ? WC[m1] : 0.f);
            u32x2 w;
            w.x = pack2(x[0] + rt[tj * 4], x[1] + rt[tj * 4 + 1]); w.y = pack2(x[2] + rt[tj * 4 + 2], x[3] + rt[tj * 4 + 3]); *(u32x2*)(opsA + off) = w;
            w.x = pack2(gd[0], gd[1]); w.y = pack2(gd[2], gd[3]); *(u32x2*)(opsA + 8192 + off) = w;
            f32x4 y = tile16(Ark, 144, 16 * ti, VT, 144, 16 * tj, 64);
            const f32x4 y2 = tile16(Arb, 144, 16 * ti, VpT, 144, 16 * tj, 64);
            f32x4 kv = tile16(KhT, 144, 16 * ti, VT, 144, 16 * tj, 64);
            const f32x4 kv2 = tile16(BhT, 144, 16 * ti, VpT, 144, 16 * tj, 64);
            const int vcol = 16 * tj + fr, slice = vcol >> 5, r2 = vcol & 31, cb = 16 * ti + 4 * fq, mt2 = cb >> 5, q4 = (cb & 31) >> 2, h2 = q4 & 1, rg = q4 >> 1;
            const size_t off2 = ((size_t)((slice * 2 + mt2) * 64 + h2 * 32 + r2) * 16 + rg * 4) * 2;
            w.x = pack2(y[0] + y2[0], y[1] + y2[1]); w.y = pack2(y[2] + y2[2], y[3] + y2[3]); *(u32x2*)(opsB + off2) = w;
            w.x = pack2(kv[0] + kv2[0], kv[1] + kv2[1]); w.y = pack2(kv[2] + kv2[2], kv[3] + kv2[3]); *(u32x2*)(opsB + 8192 + off2) = w;
        }
    }
}

DI void rwkv_scan_block(const P& p, int bh, char* lds, bool dry = false) {
    const int tid = tidx(), lane = tid & 63, w = tid >> 6, slice = w & 1;
    const int h = bh & 7, b = bh >> 3;
    constexpr int NST = 64 * 2, AH = 3;
    auto issue = [&](int j) {
        const int n = j >> 1, k = j & 1;
        const size_t ch = (size_t)((b * 64 + n) * 8 + h) * 16384;
        const unsigned char* s0 = (k == 0 ? p.ws + WS_ROPS + ch + 8192 : p.ws + WS_ROPS + ch) + tid * 16;
        const unsigned char* s1 = (k == 0 ? (const unsigned char*)p.out + ch + 8192 : (const unsigned char*)p.out + ch) + tid * 16;
        char* dst = lds + (j & 3) * 16384 + tid * 16;
        glds16(s0, dst); glds16(s0 + 4096, dst + 4096); glds16(s1, dst + 8192); glds16(s1 + 4096, dst + 12288);
    };
    const unsigned la = (unsigned)(size_t)(lds_u32*)lds + lane * 16;
    f32x16 H[2];
#pragma unroll
    for (int i = 0; i < 2; ++i)
#pragma unroll
        for (int r = 0; r < 16; ++r) H[i][r] = 0.f;
    __syncthreads();
#pragma unroll
    for (int j = 0; j < AH; ++j) issue(j);
#pragma unroll 1
    for (int n = 0; n < 64; ++n) {
        bf16x8 Hb[4];
#pragma unroll
        for (int i = 0; i < 2; ++i) { Hb[i * 2] = pack_step(H[i], 0); Hb[i * 2 + 1] = pack_step(H[i], 1); }
#pragma unroll
        for (int k = 0; k < 2; ++k) {
            const int j = n * 2 + k;
            if (n < 63) GS_WAIT(8); else if (k == 0) GS_WAIT(4); else GS_WAIT(0);
            __builtin_amdgcn_s_barrier();
            if (j + AH < NST) issue(j + AH);
            __builtin_amdgcn_sched_barrier(0);
            const char* sl = lds + (j & 3) * 16384;
            if (w < 2) {
                f32x16 acc[2];
                bf16x8 F[4];
                const unsigned fa = la + (unsigned)((j & 3) * 16384 + 8192);
#define RS_O(i) (unsigned)((((i) & 1) * 4 + ((i) >> 1)) * 1024)
#pragma unroll
                for (int i = 0; i < 4; ++i) fr_rd(F[i], fa + RS_O(i));
#pragma unroll
                for (int mt = 0; mt < 2; ++mt) {
                    const u32x4* up = (const u32x4*)(sl + (slice * 2 + mt) * 2048 + lane * 32);
                    const u32x4 u0 = up[0], u1 = up[1];
#pragma unroll
                    for (int e = 0; e < 4; ++e) {
                        acc[mt][e * 2] = __uint_as_float(u0[e] << 16); acc[mt][e * 2 + 1] = __uint_as_float(u0[e] & 0xffff0000u);
                        acc[mt][8 + e * 2] = __uint_as_float(u1[e] << 16); acc[mt][8 + e * 2 + 1] = __uint_as_float(u1[e] & 0xffff0000u);
                    }
                }
#pragma unroll
                for (int i = 0; i < 8; ++i) {
                    if (i <= 4) fr_wait<3>(F[i & 3]); else if (i == 5) fr_wait<2>(F[i & 3]); else if (i == 6) fr_wait<1>(F[i & 3]); else fr_wait<0>(F[i & 3]);
                    acc[i & 1] = mfma32(F[i & 3], Hb[i >> 1], acc[i & 1]);
                    if (i + 4 < 8) fr_rd(F[i & 3], fa + RS_O(i + 4));
                }
                if (k == 0) { H[0] = acc[0]; H[1] = acc[1]; }
                else {
                    const size_t ch = (size_t)((b * 64 + n) * 8 + h) * 16384;
                    u32x4* Yf = (u32x4*)(dry ? p.ws + WS_DUMMY + 2097152 + (size_t)(bh & 31) * 16384 : p.ws + WS_ROPS + ch) + (size_t)(slice * 128 + lane) * 2;
#pragma unroll
                    for (int mt = 0; mt < 2; ++mt) {
                        u32x4 o0, o1;
#pragma unroll
                        for (int e = 0; e < 4; ++e) { o0[e] = pack2(acc[mt][e * 2], acc[mt][e * 2 + 1]); o1[e] = pack2(acc[mt][8 + e * 2], acc[mt][8 + e * 2 + 1]); }
                        Yf[mt * 128] = o0; Yf[mt * 128 + 1] = o1;
                    }
                }
            }
        }
    }
    __syncthreads();
}

DI void rwkv_post_unit(const P& p, int li, int ch) {
    const int tid = tidx();
    const int h = ch & 7, n = (ch >> 3) & 63, b = ch >> 9;
    const int t0 = b * SEQ + n * 64;
    const int c = tid >> 2, cq = tid & 3;
    const bf16_t* Yf = (const bf16_t*)(p.ws + WS_ROPS + (size_t)ch * 16384);
    const bf16_t* vf = (const bf16_t*)(p.ws + WS_VF) + (size_t)(t0 + c) * 512 + h * 64 + cq * 16;
    const bf16_t* gg = (const bf16_t*)(p.ws + WS_GG) + (size_t)(t0 + c) * 512 + h * 64 + cq * 16;
    const float rk = ((const float*)(p.ws + WS_RK))[(size_t)(t0 + c) * 8 + h];
    const float* lnw = p.in[I_LNW] + li * 512 + h * 64 + cq * 16;
    const float* lnb = p.in[I_LNB] + li * 512 + h * 64 + cq * 16;
    bf16_t* mp = (bf16_t*)p.out + (size_t)(t0 + c) * 1024 + 512 + h * 64 + cq * 16;
    const int mt = c >> 5, q4 = (c & 31) >> 2, hh = q4 & 1, rg = q4 >> 1, reg = rg * 4 + (c & 3), slice = cq >> 1, rb = (cq & 1) * 16;
    float y[16]; float sm = 0.f;
#pragma unroll
    for (int i = 0; i < 16; ++i) { y[i] = bf2f(Yf[(size_t)((slice * 2 + mt) * 64 + hh * 32 + rb + i) * 16 + reg]); sm += y[i]; }
    sm += __shfl_xor(sm, 1); sm += __shfl_xor(sm, 2);
    const float mean = sm * (1.f / 64.f);
    float vs = 0.f;
#pragma unroll
    for (int i = 0; i < 16; ++i) { y[i] -= mean; vs += y[i] * y[i]; }
    vs += __shfl_xor(vs, 1); vs += __shfl_xor(vs, 2);
    const float rs = rsqrtf(vs * (1.f / 64.f) + 64e-5f);
#pragma unroll
    for (int i8 = 0; i8 < 2; ++i8) {
        const u32x4 vw = *(const u32x4*)(vf + i8 * 8), gw = *(const u32x4*)(gg + i8 * 8);
        u32x4 w;
#pragma unroll
        for (int e = 0; e < 4; ++e) {
            const int i = i8 * 8 + e * 2;
            const float v0 = __uint_as_float(vw[e] << 16), v1 = __uint_as_float(vw[e] & 0xffff0000u), g0 = __uint_as_float(gw[e] << 16), g1 = __uint_as_float(gw[e] & 0xffff0000u);
            w[e] = pack2((y[i] * rs * lnw[i] + lnb[i] + rk * v0) * g0, (y[i + 1] * rs * lnw[i + 1] + lnb[i + 1] + rk * v1) * g1);
        }
        *(u32x4*)(mp + i8 * 8) = w;
    }
}


DI void attn_unit(const P& p, int unit, char* lds) {
    const int tid = tidx(), lane = tid & 63, w = tid >> 6, r_ = lane & 31, hl = lane >> 5;
    const int idx = unit & 31, h = (unit >> 5) & 7, g = (unit >> 8) % 3, b = unit / 768;
    const int lg2 = g * 2, dil = 1 << lg2, L = SEQ >> lg2, ntl = L >> 7;
    const int rs = idx / ntl, qt = idx % ntl;
    const int hg = g * 8 + h;
    const bf16_t* QK = (const bf16_t*)(p.ws + WS_QK);
    const bf16_t* VT = (const bf16_t*)(p.ws + WS_VT) + ((size_t)((b * 24 + hg) * dil + rs) * 64) * L;
    const int qi = 32 * w + r_;
    const int q_idx = 128 * qt + qi;
    const size_t qrow = (size_t)(b * SEQ + q_idx * dil + rs);
    const int kbase0 = 128 * qt - 128;
    char* Kt = lds;
    char* Vt = lds + 32768;
    __syncthreads();
#pragma unroll
    for (int i = 0; i < 8; ++i) {
        const int id = tid + i * 256, row = id >> 3, pc = id & 7, c = pc ^ ((row >> 1) & 7);
        int k_idx = kbase0 + row; if (k_idx < 0) k_idx = 0;
        glds16(QK + (size_t)(b * SEQ + k_idx * dil + rs) * 3072 + 1536 + hg * 64 + c * 8, Kt + id * 16);
    }
#pragma unroll
    for (int i = 0; i < 8; ++i) {
        const int id = tid + i * 256, row = id >> 5, pq = id & 31, q = pq ^ (row & 31);
        int k0 = kbase0 + q * 8; if (k0 < 0) k0 = 0;
        glds16(VT + (size_t)row * L + k0, Vt + id * 16);
    }
    bf16x8 qf[4];
#pragma unroll
    for (int ks = 0; ks < 4; ++ks) qf[ks] = *(const bf16x8*)(QK + qrow * 3072 + hg * 64 + 16 * ks + 8 * hl);
    asm volatile("s_waitcnt vmcnt(0)" ::: "memory");
    __syncthreads();
    f32x16 st[5];
    float mx = -1.0e30f;
#pragma unroll
    for (int kbi = 0; kbi < 5; ++kbi) {
        const int krow = 32 * (w + kbi) + r_;
#pragma unroll
        for (int r = 0; r < 16; ++r) st[kbi][r] = 0.f;
#pragma unroll
        for (int ks = 0; ks < 4; ++ks) {
            const bf16x8 kf = *(const bf16x8*)(Kt + krow * 128 + (((2 * ks + hl) ^ ((krow >> 1) & 7)) * 16));
            st[kbi] = mfma32(kf, qf[ks], st[kbi]);
        }
#pragma unroll
        for (int r = 0; r < 16; ++r) {
            const int kj = 32 * (w + kbi) + (r & 3) + 8 * (r >> 2) + 4 * hl;
            const bool valid = (kj >= qi) && (kj <= qi + 128) && (kbase0 + kj >= 0);
            const float sv = valid ? st[kbi][r] * 0.125f : -1.0e30f;
            st[kbi][r] = sv; mx = fmaxf(mx, sv);
        }
    }
    mx = fmaxf(mx, __shfl_xor(mx, 32));
    float l = 0.f;
#pragma unroll
    for (int kbi = 0; kbi < 5; ++kbi)
#pragma unroll
        for (int r = 0; r < 16; ++r) { const float pv = __expf(st[kbi][r] - mx); st[kbi][r] = pv; l += pv; }
    l += __shfl_xor(l, 32);
    f32x16 ot[2];
#pragma unroll
    for (int dt = 0; dt < 2; ++dt)
#pragma unroll
        for (int r = 0; r < 16; ++r) ot[dt][r] = 0.f;
#pragma unroll
    for (int kbi = 0; kbi < 5; ++kbi)
#pragma unroll
        for (int s2 = 0; s2 < 2; ++s2) {
            const bf16x8 pb = pack_step(st[kbi], s2);
            const int q0 = 4 * (w + kbi) + 2 * s2;
#pragma unroll
            for (int dt = 0; dt < 2; ++dt) {
                const int drow = 32 * dt + r_;
                const u32x2 lo = *(const u32x2*)(Vt + drow * 512 + ((q0 ^ (drow & 31)) * 16) + 8 * hl);
                const u32x2 hi = *(const u32x2*)(Vt + drow * 512 + (((q0 + 1) ^ (drow & 31)) * 16) + 8 * hl);
                u32x4 vw; vw.x = lo.x; vw.y = lo.y; vw.z = hi.x; vw.w = hi.y;
                ot[dt] = mfma32(__builtin_bit_cast(bf16x8, vw), pb, ot[dt]);
            }
        }
    const float inv = 1.f / l;
    bf16_t* og = (bf16_t*)(p.ws + WS_OG) + ((size_t)g * T + qrow) * 512 + h * 64;
#pragma unroll
    for (int dt = 0; dt < 2; ++dt)
#pragma unroll
        for (int rg = 0; rg < 4; ++rg) {
            u32x2 wv; wv.x = pack2(ot[dt][rg * 4] * inv, ot[dt][rg * 4 + 1] * inv); wv.y = pack2(ot[dt][rg * 4 + 2] * inv, ot[dt][rg * 4 + 3] * inv);
            *(u32x2*)(og + 32 * dt + 8 * rg + 4 * hl) = wv;
        }
    if (hl == 0) ((float*)(p.ws + WS_LSE))[((size_t)g * T + qrow) * 8 + h] = mx + __logf(l);
}
DI void phase_attn_merge(const P& p) {
    const bf16_t* og = (const bf16_t*)(p.ws + WS_OG);
    const float* lse = (const float*)(p.ws + WS_LSE);
    bf16_t* o = (bf16_t*)p.out;
    for (int i = bidx() * 256 + tidx(); i < T * 64; i += gridDim.x * 256) {
        const int t = i >> 6, c8 = i & 63, h = c8 >> 3;
        const float l0 = lse[(size_t)t * 8 + h], l1 = lse[((size_t)T + t) * 8 + h], l2 = lse[((size_t)2 * T + t) * 8 + h];
        const float m = fmaxf(l0, fmaxf(l1, l2));
        float w0 = __expf(l0 - m), w1 = __expf(l1 - m), w2 = __expf(l2 - m);
        const float inv = 1.f / (w0 + w1 + w2); w0 *= inv; w1 *= inv; w2 *= inv;
        const u32x4 a = *(const u32x4*)(og + (size_t)t * 512 + c8 * 8), bq = *(const u32x4*)(og + ((size_t)T + t) * 512 + c8 * 8), cq = *(const u32x4*)(og + ((size_t)2 * T + t) * 512 + c8 * 8);
        u32x4 r;
#pragma unroll
        for (int e = 0; e < 4; ++e) {
            const float x0 = w0 * __uint_as_float(a[e] << 16) + w1 * __uint_as_float(bq[e] << 16) + w2 * __uint_as_float(cq[e] << 16);
            const float x1 = w0 * __uint_as_float(a[e] & 0xffff0000u) + w1 * __uint_as_float(bq[e] & 0xffff0000u) + w2 * __uint_as_float(cq[e] & 0xffff0000u);
            r[e] = pack2(x0, x1);
        }
        *(u32x4*)(o + (size_t)t * 512 + c8 * 8) = r;
    }
}


#define XB_TMO      128
#define XB_XCNT(j)  (256  + 64 * (j))
#define XB_XSUB(j)  (1280 + 64 * (j))
#define XB_XGEN(j)  (2304 + 64 * (j))
#define XB_TOP      3328
#define XB_TOPGEN   3392
#define XCD_BAR_WORDS 3456
#define XB_SPIN_CAP (1u << 22)
#define LAS __attribute__((address_space(3)))
DI unsigned xb_ld(unsigned* p)              { return __hip_atomic_load(p, __ATOMIC_RELAXED, __HIP_MEMORY_SCOPE_AGENT); }
DI unsigned xb_add(unsigned* p, unsigned v) { return __hip_atomic_fetch_add(p, v, __ATOMIC_RELAXED, __HIP_MEMORY_SCOPE_AGENT); }
DI unsigned xb_xcc_id() { return (unsigned)__builtin_amdgcn_s_getreg((3 << 11) | 20) & 0xFu; }
#define XB_SPIN(cond, bar) do { unsigned _sp = 0; while (cond) { if (_sp < 32u) __builtin_amdgcn_s_sleep(2); else __builtin_amdgcn_s_sleep(24); \
    if ((++_sp & 255u) == 0u) { if (xb_ld(&(bar)[XB_TMO])) break; if (_sp > XB_SPIN_CAP) { atomicAdd(&(bar)[XB_TMO], 1u); break; } } } } while (0)
struct XcdBarrier { unsigned* bar; unsigned x; volatile LAS unsigned* st; };
DI XcdBarrier xcd_barrier_post(unsigned* bar, volatile LAS unsigned* st) {
    XcdBarrier b; b.bar = bar; b.x = xb_xcc_id(); b.st = st;
    if (threadIdx.x == 0) (void)xb_add(&bar[XB_XCNT(b.x)], 1u);
    return b;
}
DI void xcd_barrier_complete(unsigned* bar, unsigned x, unsigned& nloc, unsigned& nx) {
    const unsigned G = gridDim.x * gridDim.y * gridDim.z;
    unsigned sum, cnt, mine, sp = 0u;
    for (;;) {
        sum = 0u; cnt = 0u; mine = 0u;
#pragma unroll
        for (unsigned j = 0; j < 16; ++j) { const unsigned c = xb_ld(&bar[XB_XCNT(j)]); sum += c; cnt += (c > 0u) ? 1u : 0u; mine = (j == x) ? c : mine; }
        if (sum == G) break;
        __builtin_amdgcn_s_sleep(1);
        if ((++sp & 255u) == 0u) { if (xb_ld(&bar[XB_TMO])) break; if (sp > XB_SPIN_CAP) { atomicAdd(&bar[XB_TMO], 1u); break; } }
    }
    nloc = mine > 0u ? mine : 1u; nx = cnt > 0u ? cnt : 1u;
}
DI void xcd_barrier(const XcdBarrier& b) {
    asm volatile("s_waitcnt vmcnt(0)" ::: "memory");
    __syncthreads();
    if (threadIdx.x == 0) {
        unsigned* bar = b.bar; unsigned bx = b.x;
        asm volatile("" : "+s"(bar), "+s"(bx));
        __builtin_amdgcn_s_waitcnt(0);
        unsigned nloc = b.st[0], nx = b.st[1];
        if (nloc == 0u) { xcd_barrier_complete(bar, bx, nloc, nx); b.st[0] = nloc; b.st[1] = nx; }
        const unsigned old = xb_add(&bar[XB_XSUB(bx)], 1u);
        const unsigned gen = old / nloc;
        if (old + 1u == (gen + 1u) * nloc) {
            __builtin_amdgcn_fence(__ATOMIC_RELEASE, "agent");
            asm volatile("s_waitcnt vmcnt(0)" ::: "memory");
            const unsigned og = xb_add(&bar[XB_TOP], 1u);
            const unsigned tg = og / nx;
            if (og + 1u == (tg + 1u) * nx) xb_add(&bar[XB_TOPGEN], 1u);
            else XB_SPIN(xb_ld(&bar[XB_TOPGEN]) == tg, bar);
            __builtin_amdgcn_fence(__ATOMIC_ACQUIRE, "agent");
            xb_add(&bar[XB_XGEN(bx)], 1u);
            asm volatile("s_waitcnt vmcnt(0)" ::: "memory");
        } else {
            XB_SPIN(xb_ld(&bar[XB_XGEN(bx)]) == gen, bar);
            __builtin_amdgcn_fence(__ATOMIC_ACQUIRE, "agent");
            asm volatile("s_waitcnt vmcnt(0)" ::: "memory");
        }
    }
    __syncthreads();
}

constexpr int LDS_BYTES = RP_END;
static_assert(GP_END + 6144 <= LDS_BYTES, "LDS");
__global__ void __launch_bounds__(256, 2) __attribute__((amdgpu_waves_per_eu(2, 2))) mega(P p) {
    cg::grid_group grid = cg::this_grid();
    extern __shared__ __attribute__((aligned(16))) char lds[];
    if (threadIdx.x < 4) ((volatile LAS unsigned*)(lds + LDS_BYTES))[threadIdx.x] = 0u;
    __syncthreads();
    const XcdBarrier xb = xcd_barrier_post((unsigned*)(p.ws + WS_CTL + CTL_BAR), (volatile LAS unsigned*)(lds + LDS_BYTES));
#define GSYNC() xcd_barrier(xb)
    const bf16_t* HN = (const bf16_t*)p.out;
    const bf16_t* XB = (const bf16_t*)(p.ws + WS_XB);
    const bf16_t* Win = (const bf16_t*)(p.ws + WS_W + W_IN);
    const bf16_t* Wout = (const bf16_t*)(p.ws + WS_W + W_OUT);
    {
        const unsigned hw = (unsigned)__builtin_amdgcn_s_getreg((31 << 11) | 4);
        const unsigned key = 1u + ((xb.x << 16) | (hw & 0xFF00u));
        if (threadIdx.x == 0) ((unsigned*)(p.ws + WS_CTL + CTL_CUTAB))[bidx()] = key;
    }
    phase_rope(p);
    phase_convert_io(p, 0, lds, bidx(), gridDim.x);
    phase_prep<0>(p, p.in[I_EVNORM], 0);
    if (p.ws == nullptr) grid.sync();
    GSYNC();
    volatile LAS unsigned* qword = (volatile LAS unsigned*)(lds + LDS_BYTES + 8);
    int idle2, idle3, rank3, nact3;
    {
        const unsigned* cut = (const unsigned*)(p.ws + WS_CTL + CTL_CUTAB);
        unsigned* keys = (unsigned*)lds; unsigned* cntw = keys + 2048;
        const int G = (int)gridDim.x < 2048 ? (int)gridDim.x : 2048;
        __syncthreads();
        for (int j = threadIdx.x; j < G; j += 256) keys[j] = cut[j];
        if (threadIdx.x < 4) cntw[threadIdx.x] = 0u;
        __syncthreads();
        const unsigned mine = keys[bidx() < G ? bidx() : 0];
        for (int j = threadIdx.x; j < G; j += 256) {
            bool sh16 = false, sh32 = false;
            for (int k = 0; k < 32 && k < G; ++k) { const bool eq = keys[k] == keys[j] && k != j; if (eq) { sh32 = true; if (k < 16) sh16 = true; } }
            const bool act3 = j >= 32 && !sh32;
            if (act3) { atomicAdd(&cntw[0], 1u); if (j < bidx()) atomicAdd(&cntw[1], 1u); }
            if (j == bidx()) { cntw[2] = (j >= 16 && sh16) ? 1u : 0u; cntw[3] = (j >= 32 && sh32) ? 1u : 0u; }
        }
        (void)mine;
        __syncthreads();
        nact3 = __builtin_amdgcn_readfirstlane((int)cntw[0]); rank3 = __builtin_amdgcn_readfirstlane((int)cntw[1]);
        idle2 = __builtin_amdgcn_readfirstlane((int)cntw[2]); idle3 = __builtin_amdgcn_readfirstlane((int)cntw[3]);
        if (nact3 < 1) { nact3 = 1; }
        __syncthreads();
    }
    for (int layer = 0; layer < 4; ++layer) {
        const int li = layer >> 1;
        if ((layer & 1) == 0) {
            phase_gemm<EPI_EVEN_IN>(p, XB, 1024, Win, 1024, EVPAD / 128, lds);
            GSYNC();
            for (int u = bidx(); u < 1024; u += gridDim.x) gdn_prep_unit(p, li, u, lds);
            GSYNC();
            if (bidx() < 16) gdn_scan_block(p, bidx(), lds);
            if (!idle2) {
                unsigned* qctr = (unsigned*)(p.ws + WS_CTL + CTL_QUEUE) + li * 64;
                for (;;) {
                    __syncthreads();
                    if (threadIdx.x == 0) *qword = atomicAdd(qctr, 1u);
                    __syncthreads();
                    const unsigned u = *qword;
                    if (u >= 2048u + 768u) break;
                    if (u < 2048u) rwkv_prep_unit(p, li, (int)u, lds);
                    else convert_moe_tile(p, layer + 1, lds, (int)u - 2048);
                }
            }
            GSYNC();
            if (bidx() < 32) rwkv_scan_block(p, bidx(), lds);
            else if (!idle3) {
                for (int u = rank3; u < 1024; u += nact3) gdn_post_unit(p, li, u);
                phase_convert_moe(p, layer, lds, rank3, nact3);
            }
            GSYNC();
            for (int u = bidx(); u < 2048; u += gridDim.x) rwkv_post_unit(p, li, u);
            GSYNC();
            phase_gemm<EPI_RESID>(p, (const bf16_t*)(p.ws + WS_PROJ), EVLD, Wout, 1024, 8, lds, false, HN, 1024, 512);
        } else {
            phase_gemm<EPI_ODD_IN>(p, XB, 1024, Win, 1024, ODC / 128, lds);
            GSYNC();
            for (int u = bidx(); u < 3072; u += gridDim.x) attn_unit(p, u, lds);
            GSYNC();
            phase_attn_merge(p);
            GSYNC();
            phase_gemm<EPI_RESID>(p, HN, 512, Wout, 512, 8, lds);
        }
        GSYNC();
        phase_router(p, p.in[I_FFNNORM] + layer * 1024, layer, lds);
        GSYNC();
        {
            const int nt = phase_moe_up(p, layer, lds);
            if (layer < 3) {
                const int G = (int)gridDim.x, rounds = (nt + G - 1) / G, first = nt - (rounds - 1) * G;
                if (first >= G) phase_convert_io(p, layer + 1, lds, bidx(), G);
                else if (bidx() >= first) phase_convert_io(p, layer + 1, lds, bidx() - first, G - first);
            }
        }
        GSYNC();
        phase_moe_down(p, layer, lds);
        GSYNC();
        if (layer < 3) {
            phase_prep<1>(p, ((layer + 1) & 1) ? p.in[I_ODNORM] + ((layer + 1) >> 1) * 1024 : p.in[I_EVNORM] + ((layer + 1) >> 1) * 1024, layer + 1);
            GSYNC();
        }
    }
    phase_prep<3>(p, p.in[I_FINAL], 0);
}

extern "C" void kernel_launch(void* const* d_in, const int* in_sizes, int n_in, void* d_out, int out_size, void* d_ws, size_t ws_size, hipStream_t stream) {
    if (n_in != 34 || out_size != T * D || ws_size < WS_NEED) { fprintf(stderr, "kernel_launch: unexpected shapes (n_in %d out %d ws %zu need %zu)\n", n_in, out_size, ws_size, (size_t)WS_NEED); return; }
    static int grid_blocks = 0;
    if (!grid_blocks) {
        int dev = 0, cus = 0, per_cu = 0;
        (void)hipGetDevice(&dev);
        (void)hipDeviceGetAttribute(&cus, hipDeviceAttributeMultiprocessorCount, dev);
        (void)hipFuncSetAttribute((const void*)mega, hipFuncAttributeMaxDynamicSharedMemorySize, LDS_BYTES + 16);
        (void)hipOccupancyMaxActiveBlocksPerMultiprocessor(&per_cu, mega, 256, LDS_BYTES + 16);
        if (per_cu < 1) per_cu = 1;
        if (per_cu > 2) per_cu = 2;
        grid_blocks = cus * per_cu;
    }
    P p{};
    for (int i = 0; i < 34; ++i) p.in[i] = (const float*)d_in[i];
    p.out = (float*)d_out; p.ws = (unsigned char*)d_ws;
    (void)hipMemsetAsync((char*)d_ws + WS_CTL, 0, 65536, stream);
    void* args[] = {&p};
    hipError_t e = hipLaunchCooperativeKernel((void*)mega, dim3(grid_blocks), dim3(256), args, LDS_BYTES + 16, stream);
    if (e != hipSuccess) fprintf(stderr, "cooperative launch failed: %s (grid %d)\n", hipGetErrorString(e), grid_blocks);
}
```

```cpp
#include <hip/hip_runtime.h>
#include <cstdio>
#include <cstdint>
#include <cmath>
#include <hip/hip_cooperative_groups.h>
namespace cg = cooperative_groups;

typedef unsigned short bf16_t;
typedef short bf16x8 __attribute__((ext_vector_type(8)));
typedef float f32x4 __attribute__((ext_vector_type(4)));
typedef unsigned u32x4 __attribute__((ext_vector_type(4)));
typedef unsigned u32x2 __attribute__((ext_vector_type(2)));
#define DI __device__ __forceinline__

constexpr int T = 16384, SEQ = 4096, BATCH = 4, D = 1024;
constexpr int EVC = 3784, EVLD = 3784, EVPAD = 3840;
constexpr int ODC = 4608;
constexpr int RW0 = 2056;
constexpr int C_R = 2056, C_K = 2568, C_V = 3080, C_HW = 3592, C_HA = 3624, C_HG = 3656, C_HV = 3752;
constexpr int NEXP = 16, FF = 256;
constexpr int HROWS = 34816;

constexpr size_t WS_CTL = 0;
constexpr size_t CTL_EGL = 4096;
constexpr size_t CTL_CUTAB = 8192;
constexpr size_t CTL_QUEUE = 49152;
constexpr size_t CTL_CNT = 32768;
constexpr size_t CTL_BAR = 16384;
constexpr size_t WS_LIST = 65536;
constexpr size_t WS_GATE = WS_LIST + 16 * 16384 * 4;
constexpr size_t WS_RK = WS_GATE + 16 * 16384 * 4;
constexpr size_t WS_SSQ = WS_RK + (size_t)T * 8 * 4;
constexpr size_t WS_ROPE = WS_SSQ + (size_t)16 * T * 4;
constexpr size_t WS_W = WS_ROPE + (size_t)T * 32 * 8;
constexpr size_t W_IN = 0;
constexpr size_t W_OUT = (size_t)4608 * 1024 * 2;
constexpr size_t W_13 = W_OUT + (size_t)1024 * 1024 * 2;
constexpr size_t W_2 = W_13 + (size_t)16 * 512 * 1024 * 2;
constexpr size_t W_LW = W_2 + (size_t)16 * 1024 * 256 * 2;
constexpr size_t W_BYTES = W_LW + (size_t)512 * 192 * 2;
constexpr size_t WS_XB = WS_W + W_BYTES;
constexpr size_t WS_HN = WS_XB;
constexpr size_t WS_VF = WS_HN + (size_t)T * 1024 * 2;
constexpr size_t WS_R2 = WS_VF + (size_t)T * 512 * 2;
constexpr size_t WS_PROJ = WS_R2;
constexpr size_t WS_GOPS = WS_R2 + (size_t)T * EVLD * 2;
constexpr size_t GOPS_CH = 73728, GO_UF = 0, GO_WF = 16384, GO_QF = 32768, GO_AF = 49152, GO_KF = 57344;
constexpr size_t WS_ROPS = WS_GOPS + 1024 * GOPS_CH;
constexpr size_t WS_QK = WS_R2;
constexpr size_t WS_VT = WS_QK + (size_t)T * 3072 * 2;
constexpr size_t WS_OG = WS_VT + (size_t)T * 1536 * 2;
constexpr size_t WS_LSE = WS_OG + (size_t)3 * T * 512 * 2;
constexpr size_t WS_END3 = WS_LSE + (size_t)3 * T * 8 * 4;
constexpr size_t WS_YS = WS_R2;
constexpr size_t WS_H = WS_YS + (size_t)2 * T * 1024 * 2;
constexpr size_t WS_GG = WS_ROPS + (size_t)2048 * 16384;
constexpr size_t WS_END0 = WS_GG + (size_t)T * 512 * 2;
constexpr size_t WS_END1 = WS_H + (size_t)HROWS * 256 * 2;
constexpr size_t WS_END2 = WS_R2 + (size_t)T * 4608 * 2;
static_assert(WS_END3 <= WS_END0, "odd-layer regions exceed even-layer footprint");
constexpr size_t WS_END = WS_END0 > WS_END1 ? (WS_END0 > WS_END2 ? WS_END0 : WS_END2) : (WS_END1 > WS_END2 ? WS_END1 : WS_END2);

constexpr size_t WS_RSL = WS_END;
constexpr size_t WS_RSIN = WS_RSL + 16 * 16384 * 4;
constexpr size_t WS_NEED = WS_RSIN + (size_t)T * 4;
constexpr size_t WS_DUMMY = WS_END0;
struct P {
    const float* in[34];
    float* out;
    unsigned char* ws;
};
enum { I_X = 0, I_POS, I_EVNORM, I_EVWIN, I_VRESDOWN, I_EVWOUT, I_CONVW, I_ALOG, I_DTB, I_GDNNORM, I_MU, I_W0, I_W2, I_A0, I_A2, I_G2,
       I_KK, I_KA, I_RK, I_LNW, I_LNB, I_VRESMU, I_V0, I_V2, I_ODNORM, I_ODWIN, I_ODWOUT, I_FFNNORM, I_WGROUP, I_WEXPERT, I_W1, I_W3, I_MW2, I_FINAL };

DI int tidx() { int t = threadIdx.x; asm volatile("" : "+v"(t)); return t; }
DI int bidx() { int b = blockIdx.x; asm volatile("" : "+s"(b)); return b; }
typedef __bf16 bf2_t __attribute__((ext_vector_type(2)));
typedef float f2_t __attribute__((ext_vector_type(2)));
DI bf16_t f2bf(float x) { return __builtin_bit_cast(bf16_t, (__bf16)x); }
DI float bf2f(bf16_t h) { return __uint_as_float(((unsigned)h) << 16); }
DI unsigned pack2(float lo, float hi) { const f2_t v = {lo, hi}; return __builtin_bit_cast(unsigned, __builtin_convertvector(v, bf2_t)); }
DI float wave_sum(float v) {
#pragma unroll
    for (int o = 32; o > 0; o >>= 1) v += __shfl_xor(v, o);
    return v;
}
DI float wave_max(float v) {
#pragma unroll
    for (int o = 32; o > 0; o >>= 1) v = fmaxf(v, __shfl_xor(v, o));
    return v;
}
DI float sigmoidf_(float x) { return __builtin_amdgcn_rcpf(1.f + __expf(-x)); }
DI float siluf_(float x) { return x * __builtin_amdgcn_rcpf(1.f + __expf(-x)); }
DI float softplusf_(float x) { return fmaxf(x, 0.f) + __logf(1.f + __expf(-fabsf(x))); }

struct ConvJob { const float* src; bf16_t* dst; int K, N, ldd; int mode; const float* ks = nullptr; };
DI int rowmap(int mode, int n) { return mode == 0 ? n : ((n >> 4) * 32 + (n & 15) + (mode == 2 ? 16 : 0)); }
DI void conv_tile(const ConvJob& j, int tile, float* lds  ) {
    const int ntn = (j.N + 255) / 256;
    const int tk = tile / ntn, tn = tile % ntn;
    const int tid = tidx();
    __syncthreads();
    float4 v[16];
#pragma unroll
    for (int i = 0; i < 16; ++i) {
        const int e = tid + i * 256, k = e >> 6, n4 = (e & 63) * 4;
        const int gk = tk * 64 + k, gn = tn * 256 + n4;
        v[i] = make_float4(0.f, 0.f, 0.f, 0.f);
        if (gn < j.N) v[i] = *(const float4*)(j.src + (size_t)gk * j.N + gn);
    }
    if (j.ks) {
        float sc[16];
#pragma unroll
        for (int i = 0; i < 16; ++i) sc[i] = j.ks[tk * 64 + (tid >> 6) + 4 * i];
#pragma unroll
        for (int i = 0; i < 16; ++i) { v[i].x *= sc[i]; v[i].y *= sc[i]; v[i].z *= sc[i]; v[i].w *= sc[i]; }
    }
#pragma unroll
    for (int i = 0; i < 16; ++i) { const int e = tid + i * 256, k = e >> 6, n4 = (e & 63) * 4; *(float4*)(lds + k * 260 + n4) = v[i]; }
    __syncthreads();
#pragma unroll
    for (int i = 0; i < 8; ++i) {
        const int n = tid, k8 = i * 8;
        const int gn = tn * 256 + n;
        if (gn < j.N) {
            u32x4 w;
            w.x = pack2(lds[(k8 + 0) * 260 + n], lds[(k8 + 1) * 260 + n]); w.y = pack2(lds[(k8 + 2) * 260 + n], lds[(k8 + 3) * 260 + n]);
            w.z = pack2(lds[(k8 + 4) * 260 + n], lds[(k8 + 5) * 260 + n]); w.w = pack2(lds[(k8 + 6) * 260 + n], lds[(k8 + 7) * 260 + n]);
            *(u32x4*)(j.dst + (size_t)rowmap(j.mode, gn) * j.ldd + tk * 64 + k8) = w;
        }
    }
}
DI void phase_convert_io(const P& p, int layer, char* ldsc, int b0, int bs) {
    float* lds = (float*)ldsc;
    unsigned char* W = p.ws + WS_W;
    const int li = layer >> 1;
    if ((layer & 1) == 0) {
        const float* ng = p.in[I_EVNORM] + li * 1024;
        const ConvJob j0{p.in[I_EVWIN] + (size_t)li * 1024 * 3752, (bf16_t*)(W + W_IN), 1024, 3752, 1024, 0, ng};
        for (int t = b0; t < 16 * 15; t += bs) conv_tile(j0, t, lds);
        if (li == 1) {
            const ConvJob j1{p.in[I_VRESDOWN], (bf16_t*)(W + W_IN) + (size_t)3752 * 1024, 1024, 32, 1024, 0, ng};
            for (int t = b0; t < 16; t += bs) conv_tile(j1, t, lds);
        }
        const ConvJob j2{p.in[I_EVWOUT] + (size_t)li * 1024 * 1024, (bf16_t*)(W + W_OUT), 1024, 1024, 1024, 0};
        for (int t = b0; t < 16 * 4; t += bs) conv_tile(j2, t, lds);
        {
            bf16_t* LW = (bf16_t*)(W + W_LW);
            for (int i = b0 * 256 + tidx(); i < 512 * 192; i += bs * 256) {
                const int ch = i / 192, j = i % 192;
                float v;
                if (j < 32) v = p.in[I_W2][((size_t)li * 32 + j) * 512 + ch];
                else if (j < 64) v = p.in[I_A2][((size_t)li * 32 + j - 32) * 512 + ch];
                else if (j < 160) v = p.in[I_G2][((size_t)li * 96 + j - 64) * 512 + ch];
                else v = (li == 1) ? p.in[I_V2][(size_t)(j - 160) * 512 + ch] : 0.f;
                LW[i] = f2bf(v);
            }
        }
        const int r0 = (li == 1) ? 3784 : 3752;
        bf16_t* z = (bf16_t*)(W + W_IN) + (size_t)r0 * 1024;
        const size_t n = (size_t)(EVPAD - r0) * 1024;
        for (size_t i = (size_t)b0 * 256 + tidx(); i < n; i += (size_t)bs * 256) z[i] = 0;
    } else {
        const ConvJob j0{p.in[I_ODWIN] + (size_t)li * 1024 * 4608, (bf16_t*)(W + W_IN), 1024, 4608, 1024, 0, p.in[I_ODNORM] + li * 1024};
        for (int t = b0; t < 16 * 18; t += bs) conv_tile(j0, t, lds);
        const ConvJob j2{p.in[I_ODWOUT] + (size_t)li * 512 * 1024, (bf16_t*)(W + W_OUT), 512, 1024, 512, 0};
        for (int t = b0; t < 8 * 4; t += bs) conv_tile(j2, t, lds);
    }
}
DI unsigned char* moe_w(const P& p, int layer) { return (layer & 1) ? (unsigned char*)p.out + ((size_t)32 << 20) - W_13 : p.ws + WS_W; }
DI void convert_moe_tile(const P& p, int layer, char* ldsc, int t);
DI void phase_convert_moe(const P& p, int layer, char* ldsc, int b0, int bs) {
    for (int t = b0; t < 16 * 3 * 16; t += bs) convert_moe_tile(p, layer, ldsc, t);
}
DI void convert_moe_tile(const P& p, int layer, char* ldsc, int t) {
    float* lds = (float*)ldsc;
    unsigned char* W = moe_w(p, layer);
    {
        const int e = t / 48, r = t % 48, which = r / 16, tile = r % 16;
        ConvJob j;
        const float* fg = p.in[I_FFNNORM] + layer * 1024;
        if (which == 0) j = ConvJob{p.in[I_W1] + ((size_t)layer * 16 + e) * 1024 * 256, (bf16_t*)(W + W_13) + (size_t)e * 512 * 1024, 1024, 256, 1024, 1, fg};
        else if (which == 1) j = ConvJob{p.in[I_W3] + ((size_t)layer * 16 + e) * 1024 * 256, (bf16_t*)(W + W_13) + (size_t)e * 512 * 1024, 1024, 256, 1024, 2, fg};
        else j = ConvJob{p.in[I_MW2] + ((size_t)layer * 16 + e) * 256 * 1024, (bf16_t*)(W + W_2) + (size_t)e * 1024 * 256, 256, 1024, 256, 0};
        conv_tile(j, tile, lds);
    }
}

DI void phase_rope(const P& p) {
    float2* tab = (float2*)(p.ws + WS_ROPE);
    const int* pos = (const int*)p.in[I_POS];
    for (int i = bidx() * 256 + tidx(); i < T * 32; i += gridDim.x * 256) {
        const int t = i >> 5, f = i & 31;
        const float inv = powf(10000.0f, -(float)f * (2.0f / 64.0f));
        const float ang = (float)pos[t] * inv;
        float s, c; sincosf(ang, &s, &c);
        tab[i] = make_float2(c, s);
    }
}

template <int MODE>
DI void phase_prep(const P& p, const float* gain, int layer) {
    const int lane = tidx() & 63, wid = tidx() >> 6;
    const int nw = gridDim.x * 4;
    bf16_t* hn = (bf16_t*)p.out;
    bf16_t* xb = (bf16_t*)(p.ws + WS_XB);
    const bf16_t* y0 = (const bf16_t*)(p.ws + WS_YS);
    const bf16_t* y1 = y0 + (size_t)T * 1024;
    float4 gq[4];
#pragma unroll
    for (int i = 0; i < 4; ++i) gq[i] = *(const float4*)(gain + i * 256 + lane * 4);
    for (int t = bidx() * 4 + wid; t < T; t += nw) {
        float4 v[4];
        float ss = 0.f;
#pragma unroll
        for (int i = 0; i < 4; ++i) {
            const size_t off = (size_t)t * 1024 + i * 256 + lane * 4;
            if (MODE == 0) v[i] = *(const float4*)(p.in[I_X] + off);
            else { const u32x2 xx = *(const u32x2*)(xb + off); v[i].x = __uint_as_float(xx.x << 16); v[i].y = __uint_as_float(xx.x & 0xffff0000u); v[i].z = __uint_as_float(xx.y << 16); v[i].w = __uint_as_float(xx.y & 0xffff0000u); }
            if (MODE == 1 || MODE == 3) {
                const u32x2 a = *(const u32x2*)(y0 + off), b = *(const u32x2*)(y1 + off);
                v[i].x += __uint_as_float(a.x << 16) + __uint_as_float(b.x << 16); v[i].y += __uint_as_float(a.x & 0xffff0000u) + __uint_as_float(b.x & 0xffff0000u);
                v[i].z += __uint_as_float(a.y << 16) + __uint_as_float(b.y << 16); v[i].w += __uint_as_float(a.y & 0xffff0000u) + __uint_as_float(b.y & 0xffff0000u);
            }
            ss += v[i].x * v[i].x + v[i].y * v[i].y + v[i].z * v[i].z + v[i].w * v[i].w;
        }
        ss = wave_sum(ss);
        const float rstd = rsqrtf(ss * (1.0f / 1024.0f) + 1e-6f);
        if ((MODE == 0 || MODE == 1) && lane == 0) ((float*)(p.ws + WS_RSIN))[t] = rstd;
        float lg[20];
        if (MODE == 2) {
#pragma unroll
            for (int q = 0; q < 20; ++q) lg[q] = 0.f;
        }
#pragma unroll
        for (int i = 0; i < 4; ++i) {
            const int col = i * 256 + lane * 4;
            const size_t off = (size_t)t * 1024 + col;
            const float4 g = gq[i];
            float4 h; h.x = v[i].x * rstd * g.x; h.y = v[i].y * rstd * g.y; h.z = v[i].z * rstd * g.z; h.w = v[i].w * rstd * g.w;
            bf16_t* hd = hn + off;
            if (MODE == 0 || MODE == 1) { u32x2 w; w.x = pack2(v[i].x, v[i].y); w.y = pack2(v[i].z, v[i].w); *(u32x2*)(xb + off) = w; }
            if (MODE == 3) *(float4*)(p.out + off) = h;
            else if (MODE == 2) { u32x2 w; w.x = pack2(h.x, h.y); w.y = pack2(h.z, h.w); *(u32x2*)hd = w; }
            if (MODE == 2) {
                const float hh[4] = {h.x, h.y, h.z, h.w};
                const float* wg = p.in[I_WGROUP] + (size_t)layer * 1024 * 4;
                const float* we = p.in[I_WEXPERT] + (size_t)layer * 4 * 1024 * 4;
#pragma unroll
                for (int e = 0; e < 4; ++e) {
                    const float4 a = *(const float4*)(wg + (size_t)(col + e) * 4);
                    lg[0] += hh[e] * a.x; lg[1] += hh[e] * a.y; lg[2] += hh[e] * a.z; lg[3] += hh[e] * a.w;
#pragma unroll
                    for (int g2 = 0; g2 < 4; ++g2) {
                        const float4 b = *(const float4*)(we + ((size_t)g2 * 1024 + col + e) * 4);
                        lg[4 + g2 * 4 + 0] += hh[e] * b.x; lg[4 + g2 * 4 + 1] += hh[e] * b.y; lg[4 + g2 * 4 + 2] += hh[e] * b.z; lg[4 + g2 * 4 + 3] += hh[e] * b.w;
                    }
                }
            }
        }
        if (MODE == 2) {
#pragma unroll
            for (int q = 0; q < 20; ++q) lg[q] = wave_sum(lg[q]);
            if (lane == 0) {
                int gs = 0; float gm = lg[0];
#pragma unroll
                for (int g2 = 1; g2 < 4; ++g2) if (lg[g2] > gm) { gm = lg[g2]; gs = g2; }
                float den = 0.f;
#pragma unroll
                for (int g2 = 0; g2 < 4; ++g2) den += __expf(lg[g2] - gm);
                const float pg = 1.f / den;
                float el[4];
#pragma unroll
                for (int e = 0; e < 4; ++e) el[e] = gs == 0 ? lg[4 + e] : gs == 1 ? lg[8 + e] : gs == 2 ? lg[12 + e] : lg[16 + e];
                int i1 = 0; float v1 = el[0];
#pragma unroll
                for (int e = 1; e < 4; ++e) if (el[e] > v1) { v1 = el[e]; i1 = e; }
                int i2 = 0; float v2 = -3.4e38f;
#pragma unroll
                for (int e = 0; e < 4; ++e) if (e != i1 && el[e] > v2) { v2 = el[e]; i2 = e; }
                const float e2 = __expf(v2 - v1);
                const float g1 = pg / (1.f + e2), g2v = pg * e2 / (1.f + e2);
                unsigned* cnt = (unsigned*)(p.ws + WS_CTL + CTL_CNT) + layer * 16 * 64;
                int* list = (int*)(p.ws + WS_LIST);
                float* gl = (float*)(p.ws + WS_GATE);
                const int ea = gs * 4 + i1, eb = gs * 4 + i2;
                const unsigned ra = atomicAdd(&cnt[ea * 64], 1u);
                list[ea * 16384 + ra] = t * 2; gl[ea * 16384 + ra] = g1;
                const unsigned rb = atomicAdd(&cnt[eb * 64], 1u);
                list[eb * 16384 + rb] = t * 2 + 1; gl[eb * 16384 + rb] = g2v;
            }
        }
    }
}


typedef __attribute__((address_space(3))) unsigned lds_u32;
DI void g_dma(unsigned m0v, unsigned voff, const char* sbase) {
    asm volatile("s_mov_b32 m0, %0\n\ts_nop 0\n\tglobal_load_lds_dwordx4 %1, %2" :: "s"(m0v), "v"(voff), "s"(sbase) : "memory", "m0");
}
DI void phase_router(const P& p, const float* gain, int layer, char* ldsc) {
    const int tid = tidx(), lane = tid & 63, wid = tid >> 6;
    const bf16_t* xb = (const bf16_t*)(p.ws + WS_XB);
    const float* wg = p.in[I_WGROUP] + (size_t)layer * 1024 * 4;
    const float* we = p.in[I_WEXPERT] + (size_t)layer * 4 * 1024 * 4;
    unsigned* cnt = (unsigned*)(p.ws + WS_CTL + CTL_CNT) + layer * 16 * 64;
    int* list = (int*)(p.ws + WS_LIST);
    float* gl = (float*)(p.ws + WS_GATE);
    float* rsl = (float*)(p.ws + WS_RSL);
    f32x4* WS = (f32x4*)ldsc;
    unsigned* lcnt = (unsigned*)(ldsc + 40960); unsigned* lbase = lcnt + 16; int* e_ent = (int*)(lcnt + 32); unsigned* r_ent = (unsigned*)(e_ent + 32); int* t_ent = (int*)(r_ent + 32); float* g_ent = (float*)(t_ent + 32); float* rs_ent = g_ent + 32;
    const unsigned wsb = (unsigned)__builtin_amdgcn_readfirstlane((int)((unsigned)(size_t)(lds_u32*)ldsc + wid * 1024));
    auto stage = [&](int i, int buf) {
        const unsigned voff = (unsigned)(i * 256 + lane * 4 + wid) * 16u;
#pragma unroll
        for (int r = 0; r < 5; ++r) g_dma(wsb + (unsigned)(buf * 1280 + r * 256) * 16u, voff, (const char*)(r == 0 ? wg : we + (size_t)(r - 1) * 4096));
    };
    u32x2 xq[4];
#pragma unroll
    for (int q = 0; q < 4; ++q) xq[q] = *(const u32x2*)(xb + (size_t)(bidx() * 16 + wid * 4 + q) * 1024 + lane * 4);
    for (int tb = bidx() * 16; tb < T; tb += gridDim.x * 16) {
        const int t0 = tb + wid * 4;
        __syncthreads();
        if (tid < 16) lcnt[tid] = 0u;
        stage(0, 0);
        float rstd[4];
        {
            const float pq = ((const float*)(p.ws + WS_SSQ))[(size_t)(lane & 15) * T + t0 + (lane >> 4)];
            float ss = pq;
            ss += __shfl_xor(ss, 1); ss += __shfl_xor(ss, 2); ss += __shfl_xor(ss, 4); ss += __shfl_xor(ss, 8);
#pragma unroll
            for (int q = 0; q < 4; ++q) rstd[q] = rsqrtf(__shfl(ss, q * 16) * (1.0f / 1024.0f) + 1e-6f);
        }
        float lg[4][20];
#pragma unroll
        for (int q = 0; q < 4; ++q)
#pragma unroll
            for (int j = 0; j < 20; ++j) lg[q][j] = 0.f;
#pragma unroll 1
        for (int i = 0; i < 4; ++i) {
            asm volatile("s_waitcnt vmcnt(0)" ::: "memory");
            __syncthreads();
            if (i + 1 < 4) stage(i + 1, (i + 1) & 1);
            const f32x4* W = WS + (i & 1) * 1280;
            const int col = i * 256 + lane * 4;
            const float4 g = *(const float4*)(gain + col);
            float hh[4][4];
#pragma unroll
            for (int q = 0; q < 4; ++q) {
                hh[q][0] = __uint_as_float(xq[q].x << 16) * rstd[q] * g.x; hh[q][1] = __uint_as_float(xq[q].x & 0xffff0000u) * rstd[q] * g.y; hh[q][2] = __uint_as_float(xq[q].y << 16) * rstd[q] * g.z; hh[q][3] = __uint_as_float(xq[q].y & 0xffff0000u) * rstd[q] * g.w;
            }
            {
                int tn0 = i + 1 < 4 ? t0 : t0 + (int)gridDim.x * 16; const int cn = ((i + 1) & 3) * 256 + lane * 4;
                tn0 = tn0 < T ? tn0 : t0;
#pragma unroll
                for (int q = 0; q < 4; ++q) xq[q] = *(const u32x2*)(xb + (size_t)(tn0 + q) * 1024 + cn);
            }
#pragma unroll
            for (int e = 0; e < 4; ++e) {
                const f32x4 a = W[(0 * 4 + e) * 64 + lane];
#pragma unroll
                for (int q = 0; q < 4; ++q) { lg[q][0] += hh[q][e] * a[0]; lg[q][1] += hh[q][e] * a[1]; lg[q][2] += hh[q][e] * a[2]; lg[q][3] += hh[q][e] * a[3]; }
#pragma unroll
                for (int g2 = 0; g2 < 4; ++g2) {
                    const f32x4 b = W[((1 + g2) * 4 + e) * 64 + lane];
#pragma unroll
                    for (int q = 0; q < 4; ++q) { lg[q][4 + g2 * 4] += hh[q][e] * b[0]; lg[q][5 + g2 * 4] += hh[q][e] * b[1]; lg[q][6 + g2 * 4] += hh[q][e] * b[2]; lg[q][7 + g2 * 4] += hh[q][e] * b[3]; }
                }
            }
        }
        {
            float v[80];
#pragma unroll
            for (int q = 0; q < 4; ++q)
#pragma unroll
                for (int j = 0; j < 20; ++j) v[q * 20 + j] = lg[q][j];
#define RT_STEP(MASK, H)                                                                                        \
            { const bool hi = (lane & (MASK)) != 0;                                                             \
              _Pragma("unroll") for (int i = 0; i < (H); ++i) {                                                 \
                  const float a = v[i], b = v[i + (H)];                                                         \
                  const float r = __shfl_xor(hi ? a : b, (MASK));                                               \
                  v[i] = (hi ? b : a) + r; } }
            RT_STEP(32, 40) RT_STEP(16, 20) RT_STEP(8, 10) RT_STEP(4, 5)
            v[5] = 0.f;
            RT_STEP(2, 3)
            v[3] = 0.f;
            RT_STEP(1, 2)
#undef RT_STEP
            float* red = rs_ent + 32 + wid * 80;
#pragma unroll
            for (int j = 0; j < 2; ++j) {
                const int a = j + ((lane & 1) ? 2 : 0), b = a + ((lane & 2) ? 3 : 0);
                const int f = b + ((lane & 4) ? 5 : 0) + ((lane & 8) ? 10 : 0) + ((lane & 16) ? 20 : 0) + ((lane & 32) ? 40 : 0);
                if (a < 3 && b < 5) red[f] = v[j];
            }
            if (lane < 4) {
                float lq[20];
#pragma unroll
                for (int j = 0; j < 20; ++j) lq[j] = red[lane * 20 + j];
                const float rsq = lane == 0 ? rstd[0] : lane == 1 ? rstd[1] : lane == 2 ? rstd[2] : rstd[3];
                const int t = t0 + lane;
                int gs = 0; float gm = lq[0];
#pragma unroll
                for (int g2 = 1; g2 < 4; ++g2) if (lq[g2] > gm) { gm = lq[g2]; gs = g2; }
                float den = 0.f;
#pragma unroll
                for (int g2 = 0; g2 < 4; ++g2) den += __expf(lq[g2] - gm);
                const float pg = 1.f / den;
                float el[4];
#pragma unroll
                for (int e = 0; e < 4; ++e) el[e] = gs == 0 ? lq[4 + e] : gs == 1 ? lq[8 + e] : gs == 2 ? lq[12 + e] : lq[16 + e];
                int i1 = 0; float v1 = el[0];
#pragma unroll
                for (int e = 1; e < 4; ++e) if (el[e] > v1) { v1 = el[e]; i1 = e; }
                int i2 = 0; float v2 = -3.4e38f;
#pragma unroll
                for (int e = 0; e < 4; ++e) if (e != i1 && el[e] > v2) { v2 = el[e]; i2 = e; }
                const float e2 = __expf(v2 - v1);
                const float g1 = pg / (1.f + e2), g2v = pg * e2 / (1.f + e2);
                const int ea = gs * 4 + i1, eb = gs * 4 + i2;
                const int sl = (wid * 4 + lane) * 2;
                e_ent[sl] = ea; r_ent[sl] = atomicAdd(&lcnt[ea], 1u); t_ent[sl] = t * 2; g_ent[sl] = g1; rs_ent[sl] = rsq;
                e_ent[sl + 1] = eb; r_ent[sl + 1] = atomicAdd(&lcnt[eb], 1u); t_ent[sl + 1] = t * 2 + 1; g_ent[sl + 1] = g2v; rs_ent[sl + 1] = rsq;
            }
        }
        __syncthreads();
        if (tid < 16) lbase[tid] = lcnt[tid] ? atomicAdd(&cnt[tid * 64], lcnt[tid]) : 0u;
        __syncthreads();
        if (tid < 32) {
            const int e = e_ent[tid];
            const unsigned pos = (lbase[e] + r_ent[tid]) & 16383u;
            list[e * 16384 + pos] = t_ent[tid]; gl[e * 16384 + pos] = g_ent[tid]; rsl[e * 16384 + pos] = rs_ent[tid];
        }
    }
}

constexpr int GBK = 64;
struct TileP { int arow[4]; unsigned bo[4]; };
struct GOps { const char* A; unsigned la; const char* A2; unsigned la2; const char* B; };
DI void gemm_core(const GOps& o, const TileP& tp, int K, char* lds, f32x4 (&acc)[4][4], int ksplit, bool primed, const TileP& nx, bool have_nx) {
    const int tid = tidx(), wid = tid >> 6, lane = tid & 63, wr = wid >> 1, wc = wid & 1, fr = lane & 15, fq = lane >> 4;
    const unsigned scol = ((tid & 7) ^ ((tid >> 3) & 7)) * 16;
#pragma unroll
    for (int n = 0; n < 4; ++n)
#pragma unroll
        for (int m = 0; m < 4; ++m) acc[n][m] = (f32x4){0.f, 0.f, 0.f, 0.f};
    const int nk = K / GBK;
    if (!primed) {
        __syncthreads();
#pragma unroll
        for (int i = 0; i < 4; ++i) {
            __builtin_amdgcn_global_load_lds((const unsigned*)(o.A + (__umul24(tp.arow[i], o.la) + scol)), (lds_u32*)(lds + tid * 16 + i * 4096), 16, 0, 0);
            __builtin_amdgcn_global_load_lds((const unsigned*)(o.B + (tp.bo[i] + scol)), (lds_u32*)(lds + 16384 + tid * 16 + i * 4096), 16, 0, 0);
        }
    }
    const int sw = fr & 7;
    const unsigned aoff = (wr * 64 + fr) * 128, boff = (wc * 64 + fr) * 128, co0 = (fq ^ sw) * 16, co1 = ((4 + fq) ^ sw) * 16;
    bf16x8 a0[4], b0[4], a1[4], b1[4];
#define G_ISSUE(kt_)                                                                                                                        \
    if ((kt_) + 1 < nk) {                                                                                                                   \
        char* nb = lds + (((kt_) + 1) & 1) * 32768;                                                                                         \
        const unsigned ko = ((kt_) + 1) * (GBK * 2) + scol;                                                                                 \
        const bool hi = ((kt_) + 1) * GBK >= ksplit;                                                                                        \
        const char* Ab = hi ? o.A2 : o.A; const unsigned la = hi ? o.la2 : o.la;                                                            \
        _Pragma("unroll") for (int i = 0; i < 4; ++i) {                                                                                     \
            __builtin_amdgcn_global_load_lds((const unsigned*)(Ab + (__umul24(tp.arow[i], la) + ko)), (lds_u32*)(nb + tid * 16 + i * 4096), 16, 0, 0);   \
            __builtin_amdgcn_global_load_lds((const unsigned*)(o.B + (tp.bo[i] + ko)), (lds_u32*)(nb + 16384 + tid * 16 + i * 4096), 16, 0, 0);      \
        }                                                                                                                                   \
    } else if (have_nx) {        \
        _Pragma("unroll") for (int i = 0; i < 4; ++i) {                                                                                     \
            __builtin_amdgcn_global_load_lds((const unsigned*)(o.A + (__umul24(nx.arow[i], o.la) + scol)), (lds_u32*)(lds + tid * 16 + i * 4096), 16, 0, 0);          \
            __builtin_amdgcn_global_load_lds((const unsigned*)(o.B + (nx.bo[i] + scol)), (lds_u32*)(lds + 16384 + tid * 16 + i * 4096), 16, 0, 0);  \
        }                                                                                                                                   \
    }
#define G_READ(A_, B_, AD_)                                                                                                                 \
    asm volatile("ds_read_b128 %0, %8\n\tds_read_b128 %1, %8 offset:2048\n\tds_read_b128 %2, %8 offset:4096\n\tds_read_b128 %3, %8 offset:6144\n\t"       \
                 "ds_read_b128 %4, %9 offset:16384\n\tds_read_b128 %5, %9 offset:18432\n\tds_read_b128 %6, %9 offset:20480\n\tds_read_b128 %7, %9 offset:22528" \
                 : "=&v"(A_[0]), "=&v"(A_[1]), "=&v"(A_[2]), "=&v"(A_[3]), "=&v"(B_[0]), "=&v"(B_[1]), "=&v"(B_[2]), "=&v"(B_[3]) : "v"((AD_) + aoff), "v"((AD_) + boff) : "memory");
#define G_WAIT(A_, B_, N_)                                                                                                                  \
    asm volatile("s_waitcnt lgkmcnt(" #N_ ")" : "+v"(A_[0]), "+v"(A_[1]), "+v"(A_[2]), "+v"(A_[3]), "+v"(B_[0]), "+v"(B_[1]), "+v"(B_[2]), "+v"(B_[3]) :: "memory");
#define G_MMA(A_, B_)                                                                                                                       \
    _Pragma("unroll") for (int n = 0; n < 4; ++n)                                                                                           \
        _Pragma("unroll") for (int m = 0; m < 4; ++m) acc[n][m] = __builtin_amdgcn_mfma_f32_16x16x32_bf16(B_[n], A_[m], acc[n][m], 0, 0, 0);
    const unsigned lbase = (unsigned)(size_t)(lds_u32*)lds;
    __builtin_amdgcn_s_waitcnt(0x0070);
    __builtin_amdgcn_s_barrier();
    G_ISSUE(0)
    G_READ(a0, b0, lbase + co0)
    G_READ(a1, b1, lbase + co1)
    G_WAIT(a0, b0, 8)
    __builtin_amdgcn_sched_barrier(0);
    G_MMA(a0, b0)
    __builtin_amdgcn_sched_barrier(0);
    G_WAIT(a1, b1, 0)
#pragma unroll 1
    for (int kt = 1; kt < nk; ++kt) {
        __builtin_amdgcn_s_waitcnt(0x0070);
        __builtin_amdgcn_s_barrier();
        G_ISSUE(kt)
        const unsigned S = lbase + (kt & 1) * 32768;
        G_READ(a0, b0, S + co0)
        __builtin_amdgcn_sched_barrier(0);
        G_MMA(a1, b1)
        __builtin_amdgcn_sched_barrier(0);
        G_READ(a1, b1, S + co1)
        G_WAIT(a0, b0, 8)
        __builtin_amdgcn_sched_barrier(0);
        G_MMA(a0, b0)
        __builtin_amdgcn_sched_barrier(0);
        G_WAIT(a1, b1, 0)
    }
    G_MMA(a1, b1)
#undef G_ISSUE
#undef G_READ
#undef G_WAIT
#undef G_MMA
}

enum { EPI_EVEN_IN = 0, EPI_ODD_IN, EPI_RESID };
template <int EPI>
DI void phase_gemm(const P& p, const bf16_t* A, int lda, const bf16_t* Bt, int K, int ntn, char* lds, bool dry = false, const bf16_t* A2 = nullptr, int lda2 = 0, int ksplit = 1 << 30) {
    const int tid = tidx(), wid = tid >> 6, lane = tid & 63, wr = wid >> 1, wc = wid & 1, fr = lane & 15, fq = lane >> 4;
    const int ntm = T / 128, ntiles = ntm * ntn;
    auto fill = [&](TileP& t, int tile) {
        const int tn = tile / ntm, tm = tile % ntm, r = tid >> 3;
#pragma unroll
        for (int i = 0; i < 4; ++i) { t.arow[i] = tm * 128 + r + 32 * i; t.bo[i] = (unsigned)(tn * 128 + r + 32 * i) * (unsigned)(K * 2); }
    };
    const GOps gop{(const char*)A, (unsigned)lda * 2u, (const char*)(A2 ? A2 : A), (unsigned)(A2 ? lda2 : lda) * 2u, (const char*)Bt};
    TileP cur, nxt;
    bool primed = false;
    fill(cur, bidx() < ntiles ? bidx() : 0); nxt = cur;
    for (int tile = bidx(); tile < ntiles; tile += gridDim.x) {
        const int tn = tile / ntm, tm = tile % ntm;
        const bool have_next = tile + (int)gridDim.x < ntiles;
        if (have_next) fill(nxt, tile + gridDim.x);
        f32x4 acc[4][4];
        const int m0 = tm * 128 + wr * 64, n0 = tn * 128 + wc * 64;
        float rsr[4];
        if (EPI != EPI_RESID) {
#pragma unroll
            for (int m = 0; m < 4; ++m) rsr[m] = ((const float*)(p.ws + WS_RSIN))[m0 + m * 16 + fr];
        }
        gemm_core(gop, cur, K, lds, acc, ksplit, primed, nxt, have_next);
        primed = have_next; cur = nxt;
        if (EPI != EPI_RESID) {
#pragma unroll
            for (int m = 0; m < 4; ++m)
#pragma unroll
                for (int n = 0; n < 4; ++n) acc[n][m] *= rsr[m];
        }
        if (EPI == EPI_EVEN_IN) {
            bf16_t* C = (bf16_t*)(p.ws + WS_PROJ);
#pragma unroll
            for (int m = 0; m < 4; ++m)
#pragma unroll
                for (int n = 0; n < 4; ++n) {
                    const int row = m0 + m * 16 + fr, col = n0 + n * 16 + fq * 4;
                    if (col < EVC) { u32x2 w; w.x = pack2(acc[n][m][0], acc[n][m][1]); w.y = pack2(acc[n][m][2], acc[n][m][3]); *(u32x2*)(C + (size_t)row * EVLD + col) = w; }
                }
        } else if (EPI == EPI_ODD_IN) {
            bf16_t* C = (bf16_t*)(p.ws + WS_QK);
            const float2* tab = (const float2*)(p.ws + WS_ROPE);
            if (n0 < 3072) {
#pragma unroll
                for (int m = 0; m < 4; ++m) {
                    const int row = m0 + m * 16 + fr;
#pragma unroll
                    for (int n = 0; n < 2; ++n) {
                        float lo[4], hi[4];
#pragma unroll
                        for (int j = 0; j < 4; ++j) {
                            const float2 cs = tab[(size_t)row * 32 + n * 16 + fq * 4 + j];
                            const float x1 = acc[n][m][j], x2 = acc[n + 2][m][j];
                            lo[j] = x1 * cs.x - x2 * cs.y; hi[j] = x2 * cs.x + x1 * cs.y;
                        }
                        u32x2 w; w.x = pack2(lo[0], lo[1]); w.y = pack2(lo[2], lo[3]);
                        *(u32x2*)(C + (size_t)row * 3072 + n0 + n * 16 + fq * 4) = w;
                        w.x = pack2(hi[0], hi[1]); w.y = pack2(hi[2], hi[3]);
                        *(u32x2*)(C + (size_t)row * 3072 + n0 + (n + 2) * 16 + fq * 4) = w;
                    }
                }
            }
            if (tn * 128 >= 3072) {
                bf16_t* VT = (bf16_t*)(p.ws + WS_VT);
                const int hg0 = (tn * 128 - 3072) >> 6, g = hg0 >> 3, lg2 = g * 2, dil = 1 << lg2, L = SEQ >> lg2, run = 128 >> lg2;
                __syncthreads();
#pragma unroll
                for (int m = 0; m < 4; ++m)
#pragma unroll
                    for (int n = 0; n < 4; ++n)
#pragma unroll
                        for (int j = 0; j < 4; ++j)
                            *(bf16_t*)(lds + 32768 + (wc * 64 + n * 16 + fq * 4 + j) * 272 + (wr * 64 + m * 16 + fr) * 2) = f2bf(acc[n][m][j]);
                __syncthreads();
                const int bb = (tm * 128) >> 12, s0 = (tm * 128) & (SEQ - 1);
#pragma unroll
                for (int q = 0; q < 8; ++q) {
                    const int item = tid + q * 256, dim = item >> 4, o0 = (item & 15) * 8;
                    const int rr = o0 / run, i0 = o0 % run;
                    const char* src = lds + 32768 + dim * 272 + (rr + dil * i0) * 2;
                    float e8[8];
#pragma unroll
                    for (int e = 0; e < 8; ++e) e8[e] = bf2f(*(const bf16_t*)(src + e * dil * 2));
                    u32x4 w; w.x = pack2(e8[0], e8[1]); w.y = pack2(e8[2], e8[3]); w.z = pack2(e8[4], e8[5]); w.w = pack2(e8[6], e8[7]);
                    const int hg = hg0 + (dim >> 6);
                    *(u32x4*)(VT + ((size_t)((bb * 24 + hg) * dil + rr) * 64 + (dim & 63)) * L + (s0 >> lg2) + i0) = w;
                }
            }
        } else {
            float* ssq = (float*)(p.ws + WS_SSQ) + (size_t)(tn * 2 + wc) * T;
#pragma unroll
            for (int m = 0; m < 4; ++m) {
                float ss = 0.f;
#pragma unroll
                for (int n = 0; n < 4; ++n) {
                    const size_t qo = (size_t)(m0 + m * 16 + fr) * 1024 + n0 + n * 16 + fq * 4;
                    bf16_t* q = dry ? (bf16_t*)(p.ws + WS_DUMMY) + (qo & 0x7FFFF) : (bf16_t*)(p.ws + WS_XB) + qo;
                    const u32x2 xx = *(const u32x2*)q;
                    float4 v;
                    v.x = __uint_as_float(xx.x << 16) + acc[n][m][0]; v.y = __uint_as_float(xx.x & 0xffff0000u) + acc[n][m][1]; v.z = __uint_as_float(xx.y << 16) + acc[n][m][2]; v.w = __uint_as_float(xx.y & 0xffff0000u) + acc[n][m][3];
                    u32x2 w; w.x = pack2(v.x, v.y); w.y = pack2(v.z, v.w);
                    *(u32x2*)q = w;
                    ss += v.x * v.x + v.y * v.y + v.z * v.z + v.w * v.w;
                }
                ss += __shfl_xor(ss, 16); ss += __shfl_xor(ss, 32);
                if (fq == 0 && !dry) ssq[m0 + m * 16 + fr] = ss;
            }
        }
    }
}

DI int phase_moe_up(const P& p, int layer, char* lds) {
    const int tid = tidx(), wid = tid >> 6, lane = tid & 63, wr = wid >> 1, wc = wid & 1, fr = lane & 15, fq = lane >> 4;
    const unsigned* cntb = (const unsigned*)(p.ws + WS_CTL + CTL_CNT) + layer * 16 * 64;
    unsigned cnt[16];
#pragma unroll
    for (int e = 0; e < 16; ++e) cnt[e] = cntb[e * 64];
    const int* list = (const int*)(p.ws + WS_LIST);
    const float* gl = (const float*)(p.ws + WS_GATE);
    const bf16_t* hn = (const bf16_t*)(p.ws + WS_XB);
    const float* rsl = (const float*)(p.ws + WS_RSL);
    const bf16_t* W13 = (const bf16_t*)(moe_w(p, layer) + W_13);
    bf16_t* H = (bf16_t*)(p.ws + WS_H);
    int ttot = 0;
#pragma unroll
    for (int e = 0; e < 16; ++e) ttot += ((int)cnt[e] + 127) >> 7;
    const int ntiles = ttot * 4;
    auto locate = [&](int tile, int& e, int& lt, int& ce, int& rbe, int& tn) {
        const int mt = tile >> 2; tn = tile & 3;
        int tbe = 0, acc_t = 0; e = 0;
#pragma unroll
        for (int q = 0; q < 16; ++q) { const int nt = ((int)cnt[q] + 127) >> 7; if (mt >= acc_t) { e = q; tbe = acc_t; } acc_t += nt; }
        lt = mt - tbe; ce = (int)cnt[e]; rbe = tbe * 128;
    };
    auto fill = [&](TileP& t, int tile) {
        int e, lt, ce, rbe, tn; locate(tile, e, lt, ce, rbe, tn);
        const int r = tid >> 3;
#pragma unroll
        for (int i = 0; i < 4; ++i) {
            const int ii = lt * 128 + r + 32 * i;
            const int tk = ii < ce ? (list[e * 16384 + ii] >> 1) : 0;
            t.arow[i] = tk;
            t.bo[i] = (unsigned)(e * 512 + tn * 128 + r + 32 * i) * 2048u;
        }
    };
    const GOps gop{(const char*)hn, 2048u, (const char*)hn, 2048u, (const char*)W13};
    TileP cur, nxt;
    bool primed = false;
    fill(cur, bidx() < ntiles ? bidx() : 0); nxt = cur;
    for (int tile = bidx(); tile < ntiles; tile += gridDim.x) {
        int e, lt, ce, rbe, tn; locate(tile, e, lt, ce, rbe, tn);
        const bool have_next = tile + (int)gridDim.x < ntiles;
        if (have_next) fill(nxt, tile + gridDim.x);
        f32x4 acc[4][4];
        gemm_core(gop, cur, 1024, lds, acc, 1 << 30, primed, nxt, have_next);
        primed = have_next; cur = nxt;
#pragma unroll
        for (int m = 0; m < 4; ++m) {
            const int li = lt * 128 + wr * 64 + m * 16 + fr;
            if (li < ce) {
                const float g = gl[e * 16384 + li], rs = rsl[e * 16384 + li];
                bf16_t* hrow = H + (size_t)(rbe + li) * 256;
#pragma unroll
                for (int n = 0; n < 4; n += 2) {
                    float o[4];
#pragma unroll
                    for (int j = 0; j < 4; ++j) o[j] = siluf_(acc[n][m][j] * rs) * (acc[n + 1][m][j] * rs) * g;
                    const int f = tn * 64 + wc * 32 + (n >> 1) * 16 + fq * 4;
                    u32x2 w; w.x = pack2(o[0], o[1]); w.y = pack2(o[2], o[3]);
                    *(u32x2*)(hrow + f) = w;
                }
            }
        }
    }
    return ntiles;
}
DI void phase_moe_down(const P& p, int layer, char* lds) {
    const int tid = tidx(), wid = tid >> 6, lane = tid & 63, wr = wid >> 1, wc = wid & 1, fr = lane & 15, fq = lane >> 4;
    const unsigned* cntb = (const unsigned*)(p.ws + WS_CTL + CTL_CNT) + layer * 16 * 64;
    unsigned cnt[16];
#pragma unroll
    for (int e = 0; e < 16; ++e) cnt[e] = cntb[e * 64];
    const int* list = (const int*)(p.ws + WS_LIST);
    const bf16_t* W2 = (const bf16_t*)(moe_w(p, layer) + W_2);
    const bf16_t* H = (const bf16_t*)(p.ws + WS_H);
    bf16_t* ys = (bf16_t*)(p.ws + WS_YS);
    int ttot = 0;
#pragma unroll
    for (int e = 0; e < 16; ++e) ttot += ((int)cnt[e] + 127) >> 7;
    const int ntiles = ttot * 8;
    auto locate = [&](int tile, int& e, int& lt, int& ce, int& rbe, int& tn) {
        const int mt = tile >> 3; tn = tile & 7;
        int tbe = 0, acc_t = 0; e = 0;
#pragma unroll
        for (int q = 0; q < 16; ++q) { const int nt = ((int)cnt[q] + 127) >> 7; if (mt >= acc_t) { e = q; tbe = acc_t; } acc_t += nt; }
        lt = mt - tbe; ce = (int)cnt[e]; rbe = tbe * 128;
    };
    auto fill = [&](TileP& t, int tile) {
        int e, lt, ce, rbe, tn; locate(tile, e, lt, ce, rbe, tn);
        const int r = tid >> 3;
#pragma unroll
        for (int i = 0; i < 4; ++i) { t.arow[i] = rbe + lt * 128 + r + 32 * i; t.bo[i] = (unsigned)(e * 1024 + tn * 128 + r + 32 * i) * 512u; }
    };
    const GOps gop{(const char*)H, 512u, (const char*)H, 512u, (const char*)W2};
    TileP cur, nxt;
    bool primed = false;
    fill(cur, bidx() < ntiles ? bidx() : 0); nxt = cur;
    for (int tile = bidx(); tile < ntiles; tile += gridDim.x) {
        int e, lt, ce, rbe, tn; locate(tile, e, lt, ce, rbe, tn);
        const bool have_next = tile + (int)gridDim.x < ntiles;
        if (have_next) fill(nxt, tile + gridDim.x);
        f32x4 acc[4][4];
        gemm_core(gop, cur, 256, lds, acc, 1 << 30, primed, nxt, have_next);
        primed = have_next; cur = nxt;
#pragma unroll
        for (int m = 0; m < 4; ++m) {
            const int li = lt * 128 + wr * 64 + m * 16 + fr;
            if (li < ce) {
                const int ts = list[e * 16384 + li];
                bf16_t* yrow = ys + ((size_t)(ts & 1) * T + (ts >> 1)) * 1024 + tn * 128 + wc * 64 + fq * 4;
#pragma unroll
                for (int n = 0; n < 4; ++n) { u32x2 w; w.x = pack2(acc[n][m][0], acc[n][m][1]); w.y = pack2(acc[n][m][2], acc[n][m][3]); *(u32x2*)(yrow + n * 16) = w; }
            }
        }
    }
}


typedef float f32x16 __attribute__((ext_vector_type(16)));
DI f32x4 mfma16(bf16x8 a, bf16x8 b, f32x4 c) { return __builtin_amdgcn_mfma_f32_16x16x32_bf16(a, b, c, 0, 0, 0); }
DI f32x16 mfma32(bf16x8 a, bf16x8 b, f32x16 c) { return __builtin_amdgcn_mfma_f32_32x32x16_bf16(a, b, c, 0, 0, 0); }
DI f32x4 tile16(const char* X, int ldx, int row0, const char* Y, int ldy, int col0, int K) {
    const int lane = tidx() & 63, fr = lane & 15, fq = lane >> 4;
    const char* xp = X + (row0 + fr) * ldx + fq * 16; const char* yp = Y + (col0 + fr) * ldy + fq * 16;
    bf16x8 a[4], b[4];
#pragma unroll
    for (int s = 0; s < 4; ++s) if (s * 32 < K) { a[s] = *(const bf16x8*)(xp + s * 64); b[s] = *(const bf16x8*)(yp + s * 64); }
    f32x4 acc = {0.f, 0.f, 0.f, 0.f};
#pragma unroll
    for (int s = 0; s < 4; ++s) if (s * 32 < K) acc = mfma16(a[s], b[s], acc);
    return acc;
}
DI bf16x8 pack_step(const f32x16& x, int s) {
    u32x4 r;
    r.x = pack2(x[8 * s + 0], x[8 * s + 1]); r.y = pack2(x[8 * s + 2], x[8 * s + 3]);
    r.z = pack2(x[8 * s + 4], x[8 * s + 5]); r.w = pack2(x[8 * s + 6], x[8 * s + 7]);
    return __builtin_bit_cast(bf16x8, r);
}

constexpr int GP_LF = 0, GP_T = 17408, GP_VEC = GP_T + 9216, GP_U = GP_VEC + 1024, GP_END = GP_U + 36864;
DI void gdn_prep_unit(const P& p, int li, int ch, char* lds) {
    const int tid = tidx(), lane = tid & 63, wid = tid >> 6, fr = lane & 15, fq = lane >> 4;
    const int h = ch & 3, n = (ch >> 2) & 63, b = ch >> 8;
    const int t0 = b * SEQ + n * 64;
    float* Lf = (float*)(lds + GP_LF);
    char* Trow = lds + GP_T;
    float* gcs = (float*)(lds + GP_VEC); float* egc = gcs + 64; float* bet = gcs + 128; float* ekd = gcs + 192;
    char* Qrow = lds + GP_U; char* Krow = Qrow + 17408; char* VbT = lds + GP_U; char* KbgT = VbT + 18432;
    const bf16_t* proj = (const bf16_t*)(p.ws + WS_PROJ);
    unsigned char* ops = p.ws + WS_GOPS + (size_t)ch * GOPS_CH;
    const float* cw = p.in[I_CONVW] + (size_t)li * 4 * 1536;
    const int c = tid >> 2, cq = tid & 3;
    __syncthreads();
    float* cwl = (float*)(lds + GP_END);
    for (int i = tid; i < 4 * 3 * 32; i += 256) {
        const int j = i / 96, r = i % 96, sl = r >> 5, q4 = (r & 31) * 4;
        *(f32x4*)(cwl + (j * 3 + sl) * 128 + q4) = *(const f32x4*)(cw + j * 1536 + sl * 512 + h * 128 + q4);
    }
    __syncthreads();
    unsigned vvp[16];
#pragma unroll 1
    for (int which = 0; which < 3; ++which) {
        const int col0 = which * 512 + h * 128 + cq * 32;
        u32x4 xin[4][4];
#pragma unroll
        for (int j = 0; j < 4; ++j) {
            const int sp = n * 64 + c - 3 + j;
            const bf16_t* src = proj + (size_t)(b * SEQ + (sp < 0 ? 0 : sp)) * EVLD + col0;
#pragma unroll
            for (int i4 = 0; i4 < 4; ++i4) xin[j][i4] = *(const u32x4*)(src + i4 * 8);
        }
        float acc[32];
#pragma unroll
        for (int i = 0; i < 32; ++i) acc[i] = 0.f;
#pragma unroll
        for (int j = 0; j < 4; ++j) {
            const float ok = (n * 64 + c - 3 + j) >= 0 ? 1.f : 0.f;
            const float* wj = cwl + (j * 3 + which) * 128 + cq * 32;
#pragma unroll
            for (int i4 = 0; i4 < 4; ++i4) {
                const f32x4 wa = *(const f32x4*)(wj + i4 * 8), wb = *(const f32x4*)(wj + i4 * 8 + 4);
                const u32x4 w = xin[j][i4];
                acc[i4 * 8 + 0] += ok * wa[0] * __uint_as_float(w[0] << 16); acc[i4 * 8 + 1] += ok * wa[1] * __uint_as_float(w[0] & 0xffff0000u);
                acc[i4 * 8 + 2] += ok * wa[2] * __uint_as_float(w[1] << 16); acc[i4 * 8 + 3] += ok * wa[3] * __uint_as_float(w[1] & 0xffff0000u);
                acc[i4 * 8 + 4] += ok * wb[0] * __uint_as_float(w[2] << 16); acc[i4 * 8 + 5] += ok * wb[1] * __uint_as_float(w[2] & 0xffff0000u);
                acc[i4 * 8 + 6] += ok * wb[2] * __uint_as_float(w[3] << 16); acc[i4 * 8 + 7] += ok * wb[3] * __uint_as_float(w[3] & 0xffff0000u);
            }
        }
        float ss = 0.f;
#pragma unroll
        for (int i = 0; i < 32; ++i) { acc[i] = siluf_(acc[i]); ss += acc[i] * acc[i]; }
        ss += __shfl_xor(ss, 1); ss += __shfl_xor(ss, 2);
        const float rn = which == 2 ? 1.f : rsqrtf(ss + 1e-6f) * (which == 0 ? 0.08838834764831845f : 1.f);
        unsigned pk[16];
#pragma unroll
        for (int i = 0; i < 16; ++i) pk[i] = pack2(acc[2 * i] * rn, acc[2 * i + 1] * rn);
        if (which < 2) {
            char* img = which == 0 ? Qrow : Krow;
#pragma unroll
            for (int i4 = 0; i4 < 4; ++i4) { u32x4 w; w.x = pk[i4 * 4]; w.y = pk[i4 * 4 + 1]; w.z = pk[i4 * 4 + 2]; w.w = pk[i4 * 4 + 3]; *(u32x4*)(img + c * 272 + (cq * 32 + i4 * 8) * 2) = w; }
        } else {
#pragma unroll
            for (int i = 0; i < 16; ++i) vvp[i] = pk[i];
        }
    }
    if (cq == 0) {
        const float a = bf2f(proj[(size_t)(t0 + c) * EVLD + 2048 + h]);
        const float bb = bf2f(proj[(size_t)(t0 + c) * EVLD + 2052 + h]);
        const float Aexp = __expf(p.in[I_ALOG][li * 4 + h]), dtb = p.in[I_DTB][li * 4 + h];
        gcs[c] = -Aexp * softplusf_(a + dtb);
        bet[c] = sigmoidf_(bb);
    }
    __syncthreads();
    if (wid == 0) {
        float x = gcs[lane];
#pragma unroll
        for (int o = 1; o < 64; o <<= 1) { const float y = __shfl_up(x, o); if (lane >= o) x += y; }
        const float gl = __shfl(x, 63);
        gcs[lane] = x; egc[lane] = __expf(x); ekd[lane] = __expf(gl - x);
        if (lane == 63) ((float*)(p.ws + WS_CTL + CTL_EGL))[ch] = __expf(gl);
    }
    __syncthreads();
    {
        const int ti = wid;
#pragma unroll
        for (int tj = 0; tj < 4; ++tj) {
            if (tj <= ti) {
                const f32x4 kk = tile16(Krow, 272, 16 * ti, Krow, 272, 16 * tj, 128);
                const int c2 = 16 * tj + fr;
                f32x4 lv;
#pragma unroll
                for (int r = 0; r < 4; ++r) {
                    const int c1 = 16 * ti + fq * 4 + r;
                    lv[r] = (c1 > c2) ? bet[c1] * kk[r] * __expf(gcs[c1] - gcs[c2]) : 0.f;
                }
                *(f32x4*)&Lf[c2 * 68 + 16 * ti + fq * 4] = lv;
            }
            f32x4 qk = {0.f, 0.f, 0.f, 0.f};
            if (tj <= ti) qk = tile16(Krow, 272, 16 * tj, Qrow, 272, 16 * ti, 128);
            const int c1 = 16 * ti + fr;
            float o4[4];
#pragma unroll
            for (int r = 0; r < 4; ++r) { const int c2 = 16 * tj + fq * 4 + r; o4[r] = (c1 >= c2) ? qk[r] * __expf(gcs[c1] - gcs[c2]) : 0.f; }
            const int mt = c1 >> 5, rr = c1 & 31, hh = fq & 1, jg = fq >> 1;
            u32x2 w; w.x = pack2(o4[0], o4[1]); w.y = pack2(o4[2], o4[3]);
            *(u32x2*)(ops + GO_AF + ((size_t)((mt * 4 + tj) * 64 + hh * 32 + rr) * 8 + jg * 4) * 2) = w;
        }
#pragma unroll
        for (int i = 0; i < 4; ++i) {
            const int idx = tid + i * 256;
            {
                const int mt = idx >> 9, ks = (idx >> 6) & 7, l2 = idx & 63, rr = l2 & 31, hh = l2 >> 5, cc = 32 * mt + rr;
                const float sc = egc[cc];
                const u32x2 lo = *(const u32x2*)(Qrow + cc * 272 + (16 * ks + 4 * hh) * 2), hi = *(const u32x2*)(Qrow + cc * 272 + (16 * ks + 8 + 4 * hh) * 2);
                u32x4 w;
                w.x = pack2(__uint_as_float(lo.x << 16) * sc, __uint_as_float(lo.x & 0xffff0000u) * sc); w.y = pack2(__uint_as_float(lo.y << 16) * sc, __uint_as_float(lo.y & 0xffff0000u) * sc);
                w.z = pack2(__uint_as_float(hi.x << 16) * sc, __uint_as_float(hi.x & 0xffff0000u) * sc); w.w = pack2(__uint_as_float(hi.y << 16) * sc, __uint_as_float(hi.y & 0xffff0000u) * sc);
                *(u32x4*)(ops + GO_QF + (size_t)idx * 16) = w;
            }
            {
                const int mt = idx >> 8, ks = (idx >> 6) & 3, l2 = idx & 63, rr = l2 & 31, hh = l2 >> 5, dk = 32 * mt + rr;
                float e8[8];
#pragma unroll
                for (int j = 0; j < 8; ++j) { const int c2 = 16 * ks + 8 * (j >> 2) + 4 * hh + (j & 3); e8[j] = bf2f(*(const bf16_t*)(Krow + c2 * 272 + dk * 2)) * ekd[c2]; }
                u32x4 w; w.x = pack2(e8[0], e8[1]); w.y = pack2(e8[2], e8[3]); w.z = pack2(e8[4], e8[5]); w.w = pack2(e8[6], e8[7]);
                *(u32x4*)(ops + GO_KF + (size_t)idx * 16) = w;
            }
        }
    }
    __syncthreads();
    {
        const float bc = bet[c], bg = bc * egc[c];
        unsigned kvp[16];
#pragma unroll
        for (int i4 = 0; i4 < 4; ++i4) { const u32x4 w = *(const u32x4*)(Krow + c * 272 + (cq * 32 + i4 * 8) * 2); kvp[i4 * 4] = w.x; kvp[i4 * 4 + 1] = w.y; kvp[i4 * 4 + 2] = w.z; kvp[i4 * 4 + 3] = w.w; }
        __syncthreads();
#pragma unroll
        for (int i = 0; i < 16; ++i) {
            *(bf16_t*)(VbT + (cq * 32 + 2 * i) * 144 + c * 2) = f2bf(__uint_as_float(vvp[i] << 16) * bc);
            *(bf16_t*)(VbT + (cq * 32 + 2 * i + 1) * 144 + c * 2) = f2bf(__uint_as_float(vvp[i] & 0xffff0000u) * bc);
            *(bf16_t*)(KbgT + (cq * 32 + 2 * i) * 144 + c * 2) = f2bf(__uint_as_float(kvp[i] << 16) * bg);
            *(bf16_t*)(KbgT + (cq * 32 + 2 * i + 1) * 144 + c * 2) = f2bf(__uint_as_float(kvp[i] & 0xffff0000u) * bg);
        }
    }
    {
        char* L21i = lds + GP_END;
        char* T11T = L21i + 2560;
        char* MT = T11T + 2560;
        if (wid < 2) {
            const int o = 32 * wid;
            float Tc[32];
#pragma unroll
            for (int i = 0; i < 32; ++i) Tc[i] = (i == (lane & 31)) ? 1.f : 0.f;
#pragma unroll
            for (int j = 0; j < 31; ++j) {
                const float tj = Tc[j];
#pragma unroll
                for (int i4 = (j + 1) >> 2; i4 < 8; ++i4) {
                    const f32x4 l4 = *(const f32x4*)&Lf[(o + j) * 68 + o + i4 * 4];
#pragma unroll
                    for (int e = 0; e < 4; ++e) if (i4 * 4 + e > j) Tc[i4 * 4 + e] -= l4[e] * tj;
                }
            }
            if (lane < 32) {
#pragma unroll
                for (int i = 0; i < 32; ++i) *(bf16_t*)(Trow + (o + i) * 144 + (o + lane) * 2) = f2bf(Tc[i]);
                if (wid == 0) {
#pragma unroll
                    for (int i = 0; i < 32; ++i) *(bf16_t*)(Trow + i * 144 + (32 + lane) * 2) = 0;
#pragma unroll
                    for (int i4 = 0; i4 < 8; ++i4) { u32x2 w; w.x = pack2(Tc[i4 * 4], Tc[i4 * 4 + 1]); w.y = pack2(Tc[i4 * 4 + 2], Tc[i4 * 4 + 3]); *(u32x2*)(T11T + lane * 80 + i4 * 8) = w; }
                }
            }
        } else {
            const int t2 = tid - 128;
#pragma unroll
            for (int g2 = 0; g2 < 2; ++g2) {
                const int i = t2 & 31, k4 = ((t2 >> 5) + 4 * g2) * 4;
                u32x2 w;
                w.x = pack2(Lf[(k4 + 0) * 68 + 32 + i], Lf[(k4 + 1) * 68 + 32 + i]); w.y = pack2(Lf[(k4 + 2) * 68 + 32 + i], Lf[(k4 + 3) * 68 + 32 + i]);
                *(u32x2*)(L21i + i * 80 + k4 * 2) = w;
            }
        }
        __syncthreads();
        {
            const int r0 = 16 * (wid >> 1), c0 = 16 * (wid & 1);
            const f32x4 mm = tile16(L21i, 80, r0, T11T, 80, c0, 32);
            u32x2 w; w.x = pack2(mm[0], mm[1]); w.y = pack2(mm[2], mm[3]);
            *(u32x2*)(MT + (c0 + fr) * 80 + (r0 + 4 * fq) * 2) = w;
        }
        __syncthreads();
        {
            const int r0 = 16 * (wid >> 1), c0 = 16 * (wid & 1);
            const f32x4 tt = tile16(MT, 80, c0, Trow + 32 * 144 + 64, 144, r0, 32);
            u32x2 w; w.x = pack2(-tt[0], -tt[1]); w.y = pack2(-tt[2], -tt[3]);
            *(u32x2*)(Trow + (32 + r0 + fr) * 144 + (c0 + 4 * fq) * 2) = w;
        }
    }
    __syncthreads();
#pragma unroll
    for (int tq = 0; tq < 2; ++tq) {
        const int tj = wid * 2 + tq;
#pragma unroll
        for (int ti = 0; ti < 4; ++ti) {
            const f32x4 u = tile16(Trow, 144, 16 * ti, VbT, 144, 16 * tj, 64);
            {
                const int dv = 16 * tj + fr, slice = dv >> 5, rr = dv & 31, cb = 16 * ti + fq * 4, mt = cb >> 5, q4 = (cb & 31) >> 2, hh = q4 & 1, rg = q4 >> 1;
                u32x2 w; w.x = pack2(u[0], u[1]); w.y = pack2(u[2], u[3]);
                *(u32x2*)(ops + GO_UF + ((size_t)((slice * 2 + mt) * 64 + hh * 32 + rr) * 16 + rg * 4) * 2) = w;
            }
            const f32x4 wv = tile16(KbgT, 144, 16 * tj, Trow, 144, 16 * ti, 64);
            {
                const int c1 = 16 * ti + fr, mt = c1 >> 5, rr = c1 & 31, hh = fq & 1, jg = fq >> 1;
                u32x2 w; w.x = pack2(-wv[0], -wv[1]); w.y = pack2(-wv[2], -wv[3]);
                *(u32x2*)(ops + GO_WF + ((size_t)((mt * 8 + tj) * 64 + hh * 32 + rr) * 8 + jg * 4) * 2) = w;
            }
        }
    }
}

DI void glds16(const void* g, char* l) { __builtin_amdgcn_global_load_lds((const unsigned*)g, (lds_u32*)l, 16, 0, 0); }
DI void fr_rd(bf16x8& f, unsigned addr) { asm volatile("ds_read_b128 %0, %1" : "=v"(f) : "v"(addr) : "memory"); }
template <int N> DI void fr_wait(bf16x8& f) { asm volatile("s_waitcnt lgkmcnt(%1)" : "+v"(f) : "n"(N) : "memory"); }
template <int REM> DI void fr_waitc(bf16x8& f) { if (REM >= 3) fr_wait<3>(f); else if (REM == 2) fr_wait<2>(f); else if (REM == 1) fr_wait<1>(f); else fr_wait<0>(f); }
#define GS_WAIT(n) asm volatile("s_waitcnt vmcnt(" #n ")" ::: "memory")
DI void gdn_scan_block(const P& p, int bh, char* lds, bool dry = false) {
    const int tid = tidx(), lane = tid & 63, w = tid >> 6;
    const int h = bh & 3, b = bh >> 2;
    const float eglv = ((const float*)(p.ws + WS_CTL + CTL_EGL))[(b * 64 + lane) * 4 + h];
    unsigned char* gbase = p.ws + WS_GOPS + (size_t)(b * 256 + h) * GOPS_CH;
    auto issue = [&](int n, int k0, int cntk) {
        for (int k = k0; k < k0 + cntk; ++k) {
            const unsigned char* src = gbase + (size_t)n * 4 * GOPS_CH + k * 8192 + tid * 16;
            char* dst = lds + k * 8192 + tid * 16;
            glds16(src, dst); glds16(src + 4096, dst + 4096);
        }
    };
    const unsigned la = (unsigned)(size_t)(lds_u32*)lds + lane * 16;
    f32x16 S[4];
#pragma unroll
    for (int i = 0; i < 4; ++i)
#pragma unroll
        for (int r = 0; r < 16; ++r) S[i][r] = 0.f;
    __syncthreads();
    issue(0, 0, 7);
#pragma unroll 1
    for (int n = 0; n < 64; ++n) {
        const float egl = __shfl(eglv, n);
        bf16x8 Sb[8];
#pragma unroll
        for (int i = 0; i < 4; ++i) { Sb[i * 2] = pack_step(S[i], 0); Sb[i * 2 + 1] = pack_step(S[i], 1); }
        f32x16 av[2], ao[2];
        GS_WAIT(6);
        __builtin_amdgcn_s_barrier();
        issue(n, 7, 2);
        __builtin_amdgcn_sched_barrier(0);
        {
            const char* sl = lds + (w >> 1) * 8192;
#pragma unroll
            for (int mt = 0; mt < 2; ++mt) {
                const u32x4* up = (const u32x4*)(sl + ((w & 1) * 2 + mt) * 2048 + lane * 32);
                const u32x4 u0 = up[0], u1 = up[1];
#pragma unroll
                for (int e = 0; e < 4; ++e) {
                    av[mt][e * 2] = __uint_as_float(u0[e] << 16); av[mt][e * 2 + 1] = __uint_as_float(u0[e] & 0xffff0000u);
                    av[mt][8 + e * 2] = __uint_as_float(u1[e] << 16); av[mt][8 + e * 2 + 1] = __uint_as_float(u1[e] & 0xffff0000u);
                }
            }
        }
        bf16x8 F[4];
#define GS_O0(j) (unsigned)((2 + ((j) & 1)) * 8192 + ((j) >> 1) * 1024)
#pragma unroll
        for (int j = 0; j < 4; ++j) fr_rd(F[j], la + GS_O0(j));
#pragma unroll
        for (int j = 0; j < 16; ++j) {
            if (j <= 12) fr_wait<3>(F[j & 3]); else if (j == 13) fr_wait<2>(F[j & 3]); else if (j == 14) fr_wait<1>(F[j & 3]); else fr_wait<0>(F[j & 3]);
            av[j & 1] = mfma32(F[j & 3], Sb[j >> 1], av[j & 1]);
            if (j + 4 < 16) fr_rd(F[j & 3], la + GS_O0(j + 4));
        }
        bf16x8 Vb[4];
#pragma unroll
        for (int mt = 0; mt < 2; ++mt) { Vb[mt * 2] = pack_step(av[mt], 0); Vb[mt * 2 + 1] = pack_step(av[mt], 1); }
        GS_WAIT(4);
        __builtin_amdgcn_s_barrier();
        if (n < 63) issue(n + 1, 0, 4);
        __builtin_amdgcn_sched_barrier(0);
#pragma unroll
        for (int mt = 0; mt < 2; ++mt)
#pragma unroll
            for (int r = 0; r < 16; ++r) ao[mt][r] = 0.f;
#define GS_O1(j) (unsigned)((j) < 16 ? (4 + ((j) & 1)) * 8192 + ((j) >> 1) * 1024 : 6 * 8192 + ((j) == 16 ? 0 : (j) == 17 ? 4 : (j) == 18 ? 1 : (j) == 19 ? 5 : (j) == 20 ? 6 : 7) * 1024)
#pragma unroll
        for (int j = 0; j < 4; ++j) fr_rd(F[j], la + GS_O1(j));
#pragma unroll
        for (int j = 0; j < 22; ++j) {
            if (j <= 18) fr_wait<3>(F[j & 3]); else if (j == 19) fr_wait<2>(F[j & 3]); else if (j == 20) fr_wait<1>(F[j & 3]); else fr_wait<0>(F[j & 3]);
            if (j < 16) {
                ao[j & 1] = mfma32(F[j & 3], Sb[j >> 1], ao[j & 1]);
                if (j & 1) {
                    const int ks = j >> 1;
#pragma unroll
                    for (int r = 0; r < 8; ++r) S[ks >> 1][(ks & 1) * 8 + r] *= egl;
                }
            } else {
                const int oi = (j == 16 || j == 18) ? 0 : 1, kv = j <= 17 ? 0 : j <= 19 ? 1 : j == 20 ? 2 : 3;
                ao[oi] = mfma32(F[j & 3], Vb[kv], ao[oi]);
            }
            if (j + 4 < 22) fr_rd(F[j & 3], la + GS_O1(j + 4));
        }
        if (n < 63) GS_WAIT(8); else GS_WAIT(0);
        __builtin_amdgcn_s_barrier();
        if (n < 63) issue(n + 1, 4, 3);
        __builtin_amdgcn_sched_barrier(0);
#define GS_O2(j) (unsigned)((7 + (((j) & 3) >> 1)) * 8192 + ((((j) & 3) & 1) * 4 + ((j) >> 2)) * 1024)
#pragma unroll
        for (int j = 0; j < 4; ++j) fr_rd(F[j], la + GS_O2(j));
#pragma unroll
        for (int j = 0; j < 16; ++j) {
            if (j <= 12) fr_wait<3>(F[j & 3]); else if (j == 13) fr_wait<2>(F[j & 3]); else if (j == 14) fr_wait<1>(F[j & 3]); else fr_wait<0>(F[j & 3]);
            S[j & 3] = mfma32(F[j & 3], Vb[j >> 2], S[j & 3]);
            if (j + 4 < 16) fr_rd(F[j & 3], la + GS_O2(j + 4));
        }
        {
            u32x4* Of = (u32x4*)((dry ? p.ws + WS_DUMMY + (size_t)(bh & 15) * 65536 : gbase + (size_t)n * 4 * GOPS_CH) + GO_UF) + (size_t)(w * 2 * 64 + lane) * 2;
#pragma unroll
            for (int mt = 0; mt < 2; ++mt) {
                u32x4 o0, o1;
#pragma unroll
                for (int e = 0; e < 4; ++e) { o0[e] = pack2(ao[mt][e * 2], ao[mt][e * 2 + 1]); o1[e] = pack2(ao[mt][8 + e * 2], ao[mt][8 + e * 2 + 1]); }
                Of[mt * 128] = o0; Of[mt * 128 + 1] = o1;
            }
        }
    }
    __syncthreads();
}

DI void gdn_post_unit(const P& p, int li, int ch) {
    const int tid = tidx();
    const int h = ch & 3, n = (ch >> 2) & 63, b = ch >> 8;
    const int t0 = b * SEQ + n * 64;
    const int c = tid >> 2, cq = tid & 3;
    const bf16_t* Of = (const bf16_t*)(p.ws + WS_GOPS + (size_t)ch * GOPS_CH + GO_UF);
    const bf16_t* proj = (const bf16_t*)(p.ws + WS_PROJ);
    bf16_t* mix = (bf16_t*)(p.ws + WS_PROJ);
    const float* nw = p.in[I_GDNNORM] + li * 128 + cq * 32;
    const int mt = c >> 5, q4 = (c & 31) >> 2, hh = q4 & 1, rg = q4 >> 1, reg = rg * 4 + (c & 3);
    float o[32]; float ss = 0.f;
#pragma unroll
    for (int r = 0; r < 32; ++r) { o[r] = bf2f(Of[(size_t)((cq * 2 + mt) * 64 + hh * 32 + r) * 16 + reg]); ss += o[r] * o[r]; }
    ss += __shfl_xor(ss, 1); ss += __shfl_xor(ss, 2);
    const float rs = rsqrtf(ss * (1.f / 128.f) + 1e-6f);
    const bf16_t* zp = proj + (size_t)(t0 + c) * EVLD + 1536 + h * 128 + cq * 32;
    bf16_t* mp = mix + (size_t)(t0 + c) * EVLD + h * 128 + cq * 32;
#pragma unroll
    for (int i4 = 0; i4 < 4; ++i4) {
        const u32x4 zw = *(const u32x4*)(zp + i4 * 8);
        u32x4 w;
#pragma unroll
        for (int e = 0; e < 4; ++e) {
            const float z0 = __uint_as_float(zw[e] << 16), z1 = __uint_as_float(zw[e] & 0xffff0000u);
            w[e] = pack2(o[i4 * 8 + e * 2] * rs * nw[i4 * 8 + e * 2] * siluf_(z0), o[i4 * 8 + e * 2 + 1] * rs * nw[i4 * 8 + e * 2 + 1] * siluf_(z1));
        }
        *(u32x4*)(mp + i4 * 8) = w;
    }
}


constexpr int RP_Z0 = 0, RP_Z1 = 18432, RP_Z2 = 55296, RP_VEC = 73728, RP_PT = 75008, RP_T11 = 78080, RP_END = 80640;
constexpr int RP_LIN = 0, RP_LW = 25600;
DI void rwkv_prep_unit(const P& p, int li, int ch, char* lds) {
    const int tid = tidx(), lane = tid & 63, wid = tid >> 6, fr = lane & 15, fq = lane >> 4;
    const int h = ch & 7, n = (ch >> 3) & 63, b = ch >> 9;
    const int t0 = b * SEQ + n * 64;
    const bf16_t* proj = (const bf16_t*)(p.ws + WS_PROJ);
    char* Lfc = lds + RP_Z0; float* Lf = (float*)Lfc;
    char* ApT = lds + RP_Z0; char* AkVT = lds + RP_Z0 + 9216;
    char* Arow = lds + RP_Z1; char* Rrow = Arow + 9216; char* Brow = Arow + 18432; char* Krow = Arow + 27648;
    char* Aak = Arow; char* Arb = Rrow; char* Ark = Brow; char* Trow = Krow; char* BhT = Krow; char* VpT = Aak;
    char* AT = lds + RP_Z2; char* VT = AT + 9216; char* KhT = AT;
    float* tot = (float*)(lds + RP_VEC); float* WC = tot + 256;
    char* lin = lds + RP_LIN; char* LWi = lds + RP_LW;
    float* PT = (float*)(lds + RP_PT);
    {
        const float* mu0 = p.in[I_MU] + (size_t)li * 1696;
        if (tid < 48) {
            const int j0 = tid * 4;
            *(float4*)(PT + j0) = j0 < 160 ? *(const float4*)(mu0 + (C_HW - RW0) + j0) : *(const float4*)(p.in[I_VRESMU] + j0 - 160);
        } else if (tid < 48 + 144) {
            const int q = tid - 48, arr = q >> 4, c4 = (q & 15) * 4, chn = h * 64 + c4;
            const float* src = arr == 0 ? mu0 + (C_R - RW0) + chn : arr == 1 ? mu0 + (C_K - RW0) + chn : arr == 2 ? mu0 + (C_V - RW0) + chn
                             : arr == 3 ? p.in[I_W0] + li * 512 + chn : arr == 4 ? p.in[I_A0] + li * 512 + chn : arr == 5 ? p.in[I_V0] + chn
                             : arr == 6 ? p.in[I_KK] + li * 512 + chn : arr == 7 ? p.in[I_KA] + li * 512 + chn : p.in[I_RK] + li * 512 + chn;
            *(float4*)(PT + 192 + arr * 64 + c4) = *(const float4*)src;
        }
    }
    __syncthreads();
    {
        const int c = tid >> 2, cq = tid & 3, s = n * 64 + c;
        const bf16_t* cur = proj + (size_t)(t0 + c) * EVLD + C_HW + cq * 48;
        const float* mu = p.in[I_MU] + (size_t)li * 1696 + (C_HW - RW0);
        const float* vmu = p.in[I_VRESMU];
#pragma unroll
        for (int i6 = 0; i6 < 6; ++i6) {
            const u32x4 cw4 = *(const u32x4*)(cur + i6 * 8);
            u32x4 pw4 = *(const u32x4*)(cur - (s > 0 ? EVLD : 0) + i6 * 8);
            if (s == 0) pw4 = (u32x4){0u, 0u, 0u, 0u};
            const int j0 = cq * 48 + i6 * 8;
            const float4 ma = *(const float4*)(PT + j0), mb = *(const float4*)(PT + j0 + 4);
            const float mm[8] = {ma.x, ma.y, ma.z, ma.w, mb.x, mb.y, mb.z, mb.w};
            const bool is_t = j0 < 32, is_s = (j0 >= 64) && (j0 < 160);
            const float ca = is_t ? 1.f : 0.f, cb = is_t ? -2.f : 1.f, cc = is_t ? 2.f : -1.f;
            u32x4 w;
#pragma unroll
            for (int e = 0; e < 4; ++e) {
                float o2[2];
#pragma unroll
                for (int q = 0; q < 2; ++q) {
                    const float cv = q ? __uint_as_float(cw4[e] & 0xffff0000u) : __uint_as_float(cw4[e] << 16);
                    const float pv = q ? __uint_as_float(pw4[e] & 0xffff0000u) : __uint_as_float(pw4[e] << 16);
                    const float val = cv + mm[e * 2 + q] * (pv - cv);
                    const float act = ca + cb * __builtin_amdgcn_rcpf(1.f + __expf(cc * val));
                    o2[q] = (is_t || is_s) ? act : val;
                }
                w[e] = pack2(o2[0], o2[1]);
            }
            *(u32x4*)(lin + c * 400 + (cq * 48 + i6 * 8) * 2) = w;
        }
        const bf16_t* LW = (const bf16_t*)(p.ws + WS_W + W_LW) + (size_t)h * 64 * 192;
#pragma unroll
        for (int i6 = 0; i6 < 6; ++i6) *(u32x4*)(LWi + c * 400 + (cq * 48 + i6 * 8) * 2) = *(const u32x4*)(LW + (size_t)c * 192 + cq * 48 + i6 * 8);
    }
    __syncthreads();
    float lw_[16], la_[16], lg_[16], lv_[16];
#pragma unroll
    for (int tj = 0; tj < 4; ++tj) {
        const f32x4 a = tile16(LWi, 400, 16 * tj, lin, 400, 16 * wid, 32);
        const f32x4 bq = tile16(LWi + 64, 400, 16 * tj, lin + 64, 400, 16 * wid, 32);
        const f32x4 cg = tile16(LWi + 128, 400, 16 * tj, lin + 128, 400, 16 * wid, 96);
        const f32x4 dv = tile16(LWi + 320, 400, 16 * tj, lin + 320, 400, 16 * wid, 32);
#pragma unroll
        for (int r = 0; r < 4; ++r) { lw_[tj * 4 + r] = a[r]; la_[tj * 4 + r] = bq[r]; lg_[tj * 4 + r] = cg[r]; lv_[tj * 4 + r] = dv[r]; }
    }
    __syncthreads();
    const int c = 16 * wid + fr;
    float at[16], rt[16], bt[16], kt[16], bh[16], kh[16];
    {
        const int s = n * 64 + c;
        const size_t row = (size_t)(t0 + c);
        const float* mu = p.in[I_MU] + (size_t)li * 1696;
        const int hc = h * 64;
        float rr_[16], kk_[16], lwv[16], aa[16];
        float kn = 0.f, rk = 0.f;
        bf16_t* vf = (bf16_t*)(p.ws + WS_VF);
        bf16_t* gg = (bf16_t*)(p.ws + WS_GG);
#pragma unroll
        for (int tj = 0; tj < 4; ++tj) {
            const int cb = 16 * tj + 4 * fq;
            u32x2 cr = *(const u32x2*)(proj + row * EVLD + C_R + hc + cb), ck = *(const u32x2*)(proj + row * EVLD + C_K + hc + cb), cv = *(const u32x2*)(proj + row * EVLD + C_V + hc + cb);
            const size_t prow = s > 0 ? row - 1 : row;
            u32x2 pr = *(const u32x2*)(proj + prow * EVLD + C_R + hc + cb), pk = *(const u32x2*)(proj + prow * EVLD + C_K + hc + cb), pv = *(const u32x2*)(proj + prow * EVLD + C_V + hc + cb);
            if (s == 0) { pr = (u32x2){0u, 0u}; pk = pr; pv = pr; }
            u32x2 vfw = {0u, 0u};
            if (li == 1) vfw = *(const u32x2*)(vf + row * 512 + hc + cb);
            float vout[4], gout[4];
            const int ch0 = hc + cb;
            const float* pt = PT + 192 + cb;
            const float4 mu_r4 = *(const float4*)(pt), mu_k4 = *(const float4*)(pt + 64), mu_v4 = *(const float4*)(pt + 128);
            const float4 w0_4 = *(const float4*)(pt + 192), a0_4 = *(const float4*)(pt + 256), v0_4 = *(const float4*)(pt + 320);
            const float4 kk_4 = *(const float4*)(pt + 384), ka_4 = *(const float4*)(pt + 448), rk_4 = *(const float4*)(pt + 512);
            const float mur[4] = {mu_r4.x, mu_r4.y, mu_r4.z, mu_r4.w}, muk[4] = {mu_k4.x, mu_k4.y, mu_k4.z, mu_k4.w}, muv[4] = {mu_v4.x, mu_v4.y, mu_v4.z, mu_v4.w};
            const float w0v[4] = {w0_4.x, w0_4.y, w0_4.z, w0_4.w}, a0v[4] = {a0_4.x, a0_4.y, a0_4.z, a0_4.w}, v0v[4] = {v0_4.x, v0_4.y, v0_4.z, v0_4.w};
            const float kkp[4] = {kk_4.x, kk_4.y, kk_4.z, kk_4.w}, kap[4] = {ka_4.x, ka_4.y, ka_4.z, ka_4.w}, rkp[4] = {rk_4.x, rk_4.y, rk_4.z, rk_4.w};
#pragma unroll
            for (int r = 0; r < 4; ++r) {
                const int i = tj * 4 + r;
                const unsigned wcr = r < 2 ? cr.x : cr.y, wck = r < 2 ? ck.x : ck.y, wcv = r < 2 ? cv.x : cv.y;
                const unsigned wpr = r < 2 ? pr.x : pr.y, wpk = r < 2 ? pk.x : pk.y, wpv = r < 2 ? pv.x : pv.y, wvf = r < 2 ? vfw.x : vfw.y;
                const float c_r = (r & 1) ? __uint_as_float(wcr & 0xffff0000u) : __uint_as_float(wcr << 16);
                const float c_k = (r & 1) ? __uint_as_float(wck & 0xffff0000u) : __uint_as_float(wck << 16);
                const float c_v = (r & 1) ? __uint_as_float(wcv & 0xffff0000u) : __uint_as_float(wcv << 16);
                const float p_r = (r & 1) ? __uint_as_float(wpr & 0xffff0000u) : __uint_as_float(wpr << 16);
                const float p_k = (r & 1) ? __uint_as_float(wpk & 0xffff0000u) : __uint_as_float(wpk << 16);
                const float p_v = (r & 1) ? __uint_as_float(wpv & 0xffff0000u) : __uint_as_float(wpv << 16);
                const float rm = c_r + mur[r] * (p_r - c_r);
                const float km = c_k + muk[r] * (p_k - c_k);
                float vm = c_v + muv[r] * (p_v - c_v);
                const float wlog = -softplusf_(-(w0v[r] + lw_[i])) - 0.5f;
                lwv[i] = -__expf(wlog);
                const float a = sigmoidf_(a0v[r] + la_[i]);
                if (li == 1) {
                    const float v1 = (r & 1) ? __uint_as_float(wvf & 0xffff0000u) : __uint_as_float(wvf << 16);
                    vm = vm + (v1 - vm) * sigmoidf_(v0v[r] + lv_[i]);
                }
                const float kkv = km * kkp[r];
                kn += kkv * kkv;
                rr_[i] = rm; kk_[i] = kkv; aa[i] = a;
                kt[i] = km * (1.f + (a - 1.f) * kap[r]);
                rk += rm * kt[i] * rkp[r];
                vout[r] = vm; gout[r] = lg_[i];
            }
            u32x2 w; w.x = pack2(vout[0], vout[1]); w.y = pack2(vout[2], vout[3]);
            *(u32x2*)(vf + row * 512 + hc + cb) = w;
            w.x = pack2(gout[0], gout[1]); w.y = pack2(gout[2], gout[3]);
            *(u32x2*)(gg + row * 512 + hc + cb) = w;
#pragma unroll
            for (int r = 0; r < 4; ++r) *(bf16_t*)(VT + (cb + r) * 144 + c * 2) = f2bf(vout[r]);
            __builtin_amdgcn_sched_barrier(0);
        }
        kn += __shfl_xor(kn, 16); kn += __shfl_xor(kn, 32);
        const float kr = rsqrtf(kn + 1e-6f);
        rk += __shfl_xor(rk, 16); rk += __shfl_xor(rk, 32);
        if (fq == 0) ((float*)(p.ws + WS_RK))[row * 8 + h] = rk;
        float cs[16];
#pragma unroll
        for (int i = 0; i < 16; ++i) {
            float x = lwv[i];
#pragma unroll
            for (int o = 1; o < 16; o <<= 1) { const float y = __shfl_up(x, o, 16); if (fr >= o) x += y; }
            cs[i] = x;
        }
        if (fr == 15) {
#pragma unroll
            for (int i = 0; i < 16; ++i) tot[wid * 64 + 16 * (i >> 2) + 4 * fq + (i & 3)] = cs[i];
        }
        __syncthreads();
#pragma unroll
        for (int i = 0; i < 16; ++i) {
            const int chl = 16 * (i >> 2) + 4 * fq + (i & 3);
            float pre = 0.f, all = 0.f;
#pragma unroll
            for (int w2 = 0; w2 < 4; ++w2) { const float tv = tot[w2 * 64 + chl]; all += tv; if (w2 < wid) pre += tv; }
            const float csi = cs[i] + pre, csm = csi - lwv[i];
            const float kkn = kk_[i] * kr, k2 = kt[i];
            const float e_c = __expf(csi), e_n = __builtin_amdgcn_rcpf(e_c), e_m = __expf(csm), e_h = __expf(all) * e_n;
            at[i] = -kkn * e_m; rt[i] = rr_[i] * e_c;
            const float bp = kkn * aa[i];
            bt[i] = bp * e_n; kt[i] = k2 * e_n; bh[i] = bp * e_h; kh[i] = k2 * e_h;
            if (c == 0) WC[chl] = __expf(all);
            if ((i & 3) == 3) __builtin_amdgcn_sched_barrier(0);
        }
    }
#pragma unroll
    for (int tj = 0; tj < 4; ++tj) {
        const int cb = 16 * tj + 4 * fq;
        u32x2 w;
        w.x = pack2(at[tj * 4], at[tj * 4 + 1]); w.y = pack2(at[tj * 4 + 2], at[tj * 4 + 3]); *(u32x2*)(Arow + c * 144 + cb * 2) = w;
        w.x = pack2(rt[tj * 4], rt[tj * 4 + 1]); w.y = pack2(rt[tj * 4 + 2], rt[tj * 4 + 3]); *(u32x2*)(Rrow + c * 144 + cb * 2) = w;
        w.x = pack2(bt[tj * 4], bt[tj * 4 + 1]); w.y = pack2(bt[tj * 4 + 2], bt[tj * 4 + 3]); *(u32x2*)(Brow + c * 144 + cb * 2) = w;
        w.x = pack2(kt[tj * 4], kt[tj * 4 + 1]); w.y = pack2(kt[tj * 4 + 2], kt[tj * 4 + 3]); *(u32x2*)(Krow + c * 144 + cb * 2) = w;
#pragma unroll
        for (int r = 0; r < 4; ++r) {
            *(bf16_t*)(AT + (cb + r) * 144 + c * 2) = f2bf(at[tj * 4 + r]);
        }
    }
    __syncthreads();
    f32x4 pab[4], pak[4], prb[4], prk[4];
    {
        const int ti = wid;
#pragma unroll
        for (int tj = 0; tj < 4; ++tj) {
            pab[tj] = (f32x4){0.f, 0.f, 0.f, 0.f}; pak[tj] = pab[tj]; prb[tj] = pab[tj]; prk[tj] = pab[tj];
            if (tj <= ti) {
                pab[tj] = tile16(Arow, 144, 16 * ti, Brow, 144, 16 * tj, 64);
                pak[tj] = tile16(Krow, 144, 16 * tj, Arow, 144, 16 * ti, 64);
                prb[tj] = tile16(Brow, 144, 16 * tj, Rrow, 144, 16 * ti, 64);
                prk[tj] = tile16(Krow, 144, 16 * tj, Rrow, 144, 16 * ti, 64);
            }
        }
    }
    __syncthreads();
    {
        const int ti = wid;
#pragma unroll
        for (int tj = 0; tj < 4; ++tj) {
            const int s1 = 16 * tj + fr;
            f32x4 lv;
#pragma unroll
            for (int r = 0; r < 4; ++r) { const int t1 = 16 * ti + 4 * fq + r; lv[r] = (s1 < t1) ? -pab[tj][r] : 0.f; }
            *(f32x4*)&Lf[s1 * 72 + 16 * ti + 4 * fq] = lv;
            const int t2 = 16 * ti + fr;
            float m1[4], m2[4], m3[4];
#pragma unroll
            for (int r = 0; r < 4; ++r) { const int s2 = 16 * tj + 4 * fq + r; m1[r] = (s2 < t2) ? pak[tj][r] : 0.f; m2[r] = (s2 <= t2) ? prb[tj][r] : 0.f; m3[r] = (s2 <= t2) ? prk[tj][r] : 0.f; }
            u32x2 w;
            w.x = pack2(m1[0], m1[1]); w.y = pack2(m1[2], m1[3]); *(u32x2*)(Aak + t2 * 144 + (16 * tj + 4 * fq) * 2) = w;
            w.x = pack2(m2[0], m2[1]); w.y = pack2(m2[2], m2[3]); *(u32x2*)(Arb + t2 * 144 + (16 * tj + 4 * fq) * 2) = w;
            w.x = pack2(m3[0], m3[1]); w.y = pack2(m3[2], m3[3]); *(u32x2*)(Ark + t2 * 144 + (16 * tj + 4 * fq) * 2) = w;
        }
    }
    __syncthreads();
    {
        char* L21i = lds + RP_PT;
        char* T11T = lds + RP_T11;
        char* MT = lds + RP_Z0;
        if (wid < 2) {
            const int o = 32 * wid;
            float Tc[32];
#pragma unroll
            for (int i = 0; i < 32; ++i) Tc[i] = (i == (lane & 31)) ? 1.f : 0.f;
#pragma unroll
            for (int j = 0; j < 31; ++j) {
                const float tj = Tc[j];
#pragma unroll
                for (int i4 = (j + 1) >> 2; i4 < 8; ++i4) {
                    const f32x4 l4 = *(const f32x4*)&Lf[(o + j) * 72 + o + i4 * 4];
#pragma unroll
                    for (int e = 0; e < 4; ++e) if (i4 * 4 + e > j) Tc[i4 * 4 + e] -= l4[e] * tj;
                }
            }
            if (lane < 32) {
#pragma unroll
                for (int i = 0; i < 32; ++i) *(bf16_t*)(Trow + (o + i) * 144 + (o + lane) * 2) = f2bf(Tc[i]);
                if (wid == 0) {
#pragma unroll
                    for (int i = 0; i < 32; ++i) *(bf16_t*)(Trow + i * 144 + (32 + lane) * 2) = 0;
#pragma unroll
                    for (int i4 = 0; i4 < 8; ++i4) { u32x2 w; w.x = pack2(Tc[i4 * 4], Tc[i4 * 4 + 1]); w.y = pack2(Tc[i4 * 4 + 2], Tc[i4 * 4 + 3]); *(u32x2*)(T11T + lane * 80 + i4 * 8) = w; }
                }
            }
        } else {
            const int t2 = tid - 128;
#pragma unroll
            for (int g2 = 0; g2 < 2; ++g2) {
                const int i = t2 & 31, k4 = ((t2 >> 5) + 4 * g2) * 4;
                u32x2 w;
                w.x = pack2(Lf[(k4 + 0) * 72 + 32 + i], Lf[(k4 + 1) * 72 + 32 + i]); w.y = pack2(Lf[(k4 + 2) * 72 + 32 + i], Lf[(k4 + 3) * 72 + 32 + i]);
                *(u32x2*)(L21i + i * 80 + k4 * 2) = w;
            }
        }
        __syncthreads();
        {
            const int r0 = 16 * (wid >> 1), c0 = 16 * (wid & 1);
            const f32x4 mm = tile16(L21i, 80, r0, T11T, 80, c0, 32);
            u32x2 w; w.x = pack2(mm[0], mm[1]); w.y = pack2(mm[2], mm[3]);
            *(u32x2*)(MT + (c0 + fr) * 80 + (r0 + 4 * fq) * 2) = w;
        }
        __syncthreads();
        {
            const int r0 = 16 * (wid >> 1), c0 = 16 * (wid & 1);
            const f32x4 tt = tile16(MT, 80, c0, Trow + 32 * 144 + 64, 144, r0, 32);
            u32x2 w; w.x = pack2(-tt[0], -tt[1]); w.y = pack2(-tt[2], -tt[3]);
            *(u32x2*)(Trow + (32 + r0 + fr) * 144 + (c0 + 4 * fq) * 2) = w;
        }
    }
    __syncthreads();
    {
        const int ti = wid;
#pragma unroll
        for (int tj = 0; tj < 4; ++tj) {
            const f32x4 x = tile16(Trow, 144, 16 * ti, AT, 144, 16 * tj, 64);
            const f32x4 y = tile16(Aak, 144, 16 * ti, VT, 144, 16 * tj, 64);
            u32x2 w;
            w.x = pack2(x[0], x[1]); w.y = pack2(x[2], x[3]); *(u32x2*)(ApT + (16 * tj + fr) * 144 + (16 * ti + 4 * fq) * 2) = w;
            w.x = pack2(y[0], y[1]); w.y = pack2(y[2], y[3]); *(u32x2*)(AkVT + (16 * tj + fr) * 144 + (16 * ti + 4 * fq) * 2) = w;
        }
    }
    __syncthreads();
    {
        const int ti = wid;
#pragma unroll
        for (int tj = 0; tj < 4; ++tj) {
            const f32x4 x = tile16(Trow, 144, 16 * ti, AkVT, 144, 16 * tj, 64);
            u32x2 w; w.x = pack2(x[0], x[1]); w.y = pack2(x[2], x[3]); *(u32x2*)(VpT + (16 * tj + fr) * 144 + (16 * ti + 4 * fq) * 2) = w;
        }
    }
    __syncthreads();
#pragma unroll
    for (int tj = 0; tj < 4; ++tj)
#pragma unroll
        for (int r = 0; r < 4; ++r) {
            const int cb = 16 * tj + 4 * fq + r;
            *(bf16_t*)(BhT + cb * 144 + c * 2) = f2bf(bh[tj * 4 + r]);
            *(bf16_t*)(KhT + cb * 144 + c * 2) = f2bf(kh[tj * 4 + r]);
        }
    __syncthreads();
    {
        unsigned char* opsA = (unsigned char*)p.out + (size_t)ch * 16384;
        unsigned char* opsB = p.ws + WS_ROPS + (size_t)ch * 16384;
        const int ti = wid;
#pragma unroll
        for (int tj = 0; tj < 4; ++tj) {
            const f32x4 x = tile16(ApT, 144, 16 * tj, Arb, 144, 16 * ti, 64);
            const f32x4 g = tile16(ApT, 144, 16 * tj, BhT, 144, 16 * ti, 64);
            const int m1 = 16 * ti + fr, mt = m1 >> 5, rr = m1 & 31, hh = fq & 1, jg = fq >> 1;
            const size_t off = ((size_t)((mt * 4 + tj) * 64 + hh * 32 + rr) * 8 + jg * 4) * 2;
            float gd[4];
#pragma unroll
            for (int r = 0; r < 4; ++r) gd[r] = g[r] + ((16 * tj + 4 * fq + r == m1) ? WC[m1] : 0.f);
            u32x2 w;
            w.x = pack2(x[0] + rt[tj * 4], x[1] + rt[tj * 4 + 1]); w.y = pack2(x[2] + rt[tj * 4 + 2], x[3] + rt[tj * 4 + 3]); *(u32x2*)(opsA + off) = w;
            w.x = pack2(gd[0], gd[1]); w.y = pack2(gd[2], gd[3]); *(u32x2*)(opsA + 8192 + off) = w;
            f32x4 y = tile16(Ark, 144, 16 * ti, VT, 144, 16 * tj, 64);
            const f32x4 y2 = tile16(Arb, 144, 16 * ti, VpT, 144, 16 * tj, 64);
            f32x4 kv = tile16(KhT, 144, 16 * ti, VT, 144, 16 * tj, 64);
            const f32x4 kv2 = tile16(BhT, 144, 16 * ti, VpT, 144, 16 * tj, 64);
            const int vcol = 16 * tj + fr, slice = vcol >> 5, r2 = vcol & 31, cb = 16 * ti + 4 * fq, mt2 = cb >> 5, q4 = (cb & 31) >> 2, h2 = q4 & 1, rg = q4 >> 1;
            const size_t off2 = ((size_t)((slice * 2 + mt2) * 64 + h2 * 32 + r2) * 16 + rg * 4) * 2;
            w.x = pack2(y[0] + y2[0], y[1] + y2[1]); w.y = pack2(y[2] + y2[2], y[3] + y2[3]); *(u32x2*)(opsB + off2) = w;
            w.x = pack2(kv[0] + kv2[0], kv[1] + kv2[1]); w.y = pack2(kv[2] + kv2[2], kv[3] + kv2[3]); *(u32x2*)(opsB + 8192 + off2) = w;
        }
    }
}

DI void rwkv_scan_block(const P& p, int bh, char* lds, bool dry = false) {
    const int tid = tidx(), lane = tid & 63, w = tid >> 6, slice = w & 1;
    const int h = bh & 7, b = bh >> 3;
    constexpr int NST = 64 * 2, AH = 3;
    auto issue = [&](int j) {
        const int n = j >> 1, k = j & 1;
        const size_t ch = (size_t)((b * 64 + n) * 8 + h) * 16384;
        const unsigned char* s0 = (k == 0 ? p.ws + WS_ROPS + ch + 8192 : p.ws + WS_ROPS + ch) + tid * 16;
        const unsigned char* s1 = (k == 0 ? (const unsigned char*)p.out + ch + 8192 : (const unsigned char*)p.out + ch) + tid * 16;
        char* dst = lds + (j & 3) * 16384 + tid * 16;
        glds16(s0, dst); glds16(s0 + 4096, dst + 4096); glds16(s1, dst + 8192); glds16(s1 + 4096, dst + 12288);
    };
    const unsigned la = (unsigned)(size_t)(lds_u32*)lds + lane * 16;
    f32x16 H[2];
#pragma unroll
    for (int i = 0; i < 2; ++i)
#pragma unroll
        for (int r = 0; r < 16; ++r) H[i][r] = 0.f;
    __syncthreads();
#pragma unroll
    for (int j = 0; j < AH; ++j) issue(j);
#pragma unroll 1
    for (int n = 0; n < 64; ++n) {
        bf16x8 Hb[4];
#pragma unroll
        for (int i = 0; i < 2; ++i) { Hb[i * 2] = pack_step(H[i], 0); Hb[i * 2 + 1] = pack_step(H[i], 1); }
#pragma unroll
        for (int k = 0; k < 2; ++k) {
            const int j = n * 2 + k;
            if (n < 63) GS_WAIT(8); else if (k == 0) GS_WAIT(4); else GS_WAIT(0);
            __builtin_amdgcn_s_barrier();
            if (j + AH < NST) issue(j + AH);
            __builtin_amdgcn_sched_barrier(0);
            const char* sl = lds + (j & 3) * 16384;
            if (w < 2) {
                f32x16 acc[2];
                bf16x8 F[4];
                const unsigned fa = la + (unsigned)((j & 3) * 16384 + 8192);
#define RS_O(i) (unsigned)((((i) & 1) * 4 + ((i) >> 1)) * 1024)
#pragma unroll
                for (int i = 0; i < 4; ++i) fr_rd(F[i], fa + RS_O(i));
#pragma unroll
                for (int mt = 0; mt < 2; ++mt) {
                    const u32x4* up = (const u32x4*)(sl + (slice * 2 + mt) * 2048 + lane * 32);
                    const u32x4 u0 = up[0], u1 = up[1];
#pragma unroll
                    for (int e = 0; e < 4; ++e) {
                        acc[mt][e * 2] = __uint_as_float(u0[e] << 16); acc[mt][e * 2 + 1] = __uint_as_float(u0[e] & 0xffff0000u);
                        acc[mt][8 + e * 2] = __uint_as_float(u1[e] << 16); acc[mt][8 + e * 2 + 1] = __uint_as_float(u1[e] & 0xffff0000u);
                    }
                }
#pragma unroll
                for (int i = 0; i < 8; ++i) {
                    if (i <= 4) fr_wait<3>(F[i & 3]); else if (i == 5) fr_wait<2>(F[i & 3]); else if (i == 6) fr_wait<1>(F[i & 3]); else fr_wait<0>(F[i & 3]);
                    acc[i & 1] = mfma32(F[i & 3], Hb[i >> 1], acc[i & 1]);
                    if (i + 4 < 8) fr_rd(F[i & 3], fa + RS_O(i + 4));
                }
                if (k == 0) { H[0] = acc[0]; H[1] = acc[1]; }
                else {
                    const size_t ch = (size_t)((b * 64 + n) * 8 + h) * 16384;
                    u32x4* Yf = (u32x4*)(dry ? p.ws + WS_DUMMY + 2097152 + (size_t)(bh & 31) * 16384 : p.ws + WS_ROPS + ch) + (size_t)(slice * 128 + lane) * 2;
#pragma unroll
                    for (int mt = 0; mt < 2; ++mt) {
                        u32x4 o0, o1;
#pragma unroll
                        for (int e = 0; e < 4; ++e) { o0[e] = pack2(acc[mt][e * 2], acc[mt][e * 2 + 1]); o1[e] = pack2(acc[mt][8 + e * 2], acc[mt][8 + e * 2 + 1]); }
                        Yf[mt * 128] = o0; Yf[mt * 128 + 1] = o1;
                    }
                }
            }
        }
    }
    __syncthreads();
}

DI void rwkv_post_unit(const P& p, int li, int ch) {
    const int tid = tidx();
    const int h = ch & 7, n = (ch >> 3) & 63, b = ch >> 9;
    const int t0 = b * SEQ + n * 64;
    const int c = tid >> 2, cq = tid & 3;
    const bf16_t* Yf = (const bf16_t*)(p.ws + WS_ROPS + (size_t)ch * 16384);
    const bf16_t* vf = (const bf16_t*)(p.ws + WS_VF) + (size_t)(t0 + c) * 512 + h * 64 + cq * 16;
    const bf16_t* gg = (const bf16_t*)(p.ws + WS_GG) + (size_t)(t0 + c) * 512 + h * 64 + cq * 16;
    const float rk = ((const float*)(p.ws + WS_RK))[(size_t)(t0 + c) * 8 + h];
    const float* lnw = p.in[I_LNW] + li * 512 + h * 64 + cq * 16;
    const float* lnb = p.in[I_LNB] + li * 512 + h * 64 + cq * 16;
    bf16_t* mp = (bf16_t*)p.out + (size_t)(t0 + c) * 1024 + 512 + h * 64 + cq * 16;
    const int mt = c >> 5, q4 = (c & 31) >> 2, hh = q4 & 1, rg = q4 >> 1, reg = rg * 4 + (c & 3), slice = cq >> 1, rb = (cq & 1) * 16;
    float y[16]; float sm = 0.f;
#pragma unroll
    for (int i = 0; i < 16; ++i) { y[i] = bf2f(Yf[(size_t)((slice * 2 + mt) * 64 + hh * 32 + rb + i) * 16 + reg]); sm += y[i]; }
    sm += __shfl_xor(sm, 1); sm += __shfl_xor(sm, 2);
    const float mean = sm * (1.f / 64.f);
    float vs = 0.f;
#pragma unroll
    for (int i = 0; i < 16; ++i) { y[i] -= mean; vs += y[i] * y[i]; }
    vs += __shfl_xor(vs, 1); vs += __shfl_xor(vs, 2);
    const float rs = rsqrtf(vs * (1.f / 64.f) + 64e-5f);
#pragma unroll
    for (int i8 = 0; i8 < 2; ++i8) {
        const u32x4 vw = *(const u32x4*)(vf + i8 * 8), gw = *(const u32x4*)(gg + i8 * 8);
        u32x4 w;
#pragma unroll
        for (int e = 0; e < 4; ++e) {
            const int i = i8 * 8 + e * 2;
            const float v0 = __uint_as_float(vw[e] << 16), v1 = __uint_as_float(vw[e] & 0xffff0000u), g0 = __uint_as_float(gw[e] << 16), g1 = __uint_as_float(gw[e] & 0xffff0000u);
            w[e] = pack2((y[i] * rs * lnw[i] + lnb[i] + rk * v0) * g0, (y[i + 1] * rs * lnw[i + 1] + lnb[i + 1] + rk * v1) * g1);
        }
        *(u32x4*)(mp + i8 * 8) = w;
    }
}


DI void attn_unit(const P& p, int unit, char* lds) {
    const int tid = tidx(), lane = tid & 63, w = tid >> 6, r_ = lane & 31, hl = lane >> 5;
    const int idx = unit & 31, h = (unit >> 5) & 7, g = (unit >> 8) % 3, b = unit / 768;
    const int lg2 = g * 2, dil = 1 << lg2, L = SEQ >> lg2, ntl = L >> 7;
    const int rs = idx / ntl, qt = idx % ntl;
    const int hg = g * 8 + h;
    const bf16_t* QK = (const bf16_t*)(p.ws + WS_QK);
    const bf16_t* VT = (const bf16_t*)(p.ws + WS_VT) + ((size_t)((b * 24 + hg) * dil + rs) * 64) * L;
    const int qi = 32 * w + r_;
    const int q_idx = 128 * qt + qi;
    const size_t qrow = (size_t)(b * SEQ + q_idx * dil + rs);
    const int kbase0 = 128 * qt - 128;
    char* Kt = lds;
    char* Vt = lds + 32768;
    __syncthreads();
#pragma unroll
    for (int i = 0; i < 8; ++i) {
        const int id = tid + i * 256, row = id >> 3, pc = id & 7, c = pc ^ ((row >> 1) & 7);
        int k_idx = kbase0 + row; if (k_idx < 0) k_idx = 0;
        glds16(QK + (size_t)(b * SEQ + k_idx * dil + rs) * 3072 + 1536 + hg * 64 + c * 8, Kt + id * 16);
    }
#pragma unroll
    for (int i = 0; i < 8; ++i) {
        const int id = tid + i * 256, row = id >> 5, pq = id & 31, q = pq ^ (row & 31);
        int k0 = kbase0 + q * 8; if (k0 < 0) k0 = 0;
        glds16(VT + (size_t)row * L + k0, Vt + id * 16);
    }
    bf16x8 qf[4];
#pragma unroll
    for (int ks = 0; ks < 4; ++ks) qf[ks] = *(const bf16x8*)(QK + qrow * 3072 + hg * 64 + 16 * ks + 8 * hl);
    asm volatile("s_waitcnt vmcnt(0)" ::: "memory");
    __syncthreads();
    f32x16 st[5];
    float mx = -1.0e30f;
#pragma unroll
    for (int kbi = 0; kbi < 5; ++kbi) {
        const int krow = 32 * (w + kbi) + r_;
#pragma unroll
        for (int r = 0; r < 16; ++r) st[kbi][r] = 0.f;
#pragma unroll
        for (int ks = 0; ks < 4; ++ks) {
            const bf16x8 kf = *(const bf16x8*)(Kt + krow * 128 + (((2 * ks + hl) ^ ((krow >> 1) & 7)) * 16));
            st[kbi] = mfma32(kf, qf[ks], st[kbi]);
        }
#pragma unroll
        for (int r = 0; r < 16; ++r) {
            const int kj = 32 * (w + kbi) + (r & 3) + 8 * (r >> 2) + 4 * hl;
            const bool valid = (kj >= qi) && (kj <= qi + 128) && (kbase0 + kj >= 0);
            const float sv = valid ? st[kbi][r] * 0.125f : -1.0e30f;
            st[kbi][r] = sv; mx = fmaxf(mx, sv);
        }
    }
    mx = fmaxf(mx, __shfl_xor(mx, 32));
    float l = 0.f;
#pragma unroll
    for (int kbi = 0; kbi < 5; ++kbi)
#pragma unroll
        for (int r = 0; r < 16; ++r) { const float pv = __expf(st[kbi][r] - mx); st[kbi][r] = pv; l += pv; }
    l += __shfl_xor(l, 32);
    f32x16 ot[2];
#pragma unroll
    for (int dt = 0; dt < 2; ++dt)
#pragma unroll
        for (int r = 0; r < 16; ++r) ot[dt][r] = 0.f;
#pragma unroll
    for (int kbi = 0; kbi < 5; ++kbi)
#pragma unroll
        for (int s2 = 0; s2 < 2; ++s2) {
            const bf16x8 pb = pack_step(st[kbi], s2);
            const int q0 = 4 * (w + kbi) + 2 * s2;
#pragma unroll
            for (int dt = 0; dt < 2; ++dt) {
                const int drow = 32 * dt + r_;
                const u32x2 lo = *(const u32x2*)(Vt + drow * 512 + ((q0 ^ (drow & 31)) * 16) + 8 * hl);
                const u32x2 hi = *(const u32x2*)(Vt + drow * 512 + (((q0 + 1) ^ (drow & 31)) * 16) + 8 * hl);
                u32x4 vw; vw.x = lo.x; vw.y = lo.y; vw.z = hi.x; vw.w = hi.y;
                ot[dt] = mfma32(__builtin_bit_cast(bf16x8, vw), pb, ot[dt]);
            }
        }
    const float inv = 1.f / l;
    bf16_t* og = (bf16_t*)(p.ws + WS_OG) + ((size_t)g * T + qrow) * 512 + h * 64;
#pragma unroll
    for (int dt = 0; dt < 2; ++dt)
#pragma unroll
        for (int rg = 0; rg < 4; ++rg) {
            u32x2 wv; wv.x = pack2(ot[dt][rg * 4] * inv, ot[dt][rg * 4 + 1] * inv); wv.y = pack2(ot[dt][rg * 4 + 2] * inv, ot[dt][rg * 4 + 3] * inv);
            *(u32x2*)(og + 32 * dt + 8 * rg + 4 * hl) = wv;
        }
    if (hl == 0) ((float*)(p.ws + WS_LSE))[((size_t)g * T + qrow) * 8 + h] = mx + __logf(l);
}
DI void phase_attn_merge(const P& p) {
    const bf16_t* og = (const bf16_t*)(p.ws + WS_OG);
    const float* lse = (const float*)(p.ws + WS_LSE);
    bf16_t* o = (bf16_t*)p.out;
    for (int i = bidx() * 256 + tidx(); i < T * 64; i += gridDim.x * 256) {
        const int t = i >> 6, c8 = i & 63, h = c8 >> 3;
        const float l0 = lse[(size_t)t * 8 + h], l1 = lse[((size_t)T + t) * 8 + h], l2 = lse[((size_t)2 * T + t) * 8 + h];
        const float m = fmaxf(l0, fmaxf(l1, l2));
        float w0 = __expf(l0 - m), w1 = __expf(l1 - m), w2 = __expf(l2 - m);
        const float inv = 1.f / (w0 + w1 + w2); w0 *= inv; w1 *= inv; w2 *= inv;
        const u32x4 a = *(const u32x4*)(og + (size_t)t * 512 + c8 * 8), bq = *(const u32x4*)(og + ((size_t)T + t) * 512 + c8 * 8), cq = *(const u32x4*)(og + ((size_t)2 * T + t) * 512 + c8 * 8);
        u32x4 r;
#pragma unroll
        for (int e = 0; e < 4; ++e) {
            const float x0 = w0 * __uint_as_float(a[e] << 16) + w1 * __uint_as_float(bq[e] << 16) + w2 * __uint_as_float(cq[e] << 16);
            const float x1 = w0 * __uint_as_float(a[e] & 0xffff0000u) + w1 * __uint_as_float(bq[e] & 0xffff0000u) + w2 * __uint_as_float(cq[e] & 0xffff0000u);
            r[e] = pack2(x0, x1);
        }
        *(u32x4*)(o + (size_t)t * 512 + c8 * 8) = r;
    }
}


#define XB_TMO      128
#define XB_XCNT(j)  (256  + 64 * (j))
#define XB_XSUB(j)  (1280 + 64 * (j))
#define XB_XGEN(j)  (2304 + 64 * (j))
#define XB_TOP      3328
#define XB_TOPGEN   3392
#define XCD_BAR_WORDS 3456
#define XB_SPIN_CAP (1u << 22)
#define LAS __attribute__((address_space(3)))
DI unsigned xb_ld(unsigned* p)              { return __hip_atomic_load(p, __ATOMIC_RELAXED, __HIP_MEMORY_SCOPE_AGENT); }
DI unsigned xb_add(unsigned* p, unsigned v) { return __hip_atomic_fetch_add(p, v, __ATOMIC_RELAXED, __HIP_MEMORY_SCOPE_AGENT); }
DI unsigned xb_xcc_id() { return (unsigned)__builtin_amdgcn_s_getreg((3 << 11) | 20) & 0xFu; }
#define XB_SPIN(cond, bar) do { unsigned _sp = 0; while (cond) { if (_sp < 32u) __builtin_amdgcn_s_sleep(2); else __builtin_amdgcn_s_sleep(24); \
    if ((++_sp & 255u) == 0u) { if (xb_ld(&(bar)[XB_TMO])) break; if (_sp > XB_SPIN_CAP) { atomicAdd(&(bar)[XB_TMO], 1u); break; } } } } while (0)
struct XcdBarrier { unsigned* bar; unsigned x; volatile LAS unsigned* st; };
DI XcdBarrier xcd_barrier_post(unsigned* bar, volatile LAS unsigned* st) {
    XcdBarrier b; b.bar = bar; b.x = xb_xcc_id(); b.st = st;
    if (threadIdx.x == 0) (void)xb_add(&bar[XB_XCNT(b.x)], 1u);
    return b;
}
DI void xcd_barrier_complete(unsigned* bar, unsigned x, unsigned& nloc, unsigned& nx) {
    const unsigned G = gridDim.x * gridDim.y * gridDim.z;
    unsigned sum, cnt, mine, sp = 0u;
    for (;;) {
        sum = 0u; cnt = 0u; mine = 0u;
#pragma unroll
        for (unsigned j = 0; j < 16; ++j) { const unsigned c = xb_ld(&bar[XB_XCNT(j)]); sum += c; cnt += (c > 0u) ? 1u : 0u; mine = (j == x) ? c : mine; }
        if (sum == G) break;
        __builtin_amdgcn_s_sleep(1);
        if ((++sp & 255u) == 0u) { if (xb_ld(&bar[XB_TMO])) break; if (sp > XB_SPIN_CAP) { atomicAdd(&bar[XB_TMO], 1u); break; } }
    }
    nloc = mine > 0u ? mine : 1u; nx = cnt > 0u ? cnt : 1u;
}
DI void xcd_barrier(const XcdBarrier& b) {
    asm volatile("s_waitcnt vmcnt(0)" ::: "memory");
    __syncthreads();
    if (threadIdx.x == 0) {
        unsigned* bar = b.bar; unsigned bx = b.x;
        asm volatile("" : "+s"(bar), "+s"(bx));
        __builtin_amdgcn_s_waitcnt(0);
        unsigned nloc = b.st[0], nx = b.st[1];
        if (nloc == 0u) { xcd_barrier_complete(bar, bx, nloc, nx); b.st[0] = nloc; b.st[1] = nx; }
        const unsigned old = xb_add(&bar[XB_XSUB(bx)], 1u);
        const unsigned gen = old / nloc;
        if (old + 1u == (gen + 1u) * nloc) {
            __builtin_amdgcn_fence(__ATOMIC_RELEASE, "agent");
            asm volatile("s_waitcnt vmcnt(0)" ::: "memory");
            const unsigned og = xb_add(&bar[XB_TOP], 1u);
            const unsigned tg = og / nx;
            if (og + 1u == (tg + 1u) * nx) xb_add(&bar[XB_TOPGEN], 1u);
            else XB_SPIN(xb_ld(&bar[XB_TOPGEN]) == tg, bar);
            __builtin_amdgcn_fence(__ATOMIC_ACQUIRE, "agent");
            xb_add(&bar[XB_XGEN(bx)], 1u);
            asm volatile("s_waitcnt vmcnt(0)" ::: "memory");
        } else {
            XB_SPIN(xb_ld(&bar[XB_XGEN(bx)]) == gen, bar);
            __builtin_amdgcn_fence(__ATOMIC_ACQUIRE, "agent");
            asm volatile("s_waitcnt vmcnt(0)" ::: "memory");
        }
    }
    __syncthreads();
}

constexpr int LDS_BYTES = RP_END;
static_assert(GP_END + 6144 <= LDS_BYTES, "LDS");
__global__ void __launch_bounds__(256, 2) __attribute__((amdgpu_waves_per_eu(2, 2))) mega(P p) {
    cg::grid_group grid = cg::this_grid();
    extern __shared__ __attribute__((aligned(16))) char lds[];
    if (threadIdx.x < 4) ((volatile LAS unsigned*)(lds + LDS_BYTES))[threadIdx.x] = 0u;
    __syncthreads();
    const XcdBarrier xb = xcd_barrier_post((unsigned*)(p.ws + WS_CTL + CTL_BAR), (volatile LAS unsigned*)(lds + LDS_BYTES));
#define GSYNC() xcd_barrier(xb)
    const bf16_t* HN = (const bf16_t*)p.out;
    const bf16_t* XB = (const bf16_t*)(p.ws + WS_XB);
    const bf16_t* Win = (const bf16_t*)(p.ws + WS_W + W_IN);
    const bf16_t* Wout = (const bf16_t*)(p.ws + WS_W + W_OUT);
    {
        const unsigned hw = (unsigned)__builtin_amdgcn_s_getreg((31 << 11) | 4);
        const unsigned key = 1u + ((xb.x << 16) | (hw & 0xFF00u));
        if (threadIdx.x == 0) ((unsigned*)(p.ws + WS_CTL + CTL_CUTAB))[bidx()] = key;
    }
    phase_rope(p);
    phase_convert_io(p, 0, lds, bidx(), gridDim.x);
    phase_prep<0>(p, p.in[I_EVNORM], 0);
    if (p.ws == nullptr) grid.sync();
    GSYNC();
    volatile LAS unsigned* qword = (volatile LAS unsigned*)(lds + LDS_BYTES + 8);
    int idle2, idle3, rank3, nact3;
    {
        const unsigned* cut = (const unsigned*)(p.ws + WS_CTL + CTL_CUTAB);
        unsigned* keys = (unsigned*)lds; unsigned* cntw = keys + 2048;
        const int G = (int)gridDim.x < 2048 ? (int)gridDim.x : 2048;
        __syncthreads();
        for (int j = threadIdx.x; j < G; j += 256) keys[j] = cut[j];
        if (threadIdx.x < 4) cntw[threadIdx.x] = 0u;
        __syncthreads();
        const unsigned mine = keys[bidx() < G ? bidx() : 0];
        for (int j = threadIdx.x; j < G; j += 256) {
            bool sh16 = false, sh32 = false;
            for (int k = 0; k < 32 && k < G; ++k) { const bool eq = keys[k] == keys[j] && k != j; if (eq) { sh32 = true; if (k < 16) sh16 = true; } }
            const bool act3 = j >= 32 && !sh32;
            if (act3) { atomicAdd(&cntw[0], 1u); if (j < bidx()) atomicAdd(&cntw[1], 1u); }
            if (j == bidx()) { cntw[2] = (j >= 16 && sh16) ? 1u : 0u; cntw[3] = (j >= 32 && sh32) ? 1u : 0u; }
        }
        (void)mine;
        __syncthreads();
        nact3 = __builtin_amdgcn_readfirstlane((int)cntw[0]); rank3 = __builtin_amdgcn_readfirstlane((int)cntw[1]);
        idle2 = __builtin_amdgcn_readfirstlane((int)cntw[2]); idle3 = __builtin_amdgcn_readfirstlane((int)cntw[3]);
        if (nact3 < 1) { nact3 = 1; }
        __syncthreads();
    }
    for (int layer = 0; layer < 4; ++layer) {
        const int li = layer >> 1;
        if ((layer & 1) == 0) {
            phase_gemm<EPI_EVEN_IN>(p, XB, 1024, Win, 1024, EVPAD / 128, lds);
            GSYNC();
            for (int u = bidx(); u < 1024; u += gridDim.x) gdn_prep_unit(p, li, u, lds);
            GSYNC();
            if (bidx() < 16) gdn_scan_block(p, bidx(), lds);
            if (!idle2) {
                unsigned* qctr = (unsigned*)(p.ws + WS_CTL + CTL_QUEUE) + li * 64;
                for (;;) {
                    __syncthreads();
                    if (threadIdx.x == 0) *qword = atomicAdd(qctr, 1u);
                    __syncthreads();
                    const unsigned u = *qword;
                    if (u >= 2048u + 768u) break;
                    if (u < 2048u) rwkv_prep_unit(p, li, (int)u, lds);
                    else convert_moe_tile(p, layer + 1, lds, (int)u - 2048);
                }
            }
            GSYNC();
            if (bidx() < 32) rwkv_scan_block(p, bidx(), lds);
            else if (!idle3) {
                for (int u = rank3; u < 1024; u += nact3) gdn_post_unit(p, li, u);
                phase_convert_moe(p, layer, lds, rank3, nact3);
            }
            GSYNC();
            for (int u = bidx(); u < 2048; u += gridDim.x) rwkv_post_unit(p, li, u);
            GSYNC();
            phase_gemm<EPI_RESID>(p, (const bf16_t*)(p.ws + WS_PROJ), EVLD, Wout, 1024, 8, lds, false, HN, 1024, 512);
        } else {
            phase_gemm<EPI_ODD_IN>(p, XB, 1024, Win, 1024, ODC / 128, lds);
            GSYNC();
            for (int u = bidx(); u < 3072; u += gridDim.x) attn_unit(p, u, lds);
            GSYNC();
            phase_attn_merge(p);
            GSYNC();
            phase_gemm<EPI_RESID>(p, HN, 512, Wout, 512, 8, lds);
        }
        GSYNC();
        phase_router(p, p.in[I_FFNNORM] + layer * 1024, layer, lds);
        GSYNC();
        {
            const int nt = phase_moe_up(p, layer, lds);
            if (layer < 3) {
                const int G = (int)gridDim.x, rounds = (nt + G - 1) / G, first = nt - (rounds - 1) * G;
                if (first >= G) phase_convert_io(p, layer + 1, lds, bidx(), G);
                else if (bidx() >= first) phase_convert_io(p, layer + 1, lds, bidx() - first, G - first);
            }
        }
        GSYNC();
        phase_moe_down(p, layer, lds);
        GSYNC();
        if (layer < 3) {
            phase_prep<1>(p, ((layer + 1) & 1) ? p.in[I_ODNORM] + ((layer + 1) >> 1) * 1024 : p.in[I_EVNORM] + ((layer + 1) >> 1) * 1024, layer + 1);
            GSYNC();
        }
    }
    phase_prep<3>(p, p.in[I_FINAL], 0);
}

extern "C" void kernel_launch(void* const* d_in, const int* in_sizes, int n_in, void* d_out, int out_size, void* d_ws, size_t ws_size, hipStream_t stream) {
    if (n_in != 34 || out_size != T * D || ws_size < WS_NEED) { fprintf(stderr, "kernel_launch: unexpected shapes (n_in %d out %d ws %zu need %zu)\n", n_in, out_size, ws_size, (size_t)WS_NEED); return; }
    static int grid_blocks = 0;
    if (!grid_blocks) {
        int dev = 0, cus = 0, per_cu = 0;
        (void)hipGetDevice(&dev);
        (void)hipDeviceGetAttribute(&cus, hipDeviceAttributeMultiprocessorCount, dev);
        (void)hipFuncSetAttribute((const void*)mega, hipFuncAttributeMaxDynamicSharedMemorySize, LDS_BYTES + 16);
        (void)hipOccupancyMaxActiveBlocksPerMultiprocessor(&per_cu, mega, 256, LDS_BYTES + 16);
        if (per_cu < 1) per_cu = 1;
        if (per_cu > 2) per_cu = 2;
        grid_blocks = cus * per_cu;
    }
    P p{};
    for (int i = 0; i < 34; ++i) p.in[i] = (const float*)d_in[i];
    p.out = (float*)d_out; p.ws = (unsigned char*)d_ws;
    (void)hipMemsetAsync((char*)d_ws + WS_CTL, 0, 65536, stream);
    void* args[] = {&p};
    hipError_t e = hipLaunchCooperativeKernel((void*)mega, dim3(grid_blocks), dim3(256), args, LDS_BYTES + 16, stream);
    if (e != hipSuccess) fprintf(stderr, "cooperative launch failed: %s (grid %d)\n", hipGetErrorString(e), grid_blocks);
}
```

```cpp
#include <hip/hip_runtime.h>
#include <cstdio>
#include <cstdint>
#include <cmath>
#include <hip/hip_cooperative_groups.h>
namespace cg = cooperative_groups;

typedef unsigned short bf16_t;
typedef short bf16x8 __attribute__((ext_vector_type(8)));
typedef float f32x4 __attribute__((ext_vector_type(4)));
typedef unsigned u32x4 __attribute__((ext_vector_type(4)));
typedef unsigned u32x2 __attribute__((ext_vector_type(2)));
#define DI __device__ __forceinline__

constexpr int T = 16384, SEQ = 4096, BATCH = 4, D = 1024;
constexpr int EVC = 3784, EVLD = 3784, EVPAD = 3840;
constexpr int ODC = 4608;
constexpr int RW0 = 2056;
constexpr int C_R = 2056, C_K = 2568, C_V = 3080, C_HW = 3592, C_HA = 3624, C_HG = 3656, C_HV = 3752;
constexpr int NEXP = 16, FF = 256;
constexpr int HROWS = 34816;

constexpr size_t WS_CTL = 0;
constexpr size_t CTL_EGL = 4096;
constexpr size_t CTL_CUTAB = 8192;
constexpr size_t CTL_QUEUE = 49152;
constexpr size_t CTL_CNT = 32768;
constexpr size_t CTL_BAR = 16384;
constexpr size_t WS_LIST = 65536;
constexpr size_t WS_GATE = WS_LIST + 16 * 16384 * 4;
constexpr size_t WS_RK = WS_GATE + 16 * 16384 * 4;
constexpr size_t WS_SSQ = WS_RK + (size_t)T * 8 * 4;
constexpr size_t WS_ROPE = WS_SSQ + (size_t)16 * T * 4;
constexpr size_t WS_W = WS_ROPE + (size_t)T * 32 * 8;
constexpr size_t W_IN = 0;
constexpr size_t W_OUT = (size_t)4608 * 1024 * 2;
constexpr size_t W_13 = W_OUT + (size_t)1024 * 1024 * 2;
constexpr size_t W_2 = W_13 + (size_t)16 * 512 * 1024 * 2;
constexpr size_t W_LW = W_2 + (size_t)16 * 1024 * 256 * 2;
constexpr size_t W_BYTES = W_LW + (size_t)512 * 192 * 2;
constexpr size_t WS_XB = WS_W + W_BYTES;
constexpr size_t WS_HN = WS_XB;
constexpr size_t WS_VF = WS_HN + (size_t)T * 1024 * 2;
constexpr size_t WS_R2 = WS_VF + (size_t)T * 512 * 2;
constexpr size_t WS_PROJ = WS_R2;
constexpr size_t WS_GOPS = WS_R2 + (size_t)T * EVLD * 2;
constexpr size_t GOPS_CH = 73728, GO_UF = 0, GO_WF = 16384, GO_QF = 32768, GO_AF = 49152, GO_KF = 57344;
constexpr size_t WS_ROPS = WS_GOPS + 1024 * GOPS_CH;
constexpr size_t WS_QK = WS_R2;
constexpr size_t WS_VT = WS_QK + (size_t)T * 3072 * 2;
constexpr size_t WS_OG = WS_VT + (size_t)T * 1536 * 2;
constexpr size_t WS_LSE = WS_OG + (size_t)3 * T * 512 * 2;
constexpr size_t WS_END3 = WS_LSE + (size_t)3 * T * 8 * 4;
constexpr size_t WS_YS = WS_R2;
constexpr size_t WS_H = WS_YS + (size_t)2 * T * 1024 * 2;
constexpr size_t WS_GG = WS_ROPS + (size_t)2048 * 16384;
constexpr size_t WS_END0 = WS_GG + (size_t)T * 512 * 2;
constexpr size_t WS_END1 = WS_H + (size_t)HROWS * 256 * 2;
constexpr size_t WS_END2 = WS_R2 + (size_t)T * 4608 * 2;
static_assert(WS_END3 <= WS_END0, "odd-layer regions exceed even-layer footprint");
constexpr size_t WS_END = WS_END0 > WS_END1 ? (WS_END0 > WS_END2 ? WS_END0 : WS_END2) : (WS_END1 > WS_END2 ? WS_END1 : WS_END2);

constexpr size_t WS_RSL = WS_END;
constexpr size_t WS_RSIN = WS_RSL + 16 * 16384 * 4;
constexpr size_t WS_NEED = WS_RSIN + (size_t)T * 4;
constexpr size_t WS_DUMMY = WS_END0;
struct P {
    const float* in[34];
    float* out;
    unsigned char* ws;
};
enum { I_X = 0, I_POS, I_EVNORM, I_EVWIN, I_VRESDOWN, I_EVWOUT, I_CONVW, I_ALOG, I_DTB, I_GDNNORM, I_MU, I_W0, I_W2, I_A0, I_A2, I_G2,
       I_KK, I_KA, I_RK, I_LNW, I_LNB, I_VRESMU, I_V0, I_V2, I_ODNORM, I_ODWIN, I_ODWOUT, I_FFNNORM, I_WGROUP, I_WEXPERT, I_W1, I_W3, I_MW2, I_FINAL };

DI int tidx() { int t = threadIdx.x; asm volatile("" : "+v"(t)); return t; }
DI int bidx() { int b = blockIdx.x; asm volatile("" : "+s"(b)); return b; }
typedef __bf16 bf2_t __attribute__((ext_vector_type(2)));
typedef float f2_t __attribute__((ext_vector_type(2)));
DI bf16_t f2bf(float x) { return __builtin_bit_cast(bf16_t, (__bf16)x); }
DI float bf2f(bf16_t h) { return __uint_as_float(((unsigned)h) << 16); }
DI unsigned pack2(float lo, float hi) { const f2_t v = {lo, hi}; return __builtin_bit_cast(unsigned, __builtin_convertvector(v, bf2_t)); }
DI float wave_sum(float v) {
#pragma unroll
    for (int o = 32; o > 0; o >>= 1) v += __shfl_xor(v, o);
    return v;
}
DI float wave_max(float v) {
#pragma unroll
    for (int o = 32; o > 0; o >>= 1) v = fmaxf(v, __shfl_xor(v, o));
    return v;
}
DI float sigmoidf_(float x) { return __builtin_amdgcn_rcpf(1.f + __expf(-x)); }
DI float siluf_(float x) { return x * __builtin_amdgcn_rcpf(1.f + __expf(-x)); }
DI float softplusf_(float x) { return fmaxf(x, 0.f) + __logf(1.f + __expf(-fabsf(x))); }

struct ConvJob { const float* src; bf16_t* dst; int K, N, ldd; int mode; const float* ks = nullptr; };
DI int rowmap(int mode, int n) { return mode == 0 ? n : ((n >> 4) * 32 + (n & 15) + (mode == 2 ? 16 : 0)); }
DI void conv_tile(const ConvJob& j, int tile, float* lds  ) {
    const int ntn = (j.N + 255) / 256;
    const int tk = tile / ntn, tn = tile % ntn;
    const int tid = tidx();
    __syncthreads();
    float4 v[16];
#pragma unroll
    for (int i = 0; i < 16; ++i) {
        const int e = tid + i * 256, k = e >> 6, n4 = (e & 63) * 4;
        const int gk = tk * 64 + k, gn = tn * 256 + n4;
        v[i] = make_float4(0.f, 0.f, 0.f, 0.f);
        if (gn < j.N) v[i] = *(const float4*)(j.src + (size_t)gk * j.N + gn);
    }
    if (j.ks) {
        float sc[16];
#pragma unroll
        for (int i = 0; i < 16; ++i) sc[i] = j.ks[tk * 64 + (tid >> 6) + 4 * i];
#pragma unroll
        for (int i = 0; i < 16; ++i) { v[i].x *= sc[i]; v[i].y *= sc[i]; v[i].z *= sc[i]; v[i].w *= sc[i]; }
    }
#pragma unroll
    for (int i = 0; i < 16; ++i) { const int e = tid + i * 256, k = e >> 6, n4 = (e & 63) * 4; *(float4*)(lds + k * 260 + n4) = v[i]; }
    __syncthreads();
#pragma unroll
    for (int i = 0; i < 8; ++i) {
        const int n = tid, k8 = i * 8;
        const int gn = tn * 256 + n;
        if (gn < j.N) {
            u32x4 w;
            w.x = pack2(lds[(k8 + 0) * 260 + n], lds[(k8 + 1) * 260 + n]); w.y = pack2(lds[(k8 + 2) * 260 + n], lds[(k8 + 3) * 260 + n]);
            w.z = pack2(lds[(k8 + 4) * 260 + n], lds[(k8 + 5) * 260 + n]); w.w = pack2(lds[(k8 + 6) * 260 + n], lds[(k8 + 7) * 260 + n]);
            *(u32x4*)(j.dst + (size_t)rowmap(j.mode, gn) * j.ldd + tk * 64 + k8) = w;
        }
    }
}
DI void phase_convert_io(const P& p, int layer, char* ldsc, int b0, int bs) {
    float* lds = (float*)ldsc;
    unsigned char* W = p.ws + WS_W;
    const int li = layer >> 1;
    if ((layer & 1) == 0) {
        const float* ng = p.in[I_EVNORM] + li * 1024;
        const ConvJob j0{p.in[I_EVWIN] + (size_t)li * 1024 * 3752, (bf16_t*)(W + W_IN), 1024, 3752, 1024, 0, ng};
        for (int t = b0; t < 16 * 15; t += bs) conv_tile(j0, t, lds);
        if (li == 1) {
            const ConvJob j1{p.in[I_VRESDOWN], (bf16_t*)(W + W_IN) + (size_t)3752 * 1024, 1024, 32, 1024, 0, ng};
            for (int t = b0; t < 16; t += bs) conv_tile(j1, t, lds);
        }
        const ConvJob j2{p.in[I_EVWOUT] + (size_t)li * 1024 * 1024, (bf16_t*)(W + W_OUT), 1024, 1024, 1024, 0};
        for (int t = b0; t < 16 * 4; t += bs) conv_tile(j2, t, lds);
        {
            bf16_t* LW = (bf16_t*)(W + W_LW);
            for (int i = b0 * 256 + tidx(); i < 512 * 192; i += bs * 256) {
                const int ch = i / 192, j = i % 192;
                float v;
                if (j < 32) v = p.in[I_W2][((size_t)li * 32 + j) * 512 + ch];
                else if (j < 64) v = p.in[I_A2][((size_t)li * 32 + j - 32) * 512 + ch];
                else if (j < 160) v = p.in[I_G2][((size_t)li * 96 + j - 64) * 512 + ch];
                else v = (li == 1) ? p.in[I_V2][(size_t)(j - 160) * 512 + ch] : 0.f;
                LW[i] = f2bf(v);
            }
        }
        const int r0 = (li == 1) ? 3784 : 3752;
        bf16_t* z = (bf16_t*)(W + W_IN) + (size_t)r0 * 1024;
        const size_t n = (size_t)(EVPAD - r0) * 1024;
        for (size_t i = (size_t)b0 * 256 + tidx(); i < n; i += (size_t)bs * 256) z[i] = 0;
    } else {
        const ConvJob j0{p.in[I_ODWIN] + (size_t)li * 1024 * 4608, (bf16_t*)(W + W_IN), 1024, 4608, 1024, 0, p.in[I_ODNORM] + li * 1024};
        for (int t = b0; t < 16 * 18; t += bs) conv_tile(j0, t, lds);
        const ConvJob j2{p.in[I_ODWOUT] + (size_t)li * 512 * 1024, (bf16_t*)(W + W_OUT), 512, 1024, 512, 0};
        for (int t = b0; t < 8 * 4; t += bs) conv_tile(j2, t, lds);
    }
}
DI unsigned char* moe_w(const P& p, int layer) { return (layer & 1) ? (unsigned char*)p.out + ((size_t)32 << 20) - W_13 : p.ws + WS_W; }
DI void convert_moe_tile(const P& p, int layer, char* ldsc, int t);
DI void phase_convert_moe(const P& p, int layer, char* ldsc, int b0, int bs) {
    for (int t = b0; t < 16 * 3 * 16; t += bs) convert_moe_tile(p, layer, ldsc, t);
}
DI void convert_moe_tile(const P& p, int layer, char* ldsc, int t) {
    float* lds = (float*)ldsc;
    unsigned char* W = moe_w(p, layer);
    {
        const int e = t / 48, r = t % 48, which = r / 16, tile = r % 16;
        ConvJob j;
        const float* fg = p.in[I_FFNNORM] + layer * 1024;
        if (which == 0) j = ConvJob{p.in[I_W1] + ((size_t)layer * 16 + e) * 1024 * 256, (bf16_t*)(W + W_13) + (size_t)e * 512 * 1024, 1024, 256, 1024, 1, fg};
        else if (which == 1) j = ConvJob{p.in[I_W3] + ((size_t)layer * 16 + e) * 1024 * 256, (bf16_t*)(W + W_13) + (size_t)e * 512 * 1024, 1024, 256, 1024, 2, fg};
        else j = ConvJob{p.in[I_MW2] + ((size_t)layer * 16 + e) * 256 * 1024, (bf16_t*)(W + W_2) + (size_t)e * 1024 * 256, 256, 1024, 256, 0};
        conv_tile(j, tile, lds);
    }
}

DI void phase_rope(const P& p) {
    float2* tab = (float2*)(p.ws + WS_ROPE);
    const int* pos = (const int*)p.in[I_POS];
    for (int i = bidx() * 256 + tidx(); i < T * 32; i += gridDim.x * 256) {
        const int t = i >> 5, f = i & 31;
        const float inv = powf(10000.0f, -(float)f * (2.0f / 64.0f));
        const float ang = (float)pos[t] * inv;
        float s, c; sincosf(ang, &s, &c);
        tab[i] = make_float2(c, s);
    }
}

template <int MODE>
DI void phase_prep(const P& p, const float* gain, int layer) {
    const int lane = tidx() & 63, wid = tidx() >> 6;
    const int nw = gridDim.x * 4;
    bf16_t* hn = (bf16_t*)p.out;
    bf16_t* xb = (bf16_t*)(p.ws + WS_XB);
    const bf16_t* y0 = (const bf16_t*)(p.ws + WS_YS);
    const bf16_t* y1 = y0 + (size_t)T * 1024;
    float4 gq[4];
#pragma unroll
    for (int i = 0; i < 4; ++i) gq[i] = *(const float4*)(gain + i * 256 + lane * 4);
    for (int t = bidx() * 4 + wid; t < T; t += nw) {
        float4 v[4];
        float ss = 0.f;
#pragma unroll
        for (int i = 0; i < 4; ++i) {
            const size_t off = (size_t)t * 1024 + i * 256 + lane * 4;
            if (MODE == 0) v[i] = *(const float4*)(p.in[I_X] + off);
            else { const u32x2 xx = *(const u32x2*)(xb + off); v[i].x = __uint_as_float(xx.x << 16); v[i].y = __uint_as_float(xx.x & 0xffff0000u); v[i].z = __uint_as_float(xx.y << 16); v[i].w = __uint_as_float(xx.y & 0xffff0000u); }
            if (MODE == 1 || MODE == 3) {
                const u32x2 a = *(const u32x2*)(y0 + off), b = *(const u32x2*)(y1 + off);
                v[i].x += __uint_as_float(a.x << 16) + __uint_as_float(b.x << 16); v[i].y += __uint_as_float(a.x & 0xffff0000u) + __uint_as_float(b.x & 0xffff0000u);
                v[i].z += __uint_as_float(a.y << 16) + __uint_as_float(b.y << 16); v[i].w += __uint_as_float(a.y & 0xffff0000u) + __uint_as_float(b.y & 0xffff0000u);
            }
            ss += v[i].x * v[i].x + v[i].y * v[i].y + v[i].z * v[i].z + v[i].w * v[i].w;
        }
        ss = wave_sum(ss);
        const float rstd = rsqrtf(ss * (1.0f / 1024.0f) + 1e-6f);
        if ((MODE == 0 || MODE == 1) && lane == 0) ((float*)(p.ws + WS_RSIN))[t] = rstd;
        float lg[20];
        if (MODE == 2) {
#pragma unroll
            for (int q = 0; q < 20; ++q) lg[q] = 0.f;
        }
#pragma unroll
        for (int i = 0; i < 4; ++i) {
            const int col = i * 256 + lane * 4;
            const size_t off = (size_t)t * 1024 + col;
            const float4 g = gq[i];
            float4 h; h.x = v[i].x * rstd * g.x; h.y = v[i].y * rstd * g.y; h.z = v[i].z * rstd * g.z; h.w = v[i].w * rstd * g.w;
            bf16_t* hd = hn + off;
            if (MODE == 0 || MODE == 1) { u32x2 w; w.x = pack2(v[i].x, v[i].y); w.y = pack2(v[i].z, v[i].w); *(u32x2*)(xb + off) = w; }
            if (MODE == 3) *(float4*)(p.out + off) = h;
            else if (MODE == 2) { u32x2 w; w.x = pack2(h.x, h.y); w.y = pack2(h.z, h.w); *(u32x2*)hd = w; }
            if (MODE == 2) {
                const float hh[4] = {h.x, h.y, h.z, h.w};
                const float* wg = p.in[I_WGROUP] + (size_t)layer * 1024 * 4;
                const float* we = p.in[I_WEXPERT] + (size_t)layer * 4 * 1024 * 4;
#pragma unroll
                for (int e = 0; e < 4; ++e) {
                    const float4 a = *(const float4*)(wg + (size_t)(col + e) * 4);
                    lg[0] += hh[e] * a.x; lg[1] += hh[e] * a.y; lg[2] += hh[e] * a.z; lg[3] += hh[e] * a.w;
#pragma unroll
                    for (int g2 = 0; g2 < 4; ++g2) {
                        const float4 b = *(const float4*)(we + ((size_t)g2 * 1024 + col + e) * 4);
                        lg[4 + g2 * 4 + 0] += hh[e] * b.x; lg[4 + g2 * 4 + 1] += hh[e] * b.y; lg[4 + g2 * 4 + 2] += hh[e] * b.z; lg[4 + g2 * 4 + 3] += hh[e] * b.w;
                    }
                }
            }
        }
        if (MODE == 2) {
#pragma unroll
            for (int q = 0; q < 20; ++q) lg[q] = wave_sum(lg[q]);
            if (lane == 0) {
                int gs = 0; float gm = lg[0];
#pragma unroll
                for (int g2 = 1; g2 < 4; ++g2) if (lg[g2] > gm) { gm = lg[g2]; gs = g2; }
                float den = 0.f;
#pragma unroll
                for (int g2 = 0; g2 < 4; ++g2) den += __expf(lg[g2] - gm);
                const float pg = 1.f / den;
                float el[4];
#pragma unroll
                for (int e = 0; e < 4; ++e) el[e] = gs == 0 ? lg[4 + e] : gs == 1 ? lg[8 + e] : gs == 2 ? lg[12 + e] : lg[16 + e];
                int i1 = 0; float v1 = el[0];
#pragma unroll
                for (int e = 1; e < 4; ++e) if (el[e] > v1) { v1 = el[e]; i1 = e; }
                int i2 = 0; float v2 = -3.4e38f;
#pragma unroll
                for (int e = 0; e < 4; ++e) if (e != i1 && el[e] > v2) { v2 = el[e]; i2 = e; }
                const float e2 = __expf(v2 - v1);
                const float g1 = pg / (1.f + e2), g2v = pg * e2 / (1.f + e2);
                unsigned* cnt = (unsigned*)(p.ws + WS_CTL + CTL_CNT) + layer * 16 * 64;
                int* list = (int*)(p.ws + WS_LIST);
                float* gl = (float*)(p.ws + WS_GATE);
                const int ea = gs * 4 + i1, eb = gs * 4 + i2;
                const unsigned ra = atomicAdd(&cnt[ea * 64], 1u);
                list[ea * 16384 + ra] = t * 2; gl[ea * 16384 + ra] = g1;
                const unsigned rb = atomicAdd(&cnt[eb * 64], 1u);
                list[eb * 16384 + rb] = t * 2 + 1; gl[eb * 16384 + rb] = g2v;
            }
        }
    }
}


typedef __attribute__((address_space(3))) unsigned lds_u32;
DI void g_dma(unsigned m0v, unsigned voff, const char* sbase) {
    asm volatile("s_mov_b32 m0, %0\n\ts_nop 0\n\tglobal_load_lds_dwordx4 %1, %2" :: "s"(m0v), "v"(voff), "s"(sbase) : "memory", "m0");
}
DI void phase_router(const P& p, const float* gain, int layer, char* ldsc) {
    const int tid = tidx(), lane = tid & 63, wid = tid >> 6;
    const bf16_t* xb = (const bf16_t*)(p.ws + WS_XB);
    const float* wg = p.in[I_WGROUP] + (size_t)layer * 1024 * 4;
    const float* we = p.in[I_WEXPERT] + (size_t)layer * 4 * 1024 * 4;
    unsigned* cnt = (unsigned*)(p.ws + WS_CTL + CTL_CNT) + layer * 16 * 64;
    int* list = (int*)(p.ws + WS_LIST);
    float* gl = (float*)(p.ws + WS_GATE);
    float* rsl = (float*)(p.ws + WS_RSL);
    f32x4* WS = (f32x4*)ldsc;
    unsigned* lcnt = (unsigned*)(ldsc + 40960); unsigned* lbase = lcnt + 16; int* e_ent = (int*)(lcnt + 32); unsigned* r_ent = (unsigned*)(e_ent + 32); int* t_ent = (int*)(r_ent + 32); float* g_ent = (float*)(t_ent + 32); float* rs_ent = g_ent + 32;
    const unsigned wsb = (unsigned)__builtin_amdgcn_readfirstlane((int)((unsigned)(size_t)(lds_u32*)ldsc + wid * 1024));
    auto stage = [&](int i, int buf) {
        const unsigned voff = (unsigned)(i * 256 + lane * 4 + wid) * 16u;
#pragma unroll
        for (int r = 0; r < 5; ++r) g_dma(wsb + (unsigned)(buf * 1280 + r * 256) * 16u, voff, (const char*)(r == 0 ? wg : we + (size_t)(r - 1) * 4096));
    };
    u32x2 xq[4];
#pragma unroll
    for (int q = 0; q < 4; ++q) xq[q] = *(const u32x2*)(xb + (size_t)(bidx() * 16 + wid * 4 + q) * 1024 + lane * 4);
    for (int tb = bidx() * 16; tb < T; tb += gridDim.x * 16) {
        const int t0 = tb + wid * 4;
        __syncthreads();
        if (tid < 16) lcnt[tid] = 0u;
        stage(0, 0);
        float rstd[4];
        {
            const float pq = ((const float*)(p.ws + WS_SSQ))[(size_t)(lane & 15) * T + t0 + (lane >> 4)];
            float ss = pq;
            ss += __shfl_xor(ss, 1); ss += __shfl_xor(ss, 2); ss += __shfl_xor(ss, 4); ss += __shfl_xor(ss, 8);
#pragma unroll
            for (int q = 0; q < 4; ++q) rstd[q] = rsqrtf(__shfl(ss, q * 16) * (1.0f / 1024.0f) + 1e-6f);
        }
        float lg[4][20];
#pragma unroll
        for (int q = 0; q < 4; ++q)
#pragma unroll
            for (int j = 0; j < 20; ++j) lg[q][j] = 0.f;
#pragma unroll 1
        for (int i = 0; i < 4; ++i) {
            asm volatile("s_waitcnt vmcnt(0)" ::: "memory");
            __syncthreads();
            if (i + 1 < 4) stage(i + 1, (i + 1) & 1);
            const f32x4* W = WS + (i & 1) * 1280;
            const int col = i * 256 + lane * 4;
            const float4 g = *(const float4*)(gain + col);
            float hh[4][4];
#pragma unroll
            for (int q = 0; q < 4; ++q) {
                hh[q][0] = __uint_as_float(xq[q].x << 16) * rstd[q] * g.x; hh[q][1] = __uint_as_float(xq[q].x & 0xffff0000u) * rstd[q] * g.y; hh[q][2] = __uint_as_float(xq[q].y << 16) * rstd[q] * g.z; hh[q][3] = __uint_as_float(xq[q].y & 0xffff0000u) * rstd[q] * g.w;
            }
            {
                int tn0 = i + 1 < 4 ? t0 : t0 + (int)gridDim.x * 16; const int cn = ((i + 1) & 3) * 256 + lane * 4;
                tn0 = tn0 < T ? tn0 : t0;
#pragma unroll
                for (int q = 0; q < 4; ++q) xq[q] = *(const u32x2*)(xb + (size_t)(tn0 + q) * 1024 + cn);
            }
#pragma unroll
            for (int e = 0; e < 4; ++e) {
                const f32x4 a = W[(0 * 4 + e) * 64 + lane];
#pragma unroll
                for (int q = 0; q < 4; ++q) { lg[q][0] += hh[q][e] * a[0]; lg[q][1] += hh[q][e] * a[1]; lg[q][2] += hh[q][e] * a[2]; lg[q][3] += hh[q][e] * a[3]; }
#pragma unroll
                for (int g2 = 0; g2 < 4; ++g2) {
                    const f32x4 b = W[((1 + g2) * 4 + e) * 64 + lane];
#pragma unroll
                    for (int q = 0; q < 4; ++q) { lg[q][4 + g2 * 4] += hh[q][e] * b[0]; lg[q][5 + g2 * 4] += hh[q][e] * b[1]; lg[q][6 + g2 * 4] += hh[q][e] * b[2]; lg[q][7 + g2 * 4] += hh[q][e] * b[3]; }
                }
            }
        }
        {
            float v[80];
#pragma unroll
            for (int q = 0; q < 4; ++q)
#pragma unroll
                for (int j = 0; j < 20; ++j) v[q * 20 + j] = lg[q][j];
#define RT_STEP(MASK, H)                                                                                        \
            { const bool hi = (lane & (MASK)) != 0;                                                             \
              _Pragma("unroll") for (int i = 0; i < (H); ++i) {                                                 \
                  const float a = v[i], b = v[i + (H)];                                                         \
                  const float r = __shfl_xor(hi ? a : b, (MASK));                                               \
                  v[i] = (hi ? b : a) + r; } }
            RT_STEP(32, 40) RT_STEP(16, 20) RT_STEP(8, 10) RT_STEP(4, 5)
            v[5] = 0.f;
            RT_STEP(2, 3)
            v[3] = 0.f;
            RT_STEP(1, 2)
#undef RT_STEP
            float* red = rs_ent + 32 + wid * 80;
#pragma unroll
            for (int j = 0; j < 2; ++j) {
                const int a = j + ((lane & 1) ? 2 : 0), b = a + ((lane & 2) ? 3 : 0);
                const int f = b + ((lane & 4) ? 5 : 0) + ((lane & 8) ? 10 : 0) + ((lane & 16) ? 20 : 0) + ((lane & 32) ? 40 : 0);
                if (a < 3 && b < 5) red[f] = v[j];
            }
            if (lane < 4) {
                float lq[20];
#pragma unroll
                for (int j = 0; j < 20; ++j) lq[j] = red[lane * 20 + j];
                const float rsq = lane == 0 ? rstd[0] : lane == 1 ? rstd[1] : lane == 2 ? rstd[2] : rstd[3];
                const int t = t0 + lane;
                int gs = 0; float gm = lq[0];
#pragma unroll
                for (int g2 = 1; g2 < 4; ++g2) if (lq[g2] > gm) { gm = lq[g2]; gs = g2; }
                float den = 0.f;
#pragma unroll
                for (int g2 = 0; g2 < 4; ++g2) den += __expf(lq[g2] - gm);
                const float pg = 1.f / den;
                float el[4];
#pragma unroll
                for (int e = 0; e < 4; ++e) el[e] = gs == 0 ? lq[4 + e] : gs == 1 ? lq[8 + e] : gs == 2 ? lq[12 + e] : lq[16 + e];
                int i1 = 0; float v1 = el[0];
#pragma unroll
                for (int e = 1; e < 4; ++e) if (el[e] > v1) { v1 = el[e]; i1 = e; }
                int i2 = 0; float v2 = -3.4e38f;
#pragma unroll
                for (int e = 0; e < 4; ++e) if (e != i1 && el[e] > v2) { v2 = el[e]; i2 = e; }
                const float e2 = __expf(v2 - v1);
                const float g1 = pg / (1.f + e2), g2v = pg * e2 / (1.f + e2);
                const int ea = gs * 4 + i1, eb = gs * 4 + i2;
                const int sl = (wid * 4 + lane) * 2;
                e_ent[sl] = ea; r_ent[sl] = atomicAdd(&lcnt[ea], 1u); t_ent[sl] = t * 2; g_ent[sl] = g1; rs_ent[sl] = rsq;
                e_ent[sl + 1] = eb; r_ent[sl + 1] = atomicAdd(&lcnt[eb], 1u); t_ent[sl + 1] = t * 2 + 1; g_ent[sl + 1] = g2v; rs_ent[sl + 1] = rsq;
            }
        }
        __syncthreads();
        if (tid < 16) lbase[tid] = lcnt[tid] ? atomicAdd(&cnt[tid * 64], lcnt[tid]) : 0u;
        __syncthreads();
        if (tid < 32) {
            const int e = e_ent[tid];
            const unsigned pos = (lbase[e] + r_ent[tid]) & 16383u;
            list[e * 16384 + pos] = t_ent[tid]; gl[e * 16384 + pos] = g_ent[tid]; rsl[e * 16384 + pos] = rs_ent[tid];
        }
    }
}

constexpr int GBK = 64;
struct TileP { int arow[4]; unsigned bo[4]; };
struct GOps { const char* A; unsigned la; const char* A2; unsigned la2; const char* B; };
DI void gemm_core(const GOps& o, const TileP& tp, int K, char* lds, f32x4 (&acc)[4][4], int ksplit, bool primed, const TileP& nx, bool have_nx) {
    const int tid = tidx(), wid = tid >> 6, lane = tid & 63, wr = wid >> 1, wc = wid & 1, fr = lane & 15, fq = lane >> 4;
    const unsigned scol = ((tid & 7) ^ ((tid >> 3) & 7)) * 16;
#pragma unroll
    for (int n = 0; n < 4; ++n)
#pragma unroll
        for (int m = 0; m < 4; ++m) acc[n][m] = (f32x4){0.f, 0.f, 0.f, 0.f};
    const int nk = K / GBK;
    if (!primed) {
        __syncthreads();
#pragma unroll
        for (int i = 0; i < 4; ++i) {
            __builtin_amdgcn_global_load_lds((const unsigned*)(o.A + (__umul24(tp.arow[i], o.la) + scol)), (lds_u32*)(lds + tid * 16 + i * 4096), 16, 0, 0);
            __builtin_amdgcn_global_load_lds((const unsigned*)(o.B + (tp.bo[i] + scol)), (lds_u32*)(lds + 16384 + tid * 16 + i * 4096), 16, 0, 0);
        }
    }
    const int sw = fr & 7;
    const unsigned aoff = (wr * 64 + fr) * 128, boff = (wc * 64 + fr) * 128, co0 = (fq ^ sw) * 16, co1 = ((4 + fq) ^ sw) * 16;
    bf16x8 a0[4], b0[4], a1[4], b1[4];
#define G_ISSUE(kt_)                                                                                                                        \
    if ((kt_) + 1 < nk) {                                                                                                                   \
        char* nb = lds + (((kt_) + 1) & 1) * 32768;                                                                                         \
        const unsigned ko = ((kt_) + 1) * (GBK * 2) + scol;                                                                                 \
        const bool hi = ((kt_) + 1) * GBK >= ksplit;                                                                                        \
        const char* Ab = hi ? o.A2 : o.A; const unsigned la = hi ? o.la2 : o.la;                                                            \
        _Pragma("unroll") for (int i = 0; i < 4; ++i) {                                                                                     \
            __builtin_amdgcn_global_load_lds((const unsigned*)(Ab + (__umul24(tp.arow[i], la) + ko)), (lds_u32*)(nb + tid * 16 + i * 4096), 16, 0, 0);   \
            __builtin_amdgcn_global_load_lds((const unsigned*)(o.B + (tp.bo[i] + ko)), (lds_u32*)(nb + 16384 + tid * 16 + i * 4096), 16, 0, 0);      \
        }                                                                                                                                   \
    } else if (have_nx) {        \
        _Pragma("unroll") for (int i = 0; i < 4; ++i) {                                                                                     \
            __builtin_amdgcn_global_load_lds((const unsigned*)(o.A + (__umul24(nx.arow[i], o.la) + scol)), (lds_u32*)(lds + tid * 16 + i * 4096), 16, 0, 0);          \
            __builtin_amdgcn_global_load_lds((const unsigned*)(o.B + (nx.bo[i] + scol)), (lds_u32*)(lds + 16384 + tid * 16 + i * 4096), 16, 0, 0);  \
        }                                                                                                                                   \
    }
#define G_READ(A_, B_, AD_)                                                                                                                 \
    asm volatile("ds_read_b128 %0, %8\n\tds_read_b128 %1, %8 offset:2048\n\tds_read_b128 %2, %8 offset:4096\n\tds_read_b128 %3, %8 offset:6144\n\t"       \
                 "ds_read_b128 %4, %9 offset:16384\n\tds_read_b128 %5, %9 offset:18432\n\tds_read_b128 %6, %9 offset:20480\n\tds_read_b128 %7, %9 offset:22528" \
                 : "=&v"(A_[0]), "=&v"(A_[1]), "=&v"(A_[2]), "=&v"(A_[3]), "=&v"(B_[0]), "=&v"(B_[1]), "=&v"(B_[2]), "=&v"(B_[3]) : "v"((AD_) + aoff), "v"((AD_) + boff) : "memory");
#define G_WAIT(A_, B_, N_)                                                                                                                  \
    asm volatile("s_waitcnt lgkmcnt(" #N_ ")" : "+v"(A_[0]), "+v"(A_[1]), "+v"(A_[2]), "+v"(A_[3]), "+v"(B_[0]), "+v"(B_[1]), "+v"(B_[2]), "+v"(B_[3]) :: "memory");
#define G_MMA(A_, B_)                                                                                                                       \
    _Pragma("unroll") for (int n = 0; n < 4; ++n)                                                                                           \
        _Pragma("unroll") for (int m = 0; m < 4; ++m) acc[n][m] = __builtin_amdgcn_mfma_f32_16x16x32_bf16(B_[n], A_[m], acc[n][m], 0, 0, 0);
    const unsigned lbase = (unsigned)(size_t)(lds_u32*)lds;
    __builtin_amdgcn_s_waitcnt(0x0070);
    __builtin_amdgcn_s_barrier();
    G_ISSUE(0)
    G_READ(a0, b0, lbase + co0)
    G_READ(a1, b1, lbase + co1)
    G_WAIT(a0, b0, 8)
    __builtin_amdgcn_sched_barrier(0);
    G_MMA(a0, b0)
    __builtin_amdgcn_sched_barrier(0);
    G_WAIT(a1, b1, 0)
#pragma unroll 1
    for (int kt = 1; kt < nk; ++kt) {
        __builtin_amdgcn_s_waitcnt(0x0070);
        __builtin_amdgcn_s_barrier();
        G_ISSUE(kt)
        const unsigned S = lbase + (kt & 1) * 32768;
        G_READ(a0, b0, S + co0)
        __builtin_amdgcn_sched_barrier(0);
        G_MMA(a1, b1)
        __builtin_amdgcn_sched_barrier(0);
        G_READ(a1, b1, S + co1)
        G_WAIT(a0, b0, 8)
        __builtin_amdgcn_sched_barrier(0);
        G_MMA(a0, b0)
        __builtin_amdgcn_sched_barrier(0);
        G_WAIT(a1, b1, 0)
    }
    G_MMA(a1, b1)
#undef G_ISSUE
#undef G_READ
#undef G_WAIT
#undef G_MMA
}

struct TileP5 { int arow[5]; unsigned bo[4]; };
constexpr int G5A = 20480, G5BUF = 36864;
DI void gemm_core5(const GOps& o, const TileP5& tp, int K, char* lds, f32x4 (&acc)[4][5], bool primed, const TileP5& nx, bool have_nx) {
    const int tid = tidx(), wid = tid >> 6, lane = tid & 63, wr = wid >> 1, wc = wid & 1, fr = lane & 15, fq = lane >> 4;
    const unsigned scol = ((tid & 7) ^ ((tid >> 3) & 7)) * 16;
#pragma unroll
    for (int n = 0; n < 4; ++n)
#pragma unroll
        for (int m = 0; m < 5; ++m) acc[n][m] = (f32x4){0.f, 0.f, 0.f, 0.f};
    const int nk = K / GBK;
    if (!primed) {
        __syncthreads();
#pragma unroll
        for (int i = 0; i < 5; ++i) __builtin_amdgcn_global_load_lds((const unsigned*)(o.A + (__umul24(tp.arow[i], o.la) + scol)), (lds_u32*)(lds + tid * 16 + i * 4096), 16, 0, 0);
#pragma unroll
        for (int i = 0; i < 4; ++i) __builtin_amdgcn_global_load_lds((const unsigned*)(o.B + (tp.bo[i] + scol)), (lds_u32*)(lds + G5A + tid * 16 + i * 4096), 16, 0, 0);
    }
    const int sw = fr & 7;
    const unsigned aoff = (wr * 80 + fr) * 128, boff = G5A + (wc * 64 + fr) * 128, co0 = (fq ^ sw) * 16, co1 = ((4 + fq) ^ sw) * 16;
    bf16x8 a0[5], b0[4], a1[5], b1[4];
#define G_ISSUE(kt_)                                                                                                                        \
    if ((kt_) + 1 < nk) {                                                                                                                   \
        char* nb = lds + (((kt_) + 1) & 1) * G5BUF;                                                                                         \
        const unsigned ko = ((kt_) + 1) * (GBK * 2) + scol;                                                                                 \
        _Pragma("unroll") for (int i = 0; i < 5; ++i) __builtin_amdgcn_global_load_lds((const unsigned*)(o.A + (__umul24(tp.arow[i], o.la) + ko)), (lds_u32*)(nb + tid * 16 + i * 4096), 16, 0, 0); \
        _Pragma("unroll") for (int i = 0; i < 4; ++i) __builtin_amdgcn_global_load_lds((const unsigned*)(o.B + (tp.bo[i] + ko)), (lds_u32*)(nb + G5A + tid * 16 + i * 4096), 16, 0, 0); \
    } else if (have_nx) {                                                                                                                   \
        _Pragma("unroll") for (int i = 0; i < 5; ++i) __builtin_amdgcn_global_load_lds((const unsigned*)(o.A + (__umul24(nx.arow[i], o.la) + scol)), (lds_u32*)(lds + tid * 16 + i * 4096), 16, 0, 0); \
        _Pragma("unroll") for (int i = 0; i < 4; ++i) __builtin_amdgcn_global_load_lds((const unsigned*)(o.B + (nx.bo[i] + scol)), (lds_u32*)(lds + G5A + tid * 16 + i * 4096), 16, 0, 0); \
    }
#define G_READ(A_, B_, AD_)                                                                                                                 \
    asm volatile("ds_read_b128 %0, %9\n\tds_read_b128 %1, %9 offset:2048\n\tds_read_b128 %2, %9 offset:4096\n\tds_read_b128 %3, %9 offset:6144\n\tds_read_b128 %4, %9 offset:8192\n\t" \
                 "ds_read_b128 %5, %10\n\tds_read_b128 %6, %10 offset:2048\n\tds_read_b128 %7, %10 offset:4096\n\tds_read_b128 %8, %10 offset:6144"  \
                 : "=&v"(A_[0]), "=&v"(A_[1]), "=&v"(A_[2]), "=&v"(A_[3]), "=&v"(A_[4]), "=&v"(B_[0]), "=&v"(B_[1]), "=&v"(B_[2]), "=&v"(B_[3]) : "v"((AD_) + aoff), "v"((AD_) + boff) : "memory");
#define G_WAIT(A_, B_, N_)                                                                                                                  \
    asm volatile("s_waitcnt lgkmcnt(" #N_ ")" : "+v"(A_[0]), "+v"(A_[1]), "+v"(A_[2]), "+v"(A_[3]), "+v"(A_[4]), "+v"(B_[0]), "+v"(B_[1]), "+v"(B_[2]), "+v"(B_[3]) :: "memory");
#define G_MMA(A_, B_)                                                                                                                       \
    _Pragma("unroll") for (int n = 0; n < 4; ++n)                                                                                           \
        _Pragma("unroll") for (int m = 0; m < 5; ++m) acc[n][m] = __builtin_amdgcn_mfma_f32_16x16x32_bf16(B_[n], A_[m], acc[n][m], 0, 0, 0);
    const unsigned lbase = (unsigned)(size_t)(lds_u32*)lds;
    __builtin_amdgcn_s_waitcnt(0x0070);
    __builtin_amdgcn_s_barrier();
    G_ISSUE(0)
    G_READ(a0, b0, lbase + co0)
    G_READ(a1, b1, lbase + co1)
    G_WAIT(a0, b0, 9)
    __builtin_amdgcn_sched_barrier(0);
    G_MMA(a0, b0)
    __builtin_amdgcn_sched_barrier(0);
    G_WAIT(a1, b1, 0)
#pragma unroll 1
    for (int kt = 1; kt < nk; ++kt) {
        __builtin_amdgcn_s_waitcnt(0x0070);
        __builtin_amdgcn_s_barrier();
        G_ISSUE(kt)
        const unsigned S = lbase + (kt & 1) * G5BUF;
        G_READ(a0, b0, S + co0)
        __builtin_amdgcn_sched_barrier(0);
        G_MMA(a1, b1)
        __builtin_amdgcn_sched_barrier(0);
        G_READ(a1, b1, S + co1)
        G_WAIT(a0, b0, 9)
        __builtin_amdgcn_sched_barrier(0);
        G_MMA(a0, b0)
        __builtin_amdgcn_sched_barrier(0);
        G_WAIT(a1, b1, 0)
    }
    G_MMA(a1, b1)
#undef G_ISSUE
#undef G_READ
#undef G_WAIT
#undef G_MMA
}

enum { EPI_EVEN_IN = 0, EPI_ODD_IN, EPI_RESID };
template <int EPI>
DI void phase_gemm(const P& p, const bf16_t* A, int lda, const bf16_t* Bt, int K, int ntn, char* lds, bool dry = false, const bf16_t* A2 = nullptr, int lda2 = 0, int ksplit = 1 << 30) {
    const int tid = tidx(), wid = tid >> 6, lane = tid & 63, wr = wid >> 1, wc = wid & 1, fr = lane & 15, fq = lane >> 4;
    const int ntm = T / 128, ntiles = ntm * ntn;
    auto fill = [&](TileP& t, int tile) {
        const int tn = tile / ntm, tm = tile % ntm, r = tid >> 3;
#pragma unroll
        for (int i = 0; i < 4; ++i) { t.arow[i] = tm * 128 + r + 32 * i; t.bo[i] = (unsigned)(tn * 128 + r + 32 * i) * (unsigned)(K * 2); }
    };
    const GOps gop{(const char*)A, (unsigned)lda * 2u, (const char*)(A2 ? A2 : A), (unsigned)(A2 ? lda2 : lda) * 2u, (const char*)Bt};
    TileP cur, nxt;
    bool primed = false;
    fill(cur, bidx() < ntiles ? bidx() : 0); nxt = cur;
    for (int tile = bidx(); tile < ntiles; tile += gridDim.x) {
        const int tn = tile / ntm, tm = tile % ntm;
        const bool have_next = tile + (int)gridDim.x < ntiles;
        if (have_next) fill(nxt, tile + gridDim.x);
        f32x4 acc[4][4];
        const int m0 = tm * 128 + wr * 64, n0 = tn * 128 + wc * 64;
        float rsr[4];
        if (EPI != EPI_RESID) {
#pragma unroll
            for (int m = 0; m < 4; ++m) rsr[m] = ((const float*)(p.ws + WS_RSIN))[m0 + m * 16 + fr];
        }
        gemm_core(gop, cur, K, lds, acc, ksplit, primed, nxt, have_next);
        primed = have_next; cur = nxt;
        if (EPI != EPI_RESID) {
#pragma unroll
            for (int m = 0; m < 4; ++m)
#pragma unroll
                for (int n = 0; n < 4; ++n) acc[n][m] *= rsr[m];
        }
        if (EPI == EPI_EVEN_IN) {
            bf16_t* C = (bf16_t*)(p.ws + WS_PROJ);
#pragma unroll
            for (int m = 0; m < 4; ++m)
#pragma unroll
                for (int n = 0; n < 4; ++n) {
                    const int row = m0 + m * 16 + fr, col = n0 + n * 16 + fq * 4;
                    if (col < EVC) { u32x2 w; w.x = pack2(acc[n][m][0], acc[n][m][1]); w.y = pack2(acc[n][m][2], acc[n][m][3]); *(u32x2*)(C + (size_t)row * EVLD + col) = w; }
                }
        } else if (EPI == EPI_ODD_IN) {
            bf16_t* C = (bf16_t*)(p.ws + WS_QK);
            const float2* tab = (const float2*)(p.ws + WS_ROPE);
            if (n0 < 3072) {
#pragma unroll
                for (int m = 0; m < 4; ++m) {
                    const int row = m0 + m * 16 + fr;
#pragma unroll
                    for (int n = 0; n < 2; ++n) {
                        float lo[4], hi[4];
#pragma unroll
                        for (int j = 0; j < 4; ++j) {
                            const float2 cs = tab[(size_t)row * 32 + n * 16 + fq * 4 + j];
                            const float x1 = acc[n][m][j], x2 = acc[n + 2][m][j];
                            lo[j] = x1 * cs.x - x2 * cs.y; hi[j] = x2 * cs.x + x1 * cs.y;
                        }
                        u32x2 w; w.x = pack2(lo[0], lo[1]); w.y = pack2(lo[2], lo[3]);
                        *(u32x2*)(C + (size_t)row * 3072 + n0 + n * 16 + fq * 4) = w;
                        w.x = pack2(hi[0], hi[1]); w.y = pack2(hi[2], hi[3]);
                        *(u32x2*)(C + (size_t)row * 3072 + n0 + (n + 2) * 16 + fq * 4) = w;
                    }
                }
            }
            if (tn * 128 >= 3072) {
                bf16_t* VT = (bf16_t*)(p.ws + WS_VT);
                const int hg0 = (tn * 128 - 3072) >> 6, g = hg0 >> 3, lg2 = g * 2, dil = 1 << lg2, L = SEQ >> lg2, run = 128 >> lg2;
                __syncthreads();
#pragma unroll
                for (int m = 0; m < 4; ++m)
#pragma unroll
                    for (int n = 0; n < 4; ++n)
#pragma unroll
                        for (int j = 0; j < 4; ++j)
                            *(bf16_t*)(lds + 32768 + (wc * 64 + n * 16 + fq * 4 + j) * 272 + (wr * 64 + m * 16 + fr) * 2) = f2bf(acc[n][m][j]);
                __syncthreads();
                const int bb = (tm * 128) >> 12, s0 = (tm * 128) & (SEQ - 1);
#pragma unroll
                for (int q = 0; q < 8; ++q) {
                    const int item = tid + q * 256, dim = item >> 4, o0 = (item & 15) * 8;
                    const int rr = o0 / run, i0 = o0 % run;
                    const char* src = lds + 32768 + dim * 272 + (rr + dil * i0) * 2;
                    float e8[8];
#pragma unroll
                    for (int e = 0; e < 8; ++e) e8[e] = bf2f(*(const bf16_t*)(src + e * dil * 2));
                    u32x4 w; w.x = pack2(e8[0], e8[1]); w.y = pack2(e8[2], e8[3]); w.z = pack2(e8[4], e8[5]); w.w = pack2(e8[6], e8[7]);
                    const int hg = hg0 + (dim >> 6);
                    *(u32x4*)(VT + ((size_t)((bb * 24 + hg) * dil + rr) * 64 + (dim & 63)) * L + (s0 >> lg2) + i0) = w;
                }
            }
        } else {
            float* ssq = (float*)(p.ws + WS_SSQ) + (size_t)(tn * 2 + wc) * T;
#pragma unroll
            for (int m = 0; m < 4; ++m) {
                float ss = 0.f;
#pragma unroll
                for (int n = 0; n < 4; ++n) {
                    const size_t qo = (size_t)(m0 + m * 16 + fr) * 1024 + n0 + n * 16 + fq * 4;
                    bf16_t* q = dry ? (bf16_t*)(p.ws + WS_DUMMY) + (qo & 0x7FFFF) : (bf16_t*)(p.ws + WS_XB) + qo;
                    const u32x2 xx = *(const u32x2*)q;
                    float4 v;
                    v.x = __uint_as_float(xx.x << 16) + acc[n][m][0]; v.y = __uint_as_float(xx.x & 0xffff0000u) + acc[n][m][1]; v.z = __uint_as_float(xx.y << 16) + acc[n][m][2]; v.w = __uint_as_float(xx.y & 0xffff0000u) + acc[n][m][3];
                    u32x2 w; w.x = pack2(v.x, v.y); w.y = pack2(v.z, v.w);
                    *(u32x2*)q = w;
                    ss += v.x * v.x + v.y * v.y + v.z * v.z + v.w * v.w;
                }
                ss += __shfl_xor(ss, 16); ss += __shfl_xor(ss, 32);
                if (fq == 0 && !dry) ssq[m0 + m * 16 + fr] = ss;
            }
        }
    }
}

DI int phase_moe_up(const P& p, int layer, char* lds) {
    const int tid = tidx(), wid = tid >> 6, lane = tid & 63, wr = wid >> 1, wc = wid & 1, fr = lane & 15, fq = lane >> 4;
    const unsigned* cntb = (const unsigned*)(p.ws + WS_CTL + CTL_CNT) + layer * 16 * 64;
    unsigned cnt[16];
#pragma unroll
    for (int e = 0; e < 16; ++e) cnt[e] = cntb[e * 64];
    const int* list = (const int*)(p.ws + WS_LIST);
    const float* gl = (const float*)(p.ws + WS_GATE);
    const bf16_t* hn = (const bf16_t*)(p.ws + WS_XB);
    const float* rsl = (const float*)(p.ws + WS_RSL);
    const bf16_t* W13 = (const bf16_t*)(moe_w(p, layer) + W_13);
    bf16_t* H = (bf16_t*)(p.ws + WS_H);
    int ttot = 0;
#pragma unroll
    for (int e = 0; e < 16; ++e) ttot += ((int)cnt[e] + 159) / 160;
    const int ntiles = ttot * 4;
    auto locate = [&](int tile, int& e, int& lt, int& ce, int& rbe, int& tn) {
        const int mt = tile >> 2; tn = tile & 3;
        int tbe = 0, acc_t = 0, rb = 0, rbacc = 0; e = 0;
#pragma unroll
        for (int q = 0; q < 16; ++q) {
            const int nt = ((int)cnt[q] + 159) / 160;
            if (mt >= acc_t) { e = q; tbe = acc_t; rb = rbacc; }
            acc_t += nt; rbacc += (((int)cnt[q] + 127) >> 7) * 128;
        }
        lt = mt - tbe; ce = (int)cnt[e]; rbe = rb;
    };
    auto fill = [&](TileP5& t, int tile) {
        int e, lt, ce, rbe, tn; locate(tile, e, lt, ce, rbe, tn);
        const int r = tid >> 3;
#pragma unroll
        for (int i = 0; i < 5; ++i) {
            const int ii = lt * 160 + r + 32 * i;
            t.arow[i] = ii < ce ? (list[e * 16384 + ii] >> 1) : 0;
        }
#pragma unroll
        for (int i = 0; i < 4; ++i) t.bo[i] = (unsigned)(e * 512 + tn * 128 + r + 32 * i) * 2048u;
    };
    const GOps gop{(const char*)hn, 2048u, (const char*)hn, 2048u, (const char*)W13};
    TileP5 cur, nxt;
    bool primed = false;
    fill(cur, bidx() < ntiles ? bidx() : 0); nxt = cur;
    for (int tile = bidx(); tile < ntiles; tile += gridDim.x) {
        int e, lt, ce, rbe, tn; locate(tile, e, lt, ce, rbe, tn);
        const bool have_next = tile + (int)gridDim.x < ntiles;
        if (have_next) fill(nxt, tile + gridDim.x);
        f32x4 acc[4][5];
        gemm_core5(gop, cur, 1024, lds, acc, primed, nxt, have_next);
        primed = have_next; cur = nxt;
#pragma unroll
        for (int m = 0; m < 5; ++m) {
            const int li = lt * 160 + wr * 80 + m * 16 + fr;
            if (li < ce) {
                const float g = gl[e * 16384 + li], rs = rsl[e * 16384 + li];
                bf16_t* hrow = H + (size_t)(rbe + li) * 256;
#pragma unroll
                for (int n = 0; n < 4; n += 2) {
                    float o[4];
#pragma unroll
                    for (int j = 0; j < 4; ++j) o[j] = siluf_(acc[n][m][j] * rs) * (acc[n + 1][m][j] * rs) * g;
                    const int f = tn * 64 + wc * 32 + (n >> 1) * 16 + fq * 4;
                    u32x2 w; w.x = pack2(o[0], o[1]); w.y = pack2(o[2], o[3]);
                    *(u32x2*)(hrow + f) = w;
                }
            }
        }
    }
    return ntiles;
}
DI void phase_moe_down(const P& p, int layer, char* lds) {
    const int tid = tidx(), wid = tid >> 6, lane = tid & 63, wr = wid >> 1, wc = wid & 1, fr = lane & 15, fq = lane >> 4;
    const unsigned* cntb = (const unsigned*)(p.ws + WS_CTL + CTL_CNT) + layer * 16 * 64;
    unsigned cnt[16];
#pragma unroll
    for (int e = 0; e < 16; ++e) cnt[e] = cntb[e * 64];
    const int* list = (const int*)(p.ws + WS_LIST);
    const bf16_t* W2 = (const bf16_t*)(moe_w(p, layer) + W_2);
    const bf16_t* H = (const bf16_t*)(p.ws + WS_H);
    bf16_t* ys = (bf16_t*)(p.ws + WS_YS);
    int ttot = 0;
#pragma unroll
    for (int e = 0; e < 16; ++e) ttot += ((int)cnt[e] + 127) >> 7;
    const int ntiles = ttot * 8;
    auto locate = [&](int tile, int& e, int& lt, int& ce, int& rbe, int& tn) {
        const int mt = tile >> 3; tn = tile & 7;
        int tbe = 0, acc_t = 0; e = 0;
#pragma unroll
        for (int q = 0; q < 16; ++q) { const int nt = ((int)cnt[q] + 127) >> 7; if (mt >= acc_t) { e = q; tbe = acc_t; } acc_t += nt; }
        lt = mt - tbe; ce = (int)cnt[e]; rbe = tbe * 128;
    };
    auto fill = [&](TileP& t, int tile) {
        int e, lt, ce, rbe, tn; locate(tile, e, lt, ce, rbe, tn);
        const int r = tid >> 3;
#pragma unroll
        for (int i = 0; i < 4; ++i) { t.arow[i] = rbe + lt * 128 + r + 32 * i; t.bo[i] = (unsigned)(e * 1024 + tn * 128 + r + 32 * i) * 512u; }
    };
    const GOps gop{(const char*)H, 512u, (const char*)H, 512u, (const char*)W2};
    TileP cur, nxt;
    bool primed = false;
    fill(cur, bidx() < ntiles ? bidx() : 0); nxt = cur;
    for (int tile = bidx(); tile < ntiles; tile += gridDim.x) {
        int e, lt, ce, rbe, tn; locate(tile, e, lt, ce, rbe, tn);
        const bool have_next = tile + (int)gridDim.x < ntiles;
        if (have_next) fill(nxt, tile + gridDim.x);
        f32x4 acc[4][4];
        gemm_core(gop, cur, 256, lds, acc, 1 << 30, primed, nxt, have_next);
        primed = have_next; cur = nxt;
#pragma unroll
        for (int m = 0; m < 4; ++m) {
            const int li = lt * 128 + wr * 64 + m * 16 + fr;
            if (li < ce) {
                const int ts = list[e * 16384 + li];
                bf16_t* yrow = ys + ((size_t)(ts & 1) * T + (ts >> 1)) * 1024 + tn * 128 + wc * 64 + fq * 4;
#pragma unroll
                for (int n = 0; n < 4; ++n) { u32x2 w; w.x = pack2(acc[n][m][0], acc[n][m][1]); w.y = pack2(acc[n][m][2], acc[n][m][3]); *(u32x2*)(yrow + n * 16) = w; }
            }
        }
    }
}


typedef float f32x16 __attribute__((ext_vector_type(16)));
DI f32x4 mfma16(bf16x8 a, bf16x8 b, f32x4 c) { return __builtin_amdgcn_mfma_f32_16x16x32_bf16(a, b, c, 0, 0, 0); }
DI f32x16 mfma32(bf16x8 a, bf16x8 b, f32x16 c) { return __builtin_amdgcn_mfma_f32_32x32x16_bf16(a, b, c, 0, 0, 0); }
DI f32x4 tile16(const char* X, int ldx, int row0, const char* Y, int ldy, int col0, int K) {
    const int lane = tidx() & 63, fr = lane & 15, fq = lane >> 4;
    const char* xp = X + (row0 + fr) * ldx + fq * 16; const char* yp = Y + (col0 + fr) * ldy + fq * 16;
    bf16x8 a[4], b[4];
#pragma unroll
    for (int s = 0; s < 4; ++s) if (s * 32 < K) { a[s] = *(const bf16x8*)(xp + s * 64); b[s] = *(const bf16x8*)(yp + s * 64); }
    f32x4 acc = {0.f, 0.f, 0.f, 0.f};
#pragma unroll
    for (int s = 0; s < 4; ++s) if (s * 32 < K) acc = mfma16(a[s], b[s], acc);
    return acc;
}
DI bf16x8 pack_step(const f32x16& x, int s) {
    u32x4 r;
    r.x = pack2(x[8 * s + 0], x[8 * s + 1]); r.y = pack2(x[8 * s + 2], x[8 * s + 3]);
    r.z = pack2(x[8 * s + 4], x[8 * s + 5]); r.w = pack2(x[8 * s + 6], x[8 * s + 7]);
    return __builtin_bit_cast(bf16x8, r);
}

constexpr int GP_LF = 0, GP_T = 17408, GP_VEC = GP_T + 9216, GP_U = GP_VEC + 1024, GP_END = GP_U + 36864;
DI void gdn_prep_unit(const P& p, int li, int ch, char* lds) {
    const int tid = tidx(), lane = tid & 63, wid = tid >> 6, fr = lane & 15, fq = lane >> 4;
    const int h = ch & 3, n = (ch >> 2) & 63, b = ch >> 8;
    const int t0 = b * SEQ + n * 64;
    float* Lf = (float*)(lds + GP_LF);
    char* Trow = lds + GP_T;
    float* gcs = (float*)(lds + GP_VEC); float* egc = gcs + 64; float* bet = gcs + 128; float* ekd = gcs + 192;
    char* Qrow = lds + GP_U; char* Krow = Qrow + 17408; char* VbT = lds + GP_U; char* KbgT = VbT + 18432;
    const bf16_t* proj = (const bf16_t*)(p.ws + WS_PROJ);
    unsigned char* ops = p.ws + WS_GOPS + (size_t)ch * GOPS_CH;
    const float* cw = p.in[I_CONVW] + (size_t)li * 4 * 1536;
    const int c = tid >> 2, cq = tid & 3;
    __syncthreads();
    float* cwl = (float*)(lds + GP_END);
    for (int i = tid; i < 4 * 3 * 32; i += 256) {
        const int j = i / 96, r = i % 96, sl = r >> 5, q4 = (r & 31) * 4;
        *(f32x4*)(cwl + (j * 3 + sl) * 128 + q4) = *(const f32x4*)(cw + j * 1536 + sl * 512 + h * 128 + q4);
    }
    __syncthreads();
    unsigned vvp[16];
#pragma unroll 1
    for (int which = 0; which < 3; ++which) {
        const int col0 = which * 512 + h * 128 + cq * 32;
        u32x4 xin[4][4];
#pragma unroll
        for (int j = 0; j < 4; ++j) {
            const int sp = n * 64 + c - 3 + j;
            const bf16_t* src = proj + (size_t)(b * SEQ + (sp < 0 ? 0 : sp)) * EVLD + col0;
#pragma unroll
            for (int i4 = 0; i4 < 4; ++i4) xin[j][i4] = *(const u32x4*)(src + i4 * 8);
        }
        float acc[32];
#pragma unroll
        for (int i = 0; i < 32; ++i) acc[i] = 0.f;
#pragma unroll
        for (int j = 0; j < 4; ++j) {
            const float ok = (n * 64 + c - 3 + j) >= 0 ? 1.f : 0.f;
            const float* wj = cwl + (j * 3 + which) * 128 + cq * 32;
#pragma unroll
            for (int i4 = 0; i4 < 4; ++i4) {
                const f32x4 wa = *(const f32x4*)(wj + i4 * 8), wb = *(const f32x4*)(wj + i4 * 8 + 4);
                const u32x4 w = xin[j][i4];
                acc[i4 * 8 + 0] += ok * wa[0] * __uint_as_float(w[0] << 16); acc[i4 * 8 + 1] += ok * wa[1] * __uint_as_float(w[0] & 0xffff0000u);
                acc[i4 * 8 + 2] += ok * wa[2] * __uint_as_float(w[1] << 16); acc[i4 * 8 + 3] += ok * wa[3] * __uint_as_float(w[1] & 0xffff0000u);
                acc[i4 * 8 + 4] += ok * wb[0] * __uint_as_float(w[2] << 16); acc[i4 * 8 + 5] += ok * wb[1] * __uint_as_float(w[2] & 0xffff0000u);
                acc[i4 * 8 + 6] += ok * wb[2] * __uint_as_float(w[3] << 16); acc[i4 * 8 + 7] += ok * wb[3] * __uint_as_float(w[3] & 0xffff0000u);
            }
        }
        float ss = 0.f;
#pragma unroll
        for (int i = 0; i < 32; ++i) { acc[i] = siluf_(acc[i]); ss += acc[i] * acc[i]; }
        ss += __shfl_xor(ss, 1); ss += __shfl_xor(ss, 2);
        const float rn = which == 2 ? 1.f : rsqrtf(ss + 1e-6f) * (which == 0 ? 0.08838834764831845f : 1.f);
        unsigned pk[16];
#pragma unroll
        for (int i = 0; i < 16; ++i) pk[i] = pack2(acc[2 * i] * rn, acc[2 * i + 1] * rn);
        if (which < 2) {
            char* img = which == 0 ? Qrow : Krow;
#pragma unroll
            for (int i4 = 0; i4 < 4; ++i4) { u32x4 w; w.x = pk[i4 * 4]; w.y = pk[i4 * 4 + 1]; w.z = pk[i4 * 4 + 2]; w.w = pk[i4 * 4 + 3]; *(u32x4*)(img + c * 272 + (cq * 32 + i4 * 8) * 2) = w; }
        } else {
#pragma unroll
            for (int i = 0; i < 16; ++i) vvp[i] = pk[i];
        }
    }
    if (cq == 0) {
        const float a = bf2f(proj[(size_t)(t0 + c) * EVLD + 2048 + h]);
        const float bb = bf2f(proj[(size_t)(t0 + c) * EVLD + 2052 + h]);
        const float Aexp = __expf(p.in[I_ALOG][li * 4 + h]), dtb = p.in[I_DTB][li * 4 + h];
        gcs[c] = -Aexp * softplusf_(a + dtb);
        bet[c] = sigmoidf_(bb);
    }
    __syncthreads();
    if (wid == 0) {
        float x = gcs[lane];
#pragma unroll
        for (int o = 1; o < 64; o <<= 1) { const float y = __shfl_up(x, o); if (lane >= o) x += y; }
        const float gl = __shfl(x, 63);
        gcs[lane] = x; egc[lane] = __expf(x); ekd[lane] = __expf(gl - x);
        if (lane == 63) ((float*)(p.ws + WS_CTL + CTL_EGL))[ch] = __expf(gl);
    }
    __syncthreads();
    {
        const int ti = wid;
#pragma unroll
        for (int tj = 0; tj < 4; ++tj) {
            if (tj <= ti) {
                const f32x4 kk = tile16(Krow, 272, 16 * ti, Krow, 272, 16 * tj, 128);
                const int c2 = 16 * tj + fr;
                f32x4 lv;
#pragma unroll
                for (int r = 0; r < 4; ++r) {
                    const int c1 = 16 * ti + fq * 4 + r;
                    lv[r] = (c1 > c2) ? bet[c1] * kk[r] * __expf(gcs[c1] - gcs[c2]) : 0.f;
                }
                *(f32x4*)&Lf[c2 * 68 + 16 * ti + fq * 4] = lv;
            }
            f32x4 qk = {0.f, 0.f, 0.f, 0.f};
            if (tj <= ti) qk = tile16(Krow, 272, 16 * tj, Qrow, 272, 16 * ti, 128);
            const int c1 = 16 * ti + fr;
            float o4[4];
#pragma unroll
            for (int r = 0; r < 4; ++r) { const int c2 = 16 * tj + fq * 4 + r; o4[r] = (c1 >= c2) ? qk[r] * __expf(gcs[c1] - gcs[c2]) : 0.f; }
            const int mt = c1 >> 5, rr = c1 & 31, hh = fq & 1, jg = fq >> 1;
            u32x2 w; w.x = pack2(o4[0], o4[1]); w.y = pack2(o4[2], o4[3]);
            *(u32x2*)(ops + GO_AF + ((size_t)((mt * 4 + tj) * 64 + hh * 32 + rr) * 8 + jg * 4) * 2) = w;
        }
#pragma unroll
        for (int i = 0; i < 4; ++i) {
            const int idx = tid + i * 256;
            {
                const int mt = idx >> 9, ks = (idx >> 6) & 7, l2 = idx & 63, rr = l2 & 31, hh = l2 >> 5, cc = 32 * mt + rr;
                const float sc = egc[cc];
                const u32x2 lo = *(const u32x2*)(Qrow + cc * 272 + (16 * ks + 4 * hh) * 2), hi = *(const u32x2*)(Qrow + cc * 272 + (16 * ks + 8 + 4 * hh) * 2);
                u32x4 w;
                w.x = pack2(__uint_as_float(lo.x << 16) * sc, __uint_as_float(lo.x & 0xffff0000u) * sc); w.y = pack2(__uint_as_float(lo.y << 16) * sc, __uint_as_float(lo.y & 0xffff0000u) * sc);
                w.z = pack2(__uint_as_float(hi.x << 16) * sc, __uint_as_float(hi.x & 0xffff0000u) * sc); w.w = pack2(__uint_as_float(hi.y << 16) * sc, __uint_as_float(hi.y & 0xffff0000u) * sc);
                *(u32x4*)(ops + GO_QF + (size_t)idx * 16) = w;
            }
            {
                const int mt = idx >> 8, ks = (idx >> 6) & 3, l2 = idx & 63, rr = l2 & 31, hh = l2 >> 5, dk = 32 * mt + rr;
                float e8[8];
#pragma unroll
                for (int j = 0; j < 8; ++j) { const int c2 = 16 * ks + 8 * (j >> 2) + 4 * hh + (j & 3); e8[j] = bf2f(*(const bf16_t*)(Krow + c2 * 272 + dk * 2)) * ekd[c2]; }
                u32x4 w; w.x = pack2(e8[0], e8[1]); w.y = pack2(e8[2], e8[3]); w.z = pack2(e8[4], e8[5]); w.w = pack2(e8[6], e8[7]);
                *(u32x4*)(ops + GO_KF + (size_t)idx * 16) = w;
            }
        }
    }
    __syncthreads();
    {
        const float bc = bet[c], bg = bc * egc[c];
        unsigned kvp[16];
#pragma unroll
        for (int i4 = 0; i4 < 4; ++i4) { const u32x4 w = *(const u32x4*)(Krow + c * 272 + (cq * 32 + i4 * 8) * 2); kvp[i4 * 4] = w.x; kvp[i4 * 4 + 1] = w.y; kvp[i4 * 4 + 2] = w.z; kvp[i4 * 4 + 3] = w.w; }
        __syncthreads();
#pragma unroll
        for (int i = 0; i < 16; ++i) {
            *(bf16_t*)(VbT + (cq * 32 + 2 * i) * 144 + c * 2) = f2bf(__uint_as_float(vvp[i] << 16) * bc);
            *(bf16_t*)(VbT + (cq * 32 + 2 * i + 1) * 144 + c * 2) = f2bf(__uint_as_float(vvp[i] & 0xffff0000u) * bc);
            *(bf16_t*)(KbgT + (cq * 32 + 2 * i) * 144 + c * 2) = f2bf(__uint_as_float(kvp[i] << 16) * bg);
            *(bf16_t*)(KbgT + (cq * 32 + 2 * i + 1) * 144 + c * 2) = f2bf(__uint_as_float(kvp[i] & 0xffff0000u) * bg);
        }
    }
    {
        char* L21i = lds + GP_END;
        char* T11T = L21i + 2560;
        char* MT = T11T + 2560;
        if (wid < 2) {
            const int o = 32 * wid;
            float Tc[32];
#pragma unroll
            for (int i = 0; i < 32; ++i) Tc[i] = (i == (lane & 31)) ? 1.f : 0.f;
#pragma unroll
            for (int j = 0; j < 31; ++j) {
                const float tj = Tc[j];
#pragma unroll
                for (int i4 = (j + 1) >> 2; i4 < 8; ++i4) {
                    const f32x4 l4 = *(const f32x4*)&Lf[(o + j) * 68 + o + i4 * 4];
#pragma unroll
                    for (int e = 0; e < 4; ++e) if (i4 * 4 + e > j) Tc[i4 * 4 + e] -= l4[e] * tj;
                }
            }
            if (lane < 32) {
#pragma unroll
                for (int i = 0; i < 32; ++i) *(bf16_t*)(Trow + (o + i) * 144 + (o + lane) * 2) = f2bf(Tc[i]);
                if (wid == 0) {
#pragma unroll
                    for (int i = 0; i < 32; ++i) *(bf16_t*)(Trow + i * 144 + (32 + lane) * 2) = 0;
#pragma unroll
                    for (int i4 = 0; i4 < 8; ++i4) { u32x2 w; w.x = pack2(Tc[i4 * 4], Tc[i4 * 4 + 1]); w.y = pack2(Tc[i4 * 4 + 2], Tc[i4 * 4 + 3]); *(u32x2*)(T11T + lane * 80 + i4 * 8) = w; }
                }
            }
        } else {
            const int t2 = tid - 128;
#pragma unroll
            for (int g2 = 0; g2 < 2; ++g2) {
                const int i = t2 & 31, k4 = ((t2 >> 5) + 4 * g2) * 4;
                u32x2 w;
                w.x = pack2(Lf[(k4 + 0) * 68 + 32 + i], Lf[(k4 + 1) * 68 + 32 + i]); w.y = pack2(Lf[(k4 + 2) * 68 + 32 + i], Lf[(k4 + 3) * 68 + 32 + i]);
                *(u32x2*)(L21i + i * 80 + k4 * 2) = w;
            }
        }
        __syncthreads();
        {
            const int r0 = 16 * (wid >> 1), c0 = 16 * (wid & 1);
            const f32x4 mm = tile16(L21i, 80, r0, T11T, 80, c0, 32);
            u32x2 w; w.x = pack2(mm[0], mm[1]); w.y = pack2(mm[2], mm[3]);
            *(u32x2*)(MT + (c0 + fr) * 80 + (r0 + 4 * fq) * 2) = w;
        }
        __syncthreads();
        {
            const int r0 = 16 * (wid >> 1), c0 = 16 * (wid & 1);
            const f32x4 tt = tile16(MT, 80, c0, Trow + 32 * 144 + 64, 144, r0, 32);
            u32x2 w; w.x = pack2(-tt[0], -tt[1]); w.y = pack2(-tt[2], -tt[3]);
            *(u32x2*)(Trow + (32 + r0 + fr) * 144 + (c0 + 4 * fq) * 2) = w;
        }
    }
    __syncthreads();
#pragma unroll
    for (int tq = 0; tq < 2; ++tq) {
        const int tj = wid * 2 + tq;
#pragma unroll
        for (int ti = 0; ti < 4; ++ti) {
            const f32x4 u = tile16(Trow, 144, 16 * ti, VbT, 144, 16 * tj, 64);
            {
                const int dv = 16 * tj + fr, slice = dv >> 5, rr = dv & 31, cb = 16 * ti + fq * 4, mt = cb >> 5, q4 = (cb & 31) >> 2, hh = q4 & 1, rg = q4 >> 1;
                u32x2 w; w.x = pack2(u[0], u[1]); w.y = pack2(u[2], u[3]);
                *(u32x2*)(ops + GO_UF + ((size_t)((slice * 2 + mt) * 64 + hh * 32 + rr) * 16 + rg * 4) * 2) = w;
            }
            const f32x4 wv = tile16(KbgT, 144, 16 * tj, Trow, 144, 16 * ti, 64);
            {
                const int c1 = 16 * ti + fr, mt = c1 >> 5, rr = c1 & 31, hh = fq & 1, jg = fq >> 1;
                u32x2 w; w.x = pack2(-wv[0], -wv[1]); w.y = pack2(-wv[2], -wv[3]);
                *(u32x2*)(ops + GO_WF + ((size_t)((mt * 8 + tj) * 64 + hh * 32 + rr) * 8 + jg * 4) * 2) = w;
            }
        }
    }
}

DI void glds16(const void* g, char* l) { __builtin_amdgcn_global_load_lds((const unsigned*)g, (lds_u32*)l, 16, 0, 0); }
DI void fr_rd(bf16x8& f, unsigned addr) { asm volatile("ds_read_b128 %0, %1" : "=v"(f) : "v"(addr) : "memory"); }
template <int N> DI void fr_wait(bf16x8& f) { asm volatile("s_waitcnt lgkmcnt(%1)" : "+v"(f) : "n"(N) : "memory"); }
template <int REM> DI void fr_waitc(bf16x8& f) { if (REM >= 3) fr_wait<3>(f); else if (REM == 2) fr_wait<2>(f); else if (REM == 1) fr_wait<1>(f); else fr_wait<0>(f); }
#define GS_WAIT(n) asm volatile("s_waitcnt vmcnt(" #n ")" ::: "memory")
DI void gdn_scan_block(const P& p, int bh, char* lds, bool dry = false) {
    const int tid = tidx(), lane = tid & 63, w = tid >> 6;
    const int h = bh & 3, b = bh >> 2;
    const float eglv = ((const float*)(p.ws + WS_CTL + CTL_EGL))[(b * 64 + lane) * 4 + h];
    unsigned char* gbase = p.ws + WS_GOPS + (size_t)(b * 256 + h) * GOPS_CH;
    auto issue = [&](int n, int k0, int cntk) {
        for (int k = k0; k < k0 + cntk; ++k) {
            const unsigned char* src = gbase + (size_t)n * 4 * GOPS_CH + k * 8192 + tid * 16;
            char* dst = lds + k * 8192 + tid * 16;
            glds16(src, dst); glds16(src + 4096, dst + 4096);
        }
    };
    const unsigned la = (unsigned)(size_t)(lds_u32*)lds + lane * 16;
    f32x16 S[4];
#pragma unroll
    for (int i = 0; i < 4; ++i)
#pragma unroll
        for (int r = 0; r < 16; ++r) S[i][r] = 0.f;
    __syncthreads();
    issue(0, 0, 7);
#pragma unroll 1
    for (int n = 0; n < 64; ++n) {
        const float egl = __shfl(eglv, n);
        bf16x8 Sb[8];
#pragma unroll
        for (int i = 0; i < 4; ++i) { Sb[i * 2] = pack_step(S[i], 0); Sb[i * 2 + 1] = pack_step(S[i], 1); }
        f32x16 av[2], ao[2];
        GS_WAIT(6);
        __builtin_amdgcn_s_barrier();
        issue(n, 7, 2);
        __builtin_amdgcn_sched_barrier(0);
        {
            const char* sl = lds + (w >> 1) * 8192;
#pragma unroll
            for (int mt = 0; mt < 2; ++mt) {
                const u32x4* up = (const u32x4*)(sl + ((w & 1) * 2 + mt) * 2048 + lane * 32);
                const u32x4 u0 = up[0], u1 = up[1];
#pragma unroll
                for (int e = 0; e < 4; ++e) {
                    av[mt][e * 2] = __uint_as_float(u0[e] << 16); av[mt][e * 2 + 1] = __uint_as_float(u0[e] & 0xffff0000u);
                    av[mt][8 + e * 2] = __uint_as_float(u1[e] << 16); av[mt][8 + e * 2 + 1] = __uint_as_float(u1[e] & 0xffff0000u);
                }
            }
        }
        bf16x8 F[4];
#define GS_O0(j) (unsigned)((2 + ((j) & 1)) * 8192 + ((j) >> 1) * 1024)
#pragma unroll
        for (int j = 0; j < 4; ++j) fr_rd(F[j], la + GS_O0(j));
#pragma unroll
        for (int j = 0; j < 16; ++j) {
            if (j <= 12) fr_wait<3>(F[j & 3]); else if (j == 13) fr_wait<2>(F[j & 3]); else if (j == 14) fr_wait<1>(F[j & 3]); else fr_wait<0>(F[j & 3]);
            av[j & 1] = mfma32(F[j & 3], Sb[j >> 1], av[j & 1]);
            if (j + 4 < 16) fr_rd(F[j & 3], la + GS_O0(j + 4));
        }
        bf16x8 Vb[4];
#pragma unroll
        for (int mt = 0; mt < 2; ++mt) { Vb[mt * 2] = pack_step(av[mt], 0); Vb[mt * 2 + 1] = pack_step(av[mt], 1); }
        GS_WAIT(4);
        __builtin_amdgcn_s_barrier();
        if (n < 63) issue(n + 1, 0, 4);
        __builtin_amdgcn_sched_barrier(0);
#pragma unroll
        for (int mt = 0; mt < 2; ++mt)
#pragma unroll
            for (int r = 0; r < 16; ++r) ao[mt][r] = 0.f;
#define GS_O1(j) (unsigned)((j) < 16 ? (4 + ((j) & 1)) * 8192 + ((j) >> 1) * 1024 : 6 * 8192 + ((j) == 16 ? 0 : (j) == 17 ? 4 : (j) == 18 ? 1 : (j) == 19 ? 5 : (j) == 20 ? 6 : 7) * 1024)
#pragma unroll
        for (int j = 0; j < 4; ++j) fr_rd(F[j], la + GS_O1(j));
#pragma unroll
        for (int j = 0; j < 22; ++j) {
            if (j <= 18) fr_wait<3>(F[j & 3]); else if (j == 19) fr_wait<2>(F[j & 3]); else if (j == 20) fr_wait<1>(F[j & 3]); else fr_wait<0>(F[j & 3]);
            if (j < 16) {
                ao[j & 1] = mfma32(F[j & 3], Sb[j >> 1], ao[j & 1]);
                if (j & 1) {
                    const int ks = j >> 1;
#pragma unroll
                    for (int r = 0; r < 8; ++r) S[ks >> 1][(ks & 1) * 8 + r] *= egl;
                }
            } else {
                const int oi = (j == 16 || j == 18) ? 0 : 1, kv = j <= 17 ? 0 : j <= 19 ? 1 : j == 20 ? 2 : 3;
                ao[oi] = mfma32(F[j & 3], Vb[kv], ao[oi]);
            }
            if (j + 4 < 22) fr_rd(F[j & 3], la + GS_O1(j + 4));
        }
        if (n < 63) GS_WAIT(8); else GS_WAIT(0);
        __builtin_amdgcn_s_barrier();
        if (n < 63) issue(n + 1, 4, 3);
        __builtin_amdgcn_sched_barrier(0);
#define GS_O2(j) (unsigned)((7 + (((j) & 3) >> 1)) * 8192 + ((((j) & 3) & 1) * 4 + ((j) >> 2)) * 1024)
#pragma unroll
        for (int j = 0; j < 4; ++j) fr_rd(F[j], la + GS_O2(j));
#pragma unroll
        for (int j = 0; j < 16; ++j) {
            if (j <= 12) fr_wait<3>(F[j & 3]); else if (j == 13) fr_wait<2>(F[j & 3]); else if (j == 14) fr_wait<1>(F[j & 3]); else fr_wait<0>(F[j & 3]);
            S[j & 3] = mfma32(F[j & 3], Vb[j >> 2], S[j & 3]);
            if (j + 4 < 16) fr_rd(F[j & 3], la + GS_O2(j + 4));
        }
        {
            u32x4* Of = (u32x4*)((dry ? p.ws + WS_DUMMY + (size_t)(bh & 15) * 65536 : gbase + (size_t)n * 4 * GOPS_CH) + GO_UF) + (size_t)(w * 2 * 64 + lane) * 2;
#pragma unroll
            for (int mt = 0; mt < 2; ++mt) {
                u32x4 o0, o1;
#pragma unroll
                for (int e = 0; e < 4; ++e) { o0[e] = pack2(ao[mt][e * 2], ao[mt][e * 2 + 1]); o1[e] = pack2(ao[mt][8 + e * 2], ao[mt][8 + e * 2 + 1]); }
                Of[mt * 128] = o0; Of[mt * 128 + 1] = o1;
            }
        }
    }
    __syncthreads();
}

DI void gdn_post_unit(const P& p, int li, int ch) {
    const int tid = tidx();
    const int h = ch & 3, n = (ch >> 2) & 63, b = ch >> 8;
    const int t0 = b * SEQ + n * 64;
    const int c = tid >> 2, cq = tid & 3;
    const bf16_t* Of = (const bf16_t*)(p.ws + WS_GOPS + (size_t)ch * GOPS_CH + GO_UF);
    const bf16_t* proj = (const bf16_t*)(p.ws + WS_PROJ);
    bf16_t* mix = (bf16_t*)(p.ws + WS_PROJ);
    const float* nw = p.in[I_GDNNORM] + li * 128 + cq * 32;
    const int mt = c >> 5, q4 = (c & 31) >> 2, hh = q4 & 1, rg = q4 >> 1, reg = rg * 4 + (c & 3);
    float o[32]; float ss = 0.f;
#pragma unroll
    for (int r = 0; r < 32; ++r) { o[r] = bf2f(Of[(size_t)((cq * 2 + mt) * 64 + hh * 32 + r) * 16 + reg]); ss += o[r] * o[r]; }
    ss += __shfl_xor(ss, 1); ss += __shfl_xor(ss, 2);
    const float rs = rsqrtf(ss * (1.f / 128.f) + 1e-6f);
    const bf16_t* zp = proj + (size_t)(t0 + c) * EVLD + 1536 + h * 128 + cq * 32;
    bf16_t* mp = mix + (size_t)(t0 + c) * EVLD + h * 128 + cq * 32;
#pragma unroll
    for (int i4 = 0; i4 < 4; ++i4) {
        const u32x4 zw = *(const u32x4*)(zp + i4 * 8);
        u32x4 w;
#pragma unroll
        for (int e = 0; e < 4; ++e) {
            const float z0 = __uint_as_float(zw[e] << 16), z1 = __uint_as_float(zw[e] & 0xffff0000u);
            w[e] = pack2(o[i4 * 8 + e * 2] * rs * nw[i4 * 8 + e * 2] * siluf_(z0), o[i4 * 8 + e * 2 + 1] * rs * nw[i4 * 8 + e * 2 + 1] * siluf_(z1));
        }
        *(u32x4*)(mp + i4 * 8) = w;
    }
}


constexpr int RP_Z0 = 0, RP_Z1 = 18432, RP_Z2 = 55296, RP_VEC = 73728, RP_PT = 75008, RP_T11 = 78080, RP_END = 80640;
constexpr int RP_LIN = 0, RP_LW = 25600;
DI void rwkv_prep_unit(const P& p, int li, int ch, char* lds) {
    const int tid = tidx(), lane = tid & 63, wid = tid >> 6, fr = lane & 15, fq = lane >> 4;
    const int h = ch & 7, n = (ch >> 3) & 63, b = ch >> 9;
    const int t0 = b * SEQ + n * 64;
    const bf16_t* proj = (const bf16_t*)(p.ws + WS_PROJ);
    char* Lfc = lds + RP_Z0; float* Lf = (float*)Lfc;
    char* ApT = lds + RP_Z0; char* AkVT = lds + RP_Z0 + 9216;
    char* Arow = lds + RP_Z1; char* Rrow = Arow + 9216; char* Brow = Arow + 18432; char* Krow = Arow + 27648;
    char* Aak = Arow; char* Arb = Rrow; char* Ark = Brow; char* Trow = Krow; char* BhT = Krow; char* VpT = Aak;
    char* AT = lds + RP_Z2; char* VT = AT + 9216; char* KhT = AT;
    float* tot = (float*)(lds + RP_VEC); float* WC = tot + 256;
    char* lin = lds + RP_LIN; char* LWi = lds + RP_LW;
    float* PT = (float*)(lds + RP_PT);
    {
        const float* mu0 = p.in[I_MU] + (size_t)li * 1696;
        if (tid < 48) {
            const int j0 = tid * 4;
            *(float4*)(PT + j0) = j0 < 160 ? *(const float4*)(mu0 + (C_HW - RW0) + j0) : *(const float4*)(p.in[I_VRESMU] + j0 - 160);
        } else if (tid < 48 + 144) {
            const int q = tid - 48, arr = q >> 4, c4 = (q & 15) * 4, chn = h * 64 + c4;
            const float* src = arr == 0 ? mu0 + (C_R - RW0) + chn : arr == 1 ? mu0 + (C_K - RW0) + chn : arr == 2 ? mu0 + (C_V - RW0) + chn
                             : arr == 3 ? p.in[I_W0] + li * 512 + chn : arr == 4 ? p.in[I_A0] + li * 512 + chn : arr == 5 ? p.in[I_V0] + chn
                             : arr == 6 ? p.in[I_KK] + li * 512 + chn : arr == 7 ? p.in[I_KA] + li * 512 + chn : p.in[I_RK] + li * 512 + chn;
            *(float4*)(PT + 192 + arr * 64 + c4) = *(const float4*)src;
        }
    }
    __syncthreads();
    {
        const int c = tid >> 2, cq = tid & 3, s = n * 64 + c;
        const bf16_t* cur = proj + (size_t)(t0 + c) * EVLD + C_HW + cq * 48;
        const float* mu = p.in[I_MU] + (size_t)li * 1696 + (C_HW - RW0);
        const float* vmu = p.in[I_VRESMU];
#pragma unroll
        for (int i6 = 0; i6 < 6; ++i6) {
            const u32x4 cw4 = *(const u32x4*)(cur + i6 * 8);
            u32x4 pw4 = *(const u32x4*)(cur - (s > 0 ? EVLD : 0) + i6 * 8);
            if (s == 0) pw4 = (u32x4){0u, 0u, 0u, 0u};
            const int j0 = cq * 48 + i6 * 8;
            const float4 ma = *(const float4*)(PT + j0), mb = *(const float4*)(PT + j0 + 4);
            const float mm[8] = {ma.x, ma.y, ma.z, ma.w, mb.x, mb.y, mb.z, mb.w};
            const bool is_t = j0 < 32, is_s = (j0 >= 64) && (j0 < 160);
            const float ca = is_t ? 1.f : 0.f, cb = is_t ? -2.f : 1.f, cc = is_t ? 2.f : -1.f;
            u32x4 w;
#pragma unroll
            for (int e = 0; e < 4; ++e) {
                float o2[2];
#pragma unroll
                for (int q = 0; q < 2; ++q) {
                    const float cv = q ? __uint_as_float(cw4[e] & 0xffff0000u) : __uint_as_float(cw4[e] << 16);
                    const float pv = q ? __uint_as_float(pw4[e] & 0xffff0000u) : __uint_as_float(pw4[e] << 16);
                    const float val = cv + mm[e * 2 + q] * (pv - cv);
                    const float act = ca + cb * __builtin_amdgcn_rcpf(1.f + __expf(cc * val));
                    o2[q] = (is_t || is_s) ? act : val;
                }
                w[e] = pack2(o2[0], o2[1]);
            }
            *(u32x4*)(lin + c * 400 + (cq * 48 + i6 * 8) * 2) = w;
        }
        const bf16_t* LW = (const bf16_t*)(p.ws + WS_W + W_LW) + (size_t)h * 64 * 192;
#pragma unroll
        for (int i6 = 0; i6 < 6; ++i6) *(u32x4*)(LWi + c * 400 + (cq * 48 + i6 * 8) * 2) = *(const u32x4*)(LW + (size_t)c * 192 + cq * 48 + i6 * 8);
    }
    __syncthreads();
    float lw_[16], la_[16], lg_[16], lv_[16];
#pragma unroll
    for (int tj = 0; tj < 4; ++tj) {
        const f32x4 a = tile16(LWi, 400, 16 * tj, lin, 400, 16 * wid, 32);
        const f32x4 bq = tile16(LWi + 64, 400, 16 * tj, lin + 64, 400, 16 * wid, 32);
        const f32x4 cg = tile16(LWi + 128, 400, 16 * tj, lin + 128, 400, 16 * wid, 96);
        const f32x4 dv = tile16(LWi + 320, 400, 16 * tj, lin + 320, 400, 16 * wid, 32);
#pragma unroll
        for (int r = 0; r < 4; ++r) { lw_[tj * 4 + r] = a[r]; la_[tj * 4 + r] = bq[r]; lg_[tj * 4 + r] = cg[r]; lv_[tj * 4 + r] = dv[r]; }
    }
    __syncthreads();
    const int c = 16 * wid + fr;
    float at[16], rt[16], bt[16], kt[16], bh[16], kh[16];
    {
        const int s = n * 64 + c;
        const size_t row = (size_t)(t0 + c);
        const float* mu = p.in[I_MU] + (size_t)li * 1696;
        const int hc = h * 64;
        float rr_[16], kk_[16], lwv[16], aa[16];
        float kn = 0.f, rk = 0.f;
        bf16_t* vf = (bf16_t*)(p.ws + WS_VF);
        bf16_t* gg = (bf16_t*)(p.ws + WS_GG);
#pragma unroll
        for (int tj = 0; tj < 4; ++tj) {
            const int cb = 16 * tj + 4 * fq;
            u32x2 cr = *(const u32x2*)(proj + row * EVLD + C_R + hc + cb), ck = *(const u32x2*)(proj + row * EVLD + C_K + hc + cb), cv = *(const u32x2*)(proj + row * EVLD + C_V + hc + cb);
            const size_t prow = s > 0 ? row - 1 : row;
            u32x2 pr = *(const u32x2*)(proj + prow * EVLD + C_R + hc + cb), pk = *(const u32x2*)(proj + prow * EVLD + C_K + hc + cb), pv = *(const u32x2*)(proj + prow * EVLD + C_V + hc + cb);
            if (s == 0) { pr = (u32x2){0u, 0u}; pk = pr; pv = pr; }
            u32x2 vfw = {0u, 0u};
            if (li == 1) vfw = *(const u32x2*)(vf + row * 512 + hc + cb);
            float vout[4], gout[4];
            const int ch0 = hc + cb;
            const float* pt = PT + 192 + cb;
            const float4 mu_r4 = *(const float4*)(pt), mu_k4 = *(const float4*)(pt + 64), mu_v4 = *(const float4*)(pt + 128);
            const float4 w0_4 = *(const float4*)(pt + 192), a0_4 = *(const float4*)(pt + 256), v0_4 = *(const float4*)(pt + 320);
            const float4 kk_4 = *(const float4*)(pt + 384), ka_4 = *(const float4*)(pt + 448), rk_4 = *(const float4*)(pt + 512);
            const float mur[4] = {mu_r4.x, mu_r4.y, mu_r4.z, mu_r4.w}, muk[4] = {mu_k4.x, mu_k4.y, mu_k4.z, mu_k4.w}, muv[4] = {mu_v4.x, mu_v4.y, mu_v4.z, mu_v4.w};
            const float w0v[4] = {w0_4.x, w0_4.y, w0_4.z, w0_4.w}, a0v[4] = {a0_4.x, a0_4.y, a0_4.z, a0_4.w}, v0v[4] = {v0_4.x, v0_4.y, v0_4.z, v0_4.w};
            const float kkp[4] = {kk_4.x, kk_4.y, kk_4.z, kk_4.w}, kap[4] = {ka_4.x, ka_4.y, ka_4.z, ka_4.w}, rkp[4] = {rk_4.x, rk_4.y, rk_4.z, rk_4.w};
#pragma unroll
            for (int r = 0; r < 4; ++r) {
                const int i = tj * 4 + r;
                const unsigned wcr = r < 2 ? cr.x : cr.y, wck = r < 2 ? ck.x : ck.y, wcv = r < 2 ? cv.x : cv.y;
                const unsigned wpr = r < 2 ? pr.x : pr.y, wpk = r < 2 ? pk.x : pk.y, wpv = r < 2 ? pv.x : pv.y, wvf = r < 2 ? vfw.x : vfw.y;
                const float c_r = (r & 1) ? __uint_as_float(wcr & 0xffff0000u) : __uint_as_float(wcr << 16);
                const float c_k = (r & 1) ? __uint_as_float(wck & 0xffff0000u) : __uint_as_float(wck << 16);
                const float c_v = (r & 1) ? __uint_as_float(wcv & 0xffff0000u) : __uint_as_float(wcv << 16);
                const float p_r = (r & 1) ? __uint_as_float(wpr & 0xffff0000u) : __uint_as_float(wpr << 16);
                const float p_k = (r & 1) ? __uint_as_float(wpk & 0xffff0000u) : __uint_as_float(wpk << 16);
                const float p_v = (r & 1) ? __uint_as_float(wpv & 0xffff0000u) : __uint_as_float(wpv << 16);
                const float rm = c_r + mur[r] * (p_r - c_r);
                const float km = c_k + muk[r] * (p_k - c_k);
                float vm = c_v + muv[r] * (p_v - c_v);
                const float wlog = -softplusf_(-(w0v[r] + lw_[i])) - 0.5f;
                lwv[i] = -__expf(wlog);
                const float a = sigmoidf_(a0v[r] + la_[i]);
                if (li == 1) {
                    const float v1 = (r & 1) ? __uint_as_float(wvf & 0xffff0000u) : __uint_as_float(wvf << 16);
                    vm = vm + (v1 - vm) * sigmoidf_(v0v[r] + lv_[i]);
                }
                const float kkv = km * kkp[r];
                kn += kkv * kkv;
                rr_[i] = rm; kk_[i] = kkv; aa[i] = a;
                kt[i] = km * (1.f + (a - 1.f) * kap[r]);
                rk += rm * kt[i] * rkp[r];
                vout[r] = vm; gout[r] = lg_[i];
            }
            u32x2 w; w.x = pack2(vout[0], vout[1]); w.y = pack2(vout[2], vout[3]);
            *(u32x2*)(vf + row * 512 + hc + cb) = w;
            w.x = pack2(gout[0], gout[1]); w.y = pack2(gout[2], gout[3]);
            *(u32x2*)(gg + row * 512 + hc + cb) = w;
#pragma unroll
            for (int r = 0; r < 4; ++r) *(bf16_t*)(VT + (cb + r) * 144 + c * 2) = f2bf(vout[r]);
            __builtin_amdgcn_sched_barrier(0);
        }
        kn += __shfl_xor(kn, 16); kn += __shfl_xor(kn, 32);
        const float kr = rsqrtf(kn + 1e-6f);
        rk += __shfl_xor(rk, 16); rk += __shfl_xor(rk, 32);
        if (fq == 0) ((float*)(p.ws + WS_RK))[row * 8 + h] = rk;
        float cs[16];
#pragma unroll
        for (int i = 0; i < 16; ++i) {
            float x = lwv[i];
#pragma unroll
            for (int o = 1; o < 16; o <<= 1) { const float y = __shfl_up(x, o, 16); if (fr >= o) x += y; }
            cs[i] = x;
        }
        if (fr == 15) {
#pragma unroll
            for (int i = 0; i < 16; ++i) tot[wid * 64 + 16 * (i >> 2) + 4 * fq + (i & 3)] = cs[i];
        }
        __syncthreads();
#pragma unroll
        for (int i = 0; i < 16; ++i) {
            const int chl = 16 * (i >> 2) + 4 * fq + (i & 3);
            float pre = 0.f, all = 0.f;
#pragma unroll
            for (int w2 = 0; w2 < 4; ++w2) { const float tv = tot[w2 * 64 + chl]; all += tv; if (w2 < wid) pre += tv; }
            const float csi = cs[i] + pre, csm = csi - lwv[i];
            const float kkn = kk_[i] * kr, k2 = kt[i];
            const float e_c = __expf(csi), e_n = __builtin_amdgcn_rcpf(e_c), e_m = __expf(csm), e_h = __expf(all) * e_n;
            at[i] = -kkn * e_m; rt[i] = rr_[i] * e_c;
            const float bp = kkn * aa[i];
            bt[i] = bp * e_n; kt[i] = k2 * e_n; bh[i] = bp * e_h; kh[i] = k2 * e_h;
            if (c == 0) WC[chl] = __expf(all);
            if ((i & 3) == 3) __builtin_amdgcn_sched_barrier(0);
        }
    }
#pragma unroll
    for (int tj = 0; tj < 4; ++tj) {
        const int cb = 16 * tj + 4 * fq;
        u32x2 w;
        w.x = pack2(at[tj * 4], at[tj * 4 + 1]); w.y = pack2(at[tj * 4 + 2], at[tj * 4 + 3]); *(u32x2*)(Arow + c * 144 + cb * 2) = w;
        w.x = pack2(rt[tj * 4], rt[tj * 4 + 1]); w.y = pack2(rt[tj * 4 + 2], rt[tj * 4 + 3]); *(u32x2*)(Rrow + c * 144 + cb * 2) = w;
        w.x = pack2(bt[tj * 4], bt[tj * 4 + 1]); w.y = pack2(bt[tj * 4 + 2], bt[tj * 4 + 3]); *(u32x2*)(Brow + c * 144 + cb * 2) = w;
        w.x = pack2(kt[tj * 4], kt[tj * 4 + 1]); w.y = pack2(kt[tj * 4 + 2], kt[tj * 4 + 3]); *(u32x2*)(Krow + c * 144 + cb * 2) = w;
#pragma unroll
        for (int r = 0; r < 4; ++r) {
            *(bf16_t*)(AT + (cb + r) * 144 + c * 2) = f2bf(at[tj * 4 + r]);
        }
    }
    __syncthreads();
    f32x4 pab[4], pak[4], prb[4], prk[4];
    {
        const int ti = wid;
#pragma unroll
        for (int tj = 0; tj < 4; ++tj) {
            pab[tj] = (f32x4){0.f, 0.f, 0.f, 0.f}; pak[tj] = pab[tj]; prb[tj] = pab[tj]; prk[tj] = pab[tj];
            if (tj <= ti) {
                pab[tj] = tile16(Arow, 144, 16 * ti, Brow, 144, 16 * tj, 64);
                pak[tj] = tile16(Krow, 144, 16 * tj, Arow, 144, 16 * ti, 64);
                prb[tj] = tile16(Brow, 144, 16 * tj, Rrow, 144, 16 * ti, 64);
                prk[tj] = tile16(Krow, 144, 16 * tj, Rrow, 144, 16 * ti, 64);
            }
        }
    }
    __syncthreads();
    {
        const int ti = wid;
#pragma unroll
        for (int tj = 0; tj < 4; ++tj) {
            const int s1 = 16 * tj + fr;
            f32x4 lv;
#pragma unroll
            for (int r = 0; r < 4; ++r) { const int t1 = 16 * ti + 4 * fq + r; lv[r] = (s1 < t1) ? -pab[tj][r] : 0.f; }
            *(f32x4*)&Lf[s1 * 72 + 16 * ti + 4 * fq] = lv;
            const int t2 = 16 * ti + fr;
            float m1[4], m2[4], m3[4];
#pragma unroll
            for (int r = 0; r < 4; ++r) { const int s2 = 16 * tj + 4 * fq + r; m1[r] = (s2 < t2) ? pak[tj][r] : 0.f; m2[r] = (s2 <= t2) ? prb[tj][r] : 0.f; m3[r] = (s2 <= t2) ? prk[tj][r] : 0.f; }
            u32x2 w;
            w.x = pack2(m1[0], m1[1]); w.y = pack2(m1[2], m1[3]); *(u32x2*)(Aak + t2 * 144 + (16 * tj + 4 * fq) * 2) = w;
            w.x = pack2(m2[0], m2[1]); w.y = pack2(m2[2], m2[3]); *(u32x2*)(Arb + t2 * 144 + (16 * tj + 4 * fq) * 2) = w;
            w.x = pack2(m3[0], m3[1]); w.y = pack2(m3[2], m3[3]); *(u32x2*)(Ark + t2 * 144 + (16 * tj + 4 * fq) * 2) = w;
        }
    }
    __syncthreads();
    {
        char* L21i = lds + RP_PT;
        char* T11T = lds + RP_T11;
        char* MT = lds + RP_Z0;
        if (wid < 2) {
            const int o = 32 * wid;
            float Tc[32];
#pragma unroll
            for (int i = 0; i < 32; ++i) Tc[i] = (i == (lane & 31)) ? 1.f : 0.f;
#pragma unroll
            for (int j = 0; j < 31; ++j) {
                const float tj = Tc[j];
#pragma unroll
                for (int i4 = (j + 1) >> 2; i4 < 8; ++i4) {
                    const f32x4 l4 = *(const f32x4*)&Lf[(o + j) * 72 + o + i4 * 4];
#pragma unroll
                    for (int e = 0; e < 4; ++e) if (i4 * 4 + e > j) Tc[i4 * 4 + e] -= l4[e] * tj;
                }
            }
            if (lane < 32) {
#pragma unroll
                for (int i = 0; i < 32; ++i) *(bf16_t*)(Trow + (o + i) * 144 + (o + lane) * 2) = f2bf(Tc[i]);
                if (wid == 0) {
#pragma unroll
                    for (int i = 0; i < 32; ++i) *(bf16_t*)(Trow + i * 144 + (32 + lane) * 2) = 0;
#pragma unroll
                    for (int i4 = 0; i4 < 8; ++i4) { u32x2 w; w.x = pack2(Tc[i4 * 4], Tc[i4 * 4 + 1]); w.y = pack2(Tc[i4 * 4 + 2], Tc[i4 * 4 + 3]); *(u32x2*)(T11T + lane * 80 + i4 * 8) = w; }
                }
            }
        } else {
            const int t2 = tid - 128;
#pragma unroll
            for (int g2 = 0; g2 < 2; ++g2) {
                const int i = t2 & 31, k4 = ((t2 >> 5) + 4 * g2) * 4;
                u32x2 w;
                w.x = pack2(Lf[(k4 + 0) * 72 + 32 + i], Lf[(k4 + 1) * 72 + 32 + i]); w.y = pack2(Lf[(k4 + 2) * 72 + 32 + i], Lf[(k4 + 3) * 72 + 32 + i]);
                *(u32x2*)(L21i + i * 80 + k4 * 2) = w;
            }
        }
        __syncthreads();
        {
            const int r0 = 16 * (wid >> 1), c0 = 16 * (wid & 1);
            const f32x4 mm = tile16(L21i, 80, r0, T11T, 80, c0, 32);
            u32x2 w; w.x = pack2(mm[0], mm[1]); w.y = pack2(mm[2], mm[3]);
            *(u32x2*)(MT + (c0 + fr) * 80 + (r0 + 4 * fq) * 2) = w;
        }
        __syncthreads();
        {
            const int r0 = 16 * (wid >> 1), c0 = 16 * (wid & 1);
            const f32x4 tt = tile16(MT, 80, c0, Trow + 32 * 144 + 64, 144, r0, 32);
            u32x2 w; w.x = pack2(-tt[0], -tt[1]); w.y = pack2(-tt[2], -tt[3]);
            *(u32x2*)(Trow + (32 + r0 + fr) * 144 + (c0 + 4 * fq) * 2) = w;
        }
    }
    __syncthreads();
    {
        const int ti = wid;
#pragma unroll
        for (int tj = 0; tj < 4; ++tj) {
            const f32x4 x = tile16(Trow, 144, 16 * ti, AT, 144, 16 * tj, 64);
            const f32x4 y = tile16(Aak, 144, 16 * ti, VT, 144, 16 * tj, 64);
            u32x2 w;
            w.x = pack2(x[0], x[1]); w.y = pack2(x[2], x[3]); *(u32x2*)(ApT + (16 * tj + fr) * 144 + (16 * ti + 4 * fq) * 2) = w;
            w.x = pack2(y[0], y[1]); w.y = pack2(y[2], y[3]); *(u32x2*)(AkVT + (16 * tj + fr) * 144 + (16 * ti + 4 * fq) * 2) = w;
        }
    }
    __syncthreads();
    {
        const int ti = wid;
#pragma unroll
        for (int tj = 0; tj < 4; ++tj) {
            const f32x4 x = tile16(Trow, 144, 16 * ti, AkVT, 144, 16 * tj, 64);
            u32x2 w; w.x = pack2(x[0], x[1]); w.y = pack2(x[2], x[3]); *(u32x2*)(VpT + (16 * tj + fr) * 144 + (16 * ti + 4 * fq) * 2) = w;
        }
    }
    __syncthreads();
#pragma unroll
    for (int tj = 0; tj < 4; ++tj)
#pragma unroll
        for (int r = 0; r < 4; ++r) {
            const int cb = 16 * tj + 4 * fq + r;
            *(bf16_t*)(BhT + cb * 144 + c * 2) = f2bf(bh[tj * 4 + r]);
            *(bf16_t*)(KhT + cb * 144 + c * 2) = f2bf(kh[tj * 4 + r]);
        }
    __syncthreads();
    {
        unsigned char* opsA = (unsigned char*)p.out + (size_t)ch * 16384;
        unsigned char* opsB = p.ws + WS_ROPS + (size_t)ch * 16384;
        const int ti = wid;
#pragma unroll
        for (int tj = 0; tj < 4; ++tj) {
            const f32x4 x = tile16(ApT, 144, 16 * tj, Arb, 144, 16 * ti, 64);
            const f32x4 g = tile16(ApT, 144, 16 * tj, BhT, 144, 16 * ti, 64);
            const int m1 = 16 * ti + fr, mt = m1 >> 5, rr = m1 & 31, hh = fq & 1, jg = fq >> 1;
            const size_t off = ((size_t)((mt * 4 + tj) * 64 + hh * 32 + rr) * 8 + jg * 4) * 2;
            float gd[4];
#pragma unroll
            for (int r = 0; r < 4; ++r) gd[r] = g[r] + ((16 * tj + 4 * fq + r == m1) ? WC[m1] : 0.f);
            u32x2 w;
            w.x = pack2(x[0] + rt[tj * 4], x[1] + rt[tj * 4 + 1]); w.y = pack2(x[2] + rt[tj * 4 + 2], x[3] + rt[tj * 4 + 3]); *(u32x2*)(opsA + off) = w;
            w.x = pack2(gd[0], gd[1]); w.y = pack2(gd[2], gd[3]); *(u32x2*)(opsA + 8192 + off) = w;
            f32x4 y = tile16(Ark, 144, 16 * ti, VT, 144, 16 * tj, 64);
            const f32x4 y2 = tile16(Arb, 144, 16 * ti, VpT, 144, 16 * tj, 64);
            f32x4 kv = tile16(KhT, 144, 16 * ti, VT, 144, 16 * tj, 64);
            const f32x4 kv2 = tile16(BhT, 144, 16 * ti, VpT, 144, 16 * tj, 64);
            const int vcol = 16 * tj + fr, slice = vcol >> 5, r2 = vcol & 31, cb = 16 * ti + 4 * fq, mt2 = cb >> 5, q4 = (cb & 31) >> 2, h2 = q4 & 1, rg = q4 >> 1;
            const size_t off2 = ((size_t)((slice * 2 + mt2) * 64 + h2 * 32 + r2) * 16 + rg * 4) * 2;
            w.x = pack2(y[0] + y2[0], y[1] + y2[1]); w.y = pack2(y[2] + y2[2], y[3] + y2[3]); *(u32x2*)(opsB + off2) = w;
            w.x = pack2(kv[0] + kv2[0], kv[1] + kv2[1]); w.y = pack2(kv[2] + kv2[2], kv[3] + kv2[3]); *(u32x2*)(opsB + 8192 + off2) = w;
        }
    }
}

DI void rwkv_scan_block(const P& p, int bh, char* lds, bool dry = false) {
    const int tid = tidx(), lane = tid & 63, w = tid >> 6, slice = w & 1;
    const int h = bh & 7, b = bh >> 3;
    constexpr int NST = 64 * 2, AH = 3;
    auto issue = [&](int j) {
        const int n = j >> 1, k = j & 1;
        const size_t ch = (size_t)((b * 64 + n) * 8 + h) * 16384;
        const unsigned char* s0 = (k == 0 ? p.ws + WS_ROPS + ch + 8192 : p.ws + WS_ROPS + ch) + tid * 16;
        const unsigned char* s1 = (k == 0 ? (const unsigned char*)p.out + ch + 8192 : (const unsigned char*)p.out + ch) + tid * 16;
        char* dst = lds + (j & 3) * 16384 + tid * 16;
        glds16(s0, dst); glds16(s0 + 4096, dst + 4096); glds16(s1, dst + 8192); glds16(s1 + 4096, dst + 12288);
    };
    const unsigned la = (unsigned)(size_t)(lds_u32*)lds + lane * 16;
    f32x16 H[2];
#pragma unroll
    for (int i = 0; i < 2; ++i)
#pragma unroll
        for (int r = 0; r < 16; ++r) H[i][r] = 0.f;
    __syncthreads();
#pragma unroll
    for (int j = 0; j < AH; ++j) issue(j);
#pragma unroll 1
    for (int n = 0; n < 64; ++n) {
        bf16x8 Hb[4];
#pragma unroll
        for (int i = 0; i < 2; ++i) { Hb[i * 2] = pack_step(H[i], 0); Hb[i * 2 + 1] = pack_step(H[i], 1); }
#pragma unroll
        for (int k = 0; k < 2; ++k) {
            const int j = n * 2 + k;
            if (n < 63) GS_WAIT(8); else if (k == 0) GS_WAIT(4); else GS_WAIT(0);
            __builtin_amdgcn_s_barrier();
            if (j + AH < NST) issue(j + AH);
            __builtin_amdgcn_sched_barrier(0);
            const char* sl = lds + (j & 3) * 16384;
            if (w < 2) {
                f32x16 acc[2];
                bf16x8 F[4];
                const unsigned fa = la + (unsigned)((j & 3) * 16384 + 8192);
#define RS_O(i) (unsigned)((((i) & 1) * 4 + ((i) >> 1)) * 1024)
#pragma unroll
                for (int i = 0; i < 4; ++i) fr_rd(F[i], fa + RS_O(i));
#pragma unroll
                for (int mt = 0; mt < 2; ++mt) {
                    const u32x4* up = (const u32x4*)(sl + (slice * 2 + mt) * 2048 + lane * 32);
                    const u32x4 u0 = up[0], u1 = up[1];
#pragma unroll
                    for (int e = 0; e < 4; ++e) {
                        acc[mt][e * 2] = __uint_as_float(u0[e] << 16); acc[mt][e * 2 + 1] = __uint_as_float(u0[e] & 0xffff0000u);
                        acc[mt][8 + e * 2] = __uint_as_float(u1[e] << 16); acc[mt][8 + e * 2 + 1] = __uint_as_float(u1[e] & 0xffff0000u);
                    }
                }
#pragma unroll
                for (int i = 0; i < 8; ++i) {
                    if (i <= 4) fr_wait<3>(F[i & 3]); else if (i == 5) fr_wait<2>(F[i & 3]); else if (i == 6) fr_wait<1>(F[i & 3]); else fr_wait<0>(F[i & 3]);
                    acc[i & 1] = mfma32(F[i & 3], Hb[i >> 1], acc[i & 1]);
                    if (i + 4 < 8) fr_rd(F[i & 3], fa + RS_O(i + 4));
                }
                if (k == 0) { H[0] = acc[0]; H[1] = acc[1]; }
                else {
                    const size_t ch = (size_t)((b * 64 + n) * 8 + h) * 16384;
                    u32x4* Yf = (u32x4*)(dry ? p.ws + WS_DUMMY + 2097152 + (size_t)(bh & 31) * 16384 : p.ws + WS_ROPS + ch) + (size_t)(slice * 128 + lane) * 2;
#pragma unroll
                    for (int mt = 0; mt < 2; ++mt) {
                        u32x4 o0, o1;
#pragma unroll
                        for (int e = 0; e < 4; ++e) { o0[e] = pack2(acc[mt][e * 2], acc[mt][e * 2 + 1]); o1[e] = pack2(acc[mt][8 + e * 2], acc[mt][8 + e * 2 + 1]); }
                        Yf[mt * 128] = o0; Yf[mt * 128 + 1] = o1;
                    }
                }
            }
        }
    }
    __syncthreads();
}

DI void rwkv_post_unit(const P& p, int li, int ch) {
    const int tid = tidx();
    const int h = ch & 7, n = (ch >> 3) & 63, b = ch >> 9;
    const int t0 = b * SEQ + n * 64;
    const int c = tid >> 2, cq = tid & 3;
    const bf16_t* Yf = (const bf16_t*)(p.ws + WS_ROPS + (size_t)ch * 16384);
    const bf16_t* vf = (const bf16_t*)(p.ws + WS_VF) + (size_t)(t0 + c) * 512 + h * 64 + cq * 16;
    const bf16_t* gg = (const bf16_t*)(p.ws + WS_GG) + (size_t)(t0 + c) * 512 + h * 64 + cq * 16;
    const float rk = ((const float*)(p.ws + WS_RK))[(size_t)(t0 + c) * 8 + h];
    const float* lnw = p.in[I_LNW] + li * 512 + h * 64 + cq * 16;
    const float* lnb = p.in[I_LNB] + li * 512 + h * 64 + cq * 16;
    bf16_t* mp = (bf16_t*)p.out + (size_t)(t0 + c) * 1024 + 512 + h * 64 + cq * 16;
    const int mt = c >> 5, q4 = (c & 31) >> 2, hh = q4 & 1, rg = q4 >> 1, reg = rg * 4 + (c & 3), slice = cq >> 1, rb = (cq & 1) * 16;
    float y[16]; float sm = 0.f;
#pragma unroll
    for (int i = 0; i < 16; ++i) { y[i] = bf2f(Yf[(size_t)((slice * 2 + mt) * 64 + hh * 32 + rb + i) * 16 + reg]); sm += y[i]; }
    sm += __shfl_xor(sm, 1); sm += __shfl_xor(sm, 2);
    const float mean = sm * (1.f / 64.f);
    float vs = 0.f;
#pragma unroll
    for (int i = 0; i < 16; ++i) { y[i] -= mean; vs += y[i] * y[i]; }
    vs += __shfl_xor(vs, 1); vs += __shfl_xor(vs, 2);
    const float rs = rsqrtf(vs * (1.f / 64.f) + 64e-5f);
#pragma unroll
    for (int i8 = 0; i8 < 2; ++i8) {
        const u32x4 vw = *(const u32x4*)(vf + i8 * 8), gw = *(const u32x4*)(gg + i8 * 8);
        u32x4 w;
#pragma unroll
        for (int e = 0; e < 4; ++e) {
            const int i = i8 * 8 + e * 2;
            const float v0 = __uint_as_float(vw[e] << 16), v1 = __uint_as_float(vw[e] & 0xffff0000u), g0 = __uint_as_float(gw[e] << 16), g1 = __uint_as_float(gw[e] & 0xffff0000u);
            w[e] = pack2((y[i] * rs * lnw[i] + lnb[i] + rk * v0) * g0, (y[i + 1] * rs * lnw[i + 1] + lnb[i + 1] + rk * v1) * g1);
        }
        *(u32x4*)(mp + i8 * 8) = w;
    }
}


DI void attn_unit(const P& p, int unit, char* lds) {
    const int tid = tidx(), lane = tid & 63, w = tid >> 6, r_ = lane & 31, hl = lane >> 5;
    const int idx = unit & 31, h = (unit >> 5) & 7, g = (unit >> 8) % 3, b = unit / 768;
    const int lg2 = g * 2, dil = 1 << lg2, L = SEQ >> lg2, ntl = L >> 7;
    const int rs = idx / ntl, qt = idx % ntl;
    const int hg = g * 8 + h;
    const bf16_t* QK = (const bf16_t*)(p.ws + WS_QK);
    const bf16_t* VT = (const bf16_t*)(p.ws + WS_VT) + ((size_t)((b * 24 + hg) * dil + rs) * 64) * L;
    const int qi = 32 * w + r_;
    const int q_idx = 128 * qt + qi;
    const size_t qrow = (size_t)(b * SEQ + q_idx * dil + rs);
    const int kbase0 = 128 * qt - 128;
    char* Kt = lds;
    char* Vt = lds + 32768;
    __syncthreads();
#pragma unroll
    for (int i = 0; i < 8; ++i) {
        const int id = tid + i * 256, row = id >> 3, pc = id & 7, c = pc ^ ((row >> 1) & 7);
        int k_idx = kbase0 + row; if (k_idx < 0) k_idx = 0;
        glds16(QK + (size_t)(b * SEQ + k_idx * dil + rs) * 3072 + 1536 + hg * 64 + c * 8, Kt + id * 16);
    }
#pragma unroll
    for (int i = 0; i < 8; ++i) {
        const int id = tid + i * 256, row = id >> 5, pq = id & 31, q = pq ^ (row & 31);
        int k0 = kbase0 + q * 8; if (k0 < 0) k0 = 0;
        glds16(VT + (size_t)row * L + k0, Vt + id * 16);
    }
    bf16x8 qf[4];
#pragma unroll
    for (int ks = 0; ks < 4; ++ks) qf[ks] = *(const bf16x8*)(QK + qrow * 3072 + hg * 64 + 16 * ks + 8 * hl);
    asm volatile("s_waitcnt vmcnt(0)" ::: "memory");
    __syncthreads();
    f32x16 st[5];
    float mx = -1.0e30f;
#pragma unroll
    for (int kbi = 0; kbi < 5; ++kbi) {
        const int krow = 32 * (w + kbi) + r_;
#pragma unroll
        for (int r = 0; r < 16; ++r) st[kbi][r] = 0.f;
#pragma unroll
        for (int ks = 0; ks < 4; ++ks) {
            const bf16x8 kf = *(const bf16x8*)(Kt + krow * 128 + (((2 * ks + hl) ^ ((krow >> 1) & 7)) * 16));
            st[kbi] = mfma32(kf, qf[ks], st[kbi]);
        }
#pragma unroll
        for (int r = 0; r < 16; ++r) {
            const int kj = 32 * (w + kbi) + (r & 3) + 8 * (r >> 2) + 4 * hl;
            const bool valid = (kj >= qi) && (kj <= qi + 128) && (kbase0 + kj >= 0);
            const float sv = valid ? st[kbi][r] * 0.125f : -1.0e30f;
            st[kbi][r] = sv; mx = fmaxf(mx, sv);
        }
    }
    mx = fmaxf(mx, __shfl_xor(mx, 32));
    float l = 0.f;
#pragma unroll
    for (int kbi = 0; kbi < 5; ++kbi)
#pragma unroll
        for (int r = 0; r < 16; ++r) { const float pv = __expf(st[kbi][r] - mx); st[kbi][r] = pv; l += pv; }
    l += __shfl_xor(l, 32);
    f32x16 ot[2];
#pragma unroll
    for (int dt = 0; dt < 2; ++dt)
#pragma unroll
        for (int r = 0; r < 16; ++r) ot[dt][r] = 0.f;
#pragma unroll
    for (int kbi = 0; kbi < 5; ++kbi)
#pragma unroll
        for (int s2 = 0; s2 < 2; ++s2) {
            const bf16x8 pb = pack_step(st[kbi], s2);
            const int q0 = 4 * (w + kbi) + 2 * s2;
#pragma unroll
            for (int dt = 0; dt < 2; ++dt) {
                const int drow = 32 * dt + r_;
                const u32x2 lo = *(const u32x2*)(Vt + drow * 512 + ((q0 ^ (drow & 31)) * 16) + 8 * hl);
                const u32x2 hi = *(const u32x2*)(Vt + drow * 512 + (((q0 + 1) ^ (drow & 31)) * 16) + 8 * hl);
                u32x4 vw; vw.x = lo.x; vw.y = lo.y; vw.z = hi.x; vw.w = hi.y;
                ot[dt] = mfma32(__builtin_bit_cast(bf16x8, vw), pb, ot[dt]);
            }
        }
    const float inv = 1.f / l;
    bf16_t* og = (bf16_t*)(p.ws + WS_OG) + ((size_t)g * T + qrow) * 512 + h * 64;
#pragma unroll
    for (int dt = 0; dt < 2; ++dt)
#pragma unroll
        for (int rg = 0; rg < 4; ++rg) {
            u32x2 wv; wv.x = pack2(ot[dt][rg * 4] * inv, ot[dt][rg * 4 + 1] * inv); wv.y = pack2(ot[dt][rg * 4 + 2] * inv, ot[dt][rg * 4 + 3] * inv);
            *(u32x2*)(og + 32 * dt + 8 * rg + 4 * hl) = wv;
        }
    if (hl == 0) ((float*)(p.ws + WS_LSE))[((size_t)g * T + qrow) * 8 + h] = mx + __logf(l);
}
DI void phase_attn_merge(const P& p) {
    const bf16_t* og = (const bf16_t*)(p.ws + WS_OG);
    const float* lse = (const float*)(p.ws + WS_LSE);
    bf16_t* o = (bf16_t*)p.out;
    for (int i = bidx() * 256 + tidx(); i < T * 64; i += gridDim.x * 256) {
        const int t = i >> 6, c8 = i & 63, h = c8 >> 3;
        const float l0 = lse[(size_t)t * 8 + h], l1 = lse[((size_t)T + t) * 8 + h], l2 = lse[((size_t)2 * T + t) * 8 + h];
        const float m = fmaxf(l0, fmaxf(l1, l2));
        float w0 = __expf(l0 - m), w1 = __expf(l1 - m), w2 = __expf(l2 - m);
        const float inv = 1.f / (w0 + w1 + w2); w0 *= inv; w1 *= inv; w2 *= inv;
        const u32x4 a = *(const u32x4*)(og + (size_t)t * 512 + c8 * 8), bq = *(const u32x4*)(og + ((size_t)T + t) * 512 + c8 * 8), cq = *(const u32x4*)(og + ((size_t)2 * T + t) * 512 + c8 * 8);
        u32x4 r;
#pragma unroll
        for (int e = 0; e < 4; ++e) {
            const float x0 = w0 * __uint_as_float(a[e] << 16) + w1 * __uint_as_float(bq[e] << 16) + w2 * __uint_as_float(cq[e] << 16);
            const float x1 = w0 * __uint_as_float(a[e] & 0xffff0000u) + w1 * __uint_as_float(bq[e] & 0xffff0000u) + w2 * __uint_as_float(cq[e] & 0xffff0000u);
            r[e] = pack2(x0, x1);
        }
        *(u32x4*)(o + (size_t)t * 512 + c8 * 8) = r;
    }
}


#define XB_TMO      128
#define XB_XCNT(j)  (256  + 64 * (j))
#define XB_XSUB(j)  (1280 + 64 * (j))
#define XB_XGEN(j)  (2304 + 64 * (j))
#define XB_TOP      3328
#define XB_TOPGEN   3392
#define XCD_BAR_WORDS 3456
#define XB_SPIN_CAP (1u << 22)
#define LAS __attribute__((address_space(3)))
DI unsigned xb_ld(unsigned* p)              { return __hip_atomic_load(p, __ATOMIC_RELAXED, __HIP_MEMORY_SCOPE_AGENT); }
DI unsigned xb_add(unsigned* p, unsigned v) { return __hip_atomic_fetch_add(p, v, __ATOMIC_RELAXED, __HIP_MEMORY_SCOPE_AGENT); }
DI unsigned xb_xcc_id() { return (unsigned)__builtin_amdgcn_s_getreg((3 << 11) | 20) & 0xFu; }
#define XB_SPIN(cond, bar) do { unsigned _sp = 0; while (cond) { if (_sp < 32u) __builtin_amdgcn_s_sleep(2); else __builtin_amdgcn_s_sleep(24); \
    if ((++_sp & 255u) == 0u) { if (xb_ld(&(bar)[XB_TMO])) break; if (_sp > XB_SPIN_CAP) { atomicAdd(&(bar)[XB_TMO], 1u); break; } } } } while (0)
struct XcdBarrier { unsigned* bar; unsigned x; volatile LAS unsigned* st; };
DI XcdBarrier xcd_barrier_post(unsigned* bar, volatile LAS unsigned* st) {
    XcdBarrier b; b.bar = bar; b.x = xb_xcc_id(); b.st = st;
    if (threadIdx.x == 0) (void)xb_add(&bar[XB_XCNT(b.x)], 1u);
    return b;
}
DI void xcd_barrier_complete(unsigned* bar, unsigned x, unsigned& nloc, unsigned& nx) {
    const unsigned G = gridDim.x * gridDim.y * gridDim.z;
    unsigned sum, cnt, mine, sp = 0u;
    for (;;) {
        sum = 0u; cnt = 0u; mine = 0u;
#pragma unroll
        for (unsigned j = 0; j < 16; ++j) { const unsigned c = xb_ld(&bar[XB_XCNT(j)]); sum += c; cnt += (c > 0u) ? 1u : 0u; mine = (j == x) ? c : mine; }
        if (sum == G) break;
        __builtin_amdgcn_s_sleep(1);
        if ((++sp & 255u) == 0u) { if (xb_ld(&bar[XB_TMO])) break; if (sp > XB_SPIN_CAP) { atomicAdd(&bar[XB_TMO], 1u); break; } }
    }
    nloc = mine > 0u ? mine : 1u; nx = cnt > 0u ? cnt : 1u;
}
DI void xcd_barrier(const XcdBarrier& b) {
    asm volatile("s_waitcnt vmcnt(0)" ::: "memory");
    __syncthreads();
    if (threadIdx.x == 0) {
        unsigned* bar = b.bar; unsigned bx = b.x;
        asm volatile("" : "+s"(bar), "+s"(bx));
        __builtin_amdgcn_s_waitcnt(0);
        unsigned nloc = b.st[0], nx = b.st[1];
        if (nloc == 0u) { xcd_barrier_complete(bar, bx, nloc, nx); b.st[0] = nloc; b.st[1] = nx; }
        const unsigned old = xb_add(&bar[XB_XSUB(bx)], 1u);
        const unsigned gen = old / nloc;
        if (old + 1u == (gen + 1u) * nloc) {
            __builtin_amdgcn_fence(__ATOMIC_RELEASE, "agent");
            asm volatile("s_waitcnt vmcnt(0)" ::: "memory");
            const unsigned og = xb_add(&bar[XB_TOP], 1u);
            const unsigned tg = og / nx;
            if (og + 1u == (tg + 1u) * nx) xb_add(&bar[XB_TOPGEN], 1u);
            else XB_SPIN(xb_ld(&bar[XB_TOPGEN]) == tg, bar);
            __builtin_amdgcn_fence(__ATOMIC_ACQUIRE, "agent");
            xb_add(&bar[XB_XGEN(bx)], 1u);
            asm volatile("s_waitcnt vmcnt(0)" ::: "memory");
        } else {
            XB_SPIN(xb_ld(&bar[XB_XGEN(bx)]) == gen, bar);
            __builtin_amdgcn_fence(__ATOMIC_ACQUIRE, "agent");
            asm volatile("s_waitcnt vmcnt(0)" ::: "memory");
        }
    }
    __syncthreads();
}

constexpr int LDS_BYTES = RP_END;
static_assert(GP_END + 6144 <= LDS_BYTES, "LDS");
__global__ void __launch_bounds__(256, 2) __attribute__((amdgpu_waves_per_eu(2, 2))) mega(P p) {
    cg::grid_group grid = cg::this_grid();
    extern __shared__ __attribute__((aligned(16))) char lds[];
    if (threadIdx.x < 4) ((volatile LAS unsigned*)(lds + LDS_BYTES))[threadIdx.x] = 0u;
    __syncthreads();
    const XcdBarrier xb = xcd_barrier_post((unsigned*)(p.ws + WS_CTL + CTL_BAR), (volatile LAS unsigned*)(lds + LDS_BYTES));
#define GSYNC() xcd_barrier(xb)
    const bf16_t* HN = (const bf16_t*)p.out;
    const bf16_t* XB = (const bf16_t*)(p.ws + WS_XB);
    const bf16_t* Win = (const bf16_t*)(p.ws + WS_W + W_IN);
    const bf16_t* Wout = (const bf16_t*)(p.ws + WS_W + W_OUT);
    {
        const unsigned hw = (unsigned)__builtin_amdgcn_s_getreg((31 << 11) | 4);
        const unsigned key = 1u + ((xb.x << 16) | (hw & 0xFF00u));
        if (threadIdx.x == 0) ((unsigned*)(p.ws + WS_CTL + CTL_CUTAB))[bidx()] = key;
    }
    phase_rope(p);
    phase_convert_io(p, 0, lds, bidx(), gridDim.x);
    phase_prep<0>(p, p.in[I_EVNORM], 0);
    if (p.ws == nullptr) grid.sync();
    GSYNC();
    volatile LAS unsigned* qword = (volatile LAS unsigned*)(lds + LDS_BYTES + 8);
    int idle2, idle3, rank3, nact3;
    {
        const unsigned* cut = (const unsigned*)(p.ws + WS_CTL + CTL_CUTAB);
        unsigned* keys = (unsigned*)lds; unsigned* cntw = keys + 2048;
        const int G = (int)gridDim.x < 2048 ? (int)gridDim.x : 2048;
        __syncthreads();
        for (int j = threadIdx.x; j < G; j += 256) keys[j] = cut[j];
        if (threadIdx.x < 4) cntw[threadIdx.x] = 0u;
        __syncthreads();
        const unsigned mine = keys[bidx() < G ? bidx() : 0];
        for (int j = threadIdx.x; j < G; j += 256) {
            bool sh16 = false, sh32 = false;
            for (int k = 0; k < 32 && k < G; ++k) { const bool eq = keys[k] == keys[j] && k != j; if (eq) { sh32 = true; if (k < 16) sh16 = true; } }
            const bool act3 = j >= 32 && !sh32;
            if (act3) { atomicAdd(&cntw[0], 1u); if (j < bidx()) atomicAdd(&cntw[1], 1u); }
            if (j == bidx()) { cntw[2] = (j >= 16 && sh16) ? 1u : 0u; cntw[3] = (j >= 32 && sh32) ? 1u : 0u; }
        }
        (void)mine;
        __syncthreads();
        nact3 = __builtin_amdgcn_readfirstlane((int)cntw[0]); rank3 = __builtin_amdgcn_readfirstlane((int)cntw[1]);
        idle2 = __builtin_amdgcn_readfirstlane((int)cntw[2]); idle3 = __builtin_amdgcn_readfirstlane((int)cntw[3]);
        if (nact3 < 1) { nact3 = 1; }
        __syncthreads();
    }
    for (int layer = 0; layer < 4; ++layer) {
        const int li = layer >> 1;
        if ((layer & 1) == 0) {
            phase_gemm<EPI_EVEN_IN>(p, XB, 1024, Win, 1024, EVPAD / 128, lds);
            GSYNC();
            for (int u = bidx(); u < 1024; u += gridDim.x) gdn_prep_unit(p, li, u, lds);
            GSYNC();
            if (bidx() < 16) gdn_scan_block(p, bidx(), lds);
            if (!idle2) {
                unsigned* qctr = (unsigned*)(p.ws + WS_CTL + CTL_QUEUE) + li * 64;
                for (;;) {
                    __syncthreads();
                    if (threadIdx.x == 0) *qword = atomicAdd(qctr, 1u);
                    __syncthreads();
                    const unsigned u = *qword;
                    if (u >= 2048u + 768u) break;
                    if (u < 2048u) rwkv_prep_unit(p, li, (int)u, lds);
                    else convert_moe_tile(p, layer + 1, lds, (int)u - 2048);
                }
            }
            GSYNC();
            if (bidx() < 32) rwkv_scan_block(p, bidx(), lds);
            else if (!idle3) {
                for (int u = rank3; u < 1024; u += nact3) gdn_post_unit(p, li, u);
                phase_convert_moe(p, layer, lds, rank3, nact3);
            }
            GSYNC();
            for (int u = bidx(); u < 2048; u += gridDim.x) rwkv_post_unit(p, li, u);
            GSYNC();
            phase_gemm<EPI_RESID>(p, (const bf16_t*)(p.ws + WS_PROJ), EVLD, Wout, 1024, 8, lds, false, HN, 1024, 512);
        } else {
            phase_gemm<EPI_ODD_IN>(p, XB, 1024, Win, 1024, ODC / 128, lds);
            GSYNC();
            for (int u = bidx(); u < 3072; u += gridDim.x) attn_unit(p, u, lds);
            GSYNC();
            phase_attn_merge(p);
            GSYNC();
            phase_gemm<EPI_RESID>(p, HN, 512, Wout, 512, 8, lds);
        }
        GSYNC();
        phase_router(p, p.in[I_FFNNORM] + layer * 1024, layer, lds);
        GSYNC();
        {
            const int nt = phase_moe_up(p, layer, lds);
            if (layer < 3) {
                const int G = (int)gridDim.x, rounds = (nt + G - 1) / G, first = nt - (rounds - 1) * G;
                if (first >= G) phase_convert_io(p, layer + 1, lds, bidx(), G);
                else if (bidx() >= first) phase_convert_io(p, layer + 1, lds, bidx() - first, G - first);
            }
        }
        GSYNC();
        phase_moe_down(p, layer, lds);
        GSYNC();
        if (layer < 3) {
            phase_prep<1>(p, ((layer + 1) & 1) ? p.in[I_ODNORM] + ((layer + 1) >> 1) * 1024 : p.in[I_EVNORM] + ((layer + 1) >> 1) * 1024, layer + 1);
            GSYNC();
        }
    }
    phase_prep<3>(p, p.in[I_FINAL], 0);
}

extern "C" void kernel_launch(void* const* d_in, const int* in_sizes, int n_in, void* d_out, int out_size, void* d_ws, size_t ws_size, hipStream_t stream) {
    if (n_in != 34 || out_size != T * D || ws_size < WS_NEED) { fprintf(stderr, "kernel_launch: unexpected shapes (n_in %d out %d ws %zu need %zu)\n", n_in, out_size, ws_size, (size_t)WS_NEED); return; }
    static int grid_blocks = 0;
    if (!grid_blocks) {
        int dev = 0, cus = 0, per_cu = 0;
        (void)hipGetDevice(&dev);
        (void)hipDeviceGetAttribute(&cus, hipDeviceAttributeMultiprocessorCount, dev);
        (void)hipFuncSetAttribute((const void*)mega, hipFuncAttributeMaxDynamicSharedMemorySize, LDS_BYTES + 16);
        (void)hipOccupancyMaxActiveBlocksPerMultiprocessor(&per_cu, mega, 256, LDS_BYTES + 16);
        if (per_cu < 1) per_cu = 1;
        if (per_cu > 2) per_cu = 2;
        grid_blocks = cus * per_cu;
    }
    P p{};
    for (int i = 0; i < 34; ++i) p.in[i] = (const float*)d_in[i];
    p.out = (float*)d_out; p.ws = (unsigned char*)d_ws;
    (void)hipMemsetAsync((char*)d_ws + WS_CTL, 0, 65536, stream);
    void* args[] = {&p};
    hipError_t e = hipLaunchCooperativeKernel((void*)mega, dim3(grid_blocks), dim3(256), args, LDS_BYTES + 16, stream);
    if (e != hipSuccess) fprintf(stderr, "cooperative launch failed: %s (grid %d)\n", hipGetErrorString(e), grid_blocks);
}
```

```cpp
#include <hip/hip_runtime.h>
#include <cstdio>
#include <cstdint>
#include <cmath>
#include <hip/hip_cooperative_groups.h>
namespace cg = cooperative_groups;

typedef unsigned short bf16_t;
typedef short bf16x8 __attribute__((ext_vector_type(8)));
typedef float f32x4 __attribute__((ext_vector_type(4)));
typedef unsigned u32x4 __attribute__((ext_vector_type(4)));
typedef unsigned u32x2 __attribute__((ext_vector_type(2)));
#define DI __device__ __forceinline__

constexpr int T = 16384, SEQ = 4096, BATCH = 4, D = 1024;
constexpr int EVC = 3784, EVLD = 3784, EVPAD = 3840;
constexpr int ODC = 4608;
constexpr int RW0 = 2056;
constexpr int C_R = 2056, C_K = 2568, C_V = 3080, C_HW = 3592, C_HA = 3624, C_HG = 3656, C_HV = 3752;
constexpr int NEXP = 16, FF = 256;
constexpr int HROWS = 34816;

constexpr size_t WS_CTL = 0;
constexpr size_t CTL_EGL = 4096;
constexpr size_t CTL_CUTAB = 8192;
constexpr size_t CTL_QUEUE = 49152;
constexpr size_t CTL_CNT = 32768;
constexpr size_t CTL_BAR = 16384;
constexpr size_t WS_LIST = 65536;
constexpr size_t WS_GATE = WS_LIST + 16 * 16384 * 4;
constexpr size_t WS_RK = WS_GATE + 16 * 16384 * 4;
constexpr size_t WS_SSQ = WS_RK + (size_t)T * 8 * 4;
constexpr size_t WS_ROPE = WS_SSQ + (size_t)16 * T * 4;
constexpr size_t WS_W = WS_ROPE + (size_t)T * 32 * 8;
constexpr size_t W_IN = 0;
constexpr size_t W_OUT = (size_t)4608 * 1024 * 2;
constexpr size_t W_13 = W_OUT + (size_t)1024 * 1024 * 2;
constexpr size_t W_2 = W_13 + (size_t)16 * 512 * 1024 * 2;
constexpr size_t W_LW = W_2 + (size_t)16 * 1024 * 256 * 2;
constexpr size_t W_BYTES = W_LW + (size_t)512 * 192 * 2;
constexpr size_t WS_XB = WS_W + W_BYTES;
constexpr size_t WS_HN = WS_XB;
constexpr size_t WS_VF = WS_HN + (size_t)T * 1024 * 2;
constexpr size_t WS_R2 = WS_VF + (size_t)T * 512 * 2;
constexpr size_t WS_PROJ = WS_R2;
constexpr size_t WS_GOPS = WS_R2 + (size_t)T * EVLD * 2;
constexpr size_t GOPS_CH = 73728, GO_UF = 0, GO_WF = 16384, GO_QF = 32768, GO_AF = 49152, GO_KF = 57344;
constexpr size_t WS_ROPS = WS_GOPS + 1024 * GOPS_CH;
constexpr size_t WS_QK = WS_R2;
constexpr size_t WS_VT = WS_QK + (size_t)T * 3072 * 2;
constexpr size_t WS_OG = WS_VT + (size_t)T * 1536 * 2;
constexpr size_t WS_LSE = WS_OG + (size_t)3 * T * 512 * 2;
constexpr size_t WS_END3 = WS_LSE + (size_t)3 * T * 8 * 4;
constexpr size_t WS_YS = WS_R2;
constexpr size_t WS_H = WS_YS + (size_t)2 * T * 1024 * 2;
constexpr size_t WS_GG = WS_ROPS + (size_t)2048 * 16384;
constexpr size_t WS_END0 = WS_GG + (size_t)T * 512 * 2;
constexpr size_t WS_END1 = WS_H + (size_t)HROWS * 256 * 2;
constexpr size_t WS_END2 = WS_R2 + (size_t)T * 4608 * 2;
static_assert(WS_END3 <= WS_END0, "odd-layer regions exceed even-layer footprint");
constexpr size_t WS_END = WS_END0 > WS_END1 ? (WS_END0 > WS_END2 ? WS_END0 : WS_END2) : (WS_END1 > WS_END2 ? WS_END1 : WS_END2);

constexpr size_t WS_RSL = WS_END;
constexpr size_t WS_RSIN = WS_RSL + 16 * 16384 * 4;
constexpr size_t WS_NEED = WS_RSIN + (size_t)T * 4;
constexpr size_t WS_DUMMY = WS_END0;
struct P {
    const float* in[34];
    float* out;
    unsigned char* ws;
};
enum { I_X = 0, I_POS, I_EVNORM, I_EVWIN, I_VRESDOWN, I_EVWOUT, I_CONVW, I_ALOG, I_DTB, I_GDNNORM, I_MU, I_W0, I_W2, I_A0, I_A2, I_G2,
       I_KK, I_KA, I_RK, I_LNW, I_LNB, I_VRESMU, I_V0, I_V2, I_ODNORM, I_ODWIN, I_ODWOUT, I_FFNNORM, I_WGROUP, I_WEXPERT, I_W1, I_W3, I_MW2, I_FINAL };

DI int tidx() { int t = threadIdx.x; asm volatile("" : "+v"(t)); return t; }
DI int bidx() { int b = blockIdx.x; asm volatile("" : "+s"(b)); return b; }
typedef __bf16 bf2_t __attribute__((ext_vector_type(2)));
typedef float f2_t __attribute__((ext_vector_type(2)));
DI bf16_t f2bf(float x) { return __builtin_bit_cast(bf16_t, (__bf16)x); }
DI float bf2f(bf16_t h) { return __uint_as_float(((unsigned)h) << 16); }
DI unsigned pack2(float lo, float hi) { const f2_t v = {lo, hi}; return __builtin_bit_cast(unsigned, __builtin_convertvector(v, bf2_t)); }
DI float wave_sum(float v) {
#pragma unroll
    for (int o = 32; o > 0; o >>= 1) v += __shfl_xor(v, o);
    return v;
}
DI float wave_max(float v) {
#pragma unroll
    for (int o = 32; o > 0; o >>= 1) v = fmaxf(v, __shfl_xor(v, o));
    return v;
}
DI float sigmoidf_(float x) { return __builtin_amdgcn_rcpf(1.f + __expf(-x)); }
DI float siluf_(float x) { return x * __builtin_amdgcn_rcpf(1.f + __expf(-x)); }
DI float softplusf_(float x) { return fmaxf(x, 0.f) + __logf(1.f + __expf(-fabsf(x))); }

struct ConvJob { const float* src; bf16_t* dst; int K, N, ldd; int mode; const float* ks = nullptr; };
DI int rowmap(int mode, int n) { return mode == 0 ? n : ((n >> 4) * 32 + (n & 15) + (mode == 2 ? 16 : 0)); }
DI void conv_tile(const ConvJob& j, int tile, float* lds  ) {
    const int ntn = (j.N + 255) / 256;
    const int tk = tile / ntn, tn = tile % ntn;
    const int tid = tidx();
    __syncthreads();
    float4 v[16];
#pragma unroll
    for (int i = 0; i < 16; ++i) {
        const int e = tid + i * 256, k = e >> 6, n4 = (e & 63) * 4;
        const int gk = tk * 64 + k, gn = tn * 256 + n4;
        v[i] = make_float4(0.f, 0.f, 0.f, 0.f);
        if (gn < j.N) { const f32x4 w4 = __builtin_nontemporal_load((const f32x4*)(j.src + (size_t)gk * j.N + gn)); v[i] = make_float4(w4[0], w4[1], w4[2], w4[3]); }
    }
    if (j.ks) {
        float sc[16];
#pragma unroll
        for (int i = 0; i < 16; ++i) sc[i] = j.ks[tk * 64 + (tid >> 6) + 4 * i];
#pragma unroll
        for (int i = 0; i < 16; ++i) { v[i].x *= sc[i]; v[i].y *= sc[i]; v[i].z *= sc[i]; v[i].w *= sc[i]; }
    }
#pragma unroll
    for (int i = 0; i < 16; ++i) { const int e = tid + i * 256, k = e >> 6, n4 = (e & 63) * 4; *(float4*)(lds + k * 260 + n4) = v[i]; }
    __syncthreads();
#pragma unroll
    for (int i = 0; i < 8; ++i) {
        const int n = tid, k8 = i * 8;
        const int gn = tn * 256 + n;
        if (gn < j.N) {
            u32x4 w;
            w.x = pack2(lds[(k8 + 0) * 260 + n], lds[(k8 + 1) * 260 + n]); w.y = pack2(lds[(k8 + 2) * 260 + n], lds[(k8 + 3) * 260 + n]);
            w.z = pack2(lds[(k8 + 4) * 260 + n], lds[(k8 + 5) * 260 + n]); w.w = pack2(lds[(k8 + 6) * 260 + n], lds[(k8 + 7) * 260 + n]);
            *(u32x4*)(j.dst + (size_t)rowmap(j.mode, gn) * j.ldd + tk * 64 + k8) = w;
        }
    }
}
DI void phase_convert_io(const P& p, int layer, char* ldsc, int b0, int bs) {
    float* lds = (float*)ldsc;
    unsigned char* W = p.ws + WS_W;
    const int li = layer >> 1;
    if ((layer & 1) == 0) {
        const float* ng = p.in[I_EVNORM] + li * 1024;
        const ConvJob j0{p.in[I_EVWIN] + (size_t)li * 1024 * 3752, (bf16_t*)(W + W_IN), 1024, 3752, 1024, 0, ng};
        for (int t = b0; t < 16 * 15; t += bs) conv_tile(j0, t, lds);
        if (li == 1) {
            const ConvJob j1{p.in[I_VRESDOWN], (bf16_t*)(W + W_IN) + (size_t)3752 * 1024, 1024, 32, 1024, 0, ng};
            for (int t = b0; t < 16; t += bs) conv_tile(j1, t, lds);
        }
        const ConvJob j2{p.in[I_EVWOUT] + (size_t)li * 1024 * 1024, (bf16_t*)(W + W_OUT), 1024, 1024, 1024, 0};
        for (int t = b0; t < 16 * 4; t += bs) conv_tile(j2, t, lds);
        {
            bf16_t* LW = (bf16_t*)(W + W_LW);
            for (int i = b0 * 256 + tidx(); i < 512 * 192; i += bs * 256) {
                const int ch = i / 192, j = i % 192;
                float v;
                if (j < 32) v = p.in[I_W2][((size_t)li * 32 + j) * 512 + ch];
                else if (j < 64) v = p.in[I_A2][((size_t)li * 32 + j - 32) * 512 + ch];
                else if (j < 160) v = p.in[I_G2][((size_t)li * 96 + j - 64) * 512 + ch];
                else v = (li == 1) ? p.in[I_V2][(size_t)(j - 160) * 512 + ch] : 0.f;
                LW[i] = f2bf(v);
            }
        }
        const int r0 = (li == 1) ? 3784 : 3752;
        bf16_t* z = (bf16_t*)(W + W_IN) + (size_t)r0 * 1024;
        const size_t n = (size_t)(EVPAD - r0) * 1024;
        for (size_t i = (size_t)b0 * 256 + tidx(); i < n; i += (size_t)bs * 256) z[i] = 0;
    } else {
        const ConvJob j0{p.in[I_ODWIN] + (size_t)li * 1024 * 4608, (bf16_t*)(W + W_IN), 1024, 4608, 1024, 0, p.in[I_ODNORM] + li * 1024};
        for (int t = b0; t < 16 * 18; t += bs) conv_tile(j0, t, lds);
        const ConvJob j2{p.in[I_ODWOUT] + (size_t)li * 512 * 1024, (bf16_t*)(W + W_OUT), 512, 1024, 512, 0};
        for (int t = b0; t < 8 * 4; t += bs) conv_tile(j2, t, lds);
    }
}
DI unsigned char* moe_w(const P& p, int layer) { return (layer & 1) ? (unsigned char*)p.out + ((size_t)32 << 20) - W_13 : p.ws + WS_W; }
DI void convert_moe_tile(const P& p, int layer, char* ldsc, int t);
DI void phase_convert_moe(const P& p, int layer, char* ldsc, int b0, int bs) {
    for (int t = b0; t < 16 * 3 * 16; t += bs) convert_moe_tile(p, layer, ldsc, t);
}
DI void convert_moe_tile(const P& p, int layer, char* ldsc, int t) {
    float* lds = (float*)ldsc;
    unsigned char* W = moe_w(p, layer);
    {
        const int e = t / 48, r = t % 48, which = r / 16, tile = r % 16;
        ConvJob j;
        const float* fg = p.in[I_FFNNORM] + layer * 1024;
        if (which == 0) j = ConvJob{p.in[I_W1] + ((size_t)layer * 16 + e) * 1024 * 256, (bf16_t*)(W + W_13) + (size_t)e * 512 * 1024, 1024, 256, 1024, 1, fg};
        else if (which == 1) j = ConvJob{p.in[I_W3] + ((size_t)layer * 16 + e) * 1024 * 256, (bf16_t*)(W + W_13) + (size_t)e * 512 * 1024, 1024, 256, 1024, 2, fg};
        else j = ConvJob{p.in[I_MW2] + ((size_t)layer * 16 + e) * 256 * 1024, (bf16_t*)(W + W_2) + (size_t)e * 1024 * 256, 256, 1024, 256, 0};
        conv_tile(j, tile, lds);
    }
}

DI void phase_rope(const P& p) {
    float2* tab = (float2*)(p.ws + WS_ROPE);
    const int* pos = (const int*)p.in[I_POS];
    for (int i = bidx() * 256 + tidx(); i < T * 32; i += gridDim.x * 256) {
        const int t = i >> 5, f = i & 31;
        const float inv = powf(10000.0f, -(float)f * (2.0f / 64.0f));
        const float ang = (float)pos[t] * inv;
        float s, c; sincosf(ang, &s, &c);
        tab[i] = make_float2(c, s);
    }
}

template <int MODE>
DI void phase_prep(const P& p, const float* gain, int layer) {
    const int lane = tidx() & 63, wid = tidx() >> 6;
    const int nw = gridDim.x * 4;
    bf16_t* hn = (bf16_t*)p.out;
    bf16_t* xb = (bf16_t*)(p.ws + WS_XB);
    const bf16_t* y0 = (const bf16_t*)(p.ws + WS_YS);
    const bf16_t* y1 = y0 + (size_t)T * 1024;
    float4 gq[4];
#pragma unroll
    for (int i = 0; i < 4; ++i) gq[i] = *(const float4*)(gain + i * 256 + lane * 4);
    for (int t = bidx() * 4 + wid; t < T; t += nw) {
        float4 v[4];
        float ss = 0.f;
#pragma unroll
        for (int i = 0; i < 4; ++i) {
            const size_t off = (size_t)t * 1024 + i * 256 + lane * 4;
            if (MODE == 0) { const f32x4 w4 = __builtin_nontemporal_load((const f32x4*)(p.in[I_X] + off)); v[i] = make_float4(w4[0], w4[1], w4[2], w4[3]); }
            else { const u32x2 xx = *(const u32x2*)(xb + off); v[i].x = __uint_as_float(xx.x << 16); v[i].y = __uint_as_float(xx.x & 0xffff0000u); v[i].z = __uint_as_float(xx.y << 16); v[i].w = __uint_as_float(xx.y & 0xffff0000u); }
            if (MODE == 1 || MODE == 3) {
                const u32x2 a = __builtin_nontemporal_load((const u32x2*)(y0 + off)), b = __builtin_nontemporal_load((const u32x2*)(y1 + off));
                v[i].x += __uint_as_float(a.x << 16) + __uint_as_float(b.x << 16); v[i].y += __uint_as_float(a.x & 0xffff0000u) + __uint_as_float(b.x & 0xffff0000u);
                v[i].z += __uint_as_float(a.y << 16) + __uint_as_float(b.y << 16); v[i].w += __uint_as_float(a.y & 0xffff0000u) + __uint_as_float(b.y & 0xffff0000u);
            }
            ss += v[i].x * v[i].x + v[i].y * v[i].y + v[i].z * v[i].z + v[i].w * v[i].w;
        }
        ss = wave_sum(ss);
        const float rstd = rsqrtf(ss * (1.0f / 1024.0f) + 1e-6f);
        if ((MODE == 0 || MODE == 1) && lane == 0) ((float*)(p.ws + WS_RSIN))[t] = rstd;
        float lg[20];
        if (MODE == 2) {
#pragma unroll
            for (int q = 0; q < 20; ++q) lg[q] = 0.f;
        }
#pragma unroll
        for (int i = 0; i < 4; ++i) {
            const int col = i * 256 + lane * 4;
            const size_t off = (size_t)t * 1024 + col;
            const float4 g = gq[i];
            float4 h; h.x = v[i].x * rstd * g.x; h.y = v[i].y * rstd * g.y; h.z = v[i].z * rstd * g.z; h.w = v[i].w * rstd * g.w;
            bf16_t* hd = hn + off;
            if (MODE == 0 || MODE == 1) { u32x2 w; w.x = pack2(v[i].x, v[i].y); w.y = pack2(v[i].z, v[i].w); *(u32x2*)(xb + off) = w; }
            if (MODE == 3) *(float4*)(p.out + off) = h;
            else if (MODE == 2) { u32x2 w; w.x = pack2(h.x, h.y); w.y = pack2(h.z, h.w); *(u32x2*)hd = w; }
            if (MODE == 2) {
                const float hh[4] = {h.x, h.y, h.z, h.w};
                const float* wg = p.in[I_WGROUP] + (size_t)layer * 1024 * 4;
                const float* we = p.in[I_WEXPERT] + (size_t)layer * 4 * 1024 * 4;
#pragma unroll
                for (int e = 0; e < 4; ++e) {
                    const float4 a = *(const float4*)(wg + (size_t)(col + e) * 4);
                    lg[0] += hh[e] * a.x; lg[1] += hh[e] * a.y; lg[2] += hh[e] * a.z; lg[3] += hh[e] * a.w;
#pragma unroll
                    for (int g2 = 0; g2 < 4; ++g2) {
                        const float4 b = *(const float4*)(we + ((size_t)g2 * 1024 + col + e) * 4);
                        lg[4 + g2 * 4 + 0] += hh[e] * b.x; lg[4 + g2 * 4 + 1] += hh[e] * b.y; lg[4 + g2 * 4 + 2] += hh[e] * b.z; lg[4 + g2 * 4 + 3] += hh[e] * b.w;
                    }
                }
            }
        }
        if (MODE == 2) {
#pragma unroll
            for (int q = 0; q < 20; ++q) lg[q] = wave_sum(lg[q]);
            if (lane == 0) {
                int gs = 0; float gm = lg[0];
#pragma unroll
                for (int g2 = 1; g2 < 4; ++g2) if (lg[g2] > gm) { gm = lg[g2]; gs = g2; }
                float den = 0.f;
#pragma unroll
                for (int g2 = 0; g2 < 4; ++g2) den += __expf(lg[g2] - gm);
                const float pg = 1.f / den;
                float el[4];
#pragma unroll
                for (int e = 0; e < 4; ++e) el[e] = gs == 0 ? lg[4 + e] : gs == 1 ? lg[8 + e] : gs == 2 ? lg[12 + e] : lg[16 + e];
                int i1 = 0; float v1 = el[0];
#pragma unroll
                for (int e = 1; e < 4; ++e) if (el[e] > v1) { v1 = el[e]; i1 = e; }
                int i2 = 0; float v2 = -3.4e38f;
#pragma unroll
                for (int e = 0; e < 4; ++e) if (e != i1 && el[e] > v2) { v2 = el[e]; i2 = e; }
                const float e2 = __expf(v2 - v1);
                const float g1 = pg / (1.f + e2), g2v = pg * e2 / (1.f + e2);
                unsigned* cnt = (unsigned*)(p.ws + WS_CTL + CTL_CNT) + layer * 16 * 64;
                int* list = (int*)(p.ws + WS_LIST);
                float* gl = (float*)(p.ws + WS_GATE);
                const int ea = gs * 4 + i1, eb = gs * 4 + i2;
                const unsigned ra = atomicAdd(&cnt[ea * 64], 1u);
                list[ea * 16384 + ra] = t * 2; gl[ea * 16384 + ra] = g1;
                const unsigned rb = atomicAdd(&cnt[eb * 64], 1u);
                list[eb * 16384 + rb] = t * 2 + 1; gl[eb * 16384 + rb] = g2v;
            }
        }
    }
}


typedef __attribute__((address_space(3))) unsigned lds_u32;
DI void g_dma(unsigned m0v, unsigned voff, const char* sbase) {
    asm volatile("s_mov_b32 m0, %0\n\ts_nop 0\n\tglobal_load_lds_dwordx4 %1, %2" :: "s"(m0v), "v"(voff), "s"(sbase) : "memory", "m0");
}
DI void phase_router(const P& p, const float* gain, int layer, char* ldsc) {
    const int tid = tidx(), lane = tid & 63, wid = tid >> 6;
    const bf16_t* xb = (const bf16_t*)(p.ws + WS_XB);
    const float* wg = p.in[I_WGROUP] + (size_t)layer * 1024 * 4;
    const float* we = p.in[I_WEXPERT] + (size_t)layer * 4 * 1024 * 4;
    unsigned* cnt = (unsigned*)(p.ws + WS_CTL + CTL_CNT) + layer * 16 * 64;
    int* list = (int*)(p.ws + WS_LIST);
    float* gl = (float*)(p.ws + WS_GATE);
    float* rsl = (float*)(p.ws + WS_RSL);
    f32x4* WS = (f32x4*)ldsc;
    unsigned* lcnt = (unsigned*)(ldsc + 40960); unsigned* lbase = lcnt + 16; int* e_ent = (int*)(lcnt + 32); unsigned* r_ent = (unsigned*)(e_ent + 32); int* t_ent = (int*)(r_ent + 32); float* g_ent = (float*)(t_ent + 32); float* rs_ent = g_ent + 32;
    const unsigned wsb = (unsigned)__builtin_amdgcn_readfirstlane((int)((unsigned)(size_t)(lds_u32*)ldsc + wid * 1024));
    auto stage = [&](int i, int buf) {
        const unsigned voff = (unsigned)(i * 256 + lane * 4 + wid) * 16u;
#pragma unroll
        for (int r = 0; r < 5; ++r) g_dma(wsb + (unsigned)(buf * 1280 + r * 256) * 16u, voff, (const char*)(r == 0 ? wg : we + (size_t)(r - 1) * 4096));
    };
    u32x2 xq[4];
#pragma unroll
    for (int q = 0; q < 4; ++q) xq[q] = *(const u32x2*)(xb + (size_t)(bidx() * 16 + wid * 4 + q) * 1024 + lane * 4);
    for (int tb = bidx() * 16; tb < T; tb += gridDim.x * 16) {
        const int t0 = tb + wid * 4;
        __syncthreads();
        if (tid < 16) lcnt[tid] = 0u;
        stage(0, 0);
        float rstd[4];
        {
            const float pq = ((const float*)(p.ws + WS_SSQ))[(size_t)(lane & 15) * T + t0 + (lane >> 4)];
            float ss = pq;
            ss += __shfl_xor(ss, 1); ss += __shfl_xor(ss, 2); ss += __shfl_xor(ss, 4); ss += __shfl_xor(ss, 8);
#pragma unroll
            for (int q = 0; q < 4; ++q) rstd[q] = rsqrtf(__shfl(ss, q * 16) * (1.0f / 1024.0f) + 1e-6f);
        }
        float lg[4][20];
#pragma unroll
        for (int q = 0; q < 4; ++q)
#pragma unroll
            for (int j = 0; j < 20; ++j) lg[q][j] = 0.f;
#pragma unroll 1
        for (int i = 0; i < 4; ++i) {
            asm volatile("s_waitcnt vmcnt(0)" ::: "memory");
            __syncthreads();
            if (i + 1 < 4) stage(i + 1, (i + 1) & 1);
            const f32x4* W = WS + (i & 1) * 1280;
            const int col = i * 256 + lane * 4;
            const float4 g = *(const float4*)(gain + col);
            float hh[4][4];
#pragma unroll
            for (int q = 0; q < 4; ++q) {
                hh[q][0] = __uint_as_float(xq[q].x << 16) * rstd[q] * g.x; hh[q][1] = __uint_as_float(xq[q].x & 0xffff0000u) * rstd[q] * g.y; hh[q][2] = __uint_as_float(xq[q].y << 16) * rstd[q] * g.z; hh[q][3] = __uint_as_float(xq[q].y & 0xffff0000u) * rstd[q] * g.w;
            }
            {
                int tn0 = i + 1 < 4 ? t0 : t0 + (int)gridDim.x * 16; const int cn = ((i + 1) & 3) * 256 + lane * 4;
                tn0 = tn0 < T ? tn0 : t0;
#pragma unroll
                for (int q = 0; q < 4; ++q) xq[q] = *(const u32x2*)(xb + (size_t)(tn0 + q) * 1024 + cn);
            }
#pragma unroll
            for (int e = 0; e < 4; ++e) {
                const f32x4 a = W[(0 * 4 + e) * 64 + lane];
#pragma unroll
                for (int q = 0; q < 4; ++q) { lg[q][0] += hh[q][e] * a[0]; lg[q][1] += hh[q][e] * a[1]; lg[q][2] += hh[q][e] * a[2]; lg[q][3] += hh[q][e] * a[3]; }
#pragma unroll
                for (int g2 = 0; g2 < 4; ++g2) {
                    const f32x4 b = W[((1 + g2) * 4 + e) * 64 + lane];
#pragma unroll
                    for (int q = 0; q < 4; ++q) { lg[q][4 + g2 * 4] += hh[q][e] * b[0]; lg[q][5 + g2 * 4] += hh[q][e] * b[1]; lg[q][6 + g2 * 4] += hh[q][e] * b[2]; lg[q][7 + g2 * 4] += hh[q][e] * b[3]; }
                }
            }
        }
        {
            float v[80];
#pragma unroll
            for (int q = 0; q < 4; ++q)
#pragma unroll
                for (int j = 0; j < 20; ++j) v[q * 20 + j] = lg[q][j];
#define RT_STEP(MASK, H)                                                                                        \
            { const bool hi = (lane & (MASK)) != 0;                                                             \
              _Pragma("unroll") for (int i = 0; i < (H); ++i) {                                                 \
                  const float a = v[i], b = v[i + (H)];                                                         \
                  const float r = __shfl_xor(hi ? a : b, (MASK));                                               \
                  v[i] = (hi ? b : a) + r; } }
            RT_STEP(32, 40) RT_STEP(16, 20) RT_STEP(8, 10) RT_STEP(4, 5)
            v[5] = 0.f;
            RT_STEP(2, 3)
            v[3] = 0.f;
            RT_STEP(1, 2)
#undef RT_STEP
            float* red = rs_ent + 32 + wid * 80;
#pragma unroll
            for (int j = 0; j < 2; ++j) {
                const int a = j + ((lane & 1) ? 2 : 0), b = a + ((lane & 2) ? 3 : 0);
                const int f = b + ((lane & 4) ? 5 : 0) + ((lane & 8) ? 10 : 0) + ((lane & 16) ? 20 : 0) + ((lane & 32) ? 40 : 0);
                if (a < 3 && b < 5) red[f] = v[j];
            }
            if (lane < 4) {
                float lq[20];
#pragma unroll
                for (int j = 0; j < 20; ++j) lq[j] = red[lane * 20 + j];
                const float rsq = lane == 0 ? rstd[0] : lane == 1 ? rstd[1] : lane == 2 ? rstd[2] : rstd[3];
                const int t = t0 + lane;
                int gs = 0; float gm = lq[0];
#pragma unroll
                for (int g2 = 1; g2 < 4; ++g2) if (lq[g2] > gm) { gm = lq[g2]; gs = g2; }
                float den = 0.f;
#pragma unroll
                for (int g2 = 0; g2 < 4; ++g2) den += __expf(lq[g2] - gm);
                const float pg = 1.f / den;
                float el[4];
#pragma unroll
                for (int e = 0; e < 4; ++e) el[e] = gs == 0 ? lq[4 + e] : gs == 1 ? lq[8 + e] : gs == 2 ? lq[12 + e] : lq[16 + e];
                int i1 = 0; float v1 = el[0];
#pragma unroll
                for (int e = 1; e < 4; ++e) if (el[e] > v1) { v1 = el[e]; i1 = e; }
                int i2 = 0; float v2 = -3.4e38f;
#pragma unroll
                for (int e = 0; e < 4; ++e) if (e != i1 && el[e] > v2) { v2 = el[e]; i2 = e; }
                const float e2 = __expf(v2 - v1);
                const float g1 = pg / (1.f + e2), g2v = pg * e2 / (1.f + e2);
                const int ea = gs * 4 + i1, eb = gs * 4 + i2;
                const int sl = (wid * 4 + lane) * 2;
                e_ent[sl] = ea; r_ent[sl] = atomicAdd(&lcnt[ea], 1u); t_ent[sl] = t * 2; g_ent[sl] = g1; rs_ent[sl] = rsq;
                e_ent[sl + 1] = eb; r_ent[sl + 1] = atomicAdd(&lcnt[eb], 1u); t_ent[sl + 1] = t * 2 + 1; g_ent[sl + 1] = g2v; rs_ent[sl + 1] = rsq;
            }
        }
        __syncthreads();
        if (tid < 16) lbase[tid] = lcnt[tid] ? atomicAdd(&cnt[tid * 64], lcnt[tid]) : 0u;
        __syncthreads();
        if (tid < 32) {
            const int e = e_ent[tid];
            const unsigned pos = (lbase[e] + r_ent[tid]) & 16383u;
            list[e * 16384 + pos] = t_ent[tid]; gl[e * 16384 + pos] = g_ent[tid]; rsl[e * 16384 + pos] = rs_ent[tid];
        }
    }
}

constexpr int GBK = 64;
struct TileP { int arow[4]; unsigned bo[4]; };
struct GOps { const char* A; unsigned la; const char* A2; unsigned la2; const char* B; };
DI void gemm_core(const GOps& o, const TileP& tp, int K, char* lds, f32x4 (&acc)[4][4], int ksplit, bool primed, const TileP& nx, bool have_nx, bool primed1, bool pre1) {
    const int tid = tidx(), wid = tid >> 6, lane = tid & 63, wr = wid >> 1, wc = wid & 1, fr = lane & 15, fq = lane >> 4;
    const unsigned scol = ((tid & 7) ^ ((tid >> 3) & 7)) * 16;
#pragma unroll
    for (int n = 0; n < 4; ++n)
#pragma unroll
        for (int m = 0; m < 4; ++m) acc[n][m] = (f32x4){0.f, 0.f, 0.f, 0.f};
    const int nk = K / GBK;
    if (!primed) {
        __syncthreads();
#pragma unroll
        for (int i = 0; i < 4; ++i) {
            __builtin_amdgcn_global_load_lds((const unsigned*)(o.A + (__umul24(tp.arow[i], o.la) + scol)), (lds_u32*)(lds + tid * 16 + i * 4096), 16, 0, 0);
            __builtin_amdgcn_global_load_lds((const unsigned*)(o.B + (tp.bo[i] + scol)), (lds_u32*)(lds + 16384 + tid * 16 + i * 4096), 16, 0, 0);
        }
    }
    const int sw = fr & 7;
    const unsigned aoff = (wr * 64 + fr) * 128, boff = (wc * 64 + fr) * 128, co0 = (fq ^ sw) * 16, co1 = ((4 + fq) ^ sw) * 16;
    bf16x8 a0[4], b0[4], a1[4], b1[4];
#define G_ISSUE(kt_)                                                                                                                        \
    if ((kt_) + 1 < nk) {                                                                                                                   \
        char* nb = lds + (((kt_) + 1) & 1) * 32768;                                                                                         \
        const unsigned ko = ((kt_) + 1) * (GBK * 2) + scol;                                                                                 \
        const bool hi = ((kt_) + 1) * GBK >= ksplit;                                                                                        \
        const char* Ab = hi ? o.A2 : o.A; const unsigned la = hi ? o.la2 : o.la;                                                            \
        _Pragma("unroll") for (int i = 0; i < 4; ++i) {                                                                                     \
            __builtin_amdgcn_global_load_lds((const unsigned*)(Ab + (__umul24(tp.arow[i], la) + ko)), (lds_u32*)(nb + tid * 16 + i * 4096), 16, 0, 0);   \
            __builtin_amdgcn_global_load_lds((const unsigned*)(o.B + (tp.bo[i] + ko)), (lds_u32*)(nb + 16384 + tid * 16 + i * 4096), 16, 0, 0);      \
        }                                                                                                                                   \
    } else if (have_nx) {        \
        _Pragma("unroll") for (int i = 0; i < 4; ++i) {                                                                                     \
            __builtin_amdgcn_global_load_lds((const unsigned*)(o.A + (__umul24(nx.arow[i], o.la) + scol)), (lds_u32*)(lds + tid * 16 + i * 4096), 16, 0, 0);          \
            __builtin_amdgcn_global_load_lds((const unsigned*)(o.B + (nx.bo[i] + scol)), (lds_u32*)(lds + 16384 + tid * 16 + i * 4096), 16, 0, 0);  \
        }                                                                                                                                   \
    }
#define G_READ(A_, B_, AD_)                                                                                                                 \
    asm volatile("ds_read_b128 %0, %8\n\tds_read_b128 %1, %8 offset:2048\n\tds_read_b128 %2, %8 offset:4096\n\tds_read_b128 %3, %8 offset:6144\n\t"       \
                 "ds_read_b128 %4, %9 offset:16384\n\tds_read_b128 %5, %9 offset:18432\n\tds_read_b128 %6, %9 offset:20480\n\tds_read_b128 %7, %9 offset:22528" \
                 : "=&v"(A_[0]), "=&v"(A_[1]), "=&v"(A_[2]), "=&v"(A_[3]), "=&v"(B_[0]), "=&v"(B_[1]), "=&v"(B_[2]), "=&v"(B_[3]) : "v"((AD_) + aoff), "v"((AD_) + boff) : "memory");
#define G_WAIT(A_, B_, N_)                                                                                                                  \
    asm volatile("s_waitcnt lgkmcnt(" #N_ ")" : "+v"(A_[0]), "+v"(A_[1]), "+v"(A_[2]), "+v"(A_[3]), "+v"(B_[0]), "+v"(B_[1]), "+v"(B_[2]), "+v"(B_[3]) :: "memory");
#define G_MMA(A_, B_)                                                                                                                       \
    _Pragma("unroll") for (int n = 0; n < 4; ++n)                                                                                           \
        _Pragma("unroll") for (int m = 0; m < 4; ++m) acc[n][m] = __builtin_amdgcn_mfma_f32_16x16x32_bf16(B_[n], A_[m], acc[n][m], 0, 0, 0);
    const unsigned lbase = (unsigned)(size_t)(lds_u32*)lds;
    __builtin_amdgcn_s_waitcnt(0x0070);
    __builtin_amdgcn_s_barrier();
    if (!primed1) { G_ISSUE(0) }
    G_READ(a0, b0, lbase + co0)
    G_READ(a1, b1, lbase + co1)
    G_WAIT(a0, b0, 8)
    __builtin_amdgcn_sched_barrier(0);
    G_MMA(a0, b0)
    __builtin_amdgcn_sched_barrier(0);
    G_WAIT(a1, b1, 0)
#pragma unroll 1
    for (int kt = 1; kt < nk; ++kt) {
        __builtin_amdgcn_s_waitcnt(0x0070);
        __builtin_amdgcn_s_barrier();
        G_ISSUE(kt)
        const unsigned S = lbase + (kt & 1) * 32768;
        G_READ(a0, b0, S + co0)
        __builtin_amdgcn_sched_barrier(0);
        G_MMA(a1, b1)
        __builtin_amdgcn_sched_barrier(0);
        G_READ(a1, b1, S + co1)
        G_WAIT(a0, b0, 8)
        __builtin_amdgcn_sched_barrier(0);
        G_MMA(a0, b0)
        __builtin_amdgcn_sched_barrier(0);
        G_WAIT(a1, b1, 0)
    }
    if (have_nx && pre1) {
        __builtin_amdgcn_s_barrier();
        const unsigned ko = GBK * 2 + scol;
        _Pragma("unroll") for (int i = 0; i < 4; ++i) {
            __builtin_amdgcn_global_load_lds((const unsigned*)(o.A + (__umul24(nx.arow[i], o.la) + ko)), (lds_u32*)(lds + 32768 + tid * 16 + i * 4096), 16, 0, 0);
            __builtin_amdgcn_global_load_lds((const unsigned*)(o.B + (nx.bo[i] + ko)), (lds_u32*)(lds + 32768 + 16384 + tid * 16 + i * 4096), 16, 0, 0);
        }
        __builtin_amdgcn_sched_barrier(0);
    }
    G_MMA(a1, b1)
#undef G_ISSUE
#undef G_READ
#undef G_WAIT
#undef G_MMA
}

struct TileP5 { int arow[5]; unsigned bo[4]; };
constexpr int G5A = 20480, G5BUF = 36864;
DI void gemm_core5(const GOps& o, const TileP5& tp, int K, char* lds, f32x4 (&acc)[4][5], bool primed, const TileP5& nx, bool have_nx) {
    const int tid = tidx(), wid = tid >> 6, lane = tid & 63, wr = wid >> 1, wc = wid & 1, fr = lane & 15, fq = lane >> 4;
    const unsigned scol = ((tid & 7) ^ ((tid >> 3) & 7)) * 16;
#pragma unroll
    for (int n = 0; n < 4; ++n)
#pragma unroll
        for (int m = 0; m < 5; ++m) acc[n][m] = (f32x4){0.f, 0.f, 0.f, 0.f};
    const int nk = K / GBK;
    if (!primed) {
        __syncthreads();
#pragma unroll
        for (int i = 0; i < 5; ++i) __builtin_amdgcn_global_load_lds((const unsigned*)(o.A + (__umul24(tp.arow[i], o.la) + scol)), (lds_u32*)(lds + tid * 16 + i * 4096), 16, 0, 0);
#pragma unroll
        for (int i = 0; i < 4; ++i) __builtin_amdgcn_global_load_lds((const unsigned*)(o.B + (tp.bo[i] + scol)), (lds_u32*)(lds + G5A + tid * 16 + i * 4096), 16, 0, 0);
    }
    const int sw = fr & 7;
    const unsigned aoff = (wr * 80 + fr) * 128, boff = G5A + (wc * 64 + fr) * 128, co0 = (fq ^ sw) * 16, co1 = ((4 + fq) ^ sw) * 16;
    bf16x8 a0[5], b0[4], a1[5], b1[4];
#define G_ISSUE(kt_)                                                                                                                        \
    if ((kt_) + 1 < nk) {                                                                                                                   \
        char* nb = lds + (((kt_) + 1) & 1) * G5BUF;                                                                                         \
        const unsigned ko = ((kt_) + 1) * (GBK * 2) + scol;                                                                                 \
        _Pragma("unroll") for (int i = 0; i < 5; ++i) __builtin_amdgcn_global_load_lds((const unsigned*)(o.A + (__umul24(tp.arow[i], o.la) + ko)), (lds_u32*)(nb + tid * 16 + i * 4096), 16, 0, 0); \
        _Pragma("unroll") for (int i = 0; i < 4; ++i) __builtin_amdgcn_global_load_lds((const unsigned*)(o.B + (tp.bo[i] + ko)), (lds_u32*)(nb + G5A + tid * 16 + i * 4096), 16, 0, 0); \
    } else if (have_nx) {                                                                                                                   \
        _Pragma("unroll") for (int i = 0; i < 5; ++i) __builtin_amdgcn_global_load_lds((const unsigned*)(o.A + (__umul24(nx.arow[i], o.la) + scol)), (lds_u32*)(lds + tid * 16 + i * 4096), 16, 0, 0); \
        _Pragma("unroll") for (int i = 0; i < 4; ++i) __builtin_amdgcn_global_load_lds((const unsigned*)(o.B + (nx.bo[i] + scol)), (lds_u32*)(lds + G5A + tid * 16 + i * 4096), 16, 0, 0); \
    }
#define G_READ(A_, B_, AD_)                                                                                                                 \
    asm volatile("ds_read_b128 %0, %9\n\tds_read_b128 %1, %9 offset:2048\n\tds_read_b128 %2, %9 offset:4096\n\tds_read_b128 %3, %9 offset:6144\n\tds_read_b128 %4, %9 offset:8192\n\t" \
                 "ds_read_b128 %5, %10\n\tds_read_b128 %6, %10 offset:2048\n\tds_read_b128 %7, %10 offset:4096\n\tds_read_b128 %8, %10 offset:6144"  \
                 : "=&v"(A_[0]), "=&v"(A_[1]), "=&v"(A_[2]), "=&v"(A_[3]), "=&v"(A_[4]), "=&v"(B_[0]), "=&v"(B_[1]), "=&v"(B_[2]), "=&v"(B_[3]) : "v"((AD_) + aoff), "v"((AD_) + boff) : "memory");
#define G_WAIT(A_, B_, N_)                                                                                                                  \
    asm volatile("s_waitcnt lgkmcnt(" #N_ ")" : "+v"(A_[0]), "+v"(A_[1]), "+v"(A_[2]), "+v"(A_[3]), "+v"(A_[4]), "+v"(B_[0]), "+v"(B_[1]), "+v"(B_[2]), "+v"(B_[3]) :: "memory");
#define G_MMA(A_, B_)                                                                                                                       \
    _Pragma("unroll") for (int n = 0; n < 4; ++n)                                                                                           \
        _Pragma("unroll") for (int m = 0; m < 5; ++m) acc[n][m] = __builtin_amdgcn_mfma_f32_16x16x32_bf16(B_[n], A_[m], acc[n][m], 0, 0, 0);
    const unsigned lbase = (unsigned)(size_t)(lds_u32*)lds;
    __builtin_amdgcn_s_waitcnt(0x0070);
    __builtin_amdgcn_s_barrier();
    G_ISSUE(0)
    G_READ(a0, b0, lbase + co0)
    G_READ(a1, b1, lbase + co1)
    G_WAIT(a0, b0, 9)
    __builtin_amdgcn_sched_barrier(0);
    G_MMA(a0, b0)
    __builtin_amdgcn_sched_barrier(0);
    G_WAIT(a1, b1, 0)
#pragma unroll 1
    for (int kt = 1; kt < nk; ++kt) {
        __builtin_amdgcn_s_waitcnt(0x0070);
        __builtin_amdgcn_s_barrier();
        G_ISSUE(kt)
        const unsigned S = lbase + (kt & 1) * G5BUF;
        G_READ(a0, b0, S + co0)
        __builtin_amdgcn_sched_barrier(0);
        G_MMA(a1, b1)
        __builtin_amdgcn_sched_barrier(0);
        G_READ(a1, b1, S + co1)
        G_WAIT(a0, b0, 9)
        __builtin_amdgcn_sched_barrier(0);
        G_MMA(a0, b0)
        __builtin_amdgcn_sched_barrier(0);
        G_WAIT(a1, b1, 0)
    }
    G_MMA(a1, b1)
#undef G_ISSUE
#undef G_READ
#undef G_WAIT
#undef G_MMA
}

struct TileN5 { int arow[4]; unsigned bo[5]; };
constexpr int N5A = 16384;
DI void gemm_core5n(const GOps& o, const TileN5& tp, int K, char* lds, f32x4 (&acc)[5][4], bool primed, const TileN5& nx, bool have_nx) {
    const int tid = tidx(), wid = tid >> 6, lane = tid & 63, wr = wid >> 1, wc = wid & 1, fr = lane & 15, fq = lane >> 4;
    const unsigned scol = ((tid & 7) ^ ((tid >> 3) & 7)) * 16;
#pragma unroll
    for (int n = 0; n < 5; ++n)
#pragma unroll
        for (int m = 0; m < 4; ++m) acc[n][m] = (f32x4){0.f, 0.f, 0.f, 0.f};
    const int nk = K / GBK;
    if (!primed) {
        __syncthreads();
#pragma unroll
        for (int i = 0; i < 4; ++i) __builtin_amdgcn_global_load_lds((const unsigned*)(o.A + (__umul24(tp.arow[i], o.la) + scol)), (lds_u32*)(lds + tid * 16 + i * 4096), 16, 0, 0);
#pragma unroll
        for (int i = 0; i < 5; ++i) __builtin_amdgcn_global_load_lds((const unsigned*)(o.B + (tp.bo[i] + scol)), (lds_u32*)(lds + N5A + tid * 16 + i * 4096), 16, 0, 0);
    }
    const int sw = fr & 7;
    const unsigned aoff = (wr * 64 + fr) * 128, boff = N5A + (wc * 80 + fr) * 128, co0 = (fq ^ sw) * 16, co1 = ((4 + fq) ^ sw) * 16;
    bf16x8 a0[4], b0[5], a1[4], b1[5];
#define G_ISSUE(kt_)                                                                                                                        \
    if ((kt_) + 1 < nk) {                                                                                                                   \
        char* nb = lds + (((kt_) + 1) & 1) * G5BUF;                                                                                         \
        const unsigned ko = ((kt_) + 1) * (GBK * 2) + scol;                                                                                 \
        _Pragma("unroll") for (int i = 0; i < 4; ++i) __builtin_amdgcn_global_load_lds((const unsigned*)(o.A + (__umul24(tp.arow[i], o.la) + ko)), (lds_u32*)(nb + tid * 16 + i * 4096), 16, 0, 0); \
        _Pragma("unroll") for (int i = 0; i < 5; ++i) __builtin_amdgcn_global_load_lds((const unsigned*)(o.B + (tp.bo[i] + ko)), (lds_u32*)(nb + N5A + tid * 16 + i * 4096), 16, 0, 0); \
    } else if (have_nx) {                                                                                                                   \
        _Pragma("unroll") for (int i = 0; i < 4; ++i) __builtin_amdgcn_global_load_lds((const unsigned*)(o.A + (__umul24(nx.arow[i], o.la) + scol)), (lds_u32*)(lds + tid * 16 + i * 4096), 16, 0, 0); \
        _Pragma("unroll") for (int i = 0; i < 5; ++i) __builtin_amdgcn_global_load_lds((const unsigned*)(o.B + (nx.bo[i] + scol)), (lds_u32*)(lds + N5A + tid * 16 + i * 4096), 16, 0, 0); \
    }
#define G_READ(A_, B_, AD_)                                                                                                                 \
    asm volatile("ds_read_b128 %0, %9\n\tds_read_b128 %1, %9 offset:2048\n\tds_read_b128 %2, %9 offset:4096\n\tds_read_b128 %3, %9 offset:6144\n\t" \
                 "ds_read_b128 %4, %10\n\tds_read_b128 %5, %10 offset:2048\n\tds_read_b128 %6, %10 offset:4096\n\tds_read_b128 %7, %10 offset:6144\n\tds_read_b128 %8, %10 offset:8192"  \
                 : "=&v"(A_[0]), "=&v"(A_[1]), "=&v"(A_[2]), "=&v"(A_[3]), "=&v"(B_[0]), "=&v"(B_[1]), "=&v"(B_[2]), "=&v"(B_[3]), "=&v"(B_[4]) : "v"((AD_) + aoff), "v"((AD_) + boff) : "memory");
#define G_WAIT(A_, B_, N_)                                                                                                                  \
    asm volatile("s_waitcnt lgkmcnt(" #N_ ")" : "+v"(A_[0]), "+v"(A_[1]), "+v"(A_[2]), "+v"(A_[3]), "+v"(B_[0]), "+v"(B_[1]), "+v"(B_[2]), "+v"(B_[3]), "+v"(B_[4]) :: "memory");
#define G_MMA(A_, B_)                                                                                                                       \
    _Pragma("unroll") for (int n = 0; n < 5; ++n)                                                                                           \
        _Pragma("unroll") for (int m = 0; m < 4; ++m) acc[n][m] = __builtin_amdgcn_mfma_f32_16x16x32_bf16(B_[n], A_[m], acc[n][m], 0, 0, 0);
    const unsigned lbase = (unsigned)(size_t)(lds_u32*)lds;
    __builtin_amdgcn_s_waitcnt(0x0070);
    __builtin_amdgcn_s_barrier();
    G_ISSUE(0)
    G_READ(a0, b0, lbase + co0)
    G_READ(a1, b1, lbase + co1)
    G_WAIT(a0, b0, 9)
    __builtin_amdgcn_sched_barrier(0);
    G_MMA(a0, b0)
    __builtin_amdgcn_sched_barrier(0);
    G_WAIT(a1, b1, 0)
#pragma unroll 1
    for (int kt = 1; kt < nk; ++kt) {
        __builtin_amdgcn_s_waitcnt(0x0070);
        __builtin_amdgcn_s_barrier();
        G_ISSUE(kt)
        const unsigned S = lbase + (kt & 1) * G5BUF;
        G_READ(a0, b0, S + co0)
        __builtin_amdgcn_sched_barrier(0);
        G_MMA(a1, b1)
        __builtin_amdgcn_sched_barrier(0);
        G_READ(a1, b1, S + co1)
        G_WAIT(a0, b0, 9)
        __builtin_amdgcn_sched_barrier(0);
        G_MMA(a0, b0)
        __builtin_amdgcn_sched_barrier(0);
        G_WAIT(a1, b1, 0)
    }
    G_MMA(a1, b1)
#undef G_ISSUE
#undef G_READ
#undef G_WAIT
#undef G_MMA
}

enum { EPI_EVEN_IN = 0, EPI_ODD_IN, EPI_RESID };
template <int EPI>
DI void phase_gemm(const P& p, const bf16_t* A, int lda, const bf16_t* Bt, int K, int ntn, char* lds, bool dry = false, const bf16_t* A2 = nullptr, int lda2 = 0, int ksplit = 1 << 30) {
    const int tid = tidx(), wid = tid >> 6, lane = tid & 63, wr = wid >> 1, wc = wid & 1, fr = lane & 15, fq = lane >> 4;
    const int ntm = T / 128, ntiles = ntm * ntn;
    auto fill = [&](TileP& t, int tile) {
        const int tn = tile / ntm, tm = tile % ntm, r = tid >> 3;
#pragma unroll
        for (int i = 0; i < 4; ++i) { t.arow[i] = tm * 128 + r + 32 * i; t.bo[i] = (unsigned)(tn * 128 + r + 32 * i) * (unsigned)(K * 2); }
    };
    const GOps gop{(const char*)A, (unsigned)lda * 2u, (const char*)(A2 ? A2 : A), (unsigned)(A2 ? lda2 : lda) * 2u, (const char*)Bt};
    TileP cur, nxt;
    bool primed = false, primed1 = false;
    fill(cur, bidx() < ntiles ? bidx() : 0); nxt = cur;
    for (int tile = bidx(); tile < ntiles; tile += gridDim.x) {
        const int tn = tile / ntm, tm = tile % ntm;
        const bool have_next = tile + (int)gridDim.x < ntiles;
        if (have_next) fill(nxt, tile + gridDim.x);
        f32x4 acc[4][4];
        const int m0 = tm * 128 + wr * 64, n0 = tn * 128 + wc * 64;
        float rsr[4];
        if (EPI != EPI_RESID) {
#pragma unroll
            for (int m = 0; m < 4; ++m) rsr[m] = ((const float*)(p.ws + WS_RSIN))[m0 + m * 16 + fr];
        }
        const bool pre1 = have_next && !(EPI == EPI_ODD_IN && tn * 128 >= 3072);
        gemm_core(gop, cur, K, lds, acc, ksplit, primed, nxt, have_next, primed1, pre1);
        primed = have_next; primed1 = pre1; cur = nxt;
        if (EPI != EPI_RESID) {
            const float qs = (EPI == EPI_ODD_IN && n0 < 1536) ? 0.18033688f : 1.0f;
#pragma unroll
            for (int m = 0; m < 4; ++m) {
                const float sc = rsr[m] * qs;
#pragma unroll
                for (int n = 0; n < 4; ++n) acc[n][m] *= sc;
            }
        }
        if (EPI == EPI_EVEN_IN) {
            bf16_t* C = (bf16_t*)(p.ws + WS_PROJ);
#pragma unroll
            for (int m = 0; m < 4; ++m)
#pragma unroll
                for (int n = 0; n < 4; ++n) {
                    const int row = m0 + m * 16 + fr, col = n0 + n * 16 + fq * 4;
                    if (col < EVC) { u32x2 w; w.x = pack2(acc[n][m][0], acc[n][m][1]); w.y = pack2(acc[n][m][2], acc[n][m][3]); *(u32x2*)(C + (size_t)row * EVLD + col) = w; }
                }
        } else if (EPI == EPI_ODD_IN) {
            bf16_t* C = (bf16_t*)(p.ws + WS_QK);
            const float2* tab = (const float2*)(p.ws + WS_ROPE);
            if (n0 < 3072) {
#pragma unroll
                for (int m = 0; m < 4; ++m) {
                    const int row = m0 + m * 16 + fr;
#pragma unroll
                    for (int n = 0; n < 2; ++n) {
                        float lo[4], hi[4];
#pragma unroll
                        for (int j = 0; j < 4; ++j) {
                            const float2 cs = tab[(size_t)row * 32 + n * 16 + fq * 4 + j];
                            const float x1 = acc[n][m][j], x2 = acc[n + 2][m][j];
                            lo[j] = x1 * cs.x - x2 * cs.y; hi[j] = x2 * cs.x + x1 * cs.y;
                        }
                        u32x2 w; w.x = pack2(lo[0], lo[1]); w.y = pack2(lo[2], lo[3]);
                        *(u32x2*)(C + (size_t)row * 3072 + n0 + n * 16 + fq * 4) = w;
                        w.x = pack2(hi[0], hi[1]); w.y = pack2(hi[2], hi[3]);
                        *(u32x2*)(C + (size_t)row * 3072 + n0 + (n + 2) * 16 + fq * 4) = w;
                    }
                }
            }
            if (tn * 128 >= 3072) {
                bf16_t* VT = (bf16_t*)(p.ws + WS_VT);
                const int hg0 = (tn * 128 - 3072) >> 6, g = hg0 >> 3, lg2 = g * 2, dil = 1 << lg2, L = SEQ >> lg2, run = 128 >> lg2;
                __syncthreads();
#pragma unroll
                for (int m = 0; m < 4; ++m)
#pragma unroll
                    for (int n = 0; n < 4; ++n)
#pragma unroll
                        for (int j = 0; j < 4; ++j)
                            *(bf16_t*)(lds + 32768 + (wc * 64 + n * 16 + fq * 4 + j) * 272 + (wr * 64 + m * 16 + fr) * 2) = f2bf(acc[n][m][j]);
                __syncthreads();
                const int bb = (tm * 128) >> 12, s0 = (tm * 128) & (SEQ - 1);
#pragma unroll
                for (int q = 0; q < 8; ++q) {
                    const int item = tid + q * 256, dim = item >> 4, o0 = (item & 15) * 8;
                    const int rr = o0 / run, i0 = o0 % run;
                    const char* src = lds + 32768 + dim * 272 + (rr + dil * i0) * 2;
                    float e8[8];
#pragma unroll
                    for (int e = 0; e < 8; ++e) e8[e] = bf2f(*(const bf16_t*)(src + e * dil * 2));
                    u32x4 w; w.x = pack2(e8[0], e8[1]); w.y = pack2(e8[2], e8[3]); w.z = pack2(e8[4], e8[5]); w.w = pack2(e8[6], e8[7]);
                    const int hg = hg0 + (dim >> 6);
                    *(u32x4*)(VT + ((size_t)((bb * 24 + hg) * dil + rr) * 64 + (dim & 63)) * L + (s0 >> lg2) + i0) = w;
                }
            }
        } else {
            float* ssq = (float*)(p.ws + WS_SSQ) + (size_t)(tn * 2 + wc) * T;
#pragma unroll
            for (int m = 0; m < 4; ++m) {
                float ss = 0.f;
#pragma unroll
                for (int n = 0; n < 4; ++n) {
                    const size_t qo = (size_t)(m0 + m * 16 + fr) * 1024 + n0 + n * 16 + fq * 4;
                    bf16_t* q = dry ? (bf16_t*)(p.ws + WS_DUMMY) + (qo & 0x7FFFF) : (bf16_t*)(p.ws + WS_XB) + qo;
                    const u32x2 xx = *(const u32x2*)q;
                    float4 v;
                    v.x = __uint_as_float(xx.x << 16) + acc[n][m][0]; v.y = __uint_as_float(xx.x & 0xffff0000u) + acc[n][m][1]; v.z = __uint_as_float(xx.y << 16) + acc[n][m][2]; v.w = __uint_as_float(xx.y & 0xffff0000u) + acc[n][m][3];
                    u32x2 w; w.x = pack2(v.x, v.y); w.y = pack2(v.z, v.w);
                    *(u32x2*)q = w;
                    ss += v.x * v.x + v.y * v.y + v.z * v.z + v.w * v.w;
                }
                ss += __shfl_xor(ss, 16); ss += __shfl_xor(ss, 32);
                if (fq == 0 && !dry) ssq[m0 + m * 16 + fr] = ss;
            }
        }
    }
}

DI void phase_gemm_even160(const P& p, const bf16_t* A, const bf16_t* Bt, char* lds) {
    const int tid = tidx(), wid = tid >> 6, lane = tid & 63, wr = wid >> 1, wc = wid & 1, fr = lane & 15, fq = lane >> 4;
    constexpr int ntm = T / 128, ntn = EVPAD / 160, ntiles = ntm * ntn;
    static_assert(EVPAD % 160 == 0, "even in-projection padding");
    auto fill = [&](TileN5& t, int tile) {
        const int tn = tile / ntm, tm = tile % ntm, r = tid >> 3;
#pragma unroll
        for (int i = 0; i < 4; ++i) t.arow[i] = tm * 128 + r + 32 * i;
#pragma unroll
        for (int i = 0; i < 5; ++i) t.bo[i] = (unsigned)(tn * 160 + r + 32 * i) * 2048u;
    };
    const GOps gop{(const char*)A, 2048u, (const char*)A, 2048u, (const char*)Bt};
    TileN5 cur, nxt;
    bool primed = false;
    fill(cur, bidx() < ntiles ? bidx() : 0); nxt = cur;
    bf16_t* C = (bf16_t*)(p.ws + WS_PROJ);
    for (int tile = bidx(); tile < ntiles; tile += gridDim.x) {
        const int tn = tile / ntm, tm = tile % ntm;
        const bool have_next = tile + (int)gridDim.x < ntiles;
        if (have_next) fill(nxt, tile + gridDim.x);
        const int m0 = tm * 128 + wr * 64, n0 = tn * 160 + wc * 80;
        float rsr[4];
#pragma unroll
        for (int m = 0; m < 4; ++m) rsr[m] = ((const float*)(p.ws + WS_RSIN))[m0 + m * 16 + fr];
        f32x4 acc[5][4];
        gemm_core5n(gop, cur, 1024, lds, acc, primed, nxt, have_next);
        primed = have_next; cur = nxt;
#pragma unroll
        for (int m = 0; m < 4; ++m)
#pragma unroll
            for (int n = 0; n < 5; ++n) {
                const int row = m0 + m * 16 + fr, col = n0 + n * 16 + fq * 4;
                if (col < EVC) { u32x2 w; w.x = pack2(acc[n][m][0] * rsr[m], acc[n][m][1] * rsr[m]); w.y = pack2(acc[n][m][2] * rsr[m], acc[n][m][3] * rsr[m]); *(u32x2*)(C + (size_t)row * EVLD + col) = w; }
            }
    }
}

DI int phase_moe_up(const P& p, int layer, char* lds) {
    const int tid = tidx(), wid = tid >> 6, lane = tid & 63, wr = wid >> 1, wc = wid & 1, fr = lane & 15, fq = lane >> 4;
    const unsigned* cntb = (const unsigned*)(p.ws + WS_CTL + CTL_CNT) + layer * 16 * 64;
    unsigned cnt[16];
#pragma unroll
    for (int e = 0; e < 16; ++e) cnt[e] = cntb[e * 64];
    const int* list = (const int*)(p.ws + WS_LIST);
    const float* gl = (const float*)(p.ws + WS_GATE);
    const bf16_t* hn = (const bf16_t*)(p.ws + WS_XB);
    const float* rsl = (const float*)(p.ws + WS_RSL);
    const bf16_t* W13 = (const bf16_t*)(moe_w(p, layer) + W_13);
    bf16_t* H = (bf16_t*)(p.ws + WS_H);
    int ttot = 0;
#pragma unroll
    for (int e = 0; e < 16; ++e) ttot += ((int)cnt[e] + 159) / 160;
    const int ntiles = ttot * 4;
    auto locate = [&](int tile, int& e, int& lt, int& ce, int& rbe, int& tn) {
        const int mt = tile >> 2; tn = tile & 3;
        int tbe = 0, acc_t = 0, rb = 0, rbacc = 0; e = 0;
#pragma unroll
        for (int q = 0; q < 16; ++q) {
            const int nt = ((int)cnt[q] + 159) / 160;
            if (mt >= acc_t) { e = q; tbe = acc_t; rb = rbacc; }
            acc_t += nt; rbacc += (((int)cnt[q] + 127) >> 7) * 128;
        }
        lt = mt - tbe; ce = (int)cnt[e]; rbe = rb;
    };
    auto fill = [&](TileP5& t, int tile) {
        int e, lt, ce, rbe, tn; locate(tile, e, lt, ce, rbe, tn);
        const int r = tid >> 3;
#pragma unroll
        for (int i = 0; i < 5; ++i) {
            const int ii = lt * 160 + r + 32 * i;
            t.arow[i] = ii < ce ? (list[e * 16384 + ii] >> 1) : 0;
        }
#pragma unroll
        for (int i = 0; i < 4; ++i) t.bo[i] = (unsigned)(e * 512 + tn * 128 + r + 32 * i) * 2048u;
    };
    const GOps gop{(const char*)hn, 2048u, (const char*)hn, 2048u, (const char*)W13};
    TileP5 cur, nxt;
    bool primed = false;
    fill(cur, bidx() < ntiles ? bidx() : 0); nxt = cur;
    for (int tile = bidx(); tile < ntiles; tile += gridDim.x) {
        int e, lt, ce, rbe, tn; locate(tile, e, lt, ce, rbe, tn);
        const bool have_next = tile + (int)gridDim.x < ntiles;
        if (have_next) fill(nxt, tile + gridDim.x);
        float gm[5], rsm[5];
#pragma unroll
        for (int m = 0; m < 5; ++m) {
            const int li = lt * 160 + wr * 80 + m * 16 + fr, lc = li < ce ? li : 0;
            gm[m] = gl[e * 16384 + lc]; rsm[m] = rsl[e * 16384 + lc];
        }
        f32x4 acc[4][5];
        gemm_core5(gop, cur, 1024, lds, acc, primed, nxt, have_next);
        primed = have_next; cur = nxt;
#pragma unroll
        for (int m = 0; m < 5; ++m) {
            const int li = lt * 160 + wr * 80 + m * 16 + fr;
            if (li < ce) {
                const float g = gm[m], rs = rsm[m];
                bf16_t* hrow = H + (size_t)(rbe + li) * 256;
#pragma unroll
                for (int n = 0; n < 4; n += 2) {
                    float o[4];
#pragma unroll
                    for (int j = 0; j < 4; ++j) o[j] = siluf_(acc[n][m][j] * rs) * (acc[n + 1][m][j] * rs) * g;
                    const int f = tn * 64 + wc * 32 + (n >> 1) * 16 + fq * 4;
                    u32x2 w; w.x = pack2(o[0], o[1]); w.y = pack2(o[2], o[3]);
                    *(u32x2*)(hrow + f) = w;
                }
            }
        }
    }
    return ntiles;
}
DI void phase_moe_down(const P& p, int layer, char* lds) {
    const int tid = tidx(), wid = tid >> 6, lane = tid & 63, wr = wid >> 1, wc = wid & 1, fr = lane & 15, fq = lane >> 4;
    const unsigned* cntb = (const unsigned*)(p.ws + WS_CTL + CTL_CNT) + layer * 16 * 64;
    unsigned cnt[16];
#pragma unroll
    for (int e = 0; e < 16; ++e) cnt[e] = cntb[e * 64];
    const int* list = (const int*)(p.ws + WS_LIST);
    const bf16_t* W2 = (const bf16_t*)(moe_w(p, layer) + W_2);
    const bf16_t* H = (const bf16_t*)(p.ws + WS_H);
    bf16_t* ys = (bf16_t*)(p.ws + WS_YS);
    int ttot = 0;
#pragma unroll
    for (int e = 0; e < 16; ++e) ttot += ((int)cnt[e] + 127) >> 7;
    const int ntiles = ttot * 8;
    auto locate = [&](int tile, int& e, int& lt, int& ce, int& rbe, int& tn) {
        const int mt = tile >> 3; tn = tile & 7;
        int tbe = 0, acc_t = 0; e = 0;
#pragma unroll
        for (int q = 0; q < 16; ++q) { const int nt = ((int)cnt[q] + 127) >> 7; if (mt >= acc_t) { e = q; tbe = acc_t; } acc_t += nt; }
        lt = mt - tbe; ce = (int)cnt[e]; rbe = tbe * 128;
    };
    auto fill = [&](TileP& t, int tile) {
        int e, lt, ce, rbe, tn; locate(tile, e, lt, ce, rbe, tn);
        const int r = tid >> 3;
#pragma unroll
        for (int i = 0; i < 4; ++i) { t.arow[i] = rbe + lt * 128 + r + 32 * i; t.bo[i] = (unsigned)(e * 1024 + tn * 128 + r + 32 * i) * 512u; }
    };
    const GOps gop{(const char*)H, 512u, (const char*)H, 512u, (const char*)W2};
    TileP cur, nxt;
    bool primed = false;
    fill(cur, bidx() < ntiles ? bidx() : 0); nxt = cur;
    for (int tile = bidx(); tile < ntiles; tile += gridDim.x) {
        int e, lt, ce, rbe, tn; locate(tile, e, lt, ce, rbe, tn);
        const bool have_next = tile + (int)gridDim.x < ntiles;
        if (have_next) fill(nxt, tile + gridDim.x);
        int tsm[4];
#pragma unroll
        for (int m = 0; m < 4; ++m) { const int li = lt * 128 + wr * 64 + m * 16 + fr; tsm[m] = list[e * 16384 + (li < ce ? li : 0)]; }
        f32x4 acc[4][4];
        gemm_core(gop, cur, 256, lds, acc, 1 << 30, primed, nxt, have_next, primed, have_next);
        primed = have_next; cur = nxt;
#pragma unroll
        for (int m = 0; m < 4; ++m) {
            const int li = lt * 128 + wr * 64 + m * 16 + fr;
            if (li < ce) {
                const int ts = tsm[m];
                bf16_t* yrow = ys + ((size_t)(ts & 1) * T + (ts >> 1)) * 1024 + tn * 128 + wc * 64 + fq * 4;
#pragma unroll
                for (int n = 0; n < 4; ++n) { u32x2 w; w.x = pack2(acc[n][m][0], acc[n][m][1]); w.y = pack2(acc[n][m][2], acc[n][m][3]); *(u32x2*)(yrow + n * 16) = w; }
            }
        }
    }
}


typedef float f32x16 __attribute__((ext_vector_type(16)));
DI f32x4 mfma16(bf16x8 a, bf16x8 b, f32x4 c) { return __builtin_amdgcn_mfma_f32_16x16x32_bf16(a, b, c, 0, 0, 0); }
DI f32x16 mfma32(bf16x8 a, bf16x8 b, f32x16 c) { return __builtin_amdgcn_mfma_f32_32x32x16_bf16(a, b, c, 0, 0, 0); }
DI f32x4 tile16(const char* X, int ldx, int row0, const char* Y, int ldy, int col0, int K) {
    const int lane = tidx() & 63, fr = lane & 15, fq = lane >> 4;
    const char* xp = X + (row0 + fr) * ldx + fq * 16; const char* yp = Y + (col0 + fr) * ldy + fq * 16;
    bf16x8 a[4], b[4];
#pragma unroll
    for (int s = 0; s < 4; ++s) if (s * 32 < K) { a[s] = *(const bf16x8*)(xp + s * 64); b[s] = *(const bf16x8*)(yp + s * 64); }
    f32x4 acc = {0.f, 0.f, 0.f, 0.f};
#pragma unroll
    for (int s = 0; s < 4; ++s) if (s * 32 < K) acc = mfma16(a[s], b[s], acc);
    return acc;
}
DI bf16x8 pack_step(const f32x16& x, int s) {
    u32x4 r;
    r.x = pack2(x[8 * s + 0], x[8 * s + 1]); r.y = pack2(x[8 * s + 2], x[8 * s + 3]);
    r.z = pack2(x[8 * s + 4], x[8 * s + 5]); r.w = pack2(x[8 * s + 6], x[8 * s + 7]);
    return __builtin_bit_cast(bf16x8, r);
}

constexpr int GP_LF = 0, GP_T = 17408, GP_VEC = GP_T + 9216, GP_U = GP_VEC + 1024, GP_END = GP_U + 36864;
DI void gdn_prep_unit(const P& p, int li, int ch, char* lds) {
    const int tid = tidx(), lane = tid & 63, wid = tid >> 6, fr = lane & 15, fq = lane >> 4;
    const int h = ch & 3, n = (ch >> 2) & 63, b = ch >> 8;
    const int t0 = b * SEQ + n * 64;
    float* Lf = (float*)(lds + GP_LF);
    char* Trow = lds + GP_T;
    float* gcs = (float*)(lds + GP_VEC); float* egc = gcs + 64; float* bet = gcs + 128; float* ekd = gcs + 192;
    char* Qrow = lds + GP_U; char* Krow = Qrow + 17408; char* VbT = lds + GP_U; char* KbgT = VbT + 18432;
    const bf16_t* proj = (const bf16_t*)(p.ws + WS_PROJ);
    unsigned char* ops = p.ws + WS_GOPS + (size_t)ch * GOPS_CH;
    const float* cw = p.in[I_CONVW] + (size_t)li * 4 * 1536;
    const int c = tid >> 2, cq = tid & 3;
    __syncthreads();
    float* cwl = (float*)(lds + GP_END);
    for (int i = tid; i < 4 * 3 * 32; i += 256) {
        const int j = i / 96, r = i % 96, sl = r >> 5, q4 = (r & 31) * 4;
        *(f32x4*)(cwl + (j * 3 + sl) * 128 + q4) = *(const f32x4*)(cw + j * 1536 + sl * 512 + h * 128 + q4);
    }
    __syncthreads();
    unsigned vvp[16];
#pragma unroll 1
    for (int which = 0; which < 3; ++which) {
        const int col0 = which * 512 + h * 128 + cq * 32;
        u32x4 xin[4][4];
#pragma unroll
        for (int j = 0; j < 4; ++j) {
            const int sp = n * 64 + c - 3 + j;
            const bf16_t* src = proj + (size_t)(b * SEQ + (sp < 0 ? 0 : sp)) * EVLD + col0;
#pragma unroll
            for (int i4 = 0; i4 < 4; ++i4) xin[j][i4] = *(const u32x4*)(src + i4 * 8);
        }
        float acc[32];
#pragma unroll
        for (int i = 0; i < 32; ++i) acc[i] = 0.f;
#pragma unroll
        for (int j = 0; j < 4; ++j) {
            const float ok = (n * 64 + c - 3 + j) >= 0 ? 1.f : 0.f;
            const float* wj = cwl + (j * 3 + which) * 128 + cq * 32;
#pragma unroll
            for (int i4 = 0; i4 < 4; ++i4) {
                const f32x4 wa = *(const f32x4*)(wj + i4 * 8), wb = *(const f32x4*)(wj + i4 * 8 + 4);
                const u32x4 w = xin[j][i4];
                acc[i4 * 8 + 0] += ok * wa[0] * __uint_as_float(w[0] << 16); acc[i4 * 8 + 1] += ok * wa[1] * __uint_as_float(w[0] & 0xffff0000u);
                acc[i4 * 8 + 2] += ok * wa[2] * __uint_as_float(w[1] << 16); acc[i4 * 8 + 3] += ok * wa[3] * __uint_as_float(w[1] & 0xffff0000u);
                acc[i4 * 8 + 4] += ok * wb[0] * __uint_as_float(w[2] << 16); acc[i4 * 8 + 5] += ok * wb[1] * __uint_as_float(w[2] & 0xffff0000u);
                acc[i4 * 8 + 6] += ok * wb[2] * __uint_as_float(w[3] << 16); acc[i4 * 8 + 7] += ok * wb[3] * __uint_as_float(w[3] & 0xffff0000u);
            }
        }
        float ss = 0.f;
#pragma unroll
        for (int i = 0; i < 32; ++i) { acc[i] = siluf_(acc[i]); ss += acc[i] * acc[i]; }
        ss += __shfl_xor(ss, 1); ss += __shfl_xor(ss, 2);
        const float rn = which == 2 ? 1.f : rsqrtf(ss + 1e-6f) * (which == 0 ? 0.08838834764831845f : 1.f);
        unsigned pk[16];
#pragma unroll
        for (int i = 0; i < 16; ++i) pk[i] = pack2(acc[2 * i] * rn, acc[2 * i + 1] * rn);
        if (which < 2) {
            char* img = which == 0 ? Qrow : Krow;
#pragma unroll
            for (int i4 = 0; i4 < 4; ++i4) { u32x4 w; w.x = pk[i4 * 4]; w.y = pk[i4 * 4 + 1]; w.z = pk[i4 * 4 + 2]; w.w = pk[i4 * 4 + 3]; *(u32x4*)(img + c * 272 + (cq * 32 + i4 * 8) * 2) = w; }
        } else {
#pragma unroll
            for (int i = 0; i < 16; ++i) vvp[i] = pk[i];
        }
    }
    if (cq == 0) {
        const float a = bf2f(proj[(size_t)(t0 + c) * EVLD + 2048 + h]);
        const float bb = bf2f(proj[(size_t)(t0 + c) * EVLD + 2052 + h]);
        const float Aexp = __expf(p.in[I_ALOG][li * 4 + h]), dtb = p.in[I_DTB][li * 4 + h];
        gcs[c] = -Aexp * softplusf_(a + dtb);
        bet[c] = sigmoidf_(bb);
    }
    __syncthreads();
    if (wid == 0) {
        float x = gcs[lane];
#pragma unroll
        for (int o = 1; o < 64; o <<= 1) { const float y = __shfl_up(x, o); if (lane >= o) x += y; }
        const float gl = __shfl(x, 63);
        gcs[lane] = x; egc[lane] = __expf(x); ekd[lane] = __expf(gl - x);
        if (lane == 63) ((float*)(p.ws + WS_CTL + CTL_EGL))[ch] = __expf(gl);
    }
    __syncthreads();
    {
        const int ti = wid;
#pragma unroll
        for (int tj = 0; tj < 4; ++tj) {
            if (tj <= ti) {
                const f32x4 kk = tile16(Krow, 272, 16 * ti, Krow, 272, 16 * tj, 128);
                const int c2 = 16 * tj + fr;
                f32x4 lv;
#pragma unroll
                for (int r = 0; r < 4; ++r) {
                    const int c1 = 16 * ti + fq * 4 + r;
                    lv[r] = (c1 > c2) ? bet[c1] * kk[r] * __expf(gcs[c1] - gcs[c2]) : 0.f;
                }
                *(f32x4*)&Lf[c2 * 68 + 16 * ti + fq * 4] = lv;
            }
            f32x4 qk = {0.f, 0.f, 0.f, 0.f};
            if (tj <= ti) qk = tile16(Krow, 272, 16 * tj, Qrow, 272, 16 * ti, 128);
            const int c1 = 16 * ti + fr;
            float o4[4];
#pragma unroll
            for (int r = 0; r < 4; ++r) { const int c2 = 16 * tj + fq * 4 + r; o4[r] = (c1 >= c2) ? qk[r] * __expf(gcs[c1] - gcs[c2]) : 0.f; }
            const int mt = c1 >> 5, rr = c1 & 31, hh = fq & 1, jg = fq >> 1;
            u32x2 w; w.x = pack2(o4[0], o4[1]); w.y = pack2(o4[2], o4[3]);
            *(u32x2*)(ops + GO_AF + ((size_t)((mt * 4 + tj) * 64 + hh * 32 + rr) * 8 + jg * 4) * 2) = w;
        }
#pragma unroll
        for (int i = 0; i < 4; ++i) {
            const int idx = tid + i * 256;
            {
                const int mt = idx >> 9, ks = (idx >> 6) & 7, l2 = idx & 63, rr = l2 & 31, hh = l2 >> 5, cc = 32 * mt + rr;
                const float sc = egc[cc];
                const u32x2 lo = *(const u32x2*)(Qrow + cc * 272 + (16 * ks + 4 * hh) * 2), hi = *(const u32x2*)(Qrow + cc * 272 + (16 * ks + 8 + 4 * hh) * 2);
                u32x4 w;
                w.x = pack2(__uint_as_float(lo.x << 16) * sc, __uint_as_float(lo.x & 0xffff0000u) * sc); w.y = pack2(__uint_as_float(lo.y << 16) * sc, __uint_as_float(lo.y & 0xffff0000u) * sc);
                w.z = pack2(__uint_as_float(hi.x << 16) * sc, __uint_as_float(hi.x & 0xffff0000u) * sc); w.w = pack2(__uint_as_float(hi.y << 16) * sc, __uint_as_float(hi.y & 0xffff0000u) * sc);
                *(u32x4*)(ops + GO_QF + (size_t)idx * 16) = w;
            }
            {
                const int mt = idx >> 8, ks = (idx >> 6) & 3, l2 = idx & 63, rr = l2 & 31, hh = l2 >> 5, dk = 32 * mt + rr;
                float e8[8];
#pragma unroll
                for (int j = 0; j < 8; ++j) { const int c2 = 16 * ks + 8 * (j >> 2) + 4 * hh + (j & 3); e8[j] = bf2f(*(const bf16_t*)(Krow + c2 * 272 + dk * 2)) * ekd[c2]; }
                u32x4 w; w.x = pack2(e8[0], e8[1]); w.y = pack2(e8[2], e8[3]); w.z = pack2(e8[4], e8[5]); w.w = pack2(e8[6], e8[7]);
                *(u32x4*)(ops + GO_KF + (size_t)idx * 16) = w;
            }
        }
    }
    __syncthreads();
    {
        const float bc = bet[c], bg = bc * egc[c];
        unsigned kvp[16];
#pragma unroll
        for (int i4 = 0; i4 < 4; ++i4) { const u32x4 w = *(const u32x4*)(Krow + c * 272 + (cq * 32 + i4 * 8) * 2); kvp[i4 * 4] = w.x; kvp[i4 * 4 + 1] = w.y; kvp[i4 * 4 + 2] = w.z; kvp[i4 * 4 + 3] = w.w; }
        __syncthreads();
#pragma unroll
        for (int i = 0; i < 16; ++i) {
            *(bf16_t*)(VbT + (cq * 32 + 2 * i) * 144 + c * 2) = f2bf(__uint_as_float(vvp[i] << 16) * bc);
            *(bf16_t*)(VbT + (cq * 32 + 2 * i + 1) * 144 + c * 2) = f2bf(__uint_as_float(vvp[i] & 0xffff0000u) * bc);
            *(bf16_t*)(KbgT + (cq * 32 + 2 * i) * 144 + c * 2) = f2bf(__uint_as_float(kvp[i] << 16) * bg);
            *(bf16_t*)(KbgT + (cq * 32 + 2 * i + 1) * 144 + c * 2) = f2bf(__uint_as_float(kvp[i] & 0xffff0000u) * bg);
        }
    }
    {
        char* L21i = lds + GP_END;
        char* T11T = L21i + 2560;
        char* MT = T11T + 2560;
        if (wid < 2) {
            const int o = 32 * wid;
            float Tc[32];
#pragma unroll
            for (int i = 0; i < 32; ++i) Tc[i] = (i == (lane & 31)) ? 1.f : 0.f;
#pragma unroll
            for (int j = 0; j < 31; ++j) {
                const float tj = Tc[j];
#pragma unroll
                for (int i4 = (j + 1) >> 2; i4 < 8; ++i4) {
                    const f32x4 l4 = *(const f32x4*)&Lf[(o + j) * 68 + o + i4 * 4];
#pragma unroll
                    for (int e = 0; e < 4; ++e) if (i4 * 4 + e > j) Tc[i4 * 4 + e] -= l4[e] * tj;
                }
            }
            if (lane < 32) {
#pragma unroll
                for (int i = 0; i < 32; ++i) *(bf16_t*)(Trow + (o + i) * 144 + (o + lane) * 2) = f2bf(Tc[i]);
                if (wid == 0) {
#pragma unroll
                    for (int i = 0; i < 32; ++i) *(bf16_t*)(Trow + i * 144 + (32 + lane) * 2) = 0;
#pragma unroll
                    for (int i4 = 0; i4 < 8; ++i4) { u32x2 w; w.x = pack2(Tc[i4 * 4], Tc[i4 * 4 + 1]); w.y = pack2(Tc[i4 * 4 + 2], Tc[i4 * 4 + 3]); *(u32x2*)(T11T + lane * 80 + i4 * 8) = w; }
                }
            }
        } else {
            const int t2 = tid - 128;
#pragma unroll
            for (int g2 = 0; g2 < 2; ++g2) {
                const int i = t2 & 31, k4 = ((t2 >> 5) + 4 * g2) * 4;
                u32x2 w;
                w.x = pack2(Lf[(k4 + 0) * 68 + 32 + i], Lf[(k4 + 1) * 68 + 32 + i]); w.y = pack2(Lf[(k4 + 2) * 68 + 32 + i], Lf[(k4 + 3) * 68 + 32 + i]);
                *(u32x2*)(L21i + i * 80 + k4 * 2) = w;
            }
        }
        __syncthreads();
        {
            const int r0 = 16 * (wid >> 1), c0 = 16 * (wid & 1);
            const f32x4 mm = tile16(L21i, 80, r0, T11T, 80, c0, 32);
            u32x2 w; w.x = pack2(mm[0], mm[1]); w.y = pack2(mm[2], mm[3]);
            *(u32x2*)(MT + (c0 + fr) * 80 + (r0 + 4 * fq) * 2) = w;
        }
        __syncthreads();
        {
            const int r0 = 16 * (wid >> 1), c0 = 16 * (wid & 1);
            const f32x4 tt = tile16(MT, 80, c0, Trow + 32 * 144 + 64, 144, r0, 32);
            u32x2 w; w.x = pack2(-tt[0], -tt[1]); w.y = pack2(-tt[2], -tt[3]);
            *(u32x2*)(Trow + (32 + r0 + fr) * 144 + (c0 + 4 * fq) * 2) = w;
        }
    }
    __syncthreads();
#pragma unroll
    for (int tq = 0; tq < 2; ++tq) {
        const int tj = wid * 2 + tq;
#pragma unroll
        for (int ti = 0; ti < 4; ++ti) {
            const f32x4 u = tile16(Trow, 144, 16 * ti, VbT, 144, 16 * tj, 64);
            {
                const int dv = 16 * tj + fr, slice = dv >> 5, rr = dv & 31, cb = 16 * ti + fq * 4, mt = cb >> 5, q4 = (cb & 31) >> 2, hh = q4 & 1, rg = q4 >> 1;
                u32x2 w; w.x = pack2(u[0], u[1]); w.y = pack2(u[2], u[3]);
                *(u32x2*)(ops + GO_UF + ((size_t)((slice * 2 + mt) * 64 + hh * 32 + rr) * 16 + rg * 4) * 2) = w;
            }
            const f32x4 wv = tile16(KbgT, 144, 16 * tj, Trow, 144, 16 * ti, 64);
            {
                const int c1 = 16 * ti + fr, mt = c1 >> 5, rr = c1 & 31, hh = fq & 1, jg = fq >> 1;
                u32x2 w; w.x = pack2(-wv[0], -wv[1]); w.y = pack2(-wv[2], -wv[3]);
                *(u32x2*)(ops + GO_WF + ((size_t)((mt * 8 + tj) * 64 + hh * 32 + rr) * 8 + jg * 4) * 2) = w;
            }
        }
    }
}

DI void glds16(const void* g, char* l) { __builtin_amdgcn_global_load_lds((const unsigned*)g, (lds_u32*)l, 16, 0, 0); }
DI void glds16nt(const void* g, char* l) { __builtin_amdgcn_global_load_lds((const unsigned*)g, (lds_u32*)l, 16, 0, 2); }
DI void fr_rd(bf16x8& f, unsigned addr) { asm volatile("ds_read_b128 %0, %1" : "=v"(f) : "v"(addr) : "memory"); }
template <int N> DI void fr_wait(bf16x8& f) { asm volatile("s_waitcnt lgkmcnt(%1)" : "+v"(f) : "n"(N) : "memory"); }
template <int REM> DI void fr_waitc(bf16x8& f) { if (REM >= 3) fr_wait<3>(f); else if (REM == 2) fr_wait<2>(f); else if (REM == 1) fr_wait<1>(f); else fr_wait<0>(f); }
#define GS_WAIT(n) asm volatile("s_waitcnt vmcnt(" #n ")" ::: "memory")
DI void gdn_scan_block(const P& p, int bh, char* lds, bool dry = false) {
    const int tid = tidx(), lane = tid & 63, w = tid >> 6;
    const int h = bh & 3, b = bh >> 2;
    const float eglv = ((const float*)(p.ws + WS_CTL + CTL_EGL))[(b * 64 + lane) * 4 + h];
    unsigned char* gbase = p.ws + WS_GOPS + (size_t)(b * 256 + h) * GOPS_CH;
    auto issue = [&](int n, int k0, int cntk) {
        for (int k = k0; k < k0 + cntk; ++k) {
            const unsigned char* src = gbase + (size_t)n * 4 * GOPS_CH + k * 8192 + tid * 16;
            char* dst = lds + k * 8192 + tid * 16;
            glds16nt(src, dst); glds16nt(src + 4096, dst + 4096);
        }
    };
    const unsigned la = (unsigned)(size_t)(lds_u32*)lds + lane * 16;
    f32x16 S[4];
#pragma unroll
    for (int i = 0; i < 4; ++i)
#pragma unroll
        for (int r = 0; r < 16; ++r) S[i][r] = 0.f;
    __syncthreads();
    issue(0, 0, 7);
#pragma unroll 1
    for (int n = 0; n < 64; ++n) {
        const float egl = __shfl(eglv, n);
        bf16x8 Sb[8];
#pragma unroll
        for (int i = 0; i < 4; ++i) { Sb[i * 2] = pack_step(S[i], 0); Sb[i * 2 + 1] = pack_step(S[i], 1); }
        f32x16 av[2], ao[2];
        GS_WAIT(6);
        __builtin_amdgcn_s_barrier();
        issue(n, 7, 2);
        __builtin_amdgcn_sched_barrier(0);
        {
            const char* sl = lds + (w >> 1) * 8192;
#pragma unroll
            for (int mt = 0; mt < 2; ++mt) {
                const u32x4* up = (const u32x4*)(sl + ((w & 1) * 2 + mt) * 2048 + lane * 32);
                const u32x4 u0 = up[0], u1 = up[1];
#pragma unroll
                for (int e = 0; e < 4; ++e) {
                    av[mt][e * 2] = __uint_as_float(u0[e] << 16); av[mt][e * 2 + 1] = __uint_as_float(u0[e] & 0xffff0000u);
                    av[mt][8 + e * 2] = __uint_as_float(u1[e] << 16); av[mt][8 + e * 2 + 1] = __uint_as_float(u1[e] & 0xffff0000u);
                }
            }
        }
        bf16x8 F[4];
#define GS_O0(j) (unsigned)((2 + ((j) & 1)) * 8192 + ((j) >> 1) * 1024)
#pragma unroll
        for (int j = 0; j < 4; ++j) fr_rd(F[j], la + GS_O0(j));
#pragma unroll
        for (int j = 0; j < 16; ++j) {
            if (j <= 12) fr_wait<3>(F[j & 3]); else if (j == 13) fr_wait<2>(F[j & 3]); else if (j == 14) fr_wait<1>(F[j & 3]); else fr_wait<0>(F[j & 3]);
            av[j & 1] = mfma32(F[j & 3], Sb[j >> 1], av[j & 1]);
            if (j + 4 < 16) fr_rd(F[j & 3], la + GS_O0(j + 4));
        }
        bf16x8 Vb[4];
#pragma unroll
        for (int mt = 0; mt < 2; ++mt) { Vb[mt * 2] = pack_step(av[mt], 0); Vb[mt * 2 + 1] = pack_step(av[mt], 1); }
        GS_WAIT(4);
        __builtin_amdgcn_s_barrier();
        if (n < 63) issue(n + 1, 0, 4);
        __builtin_amdgcn_sched_barrier(0);
#pragma unroll
        for (int mt = 0; mt < 2; ++mt)
#pragma unroll
            for (int r = 0; r < 16; ++r) ao[mt][r] = 0.f;
#define GS_O1(j) (unsigned)((j) < 16 ? (4 + ((j) & 1)) * 8192 + ((j) >> 1) * 1024 : 6 * 8192 + ((j) == 16 ? 0 : (j) == 17 ? 4 : (j) == 18 ? 1 : (j) == 19 ? 5 : (j) == 20 ? 6 : 7) * 1024)
#pragma unroll
        for (int j = 0; j < 4; ++j) fr_rd(F[j], la + GS_O1(j));
#pragma unroll
        for (int j = 0; j < 22; ++j) {
            if (j <= 18) fr_wait<3>(F[j & 3]); else if (j == 19) fr_wait<2>(F[j & 3]); else if (j == 20) fr_wait<1>(F[j & 3]); else fr_wait<0>(F[j & 3]);
            if (j < 16) {
                ao[j & 1] = mfma32(F[j & 3], Sb[j >> 1], ao[j & 1]);
                if (j & 1) {
                    const int ks = j >> 1;
#pragma unroll
                    for (int r = 0; r < 8; ++r) S[ks >> 1][(ks & 1) * 8 + r] *= egl;
                }
            } else {
                const int oi = (j == 16 || j == 18) ? 0 : 1, kv = j <= 17 ? 0 : j <= 19 ? 1 : j == 20 ? 2 : 3;
                ao[oi] = mfma32(F[j & 3], Vb[kv], ao[oi]);
            }
            if (j + 4 < 22) fr_rd(F[j & 3], la + GS_O1(j + 4));
        }
        if (n < 63) GS_WAIT(8); else GS_WAIT(0);
        __builtin_amdgcn_s_barrier();
        if (n < 63) issue(n + 1, 4, 3);
        __builtin_amdgcn_sched_barrier(0);
#define GS_O2(j) (unsigned)((7 + (((j) & 3) >> 1)) * 8192 + ((((j) & 3) & 1) * 4 + ((j) >> 2)) * 1024)
#pragma unroll
        for (int j = 0; j < 4; ++j) fr_rd(F[j], la + GS_O2(j));
#pragma unroll
        for (int j = 0; j < 16; ++j) {
            if (j <= 12) fr_wait<3>(F[j & 3]); else if (j == 13) fr_wait<2>(F[j & 3]); else if (j == 14) fr_wait<1>(F[j & 3]); else fr_wait<0>(F[j & 3]);
            S[j & 3] = mfma32(F[j & 3], Vb[j >> 2], S[j & 3]);
            if (j + 4 < 16) fr_rd(F[j & 3], la + GS_O2(j + 4));
        }
        {
            u32x4* Of = (u32x4*)((dry ? p.ws + WS_DUMMY + (size_t)(bh & 15) * 65536 : gbase + (size_t)n * 4 * GOPS_CH) + GO_UF) + (size_t)(w * 2 * 64 + lane) * 2;
#pragma unroll
            for (int mt = 0; mt < 2; ++mt) {
                u32x4 o0, o1;
#pragma unroll
                for (int e = 0; e < 4; ++e) { o0[e] = pack2(ao[mt][e * 2], ao[mt][e * 2 + 1]); o1[e] = pack2(ao[mt][8 + e * 2], ao[mt][8 + e * 2 + 1]); }
                Of[mt * 128] = o0; Of[mt * 128 + 1] = o1;
            }
        }
    }
    __syncthreads();
}

DI void gdn_post_unit(const P& p, int li, int ch, char* lds) {
    const int tid = tidx();
    const int h = ch & 3, n = (ch >> 2) & 63, b = ch >> 8;
    const int t0 = b * SEQ + n * 64;
    const int c = tid >> 2, cq = tid & 3;
    {
        const u32x4* Og = (const u32x4*)(p.ws + WS_GOPS + (size_t)ch * GOPS_CH + GO_UF);
        __syncthreads();
#pragma unroll
        for (int i = 0; i < 4; ++i) ((u32x4*)lds)[tid + 256 * i] = __builtin_nontemporal_load(Og + tid + 256 * i);
        __syncthreads();
    }
    const bf16_t* Of = (const bf16_t*)lds;
    const bf16_t* proj = (const bf16_t*)(p.ws + WS_PROJ);
    bf16_t* mix = (bf16_t*)(p.ws + WS_PROJ);
    const float* nw = p.in[I_GDNNORM] + li * 128 + cq * 32;
    const int mt = c >> 5, q4 = (c & 31) >> 2, hh = q4 & 1, rg = q4 >> 1, reg = rg * 4 + (c & 3);
    float o[32]; float ss = 0.f;
#pragma unroll
    for (int r = 0; r < 32; ++r) { o[r] = bf2f(Of[(size_t)((cq * 2 + mt) * 64 + hh * 32 + r) * 16 + reg]); ss += o[r] * o[r]; }
    ss += __shfl_xor(ss, 1); ss += __shfl_xor(ss, 2);
    const float rs = rsqrtf(ss * (1.f / 128.f) + 1e-6f);
    const bf16_t* zp = proj + (size_t)(t0 + c) * EVLD + 1536 + h * 128 + cq * 32;
    bf16_t* mp = mix + (size_t)(t0 + c) * EVLD + h * 128 + cq * 32;
#pragma unroll
    for (int i4 = 0; i4 < 4; ++i4) {
        const u32x4 zw = *(const u32x4*)(zp + i4 * 8);
        u32x4 w;
#pragma unroll
        for (int e = 0; e < 4; ++e) {
            const float z0 = __uint_as_float(zw[e] << 16), z1 = __uint_as_float(zw[e] & 0xffff0000u);
            w[e] = pack2(o[i4 * 8 + e * 2] * rs * nw[i4 * 8 + e * 2] * siluf_(z0), o[i4 * 8 + e * 2 + 1] * rs * nw[i4 * 8 + e * 2 + 1] * siluf_(z1));
        }
        *(u32x4*)(mp + i4 * 8) = w;
    }
}


constexpr int RP_Z0 = 0, RP_Z1 = 18432, RP_Z2 = 55296, RP_VEC = 73728, RP_PT = 75008, RP_T11 = 78080, RP_END = 80640;
constexpr int RP_LIN = 0, RP_LW = 25600;
DI void rwkv_prep_unit(const P& p, int li, int ch, char* lds) {
    const int tid = tidx(), lane = tid & 63, wid = tid >> 6, fr = lane & 15, fq = lane >> 4;
    const int h = ch & 7, n = (ch >> 3) & 63, b = ch >> 9;
    const int t0 = b * SEQ + n * 64;
    const bf16_t* proj = (const bf16_t*)(p.ws + WS_PROJ);
    char* Lfc = lds + RP_Z0; float* Lf = (float*)Lfc;
    char* ApT = lds + RP_Z0; char* AkVT = lds + RP_Z0 + 9216;
    char* Arow = lds + RP_Z1; char* Rrow = Arow + 9216; char* Brow = Arow + 18432; char* Krow = Arow + 27648;
    char* Aak = Arow; char* Arb = Rrow; char* Ark = Brow; char* Trow = Krow; char* BhT = Krow; char* VpT = Aak;
    char* AT = lds + RP_Z2; char* VT = AT + 9216; char* KhT = AT;
    float* tot = (float*)(lds + RP_VEC); float* WC = tot + 256;
    char* lin = lds + RP_LIN; char* LWi = lds + RP_LW;
    float* PT = (float*)(lds + RP_PT);
    {
        const float* mu0 = p.in[I_MU] + (size_t)li * 1696;
        if (tid < 48) {
            const int j0 = tid * 4;
            *(float4*)(PT + j0) = j0 < 160 ? *(const float4*)(mu0 + (C_HW - RW0) + j0) : *(const float4*)(p.in[I_VRESMU] + j0 - 160);
        } else if (tid < 48 + 144) {
            const int q = tid - 48, arr = q >> 4, c4 = (q & 15) * 4, chn = h * 64 + c4;
            const float* src = arr == 0 ? mu0 + (C_R - RW0) + chn : arr == 1 ? mu0 + (C_K - RW0) + chn : arr == 2 ? mu0 + (C_V - RW0) + chn
                             : arr == 3 ? p.in[I_W0] + li * 512 + chn : arr == 4 ? p.in[I_A0] + li * 512 + chn : arr == 5 ? p.in[I_V0] + chn
                             : arr == 6 ? p.in[I_KK] + li * 512 + chn : arr == 7 ? p.in[I_KA] + li * 512 + chn : p.in[I_RK] + li * 512 + chn;
            *(float4*)(PT + 192 + arr * 64 + c4) = *(const float4*)src;
        }
    }
    __syncthreads();
    {
        const int c = tid >> 2, cq = tid & 3, s = n * 64 + c;
        const bf16_t* cur = proj + (size_t)(t0 + c) * EVLD + C_HW + cq * 48;
        const float* mu = p.in[I_MU] + (size_t)li * 1696 + (C_HW - RW0);
        const float* vmu = p.in[I_VRESMU];
#pragma unroll
        for (int i6 = 0; i6 < 6; ++i6) {
            const u32x4 cw4 = *(const u32x4*)(cur + i6 * 8);
            u32x4 pw4 = *(const u32x4*)(cur - (s > 0 ? EVLD : 0) + i6 * 8);
            if (s == 0) pw4 = (u32x4){0u, 0u, 0u, 0u};
            const int j0 = cq * 48 + i6 * 8;
            const float4 ma = *(const float4*)(PT + j0), mb = *(const float4*)(PT + j0 + 4);
            const float mm[8] = {ma.x, ma.y, ma.z, ma.w, mb.x, mb.y, mb.z, mb.w};
            const bool is_t = j0 < 32, is_s = (j0 >= 64) && (j0 < 160);
            const float ca = is_t ? 1.f : 0.f, cb = is_t ? -2.f : 1.f, cc = is_t ? 2.f : -1.f;
            u32x4 w;
#pragma unroll
            for (int e = 0; e < 4; ++e) {
                float o2[2];
#pragma unroll
                for (int q = 0; q < 2; ++q) {
                    const float cv = q ? __uint_as_float(cw4[e] & 0xffff0000u) : __uint_as_float(cw4[e] << 16);
                    const float pv = q ? __uint_as_float(pw4[e] & 0xffff0000u) : __uint_as_float(pw4[e] << 16);
                    const float val = cv + mm[e * 2 + q] * (pv - cv);
                    const float act = ca + cb * __builtin_amdgcn_rcpf(1.f + __expf(cc * val));
                    o2[q] = (is_t || is_s) ? act : val;
                }
                w[e] = pack2(o2[0], o2[1]);
            }
            *(u32x4*)(lin + c * 400 + (cq * 48 + i6 * 8) * 2) = w;
        }
        const bf16_t* LW = (const bf16_t*)(p.ws + WS_W + W_LW) + (size_t)h * 64 * 192;
#pragma unroll
        for (int i6 = 0; i6 < 6; ++i6) *(u32x4*)(LWi + c * 400 + (cq * 48 + i6 * 8) * 2) = *(const u32x4*)(LW + (size_t)c * 192 + cq * 48 + i6 * 8);
    }
    __syncthreads();
    float lw_[16], la_[16], lg_[16], lv_[16];
#pragma unroll
    for (int tj = 0; tj < 4; ++tj) {
        const f32x4 a = tile16(LWi, 400, 16 * tj, lin, 400, 16 * wid, 32);
        const f32x4 bq = tile16(LWi + 64, 400, 16 * tj, lin + 64, 400, 16 * wid, 32);
        const f32x4 cg = tile16(LWi + 128, 400, 16 * tj, lin + 128, 400, 16 * wid, 96);
        const f32x4 dv = tile16(LWi + 320, 400, 16 * tj, lin + 320, 400, 16 * wid, 32);
#pragma unroll
        for (int r = 0; r < 4; ++r) { lw_[tj * 4 + r] = a[r]; la_[tj * 4 + r] = bq[r]; lg_[tj * 4 + r] = cg[r]; lv_[tj * 4 + r] = dv[r]; }
    }
    __syncthreads();
    const int c = 16 * wid + fr;
    float at[16], rt[16], bt[16], kt[16], bh[16], kh[16];
    {
        const int s = n * 64 + c;
        const size_t row = (size_t)(t0 + c);
        const float* mu = p.in[I_MU] + (size_t)li * 1696;
        const int hc = h * 64;
        float rr_[16], kk_[16], lwv[16], aa[16];
        float kn = 0.f, rk = 0.f;
        bf16_t* vf = (bf16_t*)(p.ws + WS_VF);
        bf16_t* gg = (bf16_t*)(p.ws + WS_GG);
#pragma unroll
        for (int tj = 0; tj < 4; ++tj) {
            const int cb = 16 * tj + 4 * fq;
            u32x2 cr = *(const u32x2*)(proj + row * EVLD + C_R + hc + cb), ck = *(const u32x2*)(proj + row * EVLD + C_K + hc + cb), cv = *(const u32x2*)(proj + row * EVLD + C_V + hc + cb);
            const size_t prow = s > 0 ? row - 1 : row;
            u32x2 pr = *(const u32x2*)(proj + prow * EVLD + C_R + hc + cb), pk = *(const u32x2*)(proj + prow * EVLD + C_K + hc + cb), pv = *(const u32x2*)(proj + prow * EVLD + C_V + hc + cb);
            if (s == 0) { pr = (u32x2){0u, 0u}; pk = pr; pv = pr; }
            u32x2 vfw = {0u, 0u};
            if (li == 1) vfw = *(const u32x2*)(vf + row * 512 + hc + cb);
            float vout[4], gout[4];
            const int ch0 = hc + cb;
            const float* pt = PT + 192 + cb;
            const float4 mu_r4 = *(const float4*)(pt), mu_k4 = *(const float4*)(pt + 64), mu_v4 = *(const float4*)(pt + 128);
            const float4 w0_4 = *(const float4*)(pt + 192), a0_4 = *(const float4*)(pt + 256), v0_4 = *(const float4*)(pt + 320);
            const float4 kk_4 = *(const float4*)(pt + 384), ka_4 = *(const float4*)(pt + 448), rk_4 = *(const float4*)(pt + 512);
            const float mur[4] = {mu_r4.x, mu_r4.y, mu_r4.z, mu_r4.w}, muk[4] = {mu_k4.x, mu_k4.y, mu_k4.z, mu_k4.w}, muv[4] = {mu_v4.x, mu_v4.y, mu_v4.z, mu_v4.w};
            const float w0v[4] = {w0_4.x, w0_4.y, w0_4.z, w0_4.w}, a0v[4] = {a0_4.x, a0_4.y, a0_4.z, a0_4.w}, v0v[4] = {v0_4.x, v0_4.y, v0_4.z, v0_4.w};
            const float kkp[4] = {kk_4.x, kk_4.y, kk_4.z, kk_4.w}, kap[4] = {ka_4.x, ka_4.y, ka_4.z, ka_4.w}, rkp[4] = {rk_4.x, rk_4.y, rk_4.z, rk_4.w};
#pragma unroll
            for (int r = 0; r < 4; ++r) {
                const int i = tj * 4 + r;
                const unsigned wcr = r < 2 ? cr.x : cr.y, wck = r < 2 ? ck.x : ck.y, wcv = r < 2 ? cv.x : cv.y;
                const unsigned wpr = r < 2 ? pr.x : pr.y, wpk = r < 2 ? pk.x : pk.y, wpv = r < 2 ? pv.x : pv.y, wvf = r < 2 ? vfw.x : vfw.y;
                const float c_r = (r & 1) ? __uint_as_float(wcr & 0xffff0000u) : __uint_as_float(wcr << 16);
                const float c_k = (r & 1) ? __uint_as_float(wck & 0xffff0000u) : __uint_as_float(wck << 16);
                const float c_v = (r & 1) ? __uint_as_float(wcv & 0xffff0000u) : __uint_as_float(wcv << 16);
                const float p_r = (r & 1) ? __uint_as_float(wpr & 0xffff0000u) : __uint_as_float(wpr << 16);
                const float p_k = (r & 1) ? __uint_as_float(wpk & 0xffff0000u) : __uint_as_float(wpk << 16);
                const float p_v = (r & 1) ? __uint_as_float(wpv & 0xffff0000u) : __uint_as_float(wpv << 16);
                const float rm = c_r + mur[r] * (p_r - c_r);
                const float km = c_k + muk[r] * (p_k - c_k);
                float vm = c_v + muv[r] * (p_v - c_v);
                const float wlog = -softplusf_(-(w0v[r] + lw_[i])) - 0.5f;
                lwv[i] = -__expf(wlog);
                const float a = sigmoidf_(a0v[r] + la_[i]);
                if (li == 1) {
                    const float v1 = (r & 1) ? __uint_as_float(wvf & 0xffff0000u) : __uint_as_float(wvf << 16);
                    vm = vm + (v1 - vm) * sigmoidf_(v0v[r] + lv_[i]);
                }
                const float kkv = km * kkp[r];
                kn += kkv * kkv;
                rr_[i] = rm; kk_[i] = kkv; aa[i] = a;
                kt[i] = km * (1.f + (a - 1.f) * kap[r]);
                rk += rm * kt[i] * rkp[r];
                vout[r] = vm; gout[r] = lg_[i];
            }
            u32x2 w; w.x = pack2(vout[0], vout[1]); w.y = pack2(vout[2], vout[3]);
            *(u32x2*)(vf + row * 512 + hc + cb) = w;
            w.x = pack2(gout[0], gout[1]); w.y = pack2(gout[2], gout[3]);
            *(u32x2*)(gg + row * 512 + hc + cb) = w;
#pragma unroll
            for (int r = 0; r < 4; ++r) *(bf16_t*)(VT + (cb + r) * 144 + c * 2) = f2bf(vout[r]);
            __builtin_amdgcn_sched_barrier(0);
        }
        kn += __shfl_xor(kn, 16); kn += __shfl_xor(kn, 32);
        const float kr = rsqrtf(kn + 1e-6f);
        rk += __shfl_xor(rk, 16); rk += __shfl_xor(rk, 32);
        if (fq == 0) ((float*)(p.ws + WS_RK))[row * 8 + h] = rk;
        float cs[16];
#pragma unroll
        for (int i = 0; i < 16; ++i) {
            float x = lwv[i];
#pragma unroll
            for (int o = 1; o < 16; o <<= 1) { const float y = __shfl_up(x, o, 16); if (fr >= o) x += y; }
            cs[i] = x;
        }
        if (fr == 15) {
#pragma unroll
            for (int i = 0; i < 16; ++i) tot[wid * 64 + 16 * (i >> 2) + 4 * fq + (i & 3)] = cs[i];
        }
        __syncthreads();
#pragma unroll
        for (int i = 0; i < 16; ++i) {
            const int chl = 16 * (i >> 2) + 4 * fq + (i & 3);
            float pre = 0.f, all = 0.f;
#pragma unroll
            for (int w2 = 0; w2 < 4; ++w2) { const float tv = tot[w2 * 64 + chl]; all += tv; if (w2 < wid) pre += tv; }
            const float csi = cs[i] + pre, csm = csi - lwv[i];
            const float kkn = kk_[i] * kr, k2 = kt[i];
            const float e_c = __expf(csi), e_n = __builtin_amdgcn_rcpf(e_c), e_m = __expf(csm), e_h = __expf(all) * e_n;
            at[i] = -kkn * e_m; rt[i] = rr_[i] * e_c;
            const float bp = kkn * aa[i];
            bt[i] = bp * e_n; kt[i] = k2 * e_n; bh[i] = bp * e_h; kh[i] = k2 * e_h;
            if (c == 0) WC[chl] = __expf(all);
            if ((i & 3) == 3) __builtin_amdgcn_sched_barrier(0);
        }
    }
#pragma unroll
    for (int tj = 0; tj < 4; ++tj) {
        const int cb = 16 * tj + 4 * fq;
        u32x2 w;
        w.x = pack2(at[tj * 4], at[tj * 4 + 1]); w.y = pack2(at[tj * 4 + 2], at[tj * 4 + 3]); *(u32x2*)(Arow + c * 144 + cb * 2) = w;
        w.x = pack2(rt[tj * 4], rt[tj * 4 + 1]); w.y = pack2(rt[tj * 4 + 2], rt[tj * 4 + 3]); *(u32x2*)(Rrow + c * 144 + cb * 2) = w;
        w.x = pack2(bt[tj * 4], bt[tj * 4 + 1]); w.y = pack2(bt[tj * 4 + 2], bt[tj * 4 + 3]); *(u32x2*)(Brow + c * 144 + cb * 2) = w;
        w.x = pack2(kt[tj * 4], kt[tj * 4 + 1]); w.y = pack2(kt[tj * 4 + 2], kt[tj * 4 + 3]); *(u32x2*)(Krow + c * 144 + cb * 2) = w;
#pragma unroll
        for (int r = 0; r < 4; ++r) {
            *(bf16_t*)(AT + (cb + r) * 144 + c * 2) = f2bf(at[tj * 4 + r]);
        }
    }
    __syncthreads();
    f32x4 pab[4], pak[4], prb[4], prk[4];
    {
        const int ti = wid;
#pragma unroll
        for (int tj = 0; tj < 4; ++tj) {
            pab[tj] = (f32x4){0.f, 0.f, 0.f, 0.f}; pak[tj] = pab[tj]; prb[tj] = pab[tj]; prk[tj] = pab[tj];
            if (tj <= ti) {
                pab[tj] = tile16(Arow, 144, 16 * ti, Brow, 144, 16 * tj, 64);
                pak[tj] = tile16(Krow, 144, 16 * tj, Arow, 144, 16 * ti, 64);
                prb[tj] = tile16(Brow, 144, 16 * tj, Rrow, 144, 16 * ti, 64);
                prk[tj] = tile16(Krow, 144, 16 * tj, Rrow, 144, 16 * ti, 64);
            }
        }
    }
    __syncthreads();
    {
        const int ti = wid;
#pragma unroll
        for (int tj = 0; tj < 4; ++tj) {
            const int s1 = 16 * tj + fr;
            f32x4 lv;
#pragma unroll
            for (int r = 0; r < 4; ++r) { const int t1 = 16 * ti + 4 * fq + r; lv[r] = (s1 < t1) ? -pab[tj][r] : 0.f; }
            *(f32x4*)&Lf[s1 * 72 + 16 * ti + 4 * fq] = lv;
            const int t2 = 16 * ti + fr;
            float m1[4], m2[4], m3[4];
#pragma unroll
            for (int r = 0; r < 4; ++r) { const int s2 = 16 * tj + 4 * fq + r; m1[r] = (s2 < t2) ? pak[tj][r] : 0.f; m2[r] = (s2 <= t2) ? prb[tj][r] : 0.f; m3[r] = (s2 <= t2) ? prk[tj][r] : 0.f; }
            u32x2 w;
            w.x = pack2(m1[0], m1[1]); w.y = pack2(m1[2], m1[3]); *(u32x2*)(Aak + t2 * 144 + (16 * tj + 4 * fq) * 2) = w;
            w.x = pack2(m2[0], m2[1]); w.y = pack2(m2[2], m2[3]); *(u32x2*)(Arb + t2 * 144 + (16 * tj + 4 * fq) * 2) = w;
            w.x = pack2(m3[0], m3[1]); w.y = pack2(m3[2], m3[3]); *(u32x2*)(Ark + t2 * 144 + (16 * tj + 4 * fq) * 2) = w;
        }
    }
    __syncthreads();
    {
        char* L21i = lds + RP_PT;
        char* T11T = lds + RP_T11;
        char* MT = lds + RP_Z0;
        if (wid < 2) {
            const int o = 32 * wid;
            float Tc[32];
#pragma unroll
            for (int i = 0; i < 32; ++i) Tc[i] = (i == (lane & 31)) ? 1.f : 0.f;
#pragma unroll
            for (int j = 0; j < 31; ++j) {
                const float tj = Tc[j];
#pragma unroll
                for (int i4 = (j + 1) >> 2; i4 < 8; ++i4) {
                    const f32x4 l4 = *(const f32x4*)&Lf[(o + j) * 72 + o + i4 * 4];
#pragma unroll
                    for (int e = 0; e < 4; ++e) if (i4 * 4 + e > j) Tc[i4 * 4 + e] -= l4[e] * tj;
                }
            }
            if (lane < 32) {
#pragma unroll
                for (int i = 0; i < 32; ++i) *(bf16_t*)(Trow + (o + i) * 144 + (o + lane) * 2) = f2bf(Tc[i]);
                if (wid == 0) {
#pragma unroll
                    for (int i = 0; i < 32; ++i) *(bf16_t*)(Trow + i * 144 + (32 + lane) * 2) = 0;
#pragma unroll
                    for (int i4 = 0; i4 < 8; ++i4) { u32x2 w; w.x = pack2(Tc[i4 * 4], Tc[i4 * 4 + 1]); w.y = pack2(Tc[i4 * 4 + 2], Tc[i4 * 4 + 3]); *(u32x2*)(T11T + lane * 80 + i4 * 8) = w; }
                }
            }
        } else {
            const int t2 = tid - 128;
#pragma unroll
            for (int g2 = 0; g2 < 2; ++g2) {
                const int i = t2 & 31, k4 = ((t2 >> 5) + 4 * g2) * 4;
                u32x2 w;
                w.x = pack2(Lf[(k4 + 0) * 72 + 32 + i], Lf[(k4 + 1) * 72 + 32 + i]); w.y = pack2(Lf[(k4 + 2) * 72 + 32 + i], Lf[(k4 + 3) * 72 + 32 + i]);
                *(u32x2*)(L21i + i * 80 + k4 * 2) = w;
            }
        }
        __syncthreads();
        {
            const int r0 = 16 * (wid >> 1), c0 = 16 * (wid & 1);
            const f32x4 mm = tile16(L21i, 80, r0, T11T, 80, c0, 32);
            u32x2 w; w.x = pack2(mm[0], mm[1]); w.y = pack2(mm[2], mm[3]);
            *(u32x2*)(MT + (c0 + fr) * 80 + (r0 + 4 * fq) * 2) = w;
        }
        __syncthreads();
        {
            const int r0 = 16 * (wid >> 1), c0 = 16 * (wid & 1);
            const f32x4 tt = tile16(MT, 80, c0, Trow + 32 * 144 + 64, 144, r0, 32);
            u32x2 w; w.x = pack2(-tt[0], -tt[1]); w.y = pack2(-tt[2], -tt[3]);
            *(u32x2*)(Trow + (32 + r0 + fr) * 144 + (c0 + 4 * fq) * 2) = w;
        }
    }
    __syncthreads();
    {
        const int ti = wid;
#pragma unroll
        for (int tj = 0; tj < 4; ++tj) {
            const f32x4 x = tile16(Trow, 144, 16 * ti, AT, 144, 16 * tj, 64);
            const f32x4 y = tile16(Aak, 144, 16 * ti, VT, 144, 16 * tj, 64);
            u32x2 w;
            w.x = pack2(x[0], x[1]); w.y = pack2(x[2], x[3]); *(u32x2*)(ApT + (16 * tj + fr) * 144 + (16 * ti + 4 * fq) * 2) = w;
            w.x = pack2(y[0], y[1]); w.y = pack2(y[2], y[3]); *(u32x2*)(AkVT + (16 * tj + fr) * 144 + (16 * ti + 4 * fq) * 2) = w;
        }
    }
    __syncthreads();
    {
        const int ti = wid;
#pragma unroll
        for (int tj = 0; tj < 4; ++tj) {
            const f32x4 x = tile16(Trow, 144, 16 * ti, AkVT, 144, 16 * tj, 64);
            u32x2 w; w.x = pack2(x[0], x[1]); w.y = pack2(x[2], x[3]); *(u32x2*)(VpT + (16 * tj + fr) * 144 + (16 * ti + 4 * fq) * 2) = w;
        }
    }
    __syncthreads();
#pragma unroll
    for (int tj = 0; tj < 4; ++tj)
#pragma unroll
        for (int r = 0; r < 4; ++r) {
            const int cb = 16 * tj + 4 * fq + r;
            *(bf16_t*)(BhT + cb * 144 + c * 2) = f2bf(bh[tj * 4 + r]);
            *(bf16_t*)(KhT + cb * 144 + c * 2) = f2bf(kh[tj * 4 + r]);
        }
    __syncthreads();
    {
        unsigned char* opsA = (unsigned char*)p.out + (size_t)ch * 16384;
        unsigned char* opsB = p.ws + WS_ROPS + (size_t)ch * 16384;
        const int ti = wid;
#pragma unroll
        for (int tj = 0; tj < 4; ++tj) {
            const f32x4 x = tile16(ApT, 144, 16 * tj, Arb, 144, 16 * ti, 64);
            const f32x4 g = tile16(ApT, 144, 16 * tj, BhT, 144, 16 * ti, 64);
            const int m1 = 16 * ti + fr, mt = m1 >> 5, rr = m1 & 31, hh = fq & 1, jg = fq >> 1;
            const size_t off = ((size_t)((mt * 4 + tj) * 64 + hh * 32 + rr) * 8 + jg * 4) * 2;
            float gd[4];
#pragma unroll
            for (int r = 0; r < 4; ++r) gd[r] = g[r] + ((16 * tj + 4 * fq + r == m1) ? WC[m1] : 0.f);
            u32x2 w;
            w.x = pack2(x[0] + rt[tj * 4], x[1] + rt[tj * 4 + 1]); w.y = pack2(x[2] + rt[tj * 4 + 2], x[3] + rt[tj * 4 + 3]); *(u32x2*)(opsA + off) = w;
            w.x = pack2(gd[0], gd[1]); w.y = pack2(gd[2], gd[3]); *(u32x2*)(opsA + 8192 + off) = w;
            f32x4 y = tile16(Ark, 144, 16 * ti, VT, 144, 16 * tj, 64);
            const f32x4 y2 = tile16(Arb, 144, 16 * ti, VpT, 144, 16 * tj, 64);
            f32x4 kv = tile16(KhT, 144, 16 * ti, VT, 144, 16 * tj, 64);
            const f32x4 kv2 = tile16(BhT, 144, 16 * ti, VpT, 144, 16 * tj, 64);
            const int vcol = 16 * tj + fr, slice = vcol >> 5, r2 = vcol & 31, cb = 16 * ti + 4 * fq, mt2 = cb >> 5, q4 = (cb & 31) >> 2, h2 = q4 & 1, rg = q4 >> 1;
            const size_t off2 = ((size_t)((slice * 2 + mt2) * 64 + h2 * 32 + r2) * 16 + rg * 4) * 2;
            w.x = pack2(y[0] + y2[0], y[1] + y2[1]); w.y = pack2(y[2] + y2[2], y[3] + y2[3]); *(u32x2*)(opsB + off2) = w;
            w.x = pack2(kv[0] + kv2[0], kv[1] + kv2[1]); w.y = pack2(kv[2] + kv2[2], kv[3] + kv2[3]); *(u32x2*)(opsB + 8192 + off2) = w;
        }
    }
}

DI void rwkv_scan_block(const P& p, int bh, char* lds, bool dry = false) {
    const int tid = tidx(), lane = tid & 63, w = tid >> 6, slice = w & 1;
    const int h = bh & 7, b = bh >> 3;
    constexpr int NST = 64 * 2, AH = 3;
    auto issue = [&](int j) {
        if (w < 2) return;
        const int n = j >> 1, k = j & 1, lt = tid - 128;
        const size_t ch = (size_t)((b * 64 + n) * 8 + h) * 16384;
        const unsigned char* s0 = (k == 0 ? p.ws + WS_ROPS + ch + 8192 : p.ws + WS_ROPS + ch) + lt * 16;
        const unsigned char* s1 = (k == 0 ? (const unsigned char*)p.out + ch + 8192 : (const unsigned char*)p.out + ch) + lt * 16;
        char* dst = lds + (j & 3) * 16384 + lt * 16;
#pragma unroll
        for (int q = 0; q < 4; ++q) { glds16nt(s0 + q * 2048, dst + q * 2048); glds16nt(s1 + q * 2048, dst + 8192 + q * 2048); }
    };
    const unsigned la = (unsigned)(size_t)(lds_u32*)lds + lane * 16;
    f32x16 H[2];
#pragma unroll
    for (int i = 0; i < 2; ++i)
#pragma unroll
        for (int r = 0; r < 16; ++r) H[i][r] = 0.f;
    __syncthreads();
#pragma unroll
    for (int j = 0; j < AH; ++j) issue(j);
#pragma unroll 1
    for (int n = 0; n < 64; ++n) {
        bf16x8 Hb[4];
#pragma unroll
        for (int i = 0; i < 2; ++i) { Hb[i * 2] = pack_step(H[i], 0); Hb[i * 2 + 1] = pack_step(H[i], 1); }
#pragma unroll
        for (int k = 0; k < 2; ++k) {
            const int j = n * 2 + k;
            if (w >= 2) { if (n < 63) GS_WAIT(16); else if (k == 0) GS_WAIT(8); else GS_WAIT(0); }
            __builtin_amdgcn_s_barrier();
            if (j + AH < NST) issue(j + AH);
            __builtin_amdgcn_sched_barrier(0);
            const char* sl = lds + (j & 3) * 16384;
            if (w < 2) {
                f32x16 acc[2];
                bf16x8 F[4];
                const unsigned fa = la + (unsigned)((j & 3) * 16384 + 8192);
#define RS_O(i) (unsigned)((((i) & 1) * 4 + ((i) >> 1)) * 1024)
#pragma unroll
                for (int i = 0; i < 4; ++i) fr_rd(F[i], fa + RS_O(i));
                u32x4 uu[2][2];
#pragma unroll
                for (int mt = 0; mt < 2; ++mt) {
                    const u32x4* up = (const u32x4*)(sl + (slice * 2 + mt) * 2048 + lane * 32);
                    uu[mt][0] = up[0]; uu[mt][1] = up[1];
#pragma unroll
                    for (int r = 0; r < 16; ++r) acc[mt][r] = 0.f;
                }
#pragma unroll
                for (int i = 0; i < 8; ++i) {
                    if (i <= 4) fr_wait<3>(F[i & 3]); else if (i == 5) fr_wait<2>(F[i & 3]); else if (i == 6) fr_wait<1>(F[i & 3]); else fr_wait<0>(F[i & 3]);
                    acc[i & 1] = mfma32(F[i & 3], Hb[i >> 1], acc[i & 1]);
                    if (i + 4 < 8) fr_rd(F[i & 3], fa + RS_O(i + 4));
                }
#pragma unroll
                for (int mt = 0; mt < 2; ++mt)
#pragma unroll
                    for (int e = 0; e < 4; ++e) {
                        acc[mt][e * 2] += __uint_as_float(uu[mt][0][e] << 16); acc[mt][e * 2 + 1] += __uint_as_float(uu[mt][0][e] & 0xffff0000u);
                        acc[mt][8 + e * 2] += __uint_as_float(uu[mt][1][e] << 16); acc[mt][8 + e * 2 + 1] += __uint_as_float(uu[mt][1][e] & 0xffff0000u);
                    }
                if (k == 0) { H[0] = acc[0]; H[1] = acc[1]; }
                else {
                    const size_t ch = (size_t)((b * 64 + n) * 8 + h) * 16384;
                    u32x4* Yf = (u32x4*)(dry ? p.ws + WS_DUMMY + 2097152 + (size_t)(bh & 31) * 16384 : p.ws + WS_ROPS + ch) + (size_t)(slice * 128 + lane) * 2;
#pragma unroll
                    for (int mt = 0; mt < 2; ++mt) {
                        u32x4 o0, o1;
#pragma unroll
                        for (int e = 0; e < 4; ++e) { o0[e] = pack2(acc[mt][e * 2], acc[mt][e * 2 + 1]); o1[e] = pack2(acc[mt][8 + e * 2], acc[mt][8 + e * 2 + 1]); }
                        Yf[mt * 128] = o0; Yf[mt * 128 + 1] = o1;
                    }
                }
            }
        }
    }
    __syncthreads();
}

DI void rwkv_post_unit(const P& p, int li, int ch, char* lds) {
    const int tid = tidx();
    const int h = ch & 7, n = (ch >> 3) & 63, b = ch >> 9;
    const int t0 = b * SEQ + n * 64;
    const int c = tid >> 2, cq = tid & 3;
    {
        const u32x4* Yg = (const u32x4*)(p.ws + WS_ROPS + (size_t)ch * 16384);
        __syncthreads();
#pragma unroll
        for (int i = 0; i < 2; ++i) ((u32x4*)lds)[tid + 256 * i] = __builtin_nontemporal_load(Yg + tid + 256 * i);
        __syncthreads();
    }
    const bf16_t* Yf = (const bf16_t*)lds;
    const bf16_t* vf = (const bf16_t*)(p.ws + WS_VF) + (size_t)(t0 + c) * 512 + h * 64 + cq * 16;
    const bf16_t* gg = (const bf16_t*)(p.ws + WS_GG) + (size_t)(t0 + c) * 512 + h * 64 + cq * 16;
    const float rk = ((const float*)(p.ws + WS_RK))[(size_t)(t0 + c) * 8 + h];
    const float* lnw = p.in[I_LNW] + li * 512 + h * 64 + cq * 16;
    const float* lnb = p.in[I_LNB] + li * 512 + h * 64 + cq * 16;
    bf16_t* mp = (bf16_t*)p.out + (size_t)(t0 + c) * 1024 + 512 + h * 64 + cq * 16;
    const int mt = c >> 5, q4 = (c & 31) >> 2, hh = q4 & 1, rg = q4 >> 1, reg = rg * 4 + (c & 3), slice = cq >> 1, rb = (cq & 1) * 16;
    float y[16]; float sm = 0.f;
#pragma unroll
    for (int i = 0; i < 16; ++i) { y[i] = bf2f(Yf[(size_t)((slice * 2 + mt) * 64 + hh * 32 + rb + i) * 16 + reg]); sm += y[i]; }
    sm += __shfl_xor(sm, 1); sm += __shfl_xor(sm, 2);
    const float mean = sm * (1.f / 64.f);
    float vs = 0.f;
#pragma unroll
    for (int i = 0; i < 16; ++i) { y[i] -= mean; vs += y[i] * y[i]; }
    vs += __shfl_xor(vs, 1); vs += __shfl_xor(vs, 2);
    const float rs = rsqrtf(vs * (1.f / 64.f) + 64e-5f);
#pragma unroll
    for (int i8 = 0; i8 < 2; ++i8) {
        const u32x4 vw = *(const u32x4*)(vf + i8 * 8), gw = *(const u32x4*)(gg + i8 * 8);
        u32x4 w;
#pragma unroll
        for (int e = 0; e < 4; ++e) {
            const int i = i8 * 8 + e * 2;
            const float v0 = __uint_as_float(vw[e] << 16), v1 = __uint_as_float(vw[e] & 0xffff0000u), g0 = __uint_as_float(gw[e] << 16), g1 = __uint_as_float(gw[e] & 0xffff0000u);
            w[e] = pack2((y[i] * rs * lnw[i] + lnb[i] + rk * v0) * g0, (y[i + 1] * rs * lnw[i + 1] + lnb[i + 1] + rk * v1) * g1);
        }
        *(u32x4*)(mp + i8 * 8) = w;
    }
}


DI void attn_unit(const P& p, int unit, char* lds) {
    const int tid = tidx(), lane = tid & 63, w = tid >> 6, r_ = lane & 31, hl = lane >> 5;
    const int idx = unit & 31, h = (unit >> 5) & 7, g = (unit >> 8) % 3, b = unit / 768;
    const int lg2 = g * 2, dil = 1 << lg2, L = SEQ >> lg2, ntl = L >> 7;
    const int rs = idx / ntl, qt = idx % ntl;
    const int hg = g * 8 + h;
    const bf16_t* QK = (const bf16_t*)(p.ws + WS_QK);
    const bf16_t* VT = (const bf16_t*)(p.ws + WS_VT) + ((size_t)((b * 24 + hg) * dil + rs) * 64) * L;
    const int qi = 32 * w + r_;
    const int q_idx = 128 * qt + qi;
    const size_t qrow = (size_t)(b * SEQ + q_idx * dil + rs);
    const int kbase0 = 128 * qt - 128;
    char* Kt = lds;
    char* Vt = lds + 32768;
    __syncthreads();
#pragma unroll
    for (int i = 0; i < 8; ++i) {
        const int id = tid + i * 256, row = id >> 3, pc = id & 7, c = pc ^ ((row >> 1) & 7);
        int k_idx = kbase0 + row; if (k_idx < 0) k_idx = 0;
        glds16(QK + (size_t)(b * SEQ + k_idx * dil + rs) * 3072 + 1536 + hg * 64 + c * 8, Kt + id * 16);
    }
#pragma unroll
    for (int i = 0; i < 8; ++i) {
        const int id = tid + i * 256, row = id >> 5, pq = id & 31, q = pq ^ (row & 31);
        int k0 = kbase0 + q * 8; if (k0 < 0) k0 = 0;
        glds16(VT + (size_t)row * L + k0, Vt + id * 16);
    }
    bf16x8 qf[4];
#pragma unroll
    for (int ks = 0; ks < 4; ++ks) qf[ks] = *(const bf16x8*)(QK + qrow * 3072 + hg * 64 + 16 * ks + 8 * hl);
    asm volatile("s_waitcnt vmcnt(0)" ::: "memory");
    __syncthreads();
    f32x16 st[5];
    float mx = -1.0e30f;
#pragma unroll
    for (int kbi = 0; kbi < 5; ++kbi) {
        const int krow = 32 * (w + kbi) + r_;
#pragma unroll
        for (int r = 0; r < 16; ++r) st[kbi][r] = 0.f;
#pragma unroll
        for (int ks = 0; ks < 4; ++ks) {
            const bf16x8 kf = *(const bf16x8*)(Kt + krow * 128 + (((2 * ks + hl) ^ ((krow >> 1) & 7)) * 16));
            st[kbi] = mfma32(kf, qf[ks], st[kbi]);
        }
        if (kbi >= 1 && kbi <= 3 && kbase0 >= 0) {
#pragma unroll
            for (int r = 0; r < 16; ++r) mx = fmaxf(mx, st[kbi][r]);
        } else {
#pragma unroll
            for (int r = 0; r < 16; ++r) {
                const int kj = 32 * (w + kbi) + (r & 3) + 8 * (r >> 2) + 4 * hl;
                const bool valid = kbi == 0 ? ((kj >= qi) && (kbase0 + kj >= 0)) : kbi == 4 ? (kj <= qi + 128) : ((kj >= qi) && (kj <= qi + 128) && (kbase0 + kj >= 0));
                const float sv = valid ? st[kbi][r] : -1.0e30f;
                st[kbi][r] = sv; mx = fmaxf(mx, sv);
            }
        }
    }
    mx = fmaxf(mx, __shfl_xor(mx, 32));
    float l = 0.f;
#pragma unroll
    for (int kbi = 0; kbi < 5; ++kbi)
#pragma unroll
        for (int r = 0; r < 16; ++r) { const float pv = __builtin_amdgcn_exp2f(st[kbi][r] - mx); st[kbi][r] = pv; l += pv; }
    l += __shfl_xor(l, 32);
    f32x16 ot[2];
#pragma unroll
    for (int dt = 0; dt < 2; ++dt)
#pragma unroll
        for (int r = 0; r < 16; ++r) ot[dt][r] = 0.f;
#pragma unroll
    for (int kbi = 0; kbi < 5; ++kbi)
#pragma unroll
        for (int s2 = 0; s2 < 2; ++s2) {
            const bf16x8 pb = pack_step(st[kbi], s2);
            const int q0 = 4 * (w + kbi) + 2 * s2;
#pragma unroll
            for (int dt = 0; dt < 2; ++dt) {
                const int drow = 32 * dt + r_;
                const u32x2 lo = *(const u32x2*)(Vt + drow * 512 + ((q0 ^ (drow & 31)) * 16) + 8 * hl);
                const u32x2 hi = *(const u32x2*)(Vt + drow * 512 + (((q0 + 1) ^ (drow & 31)) * 16) + 8 * hl);
                u32x4 vw; vw.x = lo.x; vw.y = lo.y; vw.z = hi.x; vw.w = hi.y;
                ot[dt] = mfma32(__builtin_bit_cast(bf16x8, vw), pb, ot[dt]);
            }
        }
    const float inv = 1.f / l;
    bf16_t* og = (bf16_t*)(p.ws + WS_OG) + ((size_t)g * T + qrow) * 512 + h * 64;
#pragma unroll
    for (int dt = 0; dt < 2; ++dt)
#pragma unroll
        for (int rg = 0; rg < 4; ++rg) {
            u32x2 wv; wv.x = pack2(ot[dt][rg * 4] * inv, ot[dt][rg * 4 + 1] * inv); wv.y = pack2(ot[dt][rg * 4 + 2] * inv, ot[dt][rg * 4 + 3] * inv);
            *(u32x2*)(og + 32 * dt + 8 * rg + 4 * hl) = wv;
        }
    if (hl == 0) ((float*)(p.ws + WS_LSE))[((size_t)g * T + qrow) * 8 + h] = mx * 0.69314718f + __logf(l);
}
DI void phase_attn_merge(const P& p) {
    const bf16_t* og = (const bf16_t*)(p.ws + WS_OG);
    const float* lse = (const float*)(p.ws + WS_LSE);
    bf16_t* o = (bf16_t*)p.out;
    for (int i = bidx() * 256 + tidx(); i < T * 64; i += gridDim.x * 256) {
        const int t = i >> 6, c8 = i & 63, h = c8 >> 3;
        const float l0 = lse[(size_t)t * 8 + h], l1 = lse[((size_t)T + t) * 8 + h], l2 = lse[((size_t)2 * T + t) * 8 + h];
        const float m = fmaxf(l0, fmaxf(l1, l2));
        float w0 = __expf(l0 - m), w1 = __expf(l1 - m), w2 = __expf(l2 - m);
        const float inv = 1.f / (w0 + w1 + w2); w0 *= inv; w1 *= inv; w2 *= inv;
        const u32x4 a = __builtin_nontemporal_load((const u32x4*)(og + (size_t)t * 512 + c8 * 8)), bq = __builtin_nontemporal_load((const u32x4*)(og + ((size_t)T + t) * 512 + c8 * 8)), cq = __builtin_nontemporal_load((const u32x4*)(og + ((size_t)2 * T + t) * 512 + c8 * 8));
        u32x4 r;
#pragma unroll
        for (int e = 0; e < 4; ++e) {
            const float x0 = w0 * __uint_as_float(a[e] << 16) + w1 * __uint_as_float(bq[e] << 16) + w2 * __uint_as_float(cq[e] << 16);
            const float x1 = w0 * __uint_as_float(a[e] & 0xffff0000u) + w1 * __uint_as_float(bq[e] & 0xffff0000u) + w2 * __uint_as_float(cq[e] & 0xffff0000u);
            r[e] = pack2(x0, x1);
        }
        *(u32x4*)(o + (size_t)t * 512 + c8 * 8) = r;
    }
}


#define XB_TMO      128
#define XB_XCNT(j)  (256  + 64 * (j))
#define XB_XSUB(j)  (1280 + 64 * (j))
#define XB_XGEN(j)  (2304 + 64 * (j))
#define XB_TOP      3328
#define XB_TOPGEN   3392
#define XCD_BAR_WORDS 3456
#define XB_SPIN_CAP (1u << 22)
#define LAS __attribute__((address_space(3)))
DI unsigned xb_ld(unsigned* p)              { return __hip_atomic_load(p, __ATOMIC_RELAXED, __HIP_MEMORY_SCOPE_AGENT); }
DI unsigned xb_add(unsigned* p, unsigned v) { return __hip_atomic_fetch_add(p, v, __ATOMIC_RELAXED, __HIP_MEMORY_SCOPE_AGENT); }
DI unsigned xb_xcc_id() { return (unsigned)__builtin_amdgcn_s_getreg((3 << 11) | 20) & 0xFu; }
#define XB_SPIN(cond, bar) do { unsigned _sp = 0; while (cond) { if (_sp < 32u) __builtin_amdgcn_s_sleep(2); else __builtin_amdgcn_s_sleep(24); \
    if ((++_sp & 255u) == 0u) { if (xb_ld(&(bar)[XB_TMO])) break; if (_sp > XB_SPIN_CAP) { atomicAdd(&(bar)[XB_TMO], 1u); break; } } } } while (0)
struct XcdBarrier { unsigned* bar; unsigned x; volatile LAS unsigned* st; };
DI XcdBarrier xcd_barrier_post(unsigned* bar, volatile LAS unsigned* st) {
    XcdBarrier b; b.bar = bar; b.x = xb_xcc_id(); b.st = st;
    if (threadIdx.x == 0) (void)xb_add(&bar[XB_XCNT(b.x)], 1u);
    return b;
}
DI void xcd_barrier_complete(unsigned* bar, unsigned x, unsigned& nloc, unsigned& nx) {
    const unsigned G = gridDim.x * gridDim.y * gridDim.z;
    unsigned sum, cnt, mine, sp = 0u;
    for (;;) {
        sum = 0u; cnt = 0u; mine = 0u;
#pragma unroll
        for (unsigned j = 0; j < 16; ++j) { const unsigned c = xb_ld(&bar[XB_XCNT(j)]); sum += c; cnt += (c > 0u) ? 1u : 0u; mine = (j == x) ? c : mine; }
        if (sum == G) break;
        __builtin_amdgcn_s_sleep(1);
        if ((++sp & 255u) == 0u) { if (xb_ld(&bar[XB_TMO])) break; if (sp > XB_SPIN_CAP) { atomicAdd(&bar[XB_TMO], 1u); break; } }
    }
    nloc = mine > 0u ? mine : 1u; nx = cnt > 0u ? cnt : 1u;
}
DI void xcd_barrier(const XcdBarrier& b) {
    asm volatile("s_waitcnt vmcnt(0)" ::: "memory");
    __syncthreads();
    if (threadIdx.x == 0) {
        unsigned* bar = b.bar; unsigned bx = b.x;
        asm volatile("" : "+s"(bar), "+s"(bx));
        __builtin_amdgcn_s_waitcnt(0);
        unsigned nloc = b.st[0], nx = b.st[1];
        if (nloc == 0u) { xcd_barrier_complete(bar, bx, nloc, nx); b.st[0] = nloc; b.st[1] = nx; }
        const unsigned old = xb_add(&bar[XB_XSUB(bx)], 1u);
        const unsigned gen = old / nloc;
        if (old + 1u == (gen + 1u) * nloc) {
            __builtin_amdgcn_fence(__ATOMIC_RELEASE, "agent");
            asm volatile("s_waitcnt vmcnt(0)" ::: "memory");
            const unsigned og = xb_add(&bar[XB_TOP], 1u);
            const unsigned tg = og / nx;
            if (og + 1u == (tg + 1u) * nx) xb_add(&bar[XB_TOPGEN], 1u);
            else XB_SPIN(xb_ld(&bar[XB_TOPGEN]) == tg, bar);
            __builtin_amdgcn_fence(__ATOMIC_ACQUIRE, "agent");
            xb_add(&bar[XB_XGEN(bx)], 1u);
            asm volatile("s_waitcnt vmcnt(0)" ::: "memory");
        } else {
            XB_SPIN(xb_ld(&bar[XB_XGEN(bx)]) == gen, bar);
            __builtin_amdgcn_fence(__ATOMIC_ACQUIRE, "agent");
            asm volatile("s_waitcnt vmcnt(0)" ::: "memory");
        }
    }
    __syncthreads();
}

constexpr int LDS_BYTES = RP_END;
static_assert(GP_END + 6144 <= LDS_BYTES, "LDS");
__global__ void __launch_bounds__(256, 2) __attribute__((amdgpu_waves_per_eu(2, 2))) mega(P p) {
    cg::grid_group grid = cg::this_grid();
    extern __shared__ __attribute__((aligned(16))) char lds[];
    if (threadIdx.x < 4) ((volatile LAS unsigned*)(lds + LDS_BYTES))[threadIdx.x] = 0u;
    __syncthreads();
    const XcdBarrier xb = xcd_barrier_post((unsigned*)(p.ws + WS_CTL + CTL_BAR), (volatile LAS unsigned*)(lds + LDS_BYTES));
#define GSYNC() xcd_barrier(xb)
    const bf16_t* HN = (const bf16_t*)p.out;
    const bf16_t* XB = (const bf16_t*)(p.ws + WS_XB);
    const bf16_t* Win = (const bf16_t*)(p.ws + WS_W + W_IN);
    const bf16_t* Wout = (const bf16_t*)(p.ws + WS_W + W_OUT);
    {
        const unsigned hw = (unsigned)__builtin_amdgcn_s_getreg((31 << 11) | 4);
        const unsigned key = 1u + ((xb.x << 16) | (hw & 0xFF00u));
        if (threadIdx.x == 0) ((unsigned*)(p.ws + WS_CTL + CTL_CUTAB))[bidx()] = key;
    }
    phase_rope(p);
    phase_convert_io(p, 0, lds, bidx(), gridDim.x);
    phase_prep<0>(p, p.in[I_EVNORM], 0);
    if (p.ws == nullptr) grid.sync();
    GSYNC();
    volatile LAS unsigned* qword = (volatile LAS unsigned*)(lds + LDS_BYTES + 8);
    int idle2, idle3, rank3, nact3;
    {
        const unsigned* cut = (const unsigned*)(p.ws + WS_CTL + CTL_CUTAB);
        unsigned* keys = (unsigned*)lds; unsigned* cntw = keys + 2048;
        const int G = (int)gridDim.x < 2048 ? (int)gridDim.x : 2048;
        __syncthreads();
        for (int j = threadIdx.x; j < G; j += 256) keys[j] = cut[j];
        if (threadIdx.x < 8) cntw[threadIdx.x] = 0u;
        __syncthreads();
        for (int j = threadIdx.x; j < G; j += 256) {
            bool sh16 = false, sh32 = false; int nsh = 0;
            for (int k = 0; k < 32 && k < G; ++k) { const bool eq = keys[k] == keys[j] && k != j; if (eq) { sh32 = true; ++nsh; if (k < 16) sh16 = true; } }
            const bool act3 = j >= 32 && !sh32;
            if (act3) { atomicAdd(&cntw[0], 1u); if (j < bidx()) atomicAdd(&cntw[1], 1u); }
            if (j == bidx()) { cntw[2] = (j >= 16 && sh16) ? 1u : 0u; cntw[3] = (j >= 32 && sh32) ? 1u : 0u; }
            if (keys[j] == 0u || nsh > 1) atomicAdd(&cntw[4], 1u);
            if (sh32) atomicAdd(&cntw[5], 1u);
        }
        __syncthreads();
        nact3 = __builtin_amdgcn_readfirstlane((int)cntw[0]); rank3 = __builtin_amdgcn_readfirstlane((int)cntw[1]);
        idle2 = __builtin_amdgcn_readfirstlane((int)cntw[2]); idle3 = __builtin_amdgcn_readfirstlane((int)cntw[3]);
        const int bad = __builtin_amdgcn_readfirstlane((int)cntw[4]), nshare = __builtin_amdgcn_readfirstlane((int)cntw[5]);
        if (bad > 0 || nshare > 64 || nact3 < (int)gridDim.x / 2) {
            idle2 = 0; idle3 = 0; nact3 = (int)gridDim.x - 32; rank3 = bidx() - 32;
        }
        if (nact3 < 1) { nact3 = 1; }
        __syncthreads();
    }
    for (int layer = 0; layer < 4; ++layer) {
        const int li = layer >> 1;
        if ((layer & 1) == 0) {
            phase_gemm_even160(p, XB, Win, lds);
            GSYNC();
            for (int u = bidx(); u < 1024; u += gridDim.x) gdn_prep_unit(p, li, u, lds);
            GSYNC();
            if (bidx() < 16) gdn_scan_block(p, bidx(), lds);
            if (!idle2) {
                unsigned* qctr = (unsigned*)(p.ws + WS_CTL + CTL_QUEUE) + li * 64;
                for (;;) {
                    __syncthreads();
                    if (threadIdx.x == 0) *qword = atomicAdd(qctr, 1u);
                    __syncthreads();
                    const unsigned u = *qword;
                    if (u >= 2048u + 768u) break;
                    if (u < 2048u) rwkv_prep_unit(p, li, (int)u, lds);
                    else convert_moe_tile(p, layer + 1, lds, (int)u - 2048);
                }
            }
            GSYNC();
            if (bidx() < 32) rwkv_scan_block(p, bidx(), lds);
            else if (!idle3) {
                for (int u = rank3; u < 1024; u += nact3) gdn_post_unit(p, li, u, lds);
                phase_convert_moe(p, layer, lds, rank3, nact3);
            }
            GSYNC();
            for (int u = bidx(); u < 2048; u += gridDim.x) rwkv_post_unit(p, li, u, lds);
            GSYNC();
            phase_gemm<EPI_RESID>(p, (const bf16_t*)(p.ws + WS_PROJ), EVLD, Wout, 1024, 8, lds, false, HN, 1024, 512);
        } else {
            phase_gemm<EPI_ODD_IN>(p, XB, 1024, Win, 1024, ODC / 128, lds);
            GSYNC();
            for (int u = bidx(); u < 3072; u += gridDim.x) attn_unit(p, u, lds);
            GSYNC();
            phase_attn_merge(p);
            GSYNC();
            phase_gemm<EPI_RESID>(p, HN, 512, Wout, 512, 8, lds);
        }
        GSYNC();
        phase_router(p, p.in[I_FFNNORM] + layer * 1024, layer, lds);
        GSYNC();
        {
            const int nt = phase_moe_up(p, layer, lds);
            if (layer < 3) {
                const int G = (int)gridDim.x, rounds = (nt + G - 1) / G, first = nt - (rounds - 1) * G;
                if (first >= G) phase_convert_io(p, layer + 1, lds, bidx(), G);
                else if (bidx() >= first) phase_convert_io(p, layer + 1, lds, bidx() - first, G - first);
            }
        }
        GSYNC();
        phase_moe_down(p, layer, lds);
        GSYNC();
        if (layer < 3) {
            phase_prep<1>(p, ((layer + 1) & 1) ? p.in[I_ODNORM] + ((layer + 1) >> 1) * 1024 : p.in[I_EVNORM] + ((layer + 1) >> 1) * 1024, layer + 1);
            GSYNC();
        }
    }
    phase_prep<3>(p, p.in[I_FINAL], 0);
}

extern "C" void kernel_launch(void* const* d_in, const int* in_sizes, int n_in, void* d_out, int out_size, void* d_ws, size_t ws_size, hipStream_t stream) {
    if (n_in != 34 || out_size != T * D || ws_size < WS_NEED) { fprintf(stderr, "kernel_launch: unexpected shapes (n_in %d out %d ws %zu need %zu)\n", n_in, out_size, ws_size, (size_t)WS_NEED); return; }
    static int grid_blocks = 0;
    if (!grid_blocks) {
        int dev = 0, cus = 0, per_cu = 0;
        (void)hipGetDevice(&dev);
        (void)hipDeviceGetAttribute(&cus, hipDeviceAttributeMultiprocessorCount, dev);
        (void)hipFuncSetAttribute((const void*)mega, hipFuncAttributeMaxDynamicSharedMemorySize, LDS_BYTES + 16);
        (void)hipOccupancyMaxActiveBlocksPerMultiprocessor(&per_cu, mega, 256, LDS_BYTES + 16);
        if (per_cu < 1) per_cu = 1;
        if (per_cu > 2) per_cu = 2;
        grid_blocks = cus * per_cu;
    }
    P p{};
    for (int i = 0; i < 34; ++i) p.in[i] = (const float*)d_in[i];
    p.out = (float*)d_out; p.ws = (unsigned char*)d_ws;
    (void)hipMemsetAsync((char*)d_ws + WS_CTL, 0, 65536, stream);
    void* args[] = {&p};
    hipError_t e = hipLaunchCooperativeKernel((void*)mega, dim3(grid_blocks), dim3(256), args, LDS_BYTES + 16, stream);
    if (e != hipSuccess) fprintf(stderr, "cooperative launch failed: %s (grid %d)\n", hipGetErrorString(e), grid_blocks);
}
```
